# Optimizing an MI355X kernel written in HIP

```python
import math
import jax, jax.numpy as jnp
from jax import lax
import numpy as np

D_MODEL = 2048
BATCH = 4
SEQ = 2048
DEPTH = 1

D_MIX = D_MODEL
SSD_WIDTH = D_MIX // 2
SSD_HEAD_DIM = 64
SSD_HEADS = SSD_WIDTH // SSD_HEAD_DIM
SSD_GROUPS = 2
SSD_HPG = SSD_HEADS // SSD_GROUPS
SSD_STATE = 128
SSD_CONV = 4
SSD_CHUNK = 128
XBC_WIDTH = SSD_WIDTH + 2 * SSD_GROUPS * SSD_STATE
DA_WIDTH = D_MIX - SSD_WIDTH
DA_HEAD_DIM = 128
DA_HALF = DA_HEAD_DIM // 2
DA_HEADS = DA_WIDTH // DA_HEAD_DIM
Q_BLOCK = 128
IN_COLS = SSD_WIDTH + XBC_WIDTH + SSD_HEADS + 3 * DA_WIDTH
MEM_LEN = 256
XA_HEADS = 4
XA_HEAD_DIM = D_MODEL // XA_HEADS
N_EXPERTS = 32
TOP_K = 4
D_FF = D_MODEL
SWIGLU_LIMIT = 7.0
SWIGLU_ALPHA = 1.702
MOE_BLOCK = 256
EPS = 1e-6

kernel_name = 'hymba_ssd_diffattn_xmem_moe_layer'


def rms_norm(u, g):
    uf = u.astype(jnp.float32)
    uf = uf * lax.rsqrt(jnp.mean(uf * uf, axis=-1, keepdims=True) + EPS)
    return uf.astype(u.dtype) * g


def causal_depthwise_conv(u, w, b):
    out = lax.conv_general_dilated(
        u, w[:, None, :].astype(u.dtype), window_strides=(1,),
        padding=[(SSD_CONV - 1, 0)], dimension_numbers=('NWC', 'WIO', 'NWC'),
        feature_group_count=u.shape[-1])
    return out + b


def ssd_chunked_scan(xh, dt, a, bm, cm):
    bsz, s = xh.shape[0], xh.shape[1]
    nc, L = s // SSD_CHUNK, SSD_CHUNK
    f32 = jnp.float32
    x = (xh.astype(f32) * dt[..., None]).reshape(bsz, nc, L, SSD_GROUPS, SSD_HPG, SSD_HEAD_DIM)
    adt = (dt * a).reshape(bsz, nc, L, SSD_GROUPS, SSD_HPG)
    bmc = bm.astype(f32).reshape(bsz, nc, L, SSD_GROUPS, SSD_STATE)
    cmc = cm.astype(f32).reshape(bsz, nc, L, SSD_GROUPS, SSD_STATE)
    acum = jnp.cumsum(adt, axis=2)
    seg = acum[:, :, :, None] - acum[:, :, None, :]
    causal = jnp.tril(jnp.ones((L, L), dtype=bool))[None, None, :, :, None, None]
    decay = jnp.exp(jnp.where(causal, seg, -jnp.inf))
    cb = jnp.einsum('bclgn,bcsgn->bcgls', cmc, bmc)
    y_diag = jnp.einsum('bcgls,bclsgr,bcsgrp->bclgrp', cb, decay, x)
    decay_to_end = jnp.exp(acum[:, :, -1:] - acum)
    states = jnp.einsum('bclgn,bclgr,bclgrp->bcgrpn', bmc, decay_to_end, x)
    chunk_decay = jnp.exp(acum[:, :, -1])

    def step(h, inp):
        st, dec = inp
        return h * dec[..., None, None] + st, h

    h0 = jnp.zeros((bsz, SSD_GROUPS, SSD_HPG, SSD_HEAD_DIM, SSD_STATE), f32)
    _, h_in = lax.scan(step, h0, (jnp.moveaxis(states, 1, 0), jnp.moveaxis(chunk_decay, 1, 0)))
    h_in = jnp.moveaxis(h_in, 0, 1)
    y_off = jnp.einsum('bclgn,bcgrpn,bclgr->bclgrp', cmc, h_in, jnp.exp(acum))
    return (y_diag + y_off).reshape(bsz, s, SSD_GROUPS, SSD_HPG, SSD_HEAD_DIM)


def ssd_group(z, xbc, dt_raw, conv_w, conv_b, dt_bias, a_log, d_skip, norm_g):
    bsz, s = z.shape[0], z.shape[1]
    xbc = jax.nn.silu(causal_depthwise_conv(xbc, conv_w, conv_b))
    xs = xbc[..., :SSD_WIDTH].reshape(bsz, s, SSD_GROUPS, SSD_HPG, SSD_HEAD_DIM)
    bm = xbc[..., SSD_WIDTH:SSD_WIDTH + SSD_GROUPS * SSD_STATE].reshape(bsz, s, SSD_GROUPS, SSD_STATE)
    cm = xbc[..., SSD_WIDTH + SSD_GROUPS * SSD_STATE:].reshape(bsz, s, SSD_GROUPS, SSD_STATE)
    dt = jax.nn.softplus(dt_raw.astype(jnp.float32) + dt_bias.astype(jnp.float32))
    dt = dt.reshape(bsz, s, SSD_GROUPS, SSD_HPG)
    a = -jnp.exp(a_log.astype(jnp.float32)).reshape(SSD_GROUPS, SSD_HPG)
    y = ssd_chunked_scan(xs, dt, a, bm, cm)
    y = y + xs.astype(jnp.float32) * d_skip.astype(jnp.float32).reshape(SSD_GROUPS, SSD_HPG)[..., None]
    y = y.astype(z.dtype).reshape(bsz, s, SSD_WIDTH) * jax.nn.silu(z)
    y = rms_norm(y.reshape(bsz, s, SSD_GROUPS, SSD_WIDTH // SSD_GROUPS),
                 jnp.ones((), y.dtype)).reshape(bsz, s, SSD_WIDTH) * norm_g
    return y


def diff_attention_group(q, k, v, q_norm_g, k_norm_g, lq1, lk1, lq2, lk2, subln_g, lam_init):
    bsz, s = q.shape[0], q.shape[1]
    q = rms_norm(q.reshape(bsz, s, DA_HEADS, 2, DA_HALF), q_norm_g) * (DA_HALF ** -0.5)
    k = rms_norm(k.reshape(bsz, s, DA_HEADS, 2, DA_HALF), k_norm_g)
    v = v.reshape(bsz, s, DA_HEADS, DA_HEAD_DIM)
    f32 = jnp.float32
    lam = (jnp.exp(jnp.sum(lq1.astype(f32) * lk1.astype(f32)))
           - jnp.exp(jnp.sum(lq2.astype(f32) * lk2.astype(f32))) + lam_init)
    outs = []
    for i in range(s // Q_BLOCK):
        start, end = i * Q_BLOCK, (i + 1) * Q_BLOCK
        sc = jnp.einsum('bqhjd,bkhjd->bhjqk', q[:, start:end], k[:, :end],
                        preferred_element_type=f32)
        mask = jnp.arange(end)[None, :] <= (start + jnp.arange(Q_BLOCK))[:, None]
        p = jax.nn.softmax(jnp.where(mask, sc, -jnp.inf), axis=-1)
        w = p[:, :, 0] - lam * p[:, :, 1]
        outs.append(jnp.einsum('bhqk,bkhe->bqhe', w.astype(v.dtype), v[:, :end]))
    o = jnp.concatenate(outs, axis=1)
    o = rms_norm(o, subln_g) * (1.0 - lam_init)
    return o.reshape(bsz, s, DA_WIDTH)


def memory_cross_attention(hn, mem, norm_mem_g, wq, wkv, q_norm_g, k_norm_g, wo):
    bsz, s = hn.shape[0], hn.shape[1]
    mn = rms_norm(mem, norm_mem_g)
    q = rms_norm((hn @ wq).reshape(bsz, s, XA_HEADS, XA_HEAD_DIM), q_norm_g)
    kv = mn @ wkv
    k = rms_norm(kv[..., :D_MODEL].reshape(bsz, MEM_LEN, XA_HEADS, XA_HEAD_DIM), k_norm_g)
    v = kv[..., D_MODEL:].reshape(bsz, MEM_LEN, XA_HEADS, XA_HEAD_DIM)
    sc = jnp.einsum('bqhd,bkhd->bhqk', q, k, preferred_element_type=jnp.float32) * (XA_HEAD_DIM ** -0.5)
    p = jax.nn.softmax(sc, axis=-1)
    o = jnp.einsum('bhqk,bkhd->bqhd', p.astype(v.dtype), v).reshape(bsz, s, D_MODEL)
    return o @ wo


def moe_ffn(hn, router_w, router_b, w1, b1, w2, b2):
    bsz, s, d = hn.shape
    t = bsz * s
    hf = hn.reshape(t, d)
    logits = (hf @ router_w).astype(jnp.float32) + router_b.astype(jnp.float32)
    top_val, top_idx = lax.top_k(logits, TOP_K)
    gates = jax.nn.softmax(top_val, axis=-1)
    tk = t * TOP_K
    flat_e = top_idx.reshape(-1)
    flat_tok = jnp.repeat(jnp.arange(t, dtype=jnp.int32), TOP_K)
    order = jnp.argsort(flat_e)
    sorted_e = flat_e[order]
    sorted_tok = flat_tok[order]
    sorted_gate = gates.reshape(-1)[order]
    counts = jnp.bincount(flat_e, length=N_EXPERTS)
    padded = ((counts + MOE_BLOCK - 1) // MOE_BLOCK) * MOE_BLOCK
    start = jnp.cumsum(counts) - counts
    padded_end = jnp.cumsum(padded)
    padded_start = padded_end - padded
    dest = padded_start[sorted_e] + (jnp.arange(tk) - start[sorted_e])
    n_blocks = -(-tk // MOE_BLOCK) + N_EXPERTS
    n_slots = n_blocks * MOE_BLOCK
    slot_tok = jnp.full((n_slots,), t, jnp.int32).at[dest].set(sorted_tok)
    slot_gate = jnp.zeros((n_slots,), jnp.float32).at[dest].set(sorted_gate)
    block_expert = jnp.clip(jnp.searchsorted(padded_end, jnp.arange(n_blocks) * MOE_BLOCK, side='right'),
                            0, N_EXPERTS - 1)
    hf_pad = jnp.concatenate([hf, jnp.zeros((1, d), hf.dtype)], axis=0)
    xs = hf_pad[slot_tok].reshape(n_blocks, MOE_BLOCK, d)

    def expert_block(args):
        xb, e = args
        gu = xb @ w1[e] + b1[e]
        g = jnp.minimum(gu[:, :D_FF], SWIGLU_LIMIT)
        u = jnp.clip(gu[:, D_FF:], -SWIGLU_LIMIT, SWIGLU_LIMIT)
        act = g * jax.nn.sigmoid(SWIGLU_ALPHA * g) * (u + 1.0)
        return act @ w2[e] + b2[e]

    y = lax.map(expert_block, (xs, block_expert)).reshape(n_slots, d)
    y = y.astype(jnp.float32) * slot_gate[:, None]
    out = jnp.zeros((t + 1, d), jnp.float32).at[slot_tok].add(y)[:t]
    return out.astype(hn.dtype).reshape(bsz, s, d)


def setup_inputs(seed: int = 0) -> dict:
    key = jax.random.key(seed)
    ks = jax.random.split(key, 40)
    f32 = jnp.float32
    L = DEPTH

    def nrm(k, shape, scale):
        return jax.random.normal(k, shape, f32) * scale

    def gain(k, shape):
        return 1.0 + 0.02 * jax.random.normal(k, shape, f32)

    dt0 = jnp.exp(jax.random.uniform(ks[6], (L, SSD_HEADS), f32) * (math.log(0.1) - math.log(0.001)) + math.log(0.001))
    return {
        'x': nrm(ks[0], (BATCH, SEQ, D_MODEL), 1.0),
        'mem': nrm(ks[1], (BATCH, MEM_LEN, D_MODEL), 1.0),
        'norm_mix_g': gain(ks[2], (L, D_MODEL)),
        'w_in': nrm(ks[3], (L, D_MODEL, IN_COLS), D_MODEL ** -0.5),
        'conv_w': nrm(ks[4], (L, SSD_CONV, XBC_WIDTH), SSD_CONV ** -0.5),
        'conv_b': nrm(ks[5], (L, XBC_WIDTH), 0.02),
        'dt_bias': dt0 + jnp.log(-jnp.expm1(-dt0)),
        'a_log': jnp.log(jax.random.uniform(ks[7], (L, SSD_HEADS), f32, 1.0, 16.0)),
        'd_skip': gain(ks[8], (L, SSD_HEADS)),
        'ssd_norm_g': gain(ks[9], (L, SSD_WIDTH)),
        'da_q_norm_g': gain(ks[10], (L, DA_HALF)),
        'da_k_norm_g': gain(ks[11], (L, DA_HALF)),
        'lambda_q1': nrm(ks[12], (L, DA_HALF), 0.1),
        'lambda_k1': nrm(ks[13], (L, DA_HALF), 0.1),
        'lambda_q2': nrm(ks[14], (L, DA_HALF), 0.1),
        'lambda_k2': nrm(ks[15], (L, DA_HALF), 0.1),
        'da_subln_g': gain(ks[16], (L, DA_HEAD_DIM)),
        'w_out': nrm(ks[17], (L, D_MIX, D_MODEL), D_MIX ** -0.5),
        'norm_xa_g': gain(ks[18], (L, D_MODEL)),
        'norm_mem_g': gain(ks[19], (L, D_MODEL)),
        'xa_wq': nrm(ks[20], (L, D_MODEL, D_MODEL), D_MODEL ** -0.5),
        'xa_wkv': nrm(ks[21], (L, D_MODEL, 2 * D_MODEL), D_MODEL ** -0.5),
        'xa_q_norm_g': gain(ks[22], (L, XA_HEAD_DIM)),
        'xa_k_norm_g': gain(ks[23], (L, XA_HEAD_DIM)),
        'xa_wo': nrm(ks[24], (L, D_MODEL, D_MODEL), D_MODEL ** -0.5),
        'norm_ffn_g': gain(ks[25], (L, D_MODEL)),
        'router_w': nrm(ks[26], (L, D_MODEL, N_EXPERTS), D_MODEL ** -0.5),
        'router_b': nrm(ks[27], (L, N_EXPERTS), 0.01),
        'moe_w1': nrm(ks[28], (L, N_EXPERTS, D_MODEL, 2 * D_FF), D_MODEL ** -0.5),
        'moe_b1': nrm(ks[29], (L, N_EXPERTS, 2 * D_FF), 0.01),
        'moe_w2': nrm(ks[30], (L, N_EXPERTS, D_FF, D_MODEL), D_FF ** -0.5),
        'moe_b2': nrm(ks[31], (L, N_EXPERTS, D_MODEL), 0.01),
    }


def reference(x, mem, norm_mix_g, w_in, conv_w, conv_b, dt_bias, a_log, d_skip, ssd_norm_g,
              da_q_norm_g, da_k_norm_g, lambda_q1, lambda_k1, lambda_q2, lambda_k2, da_subln_g,
              w_out, norm_xa_g, norm_mem_g, xa_wq, xa_wkv, xa_q_norm_g, xa_k_norm_g, xa_wo,
              norm_ffn_g, router_w, router_b, moe_w1, moe_b1, moe_w2, moe_b2):
    h = x
    for layer in range(DEPTH):
        lam_init = 0.8 - 0.6 * math.exp(-0.3 * layer)
        hn = rms_norm(h, norm_mix_g[layer])
        proj = hn @ w_in[layer]
        o0 = SSD_WIDTH
        o1 = o0 + XBC_WIDTH
        o2 = o1 + SSD_HEADS
        o3 = o2 + DA_WIDTH
        o4 = o3 + DA_WIDTH
        y_ssd = ssd_group(proj[..., :o0], proj[..., o0:o1], proj[..., o1:o2],
                          conv_w[layer], conv_b[layer], dt_bias[layer], a_log[layer],
                          d_skip[layer], ssd_norm_g[layer])
        y_da = diff_attention_group(proj[..., o2:o3], proj[..., o3:o4], proj[..., o4:],
                                    da_q_norm_g[layer], da_k_norm_g[layer],
                                    lambda_q1[layer], lambda_k1[layer], lambda_q2[layer], lambda_k2[layer],
                                    da_subln_g[layer], lam_init)
        h = h + jnp.concatenate([y_ssd, y_da], axis=-1) @ w_out[layer]
        h = h + memory_cross_attention(rms_norm(h, norm_xa_g[layer]), mem, norm_mem_g[layer],
                                       xa_wq[layer], xa_wkv[layer], xa_q_norm_g[layer],
                                       xa_k_norm_g[layer], xa_wo[layer])
        h = h + moe_ffn(rms_norm(h, norm_ffn_g[layer]), router_w[layer], router_b[layer],
                        moe_w1[layer], moe_b1[layer], moe_w2[layer], moe_b2[layer])
    return h
```

```cpp
#define MK_PER_PHASE 1
#define MK_LAST_PHASE 12
#include <hip/hip_runtime.h>
#include <hip/hip_bf16.h>
#include <cstdio>
#include <cstdint>
#include <cmath>

#define GAS __attribute__((address_space(1)))
#define LAS __attribute__((address_space(3)))
typedef unsigned short bf16_t;
typedef short bf16x8 __attribute__((ext_vector_type(8)));
typedef float f32x2 __attribute__((ext_vector_type(2)));
typedef float f32x4 __attribute__((ext_vector_type(4)));
typedef float f32x16 __attribute__((ext_vector_type(16)));
typedef unsigned u32x2 __attribute__((ext_vector_type(2)));
typedef unsigned u32x4 __attribute__((ext_vector_type(4)));
typedef __bf16 bf16x2_t __attribute__((ext_vector_type(2)));

#define DI __device__ __forceinline__
DI unsigned pk2(float lo, float hi) { f32x2 v = {lo, hi}; bf16x2_t b = __builtin_convertvector(v, bf16x2_t); return __builtin_bit_cast(unsigned, b); }
DI float bflo(unsigned u) { return __uint_as_float(u << 16); }
DI float bfhi(unsigned u) { return __uint_as_float(u & 0xffff0000u); }
DI float bf2f(bf16_t h) { return __uint_as_float(((unsigned)h) << 16); }
DI float wave_sum(float v) {
#pragma unroll
    for (int o = 1; o < 64; o <<= 1) v += __shfl_xor(v, o);
    return v;
}
DI float siluf(float x) { return x / (1.f + __expf(-x)); }

constexpr int DM_ = 2048, NB = 4, SEQ_ = 2048, NTOK = NB * SEQ_;
constexpr int PP = 5632;
constexpr int PC_XBC = 1024, PC_Q = 2560, PC_K = 3584, PC_V = 4608, PC_DT = 5632;
constexpr int WIN_ROWS = 5888;
constexpr int NEXP = 32, MEMLEN = 256;
constexpr float EPS_ = 1e-6f;
constexpr float LAM_INIT = 0.2f;

namespace pg8 {
constexpr int BM = 256, BK = 64, HALF = 128, HTB = HALF * BK * 2  , STAGE_BYTES = 8 * HTB;
DI int lds_byte(int r, int c) { const int st = (r >> 4) * 2 + (c >> 5), rr = r & 15, cc = c & 31, ob = rr * 64 + cc * 2; return st * 1024 + (ob ^ (((ob >> 9) & 1) << 5)); }
DI void stage_rc(int b, int& R, int& C) { const int st = b / 1024, sb = b % 1024, swz = sb ^ (((sb >> 9) & 1) << 5); R = (st >> 1) * 16 + swz / 64; C = (st & 1) * 32 + (swz % 64) / 2; }
DI int perm32(int rho) { const int n = rho >> 4, i = rho & 15; return 8 * (i >> 2) + 4 * n + (i & 3); }

struct UnitD {
    const char* A; const char* B;
    const int* rows;
    unsigned lda, ldb;
    int nvalid;
    int type, pm, pn, e, x0;
};
DI void dense_voff(unsigned lda, unsigned ldb, int tid, unsigned (&vA)[2], unsigned (&vB)[2]) {
#pragma unroll
    for (int i = 0; i < 2; ++i) { int R, C; stage_rc(tid * 16 + i * 8192, R, C); const int Rb = (R & ~31) + perm32(R & 31);
        vA[i] = (unsigned)R * lda + (unsigned)C * 2u; vB[i] = (unsigned)Rb * ldb + (unsigned)C * 2u; }
}
DI void gather_voff(const UnitD& u, int tid, unsigned (&gA)[2][2]) {
#pragma unroll
    for (int i = 0; i < 2; ++i) { int R, C; stage_rc(tid * 16 + i * 8192, R, C);
#pragma unroll
        for (int h = 0; h < 2; ++h) { const int ra = h * 128 + R; const unsigned rowA = (ra < u.nvalid) ? (unsigned)u.rows[ra] : 0u; gA[h][i] = rowA * u.lda + (unsigned)C * 2u; } }
}

template <class Epi, class Sched, bool GATHER, bool ALIGN_EPI>
DI void gemm_phase(LAS unsigned char* lds, int nt, const Sched& S, const Epi& E) {

    const int tid = threadIdx.x, wid = __builtin_amdgcn_readfirstlane(tid >> 6), lane = tid & 63, wr = wid >> 2, wc = wid & 3, fr = lane & 15, fq = lane >> 4;
    const size_t kstep = (size_t)(BK * 2);
    const unsigned ldsb = (unsigned)__builtin_amdgcn_readfirstlane((int)((unsigned)(uintptr_t)lds + (unsigned)wid * 1024u));
    const int aoff = lds_byte(wr * 64 + fr, fq * 8), boff = lds_byte(wc * 32 + fr, fq * 8);
#define PG8_SA(b, h) (((b) * 2 + (h)) * HTB)
#define PG8_SB(b, h) ((4 + (b) * 2 + (h)) * HTB)
#define PG8_STAGE(bufoff, gbase, voff) do { _Pragma("unroll") for (int _i = 0; _i < 2; ++_i) { unsigned keep_; \
        asm volatile("s_mov_b32 %0, m0\n\ts_mov_b32 m0, %3\n\ts_nop 0\n\tglobal_load_lds_dwordx4 %1, %2\n\ts_mov_b32 m0, %0" \
                     : "=&s"(keep_) : "v"((voff)[_i]), "s"((const char*)(gbase)), "s"(ldsb + (unsigned)((bufoff) + _i * 8192)) : "memory"); } } while (0)
#define PG8_STA(bufoff, gbase, h, HS, GA) do { if constexpr (GATHER) { PG8_STAGE(bufoff, gbase, GA[h]); } else { PG8_STAGE(bufoff, (gbase) + (h) * (HS), vA); } } while (0)
#define PG8_STB(bufoff, gbase, h, HS) PG8_STAGE(bufoff, (gbase) + (h) * (HS), vB)
#define PG8_LDA(dst, b, h) do { _Pragma("unroll") for (int m = 0; m < 4; ++m) _Pragma("unroll") for (int k = 0; k < 2; ++k) dst[m][k] = *(const LAS bf16x8*)(lds + PG8_SA(b, h) + aoff + m * 2048 + k * 1024); } while (0)
#define PG8_LDB(dst, b, h) do { _Pragma("unroll") for (int n = 0; n < 2; ++n) _Pragma("unroll") for (int k = 0; k < 2; ++k) dst[n][k] = *(const LAS bf16x8*)(lds + PG8_SB(b, h) + boff + n * 2048 + k * 1024); } while (0)
#define PG8_MMA(ai, bj, At, Bt) do { __builtin_amdgcn_s_setprio(1); _Pragma("unroll") for (int m = 0; m < 4; ++m) _Pragma("unroll") for (int n = 0; n < 2; ++n) _Pragma("unroll") for (int k = 0; k < 2; ++k) \
        acc[ai][bj][m][n] = __builtin_amdgcn_mfma_f32_16x16x32_bf16(Bt[n][k], At[m][k], acc[ai][bj][m][n], 0, 0, 0); __builtin_amdgcn_s_setprio(0); } while (0)
#define PG8_WAIT_V(n) asm volatile("s_waitcnt vmcnt(" #n ")" ::: "memory")
#define PG8_WAIT_L(n) asm volatile("s_waitcnt lgkmcnt(" #n ")" ::: "memory")
#define PG8_BAR __builtin_amdgcn_s_barrier()
#define PG8_SCHED __builtin_amdgcn_sched_barrier(0)
#define PG8_ITER(A1P, A2P, B2P, HA2, HB2, GA2) do { \
        const char* a3p_ = (A2P) + kstep; const char* b3p_ = (B2P) + kstep; \
        PG8_LDB(B0, 0, 0); PG8_LDB(B1, 0, 1); PG8_SCHED; PG8_LDA(At, 0, 0); PG8_STA(PG8_SA(1, 1), (A1P), 1, hsA, gA); \
        PG8_WAIT_V(8); PG8_WAIT_L(0); PG8_BAR; PG8_MMA(0, 0, At, B0); PG8_MMA(0, 1, At, B1); PG8_BAR; PG8_SCHED; \
        PG8_LDA(At, 0, 1); PG8_STB(PG8_SB(0, 0), (B2P), 0, HB2); PG8_STB(PG8_SB(0, 1), (B2P), 1, HB2); PG8_STA(PG8_SA(0, 0), (A2P), 0, HA2, GA2); \
        PG8_WAIT_V(8); PG8_WAIT_L(0); PG8_BAR; PG8_MMA(1, 0, At, B0); PG8_MMA(1, 1, At, B1); PG8_BAR; PG8_SCHED; \
        PG8_LDB(B0, 1, 0); PG8_LDB(B1, 1, 1); PG8_SCHED; PG8_LDA(At, 1, 0); PG8_STA(PG8_SA(0, 1), (A2P), 1, HA2, GA2); \
        PG8_WAIT_V(8); PG8_WAIT_L(0); PG8_BAR; PG8_MMA(0, 0, At, B0); PG8_MMA(0, 1, At, B1); PG8_BAR; PG8_SCHED; \
        PG8_LDA(At, 1, 1); PG8_STB(PG8_SB(1, 0), b3p_, 0, HB2); PG8_STB(PG8_SB(1, 1), b3p_, 1, HB2); PG8_STA(PG8_SA(1, 0), a3p_, 0, HA2, GA2); \
        PG8_WAIT_V(8); PG8_WAIT_L(0); PG8_BAR; PG8_MMA(1, 0, At, B0); PG8_MMA(1, 1, At, B1); PG8_BAR; PG8_SCHED; \
    } while (0)
    UnitD cur, nxt; int ui = 0;
    if (!S.next(0, cur)) return;
    f32x4 acc[2][2][4][2];
#pragma unroll
    for (int a = 0; a < 2; ++a)
#pragma unroll
        for (int b = 0; b < 2; ++b)
#pragma unroll
            for (int m = 0; m < 4; ++m)
#pragma unroll
                for (int n = 0; n < 2; ++n) acc[a][b][m][n] = (f32x4){0.f, 0.f, 0.f, 0.f};
    bf16x8 At[4][2], B0[2][2], B1[2][2];
    unsigned vA[2], vB[2], gA[2][2], ngA[2][2];
    dense_voff(cur.lda, cur.ldb, tid, vA, vB);
    if constexpr (GATHER) gather_voff(cur, tid, gA);
    const char* cA = cur.A; const char* cB = cur.B;
    size_t hsA = GATHER ? 0 : (size_t)cur.lda * HALF, hsB = (size_t)cur.ldb * HALF;
    PG8_STB(PG8_SB(0, 0), cB, 0, hsB); PG8_STB(PG8_SB(0, 1), cB, 1, hsB); PG8_STA(PG8_SA(0, 0), cA, 0, hsA, gA); PG8_STA(PG8_SA(0, 1), cA, 1, hsA, gA);
    if (wr == 1) PG8_BAR;
    PG8_WAIT_V(2); PG8_BAR;
    PG8_STB(PG8_SB(1, 0), cB + kstep, 0, hsB); PG8_STA(PG8_SA(1, 0), cA + kstep, 0, hsA, gA); PG8_STB(PG8_SB(1, 1), cB + kstep, 1, hsB);
    PG8_WAIT_V(6); PG8_BAR;
    for (;;) {
        const bool has_next = S.next(ui + 1, nxt);
        const char* nA = cA; const char* nB = cB; size_t nhsA = hsA, nhsB = hsB;
        if (has_next) { nA = nxt.A; nB = nxt.B; nhsA = GATHER ? 0 : (size_t)nxt.lda * HALF; nhsB = (size_t)nxt.ldb * HALF; }
        if constexpr (GATHER) {
            if (has_next) gather_voff(nxt, tid, ngA);
            else {
#pragma unroll
                for (int h = 0; h < 2; ++h)
#pragma unroll
                    for (int i = 0; i < 2; ++i) ngA[h][i] = gA[h][i];
            }
        }
        for (int t = 0; t < nt - 2; t += 2)
            PG8_ITER(cA + (size_t)(t + 1) * kstep, cA + (size_t)(t + 2) * kstep, cB + (size_t)(t + 2) * kstep, hsA, hsB, gA);
        PG8_ITER(cA + (size_t)(nt - 1) * kstep, nA, nB, nhsA, nhsB, ngA);
        if constexpr (ALIGN_EPI) { if (wr == 0) PG8_BAR; }
        if constexpr (!Epi::AFTER_DRAIN) { E(acc, cur, wr, wc, fr, fq); }
        if (!has_next) break;
#pragma unroll
        for (int a = 0; a < 2; ++a)
#pragma unroll
            for (int b = 0; b < 2; ++b)
#pragma unroll
                for (int m = 0; m < 4; ++m)
#pragma unroll
                    for (int n = 0; n < 2; ++n) acc[a][b][m][n] = (f32x4){0.f, 0.f, 0.f, 0.f};
        cur = nxt; cA = nA; cB = nB; hsA = nhsA; hsB = nhsB; ++ui;
        if constexpr (GATHER) {
#pragma unroll
            for (int h = 0; h < 2; ++h)
#pragma unroll
                for (int i = 0; i < 2; ++i) gA[h][i] = ngA[h][i];
        }
        if constexpr (ALIGN_EPI) { if (wr == 1) PG8_BAR; }
    }
    PG8_WAIT_V(0);
    if constexpr (!ALIGN_EPI) { if (wr == 0) PG8_BAR; }
    PG8_BAR;
    if constexpr (Epi::AFTER_DRAIN) { E.fused(acc, cur, wr, wc, fr, fq, lds, wid, lane); }
#undef PG8_SA
#undef PG8_SB
#undef PG8_STAGE
#undef PG8_STA
#undef PG8_STB
#undef PG8_LDA
#undef PG8_LDB
#undef PG8_MMA
#undef PG8_WAIT_V
#undef PG8_WAIT_L
#undef PG8_BAR
#undef PG8_SCHED
#undef PG8_ITER
}
}
namespace attn_body {
using bf16=__hip_bfloat16;
using bf16x8=__attribute__((ext_vector_type(8)))short;
using s16x4=__attribute__((ext_vector_type(4)))short;
using f32x16=__attribute__((ext_vector_type(16)))float;
using u32x4=__attribute__((ext_vector_type(4)))unsigned;
constexpr int BATCH=4,SEQ=2048,D=64,DM=5632,OPITCH=1024;
constexpr int NW=8,QBLK=32,QB=QBLK*NW,KVBLK=64,NQB=SEQ/QB;
constexpr int ATTN_UNIT_ROWS=QB;
__device__ __forceinline__ int crow(int r,int hi){return (r&3)+8*(r>>2)+4*hi;}
#define SBAR() __builtin_amdgcn_sched_barrier(0)
__device__ __forceinline__ void cmask(f32x16&p0,f32x16&p1,int jb,int qrel,int hi){
  const float NEG=-INFINITY; int kb=64*jb+4*hi;
  #pragma unroll
  for(int r=0;r<16;++r){int kv=kb+(r&3)+8*(r>>2); if(kv>qrel)p0[r]=NEG; if(kv+32>qrel)p1[r]=NEG;}
}

constexpr int NSLOT=3, SLOTB=8192;
constexpr int LDS_K=0, LDS_V=NSLOT*SLOTB, LDS_WS=2*NSLOT*SLOTB, LDS_OST=LDS_WS+NW*64*4, LDS_BYTES=LDS_OST+NW*4096;
constexpr float C2=0.125f*1.4426950408889634f;
__device__ __forceinline__ void glds16(const void*gsrc,unsigned lds_dst){unsigned keep;
  asm volatile("s_mov_b32 %0, m0\n\ts_mov_b32 m0, %2\n\ts_nop 0\n\tglobal_load_lds_dwordx4 %1, off\n\ts_mov_b32 m0, %0":"=&s"(keep):"v"(gsrc),"s"(lds_dst):"memory");}
__device__ __forceinline__ float max3f(float a,float b,float c){float r;asm("v_max3_f32 %0, %1, %2, %3":"=v"(r):"v"(a),"v"(b),"v"(c));return r;}
__device__ __forceinline__ float max2f(float a,float b){float r;asm("v_max_f32_e32 %0, %1, %2":"=v"(r):"v"(a),"v"(b));return r;}
__device__ __forceinline__ float fadd_s(float a,float b){float r;asm("v_add_f32_e32 %0, %1, %2":"=v"(r):"v"(a),"v"(b));return r;}
__device__ __forceinline__ float fsub_s(float a,float b){float r;asm("v_sub_f32_e32 %0, %1, %2":"=v"(r):"v"(a),"v"(b));return r;}
typedef float f32x2_t __attribute__((ext_vector_type(2))); typedef __bf16 bf16x2_t __attribute__((ext_vector_type(2)));
__device__ __forceinline__ unsigned cvtpk_s(float lo,float hi){f32x2_t v={lo,hi};bf16x2_t b=__builtin_convertvector(v,bf16x2_t);return __builtin_bit_cast(unsigned,b);}
#define WAIT_BAR(N) asm volatile("s_waitcnt vmcnt(" #N ") lgkmcnt(0)\n\ts_barrier":::"memory")

__device__ __forceinline__ void qkt(f32x16&p0,f32x16&p1,const char*Kslot,const bf16x8*qr,const f32x16&negm,int r32,int hi){
  const char*kb=Kslot+hi*1024+r32*16;
  #pragma unroll
  for(int d0=0;d0<4;++d0){
    const bf16x8 b0=*reinterpret_cast<const bf16x8*>(kb+d0*2048);
    const bf16x8 b1=*reinterpret_cast<const bf16x8*>(kb+d0*2048+512);
    if(d0==0){p0=__builtin_amdgcn_mfma_f32_32x32x16_bf16(b0,qr[0],negm,0,0,0);p1=__builtin_amdgcn_mfma_f32_32x32x16_bf16(b1,qr[0],negm,0,0,0);}
    else{p0=__builtin_amdgcn_mfma_f32_32x32x16_bf16(b0,qr[d0],p0,0,0,0);p1=__builtin_amdgcn_mfma_f32_32x32x16_bf16(b1,qr[d0],p1,0,0,0);}}
}
typedef __attribute__((address_space(3))) const char* lds_cptr;
typedef short v4i16_t __attribute__((ext_vector_type(4)));
__device__ __forceinline__ void kload8(bf16x8*kf,lds_cptr kp){
  kf[0]=*(const __attribute__((address_space(3))) bf16x8*)(kp);      kf[1]=*(const __attribute__((address_space(3))) bf16x8*)(kp+512);
  kf[2]=*(const __attribute__((address_space(3))) bf16x8*)(kp+2048); kf[3]=*(const __attribute__((address_space(3))) bf16x8*)(kp+2560);
  kf[4]=*(const __attribute__((address_space(3))) bf16x8*)(kp+4096); kf[5]=*(const __attribute__((address_space(3))) bf16x8*)(kp+4608);
  kf[6]=*(const __attribute__((address_space(3))) bf16x8*)(kp+6144); kf[7]=*(const __attribute__((address_space(3))) bf16x8*)(kp+6656);
}
__device__ __forceinline__ void kload2(bf16x8*kf,lds_cptr kp,int j){ kf[2*j]=*(const __attribute__((address_space(3))) bf16x8*)(kp+j*2048); kf[2*j+1]=*(const __attribute__((address_space(3))) bf16x8*)(kp+j*2048+512); }
__device__ __forceinline__ s16x4 vtr(lds_cptr p){ return __builtin_bit_cast(s16x4,__builtin_amdgcn_ds_read_tr16_b64_v4i16((__attribute__((address_space(3))) v4i16_t*)p)); }
__device__ __forceinline__ float rowmax(const f32x16&p0,const f32x16&p1){
  float a=max3f(p0[0],p0[1],p1[0]),b=max3f(p0[2],p0[3],p1[1]);a=max3f(a,p1[2],p1[3]);
  #pragma unroll
  for(int r=4;r<16;r+=4){a=max3f(a,p0[r],p0[r+1]);b=max3f(b,p0[r+2],p0[r+3]);a=max3f(a,p1[r],p1[r+1]);b=max3f(b,p1[r+2],p1[r+3]);}
  const float m=max2f(a,b);
  auto rr=__builtin_amdgcn_permlane32_swap(__float_as_uint(m),__float_as_uint(m),false,false);
  return max2f(__uint_as_float(rr[0]),__uint_as_float(rr[1]));
}
__device__ __forceinline__ void pv(f32x16*o,int vb,bf16x8 pa0,bf16x8 pa1,bf16x8 pa2,bf16x8 pa3){
  #pragma unroll
  for(int d0=0;d0<2;++d0){s16x4 lo[4],hi[4];
    #pragma unroll
    for(int ks=0;ks<4;++ks){
      asm volatile("ds_read_b64_tr_b16 %0,%1 offset:%c2":"=&v"(lo[ks]):"v"(vb),"i"(d0*4096+ks*1024):"memory");
      asm volatile("ds_read_b64_tr_b16 %0,%1 offset:%c2":"=&v"(hi[ks]):"v"(vb),"i"(d0*4096+ks*1024+512):"memory");}
    asm volatile("s_waitcnt lgkmcnt(0)":::"memory");SBAR();
    #define PK(k) (bf16x8){lo[k][0],lo[k][1],lo[k][2],lo[k][3],hi[k][0],hi[k][1],hi[k][2],hi[k][3]}
    o[d0]=__builtin_amdgcn_mfma_f32_32x32x16_bf16(pa0,PK(0),o[d0],0,0,0);
    o[d0]=__builtin_amdgcn_mfma_f32_32x32x16_bf16(pa1,PK(1),o[d0],0,0,0);
    o[d0]=__builtin_amdgcn_mfma_f32_32x32x16_bf16(pa2,PK(2),o[d0],0,0,0);
    o[d0]=__builtin_amdgcn_mfma_f32_32x32x16_bf16(pa3,PK(3),o[d0],0,0,0);
    #undef PK
  }
}

#ifndef ATTN_STORE16
#define ATTN_STORE16(p,v) (*(u32x4*)(p)=(v))
#endif
template<int THRL> __device__ __forceinline__ void attn_unit(int b,int qcol,int vcol,int ocol,int qb,const bf16*Q,const bf16*__restrict__ K,const bf16*__restrict__ V,bf16*O,char*shm){
  const int tid=threadIdx.x,lane=tid&63,r32=lane&31,hi=lane>>5; const int wid=__builtin_amdgcn_readfirstlane(tid>>6);
  const long rowbase=(long)b*SEQ; const int q0=qb*QB;
  const bf16*Qw=Q+(rowbase+q0+wid*QBLK)*DM+qcol;
  const bf16*Kh=K+rowbase*DM+qcol,*Vh=V+rowbase*DM+vcol;
  const unsigned lds0=(unsigned)(uintptr_t)shm;
  float*wsf=(float*)(shm+LDS_WS)+wid*64;
  const bf16*ksrc=Kh+(long)lane*DM+wid*8;
  const bf16*vsrc=Vh+(long)(16*(wid&3)+(lane>>2))*DM+(wid>>2)*32+(lane&3)*8;
  const unsigned kdst=lds0+LDS_K+wid*1024, vdst=lds0+LDS_V+wid*1024;
  #define DMA_K(t,slot) glds16(ksrc+(long)(t)*KVBLK*DM,(unsigned)__builtin_amdgcn_readfirstlane(kdst+(slot)))
  #define DMA_V(t,slot) glds16(vsrc+(long)(t)*KVBLK*DM,(unsigned)__builtin_amdgcn_readfirstlane(vdst+(slot)))
  const int vb0=(int)(lds0+LDS_V)+((lane>>4)&1)*32+(lane&3)*8+(4*hi+((lane&15)>>2))*64;
  const char*Kbase=shm+LDS_K; bf16x8 kf[8];
  const lds_cptr shm3=(lds_cptr)shm; const lds_cptr kp0=shm3+LDS_K+hi*1024+r32*16; const lds_cptr vp0=shm3+LDS_V+((lane>>4)&1)*32+(lane&3)*8+(4*hi+((lane&15)>>2))*64;
  const int NT=(q0+QB)/KVBLK;
  DMA_K(0,0);DMA_V(0,0);DMA_K(1,SLOTB);
  bf16x8 qr[4];
  #pragma unroll
  for(int d0=0;d0<4;++d0)qr[d0]=*reinterpret_cast<const bf16x8*>(&Qw[(long)r32*DM+d0*16+hi*8]);
  float mhat=0.f,l_reg=0.f;f32x16 o[2];o[0]=f32x16{};o[1]=f32x16{};f32x16 negm=f32x16{};asm volatile("":"+v"(negm));
  const int qrel=wid*QBLK+r32;
  #define CMASK(P0,P1,t) do{int jb_=(t)-(NT-4); if(jb_>=0)cmask(P0,P1,jb_,qrel,hi);}while(0)
  bool resc=false;
  #define START(P0,P1) do{ const float rm=rowmax(P0,P1); resc=false; \
    { const float dl=rm; mhat=fadd_s(mhat,dl); \
      _Pragma("unroll") for(int r=0;r<16;++r){P0[r]=fsub_s(P0[r],dl);P1[r]=fsub_s(P1[r],dl);} \
      _Pragma("unroll") for(int r=0;r<16;++r)negm[r]=-mhat; asm volatile("":"+v"(negm)); } \
    _Pragma("unroll") for(int r=0;r<16;++r)P0[r]=__builtin_amdgcn_exp2f(P0[r]); }while(0)
  #define RESC() do{ if(resc){ asm volatile("s_waitcnt lgkmcnt(0)":::"memory"); \
      _Pragma("unroll") for(int d_=0;d_<2;++d_) _Pragma("unroll") for(int r=0;r<16;++r)o[d_][r]*=wsf[crow(r,hi)]; } }while(0)
  f32x16 pA0,pA1,pB0,pB1;
  int sl_prev=0,sl_cur=0,sl_next=SLOTB;
  #define ROT() do{sl_prev=sl_cur;sl_cur=sl_next;sl_next=(sl_next==(NSLOT-1)*SLOTB)?0:sl_next+SLOTB;}while(0)
  DMA_K(2,2*SLOTB);
  WAIT_BAR(3);
  qkt(pA0,pA1,Kbase,qr,negm,r32,hi);asm volatile("s_nop 15\n\ts_nop 7":"+v"(pA0),"+v"(pA1));CMASK(pA0,pA1,0);
  START(pA0,pA1);
  _Pragma("unroll") for(int r=0;r<16;++r)pA1[r]=__builtin_amdgcn_exp2f(pA1[r]);
  WAIT_BAR(0);
  DMA_K(3,0);DMA_V(1,SLOTB);
  ROT();
  kload8(kf,kp0+sl_cur);
  WAIT_BAR(2);
  s16x4 vlo[8],vhi[8]; u32x4 pw0,pw1,pw2,pw3;
  #define PKW(P,B) cvtpk_s(P[B],P[B+1])
  #define PAF(k) __builtin_bit_cast(bf16x8,pw##k)
  #define VFR(i) (bf16x8){vlo[i][0],vlo[i][1],vlo[i][2],vlo[i][3],vhi[i][0],vhi[i][1],vhi[i][2],vhi[i][3]}
  #define PIN(x) asm volatile("":"+v"(x))
  #define MX3(a,b,c) __builtin_fmaxf(__builtin_fmaxf((a),(b)),(c))
  #define GAPA(MF,A0,A1,A2,A3,W0,W1,PW) do{ MF; sacc+=A0; sacc+=A1; sacc+=A2; sacc+=A3; PIN(sacc); W0; W1; PIN(PW); SBAR(); }while(0)
  #define EX(v) __builtin_amdgcn_exp2f(v)
  #define GAPB(MF,X,B) do{ MF; X[B]=EX(X[B]); X[B+1]=EX(X[B+1]); X[B+2]=EX(X[B+2]); X[B+3]=EX(X[B+3]); PIN(X); SBAR(); }while(0)
  #define VRD(i) do{ vlo[i]=vtr(vp_+(((i)>>2)*4096+((i)&3)*1024)); vhi[i]=vtr(vp_+(((i)>>2)*4096+((i)&3)*1024+512)); }while(0)
  #define KRD(G,j) do{ if(G){ kload2(kf,kp0+sl_next,j); SBAR(); } }while(0)
  #define STEP(C0,C1,P0,P1,t,GK,GV,GL) do{ SBAR(); \
    const lds_cptr vp_=vp0+sl_prev; \
    VRD(0); SBAR(); float sacc=(P0[0]+P0[1]); \
    GAPA(C0=__builtin_amdgcn_mfma_f32_32x32x16_bf16(kf[0],qr[0],negm,0,0,0), P0[2],P0[3],P0[4],P0[5],     pw0[0]=PKW(P0,0), pw0[1]=PKW(P0,2), pw0); \
    VRD(4); SBAR(); GAPA(C1=__builtin_amdgcn_mfma_f32_32x32x16_bf16(kf[1],qr[0],negm,0,0,0), P0[6],P0[7],P0[8],P0[9],     pw0[2]=PKW(P0,4), pw0[3]=PKW(P0,6), pw0); \
    VRD(1); SBAR(); GAPA(C0=__builtin_amdgcn_mfma_f32_32x32x16_bf16(kf[2],qr[1],C0,0,0,0),   P0[10],P0[11],P0[12],P0[13], pw1[0]=PKW(P0,8), pw1[1]=PKW(P0,10), pw1); \
    VRD(5); SBAR(); GAPA(C1=__builtin_amdgcn_mfma_f32_32x32x16_bf16(kf[3],qr[1],C1,0,0,0),   P0[14],P0[15],P1[0],P1[1],   pw1[2]=PKW(P0,12),pw1[3]=PKW(P0,14), pw1); \
    VRD(2); SBAR(); GAPA(C0=__builtin_amdgcn_mfma_f32_32x32x16_bf16(kf[4],qr[2],C0,0,0,0),   P1[2],P1[3],P1[4],P1[5],     pw2[0]=PKW(P1,0), pw2[1]=PKW(P1,2), pw2); \
    VRD(6); SBAR(); GAPA(C1=__builtin_amdgcn_mfma_f32_32x32x16_bf16(kf[5],qr[2],C1,0,0,0),   P1[6],P1[7],P1[8],P1[9],     pw2[2]=PKW(P1,4), pw2[3]=PKW(P1,6), pw2); \
    VRD(3); SBAR(); GAPA(C0=__builtin_amdgcn_mfma_f32_32x32x16_bf16(kf[6],qr[3],C0,0,0,0),   P1[10],P1[11],P1[12],P1[13], pw3[0]=PKW(P1,8), pw3[1]=PKW(P1,10), pw3); \
    VRD(7); SBAR(); GAPA(C1=__builtin_amdgcn_mfma_f32_32x32x16_bf16(kf[7],qr[3],C1,0,0,0),   P1[14],P1[15],0.f,0.f,       pw3[2]=PKW(P1,12),pw3[3]=PKW(P1,14), pw3); \
    l_reg+=sacc; \
    if(GK){DMA_K((t)+3,sl_cur);} if(GV){DMA_V((t)+1,sl_next);} \
    CMASK(C0,C1,t); \
    { float a=MX3(C0[0],C0[1],C1[0]),b=MX3(C0[2],C0[3],C1[1]); a=MX3(a,C1[2],C1[3]); \
      _Pragma("unroll") for(int r=4;r<16;r+=4){a=MX3(a,C0[r],C0[r+1]);b=MX3(b,C0[r+2],C0[r+3]);a=MX3(a,C1[r],C1[r+1]);b=MX3(b,C1[r+2],C1[r+3]);} \
      float rm=__builtin_fmaxf(a,b); { auto rr=__builtin_amdgcn_permlane32_swap(__float_as_uint(rm),__float_as_uint(rm),false,false); rm=__builtin_fmaxf(__uint_as_float(rr[0]),__uint_as_float(rr[1])); } \
      resc=false; \
      if(__builtin_expect(__any(rm>(float)THRL),0)){ const float dl=__builtin_fmaxf(rm,0.f); mhat+=dl; \
        _Pragma("unroll") for(int r=0;r<16;++r){C0[r]-=dl;C1[r]-=dl;} \
        _Pragma("unroll") for(int r=0;r<16;++r)negm[r]=-mhat; asm volatile("":"+v"(negm)); \
        const float f=__builtin_amdgcn_exp2f(-dl); l_reg*=f; if(hi==0)wsf[r32]=f; resc=true; } } \
    SBAR(); \
    GAPB(o[0]=__builtin_amdgcn_mfma_f32_32x32x16_bf16(PAF(0),VFR(0),o[0],0,0,0), C0,0); \
    GAPB(o[1]=__builtin_amdgcn_mfma_f32_32x32x16_bf16(PAF(0),VFR(4),o[1],0,0,0), C0,4); \
    KRD(GL,0); GAPB(o[0]=__builtin_amdgcn_mfma_f32_32x32x16_bf16(PAF(1),VFR(1),o[0],0,0,0), C0,8); \
    KRD(GL,1); GAPB(o[1]=__builtin_amdgcn_mfma_f32_32x32x16_bf16(PAF(1),VFR(5),o[1],0,0,0), C0,12); \
    KRD(GL,2); GAPB(o[0]=__builtin_amdgcn_mfma_f32_32x32x16_bf16(PAF(2),VFR(2),o[0],0,0,0), C1,0); \
    KRD(GL,3); GAPB(o[1]=__builtin_amdgcn_mfma_f32_32x32x16_bf16(PAF(2),VFR(6),o[1],0,0,0), C1,4); \
    GAPB(o[0]=__builtin_amdgcn_mfma_f32_32x32x16_bf16(PAF(3),VFR(3),o[0],0,0,0), C1,8); \
    GAPB(o[1]=__builtin_amdgcn_mfma_f32_32x32x16_bf16(PAF(3),VFR(7),o[1],0,0,0), C1,12); \
    }while(0)
  int t=1;
  #undef CMASK
  #define CMASK(P0,P1,t) do{}while(0)
  for(;t+5<NT;t+=2){
    STEP(pB0,pB1,pA0,pA1,t,true,true,true);     WAIT_BAR(2); RESC(); ROT();
    STEP(pA0,pA1,pB0,pB1,t+1,true,true,true);   WAIT_BAR(2); RESC(); ROT();
  }
  #undef CMASK
  #define CMASK(P0,P1,t) do{int jb_=(t)-(NT-4); if(jb_>=0)cmask(P0,P1,jb_,qrel,hi);}while(0)
  #define ENDW(tt) do{ if((tt)+3<NT){WAIT_BAR(2);} else if((tt)+2<NT){WAIT_BAR(1);} else {WAIT_BAR(0);} }while(0)
  for(;t+1<NT;t+=2){
    STEP(pB0,pB1,pA0,pA1,t,(t+3<NT),(t+1<NT),(t+1<NT));       ENDW(t);   RESC(); ROT();
    STEP(pA0,pA1,pB0,pB1,t+1,(t+4<NT),(t+2<NT),(t+2<NT));     ENDW(t+1); RESC(); ROT();
  }
  STEP(pB0,pB1,pA0,pA1,NT-1,false,false,false); RESC();
  { float sacc=pB0[0]+pB0[1]; _Pragma("unroll") for(int r=2;r<16;++r)sacc+=pB0[r]; _Pragma("unroll") for(int r=0;r<16;++r)sacc+=pB1[r]; l_reg+=sacc;
    pw0=(u32x4){PKW(pB0,0),PKW(pB0,2),PKW(pB0,4),PKW(pB0,6)};pw1=(u32x4){PKW(pB0,8),PKW(pB0,10),PKW(pB0,12),PKW(pB0,14)};pw2=(u32x4){PKW(pB1,0),PKW(pB1,2),PKW(pB1,4),PKW(pB1,6)};pw3=(u32x4){PKW(pB1,8),PKW(pB1,10),PKW(pB1,12),PKW(pB1,14)};
    SBAR(); pv(o,vb0+sl_cur,PAF(0),PAF(1),PAF(2),PAF(3)); }
  #undef PKW
  #undef PAF
  #undef VFR
  #undef PIN
  #undef MX3
  #undef GAPA
  #undef GAPB
  #undef EX
  #undef VRD
  #undef KRD
  #undef STEP
  #undef ENDW
  {auto rr=__builtin_amdgcn_permlane32_swap(__float_as_uint(l_reg),__float_as_uint(l_reg),false,false);l_reg=__uint_as_float(rr[0])+__uint_as_float(rr[1]);}
  if(hi==0)wsf[32+r32]=l_reg;asm volatile("s_waitcnt lgkmcnt(0)":::"memory");
  float rli[16];
  #pragma unroll
  for(int r=0;r<16;++r)rli[r]=__builtin_amdgcn_rcpf(wsf[32+crow(r,hi)]);
  bf16*Ow=O+(rowbase+q0+wid*QBLK)*OPITCH+ocol;
  { bf16*stg=(bf16*)(shm+LDS_OST)+wid*2048;
    #pragma unroll
    for(int r=0;r<16;++r){const int orow=crow(r,hi);
      #pragma unroll
      for(int d0=0;d0<2;++d0)stg[orow*64+d0*32+r32]=__float2bfloat16(o[d0][r]*rli[r]);}
    asm volatile("s_waitcnt lgkmcnt(0)":::"memory");
    #pragma unroll
    for(int i=0;i<4;++i){const int row=i*8+(lane>>3),ch=lane&7; const u32x4 v=*(const u32x4*)(stg+row*64+ch*8); ATTN_STORE16(Ow+(long)row*OPITCH+ch*8,v);} }
  asm volatile("s_waitcnt lgkmcnt(0)\n\ts_barrier":::"memory");
  #undef DMA_K
  #undef DMA_V
  #undef CMASK
  #undef START
  #undef RESC
  #undef ROT
}
constexpr int ATTN_LDS_BYTES=LDS_BYTES;
#undef SBAR
#undef WAIT_BAR
}
constexpr size_t MiB = 1u << 20;
constexpr size_t WS_CTL = 0, CTL_ZERO_BYTES = 1 * MiB;
constexpr size_t WS_WIN = 2 * MiB, WS_WOUT = 26 * MiB, WS_WQ = 34 * MiB, WS_WKV = 42 * MiB, WS_WO = 58 * MiB, WS_W1 = 66 * MiB, WS_W2 = 578 * MiB;
constexpr size_t WS_HN = 834 * MiB, WS_MN = 866 * MiB, WS_PROJ = 870 * MiB, WS_DT = 958 * MiB, WS_KVRAW = 959 * MiB, WS_KN = 967 * MiB;
constexpr size_t WS_YCAT = 971 * MiB, WS_O0 = 1003 * MiB, WS_O1 = 1019 * MiB, WS_H1 = 1035 * MiB, WS_H1B = 1099 * MiB, WS_PART1 = 1131 * MiB, WS_PARTQ = 1132 * MiB;
constexpr size_t WS_QRAW = 1133 * MiB, WS_P = 1165 * MiB, WS_VWT = 1181 * MiB, WS_H2 = 1197 * MiB, WS_HN3 = 1261 * MiB;
constexpr size_t WS_TOKOF = 1293 * MiB, WS_GATEOF = 1294 * MiB, WS_TOKE = 1295 * MiB, WS_TOKR = 1296 * MiB, WS_ACT = 1297 * MiB, WS_Y = 1457 * MiB, WS_END = 1617 * MiB;
constexpr int CW_BAR = 4096;
constexpr int CW_CNT = 8192;
static_assert((CW_CNT + 64 * 32) * 4 <= (int)CTL_ZERO_BYTES, "CTL words inside the memset region");

constexpr int RING_OFF = 0, RING_BYTES = 131072;
constexpr int LDS_BYTES = 163840;
constexpr int MISC_OFF = 163840 - 1024;
constexpr int NWAVES = 8;

#define XB_TMO      128
#define XB_XCNT(j)  (256  + 64 * (j))
#define XB_XSUB(j)  (1280 + 64 * (j))
#define XB_XGEN(j)  (2304 + 64 * (j))
#define XB_TOP      3328
#define XB_TOPGEN   3392
#define XCD_BAR_WORDS 3456
#define XB_SPIN_CAP (1u << 20)

__device__ __forceinline__ unsigned xb_ld(unsigned* p)              { return __hip_atomic_load(p, __ATOMIC_RELAXED, __HIP_MEMORY_SCOPE_AGENT); }
__device__ __forceinline__ unsigned xb_add(unsigned* p, unsigned v) { return __hip_atomic_fetch_add(p, v, __ATOMIC_RELAXED, __HIP_MEMORY_SCOPE_AGENT); }
__device__ __forceinline__ unsigned xb_xcc_id() { return (unsigned)__builtin_amdgcn_s_getreg((3 << 11) | 20) & 0xFu; }
#define XB_SPIN(cond, bar) do { unsigned _sp = 0; while (cond) { __builtin_amdgcn_s_sleep(1); \
    if ((++_sp & 255u) == 0u) { if (xb_ld(&(bar)[XB_TMO])) break; if (_sp > XB_SPIN_CAP) { atomicAdd(&(bar)[XB_TMO], 1u); break; } } } } while (0)

struct XcdBarrier {
    unsigned* bar; unsigned x;
    volatile LAS unsigned* st;
};
__device__ __forceinline__ XcdBarrier xcd_barrier_post(unsigned* bar, volatile LAS unsigned* st) {
    XcdBarrier b; b.bar = bar; b.x = xb_xcc_id(); b.st = st;
    if (threadIdx.x == 0) (void)xb_add(&bar[XB_XCNT(b.x)], 1u);
    return b;
}
__device__ __forceinline__ void xcd_barrier_complete(unsigned* bar, unsigned x, unsigned& nloc, unsigned& nx) {
    const unsigned G = gridDim.x * gridDim.y * gridDim.z;
    unsigned sum, cnt, mine, sp = 0u;
    for (;;) {
        sum = 0u; cnt = 0u; mine = 0u;
#pragma unroll
        for (unsigned j = 0; j < 16; ++j) { const unsigned c = xb_ld(&bar[XB_XCNT(j)]); sum += c; cnt += (c > 0u) ? 1u : 0u; mine = (j == x) ? c : mine; }
        if (sum == G) break;
        __builtin_amdgcn_s_sleep(1);
        if ((++sp & 255u) == 0u) { if (xb_ld(&bar[XB_TMO])) break; if (sp > XB_SPIN_CAP) { atomicAdd(&bar[XB_TMO], 1u); break; } }
    }
    nloc = mine > 0u ? mine : 1u; nx = cnt > 0u ? cnt : 1u;
}
__device__ __forceinline__ void xcd_barrier(const XcdBarrier& b) {
    asm volatile("s_waitcnt vmcnt(0)" ::: "memory");
    __syncthreads();
    if (threadIdx.x == 0) {
        unsigned* bar = b.bar;
        __builtin_amdgcn_s_waitcnt(0);
        unsigned nloc = b.st[0], nx = b.st[1];
        if (nloc == 0u) { xcd_barrier_complete(bar, b.x, nloc, nx); b.st[0] = nloc; b.st[1] = nx; }
        const unsigned old = xb_add(&bar[XB_XSUB(b.x)], 1u);
        const unsigned gen = old / nloc;
        if (old + 1u == (gen + 1u) * nloc) {
            __builtin_amdgcn_fence(__ATOMIC_RELEASE, "agent");
            asm volatile("s_waitcnt vmcnt(0)" ::: "memory");
            const unsigned og = xb_add(&bar[XB_TOP], 1u);
            const unsigned tg = og / nx;
            if (og + 1u == (tg + 1u) * nx) xb_add(&bar[XB_TOPGEN], 1u);
            else XB_SPIN(xb_ld(&bar[XB_TOPGEN]) == tg, bar);
            __builtin_amdgcn_fence(__ATOMIC_ACQUIRE, "agent");
            xb_add(&bar[XB_XGEN(b.x)], 1u);
            asm volatile("s_waitcnt vmcnt(0)" ::: "memory");
        } else {
            XB_SPIN(xb_ld(&bar[XB_XGEN(b.x)]) == gen, bar);
            __builtin_amdgcn_fence(__ATOMIC_ACQUIRE, "agent");
            asm volatile("s_waitcnt vmcnt(0)" ::: "memory");
        }
    }
    __syncthreads();
}

struct Args { const float* in[32]; float* out; unsigned char* ws; int ph_lo, ph_hi; };
enum In { I_X = 0, I_MEM, I_GMIX, I_WIN, I_CONVW, I_CONVB, I_DTB, I_ALOG, I_DSKIP, I_SSDG, I_DAQG, I_DAKG, I_LQ1, I_LK1, I_LQ2, I_LK2, I_SUBG, I_WOUT, I_GXA, I_GMEM,
          I_WQ, I_WKV, I_XQG, I_XKG, I_WO, I_GFFN, I_RW, I_RB, I_W1, I_B1, I_W2, I_B2 };

struct ArgP {
    typedef const __attribute__((address_space(4))) char* kptr;
    DI const float* in(int i) const { kptr kp = (kptr)__builtin_amdgcn_kernarg_segment_ptr(); asm volatile("" : "+s"(kp)); return *(const float* const __attribute__((address_space(4)))*)(kp + 8 * i); }
    DI float* out() const { kptr kp = (kptr)__builtin_amdgcn_kernarg_segment_ptr(); asm volatile("" : "+s"(kp)); return *(float* const __attribute__((address_space(4)))*)(kp + 8 * 32); }
};
struct Frame {
    LAS unsigned char* lds;
    volatile LAS unsigned* MISC;
    unsigned* ctl;
    unsigned char* ws;
    int tid, lane, wave, vcu, G;
};

template <class DestRow>
DI void tr_item(const float* W, size_t ldw, int k0, int ncol0, int nvalid, const float* kscale, bf16_t* WT, int K, DestRow dr, LAS float* scr, int lane) {
    const int c = lane & 31;
#pragma unroll 8
    for (int i = 0; i < 32; ++i) { const int kk = 2 * i + (lane >> 5);
        float v = (c < nvalid) ? W[(size_t)(k0 + kk) * ldw + ncol0 + c] : 0.f;
        if (kscale) v *= kscale[k0 + kk];
        scr[kk * 33 + c] = v; }
    asm volatile("s_waitcnt lgkmcnt(0)" ::: "memory");
    const int c8 = lane & 7;
#pragma unroll
    for (int j = 0; j < 4; ++j) { const int n = (lane >> 3) + 8 * j; const LAS float* s = scr + (8 * c8) * 33 + n;
        u32x4 o; o.x = pk2(s[0 * 33], s[1 * 33]); o.y = pk2(s[2 * 33], s[3 * 33]); o.z = pk2(s[4 * 33], s[5 * 33]); o.w = pk2(s[6 * 33], s[7 * 33]);
        if (n < nvalid) *(u32x4*)(WT + (size_t)dr(ncol0 + n) * K + k0 + 8 * c8) = o; }
    asm volatile("s_waitcnt lgkmcnt(0)" ::: "memory");
}
DI int tileperm(int col) { const int o = col & 255; return (col & ~255) + 128 * ((o & 63) >> 5) + 32 * (o >> 6) + (o & 31); }
struct DrIdent { DI int operator()(int n) const { return n; } };
struct DrTile  { DI int operator()(int n) const { return tileperm(n); } };
struct DrWin   { DI int operator()(int n) const { const int pc = (n < 2560) ? n : (n < 2576 ? PC_DT + (n - 2560) : n - 16); return tileperm(pc); } };
struct DrW1    { DI int operator()(int n) const { const int half = n >> 11, j = n & 2047; return (j >> 7) * 256 + half * 128 + (j & 127); } };

DI void rms_row_to_bf16(const float* xrow, const float* g, bf16_t* orow, int lane) {
    const f32x4* xr = (const f32x4*)xrow + lane;
    f32x4 v[8]; float s = 0.f;
#pragma unroll
    for (int j = 0; j < 8; ++j) { v[j] = xr[64 * j]; s += (v[j].x * v[j].x + v[j].y * v[j].y) + (v[j].z * v[j].z + v[j].w * v[j].w); }
    const float rstd = 1.f / sqrtf(wave_sum(s) * (1.f / 2048.f) + EPS_);
    u32x2* o8 = (u32x2*)orow + lane;
#pragma unroll
    for (int j = 0; j < 8; ++j) { const f32x4 gg = ((const f32x4*)g)[lane + 64 * j];
        u32x2 o; o.x = pk2(v[j].x * rstd * gg.x, v[j].y * rstd * gg.y); o.y = pk2(v[j].z * rstd * gg.z, v[j].w * rstd * gg.w); o8[64 * j] = o; }
}

DI void p0_prologue(Frame& F, const ArgP& a) {
    LAS float* scr = (LAS float*)(F.lds + RING_OFF + F.wave * 16384);
    const int gw = F.vcu * NWAVES + F.wave, NGW = F.G * NWAVES;
    unsigned char* ws = F.ws;
    constexpr int I_A = 32 * 80, I_B = 32, I_C = 32 * 96, I_WOUT_ = 32 * 64, I_WQ_ = 32 * 64, I_WKV_ = 32 * 128, I_WO_ = 32 * 64, I_W1_ = 32 * 32 * 128, I_W2_ = 32 * 32 * 64;
    constexpr int NITEMS = I_A + I_B + I_C + I_WOUT_ + I_WQ_ + I_WKV_ + I_WO_ + I_W1_ + I_W2_;
    for (int it = gw; it < NITEMS; it += NGW) {
        int r = it;
        if (r < I_A) { tr_item(a.in(I_WIN), 5648, 64 * (r / 80), 32 * (r % 80), 32, nullptr, (bf16_t*)(ws + WS_WIN), 2048, DrWin(), scr, F.lane); continue; } r -= I_A;
        if (r < I_B) { tr_item(a.in(I_WIN), 5648, 64 * r, 2560, 16, nullptr, (bf16_t*)(ws + WS_WIN), 2048, DrWin(), scr, F.lane); continue; } r -= I_B;
        if (r < I_C) { tr_item(a.in(I_WIN), 5648, 64 * (r / 96), 2576 + 32 * (r % 96), 32, nullptr, (bf16_t*)(ws + WS_WIN), 2048, DrWin(), scr, F.lane); continue; } r -= I_C;
        if (r < I_WOUT_) { tr_item(a.in(I_WOUT), 2048, 64 * (r / 64), 32 * (r % 64), 32, nullptr, (bf16_t*)(ws + WS_WOUT), 2048, DrIdent(), scr, F.lane); continue; } r -= I_WOUT_;
        if (r < I_WQ_) { tr_item(a.in(I_WQ), 2048, 64 * (r / 64), 32 * (r % 64), 32, a.in(I_GXA), (bf16_t*)(ws + WS_WQ), 2048, DrIdent(), scr, F.lane); continue; } r -= I_WQ_;
        if (r < I_WKV_) { tr_item(a.in(I_WKV), 4096, 64 * (r / 128), 32 * (r % 128), 32, nullptr, (bf16_t*)(ws + WS_WKV), 2048, DrTile(), scr, F.lane); continue; } r -= I_WKV_;
        if (r < I_WO_) { tr_item(a.in(I_WO), 2048, 64 * (r / 64), 32 * (r % 64), 32, nullptr, (bf16_t*)(ws + WS_WO), 2048, DrIdent(), scr, F.lane); continue; } r -= I_WO_;
        if (r < I_W1_) { const int e = r / (32 * 128), q = r % (32 * 128);
            tr_item(a.in(I_W1) + (size_t)e * 2048 * 4096, 4096, 64 * (q / 128), 32 * (q % 128), 32, nullptr, (bf16_t*)(ws + WS_W1) + (size_t)e * 4096 * 2048, 2048, DrW1(), scr, F.lane); continue; } r -= I_W1_;
        { const int e = r / (32 * 64), q = r % (32 * 64);
            tr_item(a.in(I_W2) + (size_t)e * 2048 * 2048, 2048, 64 * (q / 64), 32 * (q % 64), 32, nullptr, (bf16_t*)(ws + WS_W2) + (size_t)e * 2048 * 2048, 2048, DrIdent(), scr, F.lane); }
    }
    for (int m = gw; m < NTOK; m += NGW) rms_row_to_bf16(a.in(I_X) + (size_t)m * 2048, a.in(I_GMIX), (bf16_t*)(ws + WS_HN) + (size_t)m * 2048, F.lane);
    for (int m = gw; m < NB * MEMLEN; m += NGW) rms_row_to_bf16(a.in(I_MEM) + (size_t)m * 2048, a.in(I_GMEM), (bf16_t*)(ws + WS_MN) + (size_t)m * 2048, F.lane);
}

struct SchedP1 {
    int G, c; const unsigned char* ws;
    DI bool next(int i, pg8::UnitD& u) const {
        const int L = i * G + c; if (L >= 32 * 23 + 64) return false;
        u.rows = nullptr; u.nvalid = 0; u.lda = 4096u; u.ldb = 4096u; u.e = 0; u.x0 = 0;
        if (L < 32 * 23) { u.type = 0; u.pn = L / 32; u.pm = L % 32; u.A = (const char*)(ws + WS_HN) + (size_t)u.pm * 256 * 4096; u.B = (const char*)(ws + WS_WIN) + (size_t)u.pn * 256 * 4096; }
        else { const int q = L - 32 * 23; u.type = 1; u.pn = q / 4; u.pm = q % 4; u.A = (const char*)(ws + WS_MN) + (size_t)u.pm * 256 * 4096; u.B = (const char*)(ws + WS_WKV) + (size_t)u.pn * 256 * 4096; }
        return true;
    }
};
struct EpiP1 {
    static constexpr bool AFTER_DRAIN = false;
    bf16_t* proj; float* dtb; bf16_t* kvraw; const float* gq; const float* gk;
    DI void operator()(const f32x4 (&acc)[2][2][4][2], const pg8::UnitD& u, int wr, int wc, int fr, int fq) const {
        { int ln_ = threadIdx.x; asm volatile("" : "+v"(ln_)); fr = ln_ & 15; fq = (ln_ >> 4) & 3; }
        const int row0 = u.pm * 256 + wr * 64 + fr;
        const int cn = u.pn * 256 + 64 * wc + 8 * fq;
        if (u.type == 1) {
#pragma unroll
            for (int ai = 0; ai < 2; ++ai)
#pragma unroll
                for (int m = 0; m < 4; ++m) { bf16_t* rp = kvraw + (size_t)(row0 + ai * 128 + m * 16) * 4096 + cn;
#pragma unroll
                    for (int bj = 0; bj < 2; ++bj) { const f32x4 v0 = acc[ai][bj][m][0], v1 = acc[ai][bj][m][1];
                        u32x4 w; w.x = pk2(v0[0], v0[1]); w.y = pk2(v0[2], v0[3]); w.z = pk2(v1[0], v1[1]); w.w = pk2(v1[2], v1[3]); *(u32x4*)(rp + 32 * bj) = w; } }
            return;
        }
        if (u.pn == 22) {
            if (wc == 0 && fq < 2) {
#pragma unroll
                for (int ai = 0; ai < 2; ++ai)
#pragma unroll
                    for (int m = 0; m < 4; ++m) { float* rp = dtb + (size_t)(row0 + ai * 128 + m * 16) * 16 + 8 * fq;
                        *(f32x4*)(rp) = acc[ai][0][m][0]; *(f32x4*)(rp + 4) = acc[ai][0][m][1]; }
            }
            return;
        }
        const bool isq = (u.pn >= 10 && u.pn < 14), isk = (u.pn >= 14 && u.pn < 18);
        if (!(isq || isk)) {
#pragma unroll
            for (int ai = 0; ai < 2; ++ai)
#pragma unroll
                for (int m = 0; m < 4; ++m) { bf16_t* rp = proj + (size_t)(row0 + ai * 128 + m * 16) * PP + cn;
#pragma unroll
                    for (int bj = 0; bj < 2; ++bj) { const f32x4 v0 = acc[ai][bj][m][0], v1 = acc[ai][bj][m][1];
                        u32x4 w; w.x = pk2(v0[0], v0[1]); w.y = pk2(v0[2], v0[3]); w.z = pk2(v1[0], v1[1]); w.w = pk2(v1[2], v1[3]); *(u32x4*)(rp + 32 * bj) = w; } }
            return;
        }
        const float* g = (isq ? gq : gk) + 8 * fq; const float sc = isq ? (0.125f * 1.4426950408889634f) : 1.f;
#pragma unroll
        for (int ai = 0; ai < 2; ++ai)
#pragma unroll
            for (int m = 0; m < 4; ++m) { bf16_t* rp = proj + (size_t)(row0 + ai * 128 + m * 16) * PP + cn;
                float ss = 0.f;
#pragma unroll
                for (int bj = 0; bj < 2; ++bj)
#pragma unroll
                    for (int n = 0; n < 2; ++n) { const f32x4 v = acc[ai][bj][m][n]; ss += (v[0] * v[0] + v[1] * v[1]) + (v[2] * v[2] + v[3] * v[3]); }
                ss += __shfl_xor(ss, 16); ss += __shfl_xor(ss, 32);
                const float rs = sc / sqrtf(ss * (1.f / 64.f) + EPS_);
#pragma unroll
                for (int bj = 0; bj < 2; ++bj) { const f32x4 v0 = acc[ai][bj][m][0] * rs * *(const f32x4*)(g + 32 * bj), v1 = acc[ai][bj][m][1] * rs * *(const f32x4*)(g + 32 * bj + 4);
                    u32x4 w; w.x = pk2(v0[0], v0[1]); w.y = pk2(v0[2], v0[3]); w.z = pk2(v1[0], v1[1]); w.w = pk2(v1[2], v1[3]); *(u32x4*)(rp + 32 * bj) = w; } }
    }
};

DI void kprep(Frame& F, const ArgP& a) {
    const int gw = F.vcu * NWAVES + F.wave, NGW = F.G * NWAVES;
    const bf16_t* kv = (const bf16_t*)(F.ws + WS_KVRAW); bf16_t* kn = (bf16_t*)(F.ws + WS_KN);
    for (int it = gw; it < NB * MEMLEN * 4; it += NGW) {
        const int row = it >> 2, h = it & 3, b = row >> 8, key = row & 255;
        const u32x4 raw = *(const u32x4*)(kv + (size_t)row * 4096 + h * 512 + F.lane * 8);
        float v[8]; v[0] = bflo(raw.x); v[1] = bfhi(raw.x); v[2] = bflo(raw.y); v[3] = bfhi(raw.y); v[4] = bflo(raw.z); v[5] = bfhi(raw.z); v[6] = bflo(raw.w); v[7] = bfhi(raw.w);
        float ss = 0.f;
#pragma unroll
        for (int j = 0; j < 8; ++j) ss += v[j] * v[j];
        const float rs = 1.f / sqrtf(wave_sum(ss) * (1.f / 512.f) + EPS_) * 0.04419417382415922f;
        const float* gk = a.in(I_XKG) + F.lane * 8; const float* gq = a.in(I_XQG) + F.lane * 8;
        u32x4 o; o.x = pk2(v[0] * rs * gk[0] * gq[0], v[1] * rs * gk[1] * gq[1]); o.y = pk2(v[2] * rs * gk[2] * gq[2], v[3] * rs * gk[3] * gq[3]);
        o.z = pk2(v[4] * rs * gk[4] * gq[4], v[5] * rs * gk[5] * gq[5]); o.w = pk2(v[6] * rs * gk[6] * gq[6], v[7] * rs * gk[7] * gq[7]);
        *(u32x4*)(kn + ((size_t)((b * 4 + h) * 256 + key)) * 512 + F.lane * 8) = o;
    }
}

constexpr int SP = 272;
constexpr int S_C = 0, S_BM = 34816, S_BT = 69632, S_XDT = 104448, S_XW = 121856, S_HB = 139264, S_F = 156672, SSD_LDS = 157696;
static_assert(SSD_LDS <= MISC_OFF, "SSD LDS map");
#define MFMA32(a, b, c) __builtin_amdgcn_mfma_f32_32x32x16_bf16((a), (b), (c), 0, 0, 0)
DI int crow(int r, int hi) { return (r & 3) + 8 * (r >> 2) + 4 * hi; }
DI bf16x8 ldfrag(LAS const unsigned char* base, int row, int kel) { return *(const LAS bf16x8*)(base + row * SP + kel * 2); }

DI void ssd_unit(Frame& F, const ArgP& a, int b, int hd) {
    LAS unsigned char* lds = F.lds;
    const int tid = F.tid, lane = F.lane, wid = F.wave, r32 = lane & 31, hh = lane >> 5;
    LAS float* sdt = (LAS float*)(lds + S_F); LAS float* sac = sdt + 128;
    const bf16_t* proj = (const bf16_t*)(F.ws + WS_PROJ); const float* dtbuf = (const float*)(F.ws + WS_DT); bf16_t* ycat = (bf16_t*)(F.ws + WS_YCAT);
    const int g = hd >> 3;
    const float aneg = -__expf(a.in(I_ALOG)[hd]), dtb = a.in(I_DTB)[hd], dsk = a.in(I_DSKIP)[hd];
    const float* convw = a.in(I_CONVW); const float* convb = a.in(I_CONVB);
    f32x16 hT; for (int i = 0; i < 16; ++i) hT[i] = 0.f;
    const int nb = wid & 3, pb = wid >> 2;
    for (int c = 0; c < 16; ++c) {
        const int t0 = b * SEQ_ + c * 128;
        if (wid == 0) {
            const float x0 = dtbuf[(size_t)(t0 + 2 * lane) * 16 + hd] + dtb, x1 = dtbuf[(size_t)(t0 + 2 * lane + 1) * 16 + hd] + dtb;
            const float d0 = x0 > 20.f ? x0 : log1pf(__expf(x0)), d1 = x1 > 20.f ? x1 : log1pf(__expf(x1));
            const float a0 = d0 * aneg, a1 = d1 * aneg;
            float s = a0 + a1;
#pragma unroll
            for (int o = 1; o < 64; o <<= 1) { const float t = __shfl_up(s, o); if (lane >= o) s += t; }
            sdt[2 * lane] = d0; sdt[2 * lane + 1] = d1; sac[2 * lane] = s - a1; sac[2 * lane + 1] = s;
        }
        {
            LAS unsigned char* hbp = lds + S_HB + (32 * pb + r32) * SP + (32 * nb + 4 * hh) * 2;
#pragma unroll
            for (int q4 = 0; q4 < 4; ++q4) { u32x2 w; w.x = pk2(hT[4 * q4], hT[4 * q4 + 1]); w.y = pk2(hT[4 * q4 + 2], hT[4 * q4 + 3]); *(LAS u32x2*)(hbp + 16 * q4) = w; }
        }
        __syncthreads();
        const float aend = sac[127];
        for (int item = tid; item < 640; item += 512) {
            const int seg = item / 40, cg = item % 40, l0 = seg * 8;
            const int xcol = (cg < 8) ? (hd * 64 + cg * 8) : (cg < 24 ? (1024 + g * 128 + (cg - 8) * 8) : (1280 + g * 128 + (cg - 24) * 8));
            u32x4 in[11];
#pragma unroll
            for (int j = 0; j < 11; ++j) { const int tt = c * 128 + l0 - 3 + j;
                in[j] = (tt >= 0) ? *(const u32x4*)(proj + (size_t)(b * SEQ_ + tt) * PP + PC_XBC + xcol) : (u32x4){0u, 0u, 0u, 0u}; }
            float w[4][8], bias[8];
#pragma unroll
            for (int k = 0; k < 4; ++k) { const f32x4 w0 = *(const f32x4*)(convw + k * 1536 + xcol), w1 = *(const f32x4*)(convw + k * 1536 + xcol + 4);
                w[k][0] = w0[0]; w[k][1] = w0[1]; w[k][2] = w0[2]; w[k][3] = w0[3]; w[k][4] = w1[0]; w[k][5] = w1[1]; w[k][6] = w1[2]; w[k][7] = w1[3]; }
            { const f32x4 b0 = *(const f32x4*)(convb + xcol), b1 = *(const f32x4*)(convb + xcol + 4);
              bias[0] = b0[0]; bias[1] = b0[1]; bias[2] = b0[2]; bias[3] = b0[3]; bias[4] = b1[0]; bias[5] = b1[1]; bias[6] = b1[2]; bias[7] = b1[3]; }
            float o[8][8];
#pragma unroll
            for (int j = 0; j < 8; ++j)
#pragma unroll
                for (int i = 0; i < 8; ++i) { float s = bias[i];
#pragma unroll
                    for (int k = 0; k < 4; ++k) { const unsigned wd = in[j + k][i >> 1]; s += w[k][i] * ((i & 1) ? bfhi(wd) : bflo(wd)); }
                    o[j][i] = siluf(s); }
            if (cg < 8) {
                float dv[8], ev[8];
#pragma unroll
                for (int j = 0; j < 8; ++j) { dv[j] = sdt[l0 + j]; ev[j] = dv[j] * __expf(aend - sac[l0 + j]); }
#pragma unroll
                for (int i = 0; i < 8; ++i) { const int p = cg * 8 + i;
                    u32x4 w1, w2;
                    w1.x = pk2(o[0][i] * dv[0], o[1][i] * dv[1]); w1.y = pk2(o[2][i] * dv[2], o[3][i] * dv[3]); w1.z = pk2(o[4][i] * dv[4], o[5][i] * dv[5]); w1.w = pk2(o[6][i] * dv[6], o[7][i] * dv[7]);
                    w2.x = pk2(o[0][i] * ev[0], o[1][i] * ev[1]); w2.y = pk2(o[2][i] * ev[2], o[3][i] * ev[3]); w2.z = pk2(o[4][i] * ev[4], o[5][i] * ev[5]); w2.w = pk2(o[6][i] * ev[6], o[7][i] * ev[7]);
                    *(LAS u32x4*)(lds + S_XDT + p * SP + l0 * 2) = w1; *(LAS u32x4*)(lds + S_XW + p * SP + l0 * 2) = w2; }
            } else if (cg < 24) {
                const int n0 = (cg - 8) * 8;
#pragma unroll
                for (int j = 0; j < 8; ++j) { u32x4 w1; w1.x = pk2(o[j][0], o[j][1]); w1.y = pk2(o[j][2], o[j][3]); w1.z = pk2(o[j][4], o[j][5]); w1.w = pk2(o[j][6], o[j][7]);
                    *(LAS u32x4*)(lds + S_BM + (l0 + j) * SP + n0 * 2) = w1; }
#pragma unroll
                for (int i = 0; i < 8; ++i) { u32x4 w2; w2.x = pk2(o[0][i], o[1][i]); w2.y = pk2(o[2][i], o[3][i]); w2.z = pk2(o[4][i], o[5][i]); w2.w = pk2(o[6][i], o[7][i]);
                    *(LAS u32x4*)(lds + S_BT + (n0 + i) * SP + l0 * 2) = w2; }
            } else {
                const int n0 = (cg - 24) * 8;
#pragma unroll
                for (int j = 0; j < 8; ++j) { u32x4 w1; w1.x = pk2(o[j][0], o[j][1]); w1.y = pk2(o[j][2], o[j][3]); w1.z = pk2(o[j][4], o[j][5]); w1.w = pk2(o[j][6], o[j][7]);
                    *(LAS u32x4*)(lds + S_C + (l0 + j) * SP + n0 * 2) = w1; }
            }
        }
        __syncthreads();
        const int lb = wid >> 1;
        f32x16 xt[2];
#pragma unroll
        for (int q = 0; q < 2; ++q) { const int sb = 2 * (wid & 1) + q;
            for (int i = 0; i < 16; ++i) xt[q][i] = 0.f;
            if (sb <= lb) {
#pragma unroll
                for (int ks = 0; ks < 8; ++ks) xt[q] = MFMA32(ldfrag(lds + S_BM, 32 * sb + r32, 16 * ks + 8 * hh), ldfrag(lds + S_C, 32 * lb + r32, 16 * ks + 8 * hh), xt[q]);
            }
        }
        __syncthreads();
        {
            const int l = 32 * lb + r32; const float al = sac[l], dl = sdt[l];
#pragma unroll
            for (int q = 0; q < 2; ++q) { const int sb = 2 * (wid & 1) + q;
#pragma unroll
                for (int q4 = 0; q4 < 4; ++q4) { float mv[4];
#pragma unroll
                    for (int e = 0; e < 4; ++e) { const int s = 32 * sb + 8 * q4 + 4 * hh + e;
                        float v = 0.f;
                        if (s <= l) v = xt[q][4 * q4 + e] * __expf(al - sac[s]);
                        if (s == l) v += dsk / dl;
                        mv[e] = v; }
                    u32x2 w; w.x = pk2(mv[0], mv[1]); w.y = pk2(mv[2], mv[3]);
                    *(LAS u32x2*)(lds + S_BM + l * SP + (32 * sb + 8 * q4 + 4 * hh) * 2) = w; }
            }
        }
        __syncthreads();
        {
            const int lb2 = wid & 3, pb2 = wid >> 2;
            f32x16 y1, y2; for (int i = 0; i < 16; ++i) { y1[i] = 0.f; y2[i] = 0.f; }
            for (int ks = 0; ks < 2 * (lb2 + 1); ++ks) y1 = MFMA32(ldfrag(lds + S_BM, 32 * lb2 + r32, 16 * ks + 8 * hh), ldfrag(lds + S_XDT, 32 * pb2 + r32, 16 * ks + 8 * hh), y1);
#pragma unroll
            for (int ks = 0; ks < 8; ++ks) y2 = MFMA32(ldfrag(lds + S_C, 32 * lb2 + r32, 16 * ks + 8 * hh), ldfrag(lds + S_HB, 32 * pb2 + r32, 16 * ks + 8 * hh), y2);
            const float cd = __expf(aend);
#pragma unroll
            for (int i = 0; i < 16; ++i) hT[i] *= cd;
#pragma unroll
            for (int ks = 0; ks < 8; ++ks) hT = MFMA32(ldfrag(lds + S_BT, 32 * nb + r32, 16 * ks + 8 * hh), ldfrag(lds + S_XW, 32 * pb + r32, 16 * ks + 8 * hh), hT);
            const int pcol = hd * 64 + 32 * pb2 + r32;
#pragma unroll
            for (int i = 0; i < 16; ++i) { const int l = 32 * lb2 + crow(i, hh); const size_t tok = (size_t)(t0 + l);
                const float yv = y1[i] + __expf(sac[l]) * y2[i];
                const float z = bf2f(proj[tok * PP + pcol]);
                ycat[tok * 2048 + pcol] = (bf16_t)(pk2(yv * siluf(z), 0.f) & 0xffffu); }
        }
        __syncthreads();
    }
}

DI void attn_phase_da(Frame& F) {
    const attn_body::bf16* proj = (const attn_body::bf16*)(F.ws + WS_PROJ);
    for (int r = 0; ; ++r) {
        const int u = r * F.G + F.vcu; if (u >= 1024) break;
        const int v = u & 255, rr = u >> 8;
        const int combo = v >> 1, sp = v & 1;
        const int half = combo & 1, j = (combo >> 1) & 1, h = (combo >> 2) & 7, b = combo >> 5;
        const int qb = (rr == 0) ? (7 - sp) : (rr == 1) ? sp : (rr == 2) ? (4 + sp) : (3 - sp);
        attn_body::bf16* O = (attn_body::bf16*)(F.ws + (j ? WS_O1 : WS_O0));
        attn_body::attn_unit<8>(b, PC_Q + (h * 2 + j) * 64, PC_V + h * 128 + half * 64, h * 128 + half * 64, qb, proj, proj + (PC_K - PC_Q), proj, O, (char*)F.lds);
    }
}

DI void p3_finalize(Frame& F, const ArgP& a) {
    const int gw = F.vcu * NWAVES + F.wave, NGW = F.G * NWAVES, lane = F.lane;
    bf16_t* ycat = (bf16_t*)(F.ws + WS_YCAT); const bf16_t* o0 = (const bf16_t*)(F.ws + WS_O0); const bf16_t* o1 = (const bf16_t*)(F.ws + WS_O1);
    float l1 = a.in(I_LQ1)[lane] * a.in(I_LK1)[lane], l2 = a.in(I_LQ2)[lane] * a.in(I_LK2)[lane];
    const float lam = __expf(wave_sum(l1)) - __expf(wave_sum(l2)) + LAM_INIT;
    for (int m = gw; m < NTOK; m += NGW) {
        { bf16_t* yp = ycat + (size_t)m * 2048 + 16 * lane;
          const u32x4 r0 = *(const u32x4*)yp, r1 = *(const u32x4*)(yp + 8);
          float v[16]; v[0] = bflo(r0.x); v[1] = bfhi(r0.x); v[2] = bflo(r0.y); v[3] = bfhi(r0.y); v[4] = bflo(r0.z); v[5] = bfhi(r0.z); v[6] = bflo(r0.w); v[7] = bfhi(r0.w);
          v[8] = bflo(r1.x); v[9] = bfhi(r1.x); v[10] = bflo(r1.y); v[11] = bfhi(r1.y); v[12] = bflo(r1.z); v[13] = bfhi(r1.z); v[14] = bflo(r1.w); v[15] = bfhi(r1.w);
          float ss = 0.f;
#pragma unroll
          for (int i = 0; i < 16; ++i) ss += v[i] * v[i];
#pragma unroll
          for (int o = 1; o < 32; o <<= 1) ss += __shfl_xor(ss, o);
          const float rs = 1.f / sqrtf(ss * (1.f / 512.f) + EPS_);
          const float* g = a.in(I_SSDG) + 16 * lane;
          u32x4 w0, w1;
          w0.x = pk2(v[0] * rs * g[0], v[1] * rs * g[1]); w0.y = pk2(v[2] * rs * g[2], v[3] * rs * g[3]); w0.z = pk2(v[4] * rs * g[4], v[5] * rs * g[5]); w0.w = pk2(v[6] * rs * g[6], v[7] * rs * g[7]);
          w1.x = pk2(v[8] * rs * g[8], v[9] * rs * g[9]); w1.y = pk2(v[10] * rs * g[10], v[11] * rs * g[11]); w1.z = pk2(v[12] * rs * g[12], v[13] * rs * g[13]); w1.w = pk2(v[14] * rs * g[14], v[15] * rs * g[15]);
          *(u32x4*)yp = w0; *(u32x4*)(yp + 8) = w1; }
        { const bf16_t* p0 = o0 + (size_t)m * 1024 + 16 * lane; const bf16_t* p1 = o1 + (size_t)m * 1024 + 16 * lane;
          const u32x4 a0 = *(const u32x4*)p0, a1 = *(const u32x4*)(p0 + 8), b0 = *(const u32x4*)p1, b1 = *(const u32x4*)(p1 + 8);
          float v[16];
          v[0] = bflo(a0.x) - lam * bflo(b0.x); v[1] = bfhi(a0.x) - lam * bfhi(b0.x); v[2] = bflo(a0.y) - lam * bflo(b0.y); v[3] = bfhi(a0.y) - lam * bfhi(b0.y);
          v[4] = bflo(a0.z) - lam * bflo(b0.z); v[5] = bfhi(a0.z) - lam * bfhi(b0.z); v[6] = bflo(a0.w) - lam * bflo(b0.w); v[7] = bfhi(a0.w) - lam * bfhi(b0.w);
          v[8] = bflo(a1.x) - lam * bflo(b1.x); v[9] = bfhi(a1.x) - lam * bfhi(b1.x); v[10] = bflo(a1.y) - lam * bflo(b1.y); v[11] = bfhi(a1.y) - lam * bfhi(b1.y);
          v[12] = bflo(a1.z) - lam * bflo(b1.z); v[13] = bfhi(a1.z) - lam * bfhi(b1.z); v[14] = bflo(a1.w) - lam * bflo(b1.w); v[15] = bfhi(a1.w) - lam * bfhi(b1.w);
          float ss = 0.f;
#pragma unroll
          for (int i = 0; i < 16; ++i) ss += v[i] * v[i];
          ss += __shfl_xor(ss, 1); ss += __shfl_xor(ss, 2); ss += __shfl_xor(ss, 4);
          const float rs = 1.f / sqrtf(ss * (1.f / 128.f) + EPS_) * (1.f - LAM_INIT);
          const float* g = a.in(I_SUBG) + 16 * (lane & 7);
          u32x4 w0, w1;
          w0.x = pk2(v[0] * rs * g[0], v[1] * rs * g[1]); w0.y = pk2(v[2] * rs * g[2], v[3] * rs * g[3]); w0.z = pk2(v[4] * rs * g[4], v[5] * rs * g[5]); w0.w = pk2(v[6] * rs * g[6], v[7] * rs * g[7]);
          w1.x = pk2(v[8] * rs * g[8], v[9] * rs * g[9]); w1.y = pk2(v[10] * rs * g[10], v[11] * rs * g[11]); w1.z = pk2(v[12] * rs * g[12], v[13] * rs * g[13]); w1.w = pk2(v[14] * rs * g[14], v[15] * rs * g[15]);
          bf16_t* yp = ycat + (size_t)m * 2048 + 1024 + 16 * lane;
          *(u32x4*)yp = w0; *(u32x4*)(yp + 8) = w1; }
    }
}

struct SchedDense {
    int G, c, nM, nN; const char* A; const char* B; unsigned lda, ldb; int bdiv; size_t bstride;
    DI bool next(int i, pg8::UnitD& u) const {
        const int L = i * G + c; if (L >= nM * nN) return false;
        u.rows = nullptr; u.nvalid = 0; u.lda = lda; u.ldb = ldb; u.type = 0; u.e = 0; u.x0 = 0;
        u.pn = L / nM; u.pm = L % nM;
        u.A = A + (size_t)u.pm * 256 * lda; u.B = B + (size_t)u.pn * 256 * ldb + (size_t)(u.pm / bdiv) * bstride;
        return true;
    }
};
struct EpiResid {
    static constexpr bool AFTER_DRAIN = false;
    const float* base; float* out; bf16_t* outb; float* part;
    DI void operator()(const f32x4 (&acc)[2][2][4][2], const pg8::UnitD& u, int wr, int wc, int fr, int fq) const {
        { int ln_ = threadIdx.x; asm volatile("" : "+v"(ln_)); fr = ln_ & 15; fq = (ln_ >> 4) & 3; }
        const int row0 = u.pm * 256 + wr * 64 + fr, col0 = u.pn * 256 + wc * 32 + 8 * fq;
#pragma unroll
        for (int ai = 0; ai < 2; ++ai)
#pragma unroll
            for (int m = 0; m < 4; ++m) { const size_t row = (size_t)(row0 + ai * 128 + m * 16); float ss = 0.f;
#pragma unroll
                for (int bj = 0; bj < 2; ++bj) { const size_t idx = row * 2048 + col0 + bj * 128;
                    f32x4 v0 = acc[ai][bj][m][0] + *(const f32x4*)(base + idx), v1 = acc[ai][bj][m][1] + *(const f32x4*)(base + idx + 4);
                    *(f32x4*)(out + idx) = v0; *(f32x4*)(out + idx + 4) = v1;
                    if (outb) { u32x4 w; w.x = pk2(v0[0], v0[1]); w.y = pk2(v0[2], v0[3]); w.z = pk2(v1[0], v1[1]); w.w = pk2(v1[2], v1[3]); *(u32x4*)(outb + idx) = w; }
                    ss += (v0[0] * v0[0] + v0[1] * v0[1]) + (v0[2] * v0[2] + v0[3] * v0[3]) + (v1[0] * v1[0] + v1[1] * v1[1]) + (v1[2] * v1[2] + v1[3] * v1[3]); }
                if (part) { ss += __shfl_xor(ss, 16); ss += __shfl_xor(ss, 32); if (fq == 0) part[row * 32 + u.pn * 4 + wc] = ss; } }
    }
};

struct EpiQ {
    static constexpr bool AFTER_DRAIN = false;
    bf16_t* outb; float* part;
    DI void operator()(const f32x4 (&acc)[2][2][4][2], const pg8::UnitD& u, int wr, int wc, int fr, int fq) const {
        { int ln_ = threadIdx.x; asm volatile("" : "+v"(ln_)); fr = ln_ & 15; fq = (ln_ >> 4) & 3; }
        const int row0 = u.pm * 256 + wr * 64 + fr, col0 = u.pn * 256 + wc * 32 + 8 * fq;
#pragma unroll
        for (int ai = 0; ai < 2; ++ai)
#pragma unroll
            for (int m = 0; m < 4; ++m) { const size_t row = (size_t)(row0 + ai * 128 + m * 16); float ss = 0.f;
#pragma unroll
                for (int bj = 0; bj < 2; ++bj) { const size_t idx = row * 2048 + col0 + bj * 128; const f32x4 v0 = acc[ai][bj][m][0], v1 = acc[ai][bj][m][1];
                    u32x4 w; w.x = pk2(v0[0], v0[1]); w.y = pk2(v0[2], v0[3]); w.z = pk2(v1[0], v1[1]); w.w = pk2(v1[2], v1[3]); *(u32x4*)(outb + idx) = w;
                    ss += (v0[0] * v0[0] + v0[1] * v0[1]) + (v0[2] * v0[2] + v0[3] * v0[3]) + (v1[0] * v1[0] + v1[1] * v1[1]) + (v1[2] * v1[2] + v1[3] * v1[3]); }
                ss += __shfl_xor(ss, 16); ss += __shfl_xor(ss, 32); if (fq == 0) part[row * 32 + u.pn * 4 + wc] = ss; }
    }
};

struct SchedXS {
    int G, c; const unsigned char* ws;
    DI bool next(int i, pg8::UnitD& u) const {
        const int L = i * G + c; if (L >= 256) return false;
        u.rows = nullptr; u.nvalid = 0; u.e = 0;
        const int q = L & 127, bh = q >> 3, t8 = q & 7, b = bh >> 2, h = bh & 3;
        u.pm = b; u.pn = h; u.x0 = t8;
        if (L < 128) { u.type = 0; u.lda = 4096u; u.ldb = 1024u;
            u.A = (const char*)(ws + WS_QRAW) + (size_t)(b * 2048 + t8 * 256) * 4096 + h * 1024; u.B = (const char*)(ws + WS_KN) + (size_t)(bh * 256) * 1024; }
        else { u.type = 1; u.lda = 4096u; u.ldb = 8192u;
            u.A = (const char*)(ws + WS_WO) + (size_t)(t8 * 256) * 4096 + h * 1024; u.B = (const char*)(ws + WS_KVRAW) + (size_t)(b * 256) * 8192 + (2048 + h * 512) * 2; }
        return true;
    }
};
struct EpiXS {
    static constexpr bool AFTER_DRAIN = false;
    bf16_t* P; bf16_t* VWT; const float* part1; const float* partq; LAS float* red;
    DI void operator()(const f32x4 (&acc)[2][2][4][2], const pg8::UnitD& u, int wr, int wc, int fr, int fq) const {
        { int ln_ = threadIdx.x; asm volatile("" : "+v"(ln_)); fr = ln_ & 15; fq = (ln_ >> 4) & 3; }
        const int b = u.pm, h = u.pn, t8 = u.x0;
        const int col0 = wc * 32 + 8 * fq;
        if (u.type == 1) {
            char* Vu = (char*)(VWT + ((size_t)b * 2048 + t8 * 256) * 1024 + h * 256);
#pragma unroll
            for (int ai = 0; ai < 2; ++ai)
#pragma unroll
                for (int m = 0; m < 4; ++m) { const unsigned rl = (unsigned)(ai * 128 + wr * 64 + m * 16 + fr);
#pragma unroll
                    for (int bj = 0; bj < 2; ++bj) { const f32x4 v0 = acc[ai][bj][m][0], v1 = acc[ai][bj][m][1];
                        u32x4 w; w.x = pk2(v0[0], v0[1]); w.y = pk2(v0[2], v0[3]); w.z = pk2(v1[0], v1[1]); w.w = pk2(v1[2], v1[3]);
                        *(u32x4*)(Vu + (rl * 1024u + (unsigned)(bj * 128 + col0)) * 2u) = w; } }
            return;
        }
        const size_t row0 = (size_t)b * 2048 + t8 * 256;
        const char* p1u = (const char*)(part1 + row0 * 32); const char* pqu = (const char*)(partq + row0 * 32 + h * 8); char* Pu = (char*)(P + row0 * 1024 + h * 256);
        float rsc[2][4];
#pragma unroll
        for (int ai = 0; ai < 2; ++ai)
#pragma unroll
            for (int m = 0; m < 4; ++m) { const unsigned rl = (unsigned)(ai * 128 + wr * 64 + m * 16 + fr);
                const f32x4 p0 = *(const f32x4*)(p1u + (rl * 32u + (unsigned)fq * 8u) * 4u), p1 = *(const f32x4*)(p1u + (rl * 32u + (unsigned)fq * 8u + 4u) * 4u);
                float s1 = (p0[0] + p0[1]) + (p0[2] + p0[3]) + (p1[0] + p1[1]) + (p1[2] + p1[3]);
                const f32x2 pq = *(const f32x2*)(pqu + (rl * 32u + (unsigned)fq * 2u) * 4u);
                float sq = pq[0] + pq[1];
                s1 += __shfl_xor(s1, 16); s1 += __shfl_xor(s1, 32); sq += __shfl_xor(sq, 16); sq += __shfl_xor(sq, 32);
                rsc[ai][m] = __builtin_amdgcn_rsqf(sq * (1.f / 512.f) + EPS_ * (s1 * (1.f / 2048.f) + EPS_)) * 1.4426950408889634f;
                float ps = 0.f;
#pragma unroll
                for (int bj = 0; bj < 2; ++bj)
#pragma unroll
                    for (int n = 0; n < 2; ++n)
#pragma unroll
                        for (int e = 0; e < 4; ++e) ps += __builtin_amdgcn_exp2f(fminf(acc[ai][bj][m][n][e] * rsc[ai][m], 100.f));
                ps += __shfl_xor(ps, 16); ps += __shfl_xor(ps, 32);
                if (fq == 0) red[rl * 4 + wc] = ps;
                __builtin_amdgcn_sched_barrier(0); }
        __syncthreads();
        { int ln_ = threadIdx.x; asm volatile("" : "+v"(ln_)); fr = ln_ & 15; fq = (ln_ >> 4) & 3; }
#pragma unroll
        for (int ai = 0; ai < 2; ++ai)
#pragma unroll
            for (int m = 0; m < 4; ++m) { const unsigned rl = (unsigned)(ai * 128 + wr * 64 + m * 16 + fr);
                const f32x4 t = *(const LAS f32x4*)(red + rl * 4); const float inv = __builtin_amdgcn_rcpf((t[0] + t[1]) + (t[2] + t[3])); float rs = rsc[ai][m]; asm volatile("" : "+v"(rs));
#pragma unroll
                for (int bj = 0; bj < 2; ++bj) { float x[8];
#pragma unroll
                    for (int n = 0; n < 2; ++n)
#pragma unroll
                        for (int e = 0; e < 4; ++e) x[n * 4 + e] = __builtin_amdgcn_exp2f(fminf(acc[ai][bj][m][n][e] * rs, 100.f)) * inv;
                    u32x4 w; w.x = pk2(x[0], x[1]); w.y = pk2(x[2], x[3]); w.z = pk2(x[4], x[5]); w.w = pk2(x[6], x[7]);
                    *(u32x4*)(Pu + (rl * 1024u + (unsigned)(bj * 128 + wc * 32 + 8 * fq)) * 2u) = w; } }
        __syncthreads();
    }
};

DI void p8_route(Frame& F, const ArgP& a) {
    LAS float* s_hn = (LAS float*)F.lds; LAS float* s_log = (LAS float*)(F.lds + 131072);
    const float* h2 = (const float*)(F.ws + WS_H2); bf16_t* hn3 = (bf16_t*)(F.ws + WS_HN3);
    int* tok_of = (int*)(F.ws + WS_TOKOF); float* gate_of = (float*)(F.ws + WS_GATEOF); int* tok_e = (int*)(F.ws + WS_TOKE); int* tok_r = (int*)(F.ws + WS_TOKR);
    const float* rw = a.in(I_RW); const float* rb = a.in(I_RB); const float* g3 = a.in(I_GFFN);
    const int lane = F.lane, wave = F.wave, tid = F.tid;
    for (int task = F.vcu; task < NTOK / 16; task += F.G) {
        const int tb = task * 16;
#pragma unroll
        for (int q = 0; q < 2; ++q) { const int tl = 2 * wave + q; const size_t tok = (size_t)(tb + tl);
            const f32x4* xr = (const f32x4*)(h2 + tok * 2048) + lane;
            f32x4 v[8]; float s = 0.f;
#pragma unroll
            for (int j = 0; j < 8; ++j) { v[j] = xr[64 * j]; s += (v[j].x * v[j].x + v[j].y * v[j].y) + (v[j].z * v[j].z + v[j].w * v[j].w); }
            const float rstd = 1.f / sqrtf(wave_sum(s) * (1.f / 2048.f) + EPS_);
            u32x2* o8 = (u32x2*)(hn3 + tok * 2048) + lane;
#pragma unroll
            for (int j = 0; j < 8; ++j) { const f32x4 gg = ((const f32x4*)g3)[lane + 64 * j]; const f32x4 y = v[j] * rstd * gg;
                *(LAS f32x4*)(s_hn + tl * 2048 + (lane + 64 * j) * 4) = y;
                u32x2 o; o.x = pk2(y.x, y.y); o.y = pk2(y.z, y.w); o8[64 * j] = o; } }
        __syncthreads();
        { const int tt = tid >> 5, e = tid & 31; const LAS float* hp = s_hn + tt * 2048; const float* wp = rw + e;
          float acc0 = 0.f, acc1 = 0.f, acc2 = 0.f, acc3 = 0.f;
#pragma unroll 4
          for (int k = 0; k < 2048; k += 4) { const f32x4 hv = *(const LAS f32x4*)(hp + k);
              acc0 = fmaf(hv.x, wp[(size_t)(k + 0) * 32], acc0); acc1 = fmaf(hv.y, wp[(size_t)(k + 1) * 32], acc1);
              acc2 = fmaf(hv.z, wp[(size_t)(k + 2) * 32], acc2); acc3 = fmaf(hv.w, wp[(size_t)(k + 3) * 32], acc3); }
          s_log[tt * 32 + e] = ((acc0 + acc1) + (acc2 + acc3)) + rb[e]; }
        __syncthreads();
        if (tid < 16) { const int tok = tb + tid; unsigned taken = 0u; float val[4]; int idx[4];
#pragma unroll
            for (int k = 0; k < 4; ++k) { float best = -INFINITY; int bi = 0;
                for (int e = 0; e < 32; ++e) { const float v = s_log[tid * 32 + e]; if (!((taken >> e) & 1u) && v > best) { best = v; bi = e; } }
                taken |= 1u << bi; val[k] = best; idx[k] = bi; }
            float ex[4], sum = 0.f;
#pragma unroll
            for (int k = 0; k < 4; ++k) { ex[k] = __expf(val[k] - val[0]); sum += ex[k]; }
#pragma unroll
            for (int k = 0; k < 4; ++k) { const int e = idx[k];
                const unsigned rank = __hip_atomic_fetch_add(F.ctl + CW_CNT + 64 * e, 1u, __ATOMIC_RELAXED, __HIP_MEMORY_SCOPE_AGENT);
                tok_of[e * 8192 + rank] = tok; gate_of[e * 8192 + rank] = ex[k] / sum; tok_e[tok * 4 + k] = e; tok_r[tok * 4 + k] = (int)rank; } }
        __syncthreads();
    }
}

DI void moe_tables(Frame& F) {
    if (F.tid == 0) { unsigned base = 0u;
        for (int e = 0; e < 32; ++e) { const unsigned c = F.ctl[CW_CNT + 64 * e], mt = (c + 255u) >> 8; F.MISC[16 + e] = c; F.MISC[48 + e] = base; F.MISC[80 + e] = mt; base += mt; }
        F.MISC[112] = base; }
    __syncthreads();
}
DI int ldsu(volatile LAS unsigned* p) { return __builtin_amdgcn_readfirstlane((int)*p); }
template <int NTN  >
struct SchedMoe {
    int G, c; const unsigned char* ws; volatile LAS unsigned* MISC;
    DI bool next(int i, pg8::UnitD& u) const {
        const int L = i * G + c; const int total = ldsu(MISC + 112) * NTN; if (L >= total) return false;
        int e = 0;
        for (int k = 0; k < 32; ++k) { if (L >= (ldsu(MISC + 48 + k) + ldsu(MISC + 80 + k)) * NTN) e = k + 1; }
        const int tb = ldsu(MISC + 48 + e), mte = ldsu(MISC + 80 + e), cnt = ldsu(MISC + 16 + e);
        const int local = L - tb * NTN, nt = local / mte, mt = local % mte;
        u.type = 0; u.e = e; u.pn = nt; u.pm = tb + mt; u.x0 = mt; u.lda = 4096u; u.ldb = 4096u;
        if (NTN == 16) { u.A = (const char*)(ws + WS_HN3); u.rows = (const int*)(ws + WS_TOKOF) + e * 8192 + mt * 256; u.nvalid = cnt - mt * 256;
            u.B = (const char*)(ws + WS_W1) + ((size_t)e * 4096 + (size_t)nt * 256) * 4096; }
        else { u.A = (const char*)(ws + WS_ACT) + (size_t)(tb + mt) * 256 * 4096; u.rows = nullptr; u.nvalid = cnt - mt * 256;
            u.B = (const char*)(ws + WS_W2) + ((size_t)e * 2048 + (size_t)nt * 256) * 4096; }
        return true;
    }
};
struct EpiMoe1 {
    static constexpr bool AFTER_DRAIN = false;
    bf16_t* act; const float* b1;
    DI void operator()(const f32x4 (&acc)[2][2][4][2], const pg8::UnitD& u, int wr, int wc, int fr, int fq) const {
        { int ln_ = threadIdx.x; asm volatile("" : "+v"(ln_)); fr = ln_ & 15; fq = (ln_ >> 4) & 3; }
        const int j0 = u.pn * 128 + wc * 32 + 8 * fq;
        const float* bg = b1 + (size_t)u.e * 4096 + j0; const float* bu = bg + 2048;
        const f32x4 bg0 = *(const f32x4*)bg, bg1 = *(const f32x4*)(bg + 4), bu0 = *(const f32x4*)bu, bu1 = *(const f32x4*)(bu + 4);
#pragma unroll
        for (int ai = 0; ai < 2; ++ai)
#pragma unroll
            for (int m = 0; m < 4; ++m) { const size_t row = (size_t)u.pm * 256 + ai * 128 + wr * 64 + m * 16 + fr;
                float o[8];
#pragma unroll
                for (int n = 0; n < 2; ++n)
#pragma unroll
                    for (int e = 0; e < 4; ++e) { const float g = fminf(acc[ai][0][m][n][e] + (n ? bg1[e] : bg0[e]), 7.f);
                        const float uu = fminf(fmaxf(acc[ai][1][m][n][e] + (n ? bu1[e] : bu0[e]), -7.f), 7.f);
                        o[n * 4 + e] = g / (1.f + __expf(-1.702f * g)) * (uu + 1.f); }
                u32x4 w; w.x = pk2(o[0], o[1]); w.y = pk2(o[2], o[3]); w.z = pk2(o[4], o[5]); w.w = pk2(o[6], o[7]);
                *(u32x4*)(act + row * 2048 + j0) = w; }
    }
};
struct EpiMoe2 {
    static constexpr bool AFTER_DRAIN = false;
    bf16_t* y; const float* b2; const float* gate_of;
    DI void operator()(const f32x4 (&acc)[2][2][4][2], const pg8::UnitD& u, int wr, int wc, int fr, int fq) const {
        { int ln_ = threadIdx.x; asm volatile("" : "+v"(ln_)); fr = ln_ & 15; fq = (ln_ >> 4) & 3; }
        const int col0 = u.pn * 256 + wc * 32 + 8 * fq;
        const float* bp = b2 + (size_t)u.e * 2048 + col0;
#pragma unroll
        for (int ai = 0; ai < 2; ++ai)
#pragma unroll
            for (int m = 0; m < 4; ++m) { const int rl = ai * 128 + wr * 64 + m * 16 + fr; const size_t row = (size_t)u.pm * 256 + rl;
                const float gt = (rl < u.nvalid) ? gate_of[u.e * 8192 + u.x0 * 256 + rl] : 0.f;
#pragma unroll
                for (int bj = 0; bj < 2; ++bj) { const f32x4 v0 = (acc[ai][bj][m][0] + *(const f32x4*)(bp + bj * 128)) * gt, v1 = (acc[ai][bj][m][1] + *(const f32x4*)(bp + bj * 128 + 4)) * gt;
                    u32x4 w; w.x = pk2(v0[0], v0[1]); w.y = pk2(v0[2], v0[3]); w.z = pk2(v1[0], v1[1]); w.w = pk2(v1[2], v1[3]);
                    *(u32x4*)(y + row * 2048 + col0 + bj * 128) = w; } }
    }
};

DI void p11_combine(Frame& F, const ArgP& a) {
    const int gw = F.vcu * NWAVES + F.wave, NGW = F.G * NWAVES, lane = F.lane;
    const float* h2 = (const float*)(F.ws + WS_H2); const bf16_t* y = (const bf16_t*)(F.ws + WS_Y);
    const int* tok_e = (const int*)(F.ws + WS_TOKE); const int* tok_r = (const int*)(F.ws + WS_TOKR);
    for (int t = gw; t < NTOK; t += NGW) {
        size_t yrow[4];
#pragma unroll
        for (int k = 0; k < 4; ++k) { const int e = tok_e[t * 4 + k], r = tok_r[t * 4 + k]; yrow[k] = ((size_t)F.MISC[48 + e] * 256 + (size_t)r) * 2048; }
#pragma unroll
        for (int j = 0; j < 8; ++j) { const int c = (lane + 64 * j) * 4;
            f32x4 v = *(const f32x4*)(h2 + (size_t)t * 2048 + c);
#pragma unroll
            for (int k = 0; k < 4; ++k) { const u32x2 w = *(const u32x2*)(y + yrow[k] + c); v.x += bflo(w.x); v.y += bfhi(w.x); v.z += bflo(w.y); v.w += bfhi(w.y); }
            *(f32x4*)(a.out() + (size_t)t * 2048 + c) = v; }
    }
}

#ifndef MK_PER_PHASE
#define MK_PER_PHASE 0
#endif
#ifndef MK_LAST_PHASE
#define MK_LAST_PHASE 12
#endif
constexpr int N_PHASES = MK_LAST_PHASE;

__global__ void __launch_bounds__(NWAVES * 64, 2) mega_fwd(Args args_) {
    const ArgP args{};
    extern __shared__ __attribute__((aligned(16))) unsigned char lds_raw[];
    Frame F;
    F.lds = (LAS unsigned char*)lds_raw;
    F.MISC = (volatile LAS unsigned*)(F.lds + MISC_OFF);
    F.tid = threadIdx.x; F.lane = F.tid & 63; F.wave = __builtin_amdgcn_readfirstlane(F.tid >> 6);
    F.G = gridDim.x; { const int bx = blockIdx.x; F.vcu = (F.G % 8 == 0) ? (bx % 8) * (F.G / 8) + bx / 8 : bx; }
    F.ws = args_.ws; F.ctl = (unsigned*)(args_.ws + WS_CTL);
    for (int u = F.tid; u < 256; u += NWAVES * 64) F.MISC[u] = 0u;
    __syncthreads();
    XcdBarrier bar; bar.bar = F.ctl + CW_BAR; bar.x = 0; bar.st = nullptr;
    const int lo = args_.ph_lo, hi = args_.ph_hi;
    if (hi - lo > 1) bar = xcd_barrier_post(F.ctl + CW_BAR, F.MISC + 8);
#ifndef MK_PHASE_MASK
#define MK_PHASE_MASK 0xFFFF
#endif
#define IN(k) (((MK_PHASE_MASK >> (k)) & 1) && lo <= (k) && (k) < hi)
#define SEAM(k) do { if (IN(k) && IN((k) + 1)) xcd_barrier(bar); } while (0)
#define FRESH() do { int t_ = threadIdx.x; asm volatile("" : "+v"(t_)); F.tid = t_; F.lane = t_ & 63; F.wave = __builtin_amdgcn_readfirstlane(t_ >> 6); } while (0)
    unsigned char* ws = args_.ws;

    if (IN(0)) { FRESH(); p0_prologue(F, args); }
    SEAM(0);
    if (IN(1)) { FRESH();
        SchedP1 S{F.G, F.vcu, ws};
        EpiP1 E{(bf16_t*)(ws + WS_PROJ), (float*)(ws + WS_DT), (bf16_t*)(ws + WS_KVRAW), args.in(I_DAQG), args.in(I_DAKG)};
        pg8::gemm_phase<EpiP1, SchedP1, false, true>(F.lds + RING_OFF, 32, S, E);
    }
    SEAM(1);
    if (IN(2)) { FRESH();
        kprep(F, args);
        for (int u = F.vcu; u < 64; u += F.G) ssd_unit(F, args, u >> 4, u & 15);
        __syncthreads();
        attn_phase_da(F);
    }
    SEAM(2);
    if (IN(3)) { FRESH(); p3_finalize(F, args); }
    SEAM(3);
    if (IN(4)) { FRESH();
        SchedDense S{F.G, F.vcu, 32, 8, (const char*)(ws + WS_YCAT), (const char*)(ws + WS_WOUT), 4096u, 4096u, 1 << 30, 0};
#if MK_LAST_PHASE == 5
        EpiResid E{args.in(I_X), args_.out, nullptr, nullptr};
#else
        EpiResid E{args.in(I_X), (float*)(ws + WS_H1), (bf16_t*)(ws + WS_H1B), (float*)(ws + WS_PART1)};
#endif
        pg8::gemm_phase<EpiResid, SchedDense, false, true>(F.lds + RING_OFF, 32, S, E);
    }
    SEAM(4);
    if (IN(5)) { FRESH();
        SchedDense S{F.G, F.vcu, 32, 8, (const char*)(ws + WS_H1B), (const char*)(ws + WS_WQ), 4096u, 4096u, 1 << 30, 0};
        EpiQ E{(bf16_t*)(ws + WS_QRAW), (float*)(ws + WS_PARTQ)};
        pg8::gemm_phase<EpiQ, SchedDense, false, true>(F.lds + RING_OFF, 32, S, E);
    }
    SEAM(5);
    if (IN(6)) { FRESH();
        SchedXS S{F.G, F.vcu, ws};
        EpiXS E{(bf16_t*)(ws + WS_P), (bf16_t*)(ws + WS_VWT), (const float*)(ws + WS_PART1), (const float*)(ws + WS_PARTQ), (LAS float*)(F.lds + RING_BYTES)};
        pg8::gemm_phase<EpiXS, SchedXS, false, true>(F.lds + RING_OFF, 8, S, E);
    }
    SEAM(6);
    if (IN(7)) { FRESH();
        SchedDense S{F.G, F.vcu, 32, 8, (const char*)(ws + WS_P), (const char*)(ws + WS_VWT), 2048u, 2048u, 8, (size_t)2048 * 1024 * 2};
#if MK_LAST_PHASE == 8
        EpiResid E{(const float*)(ws + WS_H1), args_.out, nullptr, nullptr};
#else
        EpiResid E{(const float*)(ws + WS_H1), (float*)(ws + WS_H2), nullptr, nullptr};
#endif
        pg8::gemm_phase<EpiResid, SchedDense, false, true>(F.lds + RING_OFF, 16, S, E);
    }
    SEAM(7);
    if (IN(8)) { FRESH(); p8_route(F, args); }
    SEAM(8);
    if (IN(9)) { FRESH();
        moe_tables(F);
        SchedMoe<16> S{F.G, F.vcu, ws, F.MISC};
        EpiMoe1 E{(bf16_t*)(ws + WS_ACT), args.in(I_B1)};
        pg8::gemm_phase<EpiMoe1, SchedMoe<16>, true, true>(F.lds + RING_OFF, 32, S, E);
    }
    SEAM(9);
    if (IN(10)) { FRESH();
        moe_tables(F);
        SchedMoe<8> S{F.G, F.vcu, ws, F.MISC};
        EpiMoe2 E{(bf16_t*)(ws + WS_Y), args.in(I_B2), (const float*)(ws + WS_GATEOF)};
        pg8::gemm_phase<EpiMoe2, SchedMoe<8>, false, true>(F.lds + RING_OFF, 32, S, E);
    }
    SEAM(10);
    if (IN(11)) { FRESH(); moe_tables(F); p11_combine(F, args); }
#undef IN
#undef SEAM
}

extern "C" void kernel_launch(void* const* d_in, const int* in_sizes, int n_in, void* d_out, int out_size, void* d_ws, size_t ws_size, hipStream_t stream) {
    static int grid = 0;
    if (grid == 0) {
        if (n_in != 32 || out_size != NTOK * 2048 || ws_size < WS_END) { fprintf(stderr, "kernel_launch: unexpected shapes (n_in %d out %d ws %zu); nothing launched\n", n_in, out_size, ws_size); grid = -1; return; }
        int dev = 0, cus = 0, per_cu = 0;
        if (hipGetDevice(&dev) != hipSuccess || hipDeviceGetAttribute(&cus, hipDeviceAttributeMultiprocessorCount, dev) != hipSuccess) { grid = -1; return; }
        if (hipFuncSetAttribute((const void*)mega_fwd, hipFuncAttributeMaxDynamicSharedMemorySize, LDS_BYTES) != hipSuccess) { fprintf(stderr, "kernel_launch: hipFuncSetAttribute failed\n"); grid = -1; return; }
        if (hipOccupancyMaxActiveBlocksPerMultiprocessor(&per_cu, (const void*)mega_fwd, NWAVES * 64, LDS_BYTES) != hipSuccess || per_cu < 1) { fprintf(stderr, "kernel_launch: occupancy query says %d\n", per_cu); }
        (void)hipGetLastError();
        if (cus < 256) { fprintf(stderr, "kernel_launch: needs 256 CUs, found %d; nothing launched\n", cus); grid = -1; return; }
        grid = 256;
    }
    if (grid < 0) return;
    if (hipMemsetAsync((char*)d_ws + WS_CTL, 0, CTL_ZERO_BYTES, stream) != hipSuccess) return;
    Args a{};
    for (int i = 0; i < 32; ++i) a.in[i] = (const float*)d_in[i];
    a.out = (float*)d_out; a.ws = (unsigned char*)d_ws;
#if MK_PER_PHASE
    for (int p = 0; p < N_PHASES; ++p) { a.ph_lo = p; a.ph_hi = p + 1; hipLaunchKernelGGL(mega_fwd, dim3(grid), dim3(NWAVES * 64), LDS_BYTES, stream, a); }
#else
    a.ph_lo = 0; a.ph_hi = N_PHASES;
    hipLaunchKernelGGL(mega_fwd, dim3(grid), dim3(NWAVES * 64), LDS_BYTES, stream, a);
#endif
}
```

```cpp
#define MK_PER_PHASE 0
#define MK_LAST_PHASE 12
#include <hip/hip_runtime.h>
#include <hip/hip_bf16.h>
#include <cstdio>
#include <cstdint>
#include <cmath>

#define GAS __attribute__((address_space(1)))
#define LAS __attribute__((address_space(3)))
typedef unsigned short bf16_t;
typedef short bf16x8 __attribute__((ext_vector_type(8)));
typedef float f32x2 __attribute__((ext_vector_type(2)));
typedef float f32x4 __attribute__((ext_vector_type(4)));
typedef float f32x16 __attribute__((ext_vector_type(16)));
typedef unsigned u32x2 __attribute__((ext_vector_type(2)));
typedef unsigned u32x4 __attribute__((ext_vector_type(4)));
typedef __bf16 bf16x2_t __attribute__((ext_vector_type(2)));

#define DI __device__ __forceinline__
DI unsigned pk2(float lo, float hi) { f32x2 v = {lo, hi}; bf16x2_t b = __builtin_convertvector(v, bf16x2_t); return __builtin_bit_cast(unsigned, b); }
DI float bflo(unsigned u) { return __uint_as_float(u << 16); }
DI float bfhi(unsigned u) { return __uint_as_float(u & 0xffff0000u); }
DI float bf2f(bf16_t h) { return __uint_as_float(((unsigned)h) << 16); }
DI float wave_sum(float v) {
#pragma unroll
    for (int o = 1; o < 64; o <<= 1) v += __shfl_xor(v, o);
    return v;
}
DI float siluf(float x) { return x / (1.f + __expf(-x)); }

constexpr int DM_ = 2048, NB = 4, SEQ_ = 2048, NTOK = NB * SEQ_;
constexpr int PP = 5632;
constexpr int PC_XBC = 1024, PC_Q = 2560, PC_K = 3584, PC_V = 4608, PC_DT = 5632;
constexpr int WIN_ROWS = 5888;
constexpr int NEXP = 32, MEMLEN = 256;
constexpr float EPS_ = 1e-6f;
constexpr float LAM_INIT = 0.2f;

namespace pg8 {
constexpr int BM = 256, BK = 64, HALF = 128, HTB = HALF * BK * 2  , STAGE_BYTES = 8 * HTB;
DI int lds_byte(int r, int c) { const int st = (r >> 4) * 2 + (c >> 5), rr = r & 15, cc = c & 31, ob = rr * 64 + cc * 2; return st * 1024 + (ob ^ (((ob >> 9) & 1) << 5)); }
DI void stage_rc(int b, int& R, int& C) { const int st = b / 1024, sb = b % 1024, swz = sb ^ (((sb >> 9) & 1) << 5); R = (st >> 1) * 16 + swz / 64; C = (st & 1) * 32 + (swz % 64) / 2; }
DI int perm32(int rho) { const int n = rho >> 4, i = rho & 15; return 8 * (i >> 2) + 4 * n + (i & 3); }

struct UnitD {
    const char* A; const char* B;
    const int* rows;
    unsigned lda, ldb;
    int nvalid;
    int type, pm, pn, e, x0;
};
DI void dense_voff(unsigned lda, unsigned ldb, int tid, unsigned (&vA)[2], unsigned (&vB)[2]) {
#pragma unroll
    for (int i = 0; i < 2; ++i) { int R, C; stage_rc(tid * 16 + i * 8192, R, C); const int Rb = (R & ~31) + perm32(R & 31);
        vA[i] = (unsigned)R * lda + (unsigned)C * 2u; vB[i] = (unsigned)Rb * ldb + (unsigned)C * 2u; }
}
DI void gather_voff(const UnitD& u, int tid, unsigned (&gA)[2][2]) {
#pragma unroll
    for (int i = 0; i < 2; ++i) { int R, C; stage_rc(tid * 16 + i * 8192, R, C);
#pragma unroll
        for (int h = 0; h < 2; ++h) { const int ra = h * 128 + R; const unsigned rowA = (ra < u.nvalid) ? (unsigned)u.rows[ra] : 0u; gA[h][i] = rowA * u.lda + (unsigned)C * 2u; } }
}

template <class Epi, class Sched, bool GATHER, bool ALIGN_EPI>
DI void gemm_phase(LAS unsigned char* lds, int nt, const Sched& S, const Epi& E) {

    const int tid = threadIdx.x, wid = __builtin_amdgcn_readfirstlane(tid >> 6), lane = tid & 63, wr = wid >> 2, wc = wid & 3, fr = lane & 15, fq = lane >> 4;
    const size_t kstep = (size_t)(BK * 2);
    const unsigned ldsb = (unsigned)__builtin_amdgcn_readfirstlane((int)((unsigned)(uintptr_t)lds + (unsigned)wid * 1024u));
    const int aoff = lds_byte(wr * 64 + fr, fq * 8), boff = lds_byte(wc * 32 + fr, fq * 8);
#define PG8_SA(b, h) (((b) * 2 + (h)) * HTB)
#define PG8_SB(b, h) ((4 + (b) * 2 + (h)) * HTB)
#define PG8_STAGE(bufoff, gbase, voff) do { _Pragma("unroll") for (int _i = 0; _i < 2; ++_i) { unsigned keep_; \
        asm volatile("s_mov_b32 %0, m0\n\ts_mov_b32 m0, %3\n\ts_nop 0\n\tglobal_load_lds_dwordx4 %1, %2\n\ts_mov_b32 m0, %0" \
                     : "=&s"(keep_) : "v"((voff)[_i]), "s"((const char*)(gbase)), "s"(ldsb + (unsigned)((bufoff) + _i * 8192)) : "memory"); } } while (0)
#define PG8_STA(bufoff, gbase, h, HS, GA) do { if constexpr (GATHER) { PG8_STAGE(bufoff, gbase, GA[h]); } else { PG8_STAGE(bufoff, (gbase) + (h) * (HS), vA); } } while (0)
#define PG8_STB(bufoff, gbase, h, HS) PG8_STAGE(bufoff, (gbase) + (h) * (HS), vB)
#define PG8_LDA(dst, b, h) do { _Pragma("unroll") for (int m = 0; m < 4; ++m) _Pragma("unroll") for (int k = 0; k < 2; ++k) dst[m][k] = *(const LAS bf16x8*)(lds + PG8_SA(b, h) + aoff + m * 2048 + k * 1024); } while (0)
#define PG8_LDB(dst, b, h) do { _Pragma("unroll") for (int n = 0; n < 2; ++n) _Pragma("unroll") for (int k = 0; k < 2; ++k) dst[n][k] = *(const LAS bf16x8*)(lds + PG8_SB(b, h) + boff + n * 2048 + k * 1024); } while (0)
#define PG8_MMA(ai, bj, At, Bt) do { __builtin_amdgcn_s_setprio(1); _Pragma("unroll") for (int m = 0; m < 4; ++m) _Pragma("unroll") for (int n = 0; n < 2; ++n) _Pragma("unroll") for (int k = 0; k < 2; ++k) \
        acc[ai][bj][m][n] = __builtin_amdgcn_mfma_f32_16x16x32_bf16(Bt[n][k], At[m][k], acc[ai][bj][m][n], 0, 0, 0); __builtin_amdgcn_s_setprio(0); } while (0)
#define PG8_WAIT_V(n) asm volatile("s_waitcnt vmcnt(" #n ")" ::: "memory")
#define PG8_WAIT_L(n) asm volatile("s_waitcnt lgkmcnt(" #n ")" ::: "memory")
#define PG8_BAR __builtin_amdgcn_s_barrier()
#define PG8_SCHED __builtin_amdgcn_sched_barrier(0)
#define PG8_ITER(A1P, A2P, B2P, HA2, HB2, GA2) do { \
        const char* a3p_ = (A2P) + kstep; const char* b3p_ = (B2P) + kstep; \
        PG8_LDB(B0, 0, 0); PG8_LDB(B1, 0, 1); PG8_SCHED; PG8_LDA(At, 0, 0); PG8_STA(PG8_SA(1, 1), (A1P), 1, hsA, gA); \
        PG8_WAIT_V(8); PG8_WAIT_L(0); PG8_BAR; PG8_MMA(0, 0, At, B0); PG8_MMA(0, 1, At, B1); PG8_BAR; PG8_SCHED; \
        PG8_LDA(At, 0, 1); PG8_STB(PG8_SB(0, 0), (B2P), 0, HB2); PG8_STB(PG8_SB(0, 1), (B2P), 1, HB2); PG8_STA(PG8_SA(0, 0), (A2P), 0, HA2, GA2); \
        PG8_WAIT_V(8); PG8_WAIT_L(0); PG8_BAR; PG8_MMA(1, 0, At, B0); PG8_MMA(1, 1, At, B1); PG8_BAR; PG8_SCHED; \
        PG8_LDB(B0, 1, 0); PG8_LDB(B1, 1, 1); PG8_SCHED; PG8_LDA(At, 1, 0); PG8_STA(PG8_SA(0, 1), (A2P), 1, HA2, GA2); \
        PG8_WAIT_V(8); PG8_WAIT_L(0); PG8_BAR; PG8_MMA(0, 0, At, B0); PG8_MMA(0, 1, At, B1); PG8_BAR; PG8_SCHED; \
        PG8_LDA(At, 1, 1); PG8_STB(PG8_SB(1, 0), b3p_, 0, HB2); PG8_STB(PG8_SB(1, 1), b3p_, 1, HB2); PG8_STA(PG8_SA(1, 0), a3p_, 0, HA2, GA2); \
        PG8_WAIT_V(8); PG8_WAIT_L(0); PG8_BAR; PG8_MMA(1, 0, At, B0); PG8_MMA(1, 1, At, B1); PG8_BAR; PG8_SCHED; \
    } while (0)
    UnitD cur, nxt; int ui = 0;
    if (!S.next(0, cur)) return;
    f32x4 acc[2][2][4][2];
#pragma unroll
    for (int a = 0; a < 2; ++a)
#pragma unroll
        for (int b = 0; b < 2; ++b)
#pragma unroll
            for (int m = 0; m < 4; ++m)
#pragma unroll
                for (int n = 0; n < 2; ++n) acc[a][b][m][n] = (f32x4){0.f, 0.f, 0.f, 0.f};
    bf16x8 At[4][2], B0[2][2], B1[2][2];
    unsigned vA[2], vB[2], gA[2][2], ngA[2][2];
    dense_voff(cur.lda, cur.ldb, tid, vA, vB);
    if constexpr (GATHER) gather_voff(cur, tid, gA);
    const char* cA = cur.A; const char* cB = cur.B;
    size_t hsA = GATHER ? 0 : (size_t)cur.lda * HALF, hsB = (size_t)cur.ldb * HALF;
    PG8_STB(PG8_SB(0, 0), cB, 0, hsB); PG8_STB(PG8_SB(0, 1), cB, 1, hsB); PG8_STA(PG8_SA(0, 0), cA, 0, hsA, gA); PG8_STA(PG8_SA(0, 1), cA, 1, hsA, gA);
    if (wr == 1) PG8_BAR;
    PG8_WAIT_V(2); PG8_BAR;
    PG8_STB(PG8_SB(1, 0), cB + kstep, 0, hsB); PG8_STA(PG8_SA(1, 0), cA + kstep, 0, hsA, gA); PG8_STB(PG8_SB(1, 1), cB + kstep, 1, hsB);
    PG8_WAIT_V(6); PG8_BAR;
    for (;;) {
        const bool has_next = S.next(ui + 1, nxt);
        const char* nA = cA; const char* nB = cB; size_t nhsA = hsA, nhsB = hsB;
        if (has_next) { nA = nxt.A; nB = nxt.B; nhsA = GATHER ? 0 : (size_t)nxt.lda * HALF; nhsB = (size_t)nxt.ldb * HALF; }
        if constexpr (GATHER) {
            if (has_next) gather_voff(nxt, tid, ngA);
            else {
#pragma unroll
                for (int h = 0; h < 2; ++h)
#pragma unroll
                    for (int i = 0; i < 2; ++i) ngA[h][i] = gA[h][i];
            }
        }
        for (int t = 0; t < nt - 2; t += 2)
            PG8_ITER(cA + (size_t)(t + 1) * kstep, cA + (size_t)(t + 2) * kstep, cB + (size_t)(t + 2) * kstep, hsA, hsB, gA);
        PG8_ITER(cA + (size_t)(nt - 1) * kstep, nA, nB, nhsA, nhsB, ngA);
        if constexpr (ALIGN_EPI) { if (wr == 0) PG8_BAR; }
        if constexpr (!Epi::AFTER_DRAIN) { E(acc, cur, wr, wc, fr, fq); }
        if (!has_next) break;
#pragma unroll
        for (int a = 0; a < 2; ++a)
#pragma unroll
            for (int b = 0; b < 2; ++b)
#pragma unroll
                for (int m = 0; m < 4; ++m)
#pragma unroll
                    for (int n = 0; n < 2; ++n) acc[a][b][m][n] = (f32x4){0.f, 0.f, 0.f, 0.f};
        cur = nxt; cA = nA; cB = nB; hsA = nhsA; hsB = nhsB; ++ui;
        if constexpr (GATHER) {
#pragma unroll
            for (int h = 0; h < 2; ++h)
#pragma unroll
                for (int i = 0; i < 2; ++i) gA[h][i] = ngA[h][i];
        }
        if constexpr (ALIGN_EPI) { if (wr == 1) PG8_BAR; }
    }
    PG8_WAIT_V(0);
    if constexpr (!ALIGN_EPI) { if (wr == 0) PG8_BAR; }
    PG8_BAR;
    if constexpr (Epi::AFTER_DRAIN) { E.fused(acc, cur, wr, wc, fr, fq, lds, wid, lane); }
#undef PG8_SA
#undef PG8_SB
#undef PG8_STAGE
#undef PG8_STA
#undef PG8_STB
#undef PG8_LDA
#undef PG8_LDB
#undef PG8_MMA
#undef PG8_WAIT_V
#undef PG8_WAIT_L
#undef PG8_BAR
#undef PG8_SCHED
#undef PG8_ITER
}
}
namespace attn_body {
using bf16=__hip_bfloat16;
using bf16x8=__attribute__((ext_vector_type(8)))short;
using s16x4=__attribute__((ext_vector_type(4)))short;
using f32x16=__attribute__((ext_vector_type(16)))float;
using u32x4=__attribute__((ext_vector_type(4)))unsigned;
constexpr int BATCH=4,SEQ=2048,D=64,DM=5632,OPITCH=1024;
constexpr int NW=8,QBLK=32,QB=QBLK*NW,KVBLK=64,NQB=SEQ/QB;
constexpr int ATTN_UNIT_ROWS=QB;
__device__ __forceinline__ int crow(int r,int hi){return (r&3)+8*(r>>2)+4*hi;}
#define SBAR() __builtin_amdgcn_sched_barrier(0)
__device__ __forceinline__ void cmask(f32x16&p0,f32x16&p1,int jb,int qrel,int hi){
  const float NEG=-INFINITY; int kb=64*jb+4*hi;
  #pragma unroll
  for(int r=0;r<16;++r){int kv=kb+(r&3)+8*(r>>2); if(kv>qrel)p0[r]=NEG; if(kv+32>qrel)p1[r]=NEG;}
}

constexpr int NSLOT=3, SLOTB=8192;
constexpr int LDS_K=0, LDS_V=NSLOT*SLOTB, LDS_WS=2*NSLOT*SLOTB, LDS_OST=LDS_WS+NW*64*4, LDS_BYTES=LDS_OST+NW*4096;
constexpr float C2=0.125f*1.4426950408889634f;
__device__ __forceinline__ void glds16(const void*gsrc,unsigned lds_dst){unsigned keep;
  asm volatile("s_mov_b32 %0, m0\n\ts_mov_b32 m0, %2\n\ts_nop 0\n\tglobal_load_lds_dwordx4 %1, off\n\ts_mov_b32 m0, %0":"=&s"(keep):"v"(gsrc),"s"(lds_dst):"memory");}
__device__ __forceinline__ float max3f(float a,float b,float c){float r;asm("v_max3_f32 %0, %1, %2, %3":"=v"(r):"v"(a),"v"(b),"v"(c));return r;}
__device__ __forceinline__ float max2f(float a,float b){float r;asm("v_max_f32_e32 %0, %1, %2":"=v"(r):"v"(a),"v"(b));return r;}
__device__ __forceinline__ float fadd_s(float a,float b){float r;asm("v_add_f32_e32 %0, %1, %2":"=v"(r):"v"(a),"v"(b));return r;}
__device__ __forceinline__ float fsub_s(float a,float b){float r;asm("v_sub_f32_e32 %0, %1, %2":"=v"(r):"v"(a),"v"(b));return r;}
typedef float f32x2_t __attribute__((ext_vector_type(2))); typedef __bf16 bf16x2_t __attribute__((ext_vector_type(2)));
__device__ __forceinline__ unsigned cvtpk_s(float lo,float hi){f32x2_t v={lo,hi};bf16x2_t b=__builtin_convertvector(v,bf16x2_t);return __builtin_bit_cast(unsigned,b);}
#define WAIT_BAR(N) asm volatile("s_waitcnt vmcnt(" #N ") lgkmcnt(0)\n\ts_barrier":::"memory")

__device__ __forceinline__ void qkt(f32x16&p0,f32x16&p1,const char*Kslot,const bf16x8*qr,const f32x16&negm,int r32,int hi){
  const char*kb=Kslot+hi*1024+r32*16;
  #pragma unroll
  for(int d0=0;d0<4;++d0){
    const bf16x8 b0=*reinterpret_cast<const bf16x8*>(kb+d0*2048);
    const bf16x8 b1=*reinterpret_cast<const bf16x8*>(kb+d0*2048+512);
    if(d0==0){p0=__builtin_amdgcn_mfma_f32_32x32x16_bf16(b0,qr[0],negm,0,0,0);p1=__builtin_amdgcn_mfma_f32_32x32x16_bf16(b1,qr[0],negm,0,0,0);}
    else{p0=__builtin_amdgcn_mfma_f32_32x32x16_bf16(b0,qr[d0],p0,0,0,0);p1=__builtin_amdgcn_mfma_f32_32x32x16_bf16(b1,qr[d0],p1,0,0,0);}}
}
typedef __attribute__((address_space(3))) const char* lds_cptr;
typedef short v4i16_t __attribute__((ext_vector_type(4)));
__device__ __forceinline__ void kload8(bf16x8*kf,lds_cptr kp){
  kf[0]=*(const __attribute__((address_space(3))) bf16x8*)(kp);      kf[1]=*(const __attribute__((address_space(3))) bf16x8*)(kp+512);
  kf[2]=*(const __attribute__((address_space(3))) bf16x8*)(kp+2048); kf[3]=*(const __attribute__((address_space(3))) bf16x8*)(kp+2560);
  kf[4]=*(const __attribute__((address_space(3))) bf16x8*)(kp+4096); kf[5]=*(const __attribute__((address_space(3))) bf16x8*)(kp+4608);
  kf[6]=*(const __attribute__((address_space(3))) bf16x8*)(kp+6144); kf[7]=*(const __attribute__((address_space(3))) bf16x8*)(kp+6656);
}
__device__ __forceinline__ void kload2(bf16x8*kf,lds_cptr kp,int j){ kf[2*j]=*(const __attribute__((address_space(3))) bf16x8*)(kp+j*2048); kf[2*j+1]=*(const __attribute__((address_space(3))) bf16x8*)(kp+j*2048+512); }
__device__ __forceinline__ s16x4 vtr(lds_cptr p){ return __builtin_bit_cast(s16x4,__builtin_amdgcn_ds_read_tr16_b64_v4i16((__attribute__((address_space(3))) v4i16_t*)p)); }
__device__ __forceinline__ float rowmax(const f32x16&p0,const f32x16&p1){
  float a=max3f(p0[0],p0[1],p1[0]),b=max3f(p0[2],p0[3],p1[1]);a=max3f(a,p1[2],p1[3]);
  #pragma unroll
  for(int r=4;r<16;r+=4){a=max3f(a,p0[r],p0[r+1]);b=max3f(b,p0[r+2],p0[r+3]);a=max3f(a,p1[r],p1[r+1]);b=max3f(b,p1[r+2],p1[r+3]);}
  const float m=max2f(a,b);
  auto rr=__builtin_amdgcn_permlane32_swap(__float_as_uint(m),__float_as_uint(m),false,false);
  return max2f(__uint_as_float(rr[0]),__uint_as_float(rr[1]));
}
__device__ __forceinline__ void pv(f32x16*o,int vb,bf16x8 pa0,bf16x8 pa1,bf16x8 pa2,bf16x8 pa3){
  #pragma unroll
  for(int d0=0;d0<2;++d0){s16x4 lo[4],hi[4];
    #pragma unroll
    for(int ks=0;ks<4;++ks){
      asm volatile("ds_read_b64_tr_b16 %0,%1 offset:%c2":"=&v"(lo[ks]):"v"(vb),"i"(d0*4096+ks*1024):"memory");
      asm volatile("ds_read_b64_tr_b16 %0,%1 offset:%c2":"=&v"(hi[ks]):"v"(vb),"i"(d0*4096+ks*1024+512):"memory");}
    asm volatile("s_waitcnt lgkmcnt(0)":::"memory");SBAR();
    #define PK(k) (bf16x8){lo[k][0],lo[k][1],lo[k][2],lo[k][3],hi[k][0],hi[k][1],hi[k][2],hi[k][3]}
    o[d0]=__builtin_amdgcn_mfma_f32_32x32x16_bf16(pa0,PK(0),o[d0],0,0,0);
    o[d0]=__builtin_amdgcn_mfma_f32_32x32x16_bf16(pa1,PK(1),o[d0],0,0,0);
    o[d0]=__builtin_amdgcn_mfma_f32_32x32x16_bf16(pa2,PK(2),o[d0],0,0,0);
    o[d0]=__builtin_amdgcn_mfma_f32_32x32x16_bf16(pa3,PK(3),o[d0],0,0,0);
    #undef PK
  }
}

#ifndef ATTN_STORE16
#define ATTN_STORE16(p,v) (*(u32x4*)(p)=(v))
#endif
template<int THRL> __device__ __forceinline__ void attn_unit(int b,int qcol,int vcol,int ocol,int qb,const bf16*Q,const bf16*__restrict__ K,const bf16*__restrict__ V,bf16*O,char*shm){
  const int tid=threadIdx.x,lane=tid&63,r32=lane&31,hi=lane>>5; const int wid=__builtin_amdgcn_readfirstlane(tid>>6);
  const long rowbase=(long)b*SEQ; const int q0=qb*QB;
  const bf16*Qw=Q+(rowbase+q0+wid*QBLK)*DM+qcol;
  const bf16*Kh=K+rowbase*DM+qcol,*Vh=V+rowbase*DM+vcol;
  const unsigned lds0=(unsigned)(uintptr_t)shm;
  float*wsf=(float*)(shm+LDS_WS)+wid*64;
  const bf16*ksrc=Kh+(long)lane*DM+wid*8;
  const bf16*vsrc=Vh+(long)(16*(wid&3)+(lane>>2))*DM+(wid>>2)*32+(lane&3)*8;
  const unsigned kdst=lds0+LDS_K+wid*1024, vdst=lds0+LDS_V+wid*1024;
  #define DMA_K(t,slot) glds16(ksrc+(long)(t)*KVBLK*DM,(unsigned)__builtin_amdgcn_readfirstlane(kdst+(slot)))
  #define DMA_V(t,slot) glds16(vsrc+(long)(t)*KVBLK*DM,(unsigned)__builtin_amdgcn_readfirstlane(vdst+(slot)))
  const int vb0=(int)(lds0+LDS_V)+((lane>>4)&1)*32+(lane&3)*8+(4*hi+((lane&15)>>2))*64;
  const char*Kbase=shm+LDS_K; bf16x8 kf[8];
  const lds_cptr shm3=(lds_cptr)shm; const lds_cptr kp0=shm3+LDS_K+hi*1024+r32*16; const lds_cptr vp0=shm3+LDS_V+((lane>>4)&1)*32+(lane&3)*8+(4*hi+((lane&15)>>2))*64;
  const int NT=(q0+QB)/KVBLK;
  DMA_K(0,0);DMA_V(0,0);DMA_K(1,SLOTB);
  bf16x8 qr[4];
  #pragma unroll
  for(int d0=0;d0<4;++d0)qr[d0]=*reinterpret_cast<const bf16x8*>(&Qw[(long)r32*DM+d0*16+hi*8]);
  float mhat=0.f,l_reg=0.f;f32x16 o[2];o[0]=f32x16{};o[1]=f32x16{};f32x16 negm=f32x16{};asm volatile("":"+v"(negm));
  const int qrel=wid*QBLK+r32;
  #define CMASK(P0,P1,t) do{int jb_=(t)-(NT-4); if(jb_>=0)cmask(P0,P1,jb_,qrel,hi);}while(0)
  bool resc=false;
  #define START(P0,P1) do{ const float rm=rowmax(P0,P1); resc=false; \
    { const float dl=rm; mhat=fadd_s(mhat,dl); \
      _Pragma("unroll") for(int r=0;r<16;++r){P0[r]=fsub_s(P0[r],dl);P1[r]=fsub_s(P1[r],dl);} \
      _Pragma("unroll") for(int r=0;r<16;++r)negm[r]=-mhat; asm volatile("":"+v"(negm)); } \
    _Pragma("unroll") for(int r=0;r<16;++r)P0[r]=__builtin_amdgcn_exp2f(P0[r]); }while(0)
  #define RESC() do{ if(resc){ asm volatile("s_waitcnt lgkmcnt(0)":::"memory"); \
      _Pragma("unroll") for(int d_=0;d_<2;++d_) _Pragma("unroll") for(int r=0;r<16;++r)o[d_][r]*=wsf[crow(r,hi)]; } }while(0)
  f32x16 pA0,pA1,pB0,pB1;
  int sl_prev=0,sl_cur=0,sl_next=SLOTB;
  #define ROT() do{sl_prev=sl_cur;sl_cur=sl_next;sl_next=(sl_next==(NSLOT-1)*SLOTB)?0:sl_next+SLOTB;}while(0)
  DMA_K(2,2*SLOTB);
  WAIT_BAR(3);
  qkt(pA0,pA1,Kbase,qr,negm,r32,hi);asm volatile("s_nop 15\n\ts_nop 7":"+v"(pA0),"+v"(pA1));CMASK(pA0,pA1,0);
  START(pA0,pA1);
  _Pragma("unroll") for(int r=0;r<16;++r)pA1[r]=__builtin_amdgcn_exp2f(pA1[r]);
  WAIT_BAR(0);
  DMA_K(3,0);DMA_V(1,SLOTB);
  ROT();
  kload8(kf,kp0+sl_cur);
  WAIT_BAR(2);
  s16x4 vlo[8],vhi[8]; u32x4 pw0,pw1,pw2,pw3;
  #define PKW(P,B) cvtpk_s(P[B],P[B+1])
  #define PAF(k) __builtin_bit_cast(bf16x8,pw##k)
  #define VFR(i) (bf16x8){vlo[i][0],vlo[i][1],vlo[i][2],vlo[i][3],vhi[i][0],vhi[i][1],vhi[i][2],vhi[i][3]}
  #define PIN(x) asm volatile("":"+v"(x))
  #define MX3(a,b,c) __builtin_fmaxf(__builtin_fmaxf((a),(b)),(c))
  #define GAPA(MF,A0,A1,A2,A3,W0,W1,PW) do{ MF; sacc+=A0; sacc+=A1; sacc+=A2; sacc+=A3; PIN(sacc); W0; W1; PIN(PW); SBAR(); }while(0)
  #define EX(v) __builtin_amdgcn_exp2f(v)
  #define GAPB(MF,X,B) do{ MF; X[B]=EX(X[B]); X[B+1]=EX(X[B+1]); X[B+2]=EX(X[B+2]); X[B+3]=EX(X[B+3]); PIN(X); SBAR(); }while(0)
  #define VRD(i) do{ vlo[i]=vtr(vp_+(((i)>>2)*4096+((i)&3)*1024)); vhi[i]=vtr(vp_+(((i)>>2)*4096+((i)&3)*1024+512)); }while(0)
  #define KRD(G,j) do{ if(G){ kload2(kf,kp0+sl_next,j); SBAR(); } }while(0)
  #define STEP(C0,C1,P0,P1,t,GK,GV,GL) do{ SBAR(); \
    const lds_cptr vp_=vp0+sl_prev; \
    VRD(0); SBAR(); float sacc=(P0[0]+P0[1]); \
    GAPA(C0=__builtin_amdgcn_mfma_f32_32x32x16_bf16(kf[0],qr[0],negm,0,0,0), P0[2],P0[3],P0[4],P0[5],     pw0[0]=PKW(P0,0), pw0[1]=PKW(P0,2), pw0); \
    VRD(4); SBAR(); GAPA(C1=__builtin_amdgcn_mfma_f32_32x32x16_bf16(kf[1],qr[0],negm,0,0,0), P0[6],P0[7],P0[8],P0[9],     pw0[2]=PKW(P0,4), pw0[3]=PKW(P0,6), pw0); \
    VRD(1); SBAR(); GAPA(C0=__builtin_amdgcn_mfma_f32_32x32x16_bf16(kf[2],qr[1],C0,0,0,0),   P0[10],P0[11],P0[12],P0[13], pw1[0]=PKW(P0,8), pw1[1]=PKW(P0,10), pw1); \
    VRD(5); SBAR(); GAPA(C1=__builtin_amdgcn_mfma_f32_32x32x16_bf16(kf[3],qr[1],C1,0,0,0),   P0[14],P0[15],P1[0],P1[1],   pw1[2]=PKW(P0,12),pw1[3]=PKW(P0,14), pw1); \
    VRD(2); SBAR(); GAPA(C0=__builtin_amdgcn_mfma_f32_32x32x16_bf16(kf[4],qr[2],C0,0,0,0),   P1[2],P1[3],P1[4],P1[5],     pw2[0]=PKW(P1,0), pw2[1]=PKW(P1,2), pw2); \
    VRD(6); SBAR(); GAPA(C1=__builtin_amdgcn_mfma_f32_32x32x16_bf16(kf[5],qr[2],C1,0,0,0),   P1[6],P1[7],P1[8],P1[9],     pw2[2]=PKW(P1,4), pw2[3]=PKW(P1,6), pw2); \
    VRD(3); SBAR(); GAPA(C0=__builtin_amdgcn_mfma_f32_32x32x16_bf16(kf[6],qr[3],C0,0,0,0),   P1[10],P1[11],P1[12],P1[13], pw3[0]=PKW(P1,8), pw3[1]=PKW(P1,10), pw3); \
    VRD(7); SBAR(); GAPA(C1=__builtin_amdgcn_mfma_f32_32x32x16_bf16(kf[7],qr[3],C1,0,0,0),   P1[14],P1[15],0.f,0.f,       pw3[2]=PKW(P1,12),pw3[3]=PKW(P1,14), pw3); \
    l_reg+=sacc; \
    if(GK){DMA_K((t)+3,sl_cur);} if(GV){DMA_V((t)+1,sl_next);} \
    CMASK(C0,C1,t); \
    { float a=MX3(C0[0],C0[1],C1[0]),b=MX3(C0[2],C0[3],C1[1]); a=MX3(a,C1[2],C1[3]); \
      _Pragma("unroll") for(int r=4;r<16;r+=4){a=MX3(a,C0[r],C0[r+1]);b=MX3(b,C0[r+2],C0[r+3]);a=MX3(a,C1[r],C1[r+1]);b=MX3(b,C1[r+2],C1[r+3]);} \
      float rm=__builtin_fmaxf(a,b); { auto rr=__builtin_amdgcn_permlane32_swap(__float_as_uint(rm),__float_as_uint(rm),false,false); rm=__builtin_fmaxf(__uint_as_float(rr[0]),__uint_as_float(rr[1])); } \
      resc=false; \
      if(__builtin_expect(__any(rm>(float)THRL),0)){ const float dl=__builtin_fmaxf(rm,0.f); mhat+=dl; \
        _Pragma("unroll") for(int r=0;r<16;++r){C0[r]-=dl;C1[r]-=dl;} \
        _Pragma("unroll") for(int r=0;r<16;++r)negm[r]=-mhat; asm volatile("":"+v"(negm)); \
        const float f=__builtin_amdgcn_exp2f(-dl); l_reg*=f; if(hi==0)wsf[r32]=f; resc=true; } } \
    SBAR(); \
    GAPB(o[0]=__builtin_amdgcn_mfma_f32_32x32x16_bf16(PAF(0),VFR(0),o[0],0,0,0), C0,0); \
    GAPB(o[1]=__builtin_amdgcn_mfma_f32_32x32x16_bf16(PAF(0),VFR(4),o[1],0,0,0), C0,4); \
    KRD(GL,0); GAPB(o[0]=__builtin_amdgcn_mfma_f32_32x32x16_bf16(PAF(1),VFR(1),o[0],0,0,0), C0,8); \
    KRD(GL,1); GAPB(o[1]=__builtin_amdgcn_mfma_f32_32x32x16_bf16(PAF(1),VFR(5),o[1],0,0,0), C0,12); \
    KRD(GL,2); GAPB(o[0]=__builtin_amdgcn_mfma_f32_32x32x16_bf16(PAF(2),VFR(2),o[0],0,0,0), C1,0); \
    KRD(GL,3); GAPB(o[1]=__builtin_amdgcn_mfma_f32_32x32x16_bf16(PAF(2),VFR(6),o[1],0,0,0), C1,4); \
    GAPB(o[0]=__builtin_amdgcn_mfma_f32_32x32x16_bf16(PAF(3),VFR(3),o[0],0,0,0), C1,8); \
    GAPB(o[1]=__builtin_amdgcn_mfma_f32_32x32x16_bf16(PAF(3),VFR(7),o[1],0,0,0), C1,12); \
    }while(0)
  int t=1;
  #undef CMASK
  #define CMASK(P0,P1,t) do{}while(0)
  for(;t+5<NT;t+=2){
    STEP(pB0,pB1,pA0,pA1,t,true,true,true);     WAIT_BAR(2); RESC(); ROT();
    STEP(pA0,pA1,pB0,pB1,t+1,true,true,true);   WAIT_BAR(2); RESC(); ROT();
  }
  #undef CMASK
  #define CMASK(P0,P1,t) do{int jb_=(t)-(NT-4); if(jb_>=0)cmask(P0,P1,jb_,qrel,hi);}while(0)
  #define ENDW(tt) do{ if((tt)+3<NT){WAIT_BAR(2);} else if((tt)+2<NT){WAIT_BAR(1);} else {WAIT_BAR(0);} }while(0)
  for(;t+1<NT;t+=2){
    STEP(pB0,pB1,pA0,pA1,t,(t+3<NT),(t+1<NT),(t+1<NT));       ENDW(t);   RESC(); ROT();
    STEP(pA0,pA1,pB0,pB1,t+1,(t+4<NT),(t+2<NT),(t+2<NT));     ENDW(t+1); RESC(); ROT();
  }
  STEP(pB0,pB1,pA0,pA1,NT-1,false,false,false); RESC();
  { float sacc=pB0[0]+pB0[1]; _Pragma("unroll") for(int r=2;r<16;++r)sacc+=pB0[r]; _Pragma("unroll") for(int r=0;r<16;++r)sacc+=pB1[r]; l_reg+=sacc;
    pw0=(u32x4){PKW(pB0,0),PKW(pB0,2),PKW(pB0,4),PKW(pB0,6)};pw1=(u32x4){PKW(pB0,8),PKW(pB0,10),PKW(pB0,12),PKW(pB0,14)};pw2=(u32x4){PKW(pB1,0),PKW(pB1,2),PKW(pB1,4),PKW(pB1,6)};pw3=(u32x4){PKW(pB1,8),PKW(pB1,10),PKW(pB1,12),PKW(pB1,14)};
    SBAR(); pv(o,vb0+sl_cur,PAF(0),PAF(1),PAF(2),PAF(3)); }
  #undef PKW
  #undef PAF
  #undef VFR
  #undef PIN
  #undef MX3
  #undef GAPA
  #undef GAPB
  #undef EX
  #undef VRD
  #undef KRD
  #undef STEP
  #undef ENDW
  {auto rr=__builtin_amdgcn_permlane32_swap(__float_as_uint(l_reg),__float_as_uint(l_reg),false,false);l_reg=__uint_as_float(rr[0])+__uint_as_float(rr[1]);}
  if(hi==0)wsf[32+r32]=l_reg;asm volatile("s_waitcnt lgkmcnt(0)":::"memory");
  float rli[16];
  #pragma unroll
  for(int r=0;r<16;++r)rli[r]=__builtin_amdgcn_rcpf(wsf[32+crow(r,hi)]);
  bf16*Ow=O+(rowbase+q0+wid*QBLK)*OPITCH+ocol;
  { bf16*stg=(bf16*)(shm+LDS_OST)+wid*2048;
    #pragma unroll
    for(int r=0;r<16;++r){const int orow=crow(r,hi);
      #pragma unroll
      for(int d0=0;d0<2;++d0)stg[orow*64+d0*32+r32]=__float2bfloat16(o[d0][r]*rli[r]);}
    asm volatile("s_waitcnt lgkmcnt(0)":::"memory");
    #pragma unroll
    for(int i=0;i<4;++i){const int row=i*8+(lane>>3),ch=lane&7; const u32x4 v=*(const u32x4*)(stg+row*64+ch*8); ATTN_STORE16(Ow+(long)row*OPITCH+ch*8,v);} }
  asm volatile("s_waitcnt lgkmcnt(0)\n\ts_barrier":::"memory");
  #undef DMA_K
  #undef DMA_V
  #undef CMASK
  #undef START
  #undef RESC
  #undef ROT
}
constexpr int ATTN_LDS_BYTES=LDS_BYTES;
#undef SBAR
#undef WAIT_BAR
}
constexpr size_t MiB = 1u << 20;
constexpr size_t WS_CTL = 0, CTL_ZERO_BYTES = 1 * MiB;
constexpr size_t WS_WIN = 2 * MiB, WS_WOUT = 26 * MiB, WS_WQ = 34 * MiB, WS_WKV = 42 * MiB, WS_WO = 58 * MiB, WS_W1 = 66 * MiB, WS_W2 = 578 * MiB;
constexpr size_t WS_HN = 834 * MiB, WS_MN = 866 * MiB, WS_PROJ = 870 * MiB, WS_DT = 958 * MiB, WS_KVRAW = 959 * MiB, WS_KN = 967 * MiB;
constexpr size_t WS_YCAT = 971 * MiB, WS_O0 = 1003 * MiB, WS_O1 = 1019 * MiB, WS_H1 = 1035 * MiB, WS_H1B = 1099 * MiB, WS_PART1 = 1131 * MiB, WS_PARTQ = 1132 * MiB;
constexpr size_t WS_QRAW = 1133 * MiB, WS_P = 1165 * MiB, WS_VWT = 1181 * MiB, WS_H2 = 1197 * MiB, WS_HN3 = 1261 * MiB;
constexpr size_t WS_TOKOF = 1293 * MiB, WS_GATEOF = 1294 * MiB, WS_TOKE = 1295 * MiB, WS_TOKR = 1296 * MiB, WS_ACT = 1297 * MiB, WS_Y = 1457 * MiB, WS_YG = 1617 * MiB, WS_END = 1633 * MiB;
constexpr int CW_BAR = 4096;
constexpr int CW_CNT = 8192;
static_assert((CW_CNT + 64 * 32) * 4 <= (int)CTL_ZERO_BYTES, "CTL words inside the memset region");

constexpr int RING_OFF = 0, RING_BYTES = 131072;
constexpr int LDS_BYTES = 163840;
constexpr int MISC_OFF = 163840 - 1024;
constexpr int NWAVES = 8;

#define XB_TMO      128
#define XB_XCNT(j)  (256  + 64 * (j))
#define XB_XSUB(j)  (1280 + 64 * (j))
#define XB_XGEN(j)  (2304 + 64 * (j))
#define XB_TOP      3328
#define XB_TOPGEN   3392
#define XCD_BAR_WORDS 3456
#define XB_SPIN_CAP (1u << 20)

__device__ __forceinline__ unsigned xb_ld(unsigned* p)              { return __hip_atomic_load(p, __ATOMIC_RELAXED, __HIP_MEMORY_SCOPE_AGENT); }
__device__ __forceinline__ unsigned xb_add(unsigned* p, unsigned v) { return __hip_atomic_fetch_add(p, v, __ATOMIC_RELAXED, __HIP_MEMORY_SCOPE_AGENT); }
__device__ __forceinline__ unsigned xb_xcc_id() { return (unsigned)__builtin_amdgcn_s_getreg((3 << 11) | 20) & 0xFu; }
#define XB_SPIN(cond, bar) do { unsigned _sp = 0; while (cond) { __builtin_amdgcn_s_sleep(1); \
    if ((++_sp & 255u) == 0u) { if (xb_ld(&(bar)[XB_TMO])) break; if (_sp > XB_SPIN_CAP) { atomicAdd(&(bar)[XB_TMO], 1u); break; } } } } while (0)

struct XcdBarrier {
    unsigned* bar; unsigned x;
    volatile LAS unsigned* st;
};
__device__ __forceinline__ XcdBarrier xcd_barrier_post(unsigned* bar, volatile LAS unsigned* st) {
    XcdBarrier b; b.bar = bar; b.x = xb_xcc_id(); b.st = st;
    if (threadIdx.x == 0) (void)xb_add(&bar[XB_XCNT(b.x)], 1u);
    return b;
}
__device__ __forceinline__ void xcd_barrier_complete(unsigned* bar, unsigned x, unsigned& nloc, unsigned& nx) {
    const unsigned G = gridDim.x * gridDim.y * gridDim.z;
    unsigned sum, cnt, mine, sp = 0u;
    for (;;) {
        sum = 0u; cnt = 0u; mine = 0u;
#pragma unroll
        for (unsigned j = 0; j < 16; ++j) { const unsigned c = xb_ld(&bar[XB_XCNT(j)]); sum += c; cnt += (c > 0u) ? 1u : 0u; mine = (j == x) ? c : mine; }
        if (sum == G) break;
        __builtin_amdgcn_s_sleep(1);
        if ((++sp & 255u) == 0u) { if (xb_ld(&bar[XB_TMO])) break; if (sp > XB_SPIN_CAP) { atomicAdd(&bar[XB_TMO], 1u); break; } }
    }
    nloc = mine > 0u ? mine : 1u; nx = cnt > 0u ? cnt : 1u;
}
__device__ __forceinline__ void xcd_barrier(const XcdBarrier& b) {
    asm volatile("s_waitcnt vmcnt(0)" ::: "memory");
    __syncthreads();
    if (threadIdx.x == 0) {
        unsigned* bar = b.bar;
        __builtin_amdgcn_s_waitcnt(0);
        unsigned nloc = b.st[0], nx = b.st[1];
        if (nloc == 0u) { xcd_barrier_complete(bar, b.x, nloc, nx); b.st[0] = nloc; b.st[1] = nx; }
        const unsigned old = xb_add(&bar[XB_XSUB(b.x)], 1u);
        const unsigned gen = old / nloc;
        if (old + 1u == (gen + 1u) * nloc) {
            __builtin_amdgcn_fence(__ATOMIC_RELEASE, "agent");
            asm volatile("s_waitcnt vmcnt(0)" ::: "memory");
            const unsigned og = xb_add(&bar[XB_TOP], 1u);
            const unsigned tg = og / nx;
            if (og + 1u == (tg + 1u) * nx) xb_add(&bar[XB_TOPGEN], 1u);
            else XB_SPIN(xb_ld(&bar[XB_TOPGEN]) == tg, bar);
            __builtin_amdgcn_fence(__ATOMIC_ACQUIRE, "agent");
            xb_add(&bar[XB_XGEN(b.x)], 1u);
            asm volatile("s_waitcnt vmcnt(0)" ::: "memory");
        } else {
            XB_SPIN(xb_ld(&bar[XB_XGEN(b.x)]) == gen, bar);
            __builtin_amdgcn_fence(__ATOMIC_ACQUIRE, "agent");
            asm volatile("s_waitcnt vmcnt(0)" ::: "memory");
        }
    }
    __syncthreads();
}

struct Args { const float* in[32]; float* out; unsigned char* ws; int ph_lo, ph_hi; };
enum In { I_X = 0, I_MEM, I_GMIX, I_WIN, I_CONVW, I_CONVB, I_DTB, I_ALOG, I_DSKIP, I_SSDG, I_DAQG, I_DAKG, I_LQ1, I_LK1, I_LQ2, I_LK2, I_SUBG, I_WOUT, I_GXA, I_GMEM,
          I_WQ, I_WKV, I_XQG, I_XKG, I_WO, I_GFFN, I_RW, I_RB, I_W1, I_B1, I_W2, I_B2 };

struct ArgP {
    typedef const __attribute__((address_space(4))) char* kptr;
    DI const float* in(int i) const { kptr kp = (kptr)__builtin_amdgcn_kernarg_segment_ptr(); asm volatile("" : "+s"(kp)); return *(const float* const __attribute__((address_space(4)))*)(kp + 8 * i); }
    DI float* out() const { kptr kp = (kptr)__builtin_amdgcn_kernarg_segment_ptr(); asm volatile("" : "+s"(kp)); return *(float* const __attribute__((address_space(4)))*)(kp + 8 * 32); }
};
struct Frame {
    LAS unsigned char* lds;
    volatile LAS unsigned* MISC;
    unsigned* ctl;
    unsigned char* ws;
    int tid, lane, wave, vcu, G;
};

template <class DestRow>
DI void tr_item(const float* W, size_t ldw, int k0, int ncol0, int nvalid, const float* kscale, bf16_t* WT, int K, DestRow dr, LAS float* scr, int lane) {
    const int c = lane & 31;
#pragma unroll 8
    for (int i = 0; i < 32; ++i) { const int kk = 2 * i + (lane >> 5);
        float v = (c < nvalid) ? W[(size_t)(k0 + kk) * ldw + ncol0 + c] : 0.f;
        if (kscale) v *= kscale[k0 + kk];
        scr[kk * 33 + c] = v; }
    asm volatile("s_waitcnt lgkmcnt(0)" ::: "memory");
    const int c8 = lane & 7;
#pragma unroll
    for (int j = 0; j < 4; ++j) { const int n = (lane >> 3) + 8 * j; const LAS float* s = scr + (8 * c8) * 33 + n;
        u32x4 o; o.x = pk2(s[0 * 33], s[1 * 33]); o.y = pk2(s[2 * 33], s[3 * 33]); o.z = pk2(s[4 * 33], s[5 * 33]); o.w = pk2(s[6 * 33], s[7 * 33]);
        if (n < nvalid) *(u32x4*)(WT + (size_t)dr(ncol0 + n) * K + k0 + 8 * c8) = o; }
    asm volatile("s_waitcnt lgkmcnt(0)" ::: "memory");
}
DI int tileperm(int col) { const int o = col & 255; return (col & ~255) + 128 * ((o & 63) >> 5) + 32 * (o >> 6) + (o & 31); }
struct DrIdent { DI int operator()(int n) const { return n; } };
struct DrTile  { DI int operator()(int n) const { return tileperm(n); } };
struct DrWin   { DI int operator()(int n) const { const int pc = (n < 2560) ? n : (n < 2576 ? PC_DT + (n - 2560) : n - 16); return tileperm(pc); } };
struct DrW1    { DI int operator()(int n) const { const int half = n >> 11, j = n & 2047; return (j >> 7) * 256 + half * 128 + (j & 127); } };

DI void rms_row_to_bf16(const float* xrow, const float* g, bf16_t* orow, int lane) {
    const f32x4* xr = (const f32x4*)xrow + lane;
    f32x4 v[8]; float s = 0.f;
#pragma unroll
    for (int j = 0; j < 8; ++j) { v[j] = xr[64 * j]; s += (v[j].x * v[j].x + v[j].y * v[j].y) + (v[j].z * v[j].z + v[j].w * v[j].w); }
    const float rstd = 1.f / sqrtf(wave_sum(s) * (1.f / 2048.f) + EPS_);
    u32x2* o8 = (u32x2*)orow + lane;
#pragma unroll
    for (int j = 0; j < 8; ++j) { const f32x4 gg = ((const f32x4*)g)[lane + 64 * j];
        u32x2 o; o.x = pk2(v[j].x * rstd * gg.x, v[j].y * rstd * gg.y); o.y = pk2(v[j].z * rstd * gg.z, v[j].w * rstd * gg.w); o8[64 * j] = o; }
}

DI void p0_prologue(Frame& F, const ArgP& a) {
    LAS float* scr = (LAS float*)(F.lds + RING_OFF + F.wave * 16384);
    const int gw = F.vcu * NWAVES + F.wave, NGW = F.G * NWAVES;
    unsigned char* ws = F.ws;
    constexpr int I_A = 32 * 80, I_B = 32, I_C = 32 * 96, I_WOUT_ = 32 * 64, I_WQ_ = 32 * 64, I_WKV_ = 32 * 128, I_WO_ = 32 * 64, I_W1_ = 32 * 32 * 128, I_W2_ = 32 * 32 * 64;
    constexpr int NITEMS = I_A + I_B + I_C + I_WOUT_ + I_WQ_ + I_WKV_ + I_WO_ + I_W1_ + I_W2_;
    for (int it = gw; it < NITEMS; it += NGW) {
        int r = it;
        if (r < I_A) { tr_item(a.in(I_WIN), 5648, 64 * (r / 80), 32 * (r % 80), 32, nullptr, (bf16_t*)(ws + WS_WIN), 2048, DrWin(), scr, F.lane); continue; } r -= I_A;
        if (r < I_B) { tr_item(a.in(I_WIN), 5648, 64 * r, 2560, 16, nullptr, (bf16_t*)(ws + WS_WIN), 2048, DrWin(), scr, F.lane); continue; } r -= I_B;
        if (r < I_C) { tr_item(a.in(I_WIN), 5648, 64 * (r / 96), 2576 + 32 * (r % 96), 32, nullptr, (bf16_t*)(ws + WS_WIN), 2048, DrWin(), scr, F.lane); continue; } r -= I_C;
        if (r < I_WOUT_) { tr_item(a.in(I_WOUT), 2048, 64 * (r / 64), 32 * (r % 64), 32, nullptr, (bf16_t*)(ws + WS_WOUT), 2048, DrIdent(), scr, F.lane); continue; } r -= I_WOUT_;
        if (r < I_WQ_) { tr_item(a.in(I_WQ), 2048, 64 * (r / 64), 32 * (r % 64), 32, a.in(I_GXA), (bf16_t*)(ws + WS_WQ), 2048, DrIdent(), scr, F.lane); continue; } r -= I_WQ_;
        if (r < I_WKV_) { tr_item(a.in(I_WKV), 4096, 64 * (r / 128), 32 * (r % 128), 32, nullptr, (bf16_t*)(ws + WS_WKV), 2048, DrTile(), scr, F.lane); continue; } r -= I_WKV_;
        if (r < I_WO_) { tr_item(a.in(I_WO), 2048, 64 * (r / 64), 32 * (r % 64), 32, nullptr, (bf16_t*)(ws + WS_WO), 2048, DrIdent(), scr, F.lane); continue; } r -= I_WO_;
        if (r < I_W1_) { const int e = r / (32 * 128), q = r % (32 * 128);
            tr_item(a.in(I_W1) + (size_t)e * 2048 * 4096, 4096, 64 * (q / 128), 32 * (q % 128), 32, nullptr, (bf16_t*)(ws + WS_W1) + (size_t)e * 4096 * 2048, 2048, DrW1(), scr, F.lane); continue; } r -= I_W1_;
        { const int e = r / (32 * 64), q = r % (32 * 64);
            tr_item(a.in(I_W2) + (size_t)e * 2048 * 2048, 2048, 64 * (q / 64), 32 * (q % 64), 32, nullptr, (bf16_t*)(ws + WS_W2) + (size_t)e * 2048 * 2048, 2048, DrIdent(), scr, F.lane); }
    }
    for (int m = gw; m < NTOK; m += NGW) rms_row_to_bf16(a.in(I_X) + (size_t)m * 2048, a.in(I_GMIX), (bf16_t*)(ws + WS_HN) + (size_t)m * 2048, F.lane);
    for (int m = gw; m < NB * MEMLEN; m += NGW) rms_row_to_bf16(a.in(I_MEM) + (size_t)m * 2048, a.in(I_GMEM), (bf16_t*)(ws + WS_MN) + (size_t)m * 2048, F.lane);
}

struct SchedP1 {
    int G, c; const unsigned char* ws;
    DI bool next(int i, pg8::UnitD& u) const {
        const int L = i * G + c; if (L >= 32 * 23 + 64) return false;
        u.rows = nullptr; u.nvalid = 0; u.lda = 4096u; u.ldb = 4096u; u.e = 0; u.x0 = 0;
        if (L < 32 * 23) { u.type = 0; u.pn = L / 32; u.pm = L % 32; u.A = (const char*)(ws + WS_HN) + (size_t)u.pm * 256 * 4096; u.B = (const char*)(ws + WS_WIN) + (size_t)u.pn * 256 * 4096; }
        else { const int q = L - 32 * 23; u.type = 1; u.pn = q / 4; u.pm = q % 4; u.A = (const char*)(ws + WS_MN) + (size_t)u.pm * 256 * 4096; u.B = (const char*)(ws + WS_WKV) + (size_t)u.pn * 256 * 4096; }
        return true;
    }
};
struct EpiP1 {
    static constexpr bool AFTER_DRAIN = false;
    bf16_t* proj; float* dtb; bf16_t* kvraw; const float* gq; const float* gk;
    DI void operator()(const f32x4 (&acc)[2][2][4][2], const pg8::UnitD& u, int wr, int wc, int fr, int fq) const {
        { int ln_ = threadIdx.x; asm volatile("" : "+v"(ln_)); fr = ln_ & 15; fq = (ln_ >> 4) & 3; }
        const int row0 = u.pm * 256 + wr * 64 + fr;
        const int cn = u.pn * 256 + 64 * wc + 8 * fq;
        if (u.type == 1) {
#pragma unroll
            for (int ai = 0; ai < 2; ++ai)
#pragma unroll
                for (int m = 0; m < 4; ++m) { bf16_t* rp = kvraw + (size_t)(row0 + ai * 128 + m * 16) * 4096 + cn;
#pragma unroll
                    for (int bj = 0; bj < 2; ++bj) { const f32x4 v0 = acc[ai][bj][m][0], v1 = acc[ai][bj][m][1];
                        u32x4 w; w.x = pk2(v0[0], v0[1]); w.y = pk2(v0[2], v0[3]); w.z = pk2(v1[0], v1[1]); w.w = pk2(v1[2], v1[3]); *(u32x4*)(rp + 32 * bj) = w; } }
            return;
        }
        if (u.pn == 22) {
            if (wc == 0 && fq < 2) {
#pragma unroll
                for (int ai = 0; ai < 2; ++ai)
#pragma unroll
                    for (int m = 0; m < 4; ++m) { float* rp = dtb + (size_t)(row0 + ai * 128 + m * 16) * 16 + 8 * fq;
                        *(f32x4*)(rp) = acc[ai][0][m][0]; *(f32x4*)(rp + 4) = acc[ai][0][m][1]; }
            }
            return;
        }
        const bool isq = (u.pn >= 10 && u.pn < 14), isk = (u.pn >= 14 && u.pn < 18);
        if (!(isq || isk)) {
#pragma unroll
            for (int ai = 0; ai < 2; ++ai)
#pragma unroll
                for (int m = 0; m < 4; ++m) { bf16_t* rp = proj + (size_t)(row0 + ai * 128 + m * 16) * PP + cn;
#pragma unroll
                    for (int bj = 0; bj < 2; ++bj) { const f32x4 v0 = acc[ai][bj][m][0], v1 = acc[ai][bj][m][1];
                        u32x4 w; w.x = pk2(v0[0], v0[1]); w.y = pk2(v0[2], v0[3]); w.z = pk2(v1[0], v1[1]); w.w = pk2(v1[2], v1[3]); *(u32x4*)(rp + 32 * bj) = w; } }
            return;
        }
        const float* g = (isq ? gq : gk) + 8 * fq; const float sc = isq ? (0.125f * 1.4426950408889634f) : 1.f;
#pragma unroll
        for (int ai = 0; ai < 2; ++ai)
#pragma unroll
            for (int m = 0; m < 4; ++m) { bf16_t* rp = proj + (size_t)(row0 + ai * 128 + m * 16) * PP + cn;
                float ss = 0.f;
#pragma unroll
                for (int bj = 0; bj < 2; ++bj)
#pragma unroll
                    for (int n = 0; n < 2; ++n) { const f32x4 v = acc[ai][bj][m][n]; ss += (v[0] * v[0] + v[1] * v[1]) + (v[2] * v[2] + v[3] * v[3]); }
                ss += __shfl_xor(ss, 16); ss += __shfl_xor(ss, 32);
                const float rs = sc / sqrtf(ss * (1.f / 64.f) + EPS_);
#pragma unroll
                for (int bj = 0; bj < 2; ++bj) { const f32x4 v0 = acc[ai][bj][m][0] * rs * *(const f32x4*)(g + 32 * bj), v1 = acc[ai][bj][m][1] * rs * *(const f32x4*)(g + 32 * bj + 4);
                    u32x4 w; w.x = pk2(v0[0], v0[1]); w.y = pk2(v0[2], v0[3]); w.z = pk2(v1[0], v1[1]); w.w = pk2(v1[2], v1[3]); *(u32x4*)(rp + 32 * bj) = w; } }
    }
};

DI void kprep(Frame& F, const ArgP& a) {
    const int gw = F.vcu * NWAVES + F.wave, NGW = F.G * NWAVES;
    const bf16_t* kv = (const bf16_t*)(F.ws + WS_KVRAW); bf16_t* kn = (bf16_t*)(F.ws + WS_KN);
    for (int it = gw; it < NB * MEMLEN * 4; it += NGW) {
        const int row = it >> 2, h = it & 3, b = row >> 8, key = row & 255;
        const u32x4 raw = *(const u32x4*)(kv + (size_t)row * 4096 + h * 512 + F.lane * 8);
        float v[8]; v[0] = bflo(raw.x); v[1] = bfhi(raw.x); v[2] = bflo(raw.y); v[3] = bfhi(raw.y); v[4] = bflo(raw.z); v[5] = bfhi(raw.z); v[6] = bflo(raw.w); v[7] = bfhi(raw.w);
        float ss = 0.f;
#pragma unroll
        for (int j = 0; j < 8; ++j) ss += v[j] * v[j];
        const float rs = 1.f / sqrtf(wave_sum(ss) * (1.f / 512.f) + EPS_) * 0.04419417382415922f;
        const float* gk = a.in(I_XKG) + F.lane * 8; const float* gq = a.in(I_XQG) + F.lane * 8;
        u32x4 o; o.x = pk2(v[0] * rs * gk[0] * gq[0], v[1] * rs * gk[1] * gq[1]); o.y = pk2(v[2] * rs * gk[2] * gq[2], v[3] * rs * gk[3] * gq[3]);
        o.z = pk2(v[4] * rs * gk[4] * gq[4], v[5] * rs * gk[5] * gq[5]); o.w = pk2(v[6] * rs * gk[6] * gq[6], v[7] * rs * gk[7] * gq[7]);
        *(u32x4*)(kn + ((size_t)((b * 4 + h) * 256 + key)) * 512 + F.lane * 8) = o;
    }
}

constexpr int SP = 272;
constexpr int S_C = 0, S_BM = 34816, S_BT = 69632, S_XDT = 104448, S_XW = 121856, S_HB = 139264, S_F = 156672, SSD_LDS = 157696;
static_assert(SSD_LDS <= MISC_OFF, "SSD LDS map");
#define MFMA32(a, b, c) __builtin_amdgcn_mfma_f32_32x32x16_bf16((a), (b), (c), 0, 0, 0)
DI int crow(int r, int hi) { return (r & 3) + 8 * (r >> 2) + 4 * hi; }
DI bf16x8 ldfrag(LAS const unsigned char* base, int row, int kel) { return *(const LAS bf16x8*)(base + row * SP + kel * 2); }

DI void ssd_unit(Frame& F, const ArgP& a, int b, int hd) {
    LAS unsigned char* lds = F.lds;
    const int tid = F.tid, lane = F.lane, wid = F.wave, r32 = lane & 31, hh = lane >> 5;
    LAS float* sdt = (LAS float*)(lds + S_F); LAS float* sac = sdt + 128;
    const bf16_t* proj = (const bf16_t*)(F.ws + WS_PROJ); const float* dtbuf = (const float*)(F.ws + WS_DT); bf16_t* yg = (bf16_t*)(F.ws + WS_YG);
    const int g = hd >> 3;
    const float aneg = -__expf(a.in(I_ALOG)[hd]), dtb = a.in(I_DTB)[hd], dsk = a.in(I_DSKIP)[hd];
    const float* convw = a.in(I_CONVW); const float* convb = a.in(I_CONVB);
    f32x16 hT; for (int i = 0; i < 16; ++i) hT[i] = 0.f;
    const int nb = wid & 3, pb = wid >> 2;
    for (int c = 0; c < 16; ++c) {
        const int t0 = b * SEQ_ + c * 128;
        if (wid == 0) {
            const float x0 = dtbuf[(size_t)(t0 + 2 * lane) * 16 + hd] + dtb, x1 = dtbuf[(size_t)(t0 + 2 * lane + 1) * 16 + hd] + dtb;
            const float d0 = x0 > 20.f ? x0 : log1pf(__expf(x0)), d1 = x1 > 20.f ? x1 : log1pf(__expf(x1));
            const float a0 = d0 * aneg, a1 = d1 * aneg;
            float s = a0 + a1;
#pragma unroll
            for (int o = 1; o < 64; o <<= 1) { const float t = __shfl_up(s, o); if (lane >= o) s += t; }
            sdt[2 * lane] = d0; sdt[2 * lane + 1] = d1; sac[2 * lane] = s - a1; sac[2 * lane + 1] = s;
        }
        {
            LAS unsigned char* hbp = lds + S_HB + (32 * pb + r32) * SP + (32 * nb + 4 * hh) * 2;
#pragma unroll
            for (int q4 = 0; q4 < 4; ++q4) { u32x2 w; w.x = pk2(hT[4 * q4], hT[4 * q4 + 1]); w.y = pk2(hT[4 * q4 + 2], hT[4 * q4 + 3]); *(LAS u32x2*)(hbp + 16 * q4) = w; }
        }
        __syncthreads();
        const float aend = sac[127];
        for (int item = tid; item < 640; item += 512) {
            const int seg = item / 40, cg = item % 40, l0 = seg * 8;
            const int xcol = (cg < 8) ? (hd * 64 + cg * 8) : (cg < 24 ? (1024 + g * 128 + (cg - 8) * 8) : (1280 + g * 128 + (cg - 24) * 8));
            u32x4 in[11];
#pragma unroll
            for (int j = 0; j < 11; ++j) { const int tt = c * 128 + l0 - 3 + j;
                in[j] = (tt >= 0) ? *(const u32x4*)(proj + (size_t)(b * SEQ_ + tt) * PP + PC_XBC + xcol) : (u32x4){0u, 0u, 0u, 0u}; }
            float w[4][8], bias[8];
#pragma unroll
            for (int k = 0; k < 4; ++k) { const f32x4 w0 = *(const f32x4*)(convw + k * 1536 + xcol), w1 = *(const f32x4*)(convw + k * 1536 + xcol + 4);
                w[k][0] = w0[0]; w[k][1] = w0[1]; w[k][2] = w0[2]; w[k][3] = w0[3]; w[k][4] = w1[0]; w[k][5] = w1[1]; w[k][6] = w1[2]; w[k][7] = w1[3]; }
            { const f32x4 b0 = *(const f32x4*)(convb + xcol), b1 = *(const f32x4*)(convb + xcol + 4);
              bias[0] = b0[0]; bias[1] = b0[1]; bias[2] = b0[2]; bias[3] = b0[3]; bias[4] = b1[0]; bias[5] = b1[1]; bias[6] = b1[2]; bias[7] = b1[3]; }
            float o[8][8];
#pragma unroll
            for (int j = 0; j < 8; ++j)
#pragma unroll
                for (int i = 0; i < 8; ++i) { float s = bias[i];
#pragma unroll
                    for (int k = 0; k < 4; ++k) { const unsigned wd = in[j + k][i >> 1]; s += w[k][i] * ((i & 1) ? bfhi(wd) : bflo(wd)); }
                    o[j][i] = siluf(s); }
            if (cg < 8) {
                float dv[8], ev[8];
#pragma unroll
                for (int j = 0; j < 8; ++j) { dv[j] = sdt[l0 + j]; ev[j] = dv[j] * __expf(aend - sac[l0 + j]); }
#pragma unroll
                for (int i = 0; i < 8; ++i) { const int p = cg * 8 + i;
                    u32x4 w1, w2;
                    w1.x = pk2(o[0][i] * dv[0], o[1][i] * dv[1]); w1.y = pk2(o[2][i] * dv[2], o[3][i] * dv[3]); w1.z = pk2(o[4][i] * dv[4], o[5][i] * dv[5]); w1.w = pk2(o[6][i] * dv[6], o[7][i] * dv[7]);
                    w2.x = pk2(o[0][i] * ev[0], o[1][i] * ev[1]); w2.y = pk2(o[2][i] * ev[2], o[3][i] * ev[3]); w2.z = pk2(o[4][i] * ev[4], o[5][i] * ev[5]); w2.w = pk2(o[6][i] * ev[6], o[7][i] * ev[7]);
                    *(LAS u32x4*)(lds + S_XDT + p * SP + l0 * 2) = w1; *(LAS u32x4*)(lds + S_XW + p * SP + l0 * 2) = w2; }
            } else if (cg < 24) {
                const int n0 = (cg - 8) * 8;
#pragma unroll
                for (int j = 0; j < 8; ++j) { u32x4 w1; w1.x = pk2(o[j][0], o[j][1]); w1.y = pk2(o[j][2], o[j][3]); w1.z = pk2(o[j][4], o[j][5]); w1.w = pk2(o[j][6], o[j][7]);
                    *(LAS u32x4*)(lds + S_BM + (l0 + j) * SP + n0 * 2) = w1; }
#pragma unroll
                for (int i = 0; i < 8; ++i) { u32x4 w2; w2.x = pk2(o[0][i], o[1][i]); w2.y = pk2(o[2][i], o[3][i]); w2.z = pk2(o[4][i], o[5][i]); w2.w = pk2(o[6][i], o[7][i]);
                    *(LAS u32x4*)(lds + S_BT + (n0 + i) * SP + l0 * 2) = w2; }
            } else {
                const int n0 = (cg - 24) * 8;
#pragma unroll
                for (int j = 0; j < 8; ++j) { u32x4 w1; w1.x = pk2(o[j][0], o[j][1]); w1.y = pk2(o[j][2], o[j][3]); w1.z = pk2(o[j][4], o[j][5]); w1.w = pk2(o[j][6], o[j][7]);
                    *(LAS u32x4*)(lds + S_C + (l0 + j) * SP + n0 * 2) = w1; }
            }
        }
        __syncthreads();
        const int lb = wid >> 1;
        f32x16 xt[2];
#pragma unroll
        for (int q = 0; q < 2; ++q) { const int sb = 2 * (wid & 1) + q;
            for (int i = 0; i < 16; ++i) xt[q][i] = 0.f;
            if (sb <= lb) {
#pragma unroll
                for (int ks = 0; ks < 8; ++ks) xt[q] = MFMA32(ldfrag(lds + S_BM, 32 * sb + r32, 16 * ks + 8 * hh), ldfrag(lds + S_C, 32 * lb + r32, 16 * ks + 8 * hh), xt[q]);
            }
        }
        __syncthreads();
        {
            const int l = 32 * lb + r32; const float al = sac[l], dl = sdt[l];
#pragma unroll
            for (int q = 0; q < 2; ++q) { const int sb = 2 * (wid & 1) + q;
#pragma unroll
                for (int q4 = 0; q4 < 4; ++q4) { float mv[4];
#pragma unroll
                    for (int e = 0; e < 4; ++e) { const int s = 32 * sb + 8 * q4 + 4 * hh + e;
                        float v = 0.f;
                        if (s <= l) v = xt[q][4 * q4 + e] * __expf(al - sac[s]);
                        if (s == l) v += dsk / dl;
                        mv[e] = v; }
                    u32x2 w; w.x = pk2(mv[0], mv[1]); w.y = pk2(mv[2], mv[3]);
                    *(LAS u32x2*)(lds + S_BM + l * SP + (32 * sb + 8 * q4 + 4 * hh) * 2) = w; }
            }
        }
        __syncthreads();
        {
            const int lb2 = wid & 3, pb2 = wid >> 2;
            f32x16 y1, y2; for (int i = 0; i < 16; ++i) { y1[i] = 0.f; y2[i] = 0.f; }
            for (int ks = 0; ks < 2 * (lb2 + 1); ++ks) y1 = MFMA32(ldfrag(lds + S_BM, 32 * lb2 + r32, 16 * ks + 8 * hh), ldfrag(lds + S_XDT, 32 * pb2 + r32, 16 * ks + 8 * hh), y1);
#pragma unroll
            for (int ks = 0; ks < 8; ++ks) y2 = MFMA32(ldfrag(lds + S_C, 32 * lb2 + r32, 16 * ks + 8 * hh), ldfrag(lds + S_HB, 32 * pb2 + r32, 16 * ks + 8 * hh), y2);
            const float cd = __expf(aend);
#pragma unroll
            for (int i = 0; i < 16; ++i) hT[i] *= cd;
#pragma unroll
            for (int ks = 0; ks < 8; ++ks) hT = MFMA32(ldfrag(lds + S_BT, 32 * nb + r32, 16 * ks + 8 * hh), ldfrag(lds + S_XW, 32 * pb + r32, 16 * ks + 8 * hh), hT);
            const int pcol = hd * 64 + 32 * pb2 + r32;
#pragma unroll
            for (int i = 0; i < 16; ++i) { const int l = 32 * lb2 + crow(i, hh); const size_t tok = (size_t)(t0 + l);
                const float yv = y1[i] + __expf(sac[l]) * y2[i];
                const float z = bf2f(proj[tok * PP + pcol]);
                yg[tok * 1024 + pcol] = (bf16_t)(pk2(yv * siluf(z), 0.f) & 0xffffu); }
        }
        __syncthreads();
    }
}

DI void attn_phase_da(Frame& F) {
    const attn_body::bf16* proj = (const attn_body::bf16*)(F.ws + WS_PROJ);
    for (int r = 0; ; ++r) {
        const int u = r * F.G + F.vcu; if (u >= 1024) break;
        const int v = u & 255, rr = u >> 8;
        const int combo = v >> 1, sp = v & 1;
        const int half = combo & 1, j = (combo >> 1) & 1, h = (combo >> 2) & 7, b = combo >> 5;
        const int qb = (rr == 0) ? (7 - sp) : (rr == 1) ? sp : (rr == 2) ? (4 + sp) : (3 - sp);
        attn_body::bf16* O = (attn_body::bf16*)(F.ws + (j ? WS_O1 : WS_O0));
        attn_body::attn_unit<8>(b, PC_Q + (h * 2 + j) * 64, PC_V + h * 128 + half * 64, h * 128 + half * 64, qb, proj, proj + (PC_K - PC_Q), proj, O, (char*)F.lds);
    }
}

DI void p3_finalize(Frame& F, const ArgP& a) {
    const int gw = F.vcu * NWAVES + F.wave, NGW = F.G * NWAVES, lane = F.lane;
    bf16_t* ycat = (bf16_t*)(F.ws + WS_YCAT); const bf16_t* yg = (const bf16_t*)(F.ws + WS_YG); const bf16_t* o0 = (const bf16_t*)(F.ws + WS_O0); const bf16_t* o1 = (const bf16_t*)(F.ws + WS_O1);
    float l1 = a.in(I_LQ1)[lane] * a.in(I_LK1)[lane], l2 = a.in(I_LQ2)[lane] * a.in(I_LK2)[lane];
    const float lam = __expf(wave_sum(l1)) - __expf(wave_sum(l2)) + LAM_INIT;
    for (int m = gw; m < NTOK; m += NGW) {
        { bf16_t* yp = ycat + (size_t)m * 2048 + 16 * lane; const bf16_t* gp = yg + (size_t)m * 1024 + 16 * lane;
          const u32x4 r0 = *(const u32x4*)gp, r1 = *(const u32x4*)(gp + 8);
          float v[16]; v[0] = bflo(r0.x); v[1] = bfhi(r0.x); v[2] = bflo(r0.y); v[3] = bfhi(r0.y); v[4] = bflo(r0.z); v[5] = bfhi(r0.z); v[6] = bflo(r0.w); v[7] = bfhi(r0.w);
          v[8] = bflo(r1.x); v[9] = bfhi(r1.x); v[10] = bflo(r1.y); v[11] = bfhi(r1.y); v[12] = bflo(r1.z); v[13] = bfhi(r1.z); v[14] = bflo(r1.w); v[15] = bfhi(r1.w);
          float ss = 0.f;
#pragma unroll
          for (int i = 0; i < 16; ++i) ss += v[i] * v[i];
#pragma unroll
          for (int o = 1; o < 32; o <<= 1) ss += __shfl_xor(ss, o);
          const float rs = 1.f / sqrtf(ss * (1.f / 512.f) + EPS_);
          const float* g = a.in(I_SSDG) + 16 * lane;
          u32x4 w0, w1;
          w0.x = pk2(v[0] * rs * g[0], v[1] * rs * g[1]); w0.y = pk2(v[2] * rs * g[2], v[3] * rs * g[3]); w0.z = pk2(v[4] * rs * g[4], v[5] * rs * g[5]); w0.w = pk2(v[6] * rs * g[6], v[7] * rs * g[7]);
          w1.x = pk2(v[8] * rs * g[8], v[9] * rs * g[9]); w1.y = pk2(v[10] * rs * g[10], v[11] * rs * g[11]); w1.z = pk2(v[12] * rs * g[12], v[13] * rs * g[13]); w1.w = pk2(v[14] * rs * g[14], v[15] * rs * g[15]);
          *(u32x4*)yp = w0; *(u32x4*)(yp + 8) = w1; }
        { const bf16_t* p0 = o0 + (size_t)m * 1024 + 16 * lane; const bf16_t* p1 = o1 + (size_t)m * 1024 + 16 * lane;
          const u32x4 a0 = *(const u32x4*)p0, a1 = *(const u32x4*)(p0 + 8), b0 = *(const u32x4*)p1, b1 = *(const u32x4*)(p1 + 8);
          float v[16];
          v[0] = bflo(a0.x) - lam * bflo(b0.x); v[1] = bfhi(a0.x) - lam * bfhi(b0.x); v[2] = bflo(a0.y) - lam * bflo(b0.y); v[3] = bfhi(a0.y) - lam * bfhi(b0.y);
          v[4] = bflo(a0.z) - lam * bflo(b0.z); v[5] = bfhi(a0.z) - lam * bfhi(b0.z); v[6] = bflo(a0.w) - lam * bflo(b0.w); v[7] = bfhi(a0.w) - lam * bfhi(b0.w);
          v[8] = bflo(a1.x) - lam * bflo(b1.x); v[9] = bfhi(a1.x) - lam * bfhi(b1.x); v[10] = bflo(a1.y) - lam * bflo(b1.y); v[11] = bfhi(a1.y) - lam * bfhi(b1.y);
          v[12] = bflo(a1.z) - lam * bflo(b1.z); v[13] = bfhi(a1.z) - lam * bfhi(b1.z); v[14] = bflo(a1.w) - lam * bflo(b1.w); v[15] = bfhi(a1.w) - lam * bfhi(b1.w);
          float ss = 0.f;
#pragma unroll
          for (int i = 0; i < 16; ++i) ss += v[i] * v[i];
          ss += __shfl_xor(ss, 1); ss += __shfl_xor(ss, 2); ss += __shfl_xor(ss, 4);
          const float rs = 1.f / sqrtf(ss * (1.f / 128.f) + EPS_) * (1.f - LAM_INIT);
          const float* g = a.in(I_SUBG) + 16 * (lane & 7);
          u32x4 w0, w1;
          w0.x = pk2(v[0] * rs * g[0], v[1] * rs * g[1]); w0.y = pk2(v[2] * rs * g[2], v[3] * rs * g[3]); w0.z = pk2(v[4] * rs * g[4], v[5] * rs * g[5]); w0.w = pk2(v[6] * rs * g[6], v[7] * rs * g[7]);
          w1.x = pk2(v[8] * rs * g[8], v[9] * rs * g[9]); w1.y = pk2(v[10] * rs * g[10], v[11] * rs * g[11]); w1.z = pk2(v[12] * rs * g[12], v[13] * rs * g[13]); w1.w = pk2(v[14] * rs * g[14], v[15] * rs * g[15]);
          bf16_t* yp = ycat + (size_t)m * 2048 + 1024 + 16 * lane;
          *(u32x4*)yp = w0; *(u32x4*)(yp + 8) = w1; }
    }
}

struct SchedDense {
    int G, c, nM, nN; const char* A; const char* B; unsigned lda, ldb; int bdiv; size_t bstride;
    DI bool next(int i, pg8::UnitD& u) const {
        const int L = i * G + c; if (L >= nM * nN) return false;
        u.rows = nullptr; u.nvalid = 0; u.lda = lda; u.ldb = ldb; u.type = 0; u.e = 0; u.x0 = 0;
        u.pn = L / nM; u.pm = L % nM;
        u.A = A + (size_t)u.pm * 256 * lda; u.B = B + (size_t)u.pn * 256 * ldb + (size_t)(u.pm / bdiv) * bstride;
        return true;
    }
};
struct EpiResid {
    static constexpr bool AFTER_DRAIN = false;
    const float* base; float* out; bf16_t* outb; float* part;
    DI void operator()(const f32x4 (&acc)[2][2][4][2], const pg8::UnitD& u, int wr, int wc, int fr, int fq) const {
        { int ln_ = threadIdx.x; asm volatile("" : "+v"(ln_)); fr = ln_ & 15; fq = (ln_ >> 4) & 3; }
        const int row0 = u.pm * 256 + wr * 64 + fr, col0 = u.pn * 256 + wc * 32 + 8 * fq;
#pragma unroll
        for (int ai = 0; ai < 2; ++ai)
#pragma unroll
            for (int m = 0; m < 4; ++m) { const size_t row = (size_t)(row0 + ai * 128 + m * 16); float ss = 0.f;
#pragma unroll
                for (int bj = 0; bj < 2; ++bj) { const size_t idx = row * 2048 + col0 + bj * 128;
                    f32x4 v0 = acc[ai][bj][m][0] + *(const f32x4*)(base + idx), v1 = acc[ai][bj][m][1] + *(const f32x4*)(base + idx + 4);
                    *(f32x4*)(out + idx) = v0; *(f32x4*)(out + idx + 4) = v1;
                    if (outb) { u32x4 w; w.x = pk2(v0[0], v0[1]); w.y = pk2(v0[2], v0[3]); w.z = pk2(v1[0], v1[1]); w.w = pk2(v1[2], v1[3]); *(u32x4*)(outb + idx) = w; }
                    ss += (v0[0] * v0[0] + v0[1] * v0[1]) + (v0[2] * v0[2] + v0[3] * v0[3]) + (v1[0] * v1[0] + v1[1] * v1[1]) + (v1[2] * v1[2] + v1[3] * v1[3]); }
                if (part) { ss += __shfl_xor(ss, 16); ss += __shfl_xor(ss, 32); if (fq == 0) part[row * 32 + u.pn * 4 + wc] = ss; } }
    }
};

struct EpiQ {
    static constexpr bool AFTER_DRAIN = false;
    bf16_t* outb; float* part;
    DI void operator()(const f32x4 (&acc)[2][2][4][2], const pg8::UnitD& u, int wr, int wc, int fr, int fq) const {
        { int ln_ = threadIdx.x; asm volatile("" : "+v"(ln_)); fr = ln_ & 15; fq = (ln_ >> 4) & 3; }
        const int row0 = u.pm * 256 + wr * 64 + fr, col0 = u.pn * 256 + wc * 32 + 8 * fq;
#pragma unroll
        for (int ai = 0; ai < 2; ++ai)
#pragma unroll
            for (int m = 0; m < 4; ++m) { const size_t row = (size_t)(row0 + ai * 128 + m * 16); float ss = 0.f;
#pragma unroll
                for (int bj = 0; bj < 2; ++bj) { const size_t idx = row * 2048 + col0 + bj * 128; const f32x4 v0 = acc[ai][bj][m][0], v1 = acc[ai][bj][m][1];
                    u32x4 w; w.x = pk2(v0[0], v0[1]); w.y = pk2(v0[2], v0[3]); w.z = pk2(v1[0], v1[1]); w.w = pk2(v1[2], v1[3]); *(u32x4*)(outb + idx) = w;
                    ss += (v0[0] * v0[0] + v0[1] * v0[1]) + (v0[2] * v0[2] + v0[3] * v0[3]) + (v1[0] * v1[0] + v1[1] * v1[1]) + (v1[2] * v1[2] + v1[3] * v1[3]); }
                ss += __shfl_xor(ss, 16); ss += __shfl_xor(ss, 32); if (fq == 0) part[row * 32 + u.pn * 4 + wc] = ss; }
    }
};

struct SchedXS {
    int G, c; const unsigned char* ws;
    DI bool next(int i, pg8::UnitD& u) const {
        const int L = i * G + c; if (L >= 256) return false;
        u.rows = nullptr; u.nvalid = 0; u.e = 0;
        const int q = L & 127, bh = q >> 3, t8 = q & 7, b = bh >> 2, h = bh & 3;
        u.pm = b; u.pn = h; u.x0 = t8;
        if (L < 128) { u.type = 0; u.lda = 4096u; u.ldb = 1024u;
            u.A = (const char*)(ws + WS_QRAW) + (size_t)(b * 2048 + t8 * 256) * 4096 + h * 1024; u.B = (const char*)(ws + WS_KN) + (size_t)(bh * 256) * 1024; }
        else { u.type = 1; u.lda = 4096u; u.ldb = 8192u;
            u.A = (const char*)(ws + WS_WO) + (size_t)(t8 * 256) * 4096 + h * 1024; u.B = (const char*)(ws + WS_KVRAW) + (size_t)(b * 256) * 8192 + (2048 + h * 512) * 2; }
        return true;
    }
};
struct EpiXS {
    static constexpr bool AFTER_DRAIN = false;
    bf16_t* P; bf16_t* VWT; const float* part1; const float* partq; LAS float* red;
    DI void operator()(const f32x4 (&acc)[2][2][4][2], const pg8::UnitD& u, int wr, int wc, int fr, int fq) const {
        { int ln_ = threadIdx.x; asm volatile("" : "+v"(ln_)); fr = ln_ & 15; fq = (ln_ >> 4) & 3; }
        const int b = u.pm, h = u.pn, t8 = u.x0;
        const int col0 = wc * 32 + 8 * fq;
        if (u.type == 1) {
            char* Vu = (char*)(VWT + ((size_t)b * 2048 + t8 * 256) * 1024 + h * 256);
#pragma unroll
            for (int ai = 0; ai < 2; ++ai)
#pragma unroll
                for (int m = 0; m < 4; ++m) { const unsigned rl = (unsigned)(ai * 128 + wr * 64 + m * 16 + fr);
#pragma unroll
                    for (int bj = 0; bj < 2; ++bj) { const f32x4 v0 = acc[ai][bj][m][0], v1 = acc[ai][bj][m][1];
                        u32x4 w; w.x = pk2(v0[0], v0[1]); w.y = pk2(v0[2], v0[3]); w.z = pk2(v1[0], v1[1]); w.w = pk2(v1[2], v1[3]);
                        *(u32x4*)(Vu + (rl * 1024u + (unsigned)(bj * 128 + col0)) * 2u) = w; } }
            return;
        }
        const size_t row0 = (size_t)b * 2048 + t8 * 256;
        const char* p1u = (const char*)(part1 + row0 * 32); const char* pqu = (const char*)(partq + row0 * 32 + h * 8); char* Pu = (char*)(P + row0 * 1024 + h * 256);
        float rsc[2][4];
#pragma unroll
        for (int ai = 0; ai < 2; ++ai)
#pragma unroll
            for (int m = 0; m < 4; ++m) { const unsigned rl = (unsigned)(ai * 128 + wr * 64 + m * 16 + fr);
                const f32x4 p0 = *(const f32x4*)(p1u + (rl * 32u + (unsigned)fq * 8u) * 4u), p1 = *(const f32x4*)(p1u + (rl * 32u + (unsigned)fq * 8u + 4u) * 4u);
                float s1 = (p0[0] + p0[1]) + (p0[2] + p0[3]) + (p1[0] + p1[1]) + (p1[2] + p1[3]);
                const f32x2 pq = *(const f32x2*)(pqu + (rl * 32u + (unsigned)fq * 2u) * 4u);
                float sq = pq[0] + pq[1];
                s1 += __shfl_xor(s1, 16); s1 += __shfl_xor(s1, 32); sq += __shfl_xor(sq, 16); sq += __shfl_xor(sq, 32);
                rsc[ai][m] = __builtin_amdgcn_rsqf(sq * (1.f / 512.f) + EPS_ * (s1 * (1.f / 2048.f) + EPS_)) * 1.4426950408889634f;
                float ps = 0.f;
#pragma unroll
                for (int bj = 0; bj < 2; ++bj)
#pragma unroll
                    for (int n = 0; n < 2; ++n)
#pragma unroll
                        for (int e = 0; e < 4; ++e) ps += __builtin_amdgcn_exp2f(fminf(acc[ai][bj][m][n][e] * rsc[ai][m], 100.f));
                ps += __shfl_xor(ps, 16); ps += __shfl_xor(ps, 32);
                if (fq == 0) red[rl * 4 + wc] = ps;
                __builtin_amdgcn_sched_barrier(0); }
        __syncthreads();
        { int ln_ = threadIdx.x; asm volatile("" : "+v"(ln_)); fr = ln_ & 15; fq = (ln_ >> 4) & 3; }
#pragma unroll
        for (int ai = 0; ai < 2; ++ai)
#pragma unroll
            for (int m = 0; m < 4; ++m) { const unsigned rl = (unsigned)(ai * 128 + wr * 64 + m * 16 + fr);
                const f32x4 t = *(const LAS f32x4*)(red + rl * 4); const float inv = __builtin_amdgcn_rcpf((t[0] + t[1]) + (t[2] + t[3])); float rs = rsc[ai][m]; asm volatile("" : "+v"(rs));
#pragma unroll
                for (int bj = 0; bj < 2; ++bj) { float x[8];
#pragma unroll
                    for (int n = 0; n < 2; ++n)
#pragma unroll
                        for (int e = 0; e < 4; ++e) x[n * 4 + e] = __builtin_amdgcn_exp2f(fminf(acc[ai][bj][m][n][e] * rs, 100.f)) * inv;
                    u32x4 w; w.x = pk2(x[0], x[1]); w.y = pk2(x[2], x[3]); w.z = pk2(x[4], x[5]); w.w = pk2(x[6], x[7]);
                    *(u32x4*)(Pu + (rl * 1024u + (unsigned)(bj * 128 + wc * 32 + 8 * fq)) * 2u) = w; } }
        __syncthreads();
    }
};

DI void p8_route(Frame& F, const ArgP& a) {
    LAS float* s_hn = (LAS float*)F.lds; LAS float* s_log = (LAS float*)(F.lds + 131072);
    const float* h2 = (const float*)(F.ws + WS_H2); bf16_t* hn3 = (bf16_t*)(F.ws + WS_HN3);
    int* tok_of = (int*)(F.ws + WS_TOKOF); float* gate_of = (float*)(F.ws + WS_GATEOF); int* tok_e = (int*)(F.ws + WS_TOKE); int* tok_r = (int*)(F.ws + WS_TOKR);
    const float* rw = a.in(I_RW); const float* rb = a.in(I_RB); const float* g3 = a.in(I_GFFN);
    const int lane = F.lane, wave = F.wave, tid = F.tid;
    for (int task = F.vcu; task < NTOK / 16; task += F.G) {
        const int tb = task * 16;
#pragma unroll
        for (int q = 0; q < 2; ++q) { const int tl = 2 * wave + q; const size_t tok = (size_t)(tb + tl);
            const f32x4* xr = (const f32x4*)(h2 + tok * 2048) + lane;
            f32x4 v[8]; float s = 0.f;
#pragma unroll
            for (int j = 0; j < 8; ++j) { v[j] = xr[64 * j]; s += (v[j].x * v[j].x + v[j].y * v[j].y) + (v[j].z * v[j].z + v[j].w * v[j].w); }
            const float rstd = 1.f / sqrtf(wave_sum(s) * (1.f / 2048.f) + EPS_);
            u32x2* o8 = (u32x2*)(hn3 + tok * 2048) + lane;
#pragma unroll
            for (int j = 0; j < 8; ++j) { const f32x4 gg = ((const f32x4*)g3)[lane + 64 * j]; const f32x4 y = v[j] * rstd * gg;
                *(LAS f32x4*)(s_hn + tl * 2048 + (lane + 64 * j) * 4) = y;
                u32x2 o; o.x = pk2(y.x, y.y); o.y = pk2(y.z, y.w); o8[64 * j] = o; } }
        __syncthreads();
        { const int tt = tid >> 5, e = tid & 31; const LAS float* hp = s_hn + tt * 2048; const float* wp = rw + e;
          float acc0 = 0.f, acc1 = 0.f, acc2 = 0.f, acc3 = 0.f;
#pragma unroll 4
          for (int k = 0; k < 2048; k += 4) { const f32x4 hv = *(const LAS f32x4*)(hp + k);
              acc0 = fmaf(hv.x, wp[(size_t)(k + 0) * 32], acc0); acc1 = fmaf(hv.y, wp[(size_t)(k + 1) * 32], acc1);
              acc2 = fmaf(hv.z, wp[(size_t)(k + 2) * 32], acc2); acc3 = fmaf(hv.w, wp[(size_t)(k + 3) * 32], acc3); }
          s_log[tt * 32 + e] = ((acc0 + acc1) + (acc2 + acc3)) + rb[e]; }
        __syncthreads();
        if (tid < 16) { const int tok = tb + tid; unsigned taken = 0u; float val[4]; int idx[4];
#pragma unroll
            for (int k = 0; k < 4; ++k) { float best = -INFINITY; int bi = 0;
                for (int e = 0; e < 32; ++e) { const float v = s_log[tid * 32 + e]; if (!((taken >> e) & 1u) && v > best) { best = v; bi = e; } }
                taken |= 1u << bi; val[k] = best; idx[k] = bi; }
            float ex[4], sum = 0.f;
#pragma unroll
            for (int k = 0; k < 4; ++k) { ex[k] = __expf(val[k] - val[0]); sum += ex[k]; }
#pragma unroll
            for (int k = 0; k < 4; ++k) { const int e = idx[k];
                const unsigned rank = __hip_atomic_fetch_add(F.ctl + CW_CNT + 64 * e, 1u, __ATOMIC_RELAXED, __HIP_MEMORY_SCOPE_AGENT);
                tok_of[e * 8192 + rank] = tok; gate_of[e * 8192 + rank] = ex[k] / sum; tok_e[tok * 4 + k] = e; tok_r[tok * 4 + k] = (int)rank; } }
        __syncthreads();
    }
}

DI void moe_tables(Frame& F) {
    if (F.tid == 0) { unsigned base = 0u;
        for (int e = 0; e < 32; ++e) { const unsigned c = F.ctl[CW_CNT + 64 * e], mt = (c + 255u) >> 8; F.MISC[16 + e] = c; F.MISC[48 + e] = base; F.MISC[80 + e] = mt; base += mt; }
        F.MISC[112] = base; }
    __syncthreads();
}
DI int ldsu(volatile LAS unsigned* p) { return __builtin_amdgcn_readfirstlane((int)*p); }
template <int NTN  >
struct SchedMoe {
    int G, c; const unsigned char* ws; volatile LAS unsigned* MISC;
    DI bool next(int i, pg8::UnitD& u) const {
        const int L = i * G + c; const int total = ldsu(MISC + 112) * NTN; if (L >= total) return false;
        int e = 0;
        for (int k = 0; k < 32; ++k) { if (L >= (ldsu(MISC + 48 + k) + ldsu(MISC + 80 + k)) * NTN) e = k + 1; }
        const int tb = ldsu(MISC + 48 + e), mte = ldsu(MISC + 80 + e), cnt = ldsu(MISC + 16 + e);
        const int local = L - tb * NTN, nt = local / mte, mt = local % mte;
        u.type = 0; u.e = e; u.pn = nt; u.pm = tb + mt; u.x0 = mt; u.lda = 4096u; u.ldb = 4096u;
        if (NTN == 16) { u.A = (const char*)(ws + WS_HN3); u.rows = (const int*)(ws + WS_TOKOF) + e * 8192 + mt * 256; u.nvalid = cnt - mt * 256;
            u.B = (const char*)(ws + WS_W1) + ((size_t)e * 4096 + (size_t)nt * 256) * 4096; }
        else { u.A = (const char*)(ws + WS_ACT) + (size_t)(tb + mt) * 256 * 4096; u.rows = nullptr; u.nvalid = cnt - mt * 256;
            u.B = (const char*)(ws + WS_W2) + ((size_t)e * 2048 + (size_t)nt * 256) * 4096; }
        return true;
    }
};
struct EpiMoe1 {
    static constexpr bool AFTER_DRAIN = false;
    bf16_t* act; const float* b1;
    DI void operator()(const f32x4 (&acc)[2][2][4][2], const pg8::UnitD& u, int wr, int wc, int fr, int fq) const {
        { int ln_ = threadIdx.x; asm volatile("" : "+v"(ln_)); fr = ln_ & 15; fq = (ln_ >> 4) & 3; }
        const int j0 = u.pn * 128 + wc * 32 + 8 * fq;
        const float* bg = b1 + (size_t)u.e * 4096 + j0; const float* bu = bg + 2048;
        const f32x4 bg0 = *(const f32x4*)bg, bg1 = *(const f32x4*)(bg + 4), bu0 = *(const f32x4*)bu, bu1 = *(const f32x4*)(bu + 4);
#pragma unroll
        for (int ai = 0; ai < 2; ++ai)
#pragma unroll
            for (int m = 0; m < 4; ++m) { const size_t row = (size_t)u.pm * 256 + ai * 128 + wr * 64 + m * 16 + fr;
                float o[8];
#pragma unroll
                for (int n = 0; n < 2; ++n)
#pragma unroll
                    for (int e = 0; e < 4; ++e) { const float g = fminf(acc[ai][0][m][n][e] + (n ? bg1[e] : bg0[e]), 7.f);
                        const float uu = fminf(fmaxf(acc[ai][1][m][n][e] + (n ? bu1[e] : bu0[e]), -7.f), 7.f);
                        o[n * 4 + e] = g / (1.f + __expf(-1.702f * g)) * (uu + 1.f); }
                u32x4 w; w.x = pk2(o[0], o[1]); w.y = pk2(o[2], o[3]); w.z = pk2(o[4], o[5]); w.w = pk2(o[6], o[7]);
                *(u32x4*)(act + row * 2048 + j0) = w; }
    }
};
struct EpiMoe2 {
    static constexpr bool AFTER_DRAIN = false;
    bf16_t* y; const float* b2; const float* gate_of;
    DI void operator()(const f32x4 (&acc)[2][2][4][2], const pg8::UnitD& u, int wr, int wc, int fr, int fq) const {
        { int ln_ = threadIdx.x; asm volatile("" : "+v"(ln_)); fr = ln_ & 15; fq = (ln_ >> 4) & 3; }
        const int col0 = u.pn * 256 + wc * 32 + 8 * fq;
        const float* bp = b2 + (size_t)u.e * 2048 + col0;
#pragma unroll
        for (int ai = 0; ai < 2; ++ai)
#pragma unroll
            for (int m = 0; m < 4; ++m) { const int rl = ai * 128 + wr * 64 + m * 16 + fr; const size_t row = (size_t)u.pm * 256 + rl;
                const float gt = (rl < u.nvalid) ? gate_of[u.e * 8192 + u.x0 * 256 + rl] : 0.f;
#pragma unroll
                for (int bj = 0; bj < 2; ++bj) { const f32x4 v0 = (acc[ai][bj][m][0] + *(const f32x4*)(bp + bj * 128)) * gt, v1 = (acc[ai][bj][m][1] + *(const f32x4*)(bp + bj * 128 + 4)) * gt;
                    u32x4 w; w.x = pk2(v0[0], v0[1]); w.y = pk2(v0[2], v0[3]); w.z = pk2(v1[0], v1[1]); w.w = pk2(v1[2], v1[3]);
                    *(u32x4*)(y + row * 2048 + col0 + bj * 128) = w; } }
    }
};

DI void p11_combine(Frame& F, const ArgP& a) {
    const int gw = F.vcu * NWAVES + F.wave, NGW = F.G * NWAVES, lane = F.lane;
    const float* h2 = (const float*)(F.ws + WS_H2); const bf16_t* y = (const bf16_t*)(F.ws + WS_Y);
    const int* tok_e = (const int*)(F.ws + WS_TOKE); const int* tok_r = (const int*)(F.ws + WS_TOKR);
    for (int t = gw; t < NTOK; t += NGW) {
        size_t yrow[4];
#pragma unroll
        for (int k = 0; k < 4; ++k) { const int e = tok_e[t * 4 + k], r = tok_r[t * 4 + k]; yrow[k] = ((size_t)F.MISC[48 + e] * 256 + (size_t)r) * 2048; }
#pragma unroll
        for (int j = 0; j < 8; ++j) { const int c = (lane + 64 * j) * 4;
            f32x4 v = *(const f32x4*)(h2 + (size_t)t * 2048 + c);
#pragma unroll
            for (int k = 0; k < 4; ++k) { const u32x2 w = *(const u32x2*)(y + yrow[k] + c); v.x += bflo(w.x); v.y += bfhi(w.x); v.z += bflo(w.y); v.w += bfhi(w.y); }
            *(f32x4*)(a.out() + (size_t)t * 2048 + c) = v; }
    }
}

#ifndef MK_PER_PHASE
#define MK_PER_PHASE 0
#endif
#ifndef MK_LAST_PHASE
#define MK_LAST_PHASE 12
#endif
constexpr int N_PHASES = MK_LAST_PHASE;

__global__ void __launch_bounds__(NWAVES * 64, 2) mega_fwd(Args args_) {
    const ArgP args{};
    extern __shared__ __attribute__((aligned(16))) unsigned char lds_raw[];
    Frame F;
    F.lds = (LAS unsigned char*)lds_raw;
    F.MISC = (volatile LAS unsigned*)(F.lds + MISC_OFF);
    F.tid = threadIdx.x; F.lane = F.tid & 63; F.wave = __builtin_amdgcn_readfirstlane(F.tid >> 6);
    F.G = gridDim.x; { const int bx = blockIdx.x; F.vcu = (F.G % 8 == 0) ? (bx % 8) * (F.G / 8) + bx / 8 : bx; }
    F.ws = args_.ws; F.ctl = (unsigned*)(args_.ws + WS_CTL);
    for (int u = F.tid; u < 256; u += NWAVES * 64) F.MISC[u] = 0u;
    __syncthreads();
    XcdBarrier bar; bar.bar = F.ctl + CW_BAR; bar.x = 0; bar.st = nullptr;
    const int lo = args_.ph_lo, hi = args_.ph_hi;
    if (hi - lo > 1) bar = xcd_barrier_post(F.ctl + CW_BAR, F.MISC + 8);
#ifndef MK_PHASE_MASK
#define MK_PHASE_MASK 0xFFFF
#endif
#define IN(k) (((MK_PHASE_MASK >> (k)) & 1) && lo <= (k) && (k) < hi)
#define SEAM(k) do { if (IN(k) && IN((k) + 1)) xcd_barrier(bar); } while (0)
#define FRESH() do { int t_ = threadIdx.x; asm volatile("" : "+v"(t_)); F.tid = t_; F.lane = t_ & 63; F.wave = __builtin_amdgcn_readfirstlane(t_ >> 6); } while (0)
    unsigned char* ws = args_.ws;

    if (IN(0)) { FRESH(); p0_prologue(F, args); }
    SEAM(0);
    if (IN(1)) { FRESH();
        SchedP1 S{F.G, F.vcu, ws};
        EpiP1 E{(bf16_t*)(ws + WS_PROJ), (float*)(ws + WS_DT), (bf16_t*)(ws + WS_KVRAW), args.in(I_DAQG), args.in(I_DAKG)};
        pg8::gemm_phase<EpiP1, SchedP1, false, true>(F.lds + RING_OFF, 32, S, E);
    }
    SEAM(1);
    if (IN(2)) { FRESH();
        kprep(F, args);
        for (int u = F.vcu; u < 64; u += F.G) ssd_unit(F, args, u >> 4, u & 15);
        __syncthreads();
        attn_phase_da(F);
    }
    SEAM(2);
    if (IN(3)) { FRESH(); p3_finalize(F, args); }
    SEAM(3);
    if (IN(4)) { FRESH();
        SchedDense S{F.G, F.vcu, 32, 8, (const char*)(ws + WS_YCAT), (const char*)(ws + WS_WOUT), 4096u, 4096u, 1 << 30, 0};
#if MK_LAST_PHASE == 5
        EpiResid E{args.in(I_X), args_.out, nullptr, nullptr};
#else
        EpiResid E{args.in(I_X), (float*)(ws + WS_H1), (bf16_t*)(ws + WS_H1B), (float*)(ws + WS_PART1)};
#endif
        pg8::gemm_phase<EpiResid, SchedDense, false, true>(F.lds + RING_OFF, 32, S, E);
    }
    SEAM(4);
    if (IN(5)) { FRESH();
        SchedDense S{F.G, F.vcu, 32, 8, (const char*)(ws + WS_H1B), (const char*)(ws + WS_WQ), 4096u, 4096u, 1 << 30, 0};
        EpiQ E{(bf16_t*)(ws + WS_QRAW), (float*)(ws + WS_PARTQ)};
        pg8::gemm_phase<EpiQ, SchedDense, false, true>(F.lds + RING_OFF, 32, S, E);
    }
    SEAM(5);
    if (IN(6)) { FRESH();
        SchedXS S{F.G, F.vcu, ws};
        EpiXS E{(bf16_t*)(ws + WS_P), (bf16_t*)(ws + WS_VWT), (const float*)(ws + WS_PART1), (const float*)(ws + WS_PARTQ), (LAS float*)(F.lds + RING_BYTES)};
        pg8::gemm_phase<EpiXS, SchedXS, false, true>(F.lds + RING_OFF, 8, S, E);
    }
    SEAM(6);
    if (IN(7)) { FRESH();
        SchedDense S{F.G, F.vcu, 32, 8, (const char*)(ws + WS_P), (const char*)(ws + WS_VWT), 2048u, 2048u, 8, (size_t)2048 * 1024 * 2};
#if MK_LAST_PHASE == 8
        EpiResid E{(const float*)(ws + WS_H1), args_.out, nullptr, nullptr};
#else
        EpiResid E{(const float*)(ws + WS_H1), (float*)(ws + WS_H2), nullptr, nullptr};
#endif
        pg8::gemm_phase<EpiResid, SchedDense, false, true>(F.lds + RING_OFF, 16, S, E);
    }
    SEAM(7);
    if (IN(8)) { FRESH(); p8_route(F, args); }
    SEAM(8);
    if (IN(9)) { FRESH();
        moe_tables(F);
        SchedMoe<16> S{F.G, F.vcu, ws, F.MISC};
        EpiMoe1 E{(bf16_t*)(ws + WS_ACT), args.in(I_B1)};
        pg8::gemm_phase<EpiMoe1, SchedMoe<16>, true, true>(F.lds + RING_OFF, 32, S, E);
    }
    SEAM(9);
    if (IN(10)) { FRESH();
        moe_tables(F);
        SchedMoe<8> S{F.G, F.vcu, ws, F.MISC};
        EpiMoe2 E{(bf16_t*)(ws + WS_Y), args.in(I_B2), (const float*)(ws + WS_GATEOF)};
        pg8::gemm_phase<EpiMoe2, SchedMoe<8>, false, true>(F.lds + RING_OFF, 32, S, E);
    }
    SEAM(10);
    if (IN(11)) { FRESH(); moe_tables(F); p11_combine(F, args); }
#undef IN
#undef SEAM
}

extern "C" void kernel_launch(void* const* d_in, const int* in_sizes, int n_in, void* d_out, int out_size, void* d_ws, size_t ws_size, hipStream_t stream) {
    static int grid = 0;
    if (grid == 0) {
        if (n_in != 32 || out_size != NTOK * 2048 || ws_size < WS_END) { fprintf(stderr, "kernel_launch: unexpected shapes (n_in %d out %d ws %zu); nothing launched\n", n_in, out_size, ws_size); grid = -1; return; }
        int dev = 0, cus = 0, per_cu = 0;
        if (hipGetDevice(&dev) != hipSuccess || hipDeviceGetAttribute(&cus, hipDeviceAttributeMultiprocessorCount, dev) != hipSuccess) { grid = -1; return; }
        if (hipFuncSetAttribute((const void*)mega_fwd, hipFuncAttributeMaxDynamicSharedMemorySize, LDS_BYTES) != hipSuccess) { fprintf(stderr, "kernel_launch: hipFuncSetAttribute failed\n"); grid = -1; return; }
        if (hipOccupancyMaxActiveBlocksPerMultiprocessor(&per_cu, (const void*)mega_fwd, NWAVES * 64, LDS_BYTES) != hipSuccess || per_cu < 1) { fprintf(stderr, "kernel_launch: occupancy query says %d\n", per_cu); }
        (void)hipGetLastError();
        if (cus < 256) { fprintf(stderr, "kernel_launch: needs 256 CUs, found %d; nothing launched\n", cus); grid = -1; return; }
        grid = 256;
    }
    if (grid < 0) return;
    if (hipMemsetAsync((char*)d_ws + WS_CTL, 0, CTL_ZERO_BYTES, stream) != hipSuccess) return;
    Args a{};
    for (int i = 0; i < 32; ++i) a.in[i] = (const float*)d_in[i];
    a.out = (float*)d_out; a.ws = (unsigned char*)d_ws;
#if MK_PER_PHASE
    for (int p = 0; p < N_PHASES; ++p) { a.ph_lo = p; a.ph_hi = p + 1; hipLaunchKernelGGL(mega_fwd, dim3(grid), dim3(NWAVES * 64), LDS_BYTES, stream, a); }
#else
    a.ph_lo = 0; a.ph_hi = N_PHASES;
    hipLaunchKernelGGL(mega_fwd, dim3(grid), dim3(NWAVES * 64), LDS_BYTES, stream, a);
#endif
}
```

```cpp
#define MK_PER_PHASE 0
#define MK_LAST_PHASE 12
#define MK_PHASE_MASK 0xfff
#include <hip/hip_runtime.h>
#include <hip/hip_bf16.h>
#include <cstdio>
#include <cstdint>
#include <cmath>

#define GAS __attribute__((address_space(1)))
#define LAS __attribute__((address_space(3)))
typedef unsigned short bf16_t;
typedef short bf16x8 __attribute__((ext_vector_type(8)));
typedef float f32x2 __attribute__((ext_vector_type(2)));
typedef float f32x4 __attribute__((ext_vector_type(4)));
typedef float f32x16 __attribute__((ext_vector_type(16)));
typedef unsigned u32x2 __attribute__((ext_vector_type(2)));
typedef unsigned u32x4 __attribute__((ext_vector_type(4)));
typedef __bf16 bf16x2_t __attribute__((ext_vector_type(2)));

#define DI __device__ __forceinline__
DI unsigned pk2(float lo, float hi) { f32x2 v = {lo, hi}; bf16x2_t b = __builtin_convertvector(v, bf16x2_t); return __builtin_bit_cast(unsigned, b); }
DI float bflo(unsigned u) { return __uint_as_float(u << 16); }
DI float bfhi(unsigned u) { return __uint_as_float(u & 0xffff0000u); }
DI float bf2f(bf16_t h) { return __uint_as_float(((unsigned)h) << 16); }
DI float wave_sum(float v) {
#pragma unroll
    for (int o = 1; o < 64; o <<= 1) v += __shfl_xor(v, o);
    return v;
}
DI float siluf(float x) { return x / (1.f + __expf(-x)); }

constexpr int DM_ = 2048, NB = 4, SEQ_ = 2048, NTOK = NB * SEQ_;
constexpr int PP = 5632;
constexpr int PC_XBC = 1024, PC_Q = 2560, PC_K = 3584, PC_V = 4608, PC_DT = 5632;
constexpr int WIN_ROWS = 5888;
constexpr int NEXP = 32, MEMLEN = 256;
constexpr float EPS_ = 1e-6f;
constexpr float LAM_INIT = 0.2f;

namespace pg8 {
constexpr int BM = 256, BK = 64, HALF = 128, HTB = HALF * BK * 2  , STAGE_BYTES = 8 * HTB;
DI int lds_byte(int r, int c) { const int st = (r >> 4) * 2 + (c >> 5), rr = r & 15, cc = c & 31, ob = rr * 64 + cc * 2; return st * 1024 + (ob ^ (((ob >> 9) & 1) << 5)); }
DI void stage_rc(int b, int& R, int& C) { const int st = b / 1024, sb = b % 1024, swz = sb ^ (((sb >> 9) & 1) << 5); R = (st >> 1) * 16 + swz / 64; C = (st & 1) * 32 + (swz % 64) / 2; }
DI int perm32(int rho) { const int n = rho >> 4, i = rho & 15; return 8 * (i >> 2) + 4 * n + (i & 3); }

struct UnitD {
    const char* A; const char* B;
    const int* rows;
    unsigned lda, ldb;
    int nvalid;
    int type, pm, pn, e, x0;
};
typedef int v8i_t __attribute__((ext_vector_type(8)));
DI v8i_t cat8(bf16x8 lo, bf16x8 hi) { typedef int v4i_t __attribute__((ext_vector_type(4))); const v4i_t a = __builtin_bit_cast(v4i_t, lo), b = __builtin_bit_cast(v4i_t, hi); return (v8i_t){a[0], a[1], a[2], a[3], b[0], b[1], b[2], b[3]}; }
DI void dense_voff(unsigned lda, unsigned ldb, int tid, unsigned (&vA)[2], unsigned (&vB)[2]) {
#pragma unroll
    for (int i = 0; i < 2; ++i) { int R, C; stage_rc(tid * 16 + i * 8192, R, C); const int Rb = (R & ~31) + perm32(R & 31);
        vA[i] = (unsigned)R * lda + (unsigned)C * 2u; vB[i] = (unsigned)Rb * ldb + (unsigned)C * 2u; }
}
DI void gather_voff(const UnitD& u, int tid, unsigned (&gA)[2][2]) {
#pragma unroll
    for (int i = 0; i < 2; ++i) { int R, C; stage_rc(tid * 16 + i * 8192, R, C);
#pragma unroll
        for (int h = 0; h < 2; ++h) { const int ra = h * 128 + R; const unsigned rowA = (ra < u.nvalid) ? (unsigned)u.rows[ra] : 0u; gA[h][i] = rowA * u.lda + (unsigned)C * 2u; } }
}

template <class Epi, class Sched, bool GATHER, bool ALIGN_EPI, bool FP8 = false>
DI void gemm_phase(LAS unsigned char* lds, int nt, const Sched& S, const Epi& E) {

    const int tid = threadIdx.x, wid = __builtin_amdgcn_readfirstlane(tid >> 6), lane = tid & 63, wr = wid >> 2, wc = wid & 3, fr = lane & 15, fq = lane >> 4;
    const size_t kstep = (size_t)(BK * 2);
    const unsigned ldsb = (unsigned)__builtin_amdgcn_readfirstlane((int)((unsigned)(uintptr_t)lds + (unsigned)wid * 1024u));
    const int aoff = lds_byte(wr * 64 + fr, fq * 8), boff = lds_byte(wc * 32 + fr, fq * 8);
#define PG8_SA(b, h) (((b) * 2 + (h)) * HTB)
#define PG8_SB(b, h) ((4 + (b) * 2 + (h)) * HTB)
#define PG8_STAGE(bufoff, gbase, voff) do { _Pragma("unroll") for (int _i = 0; _i < 2; ++_i) { unsigned keep_; \
        asm volatile("s_mov_b32 %0, m0\n\ts_mov_b32 m0, %3\n\ts_nop 0\n\tglobal_load_lds_dwordx4 %1, %2\n\ts_mov_b32 m0, %0" \
                     : "=&s"(keep_) : "v"((voff)[_i]), "s"((const char*)(gbase)), "s"(ldsb + (unsigned)((bufoff) + _i * 8192)) : "memory"); } } while (0)
#define PG8_STA(bufoff, gbase, h, HS, GA) do { if constexpr (GATHER) { PG8_STAGE(bufoff, gbase, GA[h]); } else { PG8_STAGE(bufoff, (gbase) + (h) * (HS), vA); } } while (0)
#define PG8_STB(bufoff, gbase, h, HS) PG8_STAGE(bufoff, (gbase) + (h) * (HS), vB)
typedef int v4i_t __attribute__((ext_vector_type(4)));
#define PG8_LDA(dst, b, h) do { _Pragma("unroll") for (int m = 0; m < 4; ++m) { if constexpr (FP8) { \
            const v4i_t lo_ = *(const LAS v4i_t*)(lds + PG8_SA(b, h) + aoff + m * 2048), hi_ = *(const LAS v4i_t*)(lds + PG8_SA(b, h) + aoff + m * 2048 + 1024); \
            dst##8[m] = __builtin_shufflevector(lo_, hi_, 0, 1, 2, 3, 4, 5, 6, 7); } \
        else { _Pragma("unroll") for (int k = 0; k < 2; ++k) dst[m][k] = *(const LAS bf16x8*)(lds + PG8_SA(b, h) + aoff + m * 2048 + k * 1024); } } } while (0)
#define PG8_LDB(dst, b, h) do { _Pragma("unroll") for (int n = 0; n < 2; ++n) { if constexpr (FP8) { \
            const v4i_t lo_ = *(const LAS v4i_t*)(lds + PG8_SB(b, h) + boff + n * 2048), hi_ = *(const LAS v4i_t*)(lds + PG8_SB(b, h) + boff + n * 2048 + 1024); \
            dst##8[n] = __builtin_shufflevector(lo_, hi_, 0, 1, 2, 3, 4, 5, 6, 7); } \
        else { _Pragma("unroll") for (int k = 0; k < 2; ++k) dst[n][k] = *(const LAS bf16x8*)(lds + PG8_SB(b, h) + boff + n * 2048 + k * 1024); } } } while (0)
#define PG8_MMA(ai, bj, At, Bt) do { __builtin_amdgcn_s_setprio(1); _Pragma("unroll") for (int m = 0; m < 4; ++m) _Pragma("unroll") for (int n = 0; n < 2; ++n) { \
        if constexpr (FP8) { acc[ai][bj][m][n] = __builtin_amdgcn_mfma_scale_f32_16x16x128_f8f6f4(Bt##8[n], At##8[m], acc[ai][bj][m][n], 0, 0, 0, 0x7f7f7f7f, 0, 0x7f7f7f7f); } \
        else { _Pragma("unroll") for (int k = 0; k < 2; ++k) acc[ai][bj][m][n] = __builtin_amdgcn_mfma_f32_16x16x32_bf16(Bt[n][k], At[m][k], acc[ai][bj][m][n], 0, 0, 0); } } \
        __builtin_amdgcn_s_setprio(0); } while (0)
#define PG8_WAIT_V(n) asm volatile("s_waitcnt vmcnt(" #n ")" ::: "memory")
#define PG8_WAIT_L(n) asm volatile("s_waitcnt lgkmcnt(" #n ")" ::: "memory")
#define PG8_BAR __builtin_amdgcn_s_barrier()
#define PG8_SCHED __builtin_amdgcn_sched_barrier(0)
#define PG8_ITER(A1P, A2P, B2P, HA2, HB2, GA2) do { \
        const char* a3p_ = (A2P) + kstep; const char* b3p_ = (B2P) + kstep; \
        PG8_LDB(B0, 0, 0); PG8_LDB(B1, 0, 1); PG8_SCHED; PG8_LDA(At, 0, 0); PG8_STA(PG8_SA(1, 1), (A1P), 1, hsA, gA); \
        PG8_WAIT_V(8); PG8_WAIT_L(0); PG8_BAR; PG8_MMA(0, 0, At, B0); PG8_MMA(0, 1, At, B1); PG8_BAR; PG8_SCHED; \
        PG8_LDA(At, 0, 1); PG8_STB(PG8_SB(0, 0), (B2P), 0, HB2); PG8_STB(PG8_SB(0, 1), (B2P), 1, HB2); PG8_STA(PG8_SA(0, 0), (A2P), 0, HA2, GA2); \
        PG8_WAIT_V(8); PG8_WAIT_L(0); PG8_BAR; PG8_MMA(1, 0, At, B0); PG8_MMA(1, 1, At, B1); PG8_BAR; PG8_SCHED; \
        PG8_LDB(B0, 1, 0); PG8_LDB(B1, 1, 1); PG8_SCHED; PG8_LDA(At, 1, 0); PG8_STA(PG8_SA(0, 1), (A2P), 1, HA2, GA2); \
        PG8_WAIT_V(8); PG8_WAIT_L(0); PG8_BAR; PG8_MMA(0, 0, At, B0); PG8_MMA(0, 1, At, B1); PG8_BAR; PG8_SCHED; \
        PG8_LDA(At, 1, 1); PG8_STB(PG8_SB(1, 0), b3p_, 0, HB2); PG8_STB(PG8_SB(1, 1), b3p_, 1, HB2); PG8_STA(PG8_SA(1, 0), a3p_, 0, HA2, GA2); \
        PG8_WAIT_V(8); PG8_WAIT_L(0); PG8_BAR; PG8_MMA(1, 0, At, B0); PG8_MMA(1, 1, At, B1); PG8_BAR; PG8_SCHED; \
    } while (0)
    UnitD cur, nxt; int ui = 0;
    if (!S.next(0, cur)) return;
    f32x4 acc[2][2][4][2];
#pragma unroll
    for (int a = 0; a < 2; ++a)
#pragma unroll
        for (int b = 0; b < 2; ++b)
#pragma unroll
            for (int m = 0; m < 4; ++m)
#pragma unroll
                for (int n = 0; n < 2; ++n) acc[a][b][m][n] = (f32x4){0.f, 0.f, 0.f, 0.f};
    bf16x8 At[4][2], B0[2][2], B1[2][2]; v8i_t At8[4], B08[2], B18[2];
    unsigned vA[2], vB[2], gA[2][2], ngA[2][2];
    dense_voff(cur.lda, cur.ldb, tid, vA, vB);
    if constexpr (GATHER) gather_voff(cur, tid, gA);
    const char* cA = cur.A; const char* cB = cur.B;
    size_t hsA = GATHER ? 0 : (size_t)cur.lda * HALF, hsB = (size_t)cur.ldb * HALF;
    PG8_STB(PG8_SB(0, 0), cB, 0, hsB); PG8_STB(PG8_SB(0, 1), cB, 1, hsB); PG8_STA(PG8_SA(0, 0), cA, 0, hsA, gA); PG8_STA(PG8_SA(0, 1), cA, 1, hsA, gA);
    if (wr == 1) PG8_BAR;
    PG8_WAIT_V(2); PG8_BAR;
    PG8_STB(PG8_SB(1, 0), cB + kstep, 0, hsB); PG8_STA(PG8_SA(1, 0), cA + kstep, 0, hsA, gA); PG8_STB(PG8_SB(1, 1), cB + kstep, 1, hsB);
    PG8_WAIT_V(6); PG8_BAR;
    for (;;) {
        const bool has_next = S.next(ui + 1, nxt);
        const char* nA = cA; const char* nB = cB; size_t nhsA = hsA, nhsB = hsB;
        if (has_next) { nA = nxt.A; nB = nxt.B; nhsA = GATHER ? 0 : (size_t)nxt.lda * HALF; nhsB = (size_t)nxt.ldb * HALF; }
        if constexpr (GATHER) {
            if (has_next) gather_voff(nxt, tid, ngA);
            else {
#pragma unroll
                for (int h = 0; h < 2; ++h)
#pragma unroll
                    for (int i = 0; i < 2; ++i) ngA[h][i] = gA[h][i];
            }
        }
        for (int t = 0; t < nt; t += 2) {
            const bool last = (t == nt - 2);
            const char* a2 = last ? nA : cA + (size_t)(t + 2) * kstep; const char* b2 = last ? nB : cB + (size_t)(t + 2) * kstep;
            const size_t hA2 = last ? nhsA : hsA, hB2 = last ? nhsB : hsB;
            unsigned g2[2][2];
            if constexpr (GATHER) {
#pragma unroll
                for (int h = 0; h < 2; ++h)
#pragma unroll
                    for (int i = 0; i < 2; ++i) g2[h][i] = last ? ngA[h][i] : gA[h][i];
            }
            PG8_ITER(cA + (size_t)(t + 1) * kstep, a2, b2, hA2, hB2, g2);
        }
        if constexpr (ALIGN_EPI) { if (wr == 0) PG8_BAR; }
        if constexpr (!Epi::AFTER_DRAIN) { E(acc, cur, wr, wc, fr, fq); }
        if (!has_next) break;
#pragma unroll
        for (int a = 0; a < 2; ++a)
#pragma unroll
            for (int b = 0; b < 2; ++b)
#pragma unroll
                for (int m = 0; m < 4; ++m)
#pragma unroll
                    for (int n = 0; n < 2; ++n) acc[a][b][m][n] = (f32x4){0.f, 0.f, 0.f, 0.f};
        cur = nxt; cA = nA; cB = nB; hsA = nhsA; hsB = nhsB; ++ui;
        if constexpr (GATHER) {
#pragma unroll
            for (int h = 0; h < 2; ++h)
#pragma unroll
                for (int i = 0; i < 2; ++i) gA[h][i] = ngA[h][i];
        }
        if constexpr (ALIGN_EPI) { if (wr == 1) PG8_BAR; }
    }
    PG8_WAIT_V(0);
    if constexpr (!ALIGN_EPI) { if (wr == 0) PG8_BAR; }
    PG8_BAR;
    if constexpr (Epi::AFTER_DRAIN) { E.fused(acc, cur, wr, wc, fr, fq, lds, wid, lane); }
#undef PG8_SA
#undef PG8_SB
#undef PG8_STAGE
#undef PG8_STA
#undef PG8_STB
#undef PG8_LDA
#undef PG8_LDB
#undef PG8_MMA
#undef PG8_WAIT_V
#undef PG8_WAIT_L
#undef PG8_BAR
#undef PG8_SCHED
#undef PG8_ITER
}
}
namespace attn_body {
using bf16=__hip_bfloat16;
using bf16x8=__attribute__((ext_vector_type(8)))short;
using s16x4=__attribute__((ext_vector_type(4)))short;
using f32x16=__attribute__((ext_vector_type(16)))float;
using u32x4=__attribute__((ext_vector_type(4)))unsigned;
constexpr int BATCH=4,SEQ=2048,D=64,DM=5632,OPITCH=1024;
constexpr int NW=8,QBLK=32,QB=QBLK*NW,KVBLK=64,NQB=SEQ/QB;
constexpr int ATTN_UNIT_ROWS=QB;
__device__ __forceinline__ int crow(int r,int hi){return (r&3)+8*(r>>2)+4*hi;}
#define SBAR() __builtin_amdgcn_sched_barrier(0)
__device__ __forceinline__ void cmask(f32x16&p0,f32x16&p1,int jb,int qrel,int hi){
  const float NEG=-INFINITY; int kb=64*jb+4*hi;
  #pragma unroll
  for(int r=0;r<16;++r){int kv=kb+(r&3)+8*(r>>2); if(kv>qrel)p0[r]=NEG; if(kv+32>qrel)p1[r]=NEG;}
}

constexpr int NSLOT=3, SLOTB=8192;
constexpr int LDS_K=0, LDS_V=NSLOT*SLOTB, LDS_WS=2*NSLOT*SLOTB, LDS_OST=LDS_WS+NW*64*4, LDS_BYTES=LDS_OST+NW*4096;
constexpr float C2=0.125f*1.4426950408889634f;
__device__ __forceinline__ void glds16(const void*gsrc,unsigned lds_dst){unsigned keep;
  asm volatile("s_mov_b32 %0, m0\n\ts_mov_b32 m0, %2\n\ts_nop 0\n\tglobal_load_lds_dwordx4 %1, off\n\ts_mov_b32 m0, %0":"=&s"(keep):"v"(gsrc),"s"(lds_dst):"memory");}
__device__ __forceinline__ float max3f(float a,float b,float c){float r;asm("v_max3_f32 %0, %1, %2, %3":"=v"(r):"v"(a),"v"(b),"v"(c));return r;}
__device__ __forceinline__ float max2f(float a,float b){float r;asm("v_max_f32_e32 %0, %1, %2":"=v"(r):"v"(a),"v"(b));return r;}
__device__ __forceinline__ float fadd_s(float a,float b){float r;asm("v_add_f32_e32 %0, %1, %2":"=v"(r):"v"(a),"v"(b));return r;}
__device__ __forceinline__ float fsub_s(float a,float b){float r;asm("v_sub_f32_e32 %0, %1, %2":"=v"(r):"v"(a),"v"(b));return r;}
typedef float f32x2_t __attribute__((ext_vector_type(2))); typedef __bf16 bf16x2_t __attribute__((ext_vector_type(2)));
__device__ __forceinline__ unsigned cvtpk_s(float lo,float hi){f32x2_t v={lo,hi};bf16x2_t b=__builtin_convertvector(v,bf16x2_t);return __builtin_bit_cast(unsigned,b);}
#define WAIT_BAR(N) asm volatile("s_waitcnt vmcnt(" #N ") lgkmcnt(0)\n\ts_barrier":::"memory")

__device__ __forceinline__ void qkt(f32x16&p0,f32x16&p1,const char*Kslot,const bf16x8*qr,const f32x16&negm,int r32,int hi){
  const char*kb=Kslot+hi*1024+r32*16;
  #pragma unroll
  for(int d0=0;d0<4;++d0){
    const bf16x8 b0=*reinterpret_cast<const bf16x8*>(kb+d0*2048);
    const bf16x8 b1=*reinterpret_cast<const bf16x8*>(kb+d0*2048+512);
    if(d0==0){p0=__builtin_amdgcn_mfma_f32_32x32x16_bf16(b0,qr[0],negm,0,0,0);p1=__builtin_amdgcn_mfma_f32_32x32x16_bf16(b1,qr[0],negm,0,0,0);}
    else{p0=__builtin_amdgcn_mfma_f32_32x32x16_bf16(b0,qr[d0],p0,0,0,0);p1=__builtin_amdgcn_mfma_f32_32x32x16_bf16(b1,qr[d0],p1,0,0,0);}}
}
typedef __attribute__((address_space(3))) const char* lds_cptr;
typedef short v4i16_t __attribute__((ext_vector_type(4)));
__device__ __forceinline__ void kload8(bf16x8*kf,lds_cptr kp){
  kf[0]=*(const __attribute__((address_space(3))) bf16x8*)(kp);      kf[1]=*(const __attribute__((address_space(3))) bf16x8*)(kp+512);
  kf[2]=*(const __attribute__((address_space(3))) bf16x8*)(kp+2048); kf[3]=*(const __attribute__((address_space(3))) bf16x8*)(kp+2560);
  kf[4]=*(const __attribute__((address_space(3))) bf16x8*)(kp+4096); kf[5]=*(const __attribute__((address_space(3))) bf16x8*)(kp+4608);
  kf[6]=*(const __attribute__((address_space(3))) bf16x8*)(kp+6144); kf[7]=*(const __attribute__((address_space(3))) bf16x8*)(kp+6656);
}
__device__ __forceinline__ void kload2(bf16x8*kf,lds_cptr kp,int j){ kf[2*j]=*(const __attribute__((address_space(3))) bf16x8*)(kp+j*2048); kf[2*j+1]=*(const __attribute__((address_space(3))) bf16x8*)(kp+j*2048+512); }
__device__ __forceinline__ s16x4 vtr(lds_cptr p){ return __builtin_bit_cast(s16x4,__builtin_amdgcn_ds_read_tr16_b64_v4i16((__attribute__((address_space(3))) v4i16_t*)p)); }
__device__ __forceinline__ float rowmax(const f32x16&p0,const f32x16&p1){
  float a=max3f(p0[0],p0[1],p1[0]),b=max3f(p0[2],p0[3],p1[1]);a=max3f(a,p1[2],p1[3]);
  #pragma unroll
  for(int r=4;r<16;r+=4){a=max3f(a,p0[r],p0[r+1]);b=max3f(b,p0[r+2],p0[r+3]);a=max3f(a,p1[r],p1[r+1]);b=max3f(b,p1[r+2],p1[r+3]);}
  const float m=max2f(a,b);
  auto rr=__builtin_amdgcn_permlane32_swap(__float_as_uint(m),__float_as_uint(m),false,false);
  return max2f(__uint_as_float(rr[0]),__uint_as_float(rr[1]));
}
__device__ __forceinline__ void pv(f32x16*o,int vb,bf16x8 pa0,bf16x8 pa1,bf16x8 pa2,bf16x8 pa3){
  #pragma unroll
  for(int d0=0;d0<2;++d0){s16x4 lo[4],hi[4];
    #pragma unroll
    for(int ks=0;ks<4;++ks){
      asm volatile("ds_read_b64_tr_b16 %0,%1 offset:%c2":"=&v"(lo[ks]):"v"(vb),"i"(d0*4096+ks*1024):"memory");
      asm volatile("ds_read_b64_tr_b16 %0,%1 offset:%c2":"=&v"(hi[ks]):"v"(vb),"i"(d0*4096+ks*1024+512):"memory");}
    asm volatile("s_waitcnt lgkmcnt(0)":::"memory");SBAR();
    #define PK(k) (bf16x8){lo[k][0],lo[k][1],lo[k][2],lo[k][3],hi[k][0],hi[k][1],hi[k][2],hi[k][3]}
    o[d0]=__builtin_amdgcn_mfma_f32_32x32x16_bf16(pa0,PK(0),o[d0],0,0,0);
    o[d0]=__builtin_amdgcn_mfma_f32_32x32x16_bf16(pa1,PK(1),o[d0],0,0,0);
    o[d0]=__builtin_amdgcn_mfma_f32_32x32x16_bf16(pa2,PK(2),o[d0],0,0,0);
    o[d0]=__builtin_amdgcn_mfma_f32_32x32x16_bf16(pa3,PK(3),o[d0],0,0,0);
    #undef PK
  }
}

#ifndef ATTN_STORE16
#define ATTN_STORE16(p,v) (*(u32x4*)(p)=(v))
#endif
template<int THRL> __device__ __forceinline__ void attn_unit(int b,int qcol,int vcol,int ocol,int qb,const bf16*Q,const bf16*__restrict__ K,const bf16*__restrict__ V,bf16*O,char*shm){
  const int tid=threadIdx.x,lane=tid&63,r32=lane&31,hi=lane>>5; const int wid=__builtin_amdgcn_readfirstlane(tid>>6);
  const long rowbase=(long)b*SEQ; const int q0=qb*QB;
  const bf16*Qw=Q+(rowbase+q0+wid*QBLK)*DM+qcol;
  const bf16*Kh=K+rowbase*DM+qcol,*Vh=V+rowbase*DM+vcol;
  const unsigned lds0=(unsigned)(uintptr_t)shm;
  float*wsf=(float*)(shm+LDS_WS)+wid*64;
  const bf16*ksrc=Kh+(long)lane*DM+wid*8;
  const bf16*vsrc=Vh+(long)(16*(wid&3)+(lane>>2))*DM+(wid>>2)*32+(lane&3)*8;
  const unsigned kdst=lds0+LDS_K+wid*1024, vdst=lds0+LDS_V+wid*1024;
  #define DMA_K(t,slot) glds16(ksrc+(long)(t)*KVBLK*DM,(unsigned)__builtin_amdgcn_readfirstlane(kdst+(slot)))
  #define DMA_V(t,slot) glds16(vsrc+(long)(t)*KVBLK*DM,(unsigned)__builtin_amdgcn_readfirstlane(vdst+(slot)))
  const int vb0=(int)(lds0+LDS_V)+((lane>>4)&1)*32+(lane&3)*8+(4*hi+((lane&15)>>2))*64;
  const char*Kbase=shm+LDS_K; bf16x8 kf[8];
  const lds_cptr shm3=(lds_cptr)shm; const lds_cptr kp0=shm3+LDS_K+hi*1024+r32*16; const lds_cptr vp0=shm3+LDS_V+((lane>>4)&1)*32+(lane&3)*8+(4*hi+((lane&15)>>2))*64;
  const int NT=(q0+QB)/KVBLK;
  DMA_K(0,0);DMA_V(0,0);DMA_K(1,SLOTB);
  bf16x8 qr[4];
  #pragma unroll
  for(int d0=0;d0<4;++d0)qr[d0]=*reinterpret_cast<const bf16x8*>(&Qw[(long)r32*DM+d0*16+hi*8]);
  float mhat=0.f,l_reg=0.f;f32x16 o[2];o[0]=f32x16{};o[1]=f32x16{};f32x16 negm=f32x16{};asm volatile("":"+v"(negm));
  const int qrel=wid*QBLK+r32;
  #define CMASK(P0,P1,t) do{int jb_=(t)-(NT-4); if(jb_>=0)cmask(P0,P1,jb_,qrel,hi);}while(0)
  bool resc=false;
  #define START(P0,P1) do{ const float rm=rowmax(P0,P1); resc=false; \
    { const float dl=rm; mhat=fadd_s(mhat,dl); \
      _Pragma("unroll") for(int r=0;r<16;++r){P0[r]=fsub_s(P0[r],dl);P1[r]=fsub_s(P1[r],dl);} \
      _Pragma("unroll") for(int r=0;r<16;++r)negm[r]=-mhat; asm volatile("":"+v"(negm)); } \
    _Pragma("unroll") for(int r=0;r<16;++r)P0[r]=__builtin_amdgcn_exp2f(P0[r]); }while(0)
  #define RESC() do{ if(resc){ asm volatile("s_waitcnt lgkmcnt(0)":::"memory"); \
      _Pragma("unroll") for(int d_=0;d_<2;++d_) _Pragma("unroll") for(int r=0;r<16;++r)o[d_][r]*=wsf[crow(r,hi)]; } }while(0)
  f32x16 pA0,pA1,pB0,pB1;
  int sl_prev=0,sl_cur=0,sl_next=SLOTB;
  #define ROT() do{sl_prev=sl_cur;sl_cur=sl_next;sl_next=(sl_next==(NSLOT-1)*SLOTB)?0:sl_next+SLOTB;}while(0)
  DMA_K(2,2*SLOTB);
  WAIT_BAR(3);
  qkt(pA0,pA1,Kbase,qr,negm,r32,hi);asm volatile("s_nop 15\n\ts_nop 7":"+v"(pA0),"+v"(pA1));CMASK(pA0,pA1,0);
  START(pA0,pA1);
  _Pragma("unroll") for(int r=0;r<16;++r)pA1[r]=__builtin_amdgcn_exp2f(pA1[r]);
  WAIT_BAR(0);
  DMA_K(3,0);DMA_V(1,SLOTB);
  ROT();
  kload8(kf,kp0+sl_cur);
  WAIT_BAR(2);
  s16x4 vlo[8],vhi[8]; u32x4 pw0,pw1,pw2,pw3;
  #define PKW(P,B) cvtpk_s(P[B],P[B+1])
  #define PAF(k) __builtin_bit_cast(bf16x8,pw##k)
  #define VFR(i) (bf16x8){vlo[i][0],vlo[i][1],vlo[i][2],vlo[i][3],vhi[i][0],vhi[i][1],vhi[i][2],vhi[i][3]}
  #define PIN(x) asm volatile("":"+v"(x))
  #define MX3(a,b,c) __builtin_fmaxf(__builtin_fmaxf((a),(b)),(c))
  #define GAPA(MF,A0,A1,A2,A3,W0,W1,PW) do{ MF; sacc+=A0; sacc+=A1; sacc+=A2; sacc+=A3; PIN(sacc); W0; W1; PIN(PW); SBAR(); }while(0)
  #define EX(v) __builtin_amdgcn_exp2f(v)
  #define GAPB(MF,X,B) do{ MF; X[B]=EX(X[B]); X[B+1]=EX(X[B+1]); X[B+2]=EX(X[B+2]); X[B+3]=EX(X[B+3]); PIN(X); SBAR(); }while(0)
  #define VRD(i) do{ vlo[i]=vtr(vp_+(((i)>>2)*4096+((i)&3)*1024)); vhi[i]=vtr(vp_+(((i)>>2)*4096+((i)&3)*1024+512)); }while(0)
  #define KRD(G,j) do{ if(G){ kload2(kf,kp0+sl_next,j); SBAR(); } }while(0)
  #define STEP(C0,C1,P0,P1,t,GK,GV,GL) do{ SBAR(); \
    const lds_cptr vp_=vp0+sl_prev; \
    VRD(0); SBAR(); float sacc=(P0[0]+P0[1]); \
    GAPA(C0=__builtin_amdgcn_mfma_f32_32x32x16_bf16(kf[0],qr[0],negm,0,0,0), P0[2],P0[3],P0[4],P0[5],     pw0[0]=PKW(P0,0), pw0[1]=PKW(P0,2), pw0); \
    VRD(4); SBAR(); GAPA(C1=__builtin_amdgcn_mfma_f32_32x32x16_bf16(kf[1],qr[0],negm,0,0,0), P0[6],P0[7],P0[8],P0[9],     pw0[2]=PKW(P0,4), pw0[3]=PKW(P0,6), pw0); \
    VRD(1); SBAR(); GAPA(C0=__builtin_amdgcn_mfma_f32_32x32x16_bf16(kf[2],qr[1],C0,0,0,0),   P0[10],P0[11],P0[12],P0[13], pw1[0]=PKW(P0,8), pw1[1]=PKW(P0,10), pw1); \
    VRD(5); SBAR(); GAPA(C1=__builtin_amdgcn_mfma_f32_32x32x16_bf16(kf[3],qr[1],C1,0,0,0),   P0[14],P0[15],P1[0],P1[1],   pw1[2]=PKW(P0,12),pw1[3]=PKW(P0,14), pw1); \
    VRD(2); SBAR(); GAPA(C0=__builtin_amdgcn_mfma_f32_32x32x16_bf16(kf[4],qr[2],C0,0,0,0),   P1[2],P1[3],P1[4],P1[5],     pw2[0]=PKW(P1,0), pw2[1]=PKW(P1,2), pw2); \
    VRD(6); SBAR(); GAPA(C1=__builtin_amdgcn_mfma_f32_32x32x16_bf16(kf[5],qr[2],C1,0,0,0),   P1[6],P1[7],P1[8],P1[9],     pw2[2]=PKW(P1,4), pw2[3]=PKW(P1,6), pw2); \
    VRD(3); SBAR(); GAPA(C0=__builtin_amdgcn_mfma_f32_32x32x16_bf16(kf[6],qr[3],C0,0,0,0),   P1[10],P1[11],P1[12],P1[13], pw3[0]=PKW(P1,8), pw3[1]=PKW(P1,10), pw3); \
    VRD(7); SBAR(); GAPA(C1=__builtin_amdgcn_mfma_f32_32x32x16_bf16(kf[7],qr[3],C1,0,0,0),   P1[14],P1[15],0.f,0.f,       pw3[2]=PKW(P1,12),pw3[3]=PKW(P1,14), pw3); \
    l_reg+=sacc; \
    if(GK){DMA_K((t)+3,sl_cur);} if(GV){DMA_V((t)+1,sl_next);} \
    CMASK(C0,C1,t); \
    { float a=MX3(C0[0],C0[1],C1[0]),b=MX3(C0[2],C0[3],C1[1]); a=MX3(a,C1[2],C1[3]); \
      _Pragma("unroll") for(int r=4;r<16;r+=4){a=MX3(a,C0[r],C0[r+1]);b=MX3(b,C0[r+2],C0[r+3]);a=MX3(a,C1[r],C1[r+1]);b=MX3(b,C1[r+2],C1[r+3]);} \
      float rm=__builtin_fmaxf(a,b); { auto rr=__builtin_amdgcn_permlane32_swap(__float_as_uint(rm),__float_as_uint(rm),false,false); rm=__builtin_fmaxf(__uint_as_float(rr[0]),__uint_as_float(rr[1])); } \
      resc=false; \
      if(__builtin_expect(__any(rm>(float)THRL),0)){ const float dl=__builtin_fmaxf(rm,0.f); mhat+=dl; \
        _Pragma("unroll") for(int r=0;r<16;++r){C0[r]-=dl;C1[r]-=dl;} \
        _Pragma("unroll") for(int r=0;r<16;++r)negm[r]=-mhat; asm volatile("":"+v"(negm)); \
        const float f=__builtin_amdgcn_exp2f(-dl); l_reg*=f; if(hi==0)wsf[r32]=f; resc=true; } } \
    SBAR(); \
    GAPB(o[0]=__builtin_amdgcn_mfma_f32_32x32x16_bf16(PAF(0),VFR(0),o[0],0,0,0), C0,0); \
    GAPB(o[1]=__builtin_amdgcn_mfma_f32_32x32x16_bf16(PAF(0),VFR(4),o[1],0,0,0), C0,4); \
    KRD(GL,0); GAPB(o[0]=__builtin_amdgcn_mfma_f32_32x32x16_bf16(PAF(1),VFR(1),o[0],0,0,0), C0,8); \
    KRD(GL,1); GAPB(o[1]=__builtin_amdgcn_mfma_f32_32x32x16_bf16(PAF(1),VFR(5),o[1],0,0,0), C0,12); \
    KRD(GL,2); GAPB(o[0]=__builtin_amdgcn_mfma_f32_32x32x16_bf16(PAF(2),VFR(2),o[0],0,0,0), C1,0); \
    KRD(GL,3); GAPB(o[1]=__builtin_amdgcn_mfma_f32_32x32x16_bf16(PAF(2),VFR(6),o[1],0,0,0), C1,4); \
    GAPB(o[0]=__builtin_amdgcn_mfma_f32_32x32x16_bf16(PAF(3),VFR(3),o[0],0,0,0), C1,8); \
    GAPB(o[1]=__builtin_amdgcn_mfma_f32_32x32x16_bf16(PAF(3),VFR(7),o[1],0,0,0), C1,12); \
    }while(0)
  int t=1;
  #undef CMASK
  #define CMASK(P0,P1,t) do{}while(0)
  for(;t+5<NT;t+=2){
    STEP(pB0,pB1,pA0,pA1,t,true,true,true);     WAIT_BAR(2); RESC(); ROT();
    STEP(pA0,pA1,pB0,pB1,t+1,true,true,true);   WAIT_BAR(2); RESC(); ROT();
  }
  #undef CMASK
  #define CMASK(P0,P1,t) do{int jb_=(t)-(NT-4); if(jb_>=0)cmask(P0,P1,jb_,qrel,hi);}while(0)
  #define ENDW(tt) do{ if((tt)+3<NT){WAIT_BAR(2);} else if((tt)+2<NT){WAIT_BAR(1);} else {WAIT_BAR(0);} }while(0)
  for(;t+1<NT;t+=2){
    STEP(pB0,pB1,pA0,pA1,t,(t+3<NT),(t+1<NT),(t+1<NT));       ENDW(t);   RESC(); ROT();
    STEP(pA0,pA1,pB0,pB1,t+1,(t+4<NT),(t+2<NT),(t+2<NT));     ENDW(t+1); RESC(); ROT();
  }
  STEP(pB0,pB1,pA0,pA1,NT-1,false,false,false); RESC();
  { float sacc=pB0[0]+pB0[1]; _Pragma("unroll") for(int r=2;r<16;++r)sacc+=pB0[r]; _Pragma("unroll") for(int r=0;r<16;++r)sacc+=pB1[r]; l_reg+=sacc;
    pw0=(u32x4){PKW(pB0,0),PKW(pB0,2),PKW(pB0,4),PKW(pB0,6)};pw1=(u32x4){PKW(pB0,8),PKW(pB0,10),PKW(pB0,12),PKW(pB0,14)};pw2=(u32x4){PKW(pB1,0),PKW(pB1,2),PKW(pB1,4),PKW(pB1,6)};pw3=(u32x4){PKW(pB1,8),PKW(pB1,10),PKW(pB1,12),PKW(pB1,14)};
    SBAR(); pv(o,vb0+sl_cur,PAF(0),PAF(1),PAF(2),PAF(3)); }
  #undef PKW
  #undef PAF
  #undef VFR
  #undef PIN
  #undef MX3
  #undef GAPA
  #undef GAPB
  #undef EX
  #undef VRD
  #undef KRD
  #undef STEP
  #undef ENDW
  {auto rr=__builtin_amdgcn_permlane32_swap(__float_as_uint(l_reg),__float_as_uint(l_reg),false,false);l_reg=__uint_as_float(rr[0])+__uint_as_float(rr[1]);}
  if(hi==0)wsf[32+r32]=l_reg;asm volatile("s_waitcnt lgkmcnt(0)":::"memory");
  float rli[16];
  #pragma unroll
  for(int r=0;r<16;++r)rli[r]=__builtin_amdgcn_rcpf(wsf[32+crow(r,hi)]);
  bf16*Ow=O+(rowbase+q0+wid*QBLK)*OPITCH+ocol;
  { bf16*stg=(bf16*)(shm+LDS_OST)+wid*2048;
    #pragma unroll
    for(int r=0;r<16;++r){const int orow=crow(r,hi);
      #pragma unroll
      for(int d0=0;d0<2;++d0)stg[orow*64+d0*32+r32]=__float2bfloat16(o[d0][r]*rli[r]);}
    asm volatile("s_waitcnt lgkmcnt(0)":::"memory");
    #pragma unroll
    for(int i=0;i<4;++i){const int row=i*8+(lane>>3),ch=lane&7; const u32x4 v=*(const u32x4*)(stg+row*64+ch*8); ATTN_STORE16(Ow+(long)row*OPITCH+ch*8,v);} }
  asm volatile("s_waitcnt lgkmcnt(0)\n\ts_barrier":::"memory");
  #undef DMA_K
  #undef DMA_V
  #undef CMASK
  #undef START
  #undef RESC
  #undef ROT
}
constexpr int ATTN_LDS_BYTES=LDS_BYTES;
#undef SBAR
#undef WAIT_BAR
}
constexpr size_t MiB = 1u << 20;
constexpr size_t WS_CTL = 0, CTL_ZERO_BYTES = 1 * MiB;
constexpr size_t WS_WIN = 2 * MiB, WS_WOUT = 26 * MiB, WS_WQ = 34 * MiB, WS_WKV = 42 * MiB, WS_WO = 58 * MiB, WS_W1 = 66 * MiB, WS_W2 = 578 * MiB;
constexpr size_t WS_HN = 834 * MiB, WS_MN = 866 * MiB, WS_PROJ = 870 * MiB, WS_DT = 958 * MiB, WS_KVRAW = 959 * MiB, WS_KN = 967 * MiB;
constexpr size_t WS_YCAT = 971 * MiB, WS_O0 = 1003 * MiB, WS_O1 = 1019 * MiB, WS_H1 = 1035 * MiB, WS_H1B = 1099 * MiB, WS_PART1 = 1131 * MiB, WS_PARTQ = 1132 * MiB;
constexpr size_t WS_QRAW = 1133 * MiB, WS_P = 1165 * MiB, WS_VWT = 1181 * MiB, WS_H2 = 1197 * MiB, WS_HN3 = 1261 * MiB;
constexpr size_t WS_TOKOF = 1293 * MiB, WS_GATEOF = 1294 * MiB, WS_TOKE = 1295 * MiB, WS_TOKR = 1296 * MiB, WS_YG = 1297 * MiB;
constexpr size_t WS_XG = 1320 * MiB  , WS_ACT = 1832 * MiB  , WS_Y = 2344 * MiB  , WS_END = 3368 * MiB;
constexpr int CW_BAR = 4096;
constexpr int CW_CNT = 8192;
static_assert((CW_CNT + 64 * 32) * 4 <= (int)CTL_ZERO_BYTES, "CTL words inside the memset region");

constexpr int RING_OFF = 0, RING_BYTES = 131072;
constexpr int LDS_BYTES = 163840;
constexpr int MISC_OFF = 163840 - 1024;
constexpr int NWAVES = 8;

#define XB_TMO      128
#define XB_XCNT(j)  (256  + 64 * (j))
#define XB_XSUB(j)  (1280 + 64 * (j))
#define XB_XGEN(j)  (2304 + 64 * (j))
#define XB_TOP      3328
#define XB_TOPGEN   3392
#define XCD_BAR_WORDS 3456
#define XB_SPIN_CAP (1u << 20)

__device__ __forceinline__ unsigned xb_ld(unsigned* p)              { return __hip_atomic_load(p, __ATOMIC_RELAXED, __HIP_MEMORY_SCOPE_AGENT); }
__device__ __forceinline__ unsigned xb_add(unsigned* p, unsigned v) { return __hip_atomic_fetch_add(p, v, __ATOMIC_RELAXED, __HIP_MEMORY_SCOPE_AGENT); }
__device__ __forceinline__ unsigned xb_xcc_id() { return (unsigned)__builtin_amdgcn_s_getreg((3 << 11) | 20) & 0xFu; }
#define XB_SPIN(cond, bar) do { unsigned _sp = 0; while (cond) { __builtin_amdgcn_s_sleep(1); \
    if ((++_sp & 255u) == 0u) { if (xb_ld(&(bar)[XB_TMO])) break; if (_sp > XB_SPIN_CAP) { atomicAdd(&(bar)[XB_TMO], 1u); break; } } } } while (0)

struct XcdBarrier {
    unsigned* bar; unsigned x;
    volatile LAS unsigned* st;
};
__device__ __forceinline__ XcdBarrier xcd_barrier_post(unsigned* bar, volatile LAS unsigned* st) {
    XcdBarrier b; b.bar = bar; b.x = xb_xcc_id(); b.st = st;
    if (threadIdx.x == 0) (void)xb_add(&bar[XB_XCNT(b.x)], 1u);
    return b;
}
__device__ __forceinline__ void xcd_barrier_complete(unsigned* bar, unsigned x, unsigned& nloc, unsigned& nx) {
    const unsigned G = gridDim.x * gridDim.y * gridDim.z;
    unsigned sum, cnt, mine, sp = 0u;
    for (;;) {
        sum = 0u; cnt = 0u; mine = 0u;
#pragma unroll
        for (unsigned j = 0; j < 16; ++j) { const unsigned c = xb_ld(&bar[XB_XCNT(j)]); sum += c; cnt += (c > 0u) ? 1u : 0u; mine = (j == x) ? c : mine; }
        if (sum == G) break;
        __builtin_amdgcn_s_sleep(1);
        if ((++sp & 255u) == 0u) { if (xb_ld(&bar[XB_TMO])) break; if (sp > XB_SPIN_CAP) { atomicAdd(&bar[XB_TMO], 1u); break; } }
    }
    nloc = mine > 0u ? mine : 1u; nx = cnt > 0u ? cnt : 1u;
}
__device__ __forceinline__ void xcd_barrier(const XcdBarrier& b) {
    asm volatile("s_waitcnt vmcnt(0)" ::: "memory");
    __syncthreads();
    if (threadIdx.x == 0) {
        unsigned* bar = b.bar;
        __builtin_amdgcn_s_waitcnt(0);
        unsigned nloc = b.st[0], nx = b.st[1];
        if (nloc == 0u) { xcd_barrier_complete(bar, b.x, nloc, nx); b.st[0] = nloc; b.st[1] = nx; }
        const unsigned old = xb_add(&bar[XB_XSUB(b.x)], 1u);
        const unsigned gen = old / nloc;
        if (old + 1u == (gen + 1u) * nloc) {
            __builtin_amdgcn_fence(__ATOMIC_RELEASE, "agent");
            asm volatile("s_waitcnt vmcnt(0)" ::: "memory");
            const unsigned og = xb_add(&bar[XB_TOP], 1u);
            const unsigned tg = og / nx;
            if (og + 1u == (tg + 1u) * nx) xb_add(&bar[XB_TOPGEN], 1u);
            else XB_SPIN(xb_ld(&bar[XB_TOPGEN]) == tg, bar);
            __builtin_amdgcn_fence(__ATOMIC_ACQUIRE, "agent");
            xb_add(&bar[XB_XGEN(b.x)], 1u);
            asm volatile("s_waitcnt vmcnt(0)" ::: "memory");
        } else {
            XB_SPIN(xb_ld(&bar[XB_XGEN(b.x)]) == gen, bar);
            __builtin_amdgcn_fence(__ATOMIC_ACQUIRE, "agent");
            asm volatile("s_waitcnt vmcnt(0)" ::: "memory");
        }
    }
    __syncthreads();
}

struct Args { const float* in[32]; float* out; unsigned char* ws; int ph_lo, ph_hi; };
enum In { I_X = 0, I_MEM, I_GMIX, I_WIN, I_CONVW, I_CONVB, I_DTB, I_ALOG, I_DSKIP, I_SSDG, I_DAQG, I_DAKG, I_LQ1, I_LK1, I_LQ2, I_LK2, I_SUBG, I_WOUT, I_GXA, I_GMEM,
          I_WQ, I_WKV, I_XQG, I_XKG, I_WO, I_GFFN, I_RW, I_RB, I_W1, I_B1, I_W2, I_B2 };

struct ArgP {
    typedef const __attribute__((address_space(4))) char* kptr;
    DI const float* in(int i) const { kptr kp = (kptr)__builtin_amdgcn_kernarg_segment_ptr(); asm volatile("" : "+s"(kp)); return *(const float* const __attribute__((address_space(4)))*)(kp + 8 * i); }
    DI float* out() const { kptr kp = (kptr)__builtin_amdgcn_kernarg_segment_ptr(); asm volatile("" : "+s"(kp)); return *(float* const __attribute__((address_space(4)))*)(kp + 8 * 32); }
};
struct Frame {
    LAS unsigned char* lds;
    volatile LAS unsigned* MISC;
    unsigned* ctl;
    unsigned char* ws;
    int tid, lane, wave, vcu, G;
};

template <class DestRow>
DI void tr_item(const float* W, size_t ldw, int k0, int ncol0, int nvalid, const float* kscale, bf16_t* WT, int K, DestRow dr, LAS float* scr, int lane) {
    const int c = lane & 31;
#pragma unroll 8
    for (int i = 0; i < 32; ++i) { const int kk = 2 * i + (lane >> 5);
        float v = (c < nvalid) ? W[(size_t)(k0 + kk) * ldw + ncol0 + c] : 0.f;
        if (kscale) v *= kscale[k0 + kk];
        scr[kk * 33 + c] = v; }
    asm volatile("s_waitcnt lgkmcnt(0)" ::: "memory");
    const int c8 = lane & 7;
#pragma unroll
    for (int j = 0; j < 4; ++j) { const int n = (lane >> 3) + 8 * j; const LAS float* s = scr + (8 * c8) * 33 + n;
        u32x4 o; o.x = pk2(s[0 * 33], s[1 * 33]); o.y = pk2(s[2 * 33], s[3 * 33]); o.z = pk2(s[4 * 33], s[5 * 33]); o.w = pk2(s[6 * 33], s[7 * 33]);
        if (n < nvalid) *(u32x4*)(WT + (size_t)dr(ncol0 + n) * K + k0 + 8 * c8) = o; }
    asm volatile("s_waitcnt lgkmcnt(0)" ::: "memory");
}
template <class DestRow>
DI void tr_item_fp8(const float* W, size_t ldw, int k0, int ncol0, unsigned char* WT, int K, DestRow dr, LAS float* scr, int lane) {
    const int c = lane & 31;
#pragma unroll 8
    for (int i = 0; i < 32; ++i) { const int kk = 2 * i + (lane >> 5); scr[kk * 33 + c] = W[(size_t)(k0 + kk) * ldw + ncol0 + c]; }
    asm volatile("s_waitcnt lgkmcnt(0)" ::: "memory");
    const int n = lane >> 1, hf = lane & 1; const LAS float* s = scr + (32 * hf) * 33 + n;
    unsigned w[8];
#pragma unroll
    for (int j = 0; j < 8; ++j) { unsigned x = 0u;
        x = __builtin_amdgcn_cvt_pk_fp8_f32(s[(4 * j) * 33] * 64.f, s[(4 * j + 1) * 33] * 64.f, x, false);
        x = __builtin_amdgcn_cvt_pk_fp8_f32(s[(4 * j + 2) * 33] * 64.f, s[(4 * j + 3) * 33] * 64.f, x, true); w[j] = x; }
    unsigned char* op = WT + (size_t)dr(ncol0 + n) * K + k0 + 32 * hf;
    *(u32x4*)op = (u32x4){w[0], w[1], w[2], w[3]}; *(u32x4*)(op + 16) = (u32x4){w[4], w[5], w[6], w[7]};
    asm volatile("s_waitcnt lgkmcnt(0)" ::: "memory");
}
DI int tileperm(int col) { const int o = col & 255; return (col & ~255) + 128 * ((o & 63) >> 5) + 32 * (o >> 6) + (o & 31); }
struct DrIdent { DI int operator()(int n) const { return n; } };
struct DrTile  { DI int operator()(int n) const { return tileperm(n); } };
struct DrWin   { DI int operator()(int n) const { const int pc = (n < 2560) ? n : (n < 2576 ? PC_DT + (n - 2560) : n - 16); return tileperm(pc); } };
struct DrW1    { DI int operator()(int n) const { const int half = n >> 11, j = n & 2047; return (j >> 7) * 256 + half * 128 + (j & 127); } };

DI void rms_row_to_bf16(const float* xrow, const float* g, bf16_t* orow, int lane) {
    const f32x4* xr = (const f32x4*)xrow + lane;
    f32x4 v[8]; float s = 0.f;
#pragma unroll
    for (int j = 0; j < 8; ++j) { v[j] = xr[64 * j]; s += (v[j].x * v[j].x + v[j].y * v[j].y) + (v[j].z * v[j].z + v[j].w * v[j].w); }
    const float rstd = 1.f / sqrtf(wave_sum(s) * (1.f / 2048.f) + EPS_);
    u32x2* o8 = (u32x2*)orow + lane;
#pragma unroll
    for (int j = 0; j < 8; ++j) { const f32x4 gg = ((const f32x4*)g)[lane + 64 * j];
        u32x2 o; o.x = pk2(v[j].x * rstd * gg.x, v[j].y * rstd * gg.y); o.y = pk2(v[j].z * rstd * gg.z, v[j].w * rstd * gg.w); o8[64 * j] = o; }
}

DI void p0_prologue(Frame& F, const ArgP& a) {
    LAS float* scr = (LAS float*)(F.lds + RING_OFF + F.wave * 16384);
    const int gw = F.vcu * NWAVES + F.wave, NGW = F.G * NWAVES;
    unsigned char* ws = F.ws;
    constexpr int I_A = 32 * 80, I_B = 32, I_C = 32 * 96, I_WOUT_ = 32 * 64, I_WQ_ = 32 * 64, I_WKV_ = 32 * 128, I_WO_ = 32 * 64, I_W1_ = 32 * 32 * 128, I_W2_ = 32 * 32 * 64;
    constexpr int NITEMS = I_A + I_B + I_C + I_WOUT_ + I_WQ_ + I_WKV_ + I_WO_ + I_W1_ + I_W2_;
    for (int it = gw; it < NITEMS; it += NGW) {
        int r = it;
        if (r < I_A) { tr_item(a.in(I_WIN), 5648, 64 * (r / 80), 32 * (r % 80), 32, nullptr, (bf16_t*)(ws + WS_WIN), 2048, DrWin(), scr, F.lane); continue; } r -= I_A;
        if (r < I_B) { tr_item(a.in(I_WIN), 5648, 64 * r, 2560, 16, nullptr, (bf16_t*)(ws + WS_WIN), 2048, DrWin(), scr, F.lane); continue; } r -= I_B;
        if (r < I_C) { tr_item(a.in(I_WIN), 5648, 64 * (r / 96), 2576 + 32 * (r % 96), 32, nullptr, (bf16_t*)(ws + WS_WIN), 2048, DrWin(), scr, F.lane); continue; } r -= I_C;
        if (r < I_WOUT_) { tr_item(a.in(I_WOUT), 2048, 64 * (r / 64), 32 * (r % 64), 32, nullptr, (bf16_t*)(ws + WS_WOUT), 2048, DrIdent(), scr, F.lane); continue; } r -= I_WOUT_;
        if (r < I_WQ_) { tr_item(a.in(I_WQ), 2048, 64 * (r / 64), 32 * (r % 64), 32, a.in(I_GXA), (bf16_t*)(ws + WS_WQ), 2048, DrIdent(), scr, F.lane); continue; } r -= I_WQ_;
        if (r < I_WKV_) { tr_item(a.in(I_WKV), 4096, 64 * (r / 128), 32 * (r % 128), 32, nullptr, (bf16_t*)(ws + WS_WKV), 2048, DrTile(), scr, F.lane); continue; } r -= I_WKV_;
        if (r < I_WO_) { tr_item(a.in(I_WO), 2048, 64 * (r / 64), 32 * (r % 64), 32, nullptr, (bf16_t*)(ws + WS_WO), 2048, DrIdent(), scr, F.lane); continue; } r -= I_WO_;
        if (r < I_W1_) { const int e = r / (32 * 128), q = r % (32 * 128);
            tr_item_fp8(a.in(I_W1) + (size_t)e * 2048 * 4096, 4096, 64 * (q / 128), 32 * (q % 128), (unsigned char*)(ws + WS_W1) + (size_t)e * 4096 * 2048, 2048, DrW1(), scr, F.lane); continue; } r -= I_W1_;
        { const int e = r / (32 * 64), q = r % (32 * 64);
            tr_item_fp8(a.in(I_W2) + (size_t)e * 2048 * 2048, 2048, 64 * (q / 64), 32 * (q % 64), (unsigned char*)(ws + WS_W2) + (size_t)e * 2048 * 2048, 2048, DrIdent(), scr, F.lane); }
    }
    for (int m = gw; m < NTOK; m += NGW) rms_row_to_bf16(a.in(I_X) + (size_t)m * 2048, a.in(I_GMIX), (bf16_t*)(ws + WS_HN) + (size_t)m * 2048, F.lane);
    for (int m = gw; m < NB * MEMLEN; m += NGW) rms_row_to_bf16(a.in(I_MEM) + (size_t)m * 2048, a.in(I_GMEM), (bf16_t*)(ws + WS_MN) + (size_t)m * 2048, F.lane);
}

struct SchedP1 {
    int G, c; const unsigned char* ws;
    DI bool next(int i, pg8::UnitD& u) const {
        const int L = i * G + c; if (L >= 32 * 23 + 64) return false;
        u.rows = nullptr; u.nvalid = 0; u.lda = 4096u; u.ldb = 4096u; u.e = 0; u.x0 = 0;
        if (L < 32 * 23) { u.type = 0; u.pn = L / 32; u.pm = L % 32; u.A = (const char*)(ws + WS_HN) + (size_t)u.pm * 256 * 4096; u.B = (const char*)(ws + WS_WIN) + (size_t)u.pn * 256 * 4096; }
        else { const int q = L - 32 * 23; u.type = 1; u.pn = q / 4; u.pm = q % 4; u.A = (const char*)(ws + WS_MN) + (size_t)u.pm * 256 * 4096; u.B = (const char*)(ws + WS_WKV) + (size_t)u.pn * 256 * 4096; }
        return true;
    }
};
struct EpiP1 {
    static constexpr bool AFTER_DRAIN = false;
    bf16_t* proj; float* dtb; bf16_t* kvraw; const float* gq; const float* gk;
    DI void operator()(const f32x4 (&acc)[2][2][4][2], const pg8::UnitD& u, int wr, int wc, int fr, int fq) const {
        { int ln_ = threadIdx.x; asm volatile("" : "+v"(ln_)); fr = ln_ & 15; fq = (ln_ >> 4) & 3; }
        const int row0 = u.pm * 256 + wr * 64 + fr;
        const int cn = u.pn * 256 + 64 * wc + 8 * fq;
        if (u.type == 1) {
#pragma unroll
            for (int ai = 0; ai < 2; ++ai)
#pragma unroll
                for (int m = 0; m < 4; ++m) { bf16_t* rp = kvraw + (size_t)(row0 + ai * 128 + m * 16) * 4096 + cn;
#pragma unroll
                    for (int bj = 0; bj < 2; ++bj) { const f32x4 v0 = acc[ai][bj][m][0], v1 = acc[ai][bj][m][1];
                        u32x4 w; w.x = pk2(v0[0], v0[1]); w.y = pk2(v0[2], v0[3]); w.z = pk2(v1[0], v1[1]); w.w = pk2(v1[2], v1[3]); *(u32x4*)(rp + 32 * bj) = w; } }
            return;
        }
        if (u.pn == 22) {
            if (wc == 0 && fq < 2) {
#pragma unroll
                for (int ai = 0; ai < 2; ++ai)
#pragma unroll
                    for (int m = 0; m < 4; ++m) { float* rp = dtb + (size_t)(row0 + ai * 128 + m * 16) * 16 + 8 * fq;
                        *(f32x4*)(rp) = acc[ai][0][m][0]; *(f32x4*)(rp + 4) = acc[ai][0][m][1]; }
            }
            return;
        }
        const bool isq = (u.pn >= 10 && u.pn < 14), isk = (u.pn >= 14 && u.pn < 18);
        if (!(isq || isk)) {
#pragma unroll
            for (int ai = 0; ai < 2; ++ai)
#pragma unroll
                for (int m = 0; m < 4; ++m) { bf16_t* rp = proj + (size_t)(row0 + ai * 128 + m * 16) * PP + cn;
#pragma unroll
                    for (int bj = 0; bj < 2; ++bj) { const f32x4 v0 = acc[ai][bj][m][0], v1 = acc[ai][bj][m][1];
                        u32x4 w; w.x = pk2(v0[0], v0[1]); w.y = pk2(v0[2], v0[3]); w.z = pk2(v1[0], v1[1]); w.w = pk2(v1[2], v1[3]); *(u32x4*)(rp + 32 * bj) = w; } }
            return;
        }
        const float* g = (isq ? gq : gk) + 8 * fq; const float sc = isq ? (0.125f * 1.4426950408889634f) : 1.f;
#pragma unroll
        for (int ai = 0; ai < 2; ++ai)
#pragma unroll
            for (int m = 0; m < 4; ++m) { bf16_t* rp = proj + (size_t)(row0 + ai * 128 + m * 16) * PP + cn;
                float ss = 0.f;
#pragma unroll
                for (int bj = 0; bj < 2; ++bj)
#pragma unroll
                    for (int n = 0; n < 2; ++n) { const f32x4 v = acc[ai][bj][m][n]; ss += (v[0] * v[0] + v[1] * v[1]) + (v[2] * v[2] + v[3] * v[3]); }
                ss += __shfl_xor(ss, 16); ss += __shfl_xor(ss, 32);
                const float rs = sc / sqrtf(ss * (1.f / 64.f) + EPS_);
#pragma unroll
                for (int bj = 0; bj < 2; ++bj) { const f32x4 v0 = acc[ai][bj][m][0] * rs * *(const f32x4*)(g + 32 * bj), v1 = acc[ai][bj][m][1] * rs * *(const f32x4*)(g + 32 * bj + 4);
                    u32x4 w; w.x = pk2(v0[0], v0[1]); w.y = pk2(v0[2], v0[3]); w.z = pk2(v1[0], v1[1]); w.w = pk2(v1[2], v1[3]); *(u32x4*)(rp + 32 * bj) = w; } }
    }
};

DI void kprep(Frame& F, const ArgP& a) {
    const int gw = F.vcu * NWAVES + F.wave, NGW = F.G * NWAVES;
    const bf16_t* kv = (const bf16_t*)(F.ws + WS_KVRAW); bf16_t* kn = (bf16_t*)(F.ws + WS_KN);
    for (int it = gw; it < NB * MEMLEN * 4; it += NGW) {
        const int row = it >> 2, h = it & 3, b = row >> 8, key = row & 255;
        const u32x4 raw = *(const u32x4*)(kv + (size_t)row * 4096 + h * 512 + F.lane * 8);
        float v[8]; v[0] = bflo(raw.x); v[1] = bfhi(raw.x); v[2] = bflo(raw.y); v[3] = bfhi(raw.y); v[4] = bflo(raw.z); v[5] = bfhi(raw.z); v[6] = bflo(raw.w); v[7] = bfhi(raw.w);
        float ss = 0.f;
#pragma unroll
        for (int j = 0; j < 8; ++j) ss += v[j] * v[j];
        const float rs = 1.f / sqrtf(wave_sum(ss) * (1.f / 512.f) + EPS_) * 0.04419417382415922f;
        const float* gk = a.in(I_XKG) + F.lane * 8; const float* gq = a.in(I_XQG) + F.lane * 8;
        u32x4 o; o.x = pk2(v[0] * rs * gk[0] * gq[0], v[1] * rs * gk[1] * gq[1]); o.y = pk2(v[2] * rs * gk[2] * gq[2], v[3] * rs * gk[3] * gq[3]);
        o.z = pk2(v[4] * rs * gk[4] * gq[4], v[5] * rs * gk[5] * gq[5]); o.w = pk2(v[6] * rs * gk[6] * gq[6], v[7] * rs * gk[7] * gq[7]);
        *(u32x4*)(kn + ((size_t)((b * 4 + h) * 256 + key)) * 512 + F.lane * 8) = o;
    }
}

constexpr int SP = 272;
constexpr int S_C = 0, S_BM = 34816, S_BT = 69632, S_XDT = 104448, S_XW = 121856, S_HB = 139264, S_F = 156672, SSD_LDS = 157696;
static_assert(SSD_LDS <= MISC_OFF, "SSD LDS map");
#define MFMA32(a, b, c) __builtin_amdgcn_mfma_f32_32x32x16_bf16((a), (b), (c), 0, 0, 0)
DI int crow(int r, int hi) { return (r & 3) + 8 * (r >> 2) + 4 * hi; }
DI bf16x8 ldfrag(LAS const unsigned char* base, int row, int kel) { return *(const LAS bf16x8*)(base + row * SP + kel * 2); }

DI void ssd_unit(Frame& F, const ArgP& a, int b, int hd) {
    LAS unsigned char* lds = F.lds;
    const int tid = F.tid, lane = F.lane, wid = F.wave, r32 = lane & 31, hh = lane >> 5;
    LAS float* sdt = (LAS float*)(lds + S_F); LAS float* sac = sdt + 128;
    const bf16_t* proj = (const bf16_t*)(F.ws + WS_PROJ); const float* dtbuf = (const float*)(F.ws + WS_DT); bf16_t* yg = (bf16_t*)(F.ws + WS_YG);
    const int g = hd >> 3;
    const float aneg = -__expf(a.in(I_ALOG)[hd]), dtb = a.in(I_DTB)[hd], dsk = a.in(I_DSKIP)[hd];
    const float* convw = a.in(I_CONVW); const float* convb = a.in(I_CONVB);
    f32x16 hT; for (int i = 0; i < 16; ++i) hT[i] = 0.f;
    const int nb = wid & 3, pb = wid >> 2;
    for (int c = 0; c < 16; ++c) {
        const int t0 = b * SEQ_ + c * 128;
        if (wid == 0) {
            const float x0 = dtbuf[(size_t)(t0 + 2 * lane) * 16 + hd] + dtb, x1 = dtbuf[(size_t)(t0 + 2 * lane + 1) * 16 + hd] + dtb;
            const float d0 = x0 > 20.f ? x0 : log1pf(__expf(x0)), d1 = x1 > 20.f ? x1 : log1pf(__expf(x1));
            const float a0 = d0 * aneg, a1 = d1 * aneg;
            float s = a0 + a1;
#pragma unroll
            for (int o = 1; o < 64; o <<= 1) { const float t = __shfl_up(s, o); if (lane >= o) s += t; }
            sdt[2 * lane] = d0; sdt[2 * lane + 1] = d1; sac[2 * lane] = s - a1; sac[2 * lane + 1] = s;
        }
        {
            LAS unsigned char* hbp = lds + S_HB + (32 * pb + r32) * SP + (32 * nb + 4 * hh) * 2;
#pragma unroll
            for (int q4 = 0; q4 < 4; ++q4) { u32x2 w; w.x = pk2(hT[4 * q4], hT[4 * q4 + 1]); w.y = pk2(hT[4 * q4 + 2], hT[4 * q4 + 3]); *(LAS u32x2*)(hbp + 16 * q4) = w; }
        }
        __syncthreads();
        const float aend = sac[127];
        for (int item = tid; item < 640; item += 512) {
            const int seg = item / 40, cg = item % 40, l0 = seg * 8;
            const int xcol = (cg < 8) ? (hd * 64 + cg * 8) : (cg < 24 ? (1024 + g * 128 + (cg - 8) * 8) : (1280 + g * 128 + (cg - 24) * 8));
            u32x4 in[11];
#pragma unroll
            for (int j = 0; j < 11; ++j) { const int tt = c * 128 + l0 - 3 + j;
                in[j] = (tt >= 0) ? *(const u32x4*)(proj + (size_t)(b * SEQ_ + tt) * PP + PC_XBC + xcol) : (u32x4){0u, 0u, 0u, 0u}; }
            float w[4][8], bias[8];
#pragma unroll
            for (int k = 0; k < 4; ++k) { const f32x4 w0 = *(const f32x4*)(convw + k * 1536 + xcol), w1 = *(const f32x4*)(convw + k * 1536 + xcol + 4);
                w[k][0] = w0[0]; w[k][1] = w0[1]; w[k][2] = w0[2]; w[k][3] = w0[3]; w[k][4] = w1[0]; w[k][5] = w1[1]; w[k][6] = w1[2]; w[k][7] = w1[3]; }
            { const f32x4 b0 = *(const f32x4*)(convb + xcol), b1 = *(const f32x4*)(convb + xcol + 4);
              bias[0] = b0[0]; bias[1] = b0[1]; bias[2] = b0[2]; bias[3] = b0[3]; bias[4] = b1[0]; bias[5] = b1[1]; bias[6] = b1[2]; bias[7] = b1[3]; }
            float o[8][8];
#pragma unroll
            for (int j = 0; j < 8; ++j)
#pragma unroll
                for (int i = 0; i < 8; ++i) { float s = bias[i];
#pragma unroll
                    for (int k = 0; k < 4; ++k) { const unsigned wd = in[j + k][i >> 1]; s += w[k][i] * ((i & 1) ? bfhi(wd) : bflo(wd)); }
                    o[j][i] = siluf(s); }
            if (cg < 8) {
                float dv[8], ev[8];
#pragma unroll
                for (int j = 0; j < 8; ++j) { dv[j] = sdt[l0 + j]; ev[j] = dv[j] * __expf(aend - sac[l0 + j]); }
#pragma unroll
                for (int i = 0; i < 8; ++i) { const int p = cg * 8 + i;
                    u32x4 w1, w2;
                    w1.x = pk2(o[0][i] * dv[0], o[1][i] * dv[1]); w1.y = pk2(o[2][i] * dv[2], o[3][i] * dv[3]); w1.z = pk2(o[4][i] * dv[4], o[5][i] * dv[5]); w1.w = pk2(o[6][i] * dv[6], o[7][i] * dv[7]);
                    w2.x = pk2(o[0][i] * ev[0], o[1][i] * ev[1]); w2.y = pk2(o[2][i] * ev[2], o[3][i] * ev[3]); w2.z = pk2(o[4][i] * ev[4], o[5][i] * ev[5]); w2.w = pk2(o[6][i] * ev[6], o[7][i] * ev[7]);
                    *(LAS u32x4*)(lds + S_XDT + p * SP + l0 * 2) = w1; *(LAS u32x4*)(lds + S_XW + p * SP + l0 * 2) = w2; }
            } else if (cg < 24) {
                const int n0 = (cg - 8) * 8;
#pragma unroll
                for (int j = 0; j < 8; ++j) { u32x4 w1; w1.x = pk2(o[j][0], o[j][1]); w1.y = pk2(o[j][2], o[j][3]); w1.z = pk2(o[j][4], o[j][5]); w1.w = pk2(o[j][6], o[j][7]);
                    *(LAS u32x4*)(lds + S_BM + (l0 + j) * SP + n0 * 2) = w1; }
#pragma unroll
                for (int i = 0; i < 8; ++i) { u32x4 w2; w2.x = pk2(o[0][i], o[1][i]); w2.y = pk2(o[2][i], o[3][i]); w2.z = pk2(o[4][i], o[5][i]); w2.w = pk2(o[6][i], o[7][i]);
                    *(LAS u32x4*)(lds + S_BT + (n0 + i) * SP + l0 * 2) = w2; }
            } else {
                const int n0 = (cg - 24) * 8;
#pragma unroll
                for (int j = 0; j < 8; ++j) { u32x4 w1; w1.x = pk2(o[j][0], o[j][1]); w1.y = pk2(o[j][2], o[j][3]); w1.z = pk2(o[j][4], o[j][5]); w1.w = pk2(o[j][6], o[j][7]);
                    *(LAS u32x4*)(lds + S_C + (l0 + j) * SP + n0 * 2) = w1; }
            }
        }
        __syncthreads();
        const int lb = wid >> 1;
        f32x16 xt[2];
#pragma unroll
        for (int q = 0; q < 2; ++q) { const int sb = 2 * (wid & 1) + q;
            for (int i = 0; i < 16; ++i) xt[q][i] = 0.f;
            if (sb <= lb) {
#pragma unroll
                for (int ks = 0; ks < 8; ++ks) xt[q] = MFMA32(ldfrag(lds + S_BM, 32 * sb + r32, 16 * ks + 8 * hh), ldfrag(lds + S_C, 32 * lb + r32, 16 * ks + 8 * hh), xt[q]);
            }
        }
        __syncthreads();
        {
            const int l = 32 * lb + r32; const float al = sac[l], dl = sdt[l];
#pragma unroll
            for (int q = 0; q < 2; ++q) { const int sb = 2 * (wid & 1) + q;
#pragma unroll
                for (int q4 = 0; q4 < 4; ++q4) { float mv[4];
#pragma unroll
                    for (int e = 0; e < 4; ++e) { const int s = 32 * sb + 8 * q4 + 4 * hh + e;
                        float v = 0.f;
                        if (s <= l) v = xt[q][4 * q4 + e] * __expf(al - sac[s]);
                        if (s == l) v += dsk / dl;
                        mv[e] = v; }
                    u32x2 w; w.x = pk2(mv[0], mv[1]); w.y = pk2(mv[2], mv[3]);
                    *(LAS u32x2*)(lds + S_BM + l * SP + (32 * sb + 8 * q4 + 4 * hh) * 2) = w; }
            }
        }
        __syncthreads();
        {
            const int lb2 = wid & 3, pb2 = wid >> 2;
            f32x16 y1, y2; for (int i = 0; i < 16; ++i) { y1[i] = 0.f; y2[i] = 0.f; }
            for (int ks = 0; ks < 2 * (lb2 + 1); ++ks) y1 = MFMA32(ldfrag(lds + S_BM, 32 * lb2 + r32, 16 * ks + 8 * hh), ldfrag(lds + S_XDT, 32 * pb2 + r32, 16 * ks + 8 * hh), y1);
#pragma unroll
            for (int ks = 0; ks < 8; ++ks) y2 = MFMA32(ldfrag(lds + S_C, 32 * lb2 + r32, 16 * ks + 8 * hh), ldfrag(lds + S_HB, 32 * pb2 + r32, 16 * ks + 8 * hh), y2);
            const float cd = __expf(aend);
#pragma unroll
            for (int i = 0; i < 16; ++i) hT[i] *= cd;
#pragma unroll
            for (int ks = 0; ks < 8; ++ks) hT = MFMA32(ldfrag(lds + S_BT, 32 * nb + r32, 16 * ks + 8 * hh), ldfrag(lds + S_XW, 32 * pb + r32, 16 * ks + 8 * hh), hT);
            const int pcol = hd * 64 + 32 * pb2 + r32;
#pragma unroll
            for (int i = 0; i < 16; ++i) { const int l = 32 * lb2 + crow(i, hh); const size_t tok = (size_t)(t0 + l);
                const float yv = y1[i] + __expf(sac[l]) * y2[i];
                const float z = bf2f(proj[tok * PP + pcol]);
                yg[tok * 1024 + pcol] = (bf16_t)(pk2(yv * siluf(z), 0.f) & 0xffffu); }
        }
        __syncthreads();
    }
}

DI void attn_phase_da(Frame& F) {
    const attn_body::bf16* proj = (const attn_body::bf16*)(F.ws + WS_PROJ);
    for (int r = 0; ; ++r) {
        const int u = r * F.G + F.vcu; if (u >= 1024) break;
        const int v = u & 255, rr = u >> 8;
        const int combo = v >> 1, sp = v & 1;
        const int half = combo & 1, j = (combo >> 1) & 1, h = (combo >> 2) & 7, b = combo >> 5;
        const int qb = (rr == 0) ? (7 - sp) : (rr == 1) ? sp : (rr == 2) ? (4 + sp) : (3 - sp);
        attn_body::bf16* O = (attn_body::bf16*)(F.ws + (j ? WS_O1 : WS_O0));
        attn_body::attn_unit<8>(b, PC_Q + (h * 2 + j) * 64, PC_V + h * 128 + half * 64, h * 128 + half * 64, qb, proj, proj + (PC_K - PC_Q), proj, O, (char*)F.lds);
    }
}

DI void p3_finalize(Frame& F, const ArgP& a) {
    const int gw = F.vcu * NWAVES + F.wave, NGW = F.G * NWAVES, lane = F.lane;
    bf16_t* ycat = (bf16_t*)(F.ws + WS_YCAT); const bf16_t* yg = (const bf16_t*)(F.ws + WS_YG); const bf16_t* o0 = (const bf16_t*)(F.ws + WS_O0); const bf16_t* o1 = (const bf16_t*)(F.ws + WS_O1);
    float l1 = a.in(I_LQ1)[lane] * a.in(I_LK1)[lane], l2 = a.in(I_LQ2)[lane] * a.in(I_LK2)[lane];
    const float lam = __expf(wave_sum(l1)) - __expf(wave_sum(l2)) + LAM_INIT;
    for (int m = gw; m < NTOK; m += NGW) {
        { bf16_t* yp = ycat + (size_t)m * 2048 + 16 * lane; const bf16_t* gp = yg + (size_t)m * 1024 + 16 * lane;
          const u32x4 r0 = *(const u32x4*)gp, r1 = *(const u32x4*)(gp + 8);
          float v[16]; v[0] = bflo(r0.x); v[1] = bfhi(r0.x); v[2] = bflo(r0.y); v[3] = bfhi(r0.y); v[4] = bflo(r0.z); v[5] = bfhi(r0.z); v[6] = bflo(r0.w); v[7] = bfhi(r0.w);
          v[8] = bflo(r1.x); v[9] = bfhi(r1.x); v[10] = bflo(r1.y); v[11] = bfhi(r1.y); v[12] = bflo(r1.z); v[13] = bfhi(r1.z); v[14] = bflo(r1.w); v[15] = bfhi(r1.w);
          float ss = 0.f;
#pragma unroll
          for (int i = 0; i < 16; ++i) ss += v[i] * v[i];
#pragma unroll
          for (int o = 1; o < 32; o <<= 1) ss += __shfl_xor(ss, o);
          const float rs = 1.f / sqrtf(ss * (1.f / 512.f) + EPS_);
          const float* g = a.in(I_SSDG) + 16 * lane;
          u32x4 w0, w1;
          w0.x = pk2(v[0] * rs * g[0], v[1] * rs * g[1]); w0.y = pk2(v[2] * rs * g[2], v[3] * rs * g[3]); w0.z = pk2(v[4] * rs * g[4], v[5] * rs * g[5]); w0.w = pk2(v[6] * rs * g[6], v[7] * rs * g[7]);
          w1.x = pk2(v[8] * rs * g[8], v[9] * rs * g[9]); w1.y = pk2(v[10] * rs * g[10], v[11] * rs * g[11]); w1.z = pk2(v[12] * rs * g[12], v[13] * rs * g[13]); w1.w = pk2(v[14] * rs * g[14], v[15] * rs * g[15]);
          *(u32x4*)yp = w0; *(u32x4*)(yp + 8) = w1; }
        { const bf16_t* p0 = o0 + (size_t)m * 1024 + 16 * lane; const bf16_t* p1 = o1 + (size_t)m * 1024 + 16 * lane;
          const u32x4 a0 = *(const u32x4*)p0, a1 = *(const u32x4*)(p0 + 8), b0 = *(const u32x4*)p1, b1 = *(const u32x4*)(p1 + 8);
          float v[16];
          v[0] = bflo(a0.x) - lam * bflo(b0.x); v[1] = bfhi(a0.x) - lam * bfhi(b0.x); v[2] = bflo(a0.y) - lam * bflo(b0.y); v[3] = bfhi(a0.y) - lam * bfhi(b0.y);
          v[4] = bflo(a0.z) - lam * bflo(b0.z); v[5] = bfhi(a0.z) - lam * bfhi(b0.z); v[6] = bflo(a0.w) - lam * bflo(b0.w); v[7] = bfhi(a0.w) - lam * bfhi(b0.w);
          v[8] = bflo(a1.x) - lam * bflo(b1.x); v[9] = bfhi(a1.x) - lam * bfhi(b1.x); v[10] = bflo(a1.y) - lam * bflo(b1.y); v[11] = bfhi(a1.y) - lam * bfhi(b1.y);
          v[12] = bflo(a1.z) - lam * bflo(b1.z); v[13] = bfhi(a1.z) - lam * bfhi(b1.z); v[14] = bflo(a1.w) - lam * bflo(b1.w); v[15] = bfhi(a1.w) - lam * bfhi(b1.w);
          float ss = 0.f;
#pragma unroll
          for (int i = 0; i < 16; ++i) ss += v[i] * v[i];
          ss += __shfl_xor(ss, 1); ss += __shfl_xor(ss, 2); ss += __shfl_xor(ss, 4);
          const float rs = 1.f / sqrtf(ss * (1.f / 128.f) + EPS_) * (1.f - LAM_INIT);
          const float* g = a.in(I_SUBG) + 16 * (lane & 7);
          u32x4 w0, w1;
          w0.x = pk2(v[0] * rs * g[0], v[1] * rs * g[1]); w0.y = pk2(v[2] * rs * g[2], v[3] * rs * g[3]); w0.z = pk2(v[4] * rs * g[4], v[5] * rs * g[5]); w0.w = pk2(v[6] * rs * g[6], v[7] * rs * g[7]);
          w1.x = pk2(v[8] * rs * g[8], v[9] * rs * g[9]); w1.y = pk2(v[10] * rs * g[10], v[11] * rs * g[11]); w1.z = pk2(v[12] * rs * g[12], v[13] * rs * g[13]); w1.w = pk2(v[14] * rs * g[14], v[15] * rs * g[15]);
          bf16_t* yp = ycat + (size_t)m * 2048 + 1024 + 16 * lane;
          *(u32x4*)yp = w0; *(u32x4*)(yp + 8) = w1; }
    }
}

struct SchedDense {
    int G, c, nM, nN; const char* A; const char* B; unsigned lda, ldb; int bdiv; size_t bstride;
    DI bool next(int i, pg8::UnitD& u) const {
        const int L = i * G + c; if (L >= nM * nN) return false;
        u.rows = nullptr; u.nvalid = 0; u.lda = lda; u.ldb = ldb; u.type = 0; u.e = 0; u.x0 = 0;
        u.pn = L / nM; u.pm = L % nM;
        u.A = A + (size_t)u.pm * 256 * lda; u.B = B + (size_t)u.pn * 256 * ldb + (size_t)(u.pm / bdiv) * bstride;
        return true;
    }
};
struct EpiResid {
    static constexpr bool AFTER_DRAIN = false;
    const float* base; float* out; bf16_t* outb; float* part;
    DI void operator()(const f32x4 (&acc)[2][2][4][2], const pg8::UnitD& u, int wr, int wc, int fr, int fq) const {
        { int ln_ = threadIdx.x; asm volatile("" : "+v"(ln_)); fr = ln_ & 15; fq = (ln_ >> 4) & 3; }
        const int row0 = u.pm * 256 + wr * 64 + fr, col0 = u.pn * 256 + wc * 32 + 8 * fq;
#pragma unroll
        for (int ai = 0; ai < 2; ++ai)
#pragma unroll
            for (int m = 0; m < 4; ++m) { const size_t row = (size_t)(row0 + ai * 128 + m * 16); float ss = 0.f;
#pragma unroll
                for (int bj = 0; bj < 2; ++bj) { const size_t idx = row * 2048 + col0 + bj * 128;
                    f32x4 v0 = acc[ai][bj][m][0] + *(const f32x4*)(base + idx), v1 = acc[ai][bj][m][1] + *(const f32x4*)(base + idx + 4);
                    *(f32x4*)(out + idx) = v0; *(f32x4*)(out + idx + 4) = v1;
                    if (outb) { u32x4 w; w.x = pk2(v0[0], v0[1]); w.y = pk2(v0[2], v0[3]); w.z = pk2(v1[0], v1[1]); w.w = pk2(v1[2], v1[3]); *(u32x4*)(outb + idx) = w; }
                    ss += (v0[0] * v0[0] + v0[1] * v0[1]) + (v0[2] * v0[2] + v0[3] * v0[3]) + (v1[0] * v1[0] + v1[1] * v1[1]) + (v1[2] * v1[2] + v1[3] * v1[3]); }
                if (part) { ss += __shfl_xor(ss, 16); ss += __shfl_xor(ss, 32); if (fq == 0) part[row * 32 + u.pn * 4 + wc] = ss; } }
    }
};

struct EpiQ {
    static constexpr bool AFTER_DRAIN = false;
    bf16_t* outb; float* part;
    DI void operator()(const f32x4 (&acc)[2][2][4][2], const pg8::UnitD& u, int wr, int wc, int fr, int fq) const {
        { int ln_ = threadIdx.x; asm volatile("" : "+v"(ln_)); fr = ln_ & 15; fq = (ln_ >> 4) & 3; }
        const int row0 = u.pm * 256 + wr * 64 + fr, col0 = u.pn * 256 + wc * 32 + 8 * fq;
#pragma unroll
        for (int ai = 0; ai < 2; ++ai)
#pragma unroll
            for (int m = 0; m < 4; ++m) { const size_t row = (size_t)(row0 + ai * 128 + m * 16); float ss = 0.f;
#pragma unroll
                for (int bj = 0; bj < 2; ++bj) { const size_t idx = row * 2048 + col0 + bj * 128; const f32x4 v0 = acc[ai][bj][m][0], v1 = acc[ai][bj][m][1];
                    u32x4 w; w.x = pk2(v0[0], v0[1]); w.y = pk2(v0[2], v0[3]); w.z = pk2(v1[0], v1[1]); w.w = pk2(v1[2], v1[3]); *(u32x4*)(outb + idx) = w;
                    ss += (v0[0] * v0[0] + v0[1] * v0[1]) + (v0[2] * v0[2] + v0[3] * v0[3]) + (v1[0] * v1[0] + v1[1] * v1[1]) + (v1[2] * v1[2] + v1[3] * v1[3]); }
                ss += __shfl_xor(ss, 16); ss += __shfl_xor(ss, 32); if (fq == 0) part[row * 32 + u.pn * 4 + wc] = ss; }
    }
};

struct SchedXS {
    int G, c; const unsigned char* ws;
    DI bool next(int i, pg8::UnitD& u) const {
        const int L = i * G + c; if (L >= 256) return false;
        u.rows = nullptr; u.nvalid = 0; u.e = 0;
        const int q = L & 127, bh = q >> 3, t8 = q & 7, b = bh >> 2, h = bh & 3;
        u.pm = b; u.pn = h; u.x0 = t8;
        if (L < 128) { u.type = 0; u.lda = 4096u; u.ldb = 1024u;
            u.A = (const char*)(ws + WS_QRAW) + (size_t)(b * 2048 + t8 * 256) * 4096 + h * 1024; u.B = (const char*)(ws + WS_KN) + (size_t)(bh * 256) * 1024; }
        else { u.type = 1; u.lda = 4096u; u.ldb = 8192u;
            u.A = (const char*)(ws + WS_WO) + (size_t)(t8 * 256) * 4096 + h * 1024; u.B = (const char*)(ws + WS_KVRAW) + (size_t)(b * 256) * 8192 + (2048 + h * 512) * 2; }
        return true;
    }
};
struct EpiXS {
    static constexpr bool AFTER_DRAIN = false;
    bf16_t* P; bf16_t* VWT; const float* part1; const float* partq; LAS float* red;
    DI void operator()(const f32x4 (&acc)[2][2][4][2], const pg8::UnitD& u, int wr, int wc, int fr, int fq) const {
        { int ln_ = threadIdx.x; asm volatile("" : "+v"(ln_)); fr = ln_ & 15; fq = (ln_ >> 4) & 3; }
        const int b = u.pm, h = u.pn, t8 = u.x0;
        const int col0 = wc * 32 + 8 * fq;
        if (u.type == 1) {
            char* Vu = (char*)(VWT + ((size_t)b * 2048 + t8 * 256) * 1024 + h * 256);
#pragma unroll
            for (int ai = 0; ai < 2; ++ai)
#pragma unroll
                for (int m = 0; m < 4; ++m) { const unsigned rl = (unsigned)(ai * 128 + wr * 64 + m * 16 + fr);
#pragma unroll
                    for (int bj = 0; bj < 2; ++bj) { const f32x4 v0 = acc[ai][bj][m][0], v1 = acc[ai][bj][m][1];
                        u32x4 w; w.x = pk2(v0[0], v0[1]); w.y = pk2(v0[2], v0[3]); w.z = pk2(v1[0], v1[1]); w.w = pk2(v1[2], v1[3]);
                        *(u32x4*)(Vu + (rl * 1024u + (unsigned)(bj * 128 + col0)) * 2u) = w; } }
            return;
        }
        const size_t row0 = (size_t)b * 2048 + t8 * 256;
        const char* p1u = (const char*)(part1 + row0 * 32); const char* pqu = (const char*)(partq + row0 * 32 + h * 8); char* Pu = (char*)(P + row0 * 1024 + h * 256);
        float rsc[2][4];
#pragma unroll
        for (int ai = 0; ai < 2; ++ai)
#pragma unroll
            for (int m = 0; m < 4; ++m) { const unsigned rl = (unsigned)(ai * 128 + wr * 64 + m * 16 + fr);
                const f32x4 p0 = *(const f32x4*)(p1u + (rl * 32u + (unsigned)fq * 8u) * 4u), p1 = *(const f32x4*)(p1u + (rl * 32u + (unsigned)fq * 8u + 4u) * 4u);
                float s1 = (p0[0] + p0[1]) + (p0[2] + p0[3]) + (p1[0] + p1[1]) + (p1[2] + p1[3]);
                const f32x2 pq = *(const f32x2*)(pqu + (rl * 32u + (unsigned)fq * 2u) * 4u);
                float sq = pq[0] + pq[1];
                s1 += __shfl_xor(s1, 16); s1 += __shfl_xor(s1, 32); sq += __shfl_xor(sq, 16); sq += __shfl_xor(sq, 32);
                rsc[ai][m] = __builtin_amdgcn_rsqf(sq * (1.f / 512.f) + EPS_ * (s1 * (1.f / 2048.f) + EPS_)) * 1.4426950408889634f;
                float ps = 0.f;
#pragma unroll
                for (int bj = 0; bj < 2; ++bj)
#pragma unroll
                    for (int n = 0; n < 2; ++n)
#pragma unroll
                        for (int e = 0; e < 4; ++e) ps += __builtin_amdgcn_exp2f(fminf(acc[ai][bj][m][n][e] * rsc[ai][m], 100.f));
                ps += __shfl_xor(ps, 16); ps += __shfl_xor(ps, 32);
                if (fq == 0) red[rl * 4 + wc] = ps;
                __builtin_amdgcn_sched_barrier(0); }
        __syncthreads();
        { int ln_ = threadIdx.x; asm volatile("" : "+v"(ln_)); fr = ln_ & 15; fq = (ln_ >> 4) & 3; }
#pragma unroll
        for (int ai = 0; ai < 2; ++ai)
#pragma unroll
            for (int m = 0; m < 4; ++m) { const unsigned rl = (unsigned)(ai * 128 + wr * 64 + m * 16 + fr);
                const f32x4 t = *(const LAS f32x4*)(red + rl * 4); const float inv = __builtin_amdgcn_rcpf((t[0] + t[1]) + (t[2] + t[3])); float rs = rsc[ai][m]; asm volatile("" : "+v"(rs));
#pragma unroll
                for (int bj = 0; bj < 2; ++bj) { float x[8];
#pragma unroll
                    for (int n = 0; n < 2; ++n)
#pragma unroll
                        for (int e = 0; e < 4; ++e) x[n * 4 + e] = __builtin_amdgcn_exp2f(fminf(acc[ai][bj][m][n][e] * rs, 100.f)) * inv;
                    u32x4 w; w.x = pk2(x[0], x[1]); w.y = pk2(x[2], x[3]); w.z = pk2(x[4], x[5]); w.w = pk2(x[6], x[7]);
                    *(u32x4*)(Pu + (rl * 1024u + (unsigned)(bj * 128 + wc * 32 + 8 * fq)) * 2u) = w; } }
        __syncthreads();
    }
};

constexpr int HNP = 2052;
DI void p8_route(Frame& F, const ArgP& a) {
    LAS float* s_hn = (LAS float*)F.lds; LAS float* s_part = (LAS float*)(F.lds + 16 * HNP * 4); LAS float* s_log = s_part + 8 * 16 * 32; LAS int* s_slot = (LAS int*)(s_log + 16 * 32);
    const float* h2 = (const float*)(F.ws + WS_H2); unsigned char* xg = (unsigned char*)(F.ws + WS_XG);
    float* gate_of = (float*)(F.ws + WS_GATEOF); int* tok_e = (int*)(F.ws + WS_TOKE);
    const float* rw = a.in(I_RW); const float* rb = a.in(I_RB); const float* g3 = a.in(I_GFFN);
    const int lane = F.lane, wave = F.wave, tid = F.tid, hh = lane >> 5;
    for (int task = F.vcu; task < NTOK / 16; task += F.G) {
        const int tb = task * 16;
#pragma unroll
        for (int q = 0; q < 2; ++q) { const int tl = 2 * wave + q; const size_t tok = (size_t)(tb + tl);
            const f32x4* xr = (const f32x4*)(h2 + tok * 2048) + lane;
            f32x4 v[8]; float s = 0.f;
#pragma unroll
            for (int j = 0; j < 8; ++j) { v[j] = xr[64 * j]; s += (v[j].x * v[j].x + v[j].y * v[j].y) + (v[j].z * v[j].z + v[j].w * v[j].w); }
            const float rstd = 1.f / sqrtf(wave_sum(s) * (1.f / 2048.f) + EPS_);
#pragma unroll
            for (int j = 0; j < 8; ++j) { const f32x4 gg = ((const f32x4*)g3)[lane + 64 * j]; const f32x4 y = v[j] * rstd * gg;
                *(LAS f32x4*)(s_hn + tl * HNP + (lane + 64 * j) * 4) = y; } }
        __syncthreads();
        {
            f32x16 acc; for (int i = 0; i < 16; ++i) acc[i] = 0.f;
            const LAS float* ap = s_hn + (lane & 15) * HNP + 256 * wave; const float* bp = rw + (size_t)(256 * wave + hh) * 32 + (lane & 31);
#pragma unroll 8
            for (int j = 0; j < 64; ++j) { const f32x4 a4 = *(const LAS f32x4*)(ap + 4 * j);
                const float b1 = bp[(size_t)(4 * j) * 32], b2 = bp[(size_t)(4 * j + 2) * 32];
                acc = __builtin_amdgcn_mfma_f32_32x32x2f32(hh ? a4.y : a4.x, b1, acc, 0, 0, 0);
                acc = __builtin_amdgcn_mfma_f32_32x32x2f32(hh ? a4.w : a4.z, b2, acc, 0, 0, 0); }
            LAS float* pp = s_part + wave * 512 + (lane & 31);
#pragma unroll
            for (int r = 0; r < 8; ++r) pp[crow(r, hh) * 32] = acc[r];
        }
        __syncthreads();
        { const int tt = tid >> 5, e = tid & 31; float s = rb[e];
#pragma unroll
          for (int w = 0; w < 8; ++w) s += s_part[w * 512 + tt * 32 + e];
          s_log[tt * 32 + e] = s; }
        __syncthreads();
        if (tid < 16) { const int tok = tb + tid; unsigned taken = 0u; float val[4]; int idx[4];
#pragma unroll
            for (int k = 0; k < 4; ++k) { float best = -INFINITY; int bi = 0;
                for (int e = 0; e < 32; ++e) { const float v = s_log[tid * 32 + e]; if (!((taken >> e) & 1u) && v > best) { best = v; bi = e; } }
                taken |= 1u << bi; val[k] = best; idx[k] = bi; }
            float ex[4], sum = 0.f;
#pragma unroll
            for (int k = 0; k < 4; ++k) { ex[k] = __expf(val[k] - val[0]); sum += ex[k]; }
#pragma unroll
            for (int k = 0; k < 4; ++k) { const int e = idx[k];
                const unsigned rank = __hip_atomic_fetch_add(F.ctl + CW_CNT + 64 * e, 1u, __ATOMIC_RELAXED, __HIP_MEMORY_SCOPE_AGENT);
                gate_of[e * 8192 + rank] = ex[k] / sum; tok_e[tok * 4 + k] = e * 8192 + (int)rank; s_slot[tid * 4 + k] = e * 8192 + (int)rank; } }
        __syncthreads();
#pragma unroll
        for (int q = 0; q < 2; ++q) { const int tl = 2 * wave + q;
            unsigned o[8];
#pragma unroll
            for (int j = 0; j < 8; ++j) { const f32x4 y = *(const LAS f32x4*)(s_hn + tl * HNP + (lane + 64 * j) * 4);
                unsigned w = 0u; w = __builtin_amdgcn_cvt_pk_fp8_f32(y.x * 4.f, y.y * 4.f, w, false); w = __builtin_amdgcn_cvt_pk_fp8_f32(y.z * 4.f, y.w * 4.f, w, true); o[j] = w; }
#pragma unroll
            for (int k = 0; k < 4; ++k) { unsigned* o4 = (unsigned*)(xg + (size_t)s_slot[tl * 4 + k] * 2048) + lane;
#pragma unroll
                for (int j = 0; j < 8; ++j) o4[64 * j] = o[j]; } }
        __syncthreads();
    }
}

DI void moe_tables(Frame& F) {
    if (F.tid == 0) { unsigned base = 0u;
        for (int e = 0; e < 32; ++e) { const unsigned c = F.ctl[CW_CNT + 64 * e], mt = (c + 255u) >> 8; F.MISC[16 + e] = c; F.MISC[48 + e] = base; F.MISC[80 + e] = mt; base += mt; }
        F.MISC[112] = base; }
    __syncthreads();
}
DI int ldsu(volatile LAS unsigned* p) { return __builtin_amdgcn_readfirstlane((int)*p); }
template <int NTN  >
struct SchedMoe {
    int G, c; const unsigned char* ws; volatile LAS unsigned* MISC;
    DI bool next(int i, pg8::UnitD& u) const {
        const int L = i * G + c; const int total = ldsu(MISC + 112) * NTN; if (L >= total) return false;
        int e = 0;
        for (int k = 0; k < 32; ++k) { if (L >= (ldsu(MISC + 48 + k) + ldsu(MISC + 80 + k)) * NTN) e = k + 1; }
        const int tb = ldsu(MISC + 48 + e), mte = ldsu(MISC + 80 + e), cnt = ldsu(MISC + 16 + e);
        const int local = L - tb * NTN, nt = local / mte, mt = local % mte;
        u.type = 0; u.e = e; u.pn = nt; u.pm = tb + mt; u.x0 = mt; u.lda = 2048u; u.ldb = 2048u;
        u.rows = nullptr; u.nvalid = cnt - mt * 256;
        if (NTN == 16) { u.A = (const char*)(ws + WS_XG) + ((size_t)e * 8192 + (size_t)mt * 256) * 2048;
            u.B = (const char*)(ws + WS_W1) + ((size_t)e * 4096 + (size_t)nt * 256) * 2048; }
        else { u.A = (const char*)(ws + WS_ACT) + ((size_t)e * 8192 + (size_t)mt * 256) * 2048;
            u.B = (const char*)(ws + WS_W2) + ((size_t)e * 2048 + (size_t)nt * 256) * 2048; }
        return true;
    }
};
struct EpiMoe1 {
    static constexpr bool AFTER_DRAIN = false;
    unsigned char* act; const float* b1;
    DI void operator()(const f32x4 (&acc)[2][2][4][2], const pg8::UnitD& u, int wr, int wc, int fr, int fq) const {
        { int ln_ = threadIdx.x; asm volatile("" : "+v"(ln_)); fr = ln_ & 15; fq = (ln_ >> 4) & 3; }
        const int j0 = u.pn * 128 + wc * 32 + 8 * fq;
        const float* bg = b1 + (size_t)u.e * 4096 + j0; const float* bu = bg + 2048;
        const f32x4 bg0 = *(const f32x4*)bg, bg1 = *(const f32x4*)(bg + 4), bu0 = *(const f32x4*)bu, bu1 = *(const f32x4*)(bu + 4);
#pragma unroll
        for (int ai = 0; ai < 2; ++ai)
#pragma unroll
            for (int m = 0; m < 4; ++m) { const size_t row = (size_t)u.e * 8192 + u.x0 * 256 + ai * 128 + wr * 64 + m * 16 + fr;
                float o[8];
#pragma unroll
                for (int n = 0; n < 2; ++n)
#pragma unroll
                    for (int e = 0; e < 4; ++e) { const float g = fminf(acc[ai][0][m][n][e] * (1.f / 256.f) + (n ? bg1[e] : bg0[e]), 7.f);
                        const float uu = fminf(fmaxf(acc[ai][1][m][n][e] * (1.f / 256.f) + (n ? bu1[e] : bu0[e]), -7.f), 7.f);
                        o[n * 4 + e] = g / (1.f + __expf(-1.702f * g)) * (uu + 1.f) * 4.f; }
                u32x2 w; w.x = __builtin_amdgcn_cvt_pk_fp8_f32(o[0], o[1], 0u, false); w.x = __builtin_amdgcn_cvt_pk_fp8_f32(o[2], o[3], w.x, true);
                w.y = __builtin_amdgcn_cvt_pk_fp8_f32(o[4], o[5], 0u, false); w.y = __builtin_amdgcn_cvt_pk_fp8_f32(o[6], o[7], w.y, true);
                *(u32x2*)(act + row * 2048 + j0) = w; }
    }
};
struct EpiMoe2 {
    static constexpr bool AFTER_DRAIN = false;
    bf16_t* y; const float* b2; const float* gate_of;
    DI void operator()(const f32x4 (&acc)[2][2][4][2], const pg8::UnitD& u, int wr, int wc, int fr, int fq) const {
        { int ln_ = threadIdx.x; asm volatile("" : "+v"(ln_)); fr = ln_ & 15; fq = (ln_ >> 4) & 3; }
        const int col0 = u.pn * 256 + wc * 32 + 8 * fq;
        const float* bp = b2 + (size_t)u.e * 2048 + col0;
#pragma unroll
        for (int ai = 0; ai < 2; ++ai)
#pragma unroll
            for (int m = 0; m < 4; ++m) { const int rl = ai * 128 + wr * 64 + m * 16 + fr; const size_t row = (size_t)u.e * 8192 + u.x0 * 256 + rl;
                const float gt = (rl < u.nvalid) ? gate_of[u.e * 8192 + u.x0 * 256 + rl] : 0.f;
#pragma unroll
                for (int bj = 0; bj < 2; ++bj) { const f32x4 v0 = (acc[ai][bj][m][0] * (1.f / 256.f) + *(const f32x4*)(bp + bj * 128)) * gt, v1 = (acc[ai][bj][m][1] * (1.f / 256.f) + *(const f32x4*)(bp + bj * 128 + 4)) * gt;
                    u32x4 w; w.x = pk2(v0[0], v0[1]); w.y = pk2(v0[2], v0[3]); w.z = pk2(v1[0], v1[1]); w.w = pk2(v1[2], v1[3]);
                    *(u32x4*)(y + row * 2048 + col0 + bj * 128) = w; } }
    }
};

DI void p11_combine(Frame& F, const ArgP& a) {
    const int gw = F.vcu * NWAVES + F.wave, NGW = F.G * NWAVES, lane = F.lane;
    const float* h2 = (const float*)(F.ws + WS_H2); const bf16_t* y = (const bf16_t*)(F.ws + WS_Y);
    const int* tok_e = (const int*)(F.ws + WS_TOKE);
    for (int t = gw; t < NTOK; t += NGW) {
        size_t yrow[4];
#pragma unroll
        for (int k = 0; k < 4; ++k) yrow[k] = (size_t)tok_e[t * 4 + k] * 2048;
#pragma unroll
        for (int j = 0; j < 8; ++j) { const int c = (lane + 64 * j) * 4;
            f32x4 v = *(const f32x4*)(h2 + (size_t)t * 2048 + c);
#pragma unroll
            for (int k = 0; k < 4; ++k) { const u32x2 w = *(const u32x2*)(y + yrow[k] + c); v.x += bflo(w.x); v.y += bfhi(w.x); v.z += bflo(w.y); v.w += bfhi(w.y); }
            *(f32x4*)(a.out() + (size_t)t * 2048 + c) = v; }
    }
}

#ifndef MK_PER_PHASE
#define MK_PER_PHASE 0
#endif
#ifndef MK_LAST_PHASE
#define MK_LAST_PHASE 12
#endif
constexpr int N_PHASES = MK_LAST_PHASE;

__global__ void __launch_bounds__(NWAVES * 64, 2) mega_fwd(Args args_) {
    const ArgP args{};
    extern __shared__ __attribute__((aligned(16))) unsigned char lds_raw[];
    Frame F;
    F.lds = (LAS unsigned char*)lds_raw;
    F.MISC = (volatile LAS unsigned*)(F.lds + MISC_OFF);
    F.tid = threadIdx.x; F.lane = F.tid & 63; F.wave = __builtin_amdgcn_readfirstlane(F.tid >> 6);
    F.G = gridDim.x; { const int bx = blockIdx.x; F.vcu = (F.G % 8 == 0) ? (bx % 8) * (F.G / 8) + bx / 8 : bx; }
    F.ws = args_.ws; F.ctl = (unsigned*)(args_.ws + WS_CTL);
    for (int u = F.tid; u < 256; u += NWAVES * 64) F.MISC[u] = 0u;
    __syncthreads();
    XcdBarrier bar; bar.bar = F.ctl + CW_BAR; bar.x = 0; bar.st = nullptr;
    const int lo = args_.ph_lo, hi = args_.ph_hi;
    if (hi - lo > 1) bar = xcd_barrier_post(F.ctl + CW_BAR, F.MISC + 8);
#ifndef MK_PHASE_MASK
#define MK_PHASE_MASK 0xFFFF
#endif
#define IN(k) (((MK_PHASE_MASK >> (k)) & 1) && lo <= (k) && (k) < hi)
#define SEAM(k) do { if (IN(k) && IN((k) + 1)) xcd_barrier(bar); } while (0)
#define FRESH() do { int t_ = threadIdx.x; asm volatile("" : "+v"(t_)); F.tid = t_; F.lane = t_ & 63; F.wave = __builtin_amdgcn_readfirstlane(t_ >> 6); } while (0)
    unsigned char* ws = args_.ws;

    if (IN(0)) { FRESH(); p0_prologue(F, args); }
    SEAM(0);
    if (IN(1)) { FRESH();
        SchedP1 S{F.G, F.vcu, ws};
        EpiP1 E{(bf16_t*)(ws + WS_PROJ), (float*)(ws + WS_DT), (bf16_t*)(ws + WS_KVRAW), args.in(I_DAQG), args.in(I_DAKG)};
        pg8::gemm_phase<EpiP1, SchedP1, false, true>(F.lds + RING_OFF, 32, S, E);
    }
    SEAM(1);
    if (IN(2)) { FRESH();
        kprep(F, args);
        for (int u = F.vcu; u < 64; u += F.G) ssd_unit(F, args, u >> 4, u & 15);
        __syncthreads();
        attn_phase_da(F);
    }
    SEAM(2);
    if (IN(3)) { FRESH(); p3_finalize(F, args); }
    SEAM(3);
    if (IN(4)) { FRESH();
        SchedDense S{F.G, F.vcu, 32, 8, (const char*)(ws + WS_YCAT), (const char*)(ws + WS_WOUT), 4096u, 4096u, 1 << 30, 0};
#if MK_LAST_PHASE == 5
        EpiResid E{args.in(I_X), args_.out, nullptr, nullptr};
#else
        EpiResid E{args.in(I_X), (float*)(ws + WS_H1), (bf16_t*)(ws + WS_H1B), (float*)(ws + WS_PART1)};
#endif
        pg8::gemm_phase<EpiResid, SchedDense, false, true>(F.lds + RING_OFF, 32, S, E);
    }
    SEAM(4);
    if (IN(5)) { FRESH();
        SchedDense S{F.G, F.vcu, 32, 8, (const char*)(ws + WS_H1B), (const char*)(ws + WS_WQ), 4096u, 4096u, 1 << 30, 0};
        EpiQ E{(bf16_t*)(ws + WS_QRAW), (float*)(ws + WS_PARTQ)};
        pg8::gemm_phase<EpiQ, SchedDense, false, true>(F.lds + RING_OFF, 32, S, E);
    }
    SEAM(5);
    if (IN(6)) { FRESH();
        SchedXS S{F.G, F.vcu, ws};
        EpiXS E{(bf16_t*)(ws + WS_P), (bf16_t*)(ws + WS_VWT), (const float*)(ws + WS_PART1), (const float*)(ws + WS_PARTQ), (LAS float*)(F.lds + RING_BYTES)};
        pg8::gemm_phase<EpiXS, SchedXS, false, true>(F.lds + RING_OFF, 8, S, E);
    }
    SEAM(6);
    if (IN(7)) { FRESH();
        SchedDense S{F.G, F.vcu, 32, 8, (const char*)(ws + WS_P), (const char*)(ws + WS_VWT), 2048u, 2048u, 8, (size_t)2048 * 1024 * 2};
#if MK_LAST_PHASE == 8
        EpiResid E{(const float*)(ws + WS_H1), args_.out, nullptr, nullptr};
#else
        EpiResid E{(const float*)(ws + WS_H1), (float*)(ws + WS_H2), nullptr, nullptr};
#endif
        pg8::gemm_phase<EpiResid, SchedDense, false, true>(F.lds + RING_OFF, 16, S, E);
    }
    SEAM(7);
    if (IN(8)) { FRESH(); p8_route(F, args); }
    SEAM(8);
    if (IN(9)) { FRESH();
        moe_tables(F);
        SchedMoe<16> S{F.G, F.vcu, ws, F.MISC};
        EpiMoe1 E{(unsigned char*)(ws + WS_ACT), args.in(I_B1)};
        pg8::gemm_phase<EpiMoe1, SchedMoe<16>, false, true, true>(F.lds + RING_OFF, 16, S, E);
    }
    SEAM(9);
    if (IN(10)) { FRESH();
        moe_tables(F);
        SchedMoe<8> S{F.G, F.vcu, ws, F.MISC};
        EpiMoe2 E{(bf16_t*)(ws + WS_Y), args.in(I_B2), (const float*)(ws + WS_GATEOF)};
        pg8::gemm_phase<EpiMoe2, SchedMoe<8>, false, true, true>(F.lds + RING_OFF, 16, S, E);
    }
    SEAM(10);
    if (IN(11)) { FRESH(); p11_combine(F, args); }
#undef IN
#undef SEAM
}

extern "C" void kernel_launch(void* const* d_in, const int* in_sizes, int n_in, void* d_out, int out_size, void* d_ws, size_t ws_size, hipStream_t stream) {
    static int grid = 0;
    if (grid == 0) {
        if (n_in != 32 || out_size != NTOK * 2048 || ws_size < WS_END) { fprintf(stderr, "kernel_launch: unexpected shapes (n_in %d out %d ws %zu); nothing launched\n", n_in, out_size, ws_size); grid = -1; return; }
        int dev = 0, cus = 0, per_cu = 0;
        if (hipGetDevice(&dev) != hipSuccess || hipDeviceGetAttribute(&cus, hipDeviceAttributeMultiprocessorCount, dev) != hipSuccess) { grid = -1; return; }
        if (hipFuncSetAttribute((const void*)mega_fwd, hipFuncAttributeMaxDynamicSharedMemorySize, LDS_BYTES) != hipSuccess) { fprintf(stderr, "kernel_launch: hipFuncSetAttribute failed\n"); grid = -1; return; }
        if (hipOccupancyMaxActiveBlocksPerMultiprocessor(&per_cu, (const void*)mega_fwd, NWAVES * 64, LDS_BYTES) != hipSuccess || per_cu < 1) { fprintf(stderr, "kernel_launch: occupancy query says %d\n", per_cu); }
        (void)hipGetLastError();
        if (cus < 256) { fprintf(stderr, "kernel_launch: needs 256 CUs, found %d; nothing launched\n", cus); grid = -1; return; }
        grid = 256;
    }
    if (grid < 0) return;
    if (hipMemsetAsync((char*)d_ws + WS_CTL, 0, CTL_ZERO_BYTES, stream) != hipSuccess) return;
    Args a{};
    for (int i = 0; i < 32; ++i) a.in[i] = (const float*)d_in[i];
    a.out = (float*)d_out; a.ws = (unsigned char*)d_ws;
#if MK_PER_PHASE
    for (int p = 0; p < N_PHASES; ++p) { a.ph_lo = p; a.ph_hi = p + 1; hipLaunchKernelGGL(mega_fwd, dim3(grid), dim3(NWAVES * 64), LDS_BYTES, stream, a); }
#else
    a.ph_lo = 0; a.ph_hi = N_PHASES;
    hipLaunchKernelGGL(mega_fwd, dim3(grid), dim3(NWAVES * 64), LDS_BYTES, stream, a);
#ifdef MK_PROBE_LO
    for (int p = MK_PROBE_LO; p < MK_PROBE_HI; ++p) { a.ph_lo = p; a.ph_hi = p + 1; hipLaunchKernelGGL(mega_fwd, dim3(grid), dim3(NWAVES * 64), LDS_BYTES, stream, a); }
#endif
#endif
}
```

```cpp
#define MK_PER_PHASE 0
#define MK_LAST_PHASE 12
#include <hip/hip_runtime.h>
#include <hip/hip_bf16.h>
#include <cstdio>
#include <cstdint>
#include <cmath>

#define GAS __attribute__((address_space(1)))
#define LAS __attribute__((address_space(3)))
typedef unsigned short bf16_t;
typedef short bf16x8 __attribute__((ext_vector_type(8)));
typedef float f32x2 __attribute__((ext_vector_type(2)));
typedef float f32x4 __attribute__((ext_vector_type(4)));
typedef float f32x16 __attribute__((ext_vector_type(16)));
typedef unsigned u32x2 __attribute__((ext_vector_type(2)));
typedef unsigned u32x4 __attribute__((ext_vector_type(4)));
typedef __bf16 bf16x2_t __attribute__((ext_vector_type(2)));

#define DI __device__ __forceinline__
DI unsigned pk2(float lo, float hi) { f32x2 v = {lo, hi}; bf16x2_t b = __builtin_convertvector(v, bf16x2_t); return __builtin_bit_cast(unsigned, b); }
DI float bflo(unsigned u) { return __uint_as_float(u << 16); }
DI float bfhi(unsigned u) { return __uint_as_float(u & 0xffff0000u); }
DI float bf2f(bf16_t h) { return __uint_as_float(((unsigned)h) << 16); }
DI float wave_sum(float v) {
#pragma unroll
    for (int o = 1; o < 64; o <<= 1) v += __shfl_xor(v, o);
    return v;
}
DI float siluf(float x) { return x / (1.f + __expf(-x)); }

constexpr int DM_ = 2048, NB = 4, SEQ_ = 2048, NTOK = NB * SEQ_;
constexpr int PP = 5632;
constexpr int PC_XBC = 1024, PC_Q = 2560, PC_K = 3584, PC_V = 4608, PC_DT = 5632;
constexpr int WIN_ROWS = 5888;
constexpr int NEXP = 32, MEMLEN = 256;
constexpr float EPS_ = 1e-6f;
constexpr float LAM_INIT = 0.2f;

namespace pg8 {
constexpr int BM = 256, BK = 64, HALF = 128, HTB = HALF * BK * 2  , STAGE_BYTES = 8 * HTB;
DI int lds_byte(int r, int c) { const int st = (r >> 4) * 2 + (c >> 5), rr = r & 15, cc = c & 31, ob = rr * 64 + cc * 2; return st * 1024 + (ob ^ (((ob >> 9) & 1) << 5)); }
DI void stage_rc(int b, int& R, int& C) { const int st = b / 1024, sb = b % 1024, swz = sb ^ (((sb >> 9) & 1) << 5); R = (st >> 1) * 16 + swz / 64; C = (st & 1) * 32 + (swz % 64) / 2; }
DI int perm32(int rho) { const int n = rho >> 4, i = rho & 15; return 8 * (i >> 2) + 4 * n + (i & 3); }

struct UnitD {
    const char* A; const char* B;
    const int* rows;
    unsigned lda, ldb;
    int nvalid;
    int type, pm, pn, e, x0;
};
typedef int v8i_t __attribute__((ext_vector_type(8)));
DI v8i_t cat8(bf16x8 lo, bf16x8 hi) { typedef int v4i_t __attribute__((ext_vector_type(4))); const v4i_t a = __builtin_bit_cast(v4i_t, lo), b = __builtin_bit_cast(v4i_t, hi); return (v8i_t){a[0], a[1], a[2], a[3], b[0], b[1], b[2], b[3]}; }
DI void dense_voff(unsigned lda, unsigned ldb, int tid, unsigned (&vA)[2], unsigned (&vB)[2]) {
#pragma unroll
    for (int i = 0; i < 2; ++i) { int R, C; stage_rc(tid * 16 + i * 8192, R, C); const int Rb = (R & ~31) + perm32(R & 31);
        vA[i] = (unsigned)R * lda + (unsigned)C * 2u; vB[i] = (unsigned)Rb * ldb + (unsigned)C * 2u; }
}
DI void gather_voff(const UnitD& u, int tid, unsigned (&gA)[2][2]) {
#pragma unroll
    for (int i = 0; i < 2; ++i) { int R, C; stage_rc(tid * 16 + i * 8192, R, C);
#pragma unroll
        for (int h = 0; h < 2; ++h) { const int ra = h * 128 + R; const unsigned rowA = (ra < u.nvalid) ? (unsigned)u.rows[ra] : 0u; gA[h][i] = rowA * u.lda + (unsigned)C * 2u; } }
}

template <class Epi, class Sched, bool GATHER, bool ALIGN_EPI, bool FP8 = false>
DI void gemm_phase(LAS unsigned char* lds, int nt, const Sched& S, const Epi& E) {

    const int tid = threadIdx.x, wid = __builtin_amdgcn_readfirstlane(tid >> 6), lane = tid & 63, wr = wid >> 2, wc = wid & 3, fr = lane & 15, fq = lane >> 4;
    const size_t kstep = (size_t)(BK * 2);
    const unsigned ldsb = (unsigned)__builtin_amdgcn_readfirstlane((int)((unsigned)(uintptr_t)lds + (unsigned)wid * 1024u));
    const int aoff = lds_byte(wr * 64 + fr, fq * 8), boff = lds_byte(wc * 32 + fr, fq * 8);
#define PG8_SA(b, h) (((b) * 2 + (h)) * HTB)
#define PG8_SB(b, h) ((4 + (b) * 2 + (h)) * HTB)
#define PG8_STAGE(bufoff, gbase, voff) do { _Pragma("unroll") for (int _i = 0; _i < 2; ++_i) { unsigned keep_; \
        asm volatile("s_mov_b32 %0, m0\n\ts_mov_b32 m0, %3\n\ts_nop 0\n\tglobal_load_lds_dwordx4 %1, %2\n\ts_mov_b32 m0, %0" \
                     : "=&s"(keep_) : "v"((voff)[_i]), "s"((const char*)(gbase)), "s"(ldsb + (unsigned)((bufoff) + _i * 8192)) : "memory"); } } while (0)
#define PG8_STA(bufoff, gbase, h, HS, GA) do { if constexpr (GATHER) { PG8_STAGE(bufoff, gbase, GA[h]); } else { PG8_STAGE(bufoff, (gbase) + (h) * (HS), vA); } } while (0)
#define PG8_STB(bufoff, gbase, h, HS) PG8_STAGE(bufoff, (gbase) + (h) * (HS), vB)
typedef int v4i_t __attribute__((ext_vector_type(4)));
#define PG8_LDA(dst, b, h) do { _Pragma("unroll") for (int m = 0; m < 4; ++m) { if constexpr (FP8) { \
            const v4i_t lo_ = *(const LAS v4i_t*)(lds + PG8_SA(b, h) + aoff + m * 2048), hi_ = *(const LAS v4i_t*)(lds + PG8_SA(b, h) + aoff + m * 2048 + 1024); \
            dst##8[m] = __builtin_shufflevector(lo_, hi_, 0, 1, 2, 3, 4, 5, 6, 7); } \
        else { _Pragma("unroll") for (int k = 0; k < 2; ++k) dst[m][k] = *(const LAS bf16x8*)(lds + PG8_SA(b, h) + aoff + m * 2048 + k * 1024); } } } while (0)
#define PG8_LDB(dst, b, h) do { _Pragma("unroll") for (int n = 0; n < 2; ++n) { if constexpr (FP8) { \
            const v4i_t lo_ = *(const LAS v4i_t*)(lds + PG8_SB(b, h) + boff + n * 2048), hi_ = *(const LAS v4i_t*)(lds + PG8_SB(b, h) + boff + n * 2048 + 1024); \
            dst##8[n] = __builtin_shufflevector(lo_, hi_, 0, 1, 2, 3, 4, 5, 6, 7); } \
        else { _Pragma("unroll") for (int k = 0; k < 2; ++k) dst[n][k] = *(const LAS bf16x8*)(lds + PG8_SB(b, h) + boff + n * 2048 + k * 1024); } } } while (0)
#define PG8_MMA(ai, bj, At, Bt) do { __builtin_amdgcn_s_setprio(1); _Pragma("unroll") for (int m = 0; m < 4; ++m) _Pragma("unroll") for (int n = 0; n < 2; ++n) { \
        if constexpr (FP8) { acc[ai][bj][m][n] = __builtin_amdgcn_mfma_scale_f32_16x16x128_f8f6f4(Bt##8[n], At##8[m], acc[ai][bj][m][n], 0, 0, 0, 0x7f7f7f7f, 0, 0x7f7f7f7f); } \
        else { _Pragma("unroll") for (int k = 0; k < 2; ++k) acc[ai][bj][m][n] = __builtin_amdgcn_mfma_f32_16x16x32_bf16(Bt[n][k], At[m][k], acc[ai][bj][m][n], 0, 0, 0); } } \
        __builtin_amdgcn_s_setprio(0); } while (0)
#define PG8_WAIT_V(n) asm volatile("s_waitcnt vmcnt(" #n ")" ::: "memory")
#define PG8_WAIT_L(n) asm volatile("s_waitcnt lgkmcnt(" #n ")" ::: "memory")
#define PG8_BAR __builtin_amdgcn_s_barrier()
#define PG8_SCHED __builtin_amdgcn_sched_barrier(0)
#define PG8_ITER(A1P, A2P, B2P, HA2, HB2, GA2) do { \
        const char* a3p_ = (A2P) + kstep; const char* b3p_ = (B2P) + kstep; \
        PG8_LDB(B0, 0, 0); PG8_LDB(B1, 0, 1); PG8_SCHED; PG8_LDA(At, 0, 0); PG8_STA(PG8_SA(1, 1), (A1P), 1, hsA, gA); \
        PG8_WAIT_V(8); PG8_WAIT_L(0); PG8_BAR; PG8_MMA(0, 0, At, B0); PG8_MMA(0, 1, At, B1); PG8_BAR; PG8_SCHED; \
        PG8_LDA(At, 0, 1); PG8_STB(PG8_SB(0, 0), (B2P), 0, HB2); PG8_STB(PG8_SB(0, 1), (B2P), 1, HB2); PG8_STA(PG8_SA(0, 0), (A2P), 0, HA2, GA2); \
        PG8_WAIT_V(8); PG8_WAIT_L(0); PG8_BAR; PG8_MMA(1, 0, At, B0); PG8_MMA(1, 1, At, B1); PG8_BAR; PG8_SCHED; \
        PG8_LDB(B0, 1, 0); PG8_LDB(B1, 1, 1); PG8_SCHED; PG8_LDA(At, 1, 0); PG8_STA(PG8_SA(0, 1), (A2P), 1, HA2, GA2); \
        PG8_WAIT_V(8); PG8_WAIT_L(0); PG8_BAR; PG8_MMA(0, 0, At, B0); PG8_MMA(0, 1, At, B1); PG8_BAR; PG8_SCHED; \
        PG8_LDA(At, 1, 1); PG8_STB(PG8_SB(1, 0), b3p_, 0, HB2); PG8_STB(PG8_SB(1, 1), b3p_, 1, HB2); PG8_STA(PG8_SA(1, 0), a3p_, 0, HA2, GA2); \
        PG8_WAIT_V(8); PG8_WAIT_L(0); PG8_BAR; PG8_MMA(1, 0, At, B0); PG8_MMA(1, 1, At, B1); PG8_BAR; PG8_SCHED; \
    } while (0)
    UnitD cur, nxt; int ui = 0;
    if (!S.next(0, cur)) return;
    f32x4 acc[2][2][4][2];
#pragma unroll
    for (int a = 0; a < 2; ++a)
#pragma unroll
        for (int b = 0; b < 2; ++b)
#pragma unroll
            for (int m = 0; m < 4; ++m)
#pragma unroll
                for (int n = 0; n < 2; ++n) acc[a][b][m][n] = (f32x4){0.f, 0.f, 0.f, 0.f};
    bf16x8 At[4][2], B0[2][2], B1[2][2]; v8i_t At8[4], B08[2], B18[2];
    unsigned vA[2], vB[2], gA[2][2], ngA[2][2];
    dense_voff(cur.lda, cur.ldb, tid, vA, vB);
    if constexpr (GATHER) gather_voff(cur, tid, gA);
    const char* cA = cur.A; const char* cB = cur.B;
    size_t hsA = GATHER ? 0 : (size_t)cur.lda * HALF, hsB = (size_t)cur.ldb * HALF;
    PG8_STB(PG8_SB(0, 0), cB, 0, hsB); PG8_STB(PG8_SB(0, 1), cB, 1, hsB); PG8_STA(PG8_SA(0, 0), cA, 0, hsA, gA); PG8_STA(PG8_SA(0, 1), cA, 1, hsA, gA);
    if (wr == 1) PG8_BAR;
    PG8_WAIT_V(2); PG8_BAR;
    PG8_STB(PG8_SB(1, 0), cB + kstep, 0, hsB); PG8_STA(PG8_SA(1, 0), cA + kstep, 0, hsA, gA); PG8_STB(PG8_SB(1, 1), cB + kstep, 1, hsB);
    PG8_WAIT_V(6); PG8_BAR;
    for (;;) {
        const bool has_next = S.next(ui + 1, nxt);
        const char* nA = cA; const char* nB = cB; size_t nhsA = hsA, nhsB = hsB;
        if (has_next) { nA = nxt.A; nB = nxt.B; nhsA = GATHER ? 0 : (size_t)nxt.lda * HALF; nhsB = (size_t)nxt.ldb * HALF; }
        if constexpr (GATHER) {
            if (has_next) gather_voff(nxt, tid, ngA);
            else {
#pragma unroll
                for (int h = 0; h < 2; ++h)
#pragma unroll
                    for (int i = 0; i < 2; ++i) ngA[h][i] = gA[h][i];
            }
        }
        for (int t = 0; t < nt; t += 2) {
            const bool last = (t == nt - 2);
            const char* a2 = last ? nA : cA + (size_t)(t + 2) * kstep; const char* b2 = last ? nB : cB + (size_t)(t + 2) * kstep;
            const size_t hA2 = last ? nhsA : hsA, hB2 = last ? nhsB : hsB;
            unsigned g2[2][2];
            if constexpr (GATHER) {
#pragma unroll
                for (int h = 0; h < 2; ++h)
#pragma unroll
                    for (int i = 0; i < 2; ++i) g2[h][i] = last ? ngA[h][i] : gA[h][i];
            }
            PG8_ITER(cA + (size_t)(t + 1) * kstep, a2, b2, hA2, hB2, g2);
        }
        if constexpr (ALIGN_EPI) { if (wr == 0) PG8_BAR; }
        if constexpr (!Epi::AFTER_DRAIN) { E(acc, cur, wr, wc, fr, fq); }
        if (!has_next) break;
#pragma unroll
        for (int a = 0; a < 2; ++a)
#pragma unroll
            for (int b = 0; b < 2; ++b)
#pragma unroll
                for (int m = 0; m < 4; ++m)
#pragma unroll
                    for (int n = 0; n < 2; ++n) acc[a][b][m][n] = (f32x4){0.f, 0.f, 0.f, 0.f};
        cur = nxt; cA = nA; cB = nB; hsA = nhsA; hsB = nhsB; ++ui;
        if constexpr (GATHER) {
#pragma unroll
            for (int h = 0; h < 2; ++h)
#pragma unroll
                for (int i = 0; i < 2; ++i) gA[h][i] = ngA[h][i];
        }
        if constexpr (ALIGN_EPI) { if (wr == 1) PG8_BAR; }
    }
    PG8_WAIT_V(0);
    if constexpr (!ALIGN_EPI) { if (wr == 0) PG8_BAR; }
    PG8_BAR;
    if constexpr (Epi::AFTER_DRAIN) { E.fused(acc, cur, wr, wc, fr, fq, lds, wid, lane); }
#undef PG8_SA
#undef PG8_SB
#undef PG8_STAGE
#undef PG8_STA
#undef PG8_STB
#undef PG8_LDA
#undef PG8_LDB
#undef PG8_MMA
#undef PG8_WAIT_V
#undef PG8_WAIT_L
#undef PG8_BAR
#undef PG8_SCHED
#undef PG8_ITER
}
}
namespace attn_body {
using bf16=__hip_bfloat16;
using bf16x8=__attribute__((ext_vector_type(8)))short;
using s16x4=__attribute__((ext_vector_type(4)))short;
using f32x16=__attribute__((ext_vector_type(16)))float;
using u32x4=__attribute__((ext_vector_type(4)))unsigned;
constexpr int BATCH=4,SEQ=2048,D=64,DM=5632,OPITCH=1024;
constexpr int NW=8,QBLK=32,QB=QBLK*NW,KVBLK=64,NQB=SEQ/QB;
constexpr int ATTN_UNIT_ROWS=QB;
__device__ __forceinline__ int crow(int r,int hi){return (r&3)+8*(r>>2)+4*hi;}
#define SBAR() __builtin_amdgcn_sched_barrier(0)
__device__ __forceinline__ void cmask(f32x16&p0,f32x16&p1,int jb,int qrel,int hi){
  const float NEG=-INFINITY; int kb=64*jb+4*hi;
  #pragma unroll
  for(int r=0;r<16;++r){int kv=kb+(r&3)+8*(r>>2); if(kv>qrel)p0[r]=NEG; if(kv+32>qrel)p1[r]=NEG;}
}

constexpr int NSLOT=3, SLOTB=8192;
constexpr int LDS_K=0, LDS_V=NSLOT*SLOTB, LDS_WS=2*NSLOT*SLOTB, LDS_OST=LDS_WS+NW*64*4, LDS_BYTES=LDS_OST+NW*4096;
constexpr float C2=0.125f*1.4426950408889634f;
__device__ __forceinline__ void glds16(const void*gsrc,unsigned lds_dst){unsigned keep;
  asm volatile("s_mov_b32 %0, m0\n\ts_mov_b32 m0, %2\n\ts_nop 0\n\tglobal_load_lds_dwordx4 %1, off\n\ts_mov_b32 m0, %0":"=&s"(keep):"v"(gsrc),"s"(lds_dst):"memory");}
__device__ __forceinline__ float max3f(float a,float b,float c){float r;asm("v_max3_f32 %0, %1, %2, %3":"=v"(r):"v"(a),"v"(b),"v"(c));return r;}
__device__ __forceinline__ float max2f(float a,float b){float r;asm("v_max_f32_e32 %0, %1, %2":"=v"(r):"v"(a),"v"(b));return r;}
__device__ __forceinline__ float fadd_s(float a,float b){float r;asm("v_add_f32_e32 %0, %1, %2":"=v"(r):"v"(a),"v"(b));return r;}
__device__ __forceinline__ float fsub_s(float a,float b){float r;asm("v_sub_f32_e32 %0, %1, %2":"=v"(r):"v"(a),"v"(b));return r;}
typedef float f32x2_t __attribute__((ext_vector_type(2))); typedef __bf16 bf16x2_t __attribute__((ext_vector_type(2)));
__device__ __forceinline__ unsigned cvtpk_s(float lo,float hi){f32x2_t v={lo,hi};bf16x2_t b=__builtin_convertvector(v,bf16x2_t);return __builtin_bit_cast(unsigned,b);}
#define WAIT_BAR(N) asm volatile("s_waitcnt vmcnt(" #N ") lgkmcnt(0)\n\ts_barrier":::"memory")

__device__ __forceinline__ void qkt(f32x16&p0,f32x16&p1,const char*Kslot,const bf16x8*qr,const f32x16&negm,int r32,int hi){
  const char*kb=Kslot+hi*1024+r32*16;
  #pragma unroll
  for(int d0=0;d0<4;++d0){
    const bf16x8 b0=*reinterpret_cast<const bf16x8*>(kb+d0*2048);
    const bf16x8 b1=*reinterpret_cast<const bf16x8*>(kb+d0*2048+512);
    if(d0==0){p0=__builtin_amdgcn_mfma_f32_32x32x16_bf16(b0,qr[0],negm,0,0,0);p1=__builtin_amdgcn_mfma_f32_32x32x16_bf16(b1,qr[0],negm,0,0,0);}
    else{p0=__builtin_amdgcn_mfma_f32_32x32x16_bf16(b0,qr[d0],p0,0,0,0);p1=__builtin_amdgcn_mfma_f32_32x32x16_bf16(b1,qr[d0],p1,0,0,0);}}
}
typedef __attribute__((address_space(3))) const char* lds_cptr;
typedef short v4i16_t __attribute__((ext_vector_type(4)));
__device__ __forceinline__ void kload8(bf16x8*kf,lds_cptr kp){
  kf[0]=*(const __attribute__((address_space(3))) bf16x8*)(kp);      kf[1]=*(const __attribute__((address_space(3))) bf16x8*)(kp+512);
  kf[2]=*(const __attribute__((address_space(3))) bf16x8*)(kp+2048); kf[3]=*(const __attribute__((address_space(3))) bf16x8*)(kp+2560);
  kf[4]=*(const __attribute__((address_space(3))) bf16x8*)(kp+4096); kf[5]=*(const __attribute__((address_space(3))) bf16x8*)(kp+4608);
  kf[6]=*(const __attribute__((address_space(3))) bf16x8*)(kp+6144); kf[7]=*(const __attribute__((address_space(3))) bf16x8*)(kp+6656);
}
__device__ __forceinline__ void kload2(bf16x8*kf,lds_cptr kp,int j){ kf[2*j]=*(const __attribute__((address_space(3))) bf16x8*)(kp+j*2048); kf[2*j+1]=*(const __attribute__((address_space(3))) bf16x8*)(kp+j*2048+512); }
__device__ __forceinline__ s16x4 vtr(lds_cptr p){ return __builtin_bit_cast(s16x4,__builtin_amdgcn_ds_read_tr16_b64_v4i16((__attribute__((address_space(3))) v4i16_t*)p)); }
__device__ __forceinline__ float rowmax(const f32x16&p0,const f32x16&p1){
  float a=max3f(p0[0],p0[1],p1[0]),b=max3f(p0[2],p0[3],p1[1]);a=max3f(a,p1[2],p1[3]);
  #pragma unroll
  for(int r=4;r<16;r+=4){a=max3f(a,p0[r],p0[r+1]);b=max3f(b,p0[r+2],p0[r+3]);a=max3f(a,p1[r],p1[r+1]);b=max3f(b,p1[r+2],p1[r+3]);}
  const float m=max2f(a,b);
  auto rr=__builtin_amdgcn_permlane32_swap(__float_as_uint(m),__float_as_uint(m),false,false);
  return max2f(__uint_as_float(rr[0]),__uint_as_float(rr[1]));
}
__device__ __forceinline__ void pv(f32x16*o,int vb,bf16x8 pa0,bf16x8 pa1,bf16x8 pa2,bf16x8 pa3){
  #pragma unroll
  for(int d0=0;d0<2;++d0){s16x4 lo[4],hi[4];
    #pragma unroll
    for(int ks=0;ks<4;++ks){
      asm volatile("ds_read_b64_tr_b16 %0,%1 offset:%c2":"=&v"(lo[ks]):"v"(vb),"i"(d0*4096+ks*1024):"memory");
      asm volatile("ds_read_b64_tr_b16 %0,%1 offset:%c2":"=&v"(hi[ks]):"v"(vb),"i"(d0*4096+ks*1024+512):"memory");}
    asm volatile("s_waitcnt lgkmcnt(0)":::"memory");SBAR();
    #define PK(k) (bf16x8){lo[k][0],lo[k][1],lo[k][2],lo[k][3],hi[k][0],hi[k][1],hi[k][2],hi[k][3]}
    o[d0]=__builtin_amdgcn_mfma_f32_32x32x16_bf16(pa0,PK(0),o[d0],0,0,0);
    o[d0]=__builtin_amdgcn_mfma_f32_32x32x16_bf16(pa1,PK(1),o[d0],0,0,0);
    o[d0]=__builtin_amdgcn_mfma_f32_32x32x16_bf16(pa2,PK(2),o[d0],0,0,0);
    o[d0]=__builtin_amdgcn_mfma_f32_32x32x16_bf16(pa3,PK(3),o[d0],0,0,0);
    #undef PK
  }
}

#ifndef ATTN_STORE16
#define ATTN_STORE16(p,v) (*(u32x4*)(p)=(v))
#endif
template<int THRL> __device__ __forceinline__ void attn_unit(int b,int qcol,int vcol,int ocol,int qb,const bf16*Q,const bf16*__restrict__ K,const bf16*__restrict__ V,bf16*O,char*shm){
  const int tid=threadIdx.x,lane=tid&63,r32=lane&31,hi=lane>>5; const int wid=__builtin_amdgcn_readfirstlane(tid>>6);
  const long rowbase=(long)b*SEQ; const int q0=qb*QB;
  const bf16*Qw=Q+(rowbase+q0+wid*QBLK)*DM+qcol;
  const bf16*Kh=K+rowbase*DM+qcol,*Vh=V+rowbase*DM+vcol;
  const unsigned lds0=(unsigned)(uintptr_t)shm;
  float*wsf=(float*)(shm+LDS_WS)+wid*64;
  const bf16*ksrc=Kh+(long)lane*DM+wid*8;
  const bf16*vsrc=Vh+(long)(16*(wid&3)+(lane>>2))*DM+(wid>>2)*32+(lane&3)*8;
  const unsigned kdst=lds0+LDS_K+wid*1024, vdst=lds0+LDS_V+wid*1024;
  #define DMA_K(t,slot) glds16(ksrc+(long)(t)*KVBLK*DM,(unsigned)__builtin_amdgcn_readfirstlane(kdst+(slot)))
  #define DMA_V(t,slot) glds16(vsrc+(long)(t)*KVBLK*DM,(unsigned)__builtin_amdgcn_readfirstlane(vdst+(slot)))
  const int vb0=(int)(lds0+LDS_V)+((lane>>4)&1)*32+(lane&3)*8+(4*hi+((lane&15)>>2))*64;
  const char*Kbase=shm+LDS_K; bf16x8 kf[8];
  const lds_cptr shm3=(lds_cptr)shm; const lds_cptr kp0=shm3+LDS_K+hi*1024+r32*16; const lds_cptr vp0=shm3+LDS_V+((lane>>4)&1)*32+(lane&3)*8+(4*hi+((lane&15)>>2))*64;
  const int NT=(q0+QB)/KVBLK;
  DMA_K(0,0);DMA_V(0,0);DMA_K(1,SLOTB);
  bf16x8 qr[4];
  #pragma unroll
  for(int d0=0;d0<4;++d0)qr[d0]=*reinterpret_cast<const bf16x8*>(&Qw[(long)r32*DM+d0*16+hi*8]);
  float mhat=0.f,l_reg=0.f;f32x16 o[2];o[0]=f32x16{};o[1]=f32x16{};f32x16 negm=f32x16{};asm volatile("":"+v"(negm));
  const int qrel=wid*QBLK+r32;
  #define CMASK(P0,P1,t) do{int jb_=(t)-(NT-4); if(jb_>=0)cmask(P0,P1,jb_,qrel,hi);}while(0)
  bool resc=false;
  #define START(P0,P1) do{ const float rm=rowmax(P0,P1); resc=false; \
    { const float dl=rm; mhat=fadd_s(mhat,dl); \
      _Pragma("unroll") for(int r=0;r<16;++r){P0[r]=fsub_s(P0[r],dl);P1[r]=fsub_s(P1[r],dl);} \
      _Pragma("unroll") for(int r=0;r<16;++r)negm[r]=-mhat; asm volatile("":"+v"(negm)); } \
    _Pragma("unroll") for(int r=0;r<16;++r)P0[r]=__builtin_amdgcn_exp2f(P0[r]); }while(0)
  #define RESC() do{ if(resc){ asm volatile("s_waitcnt lgkmcnt(0)":::"memory"); \
      _Pragma("unroll") for(int d_=0;d_<2;++d_) _Pragma("unroll") for(int r=0;r<16;++r)o[d_][r]*=wsf[crow(r,hi)]; } }while(0)
  f32x16 pA0,pA1,pB0,pB1;
  int sl_prev=0,sl_cur=0,sl_next=SLOTB;
  #define ROT() do{sl_prev=sl_cur;sl_cur=sl_next;sl_next=(sl_next==(NSLOT-1)*SLOTB)?0:sl_next+SLOTB;}while(0)
  DMA_K(2,2*SLOTB);
  WAIT_BAR(3);
  qkt(pA0,pA1,Kbase,qr,negm,r32,hi);asm volatile("s_nop 15\n\ts_nop 7":"+v"(pA0),"+v"(pA1));CMASK(pA0,pA1,0);
  START(pA0,pA1);
  _Pragma("unroll") for(int r=0;r<16;++r)pA1[r]=__builtin_amdgcn_exp2f(pA1[r]);
  WAIT_BAR(0);
  DMA_K(3,0);DMA_V(1,SLOTB);
  ROT();
  kload8(kf,kp0+sl_cur);
  WAIT_BAR(2);
  s16x4 vlo[8],vhi[8]; u32x4 pw0,pw1,pw2,pw3;
  #define PKW(P,B) cvtpk_s(P[B],P[B+1])
  #define PAF(k) __builtin_bit_cast(bf16x8,pw##k)
  #define VFR(i) (bf16x8){vlo[i][0],vlo[i][1],vlo[i][2],vlo[i][3],vhi[i][0],vhi[i][1],vhi[i][2],vhi[i][3]}
  #define PIN(x) asm volatile("":"+v"(x))
  #define MX3(a,b,c) __builtin_fmaxf(__builtin_fmaxf((a),(b)),(c))
  #define GAPA(MF,A0,A1,A2,A3,W0,W1,PW) do{ MF; sacc+=A0; sacc+=A1; sacc+=A2; sacc+=A3; PIN(sacc); W0; W1; PIN(PW); SBAR(); }while(0)
  #define EX(v) __builtin_amdgcn_exp2f(v)
  #define GAPB(MF,X,B) do{ MF; X[B]=EX(X[B]); X[B+1]=EX(X[B+1]); X[B+2]=EX(X[B+2]); X[B+3]=EX(X[B+3]); PIN(X); SBAR(); }while(0)
  #define VRD(i) do{ vlo[i]=vtr(vp_+(((i)>>2)*4096+((i)&3)*1024)); vhi[i]=vtr(vp_+(((i)>>2)*4096+((i)&3)*1024+512)); }while(0)
  #define KRD(G,j) do{ if(G){ kload2(kf,kp0+sl_next,j); SBAR(); } }while(0)
  #define STEP(C0,C1,P0,P1,t,GK,GV,GL) do{ SBAR(); \
    const lds_cptr vp_=vp0+sl_prev; \
    VRD(0); SBAR(); float sacc=(P0[0]+P0[1]); \
    GAPA(C0=__builtin_amdgcn_mfma_f32_32x32x16_bf16(kf[0],qr[0],negm,0,0,0), P0[2],P0[3],P0[4],P0[5],     pw0[0]=PKW(P0,0), pw0[1]=PKW(P0,2), pw0); \
    VRD(4); SBAR(); GAPA(C1=__builtin_amdgcn_mfma_f32_32x32x16_bf16(kf[1],qr[0],negm,0,0,0), P0[6],P0[7],P0[8],P0[9],     pw0[2]=PKW(P0,4), pw0[3]=PKW(P0,6), pw0); \
    VRD(1); SBAR(); GAPA(C0=__builtin_amdgcn_mfma_f32_32x32x16_bf16(kf[2],qr[1],C0,0,0,0),   P0[10],P0[11],P0[12],P0[13], pw1[0]=PKW(P0,8), pw1[1]=PKW(P0,10), pw1); \
    VRD(5); SBAR(); GAPA(C1=__builtin_amdgcn_mfma_f32_32x32x16_bf16(kf[3],qr[1],C1,0,0,0),   P0[14],P0[15],P1[0],P1[1],   pw1[2]=PKW(P0,12),pw1[3]=PKW(P0,14), pw1); \
    VRD(2); SBAR(); GAPA(C0=__builtin_amdgcn_mfma_f32_32x32x16_bf16(kf[4],qr[2],C0,0,0,0),   P1[2],P1[3],P1[4],P1[5],     pw2[0]=PKW(P1,0), pw2[1]=PKW(P1,2), pw2); \
    VRD(6); SBAR(); GAPA(C1=__builtin_amdgcn_mfma_f32_32x32x16_bf16(kf[5],qr[2],C1,0,0,0),   P1[6],P1[7],P1[8],P1[9],     pw2[2]=PKW(P1,4), pw2[3]=PKW(P1,6), pw2); \
    VRD(3); SBAR(); GAPA(C0=__builtin_amdgcn_mfma_f32_32x32x16_bf16(kf[6],qr[3],C0,0,0,0),   P1[10],P1[11],P1[12],P1[13], pw3[0]=PKW(P1,8), pw3[1]=PKW(P1,10), pw3); \
    VRD(7); SBAR(); GAPA(C1=__builtin_amdgcn_mfma_f32_32x32x16_bf16(kf[7],qr[3],C1,0,0,0),   P1[14],P1[15],0.f,0.f,       pw3[2]=PKW(P1,12),pw3[3]=PKW(P1,14), pw3); \
    l_reg+=sacc; \
    if(GK){DMA_K((t)+3,sl_cur);} if(GV){DMA_V((t)+1,sl_next);} \
    CMASK(C0,C1,t); \
    { float a=MX3(C0[0],C0[1],C1[0]),b=MX3(C0[2],C0[3],C1[1]); a=MX3(a,C1[2],C1[3]); \
      _Pragma("unroll") for(int r=4;r<16;r+=4){a=MX3(a,C0[r],C0[r+1]);b=MX3(b,C0[r+2],C0[r+3]);a=MX3(a,C1[r],C1[r+1]);b=MX3(b,C1[r+2],C1[r+3]);} \
      float rm=__builtin_fmaxf(a,b); { auto rr=__builtin_amdgcn_permlane32_swap(__float_as_uint(rm),__float_as_uint(rm),false,false); rm=__builtin_fmaxf(__uint_as_float(rr[0]),__uint_as_float(rr[1])); } \
      resc=false; \
      if(__builtin_expect(__any(rm>(float)THRL),0)){ const float dl=__builtin_fmaxf(rm,0.f); mhat+=dl; \
        _Pragma("unroll") for(int r=0;r<16;++r){C0[r]-=dl;C1[r]-=dl;} \
        _Pragma("unroll") for(int r=0;r<16;++r)negm[r]=-mhat; asm volatile("":"+v"(negm)); \
        const float f=__builtin_amdgcn_exp2f(-dl); l_reg*=f; if(hi==0)wsf[r32]=f; resc=true; } } \
    SBAR(); \
    GAPB(o[0]=__builtin_amdgcn_mfma_f32_32x32x16_bf16(PAF(0),VFR(0),o[0],0,0,0), C0,0); \
    GAPB(o[1]=__builtin_amdgcn_mfma_f32_32x32x16_bf16(PAF(0),VFR(4),o[1],0,0,0), C0,4); \
    KRD(GL,0); GAPB(o[0]=__builtin_amdgcn_mfma_f32_32x32x16_bf16(PAF(1),VFR(1),o[0],0,0,0), C0,8); \
    KRD(GL,1); GAPB(o[1]=__builtin_amdgcn_mfma_f32_32x32x16_bf16(PAF(1),VFR(5),o[1],0,0,0), C0,12); \
    KRD(GL,2); GAPB(o[0]=__builtin_amdgcn_mfma_f32_32x32x16_bf16(PAF(2),VFR(2),o[0],0,0,0), C1,0); \
    KRD(GL,3); GAPB(o[1]=__builtin_amdgcn_mfma_f32_32x32x16_bf16(PAF(2),VFR(6),o[1],0,0,0), C1,4); \
    GAPB(o[0]=__builtin_amdgcn_mfma_f32_32x32x16_bf16(PAF(3),VFR(3),o[0],0,0,0), C1,8); \
    GAPB(o[1]=__builtin_amdgcn_mfma_f32_32x32x16_bf16(PAF(3),VFR(7),o[1],0,0,0), C1,12); \
    }while(0)
  int t=1;
  #undef CMASK
  #define CMASK(P0,P1,t) do{}while(0)
  for(;t+5<NT;t+=2){
    STEP(pB0,pB1,pA0,pA1,t,true,true,true);     WAIT_BAR(2); RESC(); ROT();
    STEP(pA0,pA1,pB0,pB1,t+1,true,true,true);   WAIT_BAR(2); RESC(); ROT();
  }
  #undef CMASK
  #define CMASK(P0,P1,t) do{int jb_=(t)-(NT-4); if(jb_>=0)cmask(P0,P1,jb_,qrel,hi);}while(0)
  #define ENDW(tt) do{ if((tt)+3<NT){WAIT_BAR(2);} else if((tt)+2<NT){WAIT_BAR(1);} else {WAIT_BAR(0);} }while(0)
  for(;t+1<NT;t+=2){
    STEP(pB0,pB1,pA0,pA1,t,(t+3<NT),(t+1<NT),(t+1<NT));       ENDW(t);   RESC(); ROT();
    STEP(pA0,pA1,pB0,pB1,t+1,(t+4<NT),(t+2<NT),(t+2<NT));     ENDW(t+1); RESC(); ROT();
  }
  STEP(pB0,pB1,pA0,pA1,NT-1,false,false,false); RESC();
  { float sacc=pB0[0]+pB0[1]; _Pragma("unroll") for(int r=2;r<16;++r)sacc+=pB0[r]; _Pragma("unroll") for(int r=0;r<16;++r)sacc+=pB1[r]; l_reg+=sacc;
    pw0=(u32x4){PKW(pB0,0),PKW(pB0,2),PKW(pB0,4),PKW(pB0,6)};pw1=(u32x4){PKW(pB0,8),PKW(pB0,10),PKW(pB0,12),PKW(pB0,14)};pw2=(u32x4){PKW(pB1,0),PKW(pB1,2),PKW(pB1,4),PKW(pB1,6)};pw3=(u32x4){PKW(pB1,8),PKW(pB1,10),PKW(pB1,12),PKW(pB1,14)};
    SBAR(); pv(o,vb0+sl_cur,PAF(0),PAF(1),PAF(2),PAF(3)); }
  #undef PKW
  #undef PAF
  #undef VFR
  #undef PIN
  #undef MX3
  #undef GAPA
  #undef GAPB
  #undef EX
  #undef VRD
  #undef KRD
  #undef STEP
  #undef ENDW
  {auto rr=__builtin_amdgcn_permlane32_swap(__float_as_uint(l_reg),__float_as_uint(l_reg),false,false);l_reg=__uint_as_float(rr[0])+__uint_as_float(rr[1]);}
  if(hi==0)wsf[32+r32]=l_reg;asm volatile("s_waitcnt lgkmcnt(0)":::"memory");
  float rli[16];
  #pragma unroll
  for(int r=0;r<16;++r)rli[r]=__builtin_amdgcn_rcpf(wsf[32+crow(r,hi)]);
  bf16*Ow=O+(rowbase+q0+wid*QBLK)*OPITCH+ocol;
  { bf16*stg=(bf16*)(shm+LDS_OST)+wid*2048;
    #pragma unroll
    for(int r=0;r<16;++r){const int orow=crow(r,hi);
      #pragma unroll
      for(int d0=0;d0<2;++d0)stg[orow*64+d0*32+r32]=__float2bfloat16(o[d0][r]*rli[r]);}
    asm volatile("s_waitcnt lgkmcnt(0)":::"memory");
    #pragma unroll
    for(int i=0;i<4;++i){const int row=i*8+(lane>>3),ch=lane&7; const u32x4 v=*(const u32x4*)(stg+row*64+ch*8); ATTN_STORE16(Ow+(long)row*OPITCH+ch*8,v);} }
  asm volatile("s_waitcnt lgkmcnt(0)\n\ts_barrier":::"memory");
  #undef DMA_K
  #undef DMA_V
  #undef CMASK
  #undef START
  #undef RESC
  #undef ROT
}
constexpr int ATTN_LDS_BYTES=LDS_BYTES;
#undef SBAR
#undef WAIT_BAR
}
constexpr size_t MiB = 1u << 20;
constexpr size_t WS_CTL = 0, CTL_ZERO_BYTES = 1 * MiB;
constexpr size_t WS_WIN = 2 * MiB, WS_WOUT = 26 * MiB, WS_WQ = 34 * MiB, WS_WKV = 42 * MiB, WS_WO = 58 * MiB, WS_W1 = 66 * MiB, WS_W2 = 578 * MiB;
constexpr size_t WS_HN = 834 * MiB, WS_MN = 866 * MiB, WS_PROJ = 870 * MiB, WS_DT = 958 * MiB, WS_KVRAW = 959 * MiB, WS_KN = 967 * MiB;
constexpr size_t WS_YCAT = 971 * MiB, WS_O0 = 1003 * MiB, WS_O1 = 1019 * MiB, WS_H1 = 1035 * MiB, WS_H1B = 1099 * MiB, WS_PART1 = 1131 * MiB, WS_PARTQ = 1132 * MiB;
constexpr size_t WS_QRAW = 1133 * MiB, WS_P = 1165 * MiB, WS_VWT = 1181 * MiB, WS_H2 = 1197 * MiB, WS_HN3 = 1261 * MiB;
constexpr size_t WS_TOKOF = 1293 * MiB, WS_GATEOF = 1294 * MiB, WS_TOKE = 1295 * MiB, WS_TOKR = 1296 * MiB, WS_YG = 1297 * MiB;
constexpr size_t WS_XG = 1320 * MiB  , WS_ACT = 1832 * MiB  , WS_Y = 2344 * MiB  , WS_END = 3368 * MiB;
constexpr int CW_BAR = 4096;
constexpr int CW_QATT = 12288;
constexpr int CW_CNT = 8192;
static_assert((CW_CNT + 64 * 32) * 4 <= (int)CTL_ZERO_BYTES, "CTL words inside the memset region");

constexpr int RING_OFF = 0, RING_BYTES = 131072;
constexpr int LDS_BYTES = 163840;
constexpr int MISC_OFF = 163840 - 1024;
constexpr int NWAVES = 8;

#define XB_TMO      128
#define XB_XCNT(j)  (256  + 64 * (j))
#define XB_XSUB(j)  (1280 + 64 * (j))
#define XB_XGEN(j)  (2304 + 64 * (j))
#define XB_TOP      3328
#define XB_TOPGEN   3392
#define XCD_BAR_WORDS 3456
#define XB_SPIN_CAP (1u << 20)

__device__ __forceinline__ unsigned xb_ld(unsigned* p)              { return __hip_atomic_load(p, __ATOMIC_RELAXED, __HIP_MEMORY_SCOPE_AGENT); }
__device__ __forceinline__ unsigned xb_add(unsigned* p, unsigned v) { return __hip_atomic_fetch_add(p, v, __ATOMIC_RELAXED, __HIP_MEMORY_SCOPE_AGENT); }
__device__ __forceinline__ unsigned xb_xcc_id() { return (unsigned)__builtin_amdgcn_s_getreg((3 << 11) | 20) & 0xFu; }
#define XB_SPIN(cond, bar) do { unsigned _sp = 0; while (cond) { __builtin_amdgcn_s_sleep(1); \
    if ((++_sp & 255u) == 0u) { if (xb_ld(&(bar)[XB_TMO])) break; if (_sp > XB_SPIN_CAP) { atomicAdd(&(bar)[XB_TMO], 1u); break; } } } } while (0)

struct XcdBarrier {
    unsigned* bar; unsigned x;
    volatile LAS unsigned* st;
};
__device__ __forceinline__ XcdBarrier xcd_barrier_post(unsigned* bar, volatile LAS unsigned* st) {
    XcdBarrier b; b.bar = bar; b.x = xb_xcc_id(); b.st = st;
    if (threadIdx.x == 0) (void)xb_add(&bar[XB_XCNT(b.x)], 1u);
    return b;
}
__device__ __forceinline__ void xcd_barrier_complete(unsigned* bar, unsigned x, unsigned& nloc, unsigned& nx) {
    const unsigned G = gridDim.x * gridDim.y * gridDim.z;
    unsigned sum, cnt, mine, sp = 0u;
    for (;;) {
        sum = 0u; cnt = 0u; mine = 0u;
#pragma unroll
        for (unsigned j = 0; j < 16; ++j) { const unsigned c = xb_ld(&bar[XB_XCNT(j)]); sum += c; cnt += (c > 0u) ? 1u : 0u; mine = (j == x) ? c : mine; }
        if (sum == G) break;
        __builtin_amdgcn_s_sleep(1);
        if ((++sp & 255u) == 0u) { if (xb_ld(&bar[XB_TMO])) break; if (sp > XB_SPIN_CAP) { atomicAdd(&bar[XB_TMO], 1u); break; } }
    }
    nloc = mine > 0u ? mine : 1u; nx = cnt > 0u ? cnt : 1u;
}
__device__ __forceinline__ void xcd_barrier(const XcdBarrier& b) {
    asm volatile("s_waitcnt vmcnt(0)" ::: "memory");
    __syncthreads();
    if (threadIdx.x == 0) {
        unsigned* bar = b.bar;
        __builtin_amdgcn_s_waitcnt(0);
        unsigned nloc = b.st[0], nx = b.st[1];
        if (nloc == 0u) { xcd_barrier_complete(bar, b.x, nloc, nx); b.st[0] = nloc; b.st[1] = nx; }
        const unsigned old = xb_add(&bar[XB_XSUB(b.x)], 1u);
        const unsigned gen = old / nloc;
        if (old + 1u == (gen + 1u) * nloc) {
            __builtin_amdgcn_fence(__ATOMIC_RELEASE, "agent");
            asm volatile("s_waitcnt vmcnt(0)" ::: "memory");
            const unsigned og = xb_add(&bar[XB_TOP], 1u);
            const unsigned tg = og / nx;
            if (og + 1u == (tg + 1u) * nx) xb_add(&bar[XB_TOPGEN], 1u);
            else XB_SPIN(xb_ld(&bar[XB_TOPGEN]) == tg, bar);
            __builtin_amdgcn_fence(__ATOMIC_ACQUIRE, "agent");
            xb_add(&bar[XB_XGEN(b.x)], 1u);
            asm volatile("s_waitcnt vmcnt(0)" ::: "memory");
        } else {
            XB_SPIN(xb_ld(&bar[XB_XGEN(b.x)]) == gen, bar);
            __builtin_amdgcn_fence(__ATOMIC_ACQUIRE, "agent");
            asm volatile("s_waitcnt vmcnt(0)" ::: "memory");
        }
    }
    __syncthreads();
}

struct Args { const float* in[32]; float* out; unsigned char* ws; int ph_lo, ph_hi; };
enum In { I_X = 0, I_MEM, I_GMIX, I_WIN, I_CONVW, I_CONVB, I_DTB, I_ALOG, I_DSKIP, I_SSDG, I_DAQG, I_DAKG, I_LQ1, I_LK1, I_LQ2, I_LK2, I_SUBG, I_WOUT, I_GXA, I_GMEM,
          I_WQ, I_WKV, I_XQG, I_XKG, I_WO, I_GFFN, I_RW, I_RB, I_W1, I_B1, I_W2, I_B2 };

struct ArgP {
    typedef const __attribute__((address_space(4))) char* kptr;
    DI const float* in(int i) const { kptr kp = (kptr)__builtin_amdgcn_kernarg_segment_ptr(); asm volatile("" : "+s"(kp)); return *(const float* const __attribute__((address_space(4)))*)(kp + 8 * i); }
    DI float* out() const { kptr kp = (kptr)__builtin_amdgcn_kernarg_segment_ptr(); asm volatile("" : "+s"(kp)); return *(float* const __attribute__((address_space(4)))*)(kp + 8 * 32); }
};
struct Frame {
    LAS unsigned char* lds;
    volatile LAS unsigned* MISC;
    unsigned* ctl;
    unsigned char* ws;
    int tid, lane, wave, vcu, G;
};

template <class DestRow>
DI void tr_item(const float* W, size_t ldw, int k0, int ncol0, int nvalid, const float* kscale, bf16_t* WT, int K, DestRow dr, LAS float* scr, int lane) {
    const int c = lane & 31;
#pragma unroll 8
    for (int i = 0; i < 32; ++i) { const int kk = 2 * i + (lane >> 5);
        float v = (c < nvalid) ? W[(size_t)(k0 + kk) * ldw + ncol0 + c] : 0.f;
        if (kscale) v *= kscale[k0 + kk];
        scr[kk * 33 + c] = v; }
    asm volatile("s_waitcnt lgkmcnt(0)" ::: "memory");
    const int c8 = lane & 7;
#pragma unroll
    for (int j = 0; j < 4; ++j) { const int n = (lane >> 3) + 8 * j; const LAS float* s = scr + (8 * c8) * 33 + n;
        u32x4 o; o.x = pk2(s[0 * 33], s[1 * 33]); o.y = pk2(s[2 * 33], s[3 * 33]); o.z = pk2(s[4 * 33], s[5 * 33]); o.w = pk2(s[6 * 33], s[7 * 33]);
        if (n < nvalid) *(u32x4*)(WT + (size_t)dr(ncol0 + n) * K + k0 + 8 * c8) = o; }
    asm volatile("s_waitcnt lgkmcnt(0)" ::: "memory");
}
template <class DestRow>
DI void tr_item_fp8(const float* W, size_t ldw, int k0, int ncol0, unsigned char* WT, int K, DestRow dr, LAS float* scr, int lane) {
    const int c = lane & 31;
#pragma unroll 8
    for (int i = 0; i < 32; ++i) { const int kk = 2 * i + (lane >> 5); scr[kk * 33 + c] = W[(size_t)(k0 + kk) * ldw + ncol0 + c]; }
    asm volatile("s_waitcnt lgkmcnt(0)" ::: "memory");
    const int n = lane >> 1, hf = lane & 1; const LAS float* s = scr + (32 * hf) * 33 + n;
    unsigned w[8];
#pragma unroll
    for (int j = 0; j < 8; ++j) { unsigned x = 0u;
        x = __builtin_amdgcn_cvt_pk_fp8_f32(s[(4 * j) * 33] * 64.f, s[(4 * j + 1) * 33] * 64.f, x, false);
        x = __builtin_amdgcn_cvt_pk_fp8_f32(s[(4 * j + 2) * 33] * 64.f, s[(4 * j + 3) * 33] * 64.f, x, true); w[j] = x; }
    unsigned char* op = WT + (size_t)dr(ncol0 + n) * K + k0 + 32 * hf;
    *(u32x4*)op = (u32x4){w[0], w[1], w[2], w[3]}; *(u32x4*)(op + 16) = (u32x4){w[4], w[5], w[6], w[7]};
    asm volatile("s_waitcnt lgkmcnt(0)" ::: "memory");
}
DI int tileperm(int col) { const int o = col & 255; return (col & ~255) + 128 * ((o & 63) >> 5) + 32 * (o >> 6) + (o & 31); }
struct DrIdent { DI int operator()(int n) const { return n; } };
struct DrTile  { DI int operator()(int n) const { return tileperm(n); } };
struct DrWin   { DI int operator()(int n) const { const int pc = (n < 2560) ? n : (n < 2576 ? PC_DT + (n - 2560) : n - 16); return tileperm(pc); } };
struct DrW1    { DI int operator()(int n) const { const int half = n >> 11, j = n & 2047; return (j >> 7) * 256 + half * 128 + (j & 127); } };

DI void rms_row_to_bf16(const float* xrow, const float* g, bf16_t* orow, int lane) {
    const f32x4* xr = (const f32x4*)xrow + lane;
    f32x4 v[8]; float s = 0.f;
#pragma unroll
    for (int j = 0; j < 8; ++j) { v[j] = xr[64 * j]; s += (v[j].x * v[j].x + v[j].y * v[j].y) + (v[j].z * v[j].z + v[j].w * v[j].w); }
    const float rstd = 1.f / sqrtf(wave_sum(s) * (1.f / 2048.f) + EPS_);
    u32x2* o8 = (u32x2*)orow + lane;
#pragma unroll
    for (int j = 0; j < 8; ++j) { const f32x4 gg = ((const f32x4*)g)[lane + 64 * j];
        u32x2 o; o.x = pk2(v[j].x * rstd * gg.x, v[j].y * rstd * gg.y); o.y = pk2(v[j].z * rstd * gg.z, v[j].w * rstd * gg.w); o8[64 * j] = o; }
}

DI void p0_prologue(Frame& F, const ArgP& a) {
    LAS float* scr = (LAS float*)(F.lds + RING_OFF + F.wave * 16384);
    const int gw = F.vcu * NWAVES + F.wave, NGW = F.G * NWAVES;
    unsigned char* ws = F.ws;
    constexpr int I_A = 32 * 80, I_B = 32, I_C = 32 * 96, I_WOUT_ = 32 * 64, I_WQ_ = 32 * 64, I_WKV_ = 32 * 128, I_WO_ = 32 * 64, I_W1_ = 32 * 32 * 128, I_W2_ = 32 * 32 * 64;
    constexpr int NITEMS = I_A + I_B + I_C + I_WOUT_ + I_WQ_ + I_WKV_ + I_WO_ + I_W1_ + I_W2_;
    for (int it = gw; it < NITEMS; it += NGW) {
        int r = it;
        if (r < I_A) { tr_item(a.in(I_WIN), 5648, 64 * (r / 80), 32 * (r % 80), 32, nullptr, (bf16_t*)(ws + WS_WIN), 2048, DrWin(), scr, F.lane); continue; } r -= I_A;
        if (r < I_B) { tr_item(a.in(I_WIN), 5648, 64 * r, 2560, 16, nullptr, (bf16_t*)(ws + WS_WIN), 2048, DrWin(), scr, F.lane); continue; } r -= I_B;
        if (r < I_C) { tr_item(a.in(I_WIN), 5648, 64 * (r / 96), 2576 + 32 * (r % 96), 32, nullptr, (bf16_t*)(ws + WS_WIN), 2048, DrWin(), scr, F.lane); continue; } r -= I_C;
        if (r < I_WOUT_) { tr_item(a.in(I_WOUT), 2048, 64 * (r / 64), 32 * (r % 64), 32, nullptr, (bf16_t*)(ws + WS_WOUT), 2048, DrIdent(), scr, F.lane); continue; } r -= I_WOUT_;
        if (r < I_WQ_) { tr_item(a.in(I_WQ), 2048, 64 * (r / 64), 32 * (r % 64), 32, a.in(I_GXA), (bf16_t*)(ws + WS_WQ), 2048, DrIdent(), scr, F.lane); continue; } r -= I_WQ_;
        if (r < I_WKV_) { tr_item(a.in(I_WKV), 4096, 64 * (r / 128), 32 * (r % 128), 32, nullptr, (bf16_t*)(ws + WS_WKV), 2048, DrTile(), scr, F.lane); continue; } r -= I_WKV_;
        if (r < I_WO_) { tr_item(a.in(I_WO), 2048, 64 * (r / 64), 32 * (r % 64), 32, nullptr, (bf16_t*)(ws + WS_WO), 2048, DrIdent(), scr, F.lane); continue; } r -= I_WO_;
        if (r < I_W1_) { const int e = r / (32 * 128), q = r % (32 * 128);
            tr_item_fp8(a.in(I_W1) + (size_t)e * 2048 * 4096, 4096, 64 * (q / 128), 32 * (q % 128), (unsigned char*)(ws + WS_W1) + (size_t)e * 4096 * 2048, 2048, DrW1(), scr, F.lane); continue; } r -= I_W1_;
        { const int e = r / (32 * 64), q = r % (32 * 64);
            tr_item_fp8(a.in(I_W2) + (size_t)e * 2048 * 2048, 2048, 64 * (q / 64), 32 * (q % 64), (unsigned char*)(ws + WS_W2) + (size_t)e * 2048 * 2048, 2048, DrIdent(), scr, F.lane); }
    }
    for (int m = gw; m < NTOK; m += NGW) rms_row_to_bf16(a.in(I_X) + (size_t)m * 2048, a.in(I_GMIX), (bf16_t*)(ws + WS_HN) + (size_t)m * 2048, F.lane);
    for (int m = gw; m < NB * MEMLEN; m += NGW) rms_row_to_bf16(a.in(I_MEM) + (size_t)m * 2048, a.in(I_GMEM), (bf16_t*)(ws + WS_MN) + (size_t)m * 2048, F.lane);
}

struct SchedP1 {
    int G, c; const unsigned char* ws;
    DI bool next(int i, pg8::UnitD& u) const {
        const int L = i * G + c; if (L >= 32 * 23 + 64) return false;
        u.rows = nullptr; u.nvalid = 0; u.lda = 4096u; u.ldb = 4096u; u.e = 0; u.x0 = 0;
        if (L < 32 * 23) { u.type = 0; u.pn = L / 32; u.pm = L % 32; u.A = (const char*)(ws + WS_HN) + (size_t)u.pm * 256 * 4096; u.B = (const char*)(ws + WS_WIN) + (size_t)u.pn * 256 * 4096; }
        else { const int q = L - 32 * 23; u.type = 1; u.pn = q / 4; u.pm = q % 4; u.A = (const char*)(ws + WS_MN) + (size_t)u.pm * 256 * 4096; u.B = (const char*)(ws + WS_WKV) + (size_t)u.pn * 256 * 4096; }
        return true;
    }
};
struct EpiP1 {
    static constexpr bool AFTER_DRAIN = false;
    bf16_t* proj; float* dtb; bf16_t* kvraw; const float* gq; const float* gk;
    DI void operator()(const f32x4 (&acc)[2][2][4][2], const pg8::UnitD& u, int wr, int wc, int fr, int fq) const {
        { int ln_ = threadIdx.x; asm volatile("" : "+v"(ln_)); fr = ln_ & 15; fq = (ln_ >> 4) & 3; }
        const int row0 = u.pm * 256 + wr * 64 + fr;
        const int cn = u.pn * 256 + 64 * wc + 8 * fq;
        if (u.type == 1) {
#pragma unroll
            for (int ai = 0; ai < 2; ++ai)
#pragma unroll
                for (int m = 0; m < 4; ++m) { bf16_t* rp = kvraw + (size_t)(row0 + ai * 128 + m * 16) * 4096 + cn;
#pragma unroll
                    for (int bj = 0; bj < 2; ++bj) { const f32x4 v0 = acc[ai][bj][m][0], v1 = acc[ai][bj][m][1];
                        u32x4 w; w.x = pk2(v0[0], v0[1]); w.y = pk2(v0[2], v0[3]); w.z = pk2(v1[0], v1[1]); w.w = pk2(v1[2], v1[3]); *(u32x4*)(rp + 32 * bj) = w; } }
            return;
        }
        if (u.pn == 22) {
            if (wc == 0 && fq < 2) {
#pragma unroll
                for (int ai = 0; ai < 2; ++ai)
#pragma unroll
                    for (int m = 0; m < 4; ++m) { float* rp = dtb + (size_t)(row0 + ai * 128 + m * 16) * 16 + 8 * fq;
                        *(f32x4*)(rp) = acc[ai][0][m][0]; *(f32x4*)(rp + 4) = acc[ai][0][m][1]; }
            }
            return;
        }
        const bool isq = (u.pn >= 10 && u.pn < 14), isk = (u.pn >= 14 && u.pn < 18);
        if (!(isq || isk)) {
#pragma unroll
            for (int ai = 0; ai < 2; ++ai)
#pragma unroll
                for (int m = 0; m < 4; ++m) { bf16_t* rp = proj + (size_t)(row0 + ai * 128 + m * 16) * PP + cn;
#pragma unroll
                    for (int bj = 0; bj < 2; ++bj) { const f32x4 v0 = acc[ai][bj][m][0], v1 = acc[ai][bj][m][1];
                        u32x4 w; w.x = pk2(v0[0], v0[1]); w.y = pk2(v0[2], v0[3]); w.z = pk2(v1[0], v1[1]); w.w = pk2(v1[2], v1[3]); *(u32x4*)(rp + 32 * bj) = w; } }
            return;
        }
        const float* g = (isq ? gq : gk) + 8 * fq; const float sc = isq ? (0.125f * 1.4426950408889634f) : 1.f;
#pragma unroll
        for (int ai = 0; ai < 2; ++ai)
#pragma unroll
            for (int m = 0; m < 4; ++m) { bf16_t* rp = proj + (size_t)(row0 + ai * 128 + m * 16) * PP + cn;
                float ss = 0.f;
#pragma unroll
                for (int bj = 0; bj < 2; ++bj)
#pragma unroll
                    for (int n = 0; n < 2; ++n) { const f32x4 v = acc[ai][bj][m][n]; ss += (v[0] * v[0] + v[1] * v[1]) + (v[2] * v[2] + v[3] * v[3]); }
                ss += __shfl_xor(ss, 16); ss += __shfl_xor(ss, 32);
                const float rs = sc / sqrtf(ss * (1.f / 64.f) + EPS_);
#pragma unroll
                for (int bj = 0; bj < 2; ++bj) { const f32x4 v0 = acc[ai][bj][m][0] * rs * *(const f32x4*)(g + 32 * bj), v1 = acc[ai][bj][m][1] * rs * *(const f32x4*)(g + 32 * bj + 4);
                    u32x4 w; w.x = pk2(v0[0], v0[1]); w.y = pk2(v0[2], v0[3]); w.z = pk2(v1[0], v1[1]); w.w = pk2(v1[2], v1[3]); *(u32x4*)(rp + 32 * bj) = w; } }
    }
};

DI void kprep(Frame& F, const ArgP& a) {
    const int gw = F.vcu * NWAVES + F.wave, NGW = F.G * NWAVES;
    const bf16_t* kv = (const bf16_t*)(F.ws + WS_KVRAW); bf16_t* kn = (bf16_t*)(F.ws + WS_KN);
    for (int it = gw; it < NB * MEMLEN * 4; it += NGW) {
        const int row = it >> 2, h = it & 3, b = row >> 8, key = row & 255;
        const u32x4 raw = *(const u32x4*)(kv + (size_t)row * 4096 + h * 512 + F.lane * 8);
        float v[8]; v[0] = bflo(raw.x); v[1] = bfhi(raw.x); v[2] = bflo(raw.y); v[3] = bfhi(raw.y); v[4] = bflo(raw.z); v[5] = bfhi(raw.z); v[6] = bflo(raw.w); v[7] = bfhi(raw.w);
        float ss = 0.f;
#pragma unroll
        for (int j = 0; j < 8; ++j) ss += v[j] * v[j];
        const float rs = 1.f / sqrtf(wave_sum(ss) * (1.f / 512.f) + EPS_) * 0.04419417382415922f;
        const float* gk = a.in(I_XKG) + F.lane * 8; const float* gq = a.in(I_XQG) + F.lane * 8;
        u32x4 o; o.x = pk2(v[0] * rs * gk[0] * gq[0], v[1] * rs * gk[1] * gq[1]); o.y = pk2(v[2] * rs * gk[2] * gq[2], v[3] * rs * gk[3] * gq[3]);
        o.z = pk2(v[4] * rs * gk[4] * gq[4], v[5] * rs * gk[5] * gq[5]); o.w = pk2(v[6] * rs * gk[6] * gq[6], v[7] * rs * gk[7] * gq[7]);
        *(u32x4*)(kn + ((size_t)((b * 4 + h) * 256 + key)) * 512 + F.lane * 8) = o;
    }
}

constexpr int SP = 272;
constexpr int S_C = 0, S_BM = 34816, S_BT = 69632, S_XDT = 104448, S_HB = 121856, S_F = 139264, S_W = 155648  , SSD_LDS = 162048;
static_assert(SSD_LDS <= MISC_OFF, "SSD LDS map");
#define MFMA32(a, b, c) __builtin_amdgcn_mfma_f32_32x32x16_bf16((a), (b), (c), 0, 0, 0)
DI int crow(int r, int hi) { return (r & 3) + 8 * (r >> 2) + 4 * hi; }
DI bf16x8 ldfrag(LAS const unsigned char* base, int row, int kel) { return *(const LAS bf16x8*)(base + row * SP + kel * 2); }
DI float fexp(float x) { return __builtin_amdgcn_exp2f(x * 1.4426950408889634f); }
DI float fsilu(float x) { return x * __builtin_amdgcn_rcpf(1.f + fexp(-x)); }

DI void ssd_unit(Frame& F, const ArgP& a, int b, int hd) {
    LAS unsigned char* lds = F.lds;
    int tid = F.tid, lane = F.lane, r32 = lane & 31, hh = lane >> 5; const int wid = F.wave;
    LAS float* sdt = (LAS float*)(lds + S_F); LAS float* sac = sdt + 2048;
    const bf16_t* proj = (const bf16_t*)(F.ws + WS_PROJ); const float* dtbuf = (const float*)(F.ws + WS_DT); bf16_t* yg = (bf16_t*)(F.ws + WS_YG);
    const int g = hd >> 3;
    const float aneg = -__expf(a.in(I_ALOG)[hd]), dtb = a.in(I_DTB)[hd], dsk = a.in(I_DSKIP)[hd];
#pragma unroll
    for (int q = 0; q < 2; ++q) { const int c = 2 * wid + q; const size_t t0 = (size_t)b * SEQ_ + c * 128;
        const float x0 = dtbuf[(t0 + 2 * lane) * 16 + hd] + dtb, x1 = dtbuf[(t0 + 2 * lane + 1) * 16 + hd] + dtb;
        const float d0 = x0 > 20.f ? x0 : log1pf(__expf(x0)), d1 = x1 > 20.f ? x1 : log1pf(__expf(x1));
        const float a0 = d0 * aneg, a1 = d1 * aneg;
        float s = a0 + a1;
#pragma unroll
        for (int o = 1; o < 64; o <<= 1) { const float t = __shfl_up(s, o); if (lane >= o) s += t; }
        sdt[c * 128 + 2 * lane] = d0; sdt[c * 128 + 2 * lane + 1] = d1; sac[c * 128 + 2 * lane] = s - a1; sac[c * 128 + 2 * lane + 1] = s; }
    int seg = tid >> 5, cg = tid & 31, l0 = seg * 8;
    int colbc = (cg < 16) ? (1024 + g * 128 + cg * 8) : (1280 + g * 128 + (cg - 16) * 8);
    const int colx = hd * 64 + wid * 8; int lx = 2 * lane;
    LAS float* swt = (LAS float*)(lds + S_W);
    { const float* convw = a.in(I_CONVW); const float* convb = a.in(I_CONVB);
      if (tid < 320) { const int ci = tid;
          const int xc = (ci < 64) ? (hd * 64 + ci) : (ci < 192 ? (1024 + g * 128 + (ci - 64)) : (1280 + g * 128 + (ci - 192)));
#pragma unroll
          for (int k = 0; k < 4; ++k) swt[k * 320 + ci] = convw[k * 1536 + xc];
          swt[4 * 320 + ci] = convb[xc]; } }
    int cibc = 64 + cg * 8; const int cix = wid * 8;
    const char* pub = (const char*)F.ws; const unsigned pxb = (unsigned)(WS_PROJ + ((size_t)b * SEQ_ * PP + PC_XBC) * 2), zoff = (unsigned)(WS_CTL + 524288);
    u32x4 inbc[11], inx[5];
#define SSD_PREFETCH(c_) do { \
        int sd_ = l0; asm volatile("" : "+v"(sd_)); \
        _Pragma("unroll") for (int j = 0; j < 11; ++j) { const int tt = (c_) * 128 + sd_ - 3 + j; inbc[j] = *(const u32x4*)(pub + ((tt >= 0) ? pxb + (unsigned)(tt * PP + colbc) * 2u : zoff)); } } while (0)
    SSD_PREFETCH(0);
    f32x16 hT; for (int i = 0; i < 16; ++i) hT[i] = 0.f;
    const int nb = wid & 3, pb = wid >> 2;
    __syncthreads();
    for (int c = 0; c < 16; ++c) {
        { int t_ = threadIdx.x; asm volatile("" : "+v"(t_)); tid = t_; lane = t_ & 63; r32 = lane & 31; hh = lane >> 5; seg = t_ >> 5; cg = t_ & 31; l0 = seg * 8; lx = 2 * lane;
          colbc = (cg < 16) ? (1024 + g * 128 + cg * 8) : (1280 + g * 128 + (cg - 16) * 8); cibc = 64 + cg * 8; }
        const size_t t0 = (size_t)b * SEQ_ + c * 128;
        const LAS float* cdt = sdt + c * 128; const LAS float* cac = sac + c * 128;
        const float aend = cac[127];
#pragma unroll
        for (int j = 0; j < 5; ++j) { int sd_ = lx; asm volatile("" : "+v"(sd_)); const int tt = c * 128 + sd_ - 3 + j; inx[j] = *(const u32x4*)(pub + ((tt >= 0) ? pxb + (unsigned)(tt * PP + colx) * 2u : zoff)); }
        {
            LAS unsigned char* hbp = lds + S_HB + (32 * pb + r32) * SP + (32 * nb + 4 * hh) * 2;
#pragma unroll
            for (int q4 = 0; q4 < 4; ++q4) { u32x2 w; w.x = pk2(hT[4 * q4], hT[4 * q4 + 1]); w.y = pk2(hT[4 * q4 + 2], hT[4 * q4 + 3]); *(LAS u32x2*)(hbp + 16 * q4) = w; }
        }
        {
            float wbc[5][8];
#pragma unroll
            for (int k = 0; k < 5; ++k) { const f32x4 w0 = *(const LAS f32x4*)(swt + k * 320 + cibc), w1 = *(const LAS f32x4*)(swt + k * 320 + cibc + 4);
#pragma unroll
                for (int i = 0; i < 4; ++i) { wbc[k][i] = w0[i]; wbc[k][4 + i] = w1[i]; } }
#pragma unroll
            for (int hf = 0; hf < 2; ++hf) {
                __builtin_amdgcn_sched_barrier(0);
                float o[4][8];
#pragma unroll
                for (int j = 0; j < 4; ++j)
#pragma unroll
                    for (int i = 0; i < 8; ++i) { float s = wbc[4][i];
#pragma unroll
                        for (int k = 0; k < 4; ++k) { const unsigned wd = inbc[4 * hf + j + k][i >> 1]; s += wbc[k][i] * ((i & 1) ? bfhi(wd) : bflo(wd)); }
                        o[j][i] = fsilu(s); }
                const int lh = l0 + 4 * hf;
                if (cg < 16) {
                    const int n0 = cg * 8; float ev[4];
#pragma unroll
                    for (int j = 0; j < 4; ++j) { ev[j] = fexp(aend - cac[lh + j]);
                        u32x4 w1; w1.x = pk2(o[j][0], o[j][1]); w1.y = pk2(o[j][2], o[j][3]); w1.z = pk2(o[j][4], o[j][5]); w1.w = pk2(o[j][6], o[j][7]);
                        *(LAS u32x4*)(lds + S_BM + (lh + j) * SP + n0 * 2) = w1; }
#pragma unroll
                    for (int i = 0; i < 8; ++i) { u32x2 w2; w2.x = pk2(o[0][i] * ev[0], o[1][i] * ev[1]); w2.y = pk2(o[2][i] * ev[2], o[3][i] * ev[3]);
                        *(LAS u32x2*)(lds + S_BT + (n0 + i) * SP + lh * 2) = w2; }
                } else {
                    const int n0 = (cg - 16) * 8;
#pragma unroll
                    for (int j = 0; j < 4; ++j) { u32x4 w1; w1.x = pk2(o[j][0], o[j][1]); w1.y = pk2(o[j][2], o[j][3]); w1.z = pk2(o[j][4], o[j][5]); w1.w = pk2(o[j][6], o[j][7]);
                        *(LAS u32x4*)(lds + S_C + (lh + j) * SP + n0 * 2) = w1; }
                }
            }
        }
        __builtin_amdgcn_sched_barrier(0);
        {
            const float d0 = cdt[lx], d1 = cdt[lx + 1];
            float wx[5][8];
#pragma unroll
            for (int k = 0; k < 5; ++k) { const f32x4 w0 = *(const LAS f32x4*)(swt + k * 320 + cix), w1 = *(const LAS f32x4*)(swt + k * 320 + cix + 4);
#pragma unroll
                for (int i = 0; i < 4; ++i) { wx[k][i] = w0[i]; wx[k][4 + i] = w1[i]; } }
#pragma unroll
            for (int i = 0; i < 8; ++i) { float s0 = wx[4][i], s1 = wx[4][i];
#pragma unroll
                for (int k = 0; k < 4; ++k) { const unsigned w0 = inx[k][i >> 1], w1 = inx[k + 1][i >> 1];
                    s0 += wx[k][i] * ((i & 1) ? bfhi(w0) : bflo(w0)); s1 += wx[k][i] * ((i & 1) ? bfhi(w1) : bflo(w1)); }
                *(LAS unsigned*)(lds + S_XDT + (wid * 8 + i) * SP + lx * 2) = pk2(fsilu(s0) * d0, fsilu(s1) * d1); }
        }
        if (c < 15) SSD_PREFETCH(c + 1);
        __syncthreads();
        const int lb = wid >> 1;
        f32x16 xt[2];
#pragma unroll
        for (int q = 0; q < 2; ++q) { const int sb = 2 * (wid & 1) + q;
            for (int i = 0; i < 16; ++i) xt[q][i] = 0.f;
            if (sb <= lb) {
#pragma unroll
                for (int ks = 0; ks < 8; ++ks) xt[q] = MFMA32(ldfrag(lds + S_BM, 32 * sb + r32, 16 * ks + 8 * hh), ldfrag(lds + S_C, 32 * lb + r32, 16 * ks + 8 * hh), xt[q]);
            }
        }
        __syncthreads();
        {
            const int l = 32 * lb + r32; const float al = cac[l], ddl = dsk * __builtin_amdgcn_rcpf(cdt[l]);
#pragma unroll
            for (int q = 0; q < 2; ++q) { const int sb = 2 * (wid & 1) + q;
#pragma unroll
                for (int q4 = 0; q4 < 4; ++q4) { float mv[4];
#pragma unroll
                    for (int e = 0; e < 4; ++e) { const int s = 32 * sb + 8 * q4 + 4 * hh + e;
                        float v = 0.f;
                        if (s <= l) v = xt[q][4 * q4 + e] * fexp(al - cac[s]);
                        if (s == l) v += ddl;
                        mv[e] = v; }
                    u32x2 w; w.x = pk2(mv[0], mv[1]); w.y = pk2(mv[2], mv[3]);
                    *(LAS u32x2*)(lds + S_BM + l * SP + (32 * sb + 8 * q4 + 4 * hh) * 2) = w; }
            }
        }
        __syncthreads();
        {
            const int lb2 = wid & 3, pb2 = wid >> 2; const int l = 32 * lb2 + r32; const size_t tok = t0 + l;
            const int pc0 = hd * 64 + 32 * pb2 + 4 * hh;
            u32x2 zz[4];
#pragma unroll
            for (int q4 = 0; q4 < 4; ++q4) zz[q4] = *(const u32x2*)(proj + tok * PP + pc0 + 8 * q4);
            f32x16 y1, y2; for (int i = 0; i < 16; ++i) { y1[i] = 0.f; y2[i] = 0.f; }
            for (int ks = 0; ks < 2 * (lb2 + 1); ++ks) y1 = MFMA32(ldfrag(lds + S_XDT, 32 * pb2 + r32, 16 * ks + 8 * hh), ldfrag(lds + S_BM, 32 * lb2 + r32, 16 * ks + 8 * hh), y1);
#pragma unroll
            for (int ks = 0; ks < 8; ++ks) y2 = MFMA32(ldfrag(lds + S_HB, 32 * pb2 + r32, 16 * ks + 8 * hh), ldfrag(lds + S_C, 32 * lb2 + r32, 16 * ks + 8 * hh), y2);
            const float cd = fexp(aend);
#pragma unroll
            for (int i = 0; i < 16; ++i) hT[i] *= cd;
#pragma unroll
            for (int ks = 0; ks < 8; ++ks) hT = MFMA32(ldfrag(lds + S_BT, 32 * nb + r32, 16 * ks + 8 * hh), ldfrag(lds + S_XDT, 32 * pb + r32, 16 * ks + 8 * hh), hT);
            const float el = fexp(cac[l]);
#pragma unroll
            for (int q4 = 0; q4 < 4; ++q4) { float yv[4];
#pragma unroll
                for (int e = 0; e < 4; ++e) { const float z = (e & 1) ? bfhi(e < 2 ? zz[q4].x : zz[q4].y) : bflo(e < 2 ? zz[q4].x : zz[q4].y);
                    yv[e] = (y1[4 * q4 + e] + el * y2[4 * q4 + e]) * fsilu(z); }
                u32x2 w; w.x = pk2(yv[0], yv[1]); w.y = pk2(yv[2], yv[3]);
                *(u32x2*)(yg + tok * 1024 + pc0 + 8 * q4) = w; }
        }
        __syncthreads();
    }
#undef SSD_PREFETCH
}

DI void attn_phase_da(Frame& F) {
    const attn_body::bf16* proj = (const attn_body::bf16*)(F.ws + WS_PROJ);
    for (;;) {
        if (threadIdx.x == 0) F.MISC[120] = __hip_atomic_fetch_add(F.ctl + CW_QATT, 1u, __ATOMIC_RELAXED, __HIP_MEMORY_SCOPE_AGENT);
        __syncthreads();
        const int u = __builtin_amdgcn_readfirstlane((int)F.MISC[120]);
        __syncthreads();
        if (u >= 1024) break;
        const int qb = 7 - (u >> 7), combo = u & 127;
        const int half = combo & 1, j = (combo >> 1) & 1, h = (combo >> 2) & 7, b = combo >> 5;
        attn_body::bf16* O = (attn_body::bf16*)(F.ws + (j ? WS_O1 : WS_O0));
        attn_body::attn_unit<8>(b, PC_Q + (h * 2 + j) * 64, PC_V + h * 128 + half * 64, h * 128 + half * 64, qb, proj, proj + (PC_K - PC_Q), proj, O, (char*)F.lds);
    }
}

DI void p3_finalize(Frame& F, const ArgP& a) {
    const int gw = F.vcu * NWAVES + F.wave, NGW = F.G * NWAVES, lane = F.lane;
    bf16_t* ycat = (bf16_t*)(F.ws + WS_YCAT); const bf16_t* yg = (const bf16_t*)(F.ws + WS_YG); const bf16_t* o0 = (const bf16_t*)(F.ws + WS_O0); const bf16_t* o1 = (const bf16_t*)(F.ws + WS_O1);
    float l1 = a.in(I_LQ1)[lane] * a.in(I_LK1)[lane], l2 = a.in(I_LQ2)[lane] * a.in(I_LK2)[lane];
    const float lam = __expf(wave_sum(l1)) - __expf(wave_sum(l2)) + LAM_INIT;
    for (int m = gw; m < NTOK; m += NGW) {
        { bf16_t* yp = ycat + (size_t)m * 2048 + 16 * lane; const bf16_t* gp = yg + (size_t)m * 1024 + 16 * lane;
          const u32x4 r0 = *(const u32x4*)gp, r1 = *(const u32x4*)(gp + 8);
          float v[16]; v[0] = bflo(r0.x); v[1] = bfhi(r0.x); v[2] = bflo(r0.y); v[3] = bfhi(r0.y); v[4] = bflo(r0.z); v[5] = bfhi(r0.z); v[6] = bflo(r0.w); v[7] = bfhi(r0.w);
          v[8] = bflo(r1.x); v[9] = bfhi(r1.x); v[10] = bflo(r1.y); v[11] = bfhi(r1.y); v[12] = bflo(r1.z); v[13] = bfhi(r1.z); v[14] = bflo(r1.w); v[15] = bfhi(r1.w);
          float ss = 0.f;
#pragma unroll
          for (int i = 0; i < 16; ++i) ss += v[i] * v[i];
#pragma unroll
          for (int o = 1; o < 32; o <<= 1) ss += __shfl_xor(ss, o);
          const float rs = 1.f / sqrtf(ss * (1.f / 512.f) + EPS_);
          const float* g = a.in(I_SSDG) + 16 * lane;
          u32x4 w0, w1;
          w0.x = pk2(v[0] * rs * g[0], v[1] * rs * g[1]); w0.y = pk2(v[2] * rs * g[2], v[3] * rs * g[3]); w0.z = pk2(v[4] * rs * g[4], v[5] * rs * g[5]); w0.w = pk2(v[6] * rs * g[6], v[7] * rs * g[7]);
          w1.x = pk2(v[8] * rs * g[8], v[9] * rs * g[9]); w1.y = pk2(v[10] * rs * g[10], v[11] * rs * g[11]); w1.z = pk2(v[12] * rs * g[12], v[13] * rs * g[13]); w1.w = pk2(v[14] * rs * g[14], v[15] * rs * g[15]);
          *(u32x4*)yp = w0; *(u32x4*)(yp + 8) = w1; }
        { const bf16_t* p0 = o0 + (size_t)m * 1024 + 16 * lane; const bf16_t* p1 = o1 + (size_t)m * 1024 + 16 * lane;
          const u32x4 a0 = *(const u32x4*)p0, a1 = *(const u32x4*)(p0 + 8), b0 = *(const u32x4*)p1, b1 = *(const u32x4*)(p1 + 8);
          float v[16];
          v[0] = bflo(a0.x) - lam * bflo(b0.x); v[1] = bfhi(a0.x) - lam * bfhi(b0.x); v[2] = bflo(a0.y) - lam * bflo(b0.y); v[3] = bfhi(a0.y) - lam * bfhi(b0.y);
          v[4] = bflo(a0.z) - lam * bflo(b0.z); v[5] = bfhi(a0.z) - lam * bfhi(b0.z); v[6] = bflo(a0.w) - lam * bflo(b0.w); v[7] = bfhi(a0.w) - lam * bfhi(b0.w);
          v[8] = bflo(a1.x) - lam * bflo(b1.x); v[9] = bfhi(a1.x) - lam * bfhi(b1.x); v[10] = bflo(a1.y) - lam * bflo(b1.y); v[11] = bfhi(a1.y) - lam * bfhi(b1.y);
          v[12] = bflo(a1.z) - lam * bflo(b1.z); v[13] = bfhi(a1.z) - lam * bfhi(b1.z); v[14] = bflo(a1.w) - lam * bflo(b1.w); v[15] = bfhi(a1.w) - lam * bfhi(b1.w);
          float ss = 0.f;
#pragma unroll
          for (int i = 0; i < 16; ++i) ss += v[i] * v[i];
          ss += __shfl_xor(ss, 1); ss += __shfl_xor(ss, 2); ss += __shfl_xor(ss, 4);
          const float rs = 1.f / sqrtf(ss * (1.f / 128.f) + EPS_) * (1.f - LAM_INIT);
          const float* g = a.in(I_SUBG) + 16 * (lane & 7);
          u32x4 w0, w1;
          w0.x = pk2(v[0] * rs * g[0], v[1] * rs * g[1]); w0.y = pk2(v[2] * rs * g[2], v[3] * rs * g[3]); w0.z = pk2(v[4] * rs * g[4], v[5] * rs * g[5]); w0.w = pk2(v[6] * rs * g[6], v[7] * rs * g[7]);
          w1.x = pk2(v[8] * rs * g[8], v[9] * rs * g[9]); w1.y = pk2(v[10] * rs * g[10], v[11] * rs * g[11]); w1.z = pk2(v[12] * rs * g[12], v[13] * rs * g[13]); w1.w = pk2(v[14] * rs * g[14], v[15] * rs * g[15]);
          bf16_t* yp = ycat + (size_t)m * 2048 + 1024 + 16 * lane;
          *(u32x4*)yp = w0; *(u32x4*)(yp + 8) = w1; }
    }
}

struct SchedDense {
    int G, c, nM, nN; const char* A; const char* B; unsigned lda, ldb; int bdiv; size_t bstride;
    DI bool next(int i, pg8::UnitD& u) const {
        const int L = i * G + c; if (L >= nM * nN) return false;
        u.rows = nullptr; u.nvalid = 0; u.lda = lda; u.ldb = ldb; u.type = 0; u.e = 0; u.x0 = 0;
        u.pn = L / nM; u.pm = L % nM;
        u.A = A + (size_t)u.pm * 256 * lda; u.B = B + (size_t)u.pn * 256 * ldb + (size_t)(u.pm / bdiv) * bstride;
        return true;
    }
};
struct EpiResid {
    static constexpr bool AFTER_DRAIN = false;
    const float* base; float* out; bf16_t* outb; float* part;
    DI void operator()(const f32x4 (&acc)[2][2][4][2], const pg8::UnitD& u, int wr, int wc, int fr, int fq) const {
        { int ln_ = threadIdx.x; asm volatile("" : "+v"(ln_)); fr = ln_ & 15; fq = (ln_ >> 4) & 3; }
        const int row0 = u.pm * 256 + wr * 64 + fr, col0 = u.pn * 256 + wc * 32 + 8 * fq;
#pragma unroll
        for (int ai = 0; ai < 2; ++ai)
#pragma unroll
            for (int m = 0; m < 4; ++m) { const size_t row = (size_t)(row0 + ai * 128 + m * 16); float ss = 0.f;
#pragma unroll
                for (int bj = 0; bj < 2; ++bj) { const size_t idx = row * 2048 + col0 + bj * 128;
                    f32x4 v0 = acc[ai][bj][m][0] + *(const f32x4*)(base + idx), v1 = acc[ai][bj][m][1] + *(const f32x4*)(base + idx + 4);
                    *(f32x4*)(out + idx) = v0; *(f32x4*)(out + idx + 4) = v1;
                    if (outb) { u32x4 w; w.x = pk2(v0[0], v0[1]); w.y = pk2(v0[2], v0[3]); w.z = pk2(v1[0], v1[1]); w.w = pk2(v1[2], v1[3]); *(u32x4*)(outb + idx) = w; }
                    ss += (v0[0] * v0[0] + v0[1] * v0[1]) + (v0[2] * v0[2] + v0[3] * v0[3]) + (v1[0] * v1[0] + v1[1] * v1[1]) + (v1[2] * v1[2] + v1[3] * v1[3]); }
                if (part) { ss += __shfl_xor(ss, 16); ss += __shfl_xor(ss, 32); if (fq == 0) part[row * 32 + u.pn * 4 + wc] = ss; } }
    }
};

struct EpiQ {
    static constexpr bool AFTER_DRAIN = false;
    bf16_t* outb; float* part;
    DI void operator()(const f32x4 (&acc)[2][2][4][2], const pg8::UnitD& u, int wr, int wc, int fr, int fq) const {
        { int ln_ = threadIdx.x; asm volatile("" : "+v"(ln_)); fr = ln_ & 15; fq = (ln_ >> 4) & 3; }
        const int row0 = u.pm * 256 + wr * 64 + fr, col0 = u.pn * 256 + wc * 32 + 8 * fq;
#pragma unroll
        for (int ai = 0; ai < 2; ++ai)
#pragma unroll
            for (int m = 0; m < 4; ++m) { const size_t row = (size_t)(row0 + ai * 128 + m * 16); float ss = 0.f;
#pragma unroll
                for (int bj = 0; bj < 2; ++bj) { const size_t idx = row * 2048 + col0 + bj * 128; const f32x4 v0 = acc[ai][bj][m][0], v1 = acc[ai][bj][m][1];
                    u32x4 w; w.x = pk2(v0[0], v0[1]); w.y = pk2(v0[2], v0[3]); w.z = pk2(v1[0], v1[1]); w.w = pk2(v1[2], v1[3]); *(u32x4*)(outb + idx) = w;
                    ss += (v0[0] * v0[0] + v0[1] * v0[1]) + (v0[2] * v0[2] + v0[3] * v0[3]) + (v1[0] * v1[0] + v1[1] * v1[1]) + (v1[2] * v1[2] + v1[3] * v1[3]); }
                ss += __shfl_xor(ss, 16); ss += __shfl_xor(ss, 32); if (fq == 0) part[row * 32 + u.pn * 4 + wc] = ss; }
    }
};

struct SchedXS {
    int G, c; const unsigned char* ws;
    DI bool next(int i, pg8::UnitD& u) const {
        const int L = i * G + c; if (L >= 256) return false;
        u.rows = nullptr; u.nvalid = 0; u.e = 0;
        const int q = L & 127, bh = q >> 3, t8 = q & 7, b = bh >> 2, h = bh & 3;
        u.pm = b; u.pn = h; u.x0 = t8;
        if (L < 128) { u.type = 0; u.lda = 4096u; u.ldb = 1024u;
            u.A = (const char*)(ws + WS_QRAW) + (size_t)(b * 2048 + t8 * 256) * 4096 + h * 1024; u.B = (const char*)(ws + WS_KN) + (size_t)(bh * 256) * 1024; }
        else { u.type = 1; u.lda = 4096u; u.ldb = 8192u;
            u.A = (const char*)(ws + WS_WO) + (size_t)(t8 * 256) * 4096 + h * 1024; u.B = (const char*)(ws + WS_KVRAW) + (size_t)(b * 256) * 8192 + (2048 + h * 512) * 2; }
        return true;
    }
};
struct EpiXS {
    static constexpr bool AFTER_DRAIN = false;
    bf16_t* P; bf16_t* VWT; const float* part1; const float* partq; LAS float* red;
    DI void operator()(const f32x4 (&acc)[2][2][4][2], const pg8::UnitD& u, int wr, int wc, int fr, int fq) const {
        { int ln_ = threadIdx.x; asm volatile("" : "+v"(ln_)); fr = ln_ & 15; fq = (ln_ >> 4) & 3; }
        const int b = u.pm, h = u.pn, t8 = u.x0;
        const int col0 = wc * 32 + 8 * fq;
        if (u.type == 1) {
            char* Vu = (char*)(VWT + ((size_t)b * 2048 + t8 * 256) * 1024 + h * 256);
#pragma unroll
            for (int ai = 0; ai < 2; ++ai)
#pragma unroll
                for (int m = 0; m < 4; ++m) { const unsigned rl = (unsigned)(ai * 128 + wr * 64 + m * 16 + fr);
#pragma unroll
                    for (int bj = 0; bj < 2; ++bj) { const f32x4 v0 = acc[ai][bj][m][0], v1 = acc[ai][bj][m][1];
                        u32x4 w; w.x = pk2(v0[0], v0[1]); w.y = pk2(v0[2], v0[3]); w.z = pk2(v1[0], v1[1]); w.w = pk2(v1[2], v1[3]);
                        *(u32x4*)(Vu + (rl * 1024u + (unsigned)(bj * 128 + col0)) * 2u) = w; } }
            return;
        }
        const size_t row0 = (size_t)b * 2048 + t8 * 256;
        const char* p1u = (const char*)(part1 + row0 * 32); const char* pqu = (const char*)(partq + row0 * 32 + h * 8); char* Pu = (char*)(P + row0 * 1024 + h * 256);
        float rsc[2][4];
#pragma unroll
        for (int ai = 0; ai < 2; ++ai)
#pragma unroll
            for (int m = 0; m < 4; ++m) { const unsigned rl = (unsigned)(ai * 128 + wr * 64 + m * 16 + fr);
                const f32x4 p0 = *(const f32x4*)(p1u + (rl * 32u + (unsigned)fq * 8u) * 4u), p1 = *(const f32x4*)(p1u + (rl * 32u + (unsigned)fq * 8u + 4u) * 4u);
                float s1 = (p0[0] + p0[1]) + (p0[2] + p0[3]) + (p1[0] + p1[1]) + (p1[2] + p1[3]);
                const f32x2 pq = *(const f32x2*)(pqu + (rl * 32u + (unsigned)fq * 2u) * 4u);
                float sq = pq[0] + pq[1];
                s1 += __shfl_xor(s1, 16); s1 += __shfl_xor(s1, 32); sq += __shfl_xor(sq, 16); sq += __shfl_xor(sq, 32);
                rsc[ai][m] = __builtin_amdgcn_rsqf(sq * (1.f / 512.f) + EPS_ * (s1 * (1.f / 2048.f) + EPS_)) * 1.4426950408889634f;
                float ps = 0.f;
#pragma unroll
                for (int bj = 0; bj < 2; ++bj)
#pragma unroll
                    for (int n = 0; n < 2; ++n)
#pragma unroll
                        for (int e = 0; e < 4; ++e) ps += __builtin_amdgcn_exp2f(fminf(acc[ai][bj][m][n][e] * rsc[ai][m], 100.f));
                ps += __shfl_xor(ps, 16); ps += __shfl_xor(ps, 32);
                if (fq == 0) red[rl * 4 + wc] = ps;
                __builtin_amdgcn_sched_barrier(0); }
        __syncthreads();
        { int ln_ = threadIdx.x; asm volatile("" : "+v"(ln_)); fr = ln_ & 15; fq = (ln_ >> 4) & 3; }
#pragma unroll
        for (int ai = 0; ai < 2; ++ai)
#pragma unroll
            for (int m = 0; m < 4; ++m) { const unsigned rl = (unsigned)(ai * 128 + wr * 64 + m * 16 + fr);
                const f32x4 t = *(const LAS f32x4*)(red + rl * 4); const float inv = __builtin_amdgcn_rcpf((t[0] + t[1]) + (t[2] + t[3])); float rs = rsc[ai][m]; asm volatile("" : "+v"(rs));
#pragma unroll
                for (int bj = 0; bj < 2; ++bj) { float x[8];
#pragma unroll
                    for (int n = 0; n < 2; ++n)
#pragma unroll
                        for (int e = 0; e < 4; ++e) x[n * 4 + e] = __builtin_amdgcn_exp2f(fminf(acc[ai][bj][m][n][e] * rs, 100.f)) * inv;
                    u32x4 w; w.x = pk2(x[0], x[1]); w.y = pk2(x[2], x[3]); w.z = pk2(x[4], x[5]); w.w = pk2(x[6], x[7]);
                    *(u32x4*)(Pu + (rl * 1024u + (unsigned)(bj * 128 + wc * 32 + 8 * fq)) * 2u) = w; } }
        __syncthreads();
    }
};

constexpr int HNP = 2052;
DI void p8_route(Frame& F, const ArgP& a) {
    LAS float* s_hn = (LAS float*)F.lds; LAS float* s_part = (LAS float*)(F.lds + 16 * HNP * 4); LAS float* s_log = s_part + 8 * 16 * 32; LAS int* s_slot = (LAS int*)(s_log + 16 * 32);
    const float* h2 = (const float*)(F.ws + WS_H2); unsigned char* xg = (unsigned char*)(F.ws + WS_XG);
    float* gate_of = (float*)(F.ws + WS_GATEOF); int* tok_e = (int*)(F.ws + WS_TOKE);
    const float* rw = a.in(I_RW); const float* rb = a.in(I_RB); const float* g3 = a.in(I_GFFN);
    const int lane = F.lane, wave = F.wave, tid = F.tid, hh = lane >> 5;
    for (int task = F.vcu; task < NTOK / 16; task += F.G) {
        const int tb = task * 16;
#pragma unroll
        for (int q = 0; q < 2; ++q) { const int tl = 2 * wave + q; const size_t tok = (size_t)(tb + tl);
            const f32x4* xr = (const f32x4*)(h2 + tok * 2048) + lane;
            f32x4 v[8]; float s = 0.f;
#pragma unroll
            for (int j = 0; j < 8; ++j) { v[j] = xr[64 * j]; s += (v[j].x * v[j].x + v[j].y * v[j].y) + (v[j].z * v[j].z + v[j].w * v[j].w); }
            const float rstd = 1.f / sqrtf(wave_sum(s) * (1.f / 2048.f) + EPS_);
#pragma unroll
            for (int j = 0; j < 8; ++j) { const f32x4 gg = ((const f32x4*)g3)[lane + 64 * j]; const f32x4 y = v[j] * rstd * gg;
                *(LAS f32x4*)(s_hn + tl * HNP + (lane + 64 * j) * 4) = y; } }
        __syncthreads();
        {
            f32x16 acc; for (int i = 0; i < 16; ++i) acc[i] = 0.f;
            const LAS float* ap = s_hn + (lane & 15) * HNP + 256 * wave; const float* bp = rw + (size_t)(256 * wave + hh) * 32 + (lane & 31);
#pragma unroll 8
            for (int j = 0; j < 64; ++j) { const f32x4 a4 = *(const LAS f32x4*)(ap + 4 * j);
                const float b1 = bp[(size_t)(4 * j) * 32], b2 = bp[(size_t)(4 * j + 2) * 32];
                acc = __builtin_amdgcn_mfma_f32_32x32x2f32(hh ? a4.y : a4.x, b1, acc, 0, 0, 0);
                acc = __builtin_amdgcn_mfma_f32_32x32x2f32(hh ? a4.w : a4.z, b2, acc, 0, 0, 0); }
            LAS float* pp = s_part + wave * 512 + (lane & 31);
#pragma unroll
            for (int r = 0; r < 8; ++r) pp[crow(r, hh) * 32] = acc[r];
        }
        __syncthreads();
        { const int tt = tid >> 5, e = tid & 31; float s = rb[e];
#pragma unroll
          for (int w = 0; w < 8; ++w) s += s_part[w * 512 + tt * 32 + e];
          s_log[tt * 32 + e] = s; }
        __syncthreads();
        if (tid < 16) { const int tok = tb + tid; unsigned taken = 0u; float val[4]; int idx[4];
#pragma unroll
            for (int k = 0; k < 4; ++k) { float best = -INFINITY; int bi = 0;
                for (int e = 0; e < 32; ++e) { const float v = s_log[tid * 32 + e]; if (!((taken >> e) & 1u) && v > best) { best = v; bi = e; } }
                taken |= 1u << bi; val[k] = best; idx[k] = bi; }
            float ex[4], sum = 0.f;
#pragma unroll
            for (int k = 0; k < 4; ++k) { ex[k] = __expf(val[k] - val[0]); sum += ex[k]; }
#pragma unroll
            for (int k = 0; k < 4; ++k) { const int e = idx[k];
                const unsigned rank = __hip_atomic_fetch_add(F.ctl + CW_CNT + 64 * e, 1u, __ATOMIC_RELAXED, __HIP_MEMORY_SCOPE_AGENT);
                gate_of[e * 8192 + rank] = ex[k] / sum; tok_e[tok * 4 + k] = e * 8192 + (int)rank; s_slot[tid * 4 + k] = e * 8192 + (int)rank; } }
        __syncthreads();
#pragma unroll
        for (int q = 0; q < 2; ++q) { const int tl = 2 * wave + q;
            unsigned o[8];
#pragma unroll
            for (int j = 0; j < 8; ++j) { const f32x4 y = *(const LAS f32x4*)(s_hn + tl * HNP + (lane + 64 * j) * 4);
                unsigned w = 0u; w = __builtin_amdgcn_cvt_pk_fp8_f32(y.x * 4.f, y.y * 4.f, w, false); w = __builtin_amdgcn_cvt_pk_fp8_f32(y.z * 4.f, y.w * 4.f, w, true); o[j] = w; }
#pragma unroll
            for (int k = 0; k < 4; ++k) { unsigned* o4 = (unsigned*)(xg + (size_t)s_slot[tl * 4 + k] * 2048) + lane;
#pragma unroll
                for (int j = 0; j < 8; ++j) o4[64 * j] = o[j]; } }
        __syncthreads();
    }
}

DI void moe_tables(Frame& F) {
    if (F.tid == 0) { unsigned base = 0u;
        for (int e = 0; e < 32; ++e) { const unsigned c = F.ctl[CW_CNT + 64 * e], mt = (c + 255u) >> 8; F.MISC[16 + e] = c; F.MISC[48 + e] = base; F.MISC[80 + e] = mt; base += mt; }
        F.MISC[112] = base; }
    __syncthreads();
}
DI int ldsu(volatile LAS unsigned* p) { return __builtin_amdgcn_readfirstlane((int)*p); }
template <int NTN  >
struct SchedMoe {
    int G, c; const unsigned char* ws; volatile LAS unsigned* MISC;
    DI bool next(int i, pg8::UnitD& u) const {
        const int L = i * G + c; const int total = ldsu(MISC + 112) * NTN; if (L >= total) return false;
        int e = 0;
        for (int k = 0; k < 32; ++k) { if (L >= (ldsu(MISC + 48 + k) + ldsu(MISC + 80 + k)) * NTN) e = k + 1; }
        const int tb = ldsu(MISC + 48 + e), mte = ldsu(MISC + 80 + e), cnt = ldsu(MISC + 16 + e);
        const int local = L - tb * NTN, nt = local / mte, mt = local % mte;
        u.type = 0; u.e = e; u.pn = nt; u.pm = tb + mt; u.x0 = mt; u.lda = 2048u; u.ldb = 2048u;
        u.rows = nullptr; u.nvalid = cnt - mt * 256;
        if (NTN == 16) { u.A = (const char*)(ws + WS_XG) + ((size_t)e * 8192 + (size_t)mt * 256) * 2048;
            u.B = (const char*)(ws + WS_W1) + ((size_t)e * 4096 + (size_t)nt * 256) * 2048; }
        else { u.A = (const char*)(ws + WS_ACT) + ((size_t)e * 8192 + (size_t)mt * 256) * 2048;
            u.B = (const char*)(ws + WS_W2) + ((size_t)e * 2048 + (size_t)nt * 256) * 2048; }
        return true;
    }
};
struct EpiMoe1 {
    static constexpr bool AFTER_DRAIN = false;
    unsigned char* act; const float* b1;
    DI void operator()(const f32x4 (&acc)[2][2][4][2], const pg8::UnitD& u, int wr, int wc, int fr, int fq) const {
        { int ln_ = threadIdx.x; asm volatile("" : "+v"(ln_)); fr = ln_ & 15; fq = (ln_ >> 4) & 3; }
        const int j0 = u.pn * 128 + wc * 32 + 8 * fq;
        const float* bg = b1 + (size_t)u.e * 4096 + j0; const float* bu = bg + 2048;
        const f32x4 bg0 = *(const f32x4*)bg, bg1 = *(const f32x4*)(bg + 4), bu0 = *(const f32x4*)bu, bu1 = *(const f32x4*)(bu + 4);
#pragma unroll
        for (int ai = 0; ai < 2; ++ai)
#pragma unroll
            for (int m = 0; m < 4; ++m) { const size_t row = (size_t)u.e * 8192 + u.x0 * 256 + ai * 128 + wr * 64 + m * 16 + fr;
                float o[8];
#pragma unroll
                for (int n = 0; n < 2; ++n)
#pragma unroll
                    for (int e = 0; e < 4; ++e) { const float g = fminf(acc[ai][0][m][n][e] * (1.f / 256.f) + (n ? bg1[e] : bg0[e]), 7.f);
                        const float uu = fminf(fmaxf(acc[ai][1][m][n][e] * (1.f / 256.f) + (n ? bu1[e] : bu0[e]), -7.f), 7.f);
                        o[n * 4 + e] = g / (1.f + __expf(-1.702f * g)) * (uu + 1.f) * 4.f; }
                u32x2 w; w.x = __builtin_amdgcn_cvt_pk_fp8_f32(o[0], o[1], 0u, false); w.x = __builtin_amdgcn_cvt_pk_fp8_f32(o[2], o[3], w.x, true);
                w.y = __builtin_amdgcn_cvt_pk_fp8_f32(o[4], o[5], 0u, false); w.y = __builtin_amdgcn_cvt_pk_fp8_f32(o[6], o[7], w.y, true);
                *(u32x2*)(act + row * 2048 + j0) = w; }
    }
};
struct EpiMoe2 {
    static constexpr bool AFTER_DRAIN = false;
    bf16_t* y; const float* b2; const float* gate_of;
    DI void operator()(const f32x4 (&acc)[2][2][4][2], const pg8::UnitD& u, int wr, int wc, int fr, int fq) const {
        { int ln_ = threadIdx.x; asm volatile("" : "+v"(ln_)); fr = ln_ & 15; fq = (ln_ >> 4) & 3; }
        const int col0 = u.pn * 256 + wc * 32 + 8 * fq;
        const float* bp = b2 + (size_t)u.e * 2048 + col0;
#pragma unroll
        for (int ai = 0; ai < 2; ++ai)
#pragma unroll
            for (int m = 0; m < 4; ++m) { const int rl = ai * 128 + wr * 64 + m * 16 + fr; const size_t row = (size_t)u.e * 8192 + u.x0 * 256 + rl;
                const float gt = (rl < u.nvalid) ? gate_of[u.e * 8192 + u.x0 * 256 + rl] : 0.f;
#pragma unroll
                for (int bj = 0; bj < 2; ++bj) { const f32x4 v0 = (acc[ai][bj][m][0] * (1.f / 256.f) + *(const f32x4*)(bp + bj * 128)) * gt, v1 = (acc[ai][bj][m][1] * (1.f / 256.f) + *(const f32x4*)(bp + bj * 128 + 4)) * gt;
                    u32x4 w; w.x = pk2(v0[0], v0[1]); w.y = pk2(v0[2], v0[3]); w.z = pk2(v1[0], v1[1]); w.w = pk2(v1[2], v1[3]);
                    *(u32x4*)(y + row * 2048 + col0 + bj * 128) = w; } }
    }
};

DI void p11_combine(Frame& F, const ArgP& a) {
    const int gw = F.vcu * NWAVES + F.wave, NGW = F.G * NWAVES, lane = F.lane;
    const float* h2 = (const float*)(F.ws + WS_H2); const bf16_t* y = (const bf16_t*)(F.ws + WS_Y);
    const int* tok_e = (const int*)(F.ws + WS_TOKE);
    for (int t = gw; t < NTOK; t += NGW) {
        size_t yrow[4];
#pragma unroll
        for (int k = 0; k < 4; ++k) yrow[k] = (size_t)tok_e[t * 4 + k] * 2048;
#pragma unroll
        for (int j = 0; j < 8; ++j) { const int c = (lane + 64 * j) * 4;
            f32x4 v = *(const f32x4*)(h2 + (size_t)t * 2048 + c);
#pragma unroll
            for (int k = 0; k < 4; ++k) { const u32x2 w = *(const u32x2*)(y + yrow[k] + c); v.x += bflo(w.x); v.y += bfhi(w.x); v.z += bflo(w.y); v.w += bfhi(w.y); }
            *(f32x4*)(a.out() + (size_t)t * 2048 + c) = v; }
    }
}

#ifndef MK_PER_PHASE
#define MK_PER_PHASE 0
#endif
#ifndef MK_LAST_PHASE
#define MK_LAST_PHASE 12
#endif
constexpr int N_PHASES = MK_LAST_PHASE;

__global__ void __launch_bounds__(NWAVES * 64, 2) mega_fwd(Args args_) {
    const ArgP args{};
    extern __shared__ __attribute__((aligned(16))) unsigned char lds_raw[];
    Frame F;
    F.lds = (LAS unsigned char*)lds_raw;
    F.MISC = (volatile LAS unsigned*)(F.lds + MISC_OFF);
    F.tid = threadIdx.x; F.lane = F.tid & 63; F.wave = __builtin_amdgcn_readfirstlane(F.tid >> 6);
    F.G = gridDim.x; { const int bx = blockIdx.x; F.vcu = (F.G % 8 == 0) ? (bx % 8) * (F.G / 8) + bx / 8 : bx; }
    F.ws = args_.ws; F.ctl = (unsigned*)(args_.ws + WS_CTL);
    for (int u = F.tid; u < 256; u += NWAVES * 64) F.MISC[u] = 0u;
    __syncthreads();
    XcdBarrier bar; bar.bar = F.ctl + CW_BAR; bar.x = 0; bar.st = nullptr;
    const int lo = args_.ph_lo, hi = args_.ph_hi;
    if (hi - lo > 1) bar = xcd_barrier_post(F.ctl + CW_BAR, F.MISC + 8);
#ifndef MK_PHASE_MASK
#define MK_PHASE_MASK 0xFFFF
#endif
#define IN(k) (((MK_PHASE_MASK >> (k)) & 1) && lo <= (k) && (k) < hi)
#define SEAM(k) do { if (IN(k) && IN((k) + 1)) xcd_barrier(bar); } while (0)
#define FRESH() do { int t_ = threadIdx.x; asm volatile("" : "+v"(t_)); F.tid = t_; F.lane = t_ & 63; F.wave = __builtin_amdgcn_readfirstlane(t_ >> 6); } while (0)
    unsigned char* ws = args_.ws;

    if (IN(0)) { FRESH(); p0_prologue(F, args); }
    SEAM(0);
    if (IN(1)) { FRESH();
        SchedP1 S{F.G, F.vcu, ws};
        EpiP1 E{(bf16_t*)(ws + WS_PROJ), (float*)(ws + WS_DT), (bf16_t*)(ws + WS_KVRAW), args.in(I_DAQG), args.in(I_DAKG)};
        pg8::gemm_phase<EpiP1, SchedP1, false, true>(F.lds + RING_OFF, 32, S, E);
    }
    SEAM(1);
    if (IN(2)) { FRESH();
        kprep(F, args);
        if ((F.vcu & 3) == 0) { for (int u = F.vcu >> 2; u < 64; u += (F.G + 3) >> 2) ssd_unit(F, args, u >> 4, u & 15); }
        __syncthreads();
        attn_phase_da(F);
    }
    SEAM(2);
    if (IN(3)) { FRESH(); p3_finalize(F, args); }
    SEAM(3);
    if (IN(4)) { FRESH();
        SchedDense S{F.G, F.vcu, 32, 8, (const char*)(ws + WS_YCAT), (const char*)(ws + WS_WOUT), 4096u, 4096u, 1 << 30, 0};
#if MK_LAST_PHASE == 5
        EpiResid E{args.in(I_X), args_.out, nullptr, nullptr};
#else
        EpiResid E{args.in(I_X), (float*)(ws + WS_H1), (bf16_t*)(ws + WS_H1B), (float*)(ws + WS_PART1)};
#endif
        pg8::gemm_phase<EpiResid, SchedDense, false, true>(F.lds + RING_OFF, 32, S, E);
    }
    SEAM(4);
    if (IN(5)) { FRESH();
        SchedDense S{F.G, F.vcu, 32, 8, (const char*)(ws + WS_H1B), (const char*)(ws + WS_WQ), 4096u, 4096u, 1 << 30, 0};
        EpiQ E{(bf16_t*)(ws + WS_QRAW), (float*)(ws + WS_PARTQ)};
        pg8::gemm_phase<EpiQ, SchedDense, false, true>(F.lds + RING_OFF, 32, S, E);
    }
    SEAM(5);
    if (IN(6)) { FRESH();
        SchedXS S{F.G, F.vcu, ws};
        EpiXS E{(bf16_t*)(ws + WS_P), (bf16_t*)(ws + WS_VWT), (const float*)(ws + WS_PART1), (const float*)(ws + WS_PARTQ), (LAS float*)(F.lds + RING_BYTES)};
        pg8::gemm_phase<EpiXS, SchedXS, false, true>(F.lds + RING_OFF, 8, S, E);
    }
    SEAM(6);
    if (IN(7)) { FRESH();
        SchedDense S{F.G, F.vcu, 32, 8, (const char*)(ws + WS_P), (const char*)(ws + WS_VWT), 2048u, 2048u, 8, (size_t)2048 * 1024 * 2};
#if MK_LAST_PHASE == 8
        EpiResid E{(const float*)(ws + WS_H1), args_.out, nullptr, nullptr};
#else
        EpiResid E{(const float*)(ws + WS_H1), (float*)(ws + WS_H2), nullptr, nullptr};
#endif
        pg8::gemm_phase<EpiResid, SchedDense, false, true>(F.lds + RING_OFF, 16, S, E);
    }
    SEAM(7);
    if (IN(8)) { FRESH(); p8_route(F, args); }
    SEAM(8);
    if (IN(9)) { FRESH();
        moe_tables(F);
        SchedMoe<16> S{F.G, F.vcu, ws, F.MISC};
        EpiMoe1 E{(unsigned char*)(ws + WS_ACT), args.in(I_B1)};
        pg8::gemm_phase<EpiMoe1, SchedMoe<16>, false, true, true>(F.lds + RING_OFF, 16, S, E);
    }
    SEAM(9);
    if (IN(10)) { FRESH();
        moe_tables(F);
        SchedMoe<8> S{F.G, F.vcu, ws, F.MISC};
        EpiMoe2 E{(bf16_t*)(ws + WS_Y), args.in(I_B2), (const float*)(ws + WS_GATEOF)};
        pg8::gemm_phase<EpiMoe2, SchedMoe<8>, false, true, true>(F.lds + RING_OFF, 16, S, E);
    }
    SEAM(10);
    if (IN(11)) { FRESH(); p11_combine(F, args); }
#undef IN
#undef SEAM
}

extern "C" void kernel_launch(void* const* d_in, const int* in_sizes, int n_in, void* d_out, int out_size, void* d_ws, size_t ws_size, hipStream_t stream) {
    static int grid = 0;
    if (grid == 0) {
        if (n_in != 32 || out_size != NTOK * 2048 || ws_size < WS_END) { fprintf(stderr, "kernel_launch: unexpected shapes (n_in %d out %d ws %zu); nothing launched\n", n_in, out_size, ws_size); grid = -1; return; }
        int dev = 0, cus = 0, per_cu = 0;
        if (hipGetDevice(&dev) != hipSuccess || hipDeviceGetAttribute(&cus, hipDeviceAttributeMultiprocessorCount, dev) != hipSuccess) { grid = -1; return; }
        if (hipFuncSetAttribute((const void*)mega_fwd, hipFuncAttributeMaxDynamicSharedMemorySize, LDS_BYTES) != hipSuccess) { fprintf(stderr, "kernel_launch: hipFuncSetAttribute failed\n"); grid = -1; return; }
        if (hipOccupancyMaxActiveBlocksPerMultiprocessor(&per_cu, (const void*)mega_fwd, NWAVES * 64, LDS_BYTES) != hipSuccess || per_cu < 1) { fprintf(stderr, "kernel_launch: occupancy query says %d\n", per_cu); }
        (void)hipGetLastError();
        if (cus < 256) { fprintf(stderr, "kernel_launch: needs 256 CUs, found %d; nothing launched\n", cus); grid = -1; return; }
        grid = 256;
    }
    if (grid < 0) return;
    if (hipMemsetAsync((char*)d_ws + WS_CTL, 0, CTL_ZERO_BYTES, stream) != hipSuccess) return;
    Args a{};
    for (int i = 0; i < 32; ++i) a.in[i] = (const float*)d_in[i];
    a.out = (float*)d_out; a.ws = (unsigned char*)d_ws;
#if MK_PER_PHASE
    for (int p = 0; p < N_PHASES; ++p) { a.ph_lo = p; a.ph_hi = p + 1; hipLaunchKernelGGL(mega_fwd, dim3(grid), dim3(NWAVES * 64), LDS_BYTES, stream, a); }
#else
    a.ph_lo = 0; a.ph_hi = N_PHASES;
    hipLaunchKernelGGL(mega_fwd, dim3(grid), dim3(NWAVES * 64), LDS_BYTES, stream, a);
#ifdef MK_PROBE_LO
    for (int p = MK_PROBE_LO; p < MK_PROBE_HI; ++p) { a.ph_lo = p; a.ph_hi = p + 1; hipLaunchKernelGGL(mega_fwd, dim3(grid), dim3(NWAVES * 64), LDS_BYTES, stream, a); }
#endif
#endif
}
```

```cpp
#define MK_PER_PHASE 0
#define MK_LAST_PHASE 12
#define MK_PHASE_MASK 0xfff
#include <hip/hip_runtime.h>
#include <hip/hip_bf16.h>
#include <cstdio>
#include <cstdint>
#include <cmath>

#define GAS __attribute__((address_space(1)))
#define LAS __attribute__((address_space(3)))
typedef unsigned short bf16_t;
typedef short bf16x8 __attribute__((ext_vector_type(8)));
typedef float f32x2 __attribute__((ext_vector_type(2)));
typedef float f32x4 __attribute__((ext_vector_type(4)));
typedef float f32x16 __attribute__((ext_vector_type(16)));
typedef unsigned u32x2 __attribute__((ext_vector_type(2)));
typedef unsigned u32x4 __attribute__((ext_vector_type(4)));
typedef __bf16 bf16x2_t __attribute__((ext_vector_type(2)));

#define DI __device__ __forceinline__
DI unsigned pk2(float lo, float hi) { f32x2 v = {lo, hi}; bf16x2_t b = __builtin_convertvector(v, bf16x2_t); return __builtin_bit_cast(unsigned, b); }
DI float bflo(unsigned u) { return __uint_as_float(u << 16); }
DI float bfhi(unsigned u) { return __uint_as_float(u & 0xffff0000u); }
DI float bf2f(bf16_t h) { return __uint_as_float(((unsigned)h) << 16); }
DI float wave_sum(float v) {
#pragma unroll
    for (int o = 1; o < 64; o <<= 1) v += __shfl_xor(v, o);
    return v;
}
DI float quad_sum_16_32(float v) {
    int l_ = threadIdx.x; asm volatile("" : "+v"(l_));
    const int a16 = ((l_ ^ 16) & 63) << 2, a32 = ((l_ ^ 32) & 63) << 2;
    v += __builtin_bit_cast(float, __builtin_amdgcn_ds_bpermute(a16, __builtin_bit_cast(int, v)));
    v += __builtin_bit_cast(float, __builtin_amdgcn_ds_bpermute(a32, __builtin_bit_cast(int, v)));
    return v;
}
DI float siluf(float x) { return x / (1.f + __expf(-x)); }

constexpr int DM_ = 2048, NB = 4, SEQ_ = 2048, NTOK = NB * SEQ_;
constexpr int PP = 5632;
constexpr int PC_XBC = 1024, PC_Q = 2560, PC_K = 3584, PC_V = 4608, PC_DT = 5632;
constexpr int WIN_ROWS = 5888;
constexpr int NEXP = 32, MEMLEN = 256;
constexpr float EPS_ = 1e-6f;
constexpr float LAM_INIT = 0.2f;

namespace pg8 {
constexpr int BM = 256, BK = 64, HALF = 128, HTB = HALF * BK * 2  , STAGE_BYTES = 8 * HTB;
DI int lds_byte(int r, int c) { const int st = (r >> 4) * 2 + (c >> 5), rr = r & 15, cc = c & 31, ob = rr * 64 + cc * 2; return st * 1024 + (ob ^ (((ob >> 9) & 1) << 5)); }
DI void stage_rc(int b, int& R, int& C) { const int st = b / 1024, sb = b % 1024, swz = sb ^ (((sb >> 9) & 1) << 5); R = (st >> 1) * 16 + swz / 64; C = (st & 1) * 32 + (swz % 64) / 2; }
DI int perm32(int rho) { const int n = rho >> 4, i = rho & 15; return 8 * (i >> 2) + 4 * n + (i & 3); }

struct UnitD {
    const char* A; const char* B;
    const int* rows;
    unsigned lda, ldb;
    int nvalid;
    int type, pm, pn, e, x0;
};
typedef int v8i_t __attribute__((ext_vector_type(8)));
DI v8i_t cat8(bf16x8 lo, bf16x8 hi) { typedef int v4i_t __attribute__((ext_vector_type(4))); const v4i_t a = __builtin_bit_cast(v4i_t, lo), b = __builtin_bit_cast(v4i_t, hi); return (v8i_t){a[0], a[1], a[2], a[3], b[0], b[1], b[2], b[3]}; }
DI void dense_voff(unsigned lda, unsigned ldb, int tid, unsigned (&vA)[2], unsigned (&vB)[2]) {
#pragma unroll
    for (int i = 0; i < 2; ++i) { int R, C; stage_rc(tid * 16 + i * 8192, R, C); const int Rb = (R & ~31) + perm32(R & 31);
        vA[i] = (unsigned)R * lda + (unsigned)C * 2u; vB[i] = (unsigned)Rb * ldb + (unsigned)C * 2u; }
}
DI void gather_voff(const UnitD& u, int tid, unsigned (&gA)[2][2]) {
#pragma unroll
    for (int i = 0; i < 2; ++i) { int R, C; stage_rc(tid * 16 + i * 8192, R, C);
#pragma unroll
        for (int h = 0; h < 2; ++h) { const int ra = h * 128 + R; const unsigned rowA = (ra < u.nvalid) ? (unsigned)u.rows[ra] : 0u; gA[h][i] = rowA * u.lda + (unsigned)C * 2u; } }
}

template <class Epi, class Sched, bool GATHER, bool ALIGN_EPI, bool FP8 = false>
DI void gemm_phase(LAS unsigned char* lds, int nt, const Sched& S, const Epi& E) {

    const int tid = threadIdx.x, wid = __builtin_amdgcn_readfirstlane(tid >> 6), lane = tid & 63, wr = wid >> 2, wc = wid & 3, fr = lane & 15, fq = lane >> 4;
    const size_t kstep = (size_t)(BK * 2);
    const unsigned ldsb = (unsigned)__builtin_amdgcn_readfirstlane((int)((unsigned)(uintptr_t)lds + (unsigned)wid * 1024u));
    const int aoff = lds_byte(wr * 64 + fr, fq * 8), boff = lds_byte(wc * 32 + fr, fq * 8);
#define PG8_SA(b, h) (((b) * 2 + (h)) * HTB)
#define PG8_SB(b, h) ((4 + (b) * 2 + (h)) * HTB)
#define PG8_STAGE(bufoff, gbase, voff) do { _Pragma("unroll") for (int _i = 0; _i < 2; ++_i) { unsigned keep_; \
        asm volatile("s_mov_b32 %0, m0\n\ts_mov_b32 m0, %3\n\ts_nop 0\n\tglobal_load_lds_dwordx4 %1, %2\n\ts_mov_b32 m0, %0" \
                     : "=&s"(keep_) : "v"((voff)[_i]), "s"((const char*)(gbase)), "s"(ldsb + (unsigned)((bufoff) + _i * 8192)) : "memory"); } } while (0)
#define PG8_STA(bufoff, gbase, h, HS, GA) do { if constexpr (GATHER) { PG8_STAGE(bufoff, gbase, GA[h]); } else { PG8_STAGE(bufoff, (gbase) + (h) * (HS), vA); } } while (0)
#define PG8_STB(bufoff, gbase, h, HS) PG8_STAGE(bufoff, (gbase) + (h) * (HS), vB)
typedef int v4i_t __attribute__((ext_vector_type(4)));
#define PG8_LDA(dst, b, h) do { _Pragma("unroll") for (int m = 0; m < 4; ++m) { if constexpr (FP8) { \
            const v4i_t lo_ = *(const LAS v4i_t*)(lds + PG8_SA(b, h) + aoff + m * 2048), hi_ = *(const LAS v4i_t*)(lds + PG8_SA(b, h) + aoff + m * 2048 + 1024); \
            dst##8[m] = __builtin_shufflevector(lo_, hi_, 0, 1, 2, 3, 4, 5, 6, 7); } \
        else { _Pragma("unroll") for (int k = 0; k < 2; ++k) dst[m][k] = *(const LAS bf16x8*)(lds + PG8_SA(b, h) + aoff + m * 2048 + k * 1024); } } } while (0)
#define PG8_LDB(dst, b, h) do { _Pragma("unroll") for (int n = 0; n < 2; ++n) { if constexpr (FP8) { \
            const v4i_t lo_ = *(const LAS v4i_t*)(lds + PG8_SB(b, h) + boff + n * 2048), hi_ = *(const LAS v4i_t*)(lds + PG8_SB(b, h) + boff + n * 2048 + 1024); \
            dst##8[n] = __builtin_shufflevector(lo_, hi_, 0, 1, 2, 3, 4, 5, 6, 7); } \
        else { _Pragma("unroll") for (int k = 0; k < 2; ++k) dst[n][k] = *(const LAS bf16x8*)(lds + PG8_SB(b, h) + boff + n * 2048 + k * 1024); } } } while (0)
#define PG8_MMA(ai, bj, At, Bt) do { __builtin_amdgcn_s_setprio(1); _Pragma("unroll") for (int m = 0; m < 4; ++m) _Pragma("unroll") for (int n = 0; n < 2; ++n) { \
        if constexpr (FP8) { acc[ai][bj][m][n] = __builtin_amdgcn_mfma_scale_f32_16x16x128_f8f6f4(Bt##8[n], At##8[m], acc[ai][bj][m][n], 0, 0, 0, 0x7f7f7f7f, 0, 0x7f7f7f7f); } \
        else { _Pragma("unroll") for (int k = 0; k < 2; ++k) acc[ai][bj][m][n] = __builtin_amdgcn_mfma_f32_16x16x32_bf16(Bt[n][k], At[m][k], acc[ai][bj][m][n], 0, 0, 0); } } \
        __builtin_amdgcn_s_setprio(0); } while (0)
#define PG8_WAIT_V(n) asm volatile("s_waitcnt vmcnt(" #n ")" ::: "memory")
#define PG8_WAIT_L(n) asm volatile("s_waitcnt lgkmcnt(" #n ")" ::: "memory")
#define PG8_BAR __builtin_amdgcn_s_barrier()
#define PG8_SCHED __builtin_amdgcn_sched_barrier(0)
#define PG8_ITER(A1P, A2P, B2P, HA2, HB2, GA2) do { \
        const char* a3p_ = (A2P) + kstep; const char* b3p_ = (B2P) + kstep; \
        PG8_LDB(B0, 0, 0); PG8_LDB(B1, 0, 1); PG8_SCHED; PG8_LDA(At, 0, 0); PG8_STA(PG8_SA(1, 1), (A1P), 1, hsA, gA); \
        PG8_WAIT_V(8); PG8_WAIT_L(0); PG8_BAR; PG8_MMA(0, 0, At, B0); PG8_MMA(0, 1, At, B1); PG8_BAR; PG8_SCHED; \
        PG8_LDA(At, 0, 1); PG8_STB(PG8_SB(0, 0), (B2P), 0, HB2); PG8_STB(PG8_SB(0, 1), (B2P), 1, HB2); PG8_STA(PG8_SA(0, 0), (A2P), 0, HA2, GA2); \
        PG8_WAIT_V(8); PG8_WAIT_L(0); PG8_BAR; PG8_MMA(1, 0, At, B0); PG8_MMA(1, 1, At, B1); PG8_BAR; PG8_SCHED; \
        PG8_LDB(B0, 1, 0); PG8_LDB(B1, 1, 1); PG8_SCHED; PG8_LDA(At, 1, 0); PG8_STA(PG8_SA(0, 1), (A2P), 1, HA2, GA2); \
        PG8_WAIT_V(8); PG8_WAIT_L(0); PG8_BAR; PG8_MMA(0, 0, At, B0); PG8_MMA(0, 1, At, B1); PG8_BAR; PG8_SCHED; \
        PG8_LDA(At, 1, 1); PG8_STB(PG8_SB(1, 0), b3p_, 0, HB2); PG8_STB(PG8_SB(1, 1), b3p_, 1, HB2); PG8_STA(PG8_SA(1, 0), a3p_, 0, HA2, GA2); \
        PG8_WAIT_V(8); PG8_WAIT_L(0); PG8_BAR; PG8_MMA(1, 0, At, B0); PG8_MMA(1, 1, At, B1); PG8_BAR; PG8_SCHED; \
    } while (0)
    UnitD cur, nxt; int ui = 0;
    if (!S.next(0, cur)) return;
    f32x4 acc[2][2][4][2];
#pragma unroll
    for (int a = 0; a < 2; ++a)
#pragma unroll
        for (int b = 0; b < 2; ++b)
#pragma unroll
            for (int m = 0; m < 4; ++m)
#pragma unroll
                for (int n = 0; n < 2; ++n) acc[a][b][m][n] = (f32x4){0.f, 0.f, 0.f, 0.f};
    bf16x8 At[4][2], B0[2][2], B1[2][2]; v8i_t At8[4], B08[2], B18[2];
    unsigned vA[2], vB[2], gA[2][2], ngA[2][2];
    dense_voff(cur.lda, cur.ldb, tid, vA, vB);
    if constexpr (GATHER) gather_voff(cur, tid, gA);
    const char* cA = cur.A; const char* cB = cur.B;
    size_t hsA = GATHER ? 0 : (size_t)cur.lda * HALF, hsB = (size_t)cur.ldb * HALF;
    PG8_STB(PG8_SB(0, 0), cB, 0, hsB); PG8_STB(PG8_SB(0, 1), cB, 1, hsB); PG8_STA(PG8_SA(0, 0), cA, 0, hsA, gA); PG8_STA(PG8_SA(0, 1), cA, 1, hsA, gA);
    if (wr == 1) PG8_BAR;
    PG8_WAIT_V(2); PG8_BAR;
    PG8_STB(PG8_SB(1, 0), cB + kstep, 0, hsB); PG8_STA(PG8_SA(1, 0), cA + kstep, 0, hsA, gA); PG8_STB(PG8_SB(1, 1), cB + kstep, 1, hsB);
    PG8_WAIT_V(6); PG8_BAR;
    for (;;) {
        const bool has_next = S.next(ui + 1, nxt);
        const char* nA = cA; const char* nB = cB; size_t nhsA = hsA, nhsB = hsB;
        if (has_next) { nA = nxt.A; nB = nxt.B; nhsA = GATHER ? 0 : (size_t)nxt.lda * HALF; nhsB = (size_t)nxt.ldb * HALF; }
        if constexpr (GATHER) {
            if (has_next) gather_voff(nxt, tid, ngA);
            else {
#pragma unroll
                for (int h = 0; h < 2; ++h)
#pragma unroll
                    for (int i = 0; i < 2; ++i) ngA[h][i] = gA[h][i];
            }
        }
#pragma unroll 1
        for (int t = 0; t < nt; t += 2) {
            const bool last = (t == nt - 2);
            const char* a2 = last ? nA : cA + (size_t)(t + 2) * kstep; const char* b2 = last ? nB : cB + (size_t)(t + 2) * kstep;
            const size_t hA2 = last ? nhsA : hsA, hB2 = last ? nhsB : hsB;
            unsigned g2[2][2];
            if constexpr (GATHER) {
#pragma unroll
                for (int h = 0; h < 2; ++h)
#pragma unroll
                    for (int i = 0; i < 2; ++i) g2[h][i] = last ? ngA[h][i] : gA[h][i];
            }
            PG8_ITER(cA + (size_t)(t + 1) * kstep, a2, b2, hA2, hB2, g2);
        }
        if constexpr (ALIGN_EPI) { if (wr == 0) PG8_BAR; }
        if constexpr (!Epi::AFTER_DRAIN) { E(acc, cur, wr, wc, fr, fq); }
        if (!has_next) break;
#pragma unroll
        for (int a = 0; a < 2; ++a)
#pragma unroll
            for (int b = 0; b < 2; ++b)
#pragma unroll
                for (int m = 0; m < 4; ++m)
#pragma unroll
                    for (int n = 0; n < 2; ++n) acc[a][b][m][n] = (f32x4){0.f, 0.f, 0.f, 0.f};
        cur = nxt; cA = nA; cB = nB; hsA = nhsA; hsB = nhsB; ++ui;
        if constexpr (GATHER) {
#pragma unroll
            for (int h = 0; h < 2; ++h)
#pragma unroll
                for (int i = 0; i < 2; ++i) gA[h][i] = ngA[h][i];
        }
        if constexpr (ALIGN_EPI) { if (wr == 1) PG8_BAR; }
    }
    PG8_WAIT_V(0);
    if constexpr (!ALIGN_EPI) { if (wr == 0) PG8_BAR; }
    PG8_BAR;
    if constexpr (Epi::AFTER_DRAIN) { E.fused(acc, cur, wr, wc, fr, fq, lds, wid, lane); }
#undef PG8_SA
#undef PG8_SB
#undef PG8_STAGE
#undef PG8_STA
#undef PG8_STB
#undef PG8_LDA
#undef PG8_LDB
#undef PG8_MMA
#undef PG8_WAIT_V
#undef PG8_WAIT_L
#undef PG8_BAR
#undef PG8_SCHED
#undef PG8_ITER
}
}
namespace attn_body {
using bf16=__hip_bfloat16;
using bf16x8=__attribute__((ext_vector_type(8)))short;
using s16x4=__attribute__((ext_vector_type(4)))short;
using f32x16=__attribute__((ext_vector_type(16)))float;
using u32x4=__attribute__((ext_vector_type(4)))unsigned;
constexpr int BATCH=4,SEQ=2048,D=64,DM=5632,OPITCH=1024;
constexpr int NW=8,QBLK=32,QB=QBLK*NW,KVBLK=64,NQB=SEQ/QB;
constexpr int ATTN_UNIT_ROWS=QB;
__device__ __forceinline__ int crow(int r,int hi){return (r&3)+8*(r>>2)+4*hi;}
#define SBAR() __builtin_amdgcn_sched_barrier(0)
__device__ __forceinline__ void cmask(f32x16&p0,f32x16&p1,int jb,int qrel,int hi){
  const float NEG=-INFINITY; int kb=64*jb+4*hi;
  #pragma unroll
  for(int r=0;r<16;++r){int kv=kb+(r&3)+8*(r>>2); if(kv>qrel)p0[r]=NEG; if(kv+32>qrel)p1[r]=NEG;}
}

constexpr int NSLOT=3, SLOTB=8192;
constexpr int LDS_K=0, LDS_V=NSLOT*SLOTB, LDS_WS=2*NSLOT*SLOTB, LDS_OST=LDS_WS+NW*64*4, LDS_BYTES=LDS_OST+NW*4096;
constexpr float C2=0.125f*1.4426950408889634f;
__device__ __forceinline__ void glds16(const void*gsrc,unsigned lds_dst){unsigned keep;
  asm volatile("s_mov_b32 %0, m0\n\ts_mov_b32 m0, %2\n\ts_nop 0\n\tglobal_load_lds_dwordx4 %1, off\n\ts_mov_b32 m0, %0":"=&s"(keep):"v"(gsrc),"s"(lds_dst):"memory");}
__device__ __forceinline__ float max3f(float a,float b,float c){float r;asm("v_max3_f32 %0, %1, %2, %3":"=v"(r):"v"(a),"v"(b),"v"(c));return r;}
__device__ __forceinline__ float max2f(float a,float b){float r;asm("v_max_f32_e32 %0, %1, %2":"=v"(r):"v"(a),"v"(b));return r;}
__device__ __forceinline__ float fadd_s(float a,float b){float r;asm("v_add_f32_e32 %0, %1, %2":"=v"(r):"v"(a),"v"(b));return r;}
__device__ __forceinline__ float fsub_s(float a,float b){float r;asm("v_sub_f32_e32 %0, %1, %2":"=v"(r):"v"(a),"v"(b));return r;}
typedef float f32x2_t __attribute__((ext_vector_type(2))); typedef __bf16 bf16x2_t __attribute__((ext_vector_type(2)));
__device__ __forceinline__ unsigned cvtpk_s(float lo,float hi){f32x2_t v={lo,hi};bf16x2_t b=__builtin_convertvector(v,bf16x2_t);return __builtin_bit_cast(unsigned,b);}
#define WAIT_BAR(N) asm volatile("s_waitcnt vmcnt(" #N ") lgkmcnt(0)\n\ts_barrier":::"memory")

__device__ __forceinline__ void qkt(f32x16&p0,f32x16&p1,const char*Kslot,const bf16x8*qr,const f32x16&negm,int r32,int hi){
  const char*kb=Kslot+hi*1024+r32*16;
  #pragma unroll
  for(int d0=0;d0<4;++d0){
    const bf16x8 b0=*reinterpret_cast<const bf16x8*>(kb+d0*2048);
    const bf16x8 b1=*reinterpret_cast<const bf16x8*>(kb+d0*2048+512);
    if(d0==0){p0=__builtin_amdgcn_mfma_f32_32x32x16_bf16(b0,qr[0],negm,0,0,0);p1=__builtin_amdgcn_mfma_f32_32x32x16_bf16(b1,qr[0],negm,0,0,0);}
    else{p0=__builtin_amdgcn_mfma_f32_32x32x16_bf16(b0,qr[d0],p0,0,0,0);p1=__builtin_amdgcn_mfma_f32_32x32x16_bf16(b1,qr[d0],p1,0,0,0);}}
}
typedef __attribute__((address_space(3))) const char* lds_cptr;
typedef short v4i16_t __attribute__((ext_vector_type(4)));
__device__ __forceinline__ void kload8(bf16x8*kf,lds_cptr kp){
  kf[0]=*(const __attribute__((address_space(3))) bf16x8*)(kp);      kf[1]=*(const __attribute__((address_space(3))) bf16x8*)(kp+512);
  kf[2]=*(const __attribute__((address_space(3))) bf16x8*)(kp+2048); kf[3]=*(const __attribute__((address_space(3))) bf16x8*)(kp+2560);
  kf[4]=*(const __attribute__((address_space(3))) bf16x8*)(kp+4096); kf[5]=*(const __attribute__((address_space(3))) bf16x8*)(kp+4608);
  kf[6]=*(const __attribute__((address_space(3))) bf16x8*)(kp+6144); kf[7]=*(const __attribute__((address_space(3))) bf16x8*)(kp+6656);
}
__device__ __forceinline__ void kload2(bf16x8*kf,lds_cptr kp,int j){ kf[2*j]=*(const __attribute__((address_space(3))) bf16x8*)(kp+j*2048); kf[2*j+1]=*(const __attribute__((address_space(3))) bf16x8*)(kp+j*2048+512); }
__device__ __forceinline__ s16x4 vtr(lds_cptr p){ return __builtin_bit_cast(s16x4,__builtin_amdgcn_ds_read_tr16_b64_v4i16((__attribute__((address_space(3))) v4i16_t*)p)); }
__device__ __forceinline__ float rowmax(const f32x16&p0,const f32x16&p1){
  float a=max3f(p0[0],p0[1],p1[0]),b=max3f(p0[2],p0[3],p1[1]);a=max3f(a,p1[2],p1[3]);
  #pragma unroll
  for(int r=4;r<16;r+=4){a=max3f(a,p0[r],p0[r+1]);b=max3f(b,p0[r+2],p0[r+3]);a=max3f(a,p1[r],p1[r+1]);b=max3f(b,p1[r+2],p1[r+3]);}
  const float m=max2f(a,b);
  auto rr=__builtin_amdgcn_permlane32_swap(__float_as_uint(m),__float_as_uint(m),false,false);
  return max2f(__uint_as_float(rr[0]),__uint_as_float(rr[1]));
}
__device__ __forceinline__ void pv(f32x16*o,int vb,bf16x8 pa0,bf16x8 pa1,bf16x8 pa2,bf16x8 pa3){
  #pragma unroll
  for(int d0=0;d0<2;++d0){s16x4 lo[4],hi[4];
    #pragma unroll
    for(int ks=0;ks<4;++ks){
      asm volatile("ds_read_b64_tr_b16 %0,%1 offset:%c2":"=&v"(lo[ks]):"v"(vb),"i"(d0*4096+ks*1024):"memory");
      asm volatile("ds_read_b64_tr_b16 %0,%1 offset:%c2":"=&v"(hi[ks]):"v"(vb),"i"(d0*4096+ks*1024+512):"memory");}
    asm volatile("s_waitcnt lgkmcnt(0)":::"memory");SBAR();
    #define PK(k) (bf16x8){lo[k][0],lo[k][1],lo[k][2],lo[k][3],hi[k][0],hi[k][1],hi[k][2],hi[k][3]}
    o[d0]=__builtin_amdgcn_mfma_f32_32x32x16_bf16(pa0,PK(0),o[d0],0,0,0);
    o[d0]=__builtin_amdgcn_mfma_f32_32x32x16_bf16(pa1,PK(1),o[d0],0,0,0);
    o[d0]=__builtin_amdgcn_mfma_f32_32x32x16_bf16(pa2,PK(2),o[d0],0,0,0);
    o[d0]=__builtin_amdgcn_mfma_f32_32x32x16_bf16(pa3,PK(3),o[d0],0,0,0);
    #undef PK
  }
}

#ifndef ATTN_STORE16
#define ATTN_STORE16(p,v) (*(u32x4*)(p)=(v))
#endif
template<int THRL> __device__ __forceinline__ void attn_unit(int b,int qcol,int vcol,int ocol,int qb,const bf16*Q,const bf16*__restrict__ K,const bf16*__restrict__ V,bf16*O,char*shm){
  const int tid=threadIdx.x,lane=tid&63,r32=lane&31,hi=lane>>5; const int wid=__builtin_amdgcn_readfirstlane(tid>>6);
  const long rowbase=(long)b*SEQ; const int q0=qb*QB;
  const bf16*Qw=Q+(rowbase+q0+wid*QBLK)*DM+qcol;
  const bf16*Kh=K+rowbase*DM+qcol,*Vh=V+rowbase*DM+vcol;
  const unsigned lds0=(unsigned)(uintptr_t)shm;
  float*wsf=(float*)(shm+LDS_WS)+wid*64;
  const bf16*ksrc=Kh+(long)lane*DM+wid*8;
  const bf16*vsrc=Vh+(long)(16*(wid&3)+(lane>>2))*DM+(wid>>2)*32+(lane&3)*8;
  const unsigned kdst=lds0+LDS_K+wid*1024, vdst=lds0+LDS_V+wid*1024;
  #define DMA_K(t,slot) glds16(ksrc+(long)(t)*KVBLK*DM,(unsigned)__builtin_amdgcn_readfirstlane(kdst+(slot)))
  #define DMA_V(t,slot) glds16(vsrc+(long)(t)*KVBLK*DM,(unsigned)__builtin_amdgcn_readfirstlane(vdst+(slot)))
  const int vb0=(int)(lds0+LDS_V)+((lane>>4)&1)*32+(lane&3)*8+(4*hi+((lane&15)>>2))*64;
  const char*Kbase=shm+LDS_K; bf16x8 kf[8];
  const lds_cptr shm3=(lds_cptr)shm; const lds_cptr kp0=shm3+LDS_K+hi*1024+r32*16; const lds_cptr vp0=shm3+LDS_V+((lane>>4)&1)*32+(lane&3)*8+(4*hi+((lane&15)>>2))*64;
  const int NT=(q0+QB)/KVBLK;
  DMA_K(0,0);DMA_V(0,0);DMA_K(1,SLOTB);
  bf16x8 qr[4];
  #pragma unroll
  for(int d0=0;d0<4;++d0)qr[d0]=*reinterpret_cast<const bf16x8*>(&Qw[(long)r32*DM+d0*16+hi*8]);
  float mhat=0.f,l_reg=0.f;f32x16 o[2];o[0]=f32x16{};o[1]=f32x16{};f32x16 negm=f32x16{};asm volatile("":"+v"(negm));
  const int qrel=wid*QBLK+r32;
  #define CMASK(P0,P1,t) do{int jb_=(t)-(NT-4); if(jb_>=0)cmask(P0,P1,jb_,qrel,hi);}while(0)
  bool resc=false;
  #define START(P0,P1) do{ const float rm=rowmax(P0,P1); resc=false; \
    { const float dl=rm; mhat=fadd_s(mhat,dl); \
      _Pragma("unroll") for(int r=0;r<16;++r){P0[r]=fsub_s(P0[r],dl);P1[r]=fsub_s(P1[r],dl);} \
      _Pragma("unroll") for(int r=0;r<16;++r)negm[r]=-mhat; asm volatile("":"+v"(negm)); } \
    _Pragma("unroll") for(int r=0;r<16;++r)P0[r]=__builtin_amdgcn_exp2f(P0[r]); }while(0)
  #define RESC() do{ if(resc){ asm volatile("s_waitcnt lgkmcnt(0)":::"memory"); \
      _Pragma("unroll") for(int d_=0;d_<2;++d_) _Pragma("unroll") for(int r=0;r<16;++r)o[d_][r]*=wsf[crow(r,hi)]; } }while(0)
  f32x16 pA0,pA1,pB0,pB1;
  int sl_prev=0,sl_cur=0,sl_next=SLOTB;
  #define ROT() do{sl_prev=sl_cur;sl_cur=sl_next;sl_next=(sl_next==(NSLOT-1)*SLOTB)?0:sl_next+SLOTB;}while(0)
  DMA_K(2,2*SLOTB);
  WAIT_BAR(3);
  qkt(pA0,pA1,Kbase,qr,negm,r32,hi);asm volatile("s_nop 15\n\ts_nop 7":"+v"(pA0),"+v"(pA1));CMASK(pA0,pA1,0);
  START(pA0,pA1);
  _Pragma("unroll") for(int r=0;r<16;++r)pA1[r]=__builtin_amdgcn_exp2f(pA1[r]);
  WAIT_BAR(0);
  DMA_K(3,0);DMA_V(1,SLOTB);
  ROT();
  kload8(kf,kp0+sl_cur);
  WAIT_BAR(2);
  s16x4 vlo[8],vhi[8]; u32x4 pw0,pw1,pw2,pw3;
  #define PKW(P,B) cvtpk_s(P[B],P[B+1])
  #define PAF(k) __builtin_bit_cast(bf16x8,pw##k)
  #define VFR(i) (bf16x8){vlo[i][0],vlo[i][1],vlo[i][2],vlo[i][3],vhi[i][0],vhi[i][1],vhi[i][2],vhi[i][3]}
  #define PIN(x) asm volatile("":"+v"(x))
  #define MX3(a,b,c) __builtin_fmaxf(__builtin_fmaxf((a),(b)),(c))
  #define GAPA(MF,A0,A1,A2,A3,W0,W1,PW) do{ MF; sacc+=A0; sacc+=A1; sacc+=A2; sacc+=A3; PIN(sacc); W0; W1; PIN(PW); SBAR(); }while(0)
  #define EX(v) __builtin_amdgcn_exp2f(v)
  #define GAPB(MF,X,B) do{ MF; X[B]=EX(X[B]); X[B+1]=EX(X[B+1]); X[B+2]=EX(X[B+2]); X[B+3]=EX(X[B+3]); PIN(X); SBAR(); }while(0)
  #define VRD(i) do{ vlo[i]=vtr(vp_+(((i)>>2)*4096+((i)&3)*1024)); vhi[i]=vtr(vp_+(((i)>>2)*4096+((i)&3)*1024+512)); }while(0)
  #define KRD(G,j) do{ if(G){ kload2(kf,kp0+sl_next,j); SBAR(); } }while(0)
  #define STEP(C0,C1,P0,P1,t,GK,GV,GL) do{ SBAR(); \
    const lds_cptr vp_=vp0+sl_prev; \
    VRD(0); SBAR(); float sacc=(P0[0]+P0[1]); \
    GAPA(C0=__builtin_amdgcn_mfma_f32_32x32x16_bf16(kf[0],qr[0],negm,0,0,0), P0[2],P0[3],P0[4],P0[5],     pw0[0]=PKW(P0,0), pw0[1]=PKW(P0,2), pw0); \
    VRD(4); SBAR(); GAPA(C1=__builtin_amdgcn_mfma_f32_32x32x16_bf16(kf[1],qr[0],negm,0,0,0), P0[6],P0[7],P0[8],P0[9],     pw0[2]=PKW(P0,4), pw0[3]=PKW(P0,6), pw0); \
    VRD(1); SBAR(); GAPA(C0=__builtin_amdgcn_mfma_f32_32x32x16_bf16(kf[2],qr[1],C0,0,0,0),   P0[10],P0[11],P0[12],P0[13], pw1[0]=PKW(P0,8), pw1[1]=PKW(P0,10), pw1); \
    VRD(5); SBAR(); GAPA(C1=__builtin_amdgcn_mfma_f32_32x32x16_bf16(kf[3],qr[1],C1,0,0,0),   P0[14],P0[15],P1[0],P1[1],   pw1[2]=PKW(P0,12),pw1[3]=PKW(P0,14), pw1); \
    VRD(2); SBAR(); GAPA(C0=__builtin_amdgcn_mfma_f32_32x32x16_bf16(kf[4],qr[2],C0,0,0,0),   P1[2],P1[3],P1[4],P1[5],     pw2[0]=PKW(P1,0), pw2[1]=PKW(P1,2), pw2); \
    VRD(6); SBAR(); GAPA(C1=__builtin_amdgcn_mfma_f32_32x32x16_bf16(kf[5],qr[2],C1,0,0,0),   P1[6],P1[7],P1[8],P1[9],     pw2[2]=PKW(P1,4), pw2[3]=PKW(P1,6), pw2); \
    VRD(3); SBAR(); GAPA(C0=__builtin_amdgcn_mfma_f32_32x32x16_bf16(kf[6],qr[3],C0,0,0,0),   P1[10],P1[11],P1[12],P1[13], pw3[0]=PKW(P1,8), pw3[1]=PKW(P1,10), pw3); \
    VRD(7); SBAR(); GAPA(C1=__builtin_amdgcn_mfma_f32_32x32x16_bf16(kf[7],qr[3],C1,0,0,0),   P1[14],P1[15],0.f,0.f,       pw3[2]=PKW(P1,12),pw3[3]=PKW(P1,14), pw3); \
    l_reg+=sacc; \
    if(GK){DMA_K((t)+3,sl_cur);} if(GV){DMA_V((t)+1,sl_next);} \
    CMASK(C0,C1,t); \
    { float a=MX3(C0[0],C0[1],C1[0]),b=MX3(C0[2],C0[3],C1[1]); a=MX3(a,C1[2],C1[3]); \
      _Pragma("unroll") for(int r=4;r<16;r+=4){a=MX3(a,C0[r],C0[r+1]);b=MX3(b,C0[r+2],C0[r+3]);a=MX3(a,C1[r],C1[r+1]);b=MX3(b,C1[r+2],C1[r+3]);} \
      float rm=__builtin_fmaxf(a,b); { auto rr=__builtin_amdgcn_permlane32_swap(__float_as_uint(rm),__float_as_uint(rm),false,false); rm=__builtin_fmaxf(__uint_as_float(rr[0]),__uint_as_float(rr[1])); } \
      resc=false; \
      if(__builtin_expect(__any(rm>(float)THRL),0)){ const float dl=__builtin_fmaxf(rm,0.f); mhat+=dl; \
        _Pragma("unroll") for(int r=0;r<16;++r){C0[r]-=dl;C1[r]-=dl;} \
        _Pragma("unroll") for(int r=0;r<16;++r)negm[r]=-mhat; asm volatile("":"+v"(negm)); \
        const float f=__builtin_amdgcn_exp2f(-dl); l_reg*=f; if(hi==0)wsf[r32]=f; resc=true; } } \
    SBAR(); \
    GAPB(o[0]=__builtin_amdgcn_mfma_f32_32x32x16_bf16(PAF(0),VFR(0),o[0],0,0,0), C0,0); \
    GAPB(o[1]=__builtin_amdgcn_mfma_f32_32x32x16_bf16(PAF(0),VFR(4),o[1],0,0,0), C0,4); \
    KRD(GL,0); GAPB(o[0]=__builtin_amdgcn_mfma_f32_32x32x16_bf16(PAF(1),VFR(1),o[0],0,0,0), C0,8); \
    KRD(GL,1); GAPB(o[1]=__builtin_amdgcn_mfma_f32_32x32x16_bf16(PAF(1),VFR(5),o[1],0,0,0), C0,12); \
    KRD(GL,2); GAPB(o[0]=__builtin_amdgcn_mfma_f32_32x32x16_bf16(PAF(2),VFR(2),o[0],0,0,0), C1,0); \
    KRD(GL,3); GAPB(o[1]=__builtin_amdgcn_mfma_f32_32x32x16_bf16(PAF(2),VFR(6),o[1],0,0,0), C1,4); \
    GAPB(o[0]=__builtin_amdgcn_mfma_f32_32x32x16_bf16(PAF(3),VFR(3),o[0],0,0,0), C1,8); \
    GAPB(o[1]=__builtin_amdgcn_mfma_f32_32x32x16_bf16(PAF(3),VFR(7),o[1],0,0,0), C1,12); \
    }while(0)
  int t=1;
  #undef CMASK
  #define CMASK(P0,P1,t) do{}while(0)
  for(;t+5<NT;t+=2){
    STEP(pB0,pB1,pA0,pA1,t,true,true,true);     WAIT_BAR(2); RESC(); ROT();
    STEP(pA0,pA1,pB0,pB1,t+1,true,true,true);   WAIT_BAR(2); RESC(); ROT();
  }
  #undef CMASK
  #define CMASK(P0,P1,t) do{int jb_=(t)-(NT-4); if(jb_>=0)cmask(P0,P1,jb_,qrel,hi);}while(0)
  #define ENDW(tt) do{ if((tt)+3<NT){WAIT_BAR(2);} else if((tt)+2<NT){WAIT_BAR(1);} else {WAIT_BAR(0);} }while(0)
  for(;t+1<NT;t+=2){
    STEP(pB0,pB1,pA0,pA1,t,(t+3<NT),(t+1<NT),(t+1<NT));       ENDW(t);   RESC(); ROT();
    STEP(pA0,pA1,pB0,pB1,t+1,(t+4<NT),(t+2<NT),(t+2<NT));     ENDW(t+1); RESC(); ROT();
  }
  STEP(pB0,pB1,pA0,pA1,NT-1,false,false,false); RESC();
  { float sacc=pB0[0]+pB0[1]; _Pragma("unroll") for(int r=2;r<16;++r)sacc+=pB0[r]; _Pragma("unroll") for(int r=0;r<16;++r)sacc+=pB1[r]; l_reg+=sacc;
    pw0=(u32x4){PKW(pB0,0),PKW(pB0,2),PKW(pB0,4),PKW(pB0,6)};pw1=(u32x4){PKW(pB0,8),PKW(pB0,10),PKW(pB0,12),PKW(pB0,14)};pw2=(u32x4){PKW(pB1,0),PKW(pB1,2),PKW(pB1,4),PKW(pB1,6)};pw3=(u32x4){PKW(pB1,8),PKW(pB1,10),PKW(pB1,12),PKW(pB1,14)};
    SBAR(); pv(o,vb0+sl_cur,PAF(0),PAF(1),PAF(2),PAF(3)); }
  #undef PKW
  #undef PAF
  #undef VFR
  #undef PIN
  #undef MX3
  #undef GAPA
  #undef GAPB
  #undef EX
  #undef VRD
  #undef KRD
  #undef STEP
  #undef ENDW
  {auto rr=__builtin_amdgcn_permlane32_swap(__float_as_uint(l_reg),__float_as_uint(l_reg),false,false);l_reg=__uint_as_float(rr[0])+__uint_as_float(rr[1]);}
  if(hi==0)wsf[32+r32]=l_reg;asm volatile("s_waitcnt lgkmcnt(0)":::"memory");
  float rli[16];
  #pragma unroll
  for(int r=0;r<16;++r)rli[r]=__builtin_amdgcn_rcpf(wsf[32+crow(r,hi)]);
  bf16*Ow=O+(rowbase+q0+wid*QBLK)*OPITCH+ocol;
  { bf16*stg=(bf16*)(shm+LDS_OST)+wid*2048;
    #pragma unroll
    for(int r=0;r<16;++r){const int orow=crow(r,hi);
      #pragma unroll
      for(int d0=0;d0<2;++d0)stg[orow*64+d0*32+r32]=__float2bfloat16(o[d0][r]*rli[r]);}
    asm volatile("s_waitcnt lgkmcnt(0)":::"memory");
    #pragma unroll
    for(int i=0;i<4;++i){const int row=i*8+(lane>>3),ch=lane&7; const u32x4 v=*(const u32x4*)(stg+row*64+ch*8); ATTN_STORE16(Ow+(long)row*OPITCH+ch*8,v);} }
  asm volatile("s_waitcnt lgkmcnt(0)\n\ts_barrier":::"memory");
  #undef DMA_K
  #undef DMA_V
  #undef CMASK
  #undef START
  #undef RESC
  #undef ROT
}
constexpr int ATTN_LDS_BYTES=LDS_BYTES;
#undef SBAR
#undef WAIT_BAR
}
constexpr size_t MiB = 1u << 20;
constexpr size_t WS_CTL = 0, CTL_ZERO_BYTES = 1 * MiB;
constexpr size_t WS_WIN = 2 * MiB, WS_WOUT = 26 * MiB, WS_WQ = 34 * MiB, WS_WKV = 42 * MiB, WS_WO = 58 * MiB, WS_W1 = 66 * MiB, WS_W2 = 578 * MiB;
constexpr size_t WS_HN = 834 * MiB, WS_MN = 866 * MiB, WS_PROJ = 870 * MiB, WS_DT = 958 * MiB, WS_KVRAW = 959 * MiB, WS_KN = 967 * MiB;
constexpr size_t WS_YCAT = 971 * MiB, WS_O0 = 1003 * MiB, WS_O1 = 1019 * MiB, WS_H1 = 1035 * MiB, WS_H1B = 1099 * MiB, WS_PART1 = 1131 * MiB, WS_PARTQ = 1132 * MiB;
constexpr size_t WS_QRAW = 1133 * MiB, WS_P = 1165 * MiB, WS_VWT = 1181 * MiB, WS_H2 = 1197 * MiB, WS_HN3 = 1261 * MiB;
constexpr size_t WS_TOKOF = 1293 * MiB, WS_GATEOF = 1294 * MiB, WS_TOKE = 1295 * MiB, WS_TOKR = 1296 * MiB, WS_YG = 1297 * MiB;
constexpr size_t WS_H1F8 = 3368 * MiB  , WS_QF8 = 3384 * MiB  , WS_KN8 = 3400 * MiB  , WS_VF8 = 3402 * MiB  ;
constexpr size_t WS_P8 = 3404 * MiB  , WS_VWT8 = 3412 * MiB  ;
constexpr size_t WS_XG = 1320 * MiB  , WS_ACT = 1832 * MiB  , WS_Y = 2344 * MiB  , WS_END = 3420 * MiB;
constexpr int CW_BAR = 4096;
constexpr int CW_QATT = 12288;
constexpr int CW_CNT = 8192;
static_assert((CW_CNT + 64 * 32) * 4 <= (int)CTL_ZERO_BYTES, "CTL words inside the memset region");

constexpr int RING_OFF = 0, RING_BYTES = 131072;
constexpr int LDS_BYTES = 163840;
constexpr int MISC_OFF = 163840 - 1024;
constexpr int NWAVES = 8;

#define XB_TMO      128
#define XB_XCNT(j)  (256  + 64 * (j))
#define XB_XSUB(j)  (1280 + 64 * (j))
#define XB_XGEN(j)  (2304 + 64 * (j))
#define XB_TOP      3328
#define XB_TOPGEN   3392
#define XCD_BAR_WORDS 3456
#define XB_SPIN_CAP (1u << 20)

__device__ __forceinline__ unsigned xb_ld(unsigned* p)              { return __hip_atomic_load(p, __ATOMIC_RELAXED, __HIP_MEMORY_SCOPE_AGENT); }
__device__ __forceinline__ unsigned xb_add(unsigned* p, unsigned v) { return __hip_atomic_fetch_add(p, v, __ATOMIC_RELAXED, __HIP_MEMORY_SCOPE_AGENT); }
__device__ __forceinline__ unsigned xb_xcc_id() { return (unsigned)__builtin_amdgcn_s_getreg((3 << 11) | 20) & 0xFu; }
#define XB_SPIN(cond, bar) do { unsigned _sp = 0; while (cond) { __builtin_amdgcn_s_sleep(1); \
    if ((++_sp & 255u) == 0u) { if (xb_ld(&(bar)[XB_TMO])) break; if (_sp > XB_SPIN_CAP) { atomicAdd(&(bar)[XB_TMO], 1u); break; } } } } while (0)

struct XcdBarrier {
    unsigned* bar; unsigned x;
    volatile LAS unsigned* st;
};
__device__ __forceinline__ XcdBarrier xcd_barrier_post(unsigned* bar, volatile LAS unsigned* st) {
    XcdBarrier b; b.bar = bar; b.x = xb_xcc_id(); b.st = st;
    if (threadIdx.x == 0) (void)xb_add(&bar[XB_XCNT(b.x)], 1u);
    return b;
}
__device__ __forceinline__ void xcd_barrier_complete(unsigned* bar, unsigned x, unsigned& nloc, unsigned& nx) {
    const unsigned G = gridDim.x * gridDim.y * gridDim.z;
    unsigned sum, cnt, mine, sp = 0u;
    for (;;) {
        sum = 0u; cnt = 0u; mine = 0u;
#pragma unroll
        for (unsigned j = 0; j < 16; ++j) { const unsigned c = xb_ld(&bar[XB_XCNT(j)]); sum += c; cnt += (c > 0u) ? 1u : 0u; mine = (j == x) ? c : mine; }
        if (sum == G) break;
        __builtin_amdgcn_s_sleep(1);
        if ((++sp & 255u) == 0u) { if (xb_ld(&bar[XB_TMO])) break; if (sp > XB_SPIN_CAP) { atomicAdd(&bar[XB_TMO], 1u); break; } }
    }
    nloc = mine > 0u ? mine : 1u; nx = cnt > 0u ? cnt : 1u;
}
__device__ __forceinline__ void xcd_barrier(const XcdBarrier& b) {
    asm volatile("s_waitcnt vmcnt(0)" ::: "memory");
    __syncthreads();
    if (threadIdx.x == 0) {
        unsigned* bar = b.bar;
        __builtin_amdgcn_s_waitcnt(0);
        unsigned nloc = b.st[0], nx = b.st[1];
        if (nloc == 0u) { xcd_barrier_complete(bar, b.x, nloc, nx); b.st[0] = nloc; b.st[1] = nx; }
        const unsigned old = xb_add(&bar[XB_XSUB(b.x)], 1u);
        const unsigned gen = old / nloc;
        if (old + 1u == (gen + 1u) * nloc) {
            __builtin_amdgcn_fence(__ATOMIC_RELEASE, "agent");
            asm volatile("s_waitcnt vmcnt(0)" ::: "memory");
            const unsigned og = xb_add(&bar[XB_TOP], 1u);
            const unsigned tg = og / nx;
            if (og + 1u == (tg + 1u) * nx) xb_add(&bar[XB_TOPGEN], 1u);
            else XB_SPIN(xb_ld(&bar[XB_TOPGEN]) == tg, bar);
            __builtin_amdgcn_fence(__ATOMIC_ACQUIRE, "agent");
            xb_add(&bar[XB_XGEN(b.x)], 1u);
            asm volatile("s_waitcnt vmcnt(0)" ::: "memory");
        } else {
            XB_SPIN(xb_ld(&bar[XB_XGEN(b.x)]) == gen, bar);
            __builtin_amdgcn_fence(__ATOMIC_ACQUIRE, "agent");
            asm volatile("s_waitcnt vmcnt(0)" ::: "memory");
        }
    }
    __syncthreads();
}

struct Args { const float* in[32]; float* out; unsigned char* ws; int ph_lo, ph_hi; };
enum In { I_X = 0, I_MEM, I_GMIX, I_WIN, I_CONVW, I_CONVB, I_DTB, I_ALOG, I_DSKIP, I_SSDG, I_DAQG, I_DAKG, I_LQ1, I_LK1, I_LQ2, I_LK2, I_SUBG, I_WOUT, I_GXA, I_GMEM,
          I_WQ, I_WKV, I_XQG, I_XKG, I_WO, I_GFFN, I_RW, I_RB, I_W1, I_B1, I_W2, I_B2 };

struct ArgP {
    typedef const __attribute__((address_space(4))) char* kptr;
    DI const float* in(int i) const { kptr kp = (kptr)__builtin_amdgcn_kernarg_segment_ptr(); asm volatile("" : "+s"(kp)); return *(const float* const __attribute__((address_space(4)))*)(kp + 8 * i); }
    DI float* out() const { kptr kp = (kptr)__builtin_amdgcn_kernarg_segment_ptr(); asm volatile("" : "+s"(kp)); return *(float* const __attribute__((address_space(4)))*)(kp + 8 * 32); }
};
struct Frame {
    LAS unsigned char* lds;
    volatile LAS unsigned* MISC;
    unsigned* ctl;
    unsigned char* ws;
    int tid, lane, wave, vcu, G;
};

template <class DestRow>
DI void tr_item(const float* W, size_t ldw, int k0, int ncol0, int nvalid, const float* kscale, bf16_t* WT, int K, DestRow dr, LAS float* scr, int lane) {
    const int c = lane & 31;
#pragma unroll 8
    for (int i = 0; i < 32; ++i) { const int kk = 2 * i + (lane >> 5);
        float v = (c < nvalid) ? W[(size_t)(k0 + kk) * ldw + ncol0 + c] : 0.f;
        if (kscale) v *= kscale[k0 + kk];
        scr[kk * 33 + c] = v; }
    asm volatile("s_waitcnt lgkmcnt(0)" ::: "memory");
    const int c8 = lane & 7;
#pragma unroll
    for (int j = 0; j < 4; ++j) { const int n = (lane >> 3) + 8 * j; const LAS float* s = scr + (8 * c8) * 33 + n;
        u32x4 o; o.x = pk2(s[0 * 33], s[1 * 33]); o.y = pk2(s[2 * 33], s[3 * 33]); o.z = pk2(s[4 * 33], s[5 * 33]); o.w = pk2(s[6 * 33], s[7 * 33]);
        if (n < nvalid) *(u32x4*)(WT + (size_t)dr(ncol0 + n) * K + k0 + 8 * c8) = o; }
    asm volatile("s_waitcnt lgkmcnt(0)" ::: "memory");
}
template <class DestRow>
DI void tr_item_fp8(const float* W, size_t ldw, int k0, int ncol0, const float* kscale, unsigned char* WT, int K, DestRow dr, LAS float* scr, int lane) {
    const int c = lane & 31;
#pragma unroll 8
    for (int i = 0; i < 32; ++i) { const int kk = 2 * i + (lane >> 5); float v = W[(size_t)(k0 + kk) * ldw + ncol0 + c]; if (kscale) v *= kscale[k0 + kk]; scr[kk * 33 + c] = v; }
    asm volatile("s_waitcnt lgkmcnt(0)" ::: "memory");
    const int n = lane >> 1, hf = lane & 1; const LAS float* s = scr + (32 * hf) * 33 + n;
    unsigned w[8];
#pragma unroll
    for (int j = 0; j < 8; ++j) { unsigned x = 0u;
        x = __builtin_amdgcn_cvt_pk_fp8_f32(s[(4 * j) * 33] * 64.f, s[(4 * j + 1) * 33] * 64.f, x, false);
        x = __builtin_amdgcn_cvt_pk_fp8_f32(s[(4 * j + 2) * 33] * 64.f, s[(4 * j + 3) * 33] * 64.f, x, true); w[j] = x; }
    unsigned char* op = WT + (size_t)dr(ncol0 + n) * K + k0 + 32 * hf;
    *(u32x4*)op = (u32x4){w[0], w[1], w[2], w[3]}; *(u32x4*)(op + 16) = (u32x4){w[4], w[5], w[6], w[7]};
    asm volatile("s_waitcnt lgkmcnt(0)" ::: "memory");
}
DI int tileperm(int col) { const int o = col & 255; return (col & ~255) + 128 * ((o & 63) >> 5) + 32 * (o >> 6) + (o & 31); }
struct DrIdent { DI int operator()(int n) const { return n; } };
struct DrTile  { DI int operator()(int n) const { return tileperm(n); } };
struct DrWin   { DI int operator()(int n) const { const int pc = (n < 2560) ? n : (n < 2576 ? PC_DT + (n - 2560) : n - 16); return tileperm(pc); } };
struct DrW1    { DI int operator()(int n) const { const int half = n >> 11, j = n & 2047; return (j >> 7) * 256 + half * 128 + (j & 127); } };

DI void rms_row_to_bf16(const float* xrow, const float* g, bf16_t* orow, int lane) {
    const f32x4* xr = (const f32x4*)xrow + lane;
    f32x4 v[8]; float s = 0.f;
#pragma unroll
    for (int j = 0; j < 8; ++j) { v[j] = xr[64 * j]; s += (v[j].x * v[j].x + v[j].y * v[j].y) + (v[j].z * v[j].z + v[j].w * v[j].w); }
    const float rstd = 1.f / sqrtf(wave_sum(s) * (1.f / 2048.f) + EPS_);
    u32x2* o8 = (u32x2*)orow + lane;
#pragma unroll
    for (int j = 0; j < 8; ++j) { const f32x4 gg = ((const f32x4*)g)[lane + 64 * j];
        u32x2 o; o.x = pk2(v[j].x * rstd * gg.x, v[j].y * rstd * gg.y); o.y = pk2(v[j].z * rstd * gg.z, v[j].w * rstd * gg.w); o8[64 * j] = o; }
}

DI void p0_prologue(Frame& F, const ArgP& a) {
    LAS float* scr = (LAS float*)(F.lds + RING_OFF + F.wave * 16384);
    const int gw = F.vcu * NWAVES + F.wave, NGW = F.G * NWAVES;
    unsigned char* ws = F.ws;
    constexpr int I_A = 32 * 80, I_B = 32, I_C = 32 * 96, I_WOUT_ = 32 * 64, I_WQ_ = 32 * 64, I_WKV_ = 32 * 128, I_WO_ = 32 * 64, I_W1_ = 32 * 32 * 128, I_W2_ = 32 * 32 * 64;
    constexpr int NITEMS = I_A + I_B + I_C + I_WOUT_ + I_WQ_ + I_WKV_ + I_WO_ + I_W1_ + I_W2_;
    for (int it = gw; it < NITEMS; it += NGW) {
        int r = it;
        if (r < I_A) { tr_item(a.in(I_WIN), 5648, 64 * (r / 80), 32 * (r % 80), 32, nullptr, (bf16_t*)(ws + WS_WIN), 2048, DrWin(), scr, F.lane); continue; } r -= I_A;
        if (r < I_B) { tr_item(a.in(I_WIN), 5648, 64 * r, 2560, 16, nullptr, (bf16_t*)(ws + WS_WIN), 2048, DrWin(), scr, F.lane); continue; } r -= I_B;
        if (r < I_C) { tr_item(a.in(I_WIN), 5648, 64 * (r / 96), 2576 + 32 * (r % 96), 32, nullptr, (bf16_t*)(ws + WS_WIN), 2048, DrWin(), scr, F.lane); continue; } r -= I_C;
        if (r < I_WOUT_) { tr_item(a.in(I_WOUT), 2048, 64 * (r / 64), 32 * (r % 64), 32, nullptr, (bf16_t*)(ws + WS_WOUT), 2048, DrIdent(), scr, F.lane); continue; } r -= I_WOUT_;
        if (r < I_WQ_) { tr_item_fp8(a.in(I_WQ), 2048, 64 * (r / 64), 32 * (r % 64), a.in(I_GXA), (unsigned char*)(ws + WS_WQ), 2048, DrIdent(), scr, F.lane); continue; } r -= I_WQ_;
        if (r < I_WKV_) { tr_item(a.in(I_WKV), 4096, 64 * (r / 128), 32 * (r % 128), 32, nullptr, (bf16_t*)(ws + WS_WKV), 2048, DrTile(), scr, F.lane); continue; } r -= I_WKV_;
        if (r < I_WO_) { tr_item_fp8(a.in(I_WO), 2048, 64 * (r / 64), 32 * (r % 64), nullptr, (unsigned char*)(ws + WS_WO), 2048, DrIdent(), scr, F.lane); continue; } r -= I_WO_;
        if (r < I_W1_) { const int e = r / (32 * 128), q = r % (32 * 128);
            tr_item_fp8(a.in(I_W1) + (size_t)e * 2048 * 4096, 4096, 64 * (q / 128), 32 * (q % 128), nullptr, (unsigned char*)(ws + WS_W1) + (size_t)e * 4096 * 2048, 2048, DrW1(), scr, F.lane); continue; } r -= I_W1_;
        { const int e = r / (32 * 64), q = r % (32 * 64);
            tr_item_fp8(a.in(I_W2) + (size_t)e * 2048 * 2048, 2048, 64 * (q / 64), 32 * (q % 64), nullptr, (unsigned char*)(ws + WS_W2) + (size_t)e * 2048 * 2048, 2048, DrIdent(), scr, F.lane); }
    }
    for (int m = gw; m < NTOK; m += NGW) rms_row_to_bf16(a.in(I_X) + (size_t)m * 2048, a.in(I_GMIX), (bf16_t*)(ws + WS_HN) + (size_t)m * 2048, F.lane);
    for (int m = gw; m < NB * MEMLEN; m += NGW) rms_row_to_bf16(a.in(I_MEM) + (size_t)m * 2048, a.in(I_GMEM), (bf16_t*)(ws + WS_MN) + (size_t)m * 2048, F.lane);
}

struct SchedP1 {
    int G, c; const unsigned char* ws; int lo, hi;
    DI bool next(int i, pg8::UnitD& u) const {
        const int L = lo + i * G + c; if (L >= hi) return false;
        u.rows = nullptr; u.nvalid = 0; u.lda = 4096u; u.ldb = 4096u; u.e = 0; u.x0 = 0;
        if (L < 32 * 23) { u.type = 0; u.pn = L / 32; u.pm = L % 32; u.A = (const char*)(ws + WS_HN) + (size_t)u.pm * 256 * 4096; u.B = (const char*)(ws + WS_WIN) + (size_t)u.pn * 256 * 4096; }
        else { const int q = L - 32 * 23; u.type = 1; u.pn = q / 4; u.pm = q % 4; u.A = (const char*)(ws + WS_MN) + (size_t)u.pm * 256 * 4096; u.B = (const char*)(ws + WS_WKV) + (size_t)u.pn * 256 * 4096; }
        return true;
    }
};
struct EpiP1 {
    static constexpr bool AFTER_DRAIN = false;
    bf16_t* proj; float* dtb; bf16_t* kvraw; const float* gq; const float* gk; unsigned char* vf8;
    DI void operator()(const f32x4 (&acc)[2][2][4][2], const pg8::UnitD& u, int wr, int wc, int fr, int fq) const {
        { int ln_ = threadIdx.x; asm volatile("" : "+v"(ln_)); fr = ln_ & 15; fq = (ln_ >> 4) & 3; }
        const int row0 = u.pm * 256 + wr * 64 + fr;
        const int cn = u.pn * 256 + 64 * wc + 8 * fq;
        if (u.type == 1 && u.pn >= 8) {
#pragma unroll
            for (int ai = 0; ai < 2; ++ai)
#pragma unroll
                for (int m = 0; m < 4; ++m) { unsigned char* rp = vf8 + (size_t)(row0 + ai * 128 + m * 16) * 2048 + (cn - 2048);
#pragma unroll
                    for (int bj = 0; bj < 2; ++bj) { const f32x4 v0 = acc[ai][bj][m][0] * 16.f, v1 = acc[ai][bj][m][1] * 16.f;
                        u32x2 w; w.x = __builtin_amdgcn_cvt_pk_fp8_f32(v0[0], v0[1], 0u, false); w.x = __builtin_amdgcn_cvt_pk_fp8_f32(v0[2], v0[3], w.x, true);
                        w.y = __builtin_amdgcn_cvt_pk_fp8_f32(v1[0], v1[1], 0u, false); w.y = __builtin_amdgcn_cvt_pk_fp8_f32(v1[2], v1[3], w.y, true);
                        *(u32x2*)(rp + 32 * bj) = w; } }
            return;
        }
        if (u.type == 1) {
#pragma unroll
            for (int ai = 0; ai < 2; ++ai)
#pragma unroll
                for (int m = 0; m < 4; ++m) { bf16_t* rp = kvraw + (size_t)(row0 + ai * 128 + m * 16) * 4096 + cn;
#pragma unroll
                    for (int bj = 0; bj < 2; ++bj) { const f32x4 v0 = acc[ai][bj][m][0], v1 = acc[ai][bj][m][1];
                        u32x4 w; w.x = pk2(v0[0], v0[1]); w.y = pk2(v0[2], v0[3]); w.z = pk2(v1[0], v1[1]); w.w = pk2(v1[2], v1[3]); *(u32x4*)(rp + 32 * bj) = w; } }
            return;
        }
        if (u.pn == 22) {
            if (wc == 0 && fq < 2) {
#pragma unroll
                for (int ai = 0; ai < 2; ++ai)
#pragma unroll
                    for (int m = 0; m < 4; ++m) { float* rp = dtb + (size_t)(row0 + ai * 128 + m * 16) * 16 + 8 * fq;
                        *(f32x4*)(rp) = acc[ai][0][m][0]; *(f32x4*)(rp + 4) = acc[ai][0][m][1]; }
            }
            return;
        }
        const bool isq = (u.pn >= 10 && u.pn < 14), isk = (u.pn >= 14 && u.pn < 18);
        if (!(isq || isk)) {
#pragma unroll
            for (int ai = 0; ai < 2; ++ai)
#pragma unroll
                for (int m = 0; m < 4; ++m) { bf16_t* rp = proj + (size_t)(row0 + ai * 128 + m * 16) * PP + cn;
#pragma unroll
                    for (int bj = 0; bj < 2; ++bj) { const f32x4 v0 = acc[ai][bj][m][0], v1 = acc[ai][bj][m][1];
                        u32x4 w; w.x = pk2(v0[0], v0[1]); w.y = pk2(v0[2], v0[3]); w.z = pk2(v1[0], v1[1]); w.w = pk2(v1[2], v1[3]); *(u32x4*)(rp + 32 * bj) = w; } }
            return;
        }
        const float* g = (isq ? gq : gk) + 8 * fq; const float sc = isq ? (0.125f * 1.4426950408889634f) : 1.f;
#pragma unroll
        for (int ai = 0; ai < 2; ++ai)
#pragma unroll
            for (int m = 0; m < 4; ++m) { bf16_t* rp = proj + (size_t)(row0 + ai * 128 + m * 16) * PP + cn;
                float ss = 0.f;
#pragma unroll
                for (int bj = 0; bj < 2; ++bj)
#pragma unroll
                    for (int n = 0; n < 2; ++n) { const f32x4 v = acc[ai][bj][m][n]; ss += (v[0] * v[0] + v[1] * v[1]) + (v[2] * v[2] + v[3] * v[3]); }
                ss += __shfl_xor(ss, 16); ss += __shfl_xor(ss, 32);
                const float rs = sc / sqrtf(ss * (1.f / 64.f) + EPS_);
#pragma unroll
                for (int bj = 0; bj < 2; ++bj) { const f32x4 v0 = acc[ai][bj][m][0] * rs * *(const f32x4*)(g + 32 * bj), v1 = acc[ai][bj][m][1] * rs * *(const f32x4*)(g + 32 * bj + 4);
                    u32x4 w; w.x = pk2(v0[0], v0[1]); w.y = pk2(v0[2], v0[3]); w.z = pk2(v1[0], v1[1]); w.w = pk2(v1[2], v1[3]); *(u32x4*)(rp + 32 * bj) = w; } }
    }
};

DI void kprep(Frame& F, const ArgP& a) {
    const int gw = F.vcu * NWAVES + F.wave, NGW = F.G * NWAVES;
    const bf16_t* kv = (const bf16_t*)(F.ws + WS_KVRAW); unsigned char* kn = (unsigned char*)(F.ws + WS_KN8);
    for (int it = gw; it < NB * MEMLEN * 4; it += NGW) {
        const int row = it >> 2, h = it & 3, b = row >> 8, key = row & 255;
        const u32x4 raw = *(const u32x4*)(kv + (size_t)row * 4096 + h * 512 + F.lane * 8);
        float v[8]; v[0] = bflo(raw.x); v[1] = bfhi(raw.x); v[2] = bflo(raw.y); v[3] = bfhi(raw.y); v[4] = bflo(raw.z); v[5] = bfhi(raw.z); v[6] = bflo(raw.w); v[7] = bfhi(raw.w);
        float ss = 0.f;
#pragma unroll
        for (int j = 0; j < 8; ++j) ss += v[j] * v[j];
        const float rs = 1.f / sqrtf(wave_sum(ss) * (1.f / 512.f) + EPS_) * 0.04419417382415922f * 128.f;
        const float* gk = a.in(I_XKG) + F.lane * 8; const float* gq = a.in(I_XQG) + F.lane * 8;
        u32x2 o; o.x = __builtin_amdgcn_cvt_pk_fp8_f32(v[0] * rs * gk[0] * gq[0], v[1] * rs * gk[1] * gq[1], 0u, false); o.x = __builtin_amdgcn_cvt_pk_fp8_f32(v[2] * rs * gk[2] * gq[2], v[3] * rs * gk[3] * gq[3], o.x, true);
        o.y = __builtin_amdgcn_cvt_pk_fp8_f32(v[4] * rs * gk[4] * gq[4], v[5] * rs * gk[5] * gq[5], 0u, false); o.y = __builtin_amdgcn_cvt_pk_fp8_f32(v[6] * rs * gk[6] * gq[6], v[7] * rs * gk[7] * gq[7], o.y, true);
        *(u32x2*)(kn + ((size_t)((b * 4 + h) * 256 + key)) * 512 + F.lane * 8) = o;
    }
}

constexpr int SP = 272;
constexpr int S_C = 0, S_BM = 34816, S_BT = 69632, S_XDT = 104448, S_HB = 121856, S_F = 139264, S_W = 155648  , SSD_LDS = 162048;
static_assert(SSD_LDS <= MISC_OFF, "SSD LDS map");
#define MFMA32(a, b, c) __builtin_amdgcn_mfma_f32_32x32x16_bf16((a), (b), (c), 0, 0, 0)
DI int crow(int r, int hi) { return (r & 3) + 8 * (r >> 2) + 4 * hi; }
DI bf16x8 ldfrag(LAS const unsigned char* base, int row, int kel) { return *(const LAS bf16x8*)(base + row * SP + kel * 2); }
DI float fexp(float x) { return __builtin_amdgcn_exp2f(x * 1.4426950408889634f); }
DI float fsilu(float x) { return x * __builtin_amdgcn_rcpf(1.f + fexp(-x)); }

DI void ssd_unit(Frame& F, const ArgP& a, int b, int hd) {
    LAS unsigned char* lds = F.lds;
    int tid = F.tid, lane = F.lane, r32 = lane & 31, hh = lane >> 5; const int wid = F.wave;
    LAS float* sdt = (LAS float*)(lds + S_F); LAS float* sac = sdt + 2048;
    const bf16_t* proj = (const bf16_t*)(F.ws + WS_PROJ); const float* dtbuf = (const float*)(F.ws + WS_DT); bf16_t* yg = (bf16_t*)(F.ws + WS_YG);
    const int g = hd >> 3;
    const float aneg = -__expf(a.in(I_ALOG)[hd]), dtb = a.in(I_DTB)[hd], dsk = a.in(I_DSKIP)[hd];
#pragma unroll
    for (int q = 0; q < 2; ++q) { const int c = 2 * wid + q; const size_t t0 = (size_t)b * SEQ_ + c * 128;
        const float x0 = dtbuf[(t0 + 2 * lane) * 16 + hd] + dtb, x1 = dtbuf[(t0 + 2 * lane + 1) * 16 + hd] + dtb;
        const float d0 = x0 > 20.f ? x0 : log1pf(__expf(x0)), d1 = x1 > 20.f ? x1 : log1pf(__expf(x1));
        const float a0 = d0 * aneg, a1 = d1 * aneg;
        float s = a0 + a1;
#pragma unroll
        for (int o = 1; o < 64; o <<= 1) { const float t = __shfl_up(s, o); if (lane >= o) s += t; }
        sdt[c * 128 + 2 * lane] = d0; sdt[c * 128 + 2 * lane + 1] = d1; sac[c * 128 + 2 * lane] = s - a1; sac[c * 128 + 2 * lane + 1] = s; }
    int seg = tid >> 5, cg = tid & 31, l0 = seg * 8;
    int colbc = (cg < 16) ? (1024 + g * 128 + cg * 8) : (1280 + g * 128 + (cg - 16) * 8);
    const int colx = hd * 64 + wid * 8; int lx = 2 * lane;
    LAS float* swt = (LAS float*)(lds + S_W);
    { const float* convw = a.in(I_CONVW); const float* convb = a.in(I_CONVB);
      if (tid < 320) { const int ci = tid;
          const int xc = (ci < 64) ? (hd * 64 + ci) : (ci < 192 ? (1024 + g * 128 + (ci - 64)) : (1280 + g * 128 + (ci - 192)));
#pragma unroll
          for (int k = 0; k < 4; ++k) swt[k * 320 + ci] = convw[k * 1536 + xc];
          swt[4 * 320 + ci] = convb[xc]; } }
    int cibc = 64 + cg * 8; const int cix = wid * 8;
    const char* pub = (const char*)F.ws; const unsigned pxb = (unsigned)(WS_PROJ + ((size_t)b * SEQ_ * PP + PC_XBC) * 2), zoff = (unsigned)(WS_CTL + 524288);
    u32x4 inbc[11], inx[5];
#define SSD_PREFETCH(c_) do { \
        int sd_ = l0; asm volatile("" : "+v"(sd_)); \
        _Pragma("unroll") for (int j = 0; j < 11; ++j) { const int tt = (c_) * 128 + sd_ - 3 + j; inbc[j] = *(const u32x4*)(pub + ((tt >= 0) ? pxb + (unsigned)(tt * PP + colbc) * 2u : zoff)); } } while (0)
    SSD_PREFETCH(0);
    f32x16 hT; for (int i = 0; i < 16; ++i) hT[i] = 0.f;
    const int nb = wid & 3, pb = wid >> 2;
    __syncthreads();
    for (int c = 0; c < 16; ++c) {
        { int t_ = threadIdx.x; asm volatile("" : "+v"(t_)); tid = t_; lane = t_ & 63; r32 = lane & 31; hh = lane >> 5; seg = t_ >> 5; cg = t_ & 31; l0 = seg * 8; lx = 2 * lane;
          colbc = (cg < 16) ? (1024 + g * 128 + cg * 8) : (1280 + g * 128 + (cg - 16) * 8); cibc = 64 + cg * 8; }
        const size_t t0 = (size_t)b * SEQ_ + c * 128;
        const LAS float* cdt = sdt + c * 128; const LAS float* cac = sac + c * 128;
        const float aend = cac[127];
#pragma unroll
        for (int j = 0; j < 5; ++j) { int sd_ = lx; asm volatile("" : "+v"(sd_)); const int tt = c * 128 + sd_ - 3 + j; inx[j] = *(const u32x4*)(pub + ((tt >= 0) ? pxb + (unsigned)(tt * PP + colx) * 2u : zoff)); }
        {
            LAS unsigned char* hbp = lds + S_HB + (32 * pb + r32) * SP + (32 * nb + 4 * hh) * 2;
#pragma unroll
            for (int q4 = 0; q4 < 4; ++q4) { u32x2 w; w.x = pk2(hT[4 * q4], hT[4 * q4 + 1]); w.y = pk2(hT[4 * q4 + 2], hT[4 * q4 + 3]); *(LAS u32x2*)(hbp + 16 * q4) = w; }
        }
        {
            float wbc[5][8];
#pragma unroll
            for (int k = 0; k < 5; ++k) { const f32x4 w0 = *(const LAS f32x4*)(swt + k * 320 + cibc), w1 = *(const LAS f32x4*)(swt + k * 320 + cibc + 4);
#pragma unroll
                for (int i = 0; i < 4; ++i) { wbc[k][i] = w0[i]; wbc[k][4 + i] = w1[i]; } }
#pragma unroll
            for (int hf = 0; hf < 2; ++hf) {
                __builtin_amdgcn_sched_barrier(0);
                float o[4][8];
#pragma unroll
                for (int j = 0; j < 4; ++j)
#pragma unroll
                    for (int i = 0; i < 8; ++i) { float s = wbc[4][i];
#pragma unroll
                        for (int k = 0; k < 4; ++k) { const unsigned wd = inbc[4 * hf + j + k][i >> 1]; s += wbc[k][i] * ((i & 1) ? bfhi(wd) : bflo(wd)); }
                        o[j][i] = fsilu(s); }
                const int lh = l0 + 4 * hf;
                if (cg < 16) {
                    const int n0 = cg * 8; float ev[4];
#pragma unroll
                    for (int j = 0; j < 4; ++j) { ev[j] = fexp(aend - cac[lh + j]);
                        u32x4 w1; w1.x = pk2(o[j][0], o[j][1]); w1.y = pk2(o[j][2], o[j][3]); w1.z = pk2(o[j][4], o[j][5]); w1.w = pk2(o[j][6], o[j][7]);
                        *(LAS u32x4*)(lds + S_BM + (lh + j) * SP + n0 * 2) = w1; }
#pragma unroll
                    for (int i = 0; i < 8; ++i) { u32x2 w2; w2.x = pk2(o[0][i] * ev[0], o[1][i] * ev[1]); w2.y = pk2(o[2][i] * ev[2], o[3][i] * ev[3]);
                        *(LAS u32x2*)(lds + S_BT + (n0 + i) * SP + lh * 2) = w2; }
                } else {
                    const int n0 = (cg - 16) * 8;
#pragma unroll
                    for (int j = 0; j < 4; ++j) { u32x4 w1; w1.x = pk2(o[j][0], o[j][1]); w1.y = pk2(o[j][2], o[j][3]); w1.z = pk2(o[j][4], o[j][5]); w1.w = pk2(o[j][6], o[j][7]);
                        *(LAS u32x4*)(lds + S_C + (lh + j) * SP + n0 * 2) = w1; }
                }
            }
        }
        __builtin_amdgcn_sched_barrier(0);
        {
            const float d0 = cdt[lx], d1 = cdt[lx + 1];
            float wx[5][8];
#pragma unroll
            for (int k = 0; k < 5; ++k) { const f32x4 w0 = *(const LAS f32x4*)(swt + k * 320 + cix), w1 = *(const LAS f32x4*)(swt + k * 320 + cix + 4);
#pragma unroll
                for (int i = 0; i < 4; ++i) { wx[k][i] = w0[i]; wx[k][4 + i] = w1[i]; } }
#pragma unroll
            for (int i = 0; i < 8; ++i) { float s0 = wx[4][i], s1 = wx[4][i];
#pragma unroll
                for (int k = 0; k < 4; ++k) { const unsigned w0 = inx[k][i >> 1], w1 = inx[k + 1][i >> 1];
                    s0 += wx[k][i] * ((i & 1) ? bfhi(w0) : bflo(w0)); s1 += wx[k][i] * ((i & 1) ? bfhi(w1) : bflo(w1)); }
                *(LAS unsigned*)(lds + S_XDT + (wid * 8 + i) * SP + lx * 2) = pk2(fsilu(s0) * d0, fsilu(s1) * d1); }
        }
        if (c < 15) SSD_PREFETCH(c + 1);
        __syncthreads();
        const int lb = wid >> 1;
        f32x16 xt[2];
#pragma unroll
        for (int q = 0; q < 2; ++q) { const int sb = 2 * (wid & 1) + q;
            for (int i = 0; i < 16; ++i) xt[q][i] = 0.f;
            if (sb <= lb) {
#pragma unroll
                for (int ks = 0; ks < 8; ++ks) xt[q] = MFMA32(ldfrag(lds + S_BM, 32 * sb + r32, 16 * ks + 8 * hh), ldfrag(lds + S_C, 32 * lb + r32, 16 * ks + 8 * hh), xt[q]);
            }
        }
        __syncthreads();
        {
            const int l = 32 * lb + r32; const float al = cac[l], ddl = dsk * __builtin_amdgcn_rcpf(cdt[l]);
#pragma unroll
            for (int q = 0; q < 2; ++q) { const int sb = 2 * (wid & 1) + q;
#pragma unroll
                for (int q4 = 0; q4 < 4; ++q4) { float mv[4];
#pragma unroll
                    for (int e = 0; e < 4; ++e) { const int s = 32 * sb + 8 * q4 + 4 * hh + e;
                        float v = 0.f;
                        if (s <= l) v = xt[q][4 * q4 + e] * fexp(al - cac[s]);
                        if (s == l) v += ddl;
                        mv[e] = v; }
                    u32x2 w; w.x = pk2(mv[0], mv[1]); w.y = pk2(mv[2], mv[3]);
                    *(LAS u32x2*)(lds + S_BM + l * SP + (32 * sb + 8 * q4 + 4 * hh) * 2) = w; }
            }
        }
        __syncthreads();
        {
            const int lb2 = wid & 3, pb2 = wid >> 2; const int l = 32 * lb2 + r32; const size_t tok = t0 + l;
            const int pc0 = hd * 64 + 32 * pb2 + 4 * hh;
            u32x2 zz[4];
#pragma unroll
            for (int q4 = 0; q4 < 4; ++q4) zz[q4] = *(const u32x2*)(proj + tok * PP + pc0 + 8 * q4);
            f32x16 y1, y2; for (int i = 0; i < 16; ++i) { y1[i] = 0.f; y2[i] = 0.f; }
            for (int ks = 0; ks < 2 * (lb2 + 1); ++ks) y1 = MFMA32(ldfrag(lds + S_XDT, 32 * pb2 + r32, 16 * ks + 8 * hh), ldfrag(lds + S_BM, 32 * lb2 + r32, 16 * ks + 8 * hh), y1);
#pragma unroll
            for (int ks = 0; ks < 8; ++ks) y2 = MFMA32(ldfrag(lds + S_HB, 32 * pb2 + r32, 16 * ks + 8 * hh), ldfrag(lds + S_C, 32 * lb2 + r32, 16 * ks + 8 * hh), y2);
            const float cd = fexp(aend);
#pragma unroll
            for (int i = 0; i < 16; ++i) hT[i] *= cd;
#pragma unroll
            for (int ks = 0; ks < 8; ++ks) hT = MFMA32(ldfrag(lds + S_BT, 32 * nb + r32, 16 * ks + 8 * hh), ldfrag(lds + S_XDT, 32 * pb + r32, 16 * ks + 8 * hh), hT);
            const float el = fexp(cac[l]);
#pragma unroll
            for (int q4 = 0; q4 < 4; ++q4) { float yv[4];
#pragma unroll
                for (int e = 0; e < 4; ++e) { const float z = (e & 1) ? bfhi(e < 2 ? zz[q4].x : zz[q4].y) : bflo(e < 2 ? zz[q4].x : zz[q4].y);
                    yv[e] = (y1[4 * q4 + e] + el * y2[4 * q4 + e]) * fsilu(z); }
                u32x2 w; w.x = pk2(yv[0], yv[1]); w.y = pk2(yv[2], yv[3]);
                *(u32x2*)(yg + tok * 1024 + pc0 + 8 * q4) = w; }
        }
        __syncthreads();
    }
#undef SSD_PREFETCH
}

DI void attn_phase_da(Frame& F) {
    const attn_body::bf16* proj = (const attn_body::bf16*)(F.ws + WS_PROJ);
    for (;;) {
        if (threadIdx.x == 0) F.MISC[120] = __hip_atomic_fetch_add(F.ctl + CW_QATT, 1u, __ATOMIC_RELAXED, __HIP_MEMORY_SCOPE_AGENT);
        __syncthreads();
        const int u = __builtin_amdgcn_readfirstlane((int)F.MISC[120]);
        __syncthreads();
        if (u >= 1024) break;
        const int qb = 7 - (u >> 7), combo = u & 127;
        const int half = combo & 1, j = (combo >> 1) & 1, h = (combo >> 2) & 7, b = combo >> 5;
        attn_body::bf16* O = (attn_body::bf16*)(F.ws + (j ? WS_O1 : WS_O0));
        attn_body::attn_unit<8>(b, PC_Q + (h * 2 + j) * 64, PC_V + h * 128 + half * 64, h * 128 + half * 64, qb, proj, proj + (PC_K - PC_Q), proj, O, (char*)F.lds);
    }
}

DI void p3_finalize(Frame& F, const ArgP& a) {
    const int gw = F.vcu * NWAVES + F.wave, NGW = F.G * NWAVES, lane = F.lane;
    bf16_t* ycat = (bf16_t*)(F.ws + WS_YCAT); const bf16_t* yg = (const bf16_t*)(F.ws + WS_YG); const bf16_t* o0 = (const bf16_t*)(F.ws + WS_O0); const bf16_t* o1 = (const bf16_t*)(F.ws + WS_O1);
    float l1 = a.in(I_LQ1)[lane] * a.in(I_LK1)[lane], l2 = a.in(I_LQ2)[lane] * a.in(I_LK2)[lane];
    const float lam = __expf(wave_sum(l1)) - __expf(wave_sum(l2)) + LAM_INIT;
    for (int m = gw; m < NTOK; m += NGW) {
        { bf16_t* yp = ycat + (size_t)m * 2048 + 16 * lane; const bf16_t* gp = yg + (size_t)m * 1024 + 16 * lane;
          const u32x4 r0 = *(const u32x4*)gp, r1 = *(const u32x4*)(gp + 8);
          float v[16]; v[0] = bflo(r0.x); v[1] = bfhi(r0.x); v[2] = bflo(r0.y); v[3] = bfhi(r0.y); v[4] = bflo(r0.z); v[5] = bfhi(r0.z); v[6] = bflo(r0.w); v[7] = bfhi(r0.w);
          v[8] = bflo(r1.x); v[9] = bfhi(r1.x); v[10] = bflo(r1.y); v[11] = bfhi(r1.y); v[12] = bflo(r1.z); v[13] = bfhi(r1.z); v[14] = bflo(r1.w); v[15] = bfhi(r1.w);
          float ss = 0.f;
#pragma unroll
          for (int i = 0; i < 16; ++i) ss += v[i] * v[i];
#pragma unroll
          for (int o = 1; o < 32; o <<= 1) ss += __shfl_xor(ss, o);
          const float rs = 1.f / sqrtf(ss * (1.f / 512.f) + EPS_);
          const float* g = a.in(I_SSDG) + 16 * lane;
          u32x4 w0, w1;
          w0.x = pk2(v[0] * rs * g[0], v[1] * rs * g[1]); w0.y = pk2(v[2] * rs * g[2], v[3] * rs * g[3]); w0.z = pk2(v[4] * rs * g[4], v[5] * rs * g[5]); w0.w = pk2(v[6] * rs * g[6], v[7] * rs * g[7]);
          w1.x = pk2(v[8] * rs * g[8], v[9] * rs * g[9]); w1.y = pk2(v[10] * rs * g[10], v[11] * rs * g[11]); w1.z = pk2(v[12] * rs * g[12], v[13] * rs * g[13]); w1.w = pk2(v[14] * rs * g[14], v[15] * rs * g[15]);
          *(u32x4*)yp = w0; *(u32x4*)(yp + 8) = w1; }
        { const bf16_t* p0 = o0 + (size_t)m * 1024 + 16 * lane; const bf16_t* p1 = o1 + (size_t)m * 1024 + 16 * lane;
          const u32x4 a0 = *(const u32x4*)p0, a1 = *(const u32x4*)(p0 + 8), b0 = *(const u32x4*)p1, b1 = *(const u32x4*)(p1 + 8);
          float v[16];
          v[0] = bflo(a0.x) - lam * bflo(b0.x); v[1] = bfhi(a0.x) - lam * bfhi(b0.x); v[2] = bflo(a0.y) - lam * bflo(b0.y); v[3] = bfhi(a0.y) - lam * bfhi(b0.y);
          v[4] = bflo(a0.z) - lam * bflo(b0.z); v[5] = bfhi(a0.z) - lam * bfhi(b0.z); v[6] = bflo(a0.w) - lam * bflo(b0.w); v[7] = bfhi(a0.w) - lam * bfhi(b0.w);
          v[8] = bflo(a1.x) - lam * bflo(b1.x); v[9] = bfhi(a1.x) - lam * bfhi(b1.x); v[10] = bflo(a1.y) - lam * bflo(b1.y); v[11] = bfhi(a1.y) - lam * bfhi(b1.y);
          v[12] = bflo(a1.z) - lam * bflo(b1.z); v[13] = bfhi(a1.z) - lam * bfhi(b1.z); v[14] = bflo(a1.w) - lam * bflo(b1.w); v[15] = bfhi(a1.w) - lam * bfhi(b1.w);
          float ss = 0.f;
#pragma unroll
          for (int i = 0; i < 16; ++i) ss += v[i] * v[i];
          ss += __shfl_xor(ss, 1); ss += __shfl_xor(ss, 2); ss += __shfl_xor(ss, 4);
          const float rs = 1.f / sqrtf(ss * (1.f / 128.f) + EPS_) * (1.f - LAM_INIT);
          const float* g = a.in(I_SUBG) + 16 * (lane & 7);
          u32x4 w0, w1;
          w0.x = pk2(v[0] * rs * g[0], v[1] * rs * g[1]); w0.y = pk2(v[2] * rs * g[2], v[3] * rs * g[3]); w0.z = pk2(v[4] * rs * g[4], v[5] * rs * g[5]); w0.w = pk2(v[6] * rs * g[6], v[7] * rs * g[7]);
          w1.x = pk2(v[8] * rs * g[8], v[9] * rs * g[9]); w1.y = pk2(v[10] * rs * g[10], v[11] * rs * g[11]); w1.z = pk2(v[12] * rs * g[12], v[13] * rs * g[13]); w1.w = pk2(v[14] * rs * g[14], v[15] * rs * g[15]);
          bf16_t* yp = ycat + (size_t)m * 2048 + 1024 + 16 * lane;
          *(u32x4*)yp = w0; *(u32x4*)(yp + 8) = w1; }
    }
}

struct SchedDense {
    int G, c, nM, nN; const char* A; const char* B; unsigned lda, ldb; int bdiv; size_t bstride;
    DI bool next(int i, pg8::UnitD& u) const {
        const int L = i * G + c; if (L >= nM * nN) return false;
        u.rows = nullptr; u.nvalid = 0; u.lda = lda; u.ldb = ldb; u.type = 0; u.e = 0; u.x0 = 0;
        u.pn = L / nM; u.pm = L % nM;
        u.A = A + (size_t)u.pm * 256 * lda; u.B = B + (size_t)u.pn * 256 * ldb + (size_t)(u.pm / bdiv) * bstride;
        return true;
    }
};
struct EpiResid {
    static constexpr bool AFTER_DRAIN = false;
    const float* base; float* out; bf16_t* outb; float* part; unsigned char* out8; float accscale;
    DI void operator()(const f32x4 (&acc)[2][2][4][2], const pg8::UnitD& u, int wr, int wc, int fr, int fq) const {
        { int ln_ = threadIdx.x; asm volatile("" : "+v"(ln_)); fr = ln_ & 15; fq = (ln_ >> 4) & 3; }
        const int row0 = u.pm * 256 + wr * 64 + fr, col0 = u.pn * 256 + wc * 32 + 8 * fq;
#pragma unroll
        for (int ai = 0; ai < 2; ++ai)
#pragma unroll
            for (int m = 0; m < 4; ++m) { const size_t row = (size_t)(row0 + ai * 128 + m * 16); float ss = 0.f;
#pragma unroll
                for (int bj = 0; bj < 2; ++bj) { const size_t idx = row * 2048 + col0 + bj * 128;
                    f32x4 v0 = acc[ai][bj][m][0] * accscale + *(const f32x4*)(base + idx), v1 = acc[ai][bj][m][1] * accscale + *(const f32x4*)(base + idx + 4);
                    *(f32x4*)(out + idx) = v0; *(f32x4*)(out + idx + 4) = v1;
                    if (out8) { u32x2 w; w.x = __builtin_amdgcn_cvt_pk_fp8_f32(v0[0] * 16.f, v0[1] * 16.f, 0u, false); w.x = __builtin_amdgcn_cvt_pk_fp8_f32(v0[2] * 16.f, v0[3] * 16.f, w.x, true);
                        w.y = __builtin_amdgcn_cvt_pk_fp8_f32(v1[0] * 16.f, v1[1] * 16.f, 0u, false); w.y = __builtin_amdgcn_cvt_pk_fp8_f32(v1[2] * 16.f, v1[3] * 16.f, w.y, true); *(u32x2*)(out8 + idx) = w; }
                    if (outb) { u32x4 w; w.x = pk2(v0[0], v0[1]); w.y = pk2(v0[2], v0[3]); w.z = pk2(v1[0], v1[1]); w.w = pk2(v1[2], v1[3]); *(u32x4*)(outb + idx) = w; }
                    ss += (v0[0] * v0[0] + v0[1] * v0[1]) + (v0[2] * v0[2] + v0[3] * v0[3]) + (v1[0] * v1[0] + v1[1] * v1[1]) + (v1[2] * v1[2] + v1[3] * v1[3]); }
                if (part) { ss += __shfl_xor(ss, 16); ss += __shfl_xor(ss, 32); if (fq == 0) part[row * 32 + u.pn * 4 + wc] = ss; } }
    }
};

struct EpiQ {
    static constexpr bool AFTER_DRAIN = false;
    unsigned char* out8; float* part;
    DI void operator()(const f32x4 (&acc)[2][2][4][2], const pg8::UnitD& u, int wr, int wc, int fr, int fq) const {
        { int ln_ = threadIdx.x; asm volatile("" : "+v"(ln_)); fr = ln_ & 15; fq = (ln_ >> 4) & 3; }
        const int row0 = u.pm * 256 + wr * 64 + fr, col0 = u.pn * 256 + wc * 32 + 8 * fq;
#pragma unroll
        for (int ai = 0; ai < 2; ++ai)
#pragma unroll
            for (int m = 0; m < 4; ++m) { const size_t row = (size_t)(row0 + ai * 128 + m * 16); float ss = 0.f;
#pragma unroll
                for (int bj = 0; bj < 2; ++bj) { const size_t idx = row * 2048 + col0 + bj * 128; const f32x4 v0 = acc[ai][bj][m][0] * (1.f / 1024.f), v1 = acc[ai][bj][m][1] * (1.f / 1024.f);
                    u32x2 w; w.x = __builtin_amdgcn_cvt_pk_fp8_f32(v0[0] * 16.f, v0[1] * 16.f, 0u, false); w.x = __builtin_amdgcn_cvt_pk_fp8_f32(v0[2] * 16.f, v0[3] * 16.f, w.x, true);
                    w.y = __builtin_amdgcn_cvt_pk_fp8_f32(v1[0] * 16.f, v1[1] * 16.f, 0u, false); w.y = __builtin_amdgcn_cvt_pk_fp8_f32(v1[2] * 16.f, v1[3] * 16.f, w.y, true); *(u32x2*)(out8 + idx) = w;
                    ss += (v0[0] * v0[0] + v0[1] * v0[1]) + (v0[2] * v0[2] + v0[3] * v0[3]) + (v1[0] * v1[0] + v1[1] * v1[1]) + (v1[2] * v1[2] + v1[3] * v1[3]); }
                ss += __shfl_xor(ss, 16); ss += __shfl_xor(ss, 32); if (fq == 0) part[row * 32 + u.pn * 4 + wc] = ss; }
    }
};

struct SchedXS {
    int G, c; const unsigned char* ws;
    DI bool next(int i, pg8::UnitD& u) const {
        const int L = i * G + c; if (L >= 256) return false;
        u.rows = nullptr; u.nvalid = 0; u.e = 0;
        const int q = L & 127, bh = q >> 3, t8 = q & 7, b = bh >> 2, h = bh & 3;
        u.pm = b; u.pn = h; u.x0 = t8;
        if (L < 128) { u.type = 0; u.lda = 2048u; u.ldb = 512u;
            u.A = (const char*)(ws + WS_QF8) + (size_t)(b * 2048 + t8 * 256) * 2048 + h * 512; u.B = (const char*)(ws + WS_KN8) + (size_t)(bh * 256) * 512; }
        else { u.type = 1; u.lda = 2048u; u.ldb = 2048u;
            u.A = (const char*)(ws + WS_WO) + (size_t)(t8 * 256) * 2048 + h * 512; u.B = (const char*)(ws + WS_VF8) + (size_t)(b * 256) * 2048 + h * 512; }
        return true;
    }
};
struct EpiXS {
    static constexpr bool AFTER_DRAIN = false;
    unsigned char* P; unsigned char* VWT; const float* part1; const float* partq; LAS float* red;
    DI void operator()(const f32x4 (&acc)[2][2][4][2], const pg8::UnitD& u, int wr, int wc, int fr, int fq) const {
        { int ln_ = threadIdx.x; asm volatile("" : "+v"(ln_)); fr = ln_ & 15; fq = (ln_ >> 4) & 3; }
        const int b = u.pm, h = u.pn, t8 = u.x0;
        const int col0 = wc * 32 + 8 * fq;
        if (u.type == 1) {
            unsigned char* Vu = VWT + ((size_t)b * 2048 + t8 * 256) * 1024 + h * 256;
#pragma unroll
            for (int ai = 0; ai < 2; ++ai)
#pragma unroll
                for (int m = 0; m < 4; ++m) { const unsigned rl = (unsigned)(ai * 128 + wr * 64 + m * 16 + fr);
#pragma unroll
                    for (int bj = 0; bj < 2; ++bj) { const f32x4 v0 = acc[ai][bj][m][0] * (32.f / 1024.f), v1 = acc[ai][bj][m][1] * (32.f / 1024.f);
                        u32x2 w; w.x = __builtin_amdgcn_cvt_pk_fp8_f32(v0[0], v0[1], 0u, false); w.x = __builtin_amdgcn_cvt_pk_fp8_f32(v0[2], v0[3], w.x, true);
                        w.y = __builtin_amdgcn_cvt_pk_fp8_f32(v1[0], v1[1], 0u, false); w.y = __builtin_amdgcn_cvt_pk_fp8_f32(v1[2], v1[3], w.y, true);
                        *(u32x2*)(Vu + (rl * 1024u + (unsigned)(bj * 128 + col0))) = w; } }
            return;
        }
        const size_t row0 = (size_t)b * 2048 + t8 * 256;
        const char* p1u = (const char*)(part1 + row0 * 32); const char* pqu = (const char*)(partq + row0 * 32 + h * 8); unsigned char* Pu = P + row0 * 1024 + h * 256;
        float rsc[2][4];
#pragma unroll
        for (int ai = 0; ai < 2; ++ai)
#pragma unroll
            for (int m = 0; m < 4; ++m) { const unsigned rl = (unsigned)(ai * 128 + wr * 64 + m * 16 + fr);
                const f32x4 p0 = *(const f32x4*)(p1u + (rl * 32u + (unsigned)fq * 8u) * 4u), p1 = *(const f32x4*)(p1u + (rl * 32u + (unsigned)fq * 8u + 4u) * 4u);
                float s1 = (p0[0] + p0[1]) + (p0[2] + p0[3]) + (p1[0] + p1[1]) + (p1[2] + p1[3]);
                const f32x2 pq = *(const f32x2*)(pqu + (rl * 32u + (unsigned)fq * 2u) * 4u);
                float sq = pq[0] + pq[1];
                s1 = quad_sum_16_32(s1); sq = quad_sum_16_32(sq);
                rsc[ai][m] = __builtin_amdgcn_rsqf(sq * (1.f / 512.f) + EPS_ * (s1 * (1.f / 2048.f) + EPS_)) * (1.4426950408889634f / 2048.f);
                float ps = 0.f;
#pragma unroll
                for (int bj = 0; bj < 2; ++bj)
#pragma unroll
                    for (int n = 0; n < 2; ++n)
#pragma unroll
                        for (int e = 0; e < 4; ++e) ps += __builtin_amdgcn_exp2f(fminf(acc[ai][bj][m][n][e] * rsc[ai][m], 100.f));
                ps = quad_sum_16_32(ps);
                if (fq == 0) red[rl * 4 + wc] = ps;
                __builtin_amdgcn_sched_barrier(0); }
        __syncthreads();
        { int ln_ = threadIdx.x; asm volatile("" : "+v"(ln_)); fr = ln_ & 15; fq = (ln_ >> 4) & 3; }
#pragma unroll
        for (int ai = 0; ai < 2; ++ai)
#pragma unroll
            for (int m = 0; m < 4; ++m) { const unsigned rl = (unsigned)(ai * 128 + wr * 64 + m * 16 + fr);
                const f32x4 t = *(const LAS f32x4*)(red + rl * 4); const float inv = 256.f * __builtin_amdgcn_rcpf((t[0] + t[1]) + (t[2] + t[3])); float rs = rsc[ai][m]; asm volatile("" : "+v"(rs));
#pragma unroll
                for (int bj = 0; bj < 2; ++bj) { float x[8];
#pragma unroll
                    for (int n = 0; n < 2; ++n)
#pragma unroll
                        for (int e = 0; e < 4; ++e) x[n * 4 + e] = __builtin_amdgcn_exp2f(fminf(acc[ai][bj][m][n][e] * rs, 100.f)) * inv;
                    u32x2 w; w.x = __builtin_amdgcn_cvt_pk_fp8_f32(x[0], x[1], 0u, false); w.x = __builtin_amdgcn_cvt_pk_fp8_f32(x[2], x[3], w.x, true);
                    w.y = __builtin_amdgcn_cvt_pk_fp8_f32(x[4], x[5], 0u, false); w.y = __builtin_amdgcn_cvt_pk_fp8_f32(x[6], x[7], w.y, true);
                    *(u32x2*)(Pu + (rl * 1024u + (unsigned)(bj * 128 + wc * 32 + 8 * fq))) = w; } }
        __syncthreads();
    }
};

constexpr int HNP = 2052;
DI void p8_route(Frame& F, const ArgP& a) {
    LAS float* s_hn = (LAS float*)F.lds; LAS float* s_part = (LAS float*)(F.lds + 16 * HNP * 4); LAS float* s_log = s_part + 8 * 16 * 32; LAS int* s_slot = (LAS int*)(s_log + 16 * 32);
    const float* h2 = (const float*)(F.ws + WS_H2); unsigned char* xg = (unsigned char*)(F.ws + WS_XG);
    float* gate_of = (float*)(F.ws + WS_GATEOF); int* tok_e = (int*)(F.ws + WS_TOKE);
    const float* rw = a.in(I_RW); const float* rb = a.in(I_RB); const float* g3 = a.in(I_GFFN);
    const int lane = F.lane, wave = F.wave, tid = F.tid, hh = lane >> 5;
    for (int task = F.vcu; task < NTOK / 16; task += F.G) {
        const int tb = task * 16;
#pragma unroll
        for (int q = 0; q < 2; ++q) { const int tl = 2 * wave + q; const size_t tok = (size_t)(tb + tl);
            const f32x4* xr = (const f32x4*)(h2 + tok * 2048) + lane;
            f32x4 v[8]; float s = 0.f;
#pragma unroll
            for (int j = 0; j < 8; ++j) { v[j] = xr[64 * j]; s += (v[j].x * v[j].x + v[j].y * v[j].y) + (v[j].z * v[j].z + v[j].w * v[j].w); }
            const float rstd = 1.f / sqrtf(wave_sum(s) * (1.f / 2048.f) + EPS_);
#pragma unroll
            for (int j = 0; j < 8; ++j) { const f32x4 gg = ((const f32x4*)g3)[lane + 64 * j]; const f32x4 y = v[j] * rstd * gg;
                *(LAS f32x4*)(s_hn + tl * HNP + (lane + 64 * j) * 4) = y; } }
        __syncthreads();
        {
            f32x16 acc; for (int i = 0; i < 16; ++i) acc[i] = 0.f;
            const LAS float* ap = s_hn + (lane & 15) * HNP + 256 * wave; const float* bp = rw + (size_t)(256 * wave + hh) * 32 + (lane & 31);
#pragma unroll 8
            for (int j = 0; j < 64; ++j) { const f32x4 a4 = *(const LAS f32x4*)(ap + 4 * j);
                const float b1 = bp[(size_t)(4 * j) * 32], b2 = bp[(size_t)(4 * j + 2) * 32];
                acc = __builtin_amdgcn_mfma_f32_32x32x2f32(hh ? a4.y : a4.x, b1, acc, 0, 0, 0);
                acc = __builtin_amdgcn_mfma_f32_32x32x2f32(hh ? a4.w : a4.z, b2, acc, 0, 0, 0); }
            LAS float* pp = s_part + wave * 512 + (lane & 31);
#pragma unroll
            for (int r = 0; r < 8; ++r) pp[crow(r, hh) * 32] = acc[r];
        }
        __syncthreads();
        { const int tt = tid >> 5, e = tid & 31; float s = rb[e];
#pragma unroll
          for (int w = 0; w < 8; ++w) s += s_part[w * 512 + tt * 32 + e];
          s_log[tt * 32 + e] = s; }
        __syncthreads();
        if (tid < 16) { const int tok = tb + tid; unsigned taken = 0u; float val[4]; int idx[4];
#pragma unroll
            for (int k = 0; k < 4; ++k) { float best = -INFINITY; int bi = 0;
                for (int e = 0; e < 32; ++e) { const float v = s_log[tid * 32 + e]; if (!((taken >> e) & 1u) && v > best) { best = v; bi = e; } }
                taken |= 1u << bi; val[k] = best; idx[k] = bi; }
            float ex[4], sum = 0.f;
#pragma unroll
            for (int k = 0; k < 4; ++k) { ex[k] = __expf(val[k] - val[0]); sum += ex[k]; }
#pragma unroll
            for (int k = 0; k < 4; ++k) { const int e = idx[k];
                const unsigned rank = __hip_atomic_fetch_add(F.ctl + CW_CNT + 64 * e, 1u, __ATOMIC_RELAXED, __HIP_MEMORY_SCOPE_AGENT);
                gate_of[e * 8192 + rank] = ex[k] / sum; tok_e[tok * 4 + k] = e * 8192 + (int)rank; s_slot[tid * 4 + k] = e * 8192 + (int)rank; } }
        __syncthreads();
#pragma unroll
        for (int q = 0; q < 2; ++q) { const int tl = 2 * wave + q;
            unsigned o[8];
#pragma unroll
            for (int j = 0; j < 8; ++j) { const f32x4 y = *(const LAS f32x4*)(s_hn + tl * HNP + (lane + 64 * j) * 4);
                unsigned w = 0u; w = __builtin_amdgcn_cvt_pk_fp8_f32(y.x * 4.f, y.y * 4.f, w, false); w = __builtin_amdgcn_cvt_pk_fp8_f32(y.z * 4.f, y.w * 4.f, w, true); o[j] = w; }
#pragma unroll
            for (int k = 0; k < 4; ++k) { unsigned* o4 = (unsigned*)(xg + (size_t)s_slot[tl * 4 + k] * 2048) + lane;
#pragma unroll
                for (int j = 0; j < 8; ++j) o4[64 * j] = o[j]; } }
        __syncthreads();
    }
}

DI void moe_tables(Frame& F) {
    if (F.tid == 0) { unsigned base = 0u;
        for (int e = 0; e < 32; ++e) { const unsigned c = F.ctl[CW_CNT + 64 * e], mt = (c + 255u) >> 8; F.MISC[16 + e] = c; F.MISC[48 + e] = base; F.MISC[80 + e] = mt; base += mt; }
        F.MISC[112] = base; }
    __syncthreads();
}
DI int ldsu(volatile LAS unsigned* p) { return __builtin_amdgcn_readfirstlane((int)*p); }
template <int NTN  >
struct SchedMoe {
    int G, c; const unsigned char* ws; volatile LAS unsigned* MISC;
    DI bool next(int i, pg8::UnitD& u) const {
        const int L = i * G + c; const int total = ldsu(MISC + 112) * NTN; if (L >= total) return false;
        int e = 0;
        for (int k = 0; k < 32; ++k) { if (L >= (ldsu(MISC + 48 + k) + ldsu(MISC + 80 + k)) * NTN) e = k + 1; }
        const int tb = ldsu(MISC + 48 + e), mte = ldsu(MISC + 80 + e), cnt = ldsu(MISC + 16 + e);
        const int local = L - tb * NTN, nt = local / mte, mt = local % mte;
        u.type = 0; u.e = e; u.pn = nt; u.pm = tb + mt; u.x0 = mt; u.lda = 2048u; u.ldb = 2048u;
        u.rows = nullptr; u.nvalid = cnt - mt * 256;
        if (NTN == 16) { u.A = (const char*)(ws + WS_XG) + ((size_t)e * 8192 + (size_t)mt * 256) * 2048;
            u.B = (const char*)(ws + WS_W1) + ((size_t)e * 4096 + (size_t)nt * 256) * 2048; }
        else { u.A = (const char*)(ws + WS_ACT) + ((size_t)e * 8192 + (size_t)mt * 256) * 2048;
            u.B = (const char*)(ws + WS_W2) + ((size_t)e * 2048 + (size_t)nt * 256) * 2048; }
        return true;
    }
};
struct EpiMoe1 {
    static constexpr bool AFTER_DRAIN = false;
    unsigned char* act; const float* b1;
    DI void operator()(const f32x4 (&acc)[2][2][4][2], const pg8::UnitD& u, int wr, int wc, int fr, int fq) const {
        { int ln_ = threadIdx.x; asm volatile("" : "+v"(ln_)); fr = ln_ & 15; fq = (ln_ >> 4) & 3; }
        const int j0 = u.pn * 128 + wc * 32 + 8 * fq;
        const float* bg = b1 + (size_t)u.e * 4096 + j0; const float* bu = bg + 2048;
        const f32x4 bg0 = *(const f32x4*)bg, bg1 = *(const f32x4*)(bg + 4), bu0 = *(const f32x4*)bu, bu1 = *(const f32x4*)(bu + 4);
#pragma unroll
        for (int ai = 0; ai < 2; ++ai)
#pragma unroll
            for (int m = 0; m < 4; ++m) { const size_t row = (size_t)u.e * 8192 + u.x0 * 256 + ai * 128 + wr * 64 + m * 16 + fr;
                float o[8];
#pragma unroll
                for (int n = 0; n < 2; ++n)
#pragma unroll
                    for (int e = 0; e < 4; ++e) { const float g = fminf(acc[ai][0][m][n][e] * (1.f / 256.f) + (n ? bg1[e] : bg0[e]), 7.f);
                        const float uu = fminf(fmaxf(acc[ai][1][m][n][e] * (1.f / 256.f) + (n ? bu1[e] : bu0[e]), -7.f), 7.f);
                        o[n * 4 + e] = g / (1.f + __expf(-1.702f * g)) * (uu + 1.f) * 4.f; }
                u32x2 w; w.x = __builtin_amdgcn_cvt_pk_fp8_f32(o[0], o[1], 0u, false); w.x = __builtin_amdgcn_cvt_pk_fp8_f32(o[2], o[3], w.x, true);
                w.y = __builtin_amdgcn_cvt_pk_fp8_f32(o[4], o[5], 0u, false); w.y = __builtin_amdgcn_cvt_pk_fp8_f32(o[6], o[7], w.y, true);
                *(u32x2*)(act + row * 2048 + j0) = w; }
    }
};
struct EpiMoe2 {
    static constexpr bool AFTER_DRAIN = false;
    bf16_t* y; const float* b2; const float* gate_of;
    DI void operator()(const f32x4 (&acc)[2][2][4][2], const pg8::UnitD& u, int wr, int wc, int fr, int fq) const {
        { int ln_ = threadIdx.x; asm volatile("" : "+v"(ln_)); fr = ln_ & 15; fq = (ln_ >> 4) & 3; }
        const int col0 = u.pn * 256 + wc * 32 + 8 * fq;
        const float* bp = b2 + (size_t)u.e * 2048 + col0;
#pragma unroll
        for (int ai = 0; ai < 2; ++ai)
#pragma unroll
            for (int m = 0; m < 4; ++m) { const int rl = ai * 128 + wr * 64 + m * 16 + fr; const size_t row = (size_t)u.e * 8192 + u.x0 * 256 + rl;
                const float gt = (rl < u.nvalid) ? gate_of[u.e * 8192 + u.x0 * 256 + rl] : 0.f;
#pragma unroll
                for (int bj = 0; bj < 2; ++bj) { const f32x4 v0 = (acc[ai][bj][m][0] * (1.f / 256.f) + *(const f32x4*)(bp + bj * 128)) * gt, v1 = (acc[ai][bj][m][1] * (1.f / 256.f) + *(const f32x4*)(bp + bj * 128 + 4)) * gt;
                    u32x4 w; w.x = pk2(v0[0], v0[1]); w.y = pk2(v0[2], v0[3]); w.z = pk2(v1[0], v1[1]); w.w = pk2(v1[2], v1[3]);
                    *(u32x4*)(y + row * 2048 + col0 + bj * 128) = w; } }
    }
};

DI void p11_combine(Frame& F, const ArgP& a) {
    const int gw = F.vcu * NWAVES + F.wave, NGW = F.G * NWAVES, lane = F.lane;
    const float* h2 = (const float*)(F.ws + WS_H2); const bf16_t* y = (const bf16_t*)(F.ws + WS_Y);
    const int* tok_e = (const int*)(F.ws + WS_TOKE);
    for (int t = gw; t < NTOK; t += NGW) {
        size_t yrow[4];
#pragma unroll
        for (int k = 0; k < 4; ++k) yrow[k] = (size_t)tok_e[t * 4 + k] * 2048;
#pragma unroll
        for (int j = 0; j < 8; ++j) { const int c = (lane + 64 * j) * 4;
            f32x4 v = *(const f32x4*)(h2 + (size_t)t * 2048 + c);
#pragma unroll
            for (int k = 0; k < 4; ++k) { const u32x2 w = *(const u32x2*)(y + yrow[k] + c); v.x += bflo(w.x); v.y += bfhi(w.x); v.z += bflo(w.y); v.w += bfhi(w.y); }
            *(f32x4*)(a.out() + (size_t)t * 2048 + c) = v; }
    }
}

#ifndef MK_PER_PHASE
#define MK_PER_PHASE 0
#endif
#ifndef MK_LAST_PHASE
#define MK_LAST_PHASE 12
#endif
constexpr int N_PHASES = MK_LAST_PHASE;

__global__ void __launch_bounds__(NWAVES * 64, 2) mega_fwd(Args args_) {
    const ArgP args{};
    extern __shared__ __attribute__((aligned(16))) unsigned char lds_raw[];
    Frame F;
    F.lds = (LAS unsigned char*)lds_raw;
    F.MISC = (volatile LAS unsigned*)(F.lds + MISC_OFF);
    F.tid = threadIdx.x; F.lane = F.tid & 63; F.wave = __builtin_amdgcn_readfirstlane(F.tid >> 6);
    F.G = gridDim.x; { const int bx = blockIdx.x; F.vcu = (F.G % 8 == 0) ? (bx % 8) * (F.G / 8) + bx / 8 : bx; }
    F.ws = args_.ws; F.ctl = (unsigned*)(args_.ws + WS_CTL);
    for (int u = F.tid; u < 256; u += NWAVES * 64) F.MISC[u] = 0u;
    __syncthreads();
    XcdBarrier bar; bar.bar = F.ctl + CW_BAR; bar.x = 0; bar.st = nullptr;
    const int lo = args_.ph_lo, hi = args_.ph_hi;
    if (hi - lo > 1) bar = xcd_barrier_post(F.ctl + CW_BAR, F.MISC + 8);
#ifndef MK_PHASE_MASK
#define MK_PHASE_MASK 0xFFFF
#endif
#define IN(k) (((MK_PHASE_MASK >> (k)) & 1) && lo <= (k) && (k) < hi)
#define SEAM(k) do { if (IN(k) && IN((k) + 1)) xcd_barrier(bar); } while (0)
#define FRESH() do { int t_ = threadIdx.x; asm volatile("" : "+v"(t_)); F.tid = t_; F.lane = t_ & 63; F.wave = __builtin_amdgcn_readfirstlane(t_ >> 6); } while (0)
    unsigned char* ws = args_.ws;

    if (IN(0)) { FRESH(); p0_prologue(F, args); }
    SEAM(0);
    if (IN(1)) { FRESH();
        SchedP1 S{F.G, F.vcu, ws, 0, 32 * 23};
        EpiP1 E{(bf16_t*)(ws + WS_PROJ), (float*)(ws + WS_DT), (bf16_t*)(ws + WS_KVRAW), args.in(I_DAQG), args.in(I_DAKG), (unsigned char*)(ws + WS_VF8)};
        pg8::gemm_phase<EpiP1, SchedP1, false, true>(F.lds + RING_OFF, 32, S, E);
    }
    SEAM(1);
    if (IN(2)) { FRESH();
        if ((F.vcu & 3) == 1) {
            SchedP1 S{(F.G + 3) >> 2, F.vcu >> 2, ws, 32 * 23, 32 * 23 + 64};
            EpiP1 E{(bf16_t*)(ws + WS_PROJ), (float*)(ws + WS_DT), (bf16_t*)(ws + WS_KVRAW), args.in(I_DAQG), args.in(I_DAKG), (unsigned char*)(ws + WS_VF8)};
            pg8::gemm_phase<EpiP1, SchedP1, false, true>(F.lds + RING_OFF, 32, S, E);
            __syncthreads();
        }
        if ((F.vcu & 3) == 0) { for (int u = F.vcu >> 2; u < 64; u += (F.G + 3) >> 2) ssd_unit(F, args, u >> 4, u & 15); }
        __syncthreads();
        attn_phase_da(F);
    }
    SEAM(2);
    if (IN(3)) { FRESH(); kprep(F, args); p3_finalize(F, args); }
    SEAM(3);
    if (IN(4)) { FRESH();
        SchedDense S{F.G, F.vcu, 32, 8, (const char*)(ws + WS_YCAT), (const char*)(ws + WS_WOUT), 4096u, 4096u, 1 << 30, 0};
#if MK_LAST_PHASE == 5
        EpiResid E{args.in(I_X), args_.out, nullptr, nullptr, nullptr, 1.f};
#else
        EpiResid E{args.in(I_X), (float*)(ws + WS_H1), nullptr, (float*)(ws + WS_PART1), (unsigned char*)(ws + WS_H1F8), 1.f};
#endif
        pg8::gemm_phase<EpiResid, SchedDense, false, true>(F.lds + RING_OFF, 32, S, E);
    }
    SEAM(4);
    if (IN(5)) { FRESH();
        SchedDense S{F.G, F.vcu, 32, 8, (const char*)(ws + WS_H1F8), (const char*)(ws + WS_WQ), 2048u, 2048u, 1 << 30, 0};
        EpiQ E{(unsigned char*)(ws + WS_QF8), (float*)(ws + WS_PARTQ)};
        pg8::gemm_phase<EpiQ, SchedDense, false, true, true>(F.lds + RING_OFF, 16, S, E);
    }
    SEAM(5);
    if (IN(6)) { FRESH();
        SchedXS S{F.G, F.vcu, ws};
        EpiXS E{(unsigned char*)(ws + WS_P8), (unsigned char*)(ws + WS_VWT8), (const float*)(ws + WS_PART1), (const float*)(ws + WS_PARTQ), (LAS float*)(F.lds + RING_BYTES)};
        pg8::gemm_phase<EpiXS, SchedXS, false, true, true>(F.lds + RING_OFF, 4, S, E);
    }
    SEAM(6);
    if (IN(7)) { FRESH();
        SchedDense S{F.G, F.vcu, 32, 8, (const char*)(ws + WS_P8), (const char*)(ws + WS_VWT8), 1024u, 1024u, 8, (size_t)2048 * 1024};
#if MK_LAST_PHASE == 8
        EpiResid E{(const float*)(ws + WS_H1), args_.out, nullptr, nullptr, nullptr, 1.f / 8192.f};
#else
        EpiResid E{(const float*)(ws + WS_H1), (float*)(ws + WS_H2), nullptr, nullptr, nullptr, 1.f / 8192.f};
#endif
        pg8::gemm_phase<EpiResid, SchedDense, false, true, true>(F.lds + RING_OFF, 8, S, E);
    }
    SEAM(7);
    if (IN(8)) { FRESH(); p8_route(F, args); }
    SEAM(8);
    if (IN(9)) { FRESH();
        moe_tables(F);
        SchedMoe<16> S{F.G, F.vcu, ws, F.MISC};
        EpiMoe1 E{(unsigned char*)(ws + WS_ACT), args.in(I_B1)};
        pg8::gemm_phase<EpiMoe1, SchedMoe<16>, false, true, true>(F.lds + RING_OFF, 16, S, E);
    }
    SEAM(9);
    if (IN(10)) { FRESH();
        moe_tables(F);
        SchedMoe<8> S{F.G, F.vcu, ws, F.MISC};
        EpiMoe2 E{(bf16_t*)(ws + WS_Y), args.in(I_B2), (const float*)(ws + WS_GATEOF)};
        pg8::gemm_phase<EpiMoe2, SchedMoe<8>, false, true, true>(F.lds + RING_OFF, 16, S, E);
    }
    SEAM(10);
    if (IN(11)) { FRESH(); p11_combine(F, args); }
#undef IN
#undef SEAM
}

extern "C" void kernel_launch(void* const* d_in, const int* in_sizes, int n_in, void* d_out, int out_size, void* d_ws, size_t ws_size, hipStream_t stream) {
    static int grid = 0;
    if (grid == 0) {
        if (n_in != 32 || out_size != NTOK * 2048 || ws_size < WS_END) { fprintf(stderr, "kernel_launch: unexpected shapes (n_in %d out %d ws %zu); nothing launched\n", n_in, out_size, ws_size); grid = -1; return; }
        int dev = 0, cus = 0, per_cu = 0;
        if (hipGetDevice(&dev) != hipSuccess || hipDeviceGetAttribute(&cus, hipDeviceAttributeMultiprocessorCount, dev) != hipSuccess) { grid = -1; return; }
        if (hipFuncSetAttribute((const void*)mega_fwd, hipFuncAttributeMaxDynamicSharedMemorySize, LDS_BYTES) != hipSuccess) { fprintf(stderr, "kernel_launch: hipFuncSetAttribute failed\n"); grid = -1; return; }
        if (hipOccupancyMaxActiveBlocksPerMultiprocessor(&per_cu, (const void*)mega_fwd, NWAVES * 64, LDS_BYTES) != hipSuccess || per_cu < 1) { fprintf(stderr, "kernel_launch: occupancy query says %d\n", per_cu); }
        (void)hipGetLastError();
        if (cus < 256) { fprintf(stderr, "kernel_launch: needs 256 CUs, found %d; nothing launched\n", cus); grid = -1; return; }
        grid = 256;
    }
    if (grid < 0) return;
    if (hipMemsetAsync((char*)d_ws + WS_CTL, 0, CTL_ZERO_BYTES, stream) != hipSuccess) return;
    Args a{};
    for (int i = 0; i < 32; ++i) a.in[i] = (const float*)d_in[i];
    a.out = (float*)d_out; a.ws = (unsigned char*)d_ws;
#if MK_PER_PHASE
    for (int p = 0; p < N_PHASES; ++p) { a.ph_lo = p; a.ph_hi = p + 1; hipLaunchKernelGGL(mega_fwd, dim3(grid), dim3(NWAVES * 64), LDS_BYTES, stream, a); }
#else
    a.ph_lo = 0; a.ph_hi = N_PHASES;
    hipLaunchKernelGGL(mega_fwd, dim3(grid), dim3(NWAVES * 64), LDS_BYTES, stream, a);
#ifdef MK_PROBE_LO
    for (int p = MK_PROBE_LO; p < MK_PROBE_HI; ++p) { a.ph_lo = p; a.ph_hi = p + 1; hipLaunchKernelGGL(mega_fwd, dim3(grid), dim3(NWAVES * 64), LDS_BYTES, stream, a); }
#endif
#endif
}
```

```cpp
#define MK_PER_PHASE 0
#define MK_LAST_PHASE 12
#include <hip/hip_runtime.h>
#include <hip/hip_bf16.h>
#include <cstdio>
#include <cstdint>
#include <cmath>

#define GAS __attribute__((address_space(1)))
#define LAS __attribute__((address_space(3)))
typedef unsigned short bf16_t;
typedef short bf16x8 __attribute__((ext_vector_type(8)));
typedef float f32x2 __attribute__((ext_vector_type(2)));
typedef float f32x4 __attribute__((ext_vector_type(4)));
typedef float f32x16 __attribute__((ext_vector_type(16)));
typedef unsigned u32x2 __attribute__((ext_vector_type(2)));
typedef unsigned u32x4 __attribute__((ext_vector_type(4)));
typedef __bf16 bf16x2_t __attribute__((ext_vector_type(2)));

#define DI __device__ __forceinline__
DI unsigned pk2(float lo, float hi) { f32x2 v = {lo, hi}; bf16x2_t b = __builtin_convertvector(v, bf16x2_t); return __builtin_bit_cast(unsigned, b); }
DI float bflo(unsigned u) { return __uint_as_float(u << 16); }
DI float bfhi(unsigned u) { return __uint_as_float(u & 0xffff0000u); }
DI float bf2f(bf16_t h) { return __uint_as_float(((unsigned)h) << 16); }
DI float wave_sum(float v) {
#pragma unroll
    for (int o = 1; o < 64; o <<= 1) v += __shfl_xor(v, o);
    return v;
}
DI float quad_sum_16_32(float v) {
    int l_ = threadIdx.x; asm volatile("" : "+v"(l_));
    const int a16 = ((l_ ^ 16) & 63) << 2, a32 = ((l_ ^ 32) & 63) << 2;
    v += __builtin_bit_cast(float, __builtin_amdgcn_ds_bpermute(a16, __builtin_bit_cast(int, v)));
    v += __builtin_bit_cast(float, __builtin_amdgcn_ds_bpermute(a32, __builtin_bit_cast(int, v)));
    return v;
}
DI float siluf(float x) { return x / (1.f + __expf(-x)); }

constexpr int DM_ = 2048, NB = 4, SEQ_ = 2048, NTOK = NB * SEQ_;
constexpr int PP = 5632;
constexpr int PC_XBC = 1024, PC_Q = 2560, PC_K = 3584, PC_V = 4608, PC_DT = 5632;
constexpr int WIN_ROWS = 5888;
constexpr int NEXP = 32, MEMLEN = 256;
constexpr float EPS_ = 1e-6f;
constexpr float LAM_INIT = 0.2f;

namespace pg8 {
constexpr int BM = 256, BK = 64, HALF = 128, HTB = HALF * BK * 2  , STAGE_BYTES = 8 * HTB;
DI int lds_byte(int r, int c) { const int st = (r >> 4) * 2 + (c >> 5), rr = r & 15, cc = c & 31, ob = rr * 64 + cc * 2; return st * 1024 + (ob ^ (((ob >> 9) & 1) << 5)); }
DI void stage_rc(int b, int& R, int& C) { const int st = b / 1024, sb = b % 1024, swz = sb ^ (((sb >> 9) & 1) << 5); R = (st >> 1) * 16 + swz / 64; C = (st & 1) * 32 + (swz % 64) / 2; }
DI int perm32(int rho) { const int n = rho >> 4, i = rho & 15; return 8 * (i >> 2) + 4 * n + (i & 3); }

struct UnitD {
    const char* A; const char* B;
    const int* rows;
    unsigned lda, ldb;
    int nvalid;
    int type, pm, pn, e, x0;
};
typedef int v8i_t __attribute__((ext_vector_type(8)));
DI v8i_t cat8(bf16x8 lo, bf16x8 hi) { typedef int v4i_t __attribute__((ext_vector_type(4))); const v4i_t a = __builtin_bit_cast(v4i_t, lo), b = __builtin_bit_cast(v4i_t, hi); return (v8i_t){a[0], a[1], a[2], a[3], b[0], b[1], b[2], b[3]}; }
DI void dense_voff(unsigned lda, unsigned ldb, int tid, unsigned (&vA)[2], unsigned (&vB)[2]) {
#pragma unroll
    for (int i = 0; i < 2; ++i) { int R, C; stage_rc(tid * 16 + i * 8192, R, C); const int Rb = (R & ~31) + perm32(R & 31);
        vA[i] = (unsigned)R * lda + (unsigned)C * 2u; vB[i] = (unsigned)Rb * ldb + (unsigned)C * 2u; }
}
DI void gather_voff(const UnitD& u, int tid, unsigned (&gA)[2][2]) {
#pragma unroll
    for (int i = 0; i < 2; ++i) { int R, C; stage_rc(tid * 16 + i * 8192, R, C);
#pragma unroll
        for (int h = 0; h < 2; ++h) { const int ra = h * 128 + R; const unsigned rowA = (ra < u.nvalid) ? (unsigned)u.rows[ra] : 0u; gA[h][i] = rowA * u.lda + (unsigned)C * 2u; } }
}

template <class Epi, class Sched, bool GATHER, bool ALIGN_EPI, bool FP8 = false>
DI void gemm_phase(LAS unsigned char* lds, int nt, const Sched& S, const Epi& E) {

    const int tid = threadIdx.x, wid = __builtin_amdgcn_readfirstlane(tid >> 6), lane = tid & 63, wr = wid >> 2, wc = wid & 3, fr = lane & 15, fq = lane >> 4;
    const size_t kstep = (size_t)(BK * 2);
    const unsigned ldsb = (unsigned)__builtin_amdgcn_readfirstlane((int)((unsigned)(uintptr_t)lds + (unsigned)wid * 1024u));
    const int aoff = lds_byte(wr * 64 + fr, fq * 8), boff = lds_byte(wc * 32 + fr, fq * 8);
#define PG8_SA(b, h) (((b) * 2 + (h)) * HTB)
#define PG8_SB(b, h) ((4 + (b) * 2 + (h)) * HTB)
#define PG8_STAGE(bufoff, gbase, voff) do { _Pragma("unroll") for (int _i = 0; _i < 2; ++_i) { unsigned keep_; \
        asm volatile("s_mov_b32 %0, m0\n\ts_mov_b32 m0, %3\n\ts_nop 0\n\tglobal_load_lds_dwordx4 %1, %2\n\ts_mov_b32 m0, %0" \
                     : "=&s"(keep_) : "v"((voff)[_i]), "s"((const char*)(gbase)), "s"(ldsb + (unsigned)((bufoff) + _i * 8192)) : "memory"); } } while (0)
#define PG8_STA(bufoff, gbase, h, HS, GA) do { if constexpr (GATHER) { PG8_STAGE(bufoff, gbase, GA[h]); } else { PG8_STAGE(bufoff, (gbase) + (h) * (HS), vA); } } while (0)
#define PG8_STB(bufoff, gbase, h, HS) PG8_STAGE(bufoff, (gbase) + (h) * (HS), vB)
typedef int v4i_t __attribute__((ext_vector_type(4)));
#define PG8_LDA(dst, b, h) do { _Pragma("unroll") for (int m = 0; m < 4; ++m) { if constexpr (FP8) { \
            const v4i_t lo_ = *(const LAS v4i_t*)(lds + PG8_SA(b, h) + aoff + m * 2048), hi_ = *(const LAS v4i_t*)(lds + PG8_SA(b, h) + aoff + m * 2048 + 1024); \
            dst##8[m] = __builtin_shufflevector(lo_, hi_, 0, 1, 2, 3, 4, 5, 6, 7); } \
        else { _Pragma("unroll") for (int k = 0; k < 2; ++k) dst[m][k] = *(const LAS bf16x8*)(lds + PG8_SA(b, h) + aoff + m * 2048 + k * 1024); } } } while (0)
#define PG8_LDB(dst, b, h) do { _Pragma("unroll") for (int n = 0; n < 2; ++n) { if constexpr (FP8) { \
            const v4i_t lo_ = *(const LAS v4i_t*)(lds + PG8_SB(b, h) + boff + n * 2048), hi_ = *(const LAS v4i_t*)(lds + PG8_SB(b, h) + boff + n * 2048 + 1024); \
            dst##8[n] = __builtin_shufflevector(lo_, hi_, 0, 1, 2, 3, 4, 5, 6, 7); } \
        else { _Pragma("unroll") for (int k = 0; k < 2; ++k) dst[n][k] = *(const LAS bf16x8*)(lds + PG8_SB(b, h) + boff + n * 2048 + k * 1024); } } } while (0)
#define PG8_MMA(ai, bj, At, Bt) do { __builtin_amdgcn_s_setprio(1); _Pragma("unroll") for (int m = 0; m < 4; ++m) _Pragma("unroll") for (int n = 0; n < 2; ++n) { \
        if constexpr (FP8) { acc[ai][bj][m][n] = __builtin_amdgcn_mfma_scale_f32_16x16x128_f8f6f4(Bt##8[n], At##8[m], acc[ai][bj][m][n], 0, 0, 0, 0x7f7f7f7f, 0, 0x7f7f7f7f); } \
        else { _Pragma("unroll") for (int k = 0; k < 2; ++k) acc[ai][bj][m][n] = __builtin_amdgcn_mfma_f32_16x16x32_bf16(Bt[n][k], At[m][k], acc[ai][bj][m][n], 0, 0, 0); } } \
        __builtin_amdgcn_s_setprio(0); } while (0)
#define PG8_WAIT_V(n) asm volatile("s_waitcnt vmcnt(" #n ")" ::: "memory")
#define PG8_WAIT_L(n) asm volatile("s_waitcnt lgkmcnt(" #n ")" ::: "memory")
#define PG8_BAR __builtin_amdgcn_s_barrier()
#define PG8_SCHED __builtin_amdgcn_sched_barrier(0)
#define PG8_ITER(A1P, A2P, B2P, HA2, HB2, GA2) do { \
        const char* a3p_ = (A2P) + kstep; const char* b3p_ = (B2P) + kstep; \
        PG8_LDB(B0, 0, 0); PG8_LDB(B1, 0, 1); PG8_SCHED; PG8_LDA(At, 0, 0); PG8_STA(PG8_SA(1, 1), (A1P), 1, hsA, gA); \
        PG8_WAIT_V(8); PG8_WAIT_L(0); PG8_BAR; PG8_MMA(0, 0, At, B0); PG8_MMA(0, 1, At, B1); PG8_BAR; PG8_SCHED; \
        PG8_LDA(At, 0, 1); PG8_STB(PG8_SB(0, 0), (B2P), 0, HB2); PG8_STB(PG8_SB(0, 1), (B2P), 1, HB2); PG8_STA(PG8_SA(0, 0), (A2P), 0, HA2, GA2); \
        PG8_WAIT_V(8); PG8_WAIT_L(0); PG8_BAR; PG8_MMA(1, 0, At, B0); PG8_MMA(1, 1, At, B1); PG8_BAR; PG8_SCHED; \
        PG8_LDB(B0, 1, 0); PG8_LDB(B1, 1, 1); PG8_SCHED; PG8_LDA(At, 1, 0); PG8_STA(PG8_SA(0, 1), (A2P), 1, HA2, GA2); \
        PG8_WAIT_V(8); PG8_WAIT_L(0); PG8_BAR; PG8_MMA(0, 0, At, B0); PG8_MMA(0, 1, At, B1); PG8_BAR; PG8_SCHED; \
        PG8_LDA(At, 1, 1); PG8_STB(PG8_SB(1, 0), b3p_, 0, HB2); PG8_STB(PG8_SB(1, 1), b3p_, 1, HB2); PG8_STA(PG8_SA(1, 0), a3p_, 0, HA2, GA2); \
        PG8_WAIT_V(8); PG8_WAIT_L(0); PG8_BAR; PG8_MMA(1, 0, At, B0); PG8_MMA(1, 1, At, B1); PG8_BAR; PG8_SCHED; \
    } while (0)
    UnitD cur, nxt; int ui = 0;
    if (!S.next(0, cur)) return;
    f32x4 acc[2][2][4][2];
#pragma unroll
    for (int a = 0; a < 2; ++a)
#pragma unroll
        for (int b = 0; b < 2; ++b)
#pragma unroll
            for (int m = 0; m < 4; ++m)
#pragma unroll
                for (int n = 0; n < 2; ++n) acc[a][b][m][n] = (f32x4){0.f, 0.f, 0.f, 0.f};
    bf16x8 At[4][2], B0[2][2], B1[2][2]; v8i_t At8[4], B08[2], B18[2];
    unsigned vA[2], vB[2], gA[2][2], ngA[2][2];
    dense_voff(cur.lda, cur.ldb, tid, vA, vB);
    if constexpr (GATHER) gather_voff(cur, tid, gA);
    const char* cA = cur.A; const char* cB = cur.B;
    size_t hsA = GATHER ? 0 : (size_t)cur.lda * HALF, hsB = (size_t)cur.ldb * HALF;
    PG8_STB(PG8_SB(0, 0), cB, 0, hsB); PG8_STB(PG8_SB(0, 1), cB, 1, hsB); PG8_STA(PG8_SA(0, 0), cA, 0, hsA, gA); PG8_STA(PG8_SA(0, 1), cA, 1, hsA, gA);
    if (wr == 1) PG8_BAR;
    PG8_WAIT_V(2); PG8_BAR;
    PG8_STB(PG8_SB(1, 0), cB + kstep, 0, hsB); PG8_STA(PG8_SA(1, 0), cA + kstep, 0, hsA, gA); PG8_STB(PG8_SB(1, 1), cB + kstep, 1, hsB);
    PG8_WAIT_V(6); PG8_BAR;
    for (;;) {
        const bool has_next = S.next(ui + 1, nxt);
        const char* nA = cA; const char* nB = cB; size_t nhsA = hsA, nhsB = hsB;
        if (has_next) { nA = nxt.A; nB = nxt.B; nhsA = GATHER ? 0 : (size_t)nxt.lda * HALF; nhsB = (size_t)nxt.ldb * HALF; }
        if constexpr (GATHER) {
            if (has_next) gather_voff(nxt, tid, ngA);
            else {
#pragma unroll
                for (int h = 0; h < 2; ++h)
#pragma unroll
                    for (int i = 0; i < 2; ++i) ngA[h][i] = gA[h][i];
            }
        }
#pragma unroll 1
        for (int t = 0; t < nt; t += 2) {
            const bool last = (t == nt - 2);
            const char* a2 = last ? nA : cA + (size_t)(t + 2) * kstep; const char* b2 = last ? nB : cB + (size_t)(t + 2) * kstep;
            const size_t hA2 = last ? nhsA : hsA, hB2 = last ? nhsB : hsB;
            unsigned g2[2][2];
            if constexpr (GATHER) {
#pragma unroll
                for (int h = 0; h < 2; ++h)
#pragma unroll
                    for (int i = 0; i < 2; ++i) g2[h][i] = last ? ngA[h][i] : gA[h][i];
            }
            PG8_ITER(cA + (size_t)(t + 1) * kstep, a2, b2, hA2, hB2, g2);
        }
        if constexpr (ALIGN_EPI) { if (wr == 0) PG8_BAR; }
        if constexpr (!Epi::AFTER_DRAIN) { E(acc, cur, wr, wc, fr, fq); }
        if (!has_next) break;
#pragma unroll
        for (int a = 0; a < 2; ++a)
#pragma unroll
            for (int b = 0; b < 2; ++b)
#pragma unroll
                for (int m = 0; m < 4; ++m)
#pragma unroll
                    for (int n = 0; n < 2; ++n) acc[a][b][m][n] = (f32x4){0.f, 0.f, 0.f, 0.f};
        cur = nxt; cA = nA; cB = nB; hsA = nhsA; hsB = nhsB; ++ui;
        if constexpr (GATHER) {
#pragma unroll
            for (int h = 0; h < 2; ++h)
#pragma unroll
                for (int i = 0; i < 2; ++i) gA[h][i] = ngA[h][i];
        }
        if constexpr (ALIGN_EPI) { if (wr == 1) PG8_BAR; }
    }
    PG8_WAIT_V(0);
    if constexpr (!ALIGN_EPI) { if (wr == 0) PG8_BAR; }
    PG8_BAR;
    if constexpr (Epi::AFTER_DRAIN) { E.fused(acc, cur, wr, wc, fr, fq, lds, wid, lane); }
#undef PG8_SA
#undef PG8_SB
#undef PG8_STAGE
#undef PG8_STA
#undef PG8_STB
#undef PG8_LDA
#undef PG8_LDB
#undef PG8_MMA
#undef PG8_WAIT_V
#undef PG8_WAIT_L
#undef PG8_BAR
#undef PG8_SCHED
#undef PG8_ITER
}
}
namespace attn_body {
using bf16=__hip_bfloat16;
using bf16x8=__attribute__((ext_vector_type(8)))short;
using s16x4=__attribute__((ext_vector_type(4)))short;
using f32x16=__attribute__((ext_vector_type(16)))float;
using u32x4=__attribute__((ext_vector_type(4)))unsigned;
constexpr int BATCH=4,SEQ=2048,D=64,DM=5632,OPITCH=1024;
constexpr int NW=8,QBLK=32,QB=QBLK*NW,KVBLK=64,NQB=SEQ/QB;
constexpr int ATTN_UNIT_ROWS=QB;
__device__ __forceinline__ int crow(int r,int hi){return (r&3)+8*(r>>2)+4*hi;}
#define SBAR() __builtin_amdgcn_sched_barrier(0)
__device__ __forceinline__ void cmask(f32x16&p0,f32x16&p1,int jb,int qrel,int hi){
  const float NEG=-INFINITY; int kb=64*jb+4*hi;
  #pragma unroll
  for(int r=0;r<16;++r){int kv=kb+(r&3)+8*(r>>2); if(kv>qrel)p0[r]=NEG; if(kv+32>qrel)p1[r]=NEG;}
}

constexpr int NSLOT=3, SLOTB=8192;
constexpr int LDS_K=0, LDS_V=NSLOT*SLOTB, LDS_WS=2*NSLOT*SLOTB, LDS_OST=LDS_WS+NW*64*4, LDS_BYTES=LDS_OST+NW*4096;
constexpr float C2=0.125f*1.4426950408889634f;
__device__ __forceinline__ void glds16(const void*gsrc,unsigned lds_dst){unsigned keep;
  asm volatile("s_mov_b32 %0, m0\n\ts_mov_b32 m0, %2\n\ts_nop 0\n\tglobal_load_lds_dwordx4 %1, off\n\ts_mov_b32 m0, %0":"=&s"(keep):"v"(gsrc),"s"(lds_dst):"memory");}
__device__ __forceinline__ float max3f(float a,float b,float c){float r;asm("v_max3_f32 %0, %1, %2, %3":"=v"(r):"v"(a),"v"(b),"v"(c));return r;}
__device__ __forceinline__ float max2f(float a,float b){float r;asm("v_max_f32_e32 %0, %1, %2":"=v"(r):"v"(a),"v"(b));return r;}
__device__ __forceinline__ float fadd_s(float a,float b){float r;asm("v_add_f32_e32 %0, %1, %2":"=v"(r):"v"(a),"v"(b));return r;}
__device__ __forceinline__ float fsub_s(float a,float b){float r;asm("v_sub_f32_e32 %0, %1, %2":"=v"(r):"v"(a),"v"(b));return r;}
typedef float f32x2_t __attribute__((ext_vector_type(2))); typedef __bf16 bf16x2_t __attribute__((ext_vector_type(2)));
__device__ __forceinline__ unsigned cvtpk_s(float lo,float hi){f32x2_t v={lo,hi};bf16x2_t b=__builtin_convertvector(v,bf16x2_t);return __builtin_bit_cast(unsigned,b);}
#define WAIT_BAR(N) asm volatile("s_waitcnt vmcnt(" #N ") lgkmcnt(0)\n\ts_barrier":::"memory")

__device__ __forceinline__ void qkt(f32x16&p0,f32x16&p1,const char*Kslot,const bf16x8*qr,const f32x16&negm,int r32,int hi){
  const char*kb=Kslot+hi*1024+r32*16;
  #pragma unroll
  for(int d0=0;d0<4;++d0){
    const bf16x8 b0=*reinterpret_cast<const bf16x8*>(kb+d0*2048);
    const bf16x8 b1=*reinterpret_cast<const bf16x8*>(kb+d0*2048+512);
    if(d0==0){p0=__builtin_amdgcn_mfma_f32_32x32x16_bf16(b0,qr[0],negm,0,0,0);p1=__builtin_amdgcn_mfma_f32_32x32x16_bf16(b1,qr[0],negm,0,0,0);}
    else{p0=__builtin_amdgcn_mfma_f32_32x32x16_bf16(b0,qr[d0],p0,0,0,0);p1=__builtin_amdgcn_mfma_f32_32x32x16_bf16(b1,qr[d0],p1,0,0,0);}}
}
typedef __attribute__((address_space(3))) const char* lds_cptr;
typedef short v4i16_t __attribute__((ext_vector_type(4)));
__device__ __forceinline__ void kload8(bf16x8*kf,lds_cptr kp){
  kf[0]=*(const __attribute__((address_space(3))) bf16x8*)(kp);      kf[1]=*(const __attribute__((address_space(3))) bf16x8*)(kp+512);
  kf[2]=*(const __attribute__((address_space(3))) bf16x8*)(kp+2048); kf[3]=*(const __attribute__((address_space(3))) bf16x8*)(kp+2560);
  kf[4]=*(const __attribute__((address_space(3))) bf16x8*)(kp+4096); kf[5]=*(const __attribute__((address_space(3))) bf16x8*)(kp+4608);
  kf[6]=*(const __attribute__((address_space(3))) bf16x8*)(kp+6144); kf[7]=*(const __attribute__((address_space(3))) bf16x8*)(kp+6656);
}
__device__ __forceinline__ void kload2(bf16x8*kf,lds_cptr kp,int j){ kf[2*j]=*(const __attribute__((address_space(3))) bf16x8*)(kp+j*2048); kf[2*j+1]=*(const __attribute__((address_space(3))) bf16x8*)(kp+j*2048+512); }
__device__ __forceinline__ s16x4 vtr(lds_cptr p){ return __builtin_bit_cast(s16x4,__builtin_amdgcn_ds_read_tr16_b64_v4i16((__attribute__((address_space(3))) v4i16_t*)p)); }
__device__ __forceinline__ float rowmax(const f32x16&p0,const f32x16&p1){
  float a=max3f(p0[0],p0[1],p1[0]),b=max3f(p0[2],p0[3],p1[1]);a=max3f(a,p1[2],p1[3]);
  #pragma unroll
  for(int r=4;r<16;r+=4){a=max3f(a,p0[r],p0[r+1]);b=max3f(b,p0[r+2],p0[r+3]);a=max3f(a,p1[r],p1[r+1]);b=max3f(b,p1[r+2],p1[r+3]);}
  const float m=max2f(a,b);
  auto rr=__builtin_amdgcn_permlane32_swap(__float_as_uint(m),__float_as_uint(m),false,false);
  return max2f(__uint_as_float(rr[0]),__uint_as_float(rr[1]));
}
__device__ __forceinline__ void pv(f32x16*o,int vb,bf16x8 pa0,bf16x8 pa1,bf16x8 pa2,bf16x8 pa3){
  #pragma unroll
  for(int d0=0;d0<2;++d0){s16x4 lo[4],hi[4];
    #pragma unroll
    for(int ks=0;ks<4;++ks){
      asm volatile("ds_read_b64_tr_b16 %0,%1 offset:%c2":"=&v"(lo[ks]):"v"(vb),"i"(d0*4096+ks*1024):"memory");
      asm volatile("ds_read_b64_tr_b16 %0,%1 offset:%c2":"=&v"(hi[ks]):"v"(vb),"i"(d0*4096+ks*1024+512):"memory");}
    asm volatile("s_waitcnt lgkmcnt(0)":::"memory");SBAR();
    #define PK(k) (bf16x8){lo[k][0],lo[k][1],lo[k][2],lo[k][3],hi[k][0],hi[k][1],hi[k][2],hi[k][3]}
    o[d0]=__builtin_amdgcn_mfma_f32_32x32x16_bf16(pa0,PK(0),o[d0],0,0,0);
    o[d0]=__builtin_amdgcn_mfma_f32_32x32x16_bf16(pa1,PK(1),o[d0],0,0,0);
    o[d0]=__builtin_amdgcn_mfma_f32_32x32x16_bf16(pa2,PK(2),o[d0],0,0,0);
    o[d0]=__builtin_amdgcn_mfma_f32_32x32x16_bf16(pa3,PK(3),o[d0],0,0,0);
    #undef PK
  }
}

#ifndef ATTN_STORE16
#define ATTN_STORE16(p,v) (*(u32x4*)(p)=(v))
#endif
template<int THRL> __device__ __forceinline__ void attn_unit(int b,int qcol,int vcol,int ocol,int qb,const bf16*Q,const bf16*__restrict__ K,const bf16*__restrict__ V,bf16*O,char*shm){
  const int tid=threadIdx.x,lane=tid&63,r32=lane&31,hi=lane>>5; const int wid=__builtin_amdgcn_readfirstlane(tid>>6);
  const long rowbase=(long)b*SEQ; const int q0=qb*QB;
  const bf16*Qw=Q+(rowbase+q0+wid*QBLK)*DM+qcol;
  const bf16*Kh=K+rowbase*DM+qcol,*Vh=V+rowbase*DM+vcol;
  const unsigned lds0=(unsigned)(uintptr_t)shm;
  float*wsf=(float*)(shm+LDS_WS)+wid*64;
  const bf16*ksrc=Kh+(long)lane*DM+wid*8;
  const bf16*vsrc=Vh+(long)(16*(wid&3)+(lane>>2))*DM+(wid>>2)*32+(lane&3)*8;
  const unsigned kdst=lds0+LDS_K+wid*1024, vdst=lds0+LDS_V+wid*1024;
  #define DMA_K(t,slot) glds16(ksrc+(long)(t)*KVBLK*DM,(unsigned)__builtin_amdgcn_readfirstlane(kdst+(slot)))
  #define DMA_V(t,slot) glds16(vsrc+(long)(t)*KVBLK*DM,(unsigned)__builtin_amdgcn_readfirstlane(vdst+(slot)))
  const int vb0=(int)(lds0+LDS_V)+((lane>>4)&1)*32+(lane&3)*8+(4*hi+((lane&15)>>2))*64;
  const char*Kbase=shm+LDS_K; bf16x8 kf[8];
  const lds_cptr shm3=(lds_cptr)shm; const lds_cptr kp0=shm3+LDS_K+hi*1024+r32*16; const lds_cptr vp0=shm3+LDS_V+((lane>>4)&1)*32+(lane&3)*8+(4*hi+((lane&15)>>2))*64;
  const int NT=(q0+QB)/KVBLK;
  DMA_K(0,0);DMA_V(0,0);DMA_K(1,SLOTB);
  bf16x8 qr[4];
  #pragma unroll
  for(int d0=0;d0<4;++d0)qr[d0]=*reinterpret_cast<const bf16x8*>(&Qw[(long)r32*DM+d0*16+hi*8]);
  float mhat=0.f,l_reg=0.f;f32x16 o[2];o[0]=f32x16{};o[1]=f32x16{};f32x16 negm=f32x16{};asm volatile("":"+v"(negm));
  const int qrel=wid*QBLK+r32;
  #define CMASK(P0,P1,t) do{int jb_=(t)-(NT-4); if(jb_>=0)cmask(P0,P1,jb_,qrel,hi);}while(0)
  bool resc=false;
  #define START(P0,P1) do{ const float rm=rowmax(P0,P1); resc=false; \
    { const float dl=rm; mhat=fadd_s(mhat,dl); \
      _Pragma("unroll") for(int r=0;r<16;++r){P0[r]=fsub_s(P0[r],dl);P1[r]=fsub_s(P1[r],dl);} \
      _Pragma("unroll") for(int r=0;r<16;++r)negm[r]=-mhat; asm volatile("":"+v"(negm)); } \
    _Pragma("unroll") for(int r=0;r<16;++r)P0[r]=__builtin_amdgcn_exp2f(P0[r]); }while(0)
  #define RESC() do{ if(resc){ asm volatile("s_waitcnt lgkmcnt(0)":::"memory"); \
      _Pragma("unroll") for(int d_=0;d_<2;++d_) _Pragma("unroll") for(int r=0;r<16;++r)o[d_][r]*=wsf[crow(r,hi)]; } }while(0)
  f32x16 pA0,pA1,pB0,pB1;
  int sl_prev=0,sl_cur=0,sl_next=SLOTB;
  #define ROT() do{sl_prev=sl_cur;sl_cur=sl_next;sl_next=(sl_next==(NSLOT-1)*SLOTB)?0:sl_next+SLOTB;}while(0)
  DMA_K(2,2*SLOTB);
  WAIT_BAR(3);
  qkt(pA0,pA1,Kbase,qr,negm,r32,hi);asm volatile("s_nop 15\n\ts_nop 7":"+v"(pA0),"+v"(pA1));CMASK(pA0,pA1,0);
  START(pA0,pA1);
  _Pragma("unroll") for(int r=0;r<16;++r)pA1[r]=__builtin_amdgcn_exp2f(pA1[r]);
  WAIT_BAR(0);
  DMA_K(3,0);DMA_V(1,SLOTB);
  ROT();
  kload8(kf,kp0+sl_cur);
  WAIT_BAR(2);
  s16x4 vlo[8],vhi[8]; u32x4 pw0,pw1,pw2,pw3;
  #define PKW(P,B) cvtpk_s(P[B],P[B+1])
  #define PAF(k) __builtin_bit_cast(bf16x8,pw##k)
  #define VFR(i) (bf16x8){vlo[i][0],vlo[i][1],vlo[i][2],vlo[i][3],vhi[i][0],vhi[i][1],vhi[i][2],vhi[i][3]}
  #define PIN(x) asm volatile("":"+v"(x))
  #define MX3(a,b,c) __builtin_fmaxf(__builtin_fmaxf((a),(b)),(c))
  #define GAPA(MF,A0,A1,A2,A3,W0,W1,PW) do{ MF; sacc+=A0; sacc+=A1; sacc+=A2; sacc+=A3; PIN(sacc); W0; W1; PIN(PW); SBAR(); }while(0)
  #define EX(v) __builtin_amdgcn_exp2f(v)
  #define GAPB(MF,X,B) do{ MF; X[B]=EX(X[B]); X[B+1]=EX(X[B+1]); X[B+2]=EX(X[B+2]); X[B+3]=EX(X[B+3]); PIN(X); SBAR(); }while(0)
  #define VRD(i) do{ vlo[i]=vtr(vp_+(((i)>>2)*4096+((i)&3)*1024)); vhi[i]=vtr(vp_+(((i)>>2)*4096+((i)&3)*1024+512)); }while(0)
  #define KRD(G,j) do{ if(G){ kload2(kf,kp0+sl_next,j); SBAR(); } }while(0)
  #define STEP(C0,C1,P0,P1,t,GK,GV,GL) do{ SBAR(); \
    const lds_cptr vp_=vp0+sl_prev; \
    VRD(0); SBAR(); float sacc=(P0[0]+P0[1]); \
    GAPA(C0=__builtin_amdgcn_mfma_f32_32x32x16_bf16(kf[0],qr[0],negm,0,0,0), P0[2],P0[3],P0[4],P0[5],     pw0[0]=PKW(P0,0), pw0[1]=PKW(P0,2), pw0); \
    VRD(4); SBAR(); GAPA(C1=__builtin_amdgcn_mfma_f32_32x32x16_bf16(kf[1],qr[0],negm,0,0,0), P0[6],P0[7],P0[8],P0[9],     pw0[2]=PKW(P0,4), pw0[3]=PKW(P0,6), pw0); \
    VRD(1); SBAR(); GAPA(C0=__builtin_amdgcn_mfma_f32_32x32x16_bf16(kf[2],qr[1],C0,0,0,0),   P0[10],P0[11],P0[12],P0[13], pw1[0]=PKW(P0,8), pw1[1]=PKW(P0,10), pw1); \
    VRD(5); SBAR(); GAPA(C1=__builtin_amdgcn_mfma_f32_32x32x16_bf16(kf[3],qr[1],C1,0,0,0),   P0[14],P0[15],P1[0],P1[1],   pw1[2]=PKW(P0,12),pw1[3]=PKW(P0,14), pw1); \
    VRD(2); SBAR(); GAPA(C0=__builtin_amdgcn_mfma_f32_32x32x16_bf16(kf[4],qr[2],C0,0,0,0),   P1[2],P1[3],P1[4],P1[5],     pw2[0]=PKW(P1,0), pw2[1]=PKW(P1,2), pw2); \
    VRD(6); SBAR(); GAPA(C1=__builtin_amdgcn_mfma_f32_32x32x16_bf16(kf[5],qr[2],C1,0,0,0),   P1[6],P1[7],P1[8],P1[9],     pw2[2]=PKW(P1,4), pw2[3]=PKW(P1,6), pw2); \
    VRD(3); SBAR(); GAPA(C0=__builtin_amdgcn_mfma_f32_32x32x16_bf16(kf[6],qr[3],C0,0,0,0),   P1[10],P1[11],P1[12],P1[13], pw3[0]=PKW(P1,8), pw3[1]=PKW(P1,10), pw3); \
    VRD(7); SBAR(); GAPA(C1=__builtin_amdgcn_mfma_f32_32x32x16_bf16(kf[7],qr[3],C1,0,0,0),   P1[14],P1[15],0.f,0.f,       pw3[2]=PKW(P1,12),pw3[3]=PKW(P1,14), pw3); \
    l_reg+=sacc; \
    if(GK){DMA_K((t)+3,sl_cur);} if(GV){DMA_V((t)+1,sl_next);} \
    CMASK(C0,C1,t); \
    { float a=MX3(C0[0],C0[1],C1[0]),b=MX3(C0[2],C0[3],C1[1]); a=MX3(a,C1[2],C1[3]); \
      _Pragma("unroll") for(int r=4;r<16;r+=4){a=MX3(a,C0[r],C0[r+1]);b=MX3(b,C0[r+2],C0[r+3]);a=MX3(a,C1[r],C1[r+1]);b=MX3(b,C1[r+2],C1[r+3]);} \
      float rm=__builtin_fmaxf(a,b); { auto rr=__builtin_amdgcn_permlane32_swap(__float_as_uint(rm),__float_as_uint(rm),false,false); rm=__builtin_fmaxf(__uint_as_float(rr[0]),__uint_as_float(rr[1])); } \
      resc=false; \
      if(__builtin_expect(__any(rm>(float)THRL),0)){ const float dl=__builtin_fmaxf(rm,0.f); mhat+=dl; \
        _Pragma("unroll") for(int r=0;r<16;++r){C0[r]-=dl;C1[r]-=dl;} \
        _Pragma("unroll") for(int r=0;r<16;++r)negm[r]=-mhat; asm volatile("":"+v"(negm)); \
        const float f=__builtin_amdgcn_exp2f(-dl); l_reg*=f; if(hi==0)wsf[r32]=f; resc=true; } } \
    SBAR(); \
    GAPB(o[0]=__builtin_amdgcn_mfma_f32_32x32x16_bf16(PAF(0),VFR(0),o[0],0,0,0), C0,0); \
    GAPB(o[1]=__builtin_amdgcn_mfma_f32_32x32x16_bf16(PAF(0),VFR(4),o[1],0,0,0), C0,4); \
    KRD(GL,0); GAPB(o[0]=__builtin_amdgcn_mfma_f32_32x32x16_bf16(PAF(1),VFR(1),o[0],0,0,0), C0,8); \
    KRD(GL,1); GAPB(o[1]=__builtin_amdgcn_mfma_f32_32x32x16_bf16(PAF(1),VFR(5),o[1],0,0,0), C0,12); \
    KRD(GL,2); GAPB(o[0]=__builtin_amdgcn_mfma_f32_32x32x16_bf16(PAF(2),VFR(2),o[0],0,0,0), C1,0); \
    KRD(GL,3); GAPB(o[1]=__builtin_amdgcn_mfma_f32_32x32x16_bf16(PAF(2),VFR(6),o[1],0,0,0), C1,4); \
    GAPB(o[0]=__builtin_amdgcn_mfma_f32_32x32x16_bf16(PAF(3),VFR(3),o[0],0,0,0), C1,8); \
    GAPB(o[1]=__builtin_amdgcn_mfma_f32_32x32x16_bf16(PAF(3),VFR(7),o[1],0,0,0), C1,12); \
    }while(0)
  int t=1;
  #undef CMASK
  #define CMASK(P0,P1,t) do{}while(0)
  for(;t+5<NT;t+=2){
    STEP(pB0,pB1,pA0,pA1,t,true,true,true);     WAIT_BAR(2); RESC(); ROT();
    STEP(pA0,pA1,pB0,pB1,t+1,true,true,true);   WAIT_BAR(2); RESC(); ROT();
  }
  #undef CMASK
  #define CMASK(P0,P1,t) do{int jb_=(t)-(NT-4); if(jb_>=0)cmask(P0,P1,jb_,qrel,hi);}while(0)
  #define ENDW(tt) do{ if((tt)+3<NT){WAIT_BAR(2);} else if((tt)+2<NT){WAIT_BAR(1);} else {WAIT_BAR(0);} }while(0)
  for(;t+1<NT;t+=2){
    STEP(pB0,pB1,pA0,pA1,t,(t+3<NT),(t+1<NT),(t+1<NT));       ENDW(t);   RESC(); ROT();
    STEP(pA0,pA1,pB0,pB1,t+1,(t+4<NT),(t+2<NT),(t+2<NT));     ENDW(t+1); RESC(); ROT();
  }
  STEP(pB0,pB1,pA0,pA1,NT-1,false,false,false); RESC();
  { float sacc=pB0[0]+pB0[1]; _Pragma("unroll") for(int r=2;r<16;++r)sacc+=pB0[r]; _Pragma("unroll") for(int r=0;r<16;++r)sacc+=pB1[r]; l_reg+=sacc;
    pw0=(u32x4){PKW(pB0,0),PKW(pB0,2),PKW(pB0,4),PKW(pB0,6)};pw1=(u32x4){PKW(pB0,8),PKW(pB0,10),PKW(pB0,12),PKW(pB0,14)};pw2=(u32x4){PKW(pB1,0),PKW(pB1,2),PKW(pB1,4),PKW(pB1,6)};pw3=(u32x4){PKW(pB1,8),PKW(pB1,10),PKW(pB1,12),PKW(pB1,14)};
    SBAR(); pv(o,vb0+sl_cur,PAF(0),PAF(1),PAF(2),PAF(3)); }
  #undef PKW
  #undef PAF
  #undef VFR
  #undef PIN
  #undef MX3
  #undef GAPA
  #undef GAPB
  #undef EX
  #undef VRD
  #undef KRD
  #undef STEP
  #undef ENDW
  {auto rr=__builtin_amdgcn_permlane32_swap(__float_as_uint(l_reg),__float_as_uint(l_reg),false,false);l_reg=__uint_as_float(rr[0])+__uint_as_float(rr[1]);}
  if(hi==0)wsf[32+r32]=l_reg;asm volatile("s_waitcnt lgkmcnt(0)":::"memory");
  float rli[16];
  #pragma unroll
  for(int r=0;r<16;++r)rli[r]=__builtin_amdgcn_rcpf(wsf[32+crow(r,hi)]);
  bf16*Ow=O+(rowbase+q0+wid*QBLK)*OPITCH+ocol;
  { bf16*stg=(bf16*)(shm+LDS_OST)+wid*2048;
    #pragma unroll
    for(int r=0;r<16;++r){const int orow=crow(r,hi);
      #pragma unroll
      for(int d0=0;d0<2;++d0)stg[orow*64+d0*32+r32]=__float2bfloat16(o[d0][r]*rli[r]);}
    asm volatile("s_waitcnt lgkmcnt(0)":::"memory");
    #pragma unroll
    for(int i=0;i<4;++i){const int row=i*8+(lane>>3),ch=lane&7; const u32x4 v=*(const u32x4*)(stg+row*64+ch*8); ATTN_STORE16(Ow+(long)row*OPITCH+ch*8,v);} }
  asm volatile("s_waitcnt lgkmcnt(0)\n\ts_barrier":::"memory");
  #undef DMA_K
  #undef DMA_V
  #undef CMASK
  #undef START
  #undef RESC
  #undef ROT
}
constexpr int ATTN_LDS_BYTES=LDS_BYTES;
#undef SBAR
#undef WAIT_BAR
}
constexpr size_t MiB = 1u << 20;
constexpr size_t WS_CTL = 0, CTL_ZERO_BYTES = 1 * MiB;
constexpr size_t WS_WIN = 2 * MiB, WS_WOUT = 26 * MiB, WS_WQ = 34 * MiB, WS_WKV = 42 * MiB, WS_WO = 58 * MiB, WS_W1 = 66 * MiB, WS_W2 = 578 * MiB;
constexpr size_t WS_HN = 834 * MiB, WS_MN = 866 * MiB, WS_PROJ = 870 * MiB, WS_DT = 958 * MiB, WS_KVRAW = 959 * MiB, WS_KN = 967 * MiB;
constexpr size_t WS_YCAT = 971 * MiB, WS_O0 = 1003 * MiB, WS_O1 = 1019 * MiB, WS_H1 = 1035 * MiB, WS_H1B = 1099 * MiB, WS_PART1 = 1131 * MiB, WS_PARTQ = 1132 * MiB;
constexpr size_t WS_QRAW = 1133 * MiB, WS_P = 1165 * MiB, WS_VWT = 1181 * MiB, WS_H2 = 1197 * MiB, WS_HN3 = 1261 * MiB;
constexpr size_t WS_TOKOF = 1293 * MiB, WS_GATEOF = 1294 * MiB, WS_TOKE = 1295 * MiB, WS_TOKR = 1296 * MiB, WS_YG = 1297 * MiB;
constexpr size_t WS_H1F8 = 3368 * MiB  , WS_QF8 = 3384 * MiB  , WS_KN8 = 3400 * MiB  , WS_VF8 = 3402 * MiB  ;
constexpr size_t WS_P8 = 3404 * MiB  , WS_VWT8 = 3412 * MiB  ;
constexpr size_t WS_XG = 1320 * MiB  , WS_ACT = 1832 * MiB  , WS_Y = 2344 * MiB  , WS_END = 3420 * MiB;
constexpr int CW_BAR = 4096;
constexpr int CW_QATT = 12288;
constexpr int CW_CNT = 8192;
static_assert((CW_CNT + 64 * 32) * 4 <= (int)CTL_ZERO_BYTES, "CTL words inside the memset region");

constexpr int RING_OFF = 0, RING_BYTES = 131072;
constexpr int LDS_BYTES = 163840;
constexpr int MISC_OFF = 163840 - 1024;
constexpr int NWAVES = 8;

#define XB_TMO      128
#define XB_XCNT(j)  (256  + 64 * (j))
#define XB_XSUB(j)  (1280 + 64 * (j))
#define XB_XGEN(j)  (2304 + 64 * (j))
#define XB_TOP      3328
#define XB_TOPGEN   3392
#define XCD_BAR_WORDS 3456
#define XB_SPIN_CAP (1u << 20)

__device__ __forceinline__ unsigned xb_ld(unsigned* p)              { return __hip_atomic_load(p, __ATOMIC_RELAXED, __HIP_MEMORY_SCOPE_AGENT); }
__device__ __forceinline__ unsigned xb_add(unsigned* p, unsigned v) { return __hip_atomic_fetch_add(p, v, __ATOMIC_RELAXED, __HIP_MEMORY_SCOPE_AGENT); }
__device__ __forceinline__ unsigned xb_xcc_id() { return (unsigned)__builtin_amdgcn_s_getreg((3 << 11) | 20) & 0xFu; }
#define XB_SPIN(cond, bar) do { unsigned _sp = 0; while (cond) { __builtin_amdgcn_s_sleep(1); \
    if ((++_sp & 255u) == 0u) { if (xb_ld(&(bar)[XB_TMO])) break; if (_sp > XB_SPIN_CAP) { atomicAdd(&(bar)[XB_TMO], 1u); break; } } } } while (0)

struct XcdBarrier {
    unsigned* bar; unsigned x;
    volatile LAS unsigned* st;
};
__device__ __forceinline__ XcdBarrier xcd_barrier_post(unsigned* bar, volatile LAS unsigned* st) {
    XcdBarrier b; b.bar = bar; b.x = xb_xcc_id(); b.st = st;
    if (threadIdx.x == 0) (void)xb_add(&bar[XB_XCNT(b.x)], 1u);
    return b;
}
__device__ __forceinline__ void xcd_barrier_complete(unsigned* bar, unsigned x, unsigned& nloc, unsigned& nx) {
    const unsigned G = gridDim.x * gridDim.y * gridDim.z;
    unsigned sum, cnt, mine, sp = 0u;
    for (;;) {
        sum = 0u; cnt = 0u; mine = 0u;
#pragma unroll
        for (unsigned j = 0; j < 16; ++j) { const unsigned c = xb_ld(&bar[XB_XCNT(j)]); sum += c; cnt += (c > 0u) ? 1u : 0u; mine = (j == x) ? c : mine; }
        if (sum == G) break;
        __builtin_amdgcn_s_sleep(1);
        if ((++sp & 255u) == 0u) { if (xb_ld(&bar[XB_TMO])) break; if (sp > XB_SPIN_CAP) { atomicAdd(&bar[XB_TMO], 1u); break; } }
    }
    nloc = mine > 0u ? mine : 1u; nx = cnt > 0u ? cnt : 1u;
}
__device__ __forceinline__ void xcd_barrier(const XcdBarrier& b) {
    asm volatile("s_waitcnt vmcnt(0)" ::: "memory");
    __syncthreads();
    if (threadIdx.x == 0) {
        unsigned* bar = b.bar;
        __builtin_amdgcn_s_waitcnt(0);
        unsigned nloc = b.st[0], nx = b.st[1];
        if (nloc == 0u) { xcd_barrier_complete(bar, b.x, nloc, nx); b.st[0] = nloc; b.st[1] = nx; }
        const unsigned old = xb_add(&bar[XB_XSUB(b.x)], 1u);
        const unsigned gen = old / nloc;
        if (old + 1u == (gen + 1u) * nloc) {
            __builtin_amdgcn_fence(__ATOMIC_RELEASE, "agent");
            asm volatile("s_waitcnt vmcnt(0)" ::: "memory");
            const unsigned og = xb_add(&bar[XB_TOP], 1u);
            const unsigned tg = og / nx;
            if (og + 1u == (tg + 1u) * nx) xb_add(&bar[XB_TOPGEN], 1u);
            else XB_SPIN(xb_ld(&bar[XB_TOPGEN]) == tg, bar);
            __builtin_amdgcn_fence(__ATOMIC_ACQUIRE, "agent");
            xb_add(&bar[XB_XGEN(b.x)], 1u);
            asm volatile("s_waitcnt vmcnt(0)" ::: "memory");
        } else {
            XB_SPIN(xb_ld(&bar[XB_XGEN(b.x)]) == gen, bar);
            __builtin_amdgcn_fence(__ATOMIC_ACQUIRE, "agent");
            asm volatile("s_waitcnt vmcnt(0)" ::: "memory");
        }
    }
    __syncthreads();
}

struct Args { const float* in[32]; float* out; unsigned char* ws; int ph_lo, ph_hi; };
enum In { I_X = 0, I_MEM, I_GMIX, I_WIN, I_CONVW, I_CONVB, I_DTB, I_ALOG, I_DSKIP, I_SSDG, I_DAQG, I_DAKG, I_LQ1, I_LK1, I_LQ2, I_LK2, I_SUBG, I_WOUT, I_GXA, I_GMEM,
          I_WQ, I_WKV, I_XQG, I_XKG, I_WO, I_GFFN, I_RW, I_RB, I_W1, I_B1, I_W2, I_B2 };

struct ArgP {
    typedef const __attribute__((address_space(4))) char* kptr;
    DI const float* in(int i) const { kptr kp = (kptr)__builtin_amdgcn_kernarg_segment_ptr(); asm volatile("" : "+s"(kp)); return *(const float* const __attribute__((address_space(4)))*)(kp + 8 * i); }
    DI float* out() const { kptr kp = (kptr)__builtin_amdgcn_kernarg_segment_ptr(); asm volatile("" : "+s"(kp)); return *(float* const __attribute__((address_space(4)))*)(kp + 8 * 32); }
};
struct Frame {
    LAS unsigned char* lds;
    volatile LAS unsigned* MISC;
    unsigned* ctl;
    unsigned char* ws;
    int tid, lane, wave, vcu, G;
};

template <class DestRow>
DI void tr_item(const float* W, size_t ldw, int k0, int ncol0, int nvalid, const float* kscale, bf16_t* WT, int K, DestRow dr, LAS float* scr, int lane) {
    const int c = lane & 31;
#pragma unroll 8
    for (int i = 0; i < 32; ++i) { const int kk = 2 * i + (lane >> 5);
        float v = (c < nvalid) ? W[(size_t)(k0 + kk) * ldw + ncol0 + c] : 0.f;
        if (kscale) v *= kscale[k0 + kk];
        scr[kk * 33 + c] = v; }
    asm volatile("s_waitcnt lgkmcnt(0)" ::: "memory");
    const int c8 = lane & 7;
#pragma unroll
    for (int j = 0; j < 4; ++j) { const int n = (lane >> 3) + 8 * j; const LAS float* s = scr + (8 * c8) * 33 + n;
        u32x4 o; o.x = pk2(s[0 * 33], s[1 * 33]); o.y = pk2(s[2 * 33], s[3 * 33]); o.z = pk2(s[4 * 33], s[5 * 33]); o.w = pk2(s[6 * 33], s[7 * 33]);
        if (n < nvalid) *(u32x4*)(WT + (size_t)dr(ncol0 + n) * K + k0 + 8 * c8) = o; }
    asm volatile("s_waitcnt lgkmcnt(0)" ::: "memory");
}
template <class DestRow>
DI void tr_item_fp8(const float* W, size_t ldw, int k0, int ncol0, const float* kscale, unsigned char* WT, int K, DestRow dr, LAS float* scr, int lane) {
    const int c = lane & 31;
#pragma unroll 8
    for (int i = 0; i < 32; ++i) { const int kk = 2 * i + (lane >> 5); float v = W[(size_t)(k0 + kk) * ldw + ncol0 + c]; if (kscale) v *= kscale[k0 + kk]; scr[kk * 33 + c] = v; }
    asm volatile("s_waitcnt lgkmcnt(0)" ::: "memory");
    const int n = lane >> 1, hf = lane & 1; const LAS float* s = scr + (32 * hf) * 33 + n;
    unsigned w[8];
#pragma unroll
    for (int j = 0; j < 8; ++j) { unsigned x = 0u;
        x = __builtin_amdgcn_cvt_pk_fp8_f32(s[(4 * j) * 33] * 64.f, s[(4 * j + 1) * 33] * 64.f, x, false);
        x = __builtin_amdgcn_cvt_pk_fp8_f32(s[(4 * j + 2) * 33] * 64.f, s[(4 * j + 3) * 33] * 64.f, x, true); w[j] = x; }
    unsigned char* op = WT + (size_t)dr(ncol0 + n) * K + k0 + 32 * hf;
    *(u32x4*)op = (u32x4){w[0], w[1], w[2], w[3]}; *(u32x4*)(op + 16) = (u32x4){w[4], w[5], w[6], w[7]};
    asm volatile("s_waitcnt lgkmcnt(0)" ::: "memory");
}
DI int tileperm(int col) { const int o = col & 255; return (col & ~255) + 128 * ((o & 63) >> 5) + 32 * (o >> 6) + (o & 31); }
struct DrIdent { DI int operator()(int n) const { return n; } };
struct DrTile  { DI int operator()(int n) const { return tileperm(n); } };
struct DrWin   { DI int operator()(int n) const { const int pc = (n < 2560) ? n : (n < 2576 ? PC_DT + (n - 2560) : n - 16); return tileperm(pc); } };
struct DrW1    { DI int operator()(int n) const { const int half = n >> 11, j = n & 2047; return (j >> 7) * 256 + half * 128 + (j & 127); } };

template <bool FP8, class DestRow>
DI void cv_item(const float* W, size_t ldw, int k0, int ncol0, const float* kscale, float scale, void* WT, int kpitch, DestRow dr, LAS float* scr, int lane) {
    const int r = lane >> 3, c4 = (lane & 7) * 4;
    f32x4 v[16];
#pragma unroll
    for (int i = 0; i < 16; ++i) v[i] = *(const f32x4*)(W + (size_t)(k0 + 8 * i + r) * ldw + ncol0 + c4);
#pragma unroll
    for (int i = 0; i < 16; ++i) { f32x4 x = v[i] * scale; if (kscale) x = x * kscale[k0 + 8 * i + r]; *(LAS f32x4*)(scr + (8 * i + r) * 36 + c4) = x; }
    asm volatile("s_waitcnt lgkmcnt(0)" ::: "memory");
    const int n = lane & 31, hf = lane >> 5; const LAS float* s = scr + (64 * hf) * 36 + n;
    if constexpr (FP8) {
        unsigned w[16];
#pragma unroll
        for (int j = 0; j < 16; ++j) { unsigned x = 0u; x = __builtin_amdgcn_cvt_pk_fp8_f32(s[(4 * j) * 36], s[(4 * j + 1) * 36], x, false); x = __builtin_amdgcn_cvt_pk_fp8_f32(s[(4 * j + 2) * 36], s[(4 * j + 3) * 36], x, true); w[j] = x; }
        unsigned char* op = (unsigned char*)WT + (size_t)dr(ncol0 + n) * kpitch + k0 + 64 * hf;
#pragma unroll
        for (int j = 0; j < 4; ++j) *(u32x4*)(op + 16 * j) = (u32x4){w[4 * j], w[4 * j + 1], w[4 * j + 2], w[4 * j + 3]};
    } else {
        unsigned w[32];
#pragma unroll
        for (int j = 0; j < 32; ++j) w[j] = pk2(s[(2 * j) * 36], s[(2 * j + 1) * 36]);
        unsigned char* op = (unsigned char*)WT + (size_t)dr(ncol0 + n) * kpitch + (k0 + 64 * hf) * 2;
#pragma unroll
        for (int j = 0; j < 8; ++j) *(u32x4*)(op + 16 * j) = (u32x4){w[4 * j], w[4 * j + 1], w[4 * j + 2], w[4 * j + 3]};
    }
    asm volatile("s_waitcnt lgkmcnt(0)" ::: "memory");
}
DI void rms_row_to_bf16(const float* xrow, const float* g, bf16_t* orow, int lane) {
    const f32x4* xr = (const f32x4*)xrow + lane;
    f32x4 v[8]; float s = 0.f;
#pragma unroll
    for (int j = 0; j < 8; ++j) { v[j] = xr[64 * j]; s += (v[j].x * v[j].x + v[j].y * v[j].y) + (v[j].z * v[j].z + v[j].w * v[j].w); }
    const float rstd = 1.f / sqrtf(wave_sum(s) * (1.f / 2048.f) + EPS_);
    u32x2* o8 = (u32x2*)orow + lane;
#pragma unroll
    for (int j = 0; j < 8; ++j) { const f32x4 gg = ((const f32x4*)g)[lane + 64 * j];
        u32x2 o; o.x = pk2(v[j].x * rstd * gg.x, v[j].y * rstd * gg.y); o.y = pk2(v[j].z * rstd * gg.z, v[j].w * rstd * gg.w); o8[64 * j] = o; }
}

DI void p0_prologue(Frame& F, const ArgP& a) {
    LAS float* scr = (LAS float*)(F.lds + RING_OFF + F.wave * 16384);
    const int gw = F.vcu * NWAVES + F.wave, NGW = F.G * NWAVES;
    unsigned char* ws = F.ws;
    constexpr int I_A = 32 * 80, I_B = 32, I_C = 32 * 96, NITEMS = I_A + I_B + I_C;
    for (int it = gw; it < NITEMS; it += NGW) {
        int r = it;
        if (r < I_A) { tr_item(a.in(I_WIN), 5648, 64 * (r / 80), 32 * (r % 80), 32, nullptr, (bf16_t*)(ws + WS_WIN), 2048, DrWin(), scr, F.lane); continue; } r -= I_A;
        if (r < I_B) { tr_item(a.in(I_WIN), 5648, 64 * r, 2560, 16, nullptr, (bf16_t*)(ws + WS_WIN), 2048, DrWin(), scr, F.lane); continue; } r -= I_B;
        tr_item(a.in(I_WIN), 5648, 64 * (r / 96), 2576 + 32 * (r % 96), 32, nullptr, (bf16_t*)(ws + WS_WIN), 2048, DrWin(), scr, F.lane);
    }
    for (int m = gw; m < NTOK; m += NGW) rms_row_to_bf16(a.in(I_X) + (size_t)m * 2048, a.in(I_GMIX), (bf16_t*)(ws + WS_HN) + (size_t)m * 2048, F.lane);
    for (int m = gw; m < NB * MEMLEN; m += NGW) rms_row_to_bf16(a.in(I_MEM) + (size_t)m * 2048, a.in(I_GMEM), (bf16_t*)(ws + WS_MN) + (size_t)m * 2048, F.lane);
}
struct CvIt { const float* W; size_t ldw; const float* ks; unsigned char* WT; float scale; int k0, n0, kpitch, fp8, dr; };
DI CvIt cv_decode(int it, const ArgP& a, unsigned char* ws) {
    constexpr int J_WOUT = 16 * 64, J_WKV = 16 * 128, J_WQ = 16 * 64, J_WO = 16 * 64, J_W1 = 32 * 16 * 128;
    CvIt c; c.ks = nullptr; c.scale = 64.f; c.fp8 = 1; c.dr = 0; c.kpitch = 2048; c.ldw = 2048;
    int r = it;
    if (r < J_WOUT) { c.W = a.in(I_WOUT); c.k0 = 128 * (r / 64); c.n0 = 32 * (r % 64); c.WT = ws + WS_WOUT; c.scale = 1.f; c.fp8 = 0; c.kpitch = 4096; return c; } r -= J_WOUT;
    if (r < J_WKV) { c.W = a.in(I_WKV); c.ldw = 4096; c.k0 = 128 * (r / 128); c.n0 = 32 * (r % 128); c.WT = ws + WS_WKV; c.scale = 1.f; c.fp8 = 0; c.kpitch = 4096; c.dr = 1; return c; } r -= J_WKV;
    if (r < J_WQ) { c.W = a.in(I_WQ); c.ks = a.in(I_GXA); c.k0 = 128 * (r / 64); c.n0 = 32 * (r % 64); c.WT = ws + WS_WQ; return c; } r -= J_WQ;
    if (r < J_WO) { c.W = a.in(I_WO); c.k0 = 128 * (r / 64); c.n0 = 32 * (r % 64); c.WT = ws + WS_WO; return c; } r -= J_WO;
    if (r < J_W1) { const int e = r / (16 * 128), q = r % (16 * 128); c.W = a.in(I_W1) + (size_t)e * 2048 * 4096; c.ldw = 4096; c.k0 = 128 * (q / 128); c.n0 = 32 * (q % 128); c.WT = ws + WS_W1 + (size_t)e * 4096 * 2048; c.dr = 2; return c; } r -= J_W1;
    { const int e = r / (16 * 64), q = r % (16 * 64); c.W = a.in(I_W2) + (size_t)e * 2048 * 2048; c.k0 = 128 * (q / 64); c.n0 = 32 * (q % 64); c.WT = ws + WS_W2 + (size_t)e * 2048 * 2048; }
    return c;
}
DI void conv_share(Frame& F, const ArgP& a) {
    LAS float* scr = (LAS float*)(F.lds + F.wave * 18432);
    const int gw = F.vcu * NWAVES + F.wave, NGW = F.G * NWAVES, lane = F.lane;
    unsigned char* ws = F.ws;
    constexpr int NJ = 16 * 64 * 3 + 16 * 128 + 32 * 16 * 128 + 32 * 16 * 64;
    const int r = lane >> 3, c4 = (lane & 7) * 4, n = lane & 31, hf = lane >> 5;
    if (gw >= NJ) return;
    CvIt cur = cv_decode(gw, a, ws);
    f32x4 v[16];
#pragma unroll
    for (int i = 0; i < 16; ++i) v[i] = __builtin_nontemporal_load((const f32x4*)(cur.W + (size_t)(cur.k0 + 8 * i + r) * cur.ldw + cur.n0 + c4));
    for (int it = gw; it < NJ; it += NGW) {
#pragma unroll
        for (int i = 0; i < 16; ++i) { f32x4 x = v[i] * cur.scale; if (cur.ks) x = x * cur.ks[cur.k0 + 8 * i + r]; *(LAS f32x4*)(scr + (8 * i + r) * 36 + c4) = x; }
        const bool more = (it + NGW) < NJ; CvIt nxt = cur;
        if (more) { nxt = cv_decode(it + NGW, a, ws);
#pragma unroll
            for (int i = 0; i < 16; ++i) v[i] = __builtin_nontemporal_load((const f32x4*)(nxt.W + (size_t)(nxt.k0 + 8 * i + r) * nxt.ldw + nxt.n0 + c4)); }
        asm volatile("s_waitcnt lgkmcnt(0)" ::: "memory");
        const LAS float* s = scr + (64 * hf) * 36 + n;
        const int col = cur.n0 + n; const int drow = (cur.dr == 0) ? col : (cur.dr == 1 ? tileperm(col) : DrW1()(col));
        if (cur.fp8) {
            unsigned w[16];
#pragma unroll
            for (int j = 0; j < 16; ++j) { unsigned x = 0u; x = __builtin_amdgcn_cvt_pk_fp8_f32(s[(4 * j) * 36], s[(4 * j + 1) * 36], x, false); x = __builtin_amdgcn_cvt_pk_fp8_f32(s[(4 * j + 2) * 36], s[(4 * j + 3) * 36], x, true); w[j] = x; }
            unsigned char* op = cur.WT + (size_t)drow * cur.kpitch + cur.k0 + 64 * hf;
#pragma unroll
            for (int j = 0; j < 4; ++j) *(u32x4*)(op + 16 * j) = (u32x4){w[4 * j], w[4 * j + 1], w[4 * j + 2], w[4 * j + 3]};
        } else {
            unsigned w[32];
#pragma unroll
            for (int j = 0; j < 32; ++j) w[j] = pk2(s[(2 * j) * 36], s[(2 * j + 1) * 36]);
            unsigned char* op = cur.WT + (size_t)drow * cur.kpitch + (cur.k0 + 64 * hf) * 2;
#pragma unroll
            for (int j = 0; j < 8; ++j) *(u32x4*)(op + 16 * j) = (u32x4){w[4 * j], w[4 * j + 1], w[4 * j + 2], w[4 * j + 3]};
        }
        asm volatile("s_waitcnt lgkmcnt(0)" ::: "memory");
        cur = nxt;
    }
}

struct SchedP1 {
    int G, c; const unsigned char* ws; int lo, hi;
    DI bool next(int i, pg8::UnitD& u) const {
        const int L = lo + i * G + c; if (L >= hi) return false;
        u.rows = nullptr; u.nvalid = 0; u.lda = 4096u; u.ldb = 4096u; u.e = 0; u.x0 = 0;
        if (L < 32 * 23) { u.type = 0; u.pn = L / 32; u.pm = L % 32; u.A = (const char*)(ws + WS_HN) + (size_t)u.pm * 256 * 4096; u.B = (const char*)(ws + WS_WIN) + (size_t)u.pn * 256 * 4096; }
        else { const int q = L - 32 * 23; u.type = 1; u.pn = q / 4; u.pm = q % 4; u.A = (const char*)(ws + WS_MN) + (size_t)u.pm * 256 * 4096; u.B = (const char*)(ws + WS_WKV) + (size_t)u.pn * 256 * 4096; }
        return true;
    }
};
struct EpiP1 {
    static constexpr bool AFTER_DRAIN = false;
    bf16_t* proj; float* dtb; bf16_t* kvraw; const float* gq; const float* gk; unsigned char* vf8;
    DI void operator()(const f32x4 (&acc)[2][2][4][2], const pg8::UnitD& u, int wr, int wc, int fr, int fq) const {
        { int ln_ = threadIdx.x; asm volatile("" : "+v"(ln_)); fr = ln_ & 15; fq = (ln_ >> 4) & 3; }
        const int row0 = u.pm * 256 + wr * 64 + fr;
        const int cn = u.pn * 256 + 64 * wc + 8 * fq;
        if (u.type == 1 && u.pn >= 8) {
#pragma unroll
            for (int ai = 0; ai < 2; ++ai)
#pragma unroll
                for (int m = 0; m < 4; ++m) { unsigned char* rp = vf8 + (size_t)(row0 + ai * 128 + m * 16) * 2048 + (cn - 2048);
#pragma unroll
                    for (int bj = 0; bj < 2; ++bj) { const f32x4 v0 = acc[ai][bj][m][0] * 16.f, v1 = acc[ai][bj][m][1] * 16.f;
                        u32x2 w; w.x = __builtin_amdgcn_cvt_pk_fp8_f32(v0[0], v0[1], 0u, false); w.x = __builtin_amdgcn_cvt_pk_fp8_f32(v0[2], v0[3], w.x, true);
                        w.y = __builtin_amdgcn_cvt_pk_fp8_f32(v1[0], v1[1], 0u, false); w.y = __builtin_amdgcn_cvt_pk_fp8_f32(v1[2], v1[3], w.y, true);
                        *(u32x2*)(rp + 32 * bj) = w; } }
            return;
        }
        if (u.type == 1) {
#pragma unroll
            for (int ai = 0; ai < 2; ++ai)
#pragma unroll
                for (int m = 0; m < 4; ++m) { bf16_t* rp = kvraw + (size_t)(row0 + ai * 128 + m * 16) * 4096 + cn;
#pragma unroll
                    for (int bj = 0; bj < 2; ++bj) { const f32x4 v0 = acc[ai][bj][m][0], v1 = acc[ai][bj][m][1];
                        u32x4 w; w.x = pk2(v0[0], v0[1]); w.y = pk2(v0[2], v0[3]); w.z = pk2(v1[0], v1[1]); w.w = pk2(v1[2], v1[3]); *(u32x4*)(rp + 32 * bj) = w; } }
            return;
        }
        if (u.pn == 22) {
            if (wc == 0 && fq < 2) {
#pragma unroll
                for (int ai = 0; ai < 2; ++ai)
#pragma unroll
                    for (int m = 0; m < 4; ++m) { float* rp = dtb + (size_t)(row0 + ai * 128 + m * 16) * 16 + 8 * fq;
                        *(f32x4*)(rp) = acc[ai][0][m][0]; *(f32x4*)(rp + 4) = acc[ai][0][m][1]; }
            }
            return;
        }
        const bool isq = (u.pn >= 10 && u.pn < 14), isk = (u.pn >= 14 && u.pn < 18);
        if (!(isq || isk)) {
#pragma unroll
            for (int ai = 0; ai < 2; ++ai)
#pragma unroll
                for (int m = 0; m < 4; ++m) { bf16_t* rp = proj + (size_t)(row0 + ai * 128 + m * 16) * PP + cn;
#pragma unroll
                    for (int bj = 0; bj < 2; ++bj) { const f32x4 v0 = acc[ai][bj][m][0], v1 = acc[ai][bj][m][1];
                        u32x4 w; w.x = pk2(v0[0], v0[1]); w.y = pk2(v0[2], v0[3]); w.z = pk2(v1[0], v1[1]); w.w = pk2(v1[2], v1[3]); *(u32x4*)(rp + 32 * bj) = w; } }
            return;
        }
        const float* g = (isq ? gq : gk) + 8 * fq; const float sc = isq ? (0.125f * 1.4426950408889634f) : 1.f;
#pragma unroll
        for (int ai = 0; ai < 2; ++ai)
#pragma unroll
            for (int m = 0; m < 4; ++m) { bf16_t* rp = proj + (size_t)(row0 + ai * 128 + m * 16) * PP + cn;
                float ss = 0.f;
#pragma unroll
                for (int bj = 0; bj < 2; ++bj)
#pragma unroll
                    for (int n = 0; n < 2; ++n) { const f32x4 v = acc[ai][bj][m][n]; ss += (v[0] * v[0] + v[1] * v[1]) + (v[2] * v[2] + v[3] * v[3]); }
                ss += __shfl_xor(ss, 16); ss += __shfl_xor(ss, 32);
                const float rs = sc / sqrtf(ss * (1.f / 64.f) + EPS_);
#pragma unroll
                for (int bj = 0; bj < 2; ++bj) { const f32x4 v0 = acc[ai][bj][m][0] * rs * *(const f32x4*)(g + 32 * bj), v1 = acc[ai][bj][m][1] * rs * *(const f32x4*)(g + 32 * bj + 4);
                    u32x4 w; w.x = pk2(v0[0], v0[1]); w.y = pk2(v0[2], v0[3]); w.z = pk2(v1[0], v1[1]); w.w = pk2(v1[2], v1[3]); *(u32x4*)(rp + 32 * bj) = w; } }
    }
};

DI void kprep(Frame& F, const ArgP& a) {
    const int gw = F.vcu * NWAVES + F.wave, NGW = F.G * NWAVES;
    const bf16_t* kv = (const bf16_t*)(F.ws + WS_KVRAW); unsigned char* kn = (unsigned char*)(F.ws + WS_KN8);
    for (int it = gw; it < NB * MEMLEN * 4; it += NGW) {
        const int row = it >> 2, h = it & 3, b = row >> 8, key = row & 255;
        const u32x4 raw = *(const u32x4*)(kv + (size_t)row * 4096 + h * 512 + F.lane * 8);
        float v[8]; v[0] = bflo(raw.x); v[1] = bfhi(raw.x); v[2] = bflo(raw.y); v[3] = bfhi(raw.y); v[4] = bflo(raw.z); v[5] = bfhi(raw.z); v[6] = bflo(raw.w); v[7] = bfhi(raw.w);
        float ss = 0.f;
#pragma unroll
        for (int j = 0; j < 8; ++j) ss += v[j] * v[j];
        const float rs = 1.f / sqrtf(wave_sum(ss) * (1.f / 512.f) + EPS_) * 0.04419417382415922f * 128.f;
        const float* gk = a.in(I_XKG) + F.lane * 8; const float* gq = a.in(I_XQG) + F.lane * 8;
        u32x2 o; o.x = __builtin_amdgcn_cvt_pk_fp8_f32(v[0] * rs * gk[0] * gq[0], v[1] * rs * gk[1] * gq[1], 0u, false); o.x = __builtin_amdgcn_cvt_pk_fp8_f32(v[2] * rs * gk[2] * gq[2], v[3] * rs * gk[3] * gq[3], o.x, true);
        o.y = __builtin_amdgcn_cvt_pk_fp8_f32(v[4] * rs * gk[4] * gq[4], v[5] * rs * gk[5] * gq[5], 0u, false); o.y = __builtin_amdgcn_cvt_pk_fp8_f32(v[6] * rs * gk[6] * gq[6], v[7] * rs * gk[7] * gq[7], o.y, true);
        *(u32x2*)(kn + ((size_t)((b * 4 + h) * 256 + key)) * 512 + F.lane * 8) = o;
    }
}

constexpr int SP = 272;
constexpr int S_C = 0, S_BM = 34816, S_BT = 69632, S_XDT = 104448, S_HB = 121856, S_F = 139264, S_W = 155648  , SSD_LDS = 162048;
static_assert(SSD_LDS <= MISC_OFF, "SSD LDS map");
#define MFMA32(a, b, c) __builtin_amdgcn_mfma_f32_32x32x16_bf16((a), (b), (c), 0, 0, 0)
DI int crow(int r, int hi) { return (r & 3) + 8 * (r >> 2) + 4 * hi; }
DI bf16x8 ldfrag(LAS const unsigned char* base, int row, int kel) { return *(const LAS bf16x8*)(base + row * SP + kel * 2); }
DI float fexp(float x) { return __builtin_amdgcn_exp2f(x * 1.4426950408889634f); }
DI float fsilu(float x) { return x * __builtin_amdgcn_rcpf(1.f + fexp(-x)); }

DI void ssd_unit(Frame& F, const ArgP& a, int b, int hd) {
    LAS unsigned char* lds = F.lds;
    int tid = F.tid, lane = F.lane, r32 = lane & 31, hh = lane >> 5; const int wid = F.wave;
    LAS float* sdt = (LAS float*)(lds + S_F); LAS float* sac = sdt + 2048;
    const bf16_t* proj = (const bf16_t*)(F.ws + WS_PROJ); const float* dtbuf = (const float*)(F.ws + WS_DT); bf16_t* yg = (bf16_t*)(F.ws + WS_YG);
    const int g = hd >> 3;
    const float aneg = -__expf(a.in(I_ALOG)[hd]), dtb = a.in(I_DTB)[hd], dsk = a.in(I_DSKIP)[hd];
#pragma unroll
    for (int q = 0; q < 2; ++q) { const int c = 2 * wid + q; const size_t t0 = (size_t)b * SEQ_ + c * 128;
        const float x0 = dtbuf[(t0 + 2 * lane) * 16 + hd] + dtb, x1 = dtbuf[(t0 + 2 * lane + 1) * 16 + hd] + dtb;
        const float d0 = x0 > 20.f ? x0 : log1pf(__expf(x0)), d1 = x1 > 20.f ? x1 : log1pf(__expf(x1));
        const float a0 = d0 * aneg, a1 = d1 * aneg;
        float s = a0 + a1;
#pragma unroll
        for (int o = 1; o < 64; o <<= 1) { const float t = __shfl_up(s, o); if (lane >= o) s += t; }
        sdt[c * 128 + 2 * lane] = d0; sdt[c * 128 + 2 * lane + 1] = d1; sac[c * 128 + 2 * lane] = s - a1; sac[c * 128 + 2 * lane + 1] = s; }
    int seg = tid >> 5, cg = tid & 31, l0 = seg * 8;
    int colbc = (cg < 16) ? (1024 + g * 128 + cg * 8) : (1280 + g * 128 + (cg - 16) * 8);
    const int colx = hd * 64 + wid * 8; int lx = 2 * lane;
    LAS float* swt = (LAS float*)(lds + S_W);
    { const float* convw = a.in(I_CONVW); const float* convb = a.in(I_CONVB);
      if (tid < 320) { const int ci = tid;
          const int xc = (ci < 64) ? (hd * 64 + ci) : (ci < 192 ? (1024 + g * 128 + (ci - 64)) : (1280 + g * 128 + (ci - 192)));
#pragma unroll
          for (int k = 0; k < 4; ++k) swt[k * 320 + ci] = convw[k * 1536 + xc];
          swt[4 * 320 + ci] = convb[xc]; } }
    int cibc = 64 + cg * 8; const int cix = wid * 8;
    const char* pub = (const char*)F.ws; const unsigned pxb = (unsigned)(WS_PROJ + ((size_t)b * SEQ_ * PP + PC_XBC) * 2), zoff = (unsigned)(WS_CTL + 524288);
    u32x4 inbc[11], inx[5];
#define SSD_PREFETCH(c_) do { \
        int sd_ = l0; asm volatile("" : "+v"(sd_)); \
        _Pragma("unroll") for (int j = 0; j < 11; ++j) { const int tt = (c_) * 128 + sd_ - 3 + j; inbc[j] = *(const u32x4*)(pub + ((tt >= 0) ? pxb + (unsigned)(tt * PP + colbc) * 2u : zoff)); } } while (0)
    SSD_PREFETCH(0);
    f32x16 hT; for (int i = 0; i < 16; ++i) hT[i] = 0.f;
    const int nb = wid & 3, pb = wid >> 2;
    __syncthreads();
    for (int c = 0; c < 16; ++c) {
        { int t_ = threadIdx.x; asm volatile("" : "+v"(t_)); tid = t_; lane = t_ & 63; r32 = lane & 31; hh = lane >> 5; seg = t_ >> 5; cg = t_ & 31; l0 = seg * 8; lx = 2 * lane;
          colbc = (cg < 16) ? (1024 + g * 128 + cg * 8) : (1280 + g * 128 + (cg - 16) * 8); cibc = 64 + cg * 8; }
        const size_t t0 = (size_t)b * SEQ_ + c * 128;
        const LAS float* cdt = sdt + c * 128; const LAS float* cac = sac + c * 128;
        const float aend = cac[127];
#pragma unroll
        for (int j = 0; j < 5; ++j) { int sd_ = lx; asm volatile("" : "+v"(sd_)); const int tt = c * 128 + sd_ - 3 + j; inx[j] = *(const u32x4*)(pub + ((tt >= 0) ? pxb + (unsigned)(tt * PP + colx) * 2u : zoff)); }
        {
            LAS unsigned char* hbp = lds + S_HB + (32 * pb + r32) * SP + (32 * nb + 4 * hh) * 2;
#pragma unroll
            for (int q4 = 0; q4 < 4; ++q4) { u32x2 w; w.x = pk2(hT[4 * q4], hT[4 * q4 + 1]); w.y = pk2(hT[4 * q4 + 2], hT[4 * q4 + 3]); *(LAS u32x2*)(hbp + 16 * q4) = w; }
        }
        {
            float wbc[5][8];
#pragma unroll
            for (int k = 0; k < 5; ++k) { const f32x4 w0 = *(const LAS f32x4*)(swt + k * 320 + cibc), w1 = *(const LAS f32x4*)(swt + k * 320 + cibc + 4);
#pragma unroll
                for (int i = 0; i < 4; ++i) { wbc[k][i] = w0[i]; wbc[k][4 + i] = w1[i]; } }
#pragma unroll
            for (int hf = 0; hf < 2; ++hf) {
                __builtin_amdgcn_sched_barrier(0);
                float o[4][8];
#pragma unroll
                for (int j = 0; j < 4; ++j)
#pragma unroll
                    for (int i = 0; i < 8; ++i) { float s = wbc[4][i];
#pragma unroll
                        for (int k = 0; k < 4; ++k) { const unsigned wd = inbc[4 * hf + j + k][i >> 1]; s += wbc[k][i] * ((i & 1) ? bfhi(wd) : bflo(wd)); }
                        o[j][i] = fsilu(s); }
                const int lh = l0 + 4 * hf;
                if (cg < 16) {
                    const int n0 = cg * 8; float ev[4];
#pragma unroll
                    for (int j = 0; j < 4; ++j) { ev[j] = fexp(aend - cac[lh + j]);
                        u32x4 w1; w1.x = pk2(o[j][0], o[j][1]); w1.y = pk2(o[j][2], o[j][3]); w1.z = pk2(o[j][4], o[j][5]); w1.w = pk2(o[j][6], o[j][7]);
                        *(LAS u32x4*)(lds + S_BM + (lh + j) * SP + n0 * 2) = w1; }
#pragma unroll
                    for (int i = 0; i < 8; ++i) { u32x2 w2; w2.x = pk2(o[0][i] * ev[0], o[1][i] * ev[1]); w2.y = pk2(o[2][i] * ev[2], o[3][i] * ev[3]);
                        *(LAS u32x2*)(lds + S_BT + (n0 + i) * SP + lh * 2) = w2; }
                } else {
                    const int n0 = (cg - 16) * 8;
#pragma unroll
                    for (int j = 0; j < 4; ++j) { u32x4 w1; w1.x = pk2(o[j][0], o[j][1]); w1.y = pk2(o[j][2], o[j][3]); w1.z = pk2(o[j][4], o[j][5]); w1.w = pk2(o[j][6], o[j][7]);
                        *(LAS u32x4*)(lds + S_C + (lh + j) * SP + n0 * 2) = w1; }
                }
            }
        }
        __builtin_amdgcn_sched_barrier(0);
        {
            const float d0 = cdt[lx], d1 = cdt[lx + 1];
            float wx[5][8];
#pragma unroll
            for (int k = 0; k < 5; ++k) { const f32x4 w0 = *(const LAS f32x4*)(swt + k * 320 + cix), w1 = *(const LAS f32x4*)(swt + k * 320 + cix + 4);
#pragma unroll
                for (int i = 0; i < 4; ++i) { wx[k][i] = w0[i]; wx[k][4 + i] = w1[i]; } }
#pragma unroll
            for (int i = 0; i < 8; ++i) { float s0 = wx[4][i], s1 = wx[4][i];
#pragma unroll
                for (int k = 0; k < 4; ++k) { const unsigned w0 = inx[k][i >> 1], w1 = inx[k + 1][i >> 1];
                    s0 += wx[k][i] * ((i & 1) ? bfhi(w0) : bflo(w0)); s1 += wx[k][i] * ((i & 1) ? bfhi(w1) : bflo(w1)); }
                *(LAS unsigned*)(lds + S_XDT + (wid * 8 + i) * SP + lx * 2) = pk2(fsilu(s0) * d0, fsilu(s1) * d1); }
        }
        if (c < 15) SSD_PREFETCH(c + 1);
        __syncthreads();
        const int lb = wid >> 1;
        f32x16 xt[2];
#pragma unroll
        for (int q = 0; q < 2; ++q) { const int sb = 2 * (wid & 1) + q;
            for (int i = 0; i < 16; ++i) xt[q][i] = 0.f;
            if (sb <= lb) {
#pragma unroll
                for (int ks = 0; ks < 8; ++ks) xt[q] = MFMA32(ldfrag(lds + S_BM, 32 * sb + r32, 16 * ks + 8 * hh), ldfrag(lds + S_C, 32 * lb + r32, 16 * ks + 8 * hh), xt[q]);
            }
        }
        __syncthreads();
        {
            const int l = 32 * lb + r32; const float al = cac[l], ddl = dsk * __builtin_amdgcn_rcpf(cdt[l]);
#pragma unroll
            for (int q = 0; q < 2; ++q) { const int sb = 2 * (wid & 1) + q;
#pragma unroll
                for (int q4 = 0; q4 < 4; ++q4) { float mv[4];
#pragma unroll
                    for (int e = 0; e < 4; ++e) { const int s = 32 * sb + 8 * q4 + 4 * hh + e;
                        float v = 0.f;
                        if (s <= l) v = xt[q][4 * q4 + e] * fexp(al - cac[s]);
                        if (s == l) v += ddl;
                        mv[e] = v; }
                    u32x2 w; w.x = pk2(mv[0], mv[1]); w.y = pk2(mv[2], mv[3]);
                    *(LAS u32x2*)(lds + S_BM + l * SP + (32 * sb + 8 * q4 + 4 * hh) * 2) = w; }
            }
        }
        __syncthreads();
        {
            const int lb2 = wid & 3, pb2 = wid >> 2; const int l = 32 * lb2 + r32; const size_t tok = t0 + l;
            const int pc0 = hd * 64 + 32 * pb2 + 4 * hh;
            u32x2 zz[4];
#pragma unroll
            for (int q4 = 0; q4 < 4; ++q4) zz[q4] = *(const u32x2*)(proj + tok * PP + pc0 + 8 * q4);
            f32x16 y1, y2; for (int i = 0; i < 16; ++i) { y1[i] = 0.f; y2[i] = 0.f; }
            for (int ks = 0; ks < 2 * (lb2 + 1); ++ks) y1 = MFMA32(ldfrag(lds + S_XDT, 32 * pb2 + r32, 16 * ks + 8 * hh), ldfrag(lds + S_BM, 32 * lb2 + r32, 16 * ks + 8 * hh), y1);
#pragma unroll
            for (int ks = 0; ks < 8; ++ks) y2 = MFMA32(ldfrag(lds + S_HB, 32 * pb2 + r32, 16 * ks + 8 * hh), ldfrag(lds + S_C, 32 * lb2 + r32, 16 * ks + 8 * hh), y2);
            const float cd = fexp(aend);
#pragma unroll
            for (int i = 0; i < 16; ++i) hT[i] *= cd;
#pragma unroll
            for (int ks = 0; ks < 8; ++ks) hT = MFMA32(ldfrag(lds + S_BT, 32 * nb + r32, 16 * ks + 8 * hh), ldfrag(lds + S_XDT, 32 * pb + r32, 16 * ks + 8 * hh), hT);
            const float el = fexp(cac[l]);
#pragma unroll
            for (int q4 = 0; q4 < 4; ++q4) { float yv[4];
#pragma unroll
                for (int e = 0; e < 4; ++e) { const float z = (e & 1) ? bfhi(e < 2 ? zz[q4].x : zz[q4].y) : bflo(e < 2 ? zz[q4].x : zz[q4].y);
                    yv[e] = (y1[4 * q4 + e] + el * y2[4 * q4 + e]) * fsilu(z); }
                u32x2 w; w.x = pk2(yv[0], yv[1]); w.y = pk2(yv[2], yv[3]);
                *(u32x2*)(yg + tok * 1024 + pc0 + 8 * q4) = w; }
        }
        __syncthreads();
    }
#undef SSD_PREFETCH
}

DI void attn_phase_da(Frame& F) {
    const attn_body::bf16* proj = (const attn_body::bf16*)(F.ws + WS_PROJ);
    for (;;) {
        if (threadIdx.x == 0) F.MISC[120] = __hip_atomic_fetch_add(F.ctl + CW_QATT, 1u, __ATOMIC_RELAXED, __HIP_MEMORY_SCOPE_AGENT);
        __syncthreads();
        const int u = __builtin_amdgcn_readfirstlane((int)F.MISC[120]);
        __syncthreads();
        if (u >= 1024) break;
        const int qb = 7 - (u >> 7), combo = u & 127;
        const int half = combo & 1, j = (combo >> 1) & 1, h = (combo >> 2) & 7, b = combo >> 5;
        attn_body::bf16* O = (attn_body::bf16*)(F.ws + (j ? WS_O1 : WS_O0));
        attn_body::attn_unit<8>(b, PC_Q + (h * 2 + j) * 64, PC_V + h * 128 + half * 64, h * 128 + half * 64, qb, proj, proj + (PC_K - PC_Q), proj, O, (char*)F.lds);
    }
}

DI void p3_finalize(Frame& F, const ArgP& a) {
    const int gw = F.vcu * NWAVES + F.wave, NGW = F.G * NWAVES, lane = F.lane;
    bf16_t* ycat = (bf16_t*)(F.ws + WS_YCAT); const bf16_t* yg = (const bf16_t*)(F.ws + WS_YG); const bf16_t* o0 = (const bf16_t*)(F.ws + WS_O0); const bf16_t* o1 = (const bf16_t*)(F.ws + WS_O1);
    float l1 = a.in(I_LQ1)[lane] * a.in(I_LK1)[lane], l2 = a.in(I_LQ2)[lane] * a.in(I_LK2)[lane];
    const float lam = __expf(wave_sum(l1)) - __expf(wave_sum(l2)) + LAM_INIT;
    for (int m = gw; m < NTOK; m += NGW) {
        { bf16_t* yp = ycat + (size_t)m * 2048 + 16 * lane; const bf16_t* gp = yg + (size_t)m * 1024 + 16 * lane;
          const u32x4 r0 = *(const u32x4*)gp, r1 = *(const u32x4*)(gp + 8);
          float v[16]; v[0] = bflo(r0.x); v[1] = bfhi(r0.x); v[2] = bflo(r0.y); v[3] = bfhi(r0.y); v[4] = bflo(r0.z); v[5] = bfhi(r0.z); v[6] = bflo(r0.w); v[7] = bfhi(r0.w);
          v[8] = bflo(r1.x); v[9] = bfhi(r1.x); v[10] = bflo(r1.y); v[11] = bfhi(r1.y); v[12] = bflo(r1.z); v[13] = bfhi(r1.z); v[14] = bflo(r1.w); v[15] = bfhi(r1.w);
          float ss = 0.f;
#pragma unroll
          for (int i = 0; i < 16; ++i) ss += v[i] * v[i];
#pragma unroll
          for (int o = 1; o < 32; o <<= 1) ss += __shfl_xor(ss, o);
          const float rs = 1.f / sqrtf(ss * (1.f / 512.f) + EPS_);
          const float* g = a.in(I_SSDG) + 16 * lane;
          u32x4 w0, w1;
          w0.x = pk2(v[0] * rs * g[0], v[1] * rs * g[1]); w0.y = pk2(v[2] * rs * g[2], v[3] * rs * g[3]); w0.z = pk2(v[4] * rs * g[4], v[5] * rs * g[5]); w0.w = pk2(v[6] * rs * g[6], v[7] * rs * g[7]);
          w1.x = pk2(v[8] * rs * g[8], v[9] * rs * g[9]); w1.y = pk2(v[10] * rs * g[10], v[11] * rs * g[11]); w1.z = pk2(v[12] * rs * g[12], v[13] * rs * g[13]); w1.w = pk2(v[14] * rs * g[14], v[15] * rs * g[15]);
          *(u32x4*)yp = w0; *(u32x4*)(yp + 8) = w1; }
        { const bf16_t* p0 = o0 + (size_t)m * 1024 + 16 * lane; const bf16_t* p1 = o1 + (size_t)m * 1024 + 16 * lane;
          const u32x4 a0 = *(const u32x4*)p0, a1 = *(const u32x4*)(p0 + 8), b0 = *(const u32x4*)p1, b1 = *(const u32x4*)(p1 + 8);
          float v[16];
          v[0] = bflo(a0.x) - lam * bflo(b0.x); v[1] = bfhi(a0.x) - lam * bfhi(b0.x); v[2] = bflo(a0.y) - lam * bflo(b0.y); v[3] = bfhi(a0.y) - lam * bfhi(b0.y);
          v[4] = bflo(a0.z) - lam * bflo(b0.z); v[5] = bfhi(a0.z) - lam * bfhi(b0.z); v[6] = bflo(a0.w) - lam * bflo(b0.w); v[7] = bfhi(a0.w) - lam * bfhi(b0.w);
          v[8] = bflo(a1.x) - lam * bflo(b1.x); v[9] = bfhi(a1.x) - lam * bfhi(b1.x); v[10] = bflo(a1.y) - lam * bflo(b1.y); v[11] = bfhi(a1.y) - lam * bfhi(b1.y);
          v[12] = bflo(a1.z) - lam * bflo(b1.z); v[13] = bfhi(a1.z) - lam * bfhi(b1.z); v[14] = bflo(a1.w) - lam * bflo(b1.w); v[15] = bfhi(a1.w) - lam * bfhi(b1.w);
          float ss = 0.f;
#pragma unroll
          for (int i = 0; i < 16; ++i) ss += v[i] * v[i];
          ss += __shfl_xor(ss, 1); ss += __shfl_xor(ss, 2); ss += __shfl_xor(ss, 4);
          const float rs = 1.f / sqrtf(ss * (1.f / 128.f) + EPS_) * (1.f - LAM_INIT);
          const float* g = a.in(I_SUBG) + 16 * (lane & 7);
          u32x4 w0, w1;
          w0.x = pk2(v[0] * rs * g[0], v[1] * rs * g[1]); w0.y = pk2(v[2] * rs * g[2], v[3] * rs * g[3]); w0.z = pk2(v[4] * rs * g[4], v[5] * rs * g[5]); w0.w = pk2(v[6] * rs * g[6], v[7] * rs * g[7]);
          w1.x = pk2(v[8] * rs * g[8], v[9] * rs * g[9]); w1.y = pk2(v[10] * rs * g[10], v[11] * rs * g[11]); w1.z = pk2(v[12] * rs * g[12], v[13] * rs * g[13]); w1.w = pk2(v[14] * rs * g[14], v[15] * rs * g[15]);
          bf16_t* yp = ycat + (size_t)m * 2048 + 1024 + 16 * lane;
          *(u32x4*)yp = w0; *(u32x4*)(yp + 8) = w1; }
    }
}

struct SchedDense {
    int G, c, nM, nN; const char* A; const char* B; unsigned lda, ldb; int bdiv; size_t bstride;
    DI bool next(int i, pg8::UnitD& u) const {
        const int L = i * G + c; if (L >= nM * nN) return false;
        u.rows = nullptr; u.nvalid = 0; u.lda = lda; u.ldb = ldb; u.type = 0; u.e = 0; u.x0 = 0;
        u.pn = L / nM; u.pm = L % nM;
        u.A = A + (size_t)u.pm * 256 * lda; u.B = B + (size_t)u.pn * 256 * ldb + (size_t)(u.pm / bdiv) * bstride;
        return true;
    }
};
struct EpiResid {
    static constexpr bool AFTER_DRAIN = false;
    const float* base; float* out; bf16_t* outb; float* part; unsigned char* out8; float accscale;
    DI void operator()(const f32x4 (&acc)[2][2][4][2], const pg8::UnitD& u, int wr, int wc, int fr, int fq) const {
        { int ln_ = threadIdx.x; asm volatile("" : "+v"(ln_)); fr = ln_ & 15; fq = (ln_ >> 4) & 3; }
        const int row0 = u.pm * 256 + wr * 64 + fr, col0 = u.pn * 256 + wc * 32 + 8 * fq;
#pragma unroll
        for (int ai = 0; ai < 2; ++ai)
#pragma unroll
            for (int m = 0; m < 4; ++m) { const size_t row = (size_t)(row0 + ai * 128 + m * 16); float ss = 0.f;
#pragma unroll
                for (int bj = 0; bj < 2; ++bj) { const size_t idx = row * 2048 + col0 + bj * 128;
                    f32x4 v0 = acc[ai][bj][m][0] * accscale + *(const f32x4*)(base + idx), v1 = acc[ai][bj][m][1] * accscale + *(const f32x4*)(base + idx + 4);
                    *(f32x4*)(out + idx) = v0; *(f32x4*)(out + idx + 4) = v1;
                    if (out8) { u32x2 w; w.x = __builtin_amdgcn_cvt_pk_fp8_f32(v0[0] * 16.f, v0[1] * 16.f, 0u, false); w.x = __builtin_amdgcn_cvt_pk_fp8_f32(v0[2] * 16.f, v0[3] * 16.f, w.x, true);
                        w.y = __builtin_amdgcn_cvt_pk_fp8_f32(v1[0] * 16.f, v1[1] * 16.f, 0u, false); w.y = __builtin_amdgcn_cvt_pk_fp8_f32(v1[2] * 16.f, v1[3] * 16.f, w.y, true); *(u32x2*)(out8 + idx) = w; }
                    if (outb) { u32x4 w; w.x = pk2(v0[0], v0[1]); w.y = pk2(v0[2], v0[3]); w.z = pk2(v1[0], v1[1]); w.w = pk2(v1[2], v1[3]); *(u32x4*)(outb + idx) = w; }
                    ss += (v0[0] * v0[0] + v0[1] * v0[1]) + (v0[2] * v0[2] + v0[3] * v0[3]) + (v1[0] * v1[0] + v1[1] * v1[1]) + (v1[2] * v1[2] + v1[3] * v1[3]); }
                if (part) { ss += __shfl_xor(ss, 16); ss += __shfl_xor(ss, 32); if (fq == 0) part[row * 32 + u.pn * 4 + wc] = ss; } }
    }
};

struct EpiQ {
    static constexpr bool AFTER_DRAIN = false;
    unsigned char* out8; float* part;
    DI void operator()(const f32x4 (&acc)[2][2][4][2], const pg8::UnitD& u, int wr, int wc, int fr, int fq) const {
        { int ln_ = threadIdx.x; asm volatile("" : "+v"(ln_)); fr = ln_ & 15; fq = (ln_ >> 4) & 3; }
        const int row0 = u.pm * 256 + wr * 64 + fr, col0 = u.pn * 256 + wc * 32 + 8 * fq;
#pragma unroll
        for (int ai = 0; ai < 2; ++ai)
#pragma unroll
            for (int m = 0; m < 4; ++m) { const size_t row = (size_t)(row0 + ai * 128 + m * 16); float ss = 0.f;
#pragma unroll
                for (int bj = 0; bj < 2; ++bj) { const size_t idx = row * 2048 + col0 + bj * 128; const f32x4 v0 = acc[ai][bj][m][0] * (1.f / 1024.f), v1 = acc[ai][bj][m][1] * (1.f / 1024.f);
                    u32x2 w; w.x = __builtin_amdgcn_cvt_pk_fp8_f32(v0[0] * 16.f, v0[1] * 16.f, 0u, false); w.x = __builtin_amdgcn_cvt_pk_fp8_f32(v0[2] * 16.f, v0[3] * 16.f, w.x, true);
                    w.y = __builtin_amdgcn_cvt_pk_fp8_f32(v1[0] * 16.f, v1[1] * 16.f, 0u, false); w.y = __builtin_amdgcn_cvt_pk_fp8_f32(v1[2] * 16.f, v1[3] * 16.f, w.y, true); *(u32x2*)(out8 + idx) = w;
                    ss += (v0[0] * v0[0] + v0[1] * v0[1]) + (v0[2] * v0[2] + v0[3] * v0[3]) + (v1[0] * v1[0] + v1[1] * v1[1]) + (v1[2] * v1[2] + v1[3] * v1[3]); }
                ss += __shfl_xor(ss, 16); ss += __shfl_xor(ss, 32); if (fq == 0) part[row * 32 + u.pn * 4 + wc] = ss; }
    }
};

struct SchedXS {
    int G, c; const unsigned char* ws;
    DI bool next(int i, pg8::UnitD& u) const {
        const int L = i * G + c; if (L >= 256) return false;
        u.rows = nullptr; u.nvalid = 0; u.e = 0;
        const int q = L & 127, bh = q >> 3, t8 = q & 7, b = bh >> 2, h = bh & 3;
        u.pm = b; u.pn = h; u.x0 = t8;
        if (L < 128) { u.type = 0; u.lda = 2048u; u.ldb = 512u;
            u.A = (const char*)(ws + WS_QF8) + (size_t)(b * 2048 + t8 * 256) * 2048 + h * 512; u.B = (const char*)(ws + WS_KN8) + (size_t)(bh * 256) * 512; }
        else { u.type = 1; u.lda = 2048u; u.ldb = 2048u;
            u.A = (const char*)(ws + WS_WO) + (size_t)(t8 * 256) * 2048 + h * 512; u.B = (const char*)(ws + WS_VF8) + (size_t)(b * 256) * 2048 + h * 512; }
        return true;
    }
};
struct EpiXS {
    static constexpr bool AFTER_DRAIN = false;
    unsigned char* P; unsigned char* VWT; const float* part1; const float* partq; LAS float* red;
    DI void operator()(const f32x4 (&acc)[2][2][4][2], const pg8::UnitD& u, int wr, int wc, int fr, int fq) const {
        { int ln_ = threadIdx.x; asm volatile("" : "+v"(ln_)); fr = ln_ & 15; fq = (ln_ >> 4) & 3; }
        const int b = u.pm, h = u.pn, t8 = u.x0;
        const int col0 = wc * 32 + 8 * fq;
        if (u.type == 1) {
            unsigned char* Vu = VWT + ((size_t)b * 2048 + t8 * 256) * 1024 + h * 256;
#pragma unroll
            for (int ai = 0; ai < 2; ++ai)
#pragma unroll
                for (int m = 0; m < 4; ++m) { const unsigned rl = (unsigned)(ai * 128 + wr * 64 + m * 16 + fr);
#pragma unroll
                    for (int bj = 0; bj < 2; ++bj) { const f32x4 v0 = acc[ai][bj][m][0] * (32.f / 1024.f), v1 = acc[ai][bj][m][1] * (32.f / 1024.f);
                        u32x2 w; w.x = __builtin_amdgcn_cvt_pk_fp8_f32(v0[0], v0[1], 0u, false); w.x = __builtin_amdgcn_cvt_pk_fp8_f32(v0[2], v0[3], w.x, true);
                        w.y = __builtin_amdgcn_cvt_pk_fp8_f32(v1[0], v1[1], 0u, false); w.y = __builtin_amdgcn_cvt_pk_fp8_f32(v1[2], v1[3], w.y, true);
                        *(u32x2*)(Vu + (rl * 1024u + (unsigned)(bj * 128 + col0))) = w; } }
            return;
        }
        const size_t row0 = (size_t)b * 2048 + t8 * 256;
        const char* p1u = (const char*)(part1 + row0 * 32); const char* pqu = (const char*)(partq + row0 * 32 + h * 8); unsigned char* Pu = P + row0 * 1024 + h * 256;
        float rsc[2][4];
#pragma unroll
        for (int ai = 0; ai < 2; ++ai)
#pragma unroll
            for (int m = 0; m < 4; ++m) { const unsigned rl = (unsigned)(ai * 128 + wr * 64 + m * 16 + fr);
                const f32x4 p0 = *(const f32x4*)(p1u + (rl * 32u + (unsigned)fq * 8u) * 4u), p1 = *(const f32x4*)(p1u + (rl * 32u + (unsigned)fq * 8u + 4u) * 4u);
                float s1 = (p0[0] + p0[1]) + (p0[2] + p0[3]) + (p1[0] + p1[1]) + (p1[2] + p1[3]);
                const f32x2 pq = *(const f32x2*)(pqu + (rl * 32u + (unsigned)fq * 2u) * 4u);
                float sq = pq[0] + pq[1];
                s1 = quad_sum_16_32(s1); sq = quad_sum_16_32(sq);
                rsc[ai][m] = __builtin_amdgcn_rsqf(sq * (1.f / 512.f) + EPS_ * (s1 * (1.f / 2048.f) + EPS_)) * (1.4426950408889634f / 2048.f);
                float ps = 0.f;
#pragma unroll
                for (int bj = 0; bj < 2; ++bj)
#pragma unroll
                    for (int n = 0; n < 2; ++n)
#pragma unroll
                        for (int e = 0; e < 4; ++e) ps += __builtin_amdgcn_exp2f(fminf(acc[ai][bj][m][n][e] * rsc[ai][m], 100.f));
                ps = quad_sum_16_32(ps);
                if (fq == 0) red[rl * 4 + wc] = ps;
                __builtin_amdgcn_sched_barrier(0); }
        __syncthreads();
        { int ln_ = threadIdx.x; asm volatile("" : "+v"(ln_)); fr = ln_ & 15; fq = (ln_ >> 4) & 3; }
#pragma unroll
        for (int ai = 0; ai < 2; ++ai)
#pragma unroll
            for (int m = 0; m < 4; ++m) { const unsigned rl = (unsigned)(ai * 128 + wr * 64 + m * 16 + fr);
                const f32x4 t = *(const LAS f32x4*)(red + rl * 4); const float inv = 256.f * __builtin_amdgcn_rcpf((t[0] + t[1]) + (t[2] + t[3])); float rs = rsc[ai][m]; asm volatile("" : "+v"(rs));
#pragma unroll
                for (int bj = 0; bj < 2; ++bj) { float x[8];
#pragma unroll
                    for (int n = 0; n < 2; ++n)
#pragma unroll
                        for (int e = 0; e < 4; ++e) x[n * 4 + e] = __builtin_amdgcn_exp2f(fminf(acc[ai][bj][m][n][e] * rs, 100.f)) * inv;
                    u32x2 w; w.x = __builtin_amdgcn_cvt_pk_fp8_f32(x[0], x[1], 0u, false); w.x = __builtin_amdgcn_cvt_pk_fp8_f32(x[2], x[3], w.x, true);
                    w.y = __builtin_amdgcn_cvt_pk_fp8_f32(x[4], x[5], 0u, false); w.y = __builtin_amdgcn_cvt_pk_fp8_f32(x[6], x[7], w.y, true);
                    *(u32x2*)(Pu + (rl * 1024u + (unsigned)(bj * 128 + wc * 32 + 8 * fq))) = w; } }
        __syncthreads();
    }
};

constexpr int HNP = 2052;
DI void p8_route(Frame& F, const ArgP& a) {
    LAS float* s_hn = (LAS float*)F.lds; LAS float* s_part = (LAS float*)(F.lds + 16 * HNP * 4); LAS float* s_log = s_part + 8 * 16 * 32; LAS int* s_slot = (LAS int*)(s_log + 16 * 32);
    const float* h2 = (const float*)(F.ws + WS_H2); unsigned char* xg = (unsigned char*)(F.ws + WS_XG);
    float* gate_of = (float*)(F.ws + WS_GATEOF); int* tok_e = (int*)(F.ws + WS_TOKE);
    const float* rw = a.in(I_RW); const float* rb = a.in(I_RB); const float* g3 = a.in(I_GFFN);
    const int lane = F.lane, wave = F.wave, tid = F.tid, hh = lane >> 5;
    for (int task = F.vcu; task < NTOK / 16; task += F.G) {
        const int tb = task * 16;
#pragma unroll
        for (int q = 0; q < 2; ++q) { const int tl = 2 * wave + q; const size_t tok = (size_t)(tb + tl);
            const f32x4* xr = (const f32x4*)(h2 + tok * 2048) + lane;
            f32x4 v[8]; float s = 0.f;
#pragma unroll
            for (int j = 0; j < 8; ++j) { v[j] = xr[64 * j]; s += (v[j].x * v[j].x + v[j].y * v[j].y) + (v[j].z * v[j].z + v[j].w * v[j].w); }
            const float rstd = 1.f / sqrtf(wave_sum(s) * (1.f / 2048.f) + EPS_);
#pragma unroll
            for (int j = 0; j < 8; ++j) { const f32x4 gg = ((const f32x4*)g3)[lane + 64 * j]; const f32x4 y = v[j] * rstd * gg;
                *(LAS f32x4*)(s_hn + tl * HNP + (lane + 64 * j) * 4) = y; } }
        __syncthreads();
        {
            f32x16 acc; for (int i = 0; i < 16; ++i) acc[i] = 0.f;
            const LAS float* ap = s_hn + (lane & 15) * HNP + 256 * wave; const float* bp = rw + (size_t)(256 * wave + hh) * 32 + (lane & 31);
#pragma unroll 8
            for (int j = 0; j < 64; ++j) { const f32x4 a4 = *(const LAS f32x4*)(ap + 4 * j);
                const float b1 = bp[(size_t)(4 * j) * 32], b2 = bp[(size_t)(4 * j + 2) * 32];
                acc = __builtin_amdgcn_mfma_f32_32x32x2f32(hh ? a4.y : a4.x, b1, acc, 0, 0, 0);
                acc = __builtin_amdgcn_mfma_f32_32x32x2f32(hh ? a4.w : a4.z, b2, acc, 0, 0, 0); }
            LAS float* pp = s_part + wave * 512 + (lane & 31);
#pragma unroll
            for (int r = 0; r < 8; ++r) pp[crow(r, hh) * 32] = acc[r];
        }
        __syncthreads();
        { const int tt = tid >> 5, e = tid & 31; float s = rb[e];
#pragma unroll
          for (int w = 0; w < 8; ++w) s += s_part[w * 512 + tt * 32 + e];
          s_log[tt * 32 + e] = s; }
        __syncthreads();
        if (tid < 16) { const int tok = tb + tid; unsigned taken = 0u; float val[4]; int idx[4];
#pragma unroll
            for (int k = 0; k < 4; ++k) { float best = -INFINITY; int bi = 0;
                for (int e = 0; e < 32; ++e) { const float v = s_log[tid * 32 + e]; if (!((taken >> e) & 1u) && v > best) { best = v; bi = e; } }
                taken |= 1u << bi; val[k] = best; idx[k] = bi; }
            float ex[4], sum = 0.f;
#pragma unroll
            for (int k = 0; k < 4; ++k) { ex[k] = __expf(val[k] - val[0]); sum += ex[k]; }
#pragma unroll
            for (int k = 0; k < 4; ++k) { const int e = idx[k];
                const unsigned rank = __hip_atomic_fetch_add(F.ctl + CW_CNT + 64 * e, 1u, __ATOMIC_RELAXED, __HIP_MEMORY_SCOPE_AGENT);
                gate_of[e * 8192 + rank] = ex[k] / sum; tok_e[tok * 4 + k] = e * 8192 + (int)rank; s_slot[tid * 4 + k] = e * 8192 + (int)rank; } }
        __syncthreads();
#pragma unroll
        for (int q = 0; q < 2; ++q) { const int tl = 2 * wave + q;
            unsigned o[8];
#pragma unroll
            for (int j = 0; j < 8; ++j) { const f32x4 y = *(const LAS f32x4*)(s_hn + tl * HNP + (lane + 64 * j) * 4);
                unsigned w = 0u; w = __builtin_amdgcn_cvt_pk_fp8_f32(y.x * 4.f, y.y * 4.f, w, false); w = __builtin_amdgcn_cvt_pk_fp8_f32(y.z * 4.f, y.w * 4.f, w, true); o[j] = w; }
#pragma unroll
            for (int k = 0; k < 4; ++k) { unsigned* o4 = (unsigned*)(xg + (size_t)s_slot[tl * 4 + k] * 2048) + lane;
#pragma unroll
                for (int j = 0; j < 8; ++j) o4[64 * j] = o[j]; } }
        __syncthreads();
    }
}

DI void moe_tables(Frame& F) {
    if (F.tid == 0) { unsigned base = 0u;
        for (int e = 0; e < 32; ++e) { const unsigned c = F.ctl[CW_CNT + 64 * e], mt = (c + 255u) >> 8; F.MISC[16 + e] = c; F.MISC[48 + e] = base; F.MISC[80 + e] = mt; base += mt; }
        F.MISC[112] = base; }
    __syncthreads();
}
DI int ldsu(volatile LAS unsigned* p) { return __builtin_amdgcn_readfirstlane((int)*p); }
template <int NTN  >
struct SchedMoe {
    int G, c; const unsigned char* ws; volatile LAS unsigned* MISC;
    DI bool next(int i, pg8::UnitD& u) const {
        const int L = i * G + c; const int total = ldsu(MISC + 112) * NTN; if (L >= total) return false;
        int e = 0;
        for (int k = 0; k < 32; ++k) { if (L >= (ldsu(MISC + 48 + k) + ldsu(MISC + 80 + k)) * NTN) e = k + 1; }
        const int tb = ldsu(MISC + 48 + e), mte = ldsu(MISC + 80 + e), cnt = ldsu(MISC + 16 + e);
        const int local = L - tb * NTN, nt = local / mte, mt = local % mte;
        u.type = 0; u.e = e; u.pn = nt; u.pm = tb + mt; u.x0 = mt; u.lda = 2048u; u.ldb = 2048u;
        u.rows = nullptr; u.nvalid = cnt - mt * 256;
        if (NTN == 16) { u.A = (const char*)(ws + WS_XG) + ((size_t)e * 8192 + (size_t)mt * 256) * 2048;
            u.B = (const char*)(ws + WS_W1) + ((size_t)e * 4096 + (size_t)nt * 256) * 2048; }
        else { u.A = (const char*)(ws + WS_ACT) + ((size_t)e * 8192 + (size_t)mt * 256) * 2048;
            u.B = (const char*)(ws + WS_W2) + ((size_t)e * 2048 + (size_t)nt * 256) * 2048; }
        return true;
    }
};
struct EpiMoe1 {
    static constexpr bool AFTER_DRAIN = false;
    unsigned char* act; const float* b1;
    DI void operator()(const f32x4 (&acc)[2][2][4][2], const pg8::UnitD& u, int wr, int wc, int fr, int fq) const {
        { int ln_ = threadIdx.x; asm volatile("" : "+v"(ln_)); fr = ln_ & 15; fq = (ln_ >> 4) & 3; }
        const int j0 = u.pn * 128 + wc * 32 + 8 * fq;
        const float* bg = b1 + (size_t)u.e * 4096 + j0; const float* bu = bg + 2048;
        const f32x4 bg0 = *(const f32x4*)bg, bg1 = *(const f32x4*)(bg + 4), bu0 = *(const f32x4*)bu, bu1 = *(const f32x4*)(bu + 4);
#pragma unroll
        for (int ai = 0; ai < 2; ++ai)
#pragma unroll
            for (int m = 0; m < 4; ++m) { const size_t row = (size_t)u.e * 8192 + u.x0 * 256 + ai * 128 + wr * 64 + m * 16 + fr;
                float o[8];
#pragma unroll
                for (int n = 0; n < 2; ++n)
#pragma unroll
                    for (int e = 0; e < 4; ++e) { const float g = fminf(acc[ai][0][m][n][e] * (1.f / 256.f) + (n ? bg1[e] : bg0[e]), 7.f);
                        const float uu = fminf(fmaxf(acc[ai][1][m][n][e] * (1.f / 256.f) + (n ? bu1[e] : bu0[e]), -7.f), 7.f);
                        o[n * 4 + e] = g / (1.f + __expf(-1.702f * g)) * (uu + 1.f) * 4.f; }
                u32x2 w; w.x = __builtin_amdgcn_cvt_pk_fp8_f32(o[0], o[1], 0u, false); w.x = __builtin_amdgcn_cvt_pk_fp8_f32(o[2], o[3], w.x, true);
                w.y = __builtin_amdgcn_cvt_pk_fp8_f32(o[4], o[5], 0u, false); w.y = __builtin_amdgcn_cvt_pk_fp8_f32(o[6], o[7], w.y, true);
                *(u32x2*)(act + row * 2048 + j0) = w; }
    }
};
struct EpiMoe2 {
    static constexpr bool AFTER_DRAIN = false;
    bf16_t* y; const float* b2; const float* gate_of;
    DI void operator()(const f32x4 (&acc)[2][2][4][2], const pg8::UnitD& u, int wr, int wc, int fr, int fq) const {
        { int ln_ = threadIdx.x; asm volatile("" : "+v"(ln_)); fr = ln_ & 15; fq = (ln_ >> 4) & 3; }
        const int col0 = u.pn * 256 + wc * 32 + 8 * fq;
        const float* bp = b2 + (size_t)u.e * 2048 + col0;
#pragma unroll
        for (int ai = 0; ai < 2; ++ai)
#pragma unroll
            for (int m = 0; m < 4; ++m) { const int rl = ai * 128 + wr * 64 + m * 16 + fr; const size_t row = (size_t)u.e * 8192 + u.x0 * 256 + rl;
                const float gt = (rl < u.nvalid) ? gate_of[u.e * 8192 + u.x0 * 256 + rl] : 0.f;
#pragma unroll
                for (int bj = 0; bj < 2; ++bj) { const f32x4 v0 = (acc[ai][bj][m][0] * (1.f / 256.f) + *(const f32x4*)(bp + bj * 128)) * gt, v1 = (acc[ai][bj][m][1] * (1.f / 256.f) + *(const f32x4*)(bp + bj * 128 + 4)) * gt;
                    u32x4 w; w.x = pk2(v0[0], v0[1]); w.y = pk2(v0[2], v0[3]); w.z = pk2(v1[0], v1[1]); w.w = pk2(v1[2], v1[3]);
                    *(u32x4*)(y + row * 2048 + col0 + bj * 128) = w; } }
    }
};

DI void p11_combine(Frame& F, const ArgP& a) {
    const int gw = F.vcu * NWAVES + F.wave, NGW = F.G * NWAVES, lane = F.lane;
    const float* h2 = (const float*)(F.ws + WS_H2); const bf16_t* y = (const bf16_t*)(F.ws + WS_Y);
    const int* tok_e = (const int*)(F.ws + WS_TOKE);
    for (int t = gw; t < NTOK; t += NGW) {
        size_t yrow[4];
#pragma unroll
        for (int k = 0; k < 4; ++k) yrow[k] = (size_t)tok_e[t * 4 + k] * 2048;
#pragma unroll
        for (int j = 0; j < 8; ++j) { const int c = (lane + 64 * j) * 4;
            f32x4 v = *(const f32x4*)(h2 + (size_t)t * 2048 + c);
#pragma unroll
            for (int k = 0; k < 4; ++k) { const u32x2 w = *(const u32x2*)(y + yrow[k] + c); v.x += bflo(w.x); v.y += bfhi(w.x); v.z += bflo(w.y); v.w += bfhi(w.y); }
            *(f32x4*)(a.out() + (size_t)t * 2048 + c) = v; }
    }
}

#ifndef MK_PER_PHASE
#define MK_PER_PHASE 0
#endif
#ifndef MK_LAST_PHASE
#define MK_LAST_PHASE 12
#endif
constexpr int N_PHASES = MK_LAST_PHASE;

__global__ void __launch_bounds__(NWAVES * 64, 2) mega_fwd(Args args_) {
    const ArgP args{};
    extern __shared__ __attribute__((aligned(16))) unsigned char lds_raw[];
    Frame F;
    F.lds = (LAS unsigned char*)lds_raw;
    F.MISC = (volatile LAS unsigned*)(F.lds + MISC_OFF);
    F.tid = threadIdx.x; F.lane = F.tid & 63; F.wave = __builtin_amdgcn_readfirstlane(F.tid >> 6);
    F.G = gridDim.x; { const int bx = blockIdx.x; F.vcu = (F.G % 8 == 0) ? (bx % 8) * (F.G / 8) + bx / 8 : bx; }
    F.ws = args_.ws; F.ctl = (unsigned*)(args_.ws + WS_CTL);
    for (int u = F.tid; u < 256; u += NWAVES * 64) F.MISC[u] = 0u;
    __syncthreads();
    XcdBarrier bar; bar.bar = F.ctl + CW_BAR; bar.x = 0; bar.st = nullptr;
    const int lo = args_.ph_lo, hi = args_.ph_hi;
    if (hi - lo > 1) bar = xcd_barrier_post(F.ctl + CW_BAR, F.MISC + 8);
#ifndef MK_PHASE_MASK
#define MK_PHASE_MASK 0xFFFF
#endif
#define IN(k) (((MK_PHASE_MASK >> (k)) & 1) && lo <= (k) && (k) < hi)
#define SEAM(k) do { if (IN(k) && IN((k) + 1)) xcd_barrier(bar); } while (0)
#define FRESH() do { int t_ = threadIdx.x; asm volatile("" : "+v"(t_)); F.tid = t_; F.lane = t_ & 63; F.wave = __builtin_amdgcn_readfirstlane(t_ >> 6); } while (0)
    unsigned char* ws = args_.ws;

    if (IN(0)) { FRESH(); p0_prologue(F, args); }
    SEAM(0);
    if (IN(1)) { FRESH();
        const bool conv_first = (F.vcu & 1) == 0;
        if (conv_first) { conv_share(F, args); __syncthreads(); }
        SchedP1 S{F.G, F.vcu, ws, 0, 32 * 23};
        EpiP1 E{(bf16_t*)(ws + WS_PROJ), (float*)(ws + WS_DT), (bf16_t*)(ws + WS_KVRAW), args.in(I_DAQG), args.in(I_DAKG), (unsigned char*)(ws + WS_VF8)};
        pg8::gemm_phase<EpiP1, SchedP1, false, true>(F.lds + RING_OFF, 32, S, E);
        if (!conv_first) { __syncthreads(); conv_share(F, args); }
    }
    SEAM(1);
    if (IN(2)) { FRESH();
        if ((F.vcu & 3) == 1) {
            SchedP1 S{(F.G + 3) >> 2, F.vcu >> 2, ws, 32 * 23, 32 * 23 + 64};
            EpiP1 E{(bf16_t*)(ws + WS_PROJ), (float*)(ws + WS_DT), (bf16_t*)(ws + WS_KVRAW), args.in(I_DAQG), args.in(I_DAKG), (unsigned char*)(ws + WS_VF8)};
            pg8::gemm_phase<EpiP1, SchedP1, false, true>(F.lds + RING_OFF, 32, S, E);
            __syncthreads();
        }
        if ((F.vcu & 3) == 0) { for (int u = F.vcu >> 2; u < 64; u += (F.G + 3) >> 2) ssd_unit(F, args, u >> 4, u & 15); }
        __syncthreads();
        attn_phase_da(F);
    }
    SEAM(2);
    if (IN(3)) { FRESH(); kprep(F, args); p3_finalize(F, args); }
    SEAM(3);
    if (IN(4)) { FRESH();
        SchedDense S{F.G, F.vcu, 32, 8, (const char*)(ws + WS_YCAT), (const char*)(ws + WS_WOUT), 4096u, 4096u, 1 << 30, 0};
#if MK_LAST_PHASE == 5
        EpiResid E{args.in(I_X), args_.out, nullptr, nullptr, nullptr, 1.f};
#else
        EpiResid E{args.in(I_X), (float*)(ws + WS_H1), nullptr, (float*)(ws + WS_PART1), (unsigned char*)(ws + WS_H1F8), 1.f};
#endif
        pg8::gemm_phase<EpiResid, SchedDense, false, true>(F.lds + RING_OFF, 32, S, E);
    }
    SEAM(4);
    if (IN(5)) { FRESH();
        SchedDense S{F.G, F.vcu, 32, 8, (const char*)(ws + WS_H1F8), (const char*)(ws + WS_WQ), 2048u, 2048u, 1 << 30, 0};
        EpiQ E{(unsigned char*)(ws + WS_QF8), (float*)(ws + WS_PARTQ)};
        pg8::gemm_phase<EpiQ, SchedDense, false, true, true>(F.lds + RING_OFF, 16, S, E);
    }
    SEAM(5);
    if (IN(6)) { FRESH();
        SchedXS S{F.G, F.vcu, ws};
        EpiXS E{(unsigned char*)(ws + WS_P8), (unsigned char*)(ws + WS_VWT8), (const float*)(ws + WS_PART1), (const float*)(ws + WS_PARTQ), (LAS float*)(F.lds + RING_BYTES)};
        pg8::gemm_phase<EpiXS, SchedXS, false, true, true>(F.lds + RING_OFF, 4, S, E);
    }
    SEAM(6);
    if (IN(7)) { FRESH();
        SchedDense S{F.G, F.vcu, 32, 8, (const char*)(ws + WS_P8), (const char*)(ws + WS_VWT8), 1024u, 1024u, 8, (size_t)2048 * 1024};
#if MK_LAST_PHASE == 8
        EpiResid E{(const float*)(ws + WS_H1), args_.out, nullptr, nullptr, nullptr, 1.f / 8192.f};
#else
        EpiResid E{(const float*)(ws + WS_H1), (float*)(ws + WS_H2), nullptr, nullptr, nullptr, 1.f / 8192.f};
#endif
        pg8::gemm_phase<EpiResid, SchedDense, false, true, true>(F.lds + RING_OFF, 8, S, E);
    }
    SEAM(7);
    if (IN(8)) { FRESH(); p8_route(F, args); }
    SEAM(8);
    if (IN(9)) { FRESH();
        moe_tables(F);
        SchedMoe<16> S{F.G, F.vcu, ws, F.MISC};
        EpiMoe1 E{(unsigned char*)(ws + WS_ACT), args.in(I_B1)};
        pg8::gemm_phase<EpiMoe1, SchedMoe<16>, false, true, true>(F.lds + RING_OFF, 16, S, E);
    }
    SEAM(9);
    if (IN(10)) { FRESH();
        moe_tables(F);
        SchedMoe<8> S{F.G, F.vcu, ws, F.MISC};
        EpiMoe2 E{(bf16_t*)(ws + WS_Y), args.in(I_B2), (const float*)(ws + WS_GATEOF)};
        pg8::gemm_phase<EpiMoe2, SchedMoe<8>, false, true, true>(F.lds + RING_OFF, 16, S, E);
    }
    SEAM(10);
    if (IN(11)) { FRESH(); p11_combine(F, args); }
#undef IN
#undef SEAM
}

extern "C" void kernel_launch(void* const* d_in, const int* in_sizes, int n_in, void* d_out, int out_size, void* d_ws, size_t ws_size, hipStream_t stream) {
    static int grid = 0;
    if (grid == 0) {
        if (n_in != 32 || out_size != NTOK * 2048 || ws_size < WS_END) { fprintf(stderr, "kernel_launch: unexpected shapes (n_in %d out %d ws %zu); nothing launched\n", n_in, out_size, ws_size); grid = -1; return; }
        int dev = 0, cus = 0, per_cu = 0;
        if (hipGetDevice(&dev) != hipSuccess || hipDeviceGetAttribute(&cus, hipDeviceAttributeMultiprocessorCount, dev) != hipSuccess) { grid = -1; return; }
        if (hipFuncSetAttribute((const void*)mega_fwd, hipFuncAttributeMaxDynamicSharedMemorySize, LDS_BYTES) != hipSuccess) { fprintf(stderr, "kernel_launch: hipFuncSetAttribute failed\n"); grid = -1; return; }
        if (hipOccupancyMaxActiveBlocksPerMultiprocessor(&per_cu, (const void*)mega_fwd, NWAVES * 64, LDS_BYTES) != hipSuccess || per_cu < 1) { fprintf(stderr, "kernel_launch: occupancy query says %d\n", per_cu); }
        (void)hipGetLastError();
        if (cus < 256) { fprintf(stderr, "kernel_launch: needs 256 CUs, found %d; nothing launched\n", cus); grid = -1; return; }
        grid = 256;
    }
    if (grid < 0) return;
    if (hipMemsetAsync((char*)d_ws + WS_CTL, 0, CTL_ZERO_BYTES, stream) != hipSuccess) return;
    Args a{};
    for (int i = 0; i < 32; ++i) a.in[i] = (const float*)d_in[i];
    a.out = (float*)d_out; a.ws = (unsigned char*)d_ws;
#if MK_PER_PHASE
    for (int p = 0; p < N_PHASES; ++p) { a.ph_lo = p; a.ph_hi = p + 1; hipLaunchKernelGGL(mega_fwd, dim3(grid), dim3(NWAVES * 64), LDS_BYTES, stream, a); }
#else
    a.ph_lo = 0; a.ph_hi = N_PHASES;
    hipLaunchKernelGGL(mega_fwd, dim3(grid), dim3(NWAVES * 64), LDS_BYTES, stream, a);
#ifdef MK_PROBE_LO
    for (int p = MK_PROBE_LO; p < MK_PROBE_HI; ++p) { a.ph_lo = p; a.ph_hi = p + 1; hipLaunchKernelGGL(mega_fwd, dim3(grid), dim3(NWAVES * 64), LDS_BYTES, stream, a); }
#endif
#endif
}
```

```cpp
#define MK_PER_PHASE 0
#define MK_LAST_PHASE 12
#include <hip/hip_runtime.h>
#include <hip/hip_bf16.h>
#include <cstdio>
#include <cstdint>
#include <cmath>

#define GAS __attribute__((address_space(1)))
#define LAS __attribute__((address_space(3)))
typedef unsigned short bf16_t;
typedef short bf16x8 __attribute__((ext_vector_type(8)));
typedef float f32x2 __attribute__((ext_vector_type(2)));
typedef float f32x4 __attribute__((ext_vector_type(4)));
typedef float f32x16 __attribute__((ext_vector_type(16)));
typedef unsigned u32x2 __attribute__((ext_vector_type(2)));
typedef unsigned u32x4 __attribute__((ext_vector_type(4)));
typedef __bf16 bf16x2_t __attribute__((ext_vector_type(2)));

#define DI __device__ __forceinline__
DI unsigned pk2(float lo, float hi) { f32x2 v = {lo, hi}; bf16x2_t b = __builtin_convertvector(v, bf16x2_t); return __builtin_bit_cast(unsigned, b); }
DI float bflo(unsigned u) { return __uint_as_float(u << 16); }
DI float bfhi(unsigned u) { return __uint_as_float(u & 0xffff0000u); }
DI float bf2f(bf16_t h) { return __uint_as_float(((unsigned)h) << 16); }
DI float wave_sum(float v) {
#pragma unroll
    for (int o = 1; o < 64; o <<= 1) v += __shfl_xor(v, o);
    return v;
}
DI float quad_sum_16_32(float v) {
    int l_ = threadIdx.x; asm volatile("" : "+v"(l_));
    const int a16 = ((l_ ^ 16) & 63) << 2, a32 = ((l_ ^ 32) & 63) << 2;
    v += __builtin_bit_cast(float, __builtin_amdgcn_ds_bpermute(a16, __builtin_bit_cast(int, v)));
    v += __builtin_bit_cast(float, __builtin_amdgcn_ds_bpermute(a32, __builtin_bit_cast(int, v)));
    return v;
}
DI float siluf(float x) { return x / (1.f + __expf(-x)); }

constexpr int DM_ = 2048, NB = 4, SEQ_ = 2048, NTOK = NB * SEQ_;
constexpr int PP = 5632;
constexpr int PC_XBC = 1024, PC_Q = 2560, PC_K = 3584, PC_V = 4608, PC_DT = 5632;
constexpr int WIN_ROWS = 5888;
constexpr int NEXP = 32, MEMLEN = 256;
constexpr float EPS_ = 1e-6f;
constexpr float LAM_INIT = 0.2f;

namespace pg8 {
constexpr int BM = 256, BK = 64, HALF = 128, HTB = HALF * BK * 2  , STAGE_BYTES = 8 * HTB;
DI int lds_byte(int r, int c) { const int st = (r >> 4) * 2 + (c >> 5), rr = r & 15, cc = c & 31, ob = rr * 64 + cc * 2; return st * 1024 + (ob ^ (((ob >> 9) & 1) << 5)); }
DI void stage_rc(int b, int& R, int& C) { const int st = b / 1024, sb = b % 1024, swz = sb ^ (((sb >> 9) & 1) << 5); R = (st >> 1) * 16 + swz / 64; C = (st & 1) * 32 + (swz % 64) / 2; }
DI int perm32(int rho) { const int n = rho >> 4, i = rho & 15; return 8 * (i >> 2) + 4 * n + (i & 3); }

struct UnitD {
    const char* A; const char* B;
    const int* rows;
    unsigned lda, ldb;
    int nvalid;
    int type, pm, pn, e, x0;
};
typedef int v8i_t __attribute__((ext_vector_type(8)));
DI v8i_t cat8(bf16x8 lo, bf16x8 hi) { typedef int v4i_t __attribute__((ext_vector_type(4))); const v4i_t a = __builtin_bit_cast(v4i_t, lo), b = __builtin_bit_cast(v4i_t, hi); return (v8i_t){a[0], a[1], a[2], a[3], b[0], b[1], b[2], b[3]}; }
DI void dense_voff(unsigned lda, unsigned ldb, int tid, unsigned (&vA)[2], unsigned (&vB)[2]) {
#pragma unroll
    for (int i = 0; i < 2; ++i) { int R, C; stage_rc(tid * 16 + i * 8192, R, C); const int Rb = (R & ~31) + perm32(R & 31);
        vA[i] = (unsigned)R * lda + (unsigned)C * 2u; vB[i] = (unsigned)Rb * ldb + (unsigned)C * 2u; }
}
DI void gather_voff(const UnitD& u, int tid, unsigned (&gA)[2][2]) {
#pragma unroll
    for (int i = 0; i < 2; ++i) { int R, C; stage_rc(tid * 16 + i * 8192, R, C);
#pragma unroll
        for (int h = 0; h < 2; ++h) { const int ra = h * 128 + R; const unsigned rowA = (ra < u.nvalid) ? (unsigned)u.rows[ra] : 0u; gA[h][i] = rowA * u.lda + (unsigned)C * 2u; } }
}

template <class Epi, class Sched, bool GATHER, bool ALIGN_EPI, bool FP8 = false>
DI void gemm_phase(LAS unsigned char* lds, int nt, const Sched& S, const Epi& E) {

    const int tid = threadIdx.x, wid = __builtin_amdgcn_readfirstlane(tid >> 6), lane = tid & 63, wr = wid >> 2, wc = wid & 3, fr = lane & 15, fq = lane >> 4;
    const size_t kstep = (size_t)(BK * 2);
    const unsigned ldsb = (unsigned)__builtin_amdgcn_readfirstlane((int)((unsigned)(uintptr_t)lds + (unsigned)wid * 1024u));
    const int aoff = lds_byte(wr * 64 + fr, fq * 8), boff = lds_byte(wc * 32 + fr, fq * 8);
#define PG8_SA(b, h) (((b) * 2 + (h)) * HTB)
#define PG8_SB(b, h) ((4 + (b) * 2 + (h)) * HTB)
#define PG8_STAGE(bufoff, gbase, voff) do { _Pragma("unroll") for (int _i = 0; _i < 2; ++_i) { unsigned keep_; \
        asm volatile("s_mov_b32 %0, m0\n\ts_mov_b32 m0, %3\n\ts_nop 0\n\tglobal_load_lds_dwordx4 %1, %2\n\ts_mov_b32 m0, %0" \
                     : "=&s"(keep_) : "v"((voff)[_i]), "s"((const char*)(gbase)), "s"(ldsb + (unsigned)((bufoff) + _i * 8192)) : "memory"); } } while (0)
#define PG8_STA(bufoff, gbase, h, HS, GA) do { if constexpr (GATHER) { PG8_STAGE(bufoff, gbase, GA[h]); } else { PG8_STAGE(bufoff, (gbase) + (h) * (HS), vA); } } while (0)
#define PG8_STB(bufoff, gbase, h, HS) PG8_STAGE(bufoff, (gbase) + (h) * (HS), vB)
typedef int v4i_t __attribute__((ext_vector_type(4)));
#define PG8_LDA(dst, b, h) do { _Pragma("unroll") for (int m = 0; m < 4; ++m) { if constexpr (FP8) { \
            const v4i_t lo_ = *(const LAS v4i_t*)(lds + PG8_SA(b, h) + aoff + m * 2048), hi_ = *(const LAS v4i_t*)(lds + PG8_SA(b, h) + aoff + m * 2048 + 1024); \
            dst##8[m] = __builtin_shufflevector(lo_, hi_, 0, 1, 2, 3, 4, 5, 6, 7); } \
        else { _Pragma("unroll") for (int k = 0; k < 2; ++k) dst[m][k] = *(const LAS bf16x8*)(lds + PG8_SA(b, h) + aoff + m * 2048 + k * 1024); } } } while (0)
#define PG8_LDB(dst, b, h) do { _Pragma("unroll") for (int n = 0; n < 2; ++n) { if constexpr (FP8) { \
            const v4i_t lo_ = *(const LAS v4i_t*)(lds + PG8_SB(b, h) + boff + n * 2048), hi_ = *(const LAS v4i_t*)(lds + PG8_SB(b, h) + boff + n * 2048 + 1024); \
            dst##8[n] = __builtin_shufflevector(lo_, hi_, 0, 1, 2, 3, 4, 5, 6, 7); } \
        else { _Pragma("unroll") for (int k = 0; k < 2; ++k) dst[n][k] = *(const LAS bf16x8*)(lds + PG8_SB(b, h) + boff + n * 2048 + k * 1024); } } } while (0)
#define PG8_MMA(ai, bj, At, Bt) do { __builtin_amdgcn_s_setprio(1); _Pragma("unroll") for (int m = 0; m < 4; ++m) _Pragma("unroll") for (int n = 0; n < 2; ++n) { \
        if constexpr (FP8) { acc[ai][bj][m][n] = __builtin_amdgcn_mfma_scale_f32_16x16x128_f8f6f4(Bt##8[n], At##8[m], acc[ai][bj][m][n], 0, 0, 0, 0x7f7f7f7f, 0, 0x7f7f7f7f); } \
        else { _Pragma("unroll") for (int k = 0; k < 2; ++k) acc[ai][bj][m][n] = __builtin_amdgcn_mfma_f32_16x16x32_bf16(Bt[n][k], At[m][k], acc[ai][bj][m][n], 0, 0, 0); } } \
        __builtin_amdgcn_s_setprio(0); } while (0)
#define PG8_WAIT_V(n) asm volatile("s_waitcnt vmcnt(" #n ")" ::: "memory")
#define PG8_WAIT_L(n) asm volatile("s_waitcnt lgkmcnt(" #n ")" ::: "memory")
#define PG8_BAR __builtin_amdgcn_s_barrier()
#define PG8_SCHED __builtin_amdgcn_sched_barrier(0)
#define PG8_ITER(A1P, A2P, B2P, HA2, HB2, GA2) do { \
        const char* a3p_ = (A2P) + kstep; const char* b3p_ = (B2P) + kstep; \
        PG8_LDB(B0, 0, 0); PG8_LDB(B1, 0, 1); PG8_SCHED; PG8_LDA(At, 0, 0); PG8_STA(PG8_SA(1, 1), (A1P), 1, hsA, gA); \
        PG8_WAIT_V(8); PG8_WAIT_L(0); PG8_BAR; PG8_MMA(0, 0, At, B0); PG8_MMA(0, 1, At, B1); PG8_BAR; PG8_SCHED; \
        PG8_LDA(At, 0, 1); PG8_STB(PG8_SB(0, 0), (B2P), 0, HB2); PG8_STB(PG8_SB(0, 1), (B2P), 1, HB2); PG8_STA(PG8_SA(0, 0), (A2P), 0, HA2, GA2); \
        PG8_WAIT_V(8); PG8_WAIT_L(0); PG8_BAR; PG8_MMA(1, 0, At, B0); PG8_MMA(1, 1, At, B1); PG8_BAR; PG8_SCHED; \
        PG8_LDB(B0, 1, 0); PG8_LDB(B1, 1, 1); PG8_SCHED; PG8_LDA(At, 1, 0); PG8_STA(PG8_SA(0, 1), (A2P), 1, HA2, GA2); \
        PG8_WAIT_V(8); PG8_WAIT_L(0); PG8_BAR; PG8_MMA(0, 0, At, B0); PG8_MMA(0, 1, At, B1); PG8_BAR; PG8_SCHED; \
        PG8_LDA(At, 1, 1); PG8_STB(PG8_SB(1, 0), b3p_, 0, HB2); PG8_STB(PG8_SB(1, 1), b3p_, 1, HB2); PG8_STA(PG8_SA(1, 0), a3p_, 0, HA2, GA2); \
        PG8_WAIT_V(8); PG8_WAIT_L(0); PG8_BAR; PG8_MMA(1, 0, At, B0); PG8_MMA(1, 1, At, B1); PG8_BAR; PG8_SCHED; \
    } while (0)
    UnitD cur, nxt; int ui = 0;
    if (!S.next(0, cur)) return;
    f32x4 acc[2][2][4][2];
#pragma unroll
    for (int a = 0; a < 2; ++a)
#pragma unroll
        for (int b = 0; b < 2; ++b)
#pragma unroll
            for (int m = 0; m < 4; ++m)
#pragma unroll
                for (int n = 0; n < 2; ++n) acc[a][b][m][n] = (f32x4){0.f, 0.f, 0.f, 0.f};
    bf16x8 At[4][2], B0[2][2], B1[2][2]; v8i_t At8[4], B08[2], B18[2];
    unsigned vA[2], vB[2], gA[2][2], ngA[2][2];
    dense_voff(cur.lda, cur.ldb, tid, vA, vB);
    if constexpr (GATHER) gather_voff(cur, tid, gA);
    const char* cA = cur.A; const char* cB = cur.B;
    size_t hsA = GATHER ? 0 : (size_t)cur.lda * HALF, hsB = (size_t)cur.ldb * HALF;
    PG8_STB(PG8_SB(0, 0), cB, 0, hsB); PG8_STB(PG8_SB(0, 1), cB, 1, hsB); PG8_STA(PG8_SA(0, 0), cA, 0, hsA, gA); PG8_STA(PG8_SA(0, 1), cA, 1, hsA, gA);
    if (wr == 1) PG8_BAR;
    PG8_WAIT_V(2); PG8_BAR;
    PG8_STB(PG8_SB(1, 0), cB + kstep, 0, hsB); PG8_STA(PG8_SA(1, 0), cA + kstep, 0, hsA, gA); PG8_STB(PG8_SB(1, 1), cB + kstep, 1, hsB);
    PG8_WAIT_V(6); PG8_BAR;
    for (;;) {
        const bool has_next = S.next(ui + 1, nxt);
        const char* nA = cA; const char* nB = cB; size_t nhsA = hsA, nhsB = hsB;
        if (has_next) { nA = nxt.A; nB = nxt.B; nhsA = GATHER ? 0 : (size_t)nxt.lda * HALF; nhsB = (size_t)nxt.ldb * HALF; }
        if constexpr (GATHER) {
            if (has_next) gather_voff(nxt, tid, ngA);
            else {
#pragma unroll
                for (int h = 0; h < 2; ++h)
#pragma unroll
                    for (int i = 0; i < 2; ++i) ngA[h][i] = gA[h][i];
            }
        }
#pragma unroll 1
        for (int t = 0; t < nt; t += 2) {
            const bool last = (t == nt - 2);
            const char* a2 = last ? nA : cA + (size_t)(t + 2) * kstep; const char* b2 = last ? nB : cB + (size_t)(t + 2) * kstep;
            const size_t hA2 = last ? nhsA : hsA, hB2 = last ? nhsB : hsB;
            unsigned g2[2][2];
            if constexpr (GATHER) {
#pragma unroll
                for (int h = 0; h < 2; ++h)
#pragma unroll
                    for (int i = 0; i < 2; ++i) g2[h][i] = last ? ngA[h][i] : gA[h][i];
            }
            PG8_ITER(cA + (size_t)(t + 1) * kstep, a2, b2, hA2, hB2, g2);
        }
        if constexpr (ALIGN_EPI) { if (wr == 0) PG8_BAR; }
        if constexpr (!Epi::AFTER_DRAIN) { E(acc, cur, wr, wc, fr, fq); }
        if (!has_next) break;
#pragma unroll
        for (int a = 0; a < 2; ++a)
#pragma unroll
            for (int b = 0; b < 2; ++b)
#pragma unroll
                for (int m = 0; m < 4; ++m)
#pragma unroll
                    for (int n = 0; n < 2; ++n) acc[a][b][m][n] = (f32x4){0.f, 0.f, 0.f, 0.f};
        cur = nxt; cA = nA; cB = nB; hsA = nhsA; hsB = nhsB; ++ui;
        if constexpr (GATHER) {
#pragma unroll
            for (int h = 0; h < 2; ++h)
#pragma unroll
                for (int i = 0; i < 2; ++i) gA[h][i] = ngA[h][i];
        }
        if constexpr (ALIGN_EPI) { if (wr == 1) PG8_BAR; }
    }
    PG8_WAIT_V(0);
    if constexpr (!ALIGN_EPI) { if (wr == 0) PG8_BAR; }
    PG8_BAR;
    if constexpr (Epi::AFTER_DRAIN) { E.fused(acc, cur, wr, wc, fr, fq, lds, wid, lane); }
#undef PG8_SA
#undef PG8_SB
#undef PG8_STAGE
#undef PG8_STA
#undef PG8_STB
#undef PG8_LDA
#undef PG8_LDB
#undef PG8_MMA
#undef PG8_WAIT_V
#undef PG8_WAIT_L
#undef PG8_BAR
#undef PG8_SCHED
#undef PG8_ITER
}
}
namespace attn_body {
using bf16=__hip_bfloat16;
using bf16x8=__attribute__((ext_vector_type(8)))short;
using s16x4=__attribute__((ext_vector_type(4)))short;
using f32x16=__attribute__((ext_vector_type(16)))float;
using u32x4=__attribute__((ext_vector_type(4)))unsigned;
constexpr int BATCH=4,SEQ=2048,D=64,DM=5632,OPITCH=1024;
constexpr int NW=8,QBLK=32,QB=QBLK*NW,KVBLK=64,NQB=SEQ/QB;
constexpr int ATTN_UNIT_ROWS=QB;
__device__ __forceinline__ int crow(int r,int hi){return (r&3)+8*(r>>2)+4*hi;}
#define SBAR() __builtin_amdgcn_sched_barrier(0)
__device__ __forceinline__ void cmask(f32x16&p0,f32x16&p1,int jb,int qrel,int hi){
  const float NEG=-INFINITY; int kb=64*jb+4*hi;
  #pragma unroll
  for(int r=0;r<16;++r){int kv=kb+(r&3)+8*(r>>2); if(kv>qrel)p0[r]=NEG; if(kv+32>qrel)p1[r]=NEG;}
}

constexpr int NSLOT=3, SLOTB=8192;
constexpr int LDS_K=0, LDS_V=NSLOT*SLOTB, LDS_WS=2*NSLOT*SLOTB, LDS_OST=LDS_WS+NW*64*4, LDS_BYTES=LDS_OST+NW*4096;
constexpr float C2=0.125f*1.4426950408889634f;
__device__ __forceinline__ void glds16(const void*gsrc,unsigned lds_dst){unsigned keep;
  asm volatile("s_mov_b32 %0, m0\n\ts_mov_b32 m0, %2\n\ts_nop 0\n\tglobal_load_lds_dwordx4 %1, off\n\ts_mov_b32 m0, %0":"=&s"(keep):"v"(gsrc),"s"(lds_dst):"memory");}
__device__ __forceinline__ float max3f(float a,float b,float c){float r;asm("v_max3_f32 %0, %1, %2, %3":"=v"(r):"v"(a),"v"(b),"v"(c));return r;}
__device__ __forceinline__ float max2f(float a,float b){float r;asm("v_max_f32_e32 %0, %1, %2":"=v"(r):"v"(a),"v"(b));return r;}
__device__ __forceinline__ float fadd_s(float a,float b){float r;asm("v_add_f32_e32 %0, %1, %2":"=v"(r):"v"(a),"v"(b));return r;}
__device__ __forceinline__ float fsub_s(float a,float b){float r;asm("v_sub_f32_e32 %0, %1, %2":"=v"(r):"v"(a),"v"(b));return r;}
typedef float f32x2_t __attribute__((ext_vector_type(2))); typedef __bf16 bf16x2_t __attribute__((ext_vector_type(2)));
__device__ __forceinline__ unsigned cvtpk_s(float lo,float hi){f32x2_t v={lo,hi};bf16x2_t b=__builtin_convertvector(v,bf16x2_t);return __builtin_bit_cast(unsigned,b);}
#define WAIT_BAR(N) asm volatile("s_waitcnt vmcnt(" #N ") lgkmcnt(0)\n\ts_barrier":::"memory")

__device__ __forceinline__ void qkt(f32x16&p0,f32x16&p1,const char*Kslot,const bf16x8*qr,const f32x16&negm,int r32,int hi){
  const char*kb=Kslot+hi*1024+r32*16;
  #pragma unroll
  for(int d0=0;d0<4;++d0){
    const bf16x8 b0=*reinterpret_cast<const bf16x8*>(kb+d0*2048);
    const bf16x8 b1=*reinterpret_cast<const bf16x8*>(kb+d0*2048+512);
    if(d0==0){p0=__builtin_amdgcn_mfma_f32_32x32x16_bf16(b0,qr[0],negm,0,0,0);p1=__builtin_amdgcn_mfma_f32_32x32x16_bf16(b1,qr[0],negm,0,0,0);}
    else{p0=__builtin_amdgcn_mfma_f32_32x32x16_bf16(b0,qr[d0],p0,0,0,0);p1=__builtin_amdgcn_mfma_f32_32x32x16_bf16(b1,qr[d0],p1,0,0,0);}}
}
typedef __attribute__((address_space(3))) const char* lds_cptr;
typedef short v4i16_t __attribute__((ext_vector_type(4)));
__device__ __forceinline__ void kload8(bf16x8*kf,lds_cptr kp){
  kf[0]=*(const __attribute__((address_space(3))) bf16x8*)(kp);      kf[1]=*(const __attribute__((address_space(3))) bf16x8*)(kp+512);
  kf[2]=*(const __attribute__((address_space(3))) bf16x8*)(kp+2048); kf[3]=*(const __attribute__((address_space(3))) bf16x8*)(kp+2560);
  kf[4]=*(const __attribute__((address_space(3))) bf16x8*)(kp+4096); kf[5]=*(const __attribute__((address_space(3))) bf16x8*)(kp+4608);
  kf[6]=*(const __attribute__((address_space(3))) bf16x8*)(kp+6144); kf[7]=*(const __attribute__((address_space(3))) bf16x8*)(kp+6656);
}
__device__ __forceinline__ void kload2(bf16x8*kf,lds_cptr kp,int j){ kf[2*j]=*(const __attribute__((address_space(3))) bf16x8*)(kp+j*2048); kf[2*j+1]=*(const __attribute__((address_space(3))) bf16x8*)(kp+j*2048+512); }
__device__ __forceinline__ s16x4 vtr(lds_cptr p){ return __builtin_bit_cast(s16x4,__builtin_amdgcn_ds_read_tr16_b64_v4i16((__attribute__((address_space(3))) v4i16_t*)p)); }
__device__ __forceinline__ float rowmax(const f32x16&p0,const f32x16&p1){
  float a=max3f(p0[0],p0[1],p1[0]),b=max3f(p0[2],p0[3],p1[1]);a=max3f(a,p1[2],p1[3]);
  #pragma unroll
  for(int r=4;r<16;r+=4){a=max3f(a,p0[r],p0[r+1]);b=max3f(b,p0[r+2],p0[r+3]);a=max3f(a,p1[r],p1[r+1]);b=max3f(b,p1[r+2],p1[r+3]);}
  const float m=max2f(a,b);
  auto rr=__builtin_amdgcn_permlane32_swap(__float_as_uint(m),__float_as_uint(m),false,false);
  return max2f(__uint_as_float(rr[0]),__uint_as_float(rr[1]));
}
__device__ __forceinline__ void pv(f32x16*o,int vb,bf16x8 pa0,bf16x8 pa1,bf16x8 pa2,bf16x8 pa3){
  #pragma unroll
  for(int d0=0;d0<2;++d0){s16x4 lo[4],hi[4];
    #pragma unroll
    for(int ks=0;ks<4;++ks){
      asm volatile("ds_read_b64_tr_b16 %0,%1 offset:%c2":"=&v"(lo[ks]):"v"(vb),"i"(d0*4096+ks*1024):"memory");
      asm volatile("ds_read_b64_tr_b16 %0,%1 offset:%c2":"=&v"(hi[ks]):"v"(vb),"i"(d0*4096+ks*1024+512):"memory");}
    asm volatile("s_waitcnt lgkmcnt(0)":::"memory");SBAR();
    #define PK(k) (bf16x8){lo[k][0],lo[k][1],lo[k][2],lo[k][3],hi[k][0],hi[k][1],hi[k][2],hi[k][3]}
    o[d0]=__builtin_amdgcn_mfma_f32_32x32x16_bf16(pa0,PK(0),o[d0],0,0,0);
    o[d0]=__builtin_amdgcn_mfma_f32_32x32x16_bf16(pa1,PK(1),o[d0],0,0,0);
    o[d0]=__builtin_amdgcn_mfma_f32_32x32x16_bf16(pa2,PK(2),o[d0],0,0,0);
    o[d0]=__builtin_amdgcn_mfma_f32_32x32x16_bf16(pa3,PK(3),o[d0],0,0,0);
    #undef PK
  }
}

#ifndef ATTN_STORE16
#define ATTN_STORE16(p,v) (*(u32x4*)(p)=(v))
#endif
template<int THRL> __device__ __forceinline__ void attn_unit(int b,int qcol,int vcol,int ocol,int qb,const bf16*Q,const bf16*__restrict__ K,const bf16*__restrict__ V,bf16*O,char*shm){
  const int tid=threadIdx.x,lane=tid&63,r32=lane&31,hi=lane>>5; const int wid=__builtin_amdgcn_readfirstlane(tid>>6);
  const long rowbase=(long)b*SEQ; const int q0=qb*QB;
  const bf16*Qw=Q+(rowbase+q0+wid*QBLK)*DM+qcol;
  const bf16*Kh=K+rowbase*DM+qcol,*Vh=V+rowbase*DM+vcol;
  const unsigned lds0=(unsigned)(uintptr_t)shm;
  float*wsf=(float*)(shm+LDS_WS)+wid*64;
  const bf16*ksrc=Kh+(long)lane*DM+wid*8;
  const bf16*vsrc=Vh+(long)(16*(wid&3)+(lane>>2))*DM+(wid>>2)*32+(lane&3)*8;
  const unsigned kdst=lds0+LDS_K+wid*1024, vdst=lds0+LDS_V+wid*1024;
  #define DMA_K(t,slot) glds16(ksrc+(long)(t)*KVBLK*DM,(unsigned)__builtin_amdgcn_readfirstlane(kdst+(slot)))
  #define DMA_V(t,slot) glds16(vsrc+(long)(t)*KVBLK*DM,(unsigned)__builtin_amdgcn_readfirstlane(vdst+(slot)))
  const int vb0=(int)(lds0+LDS_V)+((lane>>4)&1)*32+(lane&3)*8+(4*hi+((lane&15)>>2))*64;
  const char*Kbase=shm+LDS_K; bf16x8 kf[8];
  const lds_cptr shm3=(lds_cptr)shm; const lds_cptr kp0=shm3+LDS_K+hi*1024+r32*16; const lds_cptr vp0=shm3+LDS_V+((lane>>4)&1)*32+(lane&3)*8+(4*hi+((lane&15)>>2))*64;
  const int NT=(q0+QB)/KVBLK;
  DMA_K(0,0);DMA_V(0,0);DMA_K(1,SLOTB);
  bf16x8 qr[4];
  #pragma unroll
  for(int d0=0;d0<4;++d0)qr[d0]=*reinterpret_cast<const bf16x8*>(&Qw[(long)r32*DM+d0*16+hi*8]);
  float mhat=0.f,l_reg=0.f;f32x16 o[2];o[0]=f32x16{};o[1]=f32x16{};f32x16 negm=f32x16{};asm volatile("":"+v"(negm));
  const int qrel=wid*QBLK+r32;
  #define CMASK(P0,P1,t) do{int jb_=(t)-(NT-4); if(jb_>=0)cmask(P0,P1,jb_,qrel,hi);}while(0)
  bool resc=false;
  #define START(P0,P1) do{ const float rm=rowmax(P0,P1); resc=false; \
    { const float dl=rm; mhat=fadd_s(mhat,dl); \
      _Pragma("unroll") for(int r=0;r<16;++r){P0[r]=fsub_s(P0[r],dl);P1[r]=fsub_s(P1[r],dl);} \
      _Pragma("unroll") for(int r=0;r<16;++r)negm[r]=-mhat; asm volatile("":"+v"(negm)); } \
    _Pragma("unroll") for(int r=0;r<16;++r)P0[r]=__builtin_amdgcn_exp2f(P0[r]); }while(0)
  #define RESC() do{ if(resc){ asm volatile("s_waitcnt lgkmcnt(0)":::"memory"); \
      _Pragma("unroll") for(int d_=0;d_<2;++d_) _Pragma("unroll") for(int r=0;r<16;++r)o[d_][r]*=wsf[crow(r,hi)]; } }while(0)
  f32x16 pA0,pA1,pB0,pB1;
  int sl_prev=0,sl_cur=0,sl_next=SLOTB;
  #define ROT() do{sl_prev=sl_cur;sl_cur=sl_next;sl_next=(sl_next==(NSLOT-1)*SLOTB)?0:sl_next+SLOTB;}while(0)
  DMA_K(2,2*SLOTB);
  WAIT_BAR(3);
  qkt(pA0,pA1,Kbase,qr,negm,r32,hi);asm volatile("s_nop 15\n\ts_nop 7":"+v"(pA0),"+v"(pA1));CMASK(pA0,pA1,0);
  START(pA0,pA1);
  _Pragma("unroll") for(int r=0;r<16;++r)pA1[r]=__builtin_amdgcn_exp2f(pA1[r]);
  WAIT_BAR(0);
  DMA_K(3,0);DMA_V(1,SLOTB);
  ROT();
  kload8(kf,kp0+sl_cur);
  WAIT_BAR(2);
  s16x4 vlo[8],vhi[8]; u32x4 pw0,pw1,pw2,pw3;
  #define PKW(P,B) cvtpk_s(P[B],P[B+1])
  #define PAF(k) __builtin_bit_cast(bf16x8,pw##k)
  #define VFR(i) (bf16x8){vlo[i][0],vlo[i][1],vlo[i][2],vlo[i][3],vhi[i][0],vhi[i][1],vhi[i][2],vhi[i][3]}
  #define PIN(x) asm volatile("":"+v"(x))
  #define MX3(a,b,c) __builtin_fmaxf(__builtin_fmaxf((a),(b)),(c))
  #define GAPA(MF,A0,A1,A2,A3,W0,W1,PW) do{ MF; sacc+=A0; sacc+=A1; sacc+=A2; sacc+=A3; PIN(sacc); W0; W1; PIN(PW); SBAR(); }while(0)
  #define EX(v) __builtin_amdgcn_exp2f(v)
  #define GAPB(MF,X,B) do{ MF; X[B]=EX(X[B]); X[B+1]=EX(X[B+1]); X[B+2]=EX(X[B+2]); X[B+3]=EX(X[B+3]); PIN(X); SBAR(); }while(0)
  #define VRD(i) do{ vlo[i]=vtr(vp_+(((i)>>2)*4096+((i)&3)*1024)); vhi[i]=vtr(vp_+(((i)>>2)*4096+((i)&3)*1024+512)); }while(0)
  #define KRD(G,j) do{ if(G){ kload2(kf,kp0+sl_next,j); SBAR(); } }while(0)
  #define STEP(C0,C1,P0,P1,t,GK,GV,GL) do{ SBAR(); \
    const lds_cptr vp_=vp0+sl_prev; \
    VRD(0); SBAR(); float sacc=(P0[0]+P0[1]); \
    GAPA(C0=__builtin_amdgcn_mfma_f32_32x32x16_bf16(kf[0],qr[0],negm,0,0,0), P0[2],P0[3],P0[4],P0[5],     pw0[0]=PKW(P0,0), pw0[1]=PKW(P0,2), pw0); \
    VRD(4); SBAR(); GAPA(C1=__builtin_amdgcn_mfma_f32_32x32x16_bf16(kf[1],qr[0],negm,0,0,0), P0[6],P0[7],P0[8],P0[9],     pw0[2]=PKW(P0,4), pw0[3]=PKW(P0,6), pw0); \
    VRD(1); SBAR(); GAPA(C0=__builtin_amdgcn_mfma_f32_32x32x16_bf16(kf[2],qr[1],C0,0,0,0),   P0[10],P0[11],P0[12],P0[13], pw1[0]=PKW(P0,8), pw1[1]=PKW(P0,10), pw1); \
    VRD(5); SBAR(); GAPA(C1=__builtin_amdgcn_mfma_f32_32x32x16_bf16(kf[3],qr[1],C1,0,0,0),   P0[14],P0[15],P1[0],P1[1],   pw1[2]=PKW(P0,12),pw1[3]=PKW(P0,14), pw1); \
    VRD(2); SBAR(); GAPA(C0=__builtin_amdgcn_mfma_f32_32x32x16_bf16(kf[4],qr[2],C0,0,0,0),   P1[2],P1[3],P1[4],P1[5],     pw2[0]=PKW(P1,0), pw2[1]=PKW(P1,2), pw2); \
    VRD(6); SBAR(); GAPA(C1=__builtin_amdgcn_mfma_f32_32x32x16_bf16(kf[5],qr[2],C1,0,0,0),   P1[6],P1[7],P1[8],P1[9],     pw2[2]=PKW(P1,4), pw2[3]=PKW(P1,6), pw2); \
    VRD(3); SBAR(); GAPA(C0=__builtin_amdgcn_mfma_f32_32x32x16_bf16(kf[6],qr[3],C0,0,0,0),   P1[10],P1[11],P1[12],P1[13], pw3[0]=PKW(P1,8), pw3[1]=PKW(P1,10), pw3); \
    VRD(7); SBAR(); GAPA(C1=__builtin_amdgcn_mfma_f32_32x32x16_bf16(kf[7],qr[3],C1,0,0,0),   P1[14],P1[15],0.f,0.f,       pw3[2]=PKW(P1,12),pw3[3]=PKW(P1,14), pw3); \
    l_reg+=sacc; \
    if(GK){DMA_K((t)+3,sl_cur);} if(GV){DMA_V((t)+1,sl_next);} \
    CMASK(C0,C1,t); \
    { float a=MX3(C0[0],C0[1],C1[0]),b=MX3(C0[2],C0[3],C1[1]); a=MX3(a,C1[2],C1[3]); \
      _Pragma("unroll") for(int r=4;r<16;r+=4){a=MX3(a,C0[r],C0[r+1]);b=MX3(b,C0[r+2],C0[r+3]);a=MX3(a,C1[r],C1[r+1]);b=MX3(b,C1[r+2],C1[r+3]);} \
      float rm=__builtin_fmaxf(a,b); { auto rr=__builtin_amdgcn_permlane32_swap(__float_as_uint(rm),__float_as_uint(rm),false,false); rm=__builtin_fmaxf(__uint_as_float(rr[0]),__uint_as_float(rr[1])); } \
      resc=false; \
      if(__builtin_expect(__any(rm>(float)THRL),0)){ const float dl=__builtin_fmaxf(rm,0.f); mhat+=dl; \
        _Pragma("unroll") for(int r=0;r<16;++r){C0[r]-=dl;C1[r]-=dl;} \
        _Pragma("unroll") for(int r=0;r<16;++r)negm[r]=-mhat; asm volatile("":"+v"(negm)); \
        const float f=__builtin_amdgcn_exp2f(-dl); l_reg*=f; if(hi==0)wsf[r32]=f; resc=true; } } \
    SBAR(); \
    GAPB(o[0]=__builtin_amdgcn_mfma_f32_32x32x16_bf16(PAF(0),VFR(0),o[0],0,0,0), C0,0); \
    GAPB(o[1]=__builtin_amdgcn_mfma_f32_32x32x16_bf16(PAF(0),VFR(4),o[1],0,0,0), C0,4); \
    KRD(GL,0); GAPB(o[0]=__builtin_amdgcn_mfma_f32_32x32x16_bf16(PAF(1),VFR(1),o[0],0,0,0), C0,8); \
    KRD(GL,1); GAPB(o[1]=__builtin_amdgcn_mfma_f32_32x32x16_bf16(PAF(1),VFR(5),o[1],0,0,0), C0,12); \
    KRD(GL,2); GAPB(o[0]=__builtin_amdgcn_mfma_f32_32x32x16_bf16(PAF(2),VFR(2),o[0],0,0,0), C1,0); \
    KRD(GL,3); GAPB(o[1]=__builtin_amdgcn_mfma_f32_32x32x16_bf16(PAF(2),VFR(6),o[1],0,0,0), C1,4); \
    GAPB(o[0]=__builtin_amdgcn_mfma_f32_32x32x16_bf16(PAF(3),VFR(3),o[0],0,0,0), C1,8); \
    GAPB(o[1]=__builtin_amdgcn_mfma_f32_32x32x16_bf16(PAF(3),VFR(7),o[1],0,0,0), C1,12); \
    }while(0)
  int t=1;
  #undef CMASK
  #define CMASK(P0,P1,t) do{}while(0)
  for(;t+5<NT;t+=2){
    STEP(pB0,pB1,pA0,pA1,t,true,true,true);     WAIT_BAR(2); RESC(); ROT();
    STEP(pA0,pA1,pB0,pB1,t+1,true,true,true);   WAIT_BAR(2); RESC(); ROT();
  }
  #undef CMASK
  #define CMASK(P0,P1,t) do{int jb_=(t)-(NT-4); if(jb_>=0)cmask(P0,P1,jb_,qrel,hi);}while(0)
  #define ENDW(tt) do{ if((tt)+3<NT){WAIT_BAR(2);} else if((tt)+2<NT){WAIT_BAR(1);} else {WAIT_BAR(0);} }while(0)
  for(;t+1<NT;t+=2){
    STEP(pB0,pB1,pA0,pA1,t,(t+3<NT),(t+1<NT),(t+1<NT));       ENDW(t);   RESC(); ROT();
    STEP(pA0,pA1,pB0,pB1,t+1,(t+4<NT),(t+2<NT),(t+2<NT));     ENDW(t+1); RESC(); ROT();
  }
  STEP(pB0,pB1,pA0,pA1,NT-1,false,false,false); RESC();
  { float sacc=pB0[0]+pB0[1]; _Pragma("unroll") for(int r=2;r<16;++r)sacc+=pB0[r]; _Pragma("unroll") for(int r=0;r<16;++r)sacc+=pB1[r]; l_reg+=sacc;
    pw0=(u32x4){PKW(pB0,0),PKW(pB0,2),PKW(pB0,4),PKW(pB0,6)};pw1=(u32x4){PKW(pB0,8),PKW(pB0,10),PKW(pB0,12),PKW(pB0,14)};pw2=(u32x4){PKW(pB1,0),PKW(pB1,2),PKW(pB1,4),PKW(pB1,6)};pw3=(u32x4){PKW(pB1,8),PKW(pB1,10),PKW(pB1,12),PKW(pB1,14)};
    SBAR(); pv(o,vb0+sl_cur,PAF(0),PAF(1),PAF(2),PAF(3)); }
  #undef PKW
  #undef PAF
  #undef VFR
  #undef PIN
  #undef MX3
  #undef GAPA
  #undef GAPB
  #undef EX
  #undef VRD
  #undef KRD
  #undef STEP
  #undef ENDW
  {auto rr=__builtin_amdgcn_permlane32_swap(__float_as_uint(l_reg),__float_as_uint(l_reg),false,false);l_reg=__uint_as_float(rr[0])+__uint_as_float(rr[1]);}
  if(hi==0)wsf[32+r32]=l_reg;asm volatile("s_waitcnt lgkmcnt(0)":::"memory");
  float rli[16];
  #pragma unroll
  for(int r=0;r<16;++r)rli[r]=__builtin_amdgcn_rcpf(wsf[32+crow(r,hi)]);
  bf16*Ow=O+(rowbase+q0+wid*QBLK)*OPITCH+ocol;
  { bf16*stg=(bf16*)(shm+LDS_OST)+wid*2048;
    #pragma unroll
    for(int r=0;r<16;++r){const int orow=crow(r,hi);
      #pragma unroll
      for(int d0=0;d0<2;++d0)stg[orow*64+d0*32+r32]=__float2bfloat16(o[d0][r]*rli[r]);}
    asm volatile("s_waitcnt lgkmcnt(0)":::"memory");
    #pragma unroll
    for(int i=0;i<4;++i){const int row=i*8+(lane>>3),ch=lane&7; const u32x4 v=*(const u32x4*)(stg+row*64+ch*8); ATTN_STORE16(Ow+(long)row*OPITCH+ch*8,v);} }
  asm volatile("s_waitcnt lgkmcnt(0)\n\ts_barrier":::"memory");
  #undef DMA_K
  #undef DMA_V
  #undef CMASK
  #undef START
  #undef RESC
  #undef ROT
}
constexpr int ATTN_LDS_BYTES=LDS_BYTES;
#undef SBAR
#undef WAIT_BAR
}
constexpr size_t MiB = 1u << 20;
constexpr size_t WS_CTL = 0, CTL_ZERO_BYTES = 1 * MiB;
constexpr size_t WS_WIN = 2 * MiB, WS_WOUT = 26 * MiB, WS_WQ = 34 * MiB, WS_WKV = 42 * MiB, WS_WO = 58 * MiB, WS_W1 = 66 * MiB, WS_W2 = 578 * MiB;
constexpr size_t WS_HN = 834 * MiB, WS_MN = 866 * MiB, WS_PROJ = 870 * MiB, WS_DT = 958 * MiB, WS_KVRAW = 959 * MiB, WS_KN = 967 * MiB;
constexpr size_t WS_YCAT = 971 * MiB, WS_O0 = 1003 * MiB, WS_O1 = 1019 * MiB, WS_H1 = 1035 * MiB, WS_H1B = 1099 * MiB, WS_PART1 = 1131 * MiB, WS_PARTQ = 1132 * MiB;
constexpr size_t WS_QRAW = 1133 * MiB, WS_P = 1165 * MiB, WS_VWT = 1181 * MiB, WS_H2 = 1197 * MiB, WS_HN3 = 1261 * MiB;
constexpr size_t WS_TOKOF = 1293 * MiB, WS_GATEOF = 1294 * MiB, WS_TOKE = 1295 * MiB, WS_TOKR = 1296 * MiB, WS_YG = 1297 * MiB;
constexpr size_t WS_H1F8 = 3368 * MiB  , WS_QF8 = 3384 * MiB  , WS_KN8 = 3400 * MiB  , WS_VF8 = 3402 * MiB  ;
constexpr size_t WS_P8 = 3404 * MiB  , WS_VWT8 = 3412 * MiB  ;
constexpr size_t WS_XG = 1320 * MiB  , WS_ACT = 1832 * MiB  , WS_Y = 2344 * MiB  , WS_END = 3420 * MiB;
constexpr int CW_BAR = 4096;
constexpr int CW_QCONV = 12352;
constexpr int CW_QATT = 12288;
constexpr int CW_CNT = 8192;
static_assert((CW_CNT + 64 * 32) * 4 <= (int)CTL_ZERO_BYTES, "CTL words inside the memset region");

constexpr int RING_OFF = 0, RING_BYTES = 131072;
constexpr int LDS_BYTES = 163840;
constexpr int MISC_OFF = 163840 - 1024;
constexpr int NWAVES = 8;

#define XB_TMO      128
#define XB_XCNT(j)  (256  + 64 * (j))
#define XB_XSUB(j)  (1280 + 64 * (j))
#define XB_XGEN(j)  (2304 + 64 * (j))
#define XB_TOP      3328
#define XB_TOPGEN   3392
#define XCD_BAR_WORDS 3456
#define XB_SPIN_CAP (1u << 20)

__device__ __forceinline__ unsigned xb_ld(unsigned* p)              { return __hip_atomic_load(p, __ATOMIC_RELAXED, __HIP_MEMORY_SCOPE_AGENT); }
__device__ __forceinline__ unsigned xb_add(unsigned* p, unsigned v) { return __hip_atomic_fetch_add(p, v, __ATOMIC_RELAXED, __HIP_MEMORY_SCOPE_AGENT); }
__device__ __forceinline__ unsigned xb_xcc_id() { return (unsigned)__builtin_amdgcn_s_getreg((3 << 11) | 20) & 0xFu; }
#define XB_SPIN(cond, bar) do { unsigned _sp = 0; while (cond) { __builtin_amdgcn_s_sleep(1); \
    if ((++_sp & 255u) == 0u) { if (xb_ld(&(bar)[XB_TMO])) break; if (_sp > XB_SPIN_CAP) { atomicAdd(&(bar)[XB_TMO], 1u); break; } } } } while (0)

struct XcdBarrier {
    unsigned* bar; unsigned x;
    volatile LAS unsigned* st;
};
__device__ __forceinline__ XcdBarrier xcd_barrier_post(unsigned* bar, volatile LAS unsigned* st) {
    XcdBarrier b; b.bar = bar; b.x = xb_xcc_id(); b.st = st;
    if (threadIdx.x == 0) (void)xb_add(&bar[XB_XCNT(b.x)], 1u);
    return b;
}
__device__ __forceinline__ void xcd_barrier_complete(unsigned* bar, unsigned x, unsigned& nloc, unsigned& nx) {
    const unsigned G = gridDim.x * gridDim.y * gridDim.z;
    unsigned sum, cnt, mine, sp = 0u;
    for (;;) {
        sum = 0u; cnt = 0u; mine = 0u;
#pragma unroll
        for (unsigned j = 0; j < 16; ++j) { const unsigned c = xb_ld(&bar[XB_XCNT(j)]); sum += c; cnt += (c > 0u) ? 1u : 0u; mine = (j == x) ? c : mine; }
        if (sum == G) break;
        __builtin_amdgcn_s_sleep(1);
        if ((++sp & 255u) == 0u) { if (xb_ld(&bar[XB_TMO])) break; if (sp > XB_SPIN_CAP) { atomicAdd(&bar[XB_TMO], 1u); break; } }
    }
    nloc = mine > 0u ? mine : 1u; nx = cnt > 0u ? cnt : 1u;
}
__device__ __forceinline__ void xcd_barrier(const XcdBarrier& b) {
    asm volatile("s_waitcnt vmcnt(0)" ::: "memory");
    __syncthreads();
    if (threadIdx.x == 0) {
        unsigned* bar = b.bar;
        __builtin_amdgcn_s_waitcnt(0);
        unsigned nloc = b.st[0], nx = b.st[1];
        if (nloc == 0u) { xcd_barrier_complete(bar, b.x, nloc, nx); b.st[0] = nloc; b.st[1] = nx; }
        const unsigned old = xb_add(&bar[XB_XSUB(b.x)], 1u);
        const unsigned gen = old / nloc;
        if (old + 1u == (gen + 1u) * nloc) {
            __builtin_amdgcn_fence(__ATOMIC_RELEASE, "agent");
            asm volatile("s_waitcnt vmcnt(0)" ::: "memory");
            const unsigned og = xb_add(&bar[XB_TOP], 1u);
            const unsigned tg = og / nx;
            if (og + 1u == (tg + 1u) * nx) xb_add(&bar[XB_TOPGEN], 1u);
            else XB_SPIN(xb_ld(&bar[XB_TOPGEN]) == tg, bar);
            __builtin_amdgcn_fence(__ATOMIC_ACQUIRE, "agent");
            xb_add(&bar[XB_XGEN(b.x)], 1u);
            asm volatile("s_waitcnt vmcnt(0)" ::: "memory");
        } else {
            XB_SPIN(xb_ld(&bar[XB_XGEN(b.x)]) == gen, bar);
            __builtin_amdgcn_fence(__ATOMIC_ACQUIRE, "agent");
            asm volatile("s_waitcnt vmcnt(0)" ::: "memory");
        }
    }
    __syncthreads();
}

struct Args { const float* in[32]; float* out; unsigned char* ws; int ph_lo, ph_hi; };
enum In { I_X = 0, I_MEM, I_GMIX, I_WIN, I_CONVW, I_CONVB, I_DTB, I_ALOG, I_DSKIP, I_SSDG, I_DAQG, I_DAKG, I_LQ1, I_LK1, I_LQ2, I_LK2, I_SUBG, I_WOUT, I_GXA, I_GMEM,
          I_WQ, I_WKV, I_XQG, I_XKG, I_WO, I_GFFN, I_RW, I_RB, I_W1, I_B1, I_W2, I_B2 };

struct ArgP {
    typedef const __attribute__((address_space(4))) char* kptr;
    DI const float* in(int i) const { kptr kp = (kptr)__builtin_amdgcn_kernarg_segment_ptr(); asm volatile("" : "+s"(kp)); return *(const float* const __attribute__((address_space(4)))*)(kp + 8 * i); }
    DI float* out() const { kptr kp = (kptr)__builtin_amdgcn_kernarg_segment_ptr(); asm volatile("" : "+s"(kp)); return *(float* const __attribute__((address_space(4)))*)(kp + 8 * 32); }
};
struct Frame {
    LAS unsigned char* lds;
    volatile LAS unsigned* MISC;
    unsigned* ctl;
    unsigned char* ws;
    int tid, lane, wave, vcu, G;
};

template <class DestRow>
DI void tr_item(const float* W, size_t ldw, int k0, int ncol0, int nvalid, const float* kscale, bf16_t* WT, int K, DestRow dr, LAS float* scr, int lane) {
    const int c = lane & 31;
#pragma unroll 8
    for (int i = 0; i < 32; ++i) { const int kk = 2 * i + (lane >> 5);
        float v = (c < nvalid) ? W[(size_t)(k0 + kk) * ldw + ncol0 + c] : 0.f;
        if (kscale) v *= kscale[k0 + kk];
        scr[kk * 33 + c] = v; }
    asm volatile("s_waitcnt lgkmcnt(0)" ::: "memory");
    const int c8 = lane & 7;
#pragma unroll
    for (int j = 0; j < 4; ++j) { const int n = (lane >> 3) + 8 * j; const LAS float* s = scr + (8 * c8) * 33 + n;
        u32x4 o; o.x = pk2(s[0 * 33], s[1 * 33]); o.y = pk2(s[2 * 33], s[3 * 33]); o.z = pk2(s[4 * 33], s[5 * 33]); o.w = pk2(s[6 * 33], s[7 * 33]);
        if (n < nvalid) *(u32x4*)(WT + (size_t)dr(ncol0 + n) * K + k0 + 8 * c8) = o; }
    asm volatile("s_waitcnt lgkmcnt(0)" ::: "memory");
}
template <class DestRow>
DI void tr_item_fp8(const float* W, size_t ldw, int k0, int ncol0, const float* kscale, unsigned char* WT, int K, DestRow dr, LAS float* scr, int lane) {
    const int c = lane & 31;
#pragma unroll 8
    for (int i = 0; i < 32; ++i) { const int kk = 2 * i + (lane >> 5); float v = W[(size_t)(k0 + kk) * ldw + ncol0 + c]; if (kscale) v *= kscale[k0 + kk]; scr[kk * 33 + c] = v; }
    asm volatile("s_waitcnt lgkmcnt(0)" ::: "memory");
    const int n = lane >> 1, hf = lane & 1; const LAS float* s = scr + (32 * hf) * 33 + n;
    unsigned w[8];
#pragma unroll
    for (int j = 0; j < 8; ++j) { unsigned x = 0u;
        x = __builtin_amdgcn_cvt_pk_fp8_f32(s[(4 * j) * 33] * 64.f, s[(4 * j + 1) * 33] * 64.f, x, false);
        x = __builtin_amdgcn_cvt_pk_fp8_f32(s[(4 * j + 2) * 33] * 64.f, s[(4 * j + 3) * 33] * 64.f, x, true); w[j] = x; }
    unsigned char* op = WT + (size_t)dr(ncol0 + n) * K + k0 + 32 * hf;
    *(u32x4*)op = (u32x4){w[0], w[1], w[2], w[3]}; *(u32x4*)(op + 16) = (u32x4){w[4], w[5], w[6], w[7]};
    asm volatile("s_waitcnt lgkmcnt(0)" ::: "memory");
}
DI int tileperm(int col) { const int o = col & 255; return (col & ~255) + 128 * ((o & 63) >> 5) + 32 * (o >> 6) + (o & 31); }
struct DrIdent { DI int operator()(int n) const { return n; } };
struct DrTile  { DI int operator()(int n) const { return tileperm(n); } };
struct DrWin   { DI int operator()(int n) const { const int pc = (n < 2560) ? n : (n < 2576 ? PC_DT + (n - 2560) : n - 16); return tileperm(pc); } };
struct DrW1    { DI int operator()(int n) const { const int half = n >> 11, j = n & 2047; return (j >> 7) * 256 + half * 128 + (j & 127); } };

template <bool FP8, class DestRow>
DI void cv_item(const float* W, size_t ldw, int k0, int ncol0, const float* kscale, float scale, void* WT, int kpitch, DestRow dr, LAS float* scr, int lane) {
    const int r = lane >> 3, c4 = (lane & 7) * 4;
    f32x4 v[16];
#pragma unroll
    for (int i = 0; i < 16; ++i) v[i] = *(const f32x4*)(W + (size_t)(k0 + 8 * i + r) * ldw + ncol0 + c4);
#pragma unroll
    for (int i = 0; i < 16; ++i) { f32x4 x = v[i] * scale; if (kscale) x = x * kscale[k0 + 8 * i + r]; *(LAS f32x4*)(scr + (8 * i + r) * 36 + c4) = x; }
    asm volatile("s_waitcnt lgkmcnt(0)" ::: "memory");
    const int n = lane & 31, hf = lane >> 5; const LAS float* s = scr + (64 * hf) * 36 + n;
    if constexpr (FP8) {
        unsigned w[16];
#pragma unroll
        for (int j = 0; j < 16; ++j) { unsigned x = 0u; x = __builtin_amdgcn_cvt_pk_fp8_f32(s[(4 * j) * 36], s[(4 * j + 1) * 36], x, false); x = __builtin_amdgcn_cvt_pk_fp8_f32(s[(4 * j + 2) * 36], s[(4 * j + 3) * 36], x, true); w[j] = x; }
        unsigned char* op = (unsigned char*)WT + (size_t)dr(ncol0 + n) * kpitch + k0 + 64 * hf;
#pragma unroll
        for (int j = 0; j < 4; ++j) *(u32x4*)(op + 16 * j) = (u32x4){w[4 * j], w[4 * j + 1], w[4 * j + 2], w[4 * j + 3]};
    } else {
        unsigned w[32];
#pragma unroll
        for (int j = 0; j < 32; ++j) w[j] = pk2(s[(2 * j) * 36], s[(2 * j + 1) * 36]);
        unsigned char* op = (unsigned char*)WT + (size_t)dr(ncol0 + n) * kpitch + (k0 + 64 * hf) * 2;
#pragma unroll
        for (int j = 0; j < 8; ++j) *(u32x4*)(op + 16 * j) = (u32x4){w[4 * j], w[4 * j + 1], w[4 * j + 2], w[4 * j + 3]};
    }
    asm volatile("s_waitcnt lgkmcnt(0)" ::: "memory");
}
DI void rms_row_to_bf16(const float* xrow, const float* g, bf16_t* orow, int lane) {
    const f32x4* xr = (const f32x4*)xrow + lane;
    f32x4 v[8]; float s = 0.f;
#pragma unroll
    for (int j = 0; j < 8; ++j) { v[j] = xr[64 * j]; s += (v[j].x * v[j].x + v[j].y * v[j].y) + (v[j].z * v[j].z + v[j].w * v[j].w); }
    const float rstd = 1.f / sqrtf(wave_sum(s) * (1.f / 2048.f) + EPS_);
    u32x2* o8 = (u32x2*)orow + lane;
#pragma unroll
    for (int j = 0; j < 8; ++j) { const f32x4 gg = ((const f32x4*)g)[lane + 64 * j];
        u32x2 o; o.x = pk2(v[j].x * rstd * gg.x, v[j].y * rstd * gg.y); o.y = pk2(v[j].z * rstd * gg.z, v[j].w * rstd * gg.w); o8[64 * j] = o; }
}

DI void p0_prologue(Frame& F, const ArgP& a) {
    LAS float* scr = (LAS float*)(F.lds + RING_OFF + F.wave * 16384);
    const int gw = F.vcu * NWAVES + F.wave, NGW = F.G * NWAVES;
    unsigned char* ws = F.ws;
    constexpr int I_A = 32 * 80, I_B = 32, I_C = 32 * 96, NITEMS = I_A + I_B + I_C;
    for (int it = gw; it < NITEMS; it += NGW) {
        int r = it;
        if (r < I_A) { tr_item(a.in(I_WIN), 5648, 64 * (r / 80), 32 * (r % 80), 32, nullptr, (bf16_t*)(ws + WS_WIN), 2048, DrWin(), scr, F.lane); continue; } r -= I_A;
        if (r < I_B) { tr_item(a.in(I_WIN), 5648, 64 * r, 2560, 16, nullptr, (bf16_t*)(ws + WS_WIN), 2048, DrWin(), scr, F.lane); continue; } r -= I_B;
        tr_item(a.in(I_WIN), 5648, 64 * (r / 96), 2576 + 32 * (r % 96), 32, nullptr, (bf16_t*)(ws + WS_WIN), 2048, DrWin(), scr, F.lane);
    }
    for (int m = gw; m < NTOK; m += NGW) rms_row_to_bf16(a.in(I_X) + (size_t)m * 2048, a.in(I_GMIX), (bf16_t*)(ws + WS_HN) + (size_t)m * 2048, F.lane);
    for (int m = gw; m < NB * MEMLEN; m += NGW) rms_row_to_bf16(a.in(I_MEM) + (size_t)m * 2048, a.in(I_GMEM), (bf16_t*)(ws + WS_MN) + (size_t)m * 2048, F.lane);
}
struct CvIt { const float* W; size_t ldw; const float* ks; unsigned char* WT; float scale; int k0, n0, kpitch, fp8, dr; };
DI CvIt cv_decode(int it, const ArgP& a, unsigned char* ws) {
    constexpr int J_WOUT = 16 * 64, J_WKV = 16 * 128, J_WQ = 16 * 64, J_WO = 16 * 64, J_W1 = 32 * 16 * 128;
    CvIt c; c.ks = nullptr; c.scale = 64.f; c.fp8 = 1; c.dr = 0; c.kpitch = 2048; c.ldw = 2048;
    int r = it;
    if (r < J_WOUT) { c.W = a.in(I_WOUT); c.k0 = 128 * (r / 64); c.n0 = 32 * (r % 64); c.WT = ws + WS_WOUT; c.scale = 1.f; c.fp8 = 0; c.kpitch = 4096; return c; } r -= J_WOUT;
    if (r < J_WKV) { c.W = a.in(I_WKV); c.ldw = 4096; c.k0 = 128 * (r / 128); c.n0 = 32 * (r % 128); c.WT = ws + WS_WKV; c.scale = 1.f; c.fp8 = 0; c.kpitch = 4096; c.dr = 1; return c; } r -= J_WKV;
    if (r < J_WQ) { c.W = a.in(I_WQ); c.ks = a.in(I_GXA); c.k0 = 128 * (r / 64); c.n0 = 32 * (r % 64); c.WT = ws + WS_WQ; return c; } r -= J_WQ;
    if (r < J_WO) { c.W = a.in(I_WO); c.k0 = 128 * (r / 64); c.n0 = 32 * (r % 64); c.WT = ws + WS_WO; return c; } r -= J_WO;
    if (r < J_W1) { const int e = r / (16 * 128), q = r % (16 * 128); c.W = a.in(I_W1) + (size_t)e * 2048 * 4096; c.ldw = 4096; c.k0 = 128 * (q / 128); c.n0 = 32 * (q % 128); c.WT = ws + WS_W1 + (size_t)e * 4096 * 2048; c.dr = 2; return c; } r -= J_W1;
    { const int e = r / (16 * 64), q = r % (16 * 64); c.W = a.in(I_W2) + (size_t)e * 2048 * 2048; c.k0 = 128 * (q / 64); c.n0 = 32 * (q % 64); c.WT = ws + WS_W2 + (size_t)e * 2048 * 2048; }
    return c;
}
constexpr int CV_NJ = 16 * 64 * 3 + 16 * 128 + 32 * 16 * 128 + 32 * 16 * 64;
constexpr int CV_TAIL = 16384;
DI void conv_share(Frame& F, const ArgP& a) {
    LAS float* scr = (LAS float*)(F.lds + F.wave * 18432);
    const int gw = F.vcu * NWAVES + F.wave, NGW = F.G * NWAVES, lane = F.lane;
    unsigned char* ws = F.ws;
    constexpr int NJ = CV_NJ - CV_TAIL;
    const int r = lane >> 3, c4 = (lane & 7) * 4, n = lane & 31, hf = lane >> 5;
    if (gw >= NJ) return;
    CvIt cur = cv_decode(gw, a, ws);
    f32x4 v[16];
#pragma unroll
    for (int i = 0; i < 16; ++i) v[i] = __builtin_nontemporal_load((const f32x4*)(cur.W + (size_t)(cur.k0 + 8 * i + r) * cur.ldw + cur.n0 + c4));
    for (int it = gw; it < NJ; it += NGW) {
#pragma unroll
        for (int i = 0; i < 16; ++i) { f32x4 x = v[i] * cur.scale; if (cur.ks) x = x * cur.ks[cur.k0 + 8 * i + r]; *(LAS f32x4*)(scr + (8 * i + r) * 36 + c4) = x; }
        const bool more = (it + NGW) < NJ; CvIt nxt = cur;
        if (more) { nxt = cv_decode(it + NGW, a, ws);
#pragma unroll
            for (int i = 0; i < 16; ++i) v[i] = __builtin_nontemporal_load((const f32x4*)(nxt.W + (size_t)(nxt.k0 + 8 * i + r) * nxt.ldw + nxt.n0 + c4)); }
        asm volatile("s_waitcnt lgkmcnt(0)" ::: "memory");
        const LAS float* s = scr + (64 * hf) * 36 + n;
        const int col = cur.n0 + n; const int drow = (cur.dr == 0) ? col : (cur.dr == 1 ? tileperm(col) : DrW1()(col));
        if (cur.fp8) {
            unsigned w[16];
#pragma unroll
            for (int j = 0; j < 16; ++j) { unsigned x = 0u; x = __builtin_amdgcn_cvt_pk_fp8_f32(s[(4 * j) * 36], s[(4 * j + 1) * 36], x, false); x = __builtin_amdgcn_cvt_pk_fp8_f32(s[(4 * j + 2) * 36], s[(4 * j + 3) * 36], x, true); w[j] = x; }
            unsigned char* op = cur.WT + (size_t)drow * cur.kpitch + cur.k0 + 64 * hf;
#pragma unroll
            for (int j = 0; j < 4; ++j) *(u32x4*)(op + 16 * j) = (u32x4){w[4 * j], w[4 * j + 1], w[4 * j + 2], w[4 * j + 3]};
        } else {
            unsigned w[32];
#pragma unroll
            for (int j = 0; j < 32; ++j) w[j] = pk2(s[(2 * j) * 36], s[(2 * j + 1) * 36]);
            unsigned char* op = cur.WT + (size_t)drow * cur.kpitch + (cur.k0 + 64 * hf) * 2;
#pragma unroll
            for (int j = 0; j < 8; ++j) *(u32x4*)(op + 16 * j) = (u32x4){w[4 * j], w[4 * j + 1], w[4 * j + 2], w[4 * j + 3]};
        }
        asm volatile("s_waitcnt lgkmcnt(0)" ::: "memory");
        cur = nxt;
    }
}

DI void conv_queue(Frame& F, const ArgP& a) {
    LAS float* scr = (LAS float*)(F.lds + F.wave * 18432);
    unsigned char* ws = F.ws;
    const int lane = threadIdx.x & 63, r = lane >> 3, c4 = (lane & 7) * 4, n = lane & 31, hf = lane >> 5;
    for (;;) {
        if (threadIdx.x == 0) F.MISC[121] = __hip_atomic_fetch_add(F.ctl + CW_QCONV, 8u, __ATOMIC_RELAXED, __HIP_MEMORY_SCOPE_AGENT);
        __syncthreads();
        const int base = __builtin_amdgcn_readfirstlane((int)F.MISC[121]);
        __syncthreads();
        if (base >= CV_TAIL) break;
        const int it = CV_NJ - CV_TAIL + base + F.wave;
        if (it < CV_NJ) {
            const CvIt cur = cv_decode(it, a, ws);
            f32x4 v[16];
#pragma unroll
            for (int i = 0; i < 16; ++i) v[i] = __builtin_nontemporal_load((const f32x4*)(cur.W + (size_t)(cur.k0 + 8 * i + r) * cur.ldw + cur.n0 + c4));
#pragma unroll
            for (int i = 0; i < 16; ++i) *(LAS f32x4*)(scr + (8 * i + r) * 36 + c4) = v[i] * cur.scale;
            asm volatile("s_waitcnt lgkmcnt(0)" ::: "memory");
            const LAS float* s = scr + (64 * hf) * 36 + n;
            unsigned w[16];
#pragma unroll
            for (int j = 0; j < 16; ++j) { unsigned x = 0u; x = __builtin_amdgcn_cvt_pk_fp8_f32(s[(4 * j) * 36], s[(4 * j + 1) * 36], x, false); x = __builtin_amdgcn_cvt_pk_fp8_f32(s[(4 * j + 2) * 36], s[(4 * j + 3) * 36], x, true); w[j] = x; }
            unsigned char* op = cur.WT + (size_t)(cur.n0 + n) * cur.kpitch + cur.k0 + 64 * hf;
#pragma unroll
            for (int j = 0; j < 4; ++j) *(u32x4*)(op + 16 * j) = (u32x4){w[4 * j], w[4 * j + 1], w[4 * j + 2], w[4 * j + 3]};
            asm volatile("s_waitcnt lgkmcnt(0)" ::: "memory");
        }
    }
}
static_assert(CV_TAIL <= 32 * 16 * 64 && CV_TAIL % 8 == 0, "the P2 tail is a suffix of the moe_w2 items");

struct SchedP1 {
    int G, c; const unsigned char* ws; int lo, hi;
    DI bool next(int i, pg8::UnitD& u) const {
        const int L = lo + i * G + c; if (L >= hi) return false;
        u.rows = nullptr; u.nvalid = 0; u.lda = 4096u; u.ldb = 4096u; u.e = 0; u.x0 = 0;
        if (L < 32 * 23) { u.type = 0; u.pn = L / 32; u.pm = L % 32; u.A = (const char*)(ws + WS_HN) + (size_t)u.pm * 256 * 4096; u.B = (const char*)(ws + WS_WIN) + (size_t)u.pn * 256 * 4096; }
        else { const int q = L - 32 * 23; u.type = 1; u.pn = q / 4; u.pm = q % 4; u.A = (const char*)(ws + WS_MN) + (size_t)u.pm * 256 * 4096; u.B = (const char*)(ws + WS_WKV) + (size_t)u.pn * 256 * 4096; }
        return true;
    }
};
struct EpiP1 {
    static constexpr bool AFTER_DRAIN = false;
    bf16_t* proj; float* dtb; bf16_t* kvraw; const float* gq; const float* gk; unsigned char* vf8;
    DI void operator()(const f32x4 (&acc)[2][2][4][2], const pg8::UnitD& u, int wr, int wc, int fr, int fq) const {
        { int ln_ = threadIdx.x; asm volatile("" : "+v"(ln_)); fr = ln_ & 15; fq = (ln_ >> 4) & 3; }
        const int row0 = u.pm * 256 + wr * 64 + fr;
        const int cn = u.pn * 256 + 64 * wc + 8 * fq;
        if (u.type == 1 && u.pn >= 8) {
#pragma unroll
            for (int ai = 0; ai < 2; ++ai)
#pragma unroll
                for (int m = 0; m < 4; ++m) { unsigned char* rp = vf8 + (size_t)(row0 + ai * 128 + m * 16) * 2048 + (cn - 2048);
#pragma unroll
                    for (int bj = 0; bj < 2; ++bj) { const f32x4 v0 = acc[ai][bj][m][0] * 16.f, v1 = acc[ai][bj][m][1] * 16.f;
                        u32x2 w; w.x = __builtin_amdgcn_cvt_pk_fp8_f32(v0[0], v0[1], 0u, false); w.x = __builtin_amdgcn_cvt_pk_fp8_f32(v0[2], v0[3], w.x, true);
                        w.y = __builtin_amdgcn_cvt_pk_fp8_f32(v1[0], v1[1], 0u, false); w.y = __builtin_amdgcn_cvt_pk_fp8_f32(v1[2], v1[3], w.y, true);
                        *(u32x2*)(rp + 32 * bj) = w; } }
            return;
        }
        if (u.type == 1) {
#pragma unroll
            for (int ai = 0; ai < 2; ++ai)
#pragma unroll
                for (int m = 0; m < 4; ++m) { bf16_t* rp = kvraw + (size_t)(row0 + ai * 128 + m * 16) * 4096 + cn;
#pragma unroll
                    for (int bj = 0; bj < 2; ++bj) { const f32x4 v0 = acc[ai][bj][m][0], v1 = acc[ai][bj][m][1];
                        u32x4 w; w.x = pk2(v0[0], v0[1]); w.y = pk2(v0[2], v0[3]); w.z = pk2(v1[0], v1[1]); w.w = pk2(v1[2], v1[3]); *(u32x4*)(rp + 32 * bj) = w; } }
            return;
        }
        if (u.pn == 22) {
            if (wc == 0 && fq < 2) {
#pragma unroll
                for (int ai = 0; ai < 2; ++ai)
#pragma unroll
                    for (int m = 0; m < 4; ++m) { float* rp = dtb + (size_t)(row0 + ai * 128 + m * 16) * 16 + 8 * fq;
                        *(f32x4*)(rp) = acc[ai][0][m][0]; *(f32x4*)(rp + 4) = acc[ai][0][m][1]; }
            }
            return;
        }
        const bool isq = (u.pn >= 10 && u.pn < 14), isk = (u.pn >= 14 && u.pn < 18);
        if (!(isq || isk)) {
#pragma unroll
            for (int ai = 0; ai < 2; ++ai)
#pragma unroll
                for (int m = 0; m < 4; ++m) { bf16_t* rp = proj + (size_t)(row0 + ai * 128 + m * 16) * PP + cn;
#pragma unroll
                    for (int bj = 0; bj < 2; ++bj) { const f32x4 v0 = acc[ai][bj][m][0], v1 = acc[ai][bj][m][1];
                        u32x4 w; w.x = pk2(v0[0], v0[1]); w.y = pk2(v0[2], v0[3]); w.z = pk2(v1[0], v1[1]); w.w = pk2(v1[2], v1[3]); *(u32x4*)(rp + 32 * bj) = w; } }
            return;
        }
        const float* g = (isq ? gq : gk) + 8 * fq; const float sc = isq ? (0.125f * 1.4426950408889634f) : 1.f;
#pragma unroll
        for (int ai = 0; ai < 2; ++ai)
#pragma unroll
            for (int m = 0; m < 4; ++m) { bf16_t* rp = proj + (size_t)(row0 + ai * 128 + m * 16) * PP + cn;
                float ss = 0.f;
#pragma unroll
                for (int bj = 0; bj < 2; ++bj)
#pragma unroll
                    for (int n = 0; n < 2; ++n) { const f32x4 v = acc[ai][bj][m][n]; ss += (v[0] * v[0] + v[1] * v[1]) + (v[2] * v[2] + v[3] * v[3]); }
                ss += __shfl_xor(ss, 16); ss += __shfl_xor(ss, 32);
                const float rs = sc / sqrtf(ss * (1.f / 64.f) + EPS_);
#pragma unroll
                for (int bj = 0; bj < 2; ++bj) { const f32x4 v0 = acc[ai][bj][m][0] * rs * *(const f32x4*)(g + 32 * bj), v1 = acc[ai][bj][m][1] * rs * *(const f32x4*)(g + 32 * bj + 4);
                    u32x4 w; w.x = pk2(v0[0], v0[1]); w.y = pk2(v0[2], v0[3]); w.z = pk2(v1[0], v1[1]); w.w = pk2(v1[2], v1[3]); *(u32x4*)(rp + 32 * bj) = w; } }
    }
};

DI void kprep(Frame& F, const ArgP& a) {
    const int gw = F.vcu * NWAVES + F.wave, NGW = F.G * NWAVES;
    const bf16_t* kv = (const bf16_t*)(F.ws + WS_KVRAW); unsigned char* kn = (unsigned char*)(F.ws + WS_KN8);
    for (int it = gw; it < NB * MEMLEN * 4; it += NGW) {
        const int row = it >> 2, h = it & 3, b = row >> 8, key = row & 255;
        const u32x4 raw = *(const u32x4*)(kv + (size_t)row * 4096 + h * 512 + F.lane * 8);
        float v[8]; v[0] = bflo(raw.x); v[1] = bfhi(raw.x); v[2] = bflo(raw.y); v[3] = bfhi(raw.y); v[4] = bflo(raw.z); v[5] = bfhi(raw.z); v[6] = bflo(raw.w); v[7] = bfhi(raw.w);
        float ss = 0.f;
#pragma unroll
        for (int j = 0; j < 8; ++j) ss += v[j] * v[j];
        const float rs = 1.f / sqrtf(wave_sum(ss) * (1.f / 512.f) + EPS_) * 0.04419417382415922f * 128.f;
        const float* gk = a.in(I_XKG) + F.lane * 8; const float* gq = a.in(I_XQG) + F.lane * 8;
        u32x2 o; o.x = __builtin_amdgcn_cvt_pk_fp8_f32(v[0] * rs * gk[0] * gq[0], v[1] * rs * gk[1] * gq[1], 0u, false); o.x = __builtin_amdgcn_cvt_pk_fp8_f32(v[2] * rs * gk[2] * gq[2], v[3] * rs * gk[3] * gq[3], o.x, true);
        o.y = __builtin_amdgcn_cvt_pk_fp8_f32(v[4] * rs * gk[4] * gq[4], v[5] * rs * gk[5] * gq[5], 0u, false); o.y = __builtin_amdgcn_cvt_pk_fp8_f32(v[6] * rs * gk[6] * gq[6], v[7] * rs * gk[7] * gq[7], o.y, true);
        *(u32x2*)(kn + ((size_t)((b * 4 + h) * 256 + key)) * 512 + F.lane * 8) = o;
    }
}

constexpr int SP = 272;
constexpr int S_C = 0, S_BM = 34816, S_BT = 69632, S_XDT = 104448, S_HB = 121856, S_F = 139264, S_W = 155648  , SSD_LDS = 162048;
static_assert(SSD_LDS <= MISC_OFF, "SSD LDS map");
#define MFMA32(a, b, c) __builtin_amdgcn_mfma_f32_32x32x16_bf16((a), (b), (c), 0, 0, 0)
DI int crow(int r, int hi) { return (r & 3) + 8 * (r >> 2) + 4 * hi; }
DI bf16x8 ldfrag(LAS const unsigned char* base, int row, int kel) { return *(const LAS bf16x8*)(base + row * SP + kel * 2); }
DI float fexp(float x) { return __builtin_amdgcn_exp2f(x * 1.4426950408889634f); }
DI float fsilu(float x) { return x * __builtin_amdgcn_rcpf(1.f + fexp(-x)); }

DI void ssd_unit(Frame& F, const ArgP& a, int b, int hd) {
    LAS unsigned char* lds = F.lds;
    int tid = F.tid, lane = F.lane, r32 = lane & 31, hh = lane >> 5; const int wid = F.wave;
    LAS float* sdt = (LAS float*)(lds + S_F); LAS float* sac = sdt + 2048;
    const bf16_t* proj = (const bf16_t*)(F.ws + WS_PROJ); const float* dtbuf = (const float*)(F.ws + WS_DT); bf16_t* yg = (bf16_t*)(F.ws + WS_YG);
    const int g = hd >> 3;
    const float aneg = -__expf(a.in(I_ALOG)[hd]), dtb = a.in(I_DTB)[hd], dsk = a.in(I_DSKIP)[hd];
#pragma unroll
    for (int q = 0; q < 2; ++q) { const int c = 2 * wid + q; const size_t t0 = (size_t)b * SEQ_ + c * 128;
        const float x0 = dtbuf[(t0 + 2 * lane) * 16 + hd] + dtb, x1 = dtbuf[(t0 + 2 * lane + 1) * 16 + hd] + dtb;
        const float d0 = x0 > 20.f ? x0 : log1pf(__expf(x0)), d1 = x1 > 20.f ? x1 : log1pf(__expf(x1));
        const float a0 = d0 * aneg, a1 = d1 * aneg;
        float s = a0 + a1;
#pragma unroll
        for (int o = 1; o < 64; o <<= 1) { const float t = __shfl_up(s, o); if (lane >= o) s += t; }
        sdt[c * 128 + 2 * lane] = d0; sdt[c * 128 + 2 * lane + 1] = d1; sac[c * 128 + 2 * lane] = s - a1; sac[c * 128 + 2 * lane + 1] = s; }
    int seg = tid >> 5, cg = tid & 31, l0 = seg * 8;
    int colbc = (cg < 16) ? (1024 + g * 128 + cg * 8) : (1280 + g * 128 + (cg - 16) * 8);
    const int colx = hd * 64 + wid * 8; int lx = 2 * lane;
    LAS float* swt = (LAS float*)(lds + S_W);
    { const float* convw = a.in(I_CONVW); const float* convb = a.in(I_CONVB);
      if (tid < 320) { const int ci = tid;
          const int xc = (ci < 64) ? (hd * 64 + ci) : (ci < 192 ? (1024 + g * 128 + (ci - 64)) : (1280 + g * 128 + (ci - 192)));
#pragma unroll
          for (int k = 0; k < 4; ++k) swt[k * 320 + ci] = convw[k * 1536 + xc];
          swt[4 * 320 + ci] = convb[xc]; } }
    int cibc = 64 + cg * 8; const int cix = wid * 8;
    const char* pub = (const char*)F.ws; const unsigned pxb = (unsigned)(WS_PROJ + ((size_t)b * SEQ_ * PP + PC_XBC) * 2), zoff = (unsigned)(WS_CTL + 524288);
    u32x4 inbc[11], inx[5];
#define SSD_PREFETCH(c_) do { \
        int sd_ = l0; asm volatile("" : "+v"(sd_)); \
        _Pragma("unroll") for (int j = 0; j < 11; ++j) { const int tt = (c_) * 128 + sd_ - 3 + j; inbc[j] = *(const u32x4*)(pub + ((tt >= 0) ? pxb + (unsigned)(tt * PP + colbc) * 2u : zoff)); } } while (0)
    SSD_PREFETCH(0);
    f32x16 hT; for (int i = 0; i < 16; ++i) hT[i] = 0.f;
    const int nb = wid & 3, pb = wid >> 2;
    __syncthreads();
    for (int c = 0; c < 16; ++c) {
        { int t_ = threadIdx.x; asm volatile("" : "+v"(t_)); tid = t_; lane = t_ & 63; r32 = lane & 31; hh = lane >> 5; seg = t_ >> 5; cg = t_ & 31; l0 = seg * 8; lx = 2 * lane;
          colbc = (cg < 16) ? (1024 + g * 128 + cg * 8) : (1280 + g * 128 + (cg - 16) * 8); cibc = 64 + cg * 8; }
        const size_t t0 = (size_t)b * SEQ_ + c * 128;
        const LAS float* cdt = sdt + c * 128; const LAS float* cac = sac + c * 128;
        const float aend = cac[127];
#pragma unroll
        for (int j = 0; j < 5; ++j) { int sd_ = lx; asm volatile("" : "+v"(sd_)); const int tt = c * 128 + sd_ - 3 + j; inx[j] = *(const u32x4*)(pub + ((tt >= 0) ? pxb + (unsigned)(tt * PP + colx) * 2u : zoff)); }
        {
            LAS unsigned char* hbp = lds + S_HB + (32 * pb + r32) * SP + (32 * nb + 4 * hh) * 2;
#pragma unroll
            for (int q4 = 0; q4 < 4; ++q4) { u32x2 w; w.x = pk2(hT[4 * q4], hT[4 * q4 + 1]); w.y = pk2(hT[4 * q4 + 2], hT[4 * q4 + 3]); *(LAS u32x2*)(hbp + 16 * q4) = w; }
        }
        {
            float wbc[5][8];
#pragma unroll
            for (int k = 0; k < 5; ++k) { const f32x4 w0 = *(const LAS f32x4*)(swt + k * 320 + cibc), w1 = *(const LAS f32x4*)(swt + k * 320 + cibc + 4);
#pragma unroll
                for (int i = 0; i < 4; ++i) { wbc[k][i] = w0[i]; wbc[k][4 + i] = w1[i]; } }
#pragma unroll
            for (int hf = 0; hf < 2; ++hf) {
                __builtin_amdgcn_sched_barrier(0);
                float o[4][8];
#pragma unroll
                for (int j = 0; j < 4; ++j)
#pragma unroll
                    for (int i = 0; i < 8; ++i) { float s = wbc[4][i];
#pragma unroll
                        for (int k = 0; k < 4; ++k) { const unsigned wd = inbc[4 * hf + j + k][i >> 1]; s += wbc[k][i] * ((i & 1) ? bfhi(wd) : bflo(wd)); }
                        o[j][i] = fsilu(s); }
                const int lh = l0 + 4 * hf;
                if (cg < 16) {
                    const int n0 = cg * 8; float ev[4];
#pragma unroll
                    for (int j = 0; j < 4; ++j) { ev[j] = fexp(aend - cac[lh + j]);
                        u32x4 w1; w1.x = pk2(o[j][0], o[j][1]); w1.y = pk2(o[j][2], o[j][3]); w1.z = pk2(o[j][4], o[j][5]); w1.w = pk2(o[j][6], o[j][7]);
                        *(LAS u32x4*)(lds + S_BM + (lh + j) * SP + n0 * 2) = w1; }
#pragma unroll
                    for (int i = 0; i < 8; ++i) { u32x2 w2; w2.x = pk2(o[0][i] * ev[0], o[1][i] * ev[1]); w2.y = pk2(o[2][i] * ev[2], o[3][i] * ev[3]);
                        *(LAS u32x2*)(lds + S_BT + (n0 + i) * SP + lh * 2) = w2; }
                } else {
                    const int n0 = (cg - 16) * 8;
#pragma unroll
                    for (int j = 0; j < 4; ++j) { u32x4 w1; w1.x = pk2(o[j][0], o[j][1]); w1.y = pk2(o[j][2], o[j][3]); w1.z = pk2(o[j][4], o[j][5]); w1.w = pk2(o[j][6], o[j][7]);
                        *(LAS u32x4*)(lds + S_C + (lh + j) * SP + n0 * 2) = w1; }
                }
            }
        }
        __builtin_amdgcn_sched_barrier(0);
        {
            const float d0 = cdt[lx], d1 = cdt[lx + 1];
            float wx[5][8];
#pragma unroll
            for (int k = 0; k < 5; ++k) { const f32x4 w0 = *(const LAS f32x4*)(swt + k * 320 + cix), w1 = *(const LAS f32x4*)(swt + k * 320 + cix + 4);
#pragma unroll
                for (int i = 0; i < 4; ++i) { wx[k][i] = w0[i]; wx[k][4 + i] = w1[i]; } }
#pragma unroll
            for (int i = 0; i < 8; ++i) { float s0 = wx[4][i], s1 = wx[4][i];
#pragma unroll
                for (int k = 0; k < 4; ++k) { const unsigned w0 = inx[k][i >> 1], w1 = inx[k + 1][i >> 1];
                    s0 += wx[k][i] * ((i & 1) ? bfhi(w0) : bflo(w0)); s1 += wx[k][i] * ((i & 1) ? bfhi(w1) : bflo(w1)); }
                *(LAS unsigned*)(lds + S_XDT + (wid * 8 + i) * SP + lx * 2) = pk2(fsilu(s0) * d0, fsilu(s1) * d1); }
        }
        if (c < 15) SSD_PREFETCH(c + 1);
        __syncthreads();
        const int lb = wid >> 1;
        f32x16 xt[2];
#pragma unroll
        for (int q = 0; q < 2; ++q) { const int sb = 2 * (wid & 1) + q;
            for (int i = 0; i < 16; ++i) xt[q][i] = 0.f;
            if (sb <= lb) {
#pragma unroll
                for (int ks = 0; ks < 8; ++ks) xt[q] = MFMA32(ldfrag(lds + S_BM, 32 * sb + r32, 16 * ks + 8 * hh), ldfrag(lds + S_C, 32 * lb + r32, 16 * ks + 8 * hh), xt[q]);
            }
        }
        __syncthreads();
        {
            const int l = 32 * lb + r32; const float al = cac[l], ddl = dsk * __builtin_amdgcn_rcpf(cdt[l]);
#pragma unroll
            for (int q = 0; q < 2; ++q) { const int sb = 2 * (wid & 1) + q;
#pragma unroll
                for (int q4 = 0; q4 < 4; ++q4) { float mv[4];
#pragma unroll
                    for (int e = 0; e < 4; ++e) { const int s = 32 * sb + 8 * q4 + 4 * hh + e;
                        float v = 0.f;
                        if (s <= l) v = xt[q][4 * q4 + e] * fexp(al - cac[s]);
                        if (s == l) v += ddl;
                        mv[e] = v; }
                    u32x2 w; w.x = pk2(mv[0], mv[1]); w.y = pk2(mv[2], mv[3]);
                    *(LAS u32x2*)(lds + S_BM + l * SP + (32 * sb + 8 * q4 + 4 * hh) * 2) = w; }
            }
        }
        __syncthreads();
        {
            const int lb2 = wid & 3, pb2 = wid >> 2; const int l = 32 * lb2 + r32; const size_t tok = t0 + l;
            const int pc0 = hd * 64 + 32 * pb2 + 4 * hh;
            u32x2 zz[4];
#pragma unroll
            for (int q4 = 0; q4 < 4; ++q4) zz[q4] = *(const u32x2*)(proj + tok * PP + pc0 + 8 * q4);
            f32x16 y1, y2; for (int i = 0; i < 16; ++i) { y1[i] = 0.f; y2[i] = 0.f; }
            for (int ks = 0; ks < 2 * (lb2 + 1); ++ks) y1 = MFMA32(ldfrag(lds + S_XDT, 32 * pb2 + r32, 16 * ks + 8 * hh), ldfrag(lds + S_BM, 32 * lb2 + r32, 16 * ks + 8 * hh), y1);
#pragma unroll
            for (int ks = 0; ks < 8; ++ks) y2 = MFMA32(ldfrag(lds + S_HB, 32 * pb2 + r32, 16 * ks + 8 * hh), ldfrag(lds + S_C, 32 * lb2 + r32, 16 * ks + 8 * hh), y2);
            const float cd = fexp(aend);
#pragma unroll
            for (int i = 0; i < 16; ++i) hT[i] *= cd;
#pragma unroll
            for (int ks = 0; ks < 8; ++ks) hT = MFMA32(ldfrag(lds + S_BT, 32 * nb + r32, 16 * ks + 8 * hh), ldfrag(lds + S_XDT, 32 * pb + r32, 16 * ks + 8 * hh), hT);
            const float el = fexp(cac[l]);
#pragma unroll
            for (int q4 = 0; q4 < 4; ++q4) { float yv[4];
#pragma unroll
                for (int e = 0; e < 4; ++e) { const float z = (e & 1) ? bfhi(e < 2 ? zz[q4].x : zz[q4].y) : bflo(e < 2 ? zz[q4].x : zz[q4].y);
                    yv[e] = (y1[4 * q4 + e] + el * y2[4 * q4 + e]) * fsilu(z); }
                u32x2 w; w.x = pk2(yv[0], yv[1]); w.y = pk2(yv[2], yv[3]);
                *(u32x2*)(yg + tok * 1024 + pc0 + 8 * q4) = w; }
        }
        __syncthreads();
    }
#undef SSD_PREFETCH
}

DI void attn_phase_da(Frame& F) {
    const attn_body::bf16* proj = (const attn_body::bf16*)(F.ws + WS_PROJ);
    for (;;) {
        if (threadIdx.x == 0) F.MISC[120] = __hip_atomic_fetch_add(F.ctl + CW_QATT, 1u, __ATOMIC_RELAXED, __HIP_MEMORY_SCOPE_AGENT);
        __syncthreads();
        const int u = __builtin_amdgcn_readfirstlane((int)F.MISC[120]);
        __syncthreads();
        if (u >= 1024) break;
        const int qb = 7 - (u >> 7), combo = u & 127;
        const int half = combo & 1, j = (combo >> 1) & 1, h = (combo >> 2) & 7, b = combo >> 5;
        attn_body::bf16* O = (attn_body::bf16*)(F.ws + (j ? WS_O1 : WS_O0));
        attn_body::attn_unit<8>(b, PC_Q + (h * 2 + j) * 64, PC_V + h * 128 + half * 64, h * 128 + half * 64, qb, proj, proj + (PC_K - PC_Q), proj, O, (char*)F.lds);
    }
}

DI void p3_finalize(Frame& F, const ArgP& a) {
    const int gw = F.vcu * NWAVES + F.wave, NGW = F.G * NWAVES, lane = F.lane;
    bf16_t* ycat = (bf16_t*)(F.ws + WS_YCAT); const bf16_t* yg = (const bf16_t*)(F.ws + WS_YG); const bf16_t* o0 = (const bf16_t*)(F.ws + WS_O0); const bf16_t* o1 = (const bf16_t*)(F.ws + WS_O1);
    float l1 = a.in(I_LQ1)[lane] * a.in(I_LK1)[lane], l2 = a.in(I_LQ2)[lane] * a.in(I_LK2)[lane];
    const float lam = __expf(wave_sum(l1)) - __expf(wave_sum(l2)) + LAM_INIT;
    for (int m = gw; m < NTOK; m += NGW) {
        { bf16_t* yp = ycat + (size_t)m * 2048 + 16 * lane; const bf16_t* gp = yg + (size_t)m * 1024 + 16 * lane;
          const u32x4 r0 = *(const u32x4*)gp, r1 = *(const u32x4*)(gp + 8);
          float v[16]; v[0] = bflo(r0.x); v[1] = bfhi(r0.x); v[2] = bflo(r0.y); v[3] = bfhi(r0.y); v[4] = bflo(r0.z); v[5] = bfhi(r0.z); v[6] = bflo(r0.w); v[7] = bfhi(r0.w);
          v[8] = bflo(r1.x); v[9] = bfhi(r1.x); v[10] = bflo(r1.y); v[11] = bfhi(r1.y); v[12] = bflo(r1.z); v[13] = bfhi(r1.z); v[14] = bflo(r1.w); v[15] = bfhi(r1.w);
          float ss = 0.f;
#pragma unroll
          for (int i = 0; i < 16; ++i) ss += v[i] * v[i];
#pragma unroll
          for (int o = 1; o < 32; o <<= 1) ss += __shfl_xor(ss, o);
          const float rs = 1.f / sqrtf(ss * (1.f / 512.f) + EPS_);
          const float* g = a.in(I_SSDG) + 16 * lane;
          u32x4 w0, w1;
          w0.x = pk2(v[0] * rs * g[0], v[1] * rs * g[1]); w0.y = pk2(v[2] * rs * g[2], v[3] * rs * g[3]); w0.z = pk2(v[4] * rs * g[4], v[5] * rs * g[5]); w0.w = pk2(v[6] * rs * g[6], v[7] * rs * g[7]);
          w1.x = pk2(v[8] * rs * g[8], v[9] * rs * g[9]); w1.y = pk2(v[10] * rs * g[10], v[11] * rs * g[11]); w1.z = pk2(v[12] * rs * g[12], v[13] * rs * g[13]); w1.w = pk2(v[14] * rs * g[14], v[15] * rs * g[15]);
          *(u32x4*)yp = w0; *(u32x4*)(yp + 8) = w1; }
        { const bf16_t* p0 = o0 + (size_t)m * 1024 + 16 * lane; const bf16_t* p1 = o1 + (size_t)m * 1024 + 16 * lane;
          const u32x4 a0 = *(const u32x4*)p0, a1 = *(const u32x4*)(p0 + 8), b0 = *(const u32x4*)p1, b1 = *(const u32x4*)(p1 + 8);
          float v[16];
          v[0] = bflo(a0.x) - lam * bflo(b0.x); v[1] = bfhi(a0.x) - lam * bfhi(b0.x); v[2] = bflo(a0.y) - lam * bflo(b0.y); v[3] = bfhi(a0.y) - lam * bfhi(b0.y);
          v[4] = bflo(a0.z) - lam * bflo(b0.z); v[5] = bfhi(a0.z) - lam * bfhi(b0.z); v[6] = bflo(a0.w) - lam * bflo(b0.w); v[7] = bfhi(a0.w) - lam * bfhi(b0.w);
          v[8] = bflo(a1.x) - lam * bflo(b1.x); v[9] = bfhi(a1.x) - lam * bfhi(b1.x); v[10] = bflo(a1.y) - lam * bflo(b1.y); v[11] = bfhi(a1.y) - lam * bfhi(b1.y);
          v[12] = bflo(a1.z) - lam * bflo(b1.z); v[13] = bfhi(a1.z) - lam * bfhi(b1.z); v[14] = bflo(a1.w) - lam * bflo(b1.w); v[15] = bfhi(a1.w) - lam * bfhi(b1.w);
          float ss = 0.f;
#pragma unroll
          for (int i = 0; i < 16; ++i) ss += v[i] * v[i];
          ss += __shfl_xor(ss, 1); ss += __shfl_xor(ss, 2); ss += __shfl_xor(ss, 4);
          const float rs = 1.f / sqrtf(ss * (1.f / 128.f) + EPS_) * (1.f - LAM_INIT);
          const float* g = a.in(I_SUBG) + 16 * (lane & 7);
          u32x4 w0, w1;
          w0.x = pk2(v[0] * rs * g[0], v[1] * rs * g[1]); w0.y = pk2(v[2] * rs * g[2], v[3] * rs * g[3]); w0.z = pk2(v[4] * rs * g[4], v[5] * rs * g[5]); w0.w = pk2(v[6] * rs * g[6], v[7] * rs * g[7]);
          w1.x = pk2(v[8] * rs * g[8], v[9] * rs * g[9]); w1.y = pk2(v[10] * rs * g[10], v[11] * rs * g[11]); w1.z = pk2(v[12] * rs * g[12], v[13] * rs * g[13]); w1.w = pk2(v[14] * rs * g[14], v[15] * rs * g[15]);
          bf16_t* yp = ycat + (size_t)m * 2048 + 1024 + 16 * lane;
          *(u32x4*)yp = w0; *(u32x4*)(yp + 8) = w1; }
    }
}

struct SchedDense {
    int G, c, nM, nN; const char* A; const char* B; unsigned lda, ldb; int bdiv; size_t bstride;
    DI bool next(int i, pg8::UnitD& u) const {
        const int L = i * G + c; if (L >= nM * nN) return false;
        u.rows = nullptr; u.nvalid = 0; u.lda = lda; u.ldb = ldb; u.type = 0; u.e = 0; u.x0 = 0;
        u.pn = L / nM; u.pm = L % nM;
        u.A = A + (size_t)u.pm * 256 * lda; u.B = B + (size_t)u.pn * 256 * ldb + (size_t)(u.pm / bdiv) * bstride;
        return true;
    }
};
struct EpiResid {
    static constexpr bool AFTER_DRAIN = false;
    const float* base; float* out; bf16_t* outb; float* part; unsigned char* out8; float accscale;
    DI void operator()(const f32x4 (&acc)[2][2][4][2], const pg8::UnitD& u, int wr, int wc, int fr, int fq) const {
        { int ln_ = threadIdx.x; asm volatile("" : "+v"(ln_)); fr = ln_ & 15; fq = (ln_ >> 4) & 3; }
        const int row0 = u.pm * 256 + wr * 64 + fr, col0 = u.pn * 256 + wc * 32 + 8 * fq;
#pragma unroll
        for (int ai = 0; ai < 2; ++ai)
#pragma unroll
            for (int m = 0; m < 4; ++m) { const size_t row = (size_t)(row0 + ai * 128 + m * 16); float ss = 0.f;
#pragma unroll
                for (int bj = 0; bj < 2; ++bj) { const size_t idx = row * 2048 + col0 + bj * 128;
                    f32x4 v0 = acc[ai][bj][m][0] * accscale + *(const f32x4*)(base + idx), v1 = acc[ai][bj][m][1] * accscale + *(const f32x4*)(base + idx + 4);
                    *(f32x4*)(out + idx) = v0; *(f32x4*)(out + idx + 4) = v1;
                    if (out8) { u32x2 w; w.x = __builtin_amdgcn_cvt_pk_fp8_f32(v0[0] * 16.f, v0[1] * 16.f, 0u, false); w.x = __builtin_amdgcn_cvt_pk_fp8_f32(v0[2] * 16.f, v0[3] * 16.f, w.x, true);
                        w.y = __builtin_amdgcn_cvt_pk_fp8_f32(v1[0] * 16.f, v1[1] * 16.f, 0u, false); w.y = __builtin_amdgcn_cvt_pk_fp8_f32(v1[2] * 16.f, v1[3] * 16.f, w.y, true); *(u32x2*)(out8 + idx) = w; }
                    if (outb) { u32x4 w; w.x = pk2(v0[0], v0[1]); w.y = pk2(v0[2], v0[3]); w.z = pk2(v1[0], v1[1]); w.w = pk2(v1[2], v1[3]); *(u32x4*)(outb + idx) = w; }
                    ss += (v0[0] * v0[0] + v0[1] * v0[1]) + (v0[2] * v0[2] + v0[3] * v0[3]) + (v1[0] * v1[0] + v1[1] * v1[1]) + (v1[2] * v1[2] + v1[3] * v1[3]); }
                if (part) { ss += __shfl_xor(ss, 16); ss += __shfl_xor(ss, 32); if (fq == 0) part[row * 32 + u.pn * 4 + wc] = ss; } }
    }
};

struct EpiQ {
    static constexpr bool AFTER_DRAIN = false;
    unsigned char* out8; float* part;
    DI void operator()(const f32x4 (&acc)[2][2][4][2], const pg8::UnitD& u, int wr, int wc, int fr, int fq) const {
        { int ln_ = threadIdx.x; asm volatile("" : "+v"(ln_)); fr = ln_ & 15; fq = (ln_ >> 4) & 3; }
        const int row0 = u.pm * 256 + wr * 64 + fr, col0 = u.pn * 256 + wc * 32 + 8 * fq;
#pragma unroll
        for (int ai = 0; ai < 2; ++ai)
#pragma unroll
            for (int m = 0; m < 4; ++m) { const size_t row = (size_t)(row0 + ai * 128 + m * 16); float ss = 0.f;
#pragma unroll
                for (int bj = 0; bj < 2; ++bj) { const size_t idx = row * 2048 + col0 + bj * 128; const f32x4 v0 = acc[ai][bj][m][0] * (1.f / 1024.f), v1 = acc[ai][bj][m][1] * (1.f / 1024.f);
                    u32x2 w; w.x = __builtin_amdgcn_cvt_pk_fp8_f32(v0[0] * 16.f, v0[1] * 16.f, 0u, false); w.x = __builtin_amdgcn_cvt_pk_fp8_f32(v0[2] * 16.f, v0[3] * 16.f, w.x, true);
                    w.y = __builtin_amdgcn_cvt_pk_fp8_f32(v1[0] * 16.f, v1[1] * 16.f, 0u, false); w.y = __builtin_amdgcn_cvt_pk_fp8_f32(v1[2] * 16.f, v1[3] * 16.f, w.y, true); *(u32x2*)(out8 + idx) = w;
                    ss += (v0[0] * v0[0] + v0[1] * v0[1]) + (v0[2] * v0[2] + v0[3] * v0[3]) + (v1[0] * v1[0] + v1[1] * v1[1]) + (v1[2] * v1[2] + v1[3] * v1[3]); }
                ss += __shfl_xor(ss, 16); ss += __shfl_xor(ss, 32); if (fq == 0) part[row * 32 + u.pn * 4 + wc] = ss; }
    }
};

struct SchedXS {
    int G, c; const unsigned char* ws;
    DI bool next(int i, pg8::UnitD& u) const {
        const int L = i * G + c; if (L >= 256) return false;
        u.rows = nullptr; u.nvalid = 0; u.e = 0;
        const int q = L & 127, bh = q >> 3, t8 = q & 7, b = bh >> 2, h = bh & 3;
        u.pm = b; u.pn = h; u.x0 = t8;
        if (L < 128) { u.type = 0; u.lda = 2048u; u.ldb = 512u;
            u.A = (const char*)(ws + WS_QF8) + (size_t)(b * 2048 + t8 * 256) * 2048 + h * 512; u.B = (const char*)(ws + WS_KN8) + (size_t)(bh * 256) * 512; }
        else { u.type = 1; u.lda = 2048u; u.ldb = 2048u;
            u.A = (const char*)(ws + WS_WO) + (size_t)(t8 * 256) * 2048 + h * 512; u.B = (const char*)(ws + WS_VF8) + (size_t)(b * 256) * 2048 + h * 512; }
        return true;
    }
};
struct EpiXS {
    static constexpr bool AFTER_DRAIN = false;
    unsigned char* P; unsigned char* VWT; const float* part1; const float* partq; LAS float* red;
    DI void operator()(const f32x4 (&acc)[2][2][4][2], const pg8::UnitD& u, int wr, int wc, int fr, int fq) const {
        { int ln_ = threadIdx.x; asm volatile("" : "+v"(ln_)); fr = ln_ & 15; fq = (ln_ >> 4) & 3; }
        const int b = u.pm, h = u.pn, t8 = u.x0;
        const int col0 = wc * 32 + 8 * fq;
        if (u.type == 1) {
            unsigned char* Vu = VWT + ((size_t)b * 2048 + t8 * 256) * 1024 + h * 256;
#pragma unroll
            for (int ai = 0; ai < 2; ++ai)
#pragma unroll
                for (int m = 0; m < 4; ++m) { const unsigned rl = (unsigned)(ai * 128 + wr * 64 + m * 16 + fr);
#pragma unroll
                    for (int bj = 0; bj < 2; ++bj) { const f32x4 v0 = acc[ai][bj][m][0] * (32.f / 1024.f), v1 = acc[ai][bj][m][1] * (32.f / 1024.f);
                        u32x2 w; w.x = __builtin_amdgcn_cvt_pk_fp8_f32(v0[0], v0[1], 0u, false); w.x = __builtin_amdgcn_cvt_pk_fp8_f32(v0[2], v0[3], w.x, true);
                        w.y = __builtin_amdgcn_cvt_pk_fp8_f32(v1[0], v1[1], 0u, false); w.y = __builtin_amdgcn_cvt_pk_fp8_f32(v1[2], v1[3], w.y, true);
                        *(u32x2*)(Vu + (rl * 1024u + (unsigned)(bj * 128 + col0))) = w; } }
            return;
        }
        const size_t row0 = (size_t)b * 2048 + t8 * 256;
        const char* p1u = (const char*)(part1 + row0 * 32); const char* pqu = (const char*)(partq + row0 * 32 + h * 8); unsigned char* Pu = P + row0 * 1024 + h * 256;
        float rsc[2][4];
#pragma unroll
        for (int ai = 0; ai < 2; ++ai)
#pragma unroll
            for (int m = 0; m < 4; ++m) { const unsigned rl = (unsigned)(ai * 128 + wr * 64 + m * 16 + fr);
                const f32x4 p0 = *(const f32x4*)(p1u + (rl * 32u + (unsigned)fq * 8u) * 4u), p1 = *(const f32x4*)(p1u + (rl * 32u + (unsigned)fq * 8u + 4u) * 4u);
                float s1 = (p0[0] + p0[1]) + (p0[2] + p0[3]) + (p1[0] + p1[1]) + (p1[2] + p1[3]);
                const f32x2 pq = *(const f32x2*)(pqu + (rl * 32u + (unsigned)fq * 2u) * 4u);
                float sq = pq[0] + pq[1];
                s1 = quad_sum_16_32(s1); sq = quad_sum_16_32(sq);
                rsc[ai][m] = __builtin_amdgcn_rsqf(sq * (1.f / 512.f) + EPS_ * (s1 * (1.f / 2048.f) + EPS_)) * (1.4426950408889634f / 2048.f);
                float ps = 0.f;
#pragma unroll
                for (int bj = 0; bj < 2; ++bj)
#pragma unroll
                    for (int n = 0; n < 2; ++n)
#pragma unroll
                        for (int e = 0; e < 4; ++e) ps += __builtin_amdgcn_exp2f(fminf(acc[ai][bj][m][n][e] * rsc[ai][m], 100.f));
                ps = quad_sum_16_32(ps);
                if (fq == 0) red[rl * 4 + wc] = ps;
                __builtin_amdgcn_sched_barrier(0); }
        __syncthreads();
        { int ln_ = threadIdx.x; asm volatile("" : "+v"(ln_)); fr = ln_ & 15; fq = (ln_ >> 4) & 3; }
#pragma unroll
        for (int ai = 0; ai < 2; ++ai)
#pragma unroll
            for (int m = 0; m < 4; ++m) { const unsigned rl = (unsigned)(ai * 128 + wr * 64 + m * 16 + fr);
                const f32x4 t = *(const LAS f32x4*)(red + rl * 4); const float inv = 256.f * __builtin_amdgcn_rcpf((t[0] + t[1]) + (t[2] + t[3])); float rs = rsc[ai][m]; asm volatile("" : "+v"(rs));
#pragma unroll
                for (int bj = 0; bj < 2; ++bj) { float x[8];
#pragma unroll
                    for (int n = 0; n < 2; ++n)
#pragma unroll
                        for (int e = 0; e < 4; ++e) x[n * 4 + e] = __builtin_amdgcn_exp2f(fminf(acc[ai][bj][m][n][e] * rs, 100.f)) * inv;
                    u32x2 w; w.x = __builtin_amdgcn_cvt_pk_fp8_f32(x[0], x[1], 0u, false); w.x = __builtin_amdgcn_cvt_pk_fp8_f32(x[2], x[3], w.x, true);
                    w.y = __builtin_amdgcn_cvt_pk_fp8_f32(x[4], x[5], 0u, false); w.y = __builtin_amdgcn_cvt_pk_fp8_f32(x[6], x[7], w.y, true);
                    *(u32x2*)(Pu + (rl * 1024u + (unsigned)(bj * 128 + wc * 32 + 8 * fq))) = w; } }
        __syncthreads();
    }
};

constexpr int HNP = 2052;
DI void p8_route(Frame& F, const ArgP& a) {
    LAS float* s_hn = (LAS float*)F.lds; LAS float* s_part = (LAS float*)(F.lds + 16 * HNP * 4); LAS float* s_log = s_part + 8 * 16 * 32; LAS int* s_slot = (LAS int*)(s_log + 16 * 32);
    LAS int* s_cnt = s_slot + 64; LAS int* s_base = s_cnt + 32;
    const float* h2 = (const float*)(F.ws + WS_H2); unsigned char* xg = (unsigned char*)(F.ws + WS_XG);
    float* gate_of = (float*)(F.ws + WS_GATEOF); int* tok_e = (int*)(F.ws + WS_TOKE);
    const float* rw = a.in(I_RW); const float* rb = a.in(I_RB); const float* g3 = a.in(I_GFFN);
    const int lane = F.lane, wave = F.wave, tid = F.tid, hh = lane >> 5;
    for (int task = F.vcu; task < NTOK / 16; task += F.G) {
        const int tb = task * 16;
#pragma unroll
        for (int q = 0; q < 2; ++q) { const int tl = 2 * wave + q; const size_t tok = (size_t)(tb + tl);
            const f32x4* xr = (const f32x4*)(h2 + tok * 2048) + lane;
            f32x4 v[8]; float s = 0.f;
#pragma unroll
            for (int j = 0; j < 8; ++j) { v[j] = xr[64 * j]; s += (v[j].x * v[j].x + v[j].y * v[j].y) + (v[j].z * v[j].z + v[j].w * v[j].w); }
            const float rstd = 1.f / sqrtf(wave_sum(s) * (1.f / 2048.f) + EPS_);
#pragma unroll
            for (int j = 0; j < 8; ++j) { const f32x4 gg = ((const f32x4*)g3)[lane + 64 * j]; const f32x4 y = v[j] * rstd * gg;
                *(LAS f32x4*)(s_hn + tl * HNP + (lane + 64 * j) * 4) = y; } }
        __syncthreads();
        {
            f32x4 acc0 = {0.f, 0.f, 0.f, 0.f}, acc1 = {0.f, 0.f, 0.f, 0.f};
            const int kq = lane >> 4, c16 = lane & 15;
            const LAS float* ap = s_hn + c16 * HNP + 256 * wave; const float* bp = rw + (size_t)(256 * wave + kq) * 32 + c16;
#pragma unroll 8
            for (int j = 0; j < 64; ++j) { const f32x4 a4 = *(const LAS f32x4*)(ap + 4 * j);
                const float av = (kq == 0) ? a4.x : (kq == 1) ? a4.y : (kq == 2) ? a4.z : a4.w;
                const float b0 = bp[(size_t)(4 * j) * 32], b1 = bp[(size_t)(4 * j) * 32 + 16];
                acc0 = __builtin_amdgcn_mfma_f32_16x16x4f32(av, b0, acc0, 0, 0, 0);
                acc1 = __builtin_amdgcn_mfma_f32_16x16x4f32(av, b1, acc1, 0, 0, 0); }
            LAS float* pp = s_part + wave * 512 + c16;
#pragma unroll
            for (int r = 0; r < 4; ++r) { pp[(4 * kq + r) * 32] = acc0[r]; pp[(4 * kq + r) * 32 + 16] = acc1[r]; }
        }
        __syncthreads();
        {
            const int tt = tid >> 5, e = tid & 31; float lg = rb[e];
#pragma unroll
            for (int w = 0; w < 8; ++w) lg += s_part[w * 512 + tt * 32 + e];
            if (tid < 32) s_cnt[tid] = 0;
            float val[4]; int idx[4]; float cur = lg;
#pragma unroll
            for (int k = 0; k < 4; ++k) { float bv = cur; int bi = e;
#pragma unroll
                for (int o = 1; o < 32; o <<= 1) { const float ov = __shfl_xor(bv, o); const int oi = __shfl_xor(bi, o); if (ov > bv || (ov == bv && oi < bi)) { bv = ov; bi = oi; } }
                val[k] = bv; idx[k] = bi; if (e == bi) cur = -INFINITY; }
            __syncthreads();
            int myrank = 0, myexp = 0; float mygate = 0.f;
            if (e < 4) { const float sum = (__expf(val[0] - val[0]) + __expf(val[1] - val[0])) + (__expf(val[2] - val[0]) + __expf(val[3] - val[0]));
                const float mv = (e == 0) ? val[0] : (e == 1) ? val[1] : (e == 2) ? val[2] : val[3]; myexp = (e == 0) ? idx[0] : (e == 1) ? idx[1] : (e == 2) ? idx[2] : idx[3];
                mygate = __expf(mv - val[0]) / sum; myrank = __hip_atomic_fetch_add(&s_cnt[myexp], 1, __ATOMIC_RELAXED, __HIP_MEMORY_SCOPE_WORKGROUP); }
            __syncthreads();
            if (tid < 32) { const int c = s_cnt[tid]; s_base[tid] = c ? (int)__hip_atomic_fetch_add(F.ctl + CW_CNT + 64 * tid, (unsigned)c, __ATOMIC_RELAXED, __HIP_MEMORY_SCOPE_AGENT) : 0; }
            __syncthreads();
            if (e < 4) { const int slot = myexp * 8192 + s_base[myexp] + myrank; const int tok = tb + tt;
                gate_of[slot] = mygate; tok_e[tok * 4 + e] = slot; s_slot[tt * 4 + e] = slot; }
        }
        __syncthreads();
#pragma unroll
        for (int q = 0; q < 2; ++q) { const int tl = 2 * wave + q;
            unsigned o[8];
#pragma unroll
            for (int j = 0; j < 8; ++j) { const f32x4 y = *(const LAS f32x4*)(s_hn + tl * HNP + (lane + 64 * j) * 4);
                unsigned w = 0u; w = __builtin_amdgcn_cvt_pk_fp8_f32(y.x * 4.f, y.y * 4.f, w, false); w = __builtin_amdgcn_cvt_pk_fp8_f32(y.z * 4.f, y.w * 4.f, w, true); o[j] = w; }
#pragma unroll
            for (int k = 0; k < 4; ++k) { unsigned* o4 = (unsigned*)(xg + (size_t)s_slot[tl * 4 + k] * 2048) + lane;
#pragma unroll
                for (int j = 0; j < 8; ++j) o4[64 * j] = o[j]; } }
        __syncthreads();
    }
}

DI void moe_tables(Frame& F) {
    if (F.tid == 0) { unsigned base = 0u;
        for (int e = 0; e < 32; ++e) { const unsigned c = F.ctl[CW_CNT + 64 * e], mt = (c + 255u) >> 8; F.MISC[16 + e] = c; F.MISC[48 + e] = base; F.MISC[80 + e] = mt; base += mt; }
        F.MISC[112] = base; }
    __syncthreads();
}
DI int ldsu(volatile LAS unsigned* p) { return __builtin_amdgcn_readfirstlane((int)*p); }
template <int NTN  >
struct SchedMoe {
    int G, c; const unsigned char* ws; volatile LAS unsigned* MISC;
    DI bool next(int i, pg8::UnitD& u) const {
        const int L = i * G + c; const int total = ldsu(MISC + 112) * NTN; if (L >= total) return false;
        int e = 0;
        for (int k = 0; k < 32; ++k) { if (L >= (ldsu(MISC + 48 + k) + ldsu(MISC + 80 + k)) * NTN) e = k + 1; }
        const int tb = ldsu(MISC + 48 + e), mte = ldsu(MISC + 80 + e), cnt = ldsu(MISC + 16 + e);
        const int local = L - tb * NTN, nt = local / mte, mt = local % mte;
        u.type = 0; u.e = e; u.pn = nt; u.pm = tb + mt; u.x0 = mt; u.lda = 2048u; u.ldb = 2048u;
        u.rows = nullptr; u.nvalid = cnt - mt * 256;
        if (NTN == 16) { u.A = (const char*)(ws + WS_XG) + ((size_t)e * 8192 + (size_t)mt * 256) * 2048;
            u.B = (const char*)(ws + WS_W1) + ((size_t)e * 4096 + (size_t)nt * 256) * 2048; }
        else { u.A = (const char*)(ws + WS_ACT) + ((size_t)e * 8192 + (size_t)mt * 256) * 2048;
            u.B = (const char*)(ws + WS_W2) + ((size_t)e * 2048 + (size_t)nt * 256) * 2048; }
        return true;
    }
};
struct EpiMoe1 {
    static constexpr bool AFTER_DRAIN = false;
    unsigned char* act; const float* b1;
    DI void operator()(const f32x4 (&acc)[2][2][4][2], const pg8::UnitD& u, int wr, int wc, int fr, int fq) const {
        { int ln_ = threadIdx.x; asm volatile("" : "+v"(ln_)); fr = ln_ & 15; fq = (ln_ >> 4) & 3; }
        const int j0 = u.pn * 128 + wc * 32 + 8 * fq;
        const float* bg = b1 + (size_t)u.e * 4096 + j0; const float* bu = bg + 2048;
        const f32x4 bg0 = *(const f32x4*)bg, bg1 = *(const f32x4*)(bg + 4), bu0 = *(const f32x4*)bu, bu1 = *(const f32x4*)(bu + 4);
#pragma unroll
        for (int ai = 0; ai < 2; ++ai)
#pragma unroll
            for (int m = 0; m < 4; ++m) { const size_t row = (size_t)u.e * 8192 + u.x0 * 256 + ai * 128 + wr * 64 + m * 16 + fr;
                float o[8];
#pragma unroll
                for (int n = 0; n < 2; ++n)
#pragma unroll
                    for (int e = 0; e < 4; ++e) { const float g = fminf(acc[ai][0][m][n][e] * (1.f / 256.f) + (n ? bg1[e] : bg0[e]), 7.f);
                        const float uu = fminf(fmaxf(acc[ai][1][m][n][e] * (1.f / 256.f) + (n ? bu1[e] : bu0[e]), -7.f), 7.f);
                        o[n * 4 + e] = g / (1.f + __expf(-1.702f * g)) * (uu + 1.f) * 4.f; }
                u32x2 w; w.x = __builtin_amdgcn_cvt_pk_fp8_f32(o[0], o[1], 0u, false); w.x = __builtin_amdgcn_cvt_pk_fp8_f32(o[2], o[3], w.x, true);
                w.y = __builtin_amdgcn_cvt_pk_fp8_f32(o[4], o[5], 0u, false); w.y = __builtin_amdgcn_cvt_pk_fp8_f32(o[6], o[7], w.y, true);
                *(u32x2*)(act + row * 2048 + j0) = w; }
    }
};
struct EpiMoe2 {
    static constexpr bool AFTER_DRAIN = false;
    bf16_t* y; const float* b2; const float* gate_of;
    DI void operator()(const f32x4 (&acc)[2][2][4][2], const pg8::UnitD& u, int wr, int wc, int fr, int fq) const {
        { int ln_ = threadIdx.x; asm volatile("" : "+v"(ln_)); fr = ln_ & 15; fq = (ln_ >> 4) & 3; }
        const int col0 = u.pn * 256 + wc * 32 + 8 * fq;
        const float* bp = b2 + (size_t)u.e * 2048 + col0;
#pragma unroll
        for (int ai = 0; ai < 2; ++ai)
#pragma unroll
            for (int m = 0; m < 4; ++m) { const int rl = ai * 128 + wr * 64 + m * 16 + fr; const size_t row = (size_t)u.e * 8192 + u.x0 * 256 + rl;
                const float gt = (rl < u.nvalid) ? gate_of[u.e * 8192 + u.x0 * 256 + rl] : 0.f;
#pragma unroll
                for (int bj = 0; bj < 2; ++bj) { const f32x4 v0 = (acc[ai][bj][m][0] * (1.f / 256.f) + *(const f32x4*)(bp + bj * 128)) * gt, v1 = (acc[ai][bj][m][1] * (1.f / 256.f) + *(const f32x4*)(bp + bj * 128 + 4)) * gt;
                    u32x4 w; w.x = pk2(v0[0], v0[1]); w.y = pk2(v0[2], v0[3]); w.z = pk2(v1[0], v1[1]); w.w = pk2(v1[2], v1[3]);
                    *(u32x4*)(y + row * 2048 + col0 + bj * 128) = w; } }
    }
};

DI void p11_combine(Frame& F, const ArgP& a) {
    const int gw = F.vcu * NWAVES + F.wave, NGW = F.G * NWAVES, lane = F.lane;
    const float* h2 = (const float*)(F.ws + WS_H2); const bf16_t* y = (const bf16_t*)(F.ws + WS_Y);
    const int* tok_e = (const int*)(F.ws + WS_TOKE);
    for (int t = gw; t < NTOK; t += NGW) {
        size_t yrow[4];
#pragma unroll
        for (int k = 0; k < 4; ++k) yrow[k] = (size_t)tok_e[t * 4 + k] * 2048;
#pragma unroll
        for (int j = 0; j < 8; ++j) { const int c = (lane + 64 * j) * 4;
            f32x4 v = *(const f32x4*)(h2 + (size_t)t * 2048 + c);
#pragma unroll
            for (int k = 0; k < 4; ++k) { const u32x2 w = *(const u32x2*)(y + yrow[k] + c); v.x += bflo(w.x); v.y += bfhi(w.x); v.z += bflo(w.y); v.w += bfhi(w.y); }
            *(f32x4*)(a.out() + (size_t)t * 2048 + c) = v; }
    }
}

#ifndef MK_PER_PHASE
#define MK_PER_PHASE 0
#endif
#ifndef MK_LAST_PHASE
#define MK_LAST_PHASE 12
#endif
constexpr int N_PHASES = MK_LAST_PHASE;

__global__ void __launch_bounds__(NWAVES * 64, 2) mega_fwd(Args args_) {
    const ArgP args{};
    extern __shared__ __attribute__((aligned(16))) unsigned char lds_raw[];
    Frame F;
    F.lds = (LAS unsigned char*)lds_raw;
    F.MISC = (volatile LAS unsigned*)(F.lds + MISC_OFF);
    F.tid = threadIdx.x; F.lane = F.tid & 63; F.wave = __builtin_amdgcn_readfirstlane(F.tid >> 6);
    F.G = gridDim.x; { const int bx = blockIdx.x; F.vcu = (F.G % 8 == 0) ? (bx % 8) * (F.G / 8) + bx / 8 : bx; }
    F.ws = args_.ws; F.ctl = (unsigned*)(args_.ws + WS_CTL);
    for (int u = F.tid; u < 256; u += NWAVES * 64) F.MISC[u] = 0u;
    __syncthreads();
    XcdBarrier bar; bar.bar = F.ctl + CW_BAR; bar.x = 0; bar.st = nullptr;
    const int lo = args_.ph_lo, hi = args_.ph_hi;
    if (hi - lo > 1) bar = xcd_barrier_post(F.ctl + CW_BAR, F.MISC + 8);
#ifndef MK_PHASE_MASK
#define MK_PHASE_MASK 0xFFFF
#endif
#define IN(k) (((MK_PHASE_MASK >> (k)) & 1) && lo <= (k) && (k) < hi)
#define SEAM(k) do { if (IN(k) && IN((k) + 1)) xcd_barrier(bar); } while (0)
#define FRESH() do { int t_ = threadIdx.x; asm volatile("" : "+v"(t_)); F.tid = t_; F.lane = t_ & 63; F.wave = __builtin_amdgcn_readfirstlane(t_ >> 6); } while (0)
    unsigned char* ws = args_.ws;

    if (IN(0)) { FRESH(); p0_prologue(F, args); }
    SEAM(0);
    if (IN(1)) { FRESH();
        const bool conv_first = (F.vcu & 1) == 0;
        if (conv_first) { conv_share(F, args); __syncthreads(); }
        SchedP1 S{F.G, F.vcu, ws, 0, 32 * 23};
        EpiP1 E{(bf16_t*)(ws + WS_PROJ), (float*)(ws + WS_DT), (bf16_t*)(ws + WS_KVRAW), args.in(I_DAQG), args.in(I_DAKG), (unsigned char*)(ws + WS_VF8)};
        pg8::gemm_phase<EpiP1, SchedP1, false, true>(F.lds + RING_OFF, 32, S, E);
        if (!conv_first) { __syncthreads(); conv_share(F, args); }
    }
    SEAM(1);
    if (IN(2)) { FRESH();
        if ((F.vcu & 3) == 1) {
            SchedP1 S{(F.G + 3) >> 2, F.vcu >> 2, ws, 32 * 23, 32 * 23 + 64};
            EpiP1 E{(bf16_t*)(ws + WS_PROJ), (float*)(ws + WS_DT), (bf16_t*)(ws + WS_KVRAW), args.in(I_DAQG), args.in(I_DAKG), (unsigned char*)(ws + WS_VF8)};
            pg8::gemm_phase<EpiP1, SchedP1, false, true>(F.lds + RING_OFF, 32, S, E);
            __syncthreads();
        }
        if ((F.vcu & 3) == 0) { for (int u = F.vcu >> 2; u < 64; u += (F.G + 3) >> 2) ssd_unit(F, args, u >> 4, u & 15); }
        __syncthreads();
        attn_phase_da(F);
        __syncthreads();
        conv_queue(F, args);
    }
    SEAM(2);
    if (IN(3)) { FRESH(); kprep(F, args); p3_finalize(F, args); }
    SEAM(3);
    if (IN(4)) { FRESH();
        SchedDense S{F.G, F.vcu, 32, 8, (const char*)(ws + WS_YCAT), (const char*)(ws + WS_WOUT), 4096u, 4096u, 1 << 30, 0};
#if MK_LAST_PHASE == 5
        EpiResid E{args.in(I_X), args_.out, nullptr, nullptr, nullptr, 1.f};
#else
        EpiResid E{args.in(I_X), (float*)(ws + WS_H1), nullptr, (float*)(ws + WS_PART1), (unsigned char*)(ws + WS_H1F8), 1.f};
#endif
        pg8::gemm_phase<EpiResid, SchedDense, false, true>(F.lds + RING_OFF, 32, S, E);
    }
    SEAM(4);
    if (IN(5)) { FRESH();
        SchedDense S{F.G, F.vcu, 32, 8, (const char*)(ws + WS_H1F8), (const char*)(ws + WS_WQ), 2048u, 2048u, 1 << 30, 0};
        EpiQ E{(unsigned char*)(ws + WS_QF8), (float*)(ws + WS_PARTQ)};
        pg8::gemm_phase<EpiQ, SchedDense, false, true, true>(F.lds + RING_OFF, 16, S, E);
    }
    SEAM(5);
    if (IN(6)) { FRESH();
        SchedXS S{F.G, F.vcu, ws};
        EpiXS E{(unsigned char*)(ws + WS_P8), (unsigned char*)(ws + WS_VWT8), (const float*)(ws + WS_PART1), (const float*)(ws + WS_PARTQ), (LAS float*)(F.lds + RING_BYTES)};
        pg8::gemm_phase<EpiXS, SchedXS, false, true, true>(F.lds + RING_OFF, 4, S, E);
    }
    SEAM(6);
    if (IN(7)) { FRESH();
        SchedDense S{F.G, F.vcu, 32, 8, (const char*)(ws + WS_P8), (const char*)(ws + WS_VWT8), 1024u, 1024u, 8, (size_t)2048 * 1024};
#if MK_LAST_PHASE == 8
        EpiResid E{(const float*)(ws + WS_H1), args_.out, nullptr, nullptr, nullptr, 1.f / 8192.f};
#else
        EpiResid E{(const float*)(ws + WS_H1), (float*)(ws + WS_H2), nullptr, nullptr, nullptr, 1.f / 8192.f};
#endif
        pg8::gemm_phase<EpiResid, SchedDense, false, true, true>(F.lds + RING_OFF, 8, S, E);
    }
    SEAM(7);
    if (IN(8)) { FRESH(); p8_route(F, args); }
    SEAM(8);
    if (IN(9)) { FRESH();
        moe_tables(F);
        SchedMoe<16> S{F.G, F.vcu, ws, F.MISC};
        EpiMoe1 E{(unsigned char*)(ws + WS_ACT), args.in(I_B1)};
        pg8::gemm_phase<EpiMoe1, SchedMoe<16>, false, true, true>(F.lds + RING_OFF, 16, S, E);
    }
    SEAM(9);
    if (IN(10)) { FRESH();
        moe_tables(F);
        SchedMoe<8> S{F.G, F.vcu, ws, F.MISC};
        EpiMoe2 E{(bf16_t*)(ws + WS_Y), args.in(I_B2), (const float*)(ws + WS_GATEOF)};
        pg8::gemm_phase<EpiMoe2, SchedMoe<8>, false, true, true>(F.lds + RING_OFF, 16, S, E);
    }
    SEAM(10);
    if (IN(11)) { FRESH(); p11_combine(F, args); }
#undef IN
#undef SEAM
}

extern "C" void kernel_launch(void* const* d_in, const int* in_sizes, int n_in, void* d_out, int out_size, void* d_ws, size_t ws_size, hipStream_t stream) {
    static int grid = 0;
    if (grid == 0) {
        if (n_in != 32 || out_size != NTOK * 2048 || ws_size < WS_END) { fprintf(stderr, "kernel_launch: unexpected shapes (n_in %d out %d ws %zu); nothing launched\n", n_in, out_size, ws_size); grid = -1; return; }
        int dev = 0, cus = 0, per_cu = 0;
        if (hipGetDevice(&dev) != hipSuccess || hipDeviceGetAttribute(&cus, hipDeviceAttributeMultiprocessorCount, dev) != hipSuccess) { grid = -1; return; }
        if (hipFuncSetAttribute((const void*)mega_fwd, hipFuncAttributeMaxDynamicSharedMemorySize, LDS_BYTES) != hipSuccess) { fprintf(stderr, "kernel_launch: hipFuncSetAttribute failed\n"); grid = -1; return; }
        if (hipOccupancyMaxActiveBlocksPerMultiprocessor(&per_cu, (const void*)mega_fwd, NWAVES * 64, LDS_BYTES) != hipSuccess || per_cu < 1) { fprintf(stderr, "kernel_launch: occupancy query says %d\n", per_cu); }
        (void)hipGetLastError();
        if (cus < 256) { fprintf(stderr, "kernel_launch: needs 256 CUs, found %d; nothing launched\n", cus); grid = -1; return; }
        grid = 256;
    }
    if (grid < 0) return;
    if (hipMemsetAsync((char*)d_ws + WS_CTL, 0, CTL_ZERO_BYTES, stream) != hipSuccess) return;
    Args a{};
    for (int i = 0; i < 32; ++i) a.in[i] = (const float*)d_in[i];
    a.out = (float*)d_out; a.ws = (unsigned char*)d_ws;
#if MK_PER_PHASE
    for (int p = 0; p < N_PHASES; ++p) { a.ph_lo = p; a.ph_hi = p + 1; hipLaunchKernelGGL(mega_fwd, dim3(grid), dim3(NWAVES * 64), LDS_BYTES, stream, a); }
#else
    a.ph_lo = 0; a.ph_hi = N_PHASES;
    hipLaunchKernelGGL(mega_fwd, dim3(grid), dim3(NWAVES * 64), LDS_BYTES, stream, a);
#ifdef MK_PROBE_LO
    for (int p = MK_PROBE_LO; p < MK_PROBE_HI; ++p) { a.ph_lo = p; a.ph_hi = p + 1; hipLaunchKernelGGL(mega_fwd, dim3(grid), dim3(NWAVES * 64), LDS_BYTES, stream, a); }
#endif
#endif
}
```

```cpp
#define MK_PER_PHASE 0
#define MK_LAST_PHASE 12
#include <hip/hip_runtime.h>
#include <hip/hip_bf16.h>
#include <cstdio>
#include <cstdint>
#include <cmath>

#define GAS __attribute__((address_space(1)))
#define LAS __attribute__((address_space(3)))
typedef unsigned short bf16_t;
typedef short bf16x8 __attribute__((ext_vector_type(8)));
typedef float f32x2 __attribute__((ext_vector_type(2)));
typedef float f32x4 __attribute__((ext_vector_type(4)));
typedef float f32x16 __attribute__((ext_vector_type(16)));
typedef unsigned u32x2 __attribute__((ext_vector_type(2)));
typedef unsigned u32x4 __attribute__((ext_vector_type(4)));
typedef __bf16 bf16x2_t __attribute__((ext_vector_type(2)));

#define DI __device__ __forceinline__
DI unsigned pk2(float lo, float hi) { f32x2 v = {lo, hi}; bf16x2_t b = __builtin_convertvector(v, bf16x2_t); return __builtin_bit_cast(unsigned, b); }
DI float bflo(unsigned u) { return __uint_as_float(u << 16); }
DI float bfhi(unsigned u) { return __uint_as_float(u & 0xffff0000u); }
DI float bf2f(bf16_t h) { return __uint_as_float(((unsigned)h) << 16); }
DI float wave_sum(float v) {
#pragma unroll
    for (int o = 1; o < 64; o <<= 1) v += __shfl_xor(v, o);
    return v;
}
DI float quad_sum_16_32(float v) {
    int l_ = threadIdx.x; asm volatile("" : "+v"(l_));
    const int a16 = ((l_ ^ 16) & 63) << 2, a32 = ((l_ ^ 32) & 63) << 2;
    v += __builtin_bit_cast(float, __builtin_amdgcn_ds_bpermute(a16, __builtin_bit_cast(int, v)));
    v += __builtin_bit_cast(float, __builtin_amdgcn_ds_bpermute(a32, __builtin_bit_cast(int, v)));
    return v;
}
DI float siluf(float x) { return x / (1.f + __expf(-x)); }

constexpr int DM_ = 2048, NB = 4, SEQ_ = 2048, NTOK = NB * SEQ_;
constexpr int PP = 5632;
constexpr int PC_XBC = 1024, PC_Q = 2560, PC_K = 3584, PC_V = 4608, PC_DT = 5632;
constexpr int WIN_ROWS = 5888;
constexpr int NEXP = 32, MEMLEN = 256;
constexpr float EPS_ = 1e-6f;
constexpr float LAM_INIT = 0.2f;

namespace pg8 {
constexpr int BM = 256, BK = 64, HALF = 128, HTB = HALF * BK * 2  , STAGE_BYTES = 8 * HTB;
DI int lds_byte(int r, int c) { const int st = (r >> 4) * 2 + (c >> 5), rr = r & 15, cc = c & 31, ob = rr * 64 + cc * 2; return st * 1024 + (ob ^ (((ob >> 9) & 1) << 5)); }
DI void stage_rc(int b, int& R, int& C) { const int st = b / 1024, sb = b % 1024, swz = sb ^ (((sb >> 9) & 1) << 5); R = (st >> 1) * 16 + swz / 64; C = (st & 1) * 32 + (swz % 64) / 2; }
DI int perm32(int rho) { const int n = rho >> 4, i = rho & 15; return 8 * (i >> 2) + 4 * n + (i & 3); }

struct UnitD {
    const char* A; const char* B;
    const int* rows;
    unsigned lda, ldb;
    int nvalid;
    int type, pm, pn, e, x0;
};
typedef int v8i_t __attribute__((ext_vector_type(8)));
DI v8i_t cat8(bf16x8 lo, bf16x8 hi) { typedef int v4i_t __attribute__((ext_vector_type(4))); const v4i_t a = __builtin_bit_cast(v4i_t, lo), b = __builtin_bit_cast(v4i_t, hi); return (v8i_t){a[0], a[1], a[2], a[3], b[0], b[1], b[2], b[3]}; }
DI void dense_voff(unsigned lda, unsigned ldb, int tid, unsigned (&vA)[2], unsigned (&vB)[2]) {
#pragma unroll
    for (int i = 0; i < 2; ++i) { int R, C; stage_rc(tid * 16 + i * 8192, R, C); const int Rb = (R & ~31) + perm32(R & 31);
        vA[i] = (unsigned)R * lda + (unsigned)C * 2u; vB[i] = (unsigned)Rb * ldb + (unsigned)C * 2u; }
}
DI void gather_voff(const UnitD& u, int tid, unsigned (&gA)[2][2]) {
#pragma unroll
    for (int i = 0; i < 2; ++i) { int R, C; stage_rc(tid * 16 + i * 8192, R, C);
#pragma unroll
        for (int h = 0; h < 2; ++h) { const int ra = h * 128 + R; const unsigned rowA = (ra < u.nvalid) ? (unsigned)u.rows[ra] : 0u; gA[h][i] = rowA * u.lda + (unsigned)C * 2u; } }
}

template <class Epi, class Sched, bool GATHER, bool ALIGN_EPI, bool FP8 = false>
DI void gemm_phase(LAS unsigned char* lds, int nt, const Sched& S, const Epi& E) {

    const int tid = threadIdx.x, wid = __builtin_amdgcn_readfirstlane(tid >> 6), lane = tid & 63, wr = wid >> 2, wc = wid & 3, fr = lane & 15, fq = lane >> 4;
    const size_t kstep = (size_t)(BK * 2);
    const unsigned ldsb = (unsigned)__builtin_amdgcn_readfirstlane((int)((unsigned)(uintptr_t)lds + (unsigned)wid * 1024u));
    const int aoff = lds_byte(wr * 64 + fr, fq * 8), boff = lds_byte(wc * 32 + fr, fq * 8);
#define PG8_SA(b, h) (((b) * 2 + (h)) * HTB)
#define PG8_SB(b, h) ((4 + (b) * 2 + (h)) * HTB)
#define PG8_STAGE(bufoff, gbase, voff) do { _Pragma("unroll") for (int _i = 0; _i < 2; ++_i) { unsigned keep_; \
        asm volatile("s_mov_b32 %0, m0\n\ts_mov_b32 m0, %3\n\ts_nop 0\n\tglobal_load_lds_dwordx4 %1, %2\n\ts_mov_b32 m0, %0" \
                     : "=&s"(keep_) : "v"((voff)[_i]), "s"((const char*)(gbase)), "s"(ldsb + (unsigned)((bufoff) + _i * 8192)) : "memory"); } } while (0)
#define PG8_STA(bufoff, gbase, h, HS, GA) do { if constexpr (GATHER) { PG8_STAGE(bufoff, gbase, GA[h]); } else { PG8_STAGE(bufoff, (gbase) + (h) * (HS), vA); } } while (0)
#define PG8_STB(bufoff, gbase, h, HS) PG8_STAGE(bufoff, (gbase) + (h) * (HS), vB)
typedef int v4i_t __attribute__((ext_vector_type(4)));
#define PG8_LDA(dst, b, h) do { _Pragma("unroll") for (int m = 0; m < 4; ++m) { if constexpr (FP8) { \
            const v4i_t lo_ = *(const LAS v4i_t*)(lds + PG8_SA(b, h) + aoff + m * 2048), hi_ = *(const LAS v4i_t*)(lds + PG8_SA(b, h) + aoff + m * 2048 + 1024); \
            dst##8[m] = __builtin_shufflevector(lo_, hi_, 0, 1, 2, 3, 4, 5, 6, 7); } \
        else { _Pragma("unroll") for (int k = 0; k < 2; ++k) dst[m][k] = *(const LAS bf16x8*)(lds + PG8_SA(b, h) + aoff + m * 2048 + k * 1024); } } } while (0)
#define PG8_LDB(dst, b, h) do { _Pragma("unroll") for (int n = 0; n < 2; ++n) { if constexpr (FP8) { \
            const v4i_t lo_ = *(const LAS v4i_t*)(lds + PG8_SB(b, h) + boff + n * 2048), hi_ = *(const LAS v4i_t*)(lds + PG8_SB(b, h) + boff + n * 2048 + 1024); \
            dst##8[n] = __builtin_shufflevector(lo_, hi_, 0, 1, 2, 3, 4, 5, 6, 7); } \
        else { _Pragma("unroll") for (int k = 0; k < 2; ++k) dst[n][k] = *(const LAS bf16x8*)(lds + PG8_SB(b, h) + boff + n * 2048 + k * 1024); } } } while (0)
#define PG8_MMA(ai, bj, At, Bt) do { __builtin_amdgcn_s_setprio(1); _Pragma("unroll") for (int m = 0; m < 4; ++m) _Pragma("unroll") for (int n = 0; n < 2; ++n) { \
        if constexpr (FP8) { acc[ai][bj][m][n] = __builtin_amdgcn_mfma_scale_f32_16x16x128_f8f6f4(Bt##8[n], At##8[m], acc[ai][bj][m][n], 0, 0, 0, 0x7f7f7f7f, 0, 0x7f7f7f7f); } \
        else { _Pragma("unroll") for (int k = 0; k < 2; ++k) acc[ai][bj][m][n] = __builtin_amdgcn_mfma_f32_16x16x32_bf16(Bt[n][k], At[m][k], acc[ai][bj][m][n], 0, 0, 0); } } \
        __builtin_amdgcn_s_setprio(0); } while (0)
#define PG8_WAIT_V(n) asm volatile("s_waitcnt vmcnt(" #n ")" ::: "memory")
#define PG8_WAIT_L(n) asm volatile("s_waitcnt lgkmcnt(" #n ")" ::: "memory")
#define PG8_BAR __builtin_amdgcn_s_barrier()
#define PG8_SCHED __builtin_amdgcn_sched_barrier(0)
#define PG8_ITER(A1P, A2P, B2P, HA2, HB2, GA2) do { \
        const char* a3p_ = (A2P) + kstep; const char* b3p_ = (B2P) + kstep; \
        PG8_LDB(B0, 0, 0); PG8_LDB(B1, 0, 1); PG8_SCHED; PG8_LDA(At, 0, 0); PG8_STA(PG8_SA(1, 1), (A1P), 1, hsA, gA); \
        PG8_WAIT_V(8); PG8_WAIT_L(0); PG8_BAR; PG8_MMA(0, 0, At, B0); PG8_MMA(0, 1, At, B1); PG8_BAR; PG8_SCHED; \
        PG8_LDA(At, 0, 1); PG8_STB(PG8_SB(0, 0), (B2P), 0, HB2); PG8_STB(PG8_SB(0, 1), (B2P), 1, HB2); PG8_STA(PG8_SA(0, 0), (A2P), 0, HA2, GA2); \
        PG8_WAIT_V(8); PG8_WAIT_L(0); PG8_BAR; PG8_MMA(1, 0, At, B0); PG8_MMA(1, 1, At, B1); PG8_BAR; PG8_SCHED; \
        PG8_LDB(B0, 1, 0); PG8_LDB(B1, 1, 1); PG8_SCHED; PG8_LDA(At, 1, 0); PG8_STA(PG8_SA(0, 1), (A2P), 1, HA2, GA2); \
        PG8_WAIT_V(8); PG8_WAIT_L(0); PG8_BAR; PG8_MMA(0, 0, At, B0); PG8_MMA(0, 1, At, B1); PG8_BAR; PG8_SCHED; \
        PG8_LDA(At, 1, 1); PG8_STB(PG8_SB(1, 0), b3p_, 0, HB2); PG8_STB(PG8_SB(1, 1), b3p_, 1, HB2); PG8_STA(PG8_SA(1, 0), a3p_, 0, HA2, GA2); \
        PG8_WAIT_V(8); PG8_WAIT_L(0); PG8_BAR; PG8_MMA(1, 0, At, B0); PG8_MMA(1, 1, At, B1); PG8_BAR; PG8_SCHED; \
    } while (0)
    UnitD cur, nxt; int ui = 0;
    if (!S.next(0, cur)) return;
    f32x4 acc[2][2][4][2];
#pragma unroll
    for (int a = 0; a < 2; ++a)
#pragma unroll
        for (int b = 0; b < 2; ++b)
#pragma unroll
            for (int m = 0; m < 4; ++m)
#pragma unroll
                for (int n = 0; n < 2; ++n) acc[a][b][m][n] = (f32x4){0.f, 0.f, 0.f, 0.f};
    bf16x8 At[4][2], B0[2][2], B1[2][2]; v8i_t At8[4], B08[2], B18[2];
    unsigned vA[2], vB[2], gA[2][2], ngA[2][2];
    dense_voff(cur.lda, cur.ldb, tid, vA, vB);
    if constexpr (GATHER) gather_voff(cur, tid, gA);
    const char* cA = cur.A; const char* cB = cur.B;
    size_t hsA = GATHER ? 0 : (size_t)cur.lda * HALF, hsB = (size_t)cur.ldb * HALF;
    PG8_STB(PG8_SB(0, 0), cB, 0, hsB); PG8_STB(PG8_SB(0, 1), cB, 1, hsB); PG8_STA(PG8_SA(0, 0), cA, 0, hsA, gA); PG8_STA(PG8_SA(0, 1), cA, 1, hsA, gA);
    if (wr == 1) PG8_BAR;
    PG8_WAIT_V(2); PG8_BAR;
    PG8_STB(PG8_SB(1, 0), cB + kstep, 0, hsB); PG8_STA(PG8_SA(1, 0), cA + kstep, 0, hsA, gA); PG8_STB(PG8_SB(1, 1), cB + kstep, 1, hsB);
    PG8_WAIT_V(6); PG8_BAR;
    for (;;) {
        const bool has_next = S.next(ui + 1, nxt);
        const char* nA = cA; const char* nB = cB; size_t nhsA = hsA, nhsB = hsB;
        if (has_next) { nA = nxt.A; nB = nxt.B; nhsA = GATHER ? 0 : (size_t)nxt.lda * HALF; nhsB = (size_t)nxt.ldb * HALF; }
        if constexpr (GATHER) {
            if (has_next) gather_voff(nxt, tid, ngA);
            else {
#pragma unroll
                for (int h = 0; h < 2; ++h)
#pragma unroll
                    for (int i = 0; i < 2; ++i) ngA[h][i] = gA[h][i];
            }
        }
#pragma unroll 1
        for (int t = 0; t < nt; t += 2) {
            const bool last = (t == nt - 2);
            const char* a2 = last ? nA : cA + (size_t)(t + 2) * kstep; const char* b2 = last ? nB : cB + (size_t)(t + 2) * kstep;
            const size_t hA2 = last ? nhsA : hsA, hB2 = last ? nhsB : hsB;
            unsigned g2[2][2];
            if constexpr (GATHER) {
#pragma unroll
                for (int h = 0; h < 2; ++h)
#pragma unroll
                    for (int i = 0; i < 2; ++i) g2[h][i] = last ? ngA[h][i] : gA[h][i];
            }
            PG8_ITER(cA + (size_t)(t + 1) * kstep, a2, b2, hA2, hB2, g2);
        }
        if constexpr (ALIGN_EPI) { if (wr == 0) PG8_BAR; }
        if constexpr (!Epi::AFTER_DRAIN) { E(acc, cur, wr, wc, fr, fq); }
        if (!has_next) break;
#pragma unroll
        for (int a = 0; a < 2; ++a)
#pragma unroll
            for (int b = 0; b < 2; ++b)
#pragma unroll
                for (int m = 0; m < 4; ++m)
#pragma unroll
                    for (int n = 0; n < 2; ++n) acc[a][b][m][n] = (f32x4){0.f, 0.f, 0.f, 0.f};
        cur = nxt; cA = nA; cB = nB; hsA = nhsA; hsB = nhsB; ++ui;
        if constexpr (GATHER) {
#pragma unroll
            for (int h = 0; h < 2; ++h)
#pragma unroll
                for (int i = 0; i < 2; ++i) gA[h][i] = ngA[h][i];
        }
        if constexpr (ALIGN_EPI) { if (wr == 1) PG8_BAR; }
    }
    PG8_WAIT_V(0);
    if constexpr (!ALIGN_EPI) { if (wr == 0) PG8_BAR; }
    PG8_BAR;
    if constexpr (Epi::AFTER_DRAIN) { E.fused(acc, cur, wr, wc, fr, fq, lds, wid, lane); }
#undef PG8_SA
#undef PG8_SB
#undef PG8_STAGE
#undef PG8_STA
#undef PG8_STB
#undef PG8_LDA
#undef PG8_LDB
#undef PG8_MMA
#undef PG8_WAIT_V
#undef PG8_WAIT_L
#undef PG8_BAR
#undef PG8_SCHED
#undef PG8_ITER
}
}
namespace attn_body {
using bf16=__hip_bfloat16;
using bf16x8=__attribute__((ext_vector_type(8)))short;
using s16x4=__attribute__((ext_vector_type(4)))short;
using f32x16=__attribute__((ext_vector_type(16)))float;
using u32x4=__attribute__((ext_vector_type(4)))unsigned;
constexpr int BATCH=4,SEQ=2048,D=64,DM=5632,OPITCH=1024;
constexpr int NW=8,QBLK=32,QB=QBLK*NW,KVBLK=64,NQB=SEQ/QB;
constexpr int ATTN_UNIT_ROWS=QB;
__device__ __forceinline__ int crow(int r,int hi){return (r&3)+8*(r>>2)+4*hi;}
#define SBAR() __builtin_amdgcn_sched_barrier(0)
__device__ __forceinline__ void cmask(f32x16&p0,f32x16&p1,int jb,int qrel,int hi){
  const float NEG=-INFINITY; int kb=64*jb+4*hi;
  #pragma unroll
  for(int r=0;r<16;++r){int kv=kb+(r&3)+8*(r>>2); if(kv>qrel)p0[r]=NEG; if(kv+32>qrel)p1[r]=NEG;}
}

constexpr int NSLOT=3, SLOTB=8192;
constexpr int LDS_K=0, LDS_V=NSLOT*SLOTB, LDS_WS=2*NSLOT*SLOTB, LDS_OST=LDS_WS+NW*64*4, LDS_BYTES=LDS_OST+NW*4096;
constexpr float C2=0.125f*1.4426950408889634f;
__device__ __forceinline__ void glds16(const void*gsrc,unsigned lds_dst){unsigned keep;
  asm volatile("s_mov_b32 %0, m0\n\ts_mov_b32 m0, %2\n\ts_nop 0\n\tglobal_load_lds_dwordx4 %1, off\n\ts_mov_b32 m0, %0":"=&s"(keep):"v"(gsrc),"s"(lds_dst):"memory");}
__device__ __forceinline__ float max3f(float a,float b,float c){float r;asm("v_max3_f32 %0, %1, %2, %3":"=v"(r):"v"(a),"v"(b),"v"(c));return r;}
__device__ __forceinline__ float max2f(float a,float b){float r;asm("v_max_f32_e32 %0, %1, %2":"=v"(r):"v"(a),"v"(b));return r;}
__device__ __forceinline__ float fadd_s(float a,float b){float r;asm("v_add_f32_e32 %0, %1, %2":"=v"(r):"v"(a),"v"(b));return r;}
__device__ __forceinline__ float fsub_s(float a,float b){float r;asm("v_sub_f32_e32 %0, %1, %2":"=v"(r):"v"(a),"v"(b));return r;}
typedef float f32x2_t __attribute__((ext_vector_type(2))); typedef __bf16 bf16x2_t __attribute__((ext_vector_type(2)));
__device__ __forceinline__ unsigned cvtpk_s(float lo,float hi){f32x2_t v={lo,hi};bf16x2_t b=__builtin_convertvector(v,bf16x2_t);return __builtin_bit_cast(unsigned,b);}
#define WAIT_BAR(N) asm volatile("s_waitcnt vmcnt(" #N ") lgkmcnt(0)\n\ts_barrier":::"memory")

__device__ __forceinline__ void qkt(f32x16&p0,f32x16&p1,const char*Kslot,const bf16x8*qr,const f32x16&negm,int r32,int hi){
  const char*kb=Kslot+hi*1024+r32*16;
  #pragma unroll
  for(int d0=0;d0<4;++d0){
    const bf16x8 b0=*reinterpret_cast<const bf16x8*>(kb+d0*2048);
    const bf16x8 b1=*reinterpret_cast<const bf16x8*>(kb+d0*2048+512);
    if(d0==0){p0=__builtin_amdgcn_mfma_f32_32x32x16_bf16(b0,qr[0],negm,0,0,0);p1=__builtin_amdgcn_mfma_f32_32x32x16_bf16(b1,qr[0],negm,0,0,0);}
    else{p0=__builtin_amdgcn_mfma_f32_32x32x16_bf16(b0,qr[d0],p0,0,0,0);p1=__builtin_amdgcn_mfma_f32_32x32x16_bf16(b1,qr[d0],p1,0,0,0);}}
}
typedef __attribute__((address_space(3))) const char* lds_cptr;
typedef short v4i16_t __attribute__((ext_vector_type(4)));
__device__ __forceinline__ void kload8(bf16x8*kf,lds_cptr kp){
  kf[0]=*(const __attribute__((address_space(3))) bf16x8*)(kp);      kf[1]=*(const __attribute__((address_space(3))) bf16x8*)(kp+512);
  kf[2]=*(const __attribute__((address_space(3))) bf16x8*)(kp+2048); kf[3]=*(const __attribute__((address_space(3))) bf16x8*)(kp+2560);
  kf[4]=*(const __attribute__((address_space(3))) bf16x8*)(kp+4096); kf[5]=*(const __attribute__((address_space(3))) bf16x8*)(kp+4608);
  kf[6]=*(const __attribute__((address_space(3))) bf16x8*)(kp+6144); kf[7]=*(const __attribute__((address_space(3))) bf16x8*)(kp+6656);
}
__device__ __forceinline__ void kload2(bf16x8*kf,lds_cptr kp,int j){ kf[2*j]=*(const __attribute__((address_space(3))) bf16x8*)(kp+j*2048); kf[2*j+1]=*(const __attribute__((address_space(3))) bf16x8*)(kp+j*2048+512); }
__device__ __forceinline__ s16x4 vtr(lds_cptr p){ return __builtin_bit_cast(s16x4,__builtin_amdgcn_ds_read_tr16_b64_v4i16((__attribute__((address_space(3))) v4i16_t*)p)); }
__device__ __forceinline__ float rowmax(const f32x16&p0,const f32x16&p1){
  float a=max3f(p0[0],p0[1],p1[0]),b=max3f(p0[2],p0[3],p1[1]);a=max3f(a,p1[2],p1[3]);
  #pragma unroll
  for(int r=4;r<16;r+=4){a=max3f(a,p0[r],p0[r+1]);b=max3f(b,p0[r+2],p0[r+3]);a=max3f(a,p1[r],p1[r+1]);b=max3f(b,p1[r+2],p1[r+3]);}
  const float m=max2f(a,b);
  auto rr=__builtin_amdgcn_permlane32_swap(__float_as_uint(m),__float_as_uint(m),false,false);
  return max2f(__uint_as_float(rr[0]),__uint_as_float(rr[1]));
}
__device__ __forceinline__ void pv(f32x16*o,int vb,bf16x8 pa0,bf16x8 pa1,bf16x8 pa2,bf16x8 pa3){
  #pragma unroll
  for(int d0=0;d0<2;++d0){s16x4 lo[4],hi[4];
    #pragma unroll
    for(int ks=0;ks<4;++ks){
      asm volatile("ds_read_b64_tr_b16 %0,%1 offset:%c2":"=&v"(lo[ks]):"v"(vb),"i"(d0*4096+ks*1024):"memory");
      asm volatile("ds_read_b64_tr_b16 %0,%1 offset:%c2":"=&v"(hi[ks]):"v"(vb),"i"(d0*4096+ks*1024+512):"memory");}
    asm volatile("s_waitcnt lgkmcnt(0)":::"memory");SBAR();
    #define PK(k) (bf16x8){lo[k][0],lo[k][1],lo[k][2],lo[k][3],hi[k][0],hi[k][1],hi[k][2],hi[k][3]}
    o[d0]=__builtin_amdgcn_mfma_f32_32x32x16_bf16(pa0,PK(0),o[d0],0,0,0);
    o[d0]=__builtin_amdgcn_mfma_f32_32x32x16_bf16(pa1,PK(1),o[d0],0,0,0);
    o[d0]=__builtin_amdgcn_mfma_f32_32x32x16_bf16(pa2,PK(2),o[d0],0,0,0);
    o[d0]=__builtin_amdgcn_mfma_f32_32x32x16_bf16(pa3,PK(3),o[d0],0,0,0);
    #undef PK
  }
}

#ifndef ATTN_STORE16
#define ATTN_STORE16(p,v) (*(u32x4*)(p)=(v))
#endif
template<int THRL> __device__ __forceinline__ void attn_unit(int b,int qcol,int vcol,int ocol,int qb,const bf16*Q,const bf16*__restrict__ K,const bf16*__restrict__ V,bf16*O,char*shm){
  const int tid=threadIdx.x,lane=tid&63,r32=lane&31,hi=lane>>5; const int wid=__builtin_amdgcn_readfirstlane(tid>>6);
  const long rowbase=(long)b*SEQ; const int q0=qb*QB;
  const bf16*Qw=Q+(rowbase+q0+wid*QBLK)*DM+qcol;
  const bf16*Kh=K+rowbase*DM+qcol,*Vh=V+rowbase*DM+vcol;
  const unsigned lds0=(unsigned)(uintptr_t)shm;
  float*wsf=(float*)(shm+LDS_WS)+wid*64;
  const bf16*ksrc=Kh+(long)lane*DM+wid*8;
  const bf16*vsrc=Vh+(long)(16*(wid&3)+(lane>>2))*DM+(wid>>2)*32+(lane&3)*8;
  const unsigned kdst=lds0+LDS_K+wid*1024, vdst=lds0+LDS_V+wid*1024;
  #define DMA_K(t,slot) glds16(ksrc+(long)(t)*KVBLK*DM,(unsigned)__builtin_amdgcn_readfirstlane(kdst+(slot)))
  #define DMA_V(t,slot) glds16(vsrc+(long)(t)*KVBLK*DM,(unsigned)__builtin_amdgcn_readfirstlane(vdst+(slot)))
  const int vb0=(int)(lds0+LDS_V)+((lane>>4)&1)*32+(lane&3)*8+(4*hi+((lane&15)>>2))*64;
  const char*Kbase=shm+LDS_K; bf16x8 kf[8];
  const lds_cptr shm3=(lds_cptr)shm; const lds_cptr kp0=shm3+LDS_K+hi*1024+r32*16; const lds_cptr vp0=shm3+LDS_V+((lane>>4)&1)*32+(lane&3)*8+(4*hi+((lane&15)>>2))*64;
  const int NT=(q0+QB)/KVBLK;
  DMA_K(0,0);DMA_V(0,0);DMA_K(1,SLOTB);
  bf16x8 qr[4];
  #pragma unroll
  for(int d0=0;d0<4;++d0)qr[d0]=*reinterpret_cast<const bf16x8*>(&Qw[(long)r32*DM+d0*16+hi*8]);
  float mhat=0.f,l_reg=0.f;f32x16 o[2];o[0]=f32x16{};o[1]=f32x16{};f32x16 negm=f32x16{};asm volatile("":"+v"(negm));
  const int qrel=wid*QBLK+r32;
  #define CMASK(P0,P1,t) do{int jb_=(t)-(NT-4); if(jb_>=0)cmask(P0,P1,jb_,qrel,hi);}while(0)
  bool resc=false;
  #define START(P0,P1) do{ const float rm=rowmax(P0,P1); resc=false; \
    { const float dl=rm; mhat=fadd_s(mhat,dl); \
      _Pragma("unroll") for(int r=0;r<16;++r){P0[r]=fsub_s(P0[r],dl);P1[r]=fsub_s(P1[r],dl);} \
      _Pragma("unroll") for(int r=0;r<16;++r)negm[r]=-mhat; asm volatile("":"+v"(negm)); } \
    _Pragma("unroll") for(int r=0;r<16;++r)P0[r]=__builtin_amdgcn_exp2f(P0[r]); }while(0)
  #define RESC() do{ if(resc){ asm volatile("s_waitcnt lgkmcnt(0)":::"memory"); \
      _Pragma("unroll") for(int d_=0;d_<2;++d_) _Pragma("unroll") for(int r=0;r<16;++r)o[d_][r]*=wsf[crow(r,hi)]; } }while(0)
  f32x16 pA0,pA1,pB0,pB1;
  int sl_prev=0,sl_cur=0,sl_next=SLOTB;
  #define ROT() do{sl_prev=sl_cur;sl_cur=sl_next;sl_next=(sl_next==(NSLOT-1)*SLOTB)?0:sl_next+SLOTB;}while(0)
  DMA_K(2,2*SLOTB);
  WAIT_BAR(3);
  qkt(pA0,pA1,Kbase,qr,negm,r32,hi);asm volatile("s_nop 15\n\ts_nop 7":"+v"(pA0),"+v"(pA1));CMASK(pA0,pA1,0);
  START(pA0,pA1);
  _Pragma("unroll") for(int r=0;r<16;++r)pA1[r]=__builtin_amdgcn_exp2f(pA1[r]);
  WAIT_BAR(0);
  DMA_K(3,0);DMA_V(1,SLOTB);
  ROT();
  kload8(kf,kp0+sl_cur);
  WAIT_BAR(2);
  s16x4 vlo[8],vhi[8]; u32x4 pw0,pw1,pw2,pw3;
  #define PKW(P,B) cvtpk_s(P[B],P[B+1])
  #define PAF(k) __builtin_bit_cast(bf16x8,pw##k)
  #define VFR(i) (bf16x8){vlo[i][0],vlo[i][1],vlo[i][2],vlo[i][3],vhi[i][0],vhi[i][1],vhi[i][2],vhi[i][3]}
  #define PIN(x) asm volatile("":"+v"(x))
  #define MX3(a,b,c) __builtin_fmaxf(__builtin_fmaxf((a),(b)),(c))
  #define GAPA(MF,A0,A1,A2,A3,W0,W1,PW) do{ MF; sacc+=A0; sacc+=A1; sacc+=A2; sacc+=A3; PIN(sacc); W0; W1; PIN(PW); SBAR(); }while(0)
  #define EX(v) __builtin_amdgcn_exp2f(v)
  #define GAPB(MF,X,B) do{ MF; X[B]=EX(X[B]); X[B+1]=EX(X[B+1]); X[B+2]=EX(X[B+2]); X[B+3]=EX(X[B+3]); PIN(X); SBAR(); }while(0)
  #define VRD(i) do{ vlo[i]=vtr(vp_+(((i)>>2)*4096+((i)&3)*1024)); vhi[i]=vtr(vp_+(((i)>>2)*4096+((i)&3)*1024+512)); }while(0)
  #define KRD(G,j) do{ if(G){ kload2(kf,kp0+sl_next,j); SBAR(); } }while(0)
  #define STEP(C0,C1,P0,P1,t,GK,GV,GL) do{ SBAR(); \
    const lds_cptr vp_=vp0+sl_prev; \
    VRD(0); SBAR(); float sacc=(P0[0]+P0[1]); \
    GAPA(C0=__builtin_amdgcn_mfma_f32_32x32x16_bf16(kf[0],qr[0],negm,0,0,0), P0[2],P0[3],P0[4],P0[5],     pw0[0]=PKW(P0,0), pw0[1]=PKW(P0,2), pw0); \
    VRD(4); SBAR(); GAPA(C1=__builtin_amdgcn_mfma_f32_32x32x16_bf16(kf[1],qr[0],negm,0,0,0), P0[6],P0[7],P0[8],P0[9],     pw0[2]=PKW(P0,4), pw0[3]=PKW(P0,6), pw0); \
    VRD(1); SBAR(); GAPA(C0=__builtin_amdgcn_mfma_f32_32x32x16_bf16(kf[2],qr[1],C0,0,0,0),   P0[10],P0[11],P0[12],P0[13], pw1[0]=PKW(P0,8), pw1[1]=PKW(P0,10), pw1); \
    VRD(5); SBAR(); GAPA(C1=__builtin_amdgcn_mfma_f32_32x32x16_bf16(kf[3],qr[1],C1,0,0,0),   P0[14],P0[15],P1[0],P1[1],   pw1[2]=PKW(P0,12),pw1[3]=PKW(P0,14), pw1); \
    VRD(2); SBAR(); GAPA(C0=__builtin_amdgcn_mfma_f32_32x32x16_bf16(kf[4],qr[2],C0,0,0,0),   P1[2],P1[3],P1[4],P1[5],     pw2[0]=PKW(P1,0), pw2[1]=PKW(P1,2), pw2); \
    VRD(6); SBAR(); GAPA(C1=__builtin_amdgcn_mfma_f32_32x32x16_bf16(kf[5],qr[2],C1,0,0,0),   P1[6],P1[7],P1[8],P1[9],     pw2[2]=PKW(P1,4), pw2[3]=PKW(P1,6), pw2); \
    VRD(3); SBAR(); GAPA(C0=__builtin_amdgcn_mfma_f32_32x32x16_bf16(kf[6],qr[3],C0,0,0,0),   P1[10],P1[11],P1[12],P1[13], pw3[0]=PKW(P1,8), pw3[1]=PKW(P1,10), pw3); \
    VRD(7); SBAR(); GAPA(C1=__builtin_amdgcn_mfma_f32_32x32x16_bf16(kf[7],qr[3],C1,0,0,0),   P1[14],P1[15],0.f,0.f,       pw3[2]=PKW(P1,12),pw3[3]=PKW(P1,14), pw3); \
    l_reg+=sacc; \
    if(GK){DMA_K((t)+3,sl_cur);} if(GV){DMA_V((t)+1,sl_next);} \
    CMASK(C0,C1,t); \
    { float a=MX3(C0[0],C0[1],C1[0]),b=MX3(C0[2],C0[3],C1[1]); a=MX3(a,C1[2],C1[3]); \
      _Pragma("unroll") for(int r=4;r<16;r+=4){a=MX3(a,C0[r],C0[r+1]);b=MX3(b,C0[r+2],C0[r+3]);a=MX3(a,C1[r],C1[r+1]);b=MX3(b,C1[r+2],C1[r+3]);} \
      float rm=__builtin_fmaxf(a,b); { auto rr=__builtin_amdgcn_permlane32_swap(__float_as_uint(rm),__float_as_uint(rm),false,false); rm=__builtin_fmaxf(__uint_as_float(rr[0]),__uint_as_float(rr[1])); } \
      resc=false; \
      if(__builtin_expect(__any(rm>(float)THRL),0)){ const float dl=__builtin_fmaxf(rm,0.f); mhat+=dl; \
        _Pragma("unroll") for(int r=0;r<16;++r){C0[r]-=dl;C1[r]-=dl;} \
        _Pragma("unroll") for(int r=0;r<16;++r)negm[r]=-mhat; asm volatile("":"+v"(negm)); \
        const float f=__builtin_amdgcn_exp2f(-dl); l_reg*=f; if(hi==0)wsf[r32]=f; resc=true; } } \
    SBAR(); \
    GAPB(o[0]=__builtin_amdgcn_mfma_f32_32x32x16_bf16(PAF(0),VFR(0),o[0],0,0,0), C0,0); \
    GAPB(o[1]=__builtin_amdgcn_mfma_f32_32x32x16_bf16(PAF(0),VFR(4),o[1],0,0,0), C0,4); \
    KRD(GL,0); GAPB(o[0]=__builtin_amdgcn_mfma_f32_32x32x16_bf16(PAF(1),VFR(1),o[0],0,0,0), C0,8); \
    KRD(GL,1); GAPB(o[1]=__builtin_amdgcn_mfma_f32_32x32x16_bf16(PAF(1),VFR(5),o[1],0,0,0), C0,12); \
    KRD(GL,2); GAPB(o[0]=__builtin_amdgcn_mfma_f32_32x32x16_bf16(PAF(2),VFR(2),o[0],0,0,0), C1,0); \
    KRD(GL,3); GAPB(o[1]=__builtin_amdgcn_mfma_f32_32x32x16_bf16(PAF(2),VFR(6),o[1],0,0,0), C1,4); \
    GAPB(o[0]=__builtin_amdgcn_mfma_f32_32x32x16_bf16(PAF(3),VFR(3),o[0],0,0,0), C1,8); \
    GAPB(o[1]=__builtin_amdgcn_mfma_f32_32x32x16_bf16(PAF(3),VFR(7),o[1],0,0,0), C1,12); \
    }while(0)
  int t=1;
  #undef CMASK
  #define CMASK(P0,P1,t) do{}while(0)
  for(;t+5<NT;t+=2){
    STEP(pB0,pB1,pA0,pA1,t,true,true,true);     WAIT_BAR(2); RESC(); ROT();
    STEP(pA0,pA1,pB0,pB1,t+1,true,true,true);   WAIT_BAR(2); RESC(); ROT();
  }
  #undef CMASK
  #define CMASK(P0,P1,t) do{int jb_=(t)-(NT-4); if(jb_>=0)cmask(P0,P1,jb_,qrel,hi);}while(0)
  #define ENDW(tt) do{ if((tt)+3<NT){WAIT_BAR(2);} else if((tt)+2<NT){WAIT_BAR(1);} else {WAIT_BAR(0);} }while(0)
  for(;t+1<NT;t+=2){
    STEP(pB0,pB1,pA0,pA1,t,(t+3<NT),(t+1<NT),(t+1<NT));       ENDW(t);   RESC(); ROT();
    STEP(pA0,pA1,pB0,pB1,t+1,(t+4<NT),(t+2<NT),(t+2<NT));     ENDW(t+1); RESC(); ROT();
  }
  STEP(pB0,pB1,pA0,pA1,NT-1,false,false,false); RESC();
  { float sacc=pB0[0]+pB0[1]; _Pragma("unroll") for(int r=2;r<16;++r)sacc+=pB0[r]; _Pragma("unroll") for(int r=0;r<16;++r)sacc+=pB1[r]; l_reg+=sacc;
    pw0=(u32x4){PKW(pB0,0),PKW(pB0,2),PKW(pB0,4),PKW(pB0,6)};pw1=(u32x4){PKW(pB0,8),PKW(pB0,10),PKW(pB0,12),PKW(pB0,14)};pw2=(u32x4){PKW(pB1,0),PKW(pB1,2),PKW(pB1,4),PKW(pB1,6)};pw3=(u32x4){PKW(pB1,8),PKW(pB1,10),PKW(pB1,12),PKW(pB1,14)};
    SBAR(); pv(o,vb0+sl_cur,PAF(0),PAF(1),PAF(2),PAF(3)); }
  #undef PKW
  #undef PAF
  #undef VFR
  #undef PIN
  #undef MX3
  #undef GAPA
  #undef GAPB
  #undef EX
  #undef VRD
  #undef KRD
  #undef STEP
  #undef ENDW
  {auto rr=__builtin_amdgcn_permlane32_swap(__float_as_uint(l_reg),__float_as_uint(l_reg),false,false);l_reg=__uint_as_float(rr[0])+__uint_as_float(rr[1]);}
  if(hi==0)wsf[32+r32]=l_reg;asm volatile("s_waitcnt lgkmcnt(0)":::"memory");
  float rli[16];
  #pragma unroll
  for(int r=0;r<16;++r)rli[r]=__builtin_amdgcn_rcpf(wsf[32+crow(r,hi)]);
  bf16*Ow=O+(rowbase+q0+wid*QBLK)*OPITCH+ocol;
  { bf16*stg=(bf16*)(shm+LDS_OST)+wid*2048;
    #pragma unroll
    for(int r=0;r<16;++r){const int orow=crow(r,hi);
      #pragma unroll
      for(int d0=0;d0<2;++d0)stg[orow*64+d0*32+r32]=__float2bfloat16(o[d0][r]*rli[r]);}
    asm volatile("s_waitcnt lgkmcnt(0)":::"memory");
    #pragma unroll
    for(int i=0;i<4;++i){const int row=i*8+(lane>>3),ch=lane&7; const u32x4 v=*(const u32x4*)(stg+row*64+ch*8); ATTN_STORE16(Ow+(long)row*OPITCH+ch*8,v);} }
  asm volatile("s_waitcnt lgkmcnt(0)\n\ts_barrier":::"memory");
  #undef DMA_K
  #undef DMA_V
  #undef CMASK
  #undef START
  #undef RESC
  #undef ROT
}
constexpr int ATTN_LDS_BYTES=LDS_BYTES;
#undef SBAR
#undef WAIT_BAR
}
constexpr size_t MiB = 1u << 20;
constexpr size_t WS_CTL = 0, CTL_ZERO_BYTES = 1 * MiB;
constexpr size_t WS_WIN = 2 * MiB, WS_WOUT = 26 * MiB, WS_WQ = 34 * MiB, WS_WKV = 42 * MiB, WS_WO = 58 * MiB, WS_W1 = 66 * MiB, WS_W2 = 578 * MiB;
constexpr size_t WS_HN = 834 * MiB, WS_MN = 866 * MiB, WS_PROJ = 870 * MiB, WS_DT = 958 * MiB, WS_KVRAW = 959 * MiB, WS_KN = 967 * MiB;
constexpr size_t WS_YCAT = 971 * MiB, WS_O0 = 1003 * MiB, WS_O1 = 1019 * MiB, WS_H1 = 1035 * MiB, WS_H1B = 1099 * MiB, WS_PART1 = 1131 * MiB, WS_PARTQ = 1132 * MiB;
constexpr size_t WS_QRAW = 1133 * MiB, WS_P = 1165 * MiB, WS_VWT = 1181 * MiB, WS_H2 = 1197 * MiB, WS_HN3 = 1261 * MiB;
constexpr size_t WS_TOKOF = 1293 * MiB, WS_GATEOF = 1294 * MiB, WS_TOKE = 1295 * MiB, WS_TOKR = 1296 * MiB, WS_YG = 1297 * MiB;
constexpr size_t WS_H1F8 = 3368 * MiB  , WS_QF8 = 3384 * MiB  , WS_KN8 = 3400 * MiB  , WS_VF8 = 3402 * MiB  ;
constexpr size_t WS_P8 = 3404 * MiB  , WS_VWT8 = 3412 * MiB  ;
constexpr size_t WS_XG = 1320 * MiB  , WS_ACT = 1832 * MiB  , WS_Y = 2344 * MiB  , WS_END = 3420 * MiB;
constexpr int CW_BAR = 4096;
constexpr int CW_QCONV2 = 12416;
constexpr int CW_QCONV = 12352;
constexpr int CW_QATT = 12288;
constexpr int CW_CNT = 8192;
static_assert((CW_CNT + 64 * 32) * 4 <= (int)CTL_ZERO_BYTES, "CTL words inside the memset region");

constexpr int RING_OFF = 0, RING_BYTES = 131072;
constexpr int LDS_BYTES = 163840;
constexpr int MISC_OFF = 163840 - 1024;
constexpr int NWAVES = 8;

#define XB_TMO      128
#define XB_XCNT(j)  (256  + 64 * (j))
#define XB_XSUB(j)  (1280 + 64 * (j))
#define XB_XGEN(j)  (2304 + 64 * (j))
#define XB_TOP      3328
#define XB_TOPGEN   3392
#define XCD_BAR_WORDS 3456
#define XB_SPIN_CAP (1u << 20)

__device__ __forceinline__ unsigned xb_ld(unsigned* p)              { return __hip_atomic_load(p, __ATOMIC_RELAXED, __HIP_MEMORY_SCOPE_AGENT); }
__device__ __forceinline__ unsigned xb_add(unsigned* p, unsigned v) { return __hip_atomic_fetch_add(p, v, __ATOMIC_RELAXED, __HIP_MEMORY_SCOPE_AGENT); }
__device__ __forceinline__ unsigned xb_xcc_id() { return (unsigned)__builtin_amdgcn_s_getreg((3 << 11) | 20) & 0xFu; }
#define XB_SPIN(cond, bar) do { unsigned _sp = 0; while (cond) { __builtin_amdgcn_s_sleep(1); \
    if ((++_sp & 255u) == 0u) { if (xb_ld(&(bar)[XB_TMO])) break; if (_sp > XB_SPIN_CAP) { atomicAdd(&(bar)[XB_TMO], 1u); break; } } } } while (0)

struct XcdBarrier {
    unsigned* bar; unsigned x;
    volatile LAS unsigned* st;
};
__device__ __forceinline__ XcdBarrier xcd_barrier_post(unsigned* bar, volatile LAS unsigned* st) {
    XcdBarrier b; b.bar = bar; b.x = xb_xcc_id(); b.st = st;
    if (threadIdx.x == 0) (void)xb_add(&bar[XB_XCNT(b.x)], 1u);
    return b;
}
__device__ __forceinline__ void xcd_barrier_complete(unsigned* bar, unsigned x, unsigned& nloc, unsigned& nx) {
    const unsigned G = gridDim.x * gridDim.y * gridDim.z;
    unsigned sum, cnt, mine, sp = 0u;
    for (;;) {
        sum = 0u; cnt = 0u; mine = 0u;
#pragma unroll
        for (unsigned j = 0; j < 16; ++j) { const unsigned c = xb_ld(&bar[XB_XCNT(j)]); sum += c; cnt += (c > 0u) ? 1u : 0u; mine = (j == x) ? c : mine; }
        if (sum == G) break;
        __builtin_amdgcn_s_sleep(1);
        if ((++sp & 255u) == 0u) { if (xb_ld(&bar[XB_TMO])) break; if (sp > XB_SPIN_CAP) { atomicAdd(&bar[XB_TMO], 1u); break; } }
    }
    nloc = mine > 0u ? mine : 1u; nx = cnt > 0u ? cnt : 1u;
}
__device__ __forceinline__ void xcd_barrier(const XcdBarrier& b) {
    asm volatile("s_waitcnt vmcnt(0)" ::: "memory");
    __syncthreads();
    if (threadIdx.x == 0) {
        unsigned* bar = b.bar;
        __builtin_amdgcn_s_waitcnt(0);
        unsigned nloc = b.st[0], nx = b.st[1];
        if (nloc == 0u) { xcd_barrier_complete(bar, b.x, nloc, nx); b.st[0] = nloc; b.st[1] = nx; }
        const unsigned old = xb_add(&bar[XB_XSUB(b.x)], 1u);
        const unsigned gen = old / nloc;
        if (old + 1u == (gen + 1u) * nloc) {
            __builtin_amdgcn_fence(__ATOMIC_RELEASE, "agent");
            asm volatile("s_waitcnt vmcnt(0)" ::: "memory");
            const unsigned og = xb_add(&bar[XB_TOP], 1u);
            const unsigned tg = og / nx;
            if (og + 1u == (tg + 1u) * nx) xb_add(&bar[XB_TOPGEN], 1u);
            else XB_SPIN(xb_ld(&bar[XB_TOPGEN]) == tg, bar);
            __builtin_amdgcn_fence(__ATOMIC_ACQUIRE, "agent");
            xb_add(&bar[XB_XGEN(b.x)], 1u);
            asm volatile("s_waitcnt vmcnt(0)" ::: "memory");
        } else {
            XB_SPIN(xb_ld(&bar[XB_XGEN(b.x)]) == gen, bar);
            __builtin_amdgcn_fence(__ATOMIC_ACQUIRE, "agent");
            asm volatile("s_waitcnt vmcnt(0)" ::: "memory");
        }
    }
    __syncthreads();
}

struct Args { const float* in[32]; float* out; unsigned char* ws; int ph_lo, ph_hi; };
enum In { I_X = 0, I_MEM, I_GMIX, I_WIN, I_CONVW, I_CONVB, I_DTB, I_ALOG, I_DSKIP, I_SSDG, I_DAQG, I_DAKG, I_LQ1, I_LK1, I_LQ2, I_LK2, I_SUBG, I_WOUT, I_GXA, I_GMEM,
          I_WQ, I_WKV, I_XQG, I_XKG, I_WO, I_GFFN, I_RW, I_RB, I_W1, I_B1, I_W2, I_B2 };

struct ArgP {
    typedef const __attribute__((address_space(4))) char* kptr;
    DI const float* in(int i) const { kptr kp = (kptr)__builtin_amdgcn_kernarg_segment_ptr(); asm volatile("" : "+s"(kp)); return *(const float* const __attribute__((address_space(4)))*)(kp + 8 * i); }
    DI float* out() const { kptr kp = (kptr)__builtin_amdgcn_kernarg_segment_ptr(); asm volatile("" : "+s"(kp)); return *(float* const __attribute__((address_space(4)))*)(kp + 8 * 32); }
};
struct Frame {
    LAS unsigned char* lds;
    volatile LAS unsigned* MISC;
    unsigned* ctl;
    unsigned char* ws;
    int tid, lane, wave, vcu, G;
};

template <class DestRow>
DI void tr_item(const float* W, size_t ldw, int k0, int ncol0, int nvalid, const float* kscale, bf16_t* WT, int K, DestRow dr, LAS float* scr, int lane) {
    const int c = lane & 31;
#pragma unroll 8
    for (int i = 0; i < 32; ++i) { const int kk = 2 * i + (lane >> 5);
        float v = (c < nvalid) ? W[(size_t)(k0 + kk) * ldw + ncol0 + c] : 0.f;
        if (kscale) v *= kscale[k0 + kk];
        scr[kk * 33 + c] = v; }
    asm volatile("s_waitcnt lgkmcnt(0)" ::: "memory");
    const int c8 = lane & 7;
#pragma unroll
    for (int j = 0; j < 4; ++j) { const int n = (lane >> 3) + 8 * j; const LAS float* s = scr + (8 * c8) * 33 + n;
        u32x4 o; o.x = pk2(s[0 * 33], s[1 * 33]); o.y = pk2(s[2 * 33], s[3 * 33]); o.z = pk2(s[4 * 33], s[5 * 33]); o.w = pk2(s[6 * 33], s[7 * 33]);
        if (n < nvalid) *(u32x4*)(WT + (size_t)dr(ncol0 + n) * K + k0 + 8 * c8) = o; }
    asm volatile("s_waitcnt lgkmcnt(0)" ::: "memory");
}
template <class DestRow>
DI void tr_item_fp8(const float* W, size_t ldw, int k0, int ncol0, const float* kscale, unsigned char* WT, int K, DestRow dr, LAS float* scr, int lane) {
    const int c = lane & 31;
#pragma unroll 8
    for (int i = 0; i < 32; ++i) { const int kk = 2 * i + (lane >> 5); float v = W[(size_t)(k0 + kk) * ldw + ncol0 + c]; if (kscale) v *= kscale[k0 + kk]; scr[kk * 33 + c] = v; }
    asm volatile("s_waitcnt lgkmcnt(0)" ::: "memory");
    const int n = lane >> 1, hf = lane & 1; const LAS float* s = scr + (32 * hf) * 33 + n;
    unsigned w[8];
#pragma unroll
    for (int j = 0; j < 8; ++j) { unsigned x = 0u;
        x = __builtin_amdgcn_cvt_pk_fp8_f32(s[(4 * j) * 33] * 64.f, s[(4 * j + 1) * 33] * 64.f, x, false);
        x = __builtin_amdgcn_cvt_pk_fp8_f32(s[(4 * j + 2) * 33] * 64.f, s[(4 * j + 3) * 33] * 64.f, x, true); w[j] = x; }
    unsigned char* op = WT + (size_t)dr(ncol0 + n) * K + k0 + 32 * hf;
    *(u32x4*)op = (u32x4){w[0], w[1], w[2], w[3]}; *(u32x4*)(op + 16) = (u32x4){w[4], w[5], w[6], w[7]};
    asm volatile("s_waitcnt lgkmcnt(0)" ::: "memory");
}
DI int tileperm(int col) { const int o = col & 255; return (col & ~255) + 128 * ((o & 63) >> 5) + 32 * (o >> 6) + (o & 31); }
struct DrIdent { DI int operator()(int n) const { return n; } };
struct DrTile  { DI int operator()(int n) const { return tileperm(n); } };
struct DrWin   { DI int operator()(int n) const { const int pc = (n < 2560) ? n : (n < 2576 ? PC_DT + (n - 2560) : n - 16); return tileperm(pc); } };
struct DrW1    { DI int operator()(int n) const { const int half = n >> 11, j = n & 2047; return (j >> 7) * 256 + half * 128 + (j & 127); } };

template <bool FP8, class DestRow>
DI void cv_item(const float* W, size_t ldw, int k0, int ncol0, const float* kscale, float scale, void* WT, int kpitch, DestRow dr, LAS float* scr, int lane) {
    const int r = lane >> 3, c4 = (lane & 7) * 4;
    f32x4 v[16];
#pragma unroll
    for (int i = 0; i < 16; ++i) v[i] = *(const f32x4*)(W + (size_t)(k0 + 8 * i + r) * ldw + ncol0 + c4);
#pragma unroll
    for (int i = 0; i < 16; ++i) { f32x4 x = v[i] * scale; if (kscale) x = x * kscale[k0 + 8 * i + r]; *(LAS f32x4*)(scr + (8 * i + r) * 36 + c4) = x; }
    asm volatile("s_waitcnt lgkmcnt(0)" ::: "memory");
    const int n = lane & 31, hf = lane >> 5; const LAS float* s = scr + (64 * hf) * 36 + n;
    if constexpr (FP8) {
        unsigned w[16];
#pragma unroll
        for (int j = 0; j < 16; ++j) { unsigned x = 0u; x = __builtin_amdgcn_cvt_pk_fp8_f32(s[(4 * j) * 36], s[(4 * j + 1) * 36], x, false); x = __builtin_amdgcn_cvt_pk_fp8_f32(s[(4 * j + 2) * 36], s[(4 * j + 3) * 36], x, true); w[j] = x; }
        unsigned char* op = (unsigned char*)WT + (size_t)dr(ncol0 + n) * kpitch + k0 + 64 * hf;
#pragma unroll
        for (int j = 0; j < 4; ++j) *(u32x4*)(op + 16 * j) = (u32x4){w[4 * j], w[4 * j + 1], w[4 * j + 2], w[4 * j + 3]};
    } else {
        unsigned w[32];
#pragma unroll
        for (int j = 0; j < 32; ++j) w[j] = pk2(s[(2 * j) * 36], s[(2 * j + 1) * 36]);
        unsigned char* op = (unsigned char*)WT + (size_t)dr(ncol0 + n) * kpitch + (k0 + 64 * hf) * 2;
#pragma unroll
        for (int j = 0; j < 8; ++j) *(u32x4*)(op + 16 * j) = (u32x4){w[4 * j], w[4 * j + 1], w[4 * j + 2], w[4 * j + 3]};
    }
    asm volatile("s_waitcnt lgkmcnt(0)" ::: "memory");
}
DI void rms_row_to_bf16(const float* xrow, const float* g, bf16_t* orow, int lane) {
    const f32x4* xr = (const f32x4*)xrow + lane;
    f32x4 v[8]; float s = 0.f;
#pragma unroll
    for (int j = 0; j < 8; ++j) { v[j] = xr[64 * j]; s += (v[j].x * v[j].x + v[j].y * v[j].y) + (v[j].z * v[j].z + v[j].w * v[j].w); }
    const float rstd = 1.f / sqrtf(wave_sum(s) * (1.f / 2048.f) + EPS_);
    u32x2* o8 = (u32x2*)orow + lane;
#pragma unroll
    for (int j = 0; j < 8; ++j) { const f32x4 gg = ((const f32x4*)g)[lane + 64 * j];
        u32x2 o; o.x = pk2(v[j].x * rstd * gg.x, v[j].y * rstd * gg.y); o.y = pk2(v[j].z * rstd * gg.z, v[j].w * rstd * gg.w); o8[64 * j] = o; }
}

DI void p0_prologue(Frame& F, const ArgP& a) {
    LAS float* scr = (LAS float*)(F.lds + RING_OFF + F.wave * 16384);
    const int gw = F.vcu * NWAVES + F.wave, NGW = F.G * NWAVES;
    unsigned char* ws = F.ws;
    constexpr int I_A = 32 * 80, I_B = 32, I_C = 32 * 96, NITEMS = I_A + I_B + I_C;
    for (int it = gw; it < NITEMS; it += NGW) {
        int r = it;
        if (r < I_A) { tr_item(a.in(I_WIN), 5648, 64 * (r / 80), 32 * (r % 80), 32, nullptr, (bf16_t*)(ws + WS_WIN), 2048, DrWin(), scr, F.lane); continue; } r -= I_A;
        if (r < I_B) { tr_item(a.in(I_WIN), 5648, 64 * r, 2560, 16, nullptr, (bf16_t*)(ws + WS_WIN), 2048, DrWin(), scr, F.lane); continue; } r -= I_B;
        tr_item(a.in(I_WIN), 5648, 64 * (r / 96), 2576 + 32 * (r % 96), 32, nullptr, (bf16_t*)(ws + WS_WIN), 2048, DrWin(), scr, F.lane);
    }
    for (int m = gw; m < NTOK; m += NGW) rms_row_to_bf16(a.in(I_X) + (size_t)m * 2048, a.in(I_GMIX), (bf16_t*)(ws + WS_HN) + (size_t)m * 2048, F.lane);
    for (int m = gw; m < NB * MEMLEN; m += NGW) rms_row_to_bf16(a.in(I_MEM) + (size_t)m * 2048, a.in(I_GMEM), (bf16_t*)(ws + WS_MN) + (size_t)m * 2048, F.lane);
}
struct CvIt { const float* W; size_t ldw; const float* ks; unsigned char* WT; float scale; int k0, n0, kpitch, fp8, dr; };
DI CvIt cv_decode(int it, const ArgP& a, unsigned char* ws) {
    constexpr int J_WOUT = 16 * 64, J_WKV = 16 * 128, J_WQ = 16 * 64, J_WO = 16 * 64, J_W1 = 32 * 16 * 128;
    CvIt c; c.ks = nullptr; c.scale = 64.f; c.fp8 = 1; c.dr = 0; c.kpitch = 2048; c.ldw = 2048;
    int r = it;
    if (r < J_WOUT) { c.W = a.in(I_WOUT); c.k0 = 128 * (r / 64); c.n0 = 32 * (r % 64); c.WT = ws + WS_WOUT; c.scale = 1.f; c.fp8 = 0; c.kpitch = 4096; return c; } r -= J_WOUT;
    if (r < J_WKV) { c.W = a.in(I_WKV); c.ldw = 4096; c.k0 = 128 * (r / 128); c.n0 = 32 * (r % 128); c.WT = ws + WS_WKV; c.scale = 1.f; c.fp8 = 0; c.kpitch = 4096; c.dr = 1; return c; } r -= J_WKV;
    if (r < J_WQ) { c.W = a.in(I_WQ); c.ks = a.in(I_GXA); c.k0 = 128 * (r / 64); c.n0 = 32 * (r % 64); c.WT = ws + WS_WQ; return c; } r -= J_WQ;
    if (r < J_WO) { c.W = a.in(I_WO); c.k0 = 128 * (r / 64); c.n0 = 32 * (r % 64); c.WT = ws + WS_WO; return c; } r -= J_WO;
    if (r < J_W1) { const int e = r / (16 * 128), q = r % (16 * 128); c.W = a.in(I_W1) + (size_t)e * 2048 * 4096; c.ldw = 4096; c.k0 = 128 * (q / 128); c.n0 = 32 * (q % 128); c.WT = ws + WS_W1 + (size_t)e * 4096 * 2048; c.dr = 2; return c; } r -= J_W1;
    { const int e = r / (16 * 64), q = r % (16 * 64); c.W = a.in(I_W2) + (size_t)e * 2048 * 2048; c.k0 = 128 * (q / 64); c.n0 = 32 * (q % 64); c.WT = ws + WS_W2 + (size_t)e * 2048 * 2048; }
    return c;
}
constexpr int CV_NJ = 16 * 64 * 3 + 16 * 128 + 32 * 16 * 128 + 32 * 16 * 64;
constexpr int CV_TAIL2 = 16384;
constexpr int CV_TAIL1 = 16384;
constexpr int CV_TAIL = CV_TAIL1 + CV_TAIL2;
DI void conv_share(Frame& F, const ArgP& a) {
    LAS float* scr = (LAS float*)(F.lds + F.wave * 18432);
    const int gw = F.vcu * NWAVES + F.wave, NGW = F.G * NWAVES, lane = F.lane;
    unsigned char* ws = F.ws;
    constexpr int NJ = CV_NJ - CV_TAIL;
    const int r = lane >> 3, c4 = (lane & 7) * 4, n = lane & 31, hf = lane >> 5;
    if (gw >= NJ) return;
    CvIt cur = cv_decode(gw, a, ws);
    f32x4 v[16];
#pragma unroll
    for (int i = 0; i < 16; ++i) v[i] = __builtin_nontemporal_load((const f32x4*)(cur.W + (size_t)(cur.k0 + 8 * i + r) * cur.ldw + cur.n0 + c4));
    for (int it = gw; it < NJ; it += NGW) {
#pragma unroll
        for (int i = 0; i < 16; ++i) { f32x4 x = v[i] * cur.scale; if (cur.ks) x = x * cur.ks[cur.k0 + 8 * i + r]; *(LAS f32x4*)(scr + (8 * i + r) * 36 + c4) = x; }
        const bool more = (it + NGW) < NJ; CvIt nxt = cur;
        if (more) { nxt = cv_decode(it + NGW, a, ws);
#pragma unroll
            for (int i = 0; i < 16; ++i) v[i] = __builtin_nontemporal_load((const f32x4*)(nxt.W + (size_t)(nxt.k0 + 8 * i + r) * nxt.ldw + nxt.n0 + c4)); }
        asm volatile("s_waitcnt lgkmcnt(0)" ::: "memory");
        const LAS float* s = scr + (64 * hf) * 36 + n;
        const int col = cur.n0 + n; const int drow = (cur.dr == 0) ? col : (cur.dr == 1 ? tileperm(col) : DrW1()(col));
        if (cur.fp8) {
            unsigned w[16];
#pragma unroll
            for (int j = 0; j < 16; ++j) { unsigned x = 0u; x = __builtin_amdgcn_cvt_pk_fp8_f32(s[(4 * j) * 36], s[(4 * j + 1) * 36], x, false); x = __builtin_amdgcn_cvt_pk_fp8_f32(s[(4 * j + 2) * 36], s[(4 * j + 3) * 36], x, true); w[j] = x; }
            unsigned char* op = cur.WT + (size_t)drow * cur.kpitch + cur.k0 + 64 * hf;
#pragma unroll
            for (int j = 0; j < 4; ++j) *(u32x4*)(op + 16 * j) = (u32x4){w[4 * j], w[4 * j + 1], w[4 * j + 2], w[4 * j + 3]};
        } else {
            unsigned w[32];
#pragma unroll
            for (int j = 0; j < 32; ++j) w[j] = pk2(s[(2 * j) * 36], s[(2 * j + 1) * 36]);
            unsigned char* op = cur.WT + (size_t)drow * cur.kpitch + (cur.k0 + 64 * hf) * 2;
#pragma unroll
            for (int j = 0; j < 8; ++j) *(u32x4*)(op + 16 * j) = (u32x4){w[4 * j], w[4 * j + 1], w[4 * j + 2], w[4 * j + 3]};
        }
        asm volatile("s_waitcnt lgkmcnt(0)" ::: "memory");
        cur = nxt;
    }
}

DI void conv_queue(Frame& F, const ArgP& a, int qword, int first, int count) {
    LAS float* scr = (LAS float*)(F.lds + F.wave * 18432);
    unsigned char* ws = F.ws;
    const int lane = threadIdx.x & 63, r = lane >> 3, c4 = (lane & 7) * 4, n = lane & 31, hf = lane >> 5;
    for (;;) {
        if (threadIdx.x == 0) F.MISC[121] = __hip_atomic_fetch_add(F.ctl + qword, 8u, __ATOMIC_RELAXED, __HIP_MEMORY_SCOPE_AGENT);
        __syncthreads();
        const int base = __builtin_amdgcn_readfirstlane((int)F.MISC[121]);
        __syncthreads();
        if (base >= count) break;
        const int it = first + base + F.wave;
        if (base + F.wave < count) {
            const CvIt cur = cv_decode(it, a, ws);
            f32x4 v[16];
#pragma unroll
            for (int i = 0; i < 16; ++i) v[i] = __builtin_nontemporal_load((const f32x4*)(cur.W + (size_t)(cur.k0 + 8 * i + r) * cur.ldw + cur.n0 + c4));
#pragma unroll
            for (int i = 0; i < 16; ++i) *(LAS f32x4*)(scr + (8 * i + r) * 36 + c4) = v[i] * cur.scale;
            asm volatile("s_waitcnt lgkmcnt(0)" ::: "memory");
            const LAS float* s = scr + (64 * hf) * 36 + n;
            unsigned w[16];
#pragma unroll
            for (int j = 0; j < 16; ++j) { unsigned x = 0u; x = __builtin_amdgcn_cvt_pk_fp8_f32(s[(4 * j) * 36], s[(4 * j + 1) * 36], x, false); x = __builtin_amdgcn_cvt_pk_fp8_f32(s[(4 * j + 2) * 36], s[(4 * j + 3) * 36], x, true); w[j] = x; }
            unsigned char* op = cur.WT + (size_t)(cur.n0 + n) * cur.kpitch + cur.k0 + 64 * hf;
#pragma unroll
            for (int j = 0; j < 4; ++j) *(u32x4*)(op + 16 * j) = (u32x4){w[4 * j], w[4 * j + 1], w[4 * j + 2], w[4 * j + 3]};
            asm volatile("s_waitcnt lgkmcnt(0)" ::: "memory");
        }
    }
}
static_assert(CV_TAIL <= 32 * 16 * 64 && CV_TAIL1 % 8 == 0 && CV_TAIL2 % 8 == 0, "the tails are a suffix of the moe_w2 items");

struct SchedP1 {
    int G, c; const unsigned char* ws; int lo, hi;
    DI bool next(int i, pg8::UnitD& u) const {
        const int L = lo + i * G + c; if (L >= hi) return false;
        u.rows = nullptr; u.nvalid = 0; u.lda = 4096u; u.ldb = 4096u; u.e = 0; u.x0 = 0;
        if (L < 32 * 23) { u.type = 0; u.pn = L / 32; u.pm = L % 32; u.A = (const char*)(ws + WS_HN) + (size_t)u.pm * 256 * 4096; u.B = (const char*)(ws + WS_WIN) + (size_t)u.pn * 256 * 4096; }
        else { const int q = L - 32 * 23; u.type = 1; u.pn = q / 4; u.pm = q % 4; u.A = (const char*)(ws + WS_MN) + (size_t)u.pm * 256 * 4096; u.B = (const char*)(ws + WS_WKV) + (size_t)u.pn * 256 * 4096; }
        return true;
    }
};
struct EpiP1 {
    static constexpr bool AFTER_DRAIN = false;
    bf16_t* proj; float* dtb; bf16_t* kvraw; const float* gq; const float* gk; unsigned char* vf8;
    DI void operator()(const f32x4 (&acc)[2][2][4][2], const pg8::UnitD& u, int wr, int wc, int fr, int fq) const {
        { int ln_ = threadIdx.x; asm volatile("" : "+v"(ln_)); fr = ln_ & 15; fq = (ln_ >> 4) & 3; }
        const int row0 = u.pm * 256 + wr * 64 + fr;
        const int cn = u.pn * 256 + 64 * wc + 8 * fq;
        if (u.type == 1 && u.pn >= 8) {
#pragma unroll
            for (int ai = 0; ai < 2; ++ai)
#pragma unroll
                for (int m = 0; m < 4; ++m) { unsigned char* rp = vf8 + (size_t)(row0 + ai * 128 + m * 16) * 2048 + (cn - 2048);
#pragma unroll
                    for (int bj = 0; bj < 2; ++bj) { const f32x4 v0 = acc[ai][bj][m][0] * 16.f, v1 = acc[ai][bj][m][1] * 16.f;
                        u32x2 w; w.x = __builtin_amdgcn_cvt_pk_fp8_f32(v0[0], v0[1], 0u, false); w.x = __builtin_amdgcn_cvt_pk_fp8_f32(v0[2], v0[3], w.x, true);
                        w.y = __builtin_amdgcn_cvt_pk_fp8_f32(v1[0], v1[1], 0u, false); w.y = __builtin_amdgcn_cvt_pk_fp8_f32(v1[2], v1[3], w.y, true);
                        *(u32x2*)(rp + 32 * bj) = w; } }
            return;
        }
        if (u.type == 1) {
#pragma unroll
            for (int ai = 0; ai < 2; ++ai)
#pragma unroll
                for (int m = 0; m < 4; ++m) { bf16_t* rp = kvraw + (size_t)(row0 + ai * 128 + m * 16) * 4096 + cn;
#pragma unroll
                    for (int bj = 0; bj < 2; ++bj) { const f32x4 v0 = acc[ai][bj][m][0], v1 = acc[ai][bj][m][1];
                        u32x4 w; w.x = pk2(v0[0], v0[1]); w.y = pk2(v0[2], v0[3]); w.z = pk2(v1[0], v1[1]); w.w = pk2(v1[2], v1[3]); *(u32x4*)(rp + 32 * bj) = w; } }
            return;
        }
        if (u.pn == 22) {
            if (wc == 0 && fq < 2) {
#pragma unroll
                for (int ai = 0; ai < 2; ++ai)
#pragma unroll
                    for (int m = 0; m < 4; ++m) { float* rp = dtb + (size_t)(row0 + ai * 128 + m * 16) * 16 + 8 * fq;
                        *(f32x4*)(rp) = acc[ai][0][m][0]; *(f32x4*)(rp + 4) = acc[ai][0][m][1]; }
            }
            return;
        }
        const bool isq = (u.pn >= 10 && u.pn < 14), isk = (u.pn >= 14 && u.pn < 18);
        if (!(isq || isk)) {
#pragma unroll
            for (int ai = 0; ai < 2; ++ai)
#pragma unroll
                for (int m = 0; m < 4; ++m) { bf16_t* rp = proj + (size_t)(row0 + ai * 128 + m * 16) * PP + cn;
#pragma unroll
                    for (int bj = 0; bj < 2; ++bj) { const f32x4 v0 = acc[ai][bj][m][0], v1 = acc[ai][bj][m][1];
                        u32x4 w; w.x = pk2(v0[0], v0[1]); w.y = pk2(v0[2], v0[3]); w.z = pk2(v1[0], v1[1]); w.w = pk2(v1[2], v1[3]); *(u32x4*)(rp + 32 * bj) = w; } }
            return;
        }
        const float* g = (isq ? gq : gk) + 8 * fq; const float sc = isq ? (0.125f * 1.4426950408889634f) : 1.f;
#pragma unroll
        for (int ai = 0; ai < 2; ++ai)
#pragma unroll
            for (int m = 0; m < 4; ++m) { bf16_t* rp = proj + (size_t)(row0 + ai * 128 + m * 16) * PP + cn;
                float ss = 0.f;
#pragma unroll
                for (int bj = 0; bj < 2; ++bj)
#pragma unroll
                    for (int n = 0; n < 2; ++n) { const f32x4 v = acc[ai][bj][m][n]; ss += (v[0] * v[0] + v[1] * v[1]) + (v[2] * v[2] + v[3] * v[3]); }
                ss += __shfl_xor(ss, 16); ss += __shfl_xor(ss, 32);
                const float rs = sc / sqrtf(ss * (1.f / 64.f) + EPS_);
#pragma unroll
                for (int bj = 0; bj < 2; ++bj) { const f32x4 v0 = acc[ai][bj][m][0] * rs * *(const f32x4*)(g + 32 * bj), v1 = acc[ai][bj][m][1] * rs * *(const f32x4*)(g + 32 * bj + 4);
                    u32x4 w; w.x = pk2(v0[0], v0[1]); w.y = pk2(v0[2], v0[3]); w.z = pk2(v1[0], v1[1]); w.w = pk2(v1[2], v1[3]); *(u32x4*)(rp + 32 * bj) = w; } }
    }
};

DI void kprep(Frame& F, const ArgP& a) {
    const int gw = F.vcu * NWAVES + F.wave, NGW = F.G * NWAVES;
    const bf16_t* kv = (const bf16_t*)(F.ws + WS_KVRAW); unsigned char* kn = (unsigned char*)(F.ws + WS_KN8);
    for (int it = gw; it < NB * MEMLEN * 4; it += NGW) {
        const int row = it >> 2, h = it & 3, b = row >> 8, key = row & 255;
        const u32x4 raw = *(const u32x4*)(kv + (size_t)row * 4096 + h * 512 + F.lane * 8);
        float v[8]; v[0] = bflo(raw.x); v[1] = bfhi(raw.x); v[2] = bflo(raw.y); v[3] = bfhi(raw.y); v[4] = bflo(raw.z); v[5] = bfhi(raw.z); v[6] = bflo(raw.w); v[7] = bfhi(raw.w);
        float ss = 0.f;
#pragma unroll
        for (int j = 0; j < 8; ++j) ss += v[j] * v[j];
        const float rs = 1.f / sqrtf(wave_sum(ss) * (1.f / 512.f) + EPS_) * 0.04419417382415922f * 128.f;
        const float* gk = a.in(I_XKG) + F.lane * 8; const float* gq = a.in(I_XQG) + F.lane * 8;
        u32x2 o; o.x = __builtin_amdgcn_cvt_pk_fp8_f32(v[0] * rs * gk[0] * gq[0], v[1] * rs * gk[1] * gq[1], 0u, false); o.x = __builtin_amdgcn_cvt_pk_fp8_f32(v[2] * rs * gk[2] * gq[2], v[3] * rs * gk[3] * gq[3], o.x, true);
        o.y = __builtin_amdgcn_cvt_pk_fp8_f32(v[4] * rs * gk[4] * gq[4], v[5] * rs * gk[5] * gq[5], 0u, false); o.y = __builtin_amdgcn_cvt_pk_fp8_f32(v[6] * rs * gk[6] * gq[6], v[7] * rs * gk[7] * gq[7], o.y, true);
        *(u32x2*)(kn + ((size_t)((b * 4 + h) * 256 + key)) * 512 + F.lane * 8) = o;
    }
}

constexpr int SP = 272;
constexpr int S_C = 0, S_BM = 34816, S_BT = 69632, S_XDT = 104448, S_HB = 121856, S_F = 139264, S_W = 155648  , SSD_LDS = 162048;
static_assert(SSD_LDS <= MISC_OFF, "SSD LDS map");
#define MFMA32(a, b, c) __builtin_amdgcn_mfma_f32_32x32x16_bf16((a), (b), (c), 0, 0, 0)
DI int crow(int r, int hi) { return (r & 3) + 8 * (r >> 2) + 4 * hi; }
DI bf16x8 ldfrag(LAS const unsigned char* base, int row, int kel) { return *(const LAS bf16x8*)(base + row * SP + kel * 2); }
DI float fexp(float x) { return __builtin_amdgcn_exp2f(x * 1.4426950408889634f); }
DI float fsilu(float x) { return x * __builtin_amdgcn_rcpf(1.f + fexp(-x)); }

DI void ssd_unit(Frame& F, const ArgP& a, int b, int hd) {
    LAS unsigned char* lds = F.lds;
    int tid = F.tid, lane = F.lane, r32 = lane & 31, hh = lane >> 5; const int wid = F.wave;
    LAS float* sdt = (LAS float*)(lds + S_F); LAS float* sac = sdt + 2048;
    const bf16_t* proj = (const bf16_t*)(F.ws + WS_PROJ); const float* dtbuf = (const float*)(F.ws + WS_DT); bf16_t* yg = (bf16_t*)(F.ws + WS_YG);
    const int g = hd >> 3;
    const float aneg = -__expf(a.in(I_ALOG)[hd]), dtb = a.in(I_DTB)[hd], dsk = a.in(I_DSKIP)[hd];
#pragma unroll
    for (int q = 0; q < 2; ++q) { const int c = 2 * wid + q; const size_t t0 = (size_t)b * SEQ_ + c * 128;
        const float x0 = dtbuf[(t0 + 2 * lane) * 16 + hd] + dtb, x1 = dtbuf[(t0 + 2 * lane + 1) * 16 + hd] + dtb;
        const float d0 = x0 > 20.f ? x0 : log1pf(__expf(x0)), d1 = x1 > 20.f ? x1 : log1pf(__expf(x1));
        const float a0 = d0 * aneg, a1 = d1 * aneg;
        float s = a0 + a1;
#pragma unroll
        for (int o = 1; o < 64; o <<= 1) { const float t = __shfl_up(s, o); if (lane >= o) s += t; }
        sdt[c * 128 + 2 * lane] = d0; sdt[c * 128 + 2 * lane + 1] = d1; sac[c * 128 + 2 * lane] = s - a1; sac[c * 128 + 2 * lane + 1] = s; }
    int seg = tid >> 5, cg = tid & 31, l0 = seg * 8;
    int colbc = (cg < 16) ? (1024 + g * 128 + cg * 8) : (1280 + g * 128 + (cg - 16) * 8);
    const int colx = hd * 64 + wid * 8; int lx = 2 * lane;
    LAS float* swt = (LAS float*)(lds + S_W);
    { const float* convw = a.in(I_CONVW); const float* convb = a.in(I_CONVB);
      if (tid < 320) { const int ci = tid;
          const int xc = (ci < 64) ? (hd * 64 + ci) : (ci < 192 ? (1024 + g * 128 + (ci - 64)) : (1280 + g * 128 + (ci - 192)));
#pragma unroll
          for (int k = 0; k < 4; ++k) swt[k * 320 + ci] = convw[k * 1536 + xc];
          swt[4 * 320 + ci] = convb[xc]; } }
    int cibc = 64 + cg * 8; const int cix = wid * 8;
    const char* pub = (const char*)F.ws; const unsigned pxb = (unsigned)(WS_PROJ + ((size_t)b * SEQ_ * PP + PC_XBC) * 2), zoff = (unsigned)(WS_CTL + 524288);
    u32x4 inbc[11], inx[5];
#define SSD_PREFETCH(c_) do { \
        int sd_ = l0; asm volatile("" : "+v"(sd_)); \
        _Pragma("unroll") for (int j = 0; j < 11; ++j) { const int tt = (c_) * 128 + sd_ - 3 + j; inbc[j] = *(const u32x4*)(pub + ((tt >= 0) ? pxb + (unsigned)(tt * PP + colbc) * 2u : zoff)); } } while (0)
    SSD_PREFETCH(0);
    f32x16 hT; for (int i = 0; i < 16; ++i) hT[i] = 0.f;
    const int nb = wid & 3, pb = wid >> 2;
    __syncthreads();
    for (int c = 0; c < 16; ++c) {
        { int t_ = threadIdx.x; asm volatile("" : "+v"(t_)); tid = t_; lane = t_ & 63; r32 = lane & 31; hh = lane >> 5; seg = t_ >> 5; cg = t_ & 31; l0 = seg * 8; lx = 2 * lane;
          colbc = (cg < 16) ? (1024 + g * 128 + cg * 8) : (1280 + g * 128 + (cg - 16) * 8); cibc = 64 + cg * 8; }
        const size_t t0 = (size_t)b * SEQ_ + c * 128;
        const LAS float* cdt = sdt + c * 128; const LAS float* cac = sac + c * 128;
        const float aend = cac[127];
#pragma unroll
        for (int j = 0; j < 5; ++j) { int sd_ = lx; asm volatile("" : "+v"(sd_)); const int tt = c * 128 + sd_ - 3 + j; inx[j] = *(const u32x4*)(pub + ((tt >= 0) ? pxb + (unsigned)(tt * PP + colx) * 2u : zoff)); }
        {
            LAS unsigned char* hbp = lds + S_HB + (32 * pb + r32) * SP + (32 * nb + 4 * hh) * 2;
#pragma unroll
            for (int q4 = 0; q4 < 4; ++q4) { u32x2 w; w.x = pk2(hT[4 * q4], hT[4 * q4 + 1]); w.y = pk2(hT[4 * q4 + 2], hT[4 * q4 + 3]); *(LAS u32x2*)(hbp + 16 * q4) = w; }
        }
        {
            float wbc[5][8];
#pragma unroll
            for (int k = 0; k < 5; ++k) { const f32x4 w0 = *(const LAS f32x4*)(swt + k * 320 + cibc), w1 = *(const LAS f32x4*)(swt + k * 320 + cibc + 4);
#pragma unroll
                for (int i = 0; i < 4; ++i) { wbc[k][i] = w0[i]; wbc[k][4 + i] = w1[i]; } }
#pragma unroll
            for (int hf = 0; hf < 2; ++hf) {
                __builtin_amdgcn_sched_barrier(0);
                float o[4][8];
#pragma unroll
                for (int j = 0; j < 4; ++j)
#pragma unroll
                    for (int i = 0; i < 8; ++i) { float s = wbc[4][i];
#pragma unroll
                        for (int k = 0; k < 4; ++k) { const unsigned wd = inbc[4 * hf + j + k][i >> 1]; s += wbc[k][i] * ((i & 1) ? bfhi(wd) : bflo(wd)); }
                        o[j][i] = fsilu(s); }
                const int lh = l0 + 4 * hf;
                if (cg < 16) {
                    const int n0 = cg * 8; float ev[4];
#pragma unroll
                    for (int j = 0; j < 4; ++j) { ev[j] = fexp(aend - cac[lh + j]);
                        u32x4 w1; w1.x = pk2(o[j][0], o[j][1]); w1.y = pk2(o[j][2], o[j][3]); w1.z = pk2(o[j][4], o[j][5]); w1.w = pk2(o[j][6], o[j][7]);
                        *(LAS u32x4*)(lds + S_BM + (lh + j) * SP + n0 * 2) = w1; }
#pragma unroll
                    for (int i = 0; i < 8; ++i) { u32x2 w2; w2.x = pk2(o[0][i] * ev[0], o[1][i] * ev[1]); w2.y = pk2(o[2][i] * ev[2], o[3][i] * ev[3]);
                        *(LAS u32x2*)(lds + S_BT + (n0 + i) * SP + lh * 2) = w2; }
                } else {
                    const int n0 = (cg - 16) * 8;
#pragma unroll
                    for (int j = 0; j < 4; ++j) { u32x4 w1; w1.x = pk2(o[j][0], o[j][1]); w1.y = pk2(o[j][2], o[j][3]); w1.z = pk2(o[j][4], o[j][5]); w1.w = pk2(o[j][6], o[j][7]);
                        *(LAS u32x4*)(lds + S_C + (lh + j) * SP + n0 * 2) = w1; }
                }
            }
        }
        __builtin_amdgcn_sched_barrier(0);
        {
            const float d0 = cdt[lx], d1 = cdt[lx + 1];
            float wx[5][8];
#pragma unroll
            for (int k = 0; k < 5; ++k) { const f32x4 w0 = *(const LAS f32x4*)(swt + k * 320 + cix), w1 = *(const LAS f32x4*)(swt + k * 320 + cix + 4);
#pragma unroll
                for (int i = 0; i < 4; ++i) { wx[k][i] = w0[i]; wx[k][4 + i] = w1[i]; } }
#pragma unroll
            for (int i = 0; i < 8; ++i) { float s0 = wx[4][i], s1 = wx[4][i];
#pragma unroll
                for (int k = 0; k < 4; ++k) { const unsigned w0 = inx[k][i >> 1], w1 = inx[k + 1][i >> 1];
                    s0 += wx[k][i] * ((i & 1) ? bfhi(w0) : bflo(w0)); s1 += wx[k][i] * ((i & 1) ? bfhi(w1) : bflo(w1)); }
                *(LAS unsigned*)(lds + S_XDT + (wid * 8 + i) * SP + lx * 2) = pk2(fsilu(s0) * d0, fsilu(s1) * d1); }
        }
        if (c < 15) SSD_PREFETCH(c + 1);
        __syncthreads();
        const int lb = wid >> 1;
        f32x16 xt[2];
#pragma unroll
        for (int q = 0; q < 2; ++q) { const int sb = 2 * (wid & 1) + q;
            for (int i = 0; i < 16; ++i) xt[q][i] = 0.f;
            if (sb <= lb) {
#pragma unroll
                for (int ks = 0; ks < 8; ++ks) xt[q] = MFMA32(ldfrag(lds + S_BM, 32 * sb + r32, 16 * ks + 8 * hh), ldfrag(lds + S_C, 32 * lb + r32, 16 * ks + 8 * hh), xt[q]);
            }
        }
        __syncthreads();
        {
            const int l = 32 * lb + r32; const float al = cac[l], ddl = dsk * __builtin_amdgcn_rcpf(cdt[l]);
#pragma unroll
            for (int q = 0; q < 2; ++q) { const int sb = 2 * (wid & 1) + q;
#pragma unroll
                for (int q4 = 0; q4 < 4; ++q4) { float mv[4];
#pragma unroll
                    for (int e = 0; e < 4; ++e) { const int s = 32 * sb + 8 * q4 + 4 * hh + e;
                        float v = 0.f;
                        if (s <= l) v = xt[q][4 * q4 + e] * fexp(al - cac[s]);
                        if (s == l) v += ddl;
                        mv[e] = v; }
                    u32x2 w; w.x = pk2(mv[0], mv[1]); w.y = pk2(mv[2], mv[3]);
                    *(LAS u32x2*)(lds + S_BM + l * SP + (32 * sb + 8 * q4 + 4 * hh) * 2) = w; }
            }
        }
        __syncthreads();
        {
            const int lb2 = wid & 3, pb2 = wid >> 2; const int l = 32 * lb2 + r32; const size_t tok = t0 + l;
            const int pc0 = hd * 64 + 32 * pb2 + 4 * hh;
            u32x2 zz[4];
#pragma unroll
            for (int q4 = 0; q4 < 4; ++q4) zz[q4] = *(const u32x2*)(proj + tok * PP + pc0 + 8 * q4);
            f32x16 y1, y2; for (int i = 0; i < 16; ++i) { y1[i] = 0.f; y2[i] = 0.f; }
            for (int ks = 0; ks < 2 * (lb2 + 1); ++ks) y1 = MFMA32(ldfrag(lds + S_XDT, 32 * pb2 + r32, 16 * ks + 8 * hh), ldfrag(lds + S_BM, 32 * lb2 + r32, 16 * ks + 8 * hh), y1);
#pragma unroll
            for (int ks = 0; ks < 8; ++ks) y2 = MFMA32(ldfrag(lds + S_HB, 32 * pb2 + r32, 16 * ks + 8 * hh), ldfrag(lds + S_C, 32 * lb2 + r32, 16 * ks + 8 * hh), y2);
            const float cd = fexp(aend);
#pragma unroll
            for (int i = 0; i < 16; ++i) hT[i] *= cd;
#pragma unroll
            for (int ks = 0; ks < 8; ++ks) hT = MFMA32(ldfrag(lds + S_BT, 32 * nb + r32, 16 * ks + 8 * hh), ldfrag(lds + S_XDT, 32 * pb + r32, 16 * ks + 8 * hh), hT);
            const float el = fexp(cac[l]);
#pragma unroll
            for (int q4 = 0; q4 < 4; ++q4) { float yv[4];
#pragma unroll
                for (int e = 0; e < 4; ++e) { const float z = (e & 1) ? bfhi(e < 2 ? zz[q4].x : zz[q4].y) : bflo(e < 2 ? zz[q4].x : zz[q4].y);
                    yv[e] = (y1[4 * q4 + e] + el * y2[4 * q4 + e]) * fsilu(z); }
                u32x2 w; w.x = pk2(yv[0], yv[1]); w.y = pk2(yv[2], yv[3]);
                *(u32x2*)(yg + tok * 1024 + pc0 + 8 * q4) = w; }
        }
        __syncthreads();
    }
#undef SSD_PREFETCH
}

DI void attn_phase_da(Frame& F) {
    const attn_body::bf16* proj = (const attn_body::bf16*)(F.ws + WS_PROJ);
    for (;;) {
        if (threadIdx.x == 0) F.MISC[120] = __hip_atomic_fetch_add(F.ctl + CW_QATT, 1u, __ATOMIC_RELAXED, __HIP_MEMORY_SCOPE_AGENT);
        __syncthreads();
        const int u = __builtin_amdgcn_readfirstlane((int)F.MISC[120]);
        __syncthreads();
        if (u >= 1024) break;
        const int qb = 7 - (u >> 7), combo = u & 127;
        const int half = combo & 1, j = (combo >> 1) & 1, h = (combo >> 2) & 7, b = combo >> 5;
        attn_body::bf16* O = (attn_body::bf16*)(F.ws + (j ? WS_O1 : WS_O0));
        attn_body::attn_unit<8>(b, PC_Q + (h * 2 + j) * 64, PC_V + h * 128 + half * 64, h * 128 + half * 64, qb, proj, proj + (PC_K - PC_Q), proj, O, (char*)F.lds);
    }
}

DI void p3_finalize(Frame& F, const ArgP& a) {
    const int gw = F.vcu * NWAVES + F.wave, NGW = F.G * NWAVES, lane = F.lane;
    bf16_t* ycat = (bf16_t*)(F.ws + WS_YCAT); const bf16_t* yg = (const bf16_t*)(F.ws + WS_YG); const bf16_t* o0 = (const bf16_t*)(F.ws + WS_O0); const bf16_t* o1 = (const bf16_t*)(F.ws + WS_O1);
    float l1 = a.in(I_LQ1)[lane] * a.in(I_LK1)[lane], l2 = a.in(I_LQ2)[lane] * a.in(I_LK2)[lane];
    const float lam = __expf(wave_sum(l1)) - __expf(wave_sum(l2)) + LAM_INIT;
    for (int m = gw; m < NTOK; m += NGW) {
        { bf16_t* yp = ycat + (size_t)m * 2048 + 16 * lane; const bf16_t* gp = yg + (size_t)m * 1024 + 16 * lane;
          const u32x4 r0 = *(const u32x4*)gp, r1 = *(const u32x4*)(gp + 8);
          float v[16]; v[0] = bflo(r0.x); v[1] = bfhi(r0.x); v[2] = bflo(r0.y); v[3] = bfhi(r0.y); v[4] = bflo(r0.z); v[5] = bfhi(r0.z); v[6] = bflo(r0.w); v[7] = bfhi(r0.w);
          v[8] = bflo(r1.x); v[9] = bfhi(r1.x); v[10] = bflo(r1.y); v[11] = bfhi(r1.y); v[12] = bflo(r1.z); v[13] = bfhi(r1.z); v[14] = bflo(r1.w); v[15] = bfhi(r1.w);
          float ss = 0.f;
#pragma unroll
          for (int i = 0; i < 16; ++i) ss += v[i] * v[i];
#pragma unroll
          for (int o = 1; o < 32; o <<= 1) ss += __shfl_xor(ss, o);
          const float rs = 1.f / sqrtf(ss * (1.f / 512.f) + EPS_);
          const float* g = a.in(I_SSDG) + 16 * lane;
          u32x4 w0, w1;
          w0.x = pk2(v[0] * rs * g[0], v[1] * rs * g[1]); w0.y = pk2(v[2] * rs * g[2], v[3] * rs * g[3]); w0.z = pk2(v[4] * rs * g[4], v[5] * rs * g[5]); w0.w = pk2(v[6] * rs * g[6], v[7] * rs * g[7]);
          w1.x = pk2(v[8] * rs * g[8], v[9] * rs * g[9]); w1.y = pk2(v[10] * rs * g[10], v[11] * rs * g[11]); w1.z = pk2(v[12] * rs * g[12], v[13] * rs * g[13]); w1.w = pk2(v[14] * rs * g[14], v[15] * rs * g[15]);
          *(u32x4*)yp = w0; *(u32x4*)(yp + 8) = w1; }
        { const bf16_t* p0 = o0 + (size_t)m * 1024 + 16 * lane; const bf16_t* p1 = o1 + (size_t)m * 1024 + 16 * lane;
          const u32x4 a0 = *(const u32x4*)p0, a1 = *(const u32x4*)(p0 + 8), b0 = *(const u32x4*)p1, b1 = *(const u32x4*)(p1 + 8);
          float v[16];
          v[0] = bflo(a0.x) - lam * bflo(b0.x); v[1] = bfhi(a0.x) - lam * bfhi(b0.x); v[2] = bflo(a0.y) - lam * bflo(b0.y); v[3] = bfhi(a0.y) - lam * bfhi(b0.y);
          v[4] = bflo(a0.z) - lam * bflo(b0.z); v[5] = bfhi(a0.z) - lam * bfhi(b0.z); v[6] = bflo(a0.w) - lam * bflo(b0.w); v[7] = bfhi(a0.w) - lam * bfhi(b0.w);
          v[8] = bflo(a1.x) - lam * bflo(b1.x); v[9] = bfhi(a1.x) - lam * bfhi(b1.x); v[10] = bflo(a1.y) - lam * bflo(b1.y); v[11] = bfhi(a1.y) - lam * bfhi(b1.y);
          v[12] = bflo(a1.z) - lam * bflo(b1.z); v[13] = bfhi(a1.z) - lam * bfhi(b1.z); v[14] = bflo(a1.w) - lam * bflo(b1.w); v[15] = bfhi(a1.w) - lam * bfhi(b1.w);
          float ss = 0.f;
#pragma unroll
          for (int i = 0; i < 16; ++i) ss += v[i] * v[i];
          ss += __shfl_xor(ss, 1); ss += __shfl_xor(ss, 2); ss += __shfl_xor(ss, 4);
          const float rs = 1.f / sqrtf(ss * (1.f / 128.f) + EPS_) * (1.f - LAM_INIT);
          const float* g = a.in(I_SUBG) + 16 * (lane & 7);
          u32x4 w0, w1;
          w0.x = pk2(v[0] * rs * g[0], v[1] * rs * g[1]); w0.y = pk2(v[2] * rs * g[2], v[3] * rs * g[3]); w0.z = pk2(v[4] * rs * g[4], v[5] * rs * g[5]); w0.w = pk2(v[6] * rs * g[6], v[7] * rs * g[7]);
          w1.x = pk2(v[8] * rs * g[8], v[9] * rs * g[9]); w1.y = pk2(v[10] * rs * g[10], v[11] * rs * g[11]); w1.z = pk2(v[12] * rs * g[12], v[13] * rs * g[13]); w1.w = pk2(v[14] * rs * g[14], v[15] * rs * g[15]);
          bf16_t* yp = ycat + (size_t)m * 2048 + 1024 + 16 * lane;
          *(u32x4*)yp = w0; *(u32x4*)(yp + 8) = w1; }
    }
}

struct SchedDense {
    int G, c, nM, nN; const char* A; const char* B; unsigned lda, ldb; int bdiv; size_t bstride;
    DI bool next(int i, pg8::UnitD& u) const {
        const int L = i * G + c; if (L >= nM * nN) return false;
        u.rows = nullptr; u.nvalid = 0; u.lda = lda; u.ldb = ldb; u.type = 0; u.e = 0; u.x0 = 0;
        u.pn = L / nM; u.pm = L % nM;
        u.A = A + (size_t)u.pm * 256 * lda; u.B = B + (size_t)u.pn * 256 * ldb + (size_t)(u.pm / bdiv) * bstride;
        return true;
    }
};
struct EpiResid {
    static constexpr bool AFTER_DRAIN = false;
    const float* base; float* out; bf16_t* outb; float* part; unsigned char* out8; float accscale;
    DI void operator()(const f32x4 (&acc)[2][2][4][2], const pg8::UnitD& u, int wr, int wc, int fr, int fq) const {
        { int ln_ = threadIdx.x; asm volatile("" : "+v"(ln_)); fr = ln_ & 15; fq = (ln_ >> 4) & 3; }
        const int row0 = u.pm * 256 + wr * 64 + fr, col0 = u.pn * 256 + wc * 32 + 8 * fq;
#pragma unroll
        for (int ai = 0; ai < 2; ++ai)
#pragma unroll
            for (int m = 0; m < 4; ++m) { const size_t row = (size_t)(row0 + ai * 128 + m * 16); float ss = 0.f;
#pragma unroll
                for (int bj = 0; bj < 2; ++bj) { const size_t idx = row * 2048 + col0 + bj * 128;
                    f32x4 v0 = acc[ai][bj][m][0] * accscale + *(const f32x4*)(base + idx), v1 = acc[ai][bj][m][1] * accscale + *(const f32x4*)(base + idx + 4);
                    *(f32x4*)(out + idx) = v0; *(f32x4*)(out + idx + 4) = v1;
                    if (out8) { u32x2 w; w.x = __builtin_amdgcn_cvt_pk_fp8_f32(v0[0] * 16.f, v0[1] * 16.f, 0u, false); w.x = __builtin_amdgcn_cvt_pk_fp8_f32(v0[2] * 16.f, v0[3] * 16.f, w.x, true);
                        w.y = __builtin_amdgcn_cvt_pk_fp8_f32(v1[0] * 16.f, v1[1] * 16.f, 0u, false); w.y = __builtin_amdgcn_cvt_pk_fp8_f32(v1[2] * 16.f, v1[3] * 16.f, w.y, true); *(u32x2*)(out8 + idx) = w; }
                    if (outb) { u32x4 w; w.x = pk2(v0[0], v0[1]); w.y = pk2(v0[2], v0[3]); w.z = pk2(v1[0], v1[1]); w.w = pk2(v1[2], v1[3]); *(u32x4*)(outb + idx) = w; }
                    ss += (v0[0] * v0[0] + v0[1] * v0[1]) + (v0[2] * v0[2] + v0[3] * v0[3]) + (v1[0] * v1[0] + v1[1] * v1[1]) + (v1[2] * v1[2] + v1[3] * v1[3]); }
                if (part) { ss += __shfl_xor(ss, 16); ss += __shfl_xor(ss, 32); if (fq == 0) part[row * 32 + u.pn * 4 + wc] = ss; } }
    }
};

struct EpiQ {
    static constexpr bool AFTER_DRAIN = false;
    unsigned char* out8; float* part;
    DI void operator()(const f32x4 (&acc)[2][2][4][2], const pg8::UnitD& u, int wr, int wc, int fr, int fq) const {
        { int ln_ = threadIdx.x; asm volatile("" : "+v"(ln_)); fr = ln_ & 15; fq = (ln_ >> 4) & 3; }
        const int row0 = u.pm * 256 + wr * 64 + fr, col0 = u.pn * 256 + wc * 32 + 8 * fq;
#pragma unroll
        for (int ai = 0; ai < 2; ++ai)
#pragma unroll
            for (int m = 0; m < 4; ++m) { const size_t row = (size_t)(row0 + ai * 128 + m * 16); float ss = 0.f;
#pragma unroll
                for (int bj = 0; bj < 2; ++bj) { const size_t idx = row * 2048 + col0 + bj * 128; const f32x4 v0 = acc[ai][bj][m][0] * (1.f / 1024.f), v1 = acc[ai][bj][m][1] * (1.f / 1024.f);
                    u32x2 w; w.x = __builtin_amdgcn_cvt_pk_fp8_f32(v0[0] * 16.f, v0[1] * 16.f, 0u, false); w.x = __builtin_amdgcn_cvt_pk_fp8_f32(v0[2] * 16.f, v0[3] * 16.f, w.x, true);
                    w.y = __builtin_amdgcn_cvt_pk_fp8_f32(v1[0] * 16.f, v1[1] * 16.f, 0u, false); w.y = __builtin_amdgcn_cvt_pk_fp8_f32(v1[2] * 16.f, v1[3] * 16.f, w.y, true); *(u32x2*)(out8 + idx) = w;
                    ss += (v0[0] * v0[0] + v0[1] * v0[1]) + (v0[2] * v0[2] + v0[3] * v0[3]) + (v1[0] * v1[0] + v1[1] * v1[1]) + (v1[2] * v1[2] + v1[3] * v1[3]); }
                ss += __shfl_xor(ss, 16); ss += __shfl_xor(ss, 32); if (fq == 0) part[row * 32 + u.pn * 4 + wc] = ss; }
    }
};

struct SchedXS {
    int G, c; const unsigned char* ws;
    DI bool next(int i, pg8::UnitD& u) const {
        const int L = i * G + c; if (L >= 256) return false;
        u.rows = nullptr; u.nvalid = 0; u.e = 0;
        const int q = L & 127, bh = q >> 3, t8 = q & 7, b = bh >> 2, h = bh & 3;
        u.pm = b; u.pn = h; u.x0 = t8;
        if (L < 128) { u.type = 0; u.lda = 2048u; u.ldb = 512u;
            u.A = (const char*)(ws + WS_QF8) + (size_t)(b * 2048 + t8 * 256) * 2048 + h * 512; u.B = (const char*)(ws + WS_KN8) + (size_t)(bh * 256) * 512; }
        else { u.type = 1; u.lda = 2048u; u.ldb = 2048u;
            u.A = (const char*)(ws + WS_WO) + (size_t)(t8 * 256) * 2048 + h * 512; u.B = (const char*)(ws + WS_VF8) + (size_t)(b * 256) * 2048 + h * 512; }
        return true;
    }
};
struct EpiXS {
    static constexpr bool AFTER_DRAIN = false;
    unsigned char* P; unsigned char* VWT; const float* part1; const float* partq; LAS float* red;
    DI void operator()(const f32x4 (&acc)[2][2][4][2], const pg8::UnitD& u, int wr, int wc, int fr, int fq) const {
        { int ln_ = threadIdx.x; asm volatile("" : "+v"(ln_)); fr = ln_ & 15; fq = (ln_ >> 4) & 3; }
        const int b = u.pm, h = u.pn, t8 = u.x0;
        const int col0 = wc * 32 + 8 * fq;
        if (u.type == 1) {
            unsigned char* Vu = VWT + ((size_t)b * 2048 + t8 * 256) * 1024 + h * 256;
#pragma unroll
            for (int ai = 0; ai < 2; ++ai)
#pragma unroll
                for (int m = 0; m < 4; ++m) { const unsigned rl = (unsigned)(ai * 128 + wr * 64 + m * 16 + fr);
#pragma unroll
                    for (int bj = 0; bj < 2; ++bj) { const f32x4 v0 = acc[ai][bj][m][0] * (32.f / 1024.f), v1 = acc[ai][bj][m][1] * (32.f / 1024.f);
                        u32x2 w; w.x = __builtin_amdgcn_cvt_pk_fp8_f32(v0[0], v0[1], 0u, false); w.x = __builtin_amdgcn_cvt_pk_fp8_f32(v0[2], v0[3], w.x, true);
                        w.y = __builtin_amdgcn_cvt_pk_fp8_f32(v1[0], v1[1], 0u, false); w.y = __builtin_amdgcn_cvt_pk_fp8_f32(v1[2], v1[3], w.y, true);
                        *(u32x2*)(Vu + (rl * 1024u + (unsigned)(bj * 128 + col0))) = w; } }
            return;
        }
        const size_t row0 = (size_t)b * 2048 + t8 * 256;
        const char* p1u = (const char*)(part1 + row0 * 32); const char* pqu = (const char*)(partq + row0 * 32 + h * 8); unsigned char* Pu = P + row0 * 1024 + h * 256;
        float rsc[2][4];
#pragma unroll
        for (int ai = 0; ai < 2; ++ai)
#pragma unroll
            for (int m = 0; m < 4; ++m) { const unsigned rl = (unsigned)(ai * 128 + wr * 64 + m * 16 + fr);
                const f32x4 p0 = *(const f32x4*)(p1u + (rl * 32u + (unsigned)fq * 8u) * 4u), p1 = *(const f32x4*)(p1u + (rl * 32u + (unsigned)fq * 8u + 4u) * 4u);
                float s1 = (p0[0] + p0[1]) + (p0[2] + p0[3]) + (p1[0] + p1[1]) + (p1[2] + p1[3]);
                const f32x2 pq = *(const f32x2*)(pqu + (rl * 32u + (unsigned)fq * 2u) * 4u);
                float sq = pq[0] + pq[1];
                s1 = quad_sum_16_32(s1); sq = quad_sum_16_32(sq);
                rsc[ai][m] = __builtin_amdgcn_rsqf(sq * (1.f / 512.f) + EPS_ * (s1 * (1.f / 2048.f) + EPS_)) * (1.4426950408889634f / 2048.f);
                float ps = 0.f;
#pragma unroll
                for (int bj = 0; bj < 2; ++bj)
#pragma unroll
                    for (int n = 0; n < 2; ++n)
#pragma unroll
                        for (int e = 0; e < 4; ++e) ps += __builtin_amdgcn_exp2f(fminf(acc[ai][bj][m][n][e] * rsc[ai][m], 100.f));
                ps = quad_sum_16_32(ps);
                if (fq == 0) red[rl * 4 + wc] = ps;
                __builtin_amdgcn_sched_barrier(0); }
        __syncthreads();
        { int ln_ = threadIdx.x; asm volatile("" : "+v"(ln_)); fr = ln_ & 15; fq = (ln_ >> 4) & 3; }
#pragma unroll
        for (int ai = 0; ai < 2; ++ai)
#pragma unroll
            for (int m = 0; m < 4; ++m) { const unsigned rl = (unsigned)(ai * 128 + wr * 64 + m * 16 + fr);
                const f32x4 t = *(const LAS f32x4*)(red + rl * 4); const float inv = 256.f * __builtin_amdgcn_rcpf((t[0] + t[1]) + (t[2] + t[3])); float rs = rsc[ai][m]; asm volatile("" : "+v"(rs));
#pragma unroll
                for (int bj = 0; bj < 2; ++bj) { float x[8];
#pragma unroll
                    for (int n = 0; n < 2; ++n)
#pragma unroll
                        for (int e = 0; e < 4; ++e) x[n * 4 + e] = __builtin_amdgcn_exp2f(fminf(acc[ai][bj][m][n][e] * rs, 100.f)) * inv;
                    u32x2 w; w.x = __builtin_amdgcn_cvt_pk_fp8_f32(x[0], x[1], 0u, false); w.x = __builtin_amdgcn_cvt_pk_fp8_f32(x[2], x[3], w.x, true);
                    w.y = __builtin_amdgcn_cvt_pk_fp8_f32(x[4], x[5], 0u, false); w.y = __builtin_amdgcn_cvt_pk_fp8_f32(x[6], x[7], w.y, true);
                    *(u32x2*)(Pu + (rl * 1024u + (unsigned)(bj * 128 + wc * 32 + 8 * fq))) = w; } }
        __syncthreads();
    }
};

constexpr int HNP = 2052;
DI void p8_route(Frame& F, const ArgP& a) {
    LAS float* s_hn = (LAS float*)F.lds; LAS float* s_part = (LAS float*)(F.lds + 16 * HNP * 4); LAS float* s_log = s_part + 8 * 16 * 32; LAS int* s_slot = (LAS int*)(s_log + 16 * 32);
    LAS int* s_cnt = s_slot + 64; LAS int* s_base = s_cnt + 32;
    const float* h2 = (const float*)(F.ws + WS_H2); unsigned char* xg = (unsigned char*)(F.ws + WS_XG);
    float* gate_of = (float*)(F.ws + WS_GATEOF); int* tok_e = (int*)(F.ws + WS_TOKE);
    const float* rw = a.in(I_RW); const float* rb = a.in(I_RB); const float* g3 = a.in(I_GFFN);
    const int lane = F.lane, wave = F.wave, tid = F.tid, hh = lane >> 5;
    for (int task = F.vcu; task < NTOK / 16; task += F.G) {
        const int tb = task * 16;
#pragma unroll
        for (int q = 0; q < 2; ++q) { const int tl = 2 * wave + q; const size_t tok = (size_t)(tb + tl);
            const f32x4* xr = (const f32x4*)(h2 + tok * 2048) + lane;
            f32x4 v[8]; float s = 0.f;
#pragma unroll
            for (int j = 0; j < 8; ++j) { v[j] = xr[64 * j]; s += (v[j].x * v[j].x + v[j].y * v[j].y) + (v[j].z * v[j].z + v[j].w * v[j].w); }
            const float rstd = 1.f / sqrtf(wave_sum(s) * (1.f / 2048.f) + EPS_);
#pragma unroll
            for (int j = 0; j < 8; ++j) { const f32x4 gg = ((const f32x4*)g3)[lane + 64 * j]; const f32x4 y = v[j] * rstd * gg;
                *(LAS f32x4*)(s_hn + tl * HNP + (lane + 64 * j) * 4) = y; } }
        __syncthreads();
        {
            f32x4 acc0 = {0.f, 0.f, 0.f, 0.f}, acc1 = {0.f, 0.f, 0.f, 0.f};
            const int kq = lane >> 4, c16 = lane & 15;
            const LAS float* ap = s_hn + c16 * HNP + 256 * wave; const float* bp = rw + (size_t)(256 * wave + kq) * 32 + c16;
#pragma unroll 8
            for (int j = 0; j < 64; ++j) { const f32x4 a4 = *(const LAS f32x4*)(ap + 4 * j);
                const float av = (kq == 0) ? a4.x : (kq == 1) ? a4.y : (kq == 2) ? a4.z : a4.w;
                const float b0 = bp[(size_t)(4 * j) * 32], b1 = bp[(size_t)(4 * j) * 32 + 16];
                acc0 = __builtin_amdgcn_mfma_f32_16x16x4f32(av, b0, acc0, 0, 0, 0);
                acc1 = __builtin_amdgcn_mfma_f32_16x16x4f32(av, b1, acc1, 0, 0, 0); }
            LAS float* pp = s_part + wave * 512 + c16;
#pragma unroll
            for (int r = 0; r < 4; ++r) { pp[(4 * kq + r) * 32] = acc0[r]; pp[(4 * kq + r) * 32 + 16] = acc1[r]; }
        }
        __syncthreads();
        {
            const int tt = tid >> 5, e = tid & 31; float lg = rb[e];
#pragma unroll
            for (int w = 0; w < 8; ++w) lg += s_part[w * 512 + tt * 32 + e];
            if (tid < 32) s_cnt[tid] = 0;
            float val[4]; int idx[4]; float cur = lg;
#pragma unroll
            for (int k = 0; k < 4; ++k) { float bv = cur; int bi = e;
#pragma unroll
                for (int o = 1; o < 32; o <<= 1) { const float ov = __shfl_xor(bv, o); const int oi = __shfl_xor(bi, o); if (ov > bv || (ov == bv && oi < bi)) { bv = ov; bi = oi; } }
                val[k] = bv; idx[k] = bi; if (e == bi) cur = -INFINITY; }
            __syncthreads();
            int myrank = 0, myexp = 0; float mygate = 0.f;
            if (e < 4) { const float sum = (__expf(val[0] - val[0]) + __expf(val[1] - val[0])) + (__expf(val[2] - val[0]) + __expf(val[3] - val[0]));
                const float mv = (e == 0) ? val[0] : (e == 1) ? val[1] : (e == 2) ? val[2] : val[3]; myexp = (e == 0) ? idx[0] : (e == 1) ? idx[1] : (e == 2) ? idx[2] : idx[3];
                mygate = __expf(mv - val[0]) / sum; myrank = __hip_atomic_fetch_add(&s_cnt[myexp], 1, __ATOMIC_RELAXED, __HIP_MEMORY_SCOPE_WORKGROUP); }
            __syncthreads();
            if (tid < 32) { const int c = s_cnt[tid]; s_base[tid] = c ? (int)__hip_atomic_fetch_add(F.ctl + CW_CNT + 64 * tid, (unsigned)c, __ATOMIC_RELAXED, __HIP_MEMORY_SCOPE_AGENT) : 0; }
            __syncthreads();
            if (e < 4) { const int slot = myexp * 8192 + s_base[myexp] + myrank; const int tok = tb + tt;
                gate_of[slot] = mygate; tok_e[tok * 4 + e] = slot; s_slot[tt * 4 + e] = slot; }
        }
        __syncthreads();
#pragma unroll
        for (int q = 0; q < 2; ++q) { const int tl = 2 * wave + q;
            unsigned o[8];
#pragma unroll
            for (int j = 0; j < 8; ++j) { const f32x4 y = *(const LAS f32x4*)(s_hn + tl * HNP + (lane + 64 * j) * 4);
                unsigned w = 0u; w = __builtin_amdgcn_cvt_pk_fp8_f32(y.x * 4.f, y.y * 4.f, w, false); w = __builtin_amdgcn_cvt_pk_fp8_f32(y.z * 4.f, y.w * 4.f, w, true); o[j] = w; }
#pragma unroll
            for (int k = 0; k < 4; ++k) { unsigned* o4 = (unsigned*)(xg + (size_t)s_slot[tl * 4 + k] * 2048) + lane;
#pragma unroll
                for (int j = 0; j < 8; ++j) o4[64 * j] = o[j]; } }
        __syncthreads();
    }
}

DI void moe_tables(Frame& F) {
    if (F.tid == 0) { unsigned base = 0u;
        for (int e = 0; e < 32; ++e) { const unsigned c = F.ctl[CW_CNT + 64 * e], mt = (c + 255u) >> 8; F.MISC[16 + e] = c; F.MISC[48 + e] = base; F.MISC[80 + e] = mt; base += mt; }
        F.MISC[112] = base; }
    __syncthreads();
}
DI int ldsu(volatile LAS unsigned* p) { return __builtin_amdgcn_readfirstlane((int)*p); }
template <int NTN  >
struct SchedMoe {
    int G, c; const unsigned char* ws; volatile LAS unsigned* MISC; int total;
    DI bool next(int i, pg8::UnitD& u) const {
        const int L = i * G + c; if (L >= total) return false;
        int e = 0;
        for (int k = 0; k < 32; ++k) { if (L >= (ldsu(MISC + 48 + k) + ldsu(MISC + 80 + k)) * NTN) e = k + 1; }
        const int tb = ldsu(MISC + 48 + e), mte = ldsu(MISC + 80 + e), cnt = ldsu(MISC + 16 + e);
        const int local = L - tb * NTN, nt = local / mte, mt = local % mte;
        u.type = 0; u.e = e; u.pn = nt; u.pm = tb + mt; u.x0 = mt; u.lda = 2048u; u.ldb = 2048u;
        u.rows = nullptr; u.nvalid = cnt - mt * 256;
        if (NTN == 16) { u.A = (const char*)(ws + WS_XG) + ((size_t)e * 8192 + (size_t)mt * 256) * 2048;
            u.B = (const char*)(ws + WS_W1) + ((size_t)e * 4096 + (size_t)nt * 256) * 2048; }
        else { u.A = (const char*)(ws + WS_ACT) + ((size_t)e * 8192 + (size_t)mt * 256) * 2048;
            u.B = (const char*)(ws + WS_W2) + ((size_t)e * 2048 + (size_t)nt * 256) * 2048; }
        return true;
    }
};
struct EpiMoe1 {
    static constexpr bool AFTER_DRAIN = false;
    unsigned char* act; const float* b1;
    DI void operator()(const f32x4 (&acc)[2][2][4][2], const pg8::UnitD& u, int wr, int wc, int fr, int fq) const {
        { int ln_ = threadIdx.x; asm volatile("" : "+v"(ln_)); fr = ln_ & 15; fq = (ln_ >> 4) & 3; }
        const int j0 = u.pn * 128 + wc * 32 + 8 * fq;
        const float* bg = b1 + (size_t)u.e * 4096 + j0; const float* bu = bg + 2048;
        const f32x4 bg0 = *(const f32x4*)bg, bg1 = *(const f32x4*)(bg + 4), bu0 = *(const f32x4*)bu, bu1 = *(const f32x4*)(bu + 4);
#pragma unroll
        for (int ai = 0; ai < 2; ++ai)
#pragma unroll
            for (int m = 0; m < 4; ++m) { const size_t row = (size_t)u.e * 8192 + u.x0 * 256 + ai * 128 + wr * 64 + m * 16 + fr;
                float o[8];
#pragma unroll
                for (int n = 0; n < 2; ++n)
#pragma unroll
                    for (int e = 0; e < 4; ++e) { const float g = fminf(acc[ai][0][m][n][e] * (1.f / 256.f) + (n ? bg1[e] : bg0[e]), 7.f);
                        const float uu = fminf(fmaxf(acc[ai][1][m][n][e] * (1.f / 256.f) + (n ? bu1[e] : bu0[e]), -7.f), 7.f);
                        o[n * 4 + e] = g / (1.f + __expf(-1.702f * g)) * (uu + 1.f) * 4.f; }
                u32x2 w; w.x = __builtin_amdgcn_cvt_pk_fp8_f32(o[0], o[1], 0u, false); w.x = __builtin_amdgcn_cvt_pk_fp8_f32(o[2], o[3], w.x, true);
                w.y = __builtin_amdgcn_cvt_pk_fp8_f32(o[4], o[5], 0u, false); w.y = __builtin_amdgcn_cvt_pk_fp8_f32(o[6], o[7], w.y, true);
                *(u32x2*)(act + row * 2048 + j0) = w; }
    }
};
struct EpiMoe2 {
    static constexpr bool AFTER_DRAIN = false;
    bf16_t* y; const float* b2; const float* gate_of;
    DI void operator()(const f32x4 (&acc)[2][2][4][2], const pg8::UnitD& u, int wr, int wc, int fr, int fq) const {
        { int ln_ = threadIdx.x; asm volatile("" : "+v"(ln_)); fr = ln_ & 15; fq = (ln_ >> 4) & 3; }
        const int col0 = u.pn * 256 + wc * 32 + 8 * fq;
        const float* bp = b2 + (size_t)u.e * 2048 + col0;
#pragma unroll
        for (int ai = 0; ai < 2; ++ai)
#pragma unroll
            for (int m = 0; m < 4; ++m) { const int rl = ai * 128 + wr * 64 + m * 16 + fr; const size_t row = (size_t)u.e * 8192 + u.x0 * 256 + rl;
                const float gt = (rl < u.nvalid) ? gate_of[u.e * 8192 + u.x0 * 256 + rl] : 0.f;
#pragma unroll
                for (int bj = 0; bj < 2; ++bj) { const f32x4 v0 = (acc[ai][bj][m][0] * (1.f / 256.f) + *(const f32x4*)(bp + bj * 128)) * gt, v1 = (acc[ai][bj][m][1] * (1.f / 256.f) + *(const f32x4*)(bp + bj * 128 + 4)) * gt;
                    u32x4 w; w.x = pk2(v0[0], v0[1]); w.y = pk2(v0[2], v0[3]); w.z = pk2(v1[0], v1[1]); w.w = pk2(v1[2], v1[3]);
                    *(u32x4*)(y + row * 2048 + col0 + bj * 128) = w; } }
    }
};

DI void p11_combine(Frame& F, const ArgP& a) {
    const int gw = F.vcu * NWAVES + F.wave, NGW = F.G * NWAVES, lane = F.lane;
    const float* h2 = (const float*)(F.ws + WS_H2); const bf16_t* y = (const bf16_t*)(F.ws + WS_Y);
    const int* tok_e = (const int*)(F.ws + WS_TOKE);
    for (int t = gw; t < NTOK; t += NGW) {
        size_t yrow[4];
#pragma unroll
        for (int k = 0; k < 4; ++k) yrow[k] = (size_t)tok_e[t * 4 + k] * 2048;
#pragma unroll
        for (int j = 0; j < 8; ++j) { const int c = (lane + 64 * j) * 4;
            f32x4 v = *(const f32x4*)(h2 + (size_t)t * 2048 + c);
#pragma unroll
            for (int k = 0; k < 4; ++k) { const u32x2 w = *(const u32x2*)(y + yrow[k] + c); v.x += bflo(w.x); v.y += bfhi(w.x); v.z += bflo(w.y); v.w += bfhi(w.y); }
            *(f32x4*)(a.out() + (size_t)t * 2048 + c) = v; }
    }
}

#ifndef MK_PER_PHASE
#define MK_PER_PHASE 0
#endif
#ifndef MK_LAST_PHASE
#define MK_LAST_PHASE 12
#endif
constexpr int N_PHASES = MK_LAST_PHASE;

__global__ void __launch_bounds__(NWAVES * 64, 2) mega_fwd(Args args_) {
    const ArgP args{};
    extern __shared__ __attribute__((aligned(16))) unsigned char lds_raw[];
    Frame F;
    F.lds = (LAS unsigned char*)lds_raw;
    F.MISC = (volatile LAS unsigned*)(F.lds + MISC_OFF);
    F.tid = threadIdx.x; F.lane = F.tid & 63; F.wave = __builtin_amdgcn_readfirstlane(F.tid >> 6);
    F.G = gridDim.x; { const int bx = blockIdx.x; F.vcu = (F.G % 8 == 0) ? (bx % 8) * (F.G / 8) + bx / 8 : bx; }
    F.ws = args_.ws; F.ctl = (unsigned*)(args_.ws + WS_CTL);
    for (int u = F.tid; u < 256; u += NWAVES * 64) F.MISC[u] = 0u;
    __syncthreads();
    XcdBarrier bar; bar.bar = F.ctl + CW_BAR; bar.x = 0; bar.st = nullptr;
    const int lo = args_.ph_lo, hi = args_.ph_hi;
    if (hi - lo > 1) bar = xcd_barrier_post(F.ctl + CW_BAR, F.MISC + 8);
#ifndef MK_PHASE_MASK
#define MK_PHASE_MASK 0xFFFF
#endif
#define IN(k) (((MK_PHASE_MASK >> (k)) & 1) && lo <= (k) && (k) < hi)
#define SEAM(k) do { if (IN(k) && IN((k) + 1)) xcd_barrier(bar); } while (0)
#define FRESH() do { int t_ = threadIdx.x; asm volatile("" : "+v"(t_)); F.tid = t_; F.lane = t_ & 63; F.wave = __builtin_amdgcn_readfirstlane(t_ >> 6); } while (0)
    unsigned char* ws = args_.ws;

    if (IN(0)) { FRESH(); p0_prologue(F, args); }
    SEAM(0);
    if (IN(1)) { FRESH();
        const bool conv_first = (F.vcu & 1) == 0;
        if (conv_first) { conv_share(F, args); __syncthreads(); }
        SchedP1 S{F.G, F.vcu, ws, 0, 32 * 23};
        EpiP1 E{(bf16_t*)(ws + WS_PROJ), (float*)(ws + WS_DT), (bf16_t*)(ws + WS_KVRAW), args.in(I_DAQG), args.in(I_DAKG), (unsigned char*)(ws + WS_VF8)};
        pg8::gemm_phase<EpiP1, SchedP1, false, true>(F.lds + RING_OFF, 32, S, E);
        if (!conv_first) { __syncthreads(); conv_share(F, args); }
    }
    SEAM(1);
    if (IN(2)) { FRESH();
        if ((F.vcu & 3) == 1) {
            SchedP1 S{(F.G + 3) >> 2, F.vcu >> 2, ws, 32 * 23, 32 * 23 + 64};
            EpiP1 E{(bf16_t*)(ws + WS_PROJ), (float*)(ws + WS_DT), (bf16_t*)(ws + WS_KVRAW), args.in(I_DAQG), args.in(I_DAKG), (unsigned char*)(ws + WS_VF8)};
            pg8::gemm_phase<EpiP1, SchedP1, false, true>(F.lds + RING_OFF, 32, S, E);
            __syncthreads();
        }
        if ((F.vcu & 3) == 0) { for (int u = F.vcu >> 2; u < 64; u += (F.G + 3) >> 2) ssd_unit(F, args, u >> 4, u & 15); }
        __syncthreads();
        attn_phase_da(F);
        __syncthreads();
        conv_queue(F, args, CW_QCONV, CV_NJ - CV_TAIL, CV_TAIL1);
    }
    SEAM(2);
    if (IN(3)) { FRESH(); kprep(F, args); p3_finalize(F, args); }
    SEAM(3);
    if (IN(4)) { FRESH();
        SchedDense S{F.G, F.vcu, 32, 8, (const char*)(ws + WS_YCAT), (const char*)(ws + WS_WOUT), 4096u, 4096u, 1 << 30, 0};
#if MK_LAST_PHASE == 5
        EpiResid E{args.in(I_X), args_.out, nullptr, nullptr, nullptr, 1.f};
#else
        EpiResid E{args.in(I_X), (float*)(ws + WS_H1), nullptr, (float*)(ws + WS_PART1), (unsigned char*)(ws + WS_H1F8), 1.f};
#endif
        pg8::gemm_phase<EpiResid, SchedDense, false, true>(F.lds + RING_OFF, 32, S, E);
    }
    SEAM(4);
    if (IN(5)) { FRESH();
        SchedDense S{F.G, F.vcu, 32, 8, (const char*)(ws + WS_H1F8), (const char*)(ws + WS_WQ), 2048u, 2048u, 1 << 30, 0};
        EpiQ E{(unsigned char*)(ws + WS_QF8), (float*)(ws + WS_PARTQ)};
        pg8::gemm_phase<EpiQ, SchedDense, false, true, true>(F.lds + RING_OFF, 16, S, E);
    }
    SEAM(5);
    if (IN(6)) { FRESH();
        SchedXS S{F.G, F.vcu, ws};
        EpiXS E{(unsigned char*)(ws + WS_P8), (unsigned char*)(ws + WS_VWT8), (const float*)(ws + WS_PART1), (const float*)(ws + WS_PARTQ), (LAS float*)(F.lds + RING_BYTES)};
        pg8::gemm_phase<EpiXS, SchedXS, false, true, true>(F.lds + RING_OFF, 4, S, E);
    }
    SEAM(6);
    if (IN(7)) { FRESH();
        SchedDense S{F.G, F.vcu, 32, 8, (const char*)(ws + WS_P8), (const char*)(ws + WS_VWT8), 1024u, 1024u, 8, (size_t)2048 * 1024};
#if MK_LAST_PHASE == 8
        EpiResid E{(const float*)(ws + WS_H1), args_.out, nullptr, nullptr, nullptr, 1.f / 8192.f};
#else
        EpiResid E{(const float*)(ws + WS_H1), (float*)(ws + WS_H2), nullptr, nullptr, nullptr, 1.f / 8192.f};
#endif
        pg8::gemm_phase<EpiResid, SchedDense, false, true, true>(F.lds + RING_OFF, 8, S, E);
    }
    SEAM(7);
    if (IN(8)) { FRESH(); p8_route(F, args); }
    SEAM(8);
    if (IN(9)) { FRESH();
        moe_tables(F);
        SchedMoe<16> S{F.G, F.vcu, ws, F.MISC, ldsu(F.MISC + 112) * 16};
        EpiMoe1 E{(unsigned char*)(ws + WS_ACT), args.in(I_B1)};
        pg8::gemm_phase<EpiMoe1, SchedMoe<16>, false, true, true>(F.lds + RING_OFF, 16, S, E);
        __syncthreads();
        conv_queue(F, args, CW_QCONV2, CV_NJ - CV_TAIL2, CV_TAIL2);
    }
    SEAM(9);
    if (IN(10)) { FRESH();
        moe_tables(F);
        SchedMoe<8> S{F.G, F.vcu, ws, F.MISC, ldsu(F.MISC + 112) * 8};
        EpiMoe2 E{(bf16_t*)(ws + WS_Y), args.in(I_B2), (const float*)(ws + WS_GATEOF)};
        pg8::gemm_phase<EpiMoe2, SchedMoe<8>, false, true, true>(F.lds + RING_OFF, 16, S, E);
    }
    SEAM(10);
    if (IN(11)) { FRESH(); p11_combine(F, args); }
#undef IN
#undef SEAM
}

extern "C" void kernel_launch(void* const* d_in, const int* in_sizes, int n_in, void* d_out, int out_size, void* d_ws, size_t ws_size, hipStream_t stream) {
    static int grid = 0;
    if (grid == 0) {
        if (n_in != 32 || out_size != NTOK * 2048 || ws_size < WS_END) { fprintf(stderr, "kernel_launch: unexpected shapes (n_in %d out %d ws %zu); nothing launched\n", n_in, out_size, ws_size); grid = -1; return; }
        int dev = 0, cus = 0, per_cu = 0;
        if (hipGetDevice(&dev) != hipSuccess || hipDeviceGetAttribute(&cus, hipDeviceAttributeMultiprocessorCount, dev) != hipSuccess) { grid = -1; return; }
        if (hipFuncSetAttribute((const void*)mega_fwd, hipFuncAttributeMaxDynamicSharedMemorySize, LDS_BYTES) != hipSuccess) { fprintf(stderr, "kernel_launch: hipFuncSetAttribute failed\n"); grid = -1; return; }
        if (hipOccupancyMaxActiveBlocksPerMultiprocessor(&per_cu, (const void*)mega_fwd, NWAVES * 64, LDS_BYTES) != hipSuccess || per_cu < 1) { fprintf(stderr, "kernel_launch: occupancy query says %d\n", per_cu); }
        (void)hipGetLastError();
        if (cus < 256) { fprintf(stderr, "kernel_launch: needs 256 CUs, found %d; nothing launched\n", cus); grid = -1; return; }
        grid = 256;
    }
    if (grid < 0) return;
    if (hipMemsetAsync((char*)d_ws + WS_CTL, 0, CTL_ZERO_BYTES, stream) != hipSuccess) return;
    Args a{};
    for (int i = 0; i < 32; ++i) a.in[i] = (const float*)d_in[i];
    a.out = (float*)d_out; a.ws = (unsigned char*)d_ws;
#if MK_PER_PHASE
    for (int p = 0; p < N_PHASES; ++p) { a.ph_lo = p; a.ph_hi = p + 1; hipLaunchKernelGGL(mega_fwd, dim3(grid), dim3(NWAVES * 64), LDS_BYTES, stream, a); }
#else
    a.ph_lo = 0; a.ph_hi = N_PHASES;
    hipLaunchKernelGGL(mega_fwd, dim3(grid), dim3(NWAVES * 64), LDS_BYTES, stream, a);
#ifdef MK_PROBE_LO
    for (int p = MK_PROBE_LO; p < MK_PROBE_HI; ++p) { a.ph_lo = p; a.ph_hi = p + 1; hipLaunchKernelGGL(mega_fwd, dim3(grid), dim3(NWAVES * 64), LDS_BYTES, stream, a); }
#endif
#endif
}
```

```cpp
#define MK_PER_PHASE 0
#define MK_LAST_PHASE 12
#include <hip/hip_runtime.h>
#include <hip/hip_bf16.h>
#include <cstdio>
#include <cstdint>
#include <cmath>

#define GAS __attribute__((address_space(1)))
#define LAS __attribute__((address_space(3)))
typedef unsigned short bf16_t;
typedef short bf16x8 __attribute__((ext_vector_type(8)));
typedef float f32x2 __attribute__((ext_vector_type(2)));
typedef float f32x4 __attribute__((ext_vector_type(4)));
typedef float f32x16 __attribute__((ext_vector_type(16)));
typedef unsigned u32x2 __attribute__((ext_vector_type(2)));
typedef unsigned u32x4 __attribute__((ext_vector_type(4)));
typedef __bf16 bf16x2_t __attribute__((ext_vector_type(2)));

#define DI __device__ __forceinline__
DI unsigned pk2(float lo, float hi) { f32x2 v = {lo, hi}; bf16x2_t b = __builtin_convertvector(v, bf16x2_t); return __builtin_bit_cast(unsigned, b); }
DI float bflo(unsigned u) { return __uint_as_float(u << 16); }
DI float bfhi(unsigned u) { return __uint_as_float(u & 0xffff0000u); }
DI float bf2f(bf16_t h) { return __uint_as_float(((unsigned)h) << 16); }
DI float wave_sum(float v) {
#pragma unroll
    for (int o = 1; o < 64; o <<= 1) v += __shfl_xor(v, o);
    return v;
}
DI float quad_sum_16_32(float v) {
    int l_ = threadIdx.x; asm volatile("" : "+v"(l_));
    const int a16 = ((l_ ^ 16) & 63) << 2, a32 = ((l_ ^ 32) & 63) << 2;
    v += __builtin_bit_cast(float, __builtin_amdgcn_ds_bpermute(a16, __builtin_bit_cast(int, v)));
    v += __builtin_bit_cast(float, __builtin_amdgcn_ds_bpermute(a32, __builtin_bit_cast(int, v)));
    return v;
}
DI float siluf(float x) { return x / (1.f + __expf(-x)); }

constexpr int DM_ = 2048, NB = 4, SEQ_ = 2048, NTOK = NB * SEQ_;
constexpr int PP = 5632;
constexpr int PC_XBC = 1024, PC_Q = 2560, PC_K = 3584, PC_V = 4608, PC_DT = 5632;
constexpr int WIN_ROWS = 5888;
constexpr int NEXP = 32, MEMLEN = 256;
constexpr float EPS_ = 1e-6f;
constexpr float LAM_INIT = 0.2f;

namespace pg8 {
constexpr int BM = 256, BK = 64, HALF = 128, HTB = HALF * BK * 2  , STAGE_BYTES = 8 * HTB;
DI int lds_byte(int r, int c) { const int st = (r >> 4) * 2 + (c >> 5), rr = r & 15, cc = c & 31, ob = rr * 64 + cc * 2; return st * 1024 + (ob ^ (((ob >> 9) & 1) << 5)); }
DI void stage_rc(int b, int& R, int& C) { const int st = b / 1024, sb = b % 1024, swz = sb ^ (((sb >> 9) & 1) << 5); R = (st >> 1) * 16 + swz / 64; C = (st & 1) * 32 + (swz % 64) / 2; }
DI int perm32(int rho) { const int n = rho >> 4, i = rho & 15; return 8 * (i >> 2) + 4 * n + (i & 3); }

struct UnitD {
    const char* A; const char* B;
    const int* rows;
    unsigned lda, ldb;
    int nvalid;
    int type, pm, pn, e, x0;
};
typedef int v8i_t __attribute__((ext_vector_type(8)));
DI v8i_t cat8(bf16x8 lo, bf16x8 hi) { typedef int v4i_t __attribute__((ext_vector_type(4))); const v4i_t a = __builtin_bit_cast(v4i_t, lo), b = __builtin_bit_cast(v4i_t, hi); return (v8i_t){a[0], a[1], a[2], a[3], b[0], b[1], b[2], b[3]}; }
DI void dense_voff(unsigned lda, unsigned ldb, int tid, unsigned (&vA)[2], unsigned (&vB)[2]) {
#pragma unroll
    for (int i = 0; i < 2; ++i) { int R, C; stage_rc(tid * 16 + i * 8192, R, C); const int Rb = (R & ~31) + perm32(R & 31);
        vA[i] = (unsigned)R * lda + (unsigned)C * 2u; vB[i] = (unsigned)Rb * ldb + (unsigned)C * 2u; }
}
DI void gather_voff(const UnitD& u, int tid, unsigned (&gA)[2][2]) {
#pragma unroll
    for (int i = 0; i < 2; ++i) { int R, C; stage_rc(tid * 16 + i * 8192, R, C);
#pragma unroll
        for (int h = 0; h < 2; ++h) { const int ra = h * 128 + R; const unsigned rowA = (ra < u.nvalid) ? (unsigned)u.rows[ra] : 0u; gA[h][i] = rowA * u.lda + (unsigned)C * 2u; } }
}

template <class Epi, class Sched, bool GATHER, bool ALIGN_EPI, bool FP8 = false>
DI void gemm_phase(LAS unsigned char* lds, int nt, const Sched& S, const Epi& E) {

    const int tid = threadIdx.x, wid = __builtin_amdgcn_readfirstlane(tid >> 6), lane = tid & 63, wr = wid >> 2, wc = wid & 3, fr = lane & 15, fq = lane >> 4;
    const size_t kstep = (size_t)(BK * 2);
    const unsigned ldsb = (unsigned)__builtin_amdgcn_readfirstlane((int)((unsigned)(uintptr_t)lds + (unsigned)wid * 1024u));
    const int aoff = lds_byte(wr * 64 + fr, fq * 8), boff = lds_byte(wc * 32 + fr, fq * 8);
#define PG8_SA(b, h) (((b) * 2 + (h)) * HTB)
#define PG8_SB(b, h) ((4 + (b) * 2 + (h)) * HTB)
#define PG8_STAGE(bufoff, gbase, voff) do { _Pragma("unroll") for (int _i = 0; _i < 2; ++_i) { unsigned keep_; \
        asm volatile("s_mov_b32 %0, m0\n\ts_mov_b32 m0, %3\n\ts_nop 0\n\tglobal_load_lds_dwordx4 %1, %2\n\ts_mov_b32 m0, %0" \
                     : "=&s"(keep_) : "v"((voff)[_i]), "s"((const char*)(gbase)), "s"(ldsb + (unsigned)((bufoff) + _i * 8192)) : "memory"); } } while (0)
#define PG8_STA(bufoff, gbase, h, HS, GA) do { if constexpr (GATHER) { PG8_STAGE(bufoff, gbase, GA[h]); } else { PG8_STAGE(bufoff, (gbase) + (h) * (HS), vA); } } while (0)
#define PG8_STB(bufoff, gbase, h, HS) PG8_STAGE(bufoff, (gbase) + (h) * (HS), vB)
typedef int v4i_t __attribute__((ext_vector_type(4)));
#define PG8_LDA(dst, b, h) do { _Pragma("unroll") for (int m = 0; m < 4; ++m) { if constexpr (FP8) { \
            const v4i_t lo_ = *(const LAS v4i_t*)(lds + PG8_SA(b, h) + aoff + m * 2048), hi_ = *(const LAS v4i_t*)(lds + PG8_SA(b, h) + aoff + m * 2048 + 1024); \
            dst##8[m] = __builtin_shufflevector(lo_, hi_, 0, 1, 2, 3, 4, 5, 6, 7); } \
        else { _Pragma("unroll") for (int k = 0; k < 2; ++k) dst[m][k] = *(const LAS bf16x8*)(lds + PG8_SA(b, h) + aoff + m * 2048 + k * 1024); } } } while (0)
#define PG8_LDB(dst, b, h) do { _Pragma("unroll") for (int n = 0; n < 2; ++n) { if constexpr (FP8) { \
            const v4i_t lo_ = *(const LAS v4i_t*)(lds + PG8_SB(b, h) + boff + n * 2048), hi_ = *(const LAS v4i_t*)(lds + PG8_SB(b, h) + boff + n * 2048 + 1024); \
            dst##8[n] = __builtin_shufflevector(lo_, hi_, 0, 1, 2, 3, 4, 5, 6, 7); } \
        else { _Pragma("unroll") for (int k = 0; k < 2; ++k) dst[n][k] = *(const LAS bf16x8*)(lds + PG8_SB(b, h) + boff + n * 2048 + k * 1024); } } } while (0)
#ifndef PG8_FP8_PRIO
#define PG8_FP8_PRIO 1
#endif
#define PG8_MMA(ai, bj, At, Bt) do { if (!FP8 || PG8_FP8_PRIO) __builtin_amdgcn_s_setprio(1); _Pragma("unroll") for (int m = 0; m < 4; ++m) _Pragma("unroll") for (int n = 0; n < 2; ++n) { \
        if constexpr (FP8) { acc[ai][bj][m][n] = __builtin_amdgcn_mfma_scale_f32_16x16x128_f8f6f4(Bt##8[n], At##8[m], acc[ai][bj][m][n], 0, 0, 0, 0x7f7f7f7f, 0, 0x7f7f7f7f); } \
        else { _Pragma("unroll") for (int k = 0; k < 2; ++k) acc[ai][bj][m][n] = __builtin_amdgcn_mfma_f32_16x16x32_bf16(Bt[n][k], At[m][k], acc[ai][bj][m][n], 0, 0, 0); } } \
        if (!FP8 || PG8_FP8_PRIO) __builtin_amdgcn_s_setprio(0); } while (0)
#define PG8_WAIT_V(n) asm volatile("s_waitcnt vmcnt(" #n ")" ::: "memory")
#define PG8_WAIT_L(n) asm volatile("s_waitcnt lgkmcnt(" #n ")" ::: "memory")
#define PG8_BAR __builtin_amdgcn_s_barrier()
#define PG8_SCHED __builtin_amdgcn_sched_barrier(0)
#define PG8_ITER(A1P, A2P, B2P, HA2, HB2, GA2) do { \
        const char* a3p_ = (A2P) + kstep; const char* b3p_ = (B2P) + kstep; \
        PG8_LDB(B0, 0, 0); PG8_LDB(B1, 0, 1); PG8_SCHED; PG8_LDA(At, 0, 0); PG8_STA(PG8_SA(1, 1), (A1P), 1, hsA, gA); \
        PG8_WAIT_V(8); PG8_WAIT_L(0); PG8_BAR; PG8_MMA(0, 0, At, B0); PG8_MMA(0, 1, At, B1); PG8_BAR; PG8_SCHED; \
        PG8_LDA(At, 0, 1); PG8_STB(PG8_SB(0, 0), (B2P), 0, HB2); PG8_STB(PG8_SB(0, 1), (B2P), 1, HB2); PG8_STA(PG8_SA(0, 0), (A2P), 0, HA2, GA2); \
        PG8_WAIT_V(8); PG8_WAIT_L(0); PG8_BAR; PG8_MMA(1, 0, At, B0); PG8_MMA(1, 1, At, B1); PG8_BAR; PG8_SCHED; \
        PG8_LDB(B0, 1, 0); PG8_LDB(B1, 1, 1); PG8_SCHED; PG8_LDA(At, 1, 0); PG8_STA(PG8_SA(0, 1), (A2P), 1, HA2, GA2); \
        PG8_WAIT_V(8); PG8_WAIT_L(0); PG8_BAR; PG8_MMA(0, 0, At, B0); PG8_MMA(0, 1, At, B1); PG8_BAR; PG8_SCHED; \
        PG8_LDA(At, 1, 1); PG8_STB(PG8_SB(1, 0), b3p_, 0, HB2); PG8_STB(PG8_SB(1, 1), b3p_, 1, HB2); PG8_STA(PG8_SA(1, 0), a3p_, 0, HA2, GA2); \
        PG8_WAIT_V(8); PG8_WAIT_L(0); PG8_BAR; PG8_MMA(1, 0, At, B0); PG8_MMA(1, 1, At, B1); PG8_BAR; PG8_SCHED; \
    } while (0)
    UnitD cur, nxt; int ui = 0;
    if (!S.next(0, cur)) return;
    f32x4 acc[2][2][4][2];
#pragma unroll
    for (int a = 0; a < 2; ++a)
#pragma unroll
        for (int b = 0; b < 2; ++b)
#pragma unroll
            for (int m = 0; m < 4; ++m)
#pragma unroll
                for (int n = 0; n < 2; ++n) acc[a][b][m][n] = (f32x4){0.f, 0.f, 0.f, 0.f};
    bf16x8 At[4][2], B0[2][2], B1[2][2]; v8i_t At8[4], B08[2], B18[2];
    unsigned vA[2], vB[2], gA[2][2], ngA[2][2];
    dense_voff(cur.lda, cur.ldb, tid, vA, vB);
    if constexpr (GATHER) gather_voff(cur, tid, gA);
    const char* cA = cur.A; const char* cB = cur.B;
    size_t hsA = GATHER ? 0 : (size_t)cur.lda * HALF, hsB = (size_t)cur.ldb * HALF;
    PG8_STB(PG8_SB(0, 0), cB, 0, hsB); PG8_STB(PG8_SB(0, 1), cB, 1, hsB); PG8_STA(PG8_SA(0, 0), cA, 0, hsA, gA); PG8_STA(PG8_SA(0, 1), cA, 1, hsA, gA);
    if (wr == 1) PG8_BAR;
    PG8_WAIT_V(2); PG8_BAR;
    PG8_STB(PG8_SB(1, 0), cB + kstep, 0, hsB); PG8_STA(PG8_SA(1, 0), cA + kstep, 0, hsA, gA); PG8_STB(PG8_SB(1, 1), cB + kstep, 1, hsB);
    PG8_WAIT_V(6); PG8_BAR;
    for (;;) {
        const bool has_next = S.next(ui + 1, nxt);
        const char* nA = cA; const char* nB = cB; size_t nhsA = hsA, nhsB = hsB;
        if (has_next) { nA = nxt.A; nB = nxt.B; nhsA = GATHER ? 0 : (size_t)nxt.lda * HALF; nhsB = (size_t)nxt.ldb * HALF; }
        if constexpr (GATHER) {
            if (has_next) gather_voff(nxt, tid, ngA);
            else {
#pragma unroll
                for (int h = 0; h < 2; ++h)
#pragma unroll
                    for (int i = 0; i < 2; ++i) ngA[h][i] = gA[h][i];
            }
        }
#pragma unroll 1
        for (int t = 0; t < nt; t += 2) {
            const bool last = (t == nt - 2);
            const char* a2 = last ? nA : cA + (size_t)(t + 2) * kstep; const char* b2 = last ? nB : cB + (size_t)(t + 2) * kstep;
            const size_t hA2 = last ? nhsA : hsA, hB2 = last ? nhsB : hsB;
            unsigned g2[2][2];
            if constexpr (GATHER) {
#pragma unroll
                for (int h = 0; h < 2; ++h)
#pragma unroll
                    for (int i = 0; i < 2; ++i) g2[h][i] = last ? ngA[h][i] : gA[h][i];
            }
            PG8_ITER(cA + (size_t)(t + 1) * kstep, a2, b2, hA2, hB2, g2);
        }
        if constexpr (ALIGN_EPI) { if (wr == 0) PG8_BAR; }
        if constexpr (!Epi::AFTER_DRAIN) { E(acc, cur, wr, wc, fr, fq); }
        if (!has_next) break;
#pragma unroll
        for (int a = 0; a < 2; ++a)
#pragma unroll
            for (int b = 0; b < 2; ++b)
#pragma unroll
                for (int m = 0; m < 4; ++m)
#pragma unroll
                    for (int n = 0; n < 2; ++n) acc[a][b][m][n] = (f32x4){0.f, 0.f, 0.f, 0.f};
        cur = nxt; cA = nA; cB = nB; hsA = nhsA; hsB = nhsB; ++ui;
        if constexpr (GATHER) {
#pragma unroll
            for (int h = 0; h < 2; ++h)
#pragma unroll
                for (int i = 0; i < 2; ++i) gA[h][i] = ngA[h][i];
        }
        if constexpr (ALIGN_EPI) { if (wr == 1) PG8_BAR; }
    }
    PG8_WAIT_V(0);
    if constexpr (!ALIGN_EPI) { if (wr == 0) PG8_BAR; }
    PG8_BAR;
    if constexpr (Epi::AFTER_DRAIN) { E.fused(acc, cur, wr, wc, fr, fq, lds, wid, lane); }
#undef PG8_SA
#undef PG8_SB
#undef PG8_STAGE
#undef PG8_STA
#undef PG8_STB
#undef PG8_LDA
#undef PG8_LDB
#undef PG8_MMA
#undef PG8_WAIT_V
#undef PG8_WAIT_L
#undef PG8_BAR
#undef PG8_SCHED
#undef PG8_ITER
}
}
namespace attn_body {
using bf16=__hip_bfloat16;
using bf16x8=__attribute__((ext_vector_type(8)))short;
using s16x4=__attribute__((ext_vector_type(4)))short;
using f32x16=__attribute__((ext_vector_type(16)))float;
using u32x4=__attribute__((ext_vector_type(4)))unsigned;
constexpr int BATCH=4,SEQ=2048,D=64,DM=5632,OPITCH=1024;
constexpr int NW=8,QBLK=32,QB=QBLK*NW,KVBLK=64,NQB=SEQ/QB;
constexpr int ATTN_UNIT_ROWS=QB;
__device__ __forceinline__ int crow(int r,int hi){return (r&3)+8*(r>>2)+4*hi;}
#define SBAR() __builtin_amdgcn_sched_barrier(0)
__device__ __forceinline__ void cmask(f32x16&p0,f32x16&p1,int jb,int qrel,int hi){
  const float NEG=-INFINITY; int kb=64*jb+4*hi;
  #pragma unroll
  for(int r=0;r<16;++r){int kv=kb+(r&3)+8*(r>>2); if(kv>qrel)p0[r]=NEG; if(kv+32>qrel)p1[r]=NEG;}
}

constexpr int NSLOT=3, SLOTB=8192;
constexpr int LDS_K=0, LDS_V=NSLOT*SLOTB, LDS_WS=2*NSLOT*SLOTB, LDS_OST=LDS_WS+NW*64*4, LDS_BYTES=LDS_OST+NW*4096;
constexpr float C2=0.125f*1.4426950408889634f;
__device__ __forceinline__ void glds16(const void*gsrc,unsigned lds_dst){unsigned keep;
  asm volatile("s_mov_b32 %0, m0\n\ts_mov_b32 m0, %2\n\ts_nop 0\n\tglobal_load_lds_dwordx4 %1, off\n\ts_mov_b32 m0, %0":"=&s"(keep):"v"(gsrc),"s"(lds_dst):"memory");}
__device__ __forceinline__ float max3f(float a,float b,float c){float r;asm("v_max3_f32 %0, %1, %2, %3":"=v"(r):"v"(a),"v"(b),"v"(c));return r;}
__device__ __forceinline__ float max2f(float a,float b){float r;asm("v_max_f32_e32 %0, %1, %2":"=v"(r):"v"(a),"v"(b));return r;}
__device__ __forceinline__ float fadd_s(float a,float b){float r;asm("v_add_f32_e32 %0, %1, %2":"=v"(r):"v"(a),"v"(b));return r;}
__device__ __forceinline__ float fsub_s(float a,float b){float r;asm("v_sub_f32_e32 %0, %1, %2":"=v"(r):"v"(a),"v"(b));return r;}
typedef float f32x2_t __attribute__((ext_vector_type(2))); typedef __bf16 bf16x2_t __attribute__((ext_vector_type(2)));
__device__ __forceinline__ unsigned cvtpk_s(float lo,float hi){f32x2_t v={lo,hi};bf16x2_t b=__builtin_convertvector(v,bf16x2_t);return __builtin_bit_cast(unsigned,b);}
#define WAIT_BAR(N) asm volatile("s_waitcnt vmcnt(" #N ") lgkmcnt(0)\n\ts_barrier":::"memory")

__device__ __forceinline__ void qkt(f32x16&p0,f32x16&p1,const char*Kslot,const bf16x8*qr,const f32x16&negm,int r32,int hi){
  const char*kb=Kslot+hi*1024+r32*16;
  #pragma unroll
  for(int d0=0;d0<4;++d0){
    const bf16x8 b0=*reinterpret_cast<const bf16x8*>(kb+d0*2048);
    const bf16x8 b1=*reinterpret_cast<const bf16x8*>(kb+d0*2048+512);
    if(d0==0){p0=__builtin_amdgcn_mfma_f32_32x32x16_bf16(b0,qr[0],negm,0,0,0);p1=__builtin_amdgcn_mfma_f32_32x32x16_bf16(b1,qr[0],negm,0,0,0);}
    else{p0=__builtin_amdgcn_mfma_f32_32x32x16_bf16(b0,qr[d0],p0,0,0,0);p1=__builtin_amdgcn_mfma_f32_32x32x16_bf16(b1,qr[d0],p1,0,0,0);}}
}
typedef __attribute__((address_space(3))) const char* lds_cptr;
typedef short v4i16_t __attribute__((ext_vector_type(4)));
__device__ __forceinline__ void kload8(bf16x8*kf,lds_cptr kp){
  kf[0]=*(const __attribute__((address_space(3))) bf16x8*)(kp);      kf[1]=*(const __attribute__((address_space(3))) bf16x8*)(kp+512);
  kf[2]=*(const __attribute__((address_space(3))) bf16x8*)(kp+2048); kf[3]=*(const __attribute__((address_space(3))) bf16x8*)(kp+2560);
  kf[4]=*(const __attribute__((address_space(3))) bf16x8*)(kp+4096); kf[5]=*(const __attribute__((address_space(3))) bf16x8*)(kp+4608);
  kf[6]=*(const __attribute__((address_space(3))) bf16x8*)(kp+6144); kf[7]=*(const __attribute__((address_space(3))) bf16x8*)(kp+6656);
}
__device__ __forceinline__ void kload2(bf16x8*kf,lds_cptr kp,int j){ kf[2*j]=*(const __attribute__((address_space(3))) bf16x8*)(kp+j*2048); kf[2*j+1]=*(const __attribute__((address_space(3))) bf16x8*)(kp+j*2048+512); }
__device__ __forceinline__ s16x4 vtr(lds_cptr p){ return __builtin_bit_cast(s16x4,__builtin_amdgcn_ds_read_tr16_b64_v4i16((__attribute__((address_space(3))) v4i16_t*)p)); }
__device__ __forceinline__ float rowmax(const f32x16&p0,const f32x16&p1){
  float a=max3f(p0[0],p0[1],p1[0]),b=max3f(p0[2],p0[3],p1[1]);a=max3f(a,p1[2],p1[3]);
  #pragma unroll
  for(int r=4;r<16;r+=4){a=max3f(a,p0[r],p0[r+1]);b=max3f(b,p0[r+2],p0[r+3]);a=max3f(a,p1[r],p1[r+1]);b=max3f(b,p1[r+2],p1[r+3]);}
  const float m=max2f(a,b);
  auto rr=__builtin_amdgcn_permlane32_swap(__float_as_uint(m),__float_as_uint(m),false,false);
  return max2f(__uint_as_float(rr[0]),__uint_as_float(rr[1]));
}
__device__ __forceinline__ void pv(f32x16*o,int vb,bf16x8 pa0,bf16x8 pa1,bf16x8 pa2,bf16x8 pa3){
  #pragma unroll
  for(int d0=0;d0<2;++d0){s16x4 lo[4],hi[4];
    #pragma unroll
    for(int ks=0;ks<4;++ks){
      asm volatile("ds_read_b64_tr_b16 %0,%1 offset:%c2":"=&v"(lo[ks]):"v"(vb),"i"(d0*4096+ks*1024):"memory");
      asm volatile("ds_read_b64_tr_b16 %0,%1 offset:%c2":"=&v"(hi[ks]):"v"(vb),"i"(d0*4096+ks*1024+512):"memory");}
    asm volatile("s_waitcnt lgkmcnt(0)":::"memory");SBAR();
    #define PK(k) (bf16x8){lo[k][0],lo[k][1],lo[k][2],lo[k][3],hi[k][0],hi[k][1],hi[k][2],hi[k][3]}
    o[d0]=__builtin_amdgcn_mfma_f32_32x32x16_bf16(pa0,PK(0),o[d0],0,0,0);
    o[d0]=__builtin_amdgcn_mfma_f32_32x32x16_bf16(pa1,PK(1),o[d0],0,0,0);
    o[d0]=__builtin_amdgcn_mfma_f32_32x32x16_bf16(pa2,PK(2),o[d0],0,0,0);
    o[d0]=__builtin_amdgcn_mfma_f32_32x32x16_bf16(pa3,PK(3),o[d0],0,0,0);
    #undef PK
  }
}

#ifndef ATTN_STORE16
#define ATTN_STORE16(p,v) (*(u32x4*)(p)=(v))
#endif
template<int THRL> __device__ __forceinline__ void attn_unit(int b,int qcol,int vcol,int ocol,int qb,const bf16*Q,const bf16*__restrict__ K,const bf16*__restrict__ V,bf16*O,char*shm){
  const int tid=threadIdx.x,lane=tid&63,r32=lane&31,hi=lane>>5; const int wid=__builtin_amdgcn_readfirstlane(tid>>6);
  const long rowbase=(long)b*SEQ; const int q0=qb*QB;
  const bf16*Qw=Q+(rowbase+q0+wid*QBLK)*DM+qcol;
  const bf16*Kh=K+rowbase*DM+qcol,*Vh=V+rowbase*DM+vcol;
  const unsigned lds0=(unsigned)(uintptr_t)shm;
  float*wsf=(float*)(shm+LDS_WS)+wid*64;
  const bf16*ksrc=Kh+(long)lane*DM+wid*8;
  const bf16*vsrc=Vh+(long)(16*(wid&3)+(lane>>2))*DM+(wid>>2)*32+(lane&3)*8;
  const unsigned kdst=lds0+LDS_K+wid*1024, vdst=lds0+LDS_V+wid*1024;
  #define DMA_K(t,slot) glds16(ksrc+(long)(t)*KVBLK*DM,(unsigned)__builtin_amdgcn_readfirstlane(kdst+(slot)))
  #define DMA_V(t,slot) glds16(vsrc+(long)(t)*KVBLK*DM,(unsigned)__builtin_amdgcn_readfirstlane(vdst+(slot)))
  const int vb0=(int)(lds0+LDS_V)+((lane>>4)&1)*32+(lane&3)*8+(4*hi+((lane&15)>>2))*64;
  const char*Kbase=shm+LDS_K; bf16x8 kf[8];
  const lds_cptr shm3=(lds_cptr)shm; const lds_cptr kp0=shm3+LDS_K+hi*1024+r32*16; const lds_cptr vp0=shm3+LDS_V+((lane>>4)&1)*32+(lane&3)*8+(4*hi+((lane&15)>>2))*64;
  const int NT=(q0+QB)/KVBLK;
  DMA_K(0,0);DMA_V(0,0);DMA_K(1,SLOTB);
  bf16x8 qr[4];
  #pragma unroll
  for(int d0=0;d0<4;++d0)qr[d0]=*reinterpret_cast<const bf16x8*>(&Qw[(long)r32*DM+d0*16+hi*8]);
  float mhat=0.f,l_reg=0.f;f32x16 o[2];o[0]=f32x16{};o[1]=f32x16{};f32x16 negm=f32x16{};asm volatile("":"+v"(negm));
  const int qrel=wid*QBLK+r32;
  #define CMASK(P0,P1,t) do{int jb_=(t)-(NT-4); if(jb_>=0)cmask(P0,P1,jb_,qrel,hi);}while(0)
  bool resc=false;
  #define START(P0,P1) do{ const float rm=rowmax(P0,P1); resc=false; \
    { const float dl=rm; mhat=fadd_s(mhat,dl); \
      _Pragma("unroll") for(int r=0;r<16;++r){P0[r]=fsub_s(P0[r],dl);P1[r]=fsub_s(P1[r],dl);} \
      _Pragma("unroll") for(int r=0;r<16;++r)negm[r]=-mhat; asm volatile("":"+v"(negm)); } \
    _Pragma("unroll") for(int r=0;r<16;++r)P0[r]=__builtin_amdgcn_exp2f(P0[r]); }while(0)
  #define RESC() do{ if(resc){ asm volatile("s_waitcnt lgkmcnt(0)":::"memory"); \
      _Pragma("unroll") for(int d_=0;d_<2;++d_) _Pragma("unroll") for(int r=0;r<16;++r)o[d_][r]*=wsf[crow(r,hi)]; } }while(0)
  f32x16 pA0,pA1,pB0,pB1;
  int sl_prev=0,sl_cur=0,sl_next=SLOTB;
  #define ROT() do{sl_prev=sl_cur;sl_cur=sl_next;sl_next=(sl_next==(NSLOT-1)*SLOTB)?0:sl_next+SLOTB;}while(0)
  DMA_K(2,2*SLOTB);
  WAIT_BAR(3);
  qkt(pA0,pA1,Kbase,qr,negm,r32,hi);asm volatile("s_nop 15\n\ts_nop 7":"+v"(pA0),"+v"(pA1));CMASK(pA0,pA1,0);
  START(pA0,pA1);
  _Pragma("unroll") for(int r=0;r<16;++r)pA1[r]=__builtin_amdgcn_exp2f(pA1[r]);
  WAIT_BAR(0);
  DMA_K(3,0);DMA_V(1,SLOTB);
  ROT();
  kload8(kf,kp0+sl_cur);
  WAIT_BAR(2);
  s16x4 vlo[8],vhi[8]; u32x4 pw0,pw1,pw2,pw3;
  #define PKW(P,B) cvtpk_s(P[B],P[B+1])
  #define PAF(k) __builtin_bit_cast(bf16x8,pw##k)
  #define VFR(i) (bf16x8){vlo[i][0],vlo[i][1],vlo[i][2],vlo[i][3],vhi[i][0],vhi[i][1],vhi[i][2],vhi[i][3]}
  #define PIN(x) asm volatile("":"+v"(x))
  #define MX3(a,b,c) __builtin_fmaxf(__builtin_fmaxf((a),(b)),(c))
  #define GAPA(MF,A0,A1,A2,A3,W0,W1,PW) do{ MF; sacc+=A0; sacc+=A1; sacc+=A2; sacc+=A3; PIN(sacc); W0; W1; PIN(PW); SBAR(); }while(0)
  #define EX(v) __builtin_amdgcn_exp2f(v)
  #define GAPB(MF,X,B) do{ MF; X[B]=EX(X[B]); X[B+1]=EX(X[B+1]); X[B+2]=EX(X[B+2]); X[B+3]=EX(X[B+3]); PIN(X); SBAR(); }while(0)
  #define VRD(i) do{ vlo[i]=vtr(vp_+(((i)>>2)*4096+((i)&3)*1024)); vhi[i]=vtr(vp_+(((i)>>2)*4096+((i)&3)*1024+512)); }while(0)
  #define KRD(G,j) do{ if(G){ kload2(kf,kp0+sl_next,j); SBAR(); } }while(0)
  #define STEP(C0,C1,P0,P1,t,GK,GV,GL) do{ SBAR(); \
    const lds_cptr vp_=vp0+sl_prev; \
    VRD(0); SBAR(); float sacc=(P0[0]+P0[1]); \
    GAPA(C0=__builtin_amdgcn_mfma_f32_32x32x16_bf16(kf[0],qr[0],negm,0,0,0), P0[2],P0[3],P0[4],P0[5],     pw0[0]=PKW(P0,0), pw0[1]=PKW(P0,2), pw0); \
    VRD(4); SBAR(); GAPA(C1=__builtin_amdgcn_mfma_f32_32x32x16_bf16(kf[1],qr[0],negm,0,0,0), P0[6],P0[7],P0[8],P0[9],     pw0[2]=PKW(P0,4), pw0[3]=PKW(P0,6), pw0); \
    VRD(1); SBAR(); GAPA(C0=__builtin_amdgcn_mfma_f32_32x32x16_bf16(kf[2],qr[1],C0,0,0,0),   P0[10],P0[11],P0[12],P0[13], pw1[0]=PKW(P0,8), pw1[1]=PKW(P0,10), pw1); \
    VRD(5); SBAR(); GAPA(C1=__builtin_amdgcn_mfma_f32_32x32x16_bf16(kf[3],qr[1],C1,0,0,0),   P0[14],P0[15],P1[0],P1[1],   pw1[2]=PKW(P0,12),pw1[3]=PKW(P0,14), pw1); \
    VRD(2); SBAR(); GAPA(C0=__builtin_amdgcn_mfma_f32_32x32x16_bf16(kf[4],qr[2],C0,0,0,0),   P1[2],P1[3],P1[4],P1[5],     pw2[0]=PKW(P1,0), pw2[1]=PKW(P1,2), pw2); \
    VRD(6); SBAR(); GAPA(C1=__builtin_amdgcn_mfma_f32_32x32x16_bf16(kf[5],qr[2],C1,0,0,0),   P1[6],P1[7],P1[8],P1[9],     pw2[2]=PKW(P1,4), pw2[3]=PKW(P1,6), pw2); \
    VRD(3); SBAR(); GAPA(C0=__builtin_amdgcn_mfma_f32_32x32x16_bf16(kf[6],qr[3],C0,0,0,0),   P1[10],P1[11],P1[12],P1[13], pw3[0]=PKW(P1,8), pw3[1]=PKW(P1,10), pw3); \
    VRD(7); SBAR(); GAPA(C1=__builtin_amdgcn_mfma_f32_32x32x16_bf16(kf[7],qr[3],C1,0,0,0),   P1[14],P1[15],0.f,0.f,       pw3[2]=PKW(P1,12),pw3[3]=PKW(P1,14), pw3); \
    l_reg+=sacc; \
    if(GK){DMA_K((t)+3,sl_cur);} if(GV){DMA_V((t)+1,sl_next);} \
    CMASK(C0,C1,t); \
    { float a=MX3(C0[0],C0[1],C1[0]),b=MX3(C0[2],C0[3],C1[1]); a=MX3(a,C1[2],C1[3]); \
      _Pragma("unroll") for(int r=4;r<16;r+=4){a=MX3(a,C0[r],C0[r+1]);b=MX3(b,C0[r+2],C0[r+3]);a=MX3(a,C1[r],C1[r+1]);b=MX3(b,C1[r+2],C1[r+3]);} \
      float rm=__builtin_fmaxf(a,b); { auto rr=__builtin_amdgcn_permlane32_swap(__float_as_uint(rm),__float_as_uint(rm),false,false); rm=__builtin_fmaxf(__uint_as_float(rr[0]),__uint_as_float(rr[1])); } \
      resc=false; \
      if(__builtin_expect(__any(rm>(float)THRL),0)){ const float dl=__builtin_fmaxf(rm,0.f); mhat+=dl; \
        _Pragma("unroll") for(int r=0;r<16;++r){C0[r]-=dl;C1[r]-=dl;} \
        _Pragma("unroll") for(int r=0;r<16;++r)negm[r]=-mhat; asm volatile("":"+v"(negm)); \
        const float f=__builtin_amdgcn_exp2f(-dl); l_reg*=f; if(hi==0)wsf[r32]=f; resc=true; } } \
    SBAR(); \
    GAPB(o[0]=__builtin_amdgcn_mfma_f32_32x32x16_bf16(PAF(0),VFR(0),o[0],0,0,0), C0,0); \
    GAPB(o[1]=__builtin_amdgcn_mfma_f32_32x32x16_bf16(PAF(0),VFR(4),o[1],0,0,0), C0,4); \
    KRD(GL,0); GAPB(o[0]=__builtin_amdgcn_mfma_f32_32x32x16_bf16(PAF(1),VFR(1),o[0],0,0,0), C0,8); \
    KRD(GL,1); GAPB(o[1]=__builtin_amdgcn_mfma_f32_32x32x16_bf16(PAF(1),VFR(5),o[1],0,0,0), C0,12); \
    KRD(GL,2); GAPB(o[0]=__builtin_amdgcn_mfma_f32_32x32x16_bf16(PAF(2),VFR(2),o[0],0,0,0), C1,0); \
    KRD(GL,3); GAPB(o[1]=__builtin_amdgcn_mfma_f32_32x32x16_bf16(PAF(2),VFR(6),o[1],0,0,0), C1,4); \
    GAPB(o[0]=__builtin_amdgcn_mfma_f32_32x32x16_bf16(PAF(3),VFR(3),o[0],0,0,0), C1,8); \
    GAPB(o[1]=__builtin_amdgcn_mfma_f32_32x32x16_bf16(PAF(3),VFR(7),o[1],0,0,0), C1,12); \
    }while(0)
  int t=1;
  #undef CMASK
  #define CMASK(P0,P1,t) do{}while(0)
  for(;t+5<NT;t+=2){
    STEP(pB0,pB1,pA0,pA1,t,true,true,true);     WAIT_BAR(2); RESC(); ROT();
    STEP(pA0,pA1,pB0,pB1,t+1,true,true,true);   WAIT_BAR(2); RESC(); ROT();
  }
  #undef CMASK
  #define CMASK(P0,P1,t) do{int jb_=(t)-(NT-4); if(jb_>=0)cmask(P0,P1,jb_,qrel,hi);}while(0)
  #define ENDW(tt) do{ if((tt)+3<NT){WAIT_BAR(2);} else if((tt)+2<NT){WAIT_BAR(1);} else {WAIT_BAR(0);} }while(0)
  for(;t+1<NT;t+=2){
    STEP(pB0,pB1,pA0,pA1,t,(t+3<NT),(t+1<NT),(t+1<NT));       ENDW(t);   RESC(); ROT();
    STEP(pA0,pA1,pB0,pB1,t+1,(t+4<NT),(t+2<NT),(t+2<NT));     ENDW(t+1); RESC(); ROT();
  }
  STEP(pB0,pB1,pA0,pA1,NT-1,false,false,false); RESC();
  { float sacc=pB0[0]+pB0[1]; _Pragma("unroll") for(int r=2;r<16;++r)sacc+=pB0[r]; _Pragma("unroll") for(int r=0;r<16;++r)sacc+=pB1[r]; l_reg+=sacc;
    pw0=(u32x4){PKW(pB0,0),PKW(pB0,2),PKW(pB0,4),PKW(pB0,6)};pw1=(u32x4){PKW(pB0,8),PKW(pB0,10),PKW(pB0,12),PKW(pB0,14)};pw2=(u32x4){PKW(pB1,0),PKW(pB1,2),PKW(pB1,4),PKW(pB1,6)};pw3=(u32x4){PKW(pB1,8),PKW(pB1,10),PKW(pB1,12),PKW(pB1,14)};
    SBAR(); pv(o,vb0+sl_cur,PAF(0),PAF(1),PAF(2),PAF(3)); }
  #undef PKW
  #undef PAF
  #undef VFR
  #undef PIN
  #undef MX3
  #undef GAPA
  #undef GAPB
  #undef EX
  #undef VRD
  #undef KRD
  #undef STEP
  #undef ENDW
  {auto rr=__builtin_amdgcn_permlane32_swap(__float_as_uint(l_reg),__float_as_uint(l_reg),false,false);l_reg=__uint_as_float(rr[0])+__uint_as_float(rr[1]);}
  if(hi==0)wsf[32+r32]=l_reg;asm volatile("s_waitcnt lgkmcnt(0)":::"memory");
  float rli[16];
  #pragma unroll
  for(int r=0;r<16;++r)rli[r]=__builtin_amdgcn_rcpf(wsf[32+crow(r,hi)]);
  bf16*Ow=O+(rowbase+q0+wid*QBLK)*OPITCH+ocol;
  { bf16*stg=(bf16*)(shm+LDS_OST)+wid*2048;
    #pragma unroll
    for(int r=0;r<16;++r){const int orow=crow(r,hi);
      #pragma unroll
      for(int d0=0;d0<2;++d0)stg[orow*64+d0*32+r32]=__float2bfloat16(o[d0][r]*rli[r]);}
    asm volatile("s_waitcnt lgkmcnt(0)":::"memory");
    #pragma unroll
    for(int i=0;i<4;++i){const int row=i*8+(lane>>3),ch=lane&7; const u32x4 v=*(const u32x4*)(stg+row*64+ch*8); ATTN_STORE16(Ow+(long)row*OPITCH+ch*8,v);} }
  asm volatile("s_waitcnt lgkmcnt(0)\n\ts_barrier":::"memory");
  #undef DMA_K
  #undef DMA_V
  #undef CMASK
  #undef START
  #undef RESC
  #undef ROT
}
constexpr int ATTN_LDS_BYTES=LDS_BYTES;
#undef SBAR
#undef WAIT_BAR
}
constexpr size_t MiB = 1u << 20;
constexpr size_t WS_CTL = 0, CTL_ZERO_BYTES = 1 * MiB;
constexpr size_t WS_WIN = 2 * MiB, WS_WOUT = 26 * MiB, WS_WQ = 34 * MiB, WS_WKV = 42 * MiB, WS_WO = 58 * MiB, WS_W1 = 66 * MiB, WS_W2 = 578 * MiB;
constexpr size_t WS_HN = 834 * MiB, WS_MN = 866 * MiB, WS_PROJ = 870 * MiB, WS_DT = 958 * MiB, WS_KVRAW = 959 * MiB, WS_KN = 967 * MiB;
constexpr size_t WS_YCAT = 971 * MiB, WS_O0 = 1003 * MiB, WS_O1 = 1019 * MiB, WS_H1 = 1035 * MiB, WS_H1B = 1099 * MiB, WS_PART1 = 1131 * MiB, WS_PARTQ = 1132 * MiB;
constexpr size_t WS_QRAW = 1133 * MiB, WS_P = 1165 * MiB, WS_VWT = 1181 * MiB, WS_H2 = 1197 * MiB, WS_HN3 = 1261 * MiB;
constexpr size_t WS_TOKOF = 1293 * MiB, WS_GATEOF = 1294 * MiB, WS_TOKE = 1295 * MiB, WS_TOKR = 1296 * MiB, WS_YG = 1297 * MiB;
constexpr size_t WS_H1F8 = 3368 * MiB  , WS_QF8 = 3384 * MiB  , WS_KN8 = 3400 * MiB  , WS_VF8 = 3402 * MiB  ;
constexpr size_t WS_P8 = 3404 * MiB  , WS_VWT8 = 3412 * MiB  ;
constexpr size_t WS_XG = 1320 * MiB  , WS_ACT = 1832 * MiB  , WS_Y = 2344 * MiB  , WS_END = 3420 * MiB;
constexpr int CW_BAR = 4096;
constexpr int CW_QCONV2 = 12416;
constexpr int CW_QCONV = 12352;
constexpr int CW_QATT = 12288;
constexpr int CW_CNT = 8192;
static_assert((CW_CNT + 64 * 32) * 4 <= (int)CTL_ZERO_BYTES, "CTL words inside the memset region");

constexpr int RING_OFF = 0, RING_BYTES = 131072;
constexpr int LDS_BYTES = 163840;
constexpr int MISC_OFF = 163840 - 1024;
constexpr int NWAVES = 8;

#define XB_TMO      128
#define XB_XCNT(j)  (256  + 64 * (j))
#define XB_XSUB(j)  (1280 + 64 * (j))
#define XB_XGEN(j)  (2304 + 64 * (j))
#define XB_TOP      3328
#define XB_TOPGEN   3392
#define XCD_BAR_WORDS 3456
#define XB_SPIN_CAP (1u << 20)

__device__ __forceinline__ unsigned xb_ld(unsigned* p)              { return __hip_atomic_load(p, __ATOMIC_RELAXED, __HIP_MEMORY_SCOPE_AGENT); }
__device__ __forceinline__ unsigned xb_add(unsigned* p, unsigned v) { return __hip_atomic_fetch_add(p, v, __ATOMIC_RELAXED, __HIP_MEMORY_SCOPE_AGENT); }
__device__ __forceinline__ unsigned xb_xcc_id() { return (unsigned)__builtin_amdgcn_s_getreg((3 << 11) | 20) & 0xFu; }
#define XB_SPIN(cond, bar) do { unsigned _sp = 0; while (cond) { __builtin_amdgcn_s_sleep(1); \
    if ((++_sp & 255u) == 0u) { if (xb_ld(&(bar)[XB_TMO])) break; if (_sp > XB_SPIN_CAP) { atomicAdd(&(bar)[XB_TMO], 1u); break; } } } } while (0)

struct XcdBarrier {
    unsigned* bar; unsigned x;
    volatile LAS unsigned* st;
};
__device__ __forceinline__ XcdBarrier xcd_barrier_post(unsigned* bar, volatile LAS unsigned* st) {
    XcdBarrier b; b.bar = bar; b.x = xb_xcc_id(); b.st = st;
    if (threadIdx.x == 0) (void)xb_add(&bar[XB_XCNT(b.x)], 1u);
    return b;
}
__device__ __forceinline__ void xcd_barrier_complete(unsigned* bar, unsigned x, unsigned& nloc, unsigned& nx) {
    const unsigned G = gridDim.x * gridDim.y * gridDim.z;
    unsigned sum, cnt, mine, sp = 0u;
    for (;;) {
        sum = 0u; cnt = 0u; mine = 0u;
#pragma unroll
        for (unsigned j = 0; j < 16; ++j) { const unsigned c = xb_ld(&bar[XB_XCNT(j)]); sum += c; cnt += (c > 0u) ? 1u : 0u; mine = (j == x) ? c : mine; }
        if (sum == G) break;
        __builtin_amdgcn_s_sleep(1);
        if ((++sp & 255u) == 0u) { if (xb_ld(&bar[XB_TMO])) break; if (sp > XB_SPIN_CAP) { atomicAdd(&bar[XB_TMO], 1u); break; } }
    }
    nloc = mine > 0u ? mine : 1u; nx = cnt > 0u ? cnt : 1u;
}
__device__ __forceinline__ void xcd_barrier(const XcdBarrier& b) {
    asm volatile("s_waitcnt vmcnt(0)" ::: "memory");
    __syncthreads();
    if (threadIdx.x == 0) {
        unsigned* bar = b.bar;
        __builtin_amdgcn_s_waitcnt(0);
        unsigned nloc = b.st[0], nx = b.st[1];
        if (nloc == 0u) { xcd_barrier_complete(bar, b.x, nloc, nx); b.st[0] = nloc; b.st[1] = nx; }
        const unsigned old = xb_add(&bar[XB_XSUB(b.x)], 1u);
        const unsigned gen = old / nloc;
        if (old + 1u == (gen + 1u) * nloc) {
            __builtin_amdgcn_fence(__ATOMIC_RELEASE, "agent");
            asm volatile("s_waitcnt vmcnt(0)" ::: "memory");
            const unsigned og = xb_add(&bar[XB_TOP], 1u);
            const unsigned tg = og / nx;
            if (og + 1u == (tg + 1u) * nx) xb_add(&bar[XB_TOPGEN], 1u);
            else XB_SPIN(xb_ld(&bar[XB_TOPGEN]) == tg, bar);
            __builtin_amdgcn_fence(__ATOMIC_ACQUIRE, "agent");
            xb_add(&bar[XB_XGEN(b.x)], 1u);
            asm volatile("s_waitcnt vmcnt(0)" ::: "memory");
        } else {
            XB_SPIN(xb_ld(&bar[XB_XGEN(b.x)]) == gen, bar);
            __builtin_amdgcn_fence(__ATOMIC_ACQUIRE, "agent");
            asm volatile("s_waitcnt vmcnt(0)" ::: "memory");
        }
    }
    __syncthreads();
}

struct Args { const float* in[32]; float* out; unsigned char* ws; int ph_lo, ph_hi; };
enum In { I_X = 0, I_MEM, I_GMIX, I_WIN, I_CONVW, I_CONVB, I_DTB, I_ALOG, I_DSKIP, I_SSDG, I_DAQG, I_DAKG, I_LQ1, I_LK1, I_LQ2, I_LK2, I_SUBG, I_WOUT, I_GXA, I_GMEM,
          I_WQ, I_WKV, I_XQG, I_XKG, I_WO, I_GFFN, I_RW, I_RB, I_W1, I_B1, I_W2, I_B2 };

struct ArgP {
    typedef const __attribute__((address_space(4))) char* kptr;
    DI const float* in(int i) const { kptr kp = (kptr)__builtin_amdgcn_kernarg_segment_ptr(); asm volatile("" : "+s"(kp)); return *(const float* const __attribute__((address_space(4)))*)(kp + 8 * i); }
    DI float* out() const { kptr kp = (kptr)__builtin_amdgcn_kernarg_segment_ptr(); asm volatile("" : "+s"(kp)); return *(float* const __attribute__((address_space(4)))*)(kp + 8 * 32); }
};
struct Frame {
    LAS unsigned char* lds;
    volatile LAS unsigned* MISC;
    unsigned* ctl;
    unsigned char* ws;
    int tid, lane, wave, vcu, G;
};

template <class DestRow>
DI void tr_item(const float* W, size_t ldw, int k0, int ncol0, int nvalid, const float* kscale, bf16_t* WT, int K, DestRow dr, LAS float* scr, int lane) {
    const int c = lane & 31;
#pragma unroll 8
    for (int i = 0; i < 32; ++i) { const int kk = 2 * i + (lane >> 5);
        float v = (c < nvalid) ? W[(size_t)(k0 + kk) * ldw + ncol0 + c] : 0.f;
        if (kscale) v *= kscale[k0 + kk];
        scr[kk * 33 + c] = v; }
    asm volatile("s_waitcnt lgkmcnt(0)" ::: "memory");
    const int c8 = lane & 7;
#pragma unroll
    for (int j = 0; j < 4; ++j) { const int n = (lane >> 3) + 8 * j; const LAS float* s = scr + (8 * c8) * 33 + n;
        u32x4 o; o.x = pk2(s[0 * 33], s[1 * 33]); o.y = pk2(s[2 * 33], s[3 * 33]); o.z = pk2(s[4 * 33], s[5 * 33]); o.w = pk2(s[6 * 33], s[7 * 33]);
        if (n < nvalid) *(u32x4*)(WT + (size_t)dr(ncol0 + n) * K + k0 + 8 * c8) = o; }
    asm volatile("s_waitcnt lgkmcnt(0)" ::: "memory");
}
template <class DestRow>
DI void tr_item_fp8(const float* W, size_t ldw, int k0, int ncol0, const float* kscale, unsigned char* WT, int K, DestRow dr, LAS float* scr, int lane) {
    const int c = lane & 31;
#pragma unroll 8
    for (int i = 0; i < 32; ++i) { const int kk = 2 * i + (lane >> 5); float v = W[(size_t)(k0 + kk) * ldw + ncol0 + c]; if (kscale) v *= kscale[k0 + kk]; scr[kk * 33 + c] = v; }
    asm volatile("s_waitcnt lgkmcnt(0)" ::: "memory");
    const int n = lane >> 1, hf = lane & 1; const LAS float* s = scr + (32 * hf) * 33 + n;
    unsigned w[8];
#pragma unroll
    for (int j = 0; j < 8; ++j) { unsigned x = 0u;
        x = __builtin_amdgcn_cvt_pk_fp8_f32(s[(4 * j) * 33] * 64.f, s[(4 * j + 1) * 33] * 64.f, x, false);
        x = __builtin_amdgcn_cvt_pk_fp8_f32(s[(4 * j + 2) * 33] * 64.f, s[(4 * j + 3) * 33] * 64.f, x, true); w[j] = x; }
    unsigned char* op = WT + (size_t)dr(ncol0 + n) * K + k0 + 32 * hf;
    *(u32x4*)op = (u32x4){w[0], w[1], w[2], w[3]}; *(u32x4*)(op + 16) = (u32x4){w[4], w[5], w[6], w[7]};
    asm volatile("s_waitcnt lgkmcnt(0)" ::: "memory");
}
DI int tileperm(int col) { const int o = col & 255; return (col & ~255) + 128 * ((o & 63) >> 5) + 32 * (o >> 6) + (o & 31); }
struct DrIdent { DI int operator()(int n) const { return n; } };
struct DrTile  { DI int operator()(int n) const { return tileperm(n); } };
struct DrWin   { DI int operator()(int n) const { const int pc = (n < 2560) ? n : (n < 2576 ? PC_DT + (n - 2560) : n - 16); return tileperm(pc); } };
struct DrW1    { DI int operator()(int n) const { const int half = n >> 11, j = n & 2047; return (j >> 7) * 256 + half * 128 + (j & 127); } };

template <bool FP8, class DestRow>
DI void cv_item(const float* W, size_t ldw, int k0, int ncol0, const float* kscale, float scale, void* WT, int kpitch, DestRow dr, LAS float* scr, int lane) {
    const int r = lane >> 3, c4 = (lane & 7) * 4;
    f32x4 v[16];
#pragma unroll
    for (int i = 0; i < 16; ++i) v[i] = *(const f32x4*)(W + (size_t)(k0 + 8 * i + r) * ldw + ncol0 + c4);
#pragma unroll
    for (int i = 0; i < 16; ++i) { f32x4 x = v[i] * scale; if (kscale) x = x * kscale[k0 + 8 * i + r]; *(LAS f32x4*)(scr + (8 * i + r) * 36 + c4) = x; }
    asm volatile("s_waitcnt lgkmcnt(0)" ::: "memory");
    const int n = lane & 31, hf = lane >> 5; const LAS float* s = scr + (64 * hf) * 36 + n;
    if constexpr (FP8) {
        unsigned w[16];
#pragma unroll
        for (int j = 0; j < 16; ++j) { unsigned x = 0u; x = __builtin_amdgcn_cvt_pk_fp8_f32(s[(4 * j) * 36], s[(4 * j + 1) * 36], x, false); x = __builtin_amdgcn_cvt_pk_fp8_f32(s[(4 * j + 2) * 36], s[(4 * j + 3) * 36], x, true); w[j] = x; }
        unsigned char* op = (unsigned char*)WT + (size_t)dr(ncol0 + n) * kpitch + k0 + 64 * hf;
#pragma unroll
        for (int j = 0; j < 4; ++j) *(u32x4*)(op + 16 * j) = (u32x4){w[4 * j], w[4 * j + 1], w[4 * j + 2], w[4 * j + 3]};
    } else {
        unsigned w[32];
#pragma unroll
        for (int j = 0; j < 32; ++j) w[j] = pk2(s[(2 * j) * 36], s[(2 * j + 1) * 36]);
        unsigned char* op = (unsigned char*)WT + (size_t)dr(ncol0 + n) * kpitch + (k0 + 64 * hf) * 2;
#pragma unroll
        for (int j = 0; j < 8; ++j) *(u32x4*)(op + 16 * j) = (u32x4){w[4 * j], w[4 * j + 1], w[4 * j + 2], w[4 * j + 3]};
    }
    asm volatile("s_waitcnt lgkmcnt(0)" ::: "memory");
}
DI void rms_row_to_bf16(const float* xrow, const float* g, bf16_t* orow, int lane) {
    const f32x4* xr = (const f32x4*)xrow + lane;
    f32x4 v[8]; float s = 0.f;
#pragma unroll
    for (int j = 0; j < 8; ++j) { v[j] = xr[64 * j]; s += (v[j].x * v[j].x + v[j].y * v[j].y) + (v[j].z * v[j].z + v[j].w * v[j].w); }
    const float rstd = 1.f / sqrtf(wave_sum(s) * (1.f / 2048.f) + EPS_);
    u32x2* o8 = (u32x2*)orow + lane;
#pragma unroll
    for (int j = 0; j < 8; ++j) { const f32x4 gg = ((const f32x4*)g)[lane + 64 * j];
        u32x2 o; o.x = pk2(v[j].x * rstd * gg.x, v[j].y * rstd * gg.y); o.y = pk2(v[j].z * rstd * gg.z, v[j].w * rstd * gg.w); o8[64 * j] = o; }
}

DI void p0_prologue(Frame& F, const ArgP& a) {
    LAS float* scr = (LAS float*)(F.lds + RING_OFF + F.wave * 16384);
    const int gw = F.vcu * NWAVES + F.wave, NGW = F.G * NWAVES;
    unsigned char* ws = F.ws;
    constexpr int I_A = 32 * 80, I_B = 32, I_C = 32 * 96, NITEMS = I_A + I_B + I_C;
    for (int it = gw; it < NITEMS; it += NGW) {
        int r = it;
        if (r < I_A) { tr_item(a.in(I_WIN), 5648, 64 * (r / 80), 32 * (r % 80), 32, nullptr, (bf16_t*)(ws + WS_WIN), 2048, DrWin(), scr, F.lane); continue; } r -= I_A;
        if (r < I_B) { tr_item(a.in(I_WIN), 5648, 64 * r, 2560, 16, nullptr, (bf16_t*)(ws + WS_WIN), 2048, DrWin(), scr, F.lane); continue; } r -= I_B;
        tr_item(a.in(I_WIN), 5648, 64 * (r / 96), 2576 + 32 * (r % 96), 32, nullptr, (bf16_t*)(ws + WS_WIN), 2048, DrWin(), scr, F.lane);
    }
    for (int m = gw; m < NTOK; m += NGW) rms_row_to_bf16(a.in(I_X) + (size_t)m * 2048, a.in(I_GMIX), (bf16_t*)(ws + WS_HN) + (size_t)m * 2048, F.lane);
    for (int m = gw; m < NB * MEMLEN; m += NGW) rms_row_to_bf16(a.in(I_MEM) + (size_t)m * 2048, a.in(I_GMEM), (bf16_t*)(ws + WS_MN) + (size_t)m * 2048, F.lane);
}
struct CvIt { const float* W; size_t ldw; const float* ks; unsigned char* WT; float scale; int k0, n0, kpitch, fp8, dr; };
DI CvIt cv_decode(int it, const ArgP& a, unsigned char* ws) {
    constexpr int J_WOUT = 16 * 64, J_WKV = 16 * 128, J_WQ = 16 * 64, J_WO = 16 * 64, J_W1 = 32 * 16 * 128;
    CvIt c; c.ks = nullptr; c.scale = 64.f; c.fp8 = 1; c.dr = 0; c.kpitch = 2048; c.ldw = 2048;
    int r = it;
    if (r < J_WOUT) { c.W = a.in(I_WOUT); c.k0 = 128 * (r / 64); c.n0 = 32 * (r % 64); c.WT = ws + WS_WOUT; c.scale = 1.f; c.fp8 = 0; c.kpitch = 4096; return c; } r -= J_WOUT;
    if (r < J_WKV) { c.W = a.in(I_WKV); c.ldw = 4096; c.k0 = 128 * (r / 128); c.n0 = 32 * (r % 128); c.WT = ws + WS_WKV; c.scale = 1.f; c.fp8 = 0; c.kpitch = 4096; c.dr = 1; return c; } r -= J_WKV;
    if (r < J_WQ) { c.W = a.in(I_WQ); c.ks = a.in(I_GXA); c.k0 = 128 * (r / 64); c.n0 = 32 * (r % 64); c.WT = ws + WS_WQ; return c; } r -= J_WQ;
    if (r < J_WO) { c.W = a.in(I_WO); c.k0 = 128 * (r / 64); c.n0 = 32 * (r % 64); c.WT = ws + WS_WO; return c; } r -= J_WO;
    if (r < J_W1) { const int e = r / (16 * 128), q = r % (16 * 128); c.W = a.in(I_W1) + (size_t)e * 2048 * 4096; c.ldw = 4096; c.k0 = 128 * (q / 128); c.n0 = 32 * (q % 128); c.WT = ws + WS_W1 + (size_t)e * 4096 * 2048; c.dr = 2; return c; } r -= J_W1;
    { const int e = r / (16 * 64), q = r % (16 * 64); c.W = a.in(I_W2) + (size_t)e * 2048 * 2048; c.k0 = 128 * (q / 64); c.n0 = 32 * (q % 64); c.WT = ws + WS_W2 + (size_t)e * 2048 * 2048; }
    return c;
}
constexpr int CV_NJ = 16 * 64 * 3 + 16 * 128 + 32 * 16 * 128 + 32 * 16 * 64;
constexpr int CV_TAIL2 = 16384;
constexpr int CV_TAIL1 = 16384;
constexpr int CV_TAIL = CV_TAIL1 + CV_TAIL2;
DI void conv_share(Frame& F, const ArgP& a) {
    LAS float* scr = (LAS float*)(F.lds + F.wave * 18432);
    const int gw = F.vcu * NWAVES + F.wave, NGW = F.G * NWAVES, lane = F.lane;
    unsigned char* ws = F.ws;
    constexpr int NJ = CV_NJ - CV_TAIL;
    const int r = lane >> 3, c4 = (lane & 7) * 4, n = lane & 31, hf = lane >> 5;
    if (gw >= NJ) return;
    CvIt cur = cv_decode(gw, a, ws);
    f32x4 v[16];
#pragma unroll
    for (int i = 0; i < 16; ++i) v[i] = __builtin_nontemporal_load((const f32x4*)(cur.W + (size_t)(cur.k0 + 8 * i + r) * cur.ldw + cur.n0 + c4));
    for (int it = gw; it < NJ; it += NGW) {
#pragma unroll
        for (int i = 0; i < 16; ++i) { f32x4 x = v[i] * cur.scale; if (cur.ks) x = x * cur.ks[cur.k0 + 8 * i + r]; *(LAS f32x4*)(scr + (8 * i + r) * 36 + c4) = x; }
        const bool more = (it + NGW) < NJ; CvIt nxt = cur;
        if (more) { nxt = cv_decode(it + NGW, a, ws);
#pragma unroll
            for (int i = 0; i < 16; ++i) v[i] = __builtin_nontemporal_load((const f32x4*)(nxt.W + (size_t)(nxt.k0 + 8 * i + r) * nxt.ldw + nxt.n0 + c4)); }
        asm volatile("s_waitcnt lgkmcnt(0)" ::: "memory");
        const LAS float* s = scr + (64 * hf) * 36 + n;
        const int col = cur.n0 + n; const int drow = (cur.dr == 0) ? col : (cur.dr == 1 ? tileperm(col) : DrW1()(col));
        if (cur.fp8) {
            unsigned w[16];
#pragma unroll
            for (int j = 0; j < 16; ++j) { unsigned x = 0u; x = __builtin_amdgcn_cvt_pk_fp8_f32(s[(4 * j) * 36], s[(4 * j + 1) * 36], x, false); x = __builtin_amdgcn_cvt_pk_fp8_f32(s[(4 * j + 2) * 36], s[(4 * j + 3) * 36], x, true); w[j] = x; }
            unsigned char* op = cur.WT + (size_t)drow * cur.kpitch + cur.k0 + 64 * hf;
#pragma unroll
            for (int j = 0; j < 4; ++j) *(u32x4*)(op + 16 * j) = (u32x4){w[4 * j], w[4 * j + 1], w[4 * j + 2], w[4 * j + 3]};
        } else {
            unsigned w[32];
#pragma unroll
            for (int j = 0; j < 32; ++j) w[j] = pk2(s[(2 * j) * 36], s[(2 * j + 1) * 36]);
            unsigned char* op = cur.WT + (size_t)drow * cur.kpitch + (cur.k0 + 64 * hf) * 2;
#pragma unroll
            for (int j = 0; j < 8; ++j) *(u32x4*)(op + 16 * j) = (u32x4){w[4 * j], w[4 * j + 1], w[4 * j + 2], w[4 * j + 3]};
        }
        asm volatile("s_waitcnt lgkmcnt(0)" ::: "memory");
        cur = nxt;
    }
}

DI void conv_queue(Frame& F, const ArgP& a, int qword, int first, int count) {
    LAS float* scr = (LAS float*)(F.lds + F.wave * 18432);
    unsigned char* ws = F.ws;
    const int lane = threadIdx.x & 63, r = lane >> 3, c4 = (lane & 7) * 4, n = lane & 31, hf = lane >> 5;
    for (;;) {
        if (threadIdx.x == 0) F.MISC[121] = __hip_atomic_fetch_add(F.ctl + qword, 8u, __ATOMIC_RELAXED, __HIP_MEMORY_SCOPE_AGENT);
        __syncthreads();
        const int base = __builtin_amdgcn_readfirstlane((int)F.MISC[121]);
        __syncthreads();
        if (base >= count) break;
        const int it = first + base + F.wave;
        if (base + F.wave < count) {
            const CvIt cur = cv_decode(it, a, ws);
            f32x4 v[16];
#pragma unroll
            for (int i = 0; i < 16; ++i) v[i] = __builtin_nontemporal_load((const f32x4*)(cur.W + (size_t)(cur.k0 + 8 * i + r) * cur.ldw + cur.n0 + c4));
#pragma unroll
            for (int i = 0; i < 16; ++i) *(LAS f32x4*)(scr + (8 * i + r) * 36 + c4) = v[i] * cur.scale;
            asm volatile("s_waitcnt lgkmcnt(0)" ::: "memory");
            const LAS float* s = scr + (64 * hf) * 36 + n;
            unsigned w[16];
#pragma unroll
            for (int j = 0; j < 16; ++j) { unsigned x = 0u; x = __builtin_amdgcn_cvt_pk_fp8_f32(s[(4 * j) * 36], s[(4 * j + 1) * 36], x, false); x = __builtin_amdgcn_cvt_pk_fp8_f32(s[(4 * j + 2) * 36], s[(4 * j + 3) * 36], x, true); w[j] = x; }
            unsigned char* op = cur.WT + (size_t)(cur.n0 + n) * cur.kpitch + cur.k0 + 64 * hf;
#pragma unroll
            for (int j = 0; j < 4; ++j) *(u32x4*)(op + 16 * j) = (u32x4){w[4 * j], w[4 * j + 1], w[4 * j + 2], w[4 * j + 3]};
            asm volatile("s_waitcnt lgkmcnt(0)" ::: "memory");
        }
    }
}
static_assert(CV_TAIL <= 32 * 16 * 64 && CV_TAIL1 % 8 == 0 && CV_TAIL2 % 8 == 0, "the tails are a suffix of the moe_w2 items");

struct SchedP1 {
    int G, c; const unsigned char* ws; int lo, hi;
    DI bool next(int i, pg8::UnitD& u) const {
        const int L = lo + i * G + c; if (L >= hi) return false;
        u.rows = nullptr; u.nvalid = 0; u.lda = 4096u; u.ldb = 4096u; u.e = 0; u.x0 = 0;
        if (L < 32 * 23) { u.type = 0; u.pn = L / 32; u.pm = L % 32; u.A = (const char*)(ws + WS_HN) + (size_t)u.pm * 256 * 4096; u.B = (const char*)(ws + WS_WIN) + (size_t)u.pn * 256 * 4096; }
        else { const int q = L - 32 * 23; u.type = 1; u.pn = q / 4; u.pm = q % 4; u.A = (const char*)(ws + WS_MN) + (size_t)u.pm * 256 * 4096; u.B = (const char*)(ws + WS_WKV) + (size_t)u.pn * 256 * 4096; }
        return true;
    }
};
struct EpiP1 {
    static constexpr bool AFTER_DRAIN = false;
    bf16_t* proj; float* dtb; bf16_t* kvraw; const float* gq; const float* gk; unsigned char* vf8;
    DI void operator()(const f32x4 (&acc)[2][2][4][2], const pg8::UnitD& u, int wr, int wc, int fr, int fq) const {
        { int ln_ = threadIdx.x; asm volatile("" : "+v"(ln_)); fr = ln_ & 15; fq = (ln_ >> 4) & 3; }
        const int row0 = u.pm * 256 + wr * 64 + fr;
        const int cn = u.pn * 256 + 64 * wc + 8 * fq;
        if (u.type == 1 && u.pn >= 8) {
#pragma unroll
            for (int ai = 0; ai < 2; ++ai)
#pragma unroll
                for (int m = 0; m < 4; ++m) { unsigned char* rp = vf8 + (size_t)(row0 + ai * 128 + m * 16) * 2048 + (cn - 2048);
#pragma unroll
                    for (int bj = 0; bj < 2; ++bj) { const f32x4 v0 = acc[ai][bj][m][0] * 16.f, v1 = acc[ai][bj][m][1] * 16.f;
                        u32x2 w; w.x = __builtin_amdgcn_cvt_pk_fp8_f32(v0[0], v0[1], 0u, false); w.x = __builtin_amdgcn_cvt_pk_fp8_f32(v0[2], v0[3], w.x, true);
                        w.y = __builtin_amdgcn_cvt_pk_fp8_f32(v1[0], v1[1], 0u, false); w.y = __builtin_amdgcn_cvt_pk_fp8_f32(v1[2], v1[3], w.y, true);
                        *(u32x2*)(rp + 32 * bj) = w; } }
            return;
        }
        if (u.type == 1) {
#pragma unroll
            for (int ai = 0; ai < 2; ++ai)
#pragma unroll
                for (int m = 0; m < 4; ++m) { bf16_t* rp = kvraw + (size_t)(row0 + ai * 128 + m * 16) * 4096 + cn;
#pragma unroll
                    for (int bj = 0; bj < 2; ++bj) { const f32x4 v0 = acc[ai][bj][m][0], v1 = acc[ai][bj][m][1];
                        u32x4 w; w.x = pk2(v0[0], v0[1]); w.y = pk2(v0[2], v0[3]); w.z = pk2(v1[0], v1[1]); w.w = pk2(v1[2], v1[3]); *(u32x4*)(rp + 32 * bj) = w; } }
            return;
        }
        if (u.pn == 22) {
            if (wc == 0 && fq < 2) {
#pragma unroll
                for (int ai = 0; ai < 2; ++ai)
#pragma unroll
                    for (int m = 0; m < 4; ++m) { float* rp = dtb + (size_t)(row0 + ai * 128 + m * 16) * 16 + 8 * fq;
                        *(f32x4*)(rp) = acc[ai][0][m][0]; *(f32x4*)(rp + 4) = acc[ai][0][m][1]; }
            }
            return;
        }
        const bool isq = (u.pn >= 10 && u.pn < 14), isk = (u.pn >= 14 && u.pn < 18);
        if (!(isq || isk)) {
#pragma unroll
            for (int ai = 0; ai < 2; ++ai)
#pragma unroll
                for (int m = 0; m < 4; ++m) { bf16_t* rp = proj + (size_t)(row0 + ai * 128 + m * 16) * PP + cn;
#pragma unroll
                    for (int bj = 0; bj < 2; ++bj) { const f32x4 v0 = acc[ai][bj][m][0], v1 = acc[ai][bj][m][1];
                        u32x4 w; w.x = pk2(v0[0], v0[1]); w.y = pk2(v0[2], v0[3]); w.z = pk2(v1[0], v1[1]); w.w = pk2(v1[2], v1[3]); *(u32x4*)(rp + 32 * bj) = w; } }
            return;
        }
        const float* g = (isq ? gq : gk) + 8 * fq; const float sc = isq ? (0.125f * 1.4426950408889634f) : 1.f;
#pragma unroll
        for (int ai = 0; ai < 2; ++ai)
#pragma unroll
            for (int m = 0; m < 4; ++m) { bf16_t* rp = proj + (size_t)(row0 + ai * 128 + m * 16) * PP + cn;
                float ss = 0.f;
#pragma unroll
                for (int bj = 0; bj < 2; ++bj)
#pragma unroll
                    for (int n = 0; n < 2; ++n) { const f32x4 v = acc[ai][bj][m][n]; ss += (v[0] * v[0] + v[1] * v[1]) + (v[2] * v[2] + v[3] * v[3]); }
                ss += __shfl_xor(ss, 16); ss += __shfl_xor(ss, 32);
                const float rs = sc / sqrtf(ss * (1.f / 64.f) + EPS_);
#pragma unroll
                for (int bj = 0; bj < 2; ++bj) { const f32x4 v0 = acc[ai][bj][m][0] * rs * *(const f32x4*)(g + 32 * bj), v1 = acc[ai][bj][m][1] * rs * *(const f32x4*)(g + 32 * bj + 4);
                    u32x4 w; w.x = pk2(v0[0], v0[1]); w.y = pk2(v0[2], v0[3]); w.z = pk2(v1[0], v1[1]); w.w = pk2(v1[2], v1[3]); *(u32x4*)(rp + 32 * bj) = w; } }
    }
};

DI void kprep(Frame& F, const ArgP& a) {
    const int gw = F.vcu * NWAVES + F.wave, NGW = F.G * NWAVES;
    const bf16_t* kv = (const bf16_t*)(F.ws + WS_KVRAW); unsigned char* kn = (unsigned char*)(F.ws + WS_KN8);
    for (int it = gw; it < NB * MEMLEN * 4; it += NGW) {
        const int row = it >> 2, h = it & 3, b = row >> 8, key = row & 255;
        const u32x4 raw = *(const u32x4*)(kv + (size_t)row * 4096 + h * 512 + F.lane * 8);
        float v[8]; v[0] = bflo(raw.x); v[1] = bfhi(raw.x); v[2] = bflo(raw.y); v[3] = bfhi(raw.y); v[4] = bflo(raw.z); v[5] = bfhi(raw.z); v[6] = bflo(raw.w); v[7] = bfhi(raw.w);
        float ss = 0.f;
#pragma unroll
        for (int j = 0; j < 8; ++j) ss += v[j] * v[j];
        const float rs = 1.f / sqrtf(wave_sum(ss) * (1.f / 512.f) + EPS_) * 0.04419417382415922f * 128.f;
        const float* gk = a.in(I_XKG) + F.lane * 8; const float* gq = a.in(I_XQG) + F.lane * 8;
        u32x2 o; o.x = __builtin_amdgcn_cvt_pk_fp8_f32(v[0] * rs * gk[0] * gq[0], v[1] * rs * gk[1] * gq[1], 0u, false); o.x = __builtin_amdgcn_cvt_pk_fp8_f32(v[2] * rs * gk[2] * gq[2], v[3] * rs * gk[3] * gq[3], o.x, true);
        o.y = __builtin_amdgcn_cvt_pk_fp8_f32(v[4] * rs * gk[4] * gq[4], v[5] * rs * gk[5] * gq[5], 0u, false); o.y = __builtin_amdgcn_cvt_pk_fp8_f32(v[6] * rs * gk[6] * gq[6], v[7] * rs * gk[7] * gq[7], o.y, true);
        *(u32x2*)(kn + ((size_t)((b * 4 + h) * 256 + key)) * 512 + F.lane * 8) = o;
    }
}

constexpr int SP = 272;
constexpr int S_C = 0, S_BM = 34816, S_BT = 69632, S_XDT = 104448, S_HB = 121856, S_F = 139264, S_W = 155648  , SSD_LDS = 162048;
static_assert(SSD_LDS <= MISC_OFF, "SSD LDS map");
#define MFMA32(a, b, c) __builtin_amdgcn_mfma_f32_32x32x16_bf16((a), (b), (c), 0, 0, 0)
DI int crow(int r, int hi) { return (r & 3) + 8 * (r >> 2) + 4 * hi; }
DI bf16x8 ldfrag(LAS const unsigned char* base, int row, int kel) { return *(const LAS bf16x8*)(base + row * SP + kel * 2); }
DI float fexp(float x) { return __builtin_amdgcn_exp2f(x * 1.4426950408889634f); }
DI float fsilu(float x) { return x * __builtin_amdgcn_rcpf(1.f + fexp(-x)); }

DI void ssd_unit(Frame& F, const ArgP& a, int b, int hd) {
    LAS unsigned char* lds = F.lds;
    int tid = F.tid, lane = F.lane, r32 = lane & 31, hh = lane >> 5; const int wid = F.wave;
    LAS float* sdt = (LAS float*)(lds + S_F); LAS float* sac = sdt + 2048;
    const bf16_t* proj = (const bf16_t*)(F.ws + WS_PROJ); const float* dtbuf = (const float*)(F.ws + WS_DT); bf16_t* yg = (bf16_t*)(F.ws + WS_YG);
    const int g = hd >> 3;
    const float aneg = -__expf(a.in(I_ALOG)[hd]), dtb = a.in(I_DTB)[hd], dsk = a.in(I_DSKIP)[hd];
#pragma unroll
    for (int q = 0; q < 2; ++q) { const int c = 2 * wid + q; const size_t t0 = (size_t)b * SEQ_ + c * 128;
        const float x0 = dtbuf[(t0 + 2 * lane) * 16 + hd] + dtb, x1 = dtbuf[(t0 + 2 * lane + 1) * 16 + hd] + dtb;
        const float d0 = x0 > 20.f ? x0 : log1pf(__expf(x0)), d1 = x1 > 20.f ? x1 : log1pf(__expf(x1));
        const float a0 = d0 * aneg, a1 = d1 * aneg;
        float s = a0 + a1;
#pragma unroll
        for (int o = 1; o < 64; o <<= 1) { const float t = __shfl_up(s, o); if (lane >= o) s += t; }
        sdt[c * 128 + 2 * lane] = d0; sdt[c * 128 + 2 * lane + 1] = d1; sac[c * 128 + 2 * lane] = s - a1; sac[c * 128 + 2 * lane + 1] = s; }
    int seg = tid >> 5, cg = tid & 31, l0 = seg * 8;
    int colbc = (cg < 16) ? (1024 + g * 128 + cg * 8) : (1280 + g * 128 + (cg - 16) * 8);
    const int colx = hd * 64 + wid * 8; int lx = 2 * lane;
    LAS float* swt = (LAS float*)(lds + S_W);
    { const float* convw = a.in(I_CONVW); const float* convb = a.in(I_CONVB);
      if (tid < 320) { const int ci = tid;
          const int xc = (ci < 64) ? (hd * 64 + ci) : (ci < 192 ? (1024 + g * 128 + (ci - 64)) : (1280 + g * 128 + (ci - 192)));
#pragma unroll
          for (int k = 0; k < 4; ++k) swt[k * 320 + ci] = convw[k * 1536 + xc];
          swt[4 * 320 + ci] = convb[xc]; } }
    int cibc = 64 + cg * 8; const int cix = wid * 8;
    const char* pub = (const char*)F.ws; const unsigned pxb = (unsigned)(WS_PROJ + ((size_t)b * SEQ_ * PP + PC_XBC) * 2), zoff = (unsigned)(WS_CTL + 524288);
    u32x4 inbc[11], inx[5];
#define SSD_PREFETCH(c_) do { \
        int sd_ = l0; asm volatile("" : "+v"(sd_)); \
        _Pragma("unroll") for (int j = 0; j < 11; ++j) { const int tt = (c_) * 128 + sd_ - 3 + j; inbc[j] = *(const u32x4*)(pub + ((tt >= 0) ? pxb + (unsigned)(tt * PP + colbc) * 2u : zoff)); } } while (0)
    SSD_PREFETCH(0);
    f32x16 hT; for (int i = 0; i < 16; ++i) hT[i] = 0.f;
    const int nb = wid & 3, pb = wid >> 2;
    __syncthreads();
    for (int c = 0; c < 16; ++c) {
        { int t_ = threadIdx.x; asm volatile("" : "+v"(t_)); tid = t_; lane = t_ & 63; r32 = lane & 31; hh = lane >> 5; seg = t_ >> 5; cg = t_ & 31; l0 = seg * 8; lx = 2 * lane;
          colbc = (cg < 16) ? (1024 + g * 128 + cg * 8) : (1280 + g * 128 + (cg - 16) * 8); cibc = 64 + cg * 8; }
        const size_t t0 = (size_t)b * SEQ_ + c * 128;
        const LAS float* cdt = sdt + c * 128; const LAS float* cac = sac + c * 128;
        const float aend = cac[127];
        u32x2 zz[4];
        { const size_t ztok = t0 + 32 * (wid & 3) + r32; const int zc0 = hd * 64 + 32 * (wid >> 2) + 4 * hh;
#pragma unroll
          for (int q4 = 0; q4 < 4; ++q4) zz[q4] = *(const u32x2*)(proj + ztok * PP + zc0 + 8 * q4); }
#pragma unroll
        for (int j = 0; j < 5; ++j) { int sd_ = lx; asm volatile("" : "+v"(sd_)); const int tt = c * 128 + sd_ - 3 + j; inx[j] = *(const u32x4*)(pub + ((tt >= 0) ? pxb + (unsigned)(tt * PP + colx) * 2u : zoff)); }
        {
            LAS unsigned char* hbp = lds + S_HB + (32 * pb + r32) * SP + (32 * nb + 4 * hh) * 2;
#pragma unroll
            for (int q4 = 0; q4 < 4; ++q4) { u32x2 w; w.x = pk2(hT[4 * q4], hT[4 * q4 + 1]); w.y = pk2(hT[4 * q4 + 2], hT[4 * q4 + 3]); *(LAS u32x2*)(hbp + 16 * q4) = w; }
        }
        {
            float wbc[5][8];
#pragma unroll
            for (int k = 0; k < 5; ++k) { const f32x4 w0 = *(const LAS f32x4*)(swt + k * 320 + cibc), w1 = *(const LAS f32x4*)(swt + k * 320 + cibc + 4);
#pragma unroll
                for (int i = 0; i < 4; ++i) { wbc[k][i] = w0[i]; wbc[k][4 + i] = w1[i]; } }
#pragma unroll
            for (int hf = 0; hf < 2; ++hf) {
                __builtin_amdgcn_sched_barrier(0);
                float o[4][8];
#pragma unroll
                for (int j = 0; j < 4; ++j)
#pragma unroll
                    for (int i = 0; i < 8; ++i) { float s = wbc[4][i];
#pragma unroll
                        for (int k = 0; k < 4; ++k) { const unsigned wd = inbc[4 * hf + j + k][i >> 1]; s += wbc[k][i] * ((i & 1) ? bfhi(wd) : bflo(wd)); }
                        o[j][i] = fsilu(s); }
                const int lh = l0 + 4 * hf;
                if (cg < 16) {
                    const int n0 = cg * 8; float ev[4];
#pragma unroll
                    for (int j = 0; j < 4; ++j) { ev[j] = fexp(aend - cac[lh + j]);
                        u32x4 w1; w1.x = pk2(o[j][0], o[j][1]); w1.y = pk2(o[j][2], o[j][3]); w1.z = pk2(o[j][4], o[j][5]); w1.w = pk2(o[j][6], o[j][7]);
                        *(LAS u32x4*)(lds + S_BM + (lh + j) * SP + n0 * 2) = w1; }
#pragma unroll
                    for (int i = 0; i < 8; ++i) { u32x2 w2; w2.x = pk2(o[0][i] * ev[0], o[1][i] * ev[1]); w2.y = pk2(o[2][i] * ev[2], o[3][i] * ev[3]);
                        *(LAS u32x2*)(lds + S_BT + (n0 + i) * SP + lh * 2) = w2; }
                } else {
                    const int n0 = (cg - 16) * 8;
#pragma unroll
                    for (int j = 0; j < 4; ++j) { u32x4 w1; w1.x = pk2(o[j][0], o[j][1]); w1.y = pk2(o[j][2], o[j][3]); w1.z = pk2(o[j][4], o[j][5]); w1.w = pk2(o[j][6], o[j][7]);
                        *(LAS u32x4*)(lds + S_C + (lh + j) * SP + n0 * 2) = w1; }
                }
            }
        }
        __builtin_amdgcn_sched_barrier(0);
        {
            const float d0 = cdt[lx], d1 = cdt[lx + 1];
            float wx[5][8];
#pragma unroll
            for (int k = 0; k < 5; ++k) { const f32x4 w0 = *(const LAS f32x4*)(swt + k * 320 + cix), w1 = *(const LAS f32x4*)(swt + k * 320 + cix + 4);
#pragma unroll
                for (int i = 0; i < 4; ++i) { wx[k][i] = w0[i]; wx[k][4 + i] = w1[i]; } }
#pragma unroll
            for (int i = 0; i < 8; ++i) { float s0 = wx[4][i], s1 = wx[4][i];
#pragma unroll
                for (int k = 0; k < 4; ++k) { const unsigned w0 = inx[k][i >> 1], w1 = inx[k + 1][i >> 1];
                    s0 += wx[k][i] * ((i & 1) ? bfhi(w0) : bflo(w0)); s1 += wx[k][i] * ((i & 1) ? bfhi(w1) : bflo(w1)); }
                *(LAS unsigned*)(lds + S_XDT + (wid * 8 + i) * SP + lx * 2) = pk2(fsilu(s0) * d0, fsilu(s1) * d1); }
        }
        if (c < 15) SSD_PREFETCH(c + 1);
        __syncthreads();
        const int lb = wid >> 1;
        f32x16 xt[2];
#pragma unroll
        for (int q = 0; q < 2; ++q) { const int sb = 2 * (wid & 1) + q;
            for (int i = 0; i < 16; ++i) xt[q][i] = 0.f;
            if (sb <= lb) {
#pragma unroll
                for (int ks = 0; ks < 8; ++ks) xt[q] = MFMA32(ldfrag(lds + S_BM, 32 * sb + r32, 16 * ks + 8 * hh), ldfrag(lds + S_C, 32 * lb + r32, 16 * ks + 8 * hh), xt[q]);
            }
        }
        __syncthreads();
        {
            const int l = 32 * lb + r32; const float al = cac[l], ddl = dsk * __builtin_amdgcn_rcpf(cdt[l]);
#pragma unroll
            for (int q = 0; q < 2; ++q) { const int sb = 2 * (wid & 1) + q;
#pragma unroll
                for (int q4 = 0; q4 < 4; ++q4) { float mv[4];
#pragma unroll
                    for (int e = 0; e < 4; ++e) { const int s = 32 * sb + 8 * q4 + 4 * hh + e;
                        float v = 0.f;
                        if (s <= l) v = xt[q][4 * q4 + e] * fexp(al - cac[s]);
                        if (s == l) v += ddl;
                        mv[e] = v; }
                    u32x2 w; w.x = pk2(mv[0], mv[1]); w.y = pk2(mv[2], mv[3]);
                    *(LAS u32x2*)(lds + S_BM + l * SP + (32 * sb + 8 * q4 + 4 * hh) * 2) = w; }
            }
        }
        __syncthreads();
        {
            const int lb2 = wid & 3, pb2 = wid >> 2; const int l = 32 * lb2 + r32; const size_t tok = t0 + l;
            const int pc0 = hd * 64 + 32 * pb2 + 4 * hh;
            f32x16 y1, y2; for (int i = 0; i < 16; ++i) { y1[i] = 0.f; y2[i] = 0.f; }
            for (int ks = 0; ks < 2 * (lb2 + 1); ++ks) y1 = MFMA32(ldfrag(lds + S_XDT, 32 * pb2 + r32, 16 * ks + 8 * hh), ldfrag(lds + S_BM, 32 * lb2 + r32, 16 * ks + 8 * hh), y1);
#pragma unroll
            for (int ks = 0; ks < 8; ++ks) y2 = MFMA32(ldfrag(lds + S_HB, 32 * pb2 + r32, 16 * ks + 8 * hh), ldfrag(lds + S_C, 32 * lb2 + r32, 16 * ks + 8 * hh), y2);
            const float cd = fexp(aend);
#pragma unroll
            for (int i = 0; i < 16; ++i) hT[i] *= cd;
#pragma unroll
            for (int ks = 0; ks < 8; ++ks) hT = MFMA32(ldfrag(lds + S_BT, 32 * nb + r32, 16 * ks + 8 * hh), ldfrag(lds + S_XDT, 32 * pb + r32, 16 * ks + 8 * hh), hT);
            const float el = fexp(cac[l]);
#pragma unroll
            for (int q4 = 0; q4 < 4; ++q4) { float yv[4];
#pragma unroll
                for (int e = 0; e < 4; ++e) { const float z = (e & 1) ? bfhi(e < 2 ? zz[q4].x : zz[q4].y) : bflo(e < 2 ? zz[q4].x : zz[q4].y);
                    yv[e] = (y1[4 * q4 + e] + el * y2[4 * q4 + e]) * fsilu(z); }
                u32x2 w; w.x = pk2(yv[0], yv[1]); w.y = pk2(yv[2], yv[3]);
                *(u32x2*)(yg + tok * 1024 + pc0 + 8 * q4) = w; }
        }
        __syncthreads();
    }
#undef SSD_PREFETCH
}

DI void attn_phase_da(Frame& F) {
    const attn_body::bf16* proj = (const attn_body::bf16*)(F.ws + WS_PROJ);
    for (;;) {
        if (threadIdx.x == 0) F.MISC[120] = __hip_atomic_fetch_add(F.ctl + CW_QATT, 1u, __ATOMIC_RELAXED, __HIP_MEMORY_SCOPE_AGENT);
        __syncthreads();
        const int u = __builtin_amdgcn_readfirstlane((int)F.MISC[120]);
        __syncthreads();
        if (u >= 1024) break;
        const int qb = 7 - (u >> 7), combo = u & 127;
        const int half = combo & 1, j = (combo >> 1) & 1, h = (combo >> 2) & 7, b = combo >> 5;
        attn_body::bf16* O = (attn_body::bf16*)(F.ws + (j ? WS_O1 : WS_O0));
        attn_body::attn_unit<8>(b, PC_Q + (h * 2 + j) * 64, PC_V + h * 128 + half * 64, h * 128 + half * 64, qb, proj, proj + (PC_K - PC_Q), proj, O, (char*)F.lds);
    }
}

DI void p3_finalize(Frame& F, const ArgP& a) {
    const int gw = F.vcu * NWAVES + F.wave, NGW = F.G * NWAVES, lane = F.lane;
    bf16_t* ycat = (bf16_t*)(F.ws + WS_YCAT); const bf16_t* yg = (const bf16_t*)(F.ws + WS_YG); const bf16_t* o0 = (const bf16_t*)(F.ws + WS_O0); const bf16_t* o1 = (const bf16_t*)(F.ws + WS_O1);
    float l1 = a.in(I_LQ1)[lane] * a.in(I_LK1)[lane], l2 = a.in(I_LQ2)[lane] * a.in(I_LK2)[lane];
    const float lam = __expf(wave_sum(l1)) - __expf(wave_sum(l2)) + LAM_INIT;
    for (int m = gw; m < NTOK; m += NGW) {
        { bf16_t* yp = ycat + (size_t)m * 2048 + 16 * lane; const bf16_t* gp = yg + (size_t)m * 1024 + 16 * lane;
          const u32x4 r0 = *(const u32x4*)gp, r1 = *(const u32x4*)(gp + 8);
          float v[16]; v[0] = bflo(r0.x); v[1] = bfhi(r0.x); v[2] = bflo(r0.y); v[3] = bfhi(r0.y); v[4] = bflo(r0.z); v[5] = bfhi(r0.z); v[6] = bflo(r0.w); v[7] = bfhi(r0.w);
          v[8] = bflo(r1.x); v[9] = bfhi(r1.x); v[10] = bflo(r1.y); v[11] = bfhi(r1.y); v[12] = bflo(r1.z); v[13] = bfhi(r1.z); v[14] = bflo(r1.w); v[15] = bfhi(r1.w);
          float ss = 0.f;
#pragma unroll
          for (int i = 0; i < 16; ++i) ss += v[i] * v[i];
#pragma unroll
          for (int o = 1; o < 32; o <<= 1) ss += __shfl_xor(ss, o);
          const float rs = 1.f / sqrtf(ss * (1.f / 512.f) + EPS_);
          const float* g = a.in(I_SSDG) + 16 * lane;
          u32x4 w0, w1;
          w0.x = pk2(v[0] * rs * g[0], v[1] * rs * g[1]); w0.y = pk2(v[2] * rs * g[2], v[3] * rs * g[3]); w0.z = pk2(v[4] * rs * g[4], v[5] * rs * g[5]); w0.w = pk2(v[6] * rs * g[6], v[7] * rs * g[7]);
          w1.x = pk2(v[8] * rs * g[8], v[9] * rs * g[9]); w1.y = pk2(v[10] * rs * g[10], v[11] * rs * g[11]); w1.z = pk2(v[12] * rs * g[12], v[13] * rs * g[13]); w1.w = pk2(v[14] * rs * g[14], v[15] * rs * g[15]);
          *(u32x4*)yp = w0; *(u32x4*)(yp + 8) = w1; }
        { const bf16_t* p0 = o0 + (size_t)m * 1024 + 16 * lane; const bf16_t* p1 = o1 + (size_t)m * 1024 + 16 * lane;
          const u32x4 a0 = *(const u32x4*)p0, a1 = *(const u32x4*)(p0 + 8), b0 = *(const u32x4*)p1, b1 = *(const u32x4*)(p1 + 8);
          float v[16];
          v[0] = bflo(a0.x) - lam * bflo(b0.x); v[1] = bfhi(a0.x) - lam * bfhi(b0.x); v[2] = bflo(a0.y) - lam * bflo(b0.y); v[3] = bfhi(a0.y) - lam * bfhi(b0.y);
          v[4] = bflo(a0.z) - lam * bflo(b0.z); v[5] = bfhi(a0.z) - lam * bfhi(b0.z); v[6] = bflo(a0.w) - lam * bflo(b0.w); v[7] = bfhi(a0.w) - lam * bfhi(b0.w);
          v[8] = bflo(a1.x) - lam * bflo(b1.x); v[9] = bfhi(a1.x) - lam * bfhi(b1.x); v[10] = bflo(a1.y) - lam * bflo(b1.y); v[11] = bfhi(a1.y) - lam * bfhi(b1.y);
          v[12] = bflo(a1.z) - lam * bflo(b1.z); v[13] = bfhi(a1.z) - lam * bfhi(b1.z); v[14] = bflo(a1.w) - lam * bflo(b1.w); v[15] = bfhi(a1.w) - lam * bfhi(b1.w);
          float ss = 0.f;
#pragma unroll
          for (int i = 0; i < 16; ++i) ss += v[i] * v[i];
          ss += __shfl_xor(ss, 1); ss += __shfl_xor(ss, 2); ss += __shfl_xor(ss, 4);
          const float rs = 1.f / sqrtf(ss * (1.f / 128.f) + EPS_) * (1.f - LAM_INIT);
          const float* g = a.in(I_SUBG) + 16 * (lane & 7);
          u32x4 w0, w1;
          w0.x = pk2(v[0] * rs * g[0], v[1] * rs * g[1]); w0.y = pk2(v[2] * rs * g[2], v[3] * rs * g[3]); w0.z = pk2(v[4] * rs * g[4], v[5] * rs * g[5]); w0.w = pk2(v[6] * rs * g[6], v[7] * rs * g[7]);
          w1.x = pk2(v[8] * rs * g[8], v[9] * rs * g[9]); w1.y = pk2(v[10] * rs * g[10], v[11] * rs * g[11]); w1.z = pk2(v[12] * rs * g[12], v[13] * rs * g[13]); w1.w = pk2(v[14] * rs * g[14], v[15] * rs * g[15]);
          bf16_t* yp = ycat + (size_t)m * 2048 + 1024 + 16 * lane;
          *(u32x4*)yp = w0; *(u32x4*)(yp + 8) = w1; }
    }
}

struct SchedDense {
    int G, c, nM, nN; const char* A; const char* B; unsigned lda, ldb; int bdiv; size_t bstride;
    DI bool next(int i, pg8::UnitD& u) const {
        const int L = i * G + c; if (L >= nM * nN) return false;
        u.rows = nullptr; u.nvalid = 0; u.lda = lda; u.ldb = ldb; u.type = 0; u.e = 0; u.x0 = 0;
        u.pn = L / nM; u.pm = L % nM;
        u.A = A + (size_t)u.pm * 256 * lda; u.B = B + (size_t)u.pn * 256 * ldb + (size_t)(u.pm / bdiv) * bstride;
        return true;
    }
};
struct EpiResid {
    static constexpr bool AFTER_DRAIN = false;
    const float* base; float* out; bf16_t* outb; float* part; unsigned char* out8; float accscale;
    DI void operator()(const f32x4 (&acc)[2][2][4][2], const pg8::UnitD& u, int wr, int wc, int fr, int fq) const {
        { int ln_ = threadIdx.x; asm volatile("" : "+v"(ln_)); fr = ln_ & 15; fq = (ln_ >> 4) & 3; }
        const int row0 = u.pm * 256 + wr * 64 + fr, col0 = u.pn * 256 + wc * 32 + 8 * fq;
#pragma unroll
        for (int ai = 0; ai < 2; ++ai)
#pragma unroll
            for (int m = 0; m < 4; ++m) { const size_t row = (size_t)(row0 + ai * 128 + m * 16); float ss = 0.f;
#pragma unroll
                for (int bj = 0; bj < 2; ++bj) { const size_t idx = row * 2048 + col0 + bj * 128;
                    f32x4 v0 = acc[ai][bj][m][0] * accscale + *(const f32x4*)(base + idx), v1 = acc[ai][bj][m][1] * accscale + *(const f32x4*)(base + idx + 4);
                    *(f32x4*)(out + idx) = v0; *(f32x4*)(out + idx + 4) = v1;
                    if (out8) { u32x2 w; w.x = __builtin_amdgcn_cvt_pk_fp8_f32(v0[0] * 16.f, v0[1] * 16.f, 0u, false); w.x = __builtin_amdgcn_cvt_pk_fp8_f32(v0[2] * 16.f, v0[3] * 16.f, w.x, true);
                        w.y = __builtin_amdgcn_cvt_pk_fp8_f32(v1[0] * 16.f, v1[1] * 16.f, 0u, false); w.y = __builtin_amdgcn_cvt_pk_fp8_f32(v1[2] * 16.f, v1[3] * 16.f, w.y, true); *(u32x2*)(out8 + idx) = w; }
                    if (outb) { u32x4 w; w.x = pk2(v0[0], v0[1]); w.y = pk2(v0[2], v0[3]); w.z = pk2(v1[0], v1[1]); w.w = pk2(v1[2], v1[3]); *(u32x4*)(outb + idx) = w; }
                    ss += (v0[0] * v0[0] + v0[1] * v0[1]) + (v0[2] * v0[2] + v0[3] * v0[3]) + (v1[0] * v1[0] + v1[1] * v1[1]) + (v1[2] * v1[2] + v1[3] * v1[3]); }
                if (part) { ss += __shfl_xor(ss, 16); ss += __shfl_xor(ss, 32); if (fq == 0) part[row * 32 + u.pn * 4 + wc] = ss; } }
    }
};

struct EpiQ {
    static constexpr bool AFTER_DRAIN = false;
    unsigned char* out8; float* part;
    DI void operator()(const f32x4 (&acc)[2][2][4][2], const pg8::UnitD& u, int wr, int wc, int fr, int fq) const {
        { int ln_ = threadIdx.x; asm volatile("" : "+v"(ln_)); fr = ln_ & 15; fq = (ln_ >> 4) & 3; }
        const int row0 = u.pm * 256 + wr * 64 + fr, col0 = u.pn * 256 + wc * 32 + 8 * fq;
#pragma unroll
        for (int ai = 0; ai < 2; ++ai)
#pragma unroll
            for (int m = 0; m < 4; ++m) { const size_t row = (size_t)(row0 + ai * 128 + m * 16); float ss = 0.f;
#pragma unroll
                for (int bj = 0; bj < 2; ++bj) { const size_t idx = row * 2048 + col0 + bj * 128; const f32x4 v0 = acc[ai][bj][m][0] * (1.f / 1024.f), v1 = acc[ai][bj][m][1] * (1.f / 1024.f);
                    u32x2 w; w.x = __builtin_amdgcn_cvt_pk_fp8_f32(v0[0] * 16.f, v0[1] * 16.f, 0u, false); w.x = __builtin_amdgcn_cvt_pk_fp8_f32(v0[2] * 16.f, v0[3] * 16.f, w.x, true);
                    w.y = __builtin_amdgcn_cvt_pk_fp8_f32(v1[0] * 16.f, v1[1] * 16.f, 0u, false); w.y = __builtin_amdgcn_cvt_pk_fp8_f32(v1[2] * 16.f, v1[3] * 16.f, w.y, true); *(u32x2*)(out8 + idx) = w;
                    ss += (v0[0] * v0[0] + v0[1] * v0[1]) + (v0[2] * v0[2] + v0[3] * v0[3]) + (v1[0] * v1[0] + v1[1] * v1[1]) + (v1[2] * v1[2] + v1[3] * v1[3]); }
                ss += __shfl_xor(ss, 16); ss += __shfl_xor(ss, 32); if (fq == 0) part[row * 32 + u.pn * 4 + wc] = ss; }
    }
};

struct SchedXS {
    int G, c; const unsigned char* ws;
    DI bool next(int i, pg8::UnitD& u) const {
        const int L = i * G + c; if (L >= 256) return false;
        u.rows = nullptr; u.nvalid = 0; u.e = 0;
        const int q = L & 127, bh = q >> 3, t8 = q & 7, b = bh >> 2, h = bh & 3;
        u.pm = b; u.pn = h; u.x0 = t8;
        if (L < 128) { u.type = 0; u.lda = 2048u; u.ldb = 512u;
            u.A = (const char*)(ws + WS_QF8) + (size_t)(b * 2048 + t8 * 256) * 2048 + h * 512; u.B = (const char*)(ws + WS_KN8) + (size_t)(bh * 256) * 512; }
        else { u.type = 1; u.lda = 2048u; u.ldb = 2048u;
            u.A = (const char*)(ws + WS_WO) + (size_t)(t8 * 256) * 2048 + h * 512; u.B = (const char*)(ws + WS_VF8) + (size_t)(b * 256) * 2048 + h * 512; }
        return true;
    }
};
struct EpiXS {
    static constexpr bool AFTER_DRAIN = false;
    unsigned char* P; unsigned char* VWT; const float* part1; const float* partq; LAS float* red;
    DI void operator()(const f32x4 (&acc)[2][2][4][2], const pg8::UnitD& u, int wr, int wc, int fr, int fq) const {
        { int ln_ = threadIdx.x; asm volatile("" : "+v"(ln_)); fr = ln_ & 15; fq = (ln_ >> 4) & 3; }
        const int b = u.pm, h = u.pn, t8 = u.x0;
        const int col0 = wc * 32 + 8 * fq;
        if (u.type == 1) {
            unsigned char* Vu = VWT + ((size_t)b * 2048 + t8 * 256) * 1024 + h * 256;
#pragma unroll
            for (int ai = 0; ai < 2; ++ai)
#pragma unroll
                for (int m = 0; m < 4; ++m) { const unsigned rl = (unsigned)(ai * 128 + wr * 64 + m * 16 + fr);
#pragma unroll
                    for (int bj = 0; bj < 2; ++bj) { const f32x4 v0 = acc[ai][bj][m][0] * (32.f / 1024.f), v1 = acc[ai][bj][m][1] * (32.f / 1024.f);
                        u32x2 w; w.x = __builtin_amdgcn_cvt_pk_fp8_f32(v0[0], v0[1], 0u, false); w.x = __builtin_amdgcn_cvt_pk_fp8_f32(v0[2], v0[3], w.x, true);
                        w.y = __builtin_amdgcn_cvt_pk_fp8_f32(v1[0], v1[1], 0u, false); w.y = __builtin_amdgcn_cvt_pk_fp8_f32(v1[2], v1[3], w.y, true);
                        *(u32x2*)(Vu + (rl * 1024u + (unsigned)(bj * 128 + col0))) = w; } }
            return;
        }
        const size_t row0 = (size_t)b * 2048 + t8 * 256;
        const char* p1u = (const char*)(part1 + row0 * 32); const char* pqu = (const char*)(partq + row0 * 32 + h * 8); unsigned char* Pu = P + row0 * 1024 + h * 256;
        float rsc[2][4];
#pragma unroll
        for (int ai = 0; ai < 2; ++ai)
#pragma unroll
            for (int m = 0; m < 4; ++m) { const unsigned rl = (unsigned)(ai * 128 + wr * 64 + m * 16 + fr);
                const f32x4 p0 = *(const f32x4*)(p1u + (rl * 32u + (unsigned)fq * 8u) * 4u), p1 = *(const f32x4*)(p1u + (rl * 32u + (unsigned)fq * 8u + 4u) * 4u);
                float s1 = (p0[0] + p0[1]) + (p0[2] + p0[3]) + (p1[0] + p1[1]) + (p1[2] + p1[3]);
                const f32x2 pq = *(const f32x2*)(pqu + (rl * 32u + (unsigned)fq * 2u) * 4u);
                float sq = pq[0] + pq[1];
                s1 = quad_sum_16_32(s1); sq = quad_sum_16_32(sq);
                rsc[ai][m] = __builtin_amdgcn_rsqf(sq * (1.f / 512.f) + EPS_ * (s1 * (1.f / 2048.f) + EPS_)) * (1.4426950408889634f / 2048.f);
                float ps = 0.f;
#pragma unroll
                for (int bj = 0; bj < 2; ++bj)
#pragma unroll
                    for (int n = 0; n < 2; ++n)
#pragma unroll
                        for (int e = 0; e < 4; ++e) ps += __builtin_amdgcn_exp2f(fminf(acc[ai][bj][m][n][e] * rsc[ai][m], 100.f));
                ps = quad_sum_16_32(ps);
                if (fq == 0) red[rl * 4 + wc] = ps;
                __builtin_amdgcn_sched_barrier(0); }
        __syncthreads();
        { int ln_ = threadIdx.x; asm volatile("" : "+v"(ln_)); fr = ln_ & 15; fq = (ln_ >> 4) & 3; }
#pragma unroll
        for (int ai = 0; ai < 2; ++ai)
#pragma unroll
            for (int m = 0; m < 4; ++m) { const unsigned rl = (unsigned)(ai * 128 + wr * 64 + m * 16 + fr);
                const f32x4 t = *(const LAS f32x4*)(red + rl * 4); const float inv = 256.f * __builtin_amdgcn_rcpf((t[0] + t[1]) + (t[2] + t[3])); float rs = rsc[ai][m]; asm volatile("" : "+v"(rs));
#pragma unroll
                for (int bj = 0; bj < 2; ++bj) { float x[8];
#pragma unroll
                    for (int n = 0; n < 2; ++n)
#pragma unroll
                        for (int e = 0; e < 4; ++e) x[n * 4 + e] = __builtin_amdgcn_exp2f(fminf(acc[ai][bj][m][n][e] * rs, 100.f)) * inv;
                    u32x2 w; w.x = __builtin_amdgcn_cvt_pk_fp8_f32(x[0], x[1], 0u, false); w.x = __builtin_amdgcn_cvt_pk_fp8_f32(x[2], x[3], w.x, true);
                    w.y = __builtin_amdgcn_cvt_pk_fp8_f32(x[4], x[5], 0u, false); w.y = __builtin_amdgcn_cvt_pk_fp8_f32(x[6], x[7], w.y, true);
                    *(u32x2*)(Pu + (rl * 1024u + (unsigned)(bj * 128 + wc * 32 + 8 * fq))) = w; } }
        __syncthreads();
    }
};

constexpr int HNP = 2052;
DI void p8_route(Frame& F, const ArgP& a) {
    LAS float* s_hn = (LAS float*)F.lds; LAS float* s_part = (LAS float*)(F.lds + 16 * HNP * 4); LAS float* s_log = s_part + 8 * 16 * 32; LAS int* s_slot = (LAS int*)(s_log + 16 * 32);
    LAS int* s_cnt = s_slot + 64; LAS int* s_base = s_cnt + 32;
    const float* h2 = (const float*)(F.ws + WS_H2); unsigned char* xg = (unsigned char*)(F.ws + WS_XG);
    float* gate_of = (float*)(F.ws + WS_GATEOF); int* tok_e = (int*)(F.ws + WS_TOKE);
    const float* rw = a.in(I_RW); const float* rb = a.in(I_RB); const float* g3 = a.in(I_GFFN);
    const int lane = F.lane, wave = F.wave, tid = F.tid;
    float bw0[64], bw1[64];
    { const int kq = lane >> 4, c16 = lane & 15; const float* bp = rw + (size_t)(256 * wave + kq) * 32 + c16;
#pragma unroll
      for (int j = 0; j < 64; ++j) { bw0[j] = bp[(size_t)(4 * j) * 32]; bw1[j] = bp[(size_t)(4 * j) * 32 + 16]; } }
    for (int task = F.vcu; task < NTOK / 16; task += F.G) {
        const int tb = task * 16;
#pragma unroll
        for (int q = 0; q < 2; ++q) { const int tl = 2 * wave + q; const size_t tok = (size_t)(tb + tl);
            const f32x4* xr = (const f32x4*)(h2 + tok * 2048) + lane;
            f32x4 v[8]; float s = 0.f;
#pragma unroll
            for (int j = 0; j < 8; ++j) { v[j] = xr[64 * j]; s += (v[j].x * v[j].x + v[j].y * v[j].y) + (v[j].z * v[j].z + v[j].w * v[j].w); }
            const float rstd = 1.f / sqrtf(wave_sum(s) * (1.f / 2048.f) + EPS_);
#pragma unroll
            for (int j = 0; j < 8; ++j) { const f32x4 gg = ((const f32x4*)g3)[lane + 64 * j]; const f32x4 y = v[j] * rstd * gg;
                *(LAS f32x4*)(s_hn + tl * HNP + (lane + 64 * j) * 4) = y; } }
        __syncthreads();
        {
            f32x4 acc0 = {0.f, 0.f, 0.f, 0.f}, acc1 = {0.f, 0.f, 0.f, 0.f};
            const int kq = lane >> 4, c16 = lane & 15;
            const LAS float* ap = s_hn + c16 * HNP + 256 * wave;
#pragma unroll
            for (int j = 0; j < 64; ++j) { const f32x4 a4 = *(const LAS f32x4*)(ap + 4 * j);
                const float av = (kq == 0) ? a4.x : (kq == 1) ? a4.y : (kq == 2) ? a4.z : a4.w;
                acc0 = __builtin_amdgcn_mfma_f32_16x16x4f32(av, bw0[j], acc0, 0, 0, 0);
                acc1 = __builtin_amdgcn_mfma_f32_16x16x4f32(av, bw1[j], acc1, 0, 0, 0); }
            LAS float* pp = s_part + wave * 512 + c16;
#pragma unroll
            for (int r = 0; r < 4; ++r) { pp[(4 * kq + r) * 32] = acc0[r]; pp[(4 * kq + r) * 32 + 16] = acc1[r]; }
        }
        __syncthreads();
        {
            const int tt = tid >> 5, e = tid & 31; float lg = rb[e];
#pragma unroll
            for (int w = 0; w < 8; ++w) lg += s_part[w * 512 + tt * 32 + e];
            if (tid < 32) s_cnt[tid] = 0;
            float val[4]; int idx[4]; float cur = lg;
#pragma unroll
            for (int k = 0; k < 4; ++k) { float bv = cur; int bi = e;
#pragma unroll
                for (int o = 1; o < 32; o <<= 1) { const float ov = __shfl_xor(bv, o); const int oi = __shfl_xor(bi, o); if (ov > bv || (ov == bv && oi < bi)) { bv = ov; bi = oi; } }
                val[k] = bv; idx[k] = bi; if (e == bi) cur = -INFINITY; }
            __syncthreads();
            int myrank = 0, myexp = 0; float mygate = 0.f;
            if (e < 4) { const float sum = (__expf(val[0] - val[0]) + __expf(val[1] - val[0])) + (__expf(val[2] - val[0]) + __expf(val[3] - val[0]));
                const float mv = (e == 0) ? val[0] : (e == 1) ? val[1] : (e == 2) ? val[2] : val[3]; myexp = (e == 0) ? idx[0] : (e == 1) ? idx[1] : (e == 2) ? idx[2] : idx[3];
                mygate = __expf(mv - val[0]) / sum; myrank = __hip_atomic_fetch_add(&s_cnt[myexp], 1, __ATOMIC_RELAXED, __HIP_MEMORY_SCOPE_WORKGROUP); }
            __syncthreads();
            if (tid < 32) { const int c = s_cnt[tid]; s_base[tid] = c ? (int)__hip_atomic_fetch_add(F.ctl + CW_CNT + 64 * tid, (unsigned)c, __ATOMIC_RELAXED, __HIP_MEMORY_SCOPE_AGENT) : 0; }
            __syncthreads();
            if (e < 4) { const int slot = myexp * 8192 + s_base[myexp] + myrank; const int tok = tb + tt;
                gate_of[slot] = mygate; tok_e[tok * 4 + e] = slot; s_slot[tt * 4 + e] = slot; }
        }
        __syncthreads();
#pragma unroll
        for (int q = 0; q < 2; ++q) { const int tl = 2 * wave + q;
            unsigned o[8];
#pragma unroll
            for (int j = 0; j < 8; ++j) { const f32x4 y = *(const LAS f32x4*)(s_hn + tl * HNP + (lane + 64 * j) * 4);
                unsigned w = 0u; w = __builtin_amdgcn_cvt_pk_fp8_f32(y.x * 4.f, y.y * 4.f, w, false); w = __builtin_amdgcn_cvt_pk_fp8_f32(y.z * 4.f, y.w * 4.f, w, true); o[j] = w; }
#pragma unroll
            for (int k = 0; k < 4; ++k) { unsigned* o4 = (unsigned*)(xg + (size_t)s_slot[tl * 4 + k] * 2048) + lane;
#pragma unroll
                for (int j = 0; j < 8; ++j) o4[64 * j] = o[j]; } }
        __syncthreads();
    }
}

DI void moe_tables(Frame& F) {
    if (F.tid == 0) { unsigned base = 0u;
        for (int e = 0; e < 32; ++e) { const unsigned c = F.ctl[CW_CNT + 64 * e], mt = (c + 255u) >> 8; F.MISC[16 + e] = c; F.MISC[48 + e] = base; F.MISC[80 + e] = mt; base += mt; }
        F.MISC[112] = base; }
    __syncthreads();
}
DI int ldsu(volatile LAS unsigned* p) { return __builtin_amdgcn_readfirstlane((int)*p); }
template <int NTN  >
struct SchedMoe {
    int G, c; const unsigned char* ws; volatile LAS unsigned* MISC; int total;
    DI bool next(int i, pg8::UnitD& u) const {
        const int L = i * G + c; if (L >= total) return false;
        int e = 0;
        for (int k = 0; k < 32; ++k) { if (L >= (ldsu(MISC + 48 + k) + ldsu(MISC + 80 + k)) * NTN) e = k + 1; }
        const int tb = ldsu(MISC + 48 + e), mte = ldsu(MISC + 80 + e), cnt = ldsu(MISC + 16 + e);
        const int local = L - tb * NTN, nt = local / mte, mt = local % mte;
        u.type = 0; u.e = e; u.pn = nt; u.pm = tb + mt; u.x0 = mt; u.lda = 2048u; u.ldb = 2048u;
        u.rows = nullptr; u.nvalid = cnt - mt * 256;
        if (NTN == 16) { u.A = (const char*)(ws + WS_XG) + ((size_t)e * 8192 + (size_t)mt * 256) * 2048;
            u.B = (const char*)(ws + WS_W1) + ((size_t)e * 4096 + (size_t)nt * 256) * 2048; }
        else { u.A = (const char*)(ws + WS_ACT) + ((size_t)e * 8192 + (size_t)mt * 256) * 2048;
            u.B = (const char*)(ws + WS_W2) + ((size_t)e * 2048 + (size_t)nt * 256) * 2048; }
        return true;
    }
};
struct EpiMoe1 {
    static constexpr bool AFTER_DRAIN = false;
    unsigned char* act; const float* b1;
    DI void operator()(const f32x4 (&acc)[2][2][4][2], const pg8::UnitD& u, int wr, int wc, int fr, int fq) const {
        { int ln_ = threadIdx.x; asm volatile("" : "+v"(ln_)); fr = ln_ & 15; fq = (ln_ >> 4) & 3; }
        const int j0 = u.pn * 128 + wc * 32 + 8 * fq;
        const float* bg = b1 + (size_t)u.e * 4096 + j0; const float* bu = bg + 2048;
        const f32x4 bg0 = *(const f32x4*)bg, bg1 = *(const f32x4*)(bg + 4), bu0 = *(const f32x4*)bu, bu1 = *(const f32x4*)(bu + 4);
#pragma unroll
        for (int ai = 0; ai < 2; ++ai)
#pragma unroll
            for (int m = 0; m < 4; ++m) { const size_t row = (size_t)u.e * 8192 + u.x0 * 256 + ai * 128 + wr * 64 + m * 16 + fr;
                float o[8];
#pragma unroll
                for (int n = 0; n < 2; ++n)
#pragma unroll
                    for (int e = 0; e < 4; ++e) { const float g = fminf(acc[ai][0][m][n][e] * (1.f / 256.f) + (n ? bg1[e] : bg0[e]), 7.f);
                        const float uu = fminf(fmaxf(acc[ai][1][m][n][e] * (1.f / 256.f) + (n ? bu1[e] : bu0[e]), -7.f), 7.f);
                        o[n * 4 + e] = g / (1.f + __expf(-1.702f * g)) * (uu + 1.f) * 4.f; }
                u32x2 w; w.x = __builtin_amdgcn_cvt_pk_fp8_f32(o[0], o[1], 0u, false); w.x = __builtin_amdgcn_cvt_pk_fp8_f32(o[2], o[3], w.x, true);
                w.y = __builtin_amdgcn_cvt_pk_fp8_f32(o[4], o[5], 0u, false); w.y = __builtin_amdgcn_cvt_pk_fp8_f32(o[6], o[7], w.y, true);
                *(u32x2*)(act + row * 2048 + j0) = w; }
    }
};
struct EpiMoe2 {
    static constexpr bool AFTER_DRAIN = false;
    bf16_t* y; const float* b2; const float* gate_of;
    DI void operator()(const f32x4 (&acc)[2][2][4][2], const pg8::UnitD& u, int wr, int wc, int fr, int fq) const {
        { int ln_ = threadIdx.x; asm volatile("" : "+v"(ln_)); fr = ln_ & 15; fq = (ln_ >> 4) & 3; }
        const int col0 = u.pn * 256 + wc * 32 + 8 * fq;
        const float* bp = b2 + (size_t)u.e * 2048 + col0;
#pragma unroll
        for (int ai = 0; ai < 2; ++ai)
#pragma unroll
            for (int m = 0; m < 4; ++m) { const int rl = ai * 128 + wr * 64 + m * 16 + fr; const size_t row = (size_t)u.e * 8192 + u.x0 * 256 + rl;
                const float gt = (rl < u.nvalid) ? gate_of[u.e * 8192 + u.x0 * 256 + rl] : 0.f;
#pragma unroll
                for (int bj = 0; bj < 2; ++bj) { const f32x4 v0 = (acc[ai][bj][m][0] * (1.f / 256.f) + *(const f32x4*)(bp + bj * 128)) * gt, v1 = (acc[ai][bj][m][1] * (1.f / 256.f) + *(const f32x4*)(bp + bj * 128 + 4)) * gt;
                    u32x4 w; w.x = pk2(v0[0], v0[1]); w.y = pk2(v0[2], v0[3]); w.z = pk2(v1[0], v1[1]); w.w = pk2(v1[2], v1[3]);
                    *(u32x4*)(y + row * 2048 + col0 + bj * 128) = w; } }
    }
};

DI void p11_combine(Frame& F, const ArgP& a) {
    const int gw = F.vcu * NWAVES + F.wave, NGW = F.G * NWAVES, lane = F.lane;
    const float* h2 = (const float*)(F.ws + WS_H2); const bf16_t* y = (const bf16_t*)(F.ws + WS_Y);
    const int* tok_e = (const int*)(F.ws + WS_TOKE);
    for (int t = gw; t < NTOK; t += NGW) {
        size_t yrow[4];
#pragma unroll
        for (int k = 0; k < 4; ++k) yrow[k] = (size_t)tok_e[t * 4 + k] * 2048;
#pragma unroll
        for (int j = 0; j < 8; ++j) { const int c = (lane + 64 * j) * 4;
            f32x4 v = *(const f32x4*)(h2 + (size_t)t * 2048 + c);
#pragma unroll
            for (int k = 0; k < 4; ++k) { const u32x2 w = *(const u32x2*)(y + yrow[k] + c); v.x += bflo(w.x); v.y += bfhi(w.x); v.z += bflo(w.y); v.w += bfhi(w.y); }
            *(f32x4*)(a.out() + (size_t)t * 2048 + c) = v; }
    }
}

#ifndef MK_PER_PHASE
#define MK_PER_PHASE 0
#endif
#ifndef MK_LAST_PHASE
#define MK_LAST_PHASE 12
#endif
constexpr int N_PHASES = MK_LAST_PHASE;

__global__ void __launch_bounds__(NWAVES * 64, 2) mega_fwd(Args args_) {
    const ArgP args{};
    extern __shared__ __attribute__((aligned(16))) unsigned char lds_raw[];
    Frame F;
    F.lds = (LAS unsigned char*)lds_raw;
    F.MISC = (volatile LAS unsigned*)(F.lds + MISC_OFF);
    F.tid = threadIdx.x; F.lane = F.tid & 63; F.wave = __builtin_amdgcn_readfirstlane(F.tid >> 6);
    F.G = gridDim.x; { const int bx = blockIdx.x; F.vcu = (F.G % 8 == 0) ? (bx % 8) * (F.G / 8) + bx / 8 : bx; }
    F.ws = args_.ws; F.ctl = (unsigned*)(args_.ws + WS_CTL);
    for (int u = F.tid; u < 256; u += NWAVES * 64) F.MISC[u] = 0u;
    __syncthreads();
    XcdBarrier bar; bar.bar = F.ctl + CW_BAR; bar.x = 0; bar.st = nullptr;
    const int lo = args_.ph_lo, hi = args_.ph_hi;
    if (hi - lo > 1) bar = xcd_barrier_post(F.ctl + CW_BAR, F.MISC + 8);
#ifndef MK_PHASE_MASK
#define MK_PHASE_MASK 0xFFFF
#endif
#define IN(k) (((MK_PHASE_MASK >> (k)) & 1) && lo <= (k) && (k) < hi)
#define SEAM(k) do { if (IN(k) && IN((k) + 1)) xcd_barrier(bar); } while (0)
#define FRESH() do { int t_ = threadIdx.x; asm volatile("" : "+v"(t_)); F.tid = t_; F.lane = t_ & 63; F.wave = __builtin_amdgcn_readfirstlane(t_ >> 6); } while (0)
    unsigned char* ws = args_.ws;

    if (IN(0)) { FRESH(); p0_prologue(F, args); }
    SEAM(0);
    if (IN(1)) { FRESH();
        const bool conv_first = (F.vcu & 1) == 0;
        if (conv_first) { conv_share(F, args); __syncthreads(); }
        SchedP1 S{F.G, F.vcu, ws, 0, 32 * 23};
        EpiP1 E{(bf16_t*)(ws + WS_PROJ), (float*)(ws + WS_DT), (bf16_t*)(ws + WS_KVRAW), args.in(I_DAQG), args.in(I_DAKG), (unsigned char*)(ws + WS_VF8)};
        pg8::gemm_phase<EpiP1, SchedP1, false, true>(F.lds + RING_OFF, 32, S, E);
        if (!conv_first) { __syncthreads(); conv_share(F, args); }
    }
    SEAM(1);
    if (IN(2)) { FRESH();
        if ((F.vcu & 3) == 1) {
            SchedP1 S{(F.G + 3) >> 2, F.vcu >> 2, ws, 32 * 23, 32 * 23 + 64};
            EpiP1 E{(bf16_t*)(ws + WS_PROJ), (float*)(ws + WS_DT), (bf16_t*)(ws + WS_KVRAW), args.in(I_DAQG), args.in(I_DAKG), (unsigned char*)(ws + WS_VF8)};
            pg8::gemm_phase<EpiP1, SchedP1, false, true>(F.lds + RING_OFF, 32, S, E);
            __syncthreads();
        }
        if ((F.vcu & 3) == 0) { for (int u = F.vcu >> 2; u < 64; u += (F.G + 3) >> 2) ssd_unit(F, args, u >> 4, u & 15); }
        __syncthreads();
        attn_phase_da(F);
        __syncthreads();
        conv_queue(F, args, CW_QCONV, CV_NJ - CV_TAIL, CV_TAIL1);
    }
    SEAM(2);
    if (IN(3)) { FRESH(); kprep(F, args); p3_finalize(F, args); }
    SEAM(3);
    if (IN(4)) { FRESH();
        SchedDense S{F.G, F.vcu, 32, 8, (const char*)(ws + WS_YCAT), (const char*)(ws + WS_WOUT), 4096u, 4096u, 1 << 30, 0};
#if MK_LAST_PHASE == 5
        EpiResid E{args.in(I_X), args_.out, nullptr, nullptr, nullptr, 1.f};
#else
        EpiResid E{args.in(I_X), (float*)(ws + WS_H1), nullptr, (float*)(ws + WS_PART1), (unsigned char*)(ws + WS_H1F8), 1.f};
#endif
        pg8::gemm_phase<EpiResid, SchedDense, false, true>(F.lds + RING_OFF, 32, S, E);
    }
    SEAM(4);
    if (IN(5)) { FRESH();
        SchedDense S{F.G, F.vcu, 32, 8, (const char*)(ws + WS_H1F8), (const char*)(ws + WS_WQ), 2048u, 2048u, 1 << 30, 0};
        EpiQ E{(unsigned char*)(ws + WS_QF8), (float*)(ws + WS_PARTQ)};
        pg8::gemm_phase<EpiQ, SchedDense, false, true, true>(F.lds + RING_OFF, 16, S, E);
    }
    SEAM(5);
    if (IN(6)) { FRESH();
        SchedXS S{F.G, F.vcu, ws};
        EpiXS E{(unsigned char*)(ws + WS_P8), (unsigned char*)(ws + WS_VWT8), (const float*)(ws + WS_PART1), (const float*)(ws + WS_PARTQ), (LAS float*)(F.lds + RING_BYTES)};
        pg8::gemm_phase<EpiXS, SchedXS, false, true, true>(F.lds + RING_OFF, 4, S, E);
    }
    SEAM(6);
    if (IN(7)) { FRESH();
        SchedDense S{F.G, F.vcu, 32, 8, (const char*)(ws + WS_P8), (const char*)(ws + WS_VWT8), 1024u, 1024u, 8, (size_t)2048 * 1024};
#if MK_LAST_PHASE == 8
        EpiResid E{(const float*)(ws + WS_H1), args_.out, nullptr, nullptr, nullptr, 1.f / 8192.f};
#else
        EpiResid E{(const float*)(ws + WS_H1), (float*)(ws + WS_H2), nullptr, nullptr, nullptr, 1.f / 8192.f};
#endif
        pg8::gemm_phase<EpiResid, SchedDense, false, true, true>(F.lds + RING_OFF, 8, S, E);
    }
    SEAM(7);
    if (IN(8)) { FRESH(); p8_route(F, args); }
    SEAM(8);
    if (IN(9)) { FRESH();
        moe_tables(F);
        SchedMoe<16> S{F.G, F.vcu, ws, F.MISC, ldsu(F.MISC + 112) * 16};
        EpiMoe1 E{(unsigned char*)(ws + WS_ACT), args.in(I_B1)};
        pg8::gemm_phase<EpiMoe1, SchedMoe<16>, false, true, true>(F.lds + RING_OFF, 16, S, E);
        __syncthreads();
        conv_queue(F, args, CW_QCONV2, CV_NJ - CV_TAIL2, CV_TAIL2);
    }
    SEAM(9);
    if (IN(10)) { FRESH();
        moe_tables(F);
        SchedMoe<8> S{F.G, F.vcu, ws, F.MISC, ldsu(F.MISC + 112) * 8};
        EpiMoe2 E{(bf16_t*)(ws + WS_Y), args.in(I_B2), (const float*)(ws + WS_GATEOF)};
        pg8::gemm_phase<EpiMoe2, SchedMoe<8>, false, true, true>(F.lds + RING_OFF, 16, S, E);
    }
    SEAM(10);
    if (IN(11)) { FRESH(); p11_combine(F, args); }
#undef IN
#undef SEAM
}

extern "C" void kernel_launch(void* const* d_in, const int* in_sizes, int n_in, void* d_out, int out_size, void* d_ws, size_t ws_size, hipStream_t stream) {
    static int grid = 0;
    if (grid == 0) {
        if (n_in != 32 || out_size != NTOK * 2048 || ws_size < WS_END) { fprintf(stderr, "kernel_launch: unexpected shapes (n_in %d out %d ws %zu); nothing launched\n", n_in, out_size, ws_size); grid = -1; return; }
        int dev = 0, cus = 0, per_cu = 0;
        if (hipGetDevice(&dev) != hipSuccess || hipDeviceGetAttribute(&cus, hipDeviceAttributeMultiprocessorCount, dev) != hipSuccess) { grid = -1; return; }
        if (hipFuncSetAttribute((const void*)mega_fwd, hipFuncAttributeMaxDynamicSharedMemorySize, LDS_BYTES) != hipSuccess) { fprintf(stderr, "kernel_launch: hipFuncSetAttribute failed\n"); grid = -1; return; }
        if (hipOccupancyMaxActiveBlocksPerMultiprocessor(&per_cu, (const void*)mega_fwd, NWAVES * 64, LDS_BYTES) != hipSuccess || per_cu < 1) { fprintf(stderr, "kernel_launch: occupancy query says %d\n", per_cu); }
        (void)hipGetLastError();
        if (cus < 256) { fprintf(stderr, "kernel_launch: needs 256 CUs, found %d; nothing launched\n", cus); grid = -1; return; }
        grid = 256;
    }
    if (grid < 0) return;
    if (hipMemsetAsync((char*)d_ws + WS_CTL, 0, CTL_ZERO_BYTES, stream) != hipSuccess) return;
    Args a{};
    for (int i = 0; i < 32; ++i) a.in[i] = (const float*)d_in[i];
    a.out = (float*)d_out; a.ws = (unsigned char*)d_ws;
#if MK_PER_PHASE
    for (int p = 0; p < N_PHASES; ++p) { a.ph_lo = p; a.ph_hi = p + 1; hipLaunchKernelGGL(mega_fwd, dim3(grid), dim3(NWAVES * 64), LDS_BYTES, stream, a); }
#else
    a.ph_lo = 0; a.ph_hi = N_PHASES;
    hipLaunchKernelGGL(mega_fwd, dim3(grid), dim3(NWAVES * 64), LDS_BYTES, stream, a);
#ifdef MK_PROBE_LO
    for (int p = MK_PROBE_LO; p < MK_PROBE_HI; ++p) { a.ph_lo = p; a.ph_hi = p + 1; hipLaunchKernelGGL(mega_fwd, dim3(grid), dim3(NWAVES * 64), LDS_BYTES, stream, a); }
#endif
#endif
}
```

```cpp
#define MK_PER_PHASE 0
#define MK_LAST_PHASE 12
#include <hip/hip_runtime.h>
#include <hip/hip_bf16.h>
#include <cstdio>
#include <cstdint>
#include <cmath>

#define GAS __attribute__((address_space(1)))
#define LAS __attribute__((address_space(3)))
typedef unsigned short bf16_t;
typedef short bf16x8 __attribute__((ext_vector_type(8)));
typedef float f32x2 __attribute__((ext_vector_type(2)));
typedef float f32x4 __attribute__((ext_vector_type(4)));
typedef float f32x16 __attribute__((ext_vector_type(16)));
typedef unsigned u32x2 __attribute__((ext_vector_type(2)));
typedef unsigned u32x4 __attribute__((ext_vector_type(4)));
typedef __bf16 bf16x2_t __attribute__((ext_vector_type(2)));

#define DI __device__ __forceinline__
DI unsigned pk2(float lo, float hi) { f32x2 v = {lo, hi}; bf16x2_t b = __builtin_convertvector(v, bf16x2_t); return __builtin_bit_cast(unsigned, b); }
DI float bflo(unsigned u) { return __uint_as_float(u << 16); }
DI float bfhi(unsigned u) { return __uint_as_float(u & 0xffff0000u); }
DI float bf2f(bf16_t h) { return __uint_as_float(((unsigned)h) << 16); }
DI float wave_sum(float v) {
#pragma unroll
    for (int o = 1; o < 64; o <<= 1) v += __shfl_xor(v, o);
    return v;
}
DI float quad_sum_16_32(float v) {
    int l_ = threadIdx.x; asm volatile("" : "+v"(l_));
    const int a16 = ((l_ ^ 16) & 63) << 2, a32 = ((l_ ^ 32) & 63) << 2;
    v += __builtin_bit_cast(float, __builtin_amdgcn_ds_bpermute(a16, __builtin_bit_cast(int, v)));
    v += __builtin_bit_cast(float, __builtin_amdgcn_ds_bpermute(a32, __builtin_bit_cast(int, v)));
    return v;
}
DI float siluf(float x) { return x / (1.f + __expf(-x)); }

constexpr int DM_ = 2048, NB = 4, SEQ_ = 2048, NTOK = NB * SEQ_;
constexpr int PP = 5632;
constexpr int PC_XBC = 1024, PC_Q = 2560, PC_K = 3584, PC_V = 4608, PC_DT = 5632;
constexpr int WIN_ROWS = 5888;
constexpr int NEXP = 32, MEMLEN = 256;
constexpr float EPS_ = 1e-6f;
constexpr float LAM_INIT = 0.2f;

namespace pg8 {
constexpr int BM = 256, BK = 64, HALF = 128, HTB = HALF * BK * 2  , STAGE_BYTES = 8 * HTB;
DI int lds_byte(int r, int c) { const int st = (r >> 4) * 2 + (c >> 5), rr = r & 15, cc = c & 31, ob = rr * 64 + cc * 2; return st * 1024 + (ob ^ (((ob >> 9) & 1) << 5)); }
DI void stage_rc(int b, int& R, int& C) { const int st = b / 1024, sb = b % 1024, swz = sb ^ (((sb >> 9) & 1) << 5); R = (st >> 1) * 16 + swz / 64; C = (st & 1) * 32 + (swz % 64) / 2; }
DI int perm32(int rho) { const int n = rho >> 4, i = rho & 15; return 8 * (i >> 2) + 4 * n + (i & 3); }

struct UnitD {
    const char* A; const char* B;
    const int* rows;
    unsigned lda, ldb;
    int nvalid;
    int type, pm, pn, e, x0;
};
typedef int v8i_t __attribute__((ext_vector_type(8)));
DI v8i_t cat8(bf16x8 lo, bf16x8 hi) { typedef int v4i_t __attribute__((ext_vector_type(4))); const v4i_t a = __builtin_bit_cast(v4i_t, lo), b = __builtin_bit_cast(v4i_t, hi); return (v8i_t){a[0], a[1], a[2], a[3], b[0], b[1], b[2], b[3]}; }
DI void dense_voff(unsigned lda, unsigned ldb, int tid, unsigned (&vA)[2], unsigned (&vB)[2]) {
#pragma unroll
    for (int i = 0; i < 2; ++i) { int R, C; stage_rc(tid * 16 + i * 8192, R, C); const int Rb = (R & ~31) + perm32(R & 31);
        vA[i] = (unsigned)R * lda + (unsigned)C * 2u; vB[i] = (unsigned)Rb * ldb + (unsigned)C * 2u; }
}
DI void gather_voff(const UnitD& u, int tid, unsigned (&gA)[2][2]) {
#pragma unroll
    for (int i = 0; i < 2; ++i) { int R, C; stage_rc(tid * 16 + i * 8192, R, C);
#pragma unroll
        for (int h = 0; h < 2; ++h) { const int ra = h * 128 + R; const unsigned rowA = (ra < u.nvalid) ? (unsigned)u.rows[ra] : 0u; gA[h][i] = rowA * u.lda + (unsigned)C * 2u; } }
}

template <class Epi, class Sched, bool GATHER, bool ALIGN_EPI, bool FP8 = false>
DI void gemm_phase(LAS unsigned char* lds, int nt, const Sched& S, const Epi& E) {

    const int tid = threadIdx.x, wid = __builtin_amdgcn_readfirstlane(tid >> 6), lane = tid & 63, wr = wid >> 2, wc = wid & 3, fr = lane & 15, fq = lane >> 4;
    const size_t kstep = (size_t)(BK * 2);
    const unsigned ldsb = (unsigned)__builtin_amdgcn_readfirstlane((int)((unsigned)(uintptr_t)lds + (unsigned)wid * 1024u));
    const int aoff = lds_byte(wr * 64 + fr, fq * 8), boff = lds_byte(wc * 32 + fr, fq * 8);
#define PG8_SA(b, h) (((b) * 2 + (h)) * HTB)
#define PG8_SB(b, h) ((4 + (b) * 2 + (h)) * HTB)
#define PG8_STAGE(bufoff, gbase, voff) do { _Pragma("unroll") for (int _i = 0; _i < 2; ++_i) { unsigned keep_; \
        asm volatile("s_mov_b32 %0, m0\n\ts_mov_b32 m0, %3\n\ts_nop 0\n\tglobal_load_lds_dwordx4 %1, %2\n\ts_mov_b32 m0, %0" \
                     : "=&s"(keep_) : "v"((voff)[_i]), "s"((const char*)(gbase)), "s"(ldsb + (unsigned)((bufoff) + _i * 8192)) : "memory"); } } while (0)
#define PG8_STA(bufoff, gbase, h, HS, GA) do { if constexpr (GATHER) { PG8_STAGE(bufoff, gbase, GA[h]); } else { PG8_STAGE(bufoff, (gbase) + (h) * (HS), vA); } } while (0)
#define PG8_STB(bufoff, gbase, h, HS) PG8_STAGE(bufoff, (gbase) + (h) * (HS), vB)
typedef int v4i_t __attribute__((ext_vector_type(4)));
#define PG8_LDA(dst, b, h) do { _Pragma("unroll") for (int m = 0; m < 4; ++m) { if constexpr (FP8) { \
            const v4i_t lo_ = *(const LAS v4i_t*)(lds + PG8_SA(b, h) + aoff + m * 2048), hi_ = *(const LAS v4i_t*)(lds + PG8_SA(b, h) + aoff + m * 2048 + 1024); \
            dst##8[m] = __builtin_shufflevector(lo_, hi_, 0, 1, 2, 3, 4, 5, 6, 7); } \
        else { _Pragma("unroll") for (int k = 0; k < 2; ++k) dst[m][k] = *(const LAS bf16x8*)(lds + PG8_SA(b, h) + aoff + m * 2048 + k * 1024); } } } while (0)
#define PG8_LDB(dst, b, h) do { _Pragma("unroll") for (int n = 0; n < 2; ++n) { if constexpr (FP8) { \
            const v4i_t lo_ = *(const LAS v4i_t*)(lds + PG8_SB(b, h) + boff + n * 2048), hi_ = *(const LAS v4i_t*)(lds + PG8_SB(b, h) + boff + n * 2048 + 1024); \
            dst##8[n] = __builtin_shufflevector(lo_, hi_, 0, 1, 2, 3, 4, 5, 6, 7); } \
        else { _Pragma("unroll") for (int k = 0; k < 2; ++k) dst[n][k] = *(const LAS bf16x8*)(lds + PG8_SB(b, h) + boff + n * 2048 + k * 1024); } } } while (0)
#ifndef PG8_FP8_PRIO
#define PG8_FP8_PRIO 1
#endif
#define PG8_MMA(ai, bj, At, Bt) do { if (!FP8 || PG8_FP8_PRIO) __builtin_amdgcn_s_setprio(1); _Pragma("unroll") for (int m = 0; m < 4; ++m) _Pragma("unroll") for (int n = 0; n < 2; ++n) { \
        if constexpr (FP8) { acc[ai][bj][m][n] = __builtin_amdgcn_mfma_scale_f32_16x16x128_f8f6f4(Bt##8[n], At##8[m], acc[ai][bj][m][n], 0, 0, 0, 0x7f7f7f7f, 0, 0x7f7f7f7f); } \
        else { _Pragma("unroll") for (int k = 0; k < 2; ++k) acc[ai][bj][m][n] = __builtin_amdgcn_mfma_f32_16x16x32_bf16(Bt[n][k], At[m][k], acc[ai][bj][m][n], 0, 0, 0); } } \
        if (!FP8 || PG8_FP8_PRIO) __builtin_amdgcn_s_setprio(0); } while (0)
#define PG8_WAIT_V(n) asm volatile("s_waitcnt vmcnt(" #n ")" ::: "memory")
#define PG8_WAIT_L(n) asm volatile("s_waitcnt lgkmcnt(" #n ")" ::: "memory")
#define PG8_BAR __builtin_amdgcn_s_barrier()
#define PG8_SCHED __builtin_amdgcn_sched_barrier(0)
#define PG8_ITER(A1P, A2P, B2P, HA2, HB2, GA2) do { \
        const char* a3p_ = (A2P) + kstep; const char* b3p_ = (B2P) + kstep; \
        PG8_LDB(B0, 0, 0); PG8_LDB(B1, 0, 1); PG8_SCHED; PG8_LDA(At, 0, 0); PG8_STA(PG8_SA(1, 1), (A1P), 1, hsA, gA); \
        PG8_WAIT_V(8); PG8_WAIT_L(0); PG8_BAR; PG8_MMA(0, 0, At, B0); PG8_MMA(0, 1, At, B1); PG8_BAR; PG8_SCHED; \
        PG8_LDA(At, 0, 1); PG8_STB(PG8_SB(0, 0), (B2P), 0, HB2); PG8_STB(PG8_SB(0, 1), (B2P), 1, HB2); PG8_STA(PG8_SA(0, 0), (A2P), 0, HA2, GA2); \
        PG8_WAIT_V(8); PG8_WAIT_L(0); PG8_BAR; PG8_MMA(1, 0, At, B0); PG8_MMA(1, 1, At, B1); PG8_BAR; PG8_SCHED; \
        PG8_LDB(B0, 1, 0); PG8_LDB(B1, 1, 1); PG8_SCHED; PG8_LDA(At, 1, 0); PG8_STA(PG8_SA(0, 1), (A2P), 1, HA2, GA2); \
        PG8_WAIT_V(8); PG8_WAIT_L(0); PG8_BAR; PG8_MMA(0, 0, At, B0); PG8_MMA(0, 1, At, B1); PG8_BAR; PG8_SCHED; \
        PG8_LDA(At, 1, 1); PG8_STB(PG8_SB(1, 0), b3p_, 0, HB2); PG8_STB(PG8_SB(1, 1), b3p_, 1, HB2); PG8_STA(PG8_SA(1, 0), a3p_, 0, HA2, GA2); \
        PG8_WAIT_V(8); PG8_WAIT_L(0); PG8_BAR; PG8_MMA(1, 0, At, B0); PG8_MMA(1, 1, At, B1); PG8_BAR; PG8_SCHED; \
    } while (0)
    UnitD cur, nxt; int ui = 0;
    if (!S.next(0, cur)) return;
    f32x4 acc[2][2][4][2];
#pragma unroll
    for (int a = 0; a < 2; ++a)
#pragma unroll
        for (int b = 0; b < 2; ++b)
#pragma unroll
            for (int m = 0; m < 4; ++m)
#pragma unroll
                for (int n = 0; n < 2; ++n) acc[a][b][m][n] = (f32x4){0.f, 0.f, 0.f, 0.f};
    bf16x8 At[4][2], B0[2][2], B1[2][2]; v8i_t At8[4], B08[2], B18[2];
    unsigned vA[2], vB[2], gA[2][2], ngA[2][2];
    dense_voff(cur.lda, cur.ldb, tid, vA, vB);
    if constexpr (GATHER) gather_voff(cur, tid, gA);
    const char* cA = cur.A; const char* cB = cur.B;
    size_t hsA = GATHER ? 0 : (size_t)cur.lda * HALF, hsB = (size_t)cur.ldb * HALF;
    PG8_STB(PG8_SB(0, 0), cB, 0, hsB); PG8_STB(PG8_SB(0, 1), cB, 1, hsB); PG8_STA(PG8_SA(0, 0), cA, 0, hsA, gA); PG8_STA(PG8_SA(0, 1), cA, 1, hsA, gA);
    if (wr == 1) PG8_BAR;
    PG8_WAIT_V(2); PG8_BAR;
    PG8_STB(PG8_SB(1, 0), cB + kstep, 0, hsB); PG8_STA(PG8_SA(1, 0), cA + kstep, 0, hsA, gA); PG8_STB(PG8_SB(1, 1), cB + kstep, 1, hsB);
    PG8_WAIT_V(6); PG8_BAR;
    for (;;) {
        const bool has_next = S.next(ui + 1, nxt);
        const char* nA = cA; const char* nB = cB; size_t nhsA = hsA, nhsB = hsB;
        if (has_next) { nA = nxt.A; nB = nxt.B; nhsA = GATHER ? 0 : (size_t)nxt.lda * HALF; nhsB = (size_t)nxt.ldb * HALF; }
        if constexpr (GATHER) {
            if (has_next) gather_voff(nxt, tid, ngA);
            else {
#pragma unroll
                for (int h = 0; h < 2; ++h)
#pragma unroll
                    for (int i = 0; i < 2; ++i) ngA[h][i] = gA[h][i];
            }
        }
#pragma unroll 1
        for (int t = 0; t < nt; t += 2) {
            const bool last = (t == nt - 2);
            const char* a2 = last ? nA : cA + (size_t)(t + 2) * kstep; const char* b2 = last ? nB : cB + (size_t)(t + 2) * kstep;
            const size_t hA2 = last ? nhsA : hsA, hB2 = last ? nhsB : hsB;
            unsigned g2[2][2];
            if constexpr (GATHER) {
#pragma unroll
                for (int h = 0; h < 2; ++h)
#pragma unroll
                    for (int i = 0; i < 2; ++i) g2[h][i] = last ? ngA[h][i] : gA[h][i];
            }
            PG8_ITER(cA + (size_t)(t + 1) * kstep, a2, b2, hA2, hB2, g2);
        }
        if constexpr (ALIGN_EPI) { if (wr == 0) PG8_BAR; }
        if constexpr (!Epi::AFTER_DRAIN) { E(acc, cur, wr, wc, fr, fq); }
        if (!has_next) break;
#pragma unroll
        for (int a = 0; a < 2; ++a)
#pragma unroll
            for (int b = 0; b < 2; ++b)
#pragma unroll
                for (int m = 0; m < 4; ++m)
#pragma unroll
                    for (int n = 0; n < 2; ++n) acc[a][b][m][n] = (f32x4){0.f, 0.f, 0.f, 0.f};
        cur = nxt; cA = nA; cB = nB; hsA = nhsA; hsB = nhsB; ++ui;
        if constexpr (GATHER) {
#pragma unroll
            for (int h = 0; h < 2; ++h)
#pragma unroll
                for (int i = 0; i < 2; ++i) gA[h][i] = ngA[h][i];
        }
        if constexpr (ALIGN_EPI) { if (wr == 1) PG8_BAR; }
    }
    PG8_WAIT_V(0);
    if constexpr (!ALIGN_EPI) { if (wr == 0) PG8_BAR; }
    PG8_BAR;
    if constexpr (Epi::AFTER_DRAIN) { E.fused(acc, cur, wr, wc, fr, fq, lds, wid, lane); }
#undef PG8_SA
#undef PG8_SB
#undef PG8_STAGE
#undef PG8_STA
#undef PG8_STB
#undef PG8_LDA
#undef PG8_LDB
#undef PG8_MMA
#undef PG8_WAIT_V
#undef PG8_WAIT_L
#undef PG8_BAR
#undef PG8_SCHED
#undef PG8_ITER
}
}
namespace attn_body {
using bf16=__hip_bfloat16;
using bf16x8=__attribute__((ext_vector_type(8)))short;
using s16x4=__attribute__((ext_vector_type(4)))short;
using f32x16=__attribute__((ext_vector_type(16)))float;
using u32x4=__attribute__((ext_vector_type(4)))unsigned;
constexpr int BATCH=4,SEQ=2048,D=64,DM=5632,OPITCH=1024;
constexpr int NW=8,QBLK=32,QB=QBLK*NW,KVBLK=64,NQB=SEQ/QB;
constexpr int ATTN_UNIT_ROWS=QB;
__device__ __forceinline__ int crow(int r,int hi){return (r&3)+8*(r>>2)+4*hi;}
#define SBAR() __builtin_amdgcn_sched_barrier(0)
__device__ __forceinline__ void cmask(f32x16&p0,f32x16&p1,int jb,int qrel,int hi){
  const float NEG=-INFINITY; int kb=64*jb+4*hi;
  #pragma unroll
  for(int r=0;r<16;++r){int kv=kb+(r&3)+8*(r>>2); if(kv>qrel)p0[r]=NEG; if(kv+32>qrel)p1[r]=NEG;}
}

constexpr int NSLOT=3, SLOTB=8192;
constexpr int LDS_K=0, LDS_V=NSLOT*SLOTB, LDS_WS=2*NSLOT*SLOTB, LDS_OST=LDS_WS+NW*64*4, LDS_BYTES=LDS_OST+NW*4096;
constexpr float C2=0.125f*1.4426950408889634f;
__device__ __forceinline__ void glds16(const void*gsrc,unsigned lds_dst){unsigned keep;
  asm volatile("s_mov_b32 %0, m0\n\ts_mov_b32 m0, %2\n\ts_nop 0\n\tglobal_load_lds_dwordx4 %1, off\n\ts_mov_b32 m0, %0":"=&s"(keep):"v"(gsrc),"s"(lds_dst):"memory");}
__device__ __forceinline__ float max3f(float a,float b,float c){float r;asm("v_max3_f32 %0, %1, %2, %3":"=v"(r):"v"(a),"v"(b),"v"(c));return r;}
__device__ __forceinline__ float max2f(float a,float b){float r;asm("v_max_f32_e32 %0, %1, %2":"=v"(r):"v"(a),"v"(b));return r;}
__device__ __forceinline__ float fadd_s(float a,float b){float r;asm("v_add_f32_e32 %0, %1, %2":"=v"(r):"v"(a),"v"(b));return r;}
__device__ __forceinline__ float fsub_s(float a,float b){float r;asm("v_sub_f32_e32 %0, %1, %2":"=v"(r):"v"(a),"v"(b));return r;}
typedef float f32x2_t __attribute__((ext_vector_type(2))); typedef __bf16 bf16x2_t __attribute__((ext_vector_type(2)));
__device__ __forceinline__ unsigned cvtpk_s(float lo,float hi){f32x2_t v={lo,hi};bf16x2_t b=__builtin_convertvector(v,bf16x2_t);return __builtin_bit_cast(unsigned,b);}
#define WAIT_BAR(N) asm volatile("s_waitcnt vmcnt(" #N ") lgkmcnt(0)\n\ts_barrier":::"memory")

__device__ __forceinline__ void qkt(f32x16&p0,f32x16&p1,const char*Kslot,const bf16x8*qr,const f32x16&negm,int r32,int hi){
  const char*kb=Kslot+hi*1024+r32*16;
  #pragma unroll
  for(int d0=0;d0<4;++d0){
    const bf16x8 b0=*reinterpret_cast<const bf16x8*>(kb+d0*2048);
    const bf16x8 b1=*reinterpret_cast<const bf16x8*>(kb+d0*2048+512);
    if(d0==0){p0=__builtin_amdgcn_mfma_f32_32x32x16_bf16(b0,qr[0],negm,0,0,0);p1=__builtin_amdgcn_mfma_f32_32x32x16_bf16(b1,qr[0],negm,0,0,0);}
    else{p0=__builtin_amdgcn_mfma_f32_32x32x16_bf16(b0,qr[d0],p0,0,0,0);p1=__builtin_amdgcn_mfma_f32_32x32x16_bf16(b1,qr[d0],p1,0,0,0);}}
}
typedef __attribute__((address_space(3))) const char* lds_cptr;
typedef short v4i16_t __attribute__((ext_vector_type(4)));
__device__ __forceinline__ void kload8(bf16x8*kf,lds_cptr kp){
  kf[0]=*(const __attribute__((address_space(3))) bf16x8*)(kp);      kf[1]=*(const __attribute__((address_space(3))) bf16x8*)(kp+512);
  kf[2]=*(const __attribute__((address_space(3))) bf16x8*)(kp+2048); kf[3]=*(const __attribute__((address_space(3))) bf16x8*)(kp+2560);
  kf[4]=*(const __attribute__((address_space(3))) bf16x8*)(kp+4096); kf[5]=*(const __attribute__((address_space(3))) bf16x8*)(kp+4608);
  kf[6]=*(const __attribute__((address_space(3))) bf16x8*)(kp+6144); kf[7]=*(const __attribute__((address_space(3))) bf16x8*)(kp+6656);
}
__device__ __forceinline__ void kload2(bf16x8*kf,lds_cptr kp,int j){ kf[2*j]=*(const __attribute__((address_space(3))) bf16x8*)(kp+j*2048); kf[2*j+1]=*(const __attribute__((address_space(3))) bf16x8*)(kp+j*2048+512); }
__device__ __forceinline__ s16x4 vtr(lds_cptr p){ return __builtin_bit_cast(s16x4,__builtin_amdgcn_ds_read_tr16_b64_v4i16((__attribute__((address_space(3))) v4i16_t*)p)); }
__device__ __forceinline__ float rowmax(const f32x16&p0,const f32x16&p1){
  float a=max3f(p0[0],p0[1],p1[0]),b=max3f(p0[2],p0[3],p1[1]);a=max3f(a,p1[2],p1[3]);
  #pragma unroll
  for(int r=4;r<16;r+=4){a=max3f(a,p0[r],p0[r+1]);b=max3f(b,p0[r+2],p0[r+3]);a=max3f(a,p1[r],p1[r+1]);b=max3f(b,p1[r+2],p1[r+3]);}
  const float m=max2f(a,b);
  auto rr=__builtin_amdgcn_permlane32_swap(__float_as_uint(m),__float_as_uint(m),false,false);
  return max2f(__uint_as_float(rr[0]),__uint_as_float(rr[1]));
}
__device__ __forceinline__ void pv(f32x16*o,int vb,bf16x8 pa0,bf16x8 pa1,bf16x8 pa2,bf16x8 pa3){
  #pragma unroll
  for(int d0=0;d0<2;++d0){s16x4 lo[4],hi[4];
    #pragma unroll
    for(int ks=0;ks<4;++ks){
      asm volatile("ds_read_b64_tr_b16 %0,%1 offset:%c2":"=&v"(lo[ks]):"v"(vb),"i"(d0*4096+ks*1024):"memory");
      asm volatile("ds_read_b64_tr_b16 %0,%1 offset:%c2":"=&v"(hi[ks]):"v"(vb),"i"(d0*4096+ks*1024+512):"memory");}
    asm volatile("s_waitcnt lgkmcnt(0)":::"memory");SBAR();
    #define PK(k) (bf16x8){lo[k][0],lo[k][1],lo[k][2],lo[k][3],hi[k][0],hi[k][1],hi[k][2],hi[k][3]}
    o[d0]=__builtin_amdgcn_mfma_f32_32x32x16_bf16(pa0,PK(0),o[d0],0,0,0);
    o[d0]=__builtin_amdgcn_mfma_f32_32x32x16_bf16(pa1,PK(1),o[d0],0,0,0);
    o[d0]=__builtin_amdgcn_mfma_f32_32x32x16_bf16(pa2,PK(2),o[d0],0,0,0);
    o[d0]=__builtin_amdgcn_mfma_f32_32x32x16_bf16(pa3,PK(3),o[d0],0,0,0);
    #undef PK
  }
}

#ifndef ATTN_STORE16
#define ATTN_STORE16(p,v) (*(u32x4*)(p)=(v))
#endif
template<int THRL> __device__ __forceinline__ void attn_unit(int b,int qcol,int vcol,int ocol,int qb,const bf16*Q,const bf16*__restrict__ K,const bf16*__restrict__ V,bf16*O,char*shm){
  const int tid=threadIdx.x,lane=tid&63,r32=lane&31,hi=lane>>5; const int wid=__builtin_amdgcn_readfirstlane(tid>>6);
  const long rowbase=(long)b*SEQ; const int q0=qb*QB;
  const bf16*Qw=Q+(rowbase+q0+wid*QBLK)*DM+qcol;
  const bf16*Kh=K+rowbase*DM+qcol,*Vh=V+rowbase*DM+vcol;
  const unsigned lds0=(unsigned)(uintptr_t)shm;
  float*wsf=(float*)(shm+LDS_WS)+wid*64;
  const bf16*ksrc=Kh+(long)lane*DM+wid*8;
  const bf16*vsrc=Vh+(long)(16*(wid&3)+(lane>>2))*DM+(wid>>2)*32+(lane&3)*8;
  const unsigned kdst=lds0+LDS_K+wid*1024, vdst=lds0+LDS_V+wid*1024;
  #define DMA_K(t,slot) glds16(ksrc+(long)(t)*KVBLK*DM,(unsigned)__builtin_amdgcn_readfirstlane(kdst+(slot)))
  #define DMA_V(t,slot) glds16(vsrc+(long)(t)*KVBLK*DM,(unsigned)__builtin_amdgcn_readfirstlane(vdst+(slot)))
  const int vb0=(int)(lds0+LDS_V)+((lane>>4)&1)*32+(lane&3)*8+(4*hi+((lane&15)>>2))*64;
  const char*Kbase=shm+LDS_K; bf16x8 kf[8];
  const lds_cptr shm3=(lds_cptr)shm; const lds_cptr kp0=shm3+LDS_K+hi*1024+r32*16; const lds_cptr vp0=shm3+LDS_V+((lane>>4)&1)*32+(lane&3)*8+(4*hi+((lane&15)>>2))*64;
  const int NT=(q0+QB)/KVBLK;
  DMA_K(0,0);DMA_V(0,0);DMA_K(1,SLOTB);
  bf16x8 qr[4];
  #pragma unroll
  for(int d0=0;d0<4;++d0)qr[d0]=*reinterpret_cast<const bf16x8*>(&Qw[(long)r32*DM+d0*16+hi*8]);
  float mhat=0.f,l_reg=0.f;f32x16 o[2];o[0]=f32x16{};o[1]=f32x16{};f32x16 negm=f32x16{};asm volatile("":"+v"(negm));
  const int qrel=wid*QBLK+r32;
  #define CMASK(P0,P1,t) do{int jb_=(t)-(NT-4); if(jb_>=0)cmask(P0,P1,jb_,qrel,hi);}while(0)
  bool resc=false;
  #define START(P0,P1) do{ const float rm=rowmax(P0,P1); resc=false; \
    { const float dl=rm; mhat=fadd_s(mhat,dl); \
      _Pragma("unroll") for(int r=0;r<16;++r){P0[r]=fsub_s(P0[r],dl);P1[r]=fsub_s(P1[r],dl);} \
      _Pragma("unroll") for(int r=0;r<16;++r)negm[r]=-mhat; asm volatile("":"+v"(negm)); } \
    _Pragma("unroll") for(int r=0;r<16;++r)P0[r]=__builtin_amdgcn_exp2f(P0[r]); }while(0)
  #define RESC() do{ if(resc){ asm volatile("s_waitcnt lgkmcnt(0)":::"memory"); \
      _Pragma("unroll") for(int d_=0;d_<2;++d_) _Pragma("unroll") for(int r=0;r<16;++r)o[d_][r]*=wsf[crow(r,hi)]; } }while(0)
  f32x16 pA0,pA1,pB0,pB1;
  int sl_prev=0,sl_cur=0,sl_next=SLOTB;
  #define ROT() do{sl_prev=sl_cur;sl_cur=sl_next;sl_next=(sl_next==(NSLOT-1)*SLOTB)?0:sl_next+SLOTB;}while(0)
  DMA_K(2,2*SLOTB);
  WAIT_BAR(3);
  qkt(pA0,pA1,Kbase,qr,negm,r32,hi);asm volatile("s_nop 15\n\ts_nop 7":"+v"(pA0),"+v"(pA1));CMASK(pA0,pA1,0);
  START(pA0,pA1);
  _Pragma("unroll") for(int r=0;r<16;++r)pA1[r]=__builtin_amdgcn_exp2f(pA1[r]);
  WAIT_BAR(0);
  DMA_K(3,0);DMA_V(1,SLOTB);
  ROT();
  kload8(kf,kp0+sl_cur);
  WAIT_BAR(2);
  s16x4 vlo[8],vhi[8]; u32x4 pw0,pw1,pw2,pw3;
  #define PKW(P,B) cvtpk_s(P[B],P[B+1])
  #define PAF(k) __builtin_bit_cast(bf16x8,pw##k)
  #define VFR(i) (bf16x8){vlo[i][0],vlo[i][1],vlo[i][2],vlo[i][3],vhi[i][0],vhi[i][1],vhi[i][2],vhi[i][3]}
  #define PIN(x) asm volatile("":"+v"(x))
  #define MX3(a,b,c) __builtin_fmaxf(__builtin_fmaxf((a),(b)),(c))
  #define GAPA(MF,A0,A1,A2,A3,W0,W1,PW) do{ MF; sacc+=A0; sacc+=A1; sacc+=A2; sacc+=A3; PIN(sacc); W0; W1; PIN(PW); SBAR(); }while(0)
  #define EX(v) __builtin_amdgcn_exp2f(v)
  #define GAPB(MF,X,B) do{ MF; X[B]=EX(X[B]); X[B+1]=EX(X[B+1]); X[B+2]=EX(X[B+2]); X[B+3]=EX(X[B+3]); PIN(X); SBAR(); }while(0)
  #define VRD(i) do{ vlo[i]=vtr(vp_+(((i)>>2)*4096+((i)&3)*1024)); vhi[i]=vtr(vp_+(((i)>>2)*4096+((i)&3)*1024+512)); }while(0)
  #define KRD(G,j) do{ if(G){ kload2(kf,kp0+sl_next,j); SBAR(); } }while(0)
  #define STEP(C0,C1,P0,P1,t,GK,GV,GL) do{ SBAR(); \
    const lds_cptr vp_=vp0+sl_prev; \
    VRD(0); SBAR(); float sacc=(P0[0]+P0[1]); \
    GAPA(C0=__builtin_amdgcn_mfma_f32_32x32x16_bf16(kf[0],qr[0],negm,0,0,0), P0[2],P0[3],P0[4],P0[5],     pw0[0]=PKW(P0,0), pw0[1]=PKW(P0,2), pw0); \
    VRD(4); SBAR(); GAPA(C1=__builtin_amdgcn_mfma_f32_32x32x16_bf16(kf[1],qr[0],negm,0,0,0), P0[6],P0[7],P0[8],P0[9],     pw0[2]=PKW(P0,4), pw0[3]=PKW(P0,6), pw0); \
    VRD(1); SBAR(); GAPA(C0=__builtin_amdgcn_mfma_f32_32x32x16_bf16(kf[2],qr[1],C0,0,0,0),   P0[10],P0[11],P0[12],P0[13], pw1[0]=PKW(P0,8), pw1[1]=PKW(P0,10), pw1); \
    VRD(5); SBAR(); GAPA(C1=__builtin_amdgcn_mfma_f32_32x32x16_bf16(kf[3],qr[1],C1,0,0,0),   P0[14],P0[15],P1[0],P1[1],   pw1[2]=PKW(P0,12),pw1[3]=PKW(P0,14), pw1); \
    VRD(2); SBAR(); GAPA(C0=__builtin_amdgcn_mfma_f32_32x32x16_bf16(kf[4],qr[2],C0,0,0,0),   P1[2],P1[3],P1[4],P1[5],     pw2[0]=PKW(P1,0), pw2[1]=PKW(P1,2), pw2); \
    VRD(6); SBAR(); GAPA(C1=__builtin_amdgcn_mfma_f32_32x32x16_bf16(kf[5],qr[2],C1,0,0,0),   P1[6],P1[7],P1[8],P1[9],     pw2[2]=PKW(P1,4), pw2[3]=PKW(P1,6), pw2); \
    VRD(3); SBAR(); GAPA(C0=__builtin_amdgcn_mfma_f32_32x32x16_bf16(kf[6],qr[3],C0,0,0,0),   P1[10],P1[11],P1[12],P1[13], pw3[0]=PKW(P1,8), pw3[1]=PKW(P1,10), pw3); \
    VRD(7); SBAR(); GAPA(C1=__builtin_amdgcn_mfma_f32_32x32x16_bf16(kf[7],qr[3],C1,0,0,0),   P1[14],P1[15],0.f,0.f,       pw3[2]=PKW(P1,12),pw3[3]=PKW(P1,14), pw3); \
    l_reg+=sacc; \
    if(GK){DMA_K((t)+3,sl_cur);} if(GV){DMA_V((t)+1,sl_next);} \
    CMASK(C0,C1,t); \
    { float a=MX3(C0[0],C0[1],C1[0]),b=MX3(C0[2],C0[3],C1[1]); a=MX3(a,C1[2],C1[3]); \
      _Pragma("unroll") for(int r=4;r<16;r+=4){a=MX3(a,C0[r],C0[r+1]);b=MX3(b,C0[r+2],C0[r+3]);a=MX3(a,C1[r],C1[r+1]);b=MX3(b,C1[r+2],C1[r+3]);} \
      float rm=__builtin_fmaxf(a,b); { auto rr=__builtin_amdgcn_permlane32_swap(__float_as_uint(rm),__float_as_uint(rm),false,false); rm=__builtin_fmaxf(__uint_as_float(rr[0]),__uint_as_float(rr[1])); } \
      resc=false; \
      if(__builtin_expect(__any(rm>(float)THRL),0)){ const float dl=__builtin_fmaxf(rm,0.f); mhat+=dl; \
        _Pragma("unroll") for(int r=0;r<16;++r){C0[r]-=dl;C1[r]-=dl;} \
        _Pragma("unroll") for(int r=0;r<16;++r)negm[r]=-mhat; asm volatile("":"+v"(negm)); \
        const float f=__builtin_amdgcn_exp2f(-dl); l_reg*=f; if(hi==0)wsf[r32]=f; resc=true; } } \
    SBAR(); \
    GAPB(o[0]=__builtin_amdgcn_mfma_f32_32x32x16_bf16(PAF(0),VFR(0),o[0],0,0,0), C0,0); \
    GAPB(o[1]=__builtin_amdgcn_mfma_f32_32x32x16_bf16(PAF(0),VFR(4),o[1],0,0,0), C0,4); \
    KRD(GL,0); GAPB(o[0]=__builtin_amdgcn_mfma_f32_32x32x16_bf16(PAF(1),VFR(1),o[0],0,0,0), C0,8); \
    KRD(GL,1); GAPB(o[1]=__builtin_amdgcn_mfma_f32_32x32x16_bf16(PAF(1),VFR(5),o[1],0,0,0), C0,12); \
    KRD(GL,2); GAPB(o[0]=__builtin_amdgcn_mfma_f32_32x32x16_bf16(PAF(2),VFR(2),o[0],0,0,0), C1,0); \
    KRD(GL,3); GAPB(o[1]=__builtin_amdgcn_mfma_f32_32x32x16_bf16(PAF(2),VFR(6),o[1],0,0,0), C1,4); \
    GAPB(o[0]=__builtin_amdgcn_mfma_f32_32x32x16_bf16(PAF(3),VFR(3),o[0],0,0,0), C1,8); \
    GAPB(o[1]=__builtin_amdgcn_mfma_f32_32x32x16_bf16(PAF(3),VFR(7),o[1],0,0,0), C1,12); \
    }while(0)
  int t=1;
  #undef CMASK
  #define CMASK(P0,P1,t) do{}while(0)
  for(;t+5<NT;t+=2){
    STEP(pB0,pB1,pA0,pA1,t,true,true,true);     WAIT_BAR(2); RESC(); ROT();
    STEP(pA0,pA1,pB0,pB1,t+1,true,true,true);   WAIT_BAR(2); RESC(); ROT();
  }
  #undef CMASK
  #define CMASK(P0,P1,t) do{int jb_=(t)-(NT-4); if(jb_>=0)cmask(P0,P1,jb_,qrel,hi);}while(0)
  #define ENDW(tt) do{ if((tt)+3<NT){WAIT_BAR(2);} else if((tt)+2<NT){WAIT_BAR(1);} else {WAIT_BAR(0);} }while(0)
  for(;t+1<NT;t+=2){
    STEP(pB0,pB1,pA0,pA1,t,(t+3<NT),(t+1<NT),(t+1<NT));       ENDW(t);   RESC(); ROT();
    STEP(pA0,pA1,pB0,pB1,t+1,(t+4<NT),(t+2<NT),(t+2<NT));     ENDW(t+1); RESC(); ROT();
  }
  STEP(pB0,pB1,pA0,pA1,NT-1,false,false,false); RESC();
  { float sacc=pB0[0]+pB0[1]; _Pragma("unroll") for(int r=2;r<16;++r)sacc+=pB0[r]; _Pragma("unroll") for(int r=0;r<16;++r)sacc+=pB1[r]; l_reg+=sacc;
    pw0=(u32x4){PKW(pB0,0),PKW(pB0,2),PKW(pB0,4),PKW(pB0,6)};pw1=(u32x4){PKW(pB0,8),PKW(pB0,10),PKW(pB0,12),PKW(pB0,14)};pw2=(u32x4){PKW(pB1,0),PKW(pB1,2),PKW(pB1,4),PKW(pB1,6)};pw3=(u32x4){PKW(pB1,8),PKW(pB1,10),PKW(pB1,12),PKW(pB1,14)};
    SBAR(); pv(o,vb0+sl_cur,PAF(0),PAF(1),PAF(2),PAF(3)); }
  #undef PKW
  #undef PAF
  #undef VFR
  #undef PIN
  #undef MX3
  #undef GAPA
  #undef GAPB
  #undef EX
  #undef VRD
  #undef KRD
  #undef STEP
  #undef ENDW
  {auto rr=__builtin_amdgcn_permlane32_swap(__float_as_uint(l_reg),__float_as_uint(l_reg),false,false);l_reg=__uint_as_float(rr[0])+__uint_as_float(rr[1]);}
  if(hi==0)wsf[32+r32]=l_reg;asm volatile("s_waitcnt lgkmcnt(0)":::"memory");
  float rli[16];
  #pragma unroll
  for(int r=0;r<16;++r)rli[r]=__builtin_amdgcn_rcpf(wsf[32+crow(r,hi)]);
  bf16*Ow=O+(rowbase+q0+wid*QBLK)*OPITCH+ocol;
  { bf16*stg=(bf16*)(shm+LDS_OST)+wid*2048;
    #pragma unroll
    for(int r=0;r<16;++r){const int orow=crow(r,hi);
      #pragma unroll
      for(int d0=0;d0<2;++d0)stg[orow*64+d0*32+r32]=__float2bfloat16(o[d0][r]*rli[r]);}
    asm volatile("s_waitcnt lgkmcnt(0)":::"memory");
    #pragma unroll
    for(int i=0;i<4;++i){const int row=i*8+(lane>>3),ch=lane&7; const u32x4 v=*(const u32x4*)(stg+row*64+ch*8); ATTN_STORE16(Ow+(long)row*OPITCH+ch*8,v);} }
  asm volatile("s_waitcnt lgkmcnt(0)\n\ts_barrier":::"memory");
  #undef DMA_K
  #undef DMA_V
  #undef CMASK
  #undef START
  #undef RESC
  #undef ROT
}
constexpr int ATTN_LDS_BYTES=LDS_BYTES;
#undef SBAR
#undef WAIT_BAR
}
constexpr size_t MiB = 1u << 20;
constexpr size_t WS_CTL = 0, CTL_ZERO_BYTES = 1 * MiB;
constexpr size_t WS_WIN = 2 * MiB, WS_WOUT = 26 * MiB, WS_WQ = 34 * MiB, WS_WKV = 42 * MiB, WS_WO = 58 * MiB, WS_W1 = 66 * MiB, WS_W2 = 578 * MiB;
constexpr size_t WS_HN = 834 * MiB, WS_MN = 866 * MiB, WS_PROJ = 870 * MiB, WS_DT = 958 * MiB, WS_KVRAW = 959 * MiB, WS_KN = 967 * MiB;
constexpr size_t WS_YCAT = 971 * MiB, WS_O0 = 1003 * MiB, WS_O1 = 1019 * MiB, WS_H1 = 1035 * MiB, WS_H1B = 1099 * MiB, WS_PART1 = 1131 * MiB, WS_PARTQ = 1132 * MiB;
constexpr size_t WS_QRAW = 1133 * MiB, WS_P = 1165 * MiB, WS_VWT = 1181 * MiB, WS_H2 = 1197 * MiB, WS_HN3 = 1261 * MiB;
constexpr size_t WS_TOKOF = 1293 * MiB, WS_GATEOF = 1294 * MiB, WS_TOKE = 1295 * MiB, WS_TOKR = 1296 * MiB, WS_YG = 1297 * MiB;
constexpr size_t WS_H1F8 = 3368 * MiB  , WS_QF8 = 3384 * MiB  , WS_KN8 = 3400 * MiB  , WS_VF8 = 3402 * MiB  ;
constexpr size_t WS_P8 = 3404 * MiB  , WS_VWT8 = 3412 * MiB  ;
constexpr size_t WS_XG = 1320 * MiB  , WS_ACT = 1832 * MiB  , WS_Y = 2344 * MiB  , WS_END = 3420 * MiB;
constexpr int CW_BAR = 4096;
constexpr int CW_QCONV2 = 12416;
constexpr int CW_QCONV = 12352;
constexpr int CW_QATT = 12288;
constexpr int CW_CNT = 8192;
static_assert((CW_CNT + 64 * 32) * 4 <= (int)CTL_ZERO_BYTES, "CTL words inside the memset region");

constexpr int RING_OFF = 0, RING_BYTES = 131072;
constexpr int LDS_BYTES = 163840;
constexpr int MISC_OFF = 163840 - 1024;
constexpr int NWAVES = 8;

#define XB_TMO      128
#define XB_XCNT(j)  (256  + 64 * (j))
#define XB_XSUB(j)  (1280 + 64 * (j))
#define XB_XGEN(j)  (2304 + 64 * (j))
#define XB_TOP      3328
#define XB_TOPGEN   3392
#define XCD_BAR_WORDS 3456
#define XB_SPIN_CAP (1u << 20)

__device__ __forceinline__ unsigned xb_ld(unsigned* p)              { return __hip_atomic_load(p, __ATOMIC_RELAXED, __HIP_MEMORY_SCOPE_AGENT); }
__device__ __forceinline__ unsigned xb_add(unsigned* p, unsigned v) { return __hip_atomic_fetch_add(p, v, __ATOMIC_RELAXED, __HIP_MEMORY_SCOPE_AGENT); }
__device__ __forceinline__ unsigned xb_xcc_id() { return (unsigned)__builtin_amdgcn_s_getreg((3 << 11) | 20) & 0xFu; }
#define XB_SPIN(cond, bar) do { unsigned _sp = 0; while (cond) { __builtin_amdgcn_s_sleep(1); \
    if ((++_sp & 255u) == 0u) { if (xb_ld(&(bar)[XB_TMO])) break; if (_sp > XB_SPIN_CAP) { atomicAdd(&(bar)[XB_TMO], 1u); break; } } } } while (0)

struct XcdBarrier {
    unsigned* bar; unsigned x;
    volatile LAS unsigned* st;
};
__device__ __forceinline__ XcdBarrier xcd_barrier_post(unsigned* bar, volatile LAS unsigned* st) {
    XcdBarrier b; b.bar = bar; b.x = xb_xcc_id(); b.st = st;
    if (threadIdx.x == 0) (void)xb_add(&bar[XB_XCNT(b.x)], 1u);
    return b;
}
__device__ __forceinline__ void xcd_barrier_complete(unsigned* bar, unsigned x, unsigned& nloc, unsigned& nx) {
    const unsigned G = gridDim.x * gridDim.y * gridDim.z;
    unsigned sum, cnt, mine, sp = 0u;
    for (;;) {
        sum = 0u; cnt = 0u; mine = 0u;
#pragma unroll
        for (unsigned j = 0; j < 16; ++j) { const unsigned c = xb_ld(&bar[XB_XCNT(j)]); sum += c; cnt += (c > 0u) ? 1u : 0u; mine = (j == x) ? c : mine; }
        if (sum == G) break;
        __builtin_amdgcn_s_sleep(1);
        if ((++sp & 255u) == 0u) { if (xb_ld(&bar[XB_TMO])) break; if (sp > XB_SPIN_CAP) { atomicAdd(&bar[XB_TMO], 1u); break; } }
    }
    nloc = mine > 0u ? mine : 1u; nx = cnt > 0u ? cnt : 1u;
}
__device__ __forceinline__ void xcd_barrier(const XcdBarrier& b) {
    asm volatile("s_waitcnt vmcnt(0)" ::: "memory");
    __syncthreads();
    if (threadIdx.x == 0) {
        unsigned* bar = b.bar;
        __builtin_amdgcn_s_waitcnt(0);
        unsigned nloc = b.st[0], nx = b.st[1];
        if (nloc == 0u) { xcd_barrier_complete(bar, b.x, nloc, nx); b.st[0] = nloc; b.st[1] = nx; }
        const unsigned old = xb_add(&bar[XB_XSUB(b.x)], 1u);
        const unsigned gen = old / nloc;
        if (old + 1u == (gen + 1u) * nloc) {
            __builtin_amdgcn_fence(__ATOMIC_RELEASE, "agent");
            asm volatile("s_waitcnt vmcnt(0)" ::: "memory");
            const unsigned og = xb_add(&bar[XB_TOP], 1u);
            const unsigned tg = og / nx;
            if (og + 1u == (tg + 1u) * nx) xb_add(&bar[XB_TOPGEN], 1u);
            else XB_SPIN(xb_ld(&bar[XB_TOPGEN]) == tg, bar);
            __builtin_amdgcn_fence(__ATOMIC_ACQUIRE, "agent");
            xb_add(&bar[XB_XGEN(b.x)], 1u);
            asm volatile("s_waitcnt vmcnt(0)" ::: "memory");
        } else {
            XB_SPIN(xb_ld(&bar[XB_XGEN(b.x)]) == gen, bar);
            __builtin_amdgcn_fence(__ATOMIC_ACQUIRE, "agent");
            asm volatile("s_waitcnt vmcnt(0)" ::: "memory");
        }
    }
    __syncthreads();
}

struct Args { const float* in[32]; float* out; unsigned char* ws; int ph_lo, ph_hi; };
enum In { I_X = 0, I_MEM, I_GMIX, I_WIN, I_CONVW, I_CONVB, I_DTB, I_ALOG, I_DSKIP, I_SSDG, I_DAQG, I_DAKG, I_LQ1, I_LK1, I_LQ2, I_LK2, I_SUBG, I_WOUT, I_GXA, I_GMEM,
          I_WQ, I_WKV, I_XQG, I_XKG, I_WO, I_GFFN, I_RW, I_RB, I_W1, I_B1, I_W2, I_B2 };

struct ArgP {
    typedef const __attribute__((address_space(4))) char* kptr;
    DI const float* in(int i) const { kptr kp = (kptr)__builtin_amdgcn_kernarg_segment_ptr(); asm volatile("" : "+s"(kp)); return *(const float* const __attribute__((address_space(4)))*)(kp + 8 * i); }
    DI float* out() const { kptr kp = (kptr)__builtin_amdgcn_kernarg_segment_ptr(); asm volatile("" : "+s"(kp)); return *(float* const __attribute__((address_space(4)))*)(kp + 8 * 32); }
};
struct Frame {
    LAS unsigned char* lds;
    volatile LAS unsigned* MISC;
    unsigned* ctl;
    unsigned char* ws;
    int tid, lane, wave, vcu, G;
};

template <class DestRow>
DI void tr_item(const float* W, size_t ldw, int k0, int ncol0, int nvalid, const float* kscale, bf16_t* WT, int K, DestRow dr, LAS float* scr, int lane) {
    const int c = lane & 31;
#pragma unroll 8
    for (int i = 0; i < 32; ++i) { const int kk = 2 * i + (lane >> 5);
        float v = (c < nvalid) ? W[(size_t)(k0 + kk) * ldw + ncol0 + c] : 0.f;
        if (kscale) v *= kscale[k0 + kk];
        scr[kk * 33 + c] = v; }
    asm volatile("s_waitcnt lgkmcnt(0)" ::: "memory");
    const int c8 = lane & 7;
#pragma unroll
    for (int j = 0; j < 4; ++j) { const int n = (lane >> 3) + 8 * j; const LAS float* s = scr + (8 * c8) * 33 + n;
        u32x4 o; o.x = pk2(s[0 * 33], s[1 * 33]); o.y = pk2(s[2 * 33], s[3 * 33]); o.z = pk2(s[4 * 33], s[5 * 33]); o.w = pk2(s[6 * 33], s[7 * 33]);
        if (n < nvalid) *(u32x4*)(WT + (size_t)dr(ncol0 + n) * K + k0 + 8 * c8) = o; }
    asm volatile("s_waitcnt lgkmcnt(0)" ::: "memory");
}
template <class DestRow>
DI void tr_item_fp8(const float* W, size_t ldw, int k0, int ncol0, const float* kscale, unsigned char* WT, int K, DestRow dr, LAS float* scr, int lane) {
    const int c = lane & 31;
#pragma unroll 8
    for (int i = 0; i < 32; ++i) { const int kk = 2 * i + (lane >> 5); float v = W[(size_t)(k0 + kk) * ldw + ncol0 + c]; if (kscale) v *= kscale[k0 + kk]; scr[kk * 33 + c] = v; }
    asm volatile("s_waitcnt lgkmcnt(0)" ::: "memory");
    const int n = lane >> 1, hf = lane & 1; const LAS float* s = scr + (32 * hf) * 33 + n;
    unsigned w[8];
#pragma unroll
    for (int j = 0; j < 8; ++j) { unsigned x = 0u;
        x = __builtin_amdgcn_cvt_pk_fp8_f32(s[(4 * j) * 33] * 64.f, s[(4 * j + 1) * 33] * 64.f, x, false);
        x = __builtin_amdgcn_cvt_pk_fp8_f32(s[(4 * j + 2) * 33] * 64.f, s[(4 * j + 3) * 33] * 64.f, x, true); w[j] = x; }
    unsigned char* op = WT + (size_t)dr(ncol0 + n) * K + k0 + 32 * hf;
    *(u32x4*)op = (u32x4){w[0], w[1], w[2], w[3]}; *(u32x4*)(op + 16) = (u32x4){w[4], w[5], w[6], w[7]};
    asm volatile("s_waitcnt lgkmcnt(0)" ::: "memory");
}
DI int tileperm(int col) { const int o = col & 255; return (col & ~255) + 128 * ((o & 63) >> 5) + 32 * (o >> 6) + (o & 31); }
struct DrIdent { DI int operator()(int n) const { return n; } };
struct DrTile  { DI int operator()(int n) const { return tileperm(n); } };
struct DrWin   { DI int operator()(int n) const { const int pc = (n < 2560) ? n : (n < 2576 ? PC_DT + (n - 2560) : n - 16); return tileperm(pc); } };
struct DrW1    { DI int operator()(int n) const { const int half = n >> 11, j = n & 2047; return (j >> 7) * 256 + half * 128 + (j & 127); } };

template <bool FP8, class DestRow>
DI void cv_item(const float* W, size_t ldw, int k0, int ncol0, const float* kscale, float scale, void* WT, int kpitch, DestRow dr, LAS float* scr, int lane) {
    const int r = lane >> 3, c4 = (lane & 7) * 4;
    f32x4 v[16];
#pragma unroll
    for (int i = 0; i < 16; ++i) v[i] = *(const f32x4*)(W + (size_t)(k0 + 8 * i + r) * ldw + ncol0 + c4);
#pragma unroll
    for (int i = 0; i < 16; ++i) { f32x4 x = v[i] * scale; if (kscale) x = x * kscale[k0 + 8 * i + r]; *(LAS f32x4*)(scr + (8 * i + r) * 36 + c4) = x; }
    asm volatile("s_waitcnt lgkmcnt(0)" ::: "memory");
    const int n = lane & 31, hf = lane >> 5; const LAS float* s = scr + (64 * hf) * 36 + n;
    if constexpr (FP8) {
        unsigned w[16];
#pragma unroll
        for (int j = 0; j < 16; ++j) { unsigned x = 0u; x = __builtin_amdgcn_cvt_pk_fp8_f32(s[(4 * j) * 36], s[(4 * j + 1) * 36], x, false); x = __builtin_amdgcn_cvt_pk_fp8_f32(s[(4 * j + 2) * 36], s[(4 * j + 3) * 36], x, true); w[j] = x; }
        unsigned char* op = (unsigned char*)WT + (size_t)dr(ncol0 + n) * kpitch + k0 + 64 * hf;
#pragma unroll
        for (int j = 0; j < 4; ++j) *(u32x4*)(op + 16 * j) = (u32x4){w[4 * j], w[4 * j + 1], w[4 * j + 2], w[4 * j + 3]};
    } else {
        unsigned w[32];
#pragma unroll
        for (int j = 0; j < 32; ++j) w[j] = pk2(s[(2 * j) * 36], s[(2 * j + 1) * 36]);
        unsigned char* op = (unsigned char*)WT + (size_t)dr(ncol0 + n) * kpitch + (k0 + 64 * hf) * 2;
#pragma unroll
        for (int j = 0; j < 8; ++j) *(u32x4*)(op + 16 * j) = (u32x4){w[4 * j], w[4 * j + 1], w[4 * j + 2], w[4 * j + 3]};
    }
    asm volatile("s_waitcnt lgkmcnt(0)" ::: "memory");
}
DI void rms_row_to_bf16(const float* xrow, const float* g, bf16_t* orow, int lane) {
    const f32x4* xr = (const f32x4*)xrow + lane;
    f32x4 v[8]; float s = 0.f;
#pragma unroll
    for (int j = 0; j < 8; ++j) { v[j] = xr[64 * j]; s += (v[j].x * v[j].x + v[j].y * v[j].y) + (v[j].z * v[j].z + v[j].w * v[j].w); }
    const float rstd = 1.f / sqrtf(wave_sum(s) * (1.f / 2048.f) + EPS_);
    u32x2* o8 = (u32x2*)orow + lane;
#pragma unroll
    for (int j = 0; j < 8; ++j) { const f32x4 gg = ((const f32x4*)g)[lane + 64 * j];
        u32x2 o; o.x = pk2(v[j].x * rstd * gg.x, v[j].y * rstd * gg.y); o.y = pk2(v[j].z * rstd * gg.z, v[j].w * rstd * gg.w); o8[64 * j] = o; }
}

DI void p0_prologue(Frame& F, const ArgP& a) {
    LAS float* scr = (LAS float*)(F.lds + RING_OFF + F.wave * 16384);
    const int gw = F.vcu * NWAVES + F.wave, NGW = F.G * NWAVES;
    unsigned char* ws = F.ws;
    constexpr int I_A = 32 * 80, I_B = 32, I_C = 32 * 96, NITEMS = I_A + I_B + I_C;
    for (int it = gw; it < NITEMS; it += NGW) {
        int r = it;
        if (r < I_A) { tr_item(a.in(I_WIN), 5648, 64 * (r / 80), 32 * (r % 80), 32, nullptr, (bf16_t*)(ws + WS_WIN), 2048, DrWin(), scr, F.lane); continue; } r -= I_A;
        if (r < I_B) { tr_item(a.in(I_WIN), 5648, 64 * r, 2560, 16, nullptr, (bf16_t*)(ws + WS_WIN), 2048, DrWin(), scr, F.lane); continue; } r -= I_B;
        tr_item(a.in(I_WIN), 5648, 64 * (r / 96), 2576 + 32 * (r % 96), 32, nullptr, (bf16_t*)(ws + WS_WIN), 2048, DrWin(), scr, F.lane);
    }
    for (int m = gw; m < NTOK; m += NGW) rms_row_to_bf16(a.in(I_X) + (size_t)m * 2048, a.in(I_GMIX), (bf16_t*)(ws + WS_HN) + (size_t)m * 2048, F.lane);
    for (int m = gw; m < NB * MEMLEN; m += NGW) rms_row_to_bf16(a.in(I_MEM) + (size_t)m * 2048, a.in(I_GMEM), (bf16_t*)(ws + WS_MN) + (size_t)m * 2048, F.lane);
}
struct CvIt { const float* W; size_t ldw; const float* ks; unsigned char* WT; float scale; int k0, n0, kpitch, fp8, dr; };
DI CvIt cv_decode(int it, const ArgP& a, unsigned char* ws) {
    constexpr int J_WOUT = 16 * 64, J_WKV = 16 * 128, J_WQ = 16 * 64, J_WO = 16 * 64, J_W1 = 32 * 16 * 128;
    CvIt c; c.ks = nullptr; c.scale = 64.f; c.fp8 = 1; c.dr = 0; c.kpitch = 2048; c.ldw = 2048;
    int r = it;
    if (r < J_WOUT) { c.W = a.in(I_WOUT); c.k0 = 128 * (r / 64); c.n0 = 32 * (r % 64); c.WT = ws + WS_WOUT; c.scale = 1.f; c.fp8 = 0; c.kpitch = 4096; return c; } r -= J_WOUT;
    if (r < J_WKV) { c.W = a.in(I_WKV); c.ldw = 4096; c.k0 = 128 * (r / 128); c.n0 = 32 * (r % 128); c.WT = ws + WS_WKV; c.scale = 1.f; c.fp8 = 0; c.kpitch = 4096; c.dr = 1; return c; } r -= J_WKV;
    if (r < J_WQ) { c.W = a.in(I_WQ); c.ks = a.in(I_GXA); c.k0 = 128 * (r / 64); c.n0 = 32 * (r % 64); c.WT = ws + WS_WQ; return c; } r -= J_WQ;
    if (r < J_WO) { c.W = a.in(I_WO); c.k0 = 128 * (r / 64); c.n0 = 32 * (r % 64); c.WT = ws + WS_WO; return c; } r -= J_WO;
    if (r < J_W1) { const int e = r / (16 * 128), q = r % (16 * 128); c.W = a.in(I_W1) + (size_t)e * 2048 * 4096; c.ldw = 4096; c.k0 = 128 * (q / 128); c.n0 = 32 * (q % 128); c.WT = ws + WS_W1 + (size_t)e * 4096 * 2048; c.dr = 2; return c; } r -= J_W1;
    { const int e = r / (16 * 64), q = r % (16 * 64); c.W = a.in(I_W2) + (size_t)e * 2048 * 2048; c.k0 = 128 * (q / 64); c.n0 = 32 * (q % 64); c.WT = ws + WS_W2 + (size_t)e * 2048 * 2048; }
    return c;
}
constexpr int CV_NJ = 16 * 64 * 3 + 16 * 128 + 32 * 16 * 128 + 32 * 16 * 64;
constexpr int CV_TAIL2 = 16384;
constexpr int CV_TAIL1 = 16384;
constexpr int CV_TAIL = CV_TAIL1 + CV_TAIL2;
DI void conv_share(Frame& F, const ArgP& a) {
    LAS float* scr = (LAS float*)(F.lds + F.wave * 16384);
    const unsigned sbase = (unsigned)__builtin_amdgcn_readfirstlane((int)((unsigned)(uintptr_t)F.lds + (unsigned)F.wave * 16384u));
    const int gw = F.vcu * NWAVES + F.wave, NGW = F.G * NWAVES, lane = F.lane;
    unsigned char* ws = F.ws;
    constexpr int NJ = CV_NJ - CV_TAIL;
    const int n = lane & 31, hf = lane >> 5;
    for (int it = gw; it < NJ; it += NGW) {
        const CvIt cur = cv_decode(it, a, ws);
        const char* gb = (const char*)(cur.W + (size_t)cur.k0 * cur.ldw + cur.n0);
        const unsigned vo0 = (unsigned)(((size_t)(lane >> 3) * cur.ldw + (size_t)(lane & 7) * 4) * 4), vstep = (unsigned)(8 * cur.ldw * 4);
#pragma unroll
        for (int p = 0; p < 16; ++p) { unsigned keep_;
            asm volatile("s_mov_b32 %0, m0\n\ts_mov_b32 m0, %3\n\ts_nop 0\n\tglobal_load_lds_dwordx4 %1, %2 nt\n\ts_mov_b32 m0, %0"
                         : "=&s"(keep_) : "v"(vo0 + (unsigned)p * vstep), "s"(gb), "s"(sbase + (unsigned)p * 1024u) : "memory"); }
        asm volatile("s_waitcnt vmcnt(0)" ::: "memory");
        const LAS float* s = scr + (64 * hf) * 32 + n;
        const int col = cur.n0 + n; const int drow = (cur.dr == 0) ? col : (cur.dr == 1 ? tileperm(col) : DrW1()(col));
        const float* ksp = cur.ks ? cur.ks + cur.k0 + 64 * hf : nullptr;
        if (cur.fp8) {
            unsigned w[16];
#pragma unroll
            for (int j = 0; j < 16; ++j) { float x0 = s[(4 * j) * 32] * cur.scale, x1 = s[(4 * j + 1) * 32] * cur.scale, x2 = s[(4 * j + 2) * 32] * cur.scale, x3 = s[(4 * j + 3) * 32] * cur.scale;
                if (ksp) { x0 *= ksp[4 * j]; x1 *= ksp[4 * j + 1]; x2 *= ksp[4 * j + 2]; x3 *= ksp[4 * j + 3]; }
                unsigned x = 0u; x = __builtin_amdgcn_cvt_pk_fp8_f32(x0, x1, x, false); x = __builtin_amdgcn_cvt_pk_fp8_f32(x2, x3, x, true); w[j] = x; }
            unsigned char* op = cur.WT + (size_t)drow * cur.kpitch + cur.k0 + 64 * hf;
#pragma unroll
            for (int j = 0; j < 4; ++j) *(u32x4*)(op + 16 * j) = (u32x4){w[4 * j], w[4 * j + 1], w[4 * j + 2], w[4 * j + 3]};
        } else {
            unsigned w[32];
#pragma unroll
            for (int j = 0; j < 32; ++j) w[j] = pk2(s[(2 * j) * 32] * cur.scale, s[(2 * j + 1) * 32] * cur.scale);
            unsigned char* op = cur.WT + (size_t)drow * cur.kpitch + (cur.k0 + 64 * hf) * 2;
#pragma unroll
            for (int j = 0; j < 8; ++j) *(u32x4*)(op + 16 * j) = (u32x4){w[4 * j], w[4 * j + 1], w[4 * j + 2], w[4 * j + 3]};
        }
        asm volatile("s_waitcnt lgkmcnt(0)" ::: "memory");
    }
}

DI void conv_queue(Frame& F, const ArgP& a, int qword, int first, int count) {
    LAS float* scr = (LAS float*)(F.lds + F.wave * 18432);
    unsigned char* ws = F.ws;
    const int lane = threadIdx.x & 63, r = lane >> 3, c4 = (lane & 7) * 4, n = lane & 31, hf = lane >> 5;
    for (;;) {
        if (threadIdx.x == 0) F.MISC[121] = __hip_atomic_fetch_add(F.ctl + qword, 8u, __ATOMIC_RELAXED, __HIP_MEMORY_SCOPE_AGENT);
        __syncthreads();
        const int base = __builtin_amdgcn_readfirstlane((int)F.MISC[121]);
        __syncthreads();
        if (base >= count) break;
        const int it = first + base + F.wave;
        if (base + F.wave < count) {
            const CvIt cur = cv_decode(it, a, ws);
            f32x4 v[16];
#pragma unroll
            for (int i = 0; i < 16; ++i) v[i] = __builtin_nontemporal_load((const f32x4*)(cur.W + (size_t)(cur.k0 + 8 * i + r) * cur.ldw + cur.n0 + c4));
#pragma unroll
            for (int i = 0; i < 16; ++i) *(LAS f32x4*)(scr + (8 * i + r) * 36 + c4) = v[i] * cur.scale;
            asm volatile("s_waitcnt lgkmcnt(0)" ::: "memory");
            const LAS float* s = scr + (64 * hf) * 36 + n;
            unsigned w[16];
#pragma unroll
            for (int j = 0; j < 16; ++j) { unsigned x = 0u; x = __builtin_amdgcn_cvt_pk_fp8_f32(s[(4 * j) * 36], s[(4 * j + 1) * 36], x, false); x = __builtin_amdgcn_cvt_pk_fp8_f32(s[(4 * j + 2) * 36], s[(4 * j + 3) * 36], x, true); w[j] = x; }
            unsigned char* op = cur.WT + (size_t)(cur.n0 + n) * cur.kpitch + cur.k0 + 64 * hf;
#pragma unroll
            for (int j = 0; j < 4; ++j) *(u32x4*)(op + 16 * j) = (u32x4){w[4 * j], w[4 * j + 1], w[4 * j + 2], w[4 * j + 3]};
            asm volatile("s_waitcnt lgkmcnt(0)" ::: "memory");
        }
    }
}
static_assert(CV_TAIL <= 32 * 16 * 64 && CV_TAIL1 % 8 == 0 && CV_TAIL2 % 8 == 0, "the tails are a suffix of the moe_w2 items");

struct SchedP1 {
    int G, c; const unsigned char* ws; int lo, hi;
    DI bool next(int i, pg8::UnitD& u) const {
        const int L = lo + i * G + c; if (L >= hi) return false;
        u.rows = nullptr; u.nvalid = 0; u.lda = 4096u; u.ldb = 4096u; u.e = 0; u.x0 = 0;
        if (L < 32 * 23) { u.type = 0; u.pn = L / 32; u.pm = L % 32; u.A = (const char*)(ws + WS_HN) + (size_t)u.pm * 256 * 4096; u.B = (const char*)(ws + WS_WIN) + (size_t)u.pn * 256 * 4096; }
        else { const int q = L - 32 * 23; u.type = 1; u.pn = q / 4; u.pm = q % 4; u.A = (const char*)(ws + WS_MN) + (size_t)u.pm * 256 * 4096; u.B = (const char*)(ws + WS_WKV) + (size_t)u.pn * 256 * 4096; }
        return true;
    }
};
struct EpiP1 {
    static constexpr bool AFTER_DRAIN = false;
    bf16_t* proj; float* dtb; bf16_t* kvraw; const float* gq; const float* gk; unsigned char* vf8;
    DI void operator()(const f32x4 (&acc)[2][2][4][2], const pg8::UnitD& u, int wr, int wc, int fr, int fq) const {
        { int ln_ = threadIdx.x; asm volatile("" : "+v"(ln_)); fr = ln_ & 15; fq = (ln_ >> 4) & 3; }
        const int row0 = u.pm * 256 + wr * 64 + fr;
        const int cn = u.pn * 256 + 64 * wc + 8 * fq;
        if (u.type == 1 && u.pn >= 8) {
#pragma unroll
            for (int ai = 0; ai < 2; ++ai)
#pragma unroll
                for (int m = 0; m < 4; ++m) { unsigned char* rp = vf8 + (size_t)(row0 + ai * 128 + m * 16) * 2048 + (cn - 2048);
#pragma unroll
                    for (int bj = 0; bj < 2; ++bj) { const f32x4 v0 = acc[ai][bj][m][0] * 16.f, v1 = acc[ai][bj][m][1] * 16.f;
                        u32x2 w; w.x = __builtin_amdgcn_cvt_pk_fp8_f32(v0[0], v0[1], 0u, false); w.x = __builtin_amdgcn_cvt_pk_fp8_f32(v0[2], v0[3], w.x, true);
                        w.y = __builtin_amdgcn_cvt_pk_fp8_f32(v1[0], v1[1], 0u, false); w.y = __builtin_amdgcn_cvt_pk_fp8_f32(v1[2], v1[3], w.y, true);
                        *(u32x2*)(rp + 32 * bj) = w; } }
            return;
        }
        if (u.type == 1) {
#pragma unroll
            for (int ai = 0; ai < 2; ++ai)
#pragma unroll
                for (int m = 0; m < 4; ++m) { bf16_t* rp = kvraw + (size_t)(row0 + ai * 128 + m * 16) * 4096 + cn;
#pragma unroll
                    for (int bj = 0; bj < 2; ++bj) { const f32x4 v0 = acc[ai][bj][m][0], v1 = acc[ai][bj][m][1];
                        u32x4 w; w.x = pk2(v0[0], v0[1]); w.y = pk2(v0[2], v0[3]); w.z = pk2(v1[0], v1[1]); w.w = pk2(v1[2], v1[3]); *(u32x4*)(rp + 32 * bj) = w; } }
            return;
        }
        if (u.pn == 22) {
            if (wc == 0 && fq < 2) {
#pragma unroll
                for (int ai = 0; ai < 2; ++ai)
#pragma unroll
                    for (int m = 0; m < 4; ++m) { float* rp = dtb + (size_t)(row0 + ai * 128 + m * 16) * 16 + 8 * fq;
                        *(f32x4*)(rp) = acc[ai][0][m][0]; *(f32x4*)(rp + 4) = acc[ai][0][m][1]; }
            }
            return;
        }
        const bool isq = (u.pn >= 10 && u.pn < 14), isk = (u.pn >= 14 && u.pn < 18);
        if (!(isq || isk)) {
#pragma unroll
            for (int ai = 0; ai < 2; ++ai)
#pragma unroll
                for (int m = 0; m < 4; ++m) { bf16_t* rp = proj + (size_t)(row0 + ai * 128 + m * 16) * PP + cn;
#pragma unroll
                    for (int bj = 0; bj < 2; ++bj) { const f32x4 v0 = acc[ai][bj][m][0], v1 = acc[ai][bj][m][1];
                        u32x4 w; w.x = pk2(v0[0], v0[1]); w.y = pk2(v0[2], v0[3]); w.z = pk2(v1[0], v1[1]); w.w = pk2(v1[2], v1[3]); *(u32x4*)(rp + 32 * bj) = w; } }
            return;
        }
        const float* g = (isq ? gq : gk) + 8 * fq; const float sc = isq ? (0.125f * 1.4426950408889634f) : 1.f;
#pragma unroll
        for (int ai = 0; ai < 2; ++ai)
#pragma unroll
            for (int m = 0; m < 4; ++m) { bf16_t* rp = proj + (size_t)(row0 + ai * 128 + m * 16) * PP + cn;
                float ss = 0.f;
#pragma unroll
                for (int bj = 0; bj < 2; ++bj)
#pragma unroll
                    for (int n = 0; n < 2; ++n) { const f32x4 v = acc[ai][bj][m][n]; ss += (v[0] * v[0] + v[1] * v[1]) + (v[2] * v[2] + v[3] * v[3]); }
                ss += __shfl_xor(ss, 16); ss += __shfl_xor(ss, 32);
                const float rs = sc / sqrtf(ss * (1.f / 64.f) + EPS_);
#pragma unroll
                for (int bj = 0; bj < 2; ++bj) { const f32x4 v0 = acc[ai][bj][m][0] * rs * *(const f32x4*)(g + 32 * bj), v1 = acc[ai][bj][m][1] * rs * *(const f32x4*)(g + 32 * bj + 4);
                    u32x4 w; w.x = pk2(v0[0], v0[1]); w.y = pk2(v0[2], v0[3]); w.z = pk2(v1[0], v1[1]); w.w = pk2(v1[2], v1[3]); *(u32x4*)(rp + 32 * bj) = w; } }
    }
};

DI void kprep(Frame& F, const ArgP& a) {
    const int gw = F.vcu * NWAVES + F.wave, NGW = F.G * NWAVES;
    const bf16_t* kv = (const bf16_t*)(F.ws + WS_KVRAW); unsigned char* kn = (unsigned char*)(F.ws + WS_KN8);
    for (int it = gw; it < NB * MEMLEN * 4; it += NGW) {
        const int row = it >> 2, h = it & 3, b = row >> 8, key = row & 255;
        const u32x4 raw = *(const u32x4*)(kv + (size_t)row * 4096 + h * 512 + F.lane * 8);
        float v[8]; v[0] = bflo(raw.x); v[1] = bfhi(raw.x); v[2] = bflo(raw.y); v[3] = bfhi(raw.y); v[4] = bflo(raw.z); v[5] = bfhi(raw.z); v[6] = bflo(raw.w); v[7] = bfhi(raw.w);
        float ss = 0.f;
#pragma unroll
        for (int j = 0; j < 8; ++j) ss += v[j] * v[j];
        const float rs = 1.f / sqrtf(wave_sum(ss) * (1.f / 512.f) + EPS_) * 0.04419417382415922f * 128.f;
        const float* gk = a.in(I_XKG) + F.lane * 8; const float* gq = a.in(I_XQG) + F.lane * 8;
        u32x2 o; o.x = __builtin_amdgcn_cvt_pk_fp8_f32(v[0] * rs * gk[0] * gq[0], v[1] * rs * gk[1] * gq[1], 0u, false); o.x = __builtin_amdgcn_cvt_pk_fp8_f32(v[2] * rs * gk[2] * gq[2], v[3] * rs * gk[3] * gq[3], o.x, true);
        o.y = __builtin_amdgcn_cvt_pk_fp8_f32(v[4] * rs * gk[4] * gq[4], v[5] * rs * gk[5] * gq[5], 0u, false); o.y = __builtin_amdgcn_cvt_pk_fp8_f32(v[6] * rs * gk[6] * gq[6], v[7] * rs * gk[7] * gq[7], o.y, true);
        *(u32x2*)(kn + ((size_t)((b * 4 + h) * 256 + key)) * 512 + F.lane * 8) = o;
    }
}

constexpr int SP = 272;
constexpr int S_C = 0, S_BM = 34816, S_BT = 69632, S_XDT = 104448, S_HB = 121856, S_F = 139264, S_W = 155648  , SSD_LDS = 162048;
static_assert(SSD_LDS <= MISC_OFF, "SSD LDS map");
#define MFMA32(a, b, c) __builtin_amdgcn_mfma_f32_32x32x16_bf16((a), (b), (c), 0, 0, 0)
DI int crow(int r, int hi) { return (r & 3) + 8 * (r >> 2) + 4 * hi; }
DI bf16x8 ldfrag(LAS const unsigned char* base, int row, int kel) { return *(const LAS bf16x8*)(base + row * SP + kel * 2); }
DI float fexp(float x) { return __builtin_amdgcn_exp2f(x * 1.4426950408889634f); }
DI float fsilu(float x) { return x * __builtin_amdgcn_rcpf(1.f + fexp(-x)); }

DI void ssd_unit(Frame& F, const ArgP& a, int b, int hd) {
    LAS unsigned char* lds = F.lds;
    int tid = F.tid, lane = F.lane, r32 = lane & 31, hh = lane >> 5; const int wid = F.wave;
    LAS float* sdt = (LAS float*)(lds + S_F); LAS float* sac = sdt + 2048;
    const bf16_t* proj = (const bf16_t*)(F.ws + WS_PROJ); const float* dtbuf = (const float*)(F.ws + WS_DT); bf16_t* yg = (bf16_t*)(F.ws + WS_YG);
    const int g = hd >> 3;
    const float aneg = -__expf(a.in(I_ALOG)[hd]), dtb = a.in(I_DTB)[hd], dsk = a.in(I_DSKIP)[hd];
#pragma unroll
    for (int q = 0; q < 2; ++q) { const int c = 2 * wid + q; const size_t t0 = (size_t)b * SEQ_ + c * 128;
        const float x0 = dtbuf[(t0 + 2 * lane) * 16 + hd] + dtb, x1 = dtbuf[(t0 + 2 * lane + 1) * 16 + hd] + dtb;
        const float d0 = x0 > 20.f ? x0 : log1pf(__expf(x0)), d1 = x1 > 20.f ? x1 : log1pf(__expf(x1));
        const float a0 = d0 * aneg, a1 = d1 * aneg;
        float s = a0 + a1;
#pragma unroll
        for (int o = 1; o < 64; o <<= 1) { const float t = __shfl_up(s, o); if (lane >= o) s += t; }
        sdt[c * 128 + 2 * lane] = d0; sdt[c * 128 + 2 * lane + 1] = d1; sac[c * 128 + 2 * lane] = s - a1; sac[c * 128 + 2 * lane + 1] = s; }
    int seg = tid >> 5, cg = tid & 31, l0 = seg * 8;
    int colbc = (cg < 16) ? (1024 + g * 128 + cg * 8) : (1280 + g * 128 + (cg - 16) * 8);
    const int colx = hd * 64 + wid * 8; int lx = 2 * lane;
    LAS float* swt = (LAS float*)(lds + S_W);
    { const float* convw = a.in(I_CONVW); const float* convb = a.in(I_CONVB);
      if (tid < 320) { const int ci = tid;
          const int xc = (ci < 64) ? (hd * 64 + ci) : (ci < 192 ? (1024 + g * 128 + (ci - 64)) : (1280 + g * 128 + (ci - 192)));
#pragma unroll
          for (int k = 0; k < 4; ++k) swt[k * 320 + ci] = convw[k * 1536 + xc];
          swt[4 * 320 + ci] = convb[xc]; } }
    int cibc = 64 + cg * 8; const int cix = wid * 8;
    const char* pub = (const char*)F.ws; const unsigned pxb = (unsigned)(WS_PROJ + ((size_t)b * SEQ_ * PP + PC_XBC) * 2), zoff = (unsigned)(WS_CTL + 524288);
    u32x4 inbc[11], inx[5];
#define SSD_PREFETCH(c_) do { \
        int sd_ = l0; asm volatile("" : "+v"(sd_)); \
        _Pragma("unroll") for (int j = 0; j < 11; ++j) { const int tt = (c_) * 128 + sd_ - 3 + j; inbc[j] = *(const u32x4*)(pub + ((tt >= 0) ? pxb + (unsigned)(tt * PP + colbc) * 2u : zoff)); } } while (0)
    SSD_PREFETCH(0);
    f32x16 hT; for (int i = 0; i < 16; ++i) hT[i] = 0.f;
    const int nb = wid & 3, pb = wid >> 2;
    __syncthreads();
    for (int c = 0; c < 16; ++c) {
        { int t_ = threadIdx.x; asm volatile("" : "+v"(t_)); tid = t_; lane = t_ & 63; r32 = lane & 31; hh = lane >> 5; seg = t_ >> 5; cg = t_ & 31; l0 = seg * 8; lx = 2 * lane;
          colbc = (cg < 16) ? (1024 + g * 128 + cg * 8) : (1280 + g * 128 + (cg - 16) * 8); cibc = 64 + cg * 8; }
        const size_t t0 = (size_t)b * SEQ_ + c * 128;
        const LAS float* cdt = sdt + c * 128; const LAS float* cac = sac + c * 128;
        const float aend = cac[127];
        u32x2 zz[4];
        { const size_t ztok = t0 + 32 * (wid & 3) + r32; const int zc0 = hd * 64 + 32 * (wid >> 2) + 4 * hh;
#pragma unroll
          for (int q4 = 0; q4 < 4; ++q4) zz[q4] = *(const u32x2*)(proj + ztok * PP + zc0 + 8 * q4); }
#pragma unroll
        for (int j = 0; j < 5; ++j) { int sd_ = lx; asm volatile("" : "+v"(sd_)); const int tt = c * 128 + sd_ - 3 + j; inx[j] = *(const u32x4*)(pub + ((tt >= 0) ? pxb + (unsigned)(tt * PP + colx) * 2u : zoff)); }
        {
            LAS unsigned char* hbp = lds + S_HB + (32 * pb + r32) * SP + (32 * nb + 4 * hh) * 2;
#pragma unroll
            for (int q4 = 0; q4 < 4; ++q4) { u32x2 w; w.x = pk2(hT[4 * q4], hT[4 * q4 + 1]); w.y = pk2(hT[4 * q4 + 2], hT[4 * q4 + 3]); *(LAS u32x2*)(hbp + 16 * q4) = w; }
        }
        {
            float wbc[5][8];
#pragma unroll
            for (int k = 0; k < 5; ++k) { const f32x4 w0 = *(const LAS f32x4*)(swt + k * 320 + cibc), w1 = *(const LAS f32x4*)(swt + k * 320 + cibc + 4);
#pragma unroll
                for (int i = 0; i < 4; ++i) { wbc[k][i] = w0[i]; wbc[k][4 + i] = w1[i]; } }
#pragma unroll
            for (int hf = 0; hf < 2; ++hf) {
                __builtin_amdgcn_sched_barrier(0);
                float o[4][8];
#pragma unroll
                for (int j = 0; j < 4; ++j)
#pragma unroll
                    for (int i = 0; i < 8; ++i) { float s = wbc[4][i];
#pragma unroll
                        for (int k = 0; k < 4; ++k) { const unsigned wd = inbc[4 * hf + j + k][i >> 1]; s += wbc[k][i] * ((i & 1) ? bfhi(wd) : bflo(wd)); }
                        o[j][i] = fsilu(s); }
                const int lh = l0 + 4 * hf;
                if (cg < 16) {
                    const int n0 = cg * 8; float ev[4];
#pragma unroll
                    for (int j = 0; j < 4; ++j) { ev[j] = fexp(aend - cac[lh + j]);
                        u32x4 w1; w1.x = pk2(o[j][0], o[j][1]); w1.y = pk2(o[j][2], o[j][3]); w1.z = pk2(o[j][4], o[j][5]); w1.w = pk2(o[j][6], o[j][7]);
                        *(LAS u32x4*)(lds + S_BM + (lh + j) * SP + n0 * 2) = w1; }
#pragma unroll
                    for (int i = 0; i < 8; ++i) { u32x2 w2; w2.x = pk2(o[0][i] * ev[0], o[1][i] * ev[1]); w2.y = pk2(o[2][i] * ev[2], o[3][i] * ev[3]);
                        *(LAS u32x2*)(lds + S_BT + (n0 + i) * SP + lh * 2) = w2; }
                } else {
                    const int n0 = (cg - 16) * 8;
#pragma unroll
                    for (int j = 0; j < 4; ++j) { u32x4 w1; w1.x = pk2(o[j][0], o[j][1]); w1.y = pk2(o[j][2], o[j][3]); w1.z = pk2(o[j][4], o[j][5]); w1.w = pk2(o[j][6], o[j][7]);
                        *(LAS u32x4*)(lds + S_C + (lh + j) * SP + n0 * 2) = w1; }
                }
            }
        }
        __builtin_amdgcn_sched_barrier(0);
        {
            const float d0 = cdt[lx], d1 = cdt[lx + 1];
            float wx[5][8];
#pragma unroll
            for (int k = 0; k < 5; ++k) { const f32x4 w0 = *(const LAS f32x4*)(swt + k * 320 + cix), w1 = *(const LAS f32x4*)(swt + k * 320 + cix + 4);
#pragma unroll
                for (int i = 0; i < 4; ++i) { wx[k][i] = w0[i]; wx[k][4 + i] = w1[i]; } }
#pragma unroll
            for (int i = 0; i < 8; ++i) { float s0 = wx[4][i], s1 = wx[4][i];
#pragma unroll
                for (int k = 0; k < 4; ++k) { const unsigned w0 = inx[k][i >> 1], w1 = inx[k + 1][i >> 1];
                    s0 += wx[k][i] * ((i & 1) ? bfhi(w0) : bflo(w0)); s1 += wx[k][i] * ((i & 1) ? bfhi(w1) : bflo(w1)); }
                *(LAS unsigned*)(lds + S_XDT + (wid * 8 + i) * SP + lx * 2) = pk2(fsilu(s0) * d0, fsilu(s1) * d1); }
        }
        if (c < 15) SSD_PREFETCH(c + 1);
        __syncthreads();
        const int lb = wid >> 1;
        f32x16 xt[2];
#pragma unroll
        for (int q = 0; q < 2; ++q) { const int sb = 2 * (wid & 1) + q;
            for (int i = 0; i < 16; ++i) xt[q][i] = 0.f;
            if (sb <= lb) {
#pragma unroll
                for (int ks = 0; ks < 8; ++ks) xt[q] = MFMA32(ldfrag(lds + S_BM, 32 * sb + r32, 16 * ks + 8 * hh), ldfrag(lds + S_C, 32 * lb + r32, 16 * ks + 8 * hh), xt[q]);
            }
        }
        __syncthreads();
        {
            const int l = 32 * lb + r32; const float al = cac[l], ddl = dsk * __builtin_amdgcn_rcpf(cdt[l]);
#pragma unroll
            for (int q = 0; q < 2; ++q) { const int sb = 2 * (wid & 1) + q;
#pragma unroll
                for (int q4 = 0; q4 < 4; ++q4) { float mv[4];
#pragma unroll
                    for (int e = 0; e < 4; ++e) { const int s = 32 * sb + 8 * q4 + 4 * hh + e;
                        float v = 0.f;
                        if (s <= l) v = xt[q][4 * q4 + e] * fexp(al - cac[s]);
                        if (s == l) v += ddl;
                        mv[e] = v; }
                    u32x2 w; w.x = pk2(mv[0], mv[1]); w.y = pk2(mv[2], mv[3]);
                    *(LAS u32x2*)(lds + S_BM + l * SP + (32 * sb + 8 * q4 + 4 * hh) * 2) = w; }
            }
        }
        __syncthreads();
        {
            const int lb2 = wid & 3, pb2 = wid >> 2; const int l = 32 * lb2 + r32; const size_t tok = t0 + l;
            const int pc0 = hd * 64 + 32 * pb2 + 4 * hh;
            f32x16 y1, y2; for (int i = 0; i < 16; ++i) { y1[i] = 0.f; y2[i] = 0.f; }
            for (int ks = 0; ks < 2 * (lb2 + 1); ++ks) y1 = MFMA32(ldfrag(lds + S_XDT, 32 * pb2 + r32, 16 * ks + 8 * hh), ldfrag(lds + S_BM, 32 * lb2 + r32, 16 * ks + 8 * hh), y1);
#pragma unroll
            for (int ks = 0; ks < 8; ++ks) y2 = MFMA32(ldfrag(lds + S_HB, 32 * pb2 + r32, 16 * ks + 8 * hh), ldfrag(lds + S_C, 32 * lb2 + r32, 16 * ks + 8 * hh), y2);
            const float cd = fexp(aend);
#pragma unroll
            for (int i = 0; i < 16; ++i) hT[i] *= cd;
#pragma unroll
            for (int ks = 0; ks < 8; ++ks) hT = MFMA32(ldfrag(lds + S_BT, 32 * nb + r32, 16 * ks + 8 * hh), ldfrag(lds + S_XDT, 32 * pb + r32, 16 * ks + 8 * hh), hT);
            const float el = fexp(cac[l]);
#pragma unroll
            for (int q4 = 0; q4 < 4; ++q4) { float yv[4];
#pragma unroll
                for (int e = 0; e < 4; ++e) { const float z = (e & 1) ? bfhi(e < 2 ? zz[q4].x : zz[q4].y) : bflo(e < 2 ? zz[q4].x : zz[q4].y);
                    yv[e] = (y1[4 * q4 + e] + el * y2[4 * q4 + e]) * fsilu(z); }
                u32x2 w; w.x = pk2(yv[0], yv[1]); w.y = pk2(yv[2], yv[3]);
                *(u32x2*)(yg + tok * 1024 + pc0 + 8 * q4) = w; }
        }
        __syncthreads();
    }
#undef SSD_PREFETCH
}

DI void attn_phase_da(Frame& F) {
    const attn_body::bf16* proj = (const attn_body::bf16*)(F.ws + WS_PROJ);
    for (;;) {
        if (threadIdx.x == 0) F.MISC[120] = __hip_atomic_fetch_add(F.ctl + CW_QATT, 1u, __ATOMIC_RELAXED, __HIP_MEMORY_SCOPE_AGENT);
        __syncthreads();
        const int u = __builtin_amdgcn_readfirstlane((int)F.MISC[120]);
        __syncthreads();
        if (u >= 1024) break;
        const int qb = 7 - (u >> 7), combo = u & 127;
        const int half = combo & 1, j = (combo >> 1) & 1, h = (combo >> 2) & 7, b = combo >> 5;
        attn_body::bf16* O = (attn_body::bf16*)(F.ws + (j ? WS_O1 : WS_O0));
        attn_body::attn_unit<8>(b, PC_Q + (h * 2 + j) * 64, PC_V + h * 128 + half * 64, h * 128 + half * 64, qb, proj, proj + (PC_K - PC_Q), proj, O, (char*)F.lds);
    }
}

DI void p3_finalize(Frame& F, const ArgP& a) {
    const int gw = F.vcu * NWAVES + F.wave, NGW = F.G * NWAVES, lane = F.lane;
    bf16_t* ycat = (bf16_t*)(F.ws + WS_YCAT); const bf16_t* yg = (const bf16_t*)(F.ws + WS_YG); const bf16_t* o0 = (const bf16_t*)(F.ws + WS_O0); const bf16_t* o1 = (const bf16_t*)(F.ws + WS_O1);
    float l1 = a.in(I_LQ1)[lane] * a.in(I_LK1)[lane], l2 = a.in(I_LQ2)[lane] * a.in(I_LK2)[lane];
    const float lam = __expf(wave_sum(l1)) - __expf(wave_sum(l2)) + LAM_INIT;
    for (int m = gw; m < NTOK; m += NGW) {
        { bf16_t* yp = ycat + (size_t)m * 2048 + 16 * lane; const bf16_t* gp = yg + (size_t)m * 1024 + 16 * lane;
          const u32x4 r0 = *(const u32x4*)gp, r1 = *(const u32x4*)(gp + 8);
          float v[16]; v[0] = bflo(r0.x); v[1] = bfhi(r0.x); v[2] = bflo(r0.y); v[3] = bfhi(r0.y); v[4] = bflo(r0.z); v[5] = bfhi(r0.z); v[6] = bflo(r0.w); v[7] = bfhi(r0.w);
          v[8] = bflo(r1.x); v[9] = bfhi(r1.x); v[10] = bflo(r1.y); v[11] = bfhi(r1.y); v[12] = bflo(r1.z); v[13] = bfhi(r1.z); v[14] = bflo(r1.w); v[15] = bfhi(r1.w);
          float ss = 0.f;
#pragma unroll
          for (int i = 0; i < 16; ++i) ss += v[i] * v[i];
#pragma unroll
          for (int o = 1; o < 32; o <<= 1) ss += __shfl_xor(ss, o);
          const float rs = 1.f / sqrtf(ss * (1.f / 512.f) + EPS_);
          const float* g = a.in(I_SSDG) + 16 * lane;
          u32x4 w0, w1;
          w0.x = pk2(v[0] * rs * g[0], v[1] * rs * g[1]); w0.y = pk2(v[2] * rs * g[2], v[3] * rs * g[3]); w0.z = pk2(v[4] * rs * g[4], v[5] * rs * g[5]); w0.w = pk2(v[6] * rs * g[6], v[7] * rs * g[7]);
          w1.x = pk2(v[8] * rs * g[8], v[9] * rs * g[9]); w1.y = pk2(v[10] * rs * g[10], v[11] * rs * g[11]); w1.z = pk2(v[12] * rs * g[12], v[13] * rs * g[13]); w1.w = pk2(v[14] * rs * g[14], v[15] * rs * g[15]);
          *(u32x4*)yp = w0; *(u32x4*)(yp + 8) = w1; }
        { const bf16_t* p0 = o0 + (size_t)m * 1024 + 16 * lane; const bf16_t* p1 = o1 + (size_t)m * 1024 + 16 * lane;
          const u32x4 a0 = *(const u32x4*)p0, a1 = *(const u32x4*)(p0 + 8), b0 = *(const u32x4*)p1, b1 = *(const u32x4*)(p1 + 8);
          float v[16];
          v[0] = bflo(a0.x) - lam * bflo(b0.x); v[1] = bfhi(a0.x) - lam * bfhi(b0.x); v[2] = bflo(a0.y) - lam * bflo(b0.y); v[3] = bfhi(a0.y) - lam * bfhi(b0.y);
          v[4] = bflo(a0.z) - lam * bflo(b0.z); v[5] = bfhi(a0.z) - lam * bfhi(b0.z); v[6] = bflo(a0.w) - lam * bflo(b0.w); v[7] = bfhi(a0.w) - lam * bfhi(b0.w);
          v[8] = bflo(a1.x) - lam * bflo(b1.x); v[9] = bfhi(a1.x) - lam * bfhi(b1.x); v[10] = bflo(a1.y) - lam * bflo(b1.y); v[11] = bfhi(a1.y) - lam * bfhi(b1.y);
          v[12] = bflo(a1.z) - lam * bflo(b1.z); v[13] = bfhi(a1.z) - lam * bfhi(b1.z); v[14] = bflo(a1.w) - lam * bflo(b1.w); v[15] = bfhi(a1.w) - lam * bfhi(b1.w);
          float ss = 0.f;
#pragma unroll
          for (int i = 0; i < 16; ++i) ss += v[i] * v[i];
          ss += __shfl_xor(ss, 1); ss += __shfl_xor(ss, 2); ss += __shfl_xor(ss, 4);
          const float rs = 1.f / sqrtf(ss * (1.f / 128.f) + EPS_) * (1.f - LAM_INIT);
          const float* g = a.in(I_SUBG) + 16 * (lane & 7);
          u32x4 w0, w1;
          w0.x = pk2(v[0] * rs * g[0], v[1] * rs * g[1]); w0.y = pk2(v[2] * rs * g[2], v[3] * rs * g[3]); w0.z = pk2(v[4] * rs * g[4], v[5] * rs * g[5]); w0.w = pk2(v[6] * rs * g[6], v[7] * rs * g[7]);
          w1.x = pk2(v[8] * rs * g[8], v[9] * rs * g[9]); w1.y = pk2(v[10] * rs * g[10], v[11] * rs * g[11]); w1.z = pk2(v[12] * rs * g[12], v[13] * rs * g[13]); w1.w = pk2(v[14] * rs * g[14], v[15] * rs * g[15]);
          bf16_t* yp = ycat + (size_t)m * 2048 + 1024 + 16 * lane;
          *(u32x4*)yp = w0; *(u32x4*)(yp + 8) = w1; }
    }
}

struct SchedDense {
    int G, c, nM, nN; const char* A; const char* B; unsigned lda, ldb; int bdiv; size_t bstride;
    DI bool next(int i, pg8::UnitD& u) const {
        const int L = i * G + c; if (L >= nM * nN) return false;
        u.rows = nullptr; u.nvalid = 0; u.lda = lda; u.ldb = ldb; u.type = 0; u.e = 0; u.x0 = 0;
        u.pn = L / nM; u.pm = L % nM;
        u.A = A + (size_t)u.pm * 256 * lda; u.B = B + (size_t)u.pn * 256 * ldb + (size_t)(u.pm / bdiv) * bstride;
        return true;
    }
};
struct EpiResid {
    static constexpr bool AFTER_DRAIN = false;
    const float* base; float* out; bf16_t* outb; float* part; unsigned char* out8; float accscale;
    DI void operator()(const f32x4 (&acc)[2][2][4][2], const pg8::UnitD& u, int wr, int wc, int fr, int fq) const {
        { int ln_ = threadIdx.x; asm volatile("" : "+v"(ln_)); fr = ln_ & 15; fq = (ln_ >> 4) & 3; }
        const int row0 = u.pm * 256 + wr * 64 + fr, col0 = u.pn * 256 + wc * 32 + 8 * fq;
#pragma unroll
        for (int ai = 0; ai < 2; ++ai)
#pragma unroll
            for (int m = 0; m < 4; ++m) { const size_t row = (size_t)(row0 + ai * 128 + m * 16); float ss = 0.f;
#pragma unroll
                for (int bj = 0; bj < 2; ++bj) { const size_t idx = row * 2048 + col0 + bj * 128;
                    f32x4 v0 = acc[ai][bj][m][0] * accscale + *(const f32x4*)(base + idx), v1 = acc[ai][bj][m][1] * accscale + *(const f32x4*)(base + idx + 4);
                    *(f32x4*)(out + idx) = v0; *(f32x4*)(out + idx + 4) = v1;
                    if (out8) { u32x2 w; w.x = __builtin_amdgcn_cvt_pk_fp8_f32(v0[0] * 16.f, v0[1] * 16.f, 0u, false); w.x = __builtin_amdgcn_cvt_pk_fp8_f32(v0[2] * 16.f, v0[3] * 16.f, w.x, true);
                        w.y = __builtin_amdgcn_cvt_pk_fp8_f32(v1[0] * 16.f, v1[1] * 16.f, 0u, false); w.y = __builtin_amdgcn_cvt_pk_fp8_f32(v1[2] * 16.f, v1[3] * 16.f, w.y, true); *(u32x2*)(out8 + idx) = w; }
                    if (outb) { u32x4 w; w.x = pk2(v0[0], v0[1]); w.y = pk2(v0[2], v0[3]); w.z = pk2(v1[0], v1[1]); w.w = pk2(v1[2], v1[3]); *(u32x4*)(outb + idx) = w; }
                    ss += (v0[0] * v0[0] + v0[1] * v0[1]) + (v0[2] * v0[2] + v0[3] * v0[3]) + (v1[0] * v1[0] + v1[1] * v1[1]) + (v1[2] * v1[2] + v1[3] * v1[3]); }
                if (part) { ss += __shfl_xor(ss, 16); ss += __shfl_xor(ss, 32); if (fq == 0) part[row * 32 + u.pn * 4 + wc] = ss; } }
    }
};

struct EpiQ {
    static constexpr bool AFTER_DRAIN = false;
    unsigned char* out8; float* part;
    DI void operator()(const f32x4 (&acc)[2][2][4][2], const pg8::UnitD& u, int wr, int wc, int fr, int fq) const {
        { int ln_ = threadIdx.x; asm volatile("" : "+v"(ln_)); fr = ln_ & 15; fq = (ln_ >> 4) & 3; }
        const int row0 = u.pm * 256 + wr * 64 + fr, col0 = u.pn * 256 + wc * 32 + 8 * fq;
#pragma unroll
        for (int ai = 0; ai < 2; ++ai)
#pragma unroll
            for (int m = 0; m < 4; ++m) { const size_t row = (size_t)(row0 + ai * 128 + m * 16); float ss = 0.f;
#pragma unroll
                for (int bj = 0; bj < 2; ++bj) { const size_t idx = row * 2048 + col0 + bj * 128; const f32x4 v0 = acc[ai][bj][m][0] * (1.f / 1024.f), v1 = acc[ai][bj][m][1] * (1.f / 1024.f);
                    u32x2 w; w.x = __builtin_amdgcn_cvt_pk_fp8_f32(v0[0] * 16.f, v0[1] * 16.f, 0u, false); w.x = __builtin_amdgcn_cvt_pk_fp8_f32(v0[2] * 16.f, v0[3] * 16.f, w.x, true);
                    w.y = __builtin_amdgcn_cvt_pk_fp8_f32(v1[0] * 16.f, v1[1] * 16.f, 0u, false); w.y = __builtin_amdgcn_cvt_pk_fp8_f32(v1[2] * 16.f, v1[3] * 16.f, w.y, true); *(u32x2*)(out8 + idx) = w;
                    ss += (v0[0] * v0[0] + v0[1] * v0[1]) + (v0[2] * v0[2] + v0[3] * v0[3]) + (v1[0] * v1[0] + v1[1] * v1[1]) + (v1[2] * v1[2] + v1[3] * v1[3]); }
                ss += __shfl_xor(ss, 16); ss += __shfl_xor(ss, 32); if (fq == 0) part[row * 32 + u.pn * 4 + wc] = ss; }
    }
};

struct SchedXS {
    int G, c; const unsigned char* ws;
    DI bool next(int i, pg8::UnitD& u) const {
        const int L = i * G + c; if (L >= 256) return false;
        u.rows = nullptr; u.nvalid = 0; u.e = 0;
        const int q = L & 127, bh = q >> 3, t8 = q & 7, b = bh >> 2, h = bh & 3;
        u.pm = b; u.pn = h; u.x0 = t8;
        if (L < 128) { u.type = 0; u.lda = 2048u; u.ldb = 512u;
            u.A = (const char*)(ws + WS_QF8) + (size_t)(b * 2048 + t8 * 256) * 2048 + h * 512; u.B = (const char*)(ws + WS_KN8) + (size_t)(bh * 256) * 512; }
        else { u.type = 1; u.lda = 2048u; u.ldb = 2048u;
            u.A = (const char*)(ws + WS_WO) + (size_t)(t8 * 256) * 2048 + h * 512; u.B = (const char*)(ws + WS_VF8) + (size_t)(b * 256) * 2048 + h * 512; }
        return true;
    }
};
struct EpiXS {
    static constexpr bool AFTER_DRAIN = false;
    unsigned char* P; unsigned char* VWT; const float* part1; const float* partq; LAS float* red;
    DI void operator()(const f32x4 (&acc)[2][2][4][2], const pg8::UnitD& u, int wr, int wc, int fr, int fq) const {
        { int ln_ = threadIdx.x; asm volatile("" : "+v"(ln_)); fr = ln_ & 15; fq = (ln_ >> 4) & 3; }
        const int b = u.pm, h = u.pn, t8 = u.x0;
        const int col0 = wc * 32 + 8 * fq;
        if (u.type == 1) {
            unsigned char* Vu = VWT + ((size_t)b * 2048 + t8 * 256) * 1024 + h * 256;
#pragma unroll
            for (int ai = 0; ai < 2; ++ai)
#pragma unroll
                for (int m = 0; m < 4; ++m) { const unsigned rl = (unsigned)(ai * 128 + wr * 64 + m * 16 + fr);
#pragma unroll
                    for (int bj = 0; bj < 2; ++bj) { const f32x4 v0 = acc[ai][bj][m][0] * (32.f / 1024.f), v1 = acc[ai][bj][m][1] * (32.f / 1024.f);
                        u32x2 w; w.x = __builtin_amdgcn_cvt_pk_fp8_f32(v0[0], v0[1], 0u, false); w.x = __builtin_amdgcn_cvt_pk_fp8_f32(v0[2], v0[3], w.x, true);
                        w.y = __builtin_amdgcn_cvt_pk_fp8_f32(v1[0], v1[1], 0u, false); w.y = __builtin_amdgcn_cvt_pk_fp8_f32(v1[2], v1[3], w.y, true);
                        *(u32x2*)(Vu + (rl * 1024u + (unsigned)(bj * 128 + col0))) = w; } }
            return;
        }
        const size_t row0 = (size_t)b * 2048 + t8 * 256;
        const char* p1u = (const char*)(part1 + row0 * 32); const char* pqu = (const char*)(partq + row0 * 32 + h * 8); unsigned char* Pu = P + row0 * 1024 + h * 256;
        float rsc[2][4];
#pragma unroll
        for (int ai = 0; ai < 2; ++ai)
#pragma unroll
            for (int m = 0; m < 4; ++m) { const unsigned rl = (unsigned)(ai * 128 + wr * 64 + m * 16 + fr);
                const f32x4 p0 = *(const f32x4*)(p1u + (rl * 32u + (unsigned)fq * 8u) * 4u), p1 = *(const f32x4*)(p1u + (rl * 32u + (unsigned)fq * 8u + 4u) * 4u);
                float s1 = (p0[0] + p0[1]) + (p0[2] + p0[3]) + (p1[0] + p1[1]) + (p1[2] + p1[3]);
                const f32x2 pq = *(const f32x2*)(pqu + (rl * 32u + (unsigned)fq * 2u) * 4u);
                float sq = pq[0] + pq[1];
                s1 = quad_sum_16_32(s1); sq = quad_sum_16_32(sq);
                rsc[ai][m] = __builtin_amdgcn_rsqf(sq * (1.f / 512.f) + EPS_ * (s1 * (1.f / 2048.f) + EPS_)) * (1.4426950408889634f / 2048.f);
                float ps = 0.f;
#pragma unroll
                for (int bj = 0; bj < 2; ++bj)
#pragma unroll
                    for (int n = 0; n < 2; ++n)
#pragma unroll
                        for (int e = 0; e < 4; ++e) ps += __builtin_amdgcn_exp2f(fminf(acc[ai][bj][m][n][e] * rsc[ai][m], 100.f));
                ps = quad_sum_16_32(ps);
                if (fq == 0) red[rl * 4 + wc] = ps;
                __builtin_amdgcn_sched_barrier(0); }
        __syncthreads();
        { int ln_ = threadIdx.x; asm volatile("" : "+v"(ln_)); fr = ln_ & 15; fq = (ln_ >> 4) & 3; }
#pragma unroll
        for (int ai = 0; ai < 2; ++ai)
#pragma unroll
            for (int m = 0; m < 4; ++m) { const unsigned rl = (unsigned)(ai * 128 + wr * 64 + m * 16 + fr);
                const f32x4 t = *(const LAS f32x4*)(red + rl * 4); const float inv = 256.f * __builtin_amdgcn_rcpf((t[0] + t[1]) + (t[2] + t[3])); float rs = rsc[ai][m]; asm volatile("" : "+v"(rs));
#pragma unroll
                for (int bj = 0; bj < 2; ++bj) { float x[8];
#pragma unroll
                    for (int n = 0; n < 2; ++n)
#pragma unroll
                        for (int e = 0; e < 4; ++e) x[n * 4 + e] = __builtin_amdgcn_exp2f(fminf(acc[ai][bj][m][n][e] * rs, 100.f)) * inv;
                    u32x2 w; w.x = __builtin_amdgcn_cvt_pk_fp8_f32(x[0], x[1], 0u, false); w.x = __builtin_amdgcn_cvt_pk_fp8_f32(x[2], x[3], w.x, true);
                    w.y = __builtin_amdgcn_cvt_pk_fp8_f32(x[4], x[5], 0u, false); w.y = __builtin_amdgcn_cvt_pk_fp8_f32(x[6], x[7], w.y, true);
                    *(u32x2*)(Pu + (rl * 1024u + (unsigned)(bj * 128 + wc * 32 + 8 * fq))) = w; } }
        __syncthreads();
    }
};

constexpr int HNP = 2052;
DI void p8_route(Frame& F, const ArgP& a) {
    LAS float* s_hn = (LAS float*)F.lds; LAS float* s_part = (LAS float*)(F.lds + 16 * HNP * 4); LAS float* s_log = s_part + 8 * 16 * 32; LAS int* s_slot = (LAS int*)(s_log + 16 * 32);
    LAS int* s_cnt = s_slot + 64; LAS int* s_base = s_cnt + 32;
    const float* h2 = (const float*)(F.ws + WS_H2); unsigned char* xg = (unsigned char*)(F.ws + WS_XG);
    float* gate_of = (float*)(F.ws + WS_GATEOF); int* tok_e = (int*)(F.ws + WS_TOKE);
    const float* rw = a.in(I_RW); const float* rb = a.in(I_RB); const float* g3 = a.in(I_GFFN);
    const int lane = F.lane, wave = F.wave, tid = F.tid;
    float bw0[64], bw1[64];
    { const int kq = lane >> 4, c16 = lane & 15; const float* bp = rw + (size_t)(256 * wave + kq) * 32 + c16;
#pragma unroll
      for (int j = 0; j < 64; ++j) { bw0[j] = bp[(size_t)(4 * j) * 32]; bw1[j] = bp[(size_t)(4 * j) * 32 + 16]; } }
    for (int task = F.vcu; task < NTOK / 16; task += F.G) {
        const int tb = task * 16;
#pragma unroll
        for (int q = 0; q < 2; ++q) { const int tl = 2 * wave + q; const size_t tok = (size_t)(tb + tl);
            const f32x4* xr = (const f32x4*)(h2 + tok * 2048) + lane;
            f32x4 v[8]; float s = 0.f;
#pragma unroll
            for (int j = 0; j < 8; ++j) { v[j] = xr[64 * j]; s += (v[j].x * v[j].x + v[j].y * v[j].y) + (v[j].z * v[j].z + v[j].w * v[j].w); }
            const float rstd = 1.f / sqrtf(wave_sum(s) * (1.f / 2048.f) + EPS_);
#pragma unroll
            for (int j = 0; j < 8; ++j) { const f32x4 gg = ((const f32x4*)g3)[lane + 64 * j]; const f32x4 y = v[j] * rstd * gg;
                *(LAS f32x4*)(s_hn + tl * HNP + (lane + 64 * j) * 4) = y; } }
        __syncthreads();
        {
            f32x4 acc0 = {0.f, 0.f, 0.f, 0.f}, acc1 = {0.f, 0.f, 0.f, 0.f};
            const int kq = lane >> 4, c16 = lane & 15;
            const LAS float* ap = s_hn + c16 * HNP + 256 * wave;
#pragma unroll
            for (int j = 0; j < 64; ++j) { const f32x4 a4 = *(const LAS f32x4*)(ap + 4 * j);
                const float av = (kq == 0) ? a4.x : (kq == 1) ? a4.y : (kq == 2) ? a4.z : a4.w;
                acc0 = __builtin_amdgcn_mfma_f32_16x16x4f32(av, bw0[j], acc0, 0, 0, 0);
                acc1 = __builtin_amdgcn_mfma_f32_16x16x4f32(av, bw1[j], acc1, 0, 0, 0); }
            LAS float* pp = s_part + wave * 512 + c16;
#pragma unroll
            for (int r = 0; r < 4; ++r) { pp[(4 * kq + r) * 32] = acc0[r]; pp[(4 * kq + r) * 32 + 16] = acc1[r]; }
        }
        __syncthreads();
        {
            const int tt = tid >> 5, e = tid & 31; float lg = rb[e];
#pragma unroll
            for (int w = 0; w < 8; ++w) lg += s_part[w * 512 + tt * 32 + e];
            if (tid < 32) s_cnt[tid] = 0;
            float val[4]; int idx[4]; float cur = lg;
#pragma unroll
            for (int k = 0; k < 4; ++k) { float bv = cur; int bi = e;
#pragma unroll
                for (int o = 1; o < 32; o <<= 1) { const float ov = __shfl_xor(bv, o); const int oi = __shfl_xor(bi, o); if (ov > bv || (ov == bv && oi < bi)) { bv = ov; bi = oi; } }
                val[k] = bv; idx[k] = bi; if (e == bi) cur = -INFINITY; }
            __syncthreads();
            int myrank = 0, myexp = 0; float mygate = 0.f;
            if (e < 4) { const float sum = (__expf(val[0] - val[0]) + __expf(val[1] - val[0])) + (__expf(val[2] - val[0]) + __expf(val[3] - val[0]));
                const float mv = (e == 0) ? val[0] : (e == 1) ? val[1] : (e == 2) ? val[2] : val[3]; myexp = (e == 0) ? idx[0] : (e == 1) ? idx[1] : (e == 2) ? idx[2] : idx[3];
                mygate = __expf(mv - val[0]) / sum; myrank = __hip_atomic_fetch_add(&s_cnt[myexp], 1, __ATOMIC_RELAXED, __HIP_MEMORY_SCOPE_WORKGROUP); }
            __syncthreads();
            if (tid < 32) { const int c = s_cnt[tid]; s_base[tid] = c ? (int)__hip_atomic_fetch_add(F.ctl + CW_CNT + 64 * tid, (unsigned)c, __ATOMIC_RELAXED, __HIP_MEMORY_SCOPE_AGENT) : 0; }
            __syncthreads();
            if (e < 4) { const int slot = myexp * 8192 + s_base[myexp] + myrank; const int tok = tb + tt;
                gate_of[slot] = mygate; tok_e[tok * 4 + e] = slot; s_slot[tt * 4 + e] = slot; }
        }
        __syncthreads();
#pragma unroll
        for (int q = 0; q < 2; ++q) { const int tl = 2 * wave + q;
            unsigned o[8];
#pragma unroll
            for (int j = 0; j < 8; ++j) { const f32x4 y = *(const LAS f32x4*)(s_hn + tl * HNP + (lane + 64 * j) * 4);
                unsigned w = 0u; w = __builtin_amdgcn_cvt_pk_fp8_f32(y.x * 4.f, y.y * 4.f, w, false); w = __builtin_amdgcn_cvt_pk_fp8_f32(y.z * 4.f, y.w * 4.f, w, true); o[j] = w; }
#pragma unroll
            for (int k = 0; k < 4; ++k) { unsigned* o4 = (unsigned*)(xg + (size_t)s_slot[tl * 4 + k] * 2048) + lane;
#pragma unroll
                for (int j = 0; j < 8; ++j) o4[64 * j] = o[j]; } }
        __syncthreads();
    }
}

DI void moe_tables(Frame& F) {
    if (F.tid == 0) { unsigned base = 0u;
        for (int e = 0; e < 32; ++e) { const unsigned c = F.ctl[CW_CNT + 64 * e], mt = (c + 255u) >> 8; F.MISC[16 + e] = c; F.MISC[48 + e] = base; F.MISC[80 + e] = mt; base += mt; }
        F.MISC[112] = base; }
    __syncthreads();
}
DI int ldsu(volatile LAS unsigned* p) { return __builtin_amdgcn_readfirstlane((int)*p); }
template <int NTN  >
struct SchedMoe {
    int G, c; const unsigned char* ws; volatile LAS unsigned* MISC; int total;
    DI bool next(int i, pg8::UnitD& u) const {
        const int L = i * G + c; if (L >= total) return false;
        int e = 0;
        for (int k = 0; k < 32; ++k) { if (L >= (ldsu(MISC + 48 + k) + ldsu(MISC + 80 + k)) * NTN) e = k + 1; }
        const int tb = ldsu(MISC + 48 + e), mte = ldsu(MISC + 80 + e), cnt = ldsu(MISC + 16 + e);
        const int local = L - tb * NTN, nt = local / mte, mt = local % mte;
        u.type = 0; u.e = e; u.pn = nt; u.pm = tb + mt; u.x0 = mt; u.lda = 2048u; u.ldb = 2048u;
        u.rows = nullptr; u.nvalid = cnt - mt * 256;
        if (NTN == 16) { u.A = (const char*)(ws + WS_XG) + ((size_t)e * 8192 + (size_t)mt * 256) * 2048;
            u.B = (const char*)(ws + WS_W1) + ((size_t)e * 4096 + (size_t)nt * 256) * 2048; }
        else { u.A = (const char*)(ws + WS_ACT) + ((size_t)e * 8192 + (size_t)mt * 256) * 2048;
            u.B = (const char*)(ws + WS_W2) + ((size_t)e * 2048 + (size_t)nt * 256) * 2048; }
        return true;
    }
};
struct EpiMoe1 {
    static constexpr bool AFTER_DRAIN = false;
    unsigned char* act; const float* b1;
    DI void operator()(const f32x4 (&acc)[2][2][4][2], const pg8::UnitD& u, int wr, int wc, int fr, int fq) const {
        { int ln_ = threadIdx.x; asm volatile("" : "+v"(ln_)); fr = ln_ & 15; fq = (ln_ >> 4) & 3; }
        const int j0 = u.pn * 128 + wc * 32 + 8 * fq;
        const float* bg = b1 + (size_t)u.e * 4096 + j0; const float* bu = bg + 2048;
        const f32x4 bg0 = *(const f32x4*)bg, bg1 = *(const f32x4*)(bg + 4), bu0 = *(const f32x4*)bu, bu1 = *(const f32x4*)(bu + 4);
#pragma unroll
        for (int ai = 0; ai < 2; ++ai)
#pragma unroll
            for (int m = 0; m < 4; ++m) { const size_t row = (size_t)u.e * 8192 + u.x0 * 256 + ai * 128 + wr * 64 + m * 16 + fr;
                float o[8];
#pragma unroll
                for (int n = 0; n < 2; ++n)
#pragma unroll
                    for (int e = 0; e < 4; ++e) { const float g = fminf(acc[ai][0][m][n][e] * (1.f / 256.f) + (n ? bg1[e] : bg0[e]), 7.f);
                        const float uu = fminf(fmaxf(acc[ai][1][m][n][e] * (1.f / 256.f) + (n ? bu1[e] : bu0[e]), -7.f), 7.f);
                        o[n * 4 + e] = g / (1.f + __expf(-1.702f * g)) * (uu + 1.f) * 4.f; }
                u32x2 w; w.x = __builtin_amdgcn_cvt_pk_fp8_f32(o[0], o[1], 0u, false); w.x = __builtin_amdgcn_cvt_pk_fp8_f32(o[2], o[3], w.x, true);
                w.y = __builtin_amdgcn_cvt_pk_fp8_f32(o[4], o[5], 0u, false); w.y = __builtin_amdgcn_cvt_pk_fp8_f32(o[6], o[7], w.y, true);
                *(u32x2*)(act + row * 2048 + j0) = w; }
    }
};
struct EpiMoe2 {
    static constexpr bool AFTER_DRAIN = false;
    bf16_t* y; const float* b2; const float* gate_of;
    DI void operator()(const f32x4 (&acc)[2][2][4][2], const pg8::UnitD& u, int wr, int wc, int fr, int fq) const {
        { int ln_ = threadIdx.x; asm volatile("" : "+v"(ln_)); fr = ln_ & 15; fq = (ln_ >> 4) & 3; }
        const int col0 = u.pn * 256 + wc * 32 + 8 * fq;
        const float* bp = b2 + (size_t)u.e * 2048 + col0;
#pragma unroll
        for (int ai = 0; ai < 2; ++ai)
#pragma unroll
            for (int m = 0; m < 4; ++m) { const int rl = ai * 128 + wr * 64 + m * 16 + fr; const size_t row = (size_t)u.e * 8192 + u.x0 * 256 + rl;
                const float gt = (rl < u.nvalid) ? gate_of[u.e * 8192 + u.x0 * 256 + rl] : 0.f;
#pragma unroll
                for (int bj = 0; bj < 2; ++bj) { const f32x4 v0 = (acc[ai][bj][m][0] * (1.f / 256.f) + *(const f32x4*)(bp + bj * 128)) * gt, v1 = (acc[ai][bj][m][1] * (1.f / 256.f) + *(const f32x4*)(bp + bj * 128 + 4)) * gt;
                    u32x4 w; w.x = pk2(v0[0], v0[1]); w.y = pk2(v0[2], v0[3]); w.z = pk2(v1[0], v1[1]); w.w = pk2(v1[2], v1[3]);
                    *(u32x4*)(y + row * 2048 + col0 + bj * 128) = w; } }
    }
};

DI void p11_combine(Frame& F, const ArgP& a) {
    const int gw = F.vcu * NWAVES + F.wave, NGW = F.G * NWAVES, lane = F.lane;
    const float* h2 = (const float*)(F.ws + WS_H2); const bf16_t* y = (const bf16_t*)(F.ws + WS_Y);
    const int* tok_e = (const int*)(F.ws + WS_TOKE);
    for (int t = gw; t < NTOK; t += NGW) {
        size_t yrow[4];
#pragma unroll
        for (int k = 0; k < 4; ++k) yrow[k] = (size_t)tok_e[t * 4 + k] * 2048;
#pragma unroll
        for (int j = 0; j < 8; ++j) { const int c = (lane + 64 * j) * 4;
            f32x4 v = *(const f32x4*)(h2 + (size_t)t * 2048 + c);
#pragma unroll
            for (int k = 0; k < 4; ++k) { const u32x2 w = *(const u32x2*)(y + yrow[k] + c); v.x += bflo(w.x); v.y += bfhi(w.x); v.z += bflo(w.y); v.w += bfhi(w.y); }
            *(f32x4*)(a.out() + (size_t)t * 2048 + c) = v; }
    }
}

#ifndef MK_PER_PHASE
#define MK_PER_PHASE 0
#endif
#ifndef MK_LAST_PHASE
#define MK_LAST_PHASE 12
#endif
constexpr int N_PHASES = MK_LAST_PHASE;

__global__ void __launch_bounds__(NWAVES * 64, 2) mega_fwd(Args args_) {
    const ArgP args{};
    extern __shared__ __attribute__((aligned(16))) unsigned char lds_raw[];
    Frame F;
    F.lds = (LAS unsigned char*)lds_raw;
    F.MISC = (volatile LAS unsigned*)(F.lds + MISC_OFF);
    F.tid = threadIdx.x; F.lane = F.tid & 63; F.wave = __builtin_amdgcn_readfirstlane(F.tid >> 6);
    F.G = gridDim.x; { const int bx = blockIdx.x; F.vcu = (F.G % 8 == 0) ? (bx % 8) * (F.G / 8) + bx / 8 : bx; }
    F.ws = args_.ws; F.ctl = (unsigned*)(args_.ws + WS_CTL);
    for (int u = F.tid; u < 256; u += NWAVES * 64) F.MISC[u] = 0u;
    __syncthreads();
    XcdBarrier bar; bar.bar = F.ctl + CW_BAR; bar.x = 0; bar.st = nullptr;
    const int lo = args_.ph_lo, hi = args_.ph_hi;
    if (hi - lo > 1) bar = xcd_barrier_post(F.ctl + CW_BAR, F.MISC + 8);
#ifndef MK_PHASE_MASK
#define MK_PHASE_MASK 0xFFFF
#endif
#define IN(k) (((MK_PHASE_MASK >> (k)) & 1) && lo <= (k) && (k) < hi)
#define SEAM(k) do { if (IN(k) && IN((k) + 1)) xcd_barrier(bar); } while (0)
#define FRESH() do { int t_ = threadIdx.x; asm volatile("" : "+v"(t_)); F.tid = t_; F.lane = t_ & 63; F.wave = __builtin_amdgcn_readfirstlane(t_ >> 6); } while (0)
    unsigned char* ws = args_.ws;

    if (IN(0)) { FRESH(); p0_prologue(F, args); }
    SEAM(0);
    if (IN(1)) { FRESH();
        const bool conv_first = (F.vcu & 1) == 0;
        if (conv_first) { conv_share(F, args); __syncthreads(); }
        SchedP1 S{F.G, F.vcu, ws, 0, 32 * 23};
        EpiP1 E{(bf16_t*)(ws + WS_PROJ), (float*)(ws + WS_DT), (bf16_t*)(ws + WS_KVRAW), args.in(I_DAQG), args.in(I_DAKG), (unsigned char*)(ws + WS_VF8)};
        pg8::gemm_phase<EpiP1, SchedP1, false, true>(F.lds + RING_OFF, 32, S, E);
        if (!conv_first) { __syncthreads(); conv_share(F, args); }
    }
    SEAM(1);
    if (IN(2)) { FRESH();
        if ((F.vcu & 3) == 1) {
            SchedP1 S{(F.G + 3) >> 2, F.vcu >> 2, ws, 32 * 23, 32 * 23 + 64};
            EpiP1 E{(bf16_t*)(ws + WS_PROJ), (float*)(ws + WS_DT), (bf16_t*)(ws + WS_KVRAW), args.in(I_DAQG), args.in(I_DAKG), (unsigned char*)(ws + WS_VF8)};
            pg8::gemm_phase<EpiP1, SchedP1, false, true>(F.lds + RING_OFF, 32, S, E);
            __syncthreads();
        }
        if ((F.vcu & 3) == 0) { for (int u = F.vcu >> 2; u < 64; u += (F.G + 3) >> 2) ssd_unit(F, args, u >> 4, u & 15); }
        __syncthreads();
        attn_phase_da(F);
        __syncthreads();
        conv_queue(F, args, CW_QCONV, CV_NJ - CV_TAIL, CV_TAIL1);
    }
    SEAM(2);
    if (IN(3)) { FRESH(); kprep(F, args); p3_finalize(F, args); }
    SEAM(3);
    if (IN(4)) { FRESH();
        SchedDense S{F.G, F.vcu, 32, 8, (const char*)(ws + WS_YCAT), (const char*)(ws + WS_WOUT), 4096u, 4096u, 1 << 30, 0};
#if MK_LAST_PHASE == 5
        EpiResid E{args.in(I_X), args_.out, nullptr, nullptr, nullptr, 1.f};
#else
        EpiResid E{args.in(I_X), (float*)(ws + WS_H1), nullptr, (float*)(ws + WS_PART1), (unsigned char*)(ws + WS_H1F8), 1.f};
#endif
        pg8::gemm_phase<EpiResid, SchedDense, false, true>(F.lds + RING_OFF, 32, S, E);
    }
    SEAM(4);
    if (IN(5)) { FRESH();
        SchedDense S{F.G, F.vcu, 32, 8, (const char*)(ws + WS_H1F8), (const char*)(ws + WS_WQ), 2048u, 2048u, 1 << 30, 0};
        EpiQ E{(unsigned char*)(ws + WS_QF8), (float*)(ws + WS_PARTQ)};
        pg8::gemm_phase<EpiQ, SchedDense, false, true, true>(F.lds + RING_OFF, 16, S, E);
    }
    SEAM(5);
    if (IN(6)) { FRESH();
        SchedXS S{F.G, F.vcu, ws};
        EpiXS E{(unsigned char*)(ws + WS_P8), (unsigned char*)(ws + WS_VWT8), (const float*)(ws + WS_PART1), (const float*)(ws + WS_PARTQ), (LAS float*)(F.lds + RING_BYTES)};
        pg8::gemm_phase<EpiXS, SchedXS, false, true, true>(F.lds + RING_OFF, 4, S, E);
    }
    SEAM(6);
    if (IN(7)) { FRESH();
        SchedDense S{F.G, F.vcu, 32, 8, (const char*)(ws + WS_P8), (const char*)(ws + WS_VWT8), 1024u, 1024u, 8, (size_t)2048 * 1024};
#if MK_LAST_PHASE == 8
        EpiResid E{(const float*)(ws + WS_H1), args_.out, nullptr, nullptr, nullptr, 1.f / 8192.f};
#else
        EpiResid E{(const float*)(ws + WS_H1), (float*)(ws + WS_H2), nullptr, nullptr, nullptr, 1.f / 8192.f};
#endif
        pg8::gemm_phase<EpiResid, SchedDense, false, true, true>(F.lds + RING_OFF, 8, S, E);
    }
    SEAM(7);
    if (IN(8)) { FRESH(); p8_route(F, args); }
    SEAM(8);
    if (IN(9)) { FRESH();
        moe_tables(F);
        SchedMoe<16> S{F.G, F.vcu, ws, F.MISC, ldsu(F.MISC + 112) * 16};
        EpiMoe1 E{(unsigned char*)(ws + WS_ACT), args.in(I_B1)};
        pg8::gemm_phase<EpiMoe1, SchedMoe<16>, false, true, true>(F.lds + RING_OFF, 16, S, E);
        __syncthreads();
        conv_queue(F, args, CW_QCONV2, CV_NJ - CV_TAIL2, CV_TAIL2);
    }
    SEAM(9);
    if (IN(10)) { FRESH();
        moe_tables(F);
        SchedMoe<8> S{F.G, F.vcu, ws, F.MISC, ldsu(F.MISC + 112) * 8};
        EpiMoe2 E{(bf16_t*)(ws + WS_Y), args.in(I_B2), (const float*)(ws + WS_GATEOF)};
        pg8::gemm_phase<EpiMoe2, SchedMoe<8>, false, true, true>(F.lds + RING_OFF, 16, S, E);
    }
    SEAM(10);
    if (IN(11)) { FRESH(); p11_combine(F, args); }
#undef IN
#undef SEAM
}

extern "C" void kernel_launch(void* const* d_in, const int* in_sizes, int n_in, void* d_out, int out_size, void* d_ws, size_t ws_size, hipStream_t stream) {
    static int grid = 0;
    if (grid == 0) {
        if (n_in != 32 || out_size != NTOK * 2048 || ws_size < WS_END) { fprintf(stderr, "kernel_launch: unexpected shapes (n_in %d out %d ws %zu); nothing launched\n", n_in, out_size, ws_size); grid = -1; return; }
        int dev = 0, cus = 0, per_cu = 0;
        if (hipGetDevice(&dev) != hipSuccess || hipDeviceGetAttribute(&cus, hipDeviceAttributeMultiprocessorCount, dev) != hipSuccess) { grid = -1; return; }
        if (hipFuncSetAttribute((const void*)mega_fwd, hipFuncAttributeMaxDynamicSharedMemorySize, LDS_BYTES) != hipSuccess) { fprintf(stderr, "kernel_launch: hipFuncSetAttribute failed\n"); grid = -1; return; }
        if (hipOccupancyMaxActiveBlocksPerMultiprocessor(&per_cu, (const void*)mega_fwd, NWAVES * 64, LDS_BYTES) != hipSuccess || per_cu < 1) { fprintf(stderr, "kernel_launch: occupancy query says %d\n", per_cu); }
        (void)hipGetLastError();
        if (cus < 256) { fprintf(stderr, "kernel_launch: needs 256 CUs, found %d; nothing launched\n", cus); grid = -1; return; }
        grid = 256;
    }
    if (grid < 0) return;
    if (hipMemsetAsync((char*)d_ws + WS_CTL, 0, CTL_ZERO_BYTES, stream) != hipSuccess) return;
    Args a{};
    for (int i = 0; i < 32; ++i) a.in[i] = (const float*)d_in[i];
    a.out = (float*)d_out; a.ws = (unsigned char*)d_ws;
#if MK_PER_PHASE
    for (int p = 0; p < N_PHASES; ++p) { a.ph_lo = p; a.ph_hi = p + 1; hipLaunchKernelGGL(mega_fwd, dim3(grid), dim3(NWAVES * 64), LDS_BYTES, stream, a); }
#else
    a.ph_lo = 0; a.ph_hi = N_PHASES;
    hipLaunchKernelGGL(mega_fwd, dim3(grid), dim3(NWAVES * 64), LDS_BYTES, stream, a);
#ifdef MK_PROBE_LO
    for (int p = MK_PROBE_LO; p < MK_PROBE_HI; ++p) { a.ph_lo = p; a.ph_hi = p + 1; hipLaunchKernelGGL(mega_fwd, dim3(grid), dim3(NWAVES * 64), LDS_BYTES, stream, a); }
#endif
#endif
}
```

```cpp
#define MK_PER_PHASE 0
#define MK_LAST_PHASE 12
#include <hip/hip_runtime.h>
#include <hip/hip_bf16.h>
#include <cstdio>
#include <cstdint>
#include <cmath>

#define GAS __attribute__((address_space(1)))
#define LAS __attribute__((address_space(3)))
typedef unsigned short bf16_t;
typedef short bf16x8 __attribute__((ext_vector_type(8)));
typedef float f32x2 __attribute__((ext_vector_type(2)));
typedef float f32x4 __attribute__((ext_vector_type(4)));
typedef float f32x16 __attribute__((ext_vector_type(16)));
typedef unsigned u32x2 __attribute__((ext_vector_type(2)));
typedef unsigned u32x4 __attribute__((ext_vector_type(4)));
typedef __bf16 bf16x2_t __attribute__((ext_vector_type(2)));

#define DI __device__ __forceinline__
DI unsigned pk2(float lo, float hi) { f32x2 v = {lo, hi}; bf16x2_t b = __builtin_convertvector(v, bf16x2_t); return __builtin_bit_cast(unsigned, b); }
DI float bflo(unsigned u) { return __uint_as_float(u << 16); }
DI float bfhi(unsigned u) { return __uint_as_float(u & 0xffff0000u); }
DI float bf2f(bf16_t h) { return __uint_as_float(((unsigned)h) << 16); }
DI float wave_sum(float v) {
#pragma unroll
    for (int o = 1; o < 64; o <<= 1) v += __shfl_xor(v, o);
    return v;
}
DI float quad_sum_16_32(float v) {
    int l_ = threadIdx.x; asm volatile("" : "+v"(l_));
    const int a16 = ((l_ ^ 16) & 63) << 2, a32 = ((l_ ^ 32) & 63) << 2;
    v += __builtin_bit_cast(float, __builtin_amdgcn_ds_bpermute(a16, __builtin_bit_cast(int, v)));
    v += __builtin_bit_cast(float, __builtin_amdgcn_ds_bpermute(a32, __builtin_bit_cast(int, v)));
    return v;
}
DI float siluf(float x) { return x / (1.f + __expf(-x)); }

constexpr int DM_ = 2048, NB = 4, SEQ_ = 2048, NTOK = NB * SEQ_;
constexpr int PP = 5632;
constexpr int PC_XBC = 1024, PC_Q = 2560, PC_K = 3584, PC_V = 4608, PC_DT = 5632;
constexpr int WIN_ROWS = 5888;
constexpr int NEXP = 32, MEMLEN = 256;
constexpr float EPS_ = 1e-6f;
constexpr float LAM_INIT = 0.2f;

namespace pg8 {
constexpr int BM = 256, BK = 64, HALF = 128, HTB = HALF * BK * 2  , STAGE_BYTES = 8 * HTB;
DI int lds_byte(int r, int c) { const int st = (r >> 4) * 2 + (c >> 5), rr = r & 15, cc = c & 31, ob = rr * 64 + cc * 2; return st * 1024 + (ob ^ (((ob >> 9) & 1) << 5)); }
DI void stage_rc(int b, int& R, int& C) { const int st = b / 1024, sb = b % 1024, swz = sb ^ (((sb >> 9) & 1) << 5); R = (st >> 1) * 16 + swz / 64; C = (st & 1) * 32 + (swz % 64) / 2; }
DI int perm32(int rho) { const int n = rho >> 4, i = rho & 15; return 8 * (i >> 2) + 4 * n + (i & 3); }

struct UnitD {
    const char* A; const char* B;
    const int* rows;
    unsigned lda, ldb;
    int nvalid;
    int type, pm, pn, e, x0;
};
typedef int v8i_t __attribute__((ext_vector_type(8)));
DI v8i_t cat8(bf16x8 lo, bf16x8 hi) { typedef int v4i_t __attribute__((ext_vector_type(4))); const v4i_t a = __builtin_bit_cast(v4i_t, lo), b = __builtin_bit_cast(v4i_t, hi); return (v8i_t){a[0], a[1], a[2], a[3], b[0], b[1], b[2], b[3]}; }
DI void dense_voff(unsigned lda, unsigned ldb, int tid, unsigned (&vA)[2], unsigned (&vB)[2]) {
#pragma unroll
    for (int i = 0; i < 2; ++i) { int R, C; stage_rc(tid * 16 + i * 8192, R, C); const int Rb = (R & ~31) + perm32(R & 31);
        vA[i] = (unsigned)R * lda + (unsigned)C * 2u; vB[i] = (unsigned)Rb * ldb + (unsigned)C * 2u; }
}
DI void gather_voff(const UnitD& u, int tid, unsigned (&gA)[2][2]) {
#pragma unroll
    for (int i = 0; i < 2; ++i) { int R, C; stage_rc(tid * 16 + i * 8192, R, C);
#pragma unroll
        for (int h = 0; h < 2; ++h) { const int ra = h * 128 + R; const unsigned rowA = (ra < u.nvalid) ? (unsigned)u.rows[ra] : 0u; gA[h][i] = rowA * u.lda + (unsigned)C * 2u; } }
}

template <class Epi, class Sched, bool GATHER, bool ALIGN_EPI, bool FP8 = false>
DI void gemm_phase(LAS unsigned char* lds, int nt, const Sched& S, const Epi& E) {

    const int tid = threadIdx.x, wid = __builtin_amdgcn_readfirstlane(tid >> 6), lane = tid & 63, wr = wid >> 2, wc = wid & 3, fr = lane & 15, fq = lane >> 4;
    const size_t kstep = (size_t)(BK * 2);
    const unsigned ldsb = (unsigned)__builtin_amdgcn_readfirstlane((int)((unsigned)(uintptr_t)lds + (unsigned)wid * 1024u));
    const int aoff = lds_byte(wr * 64 + fr, fq * 8), boff = lds_byte(wc * 32 + fr, fq * 8);
#define PG8_SA(b, h) (((b) * 2 + (h)) * HTB)
#define PG8_SB(b, h) ((4 + (b) * 2 + (h)) * HTB)
#define PG8_STAGE(bufoff, gbase, voff) do { _Pragma("unroll") for (int _i = 0; _i < 2; ++_i) { unsigned keep_; \
        asm volatile("s_mov_b32 %0, m0\n\ts_mov_b32 m0, %3\n\ts_nop 0\n\tglobal_load_lds_dwordx4 %1, %2\n\ts_mov_b32 m0, %0" \
                     : "=&s"(keep_) : "v"((voff)[_i]), "s"((const char*)(gbase)), "s"(ldsb + (unsigned)((bufoff) + _i * 8192)) : "memory"); } } while (0)
#define PG8_STA(bufoff, gbase, h, HS, GA) do { if constexpr (GATHER) { PG8_STAGE(bufoff, gbase, GA[h]); } else { PG8_STAGE(bufoff, (gbase) + (h) * (HS), vA); } } while (0)
#define PG8_STB(bufoff, gbase, h, HS) PG8_STAGE(bufoff, (gbase) + (h) * (HS), vB)
typedef int v4i_t __attribute__((ext_vector_type(4)));
#define PG8_LDA(dst, b, h) do { _Pragma("unroll") for (int m = 0; m < 4; ++m) { if constexpr (FP8) { \
            const v4i_t lo_ = *(const LAS v4i_t*)(lds + PG8_SA(b, h) + aoff + m * 2048), hi_ = *(const LAS v4i_t*)(lds + PG8_SA(b, h) + aoff + m * 2048 + 1024); \
            dst##8[m] = __builtin_shufflevector(lo_, hi_, 0, 1, 2, 3, 4, 5, 6, 7); } \
        else { _Pragma("unroll") for (int k = 0; k < 2; ++k) dst[m][k] = *(const LAS bf16x8*)(lds + PG8_SA(b, h) + aoff + m * 2048 + k * 1024); } } } while (0)
#define PG8_LDB(dst, b, h) do { _Pragma("unroll") for (int n = 0; n < 2; ++n) { if constexpr (FP8) { \
            const v4i_t lo_ = *(const LAS v4i_t*)(lds + PG8_SB(b, h) + boff + n * 2048), hi_ = *(const LAS v4i_t*)(lds + PG8_SB(b, h) + boff + n * 2048 + 1024); \
            dst##8[n] = __builtin_shufflevector(lo_, hi_, 0, 1, 2, 3, 4, 5, 6, 7); } \
        else { _Pragma("unroll") for (int k = 0; k < 2; ++k) dst[n][k] = *(const LAS bf16x8*)(lds + PG8_SB(b, h) + boff + n * 2048 + k * 1024); } } } while (0)
#ifndef PG8_FP8_PRIO
#define PG8_FP8_PRIO 1
#endif
#define PG8_MMA(ai, bj, At, Bt) do { if (!FP8 || PG8_FP8_PRIO) __builtin_amdgcn_s_setprio(1); _Pragma("unroll") for (int m = 0; m < 4; ++m) _Pragma("unroll") for (int n = 0; n < 2; ++n) { \
        if constexpr (FP8) { acc[ai][bj][m][n] = __builtin_amdgcn_mfma_scale_f32_16x16x128_f8f6f4(Bt##8[n], At##8[m], acc[ai][bj][m][n], 0, 0, 0, 0x7f7f7f7f, 0, 0x7f7f7f7f); } \
        else { _Pragma("unroll") for (int k = 0; k < 2; ++k) acc[ai][bj][m][n] = __builtin_amdgcn_mfma_f32_16x16x32_bf16(Bt[n][k], At[m][k], acc[ai][bj][m][n], 0, 0, 0); } } \
        if (!FP8 || PG8_FP8_PRIO) __builtin_amdgcn_s_setprio(0); } while (0)
#define PG8_WAIT_V(n) asm volatile("s_waitcnt vmcnt(" #n ")" ::: "memory")
#define PG8_WAIT_L(n) asm volatile("s_waitcnt lgkmcnt(" #n ")" ::: "memory")
#define PG8_BAR __builtin_amdgcn_s_barrier()
#define PG8_SCHED __builtin_amdgcn_sched_barrier(0)
#define PG8_ITER(A1P, A2P, B2P, HA2, HB2, GA2) do { \
        const char* a3p_ = (A2P) + kstep; const char* b3p_ = (B2P) + kstep; \
        PG8_LDB(B0, 0, 0); PG8_LDB(B1, 0, 1); PG8_SCHED; PG8_LDA(At, 0, 0); PG8_STA(PG8_SA(1, 1), (A1P), 1, hsA, gA); \
        PG8_WAIT_V(8); PG8_WAIT_L(0); PG8_BAR; PG8_MMA(0, 0, At, B0); PG8_MMA(0, 1, At, B1); PG8_BAR; PG8_SCHED; \
        PG8_LDA(At, 0, 1); PG8_STB(PG8_SB(0, 0), (B2P), 0, HB2); PG8_STB(PG8_SB(0, 1), (B2P), 1, HB2); PG8_STA(PG8_SA(0, 0), (A2P), 0, HA2, GA2); \
        PG8_WAIT_V(8); PG8_WAIT_L(0); PG8_BAR; PG8_MMA(1, 0, At, B0); PG8_MMA(1, 1, At, B1); PG8_BAR; PG8_SCHED; \
        PG8_LDB(B0, 1, 0); PG8_LDB(B1, 1, 1); PG8_SCHED; PG8_LDA(At, 1, 0); PG8_STA(PG8_SA(0, 1), (A2P), 1, HA2, GA2); \
        PG8_WAIT_V(8); PG8_WAIT_L(0); PG8_BAR; PG8_MMA(0, 0, At, B0); PG8_MMA(0, 1, At, B1); PG8_BAR; PG8_SCHED; \
        PG8_LDA(At, 1, 1); PG8_STB(PG8_SB(1, 0), b3p_, 0, HB2); PG8_STB(PG8_SB(1, 1), b3p_, 1, HB2); PG8_STA(PG8_SA(1, 0), a3p_, 0, HA2, GA2); \
        PG8_WAIT_V(8); PG8_WAIT_L(0); PG8_BAR; PG8_MMA(1, 0, At, B0); PG8_MMA(1, 1, At, B1); PG8_BAR; PG8_SCHED; \
    } while (0)
    UnitD cur, nxt; int ui = 0;
    if (!S.next(0, cur)) return;
    f32x4 acc[2][2][4][2];
#pragma unroll
    for (int a = 0; a < 2; ++a)
#pragma unroll
        for (int b = 0; b < 2; ++b)
#pragma unroll
            for (int m = 0; m < 4; ++m)
#pragma unroll
                for (int n = 0; n < 2; ++n) acc[a][b][m][n] = (f32x4){0.f, 0.f, 0.f, 0.f};
    bf16x8 At[4][2], B0[2][2], B1[2][2]; v8i_t At8[4], B08[2], B18[2];
    unsigned vA[2], vB[2], gA[2][2], ngA[2][2];
    dense_voff(cur.lda, cur.ldb, tid, vA, vB);
    if constexpr (GATHER) gather_voff(cur, tid, gA);
    const char* cA = cur.A; const char* cB = cur.B;
    size_t hsA = GATHER ? 0 : (size_t)cur.lda * HALF, hsB = (size_t)cur.ldb * HALF;
    PG8_STB(PG8_SB(0, 0), cB, 0, hsB); PG8_STB(PG8_SB(0, 1), cB, 1, hsB); PG8_STA(PG8_SA(0, 0), cA, 0, hsA, gA); PG8_STA(PG8_SA(0, 1), cA, 1, hsA, gA);
    if (wr == 1) PG8_BAR;
    PG8_WAIT_V(2); PG8_BAR;
    PG8_STB(PG8_SB(1, 0), cB + kstep, 0, hsB); PG8_STA(PG8_SA(1, 0), cA + kstep, 0, hsA, gA); PG8_STB(PG8_SB(1, 1), cB + kstep, 1, hsB);
    PG8_WAIT_V(6); PG8_BAR;
    for (;;) {
        const bool has_next = S.next(ui + 1, nxt);
        const char* nA = cA; const char* nB = cB; size_t nhsA = hsA, nhsB = hsB;
        if (has_next) { nA = nxt.A; nB = nxt.B; nhsA = GATHER ? 0 : (size_t)nxt.lda * HALF; nhsB = (size_t)nxt.ldb * HALF; }
        if constexpr (GATHER) {
            if (has_next) gather_voff(nxt, tid, ngA);
            else {
#pragma unroll
                for (int h = 0; h < 2; ++h)
#pragma unroll
                    for (int i = 0; i < 2; ++i) ngA[h][i] = gA[h][i];
            }
        }
#pragma unroll 1
        for (int t = 0; t < nt; t += 2) {
            const bool last = (t == nt - 2);
            const char* a2 = last ? nA : cA + (size_t)(t + 2) * kstep; const char* b2 = last ? nB : cB + (size_t)(t + 2) * kstep;
            const size_t hA2 = last ? nhsA : hsA, hB2 = last ? nhsB : hsB;
            unsigned g2[2][2];
            if constexpr (GATHER) {
#pragma unroll
                for (int h = 0; h < 2; ++h)
#pragma unroll
                    for (int i = 0; i < 2; ++i) g2[h][i] = last ? ngA[h][i] : gA[h][i];
            }
            PG8_ITER(cA + (size_t)(t + 1) * kstep, a2, b2, hA2, hB2, g2);
        }
        if constexpr (ALIGN_EPI) { if (wr == 0) PG8_BAR; }
        if constexpr (!Epi::AFTER_DRAIN) { E(acc, cur, wr, wc, fr, fq); }
        if (!has_next) break;
#pragma unroll
        for (int a = 0; a < 2; ++a)
#pragma unroll
            for (int b = 0; b < 2; ++b)
#pragma unroll
                for (int m = 0; m < 4; ++m)
#pragma unroll
                    for (int n = 0; n < 2; ++n) acc[a][b][m][n] = (f32x4){0.f, 0.f, 0.f, 0.f};
        cur = nxt; cA = nA; cB = nB; hsA = nhsA; hsB = nhsB; ++ui;
        if constexpr (GATHER) {
#pragma unroll
            for (int h = 0; h < 2; ++h)
#pragma unroll
                for (int i = 0; i < 2; ++i) gA[h][i] = ngA[h][i];
        }
        if constexpr (ALIGN_EPI) { if (wr == 1) PG8_BAR; }
    }
    PG8_WAIT_V(0);
    if constexpr (!ALIGN_EPI) { if (wr == 0) PG8_BAR; }
    PG8_BAR;
    if constexpr (Epi::AFTER_DRAIN) { E.fused(acc, cur, wr, wc, fr, fq, lds, wid, lane); }
#undef PG8_SA
#undef PG8_SB
#undef PG8_STAGE
#undef PG8_STA
#undef PG8_STB
#undef PG8_LDA
#undef PG8_LDB
#undef PG8_MMA
#undef PG8_WAIT_V
#undef PG8_WAIT_L
#undef PG8_BAR
#undef PG8_SCHED
#undef PG8_ITER
}
}
namespace attn_body {
using bf16=__hip_bfloat16;
using bf16x8=__attribute__((ext_vector_type(8)))short;
using s16x4=__attribute__((ext_vector_type(4)))short;
using f32x16=__attribute__((ext_vector_type(16)))float;
using u32x4=__attribute__((ext_vector_type(4)))unsigned;
constexpr int BATCH=4,SEQ=2048,D=64,DM=5632,OPITCH=1024;
constexpr int NW=8,QBLK=32,QB=QBLK*NW,KVBLK=64,NQB=SEQ/QB;
constexpr int ATTN_UNIT_ROWS=QB;
__device__ __forceinline__ int crow(int r,int hi){return (r&3)+8*(r>>2)+4*hi;}
#define SBAR() __builtin_amdgcn_sched_barrier(0)
__device__ __forceinline__ void cmask(f32x16&p0,f32x16&p1,int jb,int qrel,int hi){
  const float NEG=-INFINITY; int kb=64*jb+4*hi;
  #pragma unroll
  for(int r=0;r<16;++r){int kv=kb+(r&3)+8*(r>>2); if(kv>qrel)p0[r]=NEG; if(kv+32>qrel)p1[r]=NEG;}
}

constexpr int NSLOT=3, SLOTB=8192;
constexpr int LDS_K=0, LDS_V=NSLOT*SLOTB, LDS_WS=2*NSLOT*SLOTB, LDS_OST=LDS_WS+NW*64*4, LDS_BYTES=LDS_OST+NW*4096;
constexpr float C2=0.125f*1.4426950408889634f;
__device__ __forceinline__ void glds16(const void*gsrc,unsigned lds_dst){unsigned keep;
  asm volatile("s_mov_b32 %0, m0\n\ts_mov_b32 m0, %2\n\ts_nop 0\n\tglobal_load_lds_dwordx4 %1, off\n\ts_mov_b32 m0, %0":"=&s"(keep):"v"(gsrc),"s"(lds_dst):"memory");}
__device__ __forceinline__ float max3f(float a,float b,float c){float r;asm("v_max3_f32 %0, %1, %2, %3":"=v"(r):"v"(a),"v"(b),"v"(c));return r;}
__device__ __forceinline__ float max2f(float a,float b){float r;asm("v_max_f32_e32 %0, %1, %2":"=v"(r):"v"(a),"v"(b));return r;}
__device__ __forceinline__ float fadd_s(float a,float b){float r;asm("v_add_f32_e32 %0, %1, %2":"=v"(r):"v"(a),"v"(b));return r;}
__device__ __forceinline__ float fsub_s(float a,float b){float r;asm("v_sub_f32_e32 %0, %1, %2":"=v"(r):"v"(a),"v"(b));return r;}
typedef float f32x2_t __attribute__((ext_vector_type(2))); typedef __bf16 bf16x2_t __attribute__((ext_vector_type(2)));
__device__ __forceinline__ unsigned cvtpk_s(float lo,float hi){f32x2_t v={lo,hi};bf16x2_t b=__builtin_convertvector(v,bf16x2_t);return __builtin_bit_cast(unsigned,b);}
#define WAIT_BAR(N) asm volatile("s_waitcnt vmcnt(" #N ") lgkmcnt(0)\n\ts_barrier":::"memory")

__device__ __forceinline__ void qkt(f32x16&p0,f32x16&p1,const char*Kslot,const bf16x8*qr,const f32x16&negm,int r32,int hi){
  const char*kb=Kslot+hi*1024+r32*16;
  #pragma unroll
  for(int d0=0;d0<4;++d0){
    const bf16x8 b0=*reinterpret_cast<const bf16x8*>(kb+d0*2048);
    const bf16x8 b1=*reinterpret_cast<const bf16x8*>(kb+d0*2048+512);
    if(d0==0){p0=__builtin_amdgcn_mfma_f32_32x32x16_bf16(b0,qr[0],negm,0,0,0);p1=__builtin_amdgcn_mfma_f32_32x32x16_bf16(b1,qr[0],negm,0,0,0);}
    else{p0=__builtin_amdgcn_mfma_f32_32x32x16_bf16(b0,qr[d0],p0,0,0,0);p1=__builtin_amdgcn_mfma_f32_32x32x16_bf16(b1,qr[d0],p1,0,0,0);}}
}
typedef __attribute__((address_space(3))) const char* lds_cptr;
typedef short v4i16_t __attribute__((ext_vector_type(4)));
__device__ __forceinline__ void kload8(bf16x8*kf,lds_cptr kp){
  kf[0]=*(const __attribute__((address_space(3))) bf16x8*)(kp);      kf[1]=*(const __attribute__((address_space(3))) bf16x8*)(kp+512);
  kf[2]=*(const __attribute__((address_space(3))) bf16x8*)(kp+2048); kf[3]=*(const __attribute__((address_space(3))) bf16x8*)(kp+2560);
  kf[4]=*(const __attribute__((address_space(3))) bf16x8*)(kp+4096); kf[5]=*(const __attribute__((address_space(3))) bf16x8*)(kp+4608);
  kf[6]=*(const __attribute__((address_space(3))) bf16x8*)(kp+6144); kf[7]=*(const __attribute__((address_space(3))) bf16x8*)(kp+6656);
}
__device__ __forceinline__ void kload2(bf16x8*kf,lds_cptr kp,int j){ kf[2*j]=*(const __attribute__((address_space(3))) bf16x8*)(kp+j*2048); kf[2*j+1]=*(const __attribute__((address_space(3))) bf16x8*)(kp+j*2048+512); }
__device__ __forceinline__ s16x4 vtr(lds_cptr p){ return __builtin_bit_cast(s16x4,__builtin_amdgcn_ds_read_tr16_b64_v4i16((__attribute__((address_space(3))) v4i16_t*)p)); }
__device__ __forceinline__ float rowmax(const f32x16&p0,const f32x16&p1){
  float a=max3f(p0[0],p0[1],p1[0]),b=max3f(p0[2],p0[3],p1[1]);a=max3f(a,p1[2],p1[3]);
  #pragma unroll
  for(int r=4;r<16;r+=4){a=max3f(a,p0[r],p0[r+1]);b=max3f(b,p0[r+2],p0[r+3]);a=max3f(a,p1[r],p1[r+1]);b=max3f(b,p1[r+2],p1[r+3]);}
  const float m=max2f(a,b);
  auto rr=__builtin_amdgcn_permlane32_swap(__float_as_uint(m),__float_as_uint(m),false,false);
  return max2f(__uint_as_float(rr[0]),__uint_as_float(rr[1]));
}
__device__ __forceinline__ void pv(f32x16*o,int vb,bf16x8 pa0,bf16x8 pa1,bf16x8 pa2,bf16x8 pa3){
  #pragma unroll
  for(int d0=0;d0<2;++d0){s16x4 lo[4],hi[4];
    #pragma unroll
    for(int ks=0;ks<4;++ks){
      asm volatile("ds_read_b64_tr_b16 %0,%1 offset:%c2":"=&v"(lo[ks]):"v"(vb),"i"(d0*4096+ks*1024):"memory");
      asm volatile("ds_read_b64_tr_b16 %0,%1 offset:%c2":"=&v"(hi[ks]):"v"(vb),"i"(d0*4096+ks*1024+512):"memory");}
    asm volatile("s_waitcnt lgkmcnt(0)":::"memory");SBAR();
    #define PK(k) (bf16x8){lo[k][0],lo[k][1],lo[k][2],lo[k][3],hi[k][0],hi[k][1],hi[k][2],hi[k][3]}
    o[d0]=__builtin_amdgcn_mfma_f32_32x32x16_bf16(pa0,PK(0),o[d0],0,0,0);
    o[d0]=__builtin_amdgcn_mfma_f32_32x32x16_bf16(pa1,PK(1),o[d0],0,0,0);
    o[d0]=__builtin_amdgcn_mfma_f32_32x32x16_bf16(pa2,PK(2),o[d0],0,0,0);
    o[d0]=__builtin_amdgcn_mfma_f32_32x32x16_bf16(pa3,PK(3),o[d0],0,0,0);
    #undef PK
  }
}

#ifndef ATTN_STORE16
#define ATTN_STORE16(p,v) (*(u32x4*)(p)=(v))
#endif
template<int THRL> __device__ __forceinline__ void attn_unit(int b,int qcol,int vcol,int ocol,int qb,const bf16*Q,const bf16*__restrict__ K,const bf16*__restrict__ V,bf16*O,char*shm){
  const int tid=threadIdx.x,lane=tid&63,r32=lane&31,hi=lane>>5; const int wid=__builtin_amdgcn_readfirstlane(tid>>6);
  const long rowbase=(long)b*SEQ; const int q0=qb*QB;
  const bf16*Qw=Q+(rowbase+q0+wid*QBLK)*DM+qcol;
  const bf16*Kh=K+rowbase*DM+qcol,*Vh=V+rowbase*DM+vcol;
  const unsigned lds0=(unsigned)(uintptr_t)shm;
  float*wsf=(float*)(shm+LDS_WS)+wid*64;
  const bf16*ksrc=Kh+(long)lane*DM+wid*8;
  const bf16*vsrc=Vh+(long)(16*(wid&3)+(lane>>2))*DM+(wid>>2)*32+(lane&3)*8;
  const unsigned kdst=lds0+LDS_K+wid*1024, vdst=lds0+LDS_V+wid*1024;
  #define DMA_K(t,slot) glds16(ksrc+(long)(t)*KVBLK*DM,(unsigned)__builtin_amdgcn_readfirstlane(kdst+(slot)))
  #define DMA_V(t,slot) glds16(vsrc+(long)(t)*KVBLK*DM,(unsigned)__builtin_amdgcn_readfirstlane(vdst+(slot)))
  const int vb0=(int)(lds0+LDS_V)+((lane>>4)&1)*32+(lane&3)*8+(4*hi+((lane&15)>>2))*64;
  const char*Kbase=shm+LDS_K; bf16x8 kf[8];
  const lds_cptr shm3=(lds_cptr)shm; const lds_cptr kp0=shm3+LDS_K+hi*1024+r32*16; const lds_cptr vp0=shm3+LDS_V+((lane>>4)&1)*32+(lane&3)*8+(4*hi+((lane&15)>>2))*64;
  const int NT=(q0+QB)/KVBLK;
  DMA_K(0,0);DMA_V(0,0);DMA_K(1,SLOTB);
  bf16x8 qr[4];
  #pragma unroll
  for(int d0=0;d0<4;++d0)qr[d0]=*reinterpret_cast<const bf16x8*>(&Qw[(long)r32*DM+d0*16+hi*8]);
  float mhat=0.f,l_reg=0.f;f32x16 o[2];o[0]=f32x16{};o[1]=f32x16{};f32x16 negm=f32x16{};asm volatile("":"+v"(negm));
  const int qrel=wid*QBLK+r32;
  #define CMASK(P0,P1,t) do{int jb_=(t)-(NT-4); if(jb_>=0)cmask(P0,P1,jb_,qrel,hi);}while(0)
  bool resc=false;
  #define START(P0,P1) do{ const float rm=rowmax(P0,P1); resc=false; \
    { const float dl=rm; mhat=fadd_s(mhat,dl); \
      _Pragma("unroll") for(int r=0;r<16;++r){P0[r]=fsub_s(P0[r],dl);P1[r]=fsub_s(P1[r],dl);} \
      _Pragma("unroll") for(int r=0;r<16;++r)negm[r]=-mhat; asm volatile("":"+v"(negm)); } \
    _Pragma("unroll") for(int r=0;r<16;++r)P0[r]=__builtin_amdgcn_exp2f(P0[r]); }while(0)
  #define RESC() do{ if(resc){ asm volatile("s_waitcnt lgkmcnt(0)":::"memory"); \
      _Pragma("unroll") for(int d_=0;d_<2;++d_) _Pragma("unroll") for(int r=0;r<16;++r)o[d_][r]*=wsf[crow(r,hi)]; } }while(0)
  f32x16 pA0,pA1,pB0,pB1;
  int sl_prev=0,sl_cur=0,sl_next=SLOTB;
  #define ROT() do{sl_prev=sl_cur;sl_cur=sl_next;sl_next=(sl_next==(NSLOT-1)*SLOTB)?0:sl_next+SLOTB;}while(0)
  DMA_K(2,2*SLOTB);
  WAIT_BAR(3);
  qkt(pA0,pA1,Kbase,qr,negm,r32,hi);asm volatile("s_nop 15\n\ts_nop 7":"+v"(pA0),"+v"(pA1));CMASK(pA0,pA1,0);
  START(pA0,pA1);
  _Pragma("unroll") for(int r=0;r<16;++r)pA1[r]=__builtin_amdgcn_exp2f(pA1[r]);
  WAIT_BAR(0);
  DMA_K(3,0);DMA_V(1,SLOTB);
  ROT();
  kload8(kf,kp0+sl_cur);
  WAIT_BAR(2);
  s16x4 vlo[8],vhi[8]; u32x4 pw0,pw1,pw2,pw3;
  #define PKW(P,B) cvtpk_s(P[B],P[B+1])
  #define PAF(k) __builtin_bit_cast(bf16x8,pw##k)
  #define VFR(i) (bf16x8){vlo[i][0],vlo[i][1],vlo[i][2],vlo[i][3],vhi[i][0],vhi[i][1],vhi[i][2],vhi[i][3]}
  #define PIN(x) asm volatile("":"+v"(x))
  #define MX3(a,b,c) __builtin_fmaxf(__builtin_fmaxf((a),(b)),(c))
  #define GAPA(MF,A0,A1,A2,A3,W0,W1,PW) do{ MF; sacc+=A0; sacc+=A1; sacc+=A2; sacc+=A3; PIN(sacc); W0; W1; PIN(PW); SBAR(); }while(0)
  #define EX(v) __builtin_amdgcn_exp2f(v)
  #define GAPB(MF,X,B) do{ MF; X[B]=EX(X[B]); X[B+1]=EX(X[B+1]); X[B+2]=EX(X[B+2]); X[B+3]=EX(X[B+3]); PIN(X); SBAR(); }while(0)
  #define VRD(i) do{ vlo[i]=vtr(vp_+(((i)>>2)*4096+((i)&3)*1024)); vhi[i]=vtr(vp_+(((i)>>2)*4096+((i)&3)*1024+512)); }while(0)
  #define KRD(G,j) do{ if(G){ kload2(kf,kp0+sl_next,j); SBAR(); } }while(0)
  #define STEP(C0,C1,P0,P1,t,GK,GV,GL) do{ SBAR(); \
    const lds_cptr vp_=vp0+sl_prev; \
    VRD(0); SBAR(); float sacc=(P0[0]+P0[1]); \
    GAPA(C0=__builtin_amdgcn_mfma_f32_32x32x16_bf16(kf[0],qr[0],negm,0,0,0), P0[2],P0[3],P0[4],P0[5],     pw0[0]=PKW(P0,0), pw0[1]=PKW(P0,2), pw0); \
    VRD(4); SBAR(); GAPA(C1=__builtin_amdgcn_mfma_f32_32x32x16_bf16(kf[1],qr[0],negm,0,0,0), P0[6],P0[7],P0[8],P0[9],     pw0[2]=PKW(P0,4), pw0[3]=PKW(P0,6), pw0); \
    VRD(1); SBAR(); GAPA(C0=__builtin_amdgcn_mfma_f32_32x32x16_bf16(kf[2],qr[1],C0,0,0,0),   P0[10],P0[11],P0[12],P0[13], pw1[0]=PKW(P0,8), pw1[1]=PKW(P0,10), pw1); \
    VRD(5); SBAR(); GAPA(C1=__builtin_amdgcn_mfma_f32_32x32x16_bf16(kf[3],qr[1],C1,0,0,0),   P0[14],P0[15],P1[0],P1[1],   pw1[2]=PKW(P0,12),pw1[3]=PKW(P0,14), pw1); \
    VRD(2); SBAR(); GAPA(C0=__builtin_amdgcn_mfma_f32_32x32x16_bf16(kf[4],qr[2],C0,0,0,0),   P1[2],P1[3],P1[4],P1[5],     pw2[0]=PKW(P1,0), pw2[1]=PKW(P1,2), pw2); \
    VRD(6); SBAR(); GAPA(C1=__builtin_amdgcn_mfma_f32_32x32x16_bf16(kf[5],qr[2],C1,0,0,0),   P1[6],P1[7],P1[8],P1[9],     pw2[2]=PKW(P1,4), pw2[3]=PKW(P1,6), pw2); \
    VRD(3); SBAR(); GAPA(C0=__builtin_amdgcn_mfma_f32_32x32x16_bf16(kf[6],qr[3],C0,0,0,0),   P1[10],P1[11],P1[12],P1[13], pw3[0]=PKW(P1,8), pw3[1]=PKW(P1,10), pw3); \
    VRD(7); SBAR(); GAPA(C1=__builtin_amdgcn_mfma_f32_32x32x16_bf16(kf[7],qr[3],C1,0,0,0),   P1[14],P1[15],0.f,0.f,       pw3[2]=PKW(P1,12),pw3[3]=PKW(P1,14), pw3); \
    l_reg+=sacc; \
    if(GK){DMA_K((t)+3,sl_cur);} if(GV){DMA_V((t)+1,sl_next);} \
    CMASK(C0,C1,t); \
    { float a=MX3(C0[0],C0[1],C1[0]),b=MX3(C0[2],C0[3],C1[1]); a=MX3(a,C1[2],C1[3]); \
      _Pragma("unroll") for(int r=4;r<16;r+=4){a=MX3(a,C0[r],C0[r+1]);b=MX3(b,C0[r+2],C0[r+3]);a=MX3(a,C1[r],C1[r+1]);b=MX3(b,C1[r+2],C1[r+3]);} \
      float rm=__builtin_fmaxf(a,b); { auto rr=__builtin_amdgcn_permlane32_swap(__float_as_uint(rm),__float_as_uint(rm),false,false); rm=__builtin_fmaxf(__uint_as_float(rr[0]),__uint_as_float(rr[1])); } \
      resc=false; \
      if(__builtin_expect(__any(rm>(float)THRL),0)){ const float dl=__builtin_fmaxf(rm,0.f); mhat+=dl; \
        _Pragma("unroll") for(int r=0;r<16;++r){C0[r]-=dl;C1[r]-=dl;} \
        _Pragma("unroll") for(int r=0;r<16;++r)negm[r]=-mhat; asm volatile("":"+v"(negm)); \
        const float f=__builtin_amdgcn_exp2f(-dl); l_reg*=f; if(hi==0)wsf[r32]=f; resc=true; } } \
    SBAR(); \
    GAPB(o[0]=__builtin_amdgcn_mfma_f32_32x32x16_bf16(PAF(0),VFR(0),o[0],0,0,0), C0,0); \
    GAPB(o[1]=__builtin_amdgcn_mfma_f32_32x32x16_bf16(PAF(0),VFR(4),o[1],0,0,0), C0,4); \
    KRD(GL,0); GAPB(o[0]=__builtin_amdgcn_mfma_f32_32x32x16_bf16(PAF(1),VFR(1),o[0],0,0,0), C0,8); \
    KRD(GL,1); GAPB(o[1]=__builtin_amdgcn_mfma_f32_32x32x16_bf16(PAF(1),VFR(5),o[1],0,0,0), C0,12); \
    KRD(GL,2); GAPB(o[0]=__builtin_amdgcn_mfma_f32_32x32x16_bf16(PAF(2),VFR(2),o[0],0,0,0), C1,0); \
    KRD(GL,3); GAPB(o[1]=__builtin_amdgcn_mfma_f32_32x32x16_bf16(PAF(2),VFR(6),o[1],0,0,0), C1,4); \
    GAPB(o[0]=__builtin_amdgcn_mfma_f32_32x32x16_bf16(PAF(3),VFR(3),o[0],0,0,0), C1,8); \
    GAPB(o[1]=__builtin_amdgcn_mfma_f32_32x32x16_bf16(PAF(3),VFR(7),o[1],0,0,0), C1,12); \
    }while(0)
  int t=1;
  #undef CMASK
  #define CMASK(P0,P1,t) do{}while(0)
  for(;t+5<NT;t+=2){
    STEP(pB0,pB1,pA0,pA1,t,true,true,true);     WAIT_BAR(2); RESC(); ROT();
    STEP(pA0,pA1,pB0,pB1,t+1,true,true,true);   WAIT_BAR(2); RESC(); ROT();
  }
  #undef CMASK
  #define CMASK(P0,P1,t) do{int jb_=(t)-(NT-4); if(jb_>=0)cmask(P0,P1,jb_,qrel,hi);}while(0)
  #define ENDW(tt) do{ if((tt)+3<NT){WAIT_BAR(2);} else if((tt)+2<NT){WAIT_BAR(1);} else {WAIT_BAR(0);} }while(0)
  for(;t+1<NT;t+=2){
    STEP(pB0,pB1,pA0,pA1,t,(t+3<NT),(t+1<NT),(t+1<NT));       ENDW(t);   RESC(); ROT();
    STEP(pA0,pA1,pB0,pB1,t+1,(t+4<NT),(t+2<NT),(t+2<NT));     ENDW(t+1); RESC(); ROT();
  }
  STEP(pB0,pB1,pA0,pA1,NT-1,false,false,false); RESC();
  { float sacc=pB0[0]+pB0[1]; _Pragma("unroll") for(int r=2;r<16;++r)sacc+=pB0[r]; _Pragma("unroll") for(int r=0;r<16;++r)sacc+=pB1[r]; l_reg+=sacc;
    pw0=(u32x4){PKW(pB0,0),PKW(pB0,2),PKW(pB0,4),PKW(pB0,6)};pw1=(u32x4){PKW(pB0,8),PKW(pB0,10),PKW(pB0,12),PKW(pB0,14)};pw2=(u32x4){PKW(pB1,0),PKW(pB1,2),PKW(pB1,4),PKW(pB1,6)};pw3=(u32x4){PKW(pB1,8),PKW(pB1,10),PKW(pB1,12),PKW(pB1,14)};
    SBAR(); pv(o,vb0+sl_cur,PAF(0),PAF(1),PAF(2),PAF(3)); }
  #undef PKW
  #undef PAF
  #undef VFR
  #undef PIN
  #undef MX3
  #undef GAPA
  #undef GAPB
  #undef EX
  #undef VRD
  #undef KRD
  #undef STEP
  #undef ENDW
  {auto rr=__builtin_amdgcn_permlane32_swap(__float_as_uint(l_reg),__float_as_uint(l_reg),false,false);l_reg=__uint_as_float(rr[0])+__uint_as_float(rr[1]);}
  if(hi==0)wsf[32+r32]=l_reg;asm volatile("s_waitcnt lgkmcnt(0)":::"memory");
  float rli[16];
  #pragma unroll
  for(int r=0;r<16;++r)rli[r]=__builtin_amdgcn_rcpf(wsf[32+crow(r,hi)]);
  bf16*Ow=O+(rowbase+q0+wid*QBLK)*OPITCH+ocol;
  { bf16*stg=(bf16*)(shm+LDS_OST)+wid*2048;
    #pragma unroll
    for(int r=0;r<16;++r){const int orow=crow(r,hi);
      #pragma unroll
      for(int d0=0;d0<2;++d0)stg[orow*64+d0*32+r32]=__float2bfloat16(o[d0][r]*rli[r]);}
    asm volatile("s_waitcnt lgkmcnt(0)":::"memory");
    #pragma unroll
    for(int i=0;i<4;++i){const int row=i*8+(lane>>3),ch=lane&7; const u32x4 v=*(const u32x4*)(stg+row*64+ch*8); ATTN_STORE16(Ow+(long)row*OPITCH+ch*8,v);} }
  asm volatile("s_waitcnt lgkmcnt(0)\n\ts_barrier":::"memory");
  #undef DMA_K
  #undef DMA_V
  #undef CMASK
  #undef START
  #undef RESC
  #undef ROT
}
constexpr int ATTN_LDS_BYTES=LDS_BYTES;
#undef SBAR
#undef WAIT_BAR
}
constexpr size_t MiB = 1u << 20;
constexpr size_t WS_CTL = 0, CTL_ZERO_BYTES = 1 * MiB;
constexpr size_t WS_WIN = 2 * MiB, WS_WOUT = 26 * MiB, WS_WQ = 34 * MiB, WS_WKV = 42 * MiB, WS_WO = 58 * MiB, WS_W1 = 66 * MiB, WS_W2 = 578 * MiB;
constexpr size_t WS_HN = 834 * MiB, WS_MN = 866 * MiB, WS_PROJ = 870 * MiB, WS_DT = 958 * MiB, WS_KVRAW = 959 * MiB, WS_KN = 967 * MiB;
constexpr size_t WS_YCAT = 971 * MiB, WS_O0 = 1003 * MiB, WS_O1 = 1019 * MiB, WS_H1 = 1035 * MiB, WS_H1B = 1099 * MiB, WS_PART1 = 1131 * MiB, WS_PARTQ = 1132 * MiB;
constexpr size_t WS_QRAW = 1133 * MiB, WS_P = 1165 * MiB, WS_VWT = 1181 * MiB, WS_H2 = 1197 * MiB, WS_HN3 = 1261 * MiB;
constexpr size_t WS_TOKOF = 1293 * MiB, WS_GATEOF = 1294 * MiB, WS_TOKE = 1295 * MiB, WS_TOKR = 1296 * MiB, WS_YG = 1297 * MiB;
constexpr size_t WS_H1F8 = 3368 * MiB  , WS_QF8 = 3384 * MiB  , WS_KN8 = 3400 * MiB  , WS_VF8 = 3402 * MiB  ;
constexpr size_t WS_P8 = 3404 * MiB  , WS_VWT8 = 3412 * MiB  ;
constexpr size_t WS_XG = 1320 * MiB  , WS_ACT = 1832 * MiB  , WS_Y = 2344 * MiB  , WS_END = 3420 * MiB;
constexpr int CW_BAR = 4096;
constexpr int CW_QCONV2 = 12416;
constexpr int CW_QCONV = 12352;
constexpr int CW_QATT = 12288;
constexpr int CW_CNT = 8192;
static_assert((CW_CNT + 64 * 32) * 4 <= (int)CTL_ZERO_BYTES, "CTL words inside the memset region");

constexpr int RING_OFF = 0, RING_BYTES = 131072;
constexpr int LDS_BYTES = 163840;
constexpr int MISC_OFF = 163840 - 1024;
constexpr int NWAVES = 8;

#define XB_TMO      128
#define XB_XCNT(j)  (256  + 64 * (j))
#define XB_XSUB(j)  (1280 + 64 * (j))
#define XB_XGEN(j)  (2304 + 64 * (j))
#define XB_TOP      3328
#define XB_TOPGEN   3392
#define XCD_BAR_WORDS 3456
#define XB_SPIN_CAP (1u << 20)

__device__ __forceinline__ unsigned xb_ld(unsigned* p)              { return __hip_atomic_load(p, __ATOMIC_RELAXED, __HIP_MEMORY_SCOPE_AGENT); }
__device__ __forceinline__ unsigned xb_add(unsigned* p, unsigned v) { return __hip_atomic_fetch_add(p, v, __ATOMIC_RELAXED, __HIP_MEMORY_SCOPE_AGENT); }
__device__ __forceinline__ unsigned xb_xcc_id() { return (unsigned)__builtin_amdgcn_s_getreg((3 << 11) | 20) & 0xFu; }
#define XB_SPIN(cond, bar) do { unsigned _sp = 0; while (cond) { __builtin_amdgcn_s_sleep(1); \
    if ((++_sp & 255u) == 0u) { if (xb_ld(&(bar)[XB_TMO])) break; if (_sp > XB_SPIN_CAP) { atomicAdd(&(bar)[XB_TMO], 1u); break; } } } } while (0)

struct XcdBarrier {
    unsigned* bar; unsigned x;
    volatile LAS unsigned* st;
};
__device__ __forceinline__ XcdBarrier xcd_barrier_post(unsigned* bar, volatile LAS unsigned* st) {
    XcdBarrier b; b.bar = bar; b.x = xb_xcc_id(); b.st = st;
    if (threadIdx.x == 0) (void)xb_add(&bar[XB_XCNT(b.x)], 1u);
    return b;
}
__device__ __forceinline__ void xcd_barrier_complete(unsigned* bar, unsigned x, unsigned& nloc, unsigned& nx) {
    const unsigned G = gridDim.x * gridDim.y * gridDim.z;
    unsigned sum, cnt, mine, sp = 0u;
    for (;;) {
        sum = 0u; cnt = 0u; mine = 0u;
#pragma unroll
        for (unsigned j = 0; j < 16; ++j) { const unsigned c = xb_ld(&bar[XB_XCNT(j)]); sum += c; cnt += (c > 0u) ? 1u : 0u; mine = (j == x) ? c : mine; }
        if (sum == G) break;
        __builtin_amdgcn_s_sleep(1);
        if ((++sp & 255u) == 0u) { if (xb_ld(&bar[XB_TMO])) break; if (sp > XB_SPIN_CAP) { atomicAdd(&bar[XB_TMO], 1u); break; } }
    }
    nloc = mine > 0u ? mine : 1u; nx = cnt > 0u ? cnt : 1u;
}
__device__ __forceinline__ void xcd_barrier(const XcdBarrier& b) {
    asm volatile("s_waitcnt vmcnt(0)" ::: "memory");
    __syncthreads();
    if (threadIdx.x == 0) {
        unsigned* bar = b.bar;
        __builtin_amdgcn_s_waitcnt(0);
        unsigned nloc = b.st[0], nx = b.st[1];
        if (nloc == 0u) { xcd_barrier_complete(bar, b.x, nloc, nx); b.st[0] = nloc; b.st[1] = nx; }
        const unsigned old = xb_add(&bar[XB_XSUB(b.x)], 1u);
        const unsigned gen = old / nloc;
        if (old + 1u == (gen + 1u) * nloc) {
            __builtin_amdgcn_fence(__ATOMIC_RELEASE, "agent");
            asm volatile("s_waitcnt vmcnt(0)" ::: "memory");
            const unsigned og = xb_add(&bar[XB_TOP], 1u);
            const unsigned tg = og / nx;
            if (og + 1u == (tg + 1u) * nx) xb_add(&bar[XB_TOPGEN], 1u);
            else XB_SPIN(xb_ld(&bar[XB_TOPGEN]) == tg, bar);
            __builtin_amdgcn_fence(__ATOMIC_ACQUIRE, "agent");
            xb_add(&bar[XB_XGEN(b.x)], 1u);
            asm volatile("s_waitcnt vmcnt(0)" ::: "memory");
        } else {
            XB_SPIN(xb_ld(&bar[XB_XGEN(b.x)]) == gen, bar);
            __builtin_amdgcn_fence(__ATOMIC_ACQUIRE, "agent");
            asm volatile("s_waitcnt vmcnt(0)" ::: "memory");
        }
    }
    __syncthreads();
}

struct Args { const float* in[32]; float* out; unsigned char* ws; int ph_lo, ph_hi; };
enum In { I_X = 0, I_MEM, I_GMIX, I_WIN, I_CONVW, I_CONVB, I_DTB, I_ALOG, I_DSKIP, I_SSDG, I_DAQG, I_DAKG, I_LQ1, I_LK1, I_LQ2, I_LK2, I_SUBG, I_WOUT, I_GXA, I_GMEM,
          I_WQ, I_WKV, I_XQG, I_XKG, I_WO, I_GFFN, I_RW, I_RB, I_W1, I_B1, I_W2, I_B2 };

struct ArgP {
    typedef const __attribute__((address_space(4))) char* kptr;
    DI const float* in(int i) const { kptr kp = (kptr)__builtin_amdgcn_kernarg_segment_ptr(); asm volatile("" : "+s"(kp)); return *(const float* const __attribute__((address_space(4)))*)(kp + 8 * i); }
    DI float* out() const { kptr kp = (kptr)__builtin_amdgcn_kernarg_segment_ptr(); asm volatile("" : "+s"(kp)); return *(float* const __attribute__((address_space(4)))*)(kp + 8 * 32); }
};
struct Frame {
    LAS unsigned char* lds;
    volatile LAS unsigned* MISC;
    unsigned* ctl;
    unsigned char* ws;
    int tid, lane, wave, vcu, G;
};

template <class DestRow>
DI void tr_item(const float* W, size_t ldw, int k0, int ncol0, int nvalid, const float* kscale, bf16_t* WT, int K, DestRow dr, LAS float* scr, int lane) {
    const int c = lane & 31;
#pragma unroll 8
    for (int i = 0; i < 32; ++i) { const int kk = 2 * i + (lane >> 5);
        float v = (c < nvalid) ? W[(size_t)(k0 + kk) * ldw + ncol0 + c] : 0.f;
        if (kscale) v *= kscale[k0 + kk];
        scr[kk * 33 + c] = v; }
    asm volatile("s_waitcnt lgkmcnt(0)" ::: "memory");
    const int c8 = lane & 7;
#pragma unroll
    for (int j = 0; j < 4; ++j) { const int n = (lane >> 3) + 8 * j; const LAS float* s = scr + (8 * c8) * 33 + n;
        u32x4 o; o.x = pk2(s[0 * 33], s[1 * 33]); o.y = pk2(s[2 * 33], s[3 * 33]); o.z = pk2(s[4 * 33], s[5 * 33]); o.w = pk2(s[6 * 33], s[7 * 33]);
        if (n < nvalid) *(u32x4*)(WT + (size_t)dr(ncol0 + n) * K + k0 + 8 * c8) = o; }
    asm volatile("s_waitcnt lgkmcnt(0)" ::: "memory");
}
template <class DestRow>
DI void tr_item_fp8(const float* W, size_t ldw, int k0, int ncol0, const float* kscale, unsigned char* WT, int K, DestRow dr, LAS float* scr, int lane) {
    const int c = lane & 31;
#pragma unroll 8
    for (int i = 0; i < 32; ++i) { const int kk = 2 * i + (lane >> 5); float v = W[(size_t)(k0 + kk) * ldw + ncol0 + c]; if (kscale) v *= kscale[k0 + kk]; scr[kk * 33 + c] = v; }
    asm volatile("s_waitcnt lgkmcnt(0)" ::: "memory");
    const int n = lane >> 1, hf = lane & 1; const LAS float* s = scr + (32 * hf) * 33 + n;
    unsigned w[8];
#pragma unroll
    for (int j = 0; j < 8; ++j) { unsigned x = 0u;
        x = __builtin_amdgcn_cvt_pk_fp8_f32(s[(4 * j) * 33] * 64.f, s[(4 * j + 1) * 33] * 64.f, x, false);
        x = __builtin_amdgcn_cvt_pk_fp8_f32(s[(4 * j + 2) * 33] * 64.f, s[(4 * j + 3) * 33] * 64.f, x, true); w[j] = x; }
    unsigned char* op = WT + (size_t)dr(ncol0 + n) * K + k0 + 32 * hf;
    *(u32x4*)op = (u32x4){w[0], w[1], w[2], w[3]}; *(u32x4*)(op + 16) = (u32x4){w[4], w[5], w[6], w[7]};
    asm volatile("s_waitcnt lgkmcnt(0)" ::: "memory");
}
DI int tileperm(int col) { const int o = col & 255; return (col & ~255) + 128 * ((o & 63) >> 5) + 32 * (o >> 6) + (o & 31); }
struct DrIdent { DI int operator()(int n) const { return n; } };
struct DrTile  { DI int operator()(int n) const { return tileperm(n); } };
struct DrWin   { DI int operator()(int n) const { const int pc = (n < 2560) ? n : (n < 2576 ? PC_DT + (n - 2560) : n - 16); return tileperm(pc); } };
struct DrW1    { DI int operator()(int n) const { const int half = n >> 11, j = n & 2047; return (j >> 7) * 256 + half * 128 + (j & 127); } };

template <bool FP8, class DestRow>
DI void cv_item(const float* W, size_t ldw, int k0, int ncol0, const float* kscale, float scale, void* WT, int kpitch, DestRow dr, LAS float* scr, int lane) {
    const int r = lane >> 3, c4 = (lane & 7) * 4;
    f32x4 v[16];
#pragma unroll
    for (int i = 0; i < 16; ++i) v[i] = *(const f32x4*)(W + (size_t)(k0 + 8 * i + r) * ldw + ncol0 + c4);
#pragma unroll
    for (int i = 0; i < 16; ++i) { f32x4 x = v[i] * scale; if (kscale) x = x * kscale[k0 + 8 * i + r]; *(LAS f32x4*)(scr + (8 * i + r) * 36 + c4) = x; }
    asm volatile("s_waitcnt lgkmcnt(0)" ::: "memory");
    const int n = lane & 31, hf = lane >> 5; const LAS float* s = scr + (64 * hf) * 36 + n;
    if constexpr (FP8) {
        unsigned w[16];
#pragma unroll
        for (int j = 0; j < 16; ++j) { unsigned x = 0u; x = __builtin_amdgcn_cvt_pk_fp8_f32(s[(4 * j) * 36], s[(4 * j + 1) * 36], x, false); x = __builtin_amdgcn_cvt_pk_fp8_f32(s[(4 * j + 2) * 36], s[(4 * j + 3) * 36], x, true); w[j] = x; }
        unsigned char* op = (unsigned char*)WT + (size_t)dr(ncol0 + n) * kpitch + k0 + 64 * hf;
#pragma unroll
        for (int j = 0; j < 4; ++j) *(u32x4*)(op + 16 * j) = (u32x4){w[4 * j], w[4 * j + 1], w[4 * j + 2], w[4 * j + 3]};
    } else {
        unsigned w[32];
#pragma unroll
        for (int j = 0; j < 32; ++j) w[j] = pk2(s[(2 * j) * 36], s[(2 * j + 1) * 36]);
        unsigned char* op = (unsigned char*)WT + (size_t)dr(ncol0 + n) * kpitch + (k0 + 64 * hf) * 2;
#pragma unroll
        for (int j = 0; j < 8; ++j) *(u32x4*)(op + 16 * j) = (u32x4){w[4 * j], w[4 * j + 1], w[4 * j + 2], w[4 * j + 3]};
    }
    asm volatile("s_waitcnt lgkmcnt(0)" ::: "memory");
}
DI void rms_row_to_bf16(const float* xrow, const float* g, bf16_t* orow, int lane) {
    const f32x4* xr = (const f32x4*)xrow + lane;
    f32x4 v[8]; float s = 0.f;
#pragma unroll
    for (int j = 0; j < 8; ++j) { v[j] = xr[64 * j]; s += (v[j].x * v[j].x + v[j].y * v[j].y) + (v[j].z * v[j].z + v[j].w * v[j].w); }
    const float rstd = 1.f / sqrtf(wave_sum(s) * (1.f / 2048.f) + EPS_);
    u32x2* o8 = (u32x2*)orow + lane;
#pragma unroll
    for (int j = 0; j < 8; ++j) { const f32x4 gg = ((const f32x4*)g)[lane + 64 * j];
        u32x2 o; o.x = pk2(v[j].x * rstd * gg.x, v[j].y * rstd * gg.y); o.y = pk2(v[j].z * rstd * gg.z, v[j].w * rstd * gg.w); o8[64 * j] = o; }
}

DI void p0_prologue(Frame& F, const ArgP& a) {
    LAS float* scr = (LAS float*)(F.lds + RING_OFF + F.wave * 16384);
    const int gw = F.vcu * NWAVES + F.wave, NGW = F.G * NWAVES;
    unsigned char* ws = F.ws;
    constexpr int I_A = 32 * 80, I_B = 32, I_C = 32 * 96, NITEMS = I_A + I_B + I_C;
    for (int it = gw; it < NITEMS; it += NGW) {
        int r = it;
        if (r < I_A) { tr_item(a.in(I_WIN), 5648, 64 * (r / 80), 32 * (r % 80), 32, nullptr, (bf16_t*)(ws + WS_WIN), 2048, DrWin(), scr, F.lane); continue; } r -= I_A;
        if (r < I_B) { tr_item(a.in(I_WIN), 5648, 64 * r, 2560, 16, nullptr, (bf16_t*)(ws + WS_WIN), 2048, DrWin(), scr, F.lane); continue; } r -= I_B;
        tr_item(a.in(I_WIN), 5648, 64 * (r / 96), 2576 + 32 * (r % 96), 32, nullptr, (bf16_t*)(ws + WS_WIN), 2048, DrWin(), scr, F.lane);
    }
    for (int m = gw; m < NTOK; m += NGW) rms_row_to_bf16(a.in(I_X) + (size_t)m * 2048, a.in(I_GMIX), (bf16_t*)(ws + WS_HN) + (size_t)m * 2048, F.lane);
    for (int m = gw; m < NB * MEMLEN; m += NGW) rms_row_to_bf16(a.in(I_MEM) + (size_t)m * 2048, a.in(I_GMEM), (bf16_t*)(ws + WS_MN) + (size_t)m * 2048, F.lane);
}
struct CvIt { const float* W; size_t ldw; const float* ks; unsigned char* WT; float scale; int k0, n0, kpitch, fp8, dr; };
DI CvIt cv_decode(int it, const ArgP& a, unsigned char* ws) {
    constexpr int J_WOUT = 16 * 64, J_WKV = 16 * 128, J_WQ = 16 * 64, J_WO = 16 * 64, J_W1 = 32 * 16 * 128;
    CvIt c; c.ks = nullptr; c.scale = 64.f; c.fp8 = 1; c.dr = 0; c.kpitch = 2048; c.ldw = 2048;
    int r = it;
    if (r < J_WOUT) { c.W = a.in(I_WOUT); c.k0 = 128 * (r / 64); c.n0 = 32 * (r % 64); c.WT = ws + WS_WOUT; c.scale = 1.f; c.fp8 = 0; c.kpitch = 4096; return c; } r -= J_WOUT;
    if (r < J_WKV) { c.W = a.in(I_WKV); c.ldw = 4096; c.k0 = 128 * (r / 128); c.n0 = 32 * (r % 128); c.WT = ws + WS_WKV; c.scale = 1.f; c.fp8 = 0; c.kpitch = 4096; c.dr = 1; return c; } r -= J_WKV;
    if (r < J_WQ) { c.W = a.in(I_WQ); c.ks = a.in(I_GXA); c.k0 = 128 * (r / 64); c.n0 = 32 * (r % 64); c.WT = ws + WS_WQ; return c; } r -= J_WQ;
    if (r < J_WO) { c.W = a.in(I_WO); c.k0 = 128 * (r / 64); c.n0 = 32 * (r % 64); c.WT = ws + WS_WO; return c; } r -= J_WO;
    if (r < J_W1) { const int e = r / (16 * 128), q = r % (16 * 128); c.W = a.in(I_W1) + (size_t)e * 2048 * 4096; c.ldw = 4096; c.k0 = 128 * (q / 128); c.n0 = 32 * (q % 128); c.WT = ws + WS_W1 + (size_t)e * 4096 * 2048; c.dr = 2; return c; } r -= J_W1;
    { const int e = r / (16 * 64), q = r % (16 * 64); c.W = a.in(I_W2) + (size_t)e * 2048 * 2048; c.k0 = 128 * (q / 64); c.n0 = 32 * (q % 64); c.WT = ws + WS_W2 + (size_t)e * 2048 * 2048; }
    return c;
}
constexpr int CV_NJ = 16 * 64 * 3 + 16 * 128 + 32 * 16 * 128 + 32 * 16 * 64;
constexpr int CV_TAIL2 = 16384;
constexpr int CV_TAIL1 = 16384;
constexpr int CV_TAIL = CV_TAIL1 + CV_TAIL2;
DI void conv_share(Frame& F, const ArgP& a) {
    LAS float* scr = (LAS float*)(F.lds + F.wave * 16384);
    const unsigned sbase = (unsigned)__builtin_amdgcn_readfirstlane((int)((unsigned)(uintptr_t)F.lds + (unsigned)F.wave * 16384u));
    const int gw = F.vcu * NWAVES + F.wave, NGW = F.G * NWAVES, lane = F.lane;
    unsigned char* ws = F.ws;
    constexpr int NJ = CV_NJ - CV_TAIL;
    const int n = lane & 31, hf = lane >> 5;
    for (int it = gw; it < NJ; it += NGW) {
        const CvIt cur = cv_decode(it, a, ws);
        const char* gb = (const char*)(cur.W + (size_t)cur.k0 * cur.ldw + cur.n0);
        const unsigned vo0 = (unsigned)(((size_t)(lane >> 3) * cur.ldw + (size_t)(lane & 7) * 4) * 4), vstep = (unsigned)(8 * cur.ldw * 4);
#pragma unroll
        for (int p = 0; p < 16; ++p) { unsigned keep_;
            asm volatile("s_mov_b32 %0, m0\n\ts_mov_b32 m0, %3\n\ts_nop 0\n\tglobal_load_lds_dwordx4 %1, %2 nt\n\ts_mov_b32 m0, %0"
                         : "=&s"(keep_) : "v"(vo0 + (unsigned)p * vstep), "s"(gb), "s"(sbase + (unsigned)p * 1024u) : "memory"); }
        asm volatile("s_waitcnt vmcnt(0)" ::: "memory");
        const LAS float* s = scr + (64 * hf) * 32 + n;
        const int col = cur.n0 + n; const int drow = (cur.dr == 0) ? col : (cur.dr == 1 ? tileperm(col) : DrW1()(col));
        const float* ksp = cur.ks ? cur.ks + cur.k0 + 64 * hf : nullptr;
        if (cur.fp8) {
            unsigned w[16];
#pragma unroll
            for (int j = 0; j < 16; ++j) { float x0 = s[(4 * j) * 32] * cur.scale, x1 = s[(4 * j + 1) * 32] * cur.scale, x2 = s[(4 * j + 2) * 32] * cur.scale, x3 = s[(4 * j + 3) * 32] * cur.scale;
                if (ksp) { x0 *= ksp[4 * j]; x1 *= ksp[4 * j + 1]; x2 *= ksp[4 * j + 2]; x3 *= ksp[4 * j + 3]; }
                unsigned x = 0u; x = __builtin_amdgcn_cvt_pk_fp8_f32(x0, x1, x, false); x = __builtin_amdgcn_cvt_pk_fp8_f32(x2, x3, x, true); w[j] = x; }
            unsigned char* op = cur.WT + (size_t)drow * cur.kpitch + cur.k0 + 64 * hf;
#pragma unroll
            for (int j = 0; j < 4; ++j) *(u32x4*)(op + 16 * j) = (u32x4){w[4 * j], w[4 * j + 1], w[4 * j + 2], w[4 * j + 3]};
        } else {
            unsigned w[32];
#pragma unroll
            for (int j = 0; j < 32; ++j) w[j] = pk2(s[(2 * j) * 32] * cur.scale, s[(2 * j + 1) * 32] * cur.scale);
            unsigned char* op = cur.WT + (size_t)drow * cur.kpitch + (cur.k0 + 64 * hf) * 2;
#pragma unroll
            for (int j = 0; j < 8; ++j) *(u32x4*)(op + 16 * j) = (u32x4){w[4 * j], w[4 * j + 1], w[4 * j + 2], w[4 * j + 3]};
        }
        asm volatile("s_waitcnt lgkmcnt(0)" ::: "memory");
    }
}

DI void conv_queue(Frame& F, const ArgP& a, int qword, int first, int count) {
    LAS float* scr = (LAS float*)(F.lds + F.wave * 18432);
    unsigned char* ws = F.ws;
    const int lane = threadIdx.x & 63, r = lane >> 3, c4 = (lane & 7) * 4, n = lane & 31, hf = lane >> 5;
    for (;;) {
        if (threadIdx.x == 0) F.MISC[121] = __hip_atomic_fetch_add(F.ctl + qword, 8u, __ATOMIC_RELAXED, __HIP_MEMORY_SCOPE_AGENT);
        __syncthreads();
        const int base = __builtin_amdgcn_readfirstlane((int)F.MISC[121]);
        __syncthreads();
        if (base >= count) break;
        const int it = first + base + F.wave;
        if (base + F.wave < count) {
            const CvIt cur = cv_decode(it, a, ws);
            f32x4 v[16];
#pragma unroll
            for (int i = 0; i < 16; ++i) v[i] = __builtin_nontemporal_load((const f32x4*)(cur.W + (size_t)(cur.k0 + 8 * i + r) * cur.ldw + cur.n0 + c4));
#pragma unroll
            for (int i = 0; i < 16; ++i) *(LAS f32x4*)(scr + (8 * i + r) * 36 + c4) = v[i] * cur.scale;
            asm volatile("s_waitcnt lgkmcnt(0)" ::: "memory");
            const LAS float* s = scr + (64 * hf) * 36 + n;
            unsigned w[16];
#pragma unroll
            for (int j = 0; j < 16; ++j) { unsigned x = 0u; x = __builtin_amdgcn_cvt_pk_fp8_f32(s[(4 * j) * 36], s[(4 * j + 1) * 36], x, false); x = __builtin_amdgcn_cvt_pk_fp8_f32(s[(4 * j + 2) * 36], s[(4 * j + 3) * 36], x, true); w[j] = x; }
            unsigned char* op = cur.WT + (size_t)(cur.n0 + n) * cur.kpitch + cur.k0 + 64 * hf;
#pragma unroll
            for (int j = 0; j < 4; ++j) *(u32x4*)(op + 16 * j) = (u32x4){w[4 * j], w[4 * j + 1], w[4 * j + 2], w[4 * j + 3]};
            asm volatile("s_waitcnt lgkmcnt(0)" ::: "memory");
        }
    }
}
static_assert(CV_TAIL <= 32 * 16 * 64 && CV_TAIL1 % 8 == 0 && CV_TAIL2 % 8 == 0, "the tails are a suffix of the moe_w2 items");

struct SchedP1 {
    int G, c; const unsigned char* ws; int lo, hi;
    DI bool next(int i, pg8::UnitD& u) const {
        const int L = lo + i * G + c; if (L >= hi) return false;
        u.rows = nullptr; u.nvalid = 0; u.lda = 4096u; u.ldb = 4096u; u.e = 0; u.x0 = 0;
        if (L < 32 * 23) { u.type = 0; u.pn = L / 32; u.pm = L % 32; u.A = (const char*)(ws + WS_HN) + (size_t)u.pm * 256 * 4096; u.B = (const char*)(ws + WS_WIN) + (size_t)u.pn * 256 * 4096; }
        else { const int q = L - 32 * 23; u.type = 1; u.pn = q / 4; u.pm = q % 4; u.A = (const char*)(ws + WS_MN) + (size_t)u.pm * 256 * 4096; u.B = (const char*)(ws + WS_WKV) + (size_t)u.pn * 256 * 4096; }
        return true;
    }
};
struct EpiP1 {
    static constexpr bool AFTER_DRAIN = false;
    bf16_t* proj; float* dtb; bf16_t* kvraw; const float* gq; const float* gk; unsigned char* vf8;
    DI void operator()(const f32x4 (&acc)[2][2][4][2], const pg8::UnitD& u, int wr, int wc, int fr, int fq) const {
        { int ln_ = threadIdx.x; asm volatile("" : "+v"(ln_)); fr = ln_ & 15; fq = (ln_ >> 4) & 3; }
        const int row0 = u.pm * 256 + wr * 64 + fr;
        const int cn = u.pn * 256 + 64 * wc + 8 * fq;
        if (u.type == 1 && u.pn >= 8) {
#pragma unroll
            for (int ai = 0; ai < 2; ++ai)
#pragma unroll
                for (int m = 0; m < 4; ++m) { unsigned char* rp = vf8 + (size_t)(row0 + ai * 128 + m * 16) * 2048 + (cn - 2048);
#pragma unroll
                    for (int bj = 0; bj < 2; ++bj) { const f32x4 v0 = acc[ai][bj][m][0] * 16.f, v1 = acc[ai][bj][m][1] * 16.f;
                        u32x2 w; w.x = __builtin_amdgcn_cvt_pk_fp8_f32(v0[0], v0[1], 0u, false); w.x = __builtin_amdgcn_cvt_pk_fp8_f32(v0[2], v0[3], w.x, true);
                        w.y = __builtin_amdgcn_cvt_pk_fp8_f32(v1[0], v1[1], 0u, false); w.y = __builtin_amdgcn_cvt_pk_fp8_f32(v1[2], v1[3], w.y, true);
                        *(u32x2*)(rp + 32 * bj) = w; } }
            return;
        }
        if (u.type == 1) {
#pragma unroll
            for (int ai = 0; ai < 2; ++ai)
#pragma unroll
                for (int m = 0; m < 4; ++m) { bf16_t* rp = kvraw + (size_t)(row0 + ai * 128 + m * 16) * 4096 + cn;
#pragma unroll
                    for (int bj = 0; bj < 2; ++bj) { const f32x4 v0 = acc[ai][bj][m][0], v1 = acc[ai][bj][m][1];
                        u32x4 w; w.x = pk2(v0[0], v0[1]); w.y = pk2(v0[2], v0[3]); w.z = pk2(v1[0], v1[1]); w.w = pk2(v1[2], v1[3]); *(u32x4*)(rp + 32 * bj) = w; } }
            return;
        }
        if (u.pn == 22) {
            if (wc == 0 && fq < 2) {
#pragma unroll
                for (int ai = 0; ai < 2; ++ai)
#pragma unroll
                    for (int m = 0; m < 4; ++m) { float* rp = dtb + (size_t)(row0 + ai * 128 + m * 16) * 16 + 8 * fq;
                        *(f32x4*)(rp) = acc[ai][0][m][0]; *(f32x4*)(rp + 4) = acc[ai][0][m][1]; }
            }
            return;
        }
        const bool isq = (u.pn >= 10 && u.pn < 14), isk = (u.pn >= 14 && u.pn < 18);
        if (!(isq || isk)) {
#pragma unroll
            for (int ai = 0; ai < 2; ++ai)
#pragma unroll
                for (int m = 0; m < 4; ++m) { bf16_t* rp = proj + (size_t)(row0 + ai * 128 + m * 16) * PP + cn;
#pragma unroll
                    for (int bj = 0; bj < 2; ++bj) { const f32x4 v0 = acc[ai][bj][m][0], v1 = acc[ai][bj][m][1];
                        u32x4 w; w.x = pk2(v0[0], v0[1]); w.y = pk2(v0[2], v0[3]); w.z = pk2(v1[0], v1[1]); w.w = pk2(v1[2], v1[3]); *(u32x4*)(rp + 32 * bj) = w; } }
            return;
        }
        const float* g = (isq ? gq : gk) + 8 * fq; const float sc = isq ? (0.125f * 1.4426950408889634f) : 1.f;
#pragma unroll
        for (int ai = 0; ai < 2; ++ai)
#pragma unroll
            for (int m = 0; m < 4; ++m) { bf16_t* rp = proj + (size_t)(row0 + ai * 128 + m * 16) * PP + cn;
                float ss = 0.f;
#pragma unroll
                for (int bj = 0; bj < 2; ++bj)
#pragma unroll
                    for (int n = 0; n < 2; ++n) { const f32x4 v = acc[ai][bj][m][n]; ss += (v[0] * v[0] + v[1] * v[1]) + (v[2] * v[2] + v[3] * v[3]); }
                ss += __shfl_xor(ss, 16); ss += __shfl_xor(ss, 32);
                const float rs = sc / sqrtf(ss * (1.f / 64.f) + EPS_);
#pragma unroll
                for (int bj = 0; bj < 2; ++bj) { const f32x4 v0 = acc[ai][bj][m][0] * rs * *(const f32x4*)(g + 32 * bj), v1 = acc[ai][bj][m][1] * rs * *(const f32x4*)(g + 32 * bj + 4);
                    u32x4 w; w.x = pk2(v0[0], v0[1]); w.y = pk2(v0[2], v0[3]); w.z = pk2(v1[0], v1[1]); w.w = pk2(v1[2], v1[3]); *(u32x4*)(rp + 32 * bj) = w; } }
    }
};

DI void kprep(Frame& F, const ArgP& a) {
    const int gw = F.vcu * NWAVES + F.wave, NGW = F.G * NWAVES;
    const bf16_t* kv = (const bf16_t*)(F.ws + WS_KVRAW); unsigned char* kn = (unsigned char*)(F.ws + WS_KN8);
    for (int it = gw; it < NB * MEMLEN * 4; it += NGW) {
        const int row = it >> 2, h = it & 3, b = row >> 8, key = row & 255;
        const u32x4 raw = *(const u32x4*)(kv + (size_t)row * 4096 + h * 512 + F.lane * 8);
        float v[8]; v[0] = bflo(raw.x); v[1] = bfhi(raw.x); v[2] = bflo(raw.y); v[3] = bfhi(raw.y); v[4] = bflo(raw.z); v[5] = bfhi(raw.z); v[6] = bflo(raw.w); v[7] = bfhi(raw.w);
        float ss = 0.f;
#pragma unroll
        for (int j = 0; j < 8; ++j) ss += v[j] * v[j];
        const float rs = 1.f / sqrtf(wave_sum(ss) * (1.f / 512.f) + EPS_) * 0.04419417382415922f * 128.f;
        const float* gk = a.in(I_XKG) + F.lane * 8; const float* gq = a.in(I_XQG) + F.lane * 8;
        u32x2 o; o.x = __builtin_amdgcn_cvt_pk_fp8_f32(v[0] * rs * gk[0] * gq[0], v[1] * rs * gk[1] * gq[1], 0u, false); o.x = __builtin_amdgcn_cvt_pk_fp8_f32(v[2] * rs * gk[2] * gq[2], v[3] * rs * gk[3] * gq[3], o.x, true);
        o.y = __builtin_amdgcn_cvt_pk_fp8_f32(v[4] * rs * gk[4] * gq[4], v[5] * rs * gk[5] * gq[5], 0u, false); o.y = __builtin_amdgcn_cvt_pk_fp8_f32(v[6] * rs * gk[6] * gq[6], v[7] * rs * gk[7] * gq[7], o.y, true);
        *(u32x2*)(kn + ((size_t)((b * 4 + h) * 256 + key)) * 512 + F.lane * 8) = o;
    }
}

constexpr int SP = 272;
constexpr int S_C = 0, S_BM = 34816, S_BT = 69632, S_XDT = 104448, S_HB = 121856, S_F = 139264, S_W = 155648  , SSD_LDS = 162048;
static_assert(SSD_LDS <= MISC_OFF, "SSD LDS map");
#define MFMA32(a, b, c) __builtin_amdgcn_mfma_f32_32x32x16_bf16((a), (b), (c), 0, 0, 0)
DI int crow(int r, int hi) { return (r & 3) + 8 * (r >> 2) + 4 * hi; }
DI bf16x8 ldfrag(LAS const unsigned char* base, int row, int kel) { return *(const LAS bf16x8*)(base + row * SP + kel * 2); }
DI float fexp(float x) { return __builtin_amdgcn_exp2f(x * 1.4426950408889634f); }
DI float fsilu(float x) { return x * __builtin_amdgcn_rcpf(1.f + fexp(-x)); }

DI void ssd_unit(Frame& F, const ArgP& a, int b, int hd) {
    LAS unsigned char* lds = F.lds;
    int tid = F.tid, lane = F.lane, r32 = lane & 31, hh = lane >> 5; const int wid = F.wave;
    LAS float* sdt = (LAS float*)(lds + S_F); LAS float* sac = sdt + 2048;
    const bf16_t* proj = (const bf16_t*)(F.ws + WS_PROJ); const float* dtbuf = (const float*)(F.ws + WS_DT); bf16_t* yg = (bf16_t*)(F.ws + WS_YG);
    const int g = hd >> 3;
    const float aneg = -__expf(a.in(I_ALOG)[hd]), dtb = a.in(I_DTB)[hd], dsk = a.in(I_DSKIP)[hd];
#pragma unroll
    for (int q = 0; q < 2; ++q) { const int c = 2 * wid + q; const size_t t0 = (size_t)b * SEQ_ + c * 128;
        const float x0 = dtbuf[(t0 + 2 * lane) * 16 + hd] + dtb, x1 = dtbuf[(t0 + 2 * lane + 1) * 16 + hd] + dtb;
        const float d0 = x0 > 20.f ? x0 : log1pf(__expf(x0)), d1 = x1 > 20.f ? x1 : log1pf(__expf(x1));
        const float a0 = d0 * aneg, a1 = d1 * aneg;
        float s = a0 + a1;
#pragma unroll
        for (int o = 1; o < 64; o <<= 1) { const float t = __shfl_up(s, o); if (lane >= o) s += t; }
        sdt[c * 128 + 2 * lane] = d0; sdt[c * 128 + 2 * lane + 1] = d1; sac[c * 128 + 2 * lane] = s - a1; sac[c * 128 + 2 * lane + 1] = s; }
    int seg = tid >> 5, cg = tid & 31, l0 = seg * 8;
    int colbc = (cg < 16) ? (1024 + g * 128 + cg * 8) : (1280 + g * 128 + (cg - 16) * 8);
    const int colx = hd * 64 + wid * 8; int lx = 2 * lane;
    LAS float* swt = (LAS float*)(lds + S_W);
    { const float* convw = a.in(I_CONVW); const float* convb = a.in(I_CONVB);
      if (tid < 320) { const int ci = tid;
          const int xc = (ci < 64) ? (hd * 64 + ci) : (ci < 192 ? (1024 + g * 128 + (ci - 64)) : (1280 + g * 128 + (ci - 192)));
#pragma unroll
          for (int k = 0; k < 4; ++k) swt[k * 320 + ci] = convw[k * 1536 + xc];
          swt[4 * 320 + ci] = convb[xc]; } }
    int cibc = 64 + cg * 8; const int cix = wid * 8;
    const char* pub = (const char*)F.ws; const unsigned pxb = (unsigned)(WS_PROJ + ((size_t)b * SEQ_ * PP + PC_XBC) * 2), zoff = (unsigned)(WS_CTL + 524288);
    u32x4 inbc[11], inx[5];
#define SSD_PREFETCH(c_) do { \
        int sd_ = l0; asm volatile("" : "+v"(sd_)); \
        _Pragma("unroll") for (int j = 0; j < 11; ++j) { const int tt = (c_) * 128 + sd_ - 3 + j; inbc[j] = *(const u32x4*)(pub + ((tt >= 0) ? pxb + (unsigned)(tt * PP + colbc) * 2u : zoff)); } } while (0)
    SSD_PREFETCH(0);
    f32x16 hT; for (int i = 0; i < 16; ++i) hT[i] = 0.f;
    const int nb = wid & 3, pb = wid >> 2;
    __syncthreads();
    for (int c = 0; c < 16; ++c) {
        { int t_ = threadIdx.x; asm volatile("" : "+v"(t_)); tid = t_; lane = t_ & 63; r32 = lane & 31; hh = lane >> 5; seg = t_ >> 5; cg = t_ & 31; l0 = seg * 8; lx = 2 * lane;
          colbc = (cg < 16) ? (1024 + g * 128 + cg * 8) : (1280 + g * 128 + (cg - 16) * 8); cibc = 64 + cg * 8; }
        const size_t t0 = (size_t)b * SEQ_ + c * 128;
        const LAS float* cdt = sdt + c * 128; const LAS float* cac = sac + c * 128;
        const float aend = cac[127];
#pragma unroll
        for (int j = 0; j < 5; ++j) { int sd_ = lx; asm volatile("" : "+v"(sd_)); const int tt = c * 128 + sd_ - 3 + j; inx[j] = *(const u32x4*)(pub + ((tt >= 0) ? pxb + (unsigned)(tt * PP + colx) * 2u : zoff)); }
        {
            LAS unsigned char* hbp = lds + S_HB + (32 * pb + r32) * SP + (32 * nb + 4 * hh) * 2;
#pragma unroll
            for (int q4 = 0; q4 < 4; ++q4) { u32x2 w; w.x = pk2(hT[4 * q4], hT[4 * q4 + 1]); w.y = pk2(hT[4 * q4 + 2], hT[4 * q4 + 3]); *(LAS u32x2*)(hbp + 16 * q4) = w; }
        }
        {
            float wbc[5][8];
#pragma unroll
            for (int k = 0; k < 5; ++k) { const f32x4 w0 = *(const LAS f32x4*)(swt + k * 320 + cibc), w1 = *(const LAS f32x4*)(swt + k * 320 + cibc + 4);
#pragma unroll
                for (int i = 0; i < 4; ++i) { wbc[k][i] = w0[i]; wbc[k][4 + i] = w1[i]; } }
#pragma unroll
            for (int hf = 0; hf < 2; ++hf) {
                __builtin_amdgcn_sched_barrier(0);
                float o[4][8];
#pragma unroll
                for (int j = 0; j < 4; ++j)
#pragma unroll
                    for (int i = 0; i < 8; ++i) { float s = wbc[4][i];
#pragma unroll
                        for (int k = 0; k < 4; ++k) { const unsigned wd = inbc[4 * hf + j + k][i >> 1]; s += wbc[k][i] * ((i & 1) ? bfhi(wd) : bflo(wd)); }
                        o[j][i] = fsilu(s); }
                const int lh = l0 + 4 * hf;
                if (cg < 16) {
                    const int n0 = cg * 8; float ev[4];
#pragma unroll
                    for (int j = 0; j < 4; ++j) { ev[j] = fexp(aend - cac[lh + j]);
                        u32x4 w1; w1.x = pk2(o[j][0], o[j][1]); w1.y = pk2(o[j][2], o[j][3]); w1.z = pk2(o[j][4], o[j][5]); w1.w = pk2(o[j][6], o[j][7]);
                        *(LAS u32x4*)(lds + S_BM + (lh + j) * SP + n0 * 2) = w1; }
#pragma unroll
                    for (int i = 0; i < 8; ++i) { u32x2 w2; w2.x = pk2(o[0][i] * ev[0], o[1][i] * ev[1]); w2.y = pk2(o[2][i] * ev[2], o[3][i] * ev[3]);
                        *(LAS u32x2*)(lds + S_BT + (n0 + i) * SP + lh * 2) = w2; }
                } else {
                    const int n0 = (cg - 16) * 8;
#pragma unroll
                    for (int j = 0; j < 4; ++j) { u32x4 w1; w1.x = pk2(o[j][0], o[j][1]); w1.y = pk2(o[j][2], o[j][3]); w1.z = pk2(o[j][4], o[j][5]); w1.w = pk2(o[j][6], o[j][7]);
                        *(LAS u32x4*)(lds + S_C + (lh + j) * SP + n0 * 2) = w1; }
                }
            }
        }
        __builtin_amdgcn_sched_barrier(0);
        {
            const float d0 = cdt[lx], d1 = cdt[lx + 1];
            float wx[5][8];
#pragma unroll
            for (int k = 0; k < 5; ++k) { const f32x4 w0 = *(const LAS f32x4*)(swt + k * 320 + cix), w1 = *(const LAS f32x4*)(swt + k * 320 + cix + 4);
#pragma unroll
                for (int i = 0; i < 4; ++i) { wx[k][i] = w0[i]; wx[k][4 + i] = w1[i]; } }
#pragma unroll
            for (int i = 0; i < 8; ++i) { float s0 = wx[4][i], s1 = wx[4][i];
#pragma unroll
                for (int k = 0; k < 4; ++k) { const unsigned w0 = inx[k][i >> 1], w1 = inx[k + 1][i >> 1];
                    s0 += wx[k][i] * ((i & 1) ? bfhi(w0) : bflo(w0)); s1 += wx[k][i] * ((i & 1) ? bfhi(w1) : bflo(w1)); }
                *(LAS unsigned*)(lds + S_XDT + (wid * 8 + i) * SP + lx * 2) = pk2(fsilu(s0) * d0, fsilu(s1) * d1); }
        }
        if (c < 15) SSD_PREFETCH(c + 1);
        __syncthreads();
        const int lb = wid >> 1;
        f32x16 xt[2];
        {
            bf16x8 cf[8];
#pragma unroll
            for (int ks = 0; ks < 8; ++ks) cf[ks] = ldfrag(lds + S_C, 32 * lb + r32, 16 * ks + 8 * hh);
#pragma unroll
            for (int q = 0; q < 2; ++q) { const int sb = 2 * (wid & 1) + q;
                for (int i = 0; i < 16; ++i) xt[q][i] = 0.f;
                if (sb <= lb) {
                    bf16x8 bfr[8];
#pragma unroll
                    for (int ks = 0; ks < 8; ++ks) bfr[ks] = ldfrag(lds + S_BM, 32 * sb + r32, 16 * ks + 8 * hh);
                    __builtin_amdgcn_sched_barrier(0);
#pragma unroll
                    for (int ks = 0; ks < 8; ++ks) xt[q] = MFMA32(bfr[ks], cf[ks], xt[q]);
                }
            }
        }
        __syncthreads();
        {
            const int l = 32 * lb + r32; const float al = cac[l], ddl = dsk * __builtin_amdgcn_rcpf(cdt[l]);
            f32x4 cs[2][4];
#pragma unroll
            for (int q = 0; q < 2; ++q)
#pragma unroll
                for (int q4 = 0; q4 < 4; ++q4) cs[q][q4] = *(const LAS f32x4*)(cac + 32 * (2 * (wid & 1) + q) + 8 * q4 + 4 * hh);
#pragma unroll
            for (int q = 0; q < 2; ++q) { const int sb = 2 * (wid & 1) + q;
#pragma unroll
                for (int q4 = 0; q4 < 4; ++q4) { float mv[4];
#pragma unroll
                    for (int e = 0; e < 4; ++e) { const int s = 32 * sb + 8 * q4 + 4 * hh + e;
                        const float ev = fexp(fminf(al - cs[q][q4][e], 0.f));
                        float v = (s <= l) ? xt[q][4 * q4 + e] * ev : 0.f;
                        v += (s == l) ? ddl : 0.f;
                        mv[e] = v; }
                    u32x2 w; w.x = pk2(mv[0], mv[1]); w.y = pk2(mv[2], mv[3]);
                    *(LAS u32x2*)(lds + S_BM + l * SP + (32 * sb + 8 * q4 + 4 * hh) * 2) = w; }
            }
        }
        __syncthreads();
        {
            const int lb2 = wid & 3, pb2 = wid >> 2; const int l = 32 * lb2 + r32; const size_t tok = t0 + l;
            const int pc0 = hd * 64 + 32 * pb2 + 4 * hh;
            u32x2 zz[4];
#pragma unroll
            for (int q4 = 0; q4 < 4; ++q4) zz[q4] = *(const u32x2*)(proj + tok * PP + pc0 + 8 * q4);
            f32x16 y1, y2; for (int i = 0; i < 16; ++i) { y1[i] = 0.f; y2[i] = 0.f; }
            bf16x8 fa[8], fb[8];
#pragma unroll
            for (int ks = 0; ks < 8; ++ks) { fa[ks] = ldfrag(lds + S_XDT, 32 * pb2 + r32, 16 * ks + 8 * hh); fb[ks] = ldfrag(lds + S_BM, 32 * lb2 + r32, 16 * ks + 8 * hh); }
            __builtin_amdgcn_sched_barrier(0);
#pragma unroll
            for (int ks = 0; ks < 8; ++ks) { if (ks < 2 * (lb2 + 1)) y1 = MFMA32(fa[ks], fb[ks], y1); }
            const float cd = fexp(aend);
#pragma unroll
            for (int i = 0; i < 16; ++i) hT[i] *= cd;
#pragma unroll
            for (int ks = 0; ks < 8; ++ks) fb[ks] = ldfrag(lds + S_BT, 32 * nb + r32, 16 * ks + 8 * hh);
            __builtin_amdgcn_sched_barrier(0);
#pragma unroll
            for (int ks = 0; ks < 8; ++ks) hT = MFMA32(fb[ks], fa[ks], hT);
#pragma unroll
            for (int ks = 0; ks < 8; ++ks) { fa[ks] = ldfrag(lds + S_HB, 32 * pb2 + r32, 16 * ks + 8 * hh); fb[ks] = ldfrag(lds + S_C, 32 * lb2 + r32, 16 * ks + 8 * hh); }
            __builtin_amdgcn_sched_barrier(0);
#pragma unroll
            for (int ks = 0; ks < 8; ++ks) y2 = MFMA32(fa[ks], fb[ks], y2);
            const float el = fexp(cac[l]);
#pragma unroll
            for (int q4 = 0; q4 < 4; ++q4) { float yv[4];
#pragma unroll
                for (int e = 0; e < 4; ++e) { const float z = (e & 1) ? bfhi(e < 2 ? zz[q4].x : zz[q4].y) : bflo(e < 2 ? zz[q4].x : zz[q4].y);
                    yv[e] = (y1[4 * q4 + e] + el * y2[4 * q4 + e]) * fsilu(z); }
                u32x2 w; w.x = pk2(yv[0], yv[1]); w.y = pk2(yv[2], yv[3]);
                *(u32x2*)(yg + tok * 1024 + pc0 + 8 * q4) = w; }
        }
        __syncthreads();
    }
#undef SSD_PREFETCH
}

DI void attn_phase_da(Frame& F) {
    const attn_body::bf16* proj = (const attn_body::bf16*)(F.ws + WS_PROJ);
    for (;;) {
        if (threadIdx.x == 0) F.MISC[120] = __hip_atomic_fetch_add(F.ctl + CW_QATT, 1u, __ATOMIC_RELAXED, __HIP_MEMORY_SCOPE_AGENT);
        __syncthreads();
        const int u = __builtin_amdgcn_readfirstlane((int)F.MISC[120]);
        __syncthreads();
        if (u >= 1024) break;
        const int qb = 7 - (u >> 7), combo = u & 127;
        const int half = combo & 1, j = (combo >> 1) & 1, h = (combo >> 2) & 7, b = combo >> 5;
        attn_body::bf16* O = (attn_body::bf16*)(F.ws + (j ? WS_O1 : WS_O0));
        attn_body::attn_unit<8>(b, PC_Q + (h * 2 + j) * 64, PC_V + h * 128 + half * 64, h * 128 + half * 64, qb, proj, proj + (PC_K - PC_Q), proj, O, (char*)F.lds);
    }
}

DI void p3_finalize(Frame& F, const ArgP& a) {
    const int gw = F.vcu * NWAVES + F.wave, NGW = F.G * NWAVES, lane = F.lane;
    bf16_t* ycat = (bf16_t*)(F.ws + WS_YCAT); const bf16_t* yg = (const bf16_t*)(F.ws + WS_YG); const bf16_t* o0 = (const bf16_t*)(F.ws + WS_O0); const bf16_t* o1 = (const bf16_t*)(F.ws + WS_O1);
    float l1 = a.in(I_LQ1)[lane] * a.in(I_LK1)[lane], l2 = a.in(I_LQ2)[lane] * a.in(I_LK2)[lane];
    const float lam = __expf(wave_sum(l1)) - __expf(wave_sum(l2)) + LAM_INIT;
    for (int m = gw; m < NTOK; m += NGW) {
        { bf16_t* yp = ycat + (size_t)m * 2048 + 16 * lane; const bf16_t* gp = yg + (size_t)m * 1024 + 16 * lane;
          const u32x4 r0 = *(const u32x4*)gp, r1 = *(const u32x4*)(gp + 8);
          float v[16]; v[0] = bflo(r0.x); v[1] = bfhi(r0.x); v[2] = bflo(r0.y); v[3] = bfhi(r0.y); v[4] = bflo(r0.z); v[5] = bfhi(r0.z); v[6] = bflo(r0.w); v[7] = bfhi(r0.w);
          v[8] = bflo(r1.x); v[9] = bfhi(r1.x); v[10] = bflo(r1.y); v[11] = bfhi(r1.y); v[12] = bflo(r1.z); v[13] = bfhi(r1.z); v[14] = bflo(r1.w); v[15] = bfhi(r1.w);
          float ss = 0.f;
#pragma unroll
          for (int i = 0; i < 16; ++i) ss += v[i] * v[i];
#pragma unroll
          for (int o = 1; o < 32; o <<= 1) ss += __shfl_xor(ss, o);
          const float rs = 1.f / sqrtf(ss * (1.f / 512.f) + EPS_);
          const float* g = a.in(I_SSDG) + 16 * lane;
          u32x4 w0, w1;
          w0.x = pk2(v[0] * rs * g[0], v[1] * rs * g[1]); w0.y = pk2(v[2] * rs * g[2], v[3] * rs * g[3]); w0.z = pk2(v[4] * rs * g[4], v[5] * rs * g[5]); w0.w = pk2(v[6] * rs * g[6], v[7] * rs * g[7]);
          w1.x = pk2(v[8] * rs * g[8], v[9] * rs * g[9]); w1.y = pk2(v[10] * rs * g[10], v[11] * rs * g[11]); w1.z = pk2(v[12] * rs * g[12], v[13] * rs * g[13]); w1.w = pk2(v[14] * rs * g[14], v[15] * rs * g[15]);
          *(u32x4*)yp = w0; *(u32x4*)(yp + 8) = w1; }
        { const bf16_t* p0 = o0 + (size_t)m * 1024 + 16 * lane; const bf16_t* p1 = o1 + (size_t)m * 1024 + 16 * lane;
          const u32x4 a0 = *(const u32x4*)p0, a1 = *(const u32x4*)(p0 + 8), b0 = *(const u32x4*)p1, b1 = *(const u32x4*)(p1 + 8);
          float v[16];
          v[0] = bflo(a0.x) - lam * bflo(b0.x); v[1] = bfhi(a0.x) - lam * bfhi(b0.x); v[2] = bflo(a0.y) - lam * bflo(b0.y); v[3] = bfhi(a0.y) - lam * bfhi(b0.y);
          v[4] = bflo(a0.z) - lam * bflo(b0.z); v[5] = bfhi(a0.z) - lam * bfhi(b0.z); v[6] = bflo(a0.w) - lam * bflo(b0.w); v[7] = bfhi(a0.w) - lam * bfhi(b0.w);
          v[8] = bflo(a1.x) - lam * bflo(b1.x); v[9] = bfhi(a1.x) - lam * bfhi(b1.x); v[10] = bflo(a1.y) - lam * bflo(b1.y); v[11] = bfhi(a1.y) - lam * bfhi(b1.y);
          v[12] = bflo(a1.z) - lam * bflo(b1.z); v[13] = bfhi(a1.z) - lam * bfhi(b1.z); v[14] = bflo(a1.w) - lam * bflo(b1.w); v[15] = bfhi(a1.w) - lam * bfhi(b1.w);
          float ss = 0.f;
#pragma unroll
          for (int i = 0; i < 16; ++i) ss += v[i] * v[i];
          ss += __shfl_xor(ss, 1); ss += __shfl_xor(ss, 2); ss += __shfl_xor(ss, 4);
          const float rs = 1.f / sqrtf(ss * (1.f / 128.f) + EPS_) * (1.f - LAM_INIT);
          const float* g = a.in(I_SUBG) + 16 * (lane & 7);
          u32x4 w0, w1;
          w0.x = pk2(v[0] * rs * g[0], v[1] * rs * g[1]); w0.y = pk2(v[2] * rs * g[2], v[3] * rs * g[3]); w0.z = pk2(v[4] * rs * g[4], v[5] * rs * g[5]); w0.w = pk2(v[6] * rs * g[6], v[7] * rs * g[7]);
          w1.x = pk2(v[8] * rs * g[8], v[9] * rs * g[9]); w1.y = pk2(v[10] * rs * g[10], v[11] * rs * g[11]); w1.z = pk2(v[12] * rs * g[12], v[13] * rs * g[13]); w1.w = pk2(v[14] * rs * g[14], v[15] * rs * g[15]);
          bf16_t* yp = ycat + (size_t)m * 2048 + 1024 + 16 * lane;
          *(u32x4*)yp = w0; *(u32x4*)(yp + 8) = w1; }
    }
}

struct SchedDense {
    int G, c, nM, nN; const char* A; const char* B; unsigned lda, ldb; int bdiv; size_t bstride;
    DI bool next(int i, pg8::UnitD& u) const {
        const int L = i * G + c; if (L >= nM * nN) return false;
        u.rows = nullptr; u.nvalid = 0; u.lda = lda; u.ldb = ldb; u.type = 0; u.e = 0; u.x0 = 0;
        u.pn = L / nM; u.pm = L % nM;
        u.A = A + (size_t)u.pm * 256 * lda; u.B = B + (size_t)u.pn * 256 * ldb + (size_t)(u.pm / bdiv) * bstride;
        return true;
    }
};
struct EpiResid {
    static constexpr bool AFTER_DRAIN = false;
    const float* base; float* out; bf16_t* outb; float* part; unsigned char* out8; float accscale;
    DI void operator()(const f32x4 (&acc)[2][2][4][2], const pg8::UnitD& u, int wr, int wc, int fr, int fq) const {
        { int ln_ = threadIdx.x; asm volatile("" : "+v"(ln_)); fr = ln_ & 15; fq = (ln_ >> 4) & 3; }
        const int row0 = u.pm * 256 + wr * 64 + fr, col0 = u.pn * 256 + wc * 32 + 8 * fq;
#pragma unroll
        for (int ai = 0; ai < 2; ++ai)
#pragma unroll
            for (int m = 0; m < 4; ++m) { const size_t row = (size_t)(row0 + ai * 128 + m * 16); float ss = 0.f;
#pragma unroll
                for (int bj = 0; bj < 2; ++bj) { const size_t idx = row * 2048 + col0 + bj * 128;
                    f32x4 v0 = acc[ai][bj][m][0] * accscale + *(const f32x4*)(base + idx), v1 = acc[ai][bj][m][1] * accscale + *(const f32x4*)(base + idx + 4);
                    *(f32x4*)(out + idx) = v0; *(f32x4*)(out + idx + 4) = v1;
                    if (out8) { u32x2 w; w.x = __builtin_amdgcn_cvt_pk_fp8_f32(v0[0] * 16.f, v0[1] * 16.f, 0u, false); w.x = __builtin_amdgcn_cvt_pk_fp8_f32(v0[2] * 16.f, v0[3] * 16.f, w.x, true);
                        w.y = __builtin_amdgcn_cvt_pk_fp8_f32(v1[0] * 16.f, v1[1] * 16.f, 0u, false); w.y = __builtin_amdgcn_cvt_pk_fp8_f32(v1[2] * 16.f, v1[3] * 16.f, w.y, true); *(u32x2*)(out8 + idx) = w; }
                    if (outb) { u32x4 w; w.x = pk2(v0[0], v0[1]); w.y = pk2(v0[2], v0[3]); w.z = pk2(v1[0], v1[1]); w.w = pk2(v1[2], v1[3]); *(u32x4*)(outb + idx) = w; }
                    ss += (v0[0] * v0[0] + v0[1] * v0[1]) + (v0[2] * v0[2] + v0[3] * v0[3]) + (v1[0] * v1[0] + v1[1] * v1[1]) + (v1[2] * v1[2] + v1[3] * v1[3]); }
                if (part) { ss += __shfl_xor(ss, 16); ss += __shfl_xor(ss, 32); if (fq == 0) part[row * 32 + u.pn * 4 + wc] = ss; } }
    }
};

struct EpiQ {
    static constexpr bool AFTER_DRAIN = false;
    unsigned char* out8; float* part;
    DI void operator()(const f32x4 (&acc)[2][2][4][2], const pg8::UnitD& u, int wr, int wc, int fr, int fq) const {
        { int ln_ = threadIdx.x; asm volatile("" : "+v"(ln_)); fr = ln_ & 15; fq = (ln_ >> 4) & 3; }
        const int row0 = u.pm * 256 + wr * 64 + fr, col0 = u.pn * 256 + wc * 32 + 8 * fq;
#pragma unroll
        for (int ai = 0; ai < 2; ++ai)
#pragma unroll
            for (int m = 0; m < 4; ++m) { const size_t row = (size_t)(row0 + ai * 128 + m * 16); float ss = 0.f;
#pragma unroll
                for (int bj = 0; bj < 2; ++bj) { const size_t idx = row * 2048 + col0 + bj * 128; const f32x4 v0 = acc[ai][bj][m][0] * (1.f / 1024.f), v1 = acc[ai][bj][m][1] * (1.f / 1024.f);
                    u32x2 w; w.x = __builtin_amdgcn_cvt_pk_fp8_f32(v0[0] * 16.f, v0[1] * 16.f, 0u, false); w.x = __builtin_amdgcn_cvt_pk_fp8_f32(v0[2] * 16.f, v0[3] * 16.f, w.x, true);
                    w.y = __builtin_amdgcn_cvt_pk_fp8_f32(v1[0] * 16.f, v1[1] * 16.f, 0u, false); w.y = __builtin_amdgcn_cvt_pk_fp8_f32(v1[2] * 16.f, v1[3] * 16.f, w.y, true); *(u32x2*)(out8 + idx) = w;
                    ss += (v0[0] * v0[0] + v0[1] * v0[1]) + (v0[2] * v0[2] + v0[3] * v0[3]) + (v1[0] * v1[0] + v1[1] * v1[1]) + (v1[2] * v1[2] + v1[3] * v1[3]); }
                ss += __shfl_xor(ss, 16); ss += __shfl_xor(ss, 32); if (fq == 0) part[row * 32 + u.pn * 4 + wc] = ss; }
    }
};

struct SchedXS {
    int G, c; const unsigned char* ws;
    DI bool next(int i, pg8::UnitD& u) const {
        const int L = i * G + c; if (L >= 256) return false;
        u.rows = nullptr; u.nvalid = 0; u.e = 0;
        const int q = L & 127, bh = q >> 3, t8 = q & 7, b = bh >> 2, h = bh & 3;
        u.pm = b; u.pn = h; u.x0 = t8;
        if (L < 128) { u.type = 0; u.lda = 2048u; u.ldb = 512u;
            u.A = (const char*)(ws + WS_QF8) + (size_t)(b * 2048 + t8 * 256) * 2048 + h * 512; u.B = (const char*)(ws + WS_KN8) + (size_t)(bh * 256) * 512; }
        else { u.type = 1; u.lda = 2048u; u.ldb = 2048u;
            u.A = (const char*)(ws + WS_WO) + (size_t)(t8 * 256) * 2048 + h * 512; u.B = (const char*)(ws + WS_VF8) + (size_t)(b * 256) * 2048 + h * 512; }
        return true;
    }
};
struct EpiXS {
    static constexpr bool AFTER_DRAIN = false;
    unsigned char* P; unsigned char* VWT; const float* part1; const float* partq; LAS float* red;
    DI void operator()(const f32x4 (&acc)[2][2][4][2], const pg8::UnitD& u, int wr, int wc, int fr, int fq) const {
        { int ln_ = threadIdx.x; asm volatile("" : "+v"(ln_)); fr = ln_ & 15; fq = (ln_ >> 4) & 3; }
        const int b = u.pm, h = u.pn, t8 = u.x0;
        const int col0 = wc * 32 + 8 * fq;
        if (u.type == 1) {
            unsigned char* Vu = VWT + ((size_t)b * 2048 + t8 * 256) * 1024 + h * 256;
#pragma unroll
            for (int ai = 0; ai < 2; ++ai)
#pragma unroll
                for (int m = 0; m < 4; ++m) { const unsigned rl = (unsigned)(ai * 128 + wr * 64 + m * 16 + fr);
#pragma unroll
                    for (int bj = 0; bj < 2; ++bj) { const f32x4 v0 = acc[ai][bj][m][0] * (32.f / 1024.f), v1 = acc[ai][bj][m][1] * (32.f / 1024.f);
                        u32x2 w; w.x = __builtin_amdgcn_cvt_pk_fp8_f32(v0[0], v0[1], 0u, false); w.x = __builtin_amdgcn_cvt_pk_fp8_f32(v0[2], v0[3], w.x, true);
                        w.y = __builtin_amdgcn_cvt_pk_fp8_f32(v1[0], v1[1], 0u, false); w.y = __builtin_amdgcn_cvt_pk_fp8_f32(v1[2], v1[3], w.y, true);
                        *(u32x2*)(Vu + (rl * 1024u + (unsigned)(bj * 128 + col0))) = w; } }
            return;
        }
        const size_t row0 = (size_t)b * 2048 + t8 * 256;
        const char* p1u = (const char*)(part1 + row0 * 32); const char* pqu = (const char*)(partq + row0 * 32 + h * 8); unsigned char* Pu = P + row0 * 1024 + h * 256;
        float rsc[2][4];
#pragma unroll
        for (int ai = 0; ai < 2; ++ai)
#pragma unroll
            for (int m = 0; m < 4; ++m) { const unsigned rl = (unsigned)(ai * 128 + wr * 64 + m * 16 + fr);
                const f32x4 p0 = *(const f32x4*)(p1u + (rl * 32u + (unsigned)fq * 8u) * 4u), p1 = *(const f32x4*)(p1u + (rl * 32u + (unsigned)fq * 8u + 4u) * 4u);
                float s1 = (p0[0] + p0[1]) + (p0[2] + p0[3]) + (p1[0] + p1[1]) + (p1[2] + p1[3]);
                const f32x2 pq = *(const f32x2*)(pqu + (rl * 32u + (unsigned)fq * 2u) * 4u);
                float sq = pq[0] + pq[1];
                s1 = quad_sum_16_32(s1); sq = quad_sum_16_32(sq);
                rsc[ai][m] = __builtin_amdgcn_rsqf(sq * (1.f / 512.f) + EPS_ * (s1 * (1.f / 2048.f) + EPS_)) * (1.4426950408889634f / 2048.f);
                float ps = 0.f;
#pragma unroll
                for (int bj = 0; bj < 2; ++bj)
#pragma unroll
                    for (int n = 0; n < 2; ++n)
#pragma unroll
                        for (int e = 0; e < 4; ++e) ps += __builtin_amdgcn_exp2f(fminf(acc[ai][bj][m][n][e] * rsc[ai][m], 100.f));
                ps = quad_sum_16_32(ps);
                if (fq == 0) red[rl * 4 + wc] = ps;
                __builtin_amdgcn_sched_barrier(0); }
        __syncthreads();
        { int ln_ = threadIdx.x; asm volatile("" : "+v"(ln_)); fr = ln_ & 15; fq = (ln_ >> 4) & 3; }
#pragma unroll
        for (int ai = 0; ai < 2; ++ai)
#pragma unroll
            for (int m = 0; m < 4; ++m) { const unsigned rl = (unsigned)(ai * 128 + wr * 64 + m * 16 + fr);
                const f32x4 t = *(const LAS f32x4*)(red + rl * 4); const float inv = 256.f * __builtin_amdgcn_rcpf((t[0] + t[1]) + (t[2] + t[3])); float rs = rsc[ai][m]; asm volatile("" : "+v"(rs));
#pragma unroll
                for (int bj = 0; bj < 2; ++bj) { float x[8];
#pragma unroll
                    for (int n = 0; n < 2; ++n)
#pragma unroll
                        for (int e = 0; e < 4; ++e) x[n * 4 + e] = __builtin_amdgcn_exp2f(fminf(acc[ai][bj][m][n][e] * rs, 100.f)) * inv;
                    u32x2 w; w.x = __builtin_amdgcn_cvt_pk_fp8_f32(x[0], x[1], 0u, false); w.x = __builtin_amdgcn_cvt_pk_fp8_f32(x[2], x[3], w.x, true);
                    w.y = __builtin_amdgcn_cvt_pk_fp8_f32(x[4], x[5], 0u, false); w.y = __builtin_amdgcn_cvt_pk_fp8_f32(x[6], x[7], w.y, true);
                    *(u32x2*)(Pu + (rl * 1024u + (unsigned)(bj * 128 + wc * 32 + 8 * fq))) = w; } }
        __syncthreads();
    }
};

constexpr int HNP = 2052;
DI void p8_route(Frame& F, const ArgP& a) {
    LAS float* s_hn = (LAS float*)F.lds; LAS float* s_part = (LAS float*)(F.lds + 16 * HNP * 4); LAS float* s_log = s_part + 8 * 16 * 32; LAS int* s_slot = (LAS int*)(s_log + 16 * 32);
    LAS int* s_cnt = s_slot + 64; LAS int* s_base = s_cnt + 32;
    const float* h2 = (const float*)(F.ws + WS_H2); unsigned char* xg = (unsigned char*)(F.ws + WS_XG);
    float* gate_of = (float*)(F.ws + WS_GATEOF); int* tok_e = (int*)(F.ws + WS_TOKE);
    const float* rw = a.in(I_RW); const float* rb = a.in(I_RB); const float* g3 = a.in(I_GFFN);
    const int lane = F.lane, wave = F.wave, tid = F.tid;
    float bw0[64], bw1[64];
    { const int kq = lane >> 4, c16 = lane & 15; const float* bp = rw + (size_t)(256 * wave + kq) * 32 + c16;
#pragma unroll
      for (int j = 0; j < 64; ++j) { bw0[j] = bp[(size_t)(4 * j) * 32]; bw1[j] = bp[(size_t)(4 * j) * 32 + 16]; } }
    for (int task = F.vcu; task < NTOK / 16; task += F.G) {
        const int tb = task * 16;
#pragma unroll
        for (int q = 0; q < 2; ++q) { const int tl = 2 * wave + q; const size_t tok = (size_t)(tb + tl);
            const f32x4* xr = (const f32x4*)(h2 + tok * 2048) + lane;
            f32x4 v[8]; float s = 0.f;
#pragma unroll
            for (int j = 0; j < 8; ++j) { v[j] = xr[64 * j]; s += (v[j].x * v[j].x + v[j].y * v[j].y) + (v[j].z * v[j].z + v[j].w * v[j].w); }
            const float rstd = 1.f / sqrtf(wave_sum(s) * (1.f / 2048.f) + EPS_);
#pragma unroll
            for (int j = 0; j < 8; ++j) { const f32x4 gg = ((const f32x4*)g3)[lane + 64 * j]; const f32x4 y = v[j] * rstd * gg;
                *(LAS f32x4*)(s_hn + tl * HNP + (lane + 64 * j) * 4) = y; } }
        __syncthreads();
        {
            f32x4 acc0 = {0.f, 0.f, 0.f, 0.f}, acc1 = {0.f, 0.f, 0.f, 0.f};
            const int kq = lane >> 4, c16 = lane & 15;
            const LAS float* ap = s_hn + c16 * HNP + 256 * wave;
#pragma unroll
            for (int j = 0; j < 64; ++j) { const f32x4 a4 = *(const LAS f32x4*)(ap + 4 * j);
                const float av = (kq == 0) ? a4.x : (kq == 1) ? a4.y : (kq == 2) ? a4.z : a4.w;
                acc0 = __builtin_amdgcn_mfma_f32_16x16x4f32(av, bw0[j], acc0, 0, 0, 0);
                acc1 = __builtin_amdgcn_mfma_f32_16x16x4f32(av, bw1[j], acc1, 0, 0, 0); }
            LAS float* pp = s_part + wave * 512 + c16;
#pragma unroll
            for (int r = 0; r < 4; ++r) { pp[(4 * kq + r) * 32] = acc0[r]; pp[(4 * kq + r) * 32 + 16] = acc1[r]; }
        }
        __syncthreads();
        {
            const int tt = tid >> 5, e = tid & 31; float lg = rb[e];
#pragma unroll
            for (int w = 0; w < 8; ++w) lg += s_part[w * 512 + tt * 32 + e];
            if (tid < 32) s_cnt[tid] = 0;
            float val[4]; int idx[4]; float cur = lg;
#pragma unroll
            for (int k = 0; k < 4; ++k) { float bv = cur; int bi = e;
#pragma unroll
                for (int o = 1; o < 32; o <<= 1) { const float ov = __shfl_xor(bv, o); const int oi = __shfl_xor(bi, o); if (ov > bv || (ov == bv && oi < bi)) { bv = ov; bi = oi; } }
                val[k] = bv; idx[k] = bi; if (e == bi) cur = -INFINITY; }
            __syncthreads();
            int myrank = 0, myexp = 0; float mygate = 0.f;
            if (e < 4) { const float sum = (__expf(val[0] - val[0]) + __expf(val[1] - val[0])) + (__expf(val[2] - val[0]) + __expf(val[3] - val[0]));
                const float mv = (e == 0) ? val[0] : (e == 1) ? val[1] : (e == 2) ? val[2] : val[3]; myexp = (e == 0) ? idx[0] : (e == 1) ? idx[1] : (e == 2) ? idx[2] : idx[3];
                mygate = __expf(mv - val[0]) / sum; myrank = __hip_atomic_fetch_add(&s_cnt[myexp], 1, __ATOMIC_RELAXED, __HIP_MEMORY_SCOPE_WORKGROUP); }
            __syncthreads();
            if (tid < 32) { const int c = s_cnt[tid]; s_base[tid] = c ? (int)__hip_atomic_fetch_add(F.ctl + CW_CNT + 64 * tid, (unsigned)c, __ATOMIC_RELAXED, __HIP_MEMORY_SCOPE_AGENT) : 0; }
            __syncthreads();
            if (e < 4) { const int slot = myexp * 8192 + s_base[myexp] + myrank; const int tok = tb + tt;
                gate_of[slot] = mygate; tok_e[tok * 4 + e] = slot; s_slot[tt * 4 + e] = slot; }
        }
        __syncthreads();
#pragma unroll
        for (int q = 0; q < 2; ++q) { const int tl = 2 * wave + q;
            unsigned o[8];
#pragma unroll
            for (int j = 0; j < 8; ++j) { const f32x4 y = *(const LAS f32x4*)(s_hn + tl * HNP + (lane + 64 * j) * 4);
                unsigned w = 0u; w = __builtin_amdgcn_cvt_pk_fp8_f32(y.x * 4.f, y.y * 4.f, w, false); w = __builtin_amdgcn_cvt_pk_fp8_f32(y.z * 4.f, y.w * 4.f, w, true); o[j] = w; }
#pragma unroll
            for (int k = 0; k < 4; ++k) { unsigned* o4 = (unsigned*)(xg + (size_t)s_slot[tl * 4 + k] * 2048) + lane;
#pragma unroll
                for (int j = 0; j < 8; ++j) o4[64 * j] = o[j]; } }
        __syncthreads();
    }
}

DI void moe_tables(Frame& F) {
    if (F.tid == 0) { unsigned base = 0u;
        for (int e = 0; e < 32; ++e) { const unsigned c = F.ctl[CW_CNT + 64 * e], mt = (c + 255u) >> 8; F.MISC[16 + e] = c; F.MISC[48 + e] = base; F.MISC[80 + e] = mt; base += mt; }
        F.MISC[112] = base; }
    __syncthreads();
}
DI int ldsu(volatile LAS unsigned* p) { return __builtin_amdgcn_readfirstlane((int)*p); }
template <int NTN  >
struct SchedMoe {
    int G, c; const unsigned char* ws; volatile LAS unsigned* MISC; int total;
    DI bool next(int i, pg8::UnitD& u) const {
        const int L = i * G + c; if (L >= total) return false;
        int e = 0;
        for (int k = 0; k < 32; ++k) { if (L >= (ldsu(MISC + 48 + k) + ldsu(MISC + 80 + k)) * NTN) e = k + 1; }
        const int tb = ldsu(MISC + 48 + e), mte = ldsu(MISC + 80 + e), cnt = ldsu(MISC + 16 + e);
        const int local = L - tb * NTN, nt = local / mte, mt = local % mte;
        u.type = 0; u.e = e; u.pn = nt; u.pm = tb + mt; u.x0 = mt; u.lda = 2048u; u.ldb = 2048u;
        u.rows = nullptr; u.nvalid = cnt - mt * 256;
        if (NTN == 16) { u.A = (const char*)(ws + WS_XG) + ((size_t)e * 8192 + (size_t)mt * 256) * 2048;
            u.B = (const char*)(ws + WS_W1) + ((size_t)e * 4096 + (size_t)nt * 256) * 2048; }
        else { u.A = (const char*)(ws + WS_ACT) + ((size_t)e * 8192 + (size_t)mt * 256) * 2048;
            u.B = (const char*)(ws + WS_W2) + ((size_t)e * 2048 + (size_t)nt * 256) * 2048; }
        return true;
    }
};
struct EpiMoe1 {
    static constexpr bool AFTER_DRAIN = false;
    unsigned char* act; const float* b1;
    DI void operator()(const f32x4 (&acc)[2][2][4][2], const pg8::UnitD& u, int wr, int wc, int fr, int fq) const {
        { int ln_ = threadIdx.x; asm volatile("" : "+v"(ln_)); fr = ln_ & 15; fq = (ln_ >> 4) & 3; }
        const int j0 = u.pn * 128 + wc * 32 + 8 * fq;
        const float* bg = b1 + (size_t)u.e * 4096 + j0; const float* bu = bg + 2048;
        const f32x4 bg0 = *(const f32x4*)bg, bg1 = *(const f32x4*)(bg + 4), bu0 = *(const f32x4*)bu, bu1 = *(const f32x4*)(bu + 4);
#pragma unroll
        for (int ai = 0; ai < 2; ++ai)
#pragma unroll
            for (int m = 0; m < 4; ++m) { const size_t row = (size_t)u.e * 8192 + u.x0 * 256 + ai * 128 + wr * 64 + m * 16 + fr;
                float o[8];
#pragma unroll
                for (int n = 0; n < 2; ++n)
#pragma unroll
                    for (int e = 0; e < 4; ++e) { const float g = fminf(acc[ai][0][m][n][e] * (1.f / 256.f) + (n ? bg1[e] : bg0[e]), 7.f);
                        const float uu = fminf(fmaxf(acc[ai][1][m][n][e] * (1.f / 256.f) + (n ? bu1[e] : bu0[e]), -7.f), 7.f);
                        o[n * 4 + e] = g / (1.f + __expf(-1.702f * g)) * (uu + 1.f) * 4.f; }
                u32x2 w; w.x = __builtin_amdgcn_cvt_pk_fp8_f32(o[0], o[1], 0u, false); w.x = __builtin_amdgcn_cvt_pk_fp8_f32(o[2], o[3], w.x, true);
                w.y = __builtin_amdgcn_cvt_pk_fp8_f32(o[4], o[5], 0u, false); w.y = __builtin_amdgcn_cvt_pk_fp8_f32(o[6], o[7], w.y, true);
                *(u32x2*)(act + row * 2048 + j0) = w; }
    }
};
struct EpiMoe2 {
    static constexpr bool AFTER_DRAIN = false;
    bf16_t* y; const float* b2; const float* gate_of;
    DI void operator()(const f32x4 (&acc)[2][2][4][2], const pg8::UnitD& u, int wr, int wc, int fr, int fq) const {
        { int ln_ = threadIdx.x; asm volatile("" : "+v"(ln_)); fr = ln_ & 15; fq = (ln_ >> 4) & 3; }
        const int col0 = u.pn * 256 + wc * 32 + 8 * fq;
        const float* bp = b2 + (size_t)u.e * 2048 + col0;
#pragma unroll
        for (int ai = 0; ai < 2; ++ai)
#pragma unroll
            for (int m = 0; m < 4; ++m) { const int rl = ai * 128 + wr * 64 + m * 16 + fr; const size_t row = (size_t)u.e * 8192 + u.x0 * 256 + rl;
                const float gt = (rl < u.nvalid) ? gate_of[u.e * 8192 + u.x0 * 256 + rl] : 0.f;
#pragma unroll
                for (int bj = 0; bj < 2; ++bj) { const f32x4 v0 = (acc[ai][bj][m][0] * (1.f / 256.f) + *(const f32x4*)(bp + bj * 128)) * gt, v1 = (acc[ai][bj][m][1] * (1.f / 256.f) + *(const f32x4*)(bp + bj * 128 + 4)) * gt;
                    u32x4 w; w.x = pk2(v0[0], v0[1]); w.y = pk2(v0[2], v0[3]); w.z = pk2(v1[0], v1[1]); w.w = pk2(v1[2], v1[3]);
                    *(u32x4*)(y + row * 2048 + col0 + bj * 128) = w; } }
    }
};

DI void p11_combine(Frame& F, const ArgP& a) {
    const int gw = F.vcu * NWAVES + F.wave, NGW = F.G * NWAVES, lane = F.lane;
    const float* h2 = (const float*)(F.ws + WS_H2); const bf16_t* y = (const bf16_t*)(F.ws + WS_Y);
    const int* tok_e = (const int*)(F.ws + WS_TOKE);
    for (int t = gw; t < NTOK; t += NGW) {
        size_t yrow[4];
#pragma unroll
        for (int k = 0; k < 4; ++k) yrow[k] = (size_t)tok_e[t * 4 + k] * 2048;
#pragma unroll
        for (int j = 0; j < 8; ++j) { const int c = (lane + 64 * j) * 4;
            f32x4 v = *(const f32x4*)(h2 + (size_t)t * 2048 + c);
#pragma unroll
            for (int k = 0; k < 4; ++k) { const u32x2 w = *(const u32x2*)(y + yrow[k] + c); v.x += bflo(w.x); v.y += bfhi(w.x); v.z += bflo(w.y); v.w += bfhi(w.y); }
            *(f32x4*)(a.out() + (size_t)t * 2048 + c) = v; }
    }
}

#ifndef MK_PER_PHASE
#define MK_PER_PHASE 0
#endif
#ifndef MK_LAST_PHASE
#define MK_LAST_PHASE 12
#endif
constexpr int N_PHASES = MK_LAST_PHASE;

__global__ void __launch_bounds__(NWAVES * 64, 2) mega_fwd(Args args_) {
    const ArgP args{};
    extern __shared__ __attribute__((aligned(16))) unsigned char lds_raw[];
    Frame F;
    F.lds = (LAS unsigned char*)lds_raw;
    F.MISC = (volatile LAS unsigned*)(F.lds + MISC_OFF);
    F.tid = threadIdx.x; F.lane = F.tid & 63; F.wave = __builtin_amdgcn_readfirstlane(F.tid >> 6);
    F.G = gridDim.x; { const int bx = blockIdx.x; F.vcu = (F.G % 8 == 0) ? (bx % 8) * (F.G / 8) + bx / 8 : bx; }
    F.ws = args_.ws; F.ctl = (unsigned*)(args_.ws + WS_CTL);
    for (int u = F.tid; u < 256; u += NWAVES * 64) F.MISC[u] = 0u;
    __syncthreads();
    XcdBarrier bar; bar.bar = F.ctl + CW_BAR; bar.x = 0; bar.st = nullptr;
    const int lo = args_.ph_lo, hi = args_.ph_hi;
    if (hi - lo > 1) bar = xcd_barrier_post(F.ctl + CW_BAR, F.MISC + 8);
#ifndef MK_PHASE_MASK
#define MK_PHASE_MASK 0xFFFF
#endif
#define IN(k) (((MK_PHASE_MASK >> (k)) & 1) && lo <= (k) && (k) < hi)
#define SEAM(k) do { if (IN(k) && IN((k) + 1)) xcd_barrier(bar); } while (0)
#define FRESH() do { int t_ = threadIdx.x; asm volatile("" : "+v"(t_)); F.tid = t_; F.lane = t_ & 63; F.wave = __builtin_amdgcn_readfirstlane(t_ >> 6); } while (0)
    unsigned char* ws = args_.ws;

    if (IN(0)) { FRESH(); p0_prologue(F, args); }
    SEAM(0);
    if (IN(1)) { FRESH();
        const bool conv_first = (F.vcu & 1) == 0;
        if (conv_first) { conv_share(F, args); __syncthreads(); }
        SchedP1 S{F.G, F.vcu, ws, 0, 32 * 23};
        EpiP1 E{(bf16_t*)(ws + WS_PROJ), (float*)(ws + WS_DT), (bf16_t*)(ws + WS_KVRAW), args.in(I_DAQG), args.in(I_DAKG), (unsigned char*)(ws + WS_VF8)};
        pg8::gemm_phase<EpiP1, SchedP1, false, true>(F.lds + RING_OFF, 32, S, E);
        if (!conv_first) { __syncthreads(); conv_share(F, args); }
    }
    SEAM(1);
    if (IN(2)) { FRESH();
        if ((F.vcu & 3) == 1) {
            SchedP1 S{(F.G + 3) >> 2, F.vcu >> 2, ws, 32 * 23, 32 * 23 + 64};
            EpiP1 E{(bf16_t*)(ws + WS_PROJ), (float*)(ws + WS_DT), (bf16_t*)(ws + WS_KVRAW), args.in(I_DAQG), args.in(I_DAKG), (unsigned char*)(ws + WS_VF8)};
            pg8::gemm_phase<EpiP1, SchedP1, false, true>(F.lds + RING_OFF, 32, S, E);
            __syncthreads();
        }
        if ((F.vcu & 3) == 0) { for (int u = F.vcu >> 2; u < 64; u += (F.G + 3) >> 2) ssd_unit(F, args, u >> 4, u & 15); }
        __syncthreads();
        attn_phase_da(F);
        __syncthreads();
        conv_queue(F, args, CW_QCONV, CV_NJ - CV_TAIL, CV_TAIL1);
    }
    SEAM(2);
    if (IN(3)) { FRESH(); kprep(F, args); p3_finalize(F, args); }
    SEAM(3);
    if (IN(4)) { FRESH();
        SchedDense S{F.G, F.vcu, 32, 8, (const char*)(ws + WS_YCAT), (const char*)(ws + WS_WOUT), 4096u, 4096u, 1 << 30, 0};
#if MK_LAST_PHASE == 5
        EpiResid E{args.in(I_X), args_.out, nullptr, nullptr, nullptr, 1.f};
#else
        EpiResid E{args.in(I_X), (float*)(ws + WS_H1), nullptr, (float*)(ws + WS_PART1), (unsigned char*)(ws + WS_H1F8), 1.f};
#endif
        pg8::gemm_phase<EpiResid, SchedDense, false, true>(F.lds + RING_OFF, 32, S, E);
    }
    SEAM(4);
    if (IN(5)) { FRESH();
        SchedDense S{F.G, F.vcu, 32, 8, (const char*)(ws + WS_H1F8), (const char*)(ws + WS_WQ), 2048u, 2048u, 1 << 30, 0};
        EpiQ E{(unsigned char*)(ws + WS_QF8), (float*)(ws + WS_PARTQ)};
        pg8::gemm_phase<EpiQ, SchedDense, false, true, true>(F.lds + RING_OFF, 16, S, E);
    }
    SEAM(5);
    if (IN(6)) { FRESH();
        SchedXS S{F.G, F.vcu, ws};
        EpiXS E{(unsigned char*)(ws + WS_P8), (unsigned char*)(ws + WS_VWT8), (const float*)(ws + WS_PART1), (const float*)(ws + WS_PARTQ), (LAS float*)(F.lds + RING_BYTES)};
        pg8::gemm_phase<EpiXS, SchedXS, false, true, true>(F.lds + RING_OFF, 4, S, E);
    }
    SEAM(6);
    if (IN(7)) { FRESH();
        SchedDense S{F.G, F.vcu, 32, 8, (const char*)(ws + WS_P8), (const char*)(ws + WS_VWT8), 1024u, 1024u, 8, (size_t)2048 * 1024};
#if MK_LAST_PHASE == 8
        EpiResid E{(const float*)(ws + WS_H1), args_.out, nullptr, nullptr, nullptr, 1.f / 8192.f};
#else
        EpiResid E{(const float*)(ws + WS_H1), (float*)(ws + WS_H2), nullptr, nullptr, nullptr, 1.f / 8192.f};
#endif
        pg8::gemm_phase<EpiResid, SchedDense, false, true, true>(F.lds + RING_OFF, 8, S, E);
    }
    SEAM(7);
    if (IN(8)) { FRESH(); p8_route(F, args); }
    SEAM(8);
    if (IN(9)) { FRESH();
        moe_tables(F);
        SchedMoe<16> S{F.G, F.vcu, ws, F.MISC, ldsu(F.MISC + 112) * 16};
        EpiMoe1 E{(unsigned char*)(ws + WS_ACT), args.in(I_B1)};
        pg8::gemm_phase<EpiMoe1, SchedMoe<16>, false, true, true>(F.lds + RING_OFF, 16, S, E);
        __syncthreads();
        conv_queue(F, args, CW_QCONV2, CV_NJ - CV_TAIL2, CV_TAIL2);
    }
    SEAM(9);
    if (IN(10)) { FRESH();
        moe_tables(F);
        SchedMoe<8> S{F.G, F.vcu, ws, F.MISC, ldsu(F.MISC + 112) * 8};
        EpiMoe2 E{(bf16_t*)(ws + WS_Y), args.in(I_B2), (const float*)(ws + WS_GATEOF)};
        pg8::gemm_phase<EpiMoe2, SchedMoe<8>, false, true, true>(F.lds + RING_OFF, 16, S, E);
    }
    SEAM(10);
    if (IN(11)) { FRESH(); p11_combine(F, args); }
#undef IN
#undef SEAM
}

extern "C" void kernel_launch(void* const* d_in, const int* in_sizes, int n_in, void* d_out, int out_size, void* d_ws, size_t ws_size, hipStream_t stream) {
    static int grid = 0;
    if (grid == 0) {
        if (n_in != 32 || out_size != NTOK * 2048 || ws_size < WS_END) { fprintf(stderr, "kernel_launch: unexpected shapes (n_in %d out %d ws %zu); nothing launched\n", n_in, out_size, ws_size); grid = -1; return; }
        int dev = 0, cus = 0, per_cu = 0;
        if (hipGetDevice(&dev) != hipSuccess || hipDeviceGetAttribute(&cus, hipDeviceAttributeMultiprocessorCount, dev) != hipSuccess) { grid = -1; return; }
        if (hipFuncSetAttribute((const void*)mega_fwd, hipFuncAttributeMaxDynamicSharedMemorySize, LDS_BYTES) != hipSuccess) { fprintf(stderr, "kernel_launch: hipFuncSetAttribute failed\n"); grid = -1; return; }
        if (hipOccupancyMaxActiveBlocksPerMultiprocessor(&per_cu, (const void*)mega_fwd, NWAVES * 64, LDS_BYTES) != hipSuccess || per_cu < 1) { fprintf(stderr, "kernel_launch: occupancy query says %d\n", per_cu); }
        (void)hipGetLastError();
        if (cus < 256) { fprintf(stderr, "kernel_launch: needs 256 CUs, found %d; nothing launched\n", cus); grid = -1; return; }
        grid = 256;
    }
    if (grid < 0) return;
    if (hipMemsetAsync((char*)d_ws + WS_CTL, 0, CTL_ZERO_BYTES, stream) != hipSuccess) return;
    Args a{};
    for (int i = 0; i < 32; ++i) a.in[i] = (const float*)d_in[i];
    a.out = (float*)d_out; a.ws = (unsigned char*)d_ws;
#if MK_PER_PHASE
    for (int p = 0; p < N_PHASES; ++p) { a.ph_lo = p; a.ph_hi = p + 1; hipLaunchKernelGGL(mega_fwd, dim3(grid), dim3(NWAVES * 64), LDS_BYTES, stream, a); }
#else
    a.ph_lo = 0; a.ph_hi = N_PHASES;
    hipLaunchKernelGGL(mega_fwd, dim3(grid), dim3(NWAVES * 64), LDS_BYTES, stream, a);
#ifdef MK_PROBE_LO
    for (int p = MK_PROBE_LO; p < MK_PROBE_HI; ++p) { a.ph_lo = p; a.ph_hi = p + 1;
        if (p == 2) (void)hipMemsetAsync((char*)d_ws + WS_CTL + CW_QATT * 4, 0, 1024, stream);
        hipLaunchKernelGGL(mega_fwd, dim3(grid), dim3(NWAVES * 64), LDS_BYTES, stream, a); }
#endif
#endif
}
```

```cpp
#define MK_PER_PHASE 0
#define MK_LAST_PHASE 12
#include <hip/hip_runtime.h>
#include <hip/hip_bf16.h>
#include <cstdio>
#include <cstdint>
#include <cmath>

#define GAS __attribute__((address_space(1)))
#define LAS __attribute__((address_space(3)))
typedef unsigned short bf16_t;
typedef short bf16x8 __attribute__((ext_vector_type(8)));
typedef float f32x2 __attribute__((ext_vector_type(2)));
typedef float f32x4 __attribute__((ext_vector_type(4)));
typedef float f32x16 __attribute__((ext_vector_type(16)));
typedef unsigned u32x2 __attribute__((ext_vector_type(2)));
typedef unsigned u32x4 __attribute__((ext_vector_type(4)));
typedef __bf16 bf16x2_t __attribute__((ext_vector_type(2)));

#define DI __device__ __forceinline__
DI unsigned pk2(float lo, float hi) { f32x2 v = {lo, hi}; bf16x2_t b = __builtin_convertvector(v, bf16x2_t); return __builtin_bit_cast(unsigned, b); }
DI float bflo(unsigned u) { return __uint_as_float(u << 16); }
DI float bfhi(unsigned u) { return __uint_as_float(u & 0xffff0000u); }
DI float bf2f(bf16_t h) { return __uint_as_float(((unsigned)h) << 16); }
DI float wave_sum(float v) {
#pragma unroll
    for (int o = 1; o < 64; o <<= 1) v += __shfl_xor(v, o);
    return v;
}
DI float quad_sum_16_32(float v) {
    int l_ = threadIdx.x; asm volatile("" : "+v"(l_));
    const int a16 = ((l_ ^ 16) & 63) << 2, a32 = ((l_ ^ 32) & 63) << 2;
    v += __builtin_bit_cast(float, __builtin_amdgcn_ds_bpermute(a16, __builtin_bit_cast(int, v)));
    v += __builtin_bit_cast(float, __builtin_amdgcn_ds_bpermute(a32, __builtin_bit_cast(int, v)));
    return v;
}
DI float siluf(float x) { return x / (1.f + __expf(-x)); }

constexpr int DM_ = 2048, NB = 4, SEQ_ = 2048, NTOK = NB * SEQ_;
constexpr int PP = 5632;
constexpr int PC_XBC = 1024, PC_Q = 2560, PC_K = 3584, PC_V = 4608, PC_DT = 5632;
constexpr int WIN_ROWS = 5888;
constexpr int NEXP = 32, MEMLEN = 256;
constexpr float EPS_ = 1e-6f;
constexpr float LAM_INIT = 0.2f;

namespace pg8 {
constexpr int BM = 256, BK = 64, HALF = 128, HTB = HALF * BK * 2  , STAGE_BYTES = 8 * HTB;
DI int lds_byte(int r, int c) { const int st = (r >> 4) * 2 + (c >> 5), rr = r & 15, cc = c & 31, ob = rr * 64 + cc * 2; return st * 1024 + (ob ^ (((ob >> 9) & 1) << 5)); }
DI void stage_rc(int b, int& R, int& C) { const int st = b / 1024, sb = b % 1024, swz = sb ^ (((sb >> 9) & 1) << 5); R = (st >> 1) * 16 + swz / 64; C = (st & 1) * 32 + (swz % 64) / 2; }
DI int perm32(int rho) { const int n = rho >> 4, i = rho & 15; return 8 * (i >> 2) + 4 * n + (i & 3); }

struct UnitD {
    const char* A; const char* B;
    const int* rows;
    unsigned lda, ldb;
    int nvalid;
    int type, pm, pn, e, x0;
};
typedef int v8i_t __attribute__((ext_vector_type(8)));
DI v8i_t cat8(bf16x8 lo, bf16x8 hi) { typedef int v4i_t __attribute__((ext_vector_type(4))); const v4i_t a = __builtin_bit_cast(v4i_t, lo), b = __builtin_bit_cast(v4i_t, hi); return (v8i_t){a[0], a[1], a[2], a[3], b[0], b[1], b[2], b[3]}; }
DI void dense_voff(unsigned lda, unsigned ldb, int tid, unsigned (&vA)[2], unsigned (&vB)[2]) {
#pragma unroll
    for (int i = 0; i < 2; ++i) { int R, C; stage_rc(tid * 16 + i * 8192, R, C); const int Rb = (R & ~31) + perm32(R & 31);
        vA[i] = (unsigned)R * lda + (unsigned)C * 2u; vB[i] = (unsigned)Rb * ldb + (unsigned)C * 2u; }
}
DI void gather_voff(const UnitD& u, int tid, unsigned (&gA)[2][2]) {
#pragma unroll
    for (int i = 0; i < 2; ++i) { int R, C; stage_rc(tid * 16 + i * 8192, R, C);
#pragma unroll
        for (int h = 0; h < 2; ++h) { const int ra = h * 128 + R; const unsigned rowA = (ra < u.nvalid) ? (unsigned)u.rows[ra] : 0u; gA[h][i] = rowA * u.lda + (unsigned)C * 2u; } }
}

template <class Epi, class Sched, bool GATHER, bool ALIGN_EPI, bool FP8 = false>
DI void gemm_phase(LAS unsigned char* lds, int nt, const Sched& S, const Epi& E) {

    const int tid = threadIdx.x, wid = __builtin_amdgcn_readfirstlane(tid >> 6), lane = tid & 63, wr = wid >> 2, wc = wid & 3, fr = lane & 15, fq = lane >> 4;
    const size_t kstep = (size_t)(BK * 2);
    const unsigned ldsb = (unsigned)__builtin_amdgcn_readfirstlane((int)((unsigned)(uintptr_t)lds + (unsigned)wid * 1024u));
    const int aoff = lds_byte(wr * 64 + fr, fq * 8), boff = lds_byte(wc * 32 + fr, fq * 8);
#define PG8_SA(b, h) (((b) * 2 + (h)) * HTB)
#define PG8_SB(b, h) ((4 + (b) * 2 + (h)) * HTB)
#define PG8_STAGE(bufoff, gbase, voff) do { _Pragma("unroll") for (int _i = 0; _i < 2; ++_i) { unsigned keep_; \
        asm volatile("s_mov_b32 %0, m0\n\ts_mov_b32 m0, %3\n\ts_nop 0\n\tglobal_load_lds_dwordx4 %1, %2\n\ts_mov_b32 m0, %0" \
                     : "=&s"(keep_) : "v"((voff)[_i]), "s"((const char*)(gbase)), "s"(ldsb + (unsigned)((bufoff) + _i * 8192)) : "memory"); } } while (0)
#define PG8_STA(bufoff, gbase, h, HS, GA) do { if constexpr (GATHER) { PG8_STAGE(bufoff, gbase, GA[h]); } else { PG8_STAGE(bufoff, (gbase) + (h) * (HS), vA); } } while (0)
#define PG8_STB(bufoff, gbase, h, HS) PG8_STAGE(bufoff, (gbase) + (h) * (HS), vB)
typedef int v4i_t __attribute__((ext_vector_type(4)));
#define PG8_LDA(dst, b, h) do { _Pragma("unroll") for (int m = 0; m < 4; ++m) { if constexpr (FP8) { \
            const v4i_t lo_ = *(const LAS v4i_t*)(lds + PG8_SA(b, h) + aoff + m * 2048), hi_ = *(const LAS v4i_t*)(lds + PG8_SA(b, h) + aoff + m * 2048 + 1024); \
            dst##8[m] = __builtin_shufflevector(lo_, hi_, 0, 1, 2, 3, 4, 5, 6, 7); } \
        else { _Pragma("unroll") for (int k = 0; k < 2; ++k) dst[m][k] = *(const LAS bf16x8*)(lds + PG8_SA(b, h) + aoff + m * 2048 + k * 1024); } } } while (0)
#define PG8_LDB(dst, b, h) do { _Pragma("unroll") for (int n = 0; n < 2; ++n) { if constexpr (FP8) { \
            const v4i_t lo_ = *(const LAS v4i_t*)(lds + PG8_SB(b, h) + boff + n * 2048), hi_ = *(const LAS v4i_t*)(lds + PG8_SB(b, h) + boff + n * 2048 + 1024); \
            dst##8[n] = __builtin_shufflevector(lo_, hi_, 0, 1, 2, 3, 4, 5, 6, 7); } \
        else { _Pragma("unroll") for (int k = 0; k < 2; ++k) dst[n][k] = *(const LAS bf16x8*)(lds + PG8_SB(b, h) + boff + n * 2048 + k * 1024); } } } while (0)
#ifndef PG8_FP8_PRIO
#define PG8_FP8_PRIO 1
#endif
#define PG8_MMA(ai, bj, At, Bt) do { if (!FP8 || PG8_FP8_PRIO) __builtin_amdgcn_s_setprio(1); _Pragma("unroll") for (int m = 0; m < 4; ++m) _Pragma("unroll") for (int n = 0; n < 2; ++n) { \
        if constexpr (FP8) { acc[ai][bj][m][n] = __builtin_amdgcn_mfma_scale_f32_16x16x128_f8f6f4(Bt##8[n], At##8[m], acc[ai][bj][m][n], 0, 0, 0, 0x7f7f7f7f, 0, 0x7f7f7f7f); } \
        else { _Pragma("unroll") for (int k = 0; k < 2; ++k) acc[ai][bj][m][n] = __builtin_amdgcn_mfma_f32_16x16x32_bf16(Bt[n][k], At[m][k], acc[ai][bj][m][n], 0, 0, 0); } } \
        if (!FP8 || PG8_FP8_PRIO) __builtin_amdgcn_s_setprio(0); } while (0)
#define PG8_WAIT_V(n) asm volatile("s_waitcnt vmcnt(" #n ")" ::: "memory")
#define PG8_WAIT_L(n) asm volatile("s_waitcnt lgkmcnt(" #n ")" ::: "memory")
#define PG8_BAR __builtin_amdgcn_s_barrier()
#define PG8_SCHED __builtin_amdgcn_sched_barrier(0)
#define PG8_ITER(A1P, A2P, B2P, HA2, HB2, GA2) do { \
        const char* a3p_ = (A2P) + kstep; const char* b3p_ = (B2P) + kstep; \
        PG8_LDB(B0, 0, 0); PG8_LDB(B1, 0, 1); PG8_SCHED; PG8_LDA(At, 0, 0); PG8_STA(PG8_SA(1, 1), (A1P), 1, hsA, gA); \
        PG8_WAIT_V(8); PG8_WAIT_L(0); PG8_BAR; PG8_MMA(0, 0, At, B0); PG8_MMA(0, 1, At, B1); PG8_BAR; PG8_SCHED; \
        PG8_LDA(At, 0, 1); PG8_STB(PG8_SB(0, 0), (B2P), 0, HB2); PG8_STB(PG8_SB(0, 1), (B2P), 1, HB2); PG8_STA(PG8_SA(0, 0), (A2P), 0, HA2, GA2); \
        PG8_WAIT_V(8); PG8_WAIT_L(0); PG8_BAR; PG8_MMA(1, 0, At, B0); PG8_MMA(1, 1, At, B1); PG8_BAR; PG8_SCHED; \
        PG8_LDB(B0, 1, 0); PG8_LDB(B1, 1, 1); PG8_SCHED; PG8_LDA(At, 1, 0); PG8_STA(PG8_SA(0, 1), (A2P), 1, HA2, GA2); \
        PG8_WAIT_V(8); PG8_WAIT_L(0); PG8_BAR; PG8_MMA(0, 0, At, B0); PG8_MMA(0, 1, At, B1); PG8_BAR; PG8_SCHED; \
        PG8_LDA(At, 1, 1); PG8_STB(PG8_SB(1, 0), b3p_, 0, HB2); PG8_STB(PG8_SB(1, 1), b3p_, 1, HB2); PG8_STA(PG8_SA(1, 0), a3p_, 0, HA2, GA2); \
        PG8_WAIT_V(8); PG8_WAIT_L(0); PG8_BAR; PG8_MMA(1, 0, At, B0); PG8_MMA(1, 1, At, B1); PG8_BAR; PG8_SCHED; \
    } while (0)
    UnitD cur, nxt; int ui = 0;
    if (!S.next(0, cur)) return;
    f32x4 acc[2][2][4][2];
#pragma unroll
    for (int a = 0; a < 2; ++a)
#pragma unroll
        for (int b = 0; b < 2; ++b)
#pragma unroll
            for (int m = 0; m < 4; ++m)
#pragma unroll
                for (int n = 0; n < 2; ++n) acc[a][b][m][n] = (f32x4){0.f, 0.f, 0.f, 0.f};
    bf16x8 At[4][2], B0[2][2], B1[2][2]; v8i_t At8[4], B08[2], B18[2];
    unsigned vA[2], vB[2], gA[2][2], ngA[2][2];
    dense_voff(cur.lda, cur.ldb, tid, vA, vB);
    if constexpr (GATHER) gather_voff(cur, tid, gA);
    const char* cA = cur.A; const char* cB = cur.B;
    size_t hsA = GATHER ? 0 : (size_t)cur.lda * HALF, hsB = (size_t)cur.ldb * HALF;
    PG8_STB(PG8_SB(0, 0), cB, 0, hsB); PG8_STB(PG8_SB(0, 1), cB, 1, hsB); PG8_STA(PG8_SA(0, 0), cA, 0, hsA, gA); PG8_STA(PG8_SA(0, 1), cA, 1, hsA, gA);
    if (wr == 1) PG8_BAR;
    PG8_WAIT_V(2); PG8_BAR;
    PG8_STB(PG8_SB(1, 0), cB + kstep, 0, hsB); PG8_STA(PG8_SA(1, 0), cA + kstep, 0, hsA, gA); PG8_STB(PG8_SB(1, 1), cB + kstep, 1, hsB);
    PG8_WAIT_V(6); PG8_BAR;
    for (;;) {
        const bool has_next = S.next(ui + 1, nxt);
        const char* nA = cA; const char* nB = cB; size_t nhsA = hsA, nhsB = hsB;
        if (has_next) { nA = nxt.A; nB = nxt.B; nhsA = GATHER ? 0 : (size_t)nxt.lda * HALF; nhsB = (size_t)nxt.ldb * HALF; }
        if constexpr (GATHER) {
            if (has_next) gather_voff(nxt, tid, ngA);
            else {
#pragma unroll
                for (int h = 0; h < 2; ++h)
#pragma unroll
                    for (int i = 0; i < 2; ++i) ngA[h][i] = gA[h][i];
            }
        }
#pragma unroll 1
        for (int t = 0; t < nt; t += 2) {
            const bool last = (t == nt - 2);
            const char* a2 = last ? nA : cA + (size_t)(t + 2) * kstep; const char* b2 = last ? nB : cB + (size_t)(t + 2) * kstep;
            const size_t hA2 = last ? nhsA : hsA, hB2 = last ? nhsB : hsB;
            unsigned g2[2][2];
            if constexpr (GATHER) {
#pragma unroll
                for (int h = 0; h < 2; ++h)
#pragma unroll
                    for (int i = 0; i < 2; ++i) g2[h][i] = last ? ngA[h][i] : gA[h][i];
            }
            PG8_ITER(cA + (size_t)(t + 1) * kstep, a2, b2, hA2, hB2, g2);
        }
        if constexpr (ALIGN_EPI) { if (wr == 0) PG8_BAR; }
        if constexpr (!Epi::AFTER_DRAIN) { E(acc, cur, wr, wc, fr, fq); }
        if (!has_next) break;
#pragma unroll
        for (int a = 0; a < 2; ++a)
#pragma unroll
            for (int b = 0; b < 2; ++b)
#pragma unroll
                for (int m = 0; m < 4; ++m)
#pragma unroll
                    for (int n = 0; n < 2; ++n) acc[a][b][m][n] = (f32x4){0.f, 0.f, 0.f, 0.f};
        cur = nxt; cA = nA; cB = nB; hsA = nhsA; hsB = nhsB; ++ui;
        if constexpr (GATHER) {
#pragma unroll
            for (int h = 0; h < 2; ++h)
#pragma unroll
                for (int i = 0; i < 2; ++i) gA[h][i] = ngA[h][i];
        }
        if constexpr (ALIGN_EPI) { if (wr == 1) PG8_BAR; }
    }
    PG8_WAIT_V(0);
    if constexpr (!ALIGN_EPI) { if (wr == 0) PG8_BAR; }
    PG8_BAR;
    if constexpr (Epi::AFTER_DRAIN) { E.fused(acc, cur, wr, wc, fr, fq, lds, wid, lane); }
#undef PG8_SA
#undef PG8_SB
#undef PG8_STAGE
#undef PG8_STA
#undef PG8_STB
#undef PG8_LDA
#undef PG8_LDB
#undef PG8_MMA
#undef PG8_WAIT_V
#undef PG8_WAIT_L
#undef PG8_BAR
#undef PG8_SCHED
#undef PG8_ITER
}
}
namespace attn_body {
using bf16=__hip_bfloat16;
using bf16x8=__attribute__((ext_vector_type(8)))short;
using s16x4=__attribute__((ext_vector_type(4)))short;
using f32x16=__attribute__((ext_vector_type(16)))float;
using u32x4=__attribute__((ext_vector_type(4)))unsigned;
constexpr int BATCH=4,SEQ=2048,D=64,DM=5632,OPITCH=1024;
constexpr int NW=8,QBLK=32,QB=QBLK*NW,KVBLK=64,NQB=SEQ/QB;
constexpr int ATTN_UNIT_ROWS=QB;
__device__ __forceinline__ int crow(int r,int hi){return (r&3)+8*(r>>2)+4*hi;}
#define SBAR() __builtin_amdgcn_sched_barrier(0)
__device__ __forceinline__ void cmask(f32x16&p0,f32x16&p1,int jb,int qrel,int hi){
  const float NEG=-INFINITY; int kb=64*jb+4*hi;
  #pragma unroll
  for(int r=0;r<16;++r){int kv=kb+(r&3)+8*(r>>2); if(kv>qrel)p0[r]=NEG; if(kv+32>qrel)p1[r]=NEG;}
}

constexpr int NSLOT=3, SLOTB=8192;
constexpr int LDS_K=0, LDS_V=NSLOT*SLOTB, LDS_WS=2*NSLOT*SLOTB, LDS_OST=LDS_WS+NW*64*4, LDS_BYTES=LDS_OST+NW*4096;
constexpr float C2=0.125f*1.4426950408889634f;
__device__ __forceinline__ void glds16(const void*gsrc,unsigned lds_dst){unsigned keep;
  asm volatile("s_mov_b32 %0, m0\n\ts_mov_b32 m0, %2\n\ts_nop 0\n\tglobal_load_lds_dwordx4 %1, off\n\ts_mov_b32 m0, %0":"=&s"(keep):"v"(gsrc),"s"(lds_dst):"memory");}
__device__ __forceinline__ float max3f(float a,float b,float c){float r;asm("v_max3_f32 %0, %1, %2, %3":"=v"(r):"v"(a),"v"(b),"v"(c));return r;}
__device__ __forceinline__ float max2f(float a,float b){float r;asm("v_max_f32_e32 %0, %1, %2":"=v"(r):"v"(a),"v"(b));return r;}
__device__ __forceinline__ float fadd_s(float a,float b){float r;asm("v_add_f32_e32 %0, %1, %2":"=v"(r):"v"(a),"v"(b));return r;}
__device__ __forceinline__ float fsub_s(float a,float b){float r;asm("v_sub_f32_e32 %0, %1, %2":"=v"(r):"v"(a),"v"(b));return r;}
typedef float f32x2_t __attribute__((ext_vector_type(2))); typedef __bf16 bf16x2_t __attribute__((ext_vector_type(2)));
__device__ __forceinline__ unsigned cvtpk_s(float lo,float hi){f32x2_t v={lo,hi};bf16x2_t b=__builtin_convertvector(v,bf16x2_t);return __builtin_bit_cast(unsigned,b);}
#define WAIT_BAR(N) asm volatile("s_waitcnt vmcnt(" #N ") lgkmcnt(0)\n\ts_barrier":::"memory")

__device__ __forceinline__ void qkt(f32x16&p0,f32x16&p1,const char*Kslot,const bf16x8*qr,const f32x16&negm,int r32,int hi){
  const char*kb=Kslot+hi*1024+r32*16;
  #pragma unroll
  for(int d0=0;d0<4;++d0){
    const bf16x8 b0=*reinterpret_cast<const bf16x8*>(kb+d0*2048);
    const bf16x8 b1=*reinterpret_cast<const bf16x8*>(kb+d0*2048+512);
    if(d0==0){p0=__builtin_amdgcn_mfma_f32_32x32x16_bf16(b0,qr[0],negm,0,0,0);p1=__builtin_amdgcn_mfma_f32_32x32x16_bf16(b1,qr[0],negm,0,0,0);}
    else{p0=__builtin_amdgcn_mfma_f32_32x32x16_bf16(b0,qr[d0],p0,0,0,0);p1=__builtin_amdgcn_mfma_f32_32x32x16_bf16(b1,qr[d0],p1,0,0,0);}}
}
typedef __attribute__((address_space(3))) const char* lds_cptr;
typedef short v4i16_t __attribute__((ext_vector_type(4)));
__device__ __forceinline__ void kload8(bf16x8*kf,lds_cptr kp){
  kf[0]=*(const __attribute__((address_space(3))) bf16x8*)(kp);      kf[1]=*(const __attribute__((address_space(3))) bf16x8*)(kp+512);
  kf[2]=*(const __attribute__((address_space(3))) bf16x8*)(kp+2048); kf[3]=*(const __attribute__((address_space(3))) bf16x8*)(kp+2560);
  kf[4]=*(const __attribute__((address_space(3))) bf16x8*)(kp+4096); kf[5]=*(const __attribute__((address_space(3))) bf16x8*)(kp+4608);
  kf[6]=*(const __attribute__((address_space(3))) bf16x8*)(kp+6144); kf[7]=*(const __attribute__((address_space(3))) bf16x8*)(kp+6656);
}
__device__ __forceinline__ void kload2(bf16x8*kf,lds_cptr kp,int j){ kf[2*j]=*(const __attribute__((address_space(3))) bf16x8*)(kp+j*2048); kf[2*j+1]=*(const __attribute__((address_space(3))) bf16x8*)(kp+j*2048+512); }
__device__ __forceinline__ s16x4 vtr(lds_cptr p){ return __builtin_bit_cast(s16x4,__builtin_amdgcn_ds_read_tr16_b64_v4i16((__attribute__((address_space(3))) v4i16_t*)p)); }
__device__ __forceinline__ float rowmax(const f32x16&p0,const f32x16&p1){
  float a=max3f(p0[0],p0[1],p1[0]),b=max3f(p0[2],p0[3],p1[1]);a=max3f(a,p1[2],p1[3]);
  #pragma unroll
  for(int r=4;r<16;r+=4){a=max3f(a,p0[r],p0[r+1]);b=max3f(b,p0[r+2],p0[r+3]);a=max3f(a,p1[r],p1[r+1]);b=max3f(b,p1[r+2],p1[r+3]);}
  const float m=max2f(a,b);
  auto rr=__builtin_amdgcn_permlane32_swap(__float_as_uint(m),__float_as_uint(m),false,false);
  return max2f(__uint_as_float(rr[0]),__uint_as_float(rr[1]));
}
__device__ __forceinline__ void pv(f32x16*o,int vb,bf16x8 pa0,bf16x8 pa1,bf16x8 pa2,bf16x8 pa3){
  #pragma unroll
  for(int d0=0;d0<2;++d0){s16x4 lo[4],hi[4];
    #pragma unroll
    for(int ks=0;ks<4;++ks){
      asm volatile("ds_read_b64_tr_b16 %0,%1 offset:%c2":"=&v"(lo[ks]):"v"(vb),"i"(d0*4096+ks*1024):"memory");
      asm volatile("ds_read_b64_tr_b16 %0,%1 offset:%c2":"=&v"(hi[ks]):"v"(vb),"i"(d0*4096+ks*1024+512):"memory");}
    asm volatile("s_waitcnt lgkmcnt(0)":::"memory");SBAR();
    #define PK(k) (bf16x8){lo[k][0],lo[k][1],lo[k][2],lo[k][3],hi[k][0],hi[k][1],hi[k][2],hi[k][3]}
    o[d0]=__builtin_amdgcn_mfma_f32_32x32x16_bf16(pa0,PK(0),o[d0],0,0,0);
    o[d0]=__builtin_amdgcn_mfma_f32_32x32x16_bf16(pa1,PK(1),o[d0],0,0,0);
    o[d0]=__builtin_amdgcn_mfma_f32_32x32x16_bf16(pa2,PK(2),o[d0],0,0,0);
    o[d0]=__builtin_amdgcn_mfma_f32_32x32x16_bf16(pa3,PK(3),o[d0],0,0,0);
    #undef PK
  }
}

#ifndef ATTN_STORE16
#define ATTN_STORE16(p,v) (*(u32x4*)(p)=(v))
#endif
template<int THRL> __device__ __forceinline__ void attn_unit(int b,int qcol,int vcol,int ocol,int qb,const bf16*Q,const bf16*__restrict__ K,const bf16*__restrict__ V,bf16*O,char*shm){
  const int tid=threadIdx.x,lane=tid&63,r32=lane&31,hi=lane>>5; const int wid=__builtin_amdgcn_readfirstlane(tid>>6);
  const long rowbase=(long)b*SEQ; const int q0=qb*QB;
  const bf16*Qw=Q+(rowbase+q0+wid*QBLK)*DM+qcol;
  const bf16*Kh=K+rowbase*DM+qcol,*Vh=V+rowbase*DM+vcol;
  const unsigned lds0=(unsigned)(uintptr_t)shm;
  float*wsf=(float*)(shm+LDS_WS)+wid*64;
  const bf16*ksrc=Kh+(long)lane*DM+wid*8;
  const bf16*vsrc=Vh+(long)(16*(wid&3)+(lane>>2))*DM+(wid>>2)*32+(lane&3)*8;
  const unsigned kdst=lds0+LDS_K+wid*1024, vdst=lds0+LDS_V+wid*1024;
  #define DMA_K(t,slot) glds16(ksrc+(long)(t)*KVBLK*DM,(unsigned)__builtin_amdgcn_readfirstlane(kdst+(slot)))
  #define DMA_V(t,slot) glds16(vsrc+(long)(t)*KVBLK*DM,(unsigned)__builtin_amdgcn_readfirstlane(vdst+(slot)))
  const int vb0=(int)(lds0+LDS_V)+((lane>>4)&1)*32+(lane&3)*8+(4*hi+((lane&15)>>2))*64;
  const char*Kbase=shm+LDS_K; bf16x8 kf[8];
  const lds_cptr shm3=(lds_cptr)shm; const lds_cptr kp0=shm3+LDS_K+hi*1024+r32*16; const lds_cptr vp0=shm3+LDS_V+((lane>>4)&1)*32+(lane&3)*8+(4*hi+((lane&15)>>2))*64;
  const int NT=(q0+QB)/KVBLK;
  DMA_K(0,0);DMA_V(0,0);DMA_K(1,SLOTB);
  bf16x8 qr[4];
  #pragma unroll
  for(int d0=0;d0<4;++d0)qr[d0]=*reinterpret_cast<const bf16x8*>(&Qw[(long)r32*DM+d0*16+hi*8]);
  float mhat=0.f,l_reg=0.f;f32x16 o[2];o[0]=f32x16{};o[1]=f32x16{};f32x16 negm=f32x16{};asm volatile("":"+v"(negm));
  const int qrel=wid*QBLK+r32;
  #define CMASK(P0,P1,t) do{int jb_=(t)-(NT-4); if(jb_>=0)cmask(P0,P1,jb_,qrel,hi);}while(0)
  bool resc=false;
  #define START(P0,P1) do{ const float rm=rowmax(P0,P1); resc=false; \
    { const float dl=rm; mhat=fadd_s(mhat,dl); \
      _Pragma("unroll") for(int r=0;r<16;++r){P0[r]=fsub_s(P0[r],dl);P1[r]=fsub_s(P1[r],dl);} \
      _Pragma("unroll") for(int r=0;r<16;++r)negm[r]=-mhat; asm volatile("":"+v"(negm)); } \
    _Pragma("unroll") for(int r=0;r<16;++r)P0[r]=__builtin_amdgcn_exp2f(P0[r]); }while(0)
  #define RESC() do{ if(resc){ asm volatile("s_waitcnt lgkmcnt(0)":::"memory"); \
      _Pragma("unroll") for(int d_=0;d_<2;++d_) _Pragma("unroll") for(int r=0;r<16;++r)o[d_][r]*=wsf[crow(r,hi)]; } }while(0)
  f32x16 pA0,pA1,pB0,pB1;
  int sl_prev=0,sl_cur=0,sl_next=SLOTB;
  #define ROT() do{sl_prev=sl_cur;sl_cur=sl_next;sl_next=(sl_next==(NSLOT-1)*SLOTB)?0:sl_next+SLOTB;}while(0)
  DMA_K(2,2*SLOTB);
  WAIT_BAR(3);
  qkt(pA0,pA1,Kbase,qr,negm,r32,hi);asm volatile("s_nop 15\n\ts_nop 7":"+v"(pA0),"+v"(pA1));CMASK(pA0,pA1,0);
  START(pA0,pA1);
  _Pragma("unroll") for(int r=0;r<16;++r)pA1[r]=__builtin_amdgcn_exp2f(pA1[r]);
  WAIT_BAR(0);
  DMA_K(3,0);DMA_V(1,SLOTB);
  ROT();
  kload8(kf,kp0+sl_cur);
  WAIT_BAR(2);
  s16x4 vlo[8],vhi[8]; u32x4 pw0,pw1,pw2,pw3;
  #define PKW(P,B) cvtpk_s(P[B],P[B+1])
  #define PAF(k) __builtin_bit_cast(bf16x8,pw##k)
  #define VFR(i) (bf16x8){vlo[i][0],vlo[i][1],vlo[i][2],vlo[i][3],vhi[i][0],vhi[i][1],vhi[i][2],vhi[i][3]}
  #define PIN(x) asm volatile("":"+v"(x))
  #define MX3(a,b,c) __builtin_fmaxf(__builtin_fmaxf((a),(b)),(c))
  #define GAPA(MF,A0,A1,A2,A3,W0,W1,PW) do{ MF; sacc+=A0; sacc+=A1; sacc+=A2; sacc+=A3; PIN(sacc); W0; W1; PIN(PW); SBAR(); }while(0)
  #define EX(v) __builtin_amdgcn_exp2f(v)
  #define GAPB(MF,X,B) do{ MF; X[B]=EX(X[B]); X[B+1]=EX(X[B+1]); X[B+2]=EX(X[B+2]); X[B+3]=EX(X[B+3]); PIN(X); SBAR(); }while(0)
  #define VRD(i) do{ vlo[i]=vtr(vp_+(((i)>>2)*4096+((i)&3)*1024)); vhi[i]=vtr(vp_+(((i)>>2)*4096+((i)&3)*1024+512)); }while(0)
  #define KRD(G,j) do{ if(G){ kload2(kf,kp0+sl_next,j); SBAR(); } }while(0)
  #define STEP(C0,C1,P0,P1,t,GK,GV,GL) do{ SBAR(); \
    const lds_cptr vp_=vp0+sl_prev; \
    VRD(0); SBAR(); float sacc=(P0[0]+P0[1]); \
    GAPA(C0=__builtin_amdgcn_mfma_f32_32x32x16_bf16(kf[0],qr[0],negm,0,0,0), P0[2],P0[3],P0[4],P0[5],     pw0[0]=PKW(P0,0), pw0[1]=PKW(P0,2), pw0); \
    VRD(4); SBAR(); GAPA(C1=__builtin_amdgcn_mfma_f32_32x32x16_bf16(kf[1],qr[0],negm,0,0,0), P0[6],P0[7],P0[8],P0[9],     pw0[2]=PKW(P0,4), pw0[3]=PKW(P0,6), pw0); \
    VRD(1); SBAR(); GAPA(C0=__builtin_amdgcn_mfma_f32_32x32x16_bf16(kf[2],qr[1],C0,0,0,0),   P0[10],P0[11],P0[12],P0[13], pw1[0]=PKW(P0,8), pw1[1]=PKW(P0,10), pw1); \
    VRD(5); SBAR(); GAPA(C1=__builtin_amdgcn_mfma_f32_32x32x16_bf16(kf[3],qr[1],C1,0,0,0),   P0[14],P0[15],P1[0],P1[1],   pw1[2]=PKW(P0,12),pw1[3]=PKW(P0,14), pw1); \
    VRD(2); SBAR(); GAPA(C0=__builtin_amdgcn_mfma_f32_32x32x16_bf16(kf[4],qr[2],C0,0,0,0),   P1[2],P1[3],P1[4],P1[5],     pw2[0]=PKW(P1,0), pw2[1]=PKW(P1,2), pw2); \
    VRD(6); SBAR(); GAPA(C1=__builtin_amdgcn_mfma_f32_32x32x16_bf16(kf[5],qr[2],C1,0,0,0),   P1[6],P1[7],P1[8],P1[9],     pw2[2]=PKW(P1,4), pw2[3]=PKW(P1,6), pw2); \
    VRD(3); SBAR(); GAPA(C0=__builtin_amdgcn_mfma_f32_32x32x16_bf16(kf[6],qr[3],C0,0,0,0),   P1[10],P1[11],P1[12],P1[13], pw3[0]=PKW(P1,8), pw3[1]=PKW(P1,10), pw3); \
    VRD(7); SBAR(); GAPA(C1=__builtin_amdgcn_mfma_f32_32x32x16_bf16(kf[7],qr[3],C1,0,0,0),   P1[14],P1[15],0.f,0.f,       pw3[2]=PKW(P1,12),pw3[3]=PKW(P1,14), pw3); \
    l_reg+=sacc; \
    if(GK){DMA_K((t)+3,sl_cur);} if(GV){DMA_V((t)+1,sl_next);} \
    CMASK(C0,C1,t); \
    { float a=MX3(C0[0],C0[1],C1[0]),b=MX3(C0[2],C0[3],C1[1]); a=MX3(a,C1[2],C1[3]); \
      _Pragma("unroll") for(int r=4;r<16;r+=4){a=MX3(a,C0[r],C0[r+1]);b=MX3(b,C0[r+2],C0[r+3]);a=MX3(a,C1[r],C1[r+1]);b=MX3(b,C1[r+2],C1[r+3]);} \
      float rm=__builtin_fmaxf(a,b); { auto rr=__builtin_amdgcn_permlane32_swap(__float_as_uint(rm),__float_as_uint(rm),false,false); rm=__builtin_fmaxf(__uint_as_float(rr[0]),__uint_as_float(rr[1])); } \
      resc=false; \
      if(__builtin_expect(__any(rm>(float)THRL),0)){ const float dl=__builtin_fmaxf(rm,0.f); mhat+=dl; \
        _Pragma("unroll") for(int r=0;r<16;++r){C0[r]-=dl;C1[r]-=dl;} \
        _Pragma("unroll") for(int r=0;r<16;++r)negm[r]=-mhat; asm volatile("":"+v"(negm)); \
        const float f=__builtin_amdgcn_exp2f(-dl); l_reg*=f; if(hi==0)wsf[r32]=f; resc=true; } } \
    SBAR(); \
    GAPB(o[0]=__builtin_amdgcn_mfma_f32_32x32x16_bf16(PAF(0),VFR(0),o[0],0,0,0), C0,0); \
    GAPB(o[1]=__builtin_amdgcn_mfma_f32_32x32x16_bf16(PAF(0),VFR(4),o[1],0,0,0), C0,4); \
    KRD(GL,0); GAPB(o[0]=__builtin_amdgcn_mfma_f32_32x32x16_bf16(PAF(1),VFR(1),o[0],0,0,0), C0,8); \
    KRD(GL,1); GAPB(o[1]=__builtin_amdgcn_mfma_f32_32x32x16_bf16(PAF(1),VFR(5),o[1],0,0,0), C0,12); \
    KRD(GL,2); GAPB(o[0]=__builtin_amdgcn_mfma_f32_32x32x16_bf16(PAF(2),VFR(2),o[0],0,0,0), C1,0); \
    KRD(GL,3); GAPB(o[1]=__builtin_amdgcn_mfma_f32_32x32x16_bf16(PAF(2),VFR(6),o[1],0,0,0), C1,4); \
    GAPB(o[0]=__builtin_amdgcn_mfma_f32_32x32x16_bf16(PAF(3),VFR(3),o[0],0,0,0), C1,8); \
    GAPB(o[1]=__builtin_amdgcn_mfma_f32_32x32x16_bf16(PAF(3),VFR(7),o[1],0,0,0), C1,12); \
    }while(0)
  int t=1;
  #undef CMASK
  #define CMASK(P0,P1,t) do{}while(0)
  for(;t+5<NT;t+=2){
    STEP(pB0,pB1,pA0,pA1,t,true,true,true);     WAIT_BAR(2); RESC(); ROT();
    STEP(pA0,pA1,pB0,pB1,t+1,true,true,true);   WAIT_BAR(2); RESC(); ROT();
  }
  #undef CMASK
  #define CMASK(P0,P1,t) do{int jb_=(t)-(NT-4); if(jb_>=0)cmask(P0,P1,jb_,qrel,hi);}while(0)
  #define ENDW(tt) do{ if((tt)+3<NT){WAIT_BAR(2);} else if((tt)+2<NT){WAIT_BAR(1);} else {WAIT_BAR(0);} }while(0)
  for(;t+1<NT;t+=2){
    STEP(pB0,pB1,pA0,pA1,t,(t+3<NT),(t+1<NT),(t+1<NT));       ENDW(t);   RESC(); ROT();
    STEP(pA0,pA1,pB0,pB1,t+1,(t+4<NT),(t+2<NT),(t+2<NT));     ENDW(t+1); RESC(); ROT();
  }
  STEP(pB0,pB1,pA0,pA1,NT-1,false,false,false); RESC();
  { float sacc=pB0[0]+pB0[1]; _Pragma("unroll") for(int r=2;r<16;++r)sacc+=pB0[r]; _Pragma("unroll") for(int r=0;r<16;++r)sacc+=pB1[r]; l_reg+=sacc;
    pw0=(u32x4){PKW(pB0,0),PKW(pB0,2),PKW(pB0,4),PKW(pB0,6)};pw1=(u32x4){PKW(pB0,8),PKW(pB0,10),PKW(pB0,12),PKW(pB0,14)};pw2=(u32x4){PKW(pB1,0),PKW(pB1,2),PKW(pB1,4),PKW(pB1,6)};pw3=(u32x4){PKW(pB1,8),PKW(pB1,10),PKW(pB1,12),PKW(pB1,14)};
    SBAR(); pv(o,vb0+sl_cur,PAF(0),PAF(1),PAF(2),PAF(3)); }
  #undef PKW
  #undef PAF
  #undef VFR
  #undef PIN
  #undef MX3
  #undef GAPA
  #undef GAPB
  #undef EX
  #undef VRD
  #undef KRD
  #undef STEP
  #undef ENDW
  {auto rr=__builtin_amdgcn_permlane32_swap(__float_as_uint(l_reg),__float_as_uint(l_reg),false,false);l_reg=__uint_as_float(rr[0])+__uint_as_float(rr[1]);}
  if(hi==0)wsf[32+r32]=l_reg;asm volatile("s_waitcnt lgkmcnt(0)":::"memory");
  float rli[16];
  #pragma unroll
  for(int r=0;r<16;++r)rli[r]=__builtin_amdgcn_rcpf(wsf[32+crow(r,hi)]);
  bf16*Ow=O+(rowbase+q0+wid*QBLK)*OPITCH+ocol;
  { bf16*stg=(bf16*)(shm+LDS_OST)+wid*2048;
    #pragma unroll
    for(int r=0;r<16;++r){const int orow=crow(r,hi);
      #pragma unroll
      for(int d0=0;d0<2;++d0)stg[orow*64+d0*32+r32]=__float2bfloat16(o[d0][r]*rli[r]);}
    asm volatile("s_waitcnt lgkmcnt(0)":::"memory");
    #pragma unroll
    for(int i=0;i<4;++i){const int row=i*8+(lane>>3),ch=lane&7; const u32x4 v=*(const u32x4*)(stg+row*64+ch*8); ATTN_STORE16(Ow+(long)row*OPITCH+ch*8,v);} }
  asm volatile("s_waitcnt lgkmcnt(0)\n\ts_barrier":::"memory");
  #undef DMA_K
  #undef DMA_V
  #undef CMASK
  #undef START
  #undef RESC
  #undef ROT
}
constexpr int ATTN_LDS_BYTES=LDS_BYTES;
#undef SBAR
#undef WAIT_BAR
}
constexpr size_t MiB = 1u << 20;
constexpr size_t WS_CTL = 0, CTL_ZERO_BYTES = 1 * MiB;
constexpr size_t WS_WIN = 2 * MiB, WS_WOUT = 26 * MiB, WS_WQ = 34 * MiB, WS_WKV = 42 * MiB, WS_WO = 58 * MiB, WS_W1 = 66 * MiB, WS_W2 = 578 * MiB;
constexpr size_t WS_HN = 834 * MiB, WS_MN = 866 * MiB, WS_PROJ = 870 * MiB, WS_DT = 958 * MiB, WS_KVRAW = 959 * MiB, WS_KN = 967 * MiB;
constexpr size_t WS_YCAT = 971 * MiB, WS_O0 = 1003 * MiB, WS_O1 = 1019 * MiB, WS_H1 = 1035 * MiB, WS_H1B = 1099 * MiB, WS_PART1 = 1131 * MiB, WS_PARTQ = 1132 * MiB;
constexpr size_t WS_QRAW = 1133 * MiB, WS_P = 1165 * MiB, WS_VWT = 1181 * MiB, WS_H2 = 1197 * MiB, WS_HN3 = 1261 * MiB;
constexpr size_t WS_TOKOF = 1293 * MiB, WS_GATEOF = 1294 * MiB, WS_TOKE = 1295 * MiB, WS_TOKR = 1296 * MiB, WS_YG = 1297 * MiB;
constexpr size_t WS_H1F8 = 3368 * MiB  , WS_QF8 = 3384 * MiB  , WS_KN8 = 3400 * MiB  , WS_VF8 = 3402 * MiB  ;
constexpr size_t WS_P8 = 3404 * MiB  , WS_VWT8 = 3412 * MiB  ;
constexpr size_t WS_XG = 1320 * MiB  , WS_ACT = 1832 * MiB  , WS_Y = 2344 * MiB  , WS_END = 3420 * MiB;
constexpr int CW_BAR = 4096;
constexpr int CW_QCONV2 = 12416;
constexpr int CW_QCONV = 12352;
constexpr int CW_QATT = 12288;
constexpr int CW_CNT = 8192;
static_assert((CW_CNT + 64 * 32) * 4 <= (int)CTL_ZERO_BYTES, "CTL words inside the memset region");

constexpr int RING_OFF = 0, RING_BYTES = 131072;
constexpr int LDS_BYTES = 163840;
constexpr int MISC_OFF = 163840 - 1024;
constexpr int NWAVES = 8;

#define XB_TMO      128
#define XB_XCNT(j)  (256  + 64 * (j))
#define XB_XSUB(j)  (1280 + 64 * (j))
#define XB_XGEN(j)  (2304 + 64 * (j))
#define XB_TOP      3328
#define XB_TOPGEN   3392
#define XCD_BAR_WORDS 3456
#define XB_SPIN_CAP (1u << 20)

__device__ __forceinline__ unsigned xb_ld(unsigned* p)              { return __hip_atomic_load(p, __ATOMIC_RELAXED, __HIP_MEMORY_SCOPE_AGENT); }
__device__ __forceinline__ unsigned xb_add(unsigned* p, unsigned v) { return __hip_atomic_fetch_add(p, v, __ATOMIC_RELAXED, __HIP_MEMORY_SCOPE_AGENT); }
__device__ __forceinline__ unsigned xb_xcc_id() { return (unsigned)__builtin_amdgcn_s_getreg((3 << 11) | 20) & 0xFu; }
#define XB_SPIN(cond, bar) do { unsigned _sp = 0; while (cond) { __builtin_amdgcn_s_sleep(1); \
    if ((++_sp & 255u) == 0u) { if (xb_ld(&(bar)[XB_TMO])) break; if (_sp > XB_SPIN_CAP) { atomicAdd(&(bar)[XB_TMO], 1u); break; } } } } while (0)

struct XcdBarrier {
    unsigned* bar; unsigned x;
    volatile LAS unsigned* st;
};
__device__ __forceinline__ XcdBarrier xcd_barrier_post(unsigned* bar, volatile LAS unsigned* st) {
    XcdBarrier b; b.bar = bar; b.x = xb_xcc_id(); b.st = st;
    if (threadIdx.x == 0) (void)xb_add(&bar[XB_XCNT(b.x)], 1u);
    return b;
}
__device__ __forceinline__ void xcd_barrier_complete(unsigned* bar, unsigned x, unsigned& nloc, unsigned& nx) {
    const unsigned G = gridDim.x * gridDim.y * gridDim.z;
    unsigned sum, cnt, mine, sp = 0u;
    for (;;) {
        sum = 0u; cnt = 0u; mine = 0u;
#pragma unroll
        for (unsigned j = 0; j < 16; ++j) { const unsigned c = xb_ld(&bar[XB_XCNT(j)]); sum += c; cnt += (c > 0u) ? 1u : 0u; mine = (j == x) ? c : mine; }
        if (sum == G) break;
        __builtin_amdgcn_s_sleep(1);
        if ((++sp & 255u) == 0u) { if (xb_ld(&bar[XB_TMO])) break; if (sp > XB_SPIN_CAP) { atomicAdd(&bar[XB_TMO], 1u); break; } }
    }
    nloc = mine > 0u ? mine : 1u; nx = cnt > 0u ? cnt : 1u;
}
__device__ __forceinline__ void xcd_barrier(const XcdBarrier& b) {
    asm volatile("s_waitcnt vmcnt(0)" ::: "memory");
    __syncthreads();
    if (threadIdx.x == 0) {
        unsigned* bar = b.bar;
        __builtin_amdgcn_s_waitcnt(0);
        unsigned nloc = b.st[0], nx = b.st[1];
        if (nloc == 0u) { xcd_barrier_complete(bar, b.x, nloc, nx); b.st[0] = nloc; b.st[1] = nx; }
        const unsigned old = xb_add(&bar[XB_XSUB(b.x)], 1u);
        const unsigned gen = old / nloc;
        if (old + 1u == (gen + 1u) * nloc) {
            __builtin_amdgcn_fence(__ATOMIC_RELEASE, "agent");
            asm volatile("s_waitcnt vmcnt(0)" ::: "memory");
            const unsigned og = xb_add(&bar[XB_TOP], 1u);
            const unsigned tg = og / nx;
            if (og + 1u == (tg + 1u) * nx) xb_add(&bar[XB_TOPGEN], 1u);
            else XB_SPIN(xb_ld(&bar[XB_TOPGEN]) == tg, bar);
            __builtin_amdgcn_fence(__ATOMIC_ACQUIRE, "agent");
            xb_add(&bar[XB_XGEN(b.x)], 1u);
            asm volatile("s_waitcnt vmcnt(0)" ::: "memory");
        } else {
            XB_SPIN(xb_ld(&bar[XB_XGEN(b.x)]) == gen, bar);
            __builtin_amdgcn_fence(__ATOMIC_ACQUIRE, "agent");
            asm volatile("s_waitcnt vmcnt(0)" ::: "memory");
        }
    }
    __syncthreads();
}

struct Args { const float* in[32]; float* out; unsigned char* ws; int ph_lo, ph_hi; };
enum In { I_X = 0, I_MEM, I_GMIX, I_WIN, I_CONVW, I_CONVB, I_DTB, I_ALOG, I_DSKIP, I_SSDG, I_DAQG, I_DAKG, I_LQ1, I_LK1, I_LQ2, I_LK2, I_SUBG, I_WOUT, I_GXA, I_GMEM,
          I_WQ, I_WKV, I_XQG, I_XKG, I_WO, I_GFFN, I_RW, I_RB, I_W1, I_B1, I_W2, I_B2 };

struct ArgP {
    typedef const __attribute__((address_space(4))) char* kptr;
    DI const float* in(int i) const { kptr kp = (kptr)__builtin_amdgcn_kernarg_segment_ptr(); asm volatile("" : "+s"(kp)); return *(const float* const __attribute__((address_space(4)))*)(kp + 8 * i); }
    DI float* out() const { kptr kp = (kptr)__builtin_amdgcn_kernarg_segment_ptr(); asm volatile("" : "+s"(kp)); return *(float* const __attribute__((address_space(4)))*)(kp + 8 * 32); }
};
struct Frame {
    LAS unsigned char* lds;
    volatile LAS unsigned* MISC;
    unsigned* ctl;
    unsigned char* ws;
    int tid, lane, wave, vcu, G;
};

template <class DestRow>
DI void tr_item(const float* W, size_t ldw, int k0, int ncol0, int nvalid, const float* kscale, bf16_t* WT, int K, DestRow dr, LAS float* scr, int lane) {
    const int c = lane & 31;
#pragma unroll 8
    for (int i = 0; i < 32; ++i) { const int kk = 2 * i + (lane >> 5);
        float v = (c < nvalid) ? W[(size_t)(k0 + kk) * ldw + ncol0 + c] : 0.f;
        if (kscale) v *= kscale[k0 + kk];
        scr[kk * 33 + c] = v; }
    asm volatile("s_waitcnt lgkmcnt(0)" ::: "memory");
    const int c8 = lane & 7;
#pragma unroll
    for (int j = 0; j < 4; ++j) { const int n = (lane >> 3) + 8 * j; const LAS float* s = scr + (8 * c8) * 33 + n;
        u32x4 o; o.x = pk2(s[0 * 33], s[1 * 33]); o.y = pk2(s[2 * 33], s[3 * 33]); o.z = pk2(s[4 * 33], s[5 * 33]); o.w = pk2(s[6 * 33], s[7 * 33]);
        if (n < nvalid) *(u32x4*)(WT + (size_t)dr(ncol0 + n) * K + k0 + 8 * c8) = o; }
    asm volatile("s_waitcnt lgkmcnt(0)" ::: "memory");
}
template <class DestRow>
DI void tr_item_fp8(const float* W, size_t ldw, int k0, int ncol0, const float* kscale, unsigned char* WT, int K, DestRow dr, LAS float* scr, int lane) {
    const int c = lane & 31;
#pragma unroll 8
    for (int i = 0; i < 32; ++i) { const int kk = 2 * i + (lane >> 5); float v = W[(size_t)(k0 + kk) * ldw + ncol0 + c]; if (kscale) v *= kscale[k0 + kk]; scr[kk * 33 + c] = v; }
    asm volatile("s_waitcnt lgkmcnt(0)" ::: "memory");
    const int n = lane >> 1, hf = lane & 1; const LAS float* s = scr + (32 * hf) * 33 + n;
    unsigned w[8];
#pragma unroll
    for (int j = 0; j < 8; ++j) { unsigned x = 0u;
        x = __builtin_amdgcn_cvt_pk_fp8_f32(s[(4 * j) * 33] * 64.f, s[(4 * j + 1) * 33] * 64.f, x, false);
        x = __builtin_amdgcn_cvt_pk_fp8_f32(s[(4 * j + 2) * 33] * 64.f, s[(4 * j + 3) * 33] * 64.f, x, true); w[j] = x; }
    unsigned char* op = WT + (size_t)dr(ncol0 + n) * K + k0 + 32 * hf;
    *(u32x4*)op = (u32x4){w[0], w[1], w[2], w[3]}; *(u32x4*)(op + 16) = (u32x4){w[4], w[5], w[6], w[7]};
    asm volatile("s_waitcnt lgkmcnt(0)" ::: "memory");
}
DI int tileperm(int col) { const int o = col & 255; return (col & ~255) + 128 * ((o & 63) >> 5) + 32 * (o >> 6) + (o & 31); }
struct DrIdent { DI int operator()(int n) const { return n; } };
struct DrTile  { DI int operator()(int n) const { return tileperm(n); } };
struct DrWin   { DI int operator()(int n) const { const int pc = (n < 2560) ? n : (n < 2576 ? PC_DT + (n - 2560) : n - 16); return tileperm(pc); } };
struct DrW1    { DI int operator()(int n) const { const int half = n >> 11, j = n & 2047; return (j >> 7) * 256 + half * 128 + (j & 127); } };

template <bool FP8, class DestRow>
DI void cv_item(const float* W, size_t ldw, int k0, int ncol0, const float* kscale, float scale, void* WT, int kpitch, DestRow dr, LAS float* scr, int lane) {
    const int r = lane >> 3, c4 = (lane & 7) * 4;
    f32x4 v[16];
#pragma unroll
    for (int i = 0; i < 16; ++i) v[i] = *(const f32x4*)(W + (size_t)(k0 + 8 * i + r) * ldw + ncol0 + c4);
#pragma unroll
    for (int i = 0; i < 16; ++i) { f32x4 x = v[i] * scale; if (kscale) x = x * kscale[k0 + 8 * i + r]; *(LAS f32x4*)(scr + (8 * i + r) * 36 + c4) = x; }
    asm volatile("s_waitcnt lgkmcnt(0)" ::: "memory");
    const int n = lane & 31, hf = lane >> 5; const LAS float* s = scr + (64 * hf) * 36 + n;
    if constexpr (FP8) {
        unsigned w[16];
#pragma unroll
        for (int j = 0; j < 16; ++j) { unsigned x = 0u; x = __builtin_amdgcn_cvt_pk_fp8_f32(s[(4 * j) * 36], s[(4 * j + 1) * 36], x, false); x = __builtin_amdgcn_cvt_pk_fp8_f32(s[(4 * j + 2) * 36], s[(4 * j + 3) * 36], x, true); w[j] = x; }
        unsigned char* op = (unsigned char*)WT + (size_t)dr(ncol0 + n) * kpitch + k0 + 64 * hf;
#pragma unroll
        for (int j = 0; j < 4; ++j) *(u32x4*)(op + 16 * j) = (u32x4){w[4 * j], w[4 * j + 1], w[4 * j + 2], w[4 * j + 3]};
    } else {
        unsigned w[32];
#pragma unroll
        for (int j = 0; j < 32; ++j) w[j] = pk2(s[(2 * j) * 36], s[(2 * j + 1) * 36]);
        unsigned char* op = (unsigned char*)WT + (size_t)dr(ncol0 + n) * kpitch + (k0 + 64 * hf) * 2;
#pragma unroll
        for (int j = 0; j < 8; ++j) *(u32x4*)(op + 16 * j) = (u32x4){w[4 * j], w[4 * j + 1], w[4 * j + 2], w[4 * j + 3]};
    }
    asm volatile("s_waitcnt lgkmcnt(0)" ::: "memory");
}
DI void rms_row_to_bf16(const float* xrow, const float* g, bf16_t* orow, int lane) {
    const f32x4* xr = (const f32x4*)xrow + lane;
    f32x4 v[8]; float s = 0.f;
#pragma unroll
    for (int j = 0; j < 8; ++j) { v[j] = xr[64 * j]; s += (v[j].x * v[j].x + v[j].y * v[j].y) + (v[j].z * v[j].z + v[j].w * v[j].w); }
    const float rstd = 1.f / sqrtf(wave_sum(s) * (1.f / 2048.f) + EPS_);
    u32x2* o8 = (u32x2*)orow + lane;
#pragma unroll
    for (int j = 0; j < 8; ++j) { const f32x4 gg = ((const f32x4*)g)[lane + 64 * j];
        u32x2 o; o.x = pk2(v[j].x * rstd * gg.x, v[j].y * rstd * gg.y); o.y = pk2(v[j].z * rstd * gg.z, v[j].w * rstd * gg.w); o8[64 * j] = o; }
}

DI void p0_prologue(Frame& F, const ArgP& a) {
    LAS float* scr = (LAS float*)(F.lds + RING_OFF + F.wave * 16384);
    const int gw = F.vcu * NWAVES + F.wave, NGW = F.G * NWAVES;
    unsigned char* ws = F.ws;
    constexpr int I_A = 32 * 80, I_B = 32, I_C = 32 * 96, NITEMS = I_A + I_B + I_C;
    for (int it = gw; it < NITEMS; it += NGW) {
        int r = it;
        if (r < I_A) { tr_item(a.in(I_WIN), 5648, 64 * (r / 80), 32 * (r % 80), 32, nullptr, (bf16_t*)(ws + WS_WIN), 2048, DrWin(), scr, F.lane); continue; } r -= I_A;
        if (r < I_B) { tr_item(a.in(I_WIN), 5648, 64 * r, 2560, 16, nullptr, (bf16_t*)(ws + WS_WIN), 2048, DrWin(), scr, F.lane); continue; } r -= I_B;
        tr_item(a.in(I_WIN), 5648, 64 * (r / 96), 2576 + 32 * (r % 96), 32, nullptr, (bf16_t*)(ws + WS_WIN), 2048, DrWin(), scr, F.lane);
    }
    for (int m = gw; m < NTOK; m += NGW) rms_row_to_bf16(a.in(I_X) + (size_t)m * 2048, a.in(I_GMIX), (bf16_t*)(ws + WS_HN) + (size_t)m * 2048, F.lane);
    for (int m = gw; m < NB * MEMLEN; m += NGW) rms_row_to_bf16(a.in(I_MEM) + (size_t)m * 2048, a.in(I_GMEM), (bf16_t*)(ws + WS_MN) + (size_t)m * 2048, F.lane);
}
struct CvIt { const float* W; size_t ldw; const float* ks; unsigned char* WT; float scale; int k0, n0, kpitch, fp8, dr; };
DI CvIt cv_decode(int it, const ArgP& a, unsigned char* ws) {
    constexpr int J_WOUT = 16 * 64, J_WKV = 16 * 128, J_WQ = 16 * 64, J_WO = 16 * 64, J_W1 = 32 * 16 * 128;
    CvIt c; c.ks = nullptr; c.scale = 64.f; c.fp8 = 1; c.dr = 0; c.kpitch = 2048; c.ldw = 2048;
    int r = it;
    if (r < J_WOUT) { c.W = a.in(I_WOUT); c.k0 = 128 * (r / 64); c.n0 = 32 * (r % 64); c.WT = ws + WS_WOUT; c.scale = 1.f; c.fp8 = 0; c.kpitch = 4096; return c; } r -= J_WOUT;
    if (r < J_WKV) { c.W = a.in(I_WKV); c.ldw = 4096; c.k0 = 128 * (r / 128); c.n0 = 32 * (r % 128); c.WT = ws + WS_WKV; c.scale = 1.f; c.fp8 = 0; c.kpitch = 4096; c.dr = 1; return c; } r -= J_WKV;
    if (r < J_WQ) { c.W = a.in(I_WQ); c.ks = a.in(I_GXA); c.k0 = 128 * (r / 64); c.n0 = 32 * (r % 64); c.WT = ws + WS_WQ; return c; } r -= J_WQ;
    if (r < J_WO) { c.W = a.in(I_WO); c.k0 = 128 * (r / 64); c.n0 = 32 * (r % 64); c.WT = ws + WS_WO; return c; } r -= J_WO;
    if (r < J_W1) { const int e = r / (16 * 128), q = r % (16 * 128); c.W = a.in(I_W1) + (size_t)e * 2048 * 4096; c.ldw = 4096; c.k0 = 128 * (q / 128); c.n0 = 32 * (q % 128); c.WT = ws + WS_W1 + (size_t)e * 4096 * 2048; c.dr = 2; return c; } r -= J_W1;
    { const int e = r / (16 * 64), q = r % (16 * 64); c.W = a.in(I_W2) + (size_t)e * 2048 * 2048; c.k0 = 128 * (q / 64); c.n0 = 32 * (q % 64); c.WT = ws + WS_W2 + (size_t)e * 2048 * 2048; }
    return c;
}
constexpr int CV_NJ = 16 * 64 * 3 + 16 * 128 + 32 * 16 * 128 + 32 * 16 * 64;
constexpr int CV_TAIL2 = 16384;
constexpr int CV_TAIL1 = 16384;
constexpr int CV_TAIL = CV_TAIL1 + CV_TAIL2;
DI void conv_share(Frame& F, const ArgP& a) {
    LAS float* scr = (LAS float*)(F.lds + F.wave * 16384);
    const unsigned sbase = (unsigned)__builtin_amdgcn_readfirstlane((int)((unsigned)(uintptr_t)F.lds + (unsigned)F.wave * 16384u));
    const int gw = F.vcu * NWAVES + F.wave, NGW = F.G * NWAVES, lane = F.lane;
    unsigned char* ws = F.ws;
    constexpr int NJ = CV_NJ - CV_TAIL;
    const int n = lane & 31, hf = lane >> 5;
    for (int it = gw; it < NJ; it += NGW) {
        const CvIt cur = cv_decode(it, a, ws);
        const char* gb = (const char*)(cur.W + (size_t)cur.k0 * cur.ldw + cur.n0);
        const unsigned vo0 = (unsigned)(((size_t)(lane >> 3) * cur.ldw + (size_t)(lane & 7) * 4) * 4), vstep = (unsigned)(8 * cur.ldw * 4);
#pragma unroll
        for (int p = 0; p < 16; ++p) { unsigned keep_;
            asm volatile("s_mov_b32 %0, m0\n\ts_mov_b32 m0, %3\n\ts_nop 0\n\tglobal_load_lds_dwordx4 %1, %2 nt\n\ts_mov_b32 m0, %0"
                         : "=&s"(keep_) : "v"(vo0 + (unsigned)p * vstep), "s"(gb), "s"(sbase + (unsigned)p * 1024u) : "memory"); }
        asm volatile("s_waitcnt vmcnt(0)" ::: "memory");
        const LAS float* s = scr + (64 * hf) * 32 + n;
        const int col = cur.n0 + n; const int drow = (cur.dr == 0) ? col : (cur.dr == 1 ? tileperm(col) : DrW1()(col));
        const float* ksp = cur.ks ? cur.ks + cur.k0 + 64 * hf : nullptr;
        if (cur.fp8) {
            unsigned w[16];
#pragma unroll
            for (int j = 0; j < 16; ++j) { float x0 = s[(4 * j) * 32] * cur.scale, x1 = s[(4 * j + 1) * 32] * cur.scale, x2 = s[(4 * j + 2) * 32] * cur.scale, x3 = s[(4 * j + 3) * 32] * cur.scale;
                if (ksp) { x0 *= ksp[4 * j]; x1 *= ksp[4 * j + 1]; x2 *= ksp[4 * j + 2]; x3 *= ksp[4 * j + 3]; }
                unsigned x = 0u; x = __builtin_amdgcn_cvt_pk_fp8_f32(x0, x1, x, false); x = __builtin_amdgcn_cvt_pk_fp8_f32(x2, x3, x, true); w[j] = x; }
            unsigned char* op = cur.WT + (size_t)drow * cur.kpitch + cur.k0 + 64 * hf;
#pragma unroll
            for (int j = 0; j < 4; ++j) *(u32x4*)(op + 16 * j) = (u32x4){w[4 * j], w[4 * j + 1], w[4 * j + 2], w[4 * j + 3]};
        } else {
            unsigned w[32];
#pragma unroll
            for (int j = 0; j < 32; ++j) w[j] = pk2(s[(2 * j) * 32] * cur.scale, s[(2 * j + 1) * 32] * cur.scale);
            unsigned char* op = cur.WT + (size_t)drow * cur.kpitch + (cur.k0 + 64 * hf) * 2;
#pragma unroll
            for (int j = 0; j < 8; ++j) *(u32x4*)(op + 16 * j) = (u32x4){w[4 * j], w[4 * j + 1], w[4 * j + 2], w[4 * j + 3]};
        }
        asm volatile("s_waitcnt lgkmcnt(0)" ::: "memory");
    }
}

DI void conv_queue(Frame& F, const ArgP& a, int qword, int first, int count) {
    LAS float* scr = (LAS float*)(F.lds + F.wave * 18432);
    unsigned char* ws = F.ws;
    const int lane = threadIdx.x & 63, r = lane >> 3, c4 = (lane & 7) * 4, n = lane & 31, hf = lane >> 5;
    for (;;) {
        if (threadIdx.x == 0) F.MISC[121] = __hip_atomic_fetch_add(F.ctl + qword, 8u, __ATOMIC_RELAXED, __HIP_MEMORY_SCOPE_AGENT);
        __syncthreads();
        const int base = __builtin_amdgcn_readfirstlane((int)F.MISC[121]);
        __syncthreads();
        if (base >= count) break;
        const int it = first + base + F.wave;
        if (base + F.wave < count) {
            const CvIt cur = cv_decode(it, a, ws);
            f32x4 v[16];
#pragma unroll
            for (int i = 0; i < 16; ++i) v[i] = __builtin_nontemporal_load((const f32x4*)(cur.W + (size_t)(cur.k0 + 8 * i + r) * cur.ldw + cur.n0 + c4));
#pragma unroll
            for (int i = 0; i < 16; ++i) *(LAS f32x4*)(scr + (8 * i + r) * 36 + c4) = v[i] * cur.scale;
            asm volatile("s_waitcnt lgkmcnt(0)" ::: "memory");
            const LAS float* s = scr + (64 * hf) * 36 + n;
            unsigned w[16];
#pragma unroll
            for (int j = 0; j < 16; ++j) { unsigned x = 0u; x = __builtin_amdgcn_cvt_pk_fp8_f32(s[(4 * j) * 36], s[(4 * j + 1) * 36], x, false); x = __builtin_amdgcn_cvt_pk_fp8_f32(s[(4 * j + 2) * 36], s[(4 * j + 3) * 36], x, true); w[j] = x; }
            unsigned char* op = cur.WT + (size_t)(cur.n0 + n) * cur.kpitch + cur.k0 + 64 * hf;
#pragma unroll
            for (int j = 0; j < 4; ++j) *(u32x4*)(op + 16 * j) = (u32x4){w[4 * j], w[4 * j + 1], w[4 * j + 2], w[4 * j + 3]};
            asm volatile("s_waitcnt lgkmcnt(0)" ::: "memory");
        }
    }
}
static_assert(CV_TAIL <= 32 * 16 * 64 && CV_TAIL1 % 8 == 0 && CV_TAIL2 % 8 == 0, "the tails are a suffix of the moe_w2 items");

struct SchedP1 {
    int G, c; const unsigned char* ws; int lo, hi;
    DI bool next(int i, pg8::UnitD& u) const {
        const int L = lo + i * G + c; if (L >= hi) return false;
        u.rows = nullptr; u.nvalid = 0; u.lda = 4096u; u.ldb = 4096u; u.e = 0; u.x0 = 0;
        if (L < 32 * 23) { u.type = 0; u.pn = L / 32; u.pm = L % 32; u.A = (const char*)(ws + WS_HN) + (size_t)u.pm * 256 * 4096; u.B = (const char*)(ws + WS_WIN) + (size_t)u.pn * 256 * 4096; }
        else { const int q = L - 32 * 23; u.type = 1; u.pn = q / 4; u.pm = q % 4; u.A = (const char*)(ws + WS_MN) + (size_t)u.pm * 256 * 4096; u.B = (const char*)(ws + WS_WKV) + (size_t)u.pn * 256 * 4096; }
        return true;
    }
};
struct EpiP1 {
    static constexpr bool AFTER_DRAIN = false;
    bf16_t* proj; float* dtb; bf16_t* kvraw; const float* gq; const float* gk; unsigned char* vf8;
    DI void operator()(const f32x4 (&acc)[2][2][4][2], const pg8::UnitD& u, int wr, int wc, int fr, int fq) const {
        { int ln_ = threadIdx.x; asm volatile("" : "+v"(ln_)); fr = ln_ & 15; fq = (ln_ >> 4) & 3; }
        const int row0 = u.pm * 256 + wr * 64 + fr;
        const int cn = u.pn * 256 + 64 * wc + 8 * fq;
        if (u.type == 1 && u.pn >= 8) {
#pragma unroll
            for (int ai = 0; ai < 2; ++ai)
#pragma unroll
                for (int m = 0; m < 4; ++m) { unsigned char* rp = vf8 + (size_t)(row0 + ai * 128 + m * 16) * 2048 + (cn - 2048);
#pragma unroll
                    for (int bj = 0; bj < 2; ++bj) { const f32x4 v0 = acc[ai][bj][m][0] * 16.f, v1 = acc[ai][bj][m][1] * 16.f;
                        u32x2 w; w.x = __builtin_amdgcn_cvt_pk_fp8_f32(v0[0], v0[1], 0u, false); w.x = __builtin_amdgcn_cvt_pk_fp8_f32(v0[2], v0[3], w.x, true);
                        w.y = __builtin_amdgcn_cvt_pk_fp8_f32(v1[0], v1[1], 0u, false); w.y = __builtin_amdgcn_cvt_pk_fp8_f32(v1[2], v1[3], w.y, true);
                        *(u32x2*)(rp + 32 * bj) = w; } }
            return;
        }
        if (u.type == 1) {
#pragma unroll
            for (int ai = 0; ai < 2; ++ai)
#pragma unroll
                for (int m = 0; m < 4; ++m) { bf16_t* rp = kvraw + (size_t)(row0 + ai * 128 + m * 16) * 4096 + cn;
#pragma unroll
                    for (int bj = 0; bj < 2; ++bj) { const f32x4 v0 = acc[ai][bj][m][0], v1 = acc[ai][bj][m][1];
                        u32x4 w; w.x = pk2(v0[0], v0[1]); w.y = pk2(v0[2], v0[3]); w.z = pk2(v1[0], v1[1]); w.w = pk2(v1[2], v1[3]); *(u32x4*)(rp + 32 * bj) = w; } }
            return;
        }
        if (u.pn == 22) {
            if (wc == 0 && fq < 2) {
#pragma unroll
                for (int ai = 0; ai < 2; ++ai)
#pragma unroll
                    for (int m = 0; m < 4; ++m) { float* rp = dtb + (size_t)(row0 + ai * 128 + m * 16) * 16 + 8 * fq;
                        *(f32x4*)(rp) = acc[ai][0][m][0]; *(f32x4*)(rp + 4) = acc[ai][0][m][1]; }
            }
            return;
        }
        const bool isq = (u.pn >= 10 && u.pn < 14), isk = (u.pn >= 14 && u.pn < 18);
        if (!(isq || isk)) {
#pragma unroll
            for (int ai = 0; ai < 2; ++ai)
#pragma unroll
                for (int m = 0; m < 4; ++m) { bf16_t* rp = proj + (size_t)(row0 + ai * 128 + m * 16) * PP + cn;
#pragma unroll
                    for (int bj = 0; bj < 2; ++bj) { const f32x4 v0 = acc[ai][bj][m][0], v1 = acc[ai][bj][m][1];
                        u32x4 w; w.x = pk2(v0[0], v0[1]); w.y = pk2(v0[2], v0[3]); w.z = pk2(v1[0], v1[1]); w.w = pk2(v1[2], v1[3]); *(u32x4*)(rp + 32 * bj) = w; } }
            return;
        }
        const float* g = (isq ? gq : gk) + 8 * fq; const float sc = isq ? (0.125f * 1.4426950408889634f) : 1.f;
#pragma unroll
        for (int ai = 0; ai < 2; ++ai)
#pragma unroll
            for (int m = 0; m < 4; ++m) { bf16_t* rp = proj + (size_t)(row0 + ai * 128 + m * 16) * PP + cn;
                float ss = 0.f;
#pragma unroll
                for (int bj = 0; bj < 2; ++bj)
#pragma unroll
                    for (int n = 0; n < 2; ++n) { const f32x4 v = acc[ai][bj][m][n]; ss += (v[0] * v[0] + v[1] * v[1]) + (v[2] * v[2] + v[3] * v[3]); }
                ss += __shfl_xor(ss, 16); ss += __shfl_xor(ss, 32);
                const float rs = sc / sqrtf(ss * (1.f / 64.f) + EPS_);
#pragma unroll
                for (int bj = 0; bj < 2; ++bj) { const f32x4 v0 = acc[ai][bj][m][0] * rs * *(const f32x4*)(g + 32 * bj), v1 = acc[ai][bj][m][1] * rs * *(const f32x4*)(g + 32 * bj + 4);
                    u32x4 w; w.x = pk2(v0[0], v0[1]); w.y = pk2(v0[2], v0[3]); w.z = pk2(v1[0], v1[1]); w.w = pk2(v1[2], v1[3]); *(u32x4*)(rp + 32 * bj) = w; } }
    }
};

DI void kprep(Frame& F, const ArgP& a) {
    const int gw = F.vcu * NWAVES + F.wave, NGW = F.G * NWAVES;
    const bf16_t* kv = (const bf16_t*)(F.ws + WS_KVRAW); unsigned char* kn = (unsigned char*)(F.ws + WS_KN8);
    for (int it = gw; it < NB * MEMLEN * 4; it += NGW) {
        const int row = it >> 2, h = it & 3, b = row >> 8, key = row & 255;
        const u32x4 raw = *(const u32x4*)(kv + (size_t)row * 4096 + h * 512 + F.lane * 8);
        float v[8]; v[0] = bflo(raw.x); v[1] = bfhi(raw.x); v[2] = bflo(raw.y); v[3] = bfhi(raw.y); v[4] = bflo(raw.z); v[5] = bfhi(raw.z); v[6] = bflo(raw.w); v[7] = bfhi(raw.w);
        float ss = 0.f;
#pragma unroll
        for (int j = 0; j < 8; ++j) ss += v[j] * v[j];
        const float rs = 1.f / sqrtf(wave_sum(ss) * (1.f / 512.f) + EPS_) * 0.04419417382415922f * 128.f;
        const float* gk = a.in(I_XKG) + F.lane * 8; const float* gq = a.in(I_XQG) + F.lane * 8;
        u32x2 o; o.x = __builtin_amdgcn_cvt_pk_fp8_f32(v[0] * rs * gk[0] * gq[0], v[1] * rs * gk[1] * gq[1], 0u, false); o.x = __builtin_amdgcn_cvt_pk_fp8_f32(v[2] * rs * gk[2] * gq[2], v[3] * rs * gk[3] * gq[3], o.x, true);
        o.y = __builtin_amdgcn_cvt_pk_fp8_f32(v[4] * rs * gk[4] * gq[4], v[5] * rs * gk[5] * gq[5], 0u, false); o.y = __builtin_amdgcn_cvt_pk_fp8_f32(v[6] * rs * gk[6] * gq[6], v[7] * rs * gk[7] * gq[7], o.y, true);
        *(u32x2*)(kn + ((size_t)((b * 4 + h) * 256 + key)) * 512 + F.lane * 8) = o;
    }
}

constexpr int SP = 272;
constexpr int S_C = 0, S_BM = 34816, S_BT = 69632, S_XDT = 104448, S_HB = 121856, S_F = 139264, S_W = 155648  , SSD_LDS = 162048;
static_assert(SSD_LDS <= MISC_OFF, "SSD LDS map");
#define MFMA32(a, b, c) __builtin_amdgcn_mfma_f32_32x32x16_bf16((a), (b), (c), 0, 0, 0)
DI int crow(int r, int hi) { return (r & 3) + 8 * (r >> 2) + 4 * hi; }
DI bf16x8 ldfrag(LAS const unsigned char* base, int row, int kel) { return *(const LAS bf16x8*)(base + row * SP + kel * 2); }
DI float fexp(float x) { return __builtin_amdgcn_exp2f(x * 1.4426950408889634f); }
DI float fsilu(float x) { return x * __builtin_amdgcn_rcpf(1.f + fexp(-x)); }

DI void ssd_unit(Frame& F, const ArgP& a, int b, int hd) {
    LAS unsigned char* lds = F.lds;
    int tid = F.tid, lane = F.lane, r32 = lane & 31, hh = lane >> 5; const int wid = F.wave;
    LAS float* sdt = (LAS float*)(lds + S_F); LAS float* sac = sdt + 2048;
    const bf16_t* proj = (const bf16_t*)(F.ws + WS_PROJ); const float* dtbuf = (const float*)(F.ws + WS_DT); bf16_t* yg = (bf16_t*)(F.ws + WS_YG);
    const int g = hd >> 3;
    const float aneg = -__expf(a.in(I_ALOG)[hd]), dtb = a.in(I_DTB)[hd], dsk = a.in(I_DSKIP)[hd];
#pragma unroll
    for (int q = 0; q < 2; ++q) { const int c = 2 * wid + q; const size_t t0 = (size_t)b * SEQ_ + c * 128;
        const float x0 = dtbuf[(t0 + 2 * lane) * 16 + hd] + dtb, x1 = dtbuf[(t0 + 2 * lane + 1) * 16 + hd] + dtb;
        const float d0 = x0 > 20.f ? x0 : log1pf(__expf(x0)), d1 = x1 > 20.f ? x1 : log1pf(__expf(x1));
        const float a0 = d0 * aneg, a1 = d1 * aneg;
        float s = a0 + a1;
#pragma unroll
        for (int o = 1; o < 64; o <<= 1) { const float t = __shfl_up(s, o); if (lane >= o) s += t; }
        sdt[c * 128 + 2 * lane] = d0; sdt[c * 128 + 2 * lane + 1] = d1; sac[c * 128 + 2 * lane] = s - a1; sac[c * 128 + 2 * lane + 1] = s; }
    int seg = tid >> 5, cg = tid & 31, l0 = seg * 8;
    int colbc = (cg < 16) ? (1024 + g * 128 + cg * 8) : (1280 + g * 128 + (cg - 16) * 8);
    const int colx = hd * 64 + wid * 8; int lx = 2 * lane;
    LAS float* swt = (LAS float*)(lds + S_W);
    { const float* convw = a.in(I_CONVW); const float* convb = a.in(I_CONVB);
      if (tid < 320) { const int ci = tid;
          const int xc = (ci < 64) ? (hd * 64 + ci) : (ci < 192 ? (1024 + g * 128 + (ci - 64)) : (1280 + g * 128 + (ci - 192)));
#pragma unroll
          for (int k = 0; k < 4; ++k) swt[k * 320 + ci] = convw[k * 1536 + xc];
          swt[4 * 320 + ci] = convb[xc]; } }
    int cibc = 64 + cg * 8; const int cix = wid * 8;
    const char* pub = (const char*)F.ws; const unsigned pxb = (unsigned)(WS_PROJ + ((size_t)b * SEQ_ * PP + PC_XBC) * 2), zoff = (unsigned)(WS_CTL + 524288);
    u32x4 inbc[11], inx[5];
#define SSD_PREFETCH(c_) do { \
        int sd_ = l0; asm volatile("" : "+v"(sd_)); \
        _Pragma("unroll") for (int j = 0; j < 11; ++j) { const int tt = (c_) * 128 + sd_ - 3 + j; inbc[j] = *(const u32x4*)(pub + ((tt >= 0) ? pxb + (unsigned)(tt * PP + colbc) * 2u : zoff)); } } while (0)
    SSD_PREFETCH(0);
    f32x16 hT; for (int i = 0; i < 16; ++i) hT[i] = 0.f;
    const int nb = wid & 3, pb = wid >> 2;
    __syncthreads();
    for (int c = 0; c < 16; ++c) {
        { int t_ = threadIdx.x; asm volatile("" : "+v"(t_)); tid = t_; lane = t_ & 63; r32 = lane & 31; hh = lane >> 5; seg = t_ >> 5; cg = t_ & 31; l0 = seg * 8; lx = 2 * lane;
          colbc = (cg < 16) ? (1024 + g * 128 + cg * 8) : (1280 + g * 128 + (cg - 16) * 8); cibc = 64 + cg * 8; }
        const size_t t0 = (size_t)b * SEQ_ + c * 128;
        const LAS float* cdt = sdt + c * 128; const LAS float* cac = sac + c * 128;
        const float aend = cac[127];
#pragma unroll
        for (int j = 0; j < 5; ++j) { int sd_ = lx; asm volatile("" : "+v"(sd_)); const int tt = c * 128 + sd_ - 3 + j; inx[j] = *(const u32x4*)(pub + ((tt >= 0) ? pxb + (unsigned)(tt * PP + colx) * 2u : zoff)); }
        {
            LAS unsigned char* hbp = lds + S_HB + (32 * pb + r32) * SP + (32 * nb + 4 * hh) * 2;
#pragma unroll
            for (int q4 = 0; q4 < 4; ++q4) { u32x2 w; w.x = pk2(hT[4 * q4], hT[4 * q4 + 1]); w.y = pk2(hT[4 * q4 + 2], hT[4 * q4 + 3]); *(LAS u32x2*)(hbp + 16 * q4) = w; }
        }
        {
            float wbc[5][8];
#pragma unroll
            for (int k = 0; k < 5; ++k) { const f32x4 w0 = *(const LAS f32x4*)(swt + k * 320 + cibc), w1 = *(const LAS f32x4*)(swt + k * 320 + cibc + 4);
#pragma unroll
                for (int i = 0; i < 4; ++i) { wbc[k][i] = w0[i]; wbc[k][4 + i] = w1[i]; } }
#pragma unroll
            for (int hf = 0; hf < 2; ++hf) {
                __builtin_amdgcn_sched_barrier(0);
                float o[4][8];
#pragma unroll
                for (int j = 0; j < 4; ++j)
#pragma unroll
                    for (int i = 0; i < 8; ++i) { float s = wbc[4][i];
#pragma unroll
                        for (int k = 0; k < 4; ++k) { const unsigned wd = inbc[4 * hf + j + k][i >> 1]; s += wbc[k][i] * ((i & 1) ? bfhi(wd) : bflo(wd)); }
                        o[j][i] = fsilu(s); }
                const int lh = l0 + 4 * hf;
                if (cg < 16) {
                    const int n0 = cg * 8; float ev[4];
#pragma unroll
                    for (int j = 0; j < 4; ++j) { ev[j] = fexp(aend - cac[lh + j]);
                        u32x4 w1; w1.x = pk2(o[j][0], o[j][1]); w1.y = pk2(o[j][2], o[j][3]); w1.z = pk2(o[j][4], o[j][5]); w1.w = pk2(o[j][6], o[j][7]);
                        *(LAS u32x4*)(lds + S_BM + (lh + j) * SP + n0 * 2) = w1; }
#pragma unroll
                    for (int i = 0; i < 8; ++i) { u32x2 w2; w2.x = pk2(o[0][i] * ev[0], o[1][i] * ev[1]); w2.y = pk2(o[2][i] * ev[2], o[3][i] * ev[3]);
                        *(LAS u32x2*)(lds + S_BT + (n0 + i) * SP + lh * 2) = w2; }
                } else {
                    const int n0 = (cg - 16) * 8;
#pragma unroll
                    for (int j = 0; j < 4; ++j) { u32x4 w1; w1.x = pk2(o[j][0], o[j][1]); w1.y = pk2(o[j][2], o[j][3]); w1.z = pk2(o[j][4], o[j][5]); w1.w = pk2(o[j][6], o[j][7]);
                        *(LAS u32x4*)(lds + S_C + (lh + j) * SP + n0 * 2) = w1; }
                }
            }
        }
        __builtin_amdgcn_sched_barrier(0);
        {
            const float d0 = cdt[lx], d1 = cdt[lx + 1];
            float wx[5][8];
#pragma unroll
            for (int k = 0; k < 5; ++k) { const f32x4 w0 = *(const LAS f32x4*)(swt + k * 320 + cix), w1 = *(const LAS f32x4*)(swt + k * 320 + cix + 4);
#pragma unroll
                for (int i = 0; i < 4; ++i) { wx[k][i] = w0[i]; wx[k][4 + i] = w1[i]; } }
#pragma unroll
            for (int i = 0; i < 8; ++i) { float s0 = wx[4][i], s1 = wx[4][i];
#pragma unroll
                for (int k = 0; k < 4; ++k) { const unsigned w0 = inx[k][i >> 1], w1 = inx[k + 1][i >> 1];
                    s0 += wx[k][i] * ((i & 1) ? bfhi(w0) : bflo(w0)); s1 += wx[k][i] * ((i & 1) ? bfhi(w1) : bflo(w1)); }
                *(LAS unsigned*)(lds + S_XDT + (wid * 8 + i) * SP + lx * 2) = pk2(fsilu(s0) * d0, fsilu(s1) * d1); }
        }
        if (c < 15) SSD_PREFETCH(c + 1);
        __syncthreads();
        const int lb = wid >> 1;
        f32x16 xt[2];
        {
            bf16x8 cf[8];
#pragma unroll
            for (int ks = 0; ks < 8; ++ks) cf[ks] = ldfrag(lds + S_C, 32 * lb + r32, 16 * ks + 8 * hh);
#pragma unroll
            for (int q = 0; q < 2; ++q) { const int sb = 2 * (wid & 1) + q;
                for (int i = 0; i < 16; ++i) xt[q][i] = 0.f;
                if (sb <= lb) {
                    bf16x8 bfr[8];
#pragma unroll
                    for (int ks = 0; ks < 8; ++ks) bfr[ks] = ldfrag(lds + S_BM, 32 * sb + r32, 16 * ks + 8 * hh);
                    __builtin_amdgcn_sched_barrier(0);
#pragma unroll
                    for (int ks = 0; ks < 8; ++ks) xt[q] = MFMA32(bfr[ks], cf[ks], xt[q]);
                }
            }
        }
        __syncthreads();
        {
            const int l = 32 * lb + r32; const float al = cac[l], ddl = dsk * __builtin_amdgcn_rcpf(cdt[l]);
            f32x4 cs[2][4];
#pragma unroll
            for (int q = 0; q < 2; ++q)
#pragma unroll
                for (int q4 = 0; q4 < 4; ++q4) cs[q][q4] = *(const LAS f32x4*)(cac + 32 * (2 * (wid & 1) + q) + 8 * q4 + 4 * hh);
#pragma unroll
            for (int q = 0; q < 2; ++q) { const int sb = 2 * (wid & 1) + q;
#pragma unroll
                for (int q4 = 0; q4 < 4; ++q4) { float mv[4];
#pragma unroll
                    for (int e = 0; e < 4; ++e) { const int s = 32 * sb + 8 * q4 + 4 * hh + e;
                        const float ev = fexp(fminf(al - cs[q][q4][e], 0.f));
                        float v = (s <= l) ? xt[q][4 * q4 + e] * ev : 0.f;
                        v += (s == l) ? ddl : 0.f;
                        mv[e] = v; }
                    u32x2 w; w.x = pk2(mv[0], mv[1]); w.y = pk2(mv[2], mv[3]);
                    *(LAS u32x2*)(lds + S_BM + l * SP + (32 * sb + 8 * q4 + 4 * hh) * 2) = w; }
            }
        }
        __syncthreads();
        {
            const int lb2 = wid & 3, pb2 = wid >> 2; const int l = 32 * lb2 + r32; const size_t tok = t0 + l;
            const int pc0 = hd * 64 + 32 * pb2 + 4 * hh;
            u32x2 zz[4];
#pragma unroll
            for (int q4 = 0; q4 < 4; ++q4) zz[q4] = *(const u32x2*)(proj + tok * PP + pc0 + 8 * q4);
            f32x16 y1, y2; for (int i = 0; i < 16; ++i) { y1[i] = 0.f; y2[i] = 0.f; }
            bf16x8 fa[8], fb[8];
#pragma unroll
            for (int ks = 0; ks < 8; ++ks) { fa[ks] = ldfrag(lds + S_XDT, 32 * pb2 + r32, 16 * ks + 8 * hh); fb[ks] = ldfrag(lds + S_BM, 32 * lb2 + r32, 16 * ks + 8 * hh); }
            __builtin_amdgcn_sched_barrier(0);
#pragma unroll
            for (int ks = 0; ks < 8; ++ks) { if (ks < 2 * (lb2 + 1)) y1 = MFMA32(fa[ks], fb[ks], y1); }
            const float cd = fexp(aend);
#pragma unroll
            for (int i = 0; i < 16; ++i) hT[i] *= cd;
#pragma unroll
            for (int ks = 0; ks < 8; ++ks) fb[ks] = ldfrag(lds + S_BT, 32 * nb + r32, 16 * ks + 8 * hh);
            __builtin_amdgcn_sched_barrier(0);
#pragma unroll
            for (int ks = 0; ks < 8; ++ks) hT = MFMA32(fb[ks], fa[ks], hT);
#pragma unroll
            for (int ks = 0; ks < 8; ++ks) { fa[ks] = ldfrag(lds + S_HB, 32 * pb2 + r32, 16 * ks + 8 * hh); fb[ks] = ldfrag(lds + S_C, 32 * lb2 + r32, 16 * ks + 8 * hh); }
            __builtin_amdgcn_sched_barrier(0);
#pragma unroll
            for (int ks = 0; ks < 8; ++ks) y2 = MFMA32(fa[ks], fb[ks], y2);
            const float el = fexp(cac[l]);
#pragma unroll
            for (int q4 = 0; q4 < 4; ++q4) { float yv[4];
#pragma unroll
                for (int e = 0; e < 4; ++e) { const float z = (e & 1) ? bfhi(e < 2 ? zz[q4].x : zz[q4].y) : bflo(e < 2 ? zz[q4].x : zz[q4].y);
                    yv[e] = (y1[4 * q4 + e] + el * y2[4 * q4 + e]) * fsilu(z); }
                u32x2 w; w.x = pk2(yv[0], yv[1]); w.y = pk2(yv[2], yv[3]);
                *(u32x2*)(yg + tok * 1024 + pc0 + 8 * q4) = w; }
        }
        __syncthreads();
    }
#undef SSD_PREFETCH
}

DI void attn_phase_da(Frame& F) {
    const attn_body::bf16* proj = (const attn_body::bf16*)(F.ws + WS_PROJ);
    for (;;) {
        if (threadIdx.x == 0) F.MISC[120] = __hip_atomic_fetch_add(F.ctl + CW_QATT, 1u, __ATOMIC_RELAXED, __HIP_MEMORY_SCOPE_AGENT);
        __syncthreads();
        const int u = __builtin_amdgcn_readfirstlane((int)F.MISC[120]);
        __syncthreads();
        if (u >= 1024) break;
        const int qb = 7 - (u >> 7), combo = u & 127;
        const int half = combo & 1, j = (combo >> 1) & 1, h = (combo >> 2) & 7, b = combo >> 5;
        attn_body::bf16* O = (attn_body::bf16*)(F.ws + (j ? WS_O1 : WS_O0));
        attn_body::attn_unit<8>(b, PC_Q + (h * 2 + j) * 64, PC_V + h * 128 + half * 64, h * 128 + half * 64, qb, proj, proj + (PC_K - PC_Q), proj, O, (char*)F.lds);
    }
}

DI void p3_finalize(Frame& F, const ArgP& a) {
    const int gw = F.vcu * NWAVES + F.wave, NGW = F.G * NWAVES, lane = F.lane;
    bf16_t* ycat = (bf16_t*)(F.ws + WS_YCAT); const bf16_t* yg = (const bf16_t*)(F.ws + WS_YG); const bf16_t* o0 = (const bf16_t*)(F.ws + WS_O0); const bf16_t* o1 = (const bf16_t*)(F.ws + WS_O1);
    float l1 = a.in(I_LQ1)[lane] * a.in(I_LK1)[lane], l2 = a.in(I_LQ2)[lane] * a.in(I_LK2)[lane];
    const float lam = __expf(wave_sum(l1)) - __expf(wave_sum(l2)) + LAM_INIT;
    for (int m = gw; m < NTOK; m += NGW) {
        { bf16_t* yp = ycat + (size_t)m * 2048 + 16 * lane; const bf16_t* gp = yg + (size_t)m * 1024 + 16 * lane;
          const u32x4 r0 = *(const u32x4*)gp, r1 = *(const u32x4*)(gp + 8);
          float v[16]; v[0] = bflo(r0.x); v[1] = bfhi(r0.x); v[2] = bflo(r0.y); v[3] = bfhi(r0.y); v[4] = bflo(r0.z); v[5] = bfhi(r0.z); v[6] = bflo(r0.w); v[7] = bfhi(r0.w);
          v[8] = bflo(r1.x); v[9] = bfhi(r1.x); v[10] = bflo(r1.y); v[11] = bfhi(r1.y); v[12] = bflo(r1.z); v[13] = bfhi(r1.z); v[14] = bflo(r1.w); v[15] = bfhi(r1.w);
          float ss = 0.f;
#pragma unroll
          for (int i = 0; i < 16; ++i) ss += v[i] * v[i];
#pragma unroll
          for (int o = 1; o < 32; o <<= 1) ss += __shfl_xor(ss, o);
          const float rs = 1.f / sqrtf(ss * (1.f / 512.f) + EPS_);
          const float* g = a.in(I_SSDG) + 16 * lane;
          u32x4 w0, w1;
          w0.x = pk2(v[0] * rs * g[0], v[1] * rs * g[1]); w0.y = pk2(v[2] * rs * g[2], v[3] * rs * g[3]); w0.z = pk2(v[4] * rs * g[4], v[5] * rs * g[5]); w0.w = pk2(v[6] * rs * g[6], v[7] * rs * g[7]);
          w1.x = pk2(v[8] * rs * g[8], v[9] * rs * g[9]); w1.y = pk2(v[10] * rs * g[10], v[11] * rs * g[11]); w1.z = pk2(v[12] * rs * g[12], v[13] * rs * g[13]); w1.w = pk2(v[14] * rs * g[14], v[15] * rs * g[15]);
          *(u32x4*)yp = w0; *(u32x4*)(yp + 8) = w1; }
        { const bf16_t* p0 = o0 + (size_t)m * 1024 + 16 * lane; const bf16_t* p1 = o1 + (size_t)m * 1024 + 16 * lane;
          const u32x4 a0 = *(const u32x4*)p0, a1 = *(const u32x4*)(p0 + 8), b0 = *(const u32x4*)p1, b1 = *(const u32x4*)(p1 + 8);
          float v[16];
          v[0] = bflo(a0.x) - lam * bflo(b0.x); v[1] = bfhi(a0.x) - lam * bfhi(b0.x); v[2] = bflo(a0.y) - lam * bflo(b0.y); v[3] = bfhi(a0.y) - lam * bfhi(b0.y);
          v[4] = bflo(a0.z) - lam * bflo(b0.z); v[5] = bfhi(a0.z) - lam * bfhi(b0.z); v[6] = bflo(a0.w) - lam * bflo(b0.w); v[7] = bfhi(a0.w) - lam * bfhi(b0.w);
          v[8] = bflo(a1.x) - lam * bflo(b1.x); v[9] = bfhi(a1.x) - lam * bfhi(b1.x); v[10] = bflo(a1.y) - lam * bflo(b1.y); v[11] = bfhi(a1.y) - lam * bfhi(b1.y);
          v[12] = bflo(a1.z) - lam * bflo(b1.z); v[13] = bfhi(a1.z) - lam * bfhi(b1.z); v[14] = bflo(a1.w) - lam * bflo(b1.w); v[15] = bfhi(a1.w) - lam * bfhi(b1.w);
          float ss = 0.f;
#pragma unroll
          for (int i = 0; i < 16; ++i) ss += v[i] * v[i];
          ss += __shfl_xor(ss, 1); ss += __shfl_xor(ss, 2); ss += __shfl_xor(ss, 4);
          const float rs = 1.f / sqrtf(ss * (1.f / 128.f) + EPS_) * (1.f - LAM_INIT);
          const float* g = a.in(I_SUBG) + 16 * (lane & 7);
          u32x4 w0, w1;
          w0.x = pk2(v[0] * rs * g[0], v[1] * rs * g[1]); w0.y = pk2(v[2] * rs * g[2], v[3] * rs * g[3]); w0.z = pk2(v[4] * rs * g[4], v[5] * rs * g[5]); w0.w = pk2(v[6] * rs * g[6], v[7] * rs * g[7]);
          w1.x = pk2(v[8] * rs * g[8], v[9] * rs * g[9]); w1.y = pk2(v[10] * rs * g[10], v[11] * rs * g[11]); w1.z = pk2(v[12] * rs * g[12], v[13] * rs * g[13]); w1.w = pk2(v[14] * rs * g[14], v[15] * rs * g[15]);
          bf16_t* yp = ycat + (size_t)m * 2048 + 1024 + 16 * lane;
          *(u32x4*)yp = w0; *(u32x4*)(yp + 8) = w1; }
    }
}

struct SchedDense {
    int G, c, nM, nN; const char* A; const char* B; unsigned lda, ldb; int bdiv; size_t bstride;
    DI bool next(int i, pg8::UnitD& u) const {
        const int L = i * G + c; if (L >= nM * nN) return false;
        u.rows = nullptr; u.nvalid = 0; u.lda = lda; u.ldb = ldb; u.type = 0; u.e = 0; u.x0 = 0;
        u.pn = L / nM; u.pm = L % nM;
        u.A = A + (size_t)u.pm * 256 * lda; u.B = B + (size_t)u.pn * 256 * ldb + (size_t)(u.pm / bdiv) * bstride;
        return true;
    }
};
template <bool BASE_BF16>
struct EpiResid {
    static constexpr bool AFTER_DRAIN = false;
    const void* base; bf16_t* out; float* part; unsigned char* out8; float accscale;
    DI void operator()(const f32x4 (&acc)[2][2][4][2], const pg8::UnitD& u, int wr, int wc, int fr, int fq) const {
        { int ln_ = threadIdx.x; asm volatile("" : "+v"(ln_)); fr = ln_ & 15; fq = (ln_ >> 4) & 3; }
        const int row0 = u.pm * 256 + wr * 64 + fr, col0 = u.pn * 256 + wc * 32 + 8 * fq;
#pragma unroll
        for (int ai = 0; ai < 2; ++ai)
#pragma unroll
            for (int m = 0; m < 4; ++m) { const size_t row = (size_t)(row0 + ai * 128 + m * 16); float ss = 0.f;
#pragma unroll
                for (int bj = 0; bj < 2; ++bj) { const size_t idx = row * 2048 + col0 + bj * 128;
                    f32x4 b0, b1;
                    if constexpr (BASE_BF16) { const u32x4 r = *(const u32x4*)((const bf16_t*)base + idx); b0 = (f32x4){bflo(r.x), bfhi(r.x), bflo(r.y), bfhi(r.y)}; b1 = (f32x4){bflo(r.z), bfhi(r.z), bflo(r.w), bfhi(r.w)}; }
                    else { b0 = *(const f32x4*)((const float*)base + idx); b1 = *(const f32x4*)((const float*)base + idx + 4); }
                    const f32x4 v0 = acc[ai][bj][m][0] * accscale + b0, v1 = acc[ai][bj][m][1] * accscale + b1;
                    { u32x4 w; w.x = pk2(v0[0], v0[1]); w.y = pk2(v0[2], v0[3]); w.z = pk2(v1[0], v1[1]); w.w = pk2(v1[2], v1[3]); *(u32x4*)(out + idx) = w; }
                    if (out8) { u32x2 w; w.x = __builtin_amdgcn_cvt_pk_fp8_f32(v0[0] * 16.f, v0[1] * 16.f, 0u, false); w.x = __builtin_amdgcn_cvt_pk_fp8_f32(v0[2] * 16.f, v0[3] * 16.f, w.x, true);
                        w.y = __builtin_amdgcn_cvt_pk_fp8_f32(v1[0] * 16.f, v1[1] * 16.f, 0u, false); w.y = __builtin_amdgcn_cvt_pk_fp8_f32(v1[2] * 16.f, v1[3] * 16.f, w.y, true); *(u32x2*)(out8 + idx) = w; }
                    ss += (v0[0] * v0[0] + v0[1] * v0[1]) + (v0[2] * v0[2] + v0[3] * v0[3]) + (v1[0] * v1[0] + v1[1] * v1[1]) + (v1[2] * v1[2] + v1[3] * v1[3]); }
                if (part) { ss += __shfl_xor(ss, 16); ss += __shfl_xor(ss, 32); if (fq == 0) part[row * 32 + u.pn * 4 + wc] = ss; } }
    }
};

struct EpiQ {
    static constexpr bool AFTER_DRAIN = false;
    unsigned char* out8; float* part;
    DI void operator()(const f32x4 (&acc)[2][2][4][2], const pg8::UnitD& u, int wr, int wc, int fr, int fq) const {
        { int ln_ = threadIdx.x; asm volatile("" : "+v"(ln_)); fr = ln_ & 15; fq = (ln_ >> 4) & 3; }
        const int row0 = u.pm * 256 + wr * 64 + fr, col0 = u.pn * 256 + wc * 32 + 8 * fq;
#pragma unroll
        for (int ai = 0; ai < 2; ++ai)
#pragma unroll
            for (int m = 0; m < 4; ++m) { const size_t row = (size_t)(row0 + ai * 128 + m * 16); float ss = 0.f;
#pragma unroll
                for (int bj = 0; bj < 2; ++bj) { const size_t idx = row * 2048 + col0 + bj * 128; const f32x4 v0 = acc[ai][bj][m][0] * (1.f / 1024.f), v1 = acc[ai][bj][m][1] * (1.f / 1024.f);
                    u32x2 w; w.x = __builtin_amdgcn_cvt_pk_fp8_f32(v0[0] * 16.f, v0[1] * 16.f, 0u, false); w.x = __builtin_amdgcn_cvt_pk_fp8_f32(v0[2] * 16.f, v0[3] * 16.f, w.x, true);
                    w.y = __builtin_amdgcn_cvt_pk_fp8_f32(v1[0] * 16.f, v1[1] * 16.f, 0u, false); w.y = __builtin_amdgcn_cvt_pk_fp8_f32(v1[2] * 16.f, v1[3] * 16.f, w.y, true); *(u32x2*)(out8 + idx) = w;
                    ss += (v0[0] * v0[0] + v0[1] * v0[1]) + (v0[2] * v0[2] + v0[3] * v0[3]) + (v1[0] * v1[0] + v1[1] * v1[1]) + (v1[2] * v1[2] + v1[3] * v1[3]); }
                ss += __shfl_xor(ss, 16); ss += __shfl_xor(ss, 32); if (fq == 0) part[row * 32 + u.pn * 4 + wc] = ss; }
    }
};

struct SchedXS {
    int G, c; const unsigned char* ws;
    DI bool next(int i, pg8::UnitD& u) const {
        const int L = i * G + c; if (L >= 256) return false;
        u.rows = nullptr; u.nvalid = 0; u.e = 0;
        const int q = L & 127, bh = q >> 3, t8 = q & 7, b = bh >> 2, h = bh & 3;
        u.pm = b; u.pn = h; u.x0 = t8;
        if (L < 128) { u.type = 0; u.lda = 2048u; u.ldb = 512u;
            u.A = (const char*)(ws + WS_QF8) + (size_t)(b * 2048 + t8 * 256) * 2048 + h * 512; u.B = (const char*)(ws + WS_KN8) + (size_t)(bh * 256) * 512; }
        else { u.type = 1; u.lda = 2048u; u.ldb = 2048u;
            u.A = (const char*)(ws + WS_WO) + (size_t)(t8 * 256) * 2048 + h * 512; u.B = (const char*)(ws + WS_VF8) + (size_t)(b * 256) * 2048 + h * 512; }
        return true;
    }
};
struct EpiXS {
    static constexpr bool AFTER_DRAIN = false;
    unsigned char* P; unsigned char* VWT; const float* part1; const float* partq; LAS float* red;
    DI void operator()(const f32x4 (&acc)[2][2][4][2], const pg8::UnitD& u, int wr, int wc, int fr, int fq) const {
        { int ln_ = threadIdx.x; asm volatile("" : "+v"(ln_)); fr = ln_ & 15; fq = (ln_ >> 4) & 3; }
        const int b = u.pm, h = u.pn, t8 = u.x0;
        const int col0 = wc * 32 + 8 * fq;
        if (u.type == 1) {
            unsigned char* Vu = VWT + ((size_t)b * 2048 + t8 * 256) * 1024 + h * 256;
#pragma unroll
            for (int ai = 0; ai < 2; ++ai)
#pragma unroll
                for (int m = 0; m < 4; ++m) { const unsigned rl = (unsigned)(ai * 128 + wr * 64 + m * 16 + fr);
#pragma unroll
                    for (int bj = 0; bj < 2; ++bj) { const f32x4 v0 = acc[ai][bj][m][0] * (32.f / 1024.f), v1 = acc[ai][bj][m][1] * (32.f / 1024.f);
                        u32x2 w; w.x = __builtin_amdgcn_cvt_pk_fp8_f32(v0[0], v0[1], 0u, false); w.x = __builtin_amdgcn_cvt_pk_fp8_f32(v0[2], v0[3], w.x, true);
                        w.y = __builtin_amdgcn_cvt_pk_fp8_f32(v1[0], v1[1], 0u, false); w.y = __builtin_amdgcn_cvt_pk_fp8_f32(v1[2], v1[3], w.y, true);
                        *(u32x2*)(Vu + (rl * 1024u + (unsigned)(bj * 128 + col0))) = w; } }
            return;
        }
        const size_t row0 = (size_t)b * 2048 + t8 * 256;
        const char* p1u = (const char*)(part1 + row0 * 32); const char* pqu = (const char*)(partq + row0 * 32 + h * 8); unsigned char* Pu = P + row0 * 1024 + h * 256;
        float rsc[2][4];
#pragma unroll
        for (int ai = 0; ai < 2; ++ai)
#pragma unroll
            for (int m = 0; m < 4; ++m) { const unsigned rl = (unsigned)(ai * 128 + wr * 64 + m * 16 + fr);
                const f32x4 p0 = *(const f32x4*)(p1u + (rl * 32u + (unsigned)fq * 8u) * 4u), p1 = *(const f32x4*)(p1u + (rl * 32u + (unsigned)fq * 8u + 4u) * 4u);
                float s1 = (p0[0] + p0[1]) + (p0[2] + p0[3]) + (p1[0] + p1[1]) + (p1[2] + p1[3]);
                const f32x2 pq = *(const f32x2*)(pqu + (rl * 32u + (unsigned)fq * 2u) * 4u);
                float sq = pq[0] + pq[1];
                s1 = quad_sum_16_32(s1); sq = quad_sum_16_32(sq);
                rsc[ai][m] = __builtin_amdgcn_rsqf(sq * (1.f / 512.f) + EPS_ * (s1 * (1.f / 2048.f) + EPS_)) * (1.4426950408889634f / 2048.f);
                float ps = 0.f;
#pragma unroll
                for (int bj = 0; bj < 2; ++bj)
#pragma unroll
                    for (int n = 0; n < 2; ++n)
#pragma unroll
                        for (int e = 0; e < 4; ++e) ps += __builtin_amdgcn_exp2f(fminf(acc[ai][bj][m][n][e] * rsc[ai][m], 100.f));
                ps = quad_sum_16_32(ps);
                if (fq == 0) red[rl * 4 + wc] = ps;
                __builtin_amdgcn_sched_barrier(0); }
        __syncthreads();
        { int ln_ = threadIdx.x; asm volatile("" : "+v"(ln_)); fr = ln_ & 15; fq = (ln_ >> 4) & 3; }
#pragma unroll
        for (int ai = 0; ai < 2; ++ai)
#pragma unroll
            for (int m = 0; m < 4; ++m) { const unsigned rl = (unsigned)(ai * 128 + wr * 64 + m * 16 + fr);
                const f32x4 t = *(const LAS f32x4*)(red + rl * 4); const float inv = 256.f * __builtin_amdgcn_rcpf((t[0] + t[1]) + (t[2] + t[3])); float rs = rsc[ai][m]; asm volatile("" : "+v"(rs));
#pragma unroll
                for (int bj = 0; bj < 2; ++bj) { float x[8];
#pragma unroll
                    for (int n = 0; n < 2; ++n)
#pragma unroll
                        for (int e = 0; e < 4; ++e) x[n * 4 + e] = __builtin_amdgcn_exp2f(fminf(acc[ai][bj][m][n][e] * rs, 100.f)) * inv;
                    u32x2 w; w.x = __builtin_amdgcn_cvt_pk_fp8_f32(x[0], x[1], 0u, false); w.x = __builtin_amdgcn_cvt_pk_fp8_f32(x[2], x[3], w.x, true);
                    w.y = __builtin_amdgcn_cvt_pk_fp8_f32(x[4], x[5], 0u, false); w.y = __builtin_amdgcn_cvt_pk_fp8_f32(x[6], x[7], w.y, true);
                    *(u32x2*)(Pu + (rl * 1024u + (unsigned)(bj * 128 + wc * 32 + 8 * fq))) = w; } }
        __syncthreads();
    }
};

constexpr int HNP = 2052;
DI void p8_route(Frame& F, const ArgP& a) {
    LAS float* s_hn = (LAS float*)F.lds; LAS float* s_part = (LAS float*)(F.lds + 16 * HNP * 4); LAS float* s_log = s_part + 8 * 16 * 32; LAS int* s_slot = (LAS int*)(s_log + 16 * 32);
    LAS int* s_cnt = s_slot + 64; LAS int* s_base = s_cnt + 32;
    const bf16_t* h2 = (const bf16_t*)(F.ws + WS_H2); unsigned char* xg = (unsigned char*)(F.ws + WS_XG);
    float* gate_of = (float*)(F.ws + WS_GATEOF); int* tok_e = (int*)(F.ws + WS_TOKE);
    const float* rw = a.in(I_RW); const float* rb = a.in(I_RB); const float* g3 = a.in(I_GFFN);
    const int lane = F.lane, wave = F.wave, tid = F.tid;
    float bw0[64], bw1[64];
    { const int kq = lane >> 4, c16 = lane & 15; const float* bp = rw + (size_t)(256 * wave + kq) * 32 + c16;
#pragma unroll
      for (int j = 0; j < 64; ++j) { bw0[j] = bp[(size_t)(4 * j) * 32]; bw1[j] = bp[(size_t)(4 * j) * 32 + 16]; } }
    for (int task = F.vcu; task < NTOK / 16; task += F.G) {
        const int tb = task * 16;
#pragma unroll
        for (int q = 0; q < 2; ++q) { const int tl = 2 * wave + q; const size_t tok = (size_t)(tb + tl);
            const u32x2* xr = (const u32x2*)(h2 + tok * 2048) + lane;
            f32x4 v[8]; float s = 0.f;
#pragma unroll
            for (int j = 0; j < 8; ++j) { const u32x2 rw_ = xr[64 * j]; v[j] = (f32x4){bflo(rw_.x), bfhi(rw_.x), bflo(rw_.y), bfhi(rw_.y)}; s += (v[j].x * v[j].x + v[j].y * v[j].y) + (v[j].z * v[j].z + v[j].w * v[j].w); }
            const float rstd = 1.f / sqrtf(wave_sum(s) * (1.f / 2048.f) + EPS_);
#pragma unroll
            for (int j = 0; j < 8; ++j) { const f32x4 gg = ((const f32x4*)g3)[lane + 64 * j]; const f32x4 y = v[j] * rstd * gg;
                *(LAS f32x4*)(s_hn + tl * HNP + (lane + 64 * j) * 4) = y; } }
        __syncthreads();
        {
            f32x4 acc0 = {0.f, 0.f, 0.f, 0.f}, acc1 = {0.f, 0.f, 0.f, 0.f};
            const int kq = lane >> 4, c16 = lane & 15;
            const LAS float* ap = s_hn + c16 * HNP + 256 * wave;
#pragma unroll
            for (int j = 0; j < 64; ++j) { const f32x4 a4 = *(const LAS f32x4*)(ap + 4 * j);
                const float av = (kq == 0) ? a4.x : (kq == 1) ? a4.y : (kq == 2) ? a4.z : a4.w;
                acc0 = __builtin_amdgcn_mfma_f32_16x16x4f32(av, bw0[j], acc0, 0, 0, 0);
                acc1 = __builtin_amdgcn_mfma_f32_16x16x4f32(av, bw1[j], acc1, 0, 0, 0); }
            LAS float* pp = s_part + wave * 512 + c16;
#pragma unroll
            for (int r = 0; r < 4; ++r) { pp[(4 * kq + r) * 32] = acc0[r]; pp[(4 * kq + r) * 32 + 16] = acc1[r]; }
        }
        __syncthreads();
        {
            const int tt = tid >> 5, e = tid & 31; float lg = rb[e];
#pragma unroll
            for (int w = 0; w < 8; ++w) lg += s_part[w * 512 + tt * 32 + e];
            if (tid < 32) s_cnt[tid] = 0;
            float val[4]; int idx[4]; float cur = lg;
#pragma unroll
            for (int k = 0; k < 4; ++k) { float bv = cur; int bi = e;
#pragma unroll
                for (int o = 1; o < 32; o <<= 1) { const float ov = __shfl_xor(bv, o); const int oi = __shfl_xor(bi, o); if (ov > bv || (ov == bv && oi < bi)) { bv = ov; bi = oi; } }
                val[k] = bv; idx[k] = bi; if (e == bi) cur = -INFINITY; }
            __syncthreads();
            int myrank = 0, myexp = 0; float mygate = 0.f;
            if (e < 4) { const float sum = (__expf(val[0] - val[0]) + __expf(val[1] - val[0])) + (__expf(val[2] - val[0]) + __expf(val[3] - val[0]));
                const float mv = (e == 0) ? val[0] : (e == 1) ? val[1] : (e == 2) ? val[2] : val[3]; myexp = (e == 0) ? idx[0] : (e == 1) ? idx[1] : (e == 2) ? idx[2] : idx[3];
                mygate = __expf(mv - val[0]) / sum; myrank = __hip_atomic_fetch_add(&s_cnt[myexp], 1, __ATOMIC_RELAXED, __HIP_MEMORY_SCOPE_WORKGROUP); }
            __syncthreads();
            if (tid < 32) { const int c = s_cnt[tid]; s_base[tid] = c ? (int)__hip_atomic_fetch_add(F.ctl + CW_CNT + 64 * tid, (unsigned)c, __ATOMIC_RELAXED, __HIP_MEMORY_SCOPE_AGENT) : 0; }
            __syncthreads();
            if (e < 4) { const int slot = myexp * 8192 + s_base[myexp] + myrank; const int tok = tb + tt;
                gate_of[slot] = mygate; tok_e[tok * 4 + e] = slot; s_slot[tt * 4 + e] = slot; }
        }
        __syncthreads();
#pragma unroll
        for (int q = 0; q < 2; ++q) { const int tl = 2 * wave + q;
            unsigned o[8];
#pragma unroll
            for (int j = 0; j < 8; ++j) { const f32x4 y = *(const LAS f32x4*)(s_hn + tl * HNP + (lane + 64 * j) * 4);
                unsigned w = 0u; w = __builtin_amdgcn_cvt_pk_fp8_f32(y.x * 4.f, y.y * 4.f, w, false); w = __builtin_amdgcn_cvt_pk_fp8_f32(y.z * 4.f, y.w * 4.f, w, true); o[j] = w; }
#pragma unroll
            for (int k = 0; k < 4; ++k) { unsigned* o4 = (unsigned*)(xg + (size_t)s_slot[tl * 4 + k] * 2048) + lane;
#pragma unroll
                for (int j = 0; j < 8; ++j) o4[64 * j] = o[j]; } }
        __syncthreads();
    }
}

DI void moe_tables(Frame& F) {
    if (F.tid == 0) { unsigned base = 0u;
        for (int e = 0; e < 32; ++e) { const unsigned c = F.ctl[CW_CNT + 64 * e], mt = (c + 255u) >> 8; F.MISC[16 + e] = c; F.MISC[48 + e] = base; F.MISC[80 + e] = mt; base += mt; }
        F.MISC[112] = base; }
    __syncthreads();
}
DI int ldsu(volatile LAS unsigned* p) { return __builtin_amdgcn_readfirstlane((int)*p); }
template <int NTN  >
struct SchedMoe {
    int G, c; const unsigned char* ws; volatile LAS unsigned* MISC; int total;
    DI bool next(int i, pg8::UnitD& u) const {
        const int L = i * G + c; if (L >= total) return false;
        int e = 0;
        for (int k = 0; k < 32; ++k) { if (L >= (ldsu(MISC + 48 + k) + ldsu(MISC + 80 + k)) * NTN) e = k + 1; }
        const int tb = ldsu(MISC + 48 + e), mte = ldsu(MISC + 80 + e), cnt = ldsu(MISC + 16 + e);
        const int local = L - tb * NTN, nt = local / mte, mt = local % mte;
        u.type = 0; u.e = e; u.pn = nt; u.pm = tb + mt; u.x0 = mt; u.lda = 2048u; u.ldb = 2048u;
        u.rows = nullptr; u.nvalid = cnt - mt * 256;
        if (NTN == 16) { u.A = (const char*)(ws + WS_XG) + ((size_t)e * 8192 + (size_t)mt * 256) * 2048;
            u.B = (const char*)(ws + WS_W1) + ((size_t)e * 4096 + (size_t)nt * 256) * 2048; }
        else { u.A = (const char*)(ws + WS_ACT) + ((size_t)e * 8192 + (size_t)mt * 256) * 2048;
            u.B = (const char*)(ws + WS_W2) + ((size_t)e * 2048 + (size_t)nt * 256) * 2048; }
        return true;
    }
};
struct EpiMoe1 {
    static constexpr bool AFTER_DRAIN = false;
    unsigned char* act; const float* b1;
    DI void operator()(const f32x4 (&acc)[2][2][4][2], const pg8::UnitD& u, int wr, int wc, int fr, int fq) const {
        { int ln_ = threadIdx.x; asm volatile("" : "+v"(ln_)); fr = ln_ & 15; fq = (ln_ >> 4) & 3; }
        const int j0 = u.pn * 128 + wc * 32 + 8 * fq;
        const float* bg = b1 + (size_t)u.e * 4096 + j0; const float* bu = bg + 2048;
        const f32x4 bg0 = *(const f32x4*)bg, bg1 = *(const f32x4*)(bg + 4), bu0 = *(const f32x4*)bu, bu1 = *(const f32x4*)(bu + 4);
#pragma unroll
        for (int ai = 0; ai < 2; ++ai)
#pragma unroll
            for (int m = 0; m < 4; ++m) { const size_t row = (size_t)u.e * 8192 + u.x0 * 256 + ai * 128 + wr * 64 + m * 16 + fr;
                float o[8];
#pragma unroll
                for (int n = 0; n < 2; ++n)
#pragma unroll
                    for (int e = 0; e < 4; ++e) { const float g = fminf(acc[ai][0][m][n][e] * (1.f / 256.f) + (n ? bg1[e] : bg0[e]), 7.f);
                        const float uu = fminf(fmaxf(acc[ai][1][m][n][e] * (1.f / 256.f) + (n ? bu1[e] : bu0[e]), -7.f), 7.f);
                        o[n * 4 + e] = g / (1.f + __expf(-1.702f * g)) * (uu + 1.f) * 4.f; }
                u32x2 w; w.x = __builtin_amdgcn_cvt_pk_fp8_f32(o[0], o[1], 0u, false); w.x = __builtin_amdgcn_cvt_pk_fp8_f32(o[2], o[3], w.x, true);
                w.y = __builtin_amdgcn_cvt_pk_fp8_f32(o[4], o[5], 0u, false); w.y = __builtin_amdgcn_cvt_pk_fp8_f32(o[6], o[7], w.y, true);
                *(u32x2*)(act + row * 2048 + j0) = w; }
    }
};
struct EpiMoe2 {
    static constexpr bool AFTER_DRAIN = false;
    bf16_t* y; const float* b2; const float* gate_of;
    DI void operator()(const f32x4 (&acc)[2][2][4][2], const pg8::UnitD& u, int wr, int wc, int fr, int fq) const {
        { int ln_ = threadIdx.x; asm volatile("" : "+v"(ln_)); fr = ln_ & 15; fq = (ln_ >> 4) & 3; }
        const int col0 = u.pn * 256 + wc * 32 + 8 * fq;
        const float* bp = b2 + (size_t)u.e * 2048 + col0;
#pragma unroll
        for (int ai = 0; ai < 2; ++ai)
#pragma unroll
            for (int m = 0; m < 4; ++m) { const int rl = ai * 128 + wr * 64 + m * 16 + fr; const size_t row = (size_t)u.e * 8192 + u.x0 * 256 + rl;
                const float gt = (rl < u.nvalid) ? gate_of[u.e * 8192 + u.x0 * 256 + rl] : 0.f;
#pragma unroll
                for (int bj = 0; bj < 2; ++bj) { const f32x4 v0 = (acc[ai][bj][m][0] * (1.f / 256.f) + *(const f32x4*)(bp + bj * 128)) * gt, v1 = (acc[ai][bj][m][1] * (1.f / 256.f) + *(const f32x4*)(bp + bj * 128 + 4)) * gt;
                    u32x4 w; w.x = pk2(v0[0], v0[1]); w.y = pk2(v0[2], v0[3]); w.z = pk2(v1[0], v1[1]); w.w = pk2(v1[2], v1[3]);
                    *(u32x4*)(y + row * 2048 + col0 + bj * 128) = w; } }
    }
};

DI void p11_combine(Frame& F, const ArgP& a) {
    const int gw = F.vcu * NWAVES + F.wave, NGW = F.G * NWAVES, lane = F.lane;
    const bf16_t* h2 = (const bf16_t*)(F.ws + WS_H2); const bf16_t* y = (const bf16_t*)(F.ws + WS_Y);
    const int* tok_e = (const int*)(F.ws + WS_TOKE);
    for (int t = gw; t < NTOK; t += NGW) {
        size_t yrow[4];
#pragma unroll
        for (int k = 0; k < 4; ++k) yrow[k] = (size_t)tok_e[t * 4 + k] * 2048;
#pragma unroll
        for (int j = 0; j < 8; ++j) { const int c = (lane + 64 * j) * 4;
            const u32x2 hw = *(const u32x2*)(h2 + (size_t)t * 2048 + c); f32x4 v = {bflo(hw.x), bfhi(hw.x), bflo(hw.y), bfhi(hw.y)};
#pragma unroll
            for (int k = 0; k < 4; ++k) { const u32x2 w = *(const u32x2*)(y + yrow[k] + c); v.x += bflo(w.x); v.y += bfhi(w.x); v.z += bflo(w.y); v.w += bfhi(w.y); }
            *(f32x4*)(a.out() + (size_t)t * 2048 + c) = v; }
    }
}

#ifndef MK_PER_PHASE
#define MK_PER_PHASE 0
#endif
#ifndef MK_LAST_PHASE
#define MK_LAST_PHASE 12
#endif
constexpr int N_PHASES = MK_LAST_PHASE;

__global__ void __launch_bounds__(NWAVES * 64, 2) mega_fwd(Args args_) {
    const ArgP args{};
    extern __shared__ __attribute__((aligned(16))) unsigned char lds_raw[];
    Frame F;
    F.lds = (LAS unsigned char*)lds_raw;
    F.MISC = (volatile LAS unsigned*)(F.lds + MISC_OFF);
    F.tid = threadIdx.x; F.lane = F.tid & 63; F.wave = __builtin_amdgcn_readfirstlane(F.tid >> 6);
    F.G = gridDim.x; { const int bx = blockIdx.x; F.vcu = (F.G % 8 == 0) ? (bx % 8) * (F.G / 8) + bx / 8 : bx; }
    F.ws = args_.ws; F.ctl = (unsigned*)(args_.ws + WS_CTL);
    for (int u = F.tid; u < 256; u += NWAVES * 64) F.MISC[u] = 0u;
    __syncthreads();
    XcdBarrier bar; bar.bar = F.ctl + CW_BAR; bar.x = 0; bar.st = nullptr;
    const int lo = args_.ph_lo, hi = args_.ph_hi;
    if (hi - lo > 1) bar = xcd_barrier_post(F.ctl + CW_BAR, F.MISC + 8);
#ifndef MK_PHASE_MASK
#define MK_PHASE_MASK 0xFFFF
#endif
#define IN(k) (((MK_PHASE_MASK >> (k)) & 1) && lo <= (k) && (k) < hi)
#define SEAM(k) do { if (IN(k) && IN((k) + 1)) xcd_barrier(bar); } while (0)
#define FRESH() do { int t_ = threadIdx.x; asm volatile("" : "+v"(t_)); F.tid = t_; F.lane = t_ & 63; F.wave = __builtin_amdgcn_readfirstlane(t_ >> 6); } while (0)
    unsigned char* ws = args_.ws;

    if (IN(0)) { FRESH(); p0_prologue(F, args); }
    SEAM(0);
    if (IN(1)) { FRESH();
        const bool conv_first = (F.vcu & 1) == 0;
        if (conv_first) { conv_share(F, args); __syncthreads(); }
        SchedP1 S{F.G, F.vcu, ws, 0, 32 * 23};
        EpiP1 E{(bf16_t*)(ws + WS_PROJ), (float*)(ws + WS_DT), (bf16_t*)(ws + WS_KVRAW), args.in(I_DAQG), args.in(I_DAKG), (unsigned char*)(ws + WS_VF8)};
        pg8::gemm_phase<EpiP1, SchedP1, false, true>(F.lds + RING_OFF, 32, S, E);
        if (!conv_first) { __syncthreads(); conv_share(F, args); }
    }
    SEAM(1);
    if (IN(2)) { FRESH();
        if ((F.vcu & 3) == 1) {
            SchedP1 S{(F.G + 3) >> 2, F.vcu >> 2, ws, 32 * 23, 32 * 23 + 64};
            EpiP1 E{(bf16_t*)(ws + WS_PROJ), (float*)(ws + WS_DT), (bf16_t*)(ws + WS_KVRAW), args.in(I_DAQG), args.in(I_DAKG), (unsigned char*)(ws + WS_VF8)};
            pg8::gemm_phase<EpiP1, SchedP1, false, true>(F.lds + RING_OFF, 32, S, E);
            __syncthreads();
        }
        if ((F.vcu & 3) == 0) { for (int u = F.vcu >> 2; u < 64; u += (F.G + 3) >> 2) ssd_unit(F, args, u >> 4, u & 15); }
        __syncthreads();
        attn_phase_da(F);
        __syncthreads();
        conv_queue(F, args, CW_QCONV, CV_NJ - CV_TAIL, CV_TAIL1);
    }
    SEAM(2);
    if (IN(3)) { FRESH(); kprep(F, args); p3_finalize(F, args); }
    SEAM(3);
    if (IN(4)) { FRESH();
        SchedDense S{F.G, F.vcu, 32, 8, (const char*)(ws + WS_YCAT), (const char*)(ws + WS_WOUT), 4096u, 4096u, 1 << 30, 0};
        EpiResid<false> E{args.in(I_X), (bf16_t*)(ws + WS_H1), (float*)(ws + WS_PART1), (unsigned char*)(ws + WS_H1F8), 1.f};
        pg8::gemm_phase<EpiResid<false>, SchedDense, false, true>(F.lds + RING_OFF, 32, S, E);
    }
    SEAM(4);
    if (IN(5)) { FRESH();
        SchedDense S{F.G, F.vcu, 32, 8, (const char*)(ws + WS_H1F8), (const char*)(ws + WS_WQ), 2048u, 2048u, 1 << 30, 0};
        EpiQ E{(unsigned char*)(ws + WS_QF8), (float*)(ws + WS_PARTQ)};
        pg8::gemm_phase<EpiQ, SchedDense, false, true, true>(F.lds + RING_OFF, 16, S, E);
    }
    SEAM(5);
    if (IN(6)) { FRESH();
        SchedXS S{F.G, F.vcu, ws};
        EpiXS E{(unsigned char*)(ws + WS_P8), (unsigned char*)(ws + WS_VWT8), (const float*)(ws + WS_PART1), (const float*)(ws + WS_PARTQ), (LAS float*)(F.lds + RING_BYTES)};
        pg8::gemm_phase<EpiXS, SchedXS, false, true, true>(F.lds + RING_OFF, 4, S, E);
    }
    SEAM(6);
    if (IN(7)) { FRESH();
        SchedDense S{F.G, F.vcu, 32, 8, (const char*)(ws + WS_P8), (const char*)(ws + WS_VWT8), 1024u, 1024u, 8, (size_t)2048 * 1024};
        EpiResid<true> E{(const void*)(ws + WS_H1), (bf16_t*)(ws + WS_H2), nullptr, nullptr, 1.f / 8192.f};
        pg8::gemm_phase<EpiResid<true>, SchedDense, false, true, true>(F.lds + RING_OFF, 8, S, E);
    }
    SEAM(7);
    if (IN(8)) { FRESH(); p8_route(F, args); }
    SEAM(8);
    if (IN(9)) { FRESH();
        moe_tables(F);
        SchedMoe<16> S{F.G, F.vcu, ws, F.MISC, ldsu(F.MISC + 112) * 16};
        EpiMoe1 E{(unsigned char*)(ws + WS_ACT), args.in(I_B1)};
        pg8::gemm_phase<EpiMoe1, SchedMoe<16>, false, true, true>(F.lds + RING_OFF, 16, S, E);
        __syncthreads();
        conv_queue(F, args, CW_QCONV2, CV_NJ - CV_TAIL2, CV_TAIL2);
    }
    SEAM(9);
    if (IN(10)) { FRESH();
        moe_tables(F);
        SchedMoe<8> S{F.G, F.vcu, ws, F.MISC, ldsu(F.MISC + 112) * 8};
        EpiMoe2 E{(bf16_t*)(ws + WS_Y), args.in(I_B2), (const float*)(ws + WS_GATEOF)};
        pg8::gemm_phase<EpiMoe2, SchedMoe<8>, false, true, true>(F.lds + RING_OFF, 16, S, E);
    }
    SEAM(10);
    if (IN(11)) { FRESH(); p11_combine(F, args); }
#undef IN
#undef SEAM
}

extern "C" void kernel_launch(void* const* d_in, const int* in_sizes, int n_in, void* d_out, int out_size, void* d_ws, size_t ws_size, hipStream_t stream) {
    static int grid = 0;
    if (grid == 0) {
        if (n_in != 32 || out_size != NTOK * 2048 || ws_size < WS_END) { fprintf(stderr, "kernel_launch: unexpected shapes (n_in %d out %d ws %zu); nothing launched\n", n_in, out_size, ws_size); grid = -1; return; }
        int dev = 0, cus = 0, per_cu = 0;
        if (hipGetDevice(&dev) != hipSuccess || hipDeviceGetAttribute(&cus, hipDeviceAttributeMultiprocessorCount, dev) != hipSuccess) { grid = -1; return; }
        if (hipFuncSetAttribute((const void*)mega_fwd, hipFuncAttributeMaxDynamicSharedMemorySize, LDS_BYTES) != hipSuccess) { fprintf(stderr, "kernel_launch: hipFuncSetAttribute failed\n"); grid = -1; return; }
        if (hipOccupancyMaxActiveBlocksPerMultiprocessor(&per_cu, (const void*)mega_fwd, NWAVES * 64, LDS_BYTES) != hipSuccess || per_cu < 1) { fprintf(stderr, "kernel_launch: occupancy query says %d\n", per_cu); }
        (void)hipGetLastError();
        if (cus < 256) { fprintf(stderr, "kernel_launch: needs 256 CUs, found %d; nothing launched\n", cus); grid = -1; return; }
        grid = 256;
    }
    if (grid < 0) return;
    if (hipMemsetAsync((char*)d_ws + WS_CTL, 0, CTL_ZERO_BYTES, stream) != hipSuccess) return;
    Args a{};
    for (int i = 0; i < 32; ++i) a.in[i] = (const float*)d_in[i];
    a.out = (float*)d_out; a.ws = (unsigned char*)d_ws;
#if MK_PER_PHASE
    for (int p = 0; p < N_PHASES; ++p) { a.ph_lo = p; a.ph_hi = p + 1; hipLaunchKernelGGL(mega_fwd, dim3(grid), dim3(NWAVES * 64), LDS_BYTES, stream, a); }
#else
    a.ph_lo = 0; a.ph_hi = N_PHASES;
    hipLaunchKernelGGL(mega_fwd, dim3(grid), dim3(NWAVES * 64), LDS_BYTES, stream, a);
#ifdef MK_PROBE_LO
    for (int p = MK_PROBE_LO; p < MK_PROBE_HI; ++p) { a.ph_lo = p; a.ph_hi = p + 1;
        if (p == 2) (void)hipMemsetAsync((char*)d_ws + WS_CTL + CW_QATT * 4, 0, 1024, stream);
        hipLaunchKernelGGL(mega_fwd, dim3(grid), dim3(NWAVES * 64), LDS_BYTES, stream, a); }
#endif
#endif
}
```

```cpp
#define MK_PER_PHASE 0
#define MK_LAST_PHASE 12
#include <hip/hip_runtime.h>
#include <hip/hip_bf16.h>
#include <cstdio>
#include <cstdint>
#include <cmath>

#define GAS __attribute__((address_space(1)))
#define LAS __attribute__((address_space(3)))
typedef unsigned short bf16_t;
typedef short bf16x8 __attribute__((ext_vector_type(8)));
typedef float f32x2 __attribute__((ext_vector_type(2)));
typedef float f32x4 __attribute__((ext_vector_type(4)));
typedef float f32x16 __attribute__((ext_vector_type(16)));
typedef unsigned u32x2 __attribute__((ext_vector_type(2)));
typedef unsigned u32x4 __attribute__((ext_vector_type(4)));
typedef __bf16 bf16x2_t __attribute__((ext_vector_type(2)));

#define DI __device__ __forceinline__
DI unsigned pk2(float lo, float hi) { f32x2 v = {lo, hi}; bf16x2_t b = __builtin_convertvector(v, bf16x2_t); return __builtin_bit_cast(unsigned, b); }
DI float bflo(unsigned u) { return __uint_as_float(u << 16); }
DI float bfhi(unsigned u) { return __uint_as_float(u & 0xffff0000u); }
DI float bf2f(bf16_t h) { return __uint_as_float(((unsigned)h) << 16); }
DI float wave_sum(float v) {
#pragma unroll
    for (int o = 1; o < 64; o <<= 1) v += __shfl_xor(v, o);
    return v;
}
DI float quad_sum_16_32(float v) {
    int l_ = threadIdx.x; asm volatile("" : "+v"(l_));
    const int a16 = ((l_ ^ 16) & 63) << 2, a32 = ((l_ ^ 32) & 63) << 2;
    v += __builtin_bit_cast(float, __builtin_amdgcn_ds_bpermute(a16, __builtin_bit_cast(int, v)));
    v += __builtin_bit_cast(float, __builtin_amdgcn_ds_bpermute(a32, __builtin_bit_cast(int, v)));
    return v;
}
DI float siluf(float x) { return x / (1.f + __expf(-x)); }

constexpr int DM_ = 2048, NB = 4, SEQ_ = 2048, NTOK = NB * SEQ_;
constexpr int PP = 5632;
constexpr int PC_XBC = 1024, PC_Q = 2560, PC_K = 3584, PC_V = 4608, PC_DT = 5632;
constexpr int WIN_ROWS = 5888;
constexpr int NEXP = 32, MEMLEN = 256;
constexpr float EPS_ = 1e-6f;
constexpr float LAM_INIT = 0.2f;

namespace pg8 {
constexpr int BM = 256, BK = 64, HALF = 128, HTB = HALF * BK * 2  , STAGE_BYTES = 8 * HTB;
DI int lds_byte(int r, int c) { const int st = (r >> 4) * 2 + (c >> 5), rr = r & 15, cc = c & 31, ob = rr * 64 + cc * 2; return st * 1024 + (ob ^ (((ob >> 9) & 1) << 5)); }
DI void stage_rc(int b, int& R, int& C) { const int st = b / 1024, sb = b % 1024, swz = sb ^ (((sb >> 9) & 1) << 5); R = (st >> 1) * 16 + swz / 64; C = (st & 1) * 32 + (swz % 64) / 2; }
DI int perm32(int rho) { const int n = rho >> 4, i = rho & 15; return 8 * (i >> 2) + 4 * n + (i & 3); }

struct UnitD {
    const char* A; const char* B;
    const int* rows;
    unsigned lda, ldb;
    int nvalid;
    int type, pm, pn, e, x0;
};
typedef int v8i_t __attribute__((ext_vector_type(8)));
DI v8i_t cat8(bf16x8 lo, bf16x8 hi) { typedef int v4i_t __attribute__((ext_vector_type(4))); const v4i_t a = __builtin_bit_cast(v4i_t, lo), b = __builtin_bit_cast(v4i_t, hi); return (v8i_t){a[0], a[1], a[2], a[3], b[0], b[1], b[2], b[3]}; }
DI void dense_voff(unsigned lda, unsigned ldb, int tid, unsigned (&vA)[2], unsigned (&vB)[2]) {
#pragma unroll
    for (int i = 0; i < 2; ++i) { int R, C; stage_rc(tid * 16 + i * 8192, R, C); const int Rb = (R & ~31) + perm32(R & 31);
        vA[i] = (unsigned)R * lda + (unsigned)C * 2u; vB[i] = (unsigned)Rb * ldb + (unsigned)C * 2u; }
}
DI void gather_voff(const UnitD& u, int tid, unsigned (&gA)[2][2]) {
#pragma unroll
    for (int i = 0; i < 2; ++i) { int R, C; stage_rc(tid * 16 + i * 8192, R, C);
#pragma unroll
        for (int h = 0; h < 2; ++h) { const int ra = h * 128 + R; const unsigned rowA = (ra < u.nvalid) ? (unsigned)u.rows[ra] : 0u; gA[h][i] = rowA * u.lda + (unsigned)C * 2u; } }
}

template <class Epi, class Sched, bool GATHER, bool ALIGN_EPI, bool FP8 = false>
DI void gemm_phase(LAS unsigned char* lds, int nt, const Sched& S, const Epi& E) {

    const int tid = threadIdx.x, wid = __builtin_amdgcn_readfirstlane(tid >> 6), lane = tid & 63, wr = wid >> 2, wc = wid & 3, fr = lane & 15, fq = lane >> 4;
    const size_t kstep = (size_t)(BK * 2);
    const unsigned ldsb = (unsigned)__builtin_amdgcn_readfirstlane((int)((unsigned)(uintptr_t)lds + (unsigned)wid * 1024u));
    const int aoff = lds_byte(wr * 64 + fr, fq * 8), boff = lds_byte(wc * 32 + fr, fq * 8);
#define PG8_SA(b, h) (((b) * 2 + (h)) * HTB)
#define PG8_SB(b, h) ((4 + (b) * 2 + (h)) * HTB)
#define PG8_STAGE(bufoff, gbase, voff) do { _Pragma("unroll") for (int _i = 0; _i < 2; ++_i) { unsigned keep_; \
        asm volatile("s_mov_b32 %0, m0\n\ts_mov_b32 m0, %3\n\ts_nop 0\n\tglobal_load_lds_dwordx4 %1, %2\n\ts_mov_b32 m0, %0" \
                     : "=&s"(keep_) : "v"((voff)[_i]), "s"((const char*)(gbase)), "s"(ldsb + (unsigned)((bufoff) + _i * 8192)) : "memory"); } } while (0)
#define PG8_STA(bufoff, gbase, h, HS, GA) do { if constexpr (GATHER) { PG8_STAGE(bufoff, gbase, GA[h]); } else { PG8_STAGE(bufoff, (gbase) + (h) * (HS), vA); } } while (0)
#define PG8_STB(bufoff, gbase, h, HS) PG8_STAGE(bufoff, (gbase) + (h) * (HS), vB)
typedef int v4i_t __attribute__((ext_vector_type(4)));
#define PG8_LDA(dst, b, h) do { _Pragma("unroll") for (int m = 0; m < 4; ++m) { if constexpr (FP8) { \
            const v4i_t lo_ = *(const LAS v4i_t*)(lds + PG8_SA(b, h) + aoff + m * 2048), hi_ = *(const LAS v4i_t*)(lds + PG8_SA(b, h) + aoff + m * 2048 + 1024); \
            dst##8[m] = __builtin_shufflevector(lo_, hi_, 0, 1, 2, 3, 4, 5, 6, 7); } \
        else { _Pragma("unroll") for (int k = 0; k < 2; ++k) dst[m][k] = *(const LAS bf16x8*)(lds + PG8_SA(b, h) + aoff + m * 2048 + k * 1024); } } } while (0)
#define PG8_LDB(dst, b, h) do { _Pragma("unroll") for (int n = 0; n < 2; ++n) { if constexpr (FP8) { \
            const v4i_t lo_ = *(const LAS v4i_t*)(lds + PG8_SB(b, h) + boff + n * 2048), hi_ = *(const LAS v4i_t*)(lds + PG8_SB(b, h) + boff + n * 2048 + 1024); \
            dst##8[n] = __builtin_shufflevector(lo_, hi_, 0, 1, 2, 3, 4, 5, 6, 7); } \
        else { _Pragma("unroll") for (int k = 0; k < 2; ++k) dst[n][k] = *(const LAS bf16x8*)(lds + PG8_SB(b, h) + boff + n * 2048 + k * 1024); } } } while (0)
#ifndef PG8_FP8_PRIO
#define PG8_FP8_PRIO 1
#endif
#define PG8_MMA(ai, bj, At, Bt) do { if (!FP8 || PG8_FP8_PRIO) __builtin_amdgcn_s_setprio(1); _Pragma("unroll") for (int m = 0; m < 4; ++m) _Pragma("unroll") for (int n = 0; n < 2; ++n) { \
        if constexpr (FP8) { acc[ai][bj][m][n] = __builtin_amdgcn_mfma_scale_f32_16x16x128_f8f6f4(Bt##8[n], At##8[m], acc[ai][bj][m][n], 0, 0, 0, 0x7f7f7f7f, 0, 0x7f7f7f7f); } \
        else { _Pragma("unroll") for (int k = 0; k < 2; ++k) acc[ai][bj][m][n] = __builtin_amdgcn_mfma_f32_16x16x32_bf16(Bt[n][k], At[m][k], acc[ai][bj][m][n], 0, 0, 0); } } \
        if (!FP8 || PG8_FP8_PRIO) __builtin_amdgcn_s_setprio(0); } while (0)
#define PG8_WAIT_V(n) asm volatile("s_waitcnt vmcnt(" #n ")" ::: "memory")
#define PG8_WAIT_L(n) asm volatile("s_waitcnt lgkmcnt(" #n ")" ::: "memory")
#define PG8_BAR __builtin_amdgcn_s_barrier()
#define PG8_SCHED __builtin_amdgcn_sched_barrier(0)
#define PG8_ITER(A1P, A2P, B2P, HA2, HB2, GA2) do { \
        const char* a3p_ = (A2P) + kstep; const char* b3p_ = (B2P) + kstep; \
        PG8_LDB(B0, 0, 0); PG8_LDB(B1, 0, 1); PG8_SCHED; PG8_LDA(At, 0, 0); PG8_STA(PG8_SA(1, 1), (A1P), 1, hsA, gA); \
        PG8_WAIT_V(8); PG8_WAIT_L(0); PG8_BAR; PG8_MMA(0, 0, At, B0); PG8_MMA(0, 1, At, B1); PG8_BAR; PG8_SCHED; \
        PG8_LDA(At, 0, 1); PG8_STB(PG8_SB(0, 0), (B2P), 0, HB2); PG8_STB(PG8_SB(0, 1), (B2P), 1, HB2); PG8_STA(PG8_SA(0, 0), (A2P), 0, HA2, GA2); \
        PG8_WAIT_V(8); PG8_WAIT_L(0); PG8_BAR; PG8_MMA(1, 0, At, B0); PG8_MMA(1, 1, At, B1); PG8_BAR; PG8_SCHED; \
        PG8_LDB(B0, 1, 0); PG8_LDB(B1, 1, 1); PG8_SCHED; PG8_LDA(At, 1, 0); PG8_STA(PG8_SA(0, 1), (A2P), 1, HA2, GA2); \
        PG8_WAIT_V(8); PG8_WAIT_L(0); PG8_BAR; PG8_MMA(0, 0, At, B0); PG8_MMA(0, 1, At, B1); PG8_BAR; PG8_SCHED; \
        PG8_LDA(At, 1, 1); PG8_STB(PG8_SB(1, 0), b3p_, 0, HB2); PG8_STB(PG8_SB(1, 1), b3p_, 1, HB2); PG8_STA(PG8_SA(1, 0), a3p_, 0, HA2, GA2); \
        PG8_WAIT_V(8); PG8_WAIT_L(0); PG8_BAR; PG8_MMA(1, 0, At, B0); PG8_MMA(1, 1, At, B1); PG8_BAR; PG8_SCHED; \
    } while (0)
    UnitD cur, nxt; int ui = 0;
    if (!S.next(0, cur)) return;
    f32x4 acc[2][2][4][2];
#pragma unroll
    for (int a = 0; a < 2; ++a)
#pragma unroll
        for (int b = 0; b < 2; ++b)
#pragma unroll
            for (int m = 0; m < 4; ++m)
#pragma unroll
                for (int n = 0; n < 2; ++n) acc[a][b][m][n] = (f32x4){0.f, 0.f, 0.f, 0.f};
    bf16x8 At[4][2], B0[2][2], B1[2][2]; v8i_t At8[4], B08[2], B18[2];
    unsigned vA[2], vB[2], gA[2][2], ngA[2][2];
    dense_voff(cur.lda, cur.ldb, tid, vA, vB);
    if constexpr (GATHER) gather_voff(cur, tid, gA);
    const char* cA = cur.A; const char* cB = cur.B;
    size_t hsA = GATHER ? 0 : (size_t)cur.lda * HALF, hsB = (size_t)cur.ldb * HALF;
    PG8_STB(PG8_SB(0, 0), cB, 0, hsB); PG8_STB(PG8_SB(0, 1), cB, 1, hsB); PG8_STA(PG8_SA(0, 0), cA, 0, hsA, gA); PG8_STA(PG8_SA(0, 1), cA, 1, hsA, gA);
    if (wr == 1) PG8_BAR;
    PG8_WAIT_V(2); PG8_BAR;
    PG8_STB(PG8_SB(1, 0), cB + kstep, 0, hsB); PG8_STA(PG8_SA(1, 0), cA + kstep, 0, hsA, gA); PG8_STB(PG8_SB(1, 1), cB + kstep, 1, hsB);
    PG8_WAIT_V(6); PG8_BAR;
    for (;;) {
        const bool has_next = S.next(ui + 1, nxt);
        const char* nA = cA; const char* nB = cB; size_t nhsA = hsA, nhsB = hsB;
        if (has_next) { nA = nxt.A; nB = nxt.B; nhsA = GATHER ? 0 : (size_t)nxt.lda * HALF; nhsB = (size_t)nxt.ldb * HALF; }
        if constexpr (GATHER) {
            if (has_next) gather_voff(nxt, tid, ngA);
            else {
#pragma unroll
                for (int h = 0; h < 2; ++h)
#pragma unroll
                    for (int i = 0; i < 2; ++i) ngA[h][i] = gA[h][i];
            }
        }
#pragma unroll 1
        for (int t = 0; t < nt; t += 2) {
            const bool last = (t == nt - 2);
            const char* a2 = last ? nA : cA + (size_t)(t + 2) * kstep; const char* b2 = last ? nB : cB + (size_t)(t + 2) * kstep;
            const size_t hA2 = last ? nhsA : hsA, hB2 = last ? nhsB : hsB;
            unsigned g2[2][2];
            if constexpr (GATHER) {
#pragma unroll
                for (int h = 0; h < 2; ++h)
#pragma unroll
                    for (int i = 0; i < 2; ++i) g2[h][i] = last ? ngA[h][i] : gA[h][i];
            }
            PG8_ITER(cA + (size_t)(t + 1) * kstep, a2, b2, hA2, hB2, g2);
        }
        if constexpr (ALIGN_EPI) { if (wr == 0) PG8_BAR; }
        if constexpr (!Epi::AFTER_DRAIN) { E(acc, cur, wr, wc, fr, fq); }
        if (!has_next) break;
#pragma unroll
        for (int a = 0; a < 2; ++a)
#pragma unroll
            for (int b = 0; b < 2; ++b)
#pragma unroll
                for (int m = 0; m < 4; ++m)
#pragma unroll
                    for (int n = 0; n < 2; ++n) acc[a][b][m][n] = (f32x4){0.f, 0.f, 0.f, 0.f};
        cur = nxt; cA = nA; cB = nB; hsA = nhsA; hsB = nhsB; ++ui;
        if constexpr (GATHER) {
#pragma unroll
            for (int h = 0; h < 2; ++h)
#pragma unroll
                for (int i = 0; i < 2; ++i) gA[h][i] = ngA[h][i];
        }
        if constexpr (ALIGN_EPI) { if (wr == 1) PG8_BAR; }
    }
    PG8_WAIT_V(0);
    if constexpr (!ALIGN_EPI) { if (wr == 0) PG8_BAR; }
    PG8_BAR;
    if constexpr (Epi::AFTER_DRAIN) { E.fused(acc, cur, wr, wc, fr, fq, lds, wid, lane); }
#undef PG8_SA
#undef PG8_SB
#undef PG8_STAGE
#undef PG8_STA
#undef PG8_STB
#undef PG8_LDA
#undef PG8_LDB
#undef PG8_MMA
#undef PG8_WAIT_V
#undef PG8_WAIT_L
#undef PG8_BAR
#undef PG8_SCHED
#undef PG8_ITER
}
}
namespace attn_body {
using bf16=__hip_bfloat16;
using bf16x8=__attribute__((ext_vector_type(8)))short;
using s16x4=__attribute__((ext_vector_type(4)))short;
using f32x16=__attribute__((ext_vector_type(16)))float;
using u32x4=__attribute__((ext_vector_type(4)))unsigned;
constexpr int BATCH=4,SEQ=2048,D=64,DM=5632,OPITCH=1024;
constexpr int NW=8,QBLK=32,QB=QBLK*NW,KVBLK=64,NQB=SEQ/QB;
constexpr int ATTN_UNIT_ROWS=QB;
__device__ __forceinline__ int crow(int r,int hi){return (r&3)+8*(r>>2)+4*hi;}
#define SBAR() __builtin_amdgcn_sched_barrier(0)
__device__ __forceinline__ void cmask(f32x16&p0,f32x16&p1,int jb,int qrel,int hi){
  const float NEG=-INFINITY; int kb=64*jb+4*hi;
  #pragma unroll
  for(int r=0;r<16;++r){int kv=kb+(r&3)+8*(r>>2); if(kv>qrel)p0[r]=NEG; if(kv+32>qrel)p1[r]=NEG;}
}

constexpr int NSLOT=3, SLOTB=8192;
constexpr int LDS_K=0, LDS_V=NSLOT*SLOTB, LDS_WS=2*NSLOT*SLOTB, LDS_OST=LDS_WS+NW*64*4, LDS_BYTES=LDS_OST+NW*4096;
constexpr float C2=0.125f*1.4426950408889634f;
__device__ __forceinline__ void glds16(const void*gsrc,unsigned lds_dst){unsigned keep;
  asm volatile("s_mov_b32 %0, m0\n\ts_mov_b32 m0, %2\n\ts_nop 0\n\tglobal_load_lds_dwordx4 %1, off\n\ts_mov_b32 m0, %0":"=&s"(keep):"v"(gsrc),"s"(lds_dst):"memory");}
__device__ __forceinline__ float max3f(float a,float b,float c){float r;asm("v_max3_f32 %0, %1, %2, %3":"=v"(r):"v"(a),"v"(b),"v"(c));return r;}
__device__ __forceinline__ float max2f(float a,float b){float r;asm("v_max_f32_e32 %0, %1, %2":"=v"(r):"v"(a),"v"(b));return r;}
__device__ __forceinline__ float fadd_s(float a,float b){float r;asm("v_add_f32_e32 %0, %1, %2":"=v"(r):"v"(a),"v"(b));return r;}
__device__ __forceinline__ float fsub_s(float a,float b){float r;asm("v_sub_f32_e32 %0, %1, %2":"=v"(r):"v"(a),"v"(b));return r;}
typedef float f32x2_t __attribute__((ext_vector_type(2))); typedef __bf16 bf16x2_t __attribute__((ext_vector_type(2)));
__device__ __forceinline__ unsigned cvtpk_s(float lo,float hi){f32x2_t v={lo,hi};bf16x2_t b=__builtin_convertvector(v,bf16x2_t);return __builtin_bit_cast(unsigned,b);}
#define WAIT_BAR(N) asm volatile("s_waitcnt vmcnt(" #N ") lgkmcnt(0)\n\ts_barrier":::"memory")

__device__ __forceinline__ void qkt(f32x16&p0,f32x16&p1,const char*Kslot,const bf16x8*qr,const f32x16&negm,int r32,int hi){
  const char*kb=Kslot+hi*1024+r32*16;
  #pragma unroll
  for(int d0=0;d0<4;++d0){
    const bf16x8 b0=*reinterpret_cast<const bf16x8*>(kb+d0*2048);
    const bf16x8 b1=*reinterpret_cast<const bf16x8*>(kb+d0*2048+512);
    if(d0==0){p0=__builtin_amdgcn_mfma_f32_32x32x16_bf16(b0,qr[0],negm,0,0,0);p1=__builtin_amdgcn_mfma_f32_32x32x16_bf16(b1,qr[0],negm,0,0,0);}
    else{p0=__builtin_amdgcn_mfma_f32_32x32x16_bf16(b0,qr[d0],p0,0,0,0);p1=__builtin_amdgcn_mfma_f32_32x32x16_bf16(b1,qr[d0],p1,0,0,0);}}
}
typedef __attribute__((address_space(3))) const char* lds_cptr;
typedef short v4i16_t __attribute__((ext_vector_type(4)));
__device__ __forceinline__ void kload8(bf16x8*kf,lds_cptr kp){
  kf[0]=*(const __attribute__((address_space(3))) bf16x8*)(kp);      kf[1]=*(const __attribute__((address_space(3))) bf16x8*)(kp+512);
  kf[2]=*(const __attribute__((address_space(3))) bf16x8*)(kp+2048); kf[3]=*(const __attribute__((address_space(3))) bf16x8*)(kp+2560);
  kf[4]=*(const __attribute__((address_space(3))) bf16x8*)(kp+4096); kf[5]=*(const __attribute__((address_space(3))) bf16x8*)(kp+4608);
  kf[6]=*(const __attribute__((address_space(3))) bf16x8*)(kp+6144); kf[7]=*(const __attribute__((address_space(3))) bf16x8*)(kp+6656);
}
__device__ __forceinline__ void kload2(bf16x8*kf,lds_cptr kp,int j){ kf[2*j]=*(const __attribute__((address_space(3))) bf16x8*)(kp+j*2048); kf[2*j+1]=*(const __attribute__((address_space(3))) bf16x8*)(kp+j*2048+512); }
__device__ __forceinline__ s16x4 vtr(lds_cptr p){ return __builtin_bit_cast(s16x4,__builtin_amdgcn_ds_read_tr16_b64_v4i16((__attribute__((address_space(3))) v4i16_t*)p)); }
__device__ __forceinline__ float rowmax(const f32x16&p0,const f32x16&p1){
  float a=max3f(p0[0],p0[1],p1[0]),b=max3f(p0[2],p0[3],p1[1]);a=max3f(a,p1[2],p1[3]);
  #pragma unroll
  for(int r=4;r<16;r+=4){a=max3f(a,p0[r],p0[r+1]);b=max3f(b,p0[r+2],p0[r+3]);a=max3f(a,p1[r],p1[r+1]);b=max3f(b,p1[r+2],p1[r+3]);}
  const float m=max2f(a,b);
  auto rr=__builtin_amdgcn_permlane32_swap(__float_as_uint(m),__float_as_uint(m),false,false);
  return max2f(__uint_as_float(rr[0]),__uint_as_float(rr[1]));
}
__device__ __forceinline__ void pv(f32x16*o,int vb,bf16x8 pa0,bf16x8 pa1,bf16x8 pa2,bf16x8 pa3){
  #pragma unroll
  for(int d0=0;d0<2;++d0){s16x4 lo[4],hi[4];
    #pragma unroll
    for(int ks=0;ks<4;++ks){
      asm volatile("ds_read_b64_tr_b16 %0,%1 offset:%c2":"=&v"(lo[ks]):"v"(vb),"i"(d0*4096+ks*1024):"memory");
      asm volatile("ds_read_b64_tr_b16 %0,%1 offset:%c2":"=&v"(hi[ks]):"v"(vb),"i"(d0*4096+ks*1024+512):"memory");}
    asm volatile("s_waitcnt lgkmcnt(0)":::"memory");SBAR();
    #define PK(k) (bf16x8){lo[k][0],lo[k][1],lo[k][2],lo[k][3],hi[k][0],hi[k][1],hi[k][2],hi[k][3]}
    o[d0]=__builtin_amdgcn_mfma_f32_32x32x16_bf16(pa0,PK(0),o[d0],0,0,0);
    o[d0]=__builtin_amdgcn_mfma_f32_32x32x16_bf16(pa1,PK(1),o[d0],0,0,0);
    o[d0]=__builtin_amdgcn_mfma_f32_32x32x16_bf16(pa2,PK(2),o[d0],0,0,0);
    o[d0]=__builtin_amdgcn_mfma_f32_32x32x16_bf16(pa3,PK(3),o[d0],0,0,0);
    #undef PK
  }
}

#ifndef ATTN_STORE16
#define ATTN_STORE16(p,v) (*(u32x4*)(p)=(v))
#endif
template<int THRL> __device__ __forceinline__ void attn_unit(int b,int qcol,int vcol,int ocol,int qb,const bf16*Q,const bf16*__restrict__ K,const bf16*__restrict__ V,bf16*O,char*shm){
  const int tid=threadIdx.x,lane=tid&63,r32=lane&31,hi=lane>>5; const int wid=__builtin_amdgcn_readfirstlane(tid>>6);
  const long rowbase=(long)b*SEQ; const int q0=qb*QB;
  const bf16*Qw=Q+(rowbase+q0+wid*QBLK)*DM+qcol;
  const bf16*Kh=K+rowbase*DM+qcol,*Vh=V+rowbase*DM+vcol;
  const unsigned lds0=(unsigned)(uintptr_t)shm;
  float*wsf=(float*)(shm+LDS_WS)+wid*64;
  const bf16*ksrc=Kh+(long)lane*DM+wid*8;
  const bf16*vsrc=Vh+(long)(16*(wid&3)+(lane>>2))*DM+(wid>>2)*32+(lane&3)*8;
  const unsigned kdst=lds0+LDS_K+wid*1024, vdst=lds0+LDS_V+wid*1024;
  #define DMA_K(t,slot) glds16(ksrc+(long)(t)*KVBLK*DM,(unsigned)__builtin_amdgcn_readfirstlane(kdst+(slot)))
  #define DMA_V(t,slot) glds16(vsrc+(long)(t)*KVBLK*DM,(unsigned)__builtin_amdgcn_readfirstlane(vdst+(slot)))
  const int vb0=(int)(lds0+LDS_V)+((lane>>4)&1)*32+(lane&3)*8+(4*hi+((lane&15)>>2))*64;
  const char*Kbase=shm+LDS_K; bf16x8 kf[8];
  const lds_cptr shm3=(lds_cptr)shm; const lds_cptr kp0=shm3+LDS_K+hi*1024+r32*16; const lds_cptr vp0=shm3+LDS_V+((lane>>4)&1)*32+(lane&3)*8+(4*hi+((lane&15)>>2))*64;
  const int NT=(q0+QB)/KVBLK;
  DMA_K(0,0);DMA_V(0,0);DMA_K(1,SLOTB);
  bf16x8 qr[4];
  #pragma unroll
  for(int d0=0;d0<4;++d0)qr[d0]=*reinterpret_cast<const bf16x8*>(&Qw[(long)r32*DM+d0*16+hi*8]);
  float mhat=0.f,l_reg=0.f;f32x16 o[2];o[0]=f32x16{};o[1]=f32x16{};f32x16 negm=f32x16{};asm volatile("":"+v"(negm));
  const int qrel=wid*QBLK+r32;
  #define CMASK(P0,P1,t) do{int jb_=(t)-(NT-4); if(jb_>=0)cmask(P0,P1,jb_,qrel,hi);}while(0)
  bool resc=false;
  #define START(P0,P1) do{ const float rm=rowmax(P0,P1); resc=false; \
    { const float dl=rm; mhat=fadd_s(mhat,dl); \
      _Pragma("unroll") for(int r=0;r<16;++r){P0[r]=fsub_s(P0[r],dl);P1[r]=fsub_s(P1[r],dl);} \
      _Pragma("unroll") for(int r=0;r<16;++r)negm[r]=-mhat; asm volatile("":"+v"(negm)); } \
    _Pragma("unroll") for(int r=0;r<16;++r)P0[r]=__builtin_amdgcn_exp2f(P0[r]); }while(0)
  #define RESC() do{ if(resc){ asm volatile("s_waitcnt lgkmcnt(0)":::"memory"); \
      _Pragma("unroll") for(int d_=0;d_<2;++d_) _Pragma("unroll") for(int r=0;r<16;++r)o[d_][r]*=wsf[crow(r,hi)]; } }while(0)
  f32x16 pA0,pA1,pB0,pB1;
  int sl_prev=0,sl_cur=0,sl_next=SLOTB;
  #define ROT() do{sl_prev=sl_cur;sl_cur=sl_next;sl_next=(sl_next==(NSLOT-1)*SLOTB)?0:sl_next+SLOTB;}while(0)
  DMA_K(2,2*SLOTB);
  WAIT_BAR(3);
  qkt(pA0,pA1,Kbase,qr,negm,r32,hi);asm volatile("s_nop 15\n\ts_nop 7":"+v"(pA0),"+v"(pA1));CMASK(pA0,pA1,0);
  START(pA0,pA1);
  _Pragma("unroll") for(int r=0;r<16;++r)pA1[r]=__builtin_amdgcn_exp2f(pA1[r]);
  WAIT_BAR(0);
  DMA_K(3,0);DMA_V(1,SLOTB);
  ROT();
  kload8(kf,kp0+sl_cur);
  WAIT_BAR(2);
  s16x4 vlo[8],vhi[8]; u32x4 pw0,pw1,pw2,pw3;
  #define PKW(P,B) cvtpk_s(P[B],P[B+1])
  #define PAF(k) __builtin_bit_cast(bf16x8,pw##k)
  #define VFR(i) (bf16x8){vlo[i][0],vlo[i][1],vlo[i][2],vlo[i][3],vhi[i][0],vhi[i][1],vhi[i][2],vhi[i][3]}
  #define PIN(x) asm volatile("":"+v"(x))
  #define MX3(a,b,c) __builtin_fmaxf(__builtin_fmaxf((a),(b)),(c))
  #define GAPA(MF,A0,A1,A2,A3,W0,W1,PW) do{ MF; sacc+=A0; sacc+=A1; sacc+=A2; sacc+=A3; PIN(sacc); W0; W1; PIN(PW); SBAR(); }while(0)
  #define EX(v) __builtin_amdgcn_exp2f(v)
  #define GAPB(MF,X,B) do{ MF; X[B]=EX(X[B]); X[B+1]=EX(X[B+1]); X[B+2]=EX(X[B+2]); X[B+3]=EX(X[B+3]); PIN(X); SBAR(); }while(0)
  #define VRD(i) do{ vlo[i]=vtr(vp_+(((i)>>2)*4096+((i)&3)*1024)); vhi[i]=vtr(vp_+(((i)>>2)*4096+((i)&3)*1024+512)); }while(0)
  #define KRD(G,j) do{ if(G){ kload2(kf,kp0+sl_next,j); SBAR(); } }while(0)
  #define STEP(C0,C1,P0,P1,t,GK,GV,GL) do{ SBAR(); \
    const lds_cptr vp_=vp0+sl_prev; \
    VRD(0); SBAR(); float sacc=(P0[0]+P0[1]); \
    GAPA(C0=__builtin_amdgcn_mfma_f32_32x32x16_bf16(kf[0],qr[0],negm,0,0,0), P0[2],P0[3],P0[4],P0[5],     pw0[0]=PKW(P0,0), pw0[1]=PKW(P0,2), pw0); \
    VRD(4); SBAR(); GAPA(C1=__builtin_amdgcn_mfma_f32_32x32x16_bf16(kf[1],qr[0],negm,0,0,0), P0[6],P0[7],P0[8],P0[9],     pw0[2]=PKW(P0,4), pw0[3]=PKW(P0,6), pw0); \
    VRD(1); SBAR(); GAPA(C0=__builtin_amdgcn_mfma_f32_32x32x16_bf16(kf[2],qr[1],C0,0,0,0),   P0[10],P0[11],P0[12],P0[13], pw1[0]=PKW(P0,8), pw1[1]=PKW(P0,10), pw1); \
    VRD(5); SBAR(); GAPA(C1=__builtin_amdgcn_mfma_f32_32x32x16_bf16(kf[3],qr[1],C1,0,0,0),   P0[14],P0[15],P1[0],P1[1],   pw1[2]=PKW(P0,12),pw1[3]=PKW(P0,14), pw1); \
    VRD(2); SBAR(); GAPA(C0=__builtin_amdgcn_mfma_f32_32x32x16_bf16(kf[4],qr[2],C0,0,0,0),   P1[2],P1[3],P1[4],P1[5],     pw2[0]=PKW(P1,0), pw2[1]=PKW(P1,2), pw2); \
    VRD(6); SBAR(); GAPA(C1=__builtin_amdgcn_mfma_f32_32x32x16_bf16(kf[5],qr[2],C1,0,0,0),   P1[6],P1[7],P1[8],P1[9],     pw2[2]=PKW(P1,4), pw2[3]=PKW(P1,6), pw2); \
    VRD(3); SBAR(); GAPA(C0=__builtin_amdgcn_mfma_f32_32x32x16_bf16(kf[6],qr[3],C0,0,0,0),   P1[10],P1[11],P1[12],P1[13], pw3[0]=PKW(P1,8), pw3[1]=PKW(P1,10), pw3); \
    VRD(7); SBAR(); GAPA(C1=__builtin_amdgcn_mfma_f32_32x32x16_bf16(kf[7],qr[3],C1,0,0,0),   P1[14],P1[15],0.f,0.f,       pw3[2]=PKW(P1,12),pw3[3]=PKW(P1,14), pw3); \
    l_reg+=sacc; \
    if(GK){DMA_K((t)+3,sl_cur);} if(GV){DMA_V((t)+1,sl_next);} \
    CMASK(C0,C1,t); \
    { float a=MX3(C0[0],C0[1],C1[0]),b=MX3(C0[2],C0[3],C1[1]); a=MX3(a,C1[2],C1[3]); \
      _Pragma("unroll") for(int r=4;r<16;r+=4){a=MX3(a,C0[r],C0[r+1]);b=MX3(b,C0[r+2],C0[r+3]);a=MX3(a,C1[r],C1[r+1]);b=MX3(b,C1[r+2],C1[r+3]);} \
      float rm=__builtin_fmaxf(a,b); { auto rr=__builtin_amdgcn_permlane32_swap(__float_as_uint(rm),__float_as_uint(rm),false,false); rm=__builtin_fmaxf(__uint_as_float(rr[0]),__uint_as_float(rr[1])); } \
      resc=false; \
      if(__builtin_expect(__any(rm>(float)THRL),0)){ const float dl=__builtin_fmaxf(rm,0.f); mhat+=dl; \
        _Pragma("unroll") for(int r=0;r<16;++r){C0[r]-=dl;C1[r]-=dl;} \
        _Pragma("unroll") for(int r=0;r<16;++r)negm[r]=-mhat; asm volatile("":"+v"(negm)); \
        const float f=__builtin_amdgcn_exp2f(-dl); l_reg*=f; if(hi==0)wsf[r32]=f; resc=true; } } \
    SBAR(); \
    GAPB(o[0]=__builtin_amdgcn_mfma_f32_32x32x16_bf16(PAF(0),VFR(0),o[0],0,0,0), C0,0); \
    GAPB(o[1]=__builtin_amdgcn_mfma_f32_32x32x16_bf16(PAF(0),VFR(4),o[1],0,0,0), C0,4); \
    KRD(GL,0); GAPB(o[0]=__builtin_amdgcn_mfma_f32_32x32x16_bf16(PAF(1),VFR(1),o[0],0,0,0), C0,8); \
    KRD(GL,1); GAPB(o[1]=__builtin_amdgcn_mfma_f32_32x32x16_bf16(PAF(1),VFR(5),o[1],0,0,0), C0,12); \
    KRD(GL,2); GAPB(o[0]=__builtin_amdgcn_mfma_f32_32x32x16_bf16(PAF(2),VFR(2),o[0],0,0,0), C1,0); \
    KRD(GL,3); GAPB(o[1]=__builtin_amdgcn_mfma_f32_32x32x16_bf16(PAF(2),VFR(6),o[1],0,0,0), C1,4); \
    GAPB(o[0]=__builtin_amdgcn_mfma_f32_32x32x16_bf16(PAF(3),VFR(3),o[0],0,0,0), C1,8); \
    GAPB(o[1]=__builtin_amdgcn_mfma_f32_32x32x16_bf16(PAF(3),VFR(7),o[1],0,0,0), C1,12); \
    }while(0)
  int t=1;
  #undef CMASK
  #define CMASK(P0,P1,t) do{}while(0)
  for(;t+5<NT;t+=2){
    STEP(pB0,pB1,pA0,pA1,t,true,true,true);     WAIT_BAR(2); RESC(); ROT();
    STEP(pA0,pA1,pB0,pB1,t+1,true,true,true);   WAIT_BAR(2); RESC(); ROT();
  }
  #undef CMASK
  #define CMASK(P0,P1,t) do{int jb_=(t)-(NT-4); if(jb_>=0)cmask(P0,P1,jb_,qrel,hi);}while(0)
  #define ENDW(tt) do{ if((tt)+3<NT){WAIT_BAR(2);} else if((tt)+2<NT){WAIT_BAR(1);} else {WAIT_BAR(0);} }while(0)
  for(;t+1<NT;t+=2){
    STEP(pB0,pB1,pA0,pA1,t,(t+3<NT),(t+1<NT),(t+1<NT));       ENDW(t);   RESC(); ROT();
    STEP(pA0,pA1,pB0,pB1,t+1,(t+4<NT),(t+2<NT),(t+2<NT));     ENDW(t+1); RESC(); ROT();
  }
  STEP(pB0,pB1,pA0,pA1,NT-1,false,false,false); RESC();
  { float sacc=pB0[0]+pB0[1]; _Pragma("unroll") for(int r=2;r<16;++r)sacc+=pB0[r]; _Pragma("unroll") for(int r=0;r<16;++r)sacc+=pB1[r]; l_reg+=sacc;
    pw0=(u32x4){PKW(pB0,0),PKW(pB0,2),PKW(pB0,4),PKW(pB0,6)};pw1=(u32x4){PKW(pB0,8),PKW(pB0,10),PKW(pB0,12),PKW(pB0,14)};pw2=(u32x4){PKW(pB1,0),PKW(pB1,2),PKW(pB1,4),PKW(pB1,6)};pw3=(u32x4){PKW(pB1,8),PKW(pB1,10),PKW(pB1,12),PKW(pB1,14)};
    SBAR(); pv(o,vb0+sl_cur,PAF(0),PAF(1),PAF(2),PAF(3)); }
  #undef PKW
  #undef PAF
  #undef VFR
  #undef PIN
  #undef MX3
  #undef GAPA
  #undef GAPB
  #undef EX
  #undef VRD
  #undef KRD
  #undef STEP
  #undef ENDW
  {auto rr=__builtin_amdgcn_permlane32_swap(__float_as_uint(l_reg),__float_as_uint(l_reg),false,false);l_reg=__uint_as_float(rr[0])+__uint_as_float(rr[1]);}
  if(hi==0)wsf[32+r32]=l_reg;asm volatile("s_waitcnt lgkmcnt(0)":::"memory");
  float rli[16];
  #pragma unroll
  for(int r=0;r<16;++r)rli[r]=__builtin_amdgcn_rcpf(wsf[32+crow(r,hi)]);
  bf16*Ow=O+(rowbase+q0+wid*QBLK)*OPITCH+ocol;
  { bf16*stg=(bf16*)(shm+LDS_OST)+wid*2048;
    #pragma unroll
    for(int r=0;r<16;++r){const int orow=crow(r,hi);
      #pragma unroll
      for(int d0=0;d0<2;++d0)stg[orow*64+d0*32+r32]=__float2bfloat16(o[d0][r]*rli[r]);}
    asm volatile("s_waitcnt lgkmcnt(0)":::"memory");
    #pragma unroll
    for(int i=0;i<4;++i){const int row=i*8+(lane>>3),ch=lane&7; const u32x4 v=*(const u32x4*)(stg+row*64+ch*8); ATTN_STORE16(Ow+(long)row*OPITCH+ch*8,v);} }
  asm volatile("s_waitcnt lgkmcnt(0)\n\ts_barrier":::"memory");
  #undef DMA_K
  #undef DMA_V
  #undef CMASK
  #undef START
  #undef RESC
  #undef ROT
}
constexpr int ATTN_LDS_BYTES=LDS_BYTES;
#undef SBAR
#undef WAIT_BAR
}
constexpr size_t MiB = 1u << 20;
constexpr size_t WS_CTL = 0, CTL_ZERO_BYTES = 1 * MiB;
constexpr size_t WS_WIN = 2 * MiB, WS_WOUT = 26 * MiB, WS_WQ = 34 * MiB, WS_WKV = 42 * MiB, WS_WO = 58 * MiB, WS_W1 = 66 * MiB, WS_W2 = 578 * MiB;
constexpr size_t WS_HN = 834 * MiB, WS_MN = 866 * MiB, WS_PROJ = 870 * MiB, WS_DT = 958 * MiB, WS_KVRAW = 959 * MiB, WS_KN = 967 * MiB;
constexpr size_t WS_YCAT = 971 * MiB, WS_O0 = 1003 * MiB, WS_O1 = 1019 * MiB, WS_H1 = 1035 * MiB, WS_H1B = 1099 * MiB, WS_PART1 = 1131 * MiB, WS_PARTQ = 1132 * MiB;
constexpr size_t WS_QRAW = 1133 * MiB, WS_P = 1165 * MiB, WS_VWT = 1181 * MiB, WS_H2 = 1197 * MiB, WS_HN3 = 1261 * MiB;
constexpr size_t WS_TOKOF = 1293 * MiB, WS_GATEOF = 1294 * MiB, WS_TOKE = 1295 * MiB, WS_TOKR = 1296 * MiB, WS_YG = 1297 * MiB;
constexpr size_t WS_H1F8 = 3368 * MiB  , WS_QF8 = 3384 * MiB  , WS_KN8 = 3400 * MiB  , WS_VF8 = 3402 * MiB  ;
constexpr size_t WS_P8 = 3404 * MiB  , WS_VWT8 = 3412 * MiB  ;
constexpr size_t WS_XG = 1320 * MiB  , WS_ACT = 1832 * MiB  , WS_Y = 2344 * MiB  , WS_END = 3420 * MiB;
constexpr int CW_BAR = 4096;
constexpr int CW_QCONV2 = 12416;
constexpr int CW_QCONV = 12352;
constexpr int CW_QATT = 12288;
constexpr int CW_CNT = 8192;
static_assert((CW_CNT + 64 * 32) * 4 <= (int)CTL_ZERO_BYTES, "CTL words inside the memset region");

constexpr int RING_OFF = 0, RING_BYTES = 131072;
constexpr int LDS_BYTES = 163840;
constexpr int MISC_OFF = 163840 - 1024;
constexpr int NWAVES = 8;

#define XB_TMO      128
#define XB_XCNT(j)  (256  + 64 * (j))
#define XB_XSUB(j)  (1280 + 64 * (j))
#define XB_XGEN(j)  (2304 + 64 * (j))
#define XB_TOP      3328
#define XB_TOPGEN   3392
#define XCD_BAR_WORDS 3456
#define XB_SPIN_CAP (1u << 20)

__device__ __forceinline__ unsigned xb_ld(unsigned* p)              { return __hip_atomic_load(p, __ATOMIC_RELAXED, __HIP_MEMORY_SCOPE_AGENT); }
__device__ __forceinline__ unsigned xb_add(unsigned* p, unsigned v) { return __hip_atomic_fetch_add(p, v, __ATOMIC_RELAXED, __HIP_MEMORY_SCOPE_AGENT); }
__device__ __forceinline__ unsigned xb_xcc_id() { return (unsigned)__builtin_amdgcn_s_getreg((3 << 11) | 20) & 0xFu; }
#define XB_SPIN(cond, bar) do { unsigned _sp = 0; while (cond) { __builtin_amdgcn_s_sleep(1); \
    if ((++_sp & 255u) == 0u) { if (xb_ld(&(bar)[XB_TMO])) break; if (_sp > XB_SPIN_CAP) { atomicAdd(&(bar)[XB_TMO], 1u); break; } } } } while (0)

struct XcdBarrier {
    unsigned* bar; unsigned x;
    volatile LAS unsigned* st;
};
__device__ __forceinline__ XcdBarrier xcd_barrier_post(unsigned* bar, volatile LAS unsigned* st) {
    XcdBarrier b; b.bar = bar; b.x = xb_xcc_id(); b.st = st;
    if (threadIdx.x == 0) (void)xb_add(&bar[XB_XCNT(b.x)], 1u);
    return b;
}
__device__ __forceinline__ void xcd_barrier_complete(unsigned* bar, unsigned x, unsigned& nloc, unsigned& nx) {
    const unsigned G = gridDim.x * gridDim.y * gridDim.z;
    unsigned sum, cnt, mine, sp = 0u;
    for (;;) {
        sum = 0u; cnt = 0u; mine = 0u;
#pragma unroll
        for (unsigned j = 0; j < 16; ++j) { const unsigned c = xb_ld(&bar[XB_XCNT(j)]); sum += c; cnt += (c > 0u) ? 1u : 0u; mine = (j == x) ? c : mine; }
        if (sum == G) break;
        __builtin_amdgcn_s_sleep(1);
        if ((++sp & 255u) == 0u) { if (xb_ld(&bar[XB_TMO])) break; if (sp > XB_SPIN_CAP) { atomicAdd(&bar[XB_TMO], 1u); break; } }
    }
    nloc = mine > 0u ? mine : 1u; nx = cnt > 0u ? cnt : 1u;
}
__device__ __forceinline__ void xcd_barrier(const XcdBarrier& b) {
    asm volatile("s_waitcnt vmcnt(0)" ::: "memory");
    __syncthreads();
    if (threadIdx.x == 0) {
        unsigned* bar = b.bar;
        __builtin_amdgcn_s_waitcnt(0);
        unsigned nloc = b.st[0], nx = b.st[1];
        if (nloc == 0u) { xcd_barrier_complete(bar, b.x, nloc, nx); b.st[0] = nloc; b.st[1] = nx; }
        const unsigned old = xb_add(&bar[XB_XSUB(b.x)], 1u);
        const unsigned gen = old / nloc;
        if (old + 1u == (gen + 1u) * nloc) {
            __builtin_amdgcn_fence(__ATOMIC_RELEASE, "agent");
            asm volatile("s_waitcnt vmcnt(0)" ::: "memory");
            const unsigned og = xb_add(&bar[XB_TOP], 1u);
            const unsigned tg = og / nx;
            if (og + 1u == (tg + 1u) * nx) xb_add(&bar[XB_TOPGEN], 1u);
            else XB_SPIN(xb_ld(&bar[XB_TOPGEN]) == tg, bar);
            __builtin_amdgcn_fence(__ATOMIC_ACQUIRE, "agent");
            xb_add(&bar[XB_XGEN(b.x)], 1u);
            asm volatile("s_waitcnt vmcnt(0)" ::: "memory");
        } else {
            XB_SPIN(xb_ld(&bar[XB_XGEN(b.x)]) == gen, bar);
            __builtin_amdgcn_fence(__ATOMIC_ACQUIRE, "agent");
            asm volatile("s_waitcnt vmcnt(0)" ::: "memory");
        }
    }
    __syncthreads();
}

struct Args { const float* in[32]; float* out; unsigned char* ws; int ph_lo, ph_hi; };
enum In { I_X = 0, I_MEM, I_GMIX, I_WIN, I_CONVW, I_CONVB, I_DTB, I_ALOG, I_DSKIP, I_SSDG, I_DAQG, I_DAKG, I_LQ1, I_LK1, I_LQ2, I_LK2, I_SUBG, I_WOUT, I_GXA, I_GMEM,
          I_WQ, I_WKV, I_XQG, I_XKG, I_WO, I_GFFN, I_RW, I_RB, I_W1, I_B1, I_W2, I_B2 };

struct ArgP {
    typedef const __attribute__((address_space(4))) char* kptr;
    DI const float* in(int i) const { kptr kp = (kptr)__builtin_amdgcn_kernarg_segment_ptr(); asm volatile("" : "+s"(kp)); return *(const float* const __attribute__((address_space(4)))*)(kp + 8 * i); }
    DI float* out() const { kptr kp = (kptr)__builtin_amdgcn_kernarg_segment_ptr(); asm volatile("" : "+s"(kp)); return *(float* const __attribute__((address_space(4)))*)(kp + 8 * 32); }
};
struct Frame {
    LAS unsigned char* lds;
    volatile LAS unsigned* MISC;
    unsigned* ctl;
    unsigned char* ws;
    int tid, lane, wave, vcu, G;
};

template <class DestRow>
DI void tr_item(const float* W, size_t ldw, int k0, int ncol0, int nvalid, const float* kscale, bf16_t* WT, int K, DestRow dr, LAS float* scr, int lane) {
    const int c = lane & 31;
#pragma unroll 8
    for (int i = 0; i < 32; ++i) { const int kk = 2 * i + (lane >> 5);
        float v = (c < nvalid) ? W[(size_t)(k0 + kk) * ldw + ncol0 + c] : 0.f;
        if (kscale) v *= kscale[k0 + kk];
        scr[kk * 33 + c] = v; }
    asm volatile("s_waitcnt lgkmcnt(0)" ::: "memory");
    const int c8 = lane & 7;
#pragma unroll
    for (int j = 0; j < 4; ++j) { const int n = (lane >> 3) + 8 * j; const LAS float* s = scr + (8 * c8) * 33 + n;
        u32x4 o; o.x = pk2(s[0 * 33], s[1 * 33]); o.y = pk2(s[2 * 33], s[3 * 33]); o.z = pk2(s[4 * 33], s[5 * 33]); o.w = pk2(s[6 * 33], s[7 * 33]);
        if (n < nvalid) *(u32x4*)(WT + (size_t)dr(ncol0 + n) * K + k0 + 8 * c8) = o; }
    asm volatile("s_waitcnt lgkmcnt(0)" ::: "memory");
}
template <class DestRow>
DI void tr_item_fp8(const float* W, size_t ldw, int k0, int ncol0, const float* kscale, unsigned char* WT, int K, DestRow dr, LAS float* scr, int lane) {
    const int c = lane & 31;
#pragma unroll 8
    for (int i = 0; i < 32; ++i) { const int kk = 2 * i + (lane >> 5); float v = W[(size_t)(k0 + kk) * ldw + ncol0 + c]; if (kscale) v *= kscale[k0 + kk]; scr[kk * 33 + c] = v; }
    asm volatile("s_waitcnt lgkmcnt(0)" ::: "memory");
    const int n = lane >> 1, hf = lane & 1; const LAS float* s = scr + (32 * hf) * 33 + n;
    unsigned w[8];
#pragma unroll
    for (int j = 0; j < 8; ++j) { unsigned x = 0u;
        x = __builtin_amdgcn_cvt_pk_fp8_f32(s[(4 * j) * 33] * 64.f, s[(4 * j + 1) * 33] * 64.f, x, false);
        x = __builtin_amdgcn_cvt_pk_fp8_f32(s[(4 * j + 2) * 33] * 64.f, s[(4 * j + 3) * 33] * 64.f, x, true); w[j] = x; }
    unsigned char* op = WT + (size_t)dr(ncol0 + n) * K + k0 + 32 * hf;
    *(u32x4*)op = (u32x4){w[0], w[1], w[2], w[3]}; *(u32x4*)(op + 16) = (u32x4){w[4], w[5], w[6], w[7]};
    asm volatile("s_waitcnt lgkmcnt(0)" ::: "memory");
}
DI int tileperm(int col) { const int o = col & 255; return (col & ~255) + 128 * ((o & 63) >> 5) + 32 * (o >> 6) + (o & 31); }
struct DrIdent { DI int operator()(int n) const { return n; } };
struct DrTile  { DI int operator()(int n) const { return tileperm(n); } };
struct DrWin   { DI int operator()(int n) const { const int pc = (n < 2560) ? n : (n < 2576 ? PC_DT + (n - 2560) : n - 16); return tileperm(pc); } };
struct DrW1    { DI int operator()(int n) const { const int half = n >> 11, j = n & 2047; return (j >> 7) * 256 + half * 128 + (j & 127); } };

template <bool FP8, class DestRow>
DI void cv_item(const float* W, size_t ldw, int k0, int ncol0, const float* kscale, float scale, void* WT, int kpitch, DestRow dr, LAS float* scr, int lane) {
    const int r = lane >> 3, c4 = (lane & 7) * 4;
    f32x4 v[16];
#pragma unroll
    for (int i = 0; i < 16; ++i) v[i] = *(const f32x4*)(W + (size_t)(k0 + 8 * i + r) * ldw + ncol0 + c4);
#pragma unroll
    for (int i = 0; i < 16; ++i) { f32x4 x = v[i] * scale; if (kscale) x = x * kscale[k0 + 8 * i + r]; *(LAS f32x4*)(scr + (8 * i + r) * 36 + c4) = x; }
    asm volatile("s_waitcnt lgkmcnt(0)" ::: "memory");
    const int n = lane & 31, hf = lane >> 5; const LAS float* s = scr + (64 * hf) * 36 + n;
    if constexpr (FP8) {
        unsigned w[16];
#pragma unroll
        for (int j = 0; j < 16; ++j) { unsigned x = 0u; x = __builtin_amdgcn_cvt_pk_fp8_f32(s[(4 * j) * 36], s[(4 * j + 1) * 36], x, false); x = __builtin_amdgcn_cvt_pk_fp8_f32(s[(4 * j + 2) * 36], s[(4 * j + 3) * 36], x, true); w[j] = x; }
        unsigned char* op = (unsigned char*)WT + (size_t)dr(ncol0 + n) * kpitch + k0 + 64 * hf;
#pragma unroll
        for (int j = 0; j < 4; ++j) *(u32x4*)(op + 16 * j) = (u32x4){w[4 * j], w[4 * j + 1], w[4 * j + 2], w[4 * j + 3]};
    } else {
        unsigned w[32];
#pragma unroll
        for (int j = 0; j < 32; ++j) w[j] = pk2(s[(2 * j) * 36], s[(2 * j + 1) * 36]);
        unsigned char* op = (unsigned char*)WT + (size_t)dr(ncol0 + n) * kpitch + (k0 + 64 * hf) * 2;
#pragma unroll
        for (int j = 0; j < 8; ++j) *(u32x4*)(op + 16 * j) = (u32x4){w[4 * j], w[4 * j + 1], w[4 * j + 2], w[4 * j + 3]};
    }
    asm volatile("s_waitcnt lgkmcnt(0)" ::: "memory");
}
DI void rms_row_to_bf16(const float* xrow, const float* g, bf16_t* orow, int lane) {
    const f32x4* xr = (const f32x4*)xrow + lane;
    f32x4 v[8]; float s = 0.f;
#pragma unroll
    for (int j = 0; j < 8; ++j) { v[j] = xr[64 * j]; s += (v[j].x * v[j].x + v[j].y * v[j].y) + (v[j].z * v[j].z + v[j].w * v[j].w); }
    const float rstd = 1.f / sqrtf(wave_sum(s) * (1.f / 2048.f) + EPS_);
    u32x2* o8 = (u32x2*)orow + lane;
#pragma unroll
    for (int j = 0; j < 8; ++j) { const f32x4 gg = ((const f32x4*)g)[lane + 64 * j];
        u32x2 o; o.x = pk2(v[j].x * rstd * gg.x, v[j].y * rstd * gg.y); o.y = pk2(v[j].z * rstd * gg.z, v[j].w * rstd * gg.w); o8[64 * j] = o; }
}

DI void p0_prologue(Frame& F, const ArgP& a) {
    LAS float* scr = (LAS float*)(F.lds + RING_OFF + F.wave * 16384);
    const int gw = F.vcu * NWAVES + F.wave, NGW = F.G * NWAVES;
    unsigned char* ws = F.ws;
    constexpr int I_A = 32 * 80, I_B = 32, I_C = 32 * 96, NITEMS = I_A + I_B + I_C;
    for (int it = gw; it < NITEMS; it += NGW) {
        int r = it;
        if (r < I_A) { tr_item(a.in(I_WIN), 5648, 64 * (r / 80), 32 * (r % 80), 32, nullptr, (bf16_t*)(ws + WS_WIN), 2048, DrWin(), scr, F.lane); continue; } r -= I_A;
        if (r < I_B) { tr_item(a.in(I_WIN), 5648, 64 * r, 2560, 16, nullptr, (bf16_t*)(ws + WS_WIN), 2048, DrWin(), scr, F.lane); continue; } r -= I_B;
        tr_item(a.in(I_WIN), 5648, 64 * (r / 96), 2576 + 32 * (r % 96), 32, nullptr, (bf16_t*)(ws + WS_WIN), 2048, DrWin(), scr, F.lane);
    }
    for (int m = gw; m < NTOK; m += NGW) rms_row_to_bf16(a.in(I_X) + (size_t)m * 2048, a.in(I_GMIX), (bf16_t*)(ws + WS_HN) + (size_t)m * 2048, F.lane);
    for (int m = gw; m < NB * MEMLEN; m += NGW) rms_row_to_bf16(a.in(I_MEM) + (size_t)m * 2048, a.in(I_GMEM), (bf16_t*)(ws + WS_MN) + (size_t)m * 2048, F.lane);
}
struct CvIt { const float* W; size_t ldw; const float* ks; unsigned char* WT; float scale; int k0, n0, kpitch, fp8, dr; };
DI CvIt cv_decode(int it, const ArgP& a, unsigned char* ws) {
    constexpr int J_WOUT = 16 * 64, J_WKV = 16 * 128, J_WQ = 16 * 64, J_WO = 16 * 64, J_W1 = 32 * 16 * 128;
    CvIt c; c.ks = nullptr; c.scale = 64.f; c.fp8 = 1; c.dr = 0; c.kpitch = 2048; c.ldw = 2048;
    int r = it;
    if (r < J_WOUT) { c.W = a.in(I_WOUT); c.k0 = 128 * (r / 64); c.n0 = 32 * (r % 64); c.WT = ws + WS_WOUT; c.scale = 1.f; c.fp8 = 0; c.kpitch = 4096; return c; } r -= J_WOUT;
    if (r < J_WKV) { c.W = a.in(I_WKV); c.ldw = 4096; c.k0 = 128 * (r / 128); c.n0 = 32 * (r % 128); c.WT = ws + WS_WKV; c.scale = 1.f; c.fp8 = 0; c.kpitch = 4096; c.dr = 1; return c; } r -= J_WKV;
    if (r < J_WQ) { c.W = a.in(I_WQ); c.ks = a.in(I_GXA); c.k0 = 128 * (r / 64); c.n0 = 32 * (r % 64); c.WT = ws + WS_WQ; return c; } r -= J_WQ;
    if (r < J_WO) { c.W = a.in(I_WO); c.k0 = 128 * (r / 64); c.n0 = 32 * (r % 64); c.WT = ws + WS_WO; return c; } r -= J_WO;
    if (r < J_W1) { const int e = r / (16 * 128), q = r % (16 * 128); c.W = a.in(I_W1) + (size_t)e * 2048 * 4096; c.ldw = 4096; c.k0 = 128 * (q / 128); c.n0 = 32 * (q % 128); c.WT = ws + WS_W1 + (size_t)e * 4096 * 2048; c.dr = 2; return c; } r -= J_W1;
    { const int e = r / (16 * 64), q = r % (16 * 64); c.W = a.in(I_W2) + (size_t)e * 2048 * 2048; c.k0 = 128 * (q / 64); c.n0 = 32 * (q % 64); c.WT = ws + WS_W2 + (size_t)e * 2048 * 2048; }
    return c;
}
constexpr int CV_NJ = 16 * 64 * 3 + 16 * 128 + 32 * 16 * 128 + 32 * 16 * 64;
constexpr int CV_TAIL2 = 16384;
constexpr int CV_TAIL1 = 16384;
constexpr int CV_TAIL = CV_TAIL1 + CV_TAIL2;
DI void conv_share(Frame& F, const ArgP& a) {
    LAS float* scr = (LAS float*)(F.lds + F.wave * 16384);
    const unsigned sbase = (unsigned)__builtin_amdgcn_readfirstlane((int)((unsigned)(uintptr_t)F.lds + (unsigned)F.wave * 16384u));
    const int gw = F.vcu * NWAVES + F.wave, NGW = F.G * NWAVES, lane = F.lane;
    unsigned char* ws = F.ws;
    constexpr int NJ = CV_NJ - CV_TAIL;
    const int n = lane & 31, hf = lane >> 5;
    for (int it = gw; it < NJ; it += NGW) {
        const CvIt cur = cv_decode(it, a, ws);
        const char* gb = (const char*)(cur.W + (size_t)cur.k0 * cur.ldw + cur.n0);
        const unsigned vo0 = (unsigned)(((size_t)(lane >> 3) * cur.ldw + (size_t)(lane & 7) * 4) * 4), vstep = (unsigned)(8 * cur.ldw * 4);
#pragma unroll
        for (int p = 0; p < 16; ++p) { unsigned keep_;
            asm volatile("s_mov_b32 %0, m0\n\ts_mov_b32 m0, %3\n\ts_nop 0\n\tglobal_load_lds_dwordx4 %1, %2 nt\n\ts_mov_b32 m0, %0"
                         : "=&s"(keep_) : "v"(vo0 + (unsigned)p * vstep), "s"(gb), "s"(sbase + (unsigned)p * 1024u) : "memory"); }
        asm volatile("s_waitcnt vmcnt(0)" ::: "memory");
        const LAS float* s = scr + (64 * hf) * 32 + n;
        const int col = cur.n0 + n; const int drow = (cur.dr == 0) ? col : (cur.dr == 1 ? tileperm(col) : DrW1()(col));
        const float* ksp = cur.ks ? cur.ks + cur.k0 + 64 * hf : nullptr;
        if (cur.fp8) {
            unsigned w[16];
#pragma unroll
            for (int j = 0; j < 16; ++j) { float x0 = s[(4 * j) * 32] * cur.scale, x1 = s[(4 * j + 1) * 32] * cur.scale, x2 = s[(4 * j + 2) * 32] * cur.scale, x3 = s[(4 * j + 3) * 32] * cur.scale;
                if (ksp) { x0 *= ksp[4 * j]; x1 *= ksp[4 * j + 1]; x2 *= ksp[4 * j + 2]; x3 *= ksp[4 * j + 3]; }
                unsigned x = 0u; x = __builtin_amdgcn_cvt_pk_fp8_f32(x0, x1, x, false); x = __builtin_amdgcn_cvt_pk_fp8_f32(x2, x3, x, true); w[j] = x; }
            unsigned char* op = cur.WT + (size_t)drow * cur.kpitch + cur.k0 + 64 * hf;
#pragma unroll
            for (int j = 0; j < 4; ++j) *(u32x4*)(op + 16 * j) = (u32x4){w[4 * j], w[4 * j + 1], w[4 * j + 2], w[4 * j + 3]};
        } else {
            unsigned w[32];
#pragma unroll
            for (int j = 0; j < 32; ++j) w[j] = pk2(s[(2 * j) * 32] * cur.scale, s[(2 * j + 1) * 32] * cur.scale);
            unsigned char* op = cur.WT + (size_t)drow * cur.kpitch + (cur.k0 + 64 * hf) * 2;
#pragma unroll
            for (int j = 0; j < 8; ++j) *(u32x4*)(op + 16 * j) = (u32x4){w[4 * j], w[4 * j + 1], w[4 * j + 2], w[4 * j + 3]};
        }
        asm volatile("s_waitcnt lgkmcnt(0)" ::: "memory");
    }
}

DI void conv_queue(Frame& F, const ArgP& a, int qword, int first, int count) {
    LAS float* scr = (LAS float*)(F.lds + F.wave * 18432);
    unsigned char* ws = F.ws;
    const int lane = threadIdx.x & 63, r = lane >> 3, c4 = (lane & 7) * 4, n = lane & 31, hf = lane >> 5;
    for (;;) {
        if (threadIdx.x == 0) F.MISC[121] = __hip_atomic_fetch_add(F.ctl + qword, 8u, __ATOMIC_RELAXED, __HIP_MEMORY_SCOPE_AGENT);
        __syncthreads();
        const int base = __builtin_amdgcn_readfirstlane((int)F.MISC[121]);
        __syncthreads();
        if (base >= count) break;
        const int it = first + base + F.wave;
        if (base + F.wave < count) {
            const CvIt cur = cv_decode(it, a, ws);
            f32x4 v[16];
#pragma unroll
            for (int i = 0; i < 16; ++i) v[i] = __builtin_nontemporal_load((const f32x4*)(cur.W + (size_t)(cur.k0 + 8 * i + r) * cur.ldw + cur.n0 + c4));
#pragma unroll
            for (int i = 0; i < 16; ++i) *(LAS f32x4*)(scr + (8 * i + r) * 36 + c4) = v[i] * cur.scale;
            asm volatile("s_waitcnt lgkmcnt(0)" ::: "memory");
            const LAS float* s = scr + (64 * hf) * 36 + n;
            unsigned w[16];
#pragma unroll
            for (int j = 0; j < 16; ++j) { unsigned x = 0u; x = __builtin_amdgcn_cvt_pk_fp8_f32(s[(4 * j) * 36], s[(4 * j + 1) * 36], x, false); x = __builtin_amdgcn_cvt_pk_fp8_f32(s[(4 * j + 2) * 36], s[(4 * j + 3) * 36], x, true); w[j] = x; }
            unsigned char* op = cur.WT + (size_t)(cur.n0 + n) * cur.kpitch + cur.k0 + 64 * hf;
#pragma unroll
            for (int j = 0; j < 4; ++j) *(u32x4*)(op + 16 * j) = (u32x4){w[4 * j], w[4 * j + 1], w[4 * j + 2], w[4 * j + 3]};
            asm volatile("s_waitcnt lgkmcnt(0)" ::: "memory");
        }
    }
}
static_assert(CV_TAIL <= 32 * 16 * 64 && CV_TAIL1 % 8 == 0 && CV_TAIL2 % 8 == 0, "the tails are a suffix of the moe_w2 items");

struct SchedP1 {
    int G, c; const unsigned char* ws; int lo, hi;
    DI bool next(int i, pg8::UnitD& u) const {
        const int L = lo + i * G + c; if (L >= hi) return false;
        u.rows = nullptr; u.nvalid = 0; u.lda = 4096u; u.ldb = 4096u; u.e = 0; u.x0 = 0;
        if (L < 32 * 23) { u.type = 0; u.pn = L / 32; u.pm = L % 32; u.A = (const char*)(ws + WS_HN) + (size_t)u.pm * 256 * 4096; u.B = (const char*)(ws + WS_WIN) + (size_t)u.pn * 256 * 4096; }
        else { const int q = L - 32 * 23; u.type = 1; u.pn = q / 4; u.pm = q % 4; u.A = (const char*)(ws + WS_MN) + (size_t)u.pm * 256 * 4096; u.B = (const char*)(ws + WS_WKV) + (size_t)u.pn * 256 * 4096; }
        return true;
    }
};
struct EpiP1 {
    static constexpr bool AFTER_DRAIN = false;
    bf16_t* proj; float* dtb; bf16_t* kvraw; const float* gq; const float* gk; unsigned char* vf8;
    DI void operator()(const f32x4 (&acc)[2][2][4][2], const pg8::UnitD& u, int wr, int wc, int fr, int fq) const {
        { int ln_ = threadIdx.x; asm volatile("" : "+v"(ln_)); fr = ln_ & 15; fq = (ln_ >> 4) & 3; }
        const int row0 = u.pm * 256 + wr * 64 + fr;
        const int cn = u.pn * 256 + 64 * wc + 8 * fq;
        if (u.type == 1 && u.pn >= 8) {
#pragma unroll
            for (int ai = 0; ai < 2; ++ai)
#pragma unroll
                for (int m = 0; m < 4; ++m) { unsigned char* rp = vf8 + (size_t)(row0 + ai * 128 + m * 16) * 2048 + (cn - 2048);
#pragma unroll
                    for (int bj = 0; bj < 2; ++bj) { const f32x4 v0 = acc[ai][bj][m][0] * 16.f, v1 = acc[ai][bj][m][1] * 16.f;
                        u32x2 w; w.x = __builtin_amdgcn_cvt_pk_fp8_f32(v0[0], v0[1], 0u, false); w.x = __builtin_amdgcn_cvt_pk_fp8_f32(v0[2], v0[3], w.x, true);
                        w.y = __builtin_amdgcn_cvt_pk_fp8_f32(v1[0], v1[1], 0u, false); w.y = __builtin_amdgcn_cvt_pk_fp8_f32(v1[2], v1[3], w.y, true);
                        *(u32x2*)(rp + 32 * bj) = w; } }
            return;
        }
        if (u.type == 1) {
#pragma unroll
            for (int ai = 0; ai < 2; ++ai)
#pragma unroll
                for (int m = 0; m < 4; ++m) { bf16_t* rp = kvraw + (size_t)(row0 + ai * 128 + m * 16) * 4096 + cn;
#pragma unroll
                    for (int bj = 0; bj < 2; ++bj) { const f32x4 v0 = acc[ai][bj][m][0], v1 = acc[ai][bj][m][1];
                        u32x4 w; w.x = pk2(v0[0], v0[1]); w.y = pk2(v0[2], v0[3]); w.z = pk2(v1[0], v1[1]); w.w = pk2(v1[2], v1[3]); *(u32x4*)(rp + 32 * bj) = w; } }
            return;
        }
        if (u.pn == 22) {
            if (wc == 0 && fq < 2) {
#pragma unroll
                for (int ai = 0; ai < 2; ++ai)
#pragma unroll
                    for (int m = 0; m < 4; ++m) { float* rp = dtb + (size_t)(row0 + ai * 128 + m * 16) * 16 + 8 * fq;
                        *(f32x4*)(rp) = acc[ai][0][m][0]; *(f32x4*)(rp + 4) = acc[ai][0][m][1]; }
            }
            return;
        }
        const bool isq = (u.pn >= 10 && u.pn < 14), isk = (u.pn >= 14 && u.pn < 18);
        if (!(isq || isk)) {
#pragma unroll
            for (int ai = 0; ai < 2; ++ai)
#pragma unroll
                for (int m = 0; m < 4; ++m) { bf16_t* rp = proj + (size_t)(row0 + ai * 128 + m * 16) * PP + cn;
#pragma unroll
                    for (int bj = 0; bj < 2; ++bj) { const f32x4 v0 = acc[ai][bj][m][0], v1 = acc[ai][bj][m][1];
                        u32x4 w; w.x = pk2(v0[0], v0[1]); w.y = pk2(v0[2], v0[3]); w.z = pk2(v1[0], v1[1]); w.w = pk2(v1[2], v1[3]); *(u32x4*)(rp + 32 * bj) = w; } }
            return;
        }
        const float* g = (isq ? gq : gk) + 8 * fq; const float sc = isq ? (0.125f * 1.4426950408889634f) : 1.f;
#pragma unroll
        for (int ai = 0; ai < 2; ++ai)
#pragma unroll
            for (int m = 0; m < 4; ++m) { bf16_t* rp = proj + (size_t)(row0 + ai * 128 + m * 16) * PP + cn;
                float ss = 0.f;
#pragma unroll
                for (int bj = 0; bj < 2; ++bj)
#pragma unroll
                    for (int n = 0; n < 2; ++n) { const f32x4 v = acc[ai][bj][m][n]; ss += (v[0] * v[0] + v[1] * v[1]) + (v[2] * v[2] + v[3] * v[3]); }
                ss += __shfl_xor(ss, 16); ss += __shfl_xor(ss, 32);
                const float rs = sc / sqrtf(ss * (1.f / 64.f) + EPS_);
#pragma unroll
                for (int bj = 0; bj < 2; ++bj) { const f32x4 v0 = acc[ai][bj][m][0] * rs * *(const f32x4*)(g + 32 * bj), v1 = acc[ai][bj][m][1] * rs * *(const f32x4*)(g + 32 * bj + 4);
                    u32x4 w; w.x = pk2(v0[0], v0[1]); w.y = pk2(v0[2], v0[3]); w.z = pk2(v1[0], v1[1]); w.w = pk2(v1[2], v1[3]); *(u32x4*)(rp + 32 * bj) = w; } }
    }
};

DI void kprep(Frame& F, const ArgP& a) {
    const int gw = F.vcu * NWAVES + F.wave, NGW = F.G * NWAVES;
    const bf16_t* kv = (const bf16_t*)(F.ws + WS_KVRAW); unsigned char* kn = (unsigned char*)(F.ws + WS_KN8);
    for (int it = gw; it < NB * MEMLEN * 4; it += NGW) {
        const int row = it >> 2, h = it & 3, b = row >> 8, key = row & 255;
        const u32x4 raw = *(const u32x4*)(kv + (size_t)row * 4096 + h * 512 + F.lane * 8);
        float v[8]; v[0] = bflo(raw.x); v[1] = bfhi(raw.x); v[2] = bflo(raw.y); v[3] = bfhi(raw.y); v[4] = bflo(raw.z); v[5] = bfhi(raw.z); v[6] = bflo(raw.w); v[7] = bfhi(raw.w);
        float ss = 0.f;
#pragma unroll
        for (int j = 0; j < 8; ++j) ss += v[j] * v[j];
        const float rs = 1.f / sqrtf(wave_sum(ss) * (1.f / 512.f) + EPS_) * 0.04419417382415922f * 128.f;
        const float* gk = a.in(I_XKG) + F.lane * 8; const float* gq = a.in(I_XQG) + F.lane * 8;
        u32x2 o; o.x = __builtin_amdgcn_cvt_pk_fp8_f32(v[0] * rs * gk[0] * gq[0], v[1] * rs * gk[1] * gq[1], 0u, false); o.x = __builtin_amdgcn_cvt_pk_fp8_f32(v[2] * rs * gk[2] * gq[2], v[3] * rs * gk[3] * gq[3], o.x, true);
        o.y = __builtin_amdgcn_cvt_pk_fp8_f32(v[4] * rs * gk[4] * gq[4], v[5] * rs * gk[5] * gq[5], 0u, false); o.y = __builtin_amdgcn_cvt_pk_fp8_f32(v[6] * rs * gk[6] * gq[6], v[7] * rs * gk[7] * gq[7], o.y, true);
        *(u32x2*)(kn + ((size_t)((b * 4 + h) * 256 + key)) * 512 + F.lane * 8) = o;
    }
}

constexpr int SP = 272;
constexpr int S_C = 0, S_BM = 34816, S_BT = 69632, S_XDT = 104448, S_HB = 121856, S_F = 139264, S_W = 155648  , SSD_LDS = 162048;
static_assert(SSD_LDS <= MISC_OFF, "SSD LDS map");
#define MFMA32(a, b, c) __builtin_amdgcn_mfma_f32_32x32x16_bf16((a), (b), (c), 0, 0, 0)
DI int crow(int r, int hi) { return (r & 3) + 8 * (r >> 2) + 4 * hi; }
DI bf16x8 ldfrag(LAS const unsigned char* base, int row, int kel) { return *(const LAS bf16x8*)(base + row * SP + kel * 2); }
DI float fexp(float x) { return __builtin_amdgcn_exp2f(x * 1.4426950408889634f); }
DI float fsilu(float x) { return x * __builtin_amdgcn_rcpf(1.f + fexp(-x)); }

DI void ssd_unit(Frame& F, const ArgP& a, int b, int hd) {
    LAS unsigned char* lds = F.lds;
    int tid = F.tid, lane = F.lane, r32 = lane & 31, hh = lane >> 5; const int wid = F.wave;
    LAS float* sdt = (LAS float*)(lds + S_F); LAS float* sac = sdt + 2048;
    const bf16_t* proj = (const bf16_t*)(F.ws + WS_PROJ); const float* dtbuf = (const float*)(F.ws + WS_DT); bf16_t* yg = (bf16_t*)(F.ws + WS_YG);
    const int g = hd >> 3;
    const float aneg = -__expf(a.in(I_ALOG)[hd]), dtb = a.in(I_DTB)[hd], dsk = a.in(I_DSKIP)[hd];
#pragma unroll
    for (int q = 0; q < 2; ++q) { const int c = 2 * wid + q; const size_t t0 = (size_t)b * SEQ_ + c * 128;
        const float x0 = dtbuf[(t0 + 2 * lane) * 16 + hd] + dtb, x1 = dtbuf[(t0 + 2 * lane + 1) * 16 + hd] + dtb;
        const float d0 = x0 > 20.f ? x0 : log1pf(__expf(x0)), d1 = x1 > 20.f ? x1 : log1pf(__expf(x1));
        const float a0 = d0 * aneg, a1 = d1 * aneg;
        float s = a0 + a1;
#pragma unroll
        for (int o = 1; o < 64; o <<= 1) { const float t = __shfl_up(s, o); if (lane >= o) s += t; }
        sdt[c * 128 + 2 * lane] = d0; sdt[c * 128 + 2 * lane + 1] = d1; sac[c * 128 + 2 * lane] = s - a1; sac[c * 128 + 2 * lane + 1] = s; }
    int seg = tid >> 5, cg = tid & 31, l0 = seg * 8;
    int colbc = (cg < 16) ? (1024 + g * 128 + cg * 8) : (1280 + g * 128 + (cg - 16) * 8);
    const int colx = hd * 64 + wid * 8; int lx = 2 * lane;
    LAS float* swt = (LAS float*)(lds + S_W);
    { const float* convw = a.in(I_CONVW); const float* convb = a.in(I_CONVB);
      if (tid < 320) { const int ci = tid;
          const int xc = (ci < 64) ? (hd * 64 + ci) : (ci < 192 ? (1024 + g * 128 + (ci - 64)) : (1280 + g * 128 + (ci - 192)));
#pragma unroll
          for (int k = 0; k < 4; ++k) swt[k * 320 + ci] = convw[k * 1536 + xc];
          swt[4 * 320 + ci] = convb[xc]; } }
    int cibc = 64 + cg * 8; const int cix = wid * 8;
    const char* pub = (const char*)F.ws; const unsigned pxb = (unsigned)(WS_PROJ + ((size_t)b * SEQ_ * PP + PC_XBC) * 2), zoff = (unsigned)(WS_CTL + 524288);
    u32x4 inbc[11], inx[5];
#define SSD_PREFETCH(c_) do { \
        int sd_ = l0; asm volatile("" : "+v"(sd_)); \
        _Pragma("unroll") for (int j = 0; j < 11; ++j) { const int tt = (c_) * 128 + sd_ - 3 + j; inbc[j] = *(const u32x4*)(pub + ((tt >= 0) ? pxb + (unsigned)(tt * PP + colbc) * 2u : zoff)); } } while (0)
    SSD_PREFETCH(0);
    f32x16 hT; for (int i = 0; i < 16; ++i) hT[i] = 0.f;
    const int nb = wid & 3, pb = wid >> 2;
    __syncthreads();
    for (int c = 0; c < 16; ++c) {
        { int t_ = threadIdx.x; asm volatile("" : "+v"(t_)); tid = t_; lane = t_ & 63; r32 = lane & 31; hh = lane >> 5; seg = t_ >> 5; cg = t_ & 31; l0 = seg * 8; lx = 2 * lane;
          colbc = (cg < 16) ? (1024 + g * 128 + cg * 8) : (1280 + g * 128 + (cg - 16) * 8); cibc = 64 + cg * 8; }
        const size_t t0 = (size_t)b * SEQ_ + c * 128;
        const LAS float* cdt = sdt + c * 128; const LAS float* cac = sac + c * 128;
        const float aend = cac[127];
#pragma unroll
        for (int j = 0; j < 5; ++j) { int sd_ = lx; asm volatile("" : "+v"(sd_)); const int tt = c * 128 + sd_ - 3 + j; inx[j] = *(const u32x4*)(pub + ((tt >= 0) ? pxb + (unsigned)(tt * PP + colx) * 2u : zoff)); }
        {
            LAS unsigned char* hbp = lds + S_HB + (32 * pb + r32) * SP + (32 * nb + 4 * hh) * 2;
#pragma unroll
            for (int q4 = 0; q4 < 4; ++q4) { u32x2 w; w.x = pk2(hT[4 * q4], hT[4 * q4 + 1]); w.y = pk2(hT[4 * q4 + 2], hT[4 * q4 + 3]); *(LAS u32x2*)(hbp + 16 * q4) = w; }
        }
        {
            float wbc[5][8];
#pragma unroll
            for (int k = 0; k < 5; ++k) { const f32x4 w0 = *(const LAS f32x4*)(swt + k * 320 + cibc), w1 = *(const LAS f32x4*)(swt + k * 320 + cibc + 4);
#pragma unroll
                for (int i = 0; i < 4; ++i) { wbc[k][i] = w0[i]; wbc[k][4 + i] = w1[i]; } }
#pragma unroll
            for (int hf = 0; hf < 2; ++hf) {
                __builtin_amdgcn_sched_barrier(0);
                float o[4][8];
#pragma unroll
                for (int j = 0; j < 4; ++j)
#pragma unroll
                    for (int i = 0; i < 8; ++i) { float s = wbc[4][i];
#pragma unroll
                        for (int k = 0; k < 4; ++k) { const unsigned wd = inbc[4 * hf + j + k][i >> 1]; s += wbc[k][i] * ((i & 1) ? bfhi(wd) : bflo(wd)); }
                        o[j][i] = fsilu(s); }
                const int lh = l0 + 4 * hf;
                if (cg < 16) {
                    const int n0 = cg * 8; float ev[4];
#pragma unroll
                    for (int j = 0; j < 4; ++j) { ev[j] = fexp(aend - cac[lh + j]);
                        u32x4 w1; w1.x = pk2(o[j][0], o[j][1]); w1.y = pk2(o[j][2], o[j][3]); w1.z = pk2(o[j][4], o[j][5]); w1.w = pk2(o[j][6], o[j][7]);
                        *(LAS u32x4*)(lds + S_BM + (lh + j) * SP + n0 * 2) = w1; }
#pragma unroll
                    for (int i = 0; i < 8; ++i) { u32x2 w2; w2.x = pk2(o[0][i] * ev[0], o[1][i] * ev[1]); w2.y = pk2(o[2][i] * ev[2], o[3][i] * ev[3]);
                        *(LAS u32x2*)(lds + S_BT + (n0 + i) * SP + lh * 2) = w2; }
                } else {
                    const int n0 = (cg - 16) * 8;
#pragma unroll
                    for (int j = 0; j < 4; ++j) { u32x4 w1; w1.x = pk2(o[j][0], o[j][1]); w1.y = pk2(o[j][2], o[j][3]); w1.z = pk2(o[j][4], o[j][5]); w1.w = pk2(o[j][6], o[j][7]);
                        *(LAS u32x4*)(lds + S_C + (lh + j) * SP + n0 * 2) = w1; }
                }
            }
        }
        __builtin_amdgcn_sched_barrier(0);
        {
            const float d0 = cdt[lx], d1 = cdt[lx + 1];
            float wx[5][8];
#pragma unroll
            for (int k = 0; k < 5; ++k) { const f32x4 w0 = *(const LAS f32x4*)(swt + k * 320 + cix), w1 = *(const LAS f32x4*)(swt + k * 320 + cix + 4);
#pragma unroll
                for (int i = 0; i < 4; ++i) { wx[k][i] = w0[i]; wx[k][4 + i] = w1[i]; } }
#pragma unroll
            for (int i = 0; i < 8; ++i) { float s0 = wx[4][i], s1 = wx[4][i];
#pragma unroll
                for (int k = 0; k < 4; ++k) { const unsigned w0 = inx[k][i >> 1], w1 = inx[k + 1][i >> 1];
                    s0 += wx[k][i] * ((i & 1) ? bfhi(w0) : bflo(w0)); s1 += wx[k][i] * ((i & 1) ? bfhi(w1) : bflo(w1)); }
                *(LAS unsigned*)(lds + S_XDT + (wid * 8 + i) * SP + lx * 2) = pk2(fsilu(s0) * d0, fsilu(s1) * d1); }
        }
        if (c < 15) SSD_PREFETCH(c + 1);
        __syncthreads();
        const int lb = wid >> 1;
        f32x16 xt[2];
        {
            bf16x8 cf[8];
#pragma unroll
            for (int ks = 0; ks < 8; ++ks) cf[ks] = ldfrag(lds + S_C, 32 * lb + r32, 16 * ks + 8 * hh);
#pragma unroll
            for (int q = 0; q < 2; ++q) { const int sb = 2 * (wid & 1) + q;
                for (int i = 0; i < 16; ++i) xt[q][i] = 0.f;
                if (sb <= lb) {
                    bf16x8 bfr[8];
#pragma unroll
                    for (int ks = 0; ks < 8; ++ks) bfr[ks] = ldfrag(lds + S_BM, 32 * sb + r32, 16 * ks + 8 * hh);
                    __builtin_amdgcn_sched_barrier(0);
#pragma unroll
                    for (int ks = 0; ks < 8; ++ks) xt[q] = MFMA32(bfr[ks], cf[ks], xt[q]);
                }
            }
        }
        __syncthreads();
        {
            const int l = 32 * lb + r32; const float al = cac[l], ddl = dsk * __builtin_amdgcn_rcpf(cdt[l]);
            f32x4 cs[2][4];
#pragma unroll
            for (int q = 0; q < 2; ++q)
#pragma unroll
                for (int q4 = 0; q4 < 4; ++q4) cs[q][q4] = *(const LAS f32x4*)(cac + 32 * (2 * (wid & 1) + q) + 8 * q4 + 4 * hh);
#pragma unroll
            for (int q = 0; q < 2; ++q) { const int sb = 2 * (wid & 1) + q;
#pragma unroll
                for (int q4 = 0; q4 < 4; ++q4) { float mv[4];
#pragma unroll
                    for (int e = 0; e < 4; ++e) { const int s = 32 * sb + 8 * q4 + 4 * hh + e;
                        const float ev = fexp(fminf(al - cs[q][q4][e], 0.f));
                        float v = (s <= l) ? xt[q][4 * q4 + e] * ev : 0.f;
                        v += (s == l) ? ddl : 0.f;
                        mv[e] = v; }
                    u32x2 w; w.x = pk2(mv[0], mv[1]); w.y = pk2(mv[2], mv[3]);
                    *(LAS u32x2*)(lds + S_BM + l * SP + (32 * sb + 8 * q4 + 4 * hh) * 2) = w; }
            }
        }
        __syncthreads();
        {
            const int lb2 = wid & 3, pb2 = wid >> 2; const int l = 32 * lb2 + r32; const size_t tok = t0 + l;
            const int pc0 = hd * 64 + 32 * pb2 + 4 * hh;
            u32x2 zz[4];
#pragma unroll
            for (int q4 = 0; q4 < 4; ++q4) zz[q4] = *(const u32x2*)(proj + tok * PP + pc0 + 8 * q4);
            f32x16 y1, y2; for (int i = 0; i < 16; ++i) { y1[i] = 0.f; y2[i] = 0.f; }
            bf16x8 fa[8], fb[8];
#pragma unroll
            for (int ks = 0; ks < 8; ++ks) { fa[ks] = ldfrag(lds + S_XDT, 32 * pb2 + r32, 16 * ks + 8 * hh); fb[ks] = ldfrag(lds + S_BM, 32 * lb2 + r32, 16 * ks + 8 * hh); }
            __builtin_amdgcn_sched_barrier(0);
#pragma unroll
            for (int ks = 0; ks < 8; ++ks) { if (ks < 2 * (lb2 + 1)) y1 = MFMA32(fa[ks], fb[ks], y1); }
            const float cd = fexp(aend);
#pragma unroll
            for (int i = 0; i < 16; ++i) hT[i] *= cd;
#pragma unroll
            for (int ks = 0; ks < 8; ++ks) fb[ks] = ldfrag(lds + S_BT, 32 * nb + r32, 16 * ks + 8 * hh);
            __builtin_amdgcn_sched_barrier(0);
#pragma unroll
            for (int ks = 0; ks < 8; ++ks) hT = MFMA32(fb[ks], fa[ks], hT);
#pragma unroll
            for (int ks = 0; ks < 8; ++ks) { fa[ks] = ldfrag(lds + S_HB, 32 * pb2 + r32, 16 * ks + 8 * hh); fb[ks] = ldfrag(lds + S_C, 32 * lb2 + r32, 16 * ks + 8 * hh); }
            __builtin_amdgcn_sched_barrier(0);
#pragma unroll
            for (int ks = 0; ks < 8; ++ks) y2 = MFMA32(fa[ks], fb[ks], y2);
            const float el = fexp(cac[l]);
#pragma unroll
            for (int q4 = 0; q4 < 4; ++q4) { float yv[4];
#pragma unroll
                for (int e = 0; e < 4; ++e) { const float z = (e & 1) ? bfhi(e < 2 ? zz[q4].x : zz[q4].y) : bflo(e < 2 ? zz[q4].x : zz[q4].y);
                    yv[e] = (y1[4 * q4 + e] + el * y2[4 * q4 + e]) * fsilu(z); }
                u32x2 w; w.x = pk2(yv[0], yv[1]); w.y = pk2(yv[2], yv[3]);
                *(u32x2*)(yg + tok * 1024 + pc0 + 8 * q4) = w; }
        }
        __syncthreads();
    }
#undef SSD_PREFETCH
}

DI void attn_phase_da(Frame& F) {
    const attn_body::bf16* proj = (const attn_body::bf16*)(F.ws + WS_PROJ);
    for (;;) {
        if (threadIdx.x == 0) F.MISC[120] = __hip_atomic_fetch_add(F.ctl + CW_QATT, 1u, __ATOMIC_RELAXED, __HIP_MEMORY_SCOPE_AGENT);
        __syncthreads();
        const int u = __builtin_amdgcn_readfirstlane((int)F.MISC[120]);
        __syncthreads();
        if (u >= 1024) break;
        const int qb = 7 - (u >> 7), combo = u & 127;
        const int half = combo & 1, j = (combo >> 1) & 1, h = (combo >> 2) & 7, b = combo >> 5;
        attn_body::bf16* O = (attn_body::bf16*)(F.ws + (j ? WS_O1 : WS_O0));
        attn_body::attn_unit<8>(b, PC_Q + (h * 2 + j) * 64, PC_V + h * 128 + half * 64, h * 128 + half * 64, qb, proj, proj + (PC_K - PC_Q), proj, O, (char*)F.lds);
    }
}

DI void p3_finalize(Frame& F, const ArgP& a) {
    const int gw = F.vcu * NWAVES + F.wave, NGW = F.G * NWAVES, lane = F.lane;
    bf16_t* ycat = (bf16_t*)(F.ws + WS_YCAT); const bf16_t* yg = (const bf16_t*)(F.ws + WS_YG); const bf16_t* o0 = (const bf16_t*)(F.ws + WS_O0); const bf16_t* o1 = (const bf16_t*)(F.ws + WS_O1);
    float l1 = a.in(I_LQ1)[lane] * a.in(I_LK1)[lane], l2 = a.in(I_LQ2)[lane] * a.in(I_LK2)[lane];
    const float lam = __expf(wave_sum(l1)) - __expf(wave_sum(l2)) + LAM_INIT;
    for (int m = gw; m < NTOK; m += NGW) {
        { bf16_t* yp = ycat + (size_t)m * 2048 + 16 * lane; const bf16_t* gp = yg + (size_t)m * 1024 + 16 * lane;
          const u32x4 r0 = *(const u32x4*)gp, r1 = *(const u32x4*)(gp + 8);
          float v[16]; v[0] = bflo(r0.x); v[1] = bfhi(r0.x); v[2] = bflo(r0.y); v[3] = bfhi(r0.y); v[4] = bflo(r0.z); v[5] = bfhi(r0.z); v[6] = bflo(r0.w); v[7] = bfhi(r0.w);
          v[8] = bflo(r1.x); v[9] = bfhi(r1.x); v[10] = bflo(r1.y); v[11] = bfhi(r1.y); v[12] = bflo(r1.z); v[13] = bfhi(r1.z); v[14] = bflo(r1.w); v[15] = bfhi(r1.w);
          float ss = 0.f;
#pragma unroll
          for (int i = 0; i < 16; ++i) ss += v[i] * v[i];
#pragma unroll
          for (int o = 1; o < 32; o <<= 1) ss += __shfl_xor(ss, o);
          const float rs = 1.f / sqrtf(ss * (1.f / 512.f) + EPS_);
          const float* g = a.in(I_SSDG) + 16 * lane;
          u32x4 w0, w1;
          w0.x = pk2(v[0] * rs * g[0], v[1] * rs * g[1]); w0.y = pk2(v[2] * rs * g[2], v[3] * rs * g[3]); w0.z = pk2(v[4] * rs * g[4], v[5] * rs * g[5]); w0.w = pk2(v[6] * rs * g[6], v[7] * rs * g[7]);
          w1.x = pk2(v[8] * rs * g[8], v[9] * rs * g[9]); w1.y = pk2(v[10] * rs * g[10], v[11] * rs * g[11]); w1.z = pk2(v[12] * rs * g[12], v[13] * rs * g[13]); w1.w = pk2(v[14] * rs * g[14], v[15] * rs * g[15]);
          *(u32x4*)yp = w0; *(u32x4*)(yp + 8) = w1; }
        { const bf16_t* p0 = o0 + (size_t)m * 1024 + 16 * lane; const bf16_t* p1 = o1 + (size_t)m * 1024 + 16 * lane;
          const u32x4 a0 = *(const u32x4*)p0, a1 = *(const u32x4*)(p0 + 8), b0 = *(const u32x4*)p1, b1 = *(const u32x4*)(p1 + 8);
          float v[16];
          v[0] = bflo(a0.x) - lam * bflo(b0.x); v[1] = bfhi(a0.x) - lam * bfhi(b0.x); v[2] = bflo(a0.y) - lam * bflo(b0.y); v[3] = bfhi(a0.y) - lam * bfhi(b0.y);
          v[4] = bflo(a0.z) - lam * bflo(b0.z); v[5] = bfhi(a0.z) - lam * bfhi(b0.z); v[6] = bflo(a0.w) - lam * bflo(b0.w); v[7] = bfhi(a0.w) - lam * bfhi(b0.w);
          v[8] = bflo(a1.x) - lam * bflo(b1.x); v[9] = bfhi(a1.x) - lam * bfhi(b1.x); v[10] = bflo(a1.y) - lam * bflo(b1.y); v[11] = bfhi(a1.y) - lam * bfhi(b1.y);
          v[12] = bflo(a1.z) - lam * bflo(b1.z); v[13] = bfhi(a1.z) - lam * bfhi(b1.z); v[14] = bflo(a1.w) - lam * bflo(b1.w); v[15] = bfhi(a1.w) - lam * bfhi(b1.w);
          float ss = 0.f;
#pragma unroll
          for (int i = 0; i < 16; ++i) ss += v[i] * v[i];
          ss += __shfl_xor(ss, 1); ss += __shfl_xor(ss, 2); ss += __shfl_xor(ss, 4);
          const float rs = 1.f / sqrtf(ss * (1.f / 128.f) + EPS_) * (1.f - LAM_INIT);
          const float* g = a.in(I_SUBG) + 16 * (lane & 7);
          u32x4 w0, w1;
          w0.x = pk2(v[0] * rs * g[0], v[1] * rs * g[1]); w0.y = pk2(v[2] * rs * g[2], v[3] * rs * g[3]); w0.z = pk2(v[4] * rs * g[4], v[5] * rs * g[5]); w0.w = pk2(v[6] * rs * g[6], v[7] * rs * g[7]);
          w1.x = pk2(v[8] * rs * g[8], v[9] * rs * g[9]); w1.y = pk2(v[10] * rs * g[10], v[11] * rs * g[11]); w1.z = pk2(v[12] * rs * g[12], v[13] * rs * g[13]); w1.w = pk2(v[14] * rs * g[14], v[15] * rs * g[15]);
          bf16_t* yp = ycat + (size_t)m * 2048 + 1024 + 16 * lane;
          *(u32x4*)yp = w0; *(u32x4*)(yp + 8) = w1; }
    }
}

struct SchedDense {
    int G, c, nM, nN; const char* A; const char* B; unsigned lda, ldb; int bdiv; size_t bstride;
    DI bool next(int i, pg8::UnitD& u) const {
        const int L = i * G + c; if (L >= nM * nN) return false;
        u.rows = nullptr; u.nvalid = 0; u.lda = lda; u.ldb = ldb; u.type = 0; u.e = 0; u.x0 = 0;
        u.pn = L / nM; u.pm = L % nM;
        u.A = A + (size_t)u.pm * 256 * lda; u.B = B + (size_t)u.pn * 256 * ldb + (size_t)(u.pm / bdiv) * bstride;
        return true;
    }
};
template <bool BASE_BF16>
struct EpiResid {
    static constexpr bool AFTER_DRAIN = false;
    const void* base; bf16_t* out; float* part; unsigned char* out8; float accscale;
    DI void operator()(const f32x4 (&acc)[2][2][4][2], const pg8::UnitD& u, int wr, int wc, int fr, int fq) const {
        { int ln_ = threadIdx.x; asm volatile("" : "+v"(ln_)); fr = ln_ & 15; fq = (ln_ >> 4) & 3; }
        const int row0 = u.pm * 256 + wr * 64 + fr, col0 = u.pn * 256 + wc * 32 + 8 * fq;
#pragma unroll
        for (int ai = 0; ai < 2; ++ai)
#pragma unroll
            for (int m = 0; m < 4; ++m) { const size_t row = (size_t)(row0 + ai * 128 + m * 16); float ss = 0.f;
#pragma unroll
                for (int bj = 0; bj < 2; ++bj) { const size_t idx = row * 2048 + col0 + bj * 128;
                    f32x4 b0, b1;
                    if constexpr (BASE_BF16) { const u32x4 r = *(const u32x4*)((const bf16_t*)base + idx); b0 = (f32x4){bflo(r.x), bfhi(r.x), bflo(r.y), bfhi(r.y)}; b1 = (f32x4){bflo(r.z), bfhi(r.z), bflo(r.w), bfhi(r.w)}; }
                    else { b0 = *(const f32x4*)((const float*)base + idx); b1 = *(const f32x4*)((const float*)base + idx + 4); }
                    const f32x4 v0 = acc[ai][bj][m][0] * accscale + b0, v1 = acc[ai][bj][m][1] * accscale + b1;
                    { u32x4 w; w.x = pk2(v0[0], v0[1]); w.y = pk2(v0[2], v0[3]); w.z = pk2(v1[0], v1[1]); w.w = pk2(v1[2], v1[3]); *(u32x4*)(out + idx) = w; }
                    if (out8) { u32x2 w; w.x = __builtin_amdgcn_cvt_pk_fp8_f32(v0[0] * 16.f, v0[1] * 16.f, 0u, false); w.x = __builtin_amdgcn_cvt_pk_fp8_f32(v0[2] * 16.f, v0[3] * 16.f, w.x, true);
                        w.y = __builtin_amdgcn_cvt_pk_fp8_f32(v1[0] * 16.f, v1[1] * 16.f, 0u, false); w.y = __builtin_amdgcn_cvt_pk_fp8_f32(v1[2] * 16.f, v1[3] * 16.f, w.y, true); *(u32x2*)(out8 + idx) = w; }
                    ss += (v0[0] * v0[0] + v0[1] * v0[1]) + (v0[2] * v0[2] + v0[3] * v0[3]) + (v1[0] * v1[0] + v1[1] * v1[1]) + (v1[2] * v1[2] + v1[3] * v1[3]); }
                if (part) { ss += __shfl_xor(ss, 16); ss += __shfl_xor(ss, 32); if (fq == 0) part[row * 32 + u.pn * 4 + wc] = ss; } }
    }
};

struct EpiQ {
    static constexpr bool AFTER_DRAIN = false;
    unsigned char* out8; float* part;
    DI void operator()(const f32x4 (&acc)[2][2][4][2], const pg8::UnitD& u, int wr, int wc, int fr, int fq) const {
        { int ln_ = threadIdx.x; asm volatile("" : "+v"(ln_)); fr = ln_ & 15; fq = (ln_ >> 4) & 3; }
        const int row0 = u.pm * 256 + wr * 64 + fr, col0 = u.pn * 256 + wc * 32 + 8 * fq;
#pragma unroll
        for (int ai = 0; ai < 2; ++ai)
#pragma unroll
            for (int m = 0; m < 4; ++m) { const size_t row = (size_t)(row0 + ai * 128 + m * 16); float ss = 0.f;
#pragma unroll
                for (int bj = 0; bj < 2; ++bj) { const size_t idx = row * 2048 + col0 + bj * 128; const f32x4 v0 = acc[ai][bj][m][0] * (1.f / 1024.f), v1 = acc[ai][bj][m][1] * (1.f / 1024.f);
                    u32x2 w; w.x = __builtin_amdgcn_cvt_pk_fp8_f32(v0[0] * 16.f, v0[1] * 16.f, 0u, false); w.x = __builtin_amdgcn_cvt_pk_fp8_f32(v0[2] * 16.f, v0[3] * 16.f, w.x, true);
                    w.y = __builtin_amdgcn_cvt_pk_fp8_f32(v1[0] * 16.f, v1[1] * 16.f, 0u, false); w.y = __builtin_amdgcn_cvt_pk_fp8_f32(v1[2] * 16.f, v1[3] * 16.f, w.y, true); *(u32x2*)(out8 + idx) = w;
                    ss += (v0[0] * v0[0] + v0[1] * v0[1]) + (v0[2] * v0[2] + v0[3] * v0[3]) + (v1[0] * v1[0] + v1[1] * v1[1]) + (v1[2] * v1[2] + v1[3] * v1[3]); }
                ss += __shfl_xor(ss, 16); ss += __shfl_xor(ss, 32); if (fq == 0) part[row * 32 + u.pn * 4 + wc] = ss; }
    }
};

struct SchedXS {
    int G, c; const unsigned char* ws;
    DI bool next(int i, pg8::UnitD& u) const {
        const int L = i * G + c; if (L >= 256) return false;
        u.rows = nullptr; u.nvalid = 0; u.e = 0;
        const int q = L & 127, bh = q >> 3, t8 = q & 7, b = bh >> 2, h = bh & 3;
        u.pm = b; u.pn = h; u.x0 = t8;
        if (L < 128) { u.type = 0; u.lda = 2048u; u.ldb = 512u;
            u.A = (const char*)(ws + WS_QF8) + (size_t)(b * 2048 + t8 * 256) * 2048 + h * 512; u.B = (const char*)(ws + WS_KN8) + (size_t)(bh * 256) * 512; }
        else { u.type = 1; u.lda = 2048u; u.ldb = 2048u;
            u.A = (const char*)(ws + WS_WO) + (size_t)(t8 * 256) * 2048 + h * 512; u.B = (const char*)(ws + WS_VF8) + (size_t)(b * 256) * 2048 + h * 512; }
        return true;
    }
};
struct EpiXS {
    static constexpr bool AFTER_DRAIN = false;
    unsigned char* P; unsigned char* VWT; const float* part1; const float* partq; LAS float* red;
    DI void operator()(const f32x4 (&acc)[2][2][4][2], const pg8::UnitD& u, int wr, int wc, int fr, int fq) const {
        { int ln_ = threadIdx.x; asm volatile("" : "+v"(ln_)); fr = ln_ & 15; fq = (ln_ >> 4) & 3; }
        const int b = u.pm, h = u.pn, t8 = u.x0;
        const int col0 = wc * 32 + 8 * fq;
        if (u.type == 1) {
            unsigned char* Vu = VWT + ((size_t)b * 2048 + t8 * 256) * 1024 + h * 256;
#pragma unroll
            for (int ai = 0; ai < 2; ++ai)
#pragma unroll
                for (int m = 0; m < 4; ++m) { const unsigned rl = (unsigned)(ai * 128 + wr * 64 + m * 16 + fr);
#pragma unroll
                    for (int bj = 0; bj < 2; ++bj) { const f32x4 v0 = acc[ai][bj][m][0] * (32.f / 1024.f), v1 = acc[ai][bj][m][1] * (32.f / 1024.f);
                        u32x2 w; w.x = __builtin_amdgcn_cvt_pk_fp8_f32(v0[0], v0[1], 0u, false); w.x = __builtin_amdgcn_cvt_pk_fp8_f32(v0[2], v0[3], w.x, true);
                        w.y = __builtin_amdgcn_cvt_pk_fp8_f32(v1[0], v1[1], 0u, false); w.y = __builtin_amdgcn_cvt_pk_fp8_f32(v1[2], v1[3], w.y, true);
                        *(u32x2*)(Vu + (rl * 1024u + (unsigned)(bj * 128 + col0))) = w; } }
            return;
        }
        const size_t row0 = (size_t)b * 2048 + t8 * 256;
        const char* p1u = (const char*)(part1 + row0 * 32); const char* pqu = (const char*)(partq + row0 * 32 + h * 8); unsigned char* Pu = P + row0 * 1024 + h * 256;
        float rsc[2][4];
#pragma unroll
        for (int ai = 0; ai < 2; ++ai)
#pragma unroll
            for (int m = 0; m < 4; ++m) { const unsigned rl = (unsigned)(ai * 128 + wr * 64 + m * 16 + fr);
                const f32x4 p0 = *(const f32x4*)(p1u + (rl * 32u + (unsigned)fq * 8u) * 4u), p1 = *(const f32x4*)(p1u + (rl * 32u + (unsigned)fq * 8u + 4u) * 4u);
                float s1 = (p0[0] + p0[1]) + (p0[2] + p0[3]) + (p1[0] + p1[1]) + (p1[2] + p1[3]);
                const f32x2 pq = *(const f32x2*)(pqu + (rl * 32u + (unsigned)fq * 2u) * 4u);
                float sq = pq[0] + pq[1];
                s1 = quad_sum_16_32(s1); sq = quad_sum_16_32(sq);
                rsc[ai][m] = __builtin_amdgcn_rsqf(sq * (1.f / 512.f) + EPS_ * (s1 * (1.f / 2048.f) + EPS_)) * (1.4426950408889634f / 2048.f);
                float ps = 0.f;
#pragma unroll
                for (int bj = 0; bj < 2; ++bj)
#pragma unroll
                    for (int n = 0; n < 2; ++n)
#pragma unroll
                        for (int e = 0; e < 4; ++e) ps += __builtin_amdgcn_exp2f(fminf(acc[ai][bj][m][n][e] * rsc[ai][m], 100.f));
                ps = quad_sum_16_32(ps);
                if (fq == 0) red[rl * 4 + wc] = ps;
                __builtin_amdgcn_sched_barrier(0); }
        __syncthreads();
        { int ln_ = threadIdx.x; asm volatile("" : "+v"(ln_)); fr = ln_ & 15; fq = (ln_ >> 4) & 3; }
#pragma unroll
        for (int ai = 0; ai < 2; ++ai)
#pragma unroll
            for (int m = 0; m < 4; ++m) { const unsigned rl = (unsigned)(ai * 128 + wr * 64 + m * 16 + fr);
                const f32x4 t = *(const LAS f32x4*)(red + rl * 4); const float inv = 256.f * __builtin_amdgcn_rcpf((t[0] + t[1]) + (t[2] + t[3])); float rs = rsc[ai][m]; asm volatile("" : "+v"(rs));
#pragma unroll
                for (int bj = 0; bj < 2; ++bj) { float x[8];
#pragma unroll
                    for (int n = 0; n < 2; ++n)
#pragma unroll
                        for (int e = 0; e < 4; ++e) x[n * 4 + e] = __builtin_amdgcn_exp2f(fminf(acc[ai][bj][m][n][e] * rs, 100.f)) * inv;
                    u32x2 w; w.x = __builtin_amdgcn_cvt_pk_fp8_f32(x[0], x[1], 0u, false); w.x = __builtin_amdgcn_cvt_pk_fp8_f32(x[2], x[3], w.x, true);
                    w.y = __builtin_amdgcn_cvt_pk_fp8_f32(x[4], x[5], 0u, false); w.y = __builtin_amdgcn_cvt_pk_fp8_f32(x[6], x[7], w.y, true);
                    *(u32x2*)(Pu + (rl * 1024u + (unsigned)(bj * 128 + wc * 32 + 8 * fq))) = w; } }
        __syncthreads();
    }
};

constexpr int HNP = 2052;
DI void p8_route(Frame& F, const ArgP& a) {
    LAS float* s_hn = (LAS float*)F.lds; LAS float* s_part = (LAS float*)(F.lds + 16 * HNP * 4); LAS float* s_log = s_part + 8 * 16 * 32; LAS int* s_slot = (LAS int*)(s_log + 16 * 32);
    LAS int* s_cnt = s_slot + 64; LAS int* s_base = s_cnt + 32;
    const bf16_t* h2 = (const bf16_t*)(F.ws + WS_H2); unsigned char* xg = (unsigned char*)(F.ws + WS_XG);
    float* gate_of = (float*)(F.ws + WS_GATEOF); int* tok_e = (int*)(F.ws + WS_TOKE);
    const float* rw = a.in(I_RW); const float* rb = a.in(I_RB); const float* g3 = a.in(I_GFFN);
    const int lane = F.lane, wave = F.wave, tid = F.tid;
    float bw0[64], bw1[64];
    { const int kq = lane >> 4, c16 = lane & 15; const float* bp = rw + (size_t)(256 * wave + kq) * 32 + c16;
#pragma unroll
      for (int j = 0; j < 64; ++j) { bw0[j] = bp[(size_t)(4 * j) * 32]; bw1[j] = bp[(size_t)(4 * j) * 32 + 16]; } }
    for (int task = F.vcu; task < NTOK / 16; task += F.G) {
        const int tb = task * 16;
#pragma unroll
        for (int q = 0; q < 2; ++q) { const int tl = 2 * wave + q; const size_t tok = (size_t)(tb + tl);
            const u32x2* xr = (const u32x2*)(h2 + tok * 2048) + lane;
            f32x4 v[8]; float s = 0.f;
#pragma unroll
            for (int j = 0; j < 8; ++j) { const u32x2 rw_ = xr[64 * j]; v[j] = (f32x4){bflo(rw_.x), bfhi(rw_.x), bflo(rw_.y), bfhi(rw_.y)}; s += (v[j].x * v[j].x + v[j].y * v[j].y) + (v[j].z * v[j].z + v[j].w * v[j].w); }
            const float rstd = 1.f / sqrtf(wave_sum(s) * (1.f / 2048.f) + EPS_);
#pragma unroll
            for (int j = 0; j < 8; ++j) { const f32x4 gg = ((const f32x4*)g3)[lane + 64 * j]; const f32x4 y = v[j] * rstd * gg;
                *(LAS f32x4*)(s_hn + tl * HNP + (lane + 64 * j) * 4) = y; } }
        __syncthreads();
        {
            f32x4 acc0 = {0.f, 0.f, 0.f, 0.f}, acc1 = {0.f, 0.f, 0.f, 0.f};
            const int kq = lane >> 4, c16 = lane & 15;
            const LAS float* ap = s_hn + c16 * HNP + 256 * wave;
#pragma unroll
            for (int j = 0; j < 64; ++j) { const f32x4 a4 = *(const LAS f32x4*)(ap + 4 * j);
                const float av = (kq == 0) ? a4.x : (kq == 1) ? a4.y : (kq == 2) ? a4.z : a4.w;
                acc0 = __builtin_amdgcn_mfma_f32_16x16x4f32(av, bw0[j], acc0, 0, 0, 0);
                acc1 = __builtin_amdgcn_mfma_f32_16x16x4f32(av, bw1[j], acc1, 0, 0, 0); }
            LAS float* pp = s_part + wave * 512 + c16;
#pragma unroll
            for (int r = 0; r < 4; ++r) { pp[(4 * kq + r) * 32] = acc0[r]; pp[(4 * kq + r) * 32 + 16] = acc1[r]; }
        }
        __syncthreads();
        {
            const int tt = tid >> 5, e = tid & 31; float lg = rb[e];
#pragma unroll
            for (int w = 0; w < 8; ++w) lg += s_part[w * 512 + tt * 32 + e];
            if (tid < 32) s_cnt[tid] = 0;
            float val[4]; int idx[4]; float cur = lg;
#pragma unroll
            for (int k = 0; k < 4; ++k) { float bv = cur; int bi = e;
#pragma unroll
                for (int o = 1; o < 32; o <<= 1) { const float ov = __shfl_xor(bv, o); const int oi = __shfl_xor(bi, o); if (ov > bv || (ov == bv && oi < bi)) { bv = ov; bi = oi; } }
                val[k] = bv; idx[k] = bi; if (e == bi) cur = -INFINITY; }
            __syncthreads();
            int myrank = 0, myexp = 0; float mygate = 0.f;
            if (e < 4) { const float sum = (__expf(val[0] - val[0]) + __expf(val[1] - val[0])) + (__expf(val[2] - val[0]) + __expf(val[3] - val[0]));
                const float mv = (e == 0) ? val[0] : (e == 1) ? val[1] : (e == 2) ? val[2] : val[3]; myexp = (e == 0) ? idx[0] : (e == 1) ? idx[1] : (e == 2) ? idx[2] : idx[3];
                mygate = __expf(mv - val[0]) / sum; myrank = __hip_atomic_fetch_add(&s_cnt[myexp], 1, __ATOMIC_RELAXED, __HIP_MEMORY_SCOPE_WORKGROUP); }
            __syncthreads();
            if (tid < 32) { const int c = s_cnt[tid]; s_base[tid] = c ? (int)__hip_atomic_fetch_add(F.ctl + CW_CNT + 64 * tid, (unsigned)c, __ATOMIC_RELAXED, __HIP_MEMORY_SCOPE_AGENT) : 0; }
            __syncthreads();
            if (e < 4) { const int slot = myexp * 8192 + s_base[myexp] + myrank; const int tok = tb + tt;
                gate_of[slot] = mygate; tok_e[tok * 4 + e] = slot; s_slot[tt * 4 + e] = slot; }
        }
        __syncthreads();
#pragma unroll
        for (int q = 0; q < 2; ++q) { const int tl = 2 * wave + q;
            unsigned o[8];
#pragma unroll
            for (int j = 0; j < 8; ++j) { const f32x4 y = *(const LAS f32x4*)(s_hn + tl * HNP + (lane + 64 * j) * 4);
                unsigned w = 0u; w = __builtin_amdgcn_cvt_pk_fp8_f32(y.x * 4.f, y.y * 4.f, w, false); w = __builtin_amdgcn_cvt_pk_fp8_f32(y.z * 4.f, y.w * 4.f, w, true); o[j] = w; }
#pragma unroll
            for (int k = 0; k < 4; ++k) { unsigned* o4 = (unsigned*)(xg + (size_t)s_slot[tl * 4 + k] * 2048) + lane;
#pragma unroll
                for (int j = 0; j < 8; ++j) o4[64 * j] = o[j]; } }
        __syncthreads();
    }
}

DI void moe_tables(Frame& F) {
    if (F.tid == 0) { unsigned base = 0u;
        for (int e = 0; e < 32; ++e) { const unsigned c = F.ctl[CW_CNT + 64 * e], mt = (c + 255u) >> 8; F.MISC[16 + e] = c; F.MISC[48 + e] = base; F.MISC[80 + e] = mt; base += mt; }
        F.MISC[112] = base; }
    __syncthreads();
}
DI int ldsu(volatile LAS unsigned* p) { return __builtin_amdgcn_readfirstlane((int)*p); }
template <int NTN  >
struct SchedMoe {
    int G, c; const unsigned char* ws; volatile LAS unsigned* MISC; int total;
    DI bool next(int i, pg8::UnitD& u) const {
        const int L = i * G + c; if (L >= total) return false;
        int e = 0;
        for (int k = 0; k < 32; ++k) { if (L >= (ldsu(MISC + 48 + k) + ldsu(MISC + 80 + k)) * NTN) e = k + 1; }
        const int tb = ldsu(MISC + 48 + e), mte = ldsu(MISC + 80 + e), cnt = ldsu(MISC + 16 + e);
        const int local = L - tb * NTN, nt = local / mte, mt = local % mte;
        u.type = 0; u.e = e; u.pn = nt; u.pm = tb + mt; u.x0 = mt; u.lda = 2048u; u.ldb = 2048u;
        u.rows = nullptr; u.nvalid = cnt - mt * 256;
        if (NTN == 16) { u.A = (const char*)(ws + WS_XG) + ((size_t)e * 8192 + (size_t)mt * 256) * 2048;
            u.B = (const char*)(ws + WS_W1) + ((size_t)e * 4096 + (size_t)nt * 256) * 2048; }
        else { u.A = (const char*)(ws + WS_ACT) + ((size_t)e * 8192 + (size_t)mt * 256) * 2048;
            u.B = (const char*)(ws + WS_W2) + ((size_t)e * 2048 + (size_t)nt * 256) * 2048; }
        return true;
    }
};
struct EpiMoe1 {
    static constexpr bool AFTER_DRAIN = false;
    unsigned char* act; const float* b1;
    DI void operator()(const f32x4 (&acc)[2][2][4][2], const pg8::UnitD& u, int wr, int wc, int fr, int fq) const {
        { int ln_ = threadIdx.x; asm volatile("" : "+v"(ln_)); fr = ln_ & 15; fq = (ln_ >> 4) & 3; }
        const int j0 = u.pn * 128 + wc * 32 + 8 * fq;
        const float* bg = b1 + (size_t)u.e * 4096 + j0; const float* bu = bg + 2048;
        const f32x4 bg0 = *(const f32x4*)bg, bg1 = *(const f32x4*)(bg + 4), bu0 = *(const f32x4*)bu, bu1 = *(const f32x4*)(bu + 4);
#pragma unroll
        for (int ai = 0; ai < 2; ++ai)
#pragma unroll
            for (int m = 0; m < 4; ++m) { const size_t row = (size_t)u.e * 8192 + u.x0 * 256 + ai * 128 + wr * 64 + m * 16 + fr;
                float o[8];
#pragma unroll
                for (int n = 0; n < 2; ++n)
#pragma unroll
                    for (int e = 0; e < 4; ++e) { const float g = fminf(acc[ai][0][m][n][e] * (1.f / 256.f) + (n ? bg1[e] : bg0[e]), 7.f);
                        const float uu = fminf(fmaxf(acc[ai][1][m][n][e] * (1.f / 256.f) + (n ? bu1[e] : bu0[e]), -7.f), 7.f);
                        o[n * 4 + e] = g / (1.f + __expf(-1.702f * g)) * (uu + 1.f) * 4.f; }
                u32x2 w; w.x = __builtin_amdgcn_cvt_pk_fp8_f32(o[0], o[1], 0u, false); w.x = __builtin_amdgcn_cvt_pk_fp8_f32(o[2], o[3], w.x, true);
                w.y = __builtin_amdgcn_cvt_pk_fp8_f32(o[4], o[5], 0u, false); w.y = __builtin_amdgcn_cvt_pk_fp8_f32(o[6], o[7], w.y, true);
                *(u32x2*)(act + row * 2048 + j0) = w; }
    }
};
struct EpiMoe2 {
    static constexpr bool AFTER_DRAIN = false;
    unsigned char* y; const float* b2; const float* gate_of;
    DI void operator()(const f32x4 (&acc)[2][2][4][2], const pg8::UnitD& u, int wr, int wc, int fr, int fq) const {
        { int ln_ = threadIdx.x; asm volatile("" : "+v"(ln_)); fr = ln_ & 15; fq = (ln_ >> 4) & 3; }
        const int col0 = u.pn * 256 + wc * 32 + 8 * fq;
        const float* bp = b2 + (size_t)u.e * 2048 + col0;
#pragma unroll
        for (int ai = 0; ai < 2; ++ai)
#pragma unroll
            for (int m = 0; m < 4; ++m) { const int rl = ai * 128 + wr * 64 + m * 16 + fr; const size_t row = (size_t)u.e * 8192 + u.x0 * 256 + rl;
                const float gt = (rl < u.nvalid) ? gate_of[u.e * 8192 + u.x0 * 256 + rl] * 32.f : 0.f;
#pragma unroll
                for (int bj = 0; bj < 2; ++bj) { const f32x4 v0 = (acc[ai][bj][m][0] * (1.f / 256.f) + *(const f32x4*)(bp + bj * 128)) * gt, v1 = (acc[ai][bj][m][1] * (1.f / 256.f) + *(const f32x4*)(bp + bj * 128 + 4)) * gt;
                    u32x2 w; w.x = __builtin_amdgcn_cvt_pk_fp8_f32(v0[0], v0[1], 0u, false); w.x = __builtin_amdgcn_cvt_pk_fp8_f32(v0[2], v0[3], w.x, true);
                    w.y = __builtin_amdgcn_cvt_pk_fp8_f32(v1[0], v1[1], 0u, false); w.y = __builtin_amdgcn_cvt_pk_fp8_f32(v1[2], v1[3], w.y, true);
                    *(u32x2*)(y + row * 2048 + col0 + bj * 128) = w; } }
    }
};

DI void p11_combine(Frame& F, const ArgP& a) {
    const int gw = F.vcu * NWAVES + F.wave, NGW = F.G * NWAVES, lane = F.lane;
    const bf16_t* h2 = (const bf16_t*)(F.ws + WS_H2); const unsigned char* y = (const unsigned char*)(F.ws + WS_Y);
    const int* tok_e = (const int*)(F.ws + WS_TOKE);
    for (int t = gw; t < NTOK; t += NGW) {
        size_t yrow[4];
#pragma unroll
        for (int k = 0; k < 4; ++k) yrow[k] = (size_t)tok_e[t * 4 + k] * 2048;
#pragma unroll
        for (int j = 0; j < 8; ++j) { const int c = (lane + 64 * j) * 4;
            const u32x2 hw = *(const u32x2*)(h2 + (size_t)t * 2048 + c); f32x4 v = {bflo(hw.x), bfhi(hw.x), bflo(hw.y), bfhi(hw.y)};
#pragma unroll
            for (int k = 0; k < 4; ++k) { const unsigned w = *(const unsigned*)(y + yrow[k] + c); const f32x2 lo = __builtin_amdgcn_cvt_pk_f32_fp8(w, false), hi = __builtin_amdgcn_cvt_pk_f32_fp8(w, true);
                v.x += lo.x * (1.f / 32.f); v.y += lo.y * (1.f / 32.f); v.z += hi.x * (1.f / 32.f); v.w += hi.y * (1.f / 32.f); }
            *(f32x4*)(a.out() + (size_t)t * 2048 + c) = v; }
    }
}

#ifndef MK_PER_PHASE
#define MK_PER_PHASE 0
#endif
#ifndef MK_LAST_PHASE
#define MK_LAST_PHASE 12
#endif
constexpr int N_PHASES = MK_LAST_PHASE;

__global__ void __launch_bounds__(NWAVES * 64, 2) mega_fwd(Args args_) {
    const ArgP args{};
    extern __shared__ __attribute__((aligned(16))) unsigned char lds_raw[];
    Frame F;
    F.lds = (LAS unsigned char*)lds_raw;
    F.MISC = (volatile LAS unsigned*)(F.lds + MISC_OFF);
    F.tid = threadIdx.x; F.lane = F.tid & 63; F.wave = __builtin_amdgcn_readfirstlane(F.tid >> 6);
    F.G = gridDim.x; { const int bx = blockIdx.x; F.vcu = (F.G % 8 == 0) ? (bx % 8) * (F.G / 8) + bx / 8 : bx; }
    F.ws = args_.ws; F.ctl = (unsigned*)(args_.ws + WS_CTL);
    for (int u = F.tid; u < 256; u += NWAVES * 64) F.MISC[u] = 0u;
    __syncthreads();
    XcdBarrier bar; bar.bar = F.ctl + CW_BAR; bar.x = 0; bar.st = nullptr;
    const int lo = args_.ph_lo, hi = args_.ph_hi;
    if (hi - lo > 1) bar = xcd_barrier_post(F.ctl + CW_BAR, F.MISC + 8);
#ifndef MK_PHASE_MASK
#define MK_PHASE_MASK 0xFFFF
#endif
#define IN(k) (((MK_PHASE_MASK >> (k)) & 1) && lo <= (k) && (k) < hi)
#define SEAM(k) do { if (IN(k) && IN((k) + 1)) xcd_barrier(bar); } while (0)
#define FRESH() do { int t_ = threadIdx.x; asm volatile("" : "+v"(t_)); F.tid = t_; F.lane = t_ & 63; F.wave = __builtin_amdgcn_readfirstlane(t_ >> 6); } while (0)
    unsigned char* ws = args_.ws;

    if (IN(0)) { FRESH(); p0_prologue(F, args); }
    SEAM(0);
    if (IN(1)) { FRESH();
        const bool conv_first = (F.vcu & 1) == 0;
        if (conv_first) { conv_share(F, args); __syncthreads(); }
        SchedP1 S{F.G, F.vcu, ws, 0, 32 * 23};
        EpiP1 E{(bf16_t*)(ws + WS_PROJ), (float*)(ws + WS_DT), (bf16_t*)(ws + WS_KVRAW), args.in(I_DAQG), args.in(I_DAKG), (unsigned char*)(ws + WS_VF8)};
        pg8::gemm_phase<EpiP1, SchedP1, false, true>(F.lds + RING_OFF, 32, S, E);
        if (!conv_first) { __syncthreads(); conv_share(F, args); }
    }
    SEAM(1);
    if (IN(2)) { FRESH();
        if ((F.vcu & 3) == 1) {
            SchedP1 S{(F.G + 3) >> 2, F.vcu >> 2, ws, 32 * 23, 32 * 23 + 64};
            EpiP1 E{(bf16_t*)(ws + WS_PROJ), (float*)(ws + WS_DT), (bf16_t*)(ws + WS_KVRAW), args.in(I_DAQG), args.in(I_DAKG), (unsigned char*)(ws + WS_VF8)};
            pg8::gemm_phase<EpiP1, SchedP1, false, true>(F.lds + RING_OFF, 32, S, E);
            __syncthreads();
        }
        if ((F.vcu & 3) == 0) { for (int u = F.vcu >> 2; u < 64; u += (F.G + 3) >> 2) ssd_unit(F, args, u >> 4, u & 15); }
        __syncthreads();
        attn_phase_da(F);
        __syncthreads();
        conv_queue(F, args, CW_QCONV, CV_NJ - CV_TAIL, CV_TAIL1);
    }
    SEAM(2);
    if (IN(3)) { FRESH(); kprep(F, args); p3_finalize(F, args); }
    SEAM(3);
    if (IN(4)) { FRESH();
        SchedDense S{F.G, F.vcu, 32, 8, (const char*)(ws + WS_YCAT), (const char*)(ws + WS_WOUT), 4096u, 4096u, 1 << 30, 0};
        EpiResid<false> E{args.in(I_X), (bf16_t*)(ws + WS_H1), (float*)(ws + WS_PART1), (unsigned char*)(ws + WS_H1F8), 1.f};
        pg8::gemm_phase<EpiResid<false>, SchedDense, false, true>(F.lds + RING_OFF, 32, S, E);
    }
    SEAM(4);
    if (IN(5)) { FRESH();
        SchedDense S{F.G, F.vcu, 32, 8, (const char*)(ws + WS_H1F8), (const char*)(ws + WS_WQ), 2048u, 2048u, 1 << 30, 0};
        EpiQ E{(unsigned char*)(ws + WS_QF8), (float*)(ws + WS_PARTQ)};
        pg8::gemm_phase<EpiQ, SchedDense, false, true, true>(F.lds + RING_OFF, 16, S, E);
    }
    SEAM(5);
    if (IN(6)) { FRESH();
        SchedXS S{F.G, F.vcu, ws};
        EpiXS E{(unsigned char*)(ws + WS_P8), (unsigned char*)(ws + WS_VWT8), (const float*)(ws + WS_PART1), (const float*)(ws + WS_PARTQ), (LAS float*)(F.lds + RING_BYTES)};
        pg8::gemm_phase<EpiXS, SchedXS, false, true, true>(F.lds + RING_OFF, 4, S, E);
    }
    SEAM(6);
    if (IN(7)) { FRESH();
        SchedDense S{F.G, F.vcu, 32, 8, (const char*)(ws + WS_P8), (const char*)(ws + WS_VWT8), 1024u, 1024u, 8, (size_t)2048 * 1024};
        EpiResid<true> E{(const void*)(ws + WS_H1), (bf16_t*)(ws + WS_H2), nullptr, nullptr, 1.f / 8192.f};
        pg8::gemm_phase<EpiResid<true>, SchedDense, false, true, true>(F.lds + RING_OFF, 8, S, E);
    }
    SEAM(7);
    if (IN(8)) { FRESH(); p8_route(F, args); }
    SEAM(8);
    if (IN(9)) { FRESH();
        moe_tables(F);
        SchedMoe<16> S{F.G, F.vcu, ws, F.MISC, ldsu(F.MISC + 112) * 16};
        EpiMoe1 E{(unsigned char*)(ws + WS_ACT), args.in(I_B1)};
        pg8::gemm_phase<EpiMoe1, SchedMoe<16>, false, true, true>(F.lds + RING_OFF, 16, S, E);
        __syncthreads();
        conv_queue(F, args, CW_QCONV2, CV_NJ - CV_TAIL2, CV_TAIL2);
    }
    SEAM(9);
    if (IN(10)) { FRESH();
        moe_tables(F);
        SchedMoe<8> S{F.G, F.vcu, ws, F.MISC, ldsu(F.MISC + 112) * 8};
        EpiMoe2 E{(unsigned char*)(ws + WS_Y), args.in(I_B2), (const float*)(ws + WS_GATEOF)};
        pg8::gemm_phase<EpiMoe2, SchedMoe<8>, false, true, true>(F.lds + RING_OFF, 16, S, E);
    }
    SEAM(10);
    if (IN(11)) { FRESH(); p11_combine(F, args); }
#undef IN
#undef SEAM
}

extern "C" void kernel_launch(void* const* d_in, const int* in_sizes, int n_in, void* d_out, int out_size, void* d_ws, size_t ws_size, hipStream_t stream) {
    static int grid = 0;
    if (grid == 0) {
        if (n_in != 32 || out_size != NTOK * 2048 || ws_size < WS_END) { fprintf(stderr, "kernel_launch: unexpected shapes (n_in %d out %d ws %zu); nothing launched\n", n_in, out_size, ws_size); grid = -1; return; }
        int dev = 0, cus = 0, per_cu = 0;
        if (hipGetDevice(&dev) != hipSuccess || hipDeviceGetAttribute(&cus, hipDeviceAttributeMultiprocessorCount, dev) != hipSuccess) { grid = -1; return; }
        if (hipFuncSetAttribute((const void*)mega_fwd, hipFuncAttributeMaxDynamicSharedMemorySize, LDS_BYTES) != hipSuccess) { fprintf(stderr, "kernel_launch: hipFuncSetAttribute failed\n"); grid = -1; return; }
        if (hipOccupancyMaxActiveBlocksPerMultiprocessor(&per_cu, (const void*)mega_fwd, NWAVES * 64, LDS_BYTES) != hipSuccess || per_cu < 1) { fprintf(stderr, "kernel_launch: occupancy query says %d\n", per_cu); }
        (void)hipGetLastError();
        if (cus < 256) { fprintf(stderr, "kernel_launch: needs 256 CUs, found %d; nothing launched\n", cus); grid = -1; return; }
        grid = 256;
    }
    if (grid < 0) return;
    if (hipMemsetAsync((char*)d_ws + WS_CTL, 0, CTL_ZERO_BYTES, stream) != hipSuccess) return;
    Args a{};
    for (int i = 0; i < 32; ++i) a.in[i] = (const float*)d_in[i];
    a.out = (float*)d_out; a.ws = (unsigned char*)d_ws;
#if MK_PER_PHASE
    for (int p = 0; p < N_PHASES; ++p) { a.ph_lo = p; a.ph_hi = p + 1; hipLaunchKernelGGL(mega_fwd, dim3(grid), dim3(NWAVES * 64), LDS_BYTES, stream, a); }
#else
    a.ph_lo = 0; a.ph_hi = N_PHASES;
    hipLaunchKernelGGL(mega_fwd, dim3(grid), dim3(NWAVES * 64), LDS_BYTES, stream, a);
#ifdef MK_PROBE_LO
    for (int p = MK_PROBE_LO; p < MK_PROBE_HI; ++p) { a.ph_lo = p; a.ph_hi = p + 1;
        if (p == 2) (void)hipMemsetAsync((char*)d_ws + WS_CTL + CW_QATT * 4, 0, 1024, stream);
        hipLaunchKernelGGL(mega_fwd, dim3(grid), dim3(NWAVES * 64), LDS_BYTES, stream, a); }
#endif
#endif
}
```

```cpp
#define MK_PER_PHASE 0
#define MK_LAST_PHASE 12
#include <hip/hip_runtime.h>
#include <hip/hip_bf16.h>
#include <cstdio>
#include <cstdint>
#include <cmath>

#define GAS __attribute__((address_space(1)))
#define LAS __attribute__((address_space(3)))
typedef unsigned short bf16_t;
typedef short bf16x8 __attribute__((ext_vector_type(8)));
typedef float f32x2 __attribute__((ext_vector_type(2)));
typedef float f32x4 __attribute__((ext_vector_type(4)));
typedef float f32x16 __attribute__((ext_vector_type(16)));
typedef unsigned u32x2 __attribute__((ext_vector_type(2)));
typedef unsigned u32x4 __attribute__((ext_vector_type(4)));
typedef __bf16 bf16x2_t __attribute__((ext_vector_type(2)));

#define DI __device__ __forceinline__
DI unsigned pk2(float lo, float hi) { f32x2 v = {lo, hi}; bf16x2_t b = __builtin_convertvector(v, bf16x2_t); return __builtin_bit_cast(unsigned, b); }
DI float bflo(unsigned u) { return __uint_as_float(u << 16); }
DI float bfhi(unsigned u) { return __uint_as_float(u & 0xffff0000u); }
DI float bf2f(bf16_t h) { return __uint_as_float(((unsigned)h) << 16); }
DI float wave_sum(float v) {
#pragma unroll
    for (int o = 1; o < 64; o <<= 1) v += __shfl_xor(v, o);
    return v;
}
DI float quad_sum_16_32(float v) {
    int l_ = threadIdx.x; asm volatile("" : "+v"(l_));
    const int a16 = ((l_ ^ 16) & 63) << 2, a32 = ((l_ ^ 32) & 63) << 2;
    v += __builtin_bit_cast(float, __builtin_amdgcn_ds_bpermute(a16, __builtin_bit_cast(int, v)));
    v += __builtin_bit_cast(float, __builtin_amdgcn_ds_bpermute(a32, __builtin_bit_cast(int, v)));
    return v;
}
DI float siluf(float x) { return x / (1.f + __expf(-x)); }

constexpr int DM_ = 2048, NB = 4, SEQ_ = 2048, NTOK = NB * SEQ_;
constexpr int PP = 5632;
constexpr int PC_XBC = 1024, PC_Q = 2560, PC_K = 3584, PC_V = 4608, PC_DT = 5632;
constexpr int WIN_ROWS = 5888;
constexpr int NEXP = 32, MEMLEN = 256;
constexpr float EPS_ = 1e-6f;
constexpr float LAM_INIT = 0.2f;

namespace pg8 {
constexpr int BM = 256, BK = 64, HALF = 128, HTB = HALF * BK * 2  , STAGE_BYTES = 8 * HTB;
DI int lds_byte(int r, int c) { const int st = (r >> 4) * 2 + (c >> 5), rr = r & 15, cc = c & 31, ob = rr * 64 + cc * 2; return st * 1024 + (ob ^ (((ob >> 9) & 1) << 5)); }
DI void stage_rc(int b, int& R, int& C) { const int st = b / 1024, sb = b % 1024, swz = sb ^ (((sb >> 9) & 1) << 5); R = (st >> 1) * 16 + swz / 64; C = (st & 1) * 32 + (swz % 64) / 2; }
DI int perm32(int rho) { const int n = rho >> 4, i = rho & 15; return 8 * (i >> 2) + 4 * n + (i & 3); }

struct UnitD {
    const char* A; const char* B;
    const int* rows;
    unsigned lda, ldb;
    int nvalid;
    int type, pm, pn, e, x0;
};
typedef int v8i_t __attribute__((ext_vector_type(8)));
DI v8i_t cat8(bf16x8 lo, bf16x8 hi) { typedef int v4i_t __attribute__((ext_vector_type(4))); const v4i_t a = __builtin_bit_cast(v4i_t, lo), b = __builtin_bit_cast(v4i_t, hi); return (v8i_t){a[0], a[1], a[2], a[3], b[0], b[1], b[2], b[3]}; }
DI void dense_voff(unsigned lda, unsigned ldb, int tid, unsigned (&vA)[2], unsigned (&vB)[2]) {
#pragma unroll
    for (int i = 0; i < 2; ++i) { int R, C; stage_rc(tid * 16 + i * 8192, R, C); const int Rb = (R & ~31) + perm32(R & 31);
        vA[i] = (unsigned)R * lda + (unsigned)C * 2u; vB[i] = (unsigned)Rb * ldb + (unsigned)C * 2u; }
}
DI void gather_voff(const UnitD& u, int tid, unsigned (&gA)[2][2]) {
#pragma unroll
    for (int i = 0; i < 2; ++i) { int R, C; stage_rc(tid * 16 + i * 8192, R, C);
#pragma unroll
        for (int h = 0; h < 2; ++h) { const int ra = h * 128 + R; const unsigned rowA = (ra < u.nvalid) ? (unsigned)u.rows[ra] : 0u; gA[h][i] = rowA * u.lda + (unsigned)C * 2u; } }
}

template <class Epi, class Sched, bool GATHER, bool ALIGN_EPI, bool FP8 = false>
DI void gemm_phase(LAS unsigned char* lds, int nt, const Sched& S, const Epi& E) {

    const int tid = threadIdx.x, wid = __builtin_amdgcn_readfirstlane(tid >> 6), lane = tid & 63, wr = wid >> 2, wc = wid & 3, fr = lane & 15, fq = lane >> 4;
    const size_t kstep = (size_t)(BK * 2);
    const unsigned ldsb = (unsigned)__builtin_amdgcn_readfirstlane((int)((unsigned)(uintptr_t)lds + (unsigned)wid * 1024u));
    const int aoff = lds_byte(wr * 64 + fr, fq * 8), boff = lds_byte(wc * 32 + fr, fq * 8);
#define PG8_SA(b, h) (((b) * 2 + (h)) * HTB)
#define PG8_SB(b, h) ((4 + (b) * 2 + (h)) * HTB)
#define PG8_STAGE(bufoff, gbase, voff) do { _Pragma("unroll") for (int _i = 0; _i < 2; ++_i) { unsigned keep_; \
        asm volatile("s_mov_b32 %0, m0\n\ts_mov_b32 m0, %3\n\ts_nop 0\n\tglobal_load_lds_dwordx4 %1, %2\n\ts_mov_b32 m0, %0" \
                     : "=&s"(keep_) : "v"((voff)[_i]), "s"((const char*)(gbase)), "s"(ldsb + (unsigned)((bufoff) + _i * 8192)) : "memory"); } } while (0)
#define PG8_STA(bufoff, gbase, h, HS, GA) do { if constexpr (GATHER) { PG8_STAGE(bufoff, gbase, GA[h]); } else { PG8_STAGE(bufoff, (gbase) + (h) * (HS), vA); } } while (0)
#define PG8_STB(bufoff, gbase, h, HS) PG8_STAGE(bufoff, (gbase) + (h) * (HS), vB)
typedef int v4i_t __attribute__((ext_vector_type(4)));
#define PG8_LDA(dst, b, h) do { _Pragma("unroll") for (int m = 0; m < 4; ++m) { if constexpr (FP8) { \
            const v4i_t lo_ = *(const LAS v4i_t*)(lds + PG8_SA(b, h) + aoff + m * 2048), hi_ = *(const LAS v4i_t*)(lds + PG8_SA(b, h) + aoff + m * 2048 + 1024); \
            dst##8[m] = __builtin_shufflevector(lo_, hi_, 0, 1, 2, 3, 4, 5, 6, 7); } \
        else { _Pragma("unroll") for (int k = 0; k < 2; ++k) dst[m][k] = *(const LAS bf16x8*)(lds + PG8_SA(b, h) + aoff + m * 2048 + k * 1024); } } } while (0)
#define PG8_LDB(dst, b, h) do { _Pragma("unroll") for (int n = 0; n < 2; ++n) { if constexpr (FP8) { \
            const v4i_t lo_ = *(const LAS v4i_t*)(lds + PG8_SB(b, h) + boff + n * 2048), hi_ = *(const LAS v4i_t*)(lds + PG8_SB(b, h) + boff + n * 2048 + 1024); \
            dst##8[n] = __builtin_shufflevector(lo_, hi_, 0, 1, 2, 3, 4, 5, 6, 7); } \
        else { _Pragma("unroll") for (int k = 0; k < 2; ++k) dst[n][k] = *(const LAS bf16x8*)(lds + PG8_SB(b, h) + boff + n * 2048 + k * 1024); } } } while (0)
#ifndef PG8_FP8_PRIO
#define PG8_FP8_PRIO 1
#endif
#define PG8_MMA(ai, bj, At, Bt) do { if (!FP8 || PG8_FP8_PRIO) __builtin_amdgcn_s_setprio(1); _Pragma("unroll") for (int m = 0; m < 4; ++m) _Pragma("unroll") for (int n = 0; n < 2; ++n) { \
        if constexpr (FP8) { acc[ai][bj][m][n] = __builtin_amdgcn_mfma_scale_f32_16x16x128_f8f6f4(Bt##8[n], At##8[m], acc[ai][bj][m][n], 0, 0, 0, 0x7f7f7f7f, 0, 0x7f7f7f7f); } \
        else { _Pragma("unroll") for (int k = 0; k < 2; ++k) acc[ai][bj][m][n] = __builtin_amdgcn_mfma_f32_16x16x32_bf16(Bt[n][k], At[m][k], acc[ai][bj][m][n], 0, 0, 0); } } \
        if (!FP8 || PG8_FP8_PRIO) __builtin_amdgcn_s_setprio(0); } while (0)
#define PG8_WAIT_V(n) asm volatile("s_waitcnt vmcnt(" #n ")" ::: "memory")
#define PG8_WAIT_L(n) asm volatile("s_waitcnt lgkmcnt(" #n ")" ::: "memory")
#define PG8_BAR __builtin_amdgcn_s_barrier()
#define PG8_SCHED __builtin_amdgcn_sched_barrier(0)
#define PG8_ITER(A1P, A2P, B2P, HA2, HB2, GA2) do { \
        const char* a3p_ = (A2P) + kstep; const char* b3p_ = (B2P) + kstep; \
        PG8_LDB(B0, 0, 0); PG8_LDB(B1, 0, 1); PG8_SCHED; PG8_LDA(At, 0, 0); PG8_STA(PG8_SA(1, 1), (A1P), 1, hsA, gA); \
        PG8_WAIT_V(8); PG8_WAIT_L(0); PG8_BAR; PG8_MMA(0, 0, At, B0); PG8_MMA(0, 1, At, B1); PG8_BAR; PG8_SCHED; \
        PG8_LDA(At, 0, 1); PG8_STB(PG8_SB(0, 0), (B2P), 0, HB2); PG8_STB(PG8_SB(0, 1), (B2P), 1, HB2); PG8_STA(PG8_SA(0, 0), (A2P), 0, HA2, GA2); \
        PG8_WAIT_V(8); PG8_WAIT_L(0); PG8_BAR; PG8_MMA(1, 0, At, B0); PG8_MMA(1, 1, At, B1); PG8_BAR; PG8_SCHED; \
        PG8_LDB(B0, 1, 0); PG8_LDB(B1, 1, 1); PG8_SCHED; PG8_LDA(At, 1, 0); PG8_STA(PG8_SA(0, 1), (A2P), 1, HA2, GA2); \
        PG8_WAIT_V(8); PG8_WAIT_L(0); PG8_BAR; PG8_MMA(0, 0, At, B0); PG8_MMA(0, 1, At, B1); PG8_BAR; PG8_SCHED; \
        PG8_LDA(At, 1, 1); PG8_STB(PG8_SB(1, 0), b3p_, 0, HB2); PG8_STB(PG8_SB(1, 1), b3p_, 1, HB2); PG8_STA(PG8_SA(1, 0), a3p_, 0, HA2, GA2); \
        PG8_WAIT_V(8); PG8_WAIT_L(0); PG8_BAR; PG8_MMA(1, 0, At, B0); PG8_MMA(1, 1, At, B1); PG8_BAR; PG8_SCHED; \
    } while (0)
    UnitD cur, nxt; int ui = 0;
    if (!S.next(0, cur)) return;
    f32x4 acc[2][2][4][2];
#pragma unroll
    for (int a = 0; a < 2; ++a)
#pragma unroll
        for (int b = 0; b < 2; ++b)
#pragma unroll
            for (int m = 0; m < 4; ++m)
#pragma unroll
                for (int n = 0; n < 2; ++n) acc[a][b][m][n] = (f32x4){0.f, 0.f, 0.f, 0.f};
    bf16x8 At[4][2], B0[2][2], B1[2][2]; v8i_t At8[4], B08[2], B18[2];
    unsigned vA[2], vB[2], gA[2][2], ngA[2][2];
    dense_voff(cur.lda, cur.ldb, tid, vA, vB);
    if constexpr (GATHER) gather_voff(cur, tid, gA);
    const char* cA = cur.A; const char* cB = cur.B;
    size_t hsA = GATHER ? 0 : (size_t)cur.lda * HALF, hsB = (size_t)cur.ldb * HALF;
    PG8_STB(PG8_SB(0, 0), cB, 0, hsB); PG8_STB(PG8_SB(0, 1), cB, 1, hsB); PG8_STA(PG8_SA(0, 0), cA, 0, hsA, gA); PG8_STA(PG8_SA(0, 1), cA, 1, hsA, gA);
    if (wr == 1) PG8_BAR;
    PG8_WAIT_V(2); PG8_BAR;
    PG8_STB(PG8_SB(1, 0), cB + kstep, 0, hsB); PG8_STA(PG8_SA(1, 0), cA + kstep, 0, hsA, gA); PG8_STB(PG8_SB(1, 1), cB + kstep, 1, hsB);
    PG8_WAIT_V(6); PG8_BAR;
    for (;;) {
        const bool has_next = S.next(ui + 1, nxt);
        const char* nA = cA; const char* nB = cB; size_t nhsA = hsA, nhsB = hsB;
        if (has_next) { nA = nxt.A; nB = nxt.B; nhsA = GATHER ? 0 : (size_t)nxt.lda * HALF; nhsB = (size_t)nxt.ldb * HALF; }
        if constexpr (GATHER) {
            if (has_next) gather_voff(nxt, tid, ngA);
            else {
#pragma unroll
                for (int h = 0; h < 2; ++h)
#pragma unroll
                    for (int i = 0; i < 2; ++i) ngA[h][i] = gA[h][i];
            }
        }
#pragma unroll 1
        for (int t = 0; t < nt; t += 2) {
            const bool last = (t == nt - 2);
            const char* a2 = last ? nA : cA + (size_t)(t + 2) * kstep; const char* b2 = last ? nB : cB + (size_t)(t + 2) * kstep;
            const size_t hA2 = last ? nhsA : hsA, hB2 = last ? nhsB : hsB;
            unsigned g2[2][2];
            if constexpr (GATHER) {
#pragma unroll
                for (int h = 0; h < 2; ++h)
#pragma unroll
                    for (int i = 0; i < 2; ++i) g2[h][i] = last ? ngA[h][i] : gA[h][i];
            }
            PG8_ITER(cA + (size_t)(t + 1) * kstep, a2, b2, hA2, hB2, g2);
        }
        if constexpr (ALIGN_EPI) { if (wr == 0) PG8_BAR; }
        if constexpr (!Epi::AFTER_DRAIN) { E(acc, cur, wr, wc, fr, fq); }
        if (!has_next) break;
#pragma unroll
        for (int a = 0; a < 2; ++a)
#pragma unroll
            for (int b = 0; b < 2; ++b)
#pragma unroll
                for (int m = 0; m < 4; ++m)
#pragma unroll
                    for (int n = 0; n < 2; ++n) acc[a][b][m][n] = (f32x4){0.f, 0.f, 0.f, 0.f};
        cur = nxt; cA = nA; cB = nB; hsA = nhsA; hsB = nhsB; ++ui;
        if constexpr (GATHER) {
#pragma unroll
            for (int h = 0; h < 2; ++h)
#pragma unroll
                for (int i = 0; i < 2; ++i) gA[h][i] = ngA[h][i];
        }
        if constexpr (ALIGN_EPI) { if (wr == 1) PG8_BAR; }
    }
    PG8_WAIT_V(0);
    if constexpr (!ALIGN_EPI) { if (wr == 0) PG8_BAR; }
    PG8_BAR;
    if constexpr (Epi::AFTER_DRAIN) { E.fused(acc, cur, wr, wc, fr, fq, lds, wid, lane); }
#undef PG8_SA
#undef PG8_SB
#undef PG8_STAGE
#undef PG8_STA
#undef PG8_STB
#undef PG8_LDA
#undef PG8_LDB
#undef PG8_MMA
#undef PG8_WAIT_V
#undef PG8_WAIT_L
#undef PG8_BAR
#undef PG8_SCHED
#undef PG8_ITER
}
}
namespace attn_body {
using bf16=__hip_bfloat16;
using bf16x8=__attribute__((ext_vector_type(8)))short;
using s16x4=__attribute__((ext_vector_type(4)))short;
using f32x16=__attribute__((ext_vector_type(16)))float;
using u32x4=__attribute__((ext_vector_type(4)))unsigned;
constexpr int BATCH=4,SEQ=2048,D=64,DM=5632,OPITCH=1024;
constexpr int NW=8,QBLK=32,QB=QBLK*NW,KVBLK=64,NQB=SEQ/QB;
constexpr int ATTN_UNIT_ROWS=QB;
__device__ __forceinline__ int crow(int r,int hi){return (r&3)+8*(r>>2)+4*hi;}
#define SBAR() __builtin_amdgcn_sched_barrier(0)
__device__ __forceinline__ void cmask(f32x16&p0,f32x16&p1,int jb,int qrel,int hi){
  const float NEG=-INFINITY; int kb=64*jb+4*hi;
  #pragma unroll
  for(int r=0;r<16;++r){int kv=kb+(r&3)+8*(r>>2); if(kv>qrel)p0[r]=NEG; if(kv+32>qrel)p1[r]=NEG;}
}

constexpr int NSLOT=3, SLOTB=8192;
constexpr int LDS_K=0, LDS_V=NSLOT*SLOTB, LDS_WS=2*NSLOT*SLOTB, LDS_OST=LDS_WS+NW*64*4, LDS_BYTES=LDS_OST+NW*4096;
constexpr float C2=0.125f*1.4426950408889634f;
__device__ __forceinline__ void glds16(const void*gsrc,unsigned lds_dst){unsigned keep;
  asm volatile("s_mov_b32 %0, m0\n\ts_mov_b32 m0, %2\n\ts_nop 0\n\tglobal_load_lds_dwordx4 %1, off\n\ts_mov_b32 m0, %0":"=&s"(keep):"v"(gsrc),"s"(lds_dst):"memory");}
__device__ __forceinline__ float max3f(float a,float b,float c){float r;asm("v_max3_f32 %0, %1, %2, %3":"=v"(r):"v"(a),"v"(b),"v"(c));return r;}
__device__ __forceinline__ float max2f(float a,float b){float r;asm("v_max_f32_e32 %0, %1, %2":"=v"(r):"v"(a),"v"(b));return r;}
__device__ __forceinline__ float fadd_s(float a,float b){float r;asm("v_add_f32_e32 %0, %1, %2":"=v"(r):"v"(a),"v"(b));return r;}
__device__ __forceinline__ float fsub_s(float a,float b){float r;asm("v_sub_f32_e32 %0, %1, %2":"=v"(r):"v"(a),"v"(b));return r;}
typedef float f32x2_t __attribute__((ext_vector_type(2))); typedef __bf16 bf16x2_t __attribute__((ext_vector_type(2)));
__device__ __forceinline__ unsigned cvtpk_s(float lo,float hi){f32x2_t v={lo,hi};bf16x2_t b=__builtin_convertvector(v,bf16x2_t);return __builtin_bit_cast(unsigned,b);}
#define WAIT_BAR(N) asm volatile("s_waitcnt vmcnt(" #N ") lgkmcnt(0)\n\ts_barrier":::"memory")

__device__ __forceinline__ void qkt(f32x16&p0,f32x16&p1,const char*Kslot,const bf16x8*qr,const f32x16&negm,int r32,int hi){
  const char*kb=Kslot+hi*1024+r32*16;
  #pragma unroll
  for(int d0=0;d0<4;++d0){
    const bf16x8 b0=*reinterpret_cast<const bf16x8*>(kb+d0*2048);
    const bf16x8 b1=*reinterpret_cast<const bf16x8*>(kb+d0*2048+512);
    if(d0==0){p0=__builtin_amdgcn_mfma_f32_32x32x16_bf16(b0,qr[0],negm,0,0,0);p1=__builtin_amdgcn_mfma_f32_32x32x16_bf16(b1,qr[0],negm,0,0,0);}
    else{p0=__builtin_amdgcn_mfma_f32_32x32x16_bf16(b0,qr[d0],p0,0,0,0);p1=__builtin_amdgcn_mfma_f32_32x32x16_bf16(b1,qr[d0],p1,0,0,0);}}
}
typedef __attribute__((address_space(3))) const char* lds_cptr;
typedef short v4i16_t __attribute__((ext_vector_type(4)));
__device__ __forceinline__ void kload8(bf16x8*kf,lds_cptr kp){
  kf[0]=*(const __attribute__((address_space(3))) bf16x8*)(kp);      kf[1]=*(const __attribute__((address_space(3))) bf16x8*)(kp+512);
  kf[2]=*(const __attribute__((address_space(3))) bf16x8*)(kp+2048); kf[3]=*(const __attribute__((address_space(3))) bf16x8*)(kp+2560);
  kf[4]=*(const __attribute__((address_space(3))) bf16x8*)(kp+4096); kf[5]=*(const __attribute__((address_space(3))) bf16x8*)(kp+4608);
  kf[6]=*(const __attribute__((address_space(3))) bf16x8*)(kp+6144); kf[7]=*(const __attribute__((address_space(3))) bf16x8*)(kp+6656);
}
__device__ __forceinline__ void kload2(bf16x8*kf,lds_cptr kp,int j){ kf[2*j]=*(const __attribute__((address_space(3))) bf16x8*)(kp+j*2048); kf[2*j+1]=*(const __attribute__((address_space(3))) bf16x8*)(kp+j*2048+512); }
__device__ __forceinline__ s16x4 vtr(lds_cptr p){ return __builtin_bit_cast(s16x4,__builtin_amdgcn_ds_read_tr16_b64_v4i16((__attribute__((address_space(3))) v4i16_t*)p)); }
__device__ __forceinline__ float rowmax(const f32x16&p0,const f32x16&p1){
  float a=max3f(p0[0],p0[1],p1[0]),b=max3f(p0[2],p0[3],p1[1]);a=max3f(a,p1[2],p1[3]);
  #pragma unroll
  for(int r=4;r<16;r+=4){a=max3f(a,p0[r],p0[r+1]);b=max3f(b,p0[r+2],p0[r+3]);a=max3f(a,p1[r],p1[r+1]);b=max3f(b,p1[r+2],p1[r+3]);}
  const float m=max2f(a,b);
  auto rr=__builtin_amdgcn_permlane32_swap(__float_as_uint(m),__float_as_uint(m),false,false);
  return max2f(__uint_as_float(rr[0]),__uint_as_float(rr[1]));
}
__device__ __forceinline__ void pv(f32x16*o,int vb,bf16x8 pa0,bf16x8 pa1,bf16x8 pa2,bf16x8 pa3){
  #pragma unroll
  for(int d0=0;d0<2;++d0){s16x4 lo[4],hi[4];
    #pragma unroll
    for(int ks=0;ks<4;++ks){
      asm volatile("ds_read_b64_tr_b16 %0,%1 offset:%c2":"=&v"(lo[ks]):"v"(vb),"i"(d0*4096+ks*1024):"memory");
      asm volatile("ds_read_b64_tr_b16 %0,%1 offset:%c2":"=&v"(hi[ks]):"v"(vb),"i"(d0*4096+ks*1024+512):"memory");}
    asm volatile("s_waitcnt lgkmcnt(0)":::"memory");SBAR();
    #define PK(k) (bf16x8){lo[k][0],lo[k][1],lo[k][2],lo[k][3],hi[k][0],hi[k][1],hi[k][2],hi[k][3]}
    o[d0]=__builtin_amdgcn_mfma_f32_32x32x16_bf16(pa0,PK(0),o[d0],0,0,0);
    o[d0]=__builtin_amdgcn_mfma_f32_32x32x16_bf16(pa1,PK(1),o[d0],0,0,0);
    o[d0]=__builtin_amdgcn_mfma_f32_32x32x16_bf16(pa2,PK(2),o[d0],0,0,0);
    o[d0]=__builtin_amdgcn_mfma_f32_32x32x16_bf16(pa3,PK(3),o[d0],0,0,0);
    #undef PK
  }
}

#ifndef ATTN_STORE16
#define ATTN_STORE16(p,v) (*(u32x4*)(p)=(v))
#endif
template<int THRL> __device__ __forceinline__ void attn_unit(int b,int qcol,int vcol,int ocol,int qb,const bf16*Q,const bf16*__restrict__ K,const bf16*__restrict__ V,bf16*O,char*shm){
  const int tid=threadIdx.x,lane=tid&63,r32=lane&31,hi=lane>>5; const int wid=__builtin_amdgcn_readfirstlane(tid>>6);
  const long rowbase=(long)b*SEQ; const int q0=qb*QB;
  const bf16*Qw=Q+(rowbase+q0+wid*QBLK)*DM+qcol;
  const bf16*Kh=K+rowbase*DM+qcol,*Vh=V+rowbase*DM+vcol;
  const unsigned lds0=(unsigned)(uintptr_t)shm;
  float*wsf=(float*)(shm+LDS_WS)+wid*64;
  const bf16*ksrc=Kh+(long)lane*DM+wid*8;
  const bf16*vsrc=Vh+(long)(16*(wid&3)+(lane>>2))*DM+(wid>>2)*32+(lane&3)*8;
  const unsigned kdst=lds0+LDS_K+wid*1024, vdst=lds0+LDS_V+wid*1024;
  #define DMA_K(t,slot) glds16(ksrc+(long)(t)*KVBLK*DM,(unsigned)__builtin_amdgcn_readfirstlane(kdst+(slot)))
  #define DMA_V(t,slot) glds16(vsrc+(long)(t)*KVBLK*DM,(unsigned)__builtin_amdgcn_readfirstlane(vdst+(slot)))
  const int vb0=(int)(lds0+LDS_V)+((lane>>4)&1)*32+(lane&3)*8+(4*hi+((lane&15)>>2))*64;
  const char*Kbase=shm+LDS_K; bf16x8 kf[8];
  const lds_cptr shm3=(lds_cptr)shm; const lds_cptr kp0=shm3+LDS_K+hi*1024+r32*16; const lds_cptr vp0=shm3+LDS_V+((lane>>4)&1)*32+(lane&3)*8+(4*hi+((lane&15)>>2))*64;
  const int NT=(q0+QB)/KVBLK;
  DMA_K(0,0);DMA_V(0,0);DMA_K(1,SLOTB);
  bf16x8 qr[4];
  #pragma unroll
  for(int d0=0;d0<4;++d0)qr[d0]=*reinterpret_cast<const bf16x8*>(&Qw[(long)r32*DM+d0*16+hi*8]);
  float mhat=0.f,l_reg=0.f;f32x16 o[2];o[0]=f32x16{};o[1]=f32x16{};f32x16 negm=f32x16{};asm volatile("":"+v"(negm));
  const int qrel=wid*QBLK+r32;
  #define CMASK(P0,P1,t) do{int jb_=(t)-(NT-4); if(jb_>=0)cmask(P0,P1,jb_,qrel,hi);}while(0)
  bool resc=false;
  #define START(P0,P1) do{ const float rm=rowmax(P0,P1); resc=false; \
    { const float dl=rm; mhat=fadd_s(mhat,dl); \
      _Pragma("unroll") for(int r=0;r<16;++r){P0[r]=fsub_s(P0[r],dl);P1[r]=fsub_s(P1[r],dl);} \
      _Pragma("unroll") for(int r=0;r<16;++r)negm[r]=-mhat; asm volatile("":"+v"(negm)); } \
    _Pragma("unroll") for(int r=0;r<16;++r)P0[r]=__builtin_amdgcn_exp2f(P0[r]); }while(0)
  #define RESC() do{ if(resc){ asm volatile("s_waitcnt lgkmcnt(0)":::"memory"); \
      _Pragma("unroll") for(int d_=0;d_<2;++d_) _Pragma("unroll") for(int r=0;r<16;++r)o[d_][r]*=wsf[crow(r,hi)]; } }while(0)
  f32x16 pA0,pA1,pB0,pB1;
  int sl_prev=0,sl_cur=0,sl_next=SLOTB;
  #define ROT() do{sl_prev=sl_cur;sl_cur=sl_next;sl_next=(sl_next==(NSLOT-1)*SLOTB)?0:sl_next+SLOTB;}while(0)
  DMA_K(2,2*SLOTB);
  WAIT_BAR(3);
  qkt(pA0,pA1,Kbase,qr,negm,r32,hi);asm volatile("s_nop 15\n\ts_nop 7":"+v"(pA0),"+v"(pA1));CMASK(pA0,pA1,0);
  START(pA0,pA1);
  _Pragma("unroll") for(int r=0;r<16;++r)pA1[r]=__builtin_amdgcn_exp2f(pA1[r]);
  WAIT_BAR(0);
  DMA_K(3,0);DMA_V(1,SLOTB);
  ROT();
  kload8(kf,kp0+sl_cur);
  WAIT_BAR(2);
  s16x4 vlo[8],vhi[8]; u32x4 pw0,pw1,pw2,pw3;
  #define PKW(P,B) cvtpk_s(P[B],P[B+1])
  #define PAF(k) __builtin_bit_cast(bf16x8,pw##k)
  #define VFR(i) (bf16x8){vlo[i][0],vlo[i][1],vlo[i][2],vlo[i][3],vhi[i][0],vhi[i][1],vhi[i][2],vhi[i][3]}
  #define PIN(x) asm volatile("":"+v"(x))
  #define MX3(a,b,c) __builtin_fmaxf(__builtin_fmaxf((a),(b)),(c))
  #define GAPA(MF,A0,A1,A2,A3,W0,W1,PW) do{ MF; sacc+=A0; sacc+=A1; sacc+=A2; sacc+=A3; PIN(sacc); W0; W1; PIN(PW); SBAR(); }while(0)
  #define EX(v) __builtin_amdgcn_exp2f(v)
  #define GAPB(MF,X,B) do{ MF; X[B]=EX(X[B]); X[B+1]=EX(X[B+1]); X[B+2]=EX(X[B+2]); X[B+3]=EX(X[B+3]); PIN(X); SBAR(); }while(0)
  #define VRD(i) do{ vlo[i]=vtr(vp_+(((i)>>2)*4096+((i)&3)*1024)); vhi[i]=vtr(vp_+(((i)>>2)*4096+((i)&3)*1024+512)); }while(0)
  #define KRD(G,j) do{ if(G){ kload2(kf,kp0+sl_next,j); SBAR(); } }while(0)
  #define STEP(C0,C1,P0,P1,t,GK,GV,GL) do{ SBAR(); \
    const lds_cptr vp_=vp0+sl_prev; \
    VRD(0); SBAR(); float sacc=(P0[0]+P0[1]); \
    GAPA(C0=__builtin_amdgcn_mfma_f32_32x32x16_bf16(kf[0],qr[0],negm,0,0,0), P0[2],P0[3],P0[4],P0[5],     pw0[0]=PKW(P0,0), pw0[1]=PKW(P0,2), pw0); \
    VRD(4); SBAR(); GAPA(C1=__builtin_amdgcn_mfma_f32_32x32x16_bf16(kf[1],qr[0],negm,0,0,0), P0[6],P0[7],P0[8],P0[9],     pw0[2]=PKW(P0,4), pw0[3]=PKW(P0,6), pw0); \
    VRD(1); SBAR(); GAPA(C0=__builtin_amdgcn_mfma_f32_32x32x16_bf16(kf[2],qr[1],C0,0,0,0),   P0[10],P0[11],P0[12],P0[13], pw1[0]=PKW(P0,8), pw1[1]=PKW(P0,10), pw1); \
    VRD(5); SBAR(); GAPA(C1=__builtin_amdgcn_mfma_f32_32x32x16_bf16(kf[3],qr[1],C1,0,0,0),   P0[14],P0[15],P1[0],P1[1],   pw1[2]=PKW(P0,12),pw1[3]=PKW(P0,14), pw1); \
    VRD(2); SBAR(); GAPA(C0=__builtin_amdgcn_mfma_f32_32x32x16_bf16(kf[4],qr[2],C0,0,0,0),   P1[2],P1[3],P1[4],P1[5],     pw2[0]=PKW(P1,0), pw2[1]=PKW(P1,2), pw2); \
    VRD(6); SBAR(); GAPA(C1=__builtin_amdgcn_mfma_f32_32x32x16_bf16(kf[5],qr[2],C1,0,0,0),   P1[6],P1[7],P1[8],P1[9],     pw2[2]=PKW(P1,4), pw2[3]=PKW(P1,6), pw2); \
    VRD(3); SBAR(); GAPA(C0=__builtin_amdgcn_mfma_f32_32x32x16_bf16(kf[6],qr[3],C0,0,0,0),   P1[10],P1[11],P1[12],P1[13], pw3[0]=PKW(P1,8), pw3[1]=PKW(P1,10), pw3); \
    VRD(7); SBAR(); GAPA(C1=__builtin_amdgcn_mfma_f32_32x32x16_bf16(kf[7],qr[3],C1,0,0,0),   P1[14],P1[15],0.f,0.f,       pw3[2]=PKW(P1,12),pw3[3]=PKW(P1,14), pw3); \
    l_reg+=sacc; \
    if(GK){DMA_K((t)+3,sl_cur);} if(GV){DMA_V((t)+1,sl_next);} \
    CMASK(C0,C1,t); \
    { float a=MX3(C0[0],C0[1],C1[0]),b=MX3(C0[2],C0[3],C1[1]); a=MX3(a,C1[2],C1[3]); \
      _Pragma("unroll") for(int r=4;r<16;r+=4){a=MX3(a,C0[r],C0[r+1]);b=MX3(b,C0[r+2],C0[r+3]);a=MX3(a,C1[r],C1[r+1]);b=MX3(b,C1[r+2],C1[r+3]);} \
      float rm=__builtin_fmaxf(a,b); { auto rr=__builtin_amdgcn_permlane32_swap(__float_as_uint(rm),__float_as_uint(rm),false,false); rm=__builtin_fmaxf(__uint_as_float(rr[0]),__uint_as_float(rr[1])); } \
      resc=false; \
      if(__builtin_expect(__any(rm>(float)THRL),0)){ const float dl=__builtin_fmaxf(rm,0.f); mhat+=dl; \
        _Pragma("unroll") for(int r=0;r<16;++r){C0[r]-=dl;C1[r]-=dl;} \
        _Pragma("unroll") for(int r=0;r<16;++r)negm[r]=-mhat; asm volatile("":"+v"(negm)); \
        const float f=__builtin_amdgcn_exp2f(-dl); l_reg*=f; if(hi==0)wsf[r32]=f; resc=true; } } \
    SBAR(); \
    GAPB(o[0]=__builtin_amdgcn_mfma_f32_32x32x16_bf16(PAF(0),VFR(0),o[0],0,0,0), C0,0); \
    GAPB(o[1]=__builtin_amdgcn_mfma_f32_32x32x16_bf16(PAF(0),VFR(4),o[1],0,0,0), C0,4); \
    KRD(GL,0); GAPB(o[0]=__builtin_amdgcn_mfma_f32_32x32x16_bf16(PAF(1),VFR(1),o[0],0,0,0), C0,8); \
    KRD(GL,1); GAPB(o[1]=__builtin_amdgcn_mfma_f32_32x32x16_bf16(PAF(1),VFR(5),o[1],0,0,0), C0,12); \
    KRD(GL,2); GAPB(o[0]=__builtin_amdgcn_mfma_f32_32x32x16_bf16(PAF(2),VFR(2),o[0],0,0,0), C1,0); \
    KRD(GL,3); GAPB(o[1]=__builtin_amdgcn_mfma_f32_32x32x16_bf16(PAF(2),VFR(6),o[1],0,0,0), C1,4); \
    GAPB(o[0]=__builtin_amdgcn_mfma_f32_32x32x16_bf16(PAF(3),VFR(3),o[0],0,0,0), C1,8); \
    GAPB(o[1]=__builtin_amdgcn_mfma_f32_32x32x16_bf16(PAF(3),VFR(7),o[1],0,0,0), C1,12); \
    }while(0)
  int t=1;
  #undef CMASK
  #define CMASK(P0,P1,t) do{}while(0)
  for(;t+5<NT;t+=2){
    STEP(pB0,pB1,pA0,pA1,t,true,true,true);     WAIT_BAR(2); RESC(); ROT();
    STEP(pA0,pA1,pB0,pB1,t+1,true,true,true);   WAIT_BAR(2); RESC(); ROT();
  }
  #undef CMASK
  #define CMASK(P0,P1,t) do{int jb_=(t)-(NT-4); if(jb_>=0)cmask(P0,P1,jb_,qrel,hi);}while(0)
  #define ENDW(tt) do{ if((tt)+3<NT){WAIT_BAR(2);} else if((tt)+2<NT){WAIT_BAR(1);} else {WAIT_BAR(0);} }while(0)
  for(;t+1<NT;t+=2){
    STEP(pB0,pB1,pA0,pA1,t,(t+3<NT),(t+1<NT),(t+1<NT));       ENDW(t);   RESC(); ROT();
    STEP(pA0,pA1,pB0,pB1,t+1,(t+4<NT),(t+2<NT),(t+2<NT));     ENDW(t+1); RESC(); ROT();
  }
  STEP(pB0,pB1,pA0,pA1,NT-1,false,false,false); RESC();
  { float sacc=pB0[0]+pB0[1]; _Pragma("unroll") for(int r=2;r<16;++r)sacc+=pB0[r]; _Pragma("unroll") for(int r=0;r<16;++r)sacc+=pB1[r]; l_reg+=sacc;
    pw0=(u32x4){PKW(pB0,0),PKW(pB0,2),PKW(pB0,4),PKW(pB0,6)};pw1=(u32x4){PKW(pB0,8),PKW(pB0,10),PKW(pB0,12),PKW(pB0,14)};pw2=(u32x4){PKW(pB1,0),PKW(pB1,2),PKW(pB1,4),PKW(pB1,6)};pw3=(u32x4){PKW(pB1,8),PKW(pB1,10),PKW(pB1,12),PKW(pB1,14)};
    SBAR(); pv(o,vb0+sl_cur,PAF(0),PAF(1),PAF(2),PAF(3)); }
  #undef PKW
  #undef PAF
  #undef VFR
  #undef PIN
  #undef MX3
  #undef GAPA
  #undef GAPB
  #undef EX
  #undef VRD
  #undef KRD
  #undef STEP
  #undef ENDW
  {auto rr=__builtin_amdgcn_permlane32_swap(__float_as_uint(l_reg),__float_as_uint(l_reg),false,false);l_reg=__uint_as_float(rr[0])+__uint_as_float(rr[1]);}
  if(hi==0)wsf[32+r32]=l_reg;asm volatile("s_waitcnt lgkmcnt(0)":::"memory");
  float rli[16];
  #pragma unroll
  for(int r=0;r<16;++r)rli[r]=__builtin_amdgcn_rcpf(wsf[32+crow(r,hi)]);
  bf16*Ow=O+(rowbase+q0+wid*QBLK)*OPITCH+ocol;
  { bf16*stg=(bf16*)(shm+LDS_OST)+wid*2048;
    #pragma unroll
    for(int r=0;r<16;++r){const int orow=crow(r,hi);
      #pragma unroll
      for(int d0=0;d0<2;++d0)stg[orow*64+d0*32+r32]=__float2bfloat16(o[d0][r]*rli[r]);}
    asm volatile("s_waitcnt lgkmcnt(0)":::"memory");
    #pragma unroll
    for(int i=0;i<4;++i){const int row=i*8+(lane>>3),ch=lane&7; const u32x4 v=*(const u32x4*)(stg+row*64+ch*8); ATTN_STORE16(Ow+(long)row*OPITCH+ch*8,v);} }
  asm volatile("s_waitcnt lgkmcnt(0)\n\ts_barrier":::"memory");
  #undef DMA_K
  #undef DMA_V
  #undef CMASK
  #undef START
  #undef RESC
  #undef ROT
}
constexpr int ATTN_LDS_BYTES=LDS_BYTES;
#undef SBAR
#undef WAIT_BAR
}
constexpr size_t MiB = 1u << 20;
constexpr size_t WS_CTL = 0, CTL_ZERO_BYTES = 1 * MiB;
constexpr size_t WS_WIN = 2 * MiB, WS_WOUT = 26 * MiB, WS_WQ = 34 * MiB, WS_WKV = 42 * MiB, WS_WO = 58 * MiB, WS_W1 = 66 * MiB, WS_W2 = 578 * MiB;
constexpr size_t WS_HN = 834 * MiB, WS_MN = 866 * MiB, WS_PROJ = 870 * MiB, WS_DT = 958 * MiB, WS_KVRAW = 959 * MiB, WS_KN = 967 * MiB;
constexpr size_t WS_YCAT = 971 * MiB, WS_O0 = 1003 * MiB, WS_O1 = 1019 * MiB, WS_H1 = 1035 * MiB, WS_H1B = 1099 * MiB, WS_PART1 = 1131 * MiB, WS_PARTQ = 1132 * MiB;
constexpr size_t WS_QRAW = 1133 * MiB, WS_P = 1165 * MiB, WS_VWT = 1181 * MiB, WS_H2 = 1197 * MiB, WS_HN3 = 1261 * MiB;
constexpr size_t WS_TOKOF = 1293 * MiB, WS_GATEOF = 1294 * MiB, WS_TOKE = 1295 * MiB, WS_TOKR = 1296 * MiB, WS_YG = 1297 * MiB;
constexpr size_t WS_H1F8 = 3368 * MiB  , WS_QF8 = 3384 * MiB  , WS_KN8 = 3400 * MiB  , WS_VF8 = 3402 * MiB  ;
constexpr size_t WS_P8 = 3404 * MiB  , WS_VWT8 = 3412 * MiB  ;
constexpr size_t WS_XG = 1320 * MiB  , WS_ACT = 1832 * MiB  , WS_Y = 2344 * MiB  , WS_END = 3420 * MiB;
constexpr int CW_BAR = 4096;
constexpr int CW_QCONV2 = 12416;
constexpr int CW_QCONV = 12352;
constexpr int CW_QATT = 12288;
constexpr int CW_CNT = 8192;
static_assert((CW_CNT + 64 * 32) * 4 <= (int)CTL_ZERO_BYTES, "CTL words inside the memset region");

constexpr int RING_OFF = 0, RING_BYTES = 131072;
constexpr int LDS_BYTES = 163840;
constexpr int MISC_OFF = 163840 - 1024;
constexpr int NWAVES = 8;

#define XB_TMO      128
#define XB_XCNT(j)  (256  + 64 * (j))
#define XB_XSUB(j)  (1280 + 64 * (j))
#define XB_XGEN(j)  (2304 + 64 * (j))
#define XB_TOP      3328
#define XB_TOPGEN   3392
#define XCD_BAR_WORDS 3456
#define XB_SPIN_CAP (1u << 20)

__device__ __forceinline__ unsigned xb_ld(unsigned* p)              { return __hip_atomic_load(p, __ATOMIC_RELAXED, __HIP_MEMORY_SCOPE_AGENT); }
__device__ __forceinline__ unsigned xb_add(unsigned* p, unsigned v) { return __hip_atomic_fetch_add(p, v, __ATOMIC_RELAXED, __HIP_MEMORY_SCOPE_AGENT); }
__device__ __forceinline__ unsigned xb_xcc_id() { return (unsigned)__builtin_amdgcn_s_getreg((3 << 11) | 20) & 0xFu; }
#define XB_SPIN(cond, bar) do { unsigned _sp = 0; while (cond) { __builtin_amdgcn_s_sleep(1); \
    if ((++_sp & 255u) == 0u) { if (xb_ld(&(bar)[XB_TMO])) break; if (_sp > XB_SPIN_CAP) { atomicAdd(&(bar)[XB_TMO], 1u); break; } } } } while (0)

struct XcdBarrier {
    unsigned* bar; unsigned x;
    volatile LAS unsigned* st;
};
__device__ __forceinline__ XcdBarrier xcd_barrier_post(unsigned* bar, volatile LAS unsigned* st) {
    XcdBarrier b; b.bar = bar; b.x = xb_xcc_id(); b.st = st;
    if (threadIdx.x == 0) (void)xb_add(&bar[XB_XCNT(b.x)], 1u);
    return b;
}
__device__ __forceinline__ void xcd_barrier_complete(unsigned* bar, unsigned x, unsigned& nloc, unsigned& nx) {
    const unsigned G = gridDim.x * gridDim.y * gridDim.z;
    unsigned sum, cnt, mine, sp = 0u;
    for (;;) {
        sum = 0u; cnt = 0u; mine = 0u;
#pragma unroll
        for (unsigned j = 0; j < 16; ++j) { const unsigned c = xb_ld(&bar[XB_XCNT(j)]); sum += c; cnt += (c > 0u) ? 1u : 0u; mine = (j == x) ? c : mine; }
        if (sum == G) break;
        __builtin_amdgcn_s_sleep(1);
        if ((++sp & 255u) == 0u) { if (xb_ld(&bar[XB_TMO])) break; if (sp > XB_SPIN_CAP) { atomicAdd(&bar[XB_TMO], 1u); break; } }
    }
    nloc = mine > 0u ? mine : 1u; nx = cnt > 0u ? cnt : 1u;
}
__device__ __forceinline__ void xcd_barrier(const XcdBarrier& b) {
    asm volatile("s_waitcnt vmcnt(0)" ::: "memory");
    __syncthreads();
    if (threadIdx.x == 0) {
        unsigned* bar = b.bar;
        __builtin_amdgcn_s_waitcnt(0);
        unsigned nloc = b.st[0], nx = b.st[1];
        if (nloc == 0u) { xcd_barrier_complete(bar, b.x, nloc, nx); b.st[0] = nloc; b.st[1] = nx; }
        const unsigned old = xb_add(&bar[XB_XSUB(b.x)], 1u);
        const unsigned gen = old / nloc;
        if (old + 1u == (gen + 1u) * nloc) {
            __builtin_amdgcn_fence(__ATOMIC_RELEASE, "agent");
            asm volatile("s_waitcnt vmcnt(0)" ::: "memory");
            const unsigned og = xb_add(&bar[XB_TOP], 1u);
            const unsigned tg = og / nx;
            if (og + 1u == (tg + 1u) * nx) xb_add(&bar[XB_TOPGEN], 1u);
            else XB_SPIN(xb_ld(&bar[XB_TOPGEN]) == tg, bar);
            __builtin_amdgcn_fence(__ATOMIC_ACQUIRE, "agent");
            xb_add(&bar[XB_XGEN(b.x)], 1u);
            asm volatile("s_waitcnt vmcnt(0)" ::: "memory");
        } else {
            XB_SPIN(xb_ld(&bar[XB_XGEN(b.x)]) == gen, bar);
            __builtin_amdgcn_fence(__ATOMIC_ACQUIRE, "agent");
            asm volatile("s_waitcnt vmcnt(0)" ::: "memory");
        }
    }
    __syncthreads();
}

struct Args { const float* in[32]; float* out; unsigned char* ws; int ph_lo, ph_hi; };
enum In { I_X = 0, I_MEM, I_GMIX, I_WIN, I_CONVW, I_CONVB, I_DTB, I_ALOG, I_DSKIP, I_SSDG, I_DAQG, I_DAKG, I_LQ1, I_LK1, I_LQ2, I_LK2, I_SUBG, I_WOUT, I_GXA, I_GMEM,
          I_WQ, I_WKV, I_XQG, I_XKG, I_WO, I_GFFN, I_RW, I_RB, I_W1, I_B1, I_W2, I_B2 };

struct ArgP {
    typedef const __attribute__((address_space(4))) char* kptr;
    DI const float* in(int i) const { kptr kp = (kptr)__builtin_amdgcn_kernarg_segment_ptr(); asm volatile("" : "+s"(kp)); return *(const float* const __attribute__((address_space(4)))*)(kp + 8 * i); }
    DI float* out() const { kptr kp = (kptr)__builtin_amdgcn_kernarg_segment_ptr(); asm volatile("" : "+s"(kp)); return *(float* const __attribute__((address_space(4)))*)(kp + 8 * 32); }
};
struct Frame {
    LAS unsigned char* lds;
    volatile LAS unsigned* MISC;
    unsigned* ctl;
    unsigned char* ws;
    int tid, lane, wave, vcu, G;
};

template <class DestRow>
DI void tr_item(const float* W, size_t ldw, int k0, int ncol0, int nvalid, const float* kscale, bf16_t* WT, int K, DestRow dr, LAS float* scr, int lane) {
    const int c = lane & 31;
#pragma unroll 8
    for (int i = 0; i < 32; ++i) { const int kk = 2 * i + (lane >> 5);
        float v = (c < nvalid) ? W[(size_t)(k0 + kk) * ldw + ncol0 + c] : 0.f;
        if (kscale) v *= kscale[k0 + kk];
        scr[kk * 33 + c] = v; }
    asm volatile("s_waitcnt lgkmcnt(0)" ::: "memory");
    const int c8 = lane & 7;
#pragma unroll
    for (int j = 0; j < 4; ++j) { const int n = (lane >> 3) + 8 * j; const LAS float* s = scr + (8 * c8) * 33 + n;
        u32x4 o; o.x = pk2(s[0 * 33], s[1 * 33]); o.y = pk2(s[2 * 33], s[3 * 33]); o.z = pk2(s[4 * 33], s[5 * 33]); o.w = pk2(s[6 * 33], s[7 * 33]);
        if (n < nvalid) *(u32x4*)(WT + (size_t)dr(ncol0 + n) * K + k0 + 8 * c8) = o; }
    asm volatile("s_waitcnt lgkmcnt(0)" ::: "memory");
}
template <class DestRow>
DI void tr_item_fp8(const float* W, size_t ldw, int k0, int ncol0, const float* kscale, unsigned char* WT, int K, DestRow dr, LAS float* scr, int lane) {
    const int c = lane & 31;
#pragma unroll 8
    for (int i = 0; i < 32; ++i) { const int kk = 2 * i + (lane >> 5); float v = W[(size_t)(k0 + kk) * ldw + ncol0 + c]; if (kscale) v *= kscale[k0 + kk]; scr[kk * 33 + c] = v; }
    asm volatile("s_waitcnt lgkmcnt(0)" ::: "memory");
    const int n = lane >> 1, hf = lane & 1; const LAS float* s = scr + (32 * hf) * 33 + n;
    unsigned w[8];
#pragma unroll
    for (int j = 0; j < 8; ++j) { unsigned x = 0u;
        x = __builtin_amdgcn_cvt_pk_fp8_f32(s[(4 * j) * 33] * 64.f, s[(4 * j + 1) * 33] * 64.f, x, false);
        x = __builtin_amdgcn_cvt_pk_fp8_f32(s[(4 * j + 2) * 33] * 64.f, s[(4 * j + 3) * 33] * 64.f, x, true); w[j] = x; }
    unsigned char* op = WT + (size_t)dr(ncol0 + n) * K + k0 + 32 * hf;
    *(u32x4*)op = (u32x4){w[0], w[1], w[2], w[3]}; *(u32x4*)(op + 16) = (u32x4){w[4], w[5], w[6], w[7]};
    asm volatile("s_waitcnt lgkmcnt(0)" ::: "memory");
}
DI int tileperm(int col) { const int o = col & 255; return (col & ~255) + 128 * ((o & 63) >> 5) + 32 * (o >> 6) + (o & 31); }
struct DrIdent { DI int operator()(int n) const { return n; } };
struct DrTile  { DI int operator()(int n) const { return tileperm(n); } };
struct DrWin   { DI int operator()(int n) const { const int pc = (n < 2560) ? n : (n < 2576 ? PC_DT + (n - 2560) : n - 16); return tileperm(pc); } };
struct DrW1    { DI int operator()(int n) const { const int half = n >> 11, j = n & 2047; return (j >> 7) * 256 + half * 128 + (j & 127); } };

template <bool FP8, class DestRow>
DI void cv_item(const float* W, size_t ldw, int k0, int ncol0, const float* kscale, float scale, void* WT, int kpitch, DestRow dr, LAS float* scr, int lane) {
    const int r = lane >> 3, c4 = (lane & 7) * 4;
    f32x4 v[16];
#pragma unroll
    for (int i = 0; i < 16; ++i) v[i] = *(const f32x4*)(W + (size_t)(k0 + 8 * i + r) * ldw + ncol0 + c4);
#pragma unroll
    for (int i = 0; i < 16; ++i) { f32x4 x = v[i] * scale; if (kscale) x = x * kscale[k0 + 8 * i + r]; *(LAS f32x4*)(scr + (8 * i + r) * 36 + c4) = x; }
    asm volatile("s_waitcnt lgkmcnt(0)" ::: "memory");
    const int n = lane & 31, hf = lane >> 5; const LAS float* s = scr + (64 * hf) * 36 + n;
    if constexpr (FP8) {
        unsigned w[16];
#pragma unroll
        for (int j = 0; j < 16; ++j) { unsigned x = 0u; x = __builtin_amdgcn_cvt_pk_fp8_f32(s[(4 * j) * 36], s[(4 * j + 1) * 36], x, false); x = __builtin_amdgcn_cvt_pk_fp8_f32(s[(4 * j + 2) * 36], s[(4 * j + 3) * 36], x, true); w[j] = x; }
        unsigned char* op = (unsigned char*)WT + (size_t)dr(ncol0 + n) * kpitch + k0 + 64 * hf;
#pragma unroll
        for (int j = 0; j < 4; ++j) *(u32x4*)(op + 16 * j) = (u32x4){w[4 * j], w[4 * j + 1], w[4 * j + 2], w[4 * j + 3]};
    } else {
        unsigned w[32];
#pragma unroll
        for (int j = 0; j < 32; ++j) w[j] = pk2(s[(2 * j) * 36], s[(2 * j + 1) * 36]);
        unsigned char* op = (unsigned char*)WT + (size_t)dr(ncol0 + n) * kpitch + (k0 + 64 * hf) * 2;
#pragma unroll
        for (int j = 0; j < 8; ++j) *(u32x4*)(op + 16 * j) = (u32x4){w[4 * j], w[4 * j + 1], w[4 * j + 2], w[4 * j + 3]};
    }
    asm volatile("s_waitcnt lgkmcnt(0)" ::: "memory");
}
DI void rms_row_to_bf16(const float* xrow, const float* g, bf16_t* orow, int lane) {
    const f32x4* xr = (const f32x4*)xrow + lane;
    f32x4 v[8]; float s = 0.f;
#pragma unroll
    for (int j = 0; j < 8; ++j) { v[j] = xr[64 * j]; s += (v[j].x * v[j].x + v[j].y * v[j].y) + (v[j].z * v[j].z + v[j].w * v[j].w); }
    const float rstd = 1.f / sqrtf(wave_sum(s) * (1.f / 2048.f) + EPS_);
    u32x2* o8 = (u32x2*)orow + lane;
#pragma unroll
    for (int j = 0; j < 8; ++j) { const f32x4 gg = ((const f32x4*)g)[lane + 64 * j];
        u32x2 o; o.x = pk2(v[j].x * rstd * gg.x, v[j].y * rstd * gg.y); o.y = pk2(v[j].z * rstd * gg.z, v[j].w * rstd * gg.w); o8[64 * j] = o; }
}

DI void p0_prologue(Frame& F, const ArgP& a) {
    LAS float* scr = (LAS float*)(F.lds + RING_OFF + F.wave * 16384);
    const int gw = F.vcu * NWAVES + F.wave, NGW = F.G * NWAVES;
    unsigned char* ws = F.ws;
    constexpr int I_A = 32 * 80, I_B = 32, I_C = 32 * 96, NITEMS = I_A + I_B + I_C;
    for (int it = gw; it < NITEMS; it += NGW) {
        int r = it;
        if (r < I_A) { tr_item(a.in(I_WIN), 5648, 64 * (r / 80), 32 * (r % 80), 32, nullptr, (bf16_t*)(ws + WS_WIN), 2048, DrWin(), scr, F.lane); continue; } r -= I_A;
        if (r < I_B) { tr_item(a.in(I_WIN), 5648, 64 * r, 2560, 16, nullptr, (bf16_t*)(ws + WS_WIN), 2048, DrWin(), scr, F.lane); continue; } r -= I_B;
        tr_item(a.in(I_WIN), 5648, 64 * (r / 96), 2576 + 32 * (r % 96), 32, nullptr, (bf16_t*)(ws + WS_WIN), 2048, DrWin(), scr, F.lane);
    }
    for (int m = gw; m < NTOK; m += NGW) rms_row_to_bf16(a.in(I_X) + (size_t)m * 2048, a.in(I_GMIX), (bf16_t*)(ws + WS_HN) + (size_t)m * 2048, F.lane);
    for (int m = gw; m < NB * MEMLEN; m += NGW) rms_row_to_bf16(a.in(I_MEM) + (size_t)m * 2048, a.in(I_GMEM), (bf16_t*)(ws + WS_MN) + (size_t)m * 2048, F.lane);
}
struct CvIt { const float* W; size_t ldw; const float* ks; unsigned char* WT; float scale; int k0, n0, kpitch, fp8, dr; };
DI CvIt cv_decode(int it, const ArgP& a, unsigned char* ws) {
    constexpr int J_WOUT = 16 * 64, J_WKV = 16 * 128, J_WQ = 16 * 64, J_WO = 16 * 64, J_W1 = 32 * 16 * 128;
    CvIt c; c.ks = nullptr; c.scale = 64.f; c.fp8 = 1; c.dr = 0; c.kpitch = 2048; c.ldw = 2048;
    int r = it;
    if (r < J_WOUT) { c.W = a.in(I_WOUT); c.k0 = 128 * (r / 64); c.n0 = 32 * (r % 64); c.WT = ws + WS_WOUT; c.scale = 1.f; c.fp8 = 0; c.kpitch = 4096; return c; } r -= J_WOUT;
    if (r < J_WKV) { c.W = a.in(I_WKV); c.ldw = 4096; c.k0 = 128 * (r / 128); c.n0 = 32 * (r % 128); c.WT = ws + WS_WKV; c.scale = 1.f; c.fp8 = 0; c.kpitch = 4096; c.dr = 1; return c; } r -= J_WKV;
    if (r < J_WQ) { c.W = a.in(I_WQ); c.ks = a.in(I_GXA); c.k0 = 128 * (r / 64); c.n0 = 32 * (r % 64); c.WT = ws + WS_WQ; return c; } r -= J_WQ;
    if (r < J_WO) { c.W = a.in(I_WO); c.k0 = 128 * (r / 64); c.n0 = 32 * (r % 64); c.WT = ws + WS_WO; return c; } r -= J_WO;
    if (r < J_W1) { const int e = r / (16 * 128), q = r % (16 * 128); c.W = a.in(I_W1) + (size_t)e * 2048 * 4096; c.ldw = 4096; c.k0 = 128 * (q / 128); c.n0 = 32 * (q % 128); c.WT = ws + WS_W1 + (size_t)e * 4096 * 2048; c.dr = 2; return c; } r -= J_W1;
    { const int e = r / (16 * 64), q = r % (16 * 64); c.W = a.in(I_W2) + (size_t)e * 2048 * 2048; c.k0 = 128 * (q / 64); c.n0 = 32 * (q % 64); c.WT = ws + WS_W2 + (size_t)e * 2048 * 2048; }
    return c;
}
constexpr int CV_NJ = 16 * 64 * 3 + 16 * 128 + 32 * 16 * 128 + 32 * 16 * 64;
constexpr int CV_TAIL2 = 16384;
constexpr int CV_TAIL1 = 16384;
constexpr int CV_TAIL = CV_TAIL1 + CV_TAIL2;
DI void conv_share(Frame& F, const ArgP& a) {
    LAS float* scr = (LAS float*)(F.lds + F.wave * 16384);
    const unsigned sbase = (unsigned)__builtin_amdgcn_readfirstlane((int)((unsigned)(uintptr_t)F.lds + (unsigned)F.wave * 16384u));
    const int gw = F.vcu * NWAVES + F.wave, NGW = F.G * NWAVES, lane = F.lane;
    unsigned char* ws = F.ws;
    constexpr int NJ = CV_NJ - CV_TAIL;
    const int n = lane & 31, hf = lane >> 5;
    for (int it = gw; it < NJ; it += NGW) {
        const CvIt cur = cv_decode(it, a, ws);
        const char* gb = (const char*)(cur.W + (size_t)cur.k0 * cur.ldw + cur.n0);
        const unsigned vo0 = (unsigned)(((size_t)(lane >> 3) * cur.ldw + (size_t)(lane & 7) * 4) * 4), vstep = (unsigned)(8 * cur.ldw * 4);
#pragma unroll
        for (int p = 0; p < 16; ++p) { unsigned keep_;
            asm volatile("s_mov_b32 %0, m0\n\ts_mov_b32 m0, %3\n\ts_nop 0\n\tglobal_load_lds_dwordx4 %1, %2 nt\n\ts_mov_b32 m0, %0"
                         : "=&s"(keep_) : "v"(vo0 + (unsigned)p * vstep), "s"(gb), "s"(sbase + (unsigned)p * 1024u) : "memory"); }
        asm volatile("s_waitcnt vmcnt(0)" ::: "memory");
        const LAS float* s = scr + (64 * hf) * 32 + n;
        const int col = cur.n0 + n; const int drow = (cur.dr == 0) ? col : (cur.dr == 1 ? tileperm(col) : DrW1()(col));
        const float* ksp = cur.ks ? cur.ks + cur.k0 + 64 * hf : nullptr;
        if (cur.fp8) {
            unsigned w[16];
#pragma unroll
            for (int j = 0; j < 16; ++j) { float x0 = s[(4 * j) * 32] * cur.scale, x1 = s[(4 * j + 1) * 32] * cur.scale, x2 = s[(4 * j + 2) * 32] * cur.scale, x3 = s[(4 * j + 3) * 32] * cur.scale;
                if (ksp) { x0 *= ksp[4 * j]; x1 *= ksp[4 * j + 1]; x2 *= ksp[4 * j + 2]; x3 *= ksp[4 * j + 3]; }
                unsigned x = 0u; x = __builtin_amdgcn_cvt_pk_fp8_f32(x0, x1, x, false); x = __builtin_amdgcn_cvt_pk_fp8_f32(x2, x3, x, true); w[j] = x; }
            unsigned char* op = cur.WT + (size_t)drow * cur.kpitch + cur.k0 + 64 * hf;
#pragma unroll
            for (int j = 0; j < 4; ++j) *(u32x4*)(op + 16 * j) = (u32x4){w[4 * j], w[4 * j + 1], w[4 * j + 2], w[4 * j + 3]};
        } else {
            unsigned w[32];
#pragma unroll
            for (int j = 0; j < 32; ++j) w[j] = pk2(s[(2 * j) * 32] * cur.scale, s[(2 * j + 1) * 32] * cur.scale);
            unsigned char* op = cur.WT + (size_t)drow * cur.kpitch + (cur.k0 + 64 * hf) * 2;
#pragma unroll
            for (int j = 0; j < 8; ++j) *(u32x4*)(op + 16 * j) = (u32x4){w[4 * j], w[4 * j + 1], w[4 * j + 2], w[4 * j + 3]};
        }
        asm volatile("s_waitcnt lgkmcnt(0)" ::: "memory");
    }
}

DI void conv_queue(Frame& F, const ArgP& a, int qword, int first, int count) {
    LAS float* scr = (LAS float*)(F.lds + F.wave * 18432);
    unsigned char* ws = F.ws;
    const int lane = threadIdx.x & 63, r = lane >> 3, c4 = (lane & 7) * 4, n = lane & 31, hf = lane >> 5;
    for (;;) {
        if (threadIdx.x == 0) F.MISC[121] = __hip_atomic_fetch_add(F.ctl + qword, 8u, __ATOMIC_RELAXED, __HIP_MEMORY_SCOPE_AGENT);
        __syncthreads();
        const int base = __builtin_amdgcn_readfirstlane((int)F.MISC[121]);
        __syncthreads();
        if (base >= count) break;
        const int it = first + base + F.wave;
        if (base + F.wave < count) {
            const CvIt cur = cv_decode(it, a, ws);
            f32x4 v[16];
#pragma unroll
            for (int i = 0; i < 16; ++i) v[i] = __builtin_nontemporal_load((const f32x4*)(cur.W + (size_t)(cur.k0 + 8 * i + r) * cur.ldw + cur.n0 + c4));
#pragma unroll
            for (int i = 0; i < 16; ++i) *(LAS f32x4*)(scr + (8 * i + r) * 36 + c4) = v[i] * cur.scale;
            asm volatile("s_waitcnt lgkmcnt(0)" ::: "memory");
            const LAS float* s = scr + (64 * hf) * 36 + n;
            unsigned w[16];
#pragma unroll
            for (int j = 0; j < 16; ++j) { unsigned x = 0u; x = __builtin_amdgcn_cvt_pk_fp8_f32(s[(4 * j) * 36], s[(4 * j + 1) * 36], x, false); x = __builtin_amdgcn_cvt_pk_fp8_f32(s[(4 * j + 2) * 36], s[(4 * j + 3) * 36], x, true); w[j] = x; }
            unsigned char* op = cur.WT + (size_t)(cur.n0 + n) * cur.kpitch + cur.k0 + 64 * hf;
#pragma unroll
            for (int j = 0; j < 4; ++j) *(u32x4*)(op + 16 * j) = (u32x4){w[4 * j], w[4 * j + 1], w[4 * j + 2], w[4 * j + 3]};
            asm volatile("s_waitcnt lgkmcnt(0)" ::: "memory");
        }
    }
}
static_assert(CV_TAIL <= 32 * 16 * 64 && CV_TAIL1 % 8 == 0 && CV_TAIL2 % 8 == 0, "the tails are a suffix of the moe_w2 items");

struct SchedP1 {
    int G, c; const unsigned char* ws; int lo, hi;
    DI bool next(int i, pg8::UnitD& u) const {
        u.rows = nullptr; u.nvalid = 0; u.lda = 4096u; u.ldb = 4096u; u.e = 0; u.x0 = 0;
        if (lo == 0) {
            if (G == 256) { const int x = c >> 5, s = c & 31, bidx = i * 8 + x; if (bidx >= 24) return false;
                const int g = bidx >> 2, h = bidx & 3; u.pn = 4 * g + (s >> 3); u.pm = h * 8 + (s & 7); if (u.pn >= 23) return false; }
            else { const int L = i * G + c; if (L >= 32 * 23) return false; u.pn = L / 32; u.pm = L % 32; }
            u.type = 0; u.A = (const char*)(ws + WS_HN) + (size_t)u.pm * 256 * 4096; u.B = (const char*)(ws + WS_WIN) + (size_t)u.pn * 256 * 4096;
            return true;
        }
        const int L = lo + i * G + c; if (L >= hi) return false;
        { const int q = L - 32 * 23; u.type = 1; u.pn = q / 4; u.pm = q % 4; u.A = (const char*)(ws + WS_MN) + (size_t)u.pm * 256 * 4096; u.B = (const char*)(ws + WS_WKV) + (size_t)u.pn * 256 * 4096; }
        return true;
    }
};
struct EpiP1 {
    static constexpr bool AFTER_DRAIN = false;
    bf16_t* proj; float* dtb; bf16_t* kvraw; const float* gq; const float* gk; unsigned char* vf8;
    DI void operator()(const f32x4 (&acc)[2][2][4][2], const pg8::UnitD& u, int wr, int wc, int fr, int fq) const {
        { int ln_ = threadIdx.x; asm volatile("" : "+v"(ln_)); fr = ln_ & 15; fq = (ln_ >> 4) & 3; }
        const int row0 = u.pm * 256 + wr * 64 + fr;
        const int cn = u.pn * 256 + 64 * wc + 8 * fq;
        if (u.type == 1 && u.pn >= 8) {
#pragma unroll
            for (int ai = 0; ai < 2; ++ai)
#pragma unroll
                for (int m = 0; m < 4; ++m) { unsigned char* rp = vf8 + (size_t)(row0 + ai * 128 + m * 16) * 2048 + (cn - 2048);
#pragma unroll
                    for (int bj = 0; bj < 2; ++bj) { const f32x4 v0 = acc[ai][bj][m][0] * 16.f, v1 = acc[ai][bj][m][1] * 16.f;
                        u32x2 w; w.x = __builtin_amdgcn_cvt_pk_fp8_f32(v0[0], v0[1], 0u, false); w.x = __builtin_amdgcn_cvt_pk_fp8_f32(v0[2], v0[3], w.x, true);
                        w.y = __builtin_amdgcn_cvt_pk_fp8_f32(v1[0], v1[1], 0u, false); w.y = __builtin_amdgcn_cvt_pk_fp8_f32(v1[2], v1[3], w.y, true);
                        *(u32x2*)(rp + 32 * bj) = w; } }
            return;
        }
        if (u.type == 1) {
#pragma unroll
            for (int ai = 0; ai < 2; ++ai)
#pragma unroll
                for (int m = 0; m < 4; ++m) { bf16_t* rp = kvraw + (size_t)(row0 + ai * 128 + m * 16) * 4096 + cn;
#pragma unroll
                    for (int bj = 0; bj < 2; ++bj) { const f32x4 v0 = acc[ai][bj][m][0], v1 = acc[ai][bj][m][1];
                        u32x4 w; w.x = pk2(v0[0], v0[1]); w.y = pk2(v0[2], v0[3]); w.z = pk2(v1[0], v1[1]); w.w = pk2(v1[2], v1[3]); *(u32x4*)(rp + 32 * bj) = w; } }
            return;
        }
        if (u.pn == 22) {
            if (wc == 0 && fq < 2) {
#pragma unroll
                for (int ai = 0; ai < 2; ++ai)
#pragma unroll
                    for (int m = 0; m < 4; ++m) { float* rp = dtb + (size_t)(row0 + ai * 128 + m * 16) * 16 + 8 * fq;
                        *(f32x4*)(rp) = acc[ai][0][m][0]; *(f32x4*)(rp + 4) = acc[ai][0][m][1]; }
            }
            return;
        }
        const bool isq = (u.pn >= 10 && u.pn < 14), isk = (u.pn >= 14 && u.pn < 18);
        if (!(isq || isk)) {
#pragma unroll
            for (int ai = 0; ai < 2; ++ai)
#pragma unroll
                for (int m = 0; m < 4; ++m) { bf16_t* rp = proj + (size_t)(row0 + ai * 128 + m * 16) * PP + cn;
#pragma unroll
                    for (int bj = 0; bj < 2; ++bj) { const f32x4 v0 = acc[ai][bj][m][0], v1 = acc[ai][bj][m][1];
                        u32x4 w; w.x = pk2(v0[0], v0[1]); w.y = pk2(v0[2], v0[3]); w.z = pk2(v1[0], v1[1]); w.w = pk2(v1[2], v1[3]); *(u32x4*)(rp + 32 * bj) = w; } }
            return;
        }
        const float* g = (isq ? gq : gk) + 8 * fq; const float sc = isq ? (0.125f * 1.4426950408889634f) : 1.f;
#pragma unroll
        for (int ai = 0; ai < 2; ++ai)
#pragma unroll
            for (int m = 0; m < 4; ++m) { bf16_t* rp = proj + (size_t)(row0 + ai * 128 + m * 16) * PP + cn;
                float ss = 0.f;
#pragma unroll
                for (int bj = 0; bj < 2; ++bj)
#pragma unroll
                    for (int n = 0; n < 2; ++n) { const f32x4 v = acc[ai][bj][m][n]; ss += (v[0] * v[0] + v[1] * v[1]) + (v[2] * v[2] + v[3] * v[3]); }
                ss += __shfl_xor(ss, 16); ss += __shfl_xor(ss, 32);
                const float rs = sc / sqrtf(ss * (1.f / 64.f) + EPS_);
#pragma unroll
                for (int bj = 0; bj < 2; ++bj) { const f32x4 v0 = acc[ai][bj][m][0] * rs * *(const f32x4*)(g + 32 * bj), v1 = acc[ai][bj][m][1] * rs * *(const f32x4*)(g + 32 * bj + 4);
                    u32x4 w; w.x = pk2(v0[0], v0[1]); w.y = pk2(v0[2], v0[3]); w.z = pk2(v1[0], v1[1]); w.w = pk2(v1[2], v1[3]); *(u32x4*)(rp + 32 * bj) = w; } }
    }
};

DI void kprep(Frame& F, const ArgP& a) {
    const int gw = F.vcu * NWAVES + F.wave, NGW = F.G * NWAVES;
    const bf16_t* kv = (const bf16_t*)(F.ws + WS_KVRAW); unsigned char* kn = (unsigned char*)(F.ws + WS_KN8);
    for (int it = gw; it < NB * MEMLEN * 4; it += NGW) {
        const int row = it >> 2, h = it & 3, b = row >> 8, key = row & 255;
        const u32x4 raw = *(const u32x4*)(kv + (size_t)row * 4096 + h * 512 + F.lane * 8);
        float v[8]; v[0] = bflo(raw.x); v[1] = bfhi(raw.x); v[2] = bflo(raw.y); v[3] = bfhi(raw.y); v[4] = bflo(raw.z); v[5] = bfhi(raw.z); v[6] = bflo(raw.w); v[7] = bfhi(raw.w);
        float ss = 0.f;
#pragma unroll
        for (int j = 0; j < 8; ++j) ss += v[j] * v[j];
        const float rs = 1.f / sqrtf(wave_sum(ss) * (1.f / 512.f) + EPS_) * 0.04419417382415922f * 128.f;
        const float* gk = a.in(I_XKG) + F.lane * 8; const float* gq = a.in(I_XQG) + F.lane * 8;
        u32x2 o; o.x = __builtin_amdgcn_cvt_pk_fp8_f32(v[0] * rs * gk[0] * gq[0], v[1] * rs * gk[1] * gq[1], 0u, false); o.x = __builtin_amdgcn_cvt_pk_fp8_f32(v[2] * rs * gk[2] * gq[2], v[3] * rs * gk[3] * gq[3], o.x, true);
        o.y = __builtin_amdgcn_cvt_pk_fp8_f32(v[4] * rs * gk[4] * gq[4], v[5] * rs * gk[5] * gq[5], 0u, false); o.y = __builtin_amdgcn_cvt_pk_fp8_f32(v[6] * rs * gk[6] * gq[6], v[7] * rs * gk[7] * gq[7], o.y, true);
        *(u32x2*)(kn + ((size_t)((b * 4 + h) * 256 + key)) * 512 + F.lane * 8) = o;
    }
}

constexpr int SP = 272;
constexpr int S_C = 0, S_BM = 34816, S_BT = 69632, S_XDT = 104448, S_HB = 121856, S_F = 139264, S_W = 155648  , SSD_LDS = 162048;
static_assert(SSD_LDS <= MISC_OFF, "SSD LDS map");
#define MFMA32(a, b, c) __builtin_amdgcn_mfma_f32_32x32x16_bf16((a), (b), (c), 0, 0, 0)
DI int crow(int r, int hi) { return (r & 3) + 8 * (r >> 2) + 4 * hi; }
DI bf16x8 ldfrag(LAS const unsigned char* base, int row, int kel) { return *(const LAS bf16x8*)(base + row * SP + kel * 2); }
DI float fexp(float x) { return __builtin_amdgcn_exp2f(x * 1.4426950408889634f); }
DI float fsilu(float x) { return x * __builtin_amdgcn_rcpf(1.f + fexp(-x)); }

DI void ssd_unit(Frame& F, const ArgP& a, int b, int hd) {
    LAS unsigned char* lds = F.lds;
    int tid = F.tid, lane = F.lane, r32 = lane & 31, hh = lane >> 5; const int wid = F.wave;
    LAS float* sdt = (LAS float*)(lds + S_F); LAS float* sac = sdt + 2048;
    const bf16_t* proj = (const bf16_t*)(F.ws + WS_PROJ); const float* dtbuf = (const float*)(F.ws + WS_DT); bf16_t* yg = (bf16_t*)(F.ws + WS_YG);
    const int g = hd >> 3;
    const float aneg = -__expf(a.in(I_ALOG)[hd]), dtb = a.in(I_DTB)[hd], dsk = a.in(I_DSKIP)[hd];
#pragma unroll
    for (int q = 0; q < 2; ++q) { const int c = 2 * wid + q; const size_t t0 = (size_t)b * SEQ_ + c * 128;
        const float x0 = dtbuf[(t0 + 2 * lane) * 16 + hd] + dtb, x1 = dtbuf[(t0 + 2 * lane + 1) * 16 + hd] + dtb;
        const float d0 = x0 > 20.f ? x0 : log1pf(__expf(x0)), d1 = x1 > 20.f ? x1 : log1pf(__expf(x1));
        const float a0 = d0 * aneg, a1 = d1 * aneg;
        float s = a0 + a1;
#pragma unroll
        for (int o = 1; o < 64; o <<= 1) { const float t = __shfl_up(s, o); if (lane >= o) s += t; }
        sdt[c * 128 + 2 * lane] = d0; sdt[c * 128 + 2 * lane + 1] = d1; sac[c * 128 + 2 * lane] = s - a1; sac[c * 128 + 2 * lane + 1] = s; }
    int seg = tid >> 5, cg = tid & 31, l0 = seg * 8;
    int colbc = (cg < 16) ? (1024 + g * 128 + cg * 8) : (1280 + g * 128 + (cg - 16) * 8);
    const int colx = hd * 64 + wid * 8; int lx = 2 * lane;
    LAS float* swt = (LAS float*)(lds + S_W);
    { const float* convw = a.in(I_CONVW); const float* convb = a.in(I_CONVB);
      if (tid < 320) { const int ci = tid;
          const int xc = (ci < 64) ? (hd * 64 + ci) : (ci < 192 ? (1024 + g * 128 + (ci - 64)) : (1280 + g * 128 + (ci - 192)));
#pragma unroll
          for (int k = 0; k < 4; ++k) swt[k * 320 + ci] = convw[k * 1536 + xc];
          swt[4 * 320 + ci] = convb[xc]; } }
    int cibc = 64 + cg * 8; const int cix = wid * 8;
    const char* pub = (const char*)F.ws; const unsigned pxb = (unsigned)(WS_PROJ + ((size_t)b * SEQ_ * PP + PC_XBC) * 2), zoff = (unsigned)(WS_CTL + 524288);
    u32x4 inbc[11], inx[5];
#define SSD_PREFETCH(c_) do { \
        int sd_ = l0; asm volatile("" : "+v"(sd_)); \
        _Pragma("unroll") for (int j = 0; j < 11; ++j) { const int tt = (c_) * 128 + sd_ - 3 + j; inbc[j] = *(const u32x4*)(pub + ((tt >= 0) ? pxb + (unsigned)(tt * PP + colbc) * 2u : zoff)); } } while (0)
    SSD_PREFETCH(0);
    f32x16 hT; for (int i = 0; i < 16; ++i) hT[i] = 0.f;
    const int nb = wid & 3, pb = wid >> 2;
    __syncthreads();
    for (int c = 0; c < 16; ++c) {
        { int t_ = threadIdx.x; asm volatile("" : "+v"(t_)); tid = t_; lane = t_ & 63; r32 = lane & 31; hh = lane >> 5; seg = t_ >> 5; cg = t_ & 31; l0 = seg * 8; lx = 2 * lane;
          colbc = (cg < 16) ? (1024 + g * 128 + cg * 8) : (1280 + g * 128 + (cg - 16) * 8); cibc = 64 + cg * 8; }
        const size_t t0 = (size_t)b * SEQ_ + c * 128;
        const LAS float* cdt = sdt + c * 128; const LAS float* cac = sac + c * 128;
        const float aend = cac[127];
#pragma unroll
        for (int j = 0; j < 5; ++j) { int sd_ = lx; asm volatile("" : "+v"(sd_)); const int tt = c * 128 + sd_ - 3 + j; inx[j] = *(const u32x4*)(pub + ((tt >= 0) ? pxb + (unsigned)(tt * PP + colx) * 2u : zoff)); }
        {
            LAS unsigned char* hbp = lds + S_HB + (32 * pb + r32) * SP + (32 * nb + 4 * hh) * 2;
#pragma unroll
            for (int q4 = 0; q4 < 4; ++q4) { u32x2 w; w.x = pk2(hT[4 * q4], hT[4 * q4 + 1]); w.y = pk2(hT[4 * q4 + 2], hT[4 * q4 + 3]); *(LAS u32x2*)(hbp + 16 * q4) = w; }
        }
        {
            float wbc[5][8];
#pragma unroll
            for (int k = 0; k < 5; ++k) { const f32x4 w0 = *(const LAS f32x4*)(swt + k * 320 + cibc), w1 = *(const LAS f32x4*)(swt + k * 320 + cibc + 4);
#pragma unroll
                for (int i = 0; i < 4; ++i) { wbc[k][i] = w0[i]; wbc[k][4 + i] = w1[i]; } }
#pragma unroll
            for (int hf = 0; hf < 2; ++hf) {
                __builtin_amdgcn_sched_barrier(0);
                float o[4][8];
#pragma unroll
                for (int j = 0; j < 4; ++j)
#pragma unroll
                    for (int i = 0; i < 8; ++i) { float s = wbc[4][i];
#pragma unroll
                        for (int k = 0; k < 4; ++k) { const unsigned wd = inbc[4 * hf + j + k][i >> 1]; s += wbc[k][i] * ((i & 1) ? bfhi(wd) : bflo(wd)); }
                        o[j][i] = fsilu(s); }
                const int lh = l0 + 4 * hf;
                if (cg < 16) {
                    const int n0 = cg * 8; float ev[4];
#pragma unroll
                    for (int j = 0; j < 4; ++j) { ev[j] = fexp(aend - cac[lh + j]);
                        u32x4 w1; w1.x = pk2(o[j][0], o[j][1]); w1.y = pk2(o[j][2], o[j][3]); w1.z = pk2(o[j][4], o[j][5]); w1.w = pk2(o[j][6], o[j][7]);
                        *(LAS u32x4*)(lds + S_BM + (lh + j) * SP + n0 * 2) = w1; }
#pragma unroll
                    for (int i = 0; i < 8; ++i) { u32x2 w2; w2.x = pk2(o[0][i] * ev[0], o[1][i] * ev[1]); w2.y = pk2(o[2][i] * ev[2], o[3][i] * ev[3]);
                        *(LAS u32x2*)(lds + S_BT + (n0 + i) * SP + lh * 2) = w2; }
                } else {
                    const int n0 = (cg - 16) * 8;
#pragma unroll
                    for (int j = 0; j < 4; ++j) { u32x4 w1; w1.x = pk2(o[j][0], o[j][1]); w1.y = pk2(o[j][2], o[j][3]); w1.z = pk2(o[j][4], o[j][5]); w1.w = pk2(o[j][6], o[j][7]);
                        *(LAS u32x4*)(lds + S_C + (lh + j) * SP + n0 * 2) = w1; }
                }
            }
        }
        __builtin_amdgcn_sched_barrier(0);
        {
            const float d0 = cdt[lx], d1 = cdt[lx + 1];
            float wx[5][8];
#pragma unroll
            for (int k = 0; k < 5; ++k) { const f32x4 w0 = *(const LAS f32x4*)(swt + k * 320 + cix), w1 = *(const LAS f32x4*)(swt + k * 320 + cix + 4);
#pragma unroll
                for (int i = 0; i < 4; ++i) { wx[k][i] = w0[i]; wx[k][4 + i] = w1[i]; } }
#pragma unroll
            for (int i = 0; i < 8; ++i) { float s0 = wx[4][i], s1 = wx[4][i];
#pragma unroll
                for (int k = 0; k < 4; ++k) { const unsigned w0 = inx[k][i >> 1], w1 = inx[k + 1][i >> 1];
                    s0 += wx[k][i] * ((i & 1) ? bfhi(w0) : bflo(w0)); s1 += wx[k][i] * ((i & 1) ? bfhi(w1) : bflo(w1)); }
                *(LAS unsigned*)(lds + S_XDT + (wid * 8 + i) * SP + lx * 2) = pk2(fsilu(s0) * d0, fsilu(s1) * d1); }
        }
        if (c < 15) SSD_PREFETCH(c + 1);
        __syncthreads();
        const int lb = wid >> 1;
        f32x16 xt[2];
        {
            bf16x8 cf[8];
#pragma unroll
            for (int ks = 0; ks < 8; ++ks) cf[ks] = ldfrag(lds + S_C, 32 * lb + r32, 16 * ks + 8 * hh);
#pragma unroll
            for (int q = 0; q < 2; ++q) { const int sb = 2 * (wid & 1) + q;
                for (int i = 0; i < 16; ++i) xt[q][i] = 0.f;
                if (sb <= lb) {
                    bf16x8 bfr[8];
#pragma unroll
                    for (int ks = 0; ks < 8; ++ks) bfr[ks] = ldfrag(lds + S_BM, 32 * sb + r32, 16 * ks + 8 * hh);
                    __builtin_amdgcn_sched_barrier(0);
#pragma unroll
                    for (int ks = 0; ks < 8; ++ks) xt[q] = MFMA32(bfr[ks], cf[ks], xt[q]);
                }
            }
        }
        __syncthreads();
        {
            const int l = 32 * lb + r32; const float al = cac[l], ddl = dsk * __builtin_amdgcn_rcpf(cdt[l]);
            f32x4 cs[2][4];
#pragma unroll
            for (int q = 0; q < 2; ++q)
#pragma unroll
                for (int q4 = 0; q4 < 4; ++q4) cs[q][q4] = *(const LAS f32x4*)(cac + 32 * (2 * (wid & 1) + q) + 8 * q4 + 4 * hh);
#pragma unroll
            for (int q = 0; q < 2; ++q) { const int sb = 2 * (wid & 1) + q;
#pragma unroll
                for (int q4 = 0; q4 < 4; ++q4) { float mv[4];
#pragma unroll
                    for (int e = 0; e < 4; ++e) { const int s = 32 * sb + 8 * q4 + 4 * hh + e;
                        const float ev = fexp(fminf(al - cs[q][q4][e], 0.f));
                        float v = (s <= l) ? xt[q][4 * q4 + e] * ev : 0.f;
                        v += (s == l) ? ddl : 0.f;
                        mv[e] = v; }
                    u32x2 w; w.x = pk2(mv[0], mv[1]); w.y = pk2(mv[2], mv[3]);
                    *(LAS u32x2*)(lds + S_BM + l * SP + (32 * sb + 8 * q4 + 4 * hh) * 2) = w; }
            }
        }
        __syncthreads();
        {
            const int lb2 = wid & 3, pb2 = wid >> 2; const int l = 32 * lb2 + r32; const size_t tok = t0 + l;
            const int pc0 = hd * 64 + 32 * pb2 + 4 * hh;
            u32x2 zz[4];
#pragma unroll
            for (int q4 = 0; q4 < 4; ++q4) zz[q4] = *(const u32x2*)(proj + tok * PP + pc0 + 8 * q4);
            f32x16 y1, y2; for (int i = 0; i < 16; ++i) { y1[i] = 0.f; y2[i] = 0.f; }
            bf16x8 fa[8], fb[8];
#pragma unroll
            for (int ks = 0; ks < 8; ++ks) { fa[ks] = ldfrag(lds + S_XDT, 32 * pb2 + r32, 16 * ks + 8 * hh); fb[ks] = ldfrag(lds + S_BM, 32 * lb2 + r32, 16 * ks + 8 * hh); }
            __builtin_amdgcn_sched_barrier(0);
#pragma unroll
            for (int ks = 0; ks < 8; ++ks) { if (ks < 2 * (lb2 + 1)) y1 = MFMA32(fa[ks], fb[ks], y1); }
            const float cd = fexp(aend);
#pragma unroll
            for (int i = 0; i < 16; ++i) hT[i] *= cd;
#pragma unroll
            for (int ks = 0; ks < 8; ++ks) fb[ks] = ldfrag(lds + S_BT, 32 * nb + r32, 16 * ks + 8 * hh);
            __builtin_amdgcn_sched_barrier(0);
#pragma unroll
            for (int ks = 0; ks < 8; ++ks) hT = MFMA32(fb[ks], fa[ks], hT);
#pragma unroll
            for (int ks = 0; ks < 8; ++ks) { fa[ks] = ldfrag(lds + S_HB, 32 * pb2 + r32, 16 * ks + 8 * hh); fb[ks] = ldfrag(lds + S_C, 32 * lb2 + r32, 16 * ks + 8 * hh); }
            __builtin_amdgcn_sched_barrier(0);
#pragma unroll
            for (int ks = 0; ks < 8; ++ks) y2 = MFMA32(fa[ks], fb[ks], y2);
            const float el = fexp(cac[l]);
#pragma unroll
            for (int q4 = 0; q4 < 4; ++q4) { float yv[4];
#pragma unroll
                for (int e = 0; e < 4; ++e) { const float z = (e & 1) ? bfhi(e < 2 ? zz[q4].x : zz[q4].y) : bflo(e < 2 ? zz[q4].x : zz[q4].y);
                    yv[e] = (y1[4 * q4 + e] + el * y2[4 * q4 + e]) * fsilu(z); }
                u32x2 w; w.x = pk2(yv[0], yv[1]); w.y = pk2(yv[2], yv[3]);
                *(u32x2*)(yg + tok * 1024 + pc0 + 8 * q4) = w; }
        }
        __syncthreads();
    }
#undef SSD_PREFETCH
}

DI void attn_phase_da(Frame& F) {
    const attn_body::bf16* proj = (const attn_body::bf16*)(F.ws + WS_PROJ);
    for (;;) {
        if (threadIdx.x == 0) F.MISC[120] = __hip_atomic_fetch_add(F.ctl + CW_QATT, 1u, __ATOMIC_RELAXED, __HIP_MEMORY_SCOPE_AGENT);
        __syncthreads();
        const int u = __builtin_amdgcn_readfirstlane((int)F.MISC[120]);
        __syncthreads();
        if (u >= 1024) break;
        const int qb = 7 - (u >> 7), combo = u & 127;
        const int half = combo & 1, j = (combo >> 1) & 1, h = (combo >> 2) & 7, b = combo >> 5;
        attn_body::bf16* O = (attn_body::bf16*)(F.ws + (j ? WS_O1 : WS_O0));
        attn_body::attn_unit<8>(b, PC_Q + (h * 2 + j) * 64, PC_V + h * 128 + half * 64, h * 128 + half * 64, qb, proj, proj + (PC_K - PC_Q), proj, O, (char*)F.lds);
    }
}

DI void p3_finalize(Frame& F, const ArgP& a) {
    const int gw = F.vcu * NWAVES + F.wave, NGW = F.G * NWAVES, lane = F.lane;
    bf16_t* ycat = (bf16_t*)(F.ws + WS_YCAT); const bf16_t* yg = (const bf16_t*)(F.ws + WS_YG); const bf16_t* o0 = (const bf16_t*)(F.ws + WS_O0); const bf16_t* o1 = (const bf16_t*)(F.ws + WS_O1);
    float l1 = a.in(I_LQ1)[lane] * a.in(I_LK1)[lane], l2 = a.in(I_LQ2)[lane] * a.in(I_LK2)[lane];
    const float lam = __expf(wave_sum(l1)) - __expf(wave_sum(l2)) + LAM_INIT;
    for (int m = gw; m < NTOK; m += NGW) {
        { bf16_t* yp = ycat + (size_t)m * 2048 + 16 * lane; const bf16_t* gp = yg + (size_t)m * 1024 + 16 * lane;
          const u32x4 r0 = *(const u32x4*)gp, r1 = *(const u32x4*)(gp + 8);
          float v[16]; v[0] = bflo(r0.x); v[1] = bfhi(r0.x); v[2] = bflo(r0.y); v[3] = bfhi(r0.y); v[4] = bflo(r0.z); v[5] = bfhi(r0.z); v[6] = bflo(r0.w); v[7] = bfhi(r0.w);
          v[8] = bflo(r1.x); v[9] = bfhi(r1.x); v[10] = bflo(r1.y); v[11] = bfhi(r1.y); v[12] = bflo(r1.z); v[13] = bfhi(r1.z); v[14] = bflo(r1.w); v[15] = bfhi(r1.w);
          float ss = 0.f;
#pragma unroll
          for (int i = 0; i < 16; ++i) ss += v[i] * v[i];
#pragma unroll
          for (int o = 1; o < 32; o <<= 1) ss += __shfl_xor(ss, o);
          const float rs = 1.f / sqrtf(ss * (1.f / 512.f) + EPS_);
          const float* g = a.in(I_SSDG) + 16 * lane;
          u32x4 w0, w1;
          w0.x = pk2(v[0] * rs * g[0], v[1] * rs * g[1]); w0.y = pk2(v[2] * rs * g[2], v[3] * rs * g[3]); w0.z = pk2(v[4] * rs * g[4], v[5] * rs * g[5]); w0.w = pk2(v[6] * rs * g[6], v[7] * rs * g[7]);
          w1.x = pk2(v[8] * rs * g[8], v[9] * rs * g[9]); w1.y = pk2(v[10] * rs * g[10], v[11] * rs * g[11]); w1.z = pk2(v[12] * rs * g[12], v[13] * rs * g[13]); w1.w = pk2(v[14] * rs * g[14], v[15] * rs * g[15]);
          *(u32x4*)yp = w0; *(u32x4*)(yp + 8) = w1; }
        { const bf16_t* p0 = o0 + (size_t)m * 1024 + 16 * lane; const bf16_t* p1 = o1 + (size_t)m * 1024 + 16 * lane;
          const u32x4 a0 = *(const u32x4*)p0, a1 = *(const u32x4*)(p0 + 8), b0 = *(const u32x4*)p1, b1 = *(const u32x4*)(p1 + 8);
          float v[16];
          v[0] = bflo(a0.x) - lam * bflo(b0.x); v[1] = bfhi(a0.x) - lam * bfhi(b0.x); v[2] = bflo(a0.y) - lam * bflo(b0.y); v[3] = bfhi(a0.y) - lam * bfhi(b0.y);
          v[4] = bflo(a0.z) - lam * bflo(b0.z); v[5] = bfhi(a0.z) - lam * bfhi(b0.z); v[6] = bflo(a0.w) - lam * bflo(b0.w); v[7] = bfhi(a0.w) - lam * bfhi(b0.w);
          v[8] = bflo(a1.x) - lam * bflo(b1.x); v[9] = bfhi(a1.x) - lam * bfhi(b1.x); v[10] = bflo(a1.y) - lam * bflo(b1.y); v[11] = bfhi(a1.y) - lam * bfhi(b1.y);
          v[12] = bflo(a1.z) - lam * bflo(b1.z); v[13] = bfhi(a1.z) - lam * bfhi(b1.z); v[14] = bflo(a1.w) - lam * bflo(b1.w); v[15] = bfhi(a1.w) - lam * bfhi(b1.w);
          float ss = 0.f;
#pragma unroll
          for (int i = 0; i < 16; ++i) ss += v[i] * v[i];
          ss += __shfl_xor(ss, 1); ss += __shfl_xor(ss, 2); ss += __shfl_xor(ss, 4);
          const float rs = 1.f / sqrtf(ss * (1.f / 128.f) + EPS_) * (1.f - LAM_INIT);
          const float* g = a.in(I_SUBG) + 16 * (lane & 7);
          u32x4 w0, w1;
          w0.x = pk2(v[0] * rs * g[0], v[1] * rs * g[1]); w0.y = pk2(v[2] * rs * g[2], v[3] * rs * g[3]); w0.z = pk2(v[4] * rs * g[4], v[5] * rs * g[5]); w0.w = pk2(v[6] * rs * g[6], v[7] * rs * g[7]);
          w1.x = pk2(v[8] * rs * g[8], v[9] * rs * g[9]); w1.y = pk2(v[10] * rs * g[10], v[11] * rs * g[11]); w1.z = pk2(v[12] * rs * g[12], v[13] * rs * g[13]); w1.w = pk2(v[14] * rs * g[14], v[15] * rs * g[15]);
          bf16_t* yp = ycat + (size_t)m * 2048 + 1024 + 16 * lane;
          *(u32x4*)yp = w0; *(u32x4*)(yp + 8) = w1; }
    }
}

struct SchedDense {
    int G, c, nM, nN; const char* A; const char* B; unsigned lda, ldb; int bdiv; size_t bstride;
    DI bool next(int i, pg8::UnitD& u) const {
        const int L = i * G + c; if (L >= nM * nN) return false;
        u.rows = nullptr; u.nvalid = 0; u.lda = lda; u.ldb = ldb; u.type = 0; u.e = 0; u.x0 = 0;
        if (G == 256 && nM == 32 && nN == 8) { const int x = L >> 5, s = L & 31; u.pm = (x & 3) * 8 + (s & 7); u.pn = (x >> 2) * 4 + (s >> 3); }
        else { u.pn = L / nM; u.pm = L % nM; }
        u.A = A + (size_t)u.pm * 256 * lda; u.B = B + (size_t)u.pn * 256 * ldb + (size_t)(u.pm / bdiv) * bstride;
        return true;
    }
};
template <bool BASE_BF16>
struct EpiResid {
    static constexpr bool AFTER_DRAIN = false;
    const void* base; bf16_t* out; float* part; unsigned char* out8; float accscale;
    DI void operator()(const f32x4 (&acc)[2][2][4][2], const pg8::UnitD& u, int wr, int wc, int fr, int fq) const {
        { int ln_ = threadIdx.x; asm volatile("" : "+v"(ln_)); fr = ln_ & 15; fq = (ln_ >> 4) & 3; }
        const int row0 = u.pm * 256 + wr * 64 + fr, col0 = u.pn * 256 + wc * 32 + 8 * fq;
#pragma unroll
        for (int ai = 0; ai < 2; ++ai)
#pragma unroll
            for (int m = 0; m < 4; ++m) { const size_t row = (size_t)(row0 + ai * 128 + m * 16); float ss = 0.f;
#pragma unroll
                for (int bj = 0; bj < 2; ++bj) { const size_t idx = row * 2048 + col0 + bj * 128;
                    f32x4 b0, b1;
                    if constexpr (BASE_BF16) { const u32x4 r = *(const u32x4*)((const bf16_t*)base + idx); b0 = (f32x4){bflo(r.x), bfhi(r.x), bflo(r.y), bfhi(r.y)}; b1 = (f32x4){bflo(r.z), bfhi(r.z), bflo(r.w), bfhi(r.w)}; }
                    else { b0 = *(const f32x4*)((const float*)base + idx); b1 = *(const f32x4*)((const float*)base + idx + 4); }
                    const f32x4 v0 = acc[ai][bj][m][0] * accscale + b0, v1 = acc[ai][bj][m][1] * accscale + b1;
                    { u32x4 w; w.x = pk2(v0[0], v0[1]); w.y = pk2(v0[2], v0[3]); w.z = pk2(v1[0], v1[1]); w.w = pk2(v1[2], v1[3]); *(u32x4*)(out + idx) = w; }
                    if (out8) { u32x2 w; w.x = __builtin_amdgcn_cvt_pk_fp8_f32(v0[0] * 16.f, v0[1] * 16.f, 0u, false); w.x = __builtin_amdgcn_cvt_pk_fp8_f32(v0[2] * 16.f, v0[3] * 16.f, w.x, true);
                        w.y = __builtin_amdgcn_cvt_pk_fp8_f32(v1[0] * 16.f, v1[1] * 16.f, 0u, false); w.y = __builtin_amdgcn_cvt_pk_fp8_f32(v1[2] * 16.f, v1[3] * 16.f, w.y, true); *(u32x2*)(out8 + idx) = w; }
                    ss += (v0[0] * v0[0] + v0[1] * v0[1]) + (v0[2] * v0[2] + v0[3] * v0[3]) + (v1[0] * v1[0] + v1[1] * v1[1]) + (v1[2] * v1[2] + v1[3] * v1[3]); }
                if (part) { ss += __shfl_xor(ss, 16); ss += __shfl_xor(ss, 32); if (fq == 0) part[row * 32 + u.pn * 4 + wc] = ss; } }
    }
};

struct EpiQ {
    static constexpr bool AFTER_DRAIN = false;
    unsigned char* out8; float* part;
    DI void operator()(const f32x4 (&acc)[2][2][4][2], const pg8::UnitD& u, int wr, int wc, int fr, int fq) const {
        { int ln_ = threadIdx.x; asm volatile("" : "+v"(ln_)); fr = ln_ & 15; fq = (ln_ >> 4) & 3; }
        const int row0 = u.pm * 256 + wr * 64 + fr, col0 = u.pn * 256 + wc * 32 + 8 * fq;
#pragma unroll
        for (int ai = 0; ai < 2; ++ai)
#pragma unroll
            for (int m = 0; m < 4; ++m) { const size_t row = (size_t)(row0 + ai * 128 + m * 16); float ss = 0.f;
#pragma unroll
                for (int bj = 0; bj < 2; ++bj) { const size_t idx = row * 2048 + col0 + bj * 128; const f32x4 v0 = acc[ai][bj][m][0] * (1.f / 1024.f), v1 = acc[ai][bj][m][1] * (1.f / 1024.f);
                    u32x2 w; w.x = __builtin_amdgcn_cvt_pk_fp8_f32(v0[0] * 16.f, v0[1] * 16.f, 0u, false); w.x = __builtin_amdgcn_cvt_pk_fp8_f32(v0[2] * 16.f, v0[3] * 16.f, w.x, true);
                    w.y = __builtin_amdgcn_cvt_pk_fp8_f32(v1[0] * 16.f, v1[1] * 16.f, 0u, false); w.y = __builtin_amdgcn_cvt_pk_fp8_f32(v1[2] * 16.f, v1[3] * 16.f, w.y, true); *(u32x2*)(out8 + idx) = w;
                    ss += (v0[0] * v0[0] + v0[1] * v0[1]) + (v0[2] * v0[2] + v0[3] * v0[3]) + (v1[0] * v1[0] + v1[1] * v1[1]) + (v1[2] * v1[2] + v1[3] * v1[3]); }
                ss += __shfl_xor(ss, 16); ss += __shfl_xor(ss, 32); if (fq == 0) part[row * 32 + u.pn * 4 + wc] = ss; }
    }
};

struct SchedXS {
    int G, c; const unsigned char* ws;
    DI bool next(int i, pg8::UnitD& u) const {
        const int L = i * G + c; if (L >= 256) return false;
        u.rows = nullptr; u.nvalid = 0; u.e = 0;
        const int q = L & 127, bh = q >> 3, t8 = q & 7, b = bh >> 2, h = bh & 3;
        u.pm = b; u.pn = h; u.x0 = t8;
        if (L < 128) { u.type = 0; u.lda = 2048u; u.ldb = 512u;
            u.A = (const char*)(ws + WS_QF8) + (size_t)(b * 2048 + t8 * 256) * 2048 + h * 512; u.B = (const char*)(ws + WS_KN8) + (size_t)(bh * 256) * 512; }
        else { u.type = 1; u.lda = 2048u; u.ldb = 2048u;
            u.A = (const char*)(ws + WS_WO) + (size_t)(t8 * 256) * 2048 + h * 512; u.B = (const char*)(ws + WS_VF8) + (size_t)(b * 256) * 2048 + h * 512; }
        return true;
    }
};
struct EpiXS {
    static constexpr bool AFTER_DRAIN = false;
    unsigned char* P; unsigned char* VWT; const float* part1; const float* partq; LAS float* red;
    DI void operator()(const f32x4 (&acc)[2][2][4][2], const pg8::UnitD& u, int wr, int wc, int fr, int fq) const {
        { int ln_ = threadIdx.x; asm volatile("" : "+v"(ln_)); fr = ln_ & 15; fq = (ln_ >> 4) & 3; }
        const int b = u.pm, h = u.pn, t8 = u.x0;
        const int col0 = wc * 32 + 8 * fq;
        if (u.type == 1) {
            unsigned char* Vu = VWT + ((size_t)b * 2048 + t8 * 256) * 1024 + h * 256;
#pragma unroll
            for (int ai = 0; ai < 2; ++ai)
#pragma unroll
                for (int m = 0; m < 4; ++m) { const unsigned rl = (unsigned)(ai * 128 + wr * 64 + m * 16 + fr);
#pragma unroll
                    for (int bj = 0; bj < 2; ++bj) { const f32x4 v0 = acc[ai][bj][m][0] * (32.f / 1024.f), v1 = acc[ai][bj][m][1] * (32.f / 1024.f);
                        u32x2 w; w.x = __builtin_amdgcn_cvt_pk_fp8_f32(v0[0], v0[1], 0u, false); w.x = __builtin_amdgcn_cvt_pk_fp8_f32(v0[2], v0[3], w.x, true);
                        w.y = __builtin_amdgcn_cvt_pk_fp8_f32(v1[0], v1[1], 0u, false); w.y = __builtin_amdgcn_cvt_pk_fp8_f32(v1[2], v1[3], w.y, true);
                        *(u32x2*)(Vu + (rl * 1024u + (unsigned)(bj * 128 + col0))) = w; } }
            return;
        }
        const size_t row0 = (size_t)b * 2048 + t8 * 256;
        const char* p1u = (const char*)(part1 + row0 * 32); const char* pqu = (const char*)(partq + row0 * 32 + h * 8); unsigned char* Pu = P + row0 * 1024 + h * 256;
        float rsc[2][4];
#pragma unroll
        for (int ai = 0; ai < 2; ++ai)
#pragma unroll
            for (int m = 0; m < 4; ++m) { const unsigned rl = (unsigned)(ai * 128 + wr * 64 + m * 16 + fr);
                const f32x4 p0 = *(const f32x4*)(p1u + (rl * 32u + (unsigned)fq * 8u) * 4u), p1 = *(const f32x4*)(p1u + (rl * 32u + (unsigned)fq * 8u + 4u) * 4u);
                float s1 = (p0[0] + p0[1]) + (p0[2] + p0[3]) + (p1[0] + p1[1]) + (p1[2] + p1[3]);
                const f32x2 pq = *(const f32x2*)(pqu + (rl * 32u + (unsigned)fq * 2u) * 4u);
                float sq = pq[0] + pq[1];
                s1 = quad_sum_16_32(s1); sq = quad_sum_16_32(sq);
                rsc[ai][m] = __builtin_amdgcn_rsqf(sq * (1.f / 512.f) + EPS_ * (s1 * (1.f / 2048.f) + EPS_)) * (1.4426950408889634f / 2048.f);
                float ps = 0.f;
#pragma unroll
                for (int bj = 0; bj < 2; ++bj)
#pragma unroll
                    for (int n = 0; n < 2; ++n)
#pragma unroll
                        for (int e = 0; e < 4; ++e) ps += __builtin_amdgcn_exp2f(fminf(acc[ai][bj][m][n][e] * rsc[ai][m], 100.f));
                ps = quad_sum_16_32(ps);
                if (fq == 0) red[rl * 4 + wc] = ps;
                __builtin_amdgcn_sched_barrier(0); }
        __syncthreads();
        { int ln_ = threadIdx.x; asm volatile("" : "+v"(ln_)); fr = ln_ & 15; fq = (ln_ >> 4) & 3; }
#pragma unroll
        for (int ai = 0; ai < 2; ++ai)
#pragma unroll
            for (int m = 0; m < 4; ++m) { const unsigned rl = (unsigned)(ai * 128 + wr * 64 + m * 16 + fr);
                const f32x4 t = *(const LAS f32x4*)(red + rl * 4); const float inv = 256.f * __builtin_amdgcn_rcpf((t[0] + t[1]) + (t[2] + t[3])); float rs = rsc[ai][m]; asm volatile("" : "+v"(rs));
#pragma unroll
                for (int bj = 0; bj < 2; ++bj) { float x[8];
#pragma unroll
                    for (int n = 0; n < 2; ++n)
#pragma unroll
                        for (int e = 0; e < 4; ++e) x[n * 4 + e] = __builtin_amdgcn_exp2f(fminf(acc[ai][bj][m][n][e] * rs, 100.f)) * inv;
                    u32x2 w; w.x = __builtin_amdgcn_cvt_pk_fp8_f32(x[0], x[1], 0u, false); w.x = __builtin_amdgcn_cvt_pk_fp8_f32(x[2], x[3], w.x, true);
                    w.y = __builtin_amdgcn_cvt_pk_fp8_f32(x[4], x[5], 0u, false); w.y = __builtin_amdgcn_cvt_pk_fp8_f32(x[6], x[7], w.y, true);
                    *(u32x2*)(Pu + (rl * 1024u + (unsigned)(bj * 128 + wc * 32 + 8 * fq))) = w; } }
        __syncthreads();
    }
};

constexpr int HNP = 2052;
DI void p8_route(Frame& F, const ArgP& a) {
    LAS float* s_hn = (LAS float*)F.lds; LAS float* s_part = (LAS float*)(F.lds + 16 * HNP * 4); LAS float* s_log = s_part + 8 * 16 * 32; LAS int* s_slot = (LAS int*)(s_log + 16 * 32);
    LAS int* s_cnt = s_slot + 64; LAS int* s_base = s_cnt + 32;
    const bf16_t* h2 = (const bf16_t*)(F.ws + WS_H2); unsigned char* xg = (unsigned char*)(F.ws + WS_XG);
    float* gate_of = (float*)(F.ws + WS_GATEOF); int* tok_e = (int*)(F.ws + WS_TOKE);
    const float* rw = a.in(I_RW); const float* rb = a.in(I_RB); const float* g3 = a.in(I_GFFN);
    const int lane = F.lane, wave = F.wave, tid = F.tid;
    float bw0[64], bw1[64];
    { const int kq = lane >> 4, c16 = lane & 15; const float* bp = rw + (size_t)(256 * wave + kq) * 32 + c16;
#pragma unroll
      for (int j = 0; j < 64; ++j) { bw0[j] = bp[(size_t)(4 * j) * 32]; bw1[j] = bp[(size_t)(4 * j) * 32 + 16]; } }
    for (int task = F.vcu; task < NTOK / 16; task += F.G) {
        const int tb = task * 16;
#pragma unroll
        for (int q = 0; q < 2; ++q) { const int tl = 2 * wave + q; const size_t tok = (size_t)(tb + tl);
            const u32x2* xr = (const u32x2*)(h2 + tok * 2048) + lane;
            f32x4 v[8]; float s = 0.f;
#pragma unroll
            for (int j = 0; j < 8; ++j) { const u32x2 rw_ = xr[64 * j]; v[j] = (f32x4){bflo(rw_.x), bfhi(rw_.x), bflo(rw_.y), bfhi(rw_.y)}; s += (v[j].x * v[j].x + v[j].y * v[j].y) + (v[j].z * v[j].z + v[j].w * v[j].w); }
            const float rstd = 1.f / sqrtf(wave_sum(s) * (1.f / 2048.f) + EPS_);
#pragma unroll
            for (int j = 0; j < 8; ++j) { const f32x4 gg = ((const f32x4*)g3)[lane + 64 * j]; const f32x4 y = v[j] * rstd * gg;
                *(LAS f32x4*)(s_hn + tl * HNP + (lane + 64 * j) * 4) = y; } }
        __syncthreads();
        {
            f32x4 acc0 = {0.f, 0.f, 0.f, 0.f}, acc1 = {0.f, 0.f, 0.f, 0.f};
            const int kq = lane >> 4, c16 = lane & 15;
            const LAS float* ap = s_hn + c16 * HNP + 256 * wave;
#pragma unroll
            for (int j = 0; j < 64; ++j) { const f32x4 a4 = *(const LAS f32x4*)(ap + 4 * j);
                const float av = (kq == 0) ? a4.x : (kq == 1) ? a4.y : (kq == 2) ? a4.z : a4.w;
                acc0 = __builtin_amdgcn_mfma_f32_16x16x4f32(av, bw0[j], acc0, 0, 0, 0);
                acc1 = __builtin_amdgcn_mfma_f32_16x16x4f32(av, bw1[j], acc1, 0, 0, 0); }
            LAS float* pp = s_part + wave * 512 + c16;
#pragma unroll
            for (int r = 0; r < 4; ++r) { pp[(4 * kq + r) * 32] = acc0[r]; pp[(4 * kq + r) * 32 + 16] = acc1[r]; }
        }
        __syncthreads();
        {
            const int tt = tid >> 5, e = tid & 31; float lg = rb[e];
#pragma unroll
            for (int w = 0; w < 8; ++w) lg += s_part[w * 512 + tt * 32 + e];
            if (tid < 32) s_cnt[tid] = 0;
            float val[4]; int idx[4]; float cur = lg;
#pragma unroll
            for (int k = 0; k < 4; ++k) { float bv = cur; int bi = e;
#pragma unroll
                for (int o = 1; o < 32; o <<= 1) { const float ov = __shfl_xor(bv, o); const int oi = __shfl_xor(bi, o); if (ov > bv || (ov == bv && oi < bi)) { bv = ov; bi = oi; } }
                val[k] = bv; idx[k] = bi; if (e == bi) cur = -INFINITY; }
            __syncthreads();
            int myrank = 0, myexp = 0; float mygate = 0.f;
            if (e < 4) { const float sum = (__expf(val[0] - val[0]) + __expf(val[1] - val[0])) + (__expf(val[2] - val[0]) + __expf(val[3] - val[0]));
                const float mv = (e == 0) ? val[0] : (e == 1) ? val[1] : (e == 2) ? val[2] : val[3]; myexp = (e == 0) ? idx[0] : (e == 1) ? idx[1] : (e == 2) ? idx[2] : idx[3];
                mygate = __expf(mv - val[0]) / sum; myrank = __hip_atomic_fetch_add(&s_cnt[myexp], 1, __ATOMIC_RELAXED, __HIP_MEMORY_SCOPE_WORKGROUP); }
            __syncthreads();
            if (tid < 32) { const int c = s_cnt[tid]; s_base[tid] = c ? (int)__hip_atomic_fetch_add(F.ctl + CW_CNT + 64 * tid, (unsigned)c, __ATOMIC_RELAXED, __HIP_MEMORY_SCOPE_AGENT) : 0; }
            __syncthreads();
            if (e < 4) { const int slot = myexp * 8192 + s_base[myexp] + myrank; const int tok = tb + tt;
                gate_of[slot] = mygate; tok_e[tok * 4 + e] = slot; s_slot[tt * 4 + e] = slot; }
        }
        __syncthreads();
#pragma unroll
        for (int q = 0; q < 2; ++q) { const int tl = 2 * wave + q;
            unsigned o[8];
#pragma unroll
            for (int j = 0; j < 8; ++j) { const f32x4 y = *(const LAS f32x4*)(s_hn + tl * HNP + (lane + 64 * j) * 4);
                unsigned w = 0u; w = __builtin_amdgcn_cvt_pk_fp8_f32(y.x * 4.f, y.y * 4.f, w, false); w = __builtin_amdgcn_cvt_pk_fp8_f32(y.z * 4.f, y.w * 4.f, w, true); o[j] = w; }
#pragma unroll
            for (int k = 0; k < 4; ++k) { unsigned* o4 = (unsigned*)(xg + (size_t)s_slot[tl * 4 + k] * 2048) + lane;
#pragma unroll
                for (int j = 0; j < 8; ++j) o4[64 * j] = o[j]; } }
        __syncthreads();
    }
}

DI void moe_tables(Frame& F) {
    if (F.tid == 0) { unsigned base = 0u;
        for (int e = 0; e < 32; ++e) { const unsigned c = F.ctl[CW_CNT + 64 * e], mt = (c + 255u) >> 8; F.MISC[16 + e] = c; F.MISC[48 + e] = base; F.MISC[80 + e] = mt; base += mt; }
        F.MISC[112] = base; }
    __syncthreads();
}
DI int ldsu(volatile LAS unsigned* p) { return __builtin_amdgcn_readfirstlane((int)*p); }
template <int NTN  >
struct SchedMoe {
    int G, c; const unsigned char* ws; volatile LAS unsigned* MISC; int total;
    DI bool next(int i, pg8::UnitD& u) const {
        const int L = i * G + c; if (L >= total) return false;
        int e = 0;
        for (int k = 0; k < 32; ++k) { if (L >= (ldsu(MISC + 48 + k) + ldsu(MISC + 80 + k)) * NTN) e = k + 1; }
        const int tb = ldsu(MISC + 48 + e), mte = ldsu(MISC + 80 + e), cnt = ldsu(MISC + 16 + e);
        const int local = L - tb * NTN, nt = local / mte, mt = local % mte;
        u.type = 0; u.e = e; u.pn = nt; u.pm = tb + mt; u.x0 = mt; u.lda = 2048u; u.ldb = 2048u;
        u.rows = nullptr; u.nvalid = cnt - mt * 256;
        if (NTN == 16) { u.A = (const char*)(ws + WS_XG) + ((size_t)e * 8192 + (size_t)mt * 256) * 2048;
            u.B = (const char*)(ws + WS_W1) + ((size_t)e * 4096 + (size_t)nt * 256) * 2048; }
        else { u.A = (const char*)(ws + WS_ACT) + ((size_t)e * 8192 + (size_t)mt * 256) * 2048;
            u.B = (const char*)(ws + WS_W2) + ((size_t)e * 2048 + (size_t)nt * 256) * 2048; }
        return true;
    }
};
struct EpiMoe1 {
    static constexpr bool AFTER_DRAIN = false;
    unsigned char* act; const float* b1;
    DI void operator()(const f32x4 (&acc)[2][2][4][2], const pg8::UnitD& u, int wr, int wc, int fr, int fq) const {
        { int ln_ = threadIdx.x; asm volatile("" : "+v"(ln_)); fr = ln_ & 15; fq = (ln_ >> 4) & 3; }
        const int j0 = u.pn * 128 + wc * 32 + 8 * fq;
        const float* bg = b1 + (size_t)u.e * 4096 + j0; const float* bu = bg + 2048;
        const f32x4 bg0 = *(const f32x4*)bg, bg1 = *(const f32x4*)(bg + 4), bu0 = *(const f32x4*)bu, bu1 = *(const f32x4*)(bu + 4);
#pragma unroll
        for (int ai = 0; ai < 2; ++ai)
#pragma unroll
            for (int m = 0; m < 4; ++m) { const size_t row = (size_t)u.e * 8192 + u.x0 * 256 + ai * 128 + wr * 64 + m * 16 + fr;
                float o[8];
#pragma unroll
                for (int n = 0; n < 2; ++n)
#pragma unroll
                    for (int e = 0; e < 4; ++e) { const float g = fminf(acc[ai][0][m][n][e] * (1.f / 256.f) + (n ? bg1[e] : bg0[e]), 7.f);
                        const float uu = fminf(fmaxf(acc[ai][1][m][n][e] * (1.f / 256.f) + (n ? bu1[e] : bu0[e]), -7.f), 7.f);
                        o[n * 4 + e] = g / (1.f + __expf(-1.702f * g)) * (uu + 1.f) * 4.f; }
                u32x2 w; w.x = __builtin_amdgcn_cvt_pk_fp8_f32(o[0], o[1], 0u, false); w.x = __builtin_amdgcn_cvt_pk_fp8_f32(o[2], o[3], w.x, true);
                w.y = __builtin_amdgcn_cvt_pk_fp8_f32(o[4], o[5], 0u, false); w.y = __builtin_amdgcn_cvt_pk_fp8_f32(o[6], o[7], w.y, true);
                *(u32x2*)(act + row * 2048 + j0) = w; }
    }
};
struct EpiMoe2 {
    static constexpr bool AFTER_DRAIN = false;
    unsigned char* y; const float* b2; const float* gate_of;
    DI void operator()(const f32x4 (&acc)[2][2][4][2], const pg8::UnitD& u, int wr, int wc, int fr, int fq) const {
        { int ln_ = threadIdx.x; asm volatile("" : "+v"(ln_)); fr = ln_ & 15; fq = (ln_ >> 4) & 3; }
        const int col0 = u.pn * 256 + wc * 32 + 8 * fq;
        const float* bp = b2 + (size_t)u.e * 2048 + col0;
#pragma unroll
        for (int ai = 0; ai < 2; ++ai)
#pragma unroll
            for (int m = 0; m < 4; ++m) { const int rl = ai * 128 + wr * 64 + m * 16 + fr; const size_t row = (size_t)u.e * 8192 + u.x0 * 256 + rl;
                const float gt = (rl < u.nvalid) ? gate_of[u.e * 8192 + u.x0 * 256 + rl] * 32.f : 0.f;
#pragma unroll
                for (int bj = 0; bj < 2; ++bj) { const f32x4 v0 = (acc[ai][bj][m][0] * (1.f / 256.f) + *(const f32x4*)(bp + bj * 128)) * gt, v1 = (acc[ai][bj][m][1] * (1.f / 256.f) + *(const f32x4*)(bp + bj * 128 + 4)) * gt;
                    u32x2 w; w.x = __builtin_amdgcn_cvt_pk_fp8_f32(v0[0], v0[1], 0u, false); w.x = __builtin_amdgcn_cvt_pk_fp8_f32(v0[2], v0[3], w.x, true);
                    w.y = __builtin_amdgcn_cvt_pk_fp8_f32(v1[0], v1[1], 0u, false); w.y = __builtin_amdgcn_cvt_pk_fp8_f32(v1[2], v1[3], w.y, true);
                    *(u32x2*)(y + row * 2048 + col0 + bj * 128) = w; } }
    }
};

DI void p11_combine(Frame& F, const ArgP& a) {
    const int gw = F.vcu * NWAVES + F.wave, NGW = F.G * NWAVES, lane = F.lane;
    const bf16_t* h2 = (const bf16_t*)(F.ws + WS_H2); const unsigned char* y = (const unsigned char*)(F.ws + WS_Y);
    const int* tok_e = (const int*)(F.ws + WS_TOKE);
    for (int t = gw; t < NTOK; t += NGW) {
        size_t yrow[4];
#pragma unroll
        for (int k = 0; k < 4; ++k) yrow[k] = (size_t)tok_e[t * 4 + k] * 2048;
#pragma unroll
        for (int j = 0; j < 8; ++j) { const int c = (lane + 64 * j) * 4;
            const u32x2 hw = *(const u32x2*)(h2 + (size_t)t * 2048 + c); f32x4 v = {bflo(hw.x), bfhi(hw.x), bflo(hw.y), bfhi(hw.y)};
#pragma unroll
            for (int k = 0; k < 4; ++k) { const unsigned w = *(const unsigned*)(y + yrow[k] + c); const f32x2 lo = __builtin_amdgcn_cvt_pk_f32_fp8(w, false), hi = __builtin_amdgcn_cvt_pk_f32_fp8(w, true);
                v.x += lo.x * (1.f / 32.f); v.y += lo.y * (1.f / 32.f); v.z += hi.x * (1.f / 32.f); v.w += hi.y * (1.f / 32.f); }
            *(f32x4*)(a.out() + (size_t)t * 2048 + c) = v; }
    }
}

#ifndef MK_PER_PHASE
#define MK_PER_PHASE 0
#endif
#ifndef MK_LAST_PHASE
#define MK_LAST_PHASE 12
#endif
constexpr int N_PHASES = MK_LAST_PHASE;

__global__ void __launch_bounds__(NWAVES * 64, 2) mega_fwd(Args args_) {
    const ArgP args{};
    extern __shared__ __attribute__((aligned(16))) unsigned char lds_raw[];
    Frame F;
    F.lds = (LAS unsigned char*)lds_raw;
    F.MISC = (volatile LAS unsigned*)(F.lds + MISC_OFF);
    F.tid = threadIdx.x; F.lane = F.tid & 63; F.wave = __builtin_amdgcn_readfirstlane(F.tid >> 6);
    F.G = gridDim.x; { const int bx = blockIdx.x; F.vcu = (F.G % 8 == 0) ? (bx % 8) * (F.G / 8) + bx / 8 : bx; }
    F.ws = args_.ws; F.ctl = (unsigned*)(args_.ws + WS_CTL);
    for (int u = F.tid; u < 256; u += NWAVES * 64) F.MISC[u] = 0u;
    __syncthreads();
    XcdBarrier bar; bar.bar = F.ctl + CW_BAR; bar.x = 0; bar.st = nullptr;
    const int lo = args_.ph_lo, hi = args_.ph_hi;
    if (hi - lo > 1) bar = xcd_barrier_post(F.ctl + CW_BAR, F.MISC + 8);
#ifndef MK_PHASE_MASK
#define MK_PHASE_MASK 0xFFFF
#endif
#define IN(k) (((MK_PHASE_MASK >> (k)) & 1) && lo <= (k) && (k) < hi)
#define SEAM(k) do { if (IN(k) && IN((k) + 1)) xcd_barrier(bar); } while (0)
#define FRESH() do { int t_ = threadIdx.x; asm volatile("" : "+v"(t_)); F.tid = t_; F.lane = t_ & 63; F.wave = __builtin_amdgcn_readfirstlane(t_ >> 6); } while (0)
    unsigned char* ws = args_.ws;

    if (IN(0)) { FRESH(); p0_prologue(F, args); }
    SEAM(0);
    if (IN(1)) { FRESH();
        const bool conv_first = (F.vcu & 1) == 0;
        if (conv_first) { conv_share(F, args); __syncthreads(); }
        SchedP1 S{F.G, F.vcu, ws, 0, 32 * 23};
        EpiP1 E{(bf16_t*)(ws + WS_PROJ), (float*)(ws + WS_DT), (bf16_t*)(ws + WS_KVRAW), args.in(I_DAQG), args.in(I_DAKG), (unsigned char*)(ws + WS_VF8)};
        pg8::gemm_phase<EpiP1, SchedP1, false, true>(F.lds + RING_OFF, 32, S, E);
        if (!conv_first) { __syncthreads(); conv_share(F, args); }
    }
    SEAM(1);
    if (IN(2)) { FRESH();
        if ((F.vcu & 3) == 1) {
            SchedP1 S{(F.G + 3) >> 2, F.vcu >> 2, ws, 32 * 23, 32 * 23 + 64};
            EpiP1 E{(bf16_t*)(ws + WS_PROJ), (float*)(ws + WS_DT), (bf16_t*)(ws + WS_KVRAW), args.in(I_DAQG), args.in(I_DAKG), (unsigned char*)(ws + WS_VF8)};
            pg8::gemm_phase<EpiP1, SchedP1, false, true>(F.lds + RING_OFF, 32, S, E);
            __syncthreads();
        }
        if ((F.vcu & 3) == 0) { for (int u = F.vcu >> 2; u < 64; u += (F.G + 3) >> 2) ssd_unit(F, args, u >> 4, u & 15); }
        __syncthreads();
        attn_phase_da(F);
        __syncthreads();
        conv_queue(F, args, CW_QCONV, CV_NJ - CV_TAIL, CV_TAIL1);
    }
    SEAM(2);
    if (IN(3)) { FRESH(); kprep(F, args); p3_finalize(F, args); }
    SEAM(3);
    if (IN(4)) { FRESH();
        SchedDense S{F.G, F.vcu, 32, 8, (const char*)(ws + WS_YCAT), (const char*)(ws + WS_WOUT), 4096u, 4096u, 1 << 30, 0};
        EpiResid<false> E{args.in(I_X), (bf16_t*)(ws + WS_H1), (float*)(ws + WS_PART1), (unsigned char*)(ws + WS_H1F8), 1.f};
        pg8::gemm_phase<EpiResid<false>, SchedDense, false, true>(F.lds + RING_OFF, 32, S, E);
    }
    SEAM(4);
    if (IN(5)) { FRESH();
        SchedDense S{F.G, F.vcu, 32, 8, (const char*)(ws + WS_H1F8), (const char*)(ws + WS_WQ), 2048u, 2048u, 1 << 30, 0};
        EpiQ E{(unsigned char*)(ws + WS_QF8), (float*)(ws + WS_PARTQ)};
        pg8::gemm_phase<EpiQ, SchedDense, false, true, true>(F.lds + RING_OFF, 16, S, E);
    }
    SEAM(5);
    if (IN(6)) { FRESH();
        SchedXS S{F.G, F.vcu, ws};
        EpiXS E{(unsigned char*)(ws + WS_P8), (unsigned char*)(ws + WS_VWT8), (const float*)(ws + WS_PART1), (const float*)(ws + WS_PARTQ), (LAS float*)(F.lds + RING_BYTES)};
        pg8::gemm_phase<EpiXS, SchedXS, false, true, true>(F.lds + RING_OFF, 4, S, E);
    }
    SEAM(6);
    if (IN(7)) { FRESH();
        SchedDense S{F.G, F.vcu, 32, 8, (const char*)(ws + WS_P8), (const char*)(ws + WS_VWT8), 1024u, 1024u, 8, (size_t)2048 * 1024};
        EpiResid<true> E{(const void*)(ws + WS_H1), (bf16_t*)(ws + WS_H2), nullptr, nullptr, 1.f / 8192.f};
        pg8::gemm_phase<EpiResid<true>, SchedDense, false, true, true>(F.lds + RING_OFF, 8, S, E);
    }
    SEAM(7);
    if (IN(8)) { FRESH(); p8_route(F, args); }
    SEAM(8);
    if (IN(9)) { FRESH();
        moe_tables(F);
        SchedMoe<16> S{F.G, F.vcu, ws, F.MISC, ldsu(F.MISC + 112) * 16};
        EpiMoe1 E{(unsigned char*)(ws + WS_ACT), args.in(I_B1)};
        pg8::gemm_phase<EpiMoe1, SchedMoe<16>, false, true, true>(F.lds + RING_OFF, 16, S, E);
        __syncthreads();
        conv_queue(F, args, CW_QCONV2, CV_NJ - CV_TAIL2, CV_TAIL2);
    }
    SEAM(9);
    if (IN(10)) { FRESH();
        moe_tables(F);
        SchedMoe<8> S{F.G, F.vcu, ws, F.MISC, ldsu(F.MISC + 112) * 8};
        EpiMoe2 E{(unsigned char*)(ws + WS_Y), args.in(I_B2), (const float*)(ws + WS_GATEOF)};
        pg8::gemm_phase<EpiMoe2, SchedMoe<8>, false, true, true>(F.lds + RING_OFF, 16, S, E);
    }
    SEAM(10);
    if (IN(11)) { FRESH(); p11_combine(F, args); }
#undef IN
#undef SEAM
}

extern "C" void kernel_launch(void* const* d_in, const int* in_sizes, int n_in, void* d_out, int out_size, void* d_ws, size_t ws_size, hipStream_t stream) {
    static int grid = 0;
    if (grid == 0) {
        if (n_in != 32 || out_size != NTOK * 2048 || ws_size < WS_END) { fprintf(stderr, "kernel_launch: unexpected shapes (n_in %d out %d ws %zu); nothing launched\n", n_in, out_size, ws_size); grid = -1; return; }
        int dev = 0, cus = 0, per_cu = 0;
        if (hipGetDevice(&dev) != hipSuccess || hipDeviceGetAttribute(&cus, hipDeviceAttributeMultiprocessorCount, dev) != hipSuccess) { grid = -1; return; }
        if (hipFuncSetAttribute((const void*)mega_fwd, hipFuncAttributeMaxDynamicSharedMemorySize, LDS_BYTES) != hipSuccess) { fprintf(stderr, "kernel_launch: hipFuncSetAttribute failed\n"); grid = -1; return; }
        if (hipOccupancyMaxActiveBlocksPerMultiprocessor(&per_cu, (const void*)mega_fwd, NWAVES * 64, LDS_BYTES) != hipSuccess || per_cu < 1) { fprintf(stderr, "kernel_launch: occupancy query says %d\n", per_cu); }
        (void)hipGetLastError();
        if (cus < 256) { fprintf(stderr, "kernel_launch: needs 256 CUs, found %d; nothing launched\n", cus); grid = -1; return; }
        grid = 256;
    }
    if (grid < 0) return;
    if (hipMemsetAsync((char*)d_ws + WS_CTL, 0, CTL_ZERO_BYTES, stream) != hipSuccess) return;
    Args a{};
    for (int i = 0; i < 32; ++i) a.in[i] = (const float*)d_in[i];
    a.out = (float*)d_out; a.ws = (unsigned char*)d_ws;
#if MK_PER_PHASE
    for (int p = 0; p < N_PHASES; ++p) { a.ph_lo = p; a.ph_hi = p + 1; hipLaunchKernelGGL(mega_fwd, dim3(grid), dim3(NWAVES * 64), LDS_BYTES, stream, a); }
#else
    a.ph_lo = 0; a.ph_hi = N_PHASES;
    hipLaunchKernelGGL(mega_fwd, dim3(grid), dim3(NWAVES * 64), LDS_BYTES, stream, a);
#ifdef MK_PROBE_LO
    for (int p = MK_PROBE_LO; p < MK_PROBE_HI; ++p) { a.ph_lo = p; a.ph_hi = p + 1;
        if (p == 2) (void)hipMemsetAsync((char*)d_ws + WS_CTL + CW_QATT * 4, 0, 1024, stream);
        hipLaunchKernelGGL(mega_fwd, dim3(grid), dim3(NWAVES * 64), LDS_BYTES, stream, a); }
#endif
#endif
}
```

```cpp
#define MK_PER_PHASE 0
#define MK_LAST_PHASE 12
#include <hip/hip_runtime.h>
#include <hip/hip_bf16.h>
#include <cstdio>
#include <cstdint>
#include <cmath>

#define GAS __attribute__((address_space(1)))
#define LAS __attribute__((address_space(3)))
typedef unsigned short bf16_t;
typedef short bf16x8 __attribute__((ext_vector_type(8)));
typedef float f32x2 __attribute__((ext_vector_type(2)));
typedef float f32x4 __attribute__((ext_vector_type(4)));
typedef float f32x16 __attribute__((ext_vector_type(16)));
typedef unsigned u32x2 __attribute__((ext_vector_type(2)));
typedef unsigned u32x4 __attribute__((ext_vector_type(4)));
typedef __bf16 bf16x2_t __attribute__((ext_vector_type(2)));

#define DI __device__ __forceinline__
DI unsigned pk2(float lo, float hi) { f32x2 v = {lo, hi}; bf16x2_t b = __builtin_convertvector(v, bf16x2_t); return __builtin_bit_cast(unsigned, b); }
DI float bflo(unsigned u) { return __uint_as_float(u << 16); }
DI float bfhi(unsigned u) { return __uint_as_float(u & 0xffff0000u); }
DI float bf2f(bf16_t h) { return __uint_as_float(((unsigned)h) << 16); }
DI float wave_sum(float v) {
#pragma unroll
    for (int o = 1; o < 64; o <<= 1) v += __shfl_xor(v, o);
    return v;
}
DI float quad_sum_16_32(float v) {
    int l_ = threadIdx.x; asm volatile("" : "+v"(l_));
    const int a16 = ((l_ ^ 16) & 63) << 2, a32 = ((l_ ^ 32) & 63) << 2;
    v += __builtin_bit_cast(float, __builtin_amdgcn_ds_bpermute(a16, __builtin_bit_cast(int, v)));
    v += __builtin_bit_cast(float, __builtin_amdgcn_ds_bpermute(a32, __builtin_bit_cast(int, v)));
    return v;
}
DI float siluf(float x) { return x / (1.f + __expf(-x)); }

constexpr int DM_ = 2048, NB = 4, SEQ_ = 2048, NTOK = NB * SEQ_;
constexpr int PP = 5632;
constexpr int PC_XBC = 1024, PC_Q = 2560, PC_K = 3584, PC_V = 4608, PC_DT = 5632;
constexpr int WIN_ROWS = 5888;
constexpr int NEXP = 32, MEMLEN = 256;
constexpr float EPS_ = 1e-6f;
constexpr float LAM_INIT = 0.2f;

namespace pg8 {
constexpr int BM = 256, BK = 64, HALF = 128, HTB = HALF * BK * 2  , STAGE_BYTES = 8 * HTB;
DI int lds_byte(int r, int c) { const int st = (r >> 4) * 2 + (c >> 5), rr = r & 15, cc = c & 31, ob = rr * 64 + cc * 2; return st * 1024 + (ob ^ (((ob >> 9) & 1) << 5)); }
DI void stage_rc(int b, int& R, int& C) { const int st = b / 1024, sb = b % 1024, swz = sb ^ (((sb >> 9) & 1) << 5); R = (st >> 1) * 16 + swz / 64; C = (st & 1) * 32 + (swz % 64) / 2; }
DI int perm32(int rho) { const int n = rho >> 4, i = rho & 15; return 8 * (i >> 2) + 4 * n + (i & 3); }

struct UnitD {
    const char* A; const char* B;
    const int* rows;
    unsigned lda, ldb;
    int nvalid;
    int type, pm, pn, e, x0;
};
typedef int v8i_t __attribute__((ext_vector_type(8)));
DI v8i_t cat8(bf16x8 lo, bf16x8 hi) { typedef int v4i_t __attribute__((ext_vector_type(4))); const v4i_t a = __builtin_bit_cast(v4i_t, lo), b = __builtin_bit_cast(v4i_t, hi); return (v8i_t){a[0], a[1], a[2], a[3], b[0], b[1], b[2], b[3]}; }
DI void dense_voff(unsigned lda, unsigned ldb, int tid, unsigned (&vA)[2], unsigned (&vB)[2]) {
#pragma unroll
    for (int i = 0; i < 2; ++i) { int R, C; stage_rc(tid * 16 + i * 8192, R, C); const int Rb = (R & ~31) + perm32(R & 31);
        vA[i] = (unsigned)R * lda + (unsigned)C * 2u; vB[i] = (unsigned)Rb * ldb + (unsigned)C * 2u; }
}
DI void gather_voff(const UnitD& u, int tid, unsigned (&gA)[2][2]) {
#pragma unroll
    for (int i = 0; i < 2; ++i) { int R, C; stage_rc(tid * 16 + i * 8192, R, C);
#pragma unroll
        for (int h = 0; h < 2; ++h) { const int ra = h * 128 + R; const unsigned rowA = (ra < u.nvalid) ? (unsigned)u.rows[ra] : 0u; gA[h][i] = rowA * u.lda + (unsigned)C * 2u; } }
}

template <class Epi, class Sched, bool GATHER, bool ALIGN_EPI, bool FP8 = false>
DI void gemm_phase(LAS unsigned char* lds, int nt, const Sched& S, const Epi& E) {

    const int tid = threadIdx.x, wid = __builtin_amdgcn_readfirstlane(tid >> 6), lane = tid & 63, wr = wid >> 2, wc = wid & 3, fr = lane & 15, fq = lane >> 4;
#ifndef MK_HOTPROBE
#define PG8_NODMA false
#define PG8_NOMMA false
#define PG8_NOLD false
#define PG8_NOEPI false
#define PG8_NOLOOP false
#else
#define PG8_NODMA ((hot_ & 4) != 0)
#define PG8_NOMMA ((hot_ & 8) != 0)
#define PG8_NOLD ((hot_ & 16) != 0)
#define PG8_NOEPI ((hot_ & 32) != 0)
#define PG8_NOLOOP ((hot_ & 64) != 0)
#endif
#ifdef MK_HOTPROBE
    int hot_; { typedef const __attribute__((address_space(4))) char* kptr; kptr kp = (kptr)__builtin_amdgcn_kernarg_segment_ptr(); asm volatile("" : "+s"(kp)); hot_ = *(const int __attribute__((address_space(4)))*)(kp + 280); }
    const size_t kstep = (hot_ & 1) ? (size_t)0 : (size_t)(BK * 2);
#else
    const size_t kstep = (size_t)(BK * 2);
#endif
    const unsigned ldsb = (unsigned)__builtin_amdgcn_readfirstlane((int)((unsigned)(uintptr_t)lds + (unsigned)wid * 1024u));
    const int aoff = lds_byte(wr * 64 + fr, fq * 8), boff = lds_byte(wc * 32 + fr, fq * 8);
#define PG8_SA(b, h) (((b) * 2 + (h)) * HTB)
#define PG8_SB(b, h) ((4 + (b) * 2 + (h)) * HTB)
#define PG8_STAGE(bufoff, gbase, voff) do { if (PG8_NODMA) break; _Pragma("unroll") for (int _i = 0; _i < 2; ++_i) { unsigned keep_; \
        asm volatile("s_mov_b32 %0, m0\n\ts_mov_b32 m0, %3\n\ts_nop 0\n\tglobal_load_lds_dwordx4 %1, %2\n\ts_mov_b32 m0, %0" \
                     : "=&s"(keep_) : "v"((voff)[_i]), "s"((const char*)(gbase)), "s"(ldsb + (unsigned)((bufoff) + _i * 8192)) : "memory"); } } while (0)
#define PG8_STA(bufoff, gbase, h, HS, GA) do { if constexpr (GATHER) { PG8_STAGE(bufoff, gbase, GA[h]); } else { PG8_STAGE(bufoff, (gbase) + (h) * (HS), vA); } } while (0)
#define PG8_STB(bufoff, gbase, h, HS) PG8_STAGE(bufoff, (gbase) + (h) * (HS), vB)
typedef int v4i_t __attribute__((ext_vector_type(4)));
#define PG8_LDA(dst, b, h) do { if (PG8_NOLD) break; _Pragma("unroll") for (int m = 0; m < 4; ++m) { if constexpr (FP8) { \
            const v4i_t lo_ = *(const LAS v4i_t*)(lds + PG8_SA(b, h) + aoff + m * 2048), hi_ = *(const LAS v4i_t*)(lds + PG8_SA(b, h) + aoff + m * 2048 + 1024); \
            dst##8[m] = __builtin_shufflevector(lo_, hi_, 0, 1, 2, 3, 4, 5, 6, 7); } \
        else { _Pragma("unroll") for (int k = 0; k < 2; ++k) dst[m][k] = *(const LAS bf16x8*)(lds + PG8_SA(b, h) + aoff + m * 2048 + k * 1024); } } } while (0)
#define PG8_LDB(dst, b, h) do { if (PG8_NOLD) break; _Pragma("unroll") for (int n = 0; n < 2; ++n) { if constexpr (FP8) { \
            const v4i_t lo_ = *(const LAS v4i_t*)(lds + PG8_SB(b, h) + boff + n * 2048), hi_ = *(const LAS v4i_t*)(lds + PG8_SB(b, h) + boff + n * 2048 + 1024); \
            dst##8[n] = __builtin_shufflevector(lo_, hi_, 0, 1, 2, 3, 4, 5, 6, 7); } \
        else { _Pragma("unroll") for (int k = 0; k < 2; ++k) dst[n][k] = *(const LAS bf16x8*)(lds + PG8_SB(b, h) + boff + n * 2048 + k * 1024); } } } while (0)
#ifndef PG8_FP8_PRIO
#define PG8_FP8_PRIO 1
#endif
#define PG8_MMA(ai, bj, At, Bt) do { if (PG8_NOMMA) break; if (!FP8 || PG8_FP8_PRIO) __builtin_amdgcn_s_setprio(1); _Pragma("unroll") for (int m = 0; m < 4; ++m) _Pragma("unroll") for (int n = 0; n < 2; ++n) { \
        if constexpr (FP8) { acc[ai][bj][m][n] = __builtin_amdgcn_mfma_scale_f32_16x16x128_f8f6f4(Bt##8[n], At##8[m], acc[ai][bj][m][n], 0, 0, 0, 0x7f7f7f7f, 0, 0x7f7f7f7f); } \
        else { _Pragma("unroll") for (int k = 0; k < 2; ++k) acc[ai][bj][m][n] = __builtin_amdgcn_mfma_f32_16x16x32_bf16(Bt[n][k], At[m][k], acc[ai][bj][m][n], 0, 0, 0); } } \
        if (!FP8 || PG8_FP8_PRIO) __builtin_amdgcn_s_setprio(0); } while (0)
#define PG8_WAIT_V(n) asm volatile("s_waitcnt vmcnt(" #n ")" ::: "memory")
#define PG8_WAIT_L(n) asm volatile("s_waitcnt lgkmcnt(" #n ")" ::: "memory")
#define PG8_BAR __builtin_amdgcn_s_barrier()
#define PG8_SCHED __builtin_amdgcn_sched_barrier(0)
#define PG8_ITER(A1P, A2P, B2P, HA2, HB2, GA2) do { \
        const char* a3p_ = (A2P) + kstep; const char* b3p_ = (B2P) + kstepB; \
        PG8_LDB(B0, 0, 0); PG8_LDB(B1, 0, 1); PG8_SCHED; PG8_LDA(At, 0, 0); PG8_STA(PG8_SA(1, 1), (A1P), 1, hsA, gA); \
        PG8_WAIT_V(8); PG8_WAIT_L(0); PG8_BAR; PG8_MMA(0, 0, At, B0); PG8_MMA(0, 1, At, B1); PG8_BAR; PG8_SCHED; \
        PG8_LDA(At, 0, 1); PG8_STB(PG8_SB(0, 0), (B2P), 0, HB2); PG8_STB(PG8_SB(0, 1), (B2P), 1, HB2); PG8_STA(PG8_SA(0, 0), (A2P), 0, HA2, GA2); \
        PG8_WAIT_V(8); PG8_WAIT_L(0); PG8_BAR; PG8_MMA(1, 0, At, B0); PG8_MMA(1, 1, At, B1); PG8_BAR; PG8_SCHED; \
        PG8_LDB(B0, 1, 0); PG8_LDB(B1, 1, 1); PG8_SCHED; PG8_LDA(At, 1, 0); PG8_STA(PG8_SA(0, 1), (A2P), 1, HA2, GA2); \
        PG8_WAIT_V(8); PG8_WAIT_L(0); PG8_BAR; PG8_MMA(0, 0, At, B0); PG8_MMA(0, 1, At, B1); PG8_BAR; PG8_SCHED; \
        PG8_LDA(At, 1, 1); PG8_STB(PG8_SB(1, 0), b3p_, 0, HB2); PG8_STB(PG8_SB(1, 1), b3p_, 1, HB2); PG8_STA(PG8_SA(1, 0), a3p_, 0, HA2, GA2); \
        PG8_WAIT_V(8); PG8_WAIT_L(0); PG8_BAR; PG8_MMA(1, 0, At, B0); PG8_MMA(1, 1, At, B1); PG8_BAR; PG8_SCHED; \
    } while (0)
    UnitD cur, nxt; int ui = 0;
    if (!S.next(0, cur)) return;
    f32x4 acc[2][2][4][2];
#pragma unroll
    for (int a = 0; a < 2; ++a)
#pragma unroll
        for (int b = 0; b < 2; ++b)
#pragma unroll
            for (int m = 0; m < 4; ++m)
#pragma unroll
                for (int n = 0; n < 2; ++n) acc[a][b][m][n] = (f32x4){0.f, 0.f, 0.f, 0.f};
    bf16x8 At[4][2], B0[2][2], B1[2][2]; v8i_t At8[4], B08[2], B18[2];
    unsigned vA[2], vB[2], gA[2][2], ngA[2][2];
    dense_voff(cur.lda, cur.ldb, tid, vA, vB);
#ifdef MK_HOTPROBE
    const size_t kstepB = (hot_ & 2) ? (size_t)0 : ((cur.ldb == 128u) ? (size_t)32768 : (size_t)(BK * 2));
#else
    const size_t kstepB = (cur.ldb == 128u) ? (size_t)32768 : kstep;
#endif
    if constexpr (GATHER) gather_voff(cur, tid, gA);
    const char* cA = cur.A; const char* cB = cur.B;
    size_t hsA = GATHER ? 0 : (size_t)cur.lda * HALF, hsB = (size_t)cur.ldb * HALF;
    PG8_STB(PG8_SB(0, 0), cB, 0, hsB); PG8_STB(PG8_SB(0, 1), cB, 1, hsB); PG8_STA(PG8_SA(0, 0), cA, 0, hsA, gA); PG8_STA(PG8_SA(0, 1), cA, 1, hsA, gA);
    if (wr == 1) PG8_BAR;
    PG8_WAIT_V(2); PG8_BAR;
    PG8_STB(PG8_SB(1, 0), cB + kstepB, 0, hsB); PG8_STA(PG8_SA(1, 0), cA + kstep, 0, hsA, gA); PG8_STB(PG8_SB(1, 1), cB + kstepB, 1, hsB);
    PG8_WAIT_V(6); PG8_BAR;
    for (;;) {
        const bool has_next = S.next(ui + 1, nxt);
        const char* nA = cA; const char* nB = cB; size_t nhsA = hsA, nhsB = hsB;
        if (has_next) { nA = nxt.A; nB = nxt.B; nhsA = GATHER ? 0 : (size_t)nxt.lda * HALF; nhsB = (size_t)nxt.ldb * HALF; }
        if constexpr (GATHER) {
            if (has_next) gather_voff(nxt, tid, ngA);
            else {
#pragma unroll
                for (int h = 0; h < 2; ++h)
#pragma unroll
                    for (int i = 0; i < 2; ++i) ngA[h][i] = gA[h][i];
            }
        }
#pragma unroll 1
        for (int t = 0; t < (PG8_NOLOOP ? 0 : nt); t += 2) {
            const bool last = (t == nt - 2);
            const char* a2 = last ? nA : cA + (size_t)(t + 2) * kstep; const char* b2 = last ? nB : cB + (size_t)(t + 2) * kstepB;
            const size_t hA2 = last ? nhsA : hsA, hB2 = last ? nhsB : hsB;
            unsigned g2[2][2];
            if constexpr (GATHER) {
#pragma unroll
                for (int h = 0; h < 2; ++h)
#pragma unroll
                    for (int i = 0; i < 2; ++i) g2[h][i] = last ? ngA[h][i] : gA[h][i];
            }
            PG8_ITER(cA + (size_t)(t + 1) * kstep, a2, b2, hA2, hB2, g2);
        }
        if constexpr (ALIGN_EPI) { if (wr == 0) PG8_BAR; }
        if constexpr (!Epi::AFTER_DRAIN) { if (!PG8_NOEPI) E(acc, cur, wr, wc, fr, fq); }
        if (!has_next) break;
#pragma unroll
        for (int a = 0; a < 2; ++a)
#pragma unroll
            for (int b = 0; b < 2; ++b)
#pragma unroll
                for (int m = 0; m < 4; ++m)
#pragma unroll
                    for (int n = 0; n < 2; ++n) acc[a][b][m][n] = (f32x4){0.f, 0.f, 0.f, 0.f};
        cur = nxt; cA = nA; cB = nB; hsA = nhsA; hsB = nhsB; ++ui;
        if constexpr (GATHER) {
#pragma unroll
            for (int h = 0; h < 2; ++h)
#pragma unroll
                for (int i = 0; i < 2; ++i) gA[h][i] = ngA[h][i];
        }
        if constexpr (ALIGN_EPI) { if (wr == 1) PG8_BAR; }
    }
    PG8_WAIT_V(0);
    if constexpr (!ALIGN_EPI) { if (wr == 0) PG8_BAR; }
    PG8_BAR;
    if constexpr (Epi::AFTER_DRAIN) { E.fused(acc, cur, wr, wc, fr, fq, lds, wid, lane); }
#undef PG8_SA
#undef PG8_SB
#undef PG8_STAGE
#undef PG8_STA
#undef PG8_STB
#undef PG8_LDA
#undef PG8_LDB
#undef PG8_MMA
#undef PG8_WAIT_V
#undef PG8_WAIT_L
#undef PG8_BAR
#undef PG8_SCHED
#undef PG8_ITER
}
}
namespace attn_body {
using bf16=__hip_bfloat16;
using bf16x8=__attribute__((ext_vector_type(8)))short;
using s16x4=__attribute__((ext_vector_type(4)))short;
using f32x16=__attribute__((ext_vector_type(16)))float;
using u32x4=__attribute__((ext_vector_type(4)))unsigned;
constexpr int BATCH=4,SEQ=2048,D=64,DM=5632,OPITCH=1024;
constexpr int NW=8,QBLK=32,QB=QBLK*NW,KVBLK=64,NQB=SEQ/QB;
constexpr int ATTN_UNIT_ROWS=QB;
__device__ __forceinline__ int crow(int r,int hi){return (r&3)+8*(r>>2)+4*hi;}
#define SBAR() __builtin_amdgcn_sched_barrier(0)
__device__ __forceinline__ void cmask(f32x16&p0,f32x16&p1,int jb,int qrel,int hi){
  const float NEG=-INFINITY; int kb=64*jb+4*hi;
  #pragma unroll
  for(int r=0;r<16;++r){int kv=kb+(r&3)+8*(r>>2); if(kv>qrel)p0[r]=NEG; if(kv+32>qrel)p1[r]=NEG;}
}

constexpr int NSLOT=3, SLOTB=8192;
constexpr int LDS_K=0, LDS_V=NSLOT*SLOTB, LDS_WS=2*NSLOT*SLOTB, LDS_OST=LDS_WS+NW*64*4, LDS_BYTES=LDS_OST+NW*4096;
constexpr float C2=0.125f*1.4426950408889634f;
__device__ __forceinline__ void glds16(const void*gsrc,unsigned lds_dst){unsigned keep;
  asm volatile("s_mov_b32 %0, m0\n\ts_mov_b32 m0, %2\n\ts_nop 0\n\tglobal_load_lds_dwordx4 %1, off\n\ts_mov_b32 m0, %0":"=&s"(keep):"v"(gsrc),"s"(lds_dst):"memory");}
__device__ __forceinline__ float max3f(float a,float b,float c){float r;asm("v_max3_f32 %0, %1, %2, %3":"=v"(r):"v"(a),"v"(b),"v"(c));return r;}
__device__ __forceinline__ float max2f(float a,float b){float r;asm("v_max_f32_e32 %0, %1, %2":"=v"(r):"v"(a),"v"(b));return r;}
__device__ __forceinline__ float fadd_s(float a,float b){float r;asm("v_add_f32_e32 %0, %1, %2":"=v"(r):"v"(a),"v"(b));return r;}
__device__ __forceinline__ float fsub_s(float a,float b){float r;asm("v_sub_f32_e32 %0, %1, %2":"=v"(r):"v"(a),"v"(b));return r;}
typedef float f32x2_t __attribute__((ext_vector_type(2))); typedef __bf16 bf16x2_t __attribute__((ext_vector_type(2)));
__device__ __forceinline__ unsigned cvtpk_s(float lo,float hi){f32x2_t v={lo,hi};bf16x2_t b=__builtin_convertvector(v,bf16x2_t);return __builtin_bit_cast(unsigned,b);}
#define WAIT_BAR(N) asm volatile("s_waitcnt vmcnt(" #N ") lgkmcnt(0)\n\ts_barrier":::"memory")

__device__ __forceinline__ void qkt(f32x16&p0,f32x16&p1,const char*Kslot,const bf16x8*qr,const f32x16&negm,int r32,int hi){
  const char*kb=Kslot+hi*1024+r32*16;
  #pragma unroll
  for(int d0=0;d0<4;++d0){
    const bf16x8 b0=*reinterpret_cast<const bf16x8*>(kb+d0*2048);
    const bf16x8 b1=*reinterpret_cast<const bf16x8*>(kb+d0*2048+512);
    if(d0==0){p0=__builtin_amdgcn_mfma_f32_32x32x16_bf16(b0,qr[0],negm,0,0,0);p1=__builtin_amdgcn_mfma_f32_32x32x16_bf16(b1,qr[0],negm,0,0,0);}
    else{p0=__builtin_amdgcn_mfma_f32_32x32x16_bf16(b0,qr[d0],p0,0,0,0);p1=__builtin_amdgcn_mfma_f32_32x32x16_bf16(b1,qr[d0],p1,0,0,0);}}
}
typedef __attribute__((address_space(3))) const char* lds_cptr;
typedef short v4i16_t __attribute__((ext_vector_type(4)));
__device__ __forceinline__ void kload8(bf16x8*kf,lds_cptr kp){
  kf[0]=*(const __attribute__((address_space(3))) bf16x8*)(kp);      kf[1]=*(const __attribute__((address_space(3))) bf16x8*)(kp+512);
  kf[2]=*(const __attribute__((address_space(3))) bf16x8*)(kp+2048); kf[3]=*(const __attribute__((address_space(3))) bf16x8*)(kp+2560);
  kf[4]=*(const __attribute__((address_space(3))) bf16x8*)(kp+4096); kf[5]=*(const __attribute__((address_space(3))) bf16x8*)(kp+4608);
  kf[6]=*(const __attribute__((address_space(3))) bf16x8*)(kp+6144); kf[7]=*(const __attribute__((address_space(3))) bf16x8*)(kp+6656);
}
__device__ __forceinline__ void kload2(bf16x8*kf,lds_cptr kp,int j){ kf[2*j]=*(const __attribute__((address_space(3))) bf16x8*)(kp+j*2048); kf[2*j+1]=*(const __attribute__((address_space(3))) bf16x8*)(kp+j*2048+512); }
__device__ __forceinline__ s16x4 vtr(lds_cptr p){ return __builtin_bit_cast(s16x4,__builtin_amdgcn_ds_read_tr16_b64_v4i16((__attribute__((address_space(3))) v4i16_t*)p)); }
__device__ __forceinline__ float rowmax(const f32x16&p0,const f32x16&p1){
  float a=max3f(p0[0],p0[1],p1[0]),b=max3f(p0[2],p0[3],p1[1]);a=max3f(a,p1[2],p1[3]);
  #pragma unroll
  for(int r=4;r<16;r+=4){a=max3f(a,p0[r],p0[r+1]);b=max3f(b,p0[r+2],p0[r+3]);a=max3f(a,p1[r],p1[r+1]);b=max3f(b,p1[r+2],p1[r+3]);}
  const float m=max2f(a,b);
  auto rr=__builtin_amdgcn_permlane32_swap(__float_as_uint(m),__float_as_uint(m),false,false);
  return max2f(__uint_as_float(rr[0]),__uint_as_float(rr[1]));
}
__device__ __forceinline__ void pv(f32x16*o,int vb,bf16x8 pa0,bf16x8 pa1,bf16x8 pa2,bf16x8 pa3){
  #pragma unroll
  for(int d0=0;d0<2;++d0){s16x4 lo[4],hi[4];
    #pragma unroll
    for(int ks=0;ks<4;++ks){
      asm volatile("ds_read_b64_tr_b16 %0,%1 offset:%c2":"=&v"(lo[ks]):"v"(vb),"i"(d0*4096+ks*1024):"memory");
      asm volatile("ds_read_b64_tr_b16 %0,%1 offset:%c2":"=&v"(hi[ks]):"v"(vb),"i"(d0*4096+ks*1024+512):"memory");}
    asm volatile("s_waitcnt lgkmcnt(0)":::"memory");SBAR();
    #define PK(k) (bf16x8){lo[k][0],lo[k][1],lo[k][2],lo[k][3],hi[k][0],hi[k][1],hi[k][2],hi[k][3]}
    o[d0]=__builtin_amdgcn_mfma_f32_32x32x16_bf16(pa0,PK(0),o[d0],0,0,0);
    o[d0]=__builtin_amdgcn_mfma_f32_32x32x16_bf16(pa1,PK(1),o[d0],0,0,0);
    o[d0]=__builtin_amdgcn_mfma_f32_32x32x16_bf16(pa2,PK(2),o[d0],0,0,0);
    o[d0]=__builtin_amdgcn_mfma_f32_32x32x16_bf16(pa3,PK(3),o[d0],0,0,0);
    #undef PK
  }
}

#ifndef ATTN_STORE16
#define ATTN_STORE16(p,v) (*(u32x4*)(p)=(v))
#endif
template<int THRL> __device__ __forceinline__ void attn_unit(int b,int qcol,int vcol,int ocol,int qb,const bf16*Q,const bf16*__restrict__ K,const bf16*__restrict__ V,bf16*O,char*shm){
  const int tid=threadIdx.x,lane=tid&63,r32=lane&31,hi=lane>>5; const int wid=__builtin_amdgcn_readfirstlane(tid>>6);
  const long rowbase=(long)b*SEQ; const int q0=qb*QB;
  const bf16*Qw=Q+(rowbase+q0+wid*QBLK)*DM+qcol;
  const bf16*Kh=K+rowbase*DM+qcol,*Vh=V+rowbase*DM+vcol;
  const unsigned lds0=(unsigned)(uintptr_t)shm;
  float*wsf=(float*)(shm+LDS_WS)+wid*64;
  const bf16*ksrc=Kh+(long)lane*DM+wid*8;
  const bf16*vsrc=Vh+(long)(16*(wid&3)+(lane>>2))*DM+(wid>>2)*32+(lane&3)*8;
  const unsigned kdst=lds0+LDS_K+wid*1024, vdst=lds0+LDS_V+wid*1024;
  #define DMA_K(t,slot) glds16(ksrc+(long)(t)*KVBLK*DM,(unsigned)__builtin_amdgcn_readfirstlane(kdst+(slot)))
  #define DMA_V(t,slot) glds16(vsrc+(long)(t)*KVBLK*DM,(unsigned)__builtin_amdgcn_readfirstlane(vdst+(slot)))
  const int vb0=(int)(lds0+LDS_V)+((lane>>4)&1)*32+(lane&3)*8+(4*hi+((lane&15)>>2))*64;
  const char*Kbase=shm+LDS_K; bf16x8 kf[8];
  const lds_cptr shm3=(lds_cptr)shm; const lds_cptr kp0=shm3+LDS_K+hi*1024+r32*16; const lds_cptr vp0=shm3+LDS_V+((lane>>4)&1)*32+(lane&3)*8+(4*hi+((lane&15)>>2))*64;
  const int NT=(q0+QB)/KVBLK;
  DMA_K(0,0);DMA_V(0,0);DMA_K(1,SLOTB);
  bf16x8 qr[4];
  #pragma unroll
  for(int d0=0;d0<4;++d0)qr[d0]=*reinterpret_cast<const bf16x8*>(&Qw[(long)r32*DM+d0*16+hi*8]);
  float mhat=0.f,l_reg=0.f;f32x16 o[2];o[0]=f32x16{};o[1]=f32x16{};f32x16 negm=f32x16{};asm volatile("":"+v"(negm));
  const int qrel=wid*QBLK+r32;
  #define CMASK(P0,P1,t) do{int jb_=(t)-(NT-4); if(jb_>=0)cmask(P0,P1,jb_,qrel,hi);}while(0)
  bool resc=false;
  #define START(P0,P1) do{ const float rm=rowmax(P0,P1); resc=false; \
    { const float dl=rm; mhat=fadd_s(mhat,dl); \
      _Pragma("unroll") for(int r=0;r<16;++r){P0[r]=fsub_s(P0[r],dl);P1[r]=fsub_s(P1[r],dl);} \
      _Pragma("unroll") for(int r=0;r<16;++r)negm[r]=-mhat; asm volatile("":"+v"(negm)); } \
    _Pragma("unroll") for(int r=0;r<16;++r)P0[r]=__builtin_amdgcn_exp2f(P0[r]); }while(0)
  #define RESC() do{ if(resc){ asm volatile("s_waitcnt lgkmcnt(0)":::"memory"); \
      _Pragma("unroll") for(int d_=0;d_<2;++d_) _Pragma("unroll") for(int r=0;r<16;++r)o[d_][r]*=wsf[crow(r,hi)]; } }while(0)
  f32x16 pA0,pA1,pB0,pB1;
  int sl_prev=0,sl_cur=0,sl_next=SLOTB;
  #define ROT() do{sl_prev=sl_cur;sl_cur=sl_next;sl_next=(sl_next==(NSLOT-1)*SLOTB)?0:sl_next+SLOTB;}while(0)
  DMA_K(2,2*SLOTB);
  WAIT_BAR(3);
  qkt(pA0,pA1,Kbase,qr,negm,r32,hi);asm volatile("s_nop 15\n\ts_nop 7":"+v"(pA0),"+v"(pA1));CMASK(pA0,pA1,0);
  START(pA0,pA1);
  _Pragma("unroll") for(int r=0;r<16;++r)pA1[r]=__builtin_amdgcn_exp2f(pA1[r]);
  WAIT_BAR(0);
  DMA_K(3,0);DMA_V(1,SLOTB);
  ROT();
  kload8(kf,kp0+sl_cur);
  WAIT_BAR(2);
  s16x4 vlo[8],vhi[8]; u32x4 pw0,pw1,pw2,pw3;
  #define PKW(P,B) cvtpk_s(P[B],P[B+1])
  #define PAF(k) __builtin_bit_cast(bf16x8,pw##k)
  #define VFR(i) (bf16x8){vlo[i][0],vlo[i][1],vlo[i][2],vlo[i][3],vhi[i][0],vhi[i][1],vhi[i][2],vhi[i][3]}
  #define PIN(x) asm volatile("":"+v"(x))
  #define MX3(a,b,c) __builtin_fmaxf(__builtin_fmaxf((a),(b)),(c))
  #define GAPA(MF,A0,A1,A2,A3,W0,W1,PW) do{ MF; sacc+=A0; sacc+=A1; sacc+=A2; sacc+=A3; PIN(sacc); W0; W1; PIN(PW); SBAR(); }while(0)
  #define EX(v) __builtin_amdgcn_exp2f(v)
  #define GAPB(MF,X,B) do{ MF; X[B]=EX(X[B]); X[B+1]=EX(X[B+1]); X[B+2]=EX(X[B+2]); X[B+3]=EX(X[B+3]); PIN(X); SBAR(); }while(0)
  #define VRD(i) do{ vlo[i]=vtr(vp_+(((i)>>2)*4096+((i)&3)*1024)); vhi[i]=vtr(vp_+(((i)>>2)*4096+((i)&3)*1024+512)); }while(0)
  #define KRD(G,j) do{ if(G){ kload2(kf,kp0+sl_next,j); SBAR(); } }while(0)
  #define STEP(C0,C1,P0,P1,t,GK,GV,GL) do{ SBAR(); \
    const lds_cptr vp_=vp0+sl_prev; \
    VRD(0); SBAR(); float sacc=(P0[0]+P0[1]); \
    GAPA(C0=__builtin_amdgcn_mfma_f32_32x32x16_bf16(kf[0],qr[0],negm,0,0,0), P0[2],P0[3],P0[4],P0[5],     pw0[0]=PKW(P0,0), pw0[1]=PKW(P0,2), pw0); \
    VRD(4); SBAR(); GAPA(C1=__builtin_amdgcn_mfma_f32_32x32x16_bf16(kf[1],qr[0],negm,0,0,0), P0[6],P0[7],P0[8],P0[9],     pw0[2]=PKW(P0,4), pw0[3]=PKW(P0,6), pw0); \
    VRD(1); SBAR(); GAPA(C0=__builtin_amdgcn_mfma_f32_32x32x16_bf16(kf[2],qr[1],C0,0,0,0),   P0[10],P0[11],P0[12],P0[13], pw1[0]=PKW(P0,8), pw1[1]=PKW(P0,10), pw1); \
    VRD(5); SBAR(); GAPA(C1=__builtin_amdgcn_mfma_f32_32x32x16_bf16(kf[3],qr[1],C1,0,0,0),   P0[14],P0[15],P1[0],P1[1],   pw1[2]=PKW(P0,12),pw1[3]=PKW(P0,14), pw1); \
    VRD(2); SBAR(); GAPA(C0=__builtin_amdgcn_mfma_f32_32x32x16_bf16(kf[4],qr[2],C0,0,0,0),   P1[2],P1[3],P1[4],P1[5],     pw2[0]=PKW(P1,0), pw2[1]=PKW(P1,2), pw2); \
    VRD(6); SBAR(); GAPA(C1=__builtin_amdgcn_mfma_f32_32x32x16_bf16(kf[5],qr[2],C1,0,0,0),   P1[6],P1[7],P1[8],P1[9],     pw2[2]=PKW(P1,4), pw2[3]=PKW(P1,6), pw2); \
    VRD(3); SBAR(); GAPA(C0=__builtin_amdgcn_mfma_f32_32x32x16_bf16(kf[6],qr[3],C0,0,0,0),   P1[10],P1[11],P1[12],P1[13], pw3[0]=PKW(P1,8), pw3[1]=PKW(P1,10), pw3); \
    VRD(7); SBAR(); GAPA(C1=__builtin_amdgcn_mfma_f32_32x32x16_bf16(kf[7],qr[3],C1,0,0,0),   P1[14],P1[15],0.f,0.f,       pw3[2]=PKW(P1,12),pw3[3]=PKW(P1,14), pw3); \
    l_reg+=sacc; \
    if(GK){DMA_K((t)+3,sl_cur);} if(GV){DMA_V((t)+1,sl_next);} \
    CMASK(C0,C1,t); \
    { float a=MX3(C0[0],C0[1],C1[0]),b=MX3(C0[2],C0[3],C1[1]); a=MX3(a,C1[2],C1[3]); \
      _Pragma("unroll") for(int r=4;r<16;r+=4){a=MX3(a,C0[r],C0[r+1]);b=MX3(b,C0[r+2],C0[r+3]);a=MX3(a,C1[r],C1[r+1]);b=MX3(b,C1[r+2],C1[r+3]);} \
      float rm=__builtin_fmaxf(a,b); { auto rr=__builtin_amdgcn_permlane32_swap(__float_as_uint(rm),__float_as_uint(rm),false,false); rm=__builtin_fmaxf(__uint_as_float(rr[0]),__uint_as_float(rr[1])); } \
      resc=false; \
      if(__builtin_expect(__any(rm>(float)THRL),0)){ const float dl=__builtin_fmaxf(rm,0.f); mhat+=dl; \
        _Pragma("unroll") for(int r=0;r<16;++r){C0[r]-=dl;C1[r]-=dl;} \
        _Pragma("unroll") for(int r=0;r<16;++r)negm[r]=-mhat; asm volatile("":"+v"(negm)); \
        const float f=__builtin_amdgcn_exp2f(-dl); l_reg*=f; if(hi==0)wsf[r32]=f; resc=true; } } \
    SBAR(); \
    GAPB(o[0]=__builtin_amdgcn_mfma_f32_32x32x16_bf16(PAF(0),VFR(0),o[0],0,0,0), C0,0); \
    GAPB(o[1]=__builtin_amdgcn_mfma_f32_32x32x16_bf16(PAF(0),VFR(4),o[1],0,0,0), C0,4); \
    KRD(GL,0); GAPB(o[0]=__builtin_amdgcn_mfma_f32_32x32x16_bf16(PAF(1),VFR(1),o[0],0,0,0), C0,8); \
    KRD(GL,1); GAPB(o[1]=__builtin_amdgcn_mfma_f32_32x32x16_bf16(PAF(1),VFR(5),o[1],0,0,0), C0,12); \
    KRD(GL,2); GAPB(o[0]=__builtin_amdgcn_mfma_f32_32x32x16_bf16(PAF(2),VFR(2),o[0],0,0,0), C1,0); \
    KRD(GL,3); GAPB(o[1]=__builtin_amdgcn_mfma_f32_32x32x16_bf16(PAF(2),VFR(6),o[1],0,0,0), C1,4); \
    GAPB(o[0]=__builtin_amdgcn_mfma_f32_32x32x16_bf16(PAF(3),VFR(3),o[0],0,0,0), C1,8); \
    GAPB(o[1]=__builtin_amdgcn_mfma_f32_32x32x16_bf16(PAF(3),VFR(7),o[1],0,0,0), C1,12); \
    }while(0)
  int t=1;
  #undef CMASK
  #define CMASK(P0,P1,t) do{}while(0)
  for(;t+5<NT;t+=2){
    STEP(pB0,pB1,pA0,pA1,t,true,true,true);     WAIT_BAR(2); RESC(); ROT();
    STEP(pA0,pA1,pB0,pB1,t+1,true,true,true);   WAIT_BAR(2); RESC(); ROT();
  }
  #undef CMASK
  #define CMASK(P0,P1,t) do{int jb_=(t)-(NT-4); if(jb_>=0)cmask(P0,P1,jb_,qrel,hi);}while(0)
  #define ENDW(tt) do{ if((tt)+3<NT){WAIT_BAR(2);} else if((tt)+2<NT){WAIT_BAR(1);} else {WAIT_BAR(0);} }while(0)
  for(;t+1<NT;t+=2){
    STEP(pB0,pB1,pA0,pA1,t,(t+3<NT),(t+1<NT),(t+1<NT));       ENDW(t);   RESC(); ROT();
    STEP(pA0,pA1,pB0,pB1,t+1,(t+4<NT),(t+2<NT),(t+2<NT));     ENDW(t+1); RESC(); ROT();
  }
  STEP(pB0,pB1,pA0,pA1,NT-1,false,false,false); RESC();
  { float sacc=pB0[0]+pB0[1]; _Pragma("unroll") for(int r=2;r<16;++r)sacc+=pB0[r]; _Pragma("unroll") for(int r=0;r<16;++r)sacc+=pB1[r]; l_reg+=sacc;
    pw0=(u32x4){PKW(pB0,0),PKW(pB0,2),PKW(pB0,4),PKW(pB0,6)};pw1=(u32x4){PKW(pB0,8),PKW(pB0,10),PKW(pB0,12),PKW(pB0,14)};pw2=(u32x4){PKW(pB1,0),PKW(pB1,2),PKW(pB1,4),PKW(pB1,6)};pw3=(u32x4){PKW(pB1,8),PKW(pB1,10),PKW(pB1,12),PKW(pB1,14)};
    SBAR(); pv(o,vb0+sl_cur,PAF(0),PAF(1),PAF(2),PAF(3)); }
  #undef PKW
  #undef PAF
  #undef VFR
  #undef PIN
  #undef MX3
  #undef GAPA
  #undef GAPB
  #undef EX
  #undef VRD
  #undef KRD
  #undef STEP
  #undef ENDW
  {auto rr=__builtin_amdgcn_permlane32_swap(__float_as_uint(l_reg),__float_as_uint(l_reg),false,false);l_reg=__uint_as_float(rr[0])+__uint_as_float(rr[1]);}
  if(hi==0)wsf[32+r32]=l_reg;asm volatile("s_waitcnt lgkmcnt(0)":::"memory");
  float rli[16];
  #pragma unroll
  for(int r=0;r<16;++r)rli[r]=__builtin_amdgcn_rcpf(wsf[32+crow(r,hi)]);
  bf16*Ow=O+(rowbase+q0+wid*QBLK)*OPITCH+ocol;
  { bf16*stg=(bf16*)(shm+LDS_OST)+wid*2048;
    #pragma unroll
    for(int r=0;r<16;++r){const int orow=crow(r,hi);
      #pragma unroll
      for(int d0=0;d0<2;++d0)stg[orow*64+d0*32+r32]=__float2bfloat16(o[d0][r]*rli[r]);}
    asm volatile("s_waitcnt lgkmcnt(0)":::"memory");
    #pragma unroll
    for(int i=0;i<4;++i){const int row=i*8+(lane>>3),ch=lane&7; const u32x4 v=*(const u32x4*)(stg+row*64+ch*8); ATTN_STORE16(Ow+(long)row*OPITCH+ch*8,v);} }
  asm volatile("s_waitcnt lgkmcnt(0)\n\ts_barrier":::"memory");
  #undef DMA_K
  #undef DMA_V
  #undef CMASK
  #undef START
  #undef RESC
  #undef ROT
}
constexpr int ATTN_LDS_BYTES=LDS_BYTES;
#undef SBAR
#undef WAIT_BAR
}
constexpr size_t MiB = 1u << 20;
constexpr size_t WS_CTL = 0, CTL_ZERO_BYTES = 1 * MiB;
constexpr size_t WS_WIN = 2 * MiB, WS_WOUT = 26 * MiB, WS_WQ = 34 * MiB, WS_WKV = 42 * MiB, WS_WO = 58 * MiB, WS_W1 = 66 * MiB, WS_W2 = 578 * MiB;
constexpr size_t WS_HN = 834 * MiB, WS_MN = 866 * MiB, WS_PROJ = 870 * MiB, WS_DT = 958 * MiB, WS_KVRAW = 959 * MiB, WS_KN = 967 * MiB;
constexpr size_t WS_YCAT = 971 * MiB, WS_O0 = 1003 * MiB, WS_O1 = 1019 * MiB, WS_H1 = 1035 * MiB, WS_H1B = 1099 * MiB, WS_PART1 = 1131 * MiB, WS_PARTQ = 1132 * MiB;
constexpr size_t WS_QRAW = 1133 * MiB, WS_P = 1165 * MiB, WS_VWT = 1181 * MiB, WS_H2 = 1197 * MiB, WS_HN3 = 1261 * MiB;
constexpr size_t WS_TOKOF = 1293 * MiB, WS_GATEOF = 1294 * MiB, WS_TOKE = 1295 * MiB, WS_TOKR = 1296 * MiB, WS_YG = 1297 * MiB;
constexpr size_t WS_H1F8 = 3368 * MiB  , WS_QF8 = 3384 * MiB  , WS_KN8 = 3400 * MiB  , WS_VF8 = 3402 * MiB  ;
constexpr size_t WS_P8 = 3404 * MiB  , WS_VWT8 = 3412 * MiB  ;
constexpr size_t WS_XG = 1320 * MiB  , WS_ACT = 1832 * MiB  , WS_Y = 2344 * MiB  , WS_END = 3420 * MiB;
constexpr int CW_BAR = 4096;
constexpr int CW_QCONV2 = 12416;
constexpr int CW_QCONV = 12352;
constexpr int CW_QATT = 12288;
constexpr int CW_CNT = 8192;
static_assert((CW_CNT + 64 * 32) * 4 <= (int)CTL_ZERO_BYTES, "CTL words inside the memset region");

constexpr int RING_OFF = 0, RING_BYTES = 131072;
constexpr int LDS_BYTES = 163840;
constexpr int MISC_OFF = 163840 - 1024;
constexpr int NWAVES = 8;

#define XB_TMO      128
#define XB_XCNT(j)  (256  + 64 * (j))
#define XB_XSUB(j)  (1280 + 64 * (j))
#define XB_XGEN(j)  (2304 + 64 * (j))
#define XB_TOP      3328
#define XB_TOPGEN   3392
#define XCD_BAR_WORDS 3456
#define XB_SPIN_CAP (1u << 20)

__device__ __forceinline__ unsigned xb_ld(unsigned* p)              { return __hip_atomic_load(p, __ATOMIC_RELAXED, __HIP_MEMORY_SCOPE_AGENT); }
__device__ __forceinline__ unsigned xb_add(unsigned* p, unsigned v) { return __hip_atomic_fetch_add(p, v, __ATOMIC_RELAXED, __HIP_MEMORY_SCOPE_AGENT); }
__device__ __forceinline__ unsigned xb_xcc_id() { return (unsigned)__builtin_amdgcn_s_getreg((3 << 11) | 20) & 0xFu; }
#define XB_SPIN(cond, bar) do { unsigned _sp = 0; while (cond) { __builtin_amdgcn_s_sleep(1); \
    if ((++_sp & 255u) == 0u) { if (xb_ld(&(bar)[XB_TMO])) break; if (_sp > XB_SPIN_CAP) { atomicAdd(&(bar)[XB_TMO], 1u); break; } } } } while (0)

struct XcdBarrier {
    unsigned* bar; unsigned x;
    volatile LAS unsigned* st;
};
__device__ __forceinline__ XcdBarrier xcd_barrier_post(unsigned* bar, volatile LAS unsigned* st) {
    XcdBarrier b; b.bar = bar; b.x = xb_xcc_id(); b.st = st;
    if (threadIdx.x == 0) (void)xb_add(&bar[XB_XCNT(b.x)], 1u);
    return b;
}
__device__ __forceinline__ void xcd_barrier_complete(unsigned* bar, unsigned x, unsigned& nloc, unsigned& nx) {
    const unsigned G = gridDim.x * gridDim.y * gridDim.z;
    unsigned sum, cnt, mine, sp = 0u;
    for (;;) {
        sum = 0u; cnt = 0u; mine = 0u;
#pragma unroll
        for (unsigned j = 0; j < 16; ++j) { const unsigned c = xb_ld(&bar[XB_XCNT(j)]); sum += c; cnt += (c > 0u) ? 1u : 0u; mine = (j == x) ? c : mine; }
        if (sum == G) break;
        __builtin_amdgcn_s_sleep(1);
        if ((++sp & 255u) == 0u) { if (xb_ld(&bar[XB_TMO])) break; if (sp > XB_SPIN_CAP) { atomicAdd(&bar[XB_TMO], 1u); break; } }
    }
    nloc = mine > 0u ? mine : 1u; nx = cnt > 0u ? cnt : 1u;
}
__device__ __forceinline__ void xcd_barrier(const XcdBarrier& b) {
    asm volatile("s_waitcnt vmcnt(0)" ::: "memory");
    __syncthreads();
    if (threadIdx.x == 0) {
        unsigned* bar = b.bar;
        __builtin_amdgcn_s_waitcnt(0);
        unsigned nloc = b.st[0], nx = b.st[1];
        if (nloc == 0u) { xcd_barrier_complete(bar, b.x, nloc, nx); b.st[0] = nloc; b.st[1] = nx; }
        const unsigned old = xb_add(&bar[XB_XSUB(b.x)], 1u);
        const unsigned gen = old / nloc;
        if (old + 1u == (gen + 1u) * nloc) {
            __builtin_amdgcn_fence(__ATOMIC_RELEASE, "agent");
            asm volatile("s_waitcnt vmcnt(0)" ::: "memory");
            const unsigned og = xb_add(&bar[XB_TOP], 1u);
            const unsigned tg = og / nx;
            if (og + 1u == (tg + 1u) * nx) xb_add(&bar[XB_TOPGEN], 1u);
            else XB_SPIN(xb_ld(&bar[XB_TOPGEN]) == tg, bar);
            __builtin_amdgcn_fence(__ATOMIC_ACQUIRE, "agent");
            xb_add(&bar[XB_XGEN(b.x)], 1u);
            asm volatile("s_waitcnt vmcnt(0)" ::: "memory");
        } else {
            XB_SPIN(xb_ld(&bar[XB_XGEN(b.x)]) == gen, bar);
            __builtin_amdgcn_fence(__ATOMIC_ACQUIRE, "agent");
            asm volatile("s_waitcnt vmcnt(0)" ::: "memory");
        }
    }
    __syncthreads();
}

struct Args { const float* in[32]; float* out; unsigned char* ws; int ph_lo, ph_hi, probe, pad_; };
enum In { I_X = 0, I_MEM, I_GMIX, I_WIN, I_CONVW, I_CONVB, I_DTB, I_ALOG, I_DSKIP, I_SSDG, I_DAQG, I_DAKG, I_LQ1, I_LK1, I_LQ2, I_LK2, I_SUBG, I_WOUT, I_GXA, I_GMEM,
          I_WQ, I_WKV, I_XQG, I_XKG, I_WO, I_GFFN, I_RW, I_RB, I_W1, I_B1, I_W2, I_B2 };

struct ArgP {
    typedef const __attribute__((address_space(4))) char* kptr;
    DI const float* in(int i) const { kptr kp = (kptr)__builtin_amdgcn_kernarg_segment_ptr(); asm volatile("" : "+s"(kp)); return *(const float* const __attribute__((address_space(4)))*)(kp + 8 * i); }
    DI float* out() const { kptr kp = (kptr)__builtin_amdgcn_kernarg_segment_ptr(); asm volatile("" : "+s"(kp)); return *(float* const __attribute__((address_space(4)))*)(kp + 8 * 32); }
};
struct Frame {
    LAS unsigned char* lds;
    volatile LAS unsigned* MISC;
    unsigned* ctl;
    unsigned char* ws;
    int tid, lane, wave, vcu, G;
};

template <class DestRow>
DI void tr_item(const float* W, size_t ldw, int k0, int ncol0, int nvalid, const float* kscale, bf16_t* WT, int K, DestRow dr, LAS float* scr, int lane) {
    const int c = lane & 31;
#pragma unroll 8
    for (int i = 0; i < 32; ++i) { const int kk = 2 * i + (lane >> 5);
        float v = (c < nvalid) ? W[(size_t)(k0 + kk) * ldw + ncol0 + c] : 0.f;
        if (kscale) v *= kscale[k0 + kk];
        scr[kk * 33 + c] = v; }
    asm volatile("s_waitcnt lgkmcnt(0)" ::: "memory");
    const int c8 = lane & 7;
#pragma unroll
    for (int j = 0; j < 4; ++j) { const int n = (lane >> 3) + 8 * j; const LAS float* s = scr + (8 * c8) * 33 + n;
        u32x4 o; o.x = pk2(s[0 * 33], s[1 * 33]); o.y = pk2(s[2 * 33], s[3 * 33]); o.z = pk2(s[4 * 33], s[5 * 33]); o.w = pk2(s[6 * 33], s[7 * 33]);
        if (n < nvalid) *(u32x4*)(WT + (size_t)dr(ncol0 + n) * K + k0 + 8 * c8) = o; }
    asm volatile("s_waitcnt lgkmcnt(0)" ::: "memory");
}
template <class DestRow>
DI void tr_item_fp8(const float* W, size_t ldw, int k0, int ncol0, const float* kscale, unsigned char* WT, int K, DestRow dr, LAS float* scr, int lane) {
    const int c = lane & 31;
#pragma unroll 8
    for (int i = 0; i < 32; ++i) { const int kk = 2 * i + (lane >> 5); float v = W[(size_t)(k0 + kk) * ldw + ncol0 + c]; if (kscale) v *= kscale[k0 + kk]; scr[kk * 33 + c] = v; }
    asm volatile("s_waitcnt lgkmcnt(0)" ::: "memory");
    const int n = lane >> 1, hf = lane & 1; const LAS float* s = scr + (32 * hf) * 33 + n;
    unsigned w[8];
#pragma unroll
    for (int j = 0; j < 8; ++j) { unsigned x = 0u;
        x = __builtin_amdgcn_cvt_pk_fp8_f32(s[(4 * j) * 33] * 64.f, s[(4 * j + 1) * 33] * 64.f, x, false);
        x = __builtin_amdgcn_cvt_pk_fp8_f32(s[(4 * j + 2) * 33] * 64.f, s[(4 * j + 3) * 33] * 64.f, x, true); w[j] = x; }
    unsigned char* op = WT + (size_t)dr(ncol0 + n) * K + k0 + 32 * hf;
    *(u32x4*)op = (u32x4){w[0], w[1], w[2], w[3]}; *(u32x4*)(op + 16) = (u32x4){w[4], w[5], w[6], w[7]};
    asm volatile("s_waitcnt lgkmcnt(0)" ::: "memory");
}
DI int tileperm(int col) { const int o = col & 255; return (col & ~255) + 128 * ((o & 63) >> 5) + 32 * (o >> 6) + (o & 31); }
struct DrIdent { DI int operator()(int n) const { return n; } };
struct DrTile  { DI int operator()(int n) const { return tileperm(n); } };
struct DrWin   { DI int operator()(int n) const { const int pc = (n < 2560) ? n : (n < 2576 ? PC_DT + (n - 2560) : n - 16); return tileperm(pc); } };
struct DrW1    { DI int operator()(int n) const { const int half = n >> 11, j = n & 2047; return (j >> 7) * 256 + half * 128 + (j & 127); } };

template <bool FP8, class DestRow>
DI void cv_item(const float* W, size_t ldw, int k0, int ncol0, const float* kscale, float scale, void* WT, int kpitch, DestRow dr, LAS float* scr, int lane) {
    const int r = lane >> 3, c4 = (lane & 7) * 4;
    f32x4 v[16];
#pragma unroll
    for (int i = 0; i < 16; ++i) v[i] = *(const f32x4*)(W + (size_t)(k0 + 8 * i + r) * ldw + ncol0 + c4);
#pragma unroll
    for (int i = 0; i < 16; ++i) { f32x4 x = v[i] * scale; if (kscale) x = x * kscale[k0 + 8 * i + r]; *(LAS f32x4*)(scr + (8 * i + r) * 36 + c4) = x; }
    asm volatile("s_waitcnt lgkmcnt(0)" ::: "memory");
    const int n = lane & 31, hf = lane >> 5; const LAS float* s = scr + (64 * hf) * 36 + n;
    if constexpr (FP8) {
        unsigned w[16];
#pragma unroll
        for (int j = 0; j < 16; ++j) { unsigned x = 0u; x = __builtin_amdgcn_cvt_pk_fp8_f32(s[(4 * j) * 36], s[(4 * j + 1) * 36], x, false); x = __builtin_amdgcn_cvt_pk_fp8_f32(s[(4 * j + 2) * 36], s[(4 * j + 3) * 36], x, true); w[j] = x; }
        unsigned char* op = (unsigned char*)WT + (size_t)dr(ncol0 + n) * kpitch + k0 + 64 * hf;
#pragma unroll
        for (int j = 0; j < 4; ++j) *(u32x4*)(op + 16 * j) = (u32x4){w[4 * j], w[4 * j + 1], w[4 * j + 2], w[4 * j + 3]};
    } else {
        unsigned w[32];
#pragma unroll
        for (int j = 0; j < 32; ++j) w[j] = pk2(s[(2 * j) * 36], s[(2 * j + 1) * 36]);
        unsigned char* op = (unsigned char*)WT + (size_t)dr(ncol0 + n) * kpitch + (k0 + 64 * hf) * 2;
#pragma unroll
        for (int j = 0; j < 8; ++j) *(u32x4*)(op + 16 * j) = (u32x4){w[4 * j], w[4 * j + 1], w[4 * j + 2], w[4 * j + 3]};
    }
    asm volatile("s_waitcnt lgkmcnt(0)" ::: "memory");
}
DI void rms_row_to_bf16(const float* xrow, const float* g, bf16_t* orow, int lane) {
    const f32x4* xr = (const f32x4*)xrow + lane;
    f32x4 v[8]; float s = 0.f;
#pragma unroll
    for (int j = 0; j < 8; ++j) { v[j] = xr[64 * j]; s += (v[j].x * v[j].x + v[j].y * v[j].y) + (v[j].z * v[j].z + v[j].w * v[j].w); }
    const float rstd = 1.f / sqrtf(wave_sum(s) * (1.f / 2048.f) + EPS_);
    u32x2* o8 = (u32x2*)orow + lane;
#pragma unroll
    for (int j = 0; j < 8; ++j) { const f32x4 gg = ((const f32x4*)g)[lane + 64 * j];
        u32x2 o; o.x = pk2(v[j].x * rstd * gg.x, v[j].y * rstd * gg.y); o.y = pk2(v[j].z * rstd * gg.z, v[j].w * rstd * gg.w); o8[64 * j] = o; }
}

DI void p0_prologue(Frame& F, const ArgP& a) {
    LAS float* scr = (LAS float*)(F.lds + RING_OFF + F.wave * 16384);
    const int gw = F.vcu * NWAVES + F.wave, NGW = F.G * NWAVES;
    unsigned char* ws = F.ws;
    constexpr int I_A = 32 * 80, I_B = 32, I_C = 32 * 96, NITEMS = I_A + I_B + I_C;
    for (int it = gw; it < NITEMS; it += NGW) {
        int r = it;
        if (r < I_A) { tr_item(a.in(I_WIN), 5648, 64 * (r / 80), 32 * (r % 80), 32, nullptr, (bf16_t*)(ws + WS_WIN), 2048, DrWin(), scr, F.lane); continue; } r -= I_A;
        if (r < I_B) { tr_item(a.in(I_WIN), 5648, 64 * r, 2560, 16, nullptr, (bf16_t*)(ws + WS_WIN), 2048, DrWin(), scr, F.lane); continue; } r -= I_B;
        tr_item(a.in(I_WIN), 5648, 64 * (r / 96), 2576 + 32 * (r % 96), 32, nullptr, (bf16_t*)(ws + WS_WIN), 2048, DrWin(), scr, F.lane);
    }
    for (int m = gw; m < NTOK; m += NGW) rms_row_to_bf16(a.in(I_X) + (size_t)m * 2048, a.in(I_GMIX), (bf16_t*)(ws + WS_HN) + (size_t)m * 2048, F.lane);
    for (int m = gw; m < NB * MEMLEN; m += NGW) rms_row_to_bf16(a.in(I_MEM) + (size_t)m * 2048, a.in(I_GMEM), (bf16_t*)(ws + WS_MN) + (size_t)m * 2048, F.lane);
}
struct CvIt { const float* W; size_t ldw; const float* ks; unsigned char* WT; float scale; int k0, n0, kpitch, fp8, dr, tiled; };
DI CvIt cv_decode(int it, const ArgP& a, unsigned char* ws) {
    constexpr int J_WOUT = 16 * 64, J_WKV = 16 * 128, J_WQ = 16 * 64, J_WO = 16 * 64, J_W1 = 32 * 16 * 128;
    CvIt c; c.ks = nullptr; c.scale = 64.f; c.fp8 = 1; c.dr = 0; c.kpitch = 2048; c.ldw = 2048; c.tiled = 0;
    int r = it;
    if (r < J_WOUT) { c.W = a.in(I_WOUT); c.k0 = 128 * (r / 64); c.n0 = 32 * (r % 64); c.WT = ws + WS_WOUT; c.scale = 1.f; c.fp8 = 0; c.kpitch = 4096; return c; } r -= J_WOUT;
    if (r < J_WKV) { c.W = a.in(I_WKV); c.ldw = 4096; c.k0 = 128 * (r / 128); c.n0 = 32 * (r % 128); c.WT = ws + WS_WKV; c.scale = 1.f; c.fp8 = 0; c.kpitch = 4096; c.dr = 1; return c; } r -= J_WKV;
    if (r < J_WQ) { c.W = a.in(I_WQ); c.ks = a.in(I_GXA); c.k0 = 128 * (r / 64); c.n0 = 32 * (r % 64); c.WT = ws + WS_WQ; return c; } r -= J_WQ;
    if (r < J_WO) { c.W = a.in(I_WO); c.k0 = 128 * (r / 64); c.n0 = 32 * (r % 64); c.WT = ws + WS_WO; return c; } r -= J_WO;
    if (r < J_W1) { const int e = r / (16 * 128), q = r % (16 * 128); c.W = a.in(I_W1) + (size_t)e * 2048 * 4096; c.ldw = 4096; c.k0 = 128 * (q / 128); c.n0 = 32 * (q % 128); c.WT = ws + WS_W1 + (size_t)e * 4096 * 2048; c.dr = 2; c.tiled = 1; return c; } r -= J_W1;
    { const int e = r / (16 * 64), q = r % (16 * 64); c.W = a.in(I_W2) + (size_t)e * 2048 * 2048; c.k0 = 128 * (q / 64); c.n0 = 32 * (q % 64); c.WT = ws + WS_W2 + (size_t)e * 2048 * 2048; c.tiled = 1; }
    return c;
}
constexpr int CV_NJ = 16 * 64 * 3 + 16 * 128 + 32 * 16 * 128 + 32 * 16 * 64;
constexpr int CV_TAIL2 = 16384;
constexpr int CV_TAIL1 = 16384;
constexpr int CV_TAIL = CV_TAIL1 + CV_TAIL2;
DI void conv_share(Frame& F, const ArgP& a) {
    LAS float* scr = (LAS float*)(F.lds + F.wave * 16384);
    const unsigned sbase = (unsigned)__builtin_amdgcn_readfirstlane((int)((unsigned)(uintptr_t)F.lds + (unsigned)F.wave * 16384u));
    const int gw = F.vcu * NWAVES + F.wave, NGW = F.G * NWAVES, lane = F.lane;
    unsigned char* ws = F.ws;
    constexpr int NJ = CV_NJ - CV_TAIL;
    const int n = lane & 31, hf = lane >> 5;
    for (int it = gw; it < NJ; it += NGW) {
        const CvIt cur = cv_decode(it, a, ws);
        const char* gb = (const char*)(cur.W + (size_t)cur.k0 * cur.ldw + cur.n0);
        const unsigned vo0 = (unsigned)(((size_t)(lane >> 3) * cur.ldw + (size_t)(lane & 7) * 4) * 4), vstep = (unsigned)(8 * cur.ldw * 4);
#pragma unroll
        for (int p = 0; p < 16; ++p) { unsigned keep_;
            asm volatile("s_mov_b32 %0, m0\n\ts_mov_b32 m0, %3\n\ts_nop 0\n\tglobal_load_lds_dwordx4 %1, %2 nt\n\ts_mov_b32 m0, %0"
                         : "=&s"(keep_) : "v"(vo0 + (unsigned)p * vstep), "s"(gb), "s"(sbase + (unsigned)p * 1024u) : "memory"); }
        asm volatile("s_waitcnt vmcnt(0)" ::: "memory");
        const LAS float* s = scr + (64 * hf) * 32 + n;
        const int col = cur.n0 + n; const int drow = (cur.dr == 0) ? col : (cur.dr == 1 ? tileperm(col) : DrW1()(col));
        const float* ksp = cur.ks ? cur.ks + cur.k0 + 64 * hf : nullptr;
        if (cur.fp8) {
            unsigned w[16];
#pragma unroll
            for (int j = 0; j < 16; ++j) { float x0 = s[(4 * j) * 32] * cur.scale, x1 = s[(4 * j + 1) * 32] * cur.scale, x2 = s[(4 * j + 2) * 32] * cur.scale, x3 = s[(4 * j + 3) * 32] * cur.scale;
                if (ksp) { x0 *= ksp[4 * j]; x1 *= ksp[4 * j + 1]; x2 *= ksp[4 * j + 2]; x3 *= ksp[4 * j + 3]; }
                unsigned x = 0u; x = __builtin_amdgcn_cvt_pk_fp8_f32(x0, x1, x, false); x = __builtin_amdgcn_cvt_pk_fp8_f32(x2, x3, x, true); w[j] = x; }
            unsigned char* op = cur.tiled ? cur.WT + ((size_t)(((drow >> 8) * 16 + (cur.k0 >> 7)) * 256 + (drow & 255))) * 128 + 64 * hf : cur.WT + (size_t)drow * cur.kpitch + cur.k0 + 64 * hf;
#pragma unroll
            for (int j = 0; j < 4; ++j) *(u32x4*)(op + 16 * j) = (u32x4){w[4 * j], w[4 * j + 1], w[4 * j + 2], w[4 * j + 3]};
        } else {
            unsigned w[32];
#pragma unroll
            for (int j = 0; j < 32; ++j) w[j] = pk2(s[(2 * j) * 32] * cur.scale, s[(2 * j + 1) * 32] * cur.scale);
            unsigned char* op = cur.WT + (size_t)drow * cur.kpitch + (cur.k0 + 64 * hf) * 2;
#pragma unroll
            for (int j = 0; j < 8; ++j) *(u32x4*)(op + 16 * j) = (u32x4){w[4 * j], w[4 * j + 1], w[4 * j + 2], w[4 * j + 3]};
        }
        asm volatile("s_waitcnt lgkmcnt(0)" ::: "memory");
    }
}

DI void conv_queue(Frame& F, const ArgP& a, int qword, int first, int count) {
    LAS float* scr = (LAS float*)(F.lds + F.wave * 18432);
    unsigned char* ws = F.ws;
    const int lane = threadIdx.x & 63, r = lane >> 3, c4 = (lane & 7) * 4, n = lane & 31, hf = lane >> 5;
    for (;;) {
        if (threadIdx.x == 0) F.MISC[121] = __hip_atomic_fetch_add(F.ctl + qword, 8u, __ATOMIC_RELAXED, __HIP_MEMORY_SCOPE_AGENT);
        __syncthreads();
        const int base = __builtin_amdgcn_readfirstlane((int)F.MISC[121]);
        __syncthreads();
        if (base >= count) break;
        const int it = first + base + F.wave;
        if (base + F.wave < count) {
            const CvIt cur = cv_decode(it, a, ws);
            f32x4 v[16];
#pragma unroll
            for (int i = 0; i < 16; ++i) v[i] = __builtin_nontemporal_load((const f32x4*)(cur.W + (size_t)(cur.k0 + 8 * i + r) * cur.ldw + cur.n0 + c4));
#pragma unroll
            for (int i = 0; i < 16; ++i) *(LAS f32x4*)(scr + (8 * i + r) * 36 + c4) = v[i] * cur.scale;
            asm volatile("s_waitcnt lgkmcnt(0)" ::: "memory");
            const LAS float* s = scr + (64 * hf) * 36 + n;
            unsigned w[16];
#pragma unroll
            for (int j = 0; j < 16; ++j) { unsigned x = 0u; x = __builtin_amdgcn_cvt_pk_fp8_f32(s[(4 * j) * 36], s[(4 * j + 1) * 36], x, false); x = __builtin_amdgcn_cvt_pk_fp8_f32(s[(4 * j + 2) * 36], s[(4 * j + 3) * 36], x, true); w[j] = x; }
            const int drow = cur.n0 + n; unsigned char* op = cur.WT + ((size_t)(((drow >> 8) * 16 + (cur.k0 >> 7)) * 256 + (drow & 255))) * 128 + 64 * hf;
#pragma unroll
            for (int j = 0; j < 4; ++j) *(u32x4*)(op + 16 * j) = (u32x4){w[4 * j], w[4 * j + 1], w[4 * j + 2], w[4 * j + 3]};
            asm volatile("s_waitcnt lgkmcnt(0)" ::: "memory");
        }
    }
}
static_assert(CV_TAIL <= 32 * 16 * 64 && CV_TAIL1 % 8 == 0 && CV_TAIL2 % 8 == 0, "the tails are a suffix of the moe_w2 items");

struct SchedP1 {
    int G, c; const unsigned char* ws; int lo, hi;
    DI bool next(int i, pg8::UnitD& u) const {
        u.rows = nullptr; u.nvalid = 0; u.lda = 4096u; u.ldb = 4096u; u.e = 0; u.x0 = 0;
        if (lo == 0) {
            if (G == 256) { const int x = c >> 5, s = c & 31, bidx = i * 8 + x; if (bidx >= 24) return false;
                const int g = bidx >> 2, h = bidx & 3; u.pn = 4 * g + (s >> 3); u.pm = h * 8 + (s & 7); if (u.pn >= 23) return false; }
            else { const int L = i * G + c; if (L >= 32 * 23) return false; u.pn = L / 32; u.pm = L % 32; }
            u.type = 0; u.A = (const char*)(ws + WS_HN) + (size_t)u.pm * 256 * 4096; u.B = (const char*)(ws + WS_WIN) + (size_t)u.pn * 256 * 4096;
            return true;
        }
        const int L = lo + i * G + c; if (L >= hi) return false;
        { const int q = L - 32 * 23; u.type = 1; u.pn = q / 4; u.pm = q % 4; u.A = (const char*)(ws + WS_MN) + (size_t)u.pm * 256 * 4096; u.B = (const char*)(ws + WS_WKV) + (size_t)u.pn * 256 * 4096; }
        return true;
    }
};
struct EpiP1 {
    static constexpr bool AFTER_DRAIN = false;
    bf16_t* proj; float* dtb; bf16_t* kvraw; const float* gq; const float* gk; unsigned char* vf8;
    DI void operator()(const f32x4 (&acc)[2][2][4][2], const pg8::UnitD& u, int wr, int wc, int fr, int fq) const {
        { int ln_ = threadIdx.x; asm volatile("" : "+v"(ln_)); fr = ln_ & 15; fq = (ln_ >> 4) & 3; }
        const int row0 = u.pm * 256 + wr * 64 + fr;
        const int cn = u.pn * 256 + 64 * wc + 8 * fq;
        if (u.type == 1 && u.pn >= 8) {
#pragma unroll
            for (int ai = 0; ai < 2; ++ai)
#pragma unroll
                for (int m = 0; m < 4; ++m) { unsigned char* rp = vf8 + (size_t)(row0 + ai * 128 + m * 16) * 2048 + (cn - 2048);
#pragma unroll
                    for (int bj = 0; bj < 2; ++bj) { const f32x4 v0 = acc[ai][bj][m][0] * 16.f, v1 = acc[ai][bj][m][1] * 16.f;
                        u32x2 w; w.x = __builtin_amdgcn_cvt_pk_fp8_f32(v0[0], v0[1], 0u, false); w.x = __builtin_amdgcn_cvt_pk_fp8_f32(v0[2], v0[3], w.x, true);
                        w.y = __builtin_amdgcn_cvt_pk_fp8_f32(v1[0], v1[1], 0u, false); w.y = __builtin_amdgcn_cvt_pk_fp8_f32(v1[2], v1[3], w.y, true);
                        *(u32x2*)(rp + 32 * bj) = w; } }
            return;
        }
        if (u.type == 1) {
#pragma unroll
            for (int ai = 0; ai < 2; ++ai)
#pragma unroll
                for (int m = 0; m < 4; ++m) { bf16_t* rp = kvraw + (size_t)(row0 + ai * 128 + m * 16) * 4096 + cn;
#pragma unroll
                    for (int bj = 0; bj < 2; ++bj) { const f32x4 v0 = acc[ai][bj][m][0], v1 = acc[ai][bj][m][1];
                        u32x4 w; w.x = pk2(v0[0], v0[1]); w.y = pk2(v0[2], v0[3]); w.z = pk2(v1[0], v1[1]); w.w = pk2(v1[2], v1[3]); *(u32x4*)(rp + 32 * bj) = w; } }
            return;
        }
        if (u.pn == 22) {
            if (wc == 0 && fq < 2) {
#pragma unroll
                for (int ai = 0; ai < 2; ++ai)
#pragma unroll
                    for (int m = 0; m < 4; ++m) { float* rp = dtb + (size_t)(row0 + ai * 128 + m * 16) * 16 + 8 * fq;
                        *(f32x4*)(rp) = acc[ai][0][m][0]; *(f32x4*)(rp + 4) = acc[ai][0][m][1]; }
            }
            return;
        }
        const bool isq = (u.pn >= 10 && u.pn < 14), isk = (u.pn >= 14 && u.pn < 18);
        if (!(isq || isk)) {
#pragma unroll
            for (int ai = 0; ai < 2; ++ai)
#pragma unroll
                for (int m = 0; m < 4; ++m) { bf16_t* rp = proj + (size_t)(row0 + ai * 128 + m * 16) * PP + cn;
#pragma unroll
                    for (int bj = 0; bj < 2; ++bj) { const f32x4 v0 = acc[ai][bj][m][0], v1 = acc[ai][bj][m][1];
                        u32x4 w; w.x = pk2(v0[0], v0[1]); w.y = pk2(v0[2], v0[3]); w.z = pk2(v1[0], v1[1]); w.w = pk2(v1[2], v1[3]); *(u32x4*)(rp + 32 * bj) = w; } }
            return;
        }
        const float* g = (isq ? gq : gk) + 8 * fq; const float sc = isq ? (0.125f * 1.4426950408889634f) : 1.f;
#pragma unroll
        for (int ai = 0; ai < 2; ++ai)
#pragma unroll
            for (int m = 0; m < 4; ++m) { bf16_t* rp = proj + (size_t)(row0 + ai * 128 + m * 16) * PP + cn;
                float ss = 0.f;
#pragma unroll
                for (int bj = 0; bj < 2; ++bj)
#pragma unroll
                    for (int n = 0; n < 2; ++n) { const f32x4 v = acc[ai][bj][m][n]; ss += (v[0] * v[0] + v[1] * v[1]) + (v[2] * v[2] + v[3] * v[3]); }
                ss += __shfl_xor(ss, 16); ss += __shfl_xor(ss, 32);
                const float rs = sc / sqrtf(ss * (1.f / 64.f) + EPS_);
#pragma unroll
                for (int bj = 0; bj < 2; ++bj) { const f32x4 v0 = acc[ai][bj][m][0] * rs * *(const f32x4*)(g + 32 * bj), v1 = acc[ai][bj][m][1] * rs * *(const f32x4*)(g + 32 * bj + 4);
                    u32x4 w; w.x = pk2(v0[0], v0[1]); w.y = pk2(v0[2], v0[3]); w.z = pk2(v1[0], v1[1]); w.w = pk2(v1[2], v1[3]); *(u32x4*)(rp + 32 * bj) = w; } }
    }
};

DI void kprep(Frame& F, const ArgP& a) {
    const int gw = F.vcu * NWAVES + F.wave, NGW = F.G * NWAVES;
    const bf16_t* kv = (const bf16_t*)(F.ws + WS_KVRAW); unsigned char* kn = (unsigned char*)(F.ws + WS_KN8);
    for (int it = gw; it < NB * MEMLEN * 4; it += NGW) {
        const int row = it >> 2, h = it & 3, b = row >> 8, key = row & 255;
        const u32x4 raw = *(const u32x4*)(kv + (size_t)row * 4096 + h * 512 + F.lane * 8);
        float v[8]; v[0] = bflo(raw.x); v[1] = bfhi(raw.x); v[2] = bflo(raw.y); v[3] = bfhi(raw.y); v[4] = bflo(raw.z); v[5] = bfhi(raw.z); v[6] = bflo(raw.w); v[7] = bfhi(raw.w);
        float ss = 0.f;
#pragma unroll
        for (int j = 0; j < 8; ++j) ss += v[j] * v[j];
        const float rs = 1.f / sqrtf(wave_sum(ss) * (1.f / 512.f) + EPS_) * 0.04419417382415922f * 128.f;
        const float* gk = a.in(I_XKG) + F.lane * 8; const float* gq = a.in(I_XQG) + F.lane * 8;
        u32x2 o; o.x = __builtin_amdgcn_cvt_pk_fp8_f32(v[0] * rs * gk[0] * gq[0], v[1] * rs * gk[1] * gq[1], 0u, false); o.x = __builtin_amdgcn_cvt_pk_fp8_f32(v[2] * rs * gk[2] * gq[2], v[3] * rs * gk[3] * gq[3], o.x, true);
        o.y = __builtin_amdgcn_cvt_pk_fp8_f32(v[4] * rs * gk[4] * gq[4], v[5] * rs * gk[5] * gq[5], 0u, false); o.y = __builtin_amdgcn_cvt_pk_fp8_f32(v[6] * rs * gk[6] * gq[6], v[7] * rs * gk[7] * gq[7], o.y, true);
        *(u32x2*)(kn + ((size_t)((b * 4 + h) * 256 + key)) * 512 + F.lane * 8) = o;
    }
}

constexpr int SP = 272;
constexpr int S_C = 0, S_BM = 34816, S_BT = 69632, S_XDT = 104448, S_HB = 121856, S_F = 139264, S_W = 155648  , SSD_LDS = 162048;
static_assert(SSD_LDS <= MISC_OFF, "SSD LDS map");
#define MFMA32(a, b, c) __builtin_amdgcn_mfma_f32_32x32x16_bf16((a), (b), (c), 0, 0, 0)
DI int crow(int r, int hi) { return (r & 3) + 8 * (r >> 2) + 4 * hi; }
DI bf16x8 ldfrag(LAS const unsigned char* base, int row, int kel) { return *(const LAS bf16x8*)(base + row * SP + kel * 2); }
DI float fexp(float x) { return __builtin_amdgcn_exp2f(x * 1.4426950408889634f); }
DI float fsilu(float x) { return x * __builtin_amdgcn_rcpf(1.f + fexp(-x)); }

DI void ssd_unit(Frame& F, const ArgP& a, int b, int hd) {
    LAS unsigned char* lds = F.lds;
    int tid = F.tid, lane = F.lane, r32 = lane & 31, hh = lane >> 5; const int wid = F.wave;
    LAS float* sdt = (LAS float*)(lds + S_F); LAS float* sac = sdt + 2048;
    const bf16_t* proj = (const bf16_t*)(F.ws + WS_PROJ); const float* dtbuf = (const float*)(F.ws + WS_DT); bf16_t* yg = (bf16_t*)(F.ws + WS_YG);
    const int g = hd >> 3;
    const float aneg = -__expf(a.in(I_ALOG)[hd]), dtb = a.in(I_DTB)[hd], dsk = a.in(I_DSKIP)[hd];
#pragma unroll
    for (int q = 0; q < 2; ++q) { const int c = 2 * wid + q; const size_t t0 = (size_t)b * SEQ_ + c * 128;
        const float x0 = dtbuf[(t0 + 2 * lane) * 16 + hd] + dtb, x1 = dtbuf[(t0 + 2 * lane + 1) * 16 + hd] + dtb;
        const float d0 = x0 > 20.f ? x0 : log1pf(__expf(x0)), d1 = x1 > 20.f ? x1 : log1pf(__expf(x1));
        const float a0 = d0 * aneg, a1 = d1 * aneg;
        float s = a0 + a1;
#pragma unroll
        for (int o = 1; o < 64; o <<= 1) { const float t = __shfl_up(s, o); if (lane >= o) s += t; }
        sdt[c * 128 + 2 * lane] = d0; sdt[c * 128 + 2 * lane + 1] = d1; sac[c * 128 + 2 * lane] = s - a1; sac[c * 128 + 2 * lane + 1] = s; }
    int seg = tid >> 5, cg = tid & 31, l0 = seg * 8;
    int colbc = (cg < 16) ? (1024 + g * 128 + cg * 8) : (1280 + g * 128 + (cg - 16) * 8);
    const int colx = hd * 64 + wid * 8; int lx = 2 * lane;
    LAS float* swt = (LAS float*)(lds + S_W);
    { const float* convw = a.in(I_CONVW); const float* convb = a.in(I_CONVB);
      if (tid < 320) { const int ci = tid;
          const int xc = (ci < 64) ? (hd * 64 + ci) : (ci < 192 ? (1024 + g * 128 + (ci - 64)) : (1280 + g * 128 + (ci - 192)));
#pragma unroll
          for (int k = 0; k < 4; ++k) swt[k * 320 + ci] = convw[k * 1536 + xc];
          swt[4 * 320 + ci] = convb[xc]; } }
    int cibc = 64 + cg * 8; const int cix = wid * 8;
    const char* pub = (const char*)F.ws; const unsigned pxb = (unsigned)(WS_PROJ + ((size_t)b * SEQ_ * PP + PC_XBC) * 2), zoff = (unsigned)(WS_CTL + 524288);
    u32x4 inbc[11], inx[5];
#define SSD_PREFETCH(c_) do { \
        int sd_ = l0; asm volatile("" : "+v"(sd_)); \
        _Pragma("unroll") for (int j = 0; j < 11; ++j) { const int tt = (c_) * 128 + sd_ - 3 + j; inbc[j] = *(const u32x4*)(pub + ((tt >= 0) ? pxb + (unsigned)(tt * PP + colbc) * 2u : zoff)); } } while (0)
    SSD_PREFETCH(0);
    f32x16 hT; for (int i = 0; i < 16; ++i) hT[i] = 0.f;
    const int nb = wid & 3, pb = wid >> 2;
    __syncthreads();
    for (int c = 0; c < 16; ++c) {
        { int t_ = threadIdx.x; asm volatile("" : "+v"(t_)); tid = t_; lane = t_ & 63; r32 = lane & 31; hh = lane >> 5; seg = t_ >> 5; cg = t_ & 31; l0 = seg * 8; lx = 2 * lane;
          colbc = (cg < 16) ? (1024 + g * 128 + cg * 8) : (1280 + g * 128 + (cg - 16) * 8); cibc = 64 + cg * 8; }
        const size_t t0 = (size_t)b * SEQ_ + c * 128;
        const LAS float* cdt = sdt + c * 128; const LAS float* cac = sac + c * 128;
        const float aend = cac[127];
#pragma unroll
        for (int j = 0; j < 5; ++j) { int sd_ = lx; asm volatile("" : "+v"(sd_)); const int tt = c * 128 + sd_ - 3 + j; inx[j] = *(const u32x4*)(pub + ((tt >= 0) ? pxb + (unsigned)(tt * PP + colx) * 2u : zoff)); }
        {
            LAS unsigned char* hbp = lds + S_HB + (32 * pb + r32) * SP + (32 * nb + 4 * hh) * 2;
#pragma unroll
            for (int q4 = 0; q4 < 4; ++q4) { u32x2 w; w.x = pk2(hT[4 * q4], hT[4 * q4 + 1]); w.y = pk2(hT[4 * q4 + 2], hT[4 * q4 + 3]); *(LAS u32x2*)(hbp + 16 * q4) = w; }
        }
        {
            float wbc[5][8];
#pragma unroll
            for (int k = 0; k < 5; ++k) { const f32x4 w0 = *(const LAS f32x4*)(swt + k * 320 + cibc), w1 = *(const LAS f32x4*)(swt + k * 320 + cibc + 4);
#pragma unroll
                for (int i = 0; i < 4; ++i) { wbc[k][i] = w0[i]; wbc[k][4 + i] = w1[i]; } }
#pragma unroll
            for (int hf = 0; hf < 2; ++hf) {
                __builtin_amdgcn_sched_barrier(0);
                float o[4][8];
#pragma unroll
                for (int j = 0; j < 4; ++j)
#pragma unroll
                    for (int i = 0; i < 8; ++i) { float s = wbc[4][i];
#pragma unroll
                        for (int k = 0; k < 4; ++k) { const unsigned wd = inbc[4 * hf + j + k][i >> 1]; s += wbc[k][i] * ((i & 1) ? bfhi(wd) : bflo(wd)); }
                        o[j][i] = fsilu(s); }
                const int lh = l0 + 4 * hf;
                if (cg < 16) {
                    const int n0 = cg * 8; float ev[4];
#pragma unroll
                    for (int j = 0; j < 4; ++j) { ev[j] = fexp(aend - cac[lh + j]);
                        u32x4 w1; w1.x = pk2(o[j][0], o[j][1]); w1.y = pk2(o[j][2], o[j][3]); w1.z = pk2(o[j][4], o[j][5]); w1.w = pk2(o[j][6], o[j][7]);
                        *(LAS u32x4*)(lds + S_BM + (lh + j) * SP + n0 * 2) = w1; }
#pragma unroll
                    for (int i = 0; i < 8; ++i) { u32x2 w2; w2.x = pk2(o[0][i] * ev[0], o[1][i] * ev[1]); w2.y = pk2(o[2][i] * ev[2], o[3][i] * ev[3]);
                        *(LAS u32x2*)(lds + S_BT + (n0 + i) * SP + lh * 2) = w2; }
                } else {
                    const int n0 = (cg - 16) * 8;
#pragma unroll
                    for (int j = 0; j < 4; ++j) { u32x4 w1; w1.x = pk2(o[j][0], o[j][1]); w1.y = pk2(o[j][2], o[j][3]); w1.z = pk2(o[j][4], o[j][5]); w1.w = pk2(o[j][6], o[j][7]);
                        *(LAS u32x4*)(lds + S_C + (lh + j) * SP + n0 * 2) = w1; }
                }
            }
        }
        __builtin_amdgcn_sched_barrier(0);
        {
            const float d0 = cdt[lx], d1 = cdt[lx + 1];
            float wx[5][8];
#pragma unroll
            for (int k = 0; k < 5; ++k) { const f32x4 w0 = *(const LAS f32x4*)(swt + k * 320 + cix), w1 = *(const LAS f32x4*)(swt + k * 320 + cix + 4);
#pragma unroll
                for (int i = 0; i < 4; ++i) { wx[k][i] = w0[i]; wx[k][4 + i] = w1[i]; } }
#pragma unroll
            for (int i = 0; i < 8; ++i) { float s0 = wx[4][i], s1 = wx[4][i];
#pragma unroll
                for (int k = 0; k < 4; ++k) { const unsigned w0 = inx[k][i >> 1], w1 = inx[k + 1][i >> 1];
                    s0 += wx[k][i] * ((i & 1) ? bfhi(w0) : bflo(w0)); s1 += wx[k][i] * ((i & 1) ? bfhi(w1) : bflo(w1)); }
                *(LAS unsigned*)(lds + S_XDT + (wid * 8 + i) * SP + lx * 2) = pk2(fsilu(s0) * d0, fsilu(s1) * d1); }
        }
        if (c < 15) SSD_PREFETCH(c + 1);
        __syncthreads();
        const int lb = wid >> 1;
        f32x16 xt[2];
        {
            bf16x8 cf[8];
#pragma unroll
            for (int ks = 0; ks < 8; ++ks) cf[ks] = ldfrag(lds + S_C, 32 * lb + r32, 16 * ks + 8 * hh);
#pragma unroll
            for (int q = 0; q < 2; ++q) { const int sb = 2 * (wid & 1) + q;
                for (int i = 0; i < 16; ++i) xt[q][i] = 0.f;
                if (sb <= lb) {
                    bf16x8 bfr[8];
#pragma unroll
                    for (int ks = 0; ks < 8; ++ks) bfr[ks] = ldfrag(lds + S_BM, 32 * sb + r32, 16 * ks + 8 * hh);
                    __builtin_amdgcn_sched_barrier(0);
#pragma unroll
                    for (int ks = 0; ks < 8; ++ks) xt[q] = MFMA32(bfr[ks], cf[ks], xt[q]);
                }
            }
        }
        __syncthreads();
        {
            const int l = 32 * lb + r32; const float al = cac[l], ddl = dsk * __builtin_amdgcn_rcpf(cdt[l]);
            f32x4 cs[2][4];
#pragma unroll
            for (int q = 0; q < 2; ++q)
#pragma unroll
                for (int q4 = 0; q4 < 4; ++q4) cs[q][q4] = *(const LAS f32x4*)(cac + 32 * (2 * (wid & 1) + q) + 8 * q4 + 4 * hh);
#pragma unroll
            for (int q = 0; q < 2; ++q) { const int sb = 2 * (wid & 1) + q;
#pragma unroll
                for (int q4 = 0; q4 < 4; ++q4) { float mv[4];
#pragma unroll
                    for (int e = 0; e < 4; ++e) { const int s = 32 * sb + 8 * q4 + 4 * hh + e;
                        const float ev = fexp(fminf(al - cs[q][q4][e], 0.f));
                        float v = (s <= l) ? xt[q][4 * q4 + e] * ev : 0.f;
                        v += (s == l) ? ddl : 0.f;
                        mv[e] = v; }
                    u32x2 w; w.x = pk2(mv[0], mv[1]); w.y = pk2(mv[2], mv[3]);
                    *(LAS u32x2*)(lds + S_BM + l * SP + (32 * sb + 8 * q4 + 4 * hh) * 2) = w; }
            }
        }
        __syncthreads();
        {
            const int lb2 = wid & 3, pb2 = wid >> 2; const int l = 32 * lb2 + r32; const size_t tok = t0 + l;
            const int pc0 = hd * 64 + 32 * pb2 + 4 * hh;
            u32x2 zz[4];
#pragma unroll
            for (int q4 = 0; q4 < 4; ++q4) zz[q4] = *(const u32x2*)(proj + tok * PP + pc0 + 8 * q4);
            f32x16 y1, y2; for (int i = 0; i < 16; ++i) { y1[i] = 0.f; y2[i] = 0.f; }
            bf16x8 fa[8], fb[8];
#pragma unroll
            for (int ks = 0; ks < 8; ++ks) { fa[ks] = ldfrag(lds + S_XDT, 32 * pb2 + r32, 16 * ks + 8 * hh); fb[ks] = ldfrag(lds + S_BM, 32 * lb2 + r32, 16 * ks + 8 * hh); }
            __builtin_amdgcn_sched_barrier(0);
#pragma unroll
            for (int ks = 0; ks < 8; ++ks) { if (ks < 2 * (lb2 + 1)) y1 = MFMA32(fa[ks], fb[ks], y1); }
            const float cd = fexp(aend);
#pragma unroll
            for (int i = 0; i < 16; ++i) hT[i] *= cd;
#pragma unroll
            for (int ks = 0; ks < 8; ++ks) fb[ks] = ldfrag(lds + S_BT, 32 * nb + r32, 16 * ks + 8 * hh);
            __builtin_amdgcn_sched_barrier(0);
#pragma unroll
            for (int ks = 0; ks < 8; ++ks) hT = MFMA32(fb[ks], fa[ks], hT);
#pragma unroll
            for (int ks = 0; ks < 8; ++ks) { fa[ks] = ldfrag(lds + S_HB, 32 * pb2 + r32, 16 * ks + 8 * hh); fb[ks] = ldfrag(lds + S_C, 32 * lb2 + r32, 16 * ks + 8 * hh); }
            __builtin_amdgcn_sched_barrier(0);
#pragma unroll
            for (int ks = 0; ks < 8; ++ks) y2 = MFMA32(fa[ks], fb[ks], y2);
            const float el = fexp(cac[l]);
#pragma unroll
            for (int q4 = 0; q4 < 4; ++q4) { float yv[4];
#pragma unroll
                for (int e = 0; e < 4; ++e) { const float z = (e & 1) ? bfhi(e < 2 ? zz[q4].x : zz[q4].y) : bflo(e < 2 ? zz[q4].x : zz[q4].y);
                    yv[e] = (y1[4 * q4 + e] + el * y2[4 * q4 + e]) * fsilu(z); }
                u32x2 w; w.x = pk2(yv[0], yv[1]); w.y = pk2(yv[2], yv[3]);
                *(u32x2*)(yg + tok * 1024 + pc0 + 8 * q4) = w; }
        }
        __syncthreads();
    }
#undef SSD_PREFETCH
}

DI void attn_phase_da(Frame& F) {
    const attn_body::bf16* proj = (const attn_body::bf16*)(F.ws + WS_PROJ);
    for (;;) {
        if (threadIdx.x == 0) F.MISC[120] = __hip_atomic_fetch_add(F.ctl + CW_QATT, 1u, __ATOMIC_RELAXED, __HIP_MEMORY_SCOPE_AGENT);
        __syncthreads();
        const int u = __builtin_amdgcn_readfirstlane((int)F.MISC[120]);
        __syncthreads();
        if (u >= 1024) break;
        const int qb = 7 - (u >> 7), combo = u & 127;
        const int half = combo & 1, j = (combo >> 1) & 1, h = (combo >> 2) & 7, b = combo >> 5;
        attn_body::bf16* O = (attn_body::bf16*)(F.ws + (j ? WS_O1 : WS_O0));
        attn_body::attn_unit<8>(b, PC_Q + (h * 2 + j) * 64, PC_V + h * 128 + half * 64, h * 128 + half * 64, qb, proj, proj + (PC_K - PC_Q), proj, O, (char*)F.lds);
    }
}

DI void p3_finalize(Frame& F, const ArgP& a) {
    const int gw = F.vcu * NWAVES + F.wave, NGW = F.G * NWAVES, lane = F.lane;
    bf16_t* ycat = (bf16_t*)(F.ws + WS_YCAT); const bf16_t* yg = (const bf16_t*)(F.ws + WS_YG); const bf16_t* o0 = (const bf16_t*)(F.ws + WS_O0); const bf16_t* o1 = (const bf16_t*)(F.ws + WS_O1);
    float l1 = a.in(I_LQ1)[lane] * a.in(I_LK1)[lane], l2 = a.in(I_LQ2)[lane] * a.in(I_LK2)[lane];
    const float lam = __expf(wave_sum(l1)) - __expf(wave_sum(l2)) + LAM_INIT;
    for (int m = gw; m < NTOK; m += NGW) {
        { bf16_t* yp = ycat + (size_t)m * 2048 + 16 * lane; const bf16_t* gp = yg + (size_t)m * 1024 + 16 * lane;
          const u32x4 r0 = *(const u32x4*)gp, r1 = *(const u32x4*)(gp + 8);
          float v[16]; v[0] = bflo(r0.x); v[1] = bfhi(r0.x); v[2] = bflo(r0.y); v[3] = bfhi(r0.y); v[4] = bflo(r0.z); v[5] = bfhi(r0.z); v[6] = bflo(r0.w); v[7] = bfhi(r0.w);
          v[8] = bflo(r1.x); v[9] = bfhi(r1.x); v[10] = bflo(r1.y); v[11] = bfhi(r1.y); v[12] = bflo(r1.z); v[13] = bfhi(r1.z); v[14] = bflo(r1.w); v[15] = bfhi(r1.w);
          float ss = 0.f;
#pragma unroll
          for (int i = 0; i < 16; ++i) ss += v[i] * v[i];
#pragma unroll
          for (int o = 1; o < 32; o <<= 1) ss += __shfl_xor(ss, o);
          const float rs = 1.f / sqrtf(ss * (1.f / 512.f) + EPS_);
          const float* g = a.in(I_SSDG) + 16 * lane;
          u32x4 w0, w1;
          w0.x = pk2(v[0] * rs * g[0], v[1] * rs * g[1]); w0.y = pk2(v[2] * rs * g[2], v[3] * rs * g[3]); w0.z = pk2(v[4] * rs * g[4], v[5] * rs * g[5]); w0.w = pk2(v[6] * rs * g[6], v[7] * rs * g[7]);
          w1.x = pk2(v[8] * rs * g[8], v[9] * rs * g[9]); w1.y = pk2(v[10] * rs * g[10], v[11] * rs * g[11]); w1.z = pk2(v[12] * rs * g[12], v[13] * rs * g[13]); w1.w = pk2(v[14] * rs * g[14], v[15] * rs * g[15]);
          *(u32x4*)yp = w0; *(u32x4*)(yp + 8) = w1; }
        { const bf16_t* p0 = o0 + (size_t)m * 1024 + 16 * lane; const bf16_t* p1 = o1 + (size_t)m * 1024 + 16 * lane;
          const u32x4 a0 = *(const u32x4*)p0, a1 = *(const u32x4*)(p0 + 8), b0 = *(const u32x4*)p1, b1 = *(const u32x4*)(p1 + 8);
          float v[16];
          v[0] = bflo(a0.x) - lam * bflo(b0.x); v[1] = bfhi(a0.x) - lam * bfhi(b0.x); v[2] = bflo(a0.y) - lam * bflo(b0.y); v[3] = bfhi(a0.y) - lam * bfhi(b0.y);
          v[4] = bflo(a0.z) - lam * bflo(b0.z); v[5] = bfhi(a0.z) - lam * bfhi(b0.z); v[6] = bflo(a0.w) - lam * bflo(b0.w); v[7] = bfhi(a0.w) - lam * bfhi(b0.w);
          v[8] = bflo(a1.x) - lam * bflo(b1.x); v[9] = bfhi(a1.x) - lam * bfhi(b1.x); v[10] = bflo(a1.y) - lam * bflo(b1.y); v[11] = bfhi(a1.y) - lam * bfhi(b1.y);
          v[12] = bflo(a1.z) - lam * bflo(b1.z); v[13] = bfhi(a1.z) - lam * bfhi(b1.z); v[14] = bflo(a1.w) - lam * bflo(b1.w); v[15] = bfhi(a1.w) - lam * bfhi(b1.w);
          float ss = 0.f;
#pragma unroll
          for (int i = 0; i < 16; ++i) ss += v[i] * v[i];
          ss += __shfl_xor(ss, 1); ss += __shfl_xor(ss, 2); ss += __shfl_xor(ss, 4);
          const float rs = 1.f / sqrtf(ss * (1.f / 128.f) + EPS_) * (1.f - LAM_INIT);
          const float* g = a.in(I_SUBG) + 16 * (lane & 7);
          u32x4 w0, w1;
          w0.x = pk2(v[0] * rs * g[0], v[1] * rs * g[1]); w0.y = pk2(v[2] * rs * g[2], v[3] * rs * g[3]); w0.z = pk2(v[4] * rs * g[4], v[5] * rs * g[5]); w0.w = pk2(v[6] * rs * g[6], v[7] * rs * g[7]);
          w1.x = pk2(v[8] * rs * g[8], v[9] * rs * g[9]); w1.y = pk2(v[10] * rs * g[10], v[11] * rs * g[11]); w1.z = pk2(v[12] * rs * g[12], v[13] * rs * g[13]); w1.w = pk2(v[14] * rs * g[14], v[15] * rs * g[15]);
          bf16_t* yp = ycat + (size_t)m * 2048 + 1024 + 16 * lane;
          *(u32x4*)yp = w0; *(u32x4*)(yp + 8) = w1; }
    }
}

struct SchedDense {
    int G, c, nM, nN; const char* A; const char* B; unsigned lda, ldb; int bdiv; size_t bstride;
    DI bool next(int i, pg8::UnitD& u) const {
        const int L = i * G + c; if (L >= nM * nN) return false;
        u.rows = nullptr; u.nvalid = 0; u.lda = lda; u.ldb = ldb; u.type = 0; u.e = 0; u.x0 = 0;
        if (G == 256 && nM == 32 && nN == 8) { const int x = L >> 5, s = L & 31; u.pm = (x & 3) * 8 + (s & 7); u.pn = (x >> 2) * 4 + (s >> 3); }
        else { u.pn = L / nM; u.pm = L % nM; }
        u.A = A + (size_t)u.pm * 256 * lda; u.B = B + (size_t)u.pn * 256 * ldb + (size_t)(u.pm / bdiv) * bstride;
        return true;
    }
};
template <bool BASE_BF16>
struct EpiResid {
    static constexpr bool AFTER_DRAIN = false;
    const void* base; bf16_t* out; float* part; unsigned char* out8; float accscale;
    DI void operator()(const f32x4 (&acc)[2][2][4][2], const pg8::UnitD& u, int wr, int wc, int fr, int fq) const {
        { int ln_ = threadIdx.x; asm volatile("" : "+v"(ln_)); fr = ln_ & 15; fq = (ln_ >> 4) & 3; }
        const int row0 = u.pm * 256 + wr * 64 + fr, col0 = u.pn * 256 + wc * 32 + 8 * fq;
#pragma unroll
        for (int ai = 0; ai < 2; ++ai)
#pragma unroll
            for (int m = 0; m < 4; ++m) { const size_t row = (size_t)(row0 + ai * 128 + m * 16); float ss = 0.f;
#pragma unroll
                for (int bj = 0; bj < 2; ++bj) { const size_t idx = row * 2048 + col0 + bj * 128;
                    f32x4 b0, b1;
                    if constexpr (BASE_BF16) { const u32x4 r = *(const u32x4*)((const bf16_t*)base + idx); b0 = (f32x4){bflo(r.x), bfhi(r.x), bflo(r.y), bfhi(r.y)}; b1 = (f32x4){bflo(r.z), bfhi(r.z), bflo(r.w), bfhi(r.w)}; }
                    else { b0 = *(const f32x4*)((const float*)base + idx); b1 = *(const f32x4*)((const float*)base + idx + 4); }
                    const f32x4 v0 = acc[ai][bj][m][0] * accscale + b0, v1 = acc[ai][bj][m][1] * accscale + b1;
                    { u32x4 w; w.x = pk2(v0[0], v0[1]); w.y = pk2(v0[2], v0[3]); w.z = pk2(v1[0], v1[1]); w.w = pk2(v1[2], v1[3]); *(u32x4*)(out + idx) = w; }
                    if (out8) { u32x2 w; w.x = __builtin_amdgcn_cvt_pk_fp8_f32(v0[0] * 16.f, v0[1] * 16.f, 0u, false); w.x = __builtin_amdgcn_cvt_pk_fp8_f32(v0[2] * 16.f, v0[3] * 16.f, w.x, true);
                        w.y = __builtin_amdgcn_cvt_pk_fp8_f32(v1[0] * 16.f, v1[1] * 16.f, 0u, false); w.y = __builtin_amdgcn_cvt_pk_fp8_f32(v1[2] * 16.f, v1[3] * 16.f, w.y, true); *(u32x2*)(out8 + idx) = w; }
                    ss += (v0[0] * v0[0] + v0[1] * v0[1]) + (v0[2] * v0[2] + v0[3] * v0[3]) + (v1[0] * v1[0] + v1[1] * v1[1]) + (v1[2] * v1[2] + v1[3] * v1[3]); }
                if (part) { ss += __shfl_xor(ss, 16); ss += __shfl_xor(ss, 32); if (fq == 0) part[row * 32 + u.pn * 4 + wc] = ss; } }
    }
};

struct EpiQ {
    static constexpr bool AFTER_DRAIN = false;
    unsigned char* out8; float* part;
    DI void operator()(const f32x4 (&acc)[2][2][4][2], const pg8::UnitD& u, int wr, int wc, int fr, int fq) const {
        { int ln_ = threadIdx.x; asm volatile("" : "+v"(ln_)); fr = ln_ & 15; fq = (ln_ >> 4) & 3; }
        const int row0 = u.pm * 256 + wr * 64 + fr, col0 = u.pn * 256 + wc * 32 + 8 * fq;
#pragma unroll
        for (int ai = 0; ai < 2; ++ai)
#pragma unroll
            for (int m = 0; m < 4; ++m) { const size_t row = (size_t)(row0 + ai * 128 + m * 16); float ss = 0.f;
#pragma unroll
                for (int bj = 0; bj < 2; ++bj) { const size_t idx = row * 2048 + col0 + bj * 128; const f32x4 v0 = acc[ai][bj][m][0] * (1.f / 1024.f), v1 = acc[ai][bj][m][1] * (1.f / 1024.f);
                    u32x2 w; w.x = __builtin_amdgcn_cvt_pk_fp8_f32(v0[0] * 16.f, v0[1] * 16.f, 0u, false); w.x = __builtin_amdgcn_cvt_pk_fp8_f32(v0[2] * 16.f, v0[3] * 16.f, w.x, true);
                    w.y = __builtin_amdgcn_cvt_pk_fp8_f32(v1[0] * 16.f, v1[1] * 16.f, 0u, false); w.y = __builtin_amdgcn_cvt_pk_fp8_f32(v1[2] * 16.f, v1[3] * 16.f, w.y, true); *(u32x2*)(out8 + idx) = w;
                    ss += (v0[0] * v0[0] + v0[1] * v0[1]) + (v0[2] * v0[2] + v0[3] * v0[3]) + (v1[0] * v1[0] + v1[1] * v1[1]) + (v1[2] * v1[2] + v1[3] * v1[3]); }
                ss += __shfl_xor(ss, 16); ss += __shfl_xor(ss, 32); if (fq == 0) part[row * 32 + u.pn * 4 + wc] = ss; }
    }
};

struct SchedXS {
    int G, c; const unsigned char* ws;
    DI bool next(int i, pg8::UnitD& u) const {
        const int L = i * G + c; if (L >= 256) return false;
        u.rows = nullptr; u.nvalid = 0; u.e = 0;
        const int q = L & 127, bh = q >> 3, t8 = q & 7, b = bh >> 2, h = bh & 3;
        u.pm = b; u.pn = h; u.x0 = t8;
        if (L < 128) { u.type = 0; u.lda = 2048u; u.ldb = 512u;
            u.A = (const char*)(ws + WS_QF8) + (size_t)(b * 2048 + t8 * 256) * 2048 + h * 512; u.B = (const char*)(ws + WS_KN8) + (size_t)(bh * 256) * 512; }
        else { u.type = 1; u.lda = 2048u; u.ldb = 2048u;
            u.A = (const char*)(ws + WS_WO) + (size_t)(t8 * 256) * 2048 + h * 512; u.B = (const char*)(ws + WS_VF8) + (size_t)(b * 256) * 2048 + h * 512; }
        return true;
    }
};
struct EpiXS {
    static constexpr bool AFTER_DRAIN = false;
    unsigned char* P; unsigned char* VWT; const float* part1; const float* partq; LAS float* red;
    DI void operator()(const f32x4 (&acc)[2][2][4][2], const pg8::UnitD& u, int wr, int wc, int fr, int fq) const {
        { int ln_ = threadIdx.x; asm volatile("" : "+v"(ln_)); fr = ln_ & 15; fq = (ln_ >> 4) & 3; }
        const int b = u.pm, h = u.pn, t8 = u.x0;
        const int col0 = wc * 32 + 8 * fq;
        if (u.type == 1) {
            unsigned char* Vu = VWT + ((size_t)b * 2048 + t8 * 256) * 1024 + h * 256;
#pragma unroll
            for (int ai = 0; ai < 2; ++ai)
#pragma unroll
                for (int m = 0; m < 4; ++m) { const unsigned rl = (unsigned)(ai * 128 + wr * 64 + m * 16 + fr);
#pragma unroll
                    for (int bj = 0; bj < 2; ++bj) { const f32x4 v0 = acc[ai][bj][m][0] * (32.f / 1024.f), v1 = acc[ai][bj][m][1] * (32.f / 1024.f);
                        u32x2 w; w.x = __builtin_amdgcn_cvt_pk_fp8_f32(v0[0], v0[1], 0u, false); w.x = __builtin_amdgcn_cvt_pk_fp8_f32(v0[2], v0[3], w.x, true);
                        w.y = __builtin_amdgcn_cvt_pk_fp8_f32(v1[0], v1[1], 0u, false); w.y = __builtin_amdgcn_cvt_pk_fp8_f32(v1[2], v1[3], w.y, true);
                        *(u32x2*)(Vu + (rl * 1024u + (unsigned)(bj * 128 + col0))) = w; } }
            return;
        }
        const size_t row0 = (size_t)b * 2048 + t8 * 256;
        const char* p1u = (const char*)(part1 + row0 * 32); const char* pqu = (const char*)(partq + row0 * 32 + h * 8); unsigned char* Pu = P + row0 * 1024 + h * 256;
        float rsc[2][4];
#pragma unroll
        for (int ai = 0; ai < 2; ++ai)
#pragma unroll
            for (int m = 0; m < 4; ++m) { const unsigned rl = (unsigned)(ai * 128 + wr * 64 + m * 16 + fr);
                const f32x4 p0 = *(const f32x4*)(p1u + (rl * 32u + (unsigned)fq * 8u) * 4u), p1 = *(const f32x4*)(p1u + (rl * 32u + (unsigned)fq * 8u + 4u) * 4u);
                float s1 = (p0[0] + p0[1]) + (p0[2] + p0[3]) + (p1[0] + p1[1]) + (p1[2] + p1[3]);
                const f32x2 pq = *(const f32x2*)(pqu + (rl * 32u + (unsigned)fq * 2u) * 4u);
                float sq = pq[0] + pq[1];
                s1 = quad_sum_16_32(s1); sq = quad_sum_16_32(sq);
                rsc[ai][m] = __builtin_amdgcn_rsqf(sq * (1.f / 512.f) + EPS_ * (s1 * (1.f / 2048.f) + EPS_)) * (1.4426950408889634f / 2048.f);
                float ps = 0.f;
#pragma unroll
                for (int bj = 0; bj < 2; ++bj)
#pragma unroll
                    for (int n = 0; n < 2; ++n)
#pragma unroll
                        for (int e = 0; e < 4; ++e) ps += __builtin_amdgcn_exp2f(fminf(acc[ai][bj][m][n][e] * rsc[ai][m], 100.f));
                ps = quad_sum_16_32(ps);
                if (fq == 0) red[rl * 4 + wc] = ps;
                __builtin_amdgcn_sched_barrier(0); }
        __syncthreads();
        { int ln_ = threadIdx.x; asm volatile("" : "+v"(ln_)); fr = ln_ & 15; fq = (ln_ >> 4) & 3; }
#pragma unroll
        for (int ai = 0; ai < 2; ++ai)
#pragma unroll
            for (int m = 0; m < 4; ++m) { const unsigned rl = (unsigned)(ai * 128 + wr * 64 + m * 16 + fr);
                const f32x4 t = *(const LAS f32x4*)(red + rl * 4); const float inv = 256.f * __builtin_amdgcn_rcpf((t[0] + t[1]) + (t[2] + t[3])); float rs = rsc[ai][m]; asm volatile("" : "+v"(rs));
#pragma unroll
                for (int bj = 0; bj < 2; ++bj) { float x[8];
#pragma unroll
                    for (int n = 0; n < 2; ++n)
#pragma unroll
                        for (int e = 0; e < 4; ++e) x[n * 4 + e] = __builtin_amdgcn_exp2f(fminf(acc[ai][bj][m][n][e] * rs, 100.f)) * inv;
                    u32x2 w; w.x = __builtin_amdgcn_cvt_pk_fp8_f32(x[0], x[1], 0u, false); w.x = __builtin_amdgcn_cvt_pk_fp8_f32(x[2], x[3], w.x, true);
                    w.y = __builtin_amdgcn_cvt_pk_fp8_f32(x[4], x[5], 0u, false); w.y = __builtin_amdgcn_cvt_pk_fp8_f32(x[6], x[7], w.y, true);
                    *(u32x2*)(Pu + (rl * 1024u + (unsigned)(bj * 128 + wc * 32 + 8 * fq))) = w; } }
        __syncthreads();
    }
};

constexpr int HNP = 2052;
DI void p8_route(Frame& F, const ArgP& a) {
    LAS float* s_hn = (LAS float*)F.lds; LAS float* s_part = (LAS float*)(F.lds + 16 * HNP * 4); LAS float* s_log = s_part + 8 * 16 * 32; LAS int* s_slot = (LAS int*)(s_log + 16 * 32);
    LAS int* s_cnt = s_slot + 64; LAS int* s_base = s_cnt + 32;
    const bf16_t* h2 = (const bf16_t*)(F.ws + WS_H2); unsigned char* xg = (unsigned char*)(F.ws + WS_XG);
    float* gate_of = (float*)(F.ws + WS_GATEOF); int* tok_e = (int*)(F.ws + WS_TOKE);
    const float* rw = a.in(I_RW); const float* rb = a.in(I_RB); const float* g3 = a.in(I_GFFN);
    const int lane = F.lane, wave = F.wave, tid = F.tid;
    float bw0[64], bw1[64];
    { const int kq = lane >> 4, c16 = lane & 15; const float* bp = rw + (size_t)(256 * wave + kq) * 32 + c16;
#pragma unroll
      for (int j = 0; j < 64; ++j) { bw0[j] = bp[(size_t)(4 * j) * 32]; bw1[j] = bp[(size_t)(4 * j) * 32 + 16]; } }
    for (int task = F.vcu; task < NTOK / 16; task += F.G) {
        const int tb = task * 16;
#pragma unroll
        for (int q = 0; q < 2; ++q) { const int tl = 2 * wave + q; const size_t tok = (size_t)(tb + tl);
            const u32x2* xr = (const u32x2*)(h2 + tok * 2048) + lane;
            f32x4 v[8]; float s = 0.f;
#pragma unroll
            for (int j = 0; j < 8; ++j) { const u32x2 rw_ = xr[64 * j]; v[j] = (f32x4){bflo(rw_.x), bfhi(rw_.x), bflo(rw_.y), bfhi(rw_.y)}; s += (v[j].x * v[j].x + v[j].y * v[j].y) + (v[j].z * v[j].z + v[j].w * v[j].w); }
            const float rstd = 1.f / sqrtf(wave_sum(s) * (1.f / 2048.f) + EPS_);
#pragma unroll
            for (int j = 0; j < 8; ++j) { const f32x4 gg = ((const f32x4*)g3)[lane + 64 * j]; const f32x4 y = v[j] * rstd * gg;
                *(LAS f32x4*)(s_hn + tl * HNP + (lane + 64 * j) * 4) = y; } }
        __syncthreads();
        {
            f32x4 acc0 = {0.f, 0.f, 0.f, 0.f}, acc1 = {0.f, 0.f, 0.f, 0.f};
            const int kq = lane >> 4, c16 = lane & 15;
            const LAS float* ap = s_hn + c16 * HNP + 256 * wave;
#pragma unroll
            for (int j = 0; j < 64; ++j) { const f32x4 a4 = *(const LAS f32x4*)(ap + 4 * j);
                const float av = (kq == 0) ? a4.x : (kq == 1) ? a4.y : (kq == 2) ? a4.z : a4.w;
                acc0 = __builtin_amdgcn_mfma_f32_16x16x4f32(av, bw0[j], acc0, 0, 0, 0);
                acc1 = __builtin_amdgcn_mfma_f32_16x16x4f32(av, bw1[j], acc1, 0, 0, 0); }
            LAS float* pp = s_part + wave * 512 + c16;
#pragma unroll
            for (int r = 0; r < 4; ++r) { pp[(4 * kq + r) * 32] = acc0[r]; pp[(4 * kq + r) * 32 + 16] = acc1[r]; }
        }
        __syncthreads();
        {
            const int tt = tid >> 5, e = tid & 31; float lg = rb[e];
#pragma unroll
            for (int w = 0; w < 8; ++w) lg += s_part[w * 512 + tt * 32 + e];
            if (tid < 32) s_cnt[tid] = 0;
            float val[4]; int idx[4]; float cur = lg;
#pragma unroll
            for (int k = 0; k < 4; ++k) { float bv = cur; int bi = e;
#pragma unroll
                for (int o = 1; o < 32; o <<= 1) { const float ov = __shfl_xor(bv, o); const int oi = __shfl_xor(bi, o); if (ov > bv || (ov == bv && oi < bi)) { bv = ov; bi = oi; } }
                val[k] = bv; idx[k] = bi; if (e == bi) cur = -INFINITY; }
            __syncthreads();
            int myrank = 0, myexp = 0; float mygate = 0.f;
            if (e < 4) { const float sum = (__expf(val[0] - val[0]) + __expf(val[1] - val[0])) + (__expf(val[2] - val[0]) + __expf(val[3] - val[0]));
                const float mv = (e == 0) ? val[0] : (e == 1) ? val[1] : (e == 2) ? val[2] : val[3]; myexp = (e == 0) ? idx[0] : (e == 1) ? idx[1] : (e == 2) ? idx[2] : idx[3];
                mygate = __expf(mv - val[0]) / sum; myrank = __hip_atomic_fetch_add(&s_cnt[myexp], 1, __ATOMIC_RELAXED, __HIP_MEMORY_SCOPE_WORKGROUP); }
            __syncthreads();
            if (tid < 32) { const int c = s_cnt[tid]; s_base[tid] = c ? (int)__hip_atomic_fetch_add(F.ctl + CW_CNT + 64 * tid, (unsigned)c, __ATOMIC_RELAXED, __HIP_MEMORY_SCOPE_AGENT) : 0; }
            __syncthreads();
            if (e < 4) { const int slot = myexp * 8192 + s_base[myexp] + myrank; const int tok = tb + tt;
                gate_of[slot] = mygate; tok_e[tok * 4 + e] = slot; s_slot[tt * 4 + e] = slot; }
        }
        __syncthreads();
#pragma unroll
        for (int q = 0; q < 2; ++q) { const int tl = 2 * wave + q;
            unsigned o[8];
#pragma unroll
            for (int j = 0; j < 8; ++j) { const f32x4 y = *(const LAS f32x4*)(s_hn + tl * HNP + (lane + 64 * j) * 4);
                unsigned w = 0u; w = __builtin_amdgcn_cvt_pk_fp8_f32(y.x * 4.f, y.y * 4.f, w, false); w = __builtin_amdgcn_cvt_pk_fp8_f32(y.z * 4.f, y.w * 4.f, w, true); o[j] = w; }
#pragma unroll
            for (int k = 0; k < 4; ++k) { unsigned* o4 = (unsigned*)(xg + (size_t)s_slot[tl * 4 + k] * 2048) + lane;
#pragma unroll
                for (int j = 0; j < 8; ++j) o4[64 * j] = o[j]; } }
        __syncthreads();
    }
}

DI void moe_tables(Frame& F) {
    if (F.tid < 64) { const int e = F.tid & 31;
        const unsigned c = F.ctl[CW_CNT + 64 * e], mt = (c + 255u) >> 8;
        unsigned incl = mt;
#pragma unroll
        for (int o = 1; o < 32; o <<= 1) { const unsigned v = __shfl_up(incl, o, 64); if (e >= o) incl += v; }
        const unsigned base = incl - mt;
        if (F.tid < 32) { F.MISC[16 + e] = c; F.MISC[48 + e] = base; F.MISC[80 + e] = mt; if (e == 31) F.MISC[112] = incl;
            volatile LAS unsigned char* tab = (volatile LAS unsigned char*)(F.MISC + 128);
            for (unsigned t = 0; t < mt; ++t) tab[base + t] = (unsigned char)e; } }
    __syncthreads();
}
DI int ldsu(volatile LAS unsigned* p) { return __builtin_amdgcn_readfirstlane((int)*p); }
template <int NTN  >
struct SchedMoe {
    int G, c; const unsigned char* ws; volatile LAS unsigned* MISC; int total;
    DI bool next(int i, pg8::UnitD& u) const {
        const int L = i * G + c; if (L >= total) return false;
        const int e = __builtin_amdgcn_readfirstlane((int)((volatile LAS unsigned char*)(MISC + 128))[L / NTN]);
        const int tb = ldsu(MISC + 48 + e), mte = ldsu(MISC + 80 + e), cnt = ldsu(MISC + 16 + e);
        const int local = L - tb * NTN, nt = local / mte, mt = local % mte;
        u.type = 0; u.e = e; u.pn = nt; u.pm = tb + mt; u.x0 = mt; u.lda = 2048u; u.ldb = 128u;
        u.rows = nullptr; u.nvalid = cnt - mt * 256;
        if (NTN == 16) { u.A = (const char*)(ws + WS_XG) + ((size_t)e * 8192 + (size_t)mt * 256) * 2048;
            u.B = (const char*)(ws + WS_W1) + ((size_t)e * 4096 + (size_t)nt * 256) * 2048; }
        else { u.A = (const char*)(ws + WS_ACT) + ((size_t)e * 8192 + (size_t)mt * 256) * 2048;
            u.B = (const char*)(ws + WS_W2) + ((size_t)e * 2048 + (size_t)nt * 256) * 2048; }
        return true;
    }
};
struct EpiMoe1 {
    static constexpr bool AFTER_DRAIN = false;
    unsigned char* act; const float* b1;
    DI void operator()(const f32x4 (&acc)[2][2][4][2], const pg8::UnitD& u, int wr, int wc, int fr, int fq) const {
        { int ln_ = threadIdx.x; asm volatile("" : "+v"(ln_)); fr = ln_ & 15; fq = (ln_ >> 4) & 3; }
        const int j0 = u.pn * 128 + wc * 32 + 8 * fq;
        const float* bg = b1 + (size_t)u.e * 4096 + j0; const float* bu = bg + 2048;
        const f32x4 bg0 = *(const f32x4*)bg, bg1 = *(const f32x4*)(bg + 4), bu0 = *(const f32x4*)bu, bu1 = *(const f32x4*)(bu + 4);
#pragma unroll
        for (int ai = 0; ai < 2; ++ai)
#pragma unroll
            for (int m = 0; m < 4; ++m) { const size_t row = (size_t)u.e * 8192 + u.x0 * 256 + ai * 128 + wr * 64 + m * 16 + fr;
                float o[8];
#pragma unroll
                for (int n = 0; n < 2; ++n)
#pragma unroll
                    for (int e = 0; e < 4; ++e) { const float g = fminf(acc[ai][0][m][n][e] * (1.f / 256.f) + (n ? bg1[e] : bg0[e]), 7.f);
                        const float uu = fminf(fmaxf(acc[ai][1][m][n][e] * (1.f / 256.f) + (n ? bu1[e] : bu0[e]), -7.f), 7.f);
                        o[n * 4 + e] = g / (1.f + __expf(-1.702f * g)) * (uu + 1.f) * 4.f; }
                u32x2 w; w.x = __builtin_amdgcn_cvt_pk_fp8_f32(o[0], o[1], 0u, false); w.x = __builtin_amdgcn_cvt_pk_fp8_f32(o[2], o[3], w.x, true);
                w.y = __builtin_amdgcn_cvt_pk_fp8_f32(o[4], o[5], 0u, false); w.y = __builtin_amdgcn_cvt_pk_fp8_f32(o[6], o[7], w.y, true);
                *(u32x2*)(act + row * 2048 + j0) = w; }
    }
};
struct EpiMoe2 {
    static constexpr bool AFTER_DRAIN = false;
    unsigned char* y; const float* b2; const float* gate_of;
    DI void operator()(const f32x4 (&acc)[2][2][4][2], const pg8::UnitD& u, int wr, int wc, int fr, int fq) const {
        { int ln_ = threadIdx.x; asm volatile("" : "+v"(ln_)); fr = ln_ & 15; fq = (ln_ >> 4) & 3; }
        const int col0 = u.pn * 256 + wc * 32 + 8 * fq;
        const float* bp = b2 + (size_t)u.e * 2048 + col0;
#pragma unroll
        for (int ai = 0; ai < 2; ++ai)
#pragma unroll
            for (int m = 0; m < 4; ++m) { const int rl = ai * 128 + wr * 64 + m * 16 + fr; const size_t row = (size_t)u.e * 8192 + u.x0 * 256 + rl;
                const float gt = (rl < u.nvalid) ? gate_of[u.e * 8192 + u.x0 * 256 + rl] * 32.f : 0.f;
#pragma unroll
                for (int bj = 0; bj < 2; ++bj) { const f32x4 v0 = (acc[ai][bj][m][0] * (1.f / 256.f) + *(const f32x4*)(bp + bj * 128)) * gt, v1 = (acc[ai][bj][m][1] * (1.f / 256.f) + *(const f32x4*)(bp + bj * 128 + 4)) * gt;
                    u32x2 w; w.x = __builtin_amdgcn_cvt_pk_fp8_f32(v0[0], v0[1], 0u, false); w.x = __builtin_amdgcn_cvt_pk_fp8_f32(v0[2], v0[3], w.x, true);
                    w.y = __builtin_amdgcn_cvt_pk_fp8_f32(v1[0], v1[1], 0u, false); w.y = __builtin_amdgcn_cvt_pk_fp8_f32(v1[2], v1[3], w.y, true);
                    *(u32x2*)(y + row * 2048 + col0 + bj * 128) = w; } }
    }
};

DI void p11_combine(Frame& F, const ArgP& a) {
    const int gw = F.vcu * NWAVES + F.wave, NGW = F.G * NWAVES, lane = F.lane;
    const bf16_t* h2 = (const bf16_t*)(F.ws + WS_H2); const unsigned char* y = (const unsigned char*)(F.ws + WS_Y);
    const int* tok_e = (const int*)(F.ws + WS_TOKE);
    for (int t = gw; t < NTOK; t += NGW) {
        size_t yrow[4];
#pragma unroll
        for (int k = 0; k < 4; ++k) yrow[k] = (size_t)tok_e[t * 4 + k] * 2048;
#pragma unroll
        for (int j = 0; j < 8; ++j) { const int c = (lane + 64 * j) * 4;
            const u32x2 hw = *(const u32x2*)(h2 + (size_t)t * 2048 + c); f32x4 v = {bflo(hw.x), bfhi(hw.x), bflo(hw.y), bfhi(hw.y)};
#pragma unroll
            for (int k = 0; k < 4; ++k) { const unsigned w = *(const unsigned*)(y + yrow[k] + c); const f32x2 lo = __builtin_amdgcn_cvt_pk_f32_fp8(w, false), hi = __builtin_amdgcn_cvt_pk_f32_fp8(w, true);
                v.x += lo.x * (1.f / 32.f); v.y += lo.y * (1.f / 32.f); v.z += hi.x * (1.f / 32.f); v.w += hi.y * (1.f / 32.f); }
            *(f32x4*)(a.out() + (size_t)t * 2048 + c) = v; }
    }
}

#ifndef MK_PER_PHASE
#define MK_PER_PHASE 0
#endif
#ifndef MK_LAST_PHASE
#define MK_LAST_PHASE 12
#endif
constexpr int N_PHASES = MK_LAST_PHASE;

__global__ void __launch_bounds__(NWAVES * 64, 2) mega_fwd(Args args_) {
    const ArgP args{};
    extern __shared__ __attribute__((aligned(16))) unsigned char lds_raw[];
    Frame F;
    F.lds = (LAS unsigned char*)lds_raw;
    F.MISC = (volatile LAS unsigned*)(F.lds + MISC_OFF);
    F.tid = threadIdx.x; F.lane = F.tid & 63; F.wave = __builtin_amdgcn_readfirstlane(F.tid >> 6);
    F.G = gridDim.x; { const int bx = blockIdx.x; F.vcu = (F.G % 8 == 0) ? (bx % 8) * (F.G / 8) + bx / 8 : bx; }
    F.ws = args_.ws; F.ctl = (unsigned*)(args_.ws + WS_CTL);
    for (int u = F.tid; u < 256; u += NWAVES * 64) F.MISC[u] = 0u;
    __syncthreads();
    XcdBarrier bar; bar.bar = F.ctl + CW_BAR; bar.x = 0; bar.st = nullptr;
    const int lo = args_.ph_lo, hi = args_.ph_hi;
    if (hi - lo > 1) bar = xcd_barrier_post(F.ctl + CW_BAR, F.MISC + 8);
#ifndef MK_PHASE_MASK
#define MK_PHASE_MASK 0xFFFF
#endif
#define IN(k) (((MK_PHASE_MASK >> (k)) & 1) && lo <= (k) && (k) < hi)
#define SEAM(k) do { if (IN(k) && IN((k) + 1)) xcd_barrier(bar); } while (0)
#define FRESH() do { int t_ = threadIdx.x; asm volatile("" : "+v"(t_)); F.tid = t_; F.lane = t_ & 63; F.wave = __builtin_amdgcn_readfirstlane(t_ >> 6); } while (0)
    unsigned char* ws = args_.ws;

    if (IN(0)) { FRESH(); p0_prologue(F, args); }
    SEAM(0);
    if (IN(1)) { FRESH();
        const bool conv_first = (F.vcu & 1) == 0;
        if (conv_first) { conv_share(F, args); __syncthreads(); }
        SchedP1 S{F.G, F.vcu, ws, 0, 32 * 23};
        EpiP1 E{(bf16_t*)(ws + WS_PROJ), (float*)(ws + WS_DT), (bf16_t*)(ws + WS_KVRAW), args.in(I_DAQG), args.in(I_DAKG), (unsigned char*)(ws + WS_VF8)};
        pg8::gemm_phase<EpiP1, SchedP1, false, true>(F.lds + RING_OFF, 32, S, E);
        if (!conv_first) { __syncthreads(); conv_share(F, args); }
    }
    SEAM(1);
    if (IN(2)) { FRESH();
        if ((F.vcu & 3) == 1) {
            SchedP1 S{(F.G + 3) >> 2, F.vcu >> 2, ws, 32 * 23, 32 * 23 + 64};
            EpiP1 E{(bf16_t*)(ws + WS_PROJ), (float*)(ws + WS_DT), (bf16_t*)(ws + WS_KVRAW), args.in(I_DAQG), args.in(I_DAKG), (unsigned char*)(ws + WS_VF8)};
            pg8::gemm_phase<EpiP1, SchedP1, false, true>(F.lds + RING_OFF, 32, S, E);
            __syncthreads();
        }
        if ((F.vcu & 3) == 0) { for (int u = F.vcu >> 2; u < 64; u += (F.G + 3) >> 2) ssd_unit(F, args, u >> 4, u & 15); }
        __syncthreads();
        attn_phase_da(F);
        __syncthreads();
        conv_queue(F, args, CW_QCONV, CV_NJ - CV_TAIL, CV_TAIL1);
    }
    SEAM(2);
    if (IN(3)) { FRESH(); kprep(F, args); p3_finalize(F, args); }
    SEAM(3);
    if (IN(4)) { FRESH();
        SchedDense S{F.G, F.vcu, 32, 8, (const char*)(ws + WS_YCAT), (const char*)(ws + WS_WOUT), 4096u, 4096u, 1 << 30, 0};
        EpiResid<false> E{args.in(I_X), (bf16_t*)(ws + WS_H1), (float*)(ws + WS_PART1), (unsigned char*)(ws + WS_H1F8), 1.f};
        pg8::gemm_phase<EpiResid<false>, SchedDense, false, true>(F.lds + RING_OFF, 32, S, E);
    }
    SEAM(4);
    if (IN(5)) { FRESH();
        SchedDense S{F.G, F.vcu, 32, 8, (const char*)(ws + WS_H1F8), (const char*)(ws + WS_WQ), 2048u, 2048u, 1 << 30, 0};
        EpiQ E{(unsigned char*)(ws + WS_QF8), (float*)(ws + WS_PARTQ)};
        pg8::gemm_phase<EpiQ, SchedDense, false, true, true>(F.lds + RING_OFF, 16, S, E);
    }
    SEAM(5);
    if (IN(6)) { FRESH();
        SchedXS S{F.G, F.vcu, ws};
        EpiXS E{(unsigned char*)(ws + WS_P8), (unsigned char*)(ws + WS_VWT8), (const float*)(ws + WS_PART1), (const float*)(ws + WS_PARTQ), (LAS float*)(F.lds + RING_BYTES)};
        pg8::gemm_phase<EpiXS, SchedXS, false, true, true>(F.lds + RING_OFF, 4, S, E);
    }
    SEAM(6);
    if (IN(7)) { FRESH();
        SchedDense S{F.G, F.vcu, 32, 8, (const char*)(ws + WS_P8), (const char*)(ws + WS_VWT8), 1024u, 1024u, 8, (size_t)2048 * 1024};
        EpiResid<true> E{(const void*)(ws + WS_H1), (bf16_t*)(ws + WS_H2), nullptr, nullptr, 1.f / 8192.f};
        pg8::gemm_phase<EpiResid<true>, SchedDense, false, true, true>(F.lds + RING_OFF, 8, S, E);
    }
    SEAM(7);
    if (IN(8)) { FRESH(); p8_route(F, args); }
    SEAM(8);
    if (IN(9)) { FRESH();
        moe_tables(F);
        SchedMoe<16> S{F.G, F.vcu, ws, F.MISC, ldsu(F.MISC + 112) * 16};
        EpiMoe1 E{(unsigned char*)(ws + WS_ACT), args.in(I_B1)};
        pg8::gemm_phase<EpiMoe1, SchedMoe<16>, false, true, true>(F.lds + RING_OFF, 16, S, E);
        __syncthreads();
        conv_queue(F, args, CW_QCONV2, CV_NJ - CV_TAIL2, CV_TAIL2);
    }
    SEAM(9);
    if (IN(10)) { FRESH();
        moe_tables(F);
        SchedMoe<8> S{F.G, F.vcu, ws, F.MISC, ldsu(F.MISC + 112) * 8};
        EpiMoe2 E{(unsigned char*)(ws + WS_Y), args.in(I_B2), (const float*)(ws + WS_GATEOF)};
        pg8::gemm_phase<EpiMoe2, SchedMoe<8>, false, true, true>(F.lds + RING_OFF, 16, S, E);
    }
    SEAM(10);
    if (IN(11)) { FRESH(); p11_combine(F, args); }
#undef IN
#undef SEAM
}

extern "C" void kernel_launch(void* const* d_in, const int* in_sizes, int n_in, void* d_out, int out_size, void* d_ws, size_t ws_size, hipStream_t stream) {
    static int grid = 0;
    if (grid == 0) {
        if (n_in != 32 || out_size != NTOK * 2048 || ws_size < WS_END) { fprintf(stderr, "kernel_launch: unexpected shapes (n_in %d out %d ws %zu); nothing launched\n", n_in, out_size, ws_size); grid = -1; return; }
        int dev = 0, cus = 0, per_cu = 0;
        if (hipGetDevice(&dev) != hipSuccess || hipDeviceGetAttribute(&cus, hipDeviceAttributeMultiprocessorCount, dev) != hipSuccess) { grid = -1; return; }
        if (hipFuncSetAttribute((const void*)mega_fwd, hipFuncAttributeMaxDynamicSharedMemorySize, LDS_BYTES) != hipSuccess) { fprintf(stderr, "kernel_launch: hipFuncSetAttribute failed\n"); grid = -1; return; }
        if (hipOccupancyMaxActiveBlocksPerMultiprocessor(&per_cu, (const void*)mega_fwd, NWAVES * 64, LDS_BYTES) != hipSuccess || per_cu < 1) { fprintf(stderr, "kernel_launch: occupancy query says %d\n", per_cu); }
        (void)hipGetLastError();
        if (cus < 256) { fprintf(stderr, "kernel_launch: needs 256 CUs, found %d; nothing launched\n", cus); grid = -1; return; }
        grid = 256;
    }
    if (grid < 0) return;
    if (hipMemsetAsync((char*)d_ws + WS_CTL, 0, CTL_ZERO_BYTES, stream) != hipSuccess) return;
    Args a{};
    for (int i = 0; i < 32; ++i) a.in[i] = (const float*)d_in[i];
    a.out = (float*)d_out; a.ws = (unsigned char*)d_ws;
#if MK_PER_PHASE
    for (int p = 0; p < N_PHASES; ++p) { a.ph_lo = p; a.ph_hi = p + 1; hipLaunchKernelGGL(mega_fwd, dim3(grid), dim3(NWAVES * 64), LDS_BYTES, stream, a); }
#else
    a.ph_lo = 0; a.ph_hi = N_PHASES;
    hipLaunchKernelGGL(mega_fwd, dim3(grid), dim3(NWAVES * 64), LDS_BYTES, stream, a);
#ifdef MK_PROBE_LO
    for (int p = MK_PROBE_LO; p < MK_PROBE_HI; ++p) { a.ph_lo = p; a.ph_hi = p + 1;
#ifdef MK_HOTPROBE
        a.probe = MK_HOTPROBE;
#endif
        if (p == 2) (void)hipMemsetAsync((char*)d_ws + WS_CTL + CW_QATT * 4, 0, 1024, stream);
        hipLaunchKernelGGL(mega_fwd, dim3(grid), dim3(NWAVES * 64), LDS_BYTES, stream, a); }
#endif
#endif
}
```

```cpp
#define MK_PER_PHASE 0
#define MK_LAST_PHASE 12
#include <hip/hip_runtime.h>
#include <hip/hip_bf16.h>
#include <cstdio>
#include <cstdint>
#include <cmath>

#define GAS __attribute__((address_space(1)))
#define LAS __attribute__((address_space(3)))
typedef unsigned short bf16_t;
typedef short bf16x8 __attribute__((ext_vector_type(8)));
typedef float f32x2 __attribute__((ext_vector_type(2)));
typedef float f32x4 __attribute__((ext_vector_type(4)));
typedef float f32x16 __attribute__((ext_vector_type(16)));
typedef unsigned u32x2 __attribute__((ext_vector_type(2)));
typedef unsigned u32x4 __attribute__((ext_vector_type(4)));
typedef __bf16 bf16x2_t __attribute__((ext_vector_type(2)));

#define DI __device__ __forceinline__
DI unsigned pk2(float lo, float hi) { f32x2 v = {lo, hi}; bf16x2_t b = __builtin_convertvector(v, bf16x2_t); return __builtin_bit_cast(unsigned, b); }
DI float bflo(unsigned u) { return __uint_as_float(u << 16); }
DI float bfhi(unsigned u) { return __uint_as_float(u & 0xffff0000u); }
DI float bf2f(bf16_t h) { return __uint_as_float(((unsigned)h) << 16); }
DI float wave_sum(float v) {
#pragma unroll
    for (int o = 1; o < 64; o <<= 1) v += __shfl_xor(v, o);
    return v;
}
DI float quad_sum_16_32(float v) {
    int l_ = threadIdx.x; asm volatile("" : "+v"(l_));
    const int a16 = ((l_ ^ 16) & 63) << 2, a32 = ((l_ ^ 32) & 63) << 2;
    v += __builtin_bit_cast(float, __builtin_amdgcn_ds_bpermute(a16, __builtin_bit_cast(int, v)));
    v += __builtin_bit_cast(float, __builtin_amdgcn_ds_bpermute(a32, __builtin_bit_cast(int, v)));
    return v;
}
DI float siluf(float x) { return x / (1.f + __expf(-x)); }

constexpr int DM_ = 2048, NB = 4, SEQ_ = 2048, NTOK = NB * SEQ_;
constexpr int PP = 5632;
constexpr int PC_XBC = 1024, PC_Q = 2560, PC_K = 3584, PC_V = 4608, PC_DT = 5632;
constexpr int WIN_ROWS = 5888;
constexpr int NEXP = 32, MEMLEN = 256;
constexpr float EPS_ = 1e-6f;
constexpr float LAM_INIT = 0.2f;

namespace pg8 {
constexpr int BM = 256, BK = 64, HALF = 128, HTB = HALF * BK * 2  , STAGE_BYTES = 8 * HTB;
DI int lds_byte(int r, int c) { const int st = (r >> 4) * 2 + (c >> 5), rr = r & 15, cc = c & 31, ob = rr * 64 + cc * 2; return st * 1024 + (ob ^ (((ob >> 9) & 1) << 5)); }
DI void stage_rc(int b, int& R, int& C) { const int st = b / 1024, sb = b % 1024, swz = sb ^ (((sb >> 9) & 1) << 5); R = (st >> 1) * 16 + swz / 64; C = (st & 1) * 32 + (swz % 64) / 2; }
DI int perm32(int rho) { const int n = rho >> 4, i = rho & 15; return 8 * (i >> 2) + 4 * n + (i & 3); }

struct UnitD {
    const char* A; const char* B;
    const int* rows;
    unsigned lda, ldb;
    int nvalid;
    int type, pm, pn, e, x0;
};
typedef int v8i_t __attribute__((ext_vector_type(8)));
DI v8i_t cat8(bf16x8 lo, bf16x8 hi) { typedef int v4i_t __attribute__((ext_vector_type(4))); const v4i_t a = __builtin_bit_cast(v4i_t, lo), b = __builtin_bit_cast(v4i_t, hi); return (v8i_t){a[0], a[1], a[2], a[3], b[0], b[1], b[2], b[3]}; }
DI void dense_voff(unsigned lda, unsigned ldb, int tid, unsigned (&vA)[2], unsigned (&vB)[2]) {
#pragma unroll
    for (int i = 0; i < 2; ++i) { int R, C; stage_rc(tid * 16 + i * 8192, R, C); const int Rb = (R & ~31) + perm32(R & 31);
        vA[i] = (unsigned)R * lda + (unsigned)C * 2u; vB[i] = (unsigned)Rb * ldb + (unsigned)C * 2u; }
}
DI void gather_voff(const UnitD& u, int tid, unsigned (&gA)[2][2]) {
#pragma unroll
    for (int i = 0; i < 2; ++i) { int R, C; stage_rc(tid * 16 + i * 8192, R, C);
#pragma unroll
        for (int h = 0; h < 2; ++h) { const int ra = h * 128 + R; const unsigned rowA = (ra < u.nvalid) ? (unsigned)u.rows[ra] : 0u; gA[h][i] = rowA * u.lda + (unsigned)C * 2u; } }
}

template <class Epi, class Sched, bool GATHER, bool ALIGN_EPI, bool FP8 = false>
DI void gemm_phase(LAS unsigned char* lds, int nt, const Sched& S, const Epi& E) {

    const int tid = threadIdx.x, wid = __builtin_amdgcn_readfirstlane(tid >> 6), lane = tid & 63, wr = wid >> 2, wc = wid & 3, fr = lane & 15, fq = lane >> 4;
#ifndef MK_HOTPROBE
#define PG8_NODMA false
#define PG8_NOMMA false
#define PG8_NOLD false
#define PG8_NOEPI false
#define PG8_NOLOOP false
#else
#define PG8_NODMA ((hot_ & 4) != 0)
#define PG8_NOMMA ((hot_ & 8) != 0)
#define PG8_NOLD ((hot_ & 16) != 0)
#define PG8_NOEPI ((hot_ & 32) != 0)
#define PG8_NOLOOP ((hot_ & 64) != 0)
#endif
#ifdef MK_HOTPROBE
    int hot_; { typedef const __attribute__((address_space(4))) char* kptr; kptr kp = (kptr)__builtin_amdgcn_kernarg_segment_ptr(); asm volatile("" : "+s"(kp)); hot_ = *(const int __attribute__((address_space(4)))*)(kp + 280); }
    const size_t kstep = (hot_ & 1) ? (size_t)0 : (size_t)(BK * 2);
#else
    const size_t kstep = (size_t)(BK * 2);
#endif
    const unsigned ldsb = (unsigned)__builtin_amdgcn_readfirstlane((int)((unsigned)(uintptr_t)lds + (unsigned)wid * 1024u));
    const int aoff = lds_byte(wr * 64 + fr, fq * 8), boff = lds_byte(wc * 32 + fr, fq * 8);
#define PG8_SA(b, h) (((b) * 2 + (h)) * HTB)
#define PG8_SB(b, h) ((4 + (b) * 2 + (h)) * HTB)
#define PG8_STAGE(bufoff, gbase, voff) do { if (PG8_NODMA) break; _Pragma("unroll") for (int _i = 0; _i < 2; ++_i) { unsigned keep_; \
        asm volatile("s_mov_b32 %0, m0\n\ts_mov_b32 m0, %3\n\ts_nop 0\n\tglobal_load_lds_dwordx4 %1, %2\n\ts_mov_b32 m0, %0" \
                     : "=&s"(keep_) : "v"((voff)[_i]), "s"((const char*)(gbase)), "s"(ldsb + (unsigned)((bufoff) + _i * 8192)) : "memory"); } } while (0)
#define PG8_STA(bufoff, gbase, h, HS, GA) do { if constexpr (GATHER) { PG8_STAGE(bufoff, gbase, GA[h]); } else { PG8_STAGE(bufoff, (gbase) + (h) * (HS), vA); } } while (0)
#define PG8_STB(bufoff, gbase, h, HS) PG8_STAGE(bufoff, (gbase) + (h) * (HS), vB)
typedef int v4i_t __attribute__((ext_vector_type(4)));
#define PG8_LDA(dst, b, h) do { if (PG8_NOLD) break; _Pragma("unroll") for (int m = 0; m < 4; ++m) { if constexpr (FP8) { \
            const v4i_t lo_ = *(const LAS v4i_t*)(lds + PG8_SA(b, h) + aoff + m * 2048), hi_ = *(const LAS v4i_t*)(lds + PG8_SA(b, h) + aoff + m * 2048 + 1024); \
            dst##8[m] = __builtin_shufflevector(lo_, hi_, 0, 1, 2, 3, 4, 5, 6, 7); } \
        else { _Pragma("unroll") for (int k = 0; k < 2; ++k) dst[m][k] = *(const LAS bf16x8*)(lds + PG8_SA(b, h) + aoff + m * 2048 + k * 1024); } } } while (0)
#define PG8_LDB(dst, b, h) do { if (PG8_NOLD) break; _Pragma("unroll") for (int n = 0; n < 2; ++n) { if constexpr (FP8) { \
            const v4i_t lo_ = *(const LAS v4i_t*)(lds + PG8_SB(b, h) + boff + n * 2048), hi_ = *(const LAS v4i_t*)(lds + PG8_SB(b, h) + boff + n * 2048 + 1024); \
            dst##8[n] = __builtin_shufflevector(lo_, hi_, 0, 1, 2, 3, 4, 5, 6, 7); } \
        else { _Pragma("unroll") for (int k = 0; k < 2; ++k) dst[n][k] = *(const LAS bf16x8*)(lds + PG8_SB(b, h) + boff + n * 2048 + k * 1024); } } } while (0)
#ifndef PG8_FP8_PRIO
#define PG8_FP8_PRIO 1
#endif
#define PG8_MMA(ai, bj, At, Bt) do { if (PG8_NOMMA) break; if (!FP8 || PG8_FP8_PRIO) __builtin_amdgcn_s_setprio(1); _Pragma("unroll") for (int m = 0; m < 4; ++m) _Pragma("unroll") for (int n = 0; n < 2; ++n) { \
        if constexpr (FP8) { acc[ai][bj][m][n] = __builtin_amdgcn_mfma_scale_f32_16x16x128_f8f6f4(Bt##8[n], At##8[m], acc[ai][bj][m][n], 0, 0, 0, 0x7f7f7f7f, 0, 0x7f7f7f7f); } \
        else { _Pragma("unroll") for (int k = 0; k < 2; ++k) acc[ai][bj][m][n] = __builtin_amdgcn_mfma_f32_16x16x32_bf16(Bt[n][k], At[m][k], acc[ai][bj][m][n], 0, 0, 0); } } \
        if (!FP8 || PG8_FP8_PRIO) __builtin_amdgcn_s_setprio(0); } while (0)
#define PG8_WAIT_V(n) asm volatile("s_waitcnt vmcnt(" #n ")" ::: "memory")
#define PG8_WAIT_L(n) asm volatile("s_waitcnt lgkmcnt(" #n ")" ::: "memory")
#define PG8_BAR __builtin_amdgcn_s_barrier()
#define PG8_SCHED __builtin_amdgcn_sched_barrier(0)
#define PG8_ITER(A1P, A2P, B2P, HA2, HB2, GA2) do { \
        const char* a3p_ = (A2P) + kstep; const char* b3p_ = (B2P) + kstepB; \
        PG8_LDB(B0, 0, 0); PG8_LDB(B1, 0, 1); PG8_SCHED; PG8_LDA(At, 0, 0); PG8_STA(PG8_SA(1, 1), (A1P), 1, hsA, gA); \
        PG8_WAIT_V(8); PG8_WAIT_L(0); PG8_BAR; PG8_MMA(0, 0, At, B0); PG8_MMA(0, 1, At, B1); PG8_BAR; PG8_SCHED; \
        PG8_LDA(At, 0, 1); PG8_STB(PG8_SB(0, 0), (B2P), 0, HB2); PG8_STB(PG8_SB(0, 1), (B2P), 1, HB2); PG8_STA(PG8_SA(0, 0), (A2P), 0, HA2, GA2); \
        PG8_WAIT_V(8); PG8_WAIT_L(0); PG8_BAR; PG8_MMA(1, 0, At, B0); PG8_MMA(1, 1, At, B1); PG8_BAR; PG8_SCHED; \
        PG8_LDB(B0, 1, 0); PG8_LDB(B1, 1, 1); PG8_SCHED; PG8_LDA(At, 1, 0); PG8_STA(PG8_SA(0, 1), (A2P), 1, HA2, GA2); \
        PG8_WAIT_V(8); PG8_WAIT_L(0); PG8_BAR; PG8_MMA(0, 0, At, B0); PG8_MMA(0, 1, At, B1); PG8_BAR; PG8_SCHED; \
        PG8_LDA(At, 1, 1); PG8_STB(PG8_SB(1, 0), b3p_, 0, HB2); PG8_STB(PG8_SB(1, 1), b3p_, 1, HB2); PG8_STA(PG8_SA(1, 0), a3p_, 0, HA2, GA2); \
        PG8_WAIT_V(8); PG8_WAIT_L(0); PG8_BAR; PG8_MMA(1, 0, At, B0); PG8_MMA(1, 1, At, B1); PG8_BAR; PG8_SCHED; \
    } while (0)
    UnitD cur, nxt; int ui = 0;
    if (!S.next(0, cur)) return;
    f32x4 acc[2][2][4][2];
#pragma unroll
    for (int a = 0; a < 2; ++a)
#pragma unroll
        for (int b = 0; b < 2; ++b)
#pragma unroll
            for (int m = 0; m < 4; ++m)
#pragma unroll
                for (int n = 0; n < 2; ++n) acc[a][b][m][n] = (f32x4){0.f, 0.f, 0.f, 0.f};
    bf16x8 At[4][2], B0[2][2], B1[2][2]; v8i_t At8[4], B08[2], B18[2];
    unsigned vA[2], vB[2], gA[2][2], ngA[2][2];
    dense_voff(cur.lda, cur.ldb, tid, vA, vB);
#ifdef MK_HOTPROBE
    const size_t kstepB = (hot_ & 2) ? (size_t)0 : ((cur.ldb == 128u) ? (size_t)32768 : (size_t)(BK * 2));
#else
    const size_t kstepB = (cur.ldb == 128u) ? (size_t)32768 : kstep;
#endif
    if constexpr (GATHER) gather_voff(cur, tid, gA);
    const char* cA = cur.A; const char* cB = cur.B;
    size_t hsA = GATHER ? 0 : (size_t)cur.lda * HALF, hsB = (size_t)cur.ldb * HALF;
    PG8_STB(PG8_SB(0, 0), cB, 0, hsB); PG8_STB(PG8_SB(0, 1), cB, 1, hsB); PG8_STA(PG8_SA(0, 0), cA, 0, hsA, gA); PG8_STA(PG8_SA(0, 1), cA, 1, hsA, gA);
    if (wr == 1) PG8_BAR;
    PG8_WAIT_V(2); PG8_BAR;
    PG8_STB(PG8_SB(1, 0), cB + kstepB, 0, hsB); PG8_STA(PG8_SA(1, 0), cA + kstep, 0, hsA, gA); PG8_STB(PG8_SB(1, 1), cB + kstepB, 1, hsB);
    PG8_WAIT_V(6); PG8_BAR;
    for (;;) {
        const bool has_next = S.next(ui + 1, nxt);
        const char* nA = cA; const char* nB = cB; size_t nhsA = hsA, nhsB = hsB;
        if (has_next) { nA = nxt.A; nB = nxt.B; nhsA = GATHER ? 0 : (size_t)nxt.lda * HALF; nhsB = (size_t)nxt.ldb * HALF; }
        if constexpr (GATHER) {
            if (has_next) gather_voff(nxt, tid, ngA);
            else {
#pragma unroll
                for (int h = 0; h < 2; ++h)
#pragma unroll
                    for (int i = 0; i < 2; ++i) ngA[h][i] = gA[h][i];
            }
        }
#pragma unroll 1
        for (int t = 0; t < (PG8_NOLOOP ? 0 : nt); t += 2) {
            const bool last = (t == nt - 2);
            const char* a2 = last ? nA : cA + (size_t)(t + 2) * kstep; const char* b2 = last ? nB : cB + (size_t)(t + 2) * kstepB;
            const size_t hA2 = last ? nhsA : hsA, hB2 = last ? nhsB : hsB;
            unsigned g2[2][2];
            if constexpr (GATHER) {
#pragma unroll
                for (int h = 0; h < 2; ++h)
#pragma unroll
                    for (int i = 0; i < 2; ++i) g2[h][i] = last ? ngA[h][i] : gA[h][i];
            }
            PG8_ITER(cA + (size_t)(t + 1) * kstep, a2, b2, hA2, hB2, g2);
        }
        if constexpr (ALIGN_EPI) { if (wr == 0) PG8_BAR; }
        if constexpr (!Epi::AFTER_DRAIN) { if (!PG8_NOEPI) E(acc, cur, wr, wc, fr, fq); }
        if (!has_next) break;
#pragma unroll
        for (int a = 0; a < 2; ++a)
#pragma unroll
            for (int b = 0; b < 2; ++b)
#pragma unroll
                for (int m = 0; m < 4; ++m)
#pragma unroll
                    for (int n = 0; n < 2; ++n) acc[a][b][m][n] = (f32x4){0.f, 0.f, 0.f, 0.f};
        cur = nxt; cA = nA; cB = nB; hsA = nhsA; hsB = nhsB; ++ui;
        if constexpr (GATHER) {
#pragma unroll
            for (int h = 0; h < 2; ++h)
#pragma unroll
                for (int i = 0; i < 2; ++i) gA[h][i] = ngA[h][i];
        }
        if constexpr (ALIGN_EPI) { if (wr == 1) PG8_BAR; }
    }
    PG8_WAIT_V(0);
    if constexpr (!ALIGN_EPI) { if (wr == 0) PG8_BAR; }
    PG8_BAR;
    if constexpr (Epi::AFTER_DRAIN) { E.fused(acc, cur, wr, wc, fr, fq, lds, wid, lane); }
#undef PG8_SA
#undef PG8_SB
#undef PG8_STAGE
#undef PG8_STA
#undef PG8_STB
#undef PG8_LDA
#undef PG8_LDB
#undef PG8_MMA
#undef PG8_WAIT_V
#undef PG8_WAIT_L
#undef PG8_BAR
#undef PG8_SCHED
#undef PG8_ITER
}
}
namespace attn_body {
using bf16=__hip_bfloat16;
using bf16x8=__attribute__((ext_vector_type(8)))short;
using s16x4=__attribute__((ext_vector_type(4)))short;
using f32x16=__attribute__((ext_vector_type(16)))float;
using u32x4=__attribute__((ext_vector_type(4)))unsigned;
constexpr int BATCH=4,SEQ=2048,D=64,DM=5632,OPITCH=1024;
constexpr int NW=8,QBLK=32,QB=QBLK*NW,KVBLK=64,NQB=SEQ/QB;
constexpr int ATTN_UNIT_ROWS=QB;
__device__ __forceinline__ int crow(int r,int hi){return (r&3)+8*(r>>2)+4*hi;}
#define SBAR() __builtin_amdgcn_sched_barrier(0)
__device__ __forceinline__ void cmask(f32x16&p0,f32x16&p1,int jb,int qrel,int hi){
  const float NEG=-INFINITY; int kb=64*jb+4*hi;
  #pragma unroll
  for(int r=0;r<16;++r){int kv=kb+(r&3)+8*(r>>2); if(kv>qrel)p0[r]=NEG; if(kv+32>qrel)p1[r]=NEG;}
}

constexpr int NSLOT=3, SLOTB=8192;
constexpr int LDS_K=0, LDS_V=NSLOT*SLOTB, LDS_WS=2*NSLOT*SLOTB, LDS_OST=LDS_WS+NW*64*4, LDS_BYTES=LDS_OST+NW*4096;
constexpr float C2=0.125f*1.4426950408889634f;
__device__ __forceinline__ void glds16(const void*gsrc,unsigned lds_dst){unsigned keep;
  asm volatile("s_mov_b32 %0, m0\n\ts_mov_b32 m0, %2\n\ts_nop 0\n\tglobal_load_lds_dwordx4 %1, off\n\ts_mov_b32 m0, %0":"=&s"(keep):"v"(gsrc),"s"(lds_dst):"memory");}
__device__ __forceinline__ float max3f(float a,float b,float c){float r;asm("v_max3_f32 %0, %1, %2, %3":"=v"(r):"v"(a),"v"(b),"v"(c));return r;}
__device__ __forceinline__ float max2f(float a,float b){float r;asm("v_max_f32_e32 %0, %1, %2":"=v"(r):"v"(a),"v"(b));return r;}
__device__ __forceinline__ float fadd_s(float a,float b){float r;asm("v_add_f32_e32 %0, %1, %2":"=v"(r):"v"(a),"v"(b));return r;}
__device__ __forceinline__ float fsub_s(float a,float b){float r;asm("v_sub_f32_e32 %0, %1, %2":"=v"(r):"v"(a),"v"(b));return r;}
typedef float f32x2_t __attribute__((ext_vector_type(2))); typedef __bf16 bf16x2_t __attribute__((ext_vector_type(2)));
__device__ __forceinline__ unsigned cvtpk_s(float lo,float hi){f32x2_t v={lo,hi};bf16x2_t b=__builtin_convertvector(v,bf16x2_t);return __builtin_bit_cast(unsigned,b);}
#define WAIT_BAR(N) asm volatile("s_waitcnt vmcnt(" #N ") lgkmcnt(0)\n\ts_barrier":::"memory")

__device__ __forceinline__ void qkt(f32x16&p0,f32x16&p1,const char*Kslot,const bf16x8*qr,const f32x16&negm,int r32,int hi){
  const char*kb=Kslot+hi*1024+r32*16;
  #pragma unroll
  for(int d0=0;d0<4;++d0){
    const bf16x8 b0=*reinterpret_cast<const bf16x8*>(kb+d0*2048);
    const bf16x8 b1=*reinterpret_cast<const bf16x8*>(kb+d0*2048+512);
    if(d0==0){p0=__builtin_amdgcn_mfma_f32_32x32x16_bf16(b0,qr[0],negm,0,0,0);p1=__builtin_amdgcn_mfma_f32_32x32x16_bf16(b1,qr[0],negm,0,0,0);}
    else{p0=__builtin_amdgcn_mfma_f32_32x32x16_bf16(b0,qr[d0],p0,0,0,0);p1=__builtin_amdgcn_mfma_f32_32x32x16_bf16(b1,qr[d0],p1,0,0,0);}}
}
typedef __attribute__((address_space(3))) const char* lds_cptr;
typedef short v4i16_t __attribute__((ext_vector_type(4)));
__device__ __forceinline__ void kload8(bf16x8*kf,lds_cptr kp){
  kf[0]=*(const __attribute__((address_space(3))) bf16x8*)(kp);      kf[1]=*(const __attribute__((address_space(3))) bf16x8*)(kp+512);
  kf[2]=*(const __attribute__((address_space(3))) bf16x8*)(kp+2048); kf[3]=*(const __attribute__((address_space(3))) bf16x8*)(kp+2560);
  kf[4]=*(const __attribute__((address_space(3))) bf16x8*)(kp+4096); kf[5]=*(const __attribute__((address_space(3))) bf16x8*)(kp+4608);
  kf[6]=*(const __attribute__((address_space(3))) bf16x8*)(kp+6144); kf[7]=*(const __attribute__((address_space(3))) bf16x8*)(kp+6656);
}
__device__ __forceinline__ void kload2(bf16x8*kf,lds_cptr kp,int j){ kf[2*j]=*(const __attribute__((address_space(3))) bf16x8*)(kp+j*2048); kf[2*j+1]=*(const __attribute__((address_space(3))) bf16x8*)(kp+j*2048+512); }
__device__ __forceinline__ s16x4 vtr(lds_cptr p){ return __builtin_bit_cast(s16x4,__builtin_amdgcn_ds_read_tr16_b64_v4i16((__attribute__((address_space(3))) v4i16_t*)p)); }
__device__ __forceinline__ float rowmax(const f32x16&p0,const f32x16&p1){
  float a=max3f(p0[0],p0[1],p1[0]),b=max3f(p0[2],p0[3],p1[1]);a=max3f(a,p1[2],p1[3]);
  #pragma unroll
  for(int r=4;r<16;r+=4){a=max3f(a,p0[r],p0[r+1]);b=max3f(b,p0[r+2],p0[r+3]);a=max3f(a,p1[r],p1[r+1]);b=max3f(b,p1[r+2],p1[r+3]);}
  const float m=max2f(a,b);
  auto rr=__builtin_amdgcn_permlane32_swap(__float_as_uint(m),__float_as_uint(m),false,false);
  return max2f(__uint_as_float(rr[0]),__uint_as_float(rr[1]));
}
__device__ __forceinline__ void pv(f32x16*o,int vb,bf16x8 pa0,bf16x8 pa1,bf16x8 pa2,bf16x8 pa3){
  #pragma unroll
  for(int d0=0;d0<2;++d0){s16x4 lo[4],hi[4];
    #pragma unroll
    for(int ks=0;ks<4;++ks){
      asm volatile("ds_read_b64_tr_b16 %0,%1 offset:%c2":"=&v"(lo[ks]):"v"(vb),"i"(d0*4096+ks*1024):"memory");
      asm volatile("ds_read_b64_tr_b16 %0,%1 offset:%c2":"=&v"(hi[ks]):"v"(vb),"i"(d0*4096+ks*1024+512):"memory");}
    asm volatile("s_waitcnt lgkmcnt(0)":::"memory");SBAR();
    #define PK(k) (bf16x8){lo[k][0],lo[k][1],lo[k][2],lo[k][3],hi[k][0],hi[k][1],hi[k][2],hi[k][3]}
    o[d0]=__builtin_amdgcn_mfma_f32_32x32x16_bf16(pa0,PK(0),o[d0],0,0,0);
    o[d0]=__builtin_amdgcn_mfma_f32_32x32x16_bf16(pa1,PK(1),o[d0],0,0,0);
    o[d0]=__builtin_amdgcn_mfma_f32_32x32x16_bf16(pa2,PK(2),o[d0],0,0,0);
    o[d0]=__builtin_amdgcn_mfma_f32_32x32x16_bf16(pa3,PK(3),o[d0],0,0,0);
    #undef PK
  }
}

#ifndef ATTN_STORE16
#define ATTN_STORE16(p,v) (*(u32x4*)(p)=(v))
#endif
template<int THRL> __device__ __forceinline__ void attn_unit(int b,int qcol,int vcol,int ocol,int qb,const bf16*Q,const bf16*__restrict__ K,const bf16*__restrict__ V,bf16*O,char*shm){
  const int tid=threadIdx.x,lane=tid&63,r32=lane&31,hi=lane>>5; const int wid=__builtin_amdgcn_readfirstlane(tid>>6);
  const long rowbase=(long)b*SEQ; const int q0=qb*QB;
  const bf16*Qw=Q+(rowbase+q0+wid*QBLK)*DM+qcol;
  const bf16*Kh=K+rowbase*DM+qcol,*Vh=V+rowbase*DM+vcol;
  const unsigned lds0=(unsigned)(uintptr_t)shm;
  float*wsf=(float*)(shm+LDS_WS)+wid*64;
  const bf16*ksrc=Kh+(long)lane*DM+wid*8;
  const bf16*vsrc=Vh+(long)(16*(wid&3)+(lane>>2))*DM+(wid>>2)*32+(lane&3)*8;
  const unsigned kdst=lds0+LDS_K+wid*1024, vdst=lds0+LDS_V+wid*1024;
  #define DMA_K(t,slot) glds16(ksrc+(long)(t)*KVBLK*DM,(unsigned)__builtin_amdgcn_readfirstlane(kdst+(slot)))
  #define DMA_V(t,slot) glds16(vsrc+(long)(t)*KVBLK*DM,(unsigned)__builtin_amdgcn_readfirstlane(vdst+(slot)))
  const int vb0=(int)(lds0+LDS_V)+((lane>>4)&1)*32+(lane&3)*8+(4*hi+((lane&15)>>2))*64;
  const char*Kbase=shm+LDS_K; bf16x8 kf[8];
  const lds_cptr shm3=(lds_cptr)shm; const lds_cptr kp0=shm3+LDS_K+hi*1024+r32*16; const lds_cptr vp0=shm3+LDS_V+((lane>>4)&1)*32+(lane&3)*8+(4*hi+((lane&15)>>2))*64;
  const int NT=(q0+QB)/KVBLK;
  DMA_K(0,0);DMA_V(0,0);DMA_K(1,SLOTB);
  bf16x8 qr[4];
  #pragma unroll
  for(int d0=0;d0<4;++d0)qr[d0]=*reinterpret_cast<const bf16x8*>(&Qw[(long)r32*DM+d0*16+hi*8]);
  float mhat=0.f,l_reg=0.f;f32x16 o[2];o[0]=f32x16{};o[1]=f32x16{};f32x16 negm=f32x16{};asm volatile("":"+v"(negm));
  const int qrel=wid*QBLK+r32;
  #define CMASK(P0,P1,t) do{int jb_=(t)-(NT-4); if(jb_>=0)cmask(P0,P1,jb_,qrel,hi);}while(0)
  bool resc=false;
  #define START(P0,P1) do{ const float rm=rowmax(P0,P1); resc=false; \
    { const float dl=rm; mhat=fadd_s(mhat,dl); \
      _Pragma("unroll") for(int r=0;r<16;++r){P0[r]=fsub_s(P0[r],dl);P1[r]=fsub_s(P1[r],dl);} \
      _Pragma("unroll") for(int r=0;r<16;++r)negm[r]=-mhat; asm volatile("":"+v"(negm)); } \
    _Pragma("unroll") for(int r=0;r<16;++r)P0[r]=__builtin_amdgcn_exp2f(P0[r]); }while(0)
  #define RESC() do{ if(resc){ asm volatile("s_waitcnt lgkmcnt(0)":::"memory"); \
      _Pragma("unroll") for(int d_=0;d_<2;++d_) _Pragma("unroll") for(int r=0;r<16;++r)o[d_][r]*=wsf[crow(r,hi)]; } }while(0)
  f32x16 pA0,pA1,pB0,pB1;
  int sl_prev=0,sl_cur=0,sl_next=SLOTB;
  #define ROT() do{sl_prev=sl_cur;sl_cur=sl_next;sl_next=(sl_next==(NSLOT-1)*SLOTB)?0:sl_next+SLOTB;}while(0)
  DMA_K(2,2*SLOTB);
  WAIT_BAR(3);
  qkt(pA0,pA1,Kbase,qr,negm,r32,hi);asm volatile("s_nop 15\n\ts_nop 7":"+v"(pA0),"+v"(pA1));CMASK(pA0,pA1,0);
  START(pA0,pA1);
  _Pragma("unroll") for(int r=0;r<16;++r)pA1[r]=__builtin_amdgcn_exp2f(pA1[r]);
  WAIT_BAR(0);
  DMA_K(3,0);DMA_V(1,SLOTB);
  ROT();
  kload8(kf,kp0+sl_cur);
  WAIT_BAR(2);
  s16x4 vlo[8],vhi[8]; u32x4 pw0,pw1,pw2,pw3;
  #define PKW(P,B) cvtpk_s(P[B],P[B+1])
  #define PAF(k) __builtin_bit_cast(bf16x8,pw##k)
  #define VFR(i) (bf16x8){vlo[i][0],vlo[i][1],vlo[i][2],vlo[i][3],vhi[i][0],vhi[i][1],vhi[i][2],vhi[i][3]}
  #define PIN(x) asm volatile("":"+v"(x))
  #define MX3(a,b,c) __builtin_fmaxf(__builtin_fmaxf((a),(b)),(c))
  #define GAPA(MF,A0,A1,A2,A3,W0,W1,PW) do{ MF; sacc+=A0; sacc+=A1; sacc+=A2; sacc+=A3; PIN(sacc); W0; W1; PIN(PW); SBAR(); }while(0)
  #define EX(v) __builtin_amdgcn_exp2f(v)
  #define GAPB(MF,X,B) do{ MF; X[B]=EX(X[B]); X[B+1]=EX(X[B+1]); X[B+2]=EX(X[B+2]); X[B+3]=EX(X[B+3]); PIN(X); SBAR(); }while(0)
  #define VRD(i) do{ vlo[i]=vtr(vp_+(((i)>>2)*4096+((i)&3)*1024)); vhi[i]=vtr(vp_+(((i)>>2)*4096+((i)&3)*1024+512)); }while(0)
  #define KRD(G,j) do{ if(G){ kload2(kf,kp0+sl_next,j); SBAR(); } }while(0)
  #define STEP(C0,C1,P0,P1,t,GK,GV,GL) do{ SBAR(); \
    const lds_cptr vp_=vp0+sl_prev; \
    VRD(0); SBAR(); float sacc=(P0[0]+P0[1]); \
    GAPA(C0=__builtin_amdgcn_mfma_f32_32x32x16_bf16(kf[0],qr[0],negm,0,0,0), P0[2],P0[3],P0[4],P0[5],     pw0[0]=PKW(P0,0), pw0[1]=PKW(P0,2), pw0); \
    VRD(4); SBAR(); GAPA(C1=__builtin_amdgcn_mfma_f32_32x32x16_bf16(kf[1],qr[0],negm,0,0,0), P0[6],P0[7],P0[8],P0[9],     pw0[2]=PKW(P0,4), pw0[3]=PKW(P0,6), pw0); \
    VRD(1); SBAR(); GAPA(C0=__builtin_amdgcn_mfma_f32_32x32x16_bf16(kf[2],qr[1],C0,0,0,0),   P0[10],P0[11],P0[12],P0[13], pw1[0]=PKW(P0,8), pw1[1]=PKW(P0,10), pw1); \
    VRD(5); SBAR(); GAPA(C1=__builtin_amdgcn_mfma_f32_32x32x16_bf16(kf[3],qr[1],C1,0,0,0),   P0[14],P0[15],P1[0],P1[1],   pw1[2]=PKW(P0,12),pw1[3]=PKW(P0,14), pw1); \
    VRD(2); SBAR(); GAPA(C0=__builtin_amdgcn_mfma_f32_32x32x16_bf16(kf[4],qr[2],C0,0,0,0),   P1[2],P1[3],P1[4],P1[5],     pw2[0]=PKW(P1,0), pw2[1]=PKW(P1,2), pw2); \
    VRD(6); SBAR(); GAPA(C1=__builtin_amdgcn_mfma_f32_32x32x16_bf16(kf[5],qr[2],C1,0,0,0),   P1[6],P1[7],P1[8],P1[9],     pw2[2]=PKW(P1,4), pw2[3]=PKW(P1,6), pw2); \
    VRD(3); SBAR(); GAPA(C0=__builtin_amdgcn_mfma_f32_32x32x16_bf16(kf[6],qr[3],C0,0,0,0),   P1[10],P1[11],P1[12],P1[13], pw3[0]=PKW(P1,8), pw3[1]=PKW(P1,10), pw3); \
    VRD(7); SBAR(); GAPA(C1=__builtin_amdgcn_mfma_f32_32x32x16_bf16(kf[7],qr[3],C1,0,0,0),   P1[14],P1[15],0.f,0.f,       pw3[2]=PKW(P1,12),pw3[3]=PKW(P1,14), pw3); \
    l_reg+=sacc; \
    if(GK){DMA_K((t)+3,sl_cur);} if(GV){DMA_V((t)+1,sl_next);} \
    CMASK(C0,C1,t); \
    { float a=MX3(C0[0],C0[1],C1[0]),b=MX3(C0[2],C0[3],C1[1]); a=MX3(a,C1[2],C1[3]); \
      _Pragma("unroll") for(int r=4;r<16;r+=4){a=MX3(a,C0[r],C0[r+1]);b=MX3(b,C0[r+2],C0[r+3]);a=MX3(a,C1[r],C1[r+1]);b=MX3(b,C1[r+2],C1[r+3]);} \
      float rm=__builtin_fmaxf(a,b); { auto rr=__builtin_amdgcn_permlane32_swap(__float_as_uint(rm),__float_as_uint(rm),false,false); rm=__builtin_fmaxf(__uint_as_float(rr[0]),__uint_as_float(rr[1])); } \
      resc=false; \
      if(__builtin_expect(__any(rm>(float)THRL),0)){ const float dl=__builtin_fmaxf(rm,0.f); mhat+=dl; \
        _Pragma("unroll") for(int r=0;r<16;++r){C0[r]-=dl;C1[r]-=dl;} \
        _Pragma("unroll") for(int r=0;r<16;++r)negm[r]=-mhat; asm volatile("":"+v"(negm)); \
        const float f=__builtin_amdgcn_exp2f(-dl); l_reg*=f; if(hi==0)wsf[r32]=f; resc=true; } } \
    SBAR(); \
    GAPB(o[0]=__builtin_amdgcn_mfma_f32_32x32x16_bf16(PAF(0),VFR(0),o[0],0,0,0), C0,0); \
    GAPB(o[1]=__builtin_amdgcn_mfma_f32_32x32x16_bf16(PAF(0),VFR(4),o[1],0,0,0), C0,4); \
    KRD(GL,0); GAPB(o[0]=__builtin_amdgcn_mfma_f32_32x32x16_bf16(PAF(1),VFR(1),o[0],0,0,0), C0,8); \
    KRD(GL,1); GAPB(o[1]=__builtin_amdgcn_mfma_f32_32x32x16_bf16(PAF(1),VFR(5),o[1],0,0,0), C0,12); \
    KRD(GL,2); GAPB(o[0]=__builtin_amdgcn_mfma_f32_32x32x16_bf16(PAF(2),VFR(2),o[0],0,0,0), C1,0); \
    KRD(GL,3); GAPB(o[1]=__builtin_amdgcn_mfma_f32_32x32x16_bf16(PAF(2),VFR(6),o[1],0,0,0), C1,4); \
    GAPB(o[0]=__builtin_amdgcn_mfma_f32_32x32x16_bf16(PAF(3),VFR(3),o[0],0,0,0), C1,8); \
    GAPB(o[1]=__builtin_amdgcn_mfma_f32_32x32x16_bf16(PAF(3),VFR(7),o[1],0,0,0), C1,12); \
    }while(0)
  int t=1;
  #undef CMASK
  #define CMASK(P0,P1,t) do{}while(0)
  for(;t+5<NT;t+=2){
    STEP(pB0,pB1,pA0,pA1,t,true,true,true);     WAIT_BAR(2); RESC(); ROT();
    STEP(pA0,pA1,pB0,pB1,t+1,true,true,true);   WAIT_BAR(2); RESC(); ROT();
  }
  #undef CMASK
  #define CMASK(P0,P1,t) do{int jb_=(t)-(NT-4); if(jb_>=0)cmask(P0,P1,jb_,qrel,hi);}while(0)
  #define ENDW(tt) do{ if((tt)+3<NT){WAIT_BAR(2);} else if((tt)+2<NT){WAIT_BAR(1);} else {WAIT_BAR(0);} }while(0)
  for(;t+1<NT;t+=2){
    STEP(pB0,pB1,pA0,pA1,t,(t+3<NT),(t+1<NT),(t+1<NT));       ENDW(t);   RESC(); ROT();
    STEP(pA0,pA1,pB0,pB1,t+1,(t+4<NT),(t+2<NT),(t+2<NT));     ENDW(t+1); RESC(); ROT();
  }
  STEP(pB0,pB1,pA0,pA1,NT-1,false,false,false); RESC();
  { float sacc=pB0[0]+pB0[1]; _Pragma("unroll") for(int r=2;r<16;++r)sacc+=pB0[r]; _Pragma("unroll") for(int r=0;r<16;++r)sacc+=pB1[r]; l_reg+=sacc;
    pw0=(u32x4){PKW(pB0,0),PKW(pB0,2),PKW(pB0,4),PKW(pB0,6)};pw1=(u32x4){PKW(pB0,8),PKW(pB0,10),PKW(pB0,12),PKW(pB0,14)};pw2=(u32x4){PKW(pB1,0),PKW(pB1,2),PKW(pB1,4),PKW(pB1,6)};pw3=(u32x4){PKW(pB1,8),PKW(pB1,10),PKW(pB1,12),PKW(pB1,14)};
    SBAR(); pv(o,vb0+sl_cur,PAF(0),PAF(1),PAF(2),PAF(3)); }
  #undef PKW
  #undef PAF
  #undef VFR
  #undef PIN
  #undef MX3
  #undef GAPA
  #undef GAPB
  #undef EX
  #undef VRD
  #undef KRD
  #undef STEP
  #undef ENDW
  {auto rr=__builtin_amdgcn_permlane32_swap(__float_as_uint(l_reg),__float_as_uint(l_reg),false,false);l_reg=__uint_as_float(rr[0])+__uint_as_float(rr[1]);}
  if(hi==0)wsf[32+r32]=l_reg;asm volatile("s_waitcnt lgkmcnt(0)":::"memory");
  float rli[16];
  #pragma unroll
  for(int r=0;r<16;++r)rli[r]=__builtin_amdgcn_rcpf(wsf[32+crow(r,hi)]);
  bf16*Ow=O+(rowbase+q0+wid*QBLK)*OPITCH+ocol;
  { bf16*stg=(bf16*)(shm+LDS_OST)+wid*2048;
    #pragma unroll
    for(int r=0;r<16;++r){const int orow=crow(r,hi);
      #pragma unroll
      for(int d0=0;d0<2;++d0)stg[orow*64+d0*32+r32]=__float2bfloat16(o[d0][r]*rli[r]);}
    asm volatile("s_waitcnt lgkmcnt(0)":::"memory");
    #pragma unroll
    for(int i=0;i<4;++i){const int row=i*8+(lane>>3),ch=lane&7; const u32x4 v=*(const u32x4*)(stg+row*64+ch*8); ATTN_STORE16(Ow+(long)row*OPITCH+ch*8,v);} }
  asm volatile("s_waitcnt lgkmcnt(0)\n\ts_barrier":::"memory");
  #undef DMA_K
  #undef DMA_V
  #undef CMASK
  #undef START
  #undef RESC
  #undef ROT
}
constexpr int ATTN_LDS_BYTES=LDS_BYTES;
#undef SBAR
#undef WAIT_BAR
}
constexpr size_t MiB = 1u << 20;
constexpr size_t WS_CTL = 0, CTL_ZERO_BYTES = 1 * MiB;
constexpr size_t WS_WIN = 2 * MiB, WS_WOUT = 26 * MiB, WS_WQ = 34 * MiB, WS_WKV = 42 * MiB, WS_WO = 58 * MiB, WS_W1 = 66 * MiB, WS_W2 = 578 * MiB;
constexpr size_t WS_HN = 834 * MiB, WS_MN = 866 * MiB, WS_PROJ = 870 * MiB, WS_DT = 958 * MiB, WS_KVRAW = 959 * MiB, WS_KN = 967 * MiB;
constexpr size_t WS_YCAT = 971 * MiB, WS_O0 = 1003 * MiB, WS_O1 = 1019 * MiB, WS_H1 = 1035 * MiB, WS_H1B = 1099 * MiB, WS_PART1 = 1131 * MiB, WS_PARTQ = 1132 * MiB;
constexpr size_t WS_QRAW = 1133 * MiB, WS_P = 1165 * MiB, WS_VWT = 1181 * MiB, WS_H2 = 1197 * MiB, WS_HN3 = 1261 * MiB;
constexpr size_t WS_TOKOF = 1293 * MiB, WS_GATEOF = 1294 * MiB, WS_TOKE = 1295 * MiB, WS_TOKR = 1296 * MiB, WS_YG = 1297 * MiB;
constexpr size_t WS_H1F8 = 3368 * MiB  , WS_QF8 = 3384 * MiB  , WS_KN8 = 3400 * MiB  , WS_VF8 = 3402 * MiB  ;
constexpr size_t WS_P8 = 3404 * MiB  , WS_VWT8 = 3412 * MiB  ;
constexpr size_t WS_XG = 1320 * MiB  , WS_ACT = 1832 * MiB  , WS_Y = 2344 * MiB  , WS_END = 3420 * MiB;
constexpr int CW_BAR = 4096;
constexpr int CW_QCONV2 = 12416;
constexpr int CW_QCONV = 12352;
constexpr int CW_QATT = 12288;
constexpr int CW_CNT = 8192;
static_assert((CW_CNT + 64 * 32) * 4 <= (int)CTL_ZERO_BYTES, "CTL words inside the memset region");

constexpr int RING_OFF = 0, RING_BYTES = 131072;
constexpr int LDS_BYTES = 163840;
constexpr int MISC_OFF = 163840 - 1024;
constexpr int NWAVES = 8;

#define XB_TMO      128
#define XB_XCNT(j)  (256  + 64 * (j))
#define XB_XSUB(j)  (1280 + 64 * (j))
#define XB_XGEN(j)  (2304 + 64 * (j))
#define XB_TOP      3328
#define XB_TOPGEN   3392
#define XCD_BAR_WORDS 3456
#define XB_SPIN_CAP (1u << 20)

__device__ __forceinline__ unsigned xb_ld(unsigned* p)              { return __hip_atomic_load(p, __ATOMIC_RELAXED, __HIP_MEMORY_SCOPE_AGENT); }
__device__ __forceinline__ unsigned xb_add(unsigned* p, unsigned v) { return __hip_atomic_fetch_add(p, v, __ATOMIC_RELAXED, __HIP_MEMORY_SCOPE_AGENT); }
__device__ __forceinline__ unsigned xb_xcc_id() { return (unsigned)__builtin_amdgcn_s_getreg((3 << 11) | 20) & 0xFu; }
#define XB_SPIN(cond, bar) do { unsigned _sp = 0; while (cond) { __builtin_amdgcn_s_sleep(1); \
    if ((++_sp & 255u) == 0u) { if (xb_ld(&(bar)[XB_TMO])) break; if (_sp > XB_SPIN_CAP) { atomicAdd(&(bar)[XB_TMO], 1u); break; } } } } while (0)

struct XcdBarrier {
    unsigned* bar; unsigned x;
    volatile LAS unsigned* st;
};
__device__ __forceinline__ XcdBarrier xcd_barrier_post(unsigned* bar, volatile LAS unsigned* st) {
    XcdBarrier b; b.bar = bar; b.x = xb_xcc_id(); b.st = st;
    if (threadIdx.x == 0) (void)xb_add(&bar[XB_XCNT(b.x)], 1u);
    return b;
}
__device__ __forceinline__ void xcd_barrier_complete(unsigned* bar, unsigned x, unsigned& nloc, unsigned& nx) {
    const unsigned G = gridDim.x * gridDim.y * gridDim.z;
    unsigned sum, cnt, mine, sp = 0u;
    for (;;) {
        sum = 0u; cnt = 0u; mine = 0u;
#pragma unroll
        for (unsigned j = 0; j < 16; ++j) { const unsigned c = xb_ld(&bar[XB_XCNT(j)]); sum += c; cnt += (c > 0u) ? 1u : 0u; mine = (j == x) ? c : mine; }
        if (sum == G) break;
        __builtin_amdgcn_s_sleep(1);
        if ((++sp & 255u) == 0u) { if (xb_ld(&bar[XB_TMO])) break; if (sp > XB_SPIN_CAP) { atomicAdd(&bar[XB_TMO], 1u); break; } }
    }
    nloc = mine > 0u ? mine : 1u; nx = cnt > 0u ? cnt : 1u;
}
__device__ __forceinline__ void xcd_barrier(const XcdBarrier& b) {
    asm volatile("s_waitcnt vmcnt(0)" ::: "memory");
    __syncthreads();
    if (threadIdx.x == 0) {
        unsigned* bar = b.bar;
        __builtin_amdgcn_s_waitcnt(0);
        unsigned nloc = b.st[0], nx = b.st[1];
        if (nloc == 0u) { xcd_barrier_complete(bar, b.x, nloc, nx); b.st[0] = nloc; b.st[1] = nx; }
        const unsigned old = xb_add(&bar[XB_XSUB(b.x)], 1u);
        const unsigned gen = old / nloc;
        if (old + 1u == (gen + 1u) * nloc) {
            __builtin_amdgcn_fence(__ATOMIC_RELEASE, "agent");
            asm volatile("s_waitcnt vmcnt(0)" ::: "memory");
            const unsigned og = xb_add(&bar[XB_TOP], 1u);
            const unsigned tg = og / nx;
            if (og + 1u == (tg + 1u) * nx) xb_add(&bar[XB_TOPGEN], 1u);
            else XB_SPIN(xb_ld(&bar[XB_TOPGEN]) == tg, bar);
            __builtin_amdgcn_fence(__ATOMIC_ACQUIRE, "agent");
            xb_add(&bar[XB_XGEN(b.x)], 1u);
            asm volatile("s_waitcnt vmcnt(0)" ::: "memory");
        } else {
            XB_SPIN(xb_ld(&bar[XB_XGEN(b.x)]) == gen, bar);
            __builtin_amdgcn_fence(__ATOMIC_ACQUIRE, "agent");
            asm volatile("s_waitcnt vmcnt(0)" ::: "memory");
        }
    }
    __syncthreads();
}

struct Args { const float* in[32]; float* out; unsigned char* ws; int ph_lo, ph_hi, probe, pad_; };
enum In { I_X = 0, I_MEM, I_GMIX, I_WIN, I_CONVW, I_CONVB, I_DTB, I_ALOG, I_DSKIP, I_SSDG, I_DAQG, I_DAKG, I_LQ1, I_LK1, I_LQ2, I_LK2, I_SUBG, I_WOUT, I_GXA, I_GMEM,
          I_WQ, I_WKV, I_XQG, I_XKG, I_WO, I_GFFN, I_RW, I_RB, I_W1, I_B1, I_W2, I_B2 };

struct ArgP {
    typedef const __attribute__((address_space(4))) char* kptr;
    DI const float* in(int i) const { kptr kp = (kptr)__builtin_amdgcn_kernarg_segment_ptr(); asm volatile("" : "+s"(kp)); return *(const float* const __attribute__((address_space(4)))*)(kp + 8 * i); }
    DI float* out() const { kptr kp = (kptr)__builtin_amdgcn_kernarg_segment_ptr(); asm volatile("" : "+s"(kp)); return *(float* const __attribute__((address_space(4)))*)(kp + 8 * 32); }
};
struct Frame {
    LAS unsigned char* lds;
    volatile LAS unsigned* MISC;
    unsigned* ctl;
    unsigned char* ws;
    int tid, lane, wave, vcu, G;
};

template <class DestRow>
DI void tr_item(const float* W, size_t ldw, int k0, int ncol0, int nvalid, const float* kscale, bf16_t* WT, int K, DestRow dr, LAS float* scr, int lane) {
    const int c = lane & 31;
#pragma unroll 8
    for (int i = 0; i < 32; ++i) { const int kk = 2 * i + (lane >> 5);
        float v = (c < nvalid) ? W[(size_t)(k0 + kk) * ldw + ncol0 + c] : 0.f;
        if (kscale) v *= kscale[k0 + kk];
        scr[kk * 33 + c] = v; }
    asm volatile("s_waitcnt lgkmcnt(0)" ::: "memory");
    const int c8 = lane & 7;
#pragma unroll
    for (int j = 0; j < 4; ++j) { const int n = (lane >> 3) + 8 * j; const LAS float* s = scr + (8 * c8) * 33 + n;
        u32x4 o; o.x = pk2(s[0 * 33], s[1 * 33]); o.y = pk2(s[2 * 33], s[3 * 33]); o.z = pk2(s[4 * 33], s[5 * 33]); o.w = pk2(s[6 * 33], s[7 * 33]);
        if (n < nvalid) *(u32x4*)(WT + (size_t)dr(ncol0 + n) * K + k0 + 8 * c8) = o; }
    asm volatile("s_waitcnt lgkmcnt(0)" ::: "memory");
}
template <class DestRow>
DI void tr_item_fp8(const float* W, size_t ldw, int k0, int ncol0, const float* kscale, unsigned char* WT, int K, DestRow dr, LAS float* scr, int lane) {
    const int c = lane & 31;
#pragma unroll 8
    for (int i = 0; i < 32; ++i) { const int kk = 2 * i + (lane >> 5); float v = W[(size_t)(k0 + kk) * ldw + ncol0 + c]; if (kscale) v *= kscale[k0 + kk]; scr[kk * 33 + c] = v; }
    asm volatile("s_waitcnt lgkmcnt(0)" ::: "memory");
    const int n = lane >> 1, hf = lane & 1; const LAS float* s = scr + (32 * hf) * 33 + n;
    unsigned w[8];
#pragma unroll
    for (int j = 0; j < 8; ++j) { unsigned x = 0u;
        x = __builtin_amdgcn_cvt_pk_fp8_f32(s[(4 * j) * 33] * 64.f, s[(4 * j + 1) * 33] * 64.f, x, false);
        x = __builtin_amdgcn_cvt_pk_fp8_f32(s[(4 * j + 2) * 33] * 64.f, s[(4 * j + 3) * 33] * 64.f, x, true); w[j] = x; }
    unsigned char* op = WT + (size_t)dr(ncol0 + n) * K + k0 + 32 * hf;
    *(u32x4*)op = (u32x4){w[0], w[1], w[2], w[3]}; *(u32x4*)(op + 16) = (u32x4){w[4], w[5], w[6], w[7]};
    asm volatile("s_waitcnt lgkmcnt(0)" ::: "memory");
}
DI int tileperm(int col) { const int o = col & 255; return (col & ~255) + 128 * ((o & 63) >> 5) + 32 * (o >> 6) + (o & 31); }
struct DrIdent { DI int operator()(int n) const { return n; } };
struct DrTile  { DI int operator()(int n) const { return tileperm(n); } };
struct DrWin   { DI int operator()(int n) const { const int pc = (n < 2560) ? n : (n < 2576 ? PC_DT + (n - 2560) : n - 16); return tileperm(pc); } };
struct DrW1    { DI int operator()(int n) const { const int half = n >> 11, j = n & 2047; return (j >> 7) * 256 + half * 128 + (j & 127); } };

template <bool FP8, class DestRow>
DI void cv_item(const float* W, size_t ldw, int k0, int ncol0, const float* kscale, float scale, void* WT, int kpitch, DestRow dr, LAS float* scr, int lane) {
    const int r = lane >> 3, c4 = (lane & 7) * 4;
    f32x4 v[16];
#pragma unroll
    for (int i = 0; i < 16; ++i) v[i] = *(const f32x4*)(W + (size_t)(k0 + 8 * i + r) * ldw + ncol0 + c4);
#pragma unroll
    for (int i = 0; i < 16; ++i) { f32x4 x = v[i] * scale; if (kscale) x = x * kscale[k0 + 8 * i + r]; *(LAS f32x4*)(scr + (8 * i + r) * 36 + c4) = x; }
    asm volatile("s_waitcnt lgkmcnt(0)" ::: "memory");
    const int n = lane & 31, hf = lane >> 5; const LAS float* s = scr + (64 * hf) * 36 + n;
    if constexpr (FP8) {
        unsigned w[16];
#pragma unroll
        for (int j = 0; j < 16; ++j) { unsigned x = 0u; x = __builtin_amdgcn_cvt_pk_fp8_f32(s[(4 * j) * 36], s[(4 * j + 1) * 36], x, false); x = __builtin_amdgcn_cvt_pk_fp8_f32(s[(4 * j + 2) * 36], s[(4 * j + 3) * 36], x, true); w[j] = x; }
        unsigned char* op = (unsigned char*)WT + (size_t)dr(ncol0 + n) * kpitch + k0 + 64 * hf;
#pragma unroll
        for (int j = 0; j < 4; ++j) *(u32x4*)(op + 16 * j) = (u32x4){w[4 * j], w[4 * j + 1], w[4 * j + 2], w[4 * j + 3]};
    } else {
        unsigned w[32];
#pragma unroll
        for (int j = 0; j < 32; ++j) w[j] = pk2(s[(2 * j) * 36], s[(2 * j + 1) * 36]);
        unsigned char* op = (unsigned char*)WT + (size_t)dr(ncol0 + n) * kpitch + (k0 + 64 * hf) * 2;
#pragma unroll
        for (int j = 0; j < 8; ++j) *(u32x4*)(op + 16 * j) = (u32x4){w[4 * j], w[4 * j + 1], w[4 * j + 2], w[4 * j + 3]};
    }
    asm volatile("s_waitcnt lgkmcnt(0)" ::: "memory");
}
DI void rms_row_to_bf16(const float* xrow, const float* g, bf16_t* orow, int lane) {
    const f32x4* xr = (const f32x4*)xrow + lane;
    f32x4 v[8]; float s = 0.f;
#pragma unroll
    for (int j = 0; j < 8; ++j) { v[j] = xr[64 * j]; s += (v[j].x * v[j].x + v[j].y * v[j].y) + (v[j].z * v[j].z + v[j].w * v[j].w); }
    const float rstd = 1.f / sqrtf(wave_sum(s) * (1.f / 2048.f) + EPS_);
    u32x2* o8 = (u32x2*)orow + lane;
#pragma unroll
    for (int j = 0; j < 8; ++j) { const f32x4 gg = ((const f32x4*)g)[lane + 64 * j];
        u32x2 o; o.x = pk2(v[j].x * rstd * gg.x, v[j].y * rstd * gg.y); o.y = pk2(v[j].z * rstd * gg.z, v[j].w * rstd * gg.w); o8[64 * j] = o; }
}

DI void p0_prologue(Frame& F, const ArgP& a) {
    LAS float* scr = (LAS float*)(F.lds + RING_OFF + F.wave * 16384);
    const int gw = F.vcu * NWAVES + F.wave, NGW = F.G * NWAVES;
    unsigned char* ws = F.ws;
    constexpr int I_A = 32 * 80, I_B = 32, I_C = 32 * 96, NITEMS = I_A + I_B + I_C;
    for (int it = gw; it < NITEMS; it += NGW) {
        int r = it;
        if (r < I_A) { tr_item(a.in(I_WIN), 5648, 64 * (r / 80), 32 * (r % 80), 32, nullptr, (bf16_t*)(ws + WS_WIN), 2048, DrWin(), scr, F.lane); continue; } r -= I_A;
        if (r < I_B) { tr_item(a.in(I_WIN), 5648, 64 * r, 2560, 16, nullptr, (bf16_t*)(ws + WS_WIN), 2048, DrWin(), scr, F.lane); continue; } r -= I_B;
        tr_item(a.in(I_WIN), 5648, 64 * (r / 96), 2576 + 32 * (r % 96), 32, nullptr, (bf16_t*)(ws + WS_WIN), 2048, DrWin(), scr, F.lane);
    }
    for (int m = gw; m < NTOK; m += NGW) rms_row_to_bf16(a.in(I_X) + (size_t)m * 2048, a.in(I_GMIX), (bf16_t*)(ws + WS_HN) + (size_t)m * 2048, F.lane);
    for (int m = gw; m < NB * MEMLEN; m += NGW) rms_row_to_bf16(a.in(I_MEM) + (size_t)m * 2048, a.in(I_GMEM), (bf16_t*)(ws + WS_MN) + (size_t)m * 2048, F.lane);
}
struct CvIt { const float* W; size_t ldw; const float* ks; unsigned char* WT; float scale; int k0, n0, kpitch, fp8, dr, tiled; };
DI CvIt cv_decode(int it, const ArgP& a, unsigned char* ws) {
    constexpr int J_WOUT = 16 * 64, J_WKV = 16 * 128, J_WQ = 16 * 64, J_WO = 16 * 64, J_W1 = 32 * 16 * 128;
    CvIt c; c.ks = nullptr; c.scale = 64.f; c.fp8 = 1; c.dr = 0; c.kpitch = 2048; c.ldw = 2048; c.tiled = 0;
    int r = it;
    if (r < J_WOUT) { c.W = a.in(I_WOUT); c.k0 = 128 * (r / 64); c.n0 = 32 * (r % 64); c.WT = ws + WS_WOUT; c.scale = 1.f; c.fp8 = 0; c.kpitch = 4096; return c; } r -= J_WOUT;
    if (r < J_WKV) { c.W = a.in(I_WKV); c.ldw = 4096; c.k0 = 128 * (r / 128); c.n0 = 32 * (r % 128); c.WT = ws + WS_WKV; c.scale = 1.f; c.fp8 = 0; c.kpitch = 4096; c.dr = 1; return c; } r -= J_WKV;
    if (r < J_WQ) { c.W = a.in(I_WQ); c.ks = a.in(I_GXA); c.k0 = 128 * (r / 64); c.n0 = 32 * (r % 64); c.WT = ws + WS_WQ; return c; } r -= J_WQ;
    if (r < J_WO) { c.W = a.in(I_WO); c.k0 = 128 * (r / 64); c.n0 = 32 * (r % 64); c.WT = ws + WS_WO; return c; } r -= J_WO;
    if (r < J_W1) { const int e = r / (16 * 128), q = r % (16 * 128); c.W = a.in(I_W1) + (size_t)e * 2048 * 4096; c.ldw = 4096; c.k0 = 128 * (q / 128); c.n0 = 32 * (q % 128); c.WT = ws + WS_W1 + (size_t)e * 4096 * 2048; c.dr = 2; c.tiled = 1; return c; } r -= J_W1;
    { const int e = r / (16 * 64), q = r % (16 * 64); c.W = a.in(I_W2) + (size_t)e * 2048 * 2048; c.k0 = 128 * (q / 64); c.n0 = 32 * (q % 64); c.WT = ws + WS_W2 + (size_t)e * 2048 * 2048; c.tiled = 1; }
    return c;
}
constexpr int CV_NJ = 16 * 64 * 3 + 16 * 128 + 32 * 16 * 128 + 32 * 16 * 64;
constexpr int CV_TAIL2 = 16384;
constexpr int CV_TAIL1 = 16384;
constexpr int CV_TAIL = CV_TAIL1 + CV_TAIL2;
DI void conv_share(Frame& F, const ArgP& a) {
    LAS float* scr = (LAS float*)(F.lds + F.wave * 16384);
    const unsigned sbase = (unsigned)__builtin_amdgcn_readfirstlane((int)((unsigned)(uintptr_t)F.lds + (unsigned)F.wave * 16384u));
    const int gw = F.vcu * NWAVES + F.wave, NGW = F.G * NWAVES, lane = F.lane;
    unsigned char* ws = F.ws;
    constexpr int NJ = CV_NJ - CV_TAIL;
    const int n = lane & 31, hf = lane >> 5;
    for (int it = gw; it < NJ; it += NGW) {
        const CvIt cur = cv_decode(it, a, ws);
        const char* gb = (const char*)(cur.W + (size_t)cur.k0 * cur.ldw + cur.n0);
        const unsigned vo0 = (unsigned)(((size_t)(lane >> 3) * cur.ldw + (size_t)(lane & 7) * 4) * 4), vstep = (unsigned)(8 * cur.ldw * 4);
#pragma unroll
        for (int p = 0; p < 16; ++p) { unsigned keep_;
            asm volatile("s_mov_b32 %0, m0\n\ts_mov_b32 m0, %3\n\ts_nop 0\n\tglobal_load_lds_dwordx4 %1, %2 nt\n\ts_mov_b32 m0, %0"
                         : "=&s"(keep_) : "v"(vo0 + (unsigned)p * vstep), "s"(gb), "s"(sbase + (unsigned)p * 1024u) : "memory"); }
        asm volatile("s_waitcnt vmcnt(0)" ::: "memory");
        const LAS float* s = scr + (64 * hf) * 32 + n;
        const int col = cur.n0 + n; const int drow = (cur.dr == 0) ? col : (cur.dr == 1 ? tileperm(col) : DrW1()(col));
        const float* ksp = cur.ks ? cur.ks + cur.k0 + 64 * hf : nullptr;
        if (cur.fp8) {
            unsigned w[16];
#pragma unroll
            for (int j = 0; j < 16; ++j) { float x0 = s[(4 * j) * 32] * cur.scale, x1 = s[(4 * j + 1) * 32] * cur.scale, x2 = s[(4 * j + 2) * 32] * cur.scale, x3 = s[(4 * j + 3) * 32] * cur.scale;
                if (ksp) { x0 *= ksp[4 * j]; x1 *= ksp[4 * j + 1]; x2 *= ksp[4 * j + 2]; x3 *= ksp[4 * j + 3]; }
                unsigned x = 0u; x = __builtin_amdgcn_cvt_pk_fp8_f32(x0, x1, x, false); x = __builtin_amdgcn_cvt_pk_fp8_f32(x2, x3, x, true); w[j] = x; }
            unsigned char* op = cur.tiled ? cur.WT + ((size_t)(((drow >> 8) * 16 + (cur.k0 >> 7)) * 256 + (drow & 255))) * 128 + 64 * hf : cur.WT + (size_t)drow * cur.kpitch + cur.k0 + 64 * hf;
#pragma unroll
            for (int j = 0; j < 4; ++j) *(u32x4*)(op + 16 * j) = (u32x4){w[4 * j], w[4 * j + 1], w[4 * j + 2], w[4 * j + 3]};
        } else {
            unsigned w[32];
#pragma unroll
            for (int j = 0; j < 32; ++j) w[j] = pk2(s[(2 * j) * 32] * cur.scale, s[(2 * j + 1) * 32] * cur.scale);
            unsigned char* op = cur.WT + (size_t)drow * cur.kpitch + (cur.k0 + 64 * hf) * 2;
#pragma unroll
            for (int j = 0; j < 8; ++j) *(u32x4*)(op + 16 * j) = (u32x4){w[4 * j], w[4 * j + 1], w[4 * j + 2], w[4 * j + 3]};
        }
        asm volatile("s_waitcnt lgkmcnt(0)" ::: "memory");
    }
}

DI void conv_queue(Frame& F, const ArgP& a, int qword, int first, int count) {
    LAS float* scr = (LAS float*)(F.lds + F.wave * 18432);
    unsigned char* ws = F.ws;
    const int lane = threadIdx.x & 63, r = lane >> 3, c4 = (lane & 7) * 4, n = lane & 31, hf = lane >> 5;
    for (;;) {
        if (threadIdx.x == 0) F.MISC[121] = __hip_atomic_fetch_add(F.ctl + qword, 8u, __ATOMIC_RELAXED, __HIP_MEMORY_SCOPE_AGENT);
        __syncthreads();
        const int base = __builtin_amdgcn_readfirstlane((int)F.MISC[121]);
        __syncthreads();
        if (base >= count) break;
        const int it = first + base + F.wave;
        if (base + F.wave < count) {
            const CvIt cur = cv_decode(it, a, ws);
            f32x4 v[16];
#pragma unroll
            for (int i = 0; i < 16; ++i) v[i] = __builtin_nontemporal_load((const f32x4*)(cur.W + (size_t)(cur.k0 + 8 * i + r) * cur.ldw + cur.n0 + c4));
#pragma unroll
            for (int i = 0; i < 16; ++i) *(LAS f32x4*)(scr + (8 * i + r) * 36 + c4) = v[i] * cur.scale;
            asm volatile("s_waitcnt lgkmcnt(0)" ::: "memory");
            const LAS float* s = scr + (64 * hf) * 36 + n;
            unsigned w[16];
#pragma unroll
            for (int j = 0; j < 16; ++j) { unsigned x = 0u; x = __builtin_amdgcn_cvt_pk_fp8_f32(s[(4 * j) * 36], s[(4 * j + 1) * 36], x, false); x = __builtin_amdgcn_cvt_pk_fp8_f32(s[(4 * j + 2) * 36], s[(4 * j + 3) * 36], x, true); w[j] = x; }
            const int drow = cur.n0 + n; unsigned char* op = cur.WT + ((size_t)(((drow >> 8) * 16 + (cur.k0 >> 7)) * 256 + (drow & 255))) * 128 + 64 * hf;
#pragma unroll
            for (int j = 0; j < 4; ++j) *(u32x4*)(op + 16 * j) = (u32x4){w[4 * j], w[4 * j + 1], w[4 * j + 2], w[4 * j + 3]};
            asm volatile("s_waitcnt lgkmcnt(0)" ::: "memory");
        }
    }
}
static_assert(CV_TAIL <= 32 * 16 * 64 && CV_TAIL1 % 8 == 0 && CV_TAIL2 % 8 == 0, "the tails are a suffix of the moe_w2 items");

struct SchedP1 {
    int G, c; const unsigned char* ws; int lo, hi;
    DI bool next(int i, pg8::UnitD& u) const {
        u.rows = nullptr; u.nvalid = 0; u.lda = 4096u; u.ldb = 4096u; u.e = 0; u.x0 = 0;
        if (lo == 0) {
            if (G == 256) { const int x = c >> 5, s = c & 31, bidx = i * 8 + x; if (bidx >= 24) return false;
                const int g = bidx >> 2, h = bidx & 3; u.pn = 4 * g + (s >> 3); u.pm = h * 8 + (s & 7); if (u.pn >= 23) return false; }
            else { const int L = i * G + c; if (L >= 32 * 23) return false; u.pn = L / 32; u.pm = L % 32; }
            u.type = 0; u.A = (const char*)(ws + WS_HN) + (size_t)u.pm * 256 * 4096; u.B = (const char*)(ws + WS_WIN) + (size_t)u.pn * 256 * 4096;
            return true;
        }
        const int L = lo + i * G + c; if (L >= hi) return false;
        { const int q = L - 32 * 23; u.type = 1; u.pn = q / 4; u.pm = q % 4; u.A = (const char*)(ws + WS_MN) + (size_t)u.pm * 256 * 4096; u.B = (const char*)(ws + WS_WKV) + (size_t)u.pn * 256 * 4096; }
        return true;
    }
};
struct EpiP1 {
    static constexpr bool AFTER_DRAIN = false;
    bf16_t* proj; float* dtb; bf16_t* kvraw; const float* gq; const float* gk; unsigned char* vf8;
    DI void operator()(const f32x4 (&acc)[2][2][4][2], const pg8::UnitD& u, int wr, int wc, int fr, int fq) const {
        { int ln_ = threadIdx.x; asm volatile("" : "+v"(ln_)); fr = ln_ & 15; fq = (ln_ >> 4) & 3; }
        const int row0 = u.pm * 256 + wr * 64 + fr;
        const int cn = u.pn * 256 + 64 * wc + 8 * fq;
        if (u.type == 1 && u.pn >= 8) {
#pragma unroll
            for (int ai = 0; ai < 2; ++ai)
#pragma unroll
                for (int m = 0; m < 4; ++m) { unsigned char* rp = vf8 + (size_t)(row0 + ai * 128 + m * 16) * 2048 + (cn - 2048);
#pragma unroll
                    for (int bj = 0; bj < 2; ++bj) { const f32x4 v0 = acc[ai][bj][m][0] * 16.f, v1 = acc[ai][bj][m][1] * 16.f;
                        u32x2 w; w.x = __builtin_amdgcn_cvt_pk_fp8_f32(v0[0], v0[1], 0u, false); w.x = __builtin_amdgcn_cvt_pk_fp8_f32(v0[2], v0[3], w.x, true);
                        w.y = __builtin_amdgcn_cvt_pk_fp8_f32(v1[0], v1[1], 0u, false); w.y = __builtin_amdgcn_cvt_pk_fp8_f32(v1[2], v1[3], w.y, true);
                        *(u32x2*)(rp + 32 * bj) = w; } }
            return;
        }
        if (u.type == 1) {
#pragma unroll
            for (int ai = 0; ai < 2; ++ai)
#pragma unroll
                for (int m = 0; m < 4; ++m) { bf16_t* rp = kvraw + (size_t)(row0 + ai * 128 + m * 16) * 4096 + cn;
#pragma unroll
                    for (int bj = 0; bj < 2; ++bj) { const f32x4 v0 = acc[ai][bj][m][0], v1 = acc[ai][bj][m][1];
                        u32x4 w; w.x = pk2(v0[0], v0[1]); w.y = pk2(v0[2], v0[3]); w.z = pk2(v1[0], v1[1]); w.w = pk2(v1[2], v1[3]); *(u32x4*)(rp + 32 * bj) = w; } }
            return;
        }
        if (u.pn == 22) {
            if (wc == 0 && fq < 2) {
#pragma unroll
                for (int ai = 0; ai < 2; ++ai)
#pragma unroll
                    for (int m = 0; m < 4; ++m) { float* rp = dtb + (size_t)(row0 + ai * 128 + m * 16) * 16 + 8 * fq;
                        *(f32x4*)(rp) = acc[ai][0][m][0]; *(f32x4*)(rp + 4) = acc[ai][0][m][1]; }
            }
            return;
        }
        const bool isq = (u.pn >= 10 && u.pn < 14), isk = (u.pn >= 14 && u.pn < 18);
        if (!(isq || isk)) {
#pragma unroll
            for (int ai = 0; ai < 2; ++ai)
#pragma unroll
                for (int m = 0; m < 4; ++m) { bf16_t* rp = proj + (size_t)(row0 + ai * 128 + m * 16) * PP + cn;
#pragma unroll
                    for (int bj = 0; bj < 2; ++bj) { const f32x4 v0 = acc[ai][bj][m][0], v1 = acc[ai][bj][m][1];
                        u32x4 w; w.x = pk2(v0[0], v0[1]); w.y = pk2(v0[2], v0[3]); w.z = pk2(v1[0], v1[1]); w.w = pk2(v1[2], v1[3]); *(u32x4*)(rp + 32 * bj) = w; } }
            return;
        }
        const float* g = (isq ? gq : gk) + 8 * fq; const float sc = isq ? (0.125f * 1.4426950408889634f) : 1.f;
#pragma unroll
        for (int ai = 0; ai < 2; ++ai)
#pragma unroll
            for (int m = 0; m < 4; ++m) { bf16_t* rp = proj + (size_t)(row0 + ai * 128 + m * 16) * PP + cn;
                float ss = 0.f;
#pragma unroll
                for (int bj = 0; bj < 2; ++bj)
#pragma unroll
                    for (int n = 0; n < 2; ++n) { const f32x4 v = acc[ai][bj][m][n]; ss += (v[0] * v[0] + v[1] * v[1]) + (v[2] * v[2] + v[3] * v[3]); }
                ss += __shfl_xor(ss, 16); ss += __shfl_xor(ss, 32);
                const float rs = sc / sqrtf(ss * (1.f / 64.f) + EPS_);
#pragma unroll
                for (int bj = 0; bj < 2; ++bj) { const f32x4 v0 = acc[ai][bj][m][0] * rs * *(const f32x4*)(g + 32 * bj), v1 = acc[ai][bj][m][1] * rs * *(const f32x4*)(g + 32 * bj + 4);
                    u32x4 w; w.x = pk2(v0[0], v0[1]); w.y = pk2(v0[2], v0[3]); w.z = pk2(v1[0], v1[1]); w.w = pk2(v1[2], v1[3]); *(u32x4*)(rp + 32 * bj) = w; } }
    }
};

DI void kprep(Frame& F, const ArgP& a) {
    const int gw = F.vcu * NWAVES + F.wave, NGW = F.G * NWAVES;
    const bf16_t* kv = (const bf16_t*)(F.ws + WS_KVRAW); unsigned char* kn = (unsigned char*)(F.ws + WS_KN8);
    for (int it = gw; it < NB * MEMLEN * 4; it += NGW) {
        const int row = it >> 2, h = it & 3, b = row >> 8, key = row & 255;
        const u32x4 raw = *(const u32x4*)(kv + (size_t)row * 4096 + h * 512 + F.lane * 8);
        float v[8]; v[0] = bflo(raw.x); v[1] = bfhi(raw.x); v[2] = bflo(raw.y); v[3] = bfhi(raw.y); v[4] = bflo(raw.z); v[5] = bfhi(raw.z); v[6] = bflo(raw.w); v[7] = bfhi(raw.w);
        float ss = 0.f;
#pragma unroll
        for (int j = 0; j < 8; ++j) ss += v[j] * v[j];
        const float rs = 1.f / sqrtf(wave_sum(ss) * (1.f / 512.f) + EPS_) * 0.04419417382415922f * 128.f;
        const float* gk = a.in(I_XKG) + F.lane * 8; const float* gq = a.in(I_XQG) + F.lane * 8;
        u32x2 o; o.x = __builtin_amdgcn_cvt_pk_fp8_f32(v[0] * rs * gk[0] * gq[0], v[1] * rs * gk[1] * gq[1], 0u, false); o.x = __builtin_amdgcn_cvt_pk_fp8_f32(v[2] * rs * gk[2] * gq[2], v[3] * rs * gk[3] * gq[3], o.x, true);
        o.y = __builtin_amdgcn_cvt_pk_fp8_f32(v[4] * rs * gk[4] * gq[4], v[5] * rs * gk[5] * gq[5], 0u, false); o.y = __builtin_amdgcn_cvt_pk_fp8_f32(v[6] * rs * gk[6] * gq[6], v[7] * rs * gk[7] * gq[7], o.y, true);
        *(u32x2*)(kn + ((size_t)((b * 4 + h) * 256 + key)) * 512 + F.lane * 8) = o;
    }
}

constexpr int SP = 272;
constexpr int S_C = 0, S_BM = 34816, S_BT = 69632, S_XDT = 104448, S_HB = 121856, S_F = 139264, S_W = 155648  , SSD_LDS = 162048;
static_assert(SSD_LDS <= MISC_OFF, "SSD LDS map");
#define MFMA32(a, b, c) __builtin_amdgcn_mfma_f32_32x32x16_bf16((a), (b), (c), 0, 0, 0)
DI int crow(int r, int hi) { return (r & 3) + 8 * (r >> 2) + 4 * hi; }
DI bf16x8 ldfrag(LAS const unsigned char* base, int row, int kel) { return *(const LAS bf16x8*)(base + row * SP + kel * 2); }
DI float fexp(float x) { return __builtin_amdgcn_exp2f(x * 1.4426950408889634f); }
DI float fsilu(float x) { return x * __builtin_amdgcn_rcpf(1.f + fexp(-x)); }

DI void ssd_unit(Frame& F, const ArgP& a, int b, int hd) {
    LAS unsigned char* lds = F.lds;
    int tid = F.tid, lane = F.lane, r32 = lane & 31, hh = lane >> 5; const int wid = F.wave;
    LAS float* sdt = (LAS float*)(lds + S_F); LAS float* sac = sdt + 2048;
    const bf16_t* proj = (const bf16_t*)(F.ws + WS_PROJ); const float* dtbuf = (const float*)(F.ws + WS_DT); bf16_t* yg = (bf16_t*)(F.ws + WS_YG);
    const int g = hd >> 3;
    const float aneg = -__expf(a.in(I_ALOG)[hd]), dtb = a.in(I_DTB)[hd], dsk = a.in(I_DSKIP)[hd];
#pragma unroll
    for (int q = 0; q < 2; ++q) { const int c = 2 * wid + q; const size_t t0 = (size_t)b * SEQ_ + c * 128;
        const float x0 = dtbuf[(t0 + 2 * lane) * 16 + hd] + dtb, x1 = dtbuf[(t0 + 2 * lane + 1) * 16 + hd] + dtb;
        const float d0 = x0 > 20.f ? x0 : log1pf(__expf(x0)), d1 = x1 > 20.f ? x1 : log1pf(__expf(x1));
        const float a0 = d0 * aneg, a1 = d1 * aneg;
        float s = a0 + a1;
#pragma unroll
        for (int o = 1; o < 64; o <<= 1) { const float t = __shfl_up(s, o); if (lane >= o) s += t; }
        sdt[c * 128 + 2 * lane] = d0; sdt[c * 128 + 2 * lane + 1] = d1; sac[c * 128 + 2 * lane] = s - a1; sac[c * 128 + 2 * lane + 1] = s; }
    int seg = tid >> 5, cg = tid & 31, l0 = seg * 8;
    int colbc = (cg < 16) ? (1024 + g * 128 + cg * 8) : (1280 + g * 128 + (cg - 16) * 8);
    const int colx = hd * 64 + wid * 8; int lx = 2 * lane;
    LAS float* swt = (LAS float*)(lds + S_W);
    { const float* convw = a.in(I_CONVW); const float* convb = a.in(I_CONVB);
      if (tid < 320) { const int ci = tid;
          const int xc = (ci < 64) ? (hd * 64 + ci) : (ci < 192 ? (1024 + g * 128 + (ci - 64)) : (1280 + g * 128 + (ci - 192)));
#pragma unroll
          for (int k = 0; k < 4; ++k) swt[k * 320 + ci] = convw[k * 1536 + xc];
          swt[4 * 320 + ci] = convb[xc]; } }
    int cibc = 64 + cg * 8; const int cix = wid * 8;
    const char* pub = (const char*)F.ws; const unsigned pxb = (unsigned)(WS_PROJ + ((size_t)b * SEQ_ * PP + PC_XBC) * 2), zoff = (unsigned)(WS_CTL + 524288);
    u32x4 inbc[11], inx[5];
#define SSD_PREFETCH(c_) do { \
        int sd_ = l0; asm volatile("" : "+v"(sd_)); \
        _Pragma("unroll") for (int j = 0; j < 11; ++j) { const int tt = (c_) * 128 + sd_ - 3 + j; inbc[j] = *(const u32x4*)(pub + ((tt >= 0) ? pxb + (unsigned)(tt * PP + colbc) * 2u : zoff)); } } while (0)
    SSD_PREFETCH(0);
    f32x16 hT; for (int i = 0; i < 16; ++i) hT[i] = 0.f;
    const int nb = wid & 3, pb = wid >> 2;
    __syncthreads();
    for (int c = 0; c < 16; ++c) {
        { int t_ = threadIdx.x; asm volatile("" : "+v"(t_)); tid = t_; lane = t_ & 63; r32 = lane & 31; hh = lane >> 5; seg = t_ >> 5; cg = t_ & 31; l0 = seg * 8; lx = 2 * lane;
          colbc = (cg < 16) ? (1024 + g * 128 + cg * 8) : (1280 + g * 128 + (cg - 16) * 8); cibc = 64 + cg * 8; }
        const size_t t0 = (size_t)b * SEQ_ + c * 128;
        const LAS float* cdt = sdt + c * 128; const LAS float* cac = sac + c * 128;
        const float aend = cac[127];
#pragma unroll
        for (int j = 0; j < 5; ++j) { int sd_ = lx; asm volatile("" : "+v"(sd_)); const int tt = c * 128 + sd_ - 3 + j; inx[j] = *(const u32x4*)(pub + ((tt >= 0) ? pxb + (unsigned)(tt * PP + colx) * 2u : zoff)); }
        {
            LAS unsigned char* hbp = lds + S_HB + (32 * pb + r32) * SP + (32 * nb + 4 * hh) * 2;
#pragma unroll
            for (int q4 = 0; q4 < 4; ++q4) { u32x2 w; w.x = pk2(hT[4 * q4], hT[4 * q4 + 1]); w.y = pk2(hT[4 * q4 + 2], hT[4 * q4 + 3]); *(LAS u32x2*)(hbp + 16 * q4) = w; }
        }
        {
            float wbc[5][8];
#pragma unroll
            for (int k = 0; k < 5; ++k) { const f32x4 w0 = *(const LAS f32x4*)(swt + k * 320 + cibc), w1 = *(const LAS f32x4*)(swt + k * 320 + cibc + 4);
#pragma unroll
                for (int i = 0; i < 4; ++i) { wbc[k][i] = w0[i]; wbc[k][4 + i] = w1[i]; } }
#pragma unroll
            for (int hf = 0; hf < 2; ++hf) {
                __builtin_amdgcn_sched_barrier(0);
                float o[4][8];
#pragma unroll
                for (int j = 0; j < 4; ++j)
#pragma unroll
                    for (int i = 0; i < 8; ++i) { float s = wbc[4][i];
#pragma unroll
                        for (int k = 0; k < 4; ++k) { const unsigned wd = inbc[4 * hf + j + k][i >> 1]; s += wbc[k][i] * ((i & 1) ? bfhi(wd) : bflo(wd)); }
                        o[j][i] = fsilu(s); }
                const int lh = l0 + 4 * hf;
                if (cg < 16) {
                    const int n0 = cg * 8; float ev[4];
#pragma unroll
                    for (int j = 0; j < 4; ++j) { ev[j] = fexp(aend - cac[lh + j]);
                        u32x4 w1; w1.x = pk2(o[j][0], o[j][1]); w1.y = pk2(o[j][2], o[j][3]); w1.z = pk2(o[j][4], o[j][5]); w1.w = pk2(o[j][6], o[j][7]);
                        *(LAS u32x4*)(lds + S_BM + (lh + j) * SP + n0 * 2) = w1; }
#pragma unroll
                    for (int i = 0; i < 8; ++i) { u32x2 w2; w2.x = pk2(o[0][i] * ev[0], o[1][i] * ev[1]); w2.y = pk2(o[2][i] * ev[2], o[3][i] * ev[3]);
                        *(LAS u32x2*)(lds + S_BT + (n0 + i) * SP + lh * 2) = w2; }
                } else {
                    const int n0 = (cg - 16) * 8;
#pragma unroll
                    for (int j = 0; j < 4; ++j) { u32x4 w1; w1.x = pk2(o[j][0], o[j][1]); w1.y = pk2(o[j][2], o[j][3]); w1.z = pk2(o[j][4], o[j][5]); w1.w = pk2(o[j][6], o[j][7]);
                        *(LAS u32x4*)(lds + S_C + (lh + j) * SP + n0 * 2) = w1; }
                }
            }
        }
        __builtin_amdgcn_sched_barrier(0);
        {
            const float d0 = cdt[lx], d1 = cdt[lx + 1];
            float wx[5][8];
#pragma unroll
            for (int k = 0; k < 5; ++k) { const f32x4 w0 = *(const LAS f32x4*)(swt + k * 320 + cix), w1 = *(const LAS f32x4*)(swt + k * 320 + cix + 4);
#pragma unroll
                for (int i = 0; i < 4; ++i) { wx[k][i] = w0[i]; wx[k][4 + i] = w1[i]; } }
#pragma unroll
            for (int i = 0; i < 8; ++i) { float s0 = wx[4][i], s1 = wx[4][i];
#pragma unroll
                for (int k = 0; k < 4; ++k) { const unsigned w0 = inx[k][i >> 1], w1 = inx[k + 1][i >> 1];
                    s0 += wx[k][i] * ((i & 1) ? bfhi(w0) : bflo(w0)); s1 += wx[k][i] * ((i & 1) ? bfhi(w1) : bflo(w1)); }
                *(LAS unsigned*)(lds + S_XDT + (wid * 8 + i) * SP + lx * 2) = pk2(fsilu(s0) * d0, fsilu(s1) * d1); }
        }
        if (c < 15) SSD_PREFETCH(c + 1);
        __syncthreads();
        const int lb = wid >> 1;
        f32x16 xt[2];
        {
            bf16x8 cf[8];
#pragma unroll
            for (int ks = 0; ks < 8; ++ks) cf[ks] = ldfrag(lds + S_C, 32 * lb + r32, 16 * ks + 8 * hh);
#pragma unroll
            for (int q = 0; q < 2; ++q) { const int sb = 2 * (wid & 1) + q;
                for (int i = 0; i < 16; ++i) xt[q][i] = 0.f;
                if (sb <= lb) {
                    bf16x8 bfr[8];
#pragma unroll
                    for (int ks = 0; ks < 8; ++ks) bfr[ks] = ldfrag(lds + S_BM, 32 * sb + r32, 16 * ks + 8 * hh);
                    __builtin_amdgcn_sched_barrier(0);
#pragma unroll
                    for (int ks = 0; ks < 8; ++ks) xt[q] = MFMA32(bfr[ks], cf[ks], xt[q]);
                }
            }
        }
        __syncthreads();
        {
            const int l = 32 * lb + r32; const float al = cac[l], ddl = dsk * __builtin_amdgcn_rcpf(cdt[l]);
            f32x4 cs[2][4];
#pragma unroll
            for (int q = 0; q < 2; ++q)
#pragma unroll
                for (int q4 = 0; q4 < 4; ++q4) cs[q][q4] = *(const LAS f32x4*)(cac + 32 * (2 * (wid & 1) + q) + 8 * q4 + 4 * hh);
#pragma unroll
            for (int q = 0; q < 2; ++q) { const int sb = 2 * (wid & 1) + q;
#pragma unroll
                for (int q4 = 0; q4 < 4; ++q4) { float mv[4];
#pragma unroll
                    for (int e = 0; e < 4; ++e) { const int s = 32 * sb + 8 * q4 + 4 * hh + e;
                        const float ev = fexp(fminf(al - cs[q][q4][e], 0.f));
                        float v = (s <= l) ? xt[q][4 * q4 + e] * ev : 0.f;
                        v += (s == l) ? ddl : 0.f;
                        mv[e] = v; }
                    u32x2 w; w.x = pk2(mv[0], mv[1]); w.y = pk2(mv[2], mv[3]);
                    *(LAS u32x2*)(lds + S_BM + l * SP + (32 * sb + 8 * q4 + 4 * hh) * 2) = w; }
            }
        }
        __syncthreads();
        {
            const int lb2 = wid & 3, pb2 = wid >> 2; const int l = 32 * lb2 + r32; const size_t tok = t0 + l;
            const int pc0 = hd * 64 + 32 * pb2 + 4 * hh;
            u32x2 zz[4];
#pragma unroll
            for (int q4 = 0; q4 < 4; ++q4) zz[q4] = *(const u32x2*)(proj + tok * PP + pc0 + 8 * q4);
            f32x16 y1, y2; for (int i = 0; i < 16; ++i) { y1[i] = 0.f; y2[i] = 0.f; }
            bf16x8 fa[8], fb[8];
#pragma unroll
            for (int ks = 0; ks < 8; ++ks) { fa[ks] = ldfrag(lds + S_XDT, 32 * pb2 + r32, 16 * ks + 8 * hh); fb[ks] = ldfrag(lds + S_BM, 32 * lb2 + r32, 16 * ks + 8 * hh); }
            __builtin_amdgcn_sched_barrier(0);
#pragma unroll
            for (int ks = 0; ks < 8; ++ks) { if (ks < 2 * (lb2 + 1)) y1 = MFMA32(fa[ks], fb[ks], y1); }
            const float cd = fexp(aend);
#pragma unroll
            for (int i = 0; i < 16; ++i) hT[i] *= cd;
#pragma unroll
            for (int ks = 0; ks < 8; ++ks) fb[ks] = ldfrag(lds + S_BT, 32 * nb + r32, 16 * ks + 8 * hh);
            __builtin_amdgcn_sched_barrier(0);
#pragma unroll
            for (int ks = 0; ks < 8; ++ks) hT = MFMA32(fb[ks], fa[ks], hT);
#pragma unroll
            for (int ks = 0; ks < 8; ++ks) { fa[ks] = ldfrag(lds + S_HB, 32 * pb2 + r32, 16 * ks + 8 * hh); fb[ks] = ldfrag(lds + S_C, 32 * lb2 + r32, 16 * ks + 8 * hh); }
            __builtin_amdgcn_sched_barrier(0);
#pragma unroll
            for (int ks = 0; ks < 8; ++ks) y2 = MFMA32(fa[ks], fb[ks], y2);
            const float el = fexp(cac[l]);
#pragma unroll
            for (int q4 = 0; q4 < 4; ++q4) { float yv[4];
#pragma unroll
                for (int e = 0; e < 4; ++e) { const float z = (e & 1) ? bfhi(e < 2 ? zz[q4].x : zz[q4].y) : bflo(e < 2 ? zz[q4].x : zz[q4].y);
                    yv[e] = (y1[4 * q4 + e] + el * y2[4 * q4 + e]) * fsilu(z); }
                u32x2 w; w.x = pk2(yv[0], yv[1]); w.y = pk2(yv[2], yv[3]);
                *(u32x2*)(yg + tok * 1024 + pc0 + 8 * q4) = w; }
        }
        __syncthreads();
    }
#undef SSD_PREFETCH
}

DI void attn_phase_da(Frame& F) {
    const attn_body::bf16* proj = (const attn_body::bf16*)(F.ws + WS_PROJ);
    for (;;) {
        if (threadIdx.x == 0) F.MISC[120] = __hip_atomic_fetch_add(F.ctl + CW_QATT, 1u, __ATOMIC_RELAXED, __HIP_MEMORY_SCOPE_AGENT);
        __syncthreads();
        const int u = __builtin_amdgcn_readfirstlane((int)F.MISC[120]);
        __syncthreads();
        if (u >= 1024) break;
        const int qb = 7 - (u >> 7), combo = u & 127;
        const int half = combo & 1, j = (combo >> 1) & 1, h = (combo >> 2) & 7, b = combo >> 5;
        attn_body::bf16* O = (attn_body::bf16*)(F.ws + (j ? WS_O1 : WS_O0));
        attn_body::attn_unit<8>(b, PC_Q + (h * 2 + j) * 64, PC_V + h * 128 + half * 64, h * 128 + half * 64, qb, proj, proj + (PC_K - PC_Q), proj, O, (char*)F.lds);
    }
}

DI void p3_finalize(Frame& F, const ArgP& a) {
    const int gw = F.vcu * NWAVES + F.wave, NGW = F.G * NWAVES, lane = F.lane;
    bf16_t* ycat = (bf16_t*)(F.ws + WS_YCAT); const bf16_t* yg = (const bf16_t*)(F.ws + WS_YG); const bf16_t* o0 = (const bf16_t*)(F.ws + WS_O0); const bf16_t* o1 = (const bf16_t*)(F.ws + WS_O1);
    float l1 = a.in(I_LQ1)[lane] * a.in(I_LK1)[lane], l2 = a.in(I_LQ2)[lane] * a.in(I_LK2)[lane];
    const float lam = __expf(wave_sum(l1)) - __expf(wave_sum(l2)) + LAM_INIT;
    for (int m = gw; m < NTOK; m += NGW) {
        { bf16_t* yp = ycat + (size_t)m * 2048 + 16 * lane; const bf16_t* gp = yg + (size_t)m * 1024 + 16 * lane;
          const u32x4 r0 = *(const u32x4*)gp, r1 = *(const u32x4*)(gp + 8);
          float v[16]; v[0] = bflo(r0.x); v[1] = bfhi(r0.x); v[2] = bflo(r0.y); v[3] = bfhi(r0.y); v[4] = bflo(r0.z); v[5] = bfhi(r0.z); v[6] = bflo(r0.w); v[7] = bfhi(r0.w);
          v[8] = bflo(r1.x); v[9] = bfhi(r1.x); v[10] = bflo(r1.y); v[11] = bfhi(r1.y); v[12] = bflo(r1.z); v[13] = bfhi(r1.z); v[14] = bflo(r1.w); v[15] = bfhi(r1.w);
          float ss = 0.f;
#pragma unroll
          for (int i = 0; i < 16; ++i) ss += v[i] * v[i];
#pragma unroll
          for (int o = 1; o < 32; o <<= 1) ss += __shfl_xor(ss, o);
          const float rs = 1.f / sqrtf(ss * (1.f / 512.f) + EPS_);
          const float* g = a.in(I_SSDG) + 16 * lane;
          u32x4 w0, w1;
          w0.x = pk2(v[0] * rs * g[0], v[1] * rs * g[1]); w0.y = pk2(v[2] * rs * g[2], v[3] * rs * g[3]); w0.z = pk2(v[4] * rs * g[4], v[5] * rs * g[5]); w0.w = pk2(v[6] * rs * g[6], v[7] * rs * g[7]);
          w1.x = pk2(v[8] * rs * g[8], v[9] * rs * g[9]); w1.y = pk2(v[10] * rs * g[10], v[11] * rs * g[11]); w1.z = pk2(v[12] * rs * g[12], v[13] * rs * g[13]); w1.w = pk2(v[14] * rs * g[14], v[15] * rs * g[15]);
          *(u32x4*)yp = w0; *(u32x4*)(yp + 8) = w1; }
        { const bf16_t* p0 = o0 + (size_t)m * 1024 + 16 * lane; const bf16_t* p1 = o1 + (size_t)m * 1024 + 16 * lane;
          const u32x4 a0 = *(const u32x4*)p0, a1 = *(const u32x4*)(p0 + 8), b0 = *(const u32x4*)p1, b1 = *(const u32x4*)(p1 + 8);
          float v[16];
          v[0] = bflo(a0.x) - lam * bflo(b0.x); v[1] = bfhi(a0.x) - lam * bfhi(b0.x); v[2] = bflo(a0.y) - lam * bflo(b0.y); v[3] = bfhi(a0.y) - lam * bfhi(b0.y);
          v[4] = bflo(a0.z) - lam * bflo(b0.z); v[5] = bfhi(a0.z) - lam * bfhi(b0.z); v[6] = bflo(a0.w) - lam * bflo(b0.w); v[7] = bfhi(a0.w) - lam * bfhi(b0.w);
          v[8] = bflo(a1.x) - lam * bflo(b1.x); v[9] = bfhi(a1.x) - lam * bfhi(b1.x); v[10] = bflo(a1.y) - lam * bflo(b1.y); v[11] = bfhi(a1.y) - lam * bfhi(b1.y);
          v[12] = bflo(a1.z) - lam * bflo(b1.z); v[13] = bfhi(a1.z) - lam * bfhi(b1.z); v[14] = bflo(a1.w) - lam * bflo(b1.w); v[15] = bfhi(a1.w) - lam * bfhi(b1.w);
          float ss = 0.f;
#pragma unroll
          for (int i = 0; i < 16; ++i) ss += v[i] * v[i];
          ss += __shfl_xor(ss, 1); ss += __shfl_xor(ss, 2); ss += __shfl_xor(ss, 4);
          const float rs = 1.f / sqrtf(ss * (1.f / 128.f) + EPS_) * (1.f - LAM_INIT);
          const float* g = a.in(I_SUBG) + 16 * (lane & 7);
          u32x4 w0, w1;
          w0.x = pk2(v[0] * rs * g[0], v[1] * rs * g[1]); w0.y = pk2(v[2] * rs * g[2], v[3] * rs * g[3]); w0.z = pk2(v[4] * rs * g[4], v[5] * rs * g[5]); w0.w = pk2(v[6] * rs * g[6], v[7] * rs * g[7]);
          w1.x = pk2(v[8] * rs * g[8], v[9] * rs * g[9]); w1.y = pk2(v[10] * rs * g[10], v[11] * rs * g[11]); w1.z = pk2(v[12] * rs * g[12], v[13] * rs * g[13]); w1.w = pk2(v[14] * rs * g[14], v[15] * rs * g[15]);
          bf16_t* yp = ycat + (size_t)m * 2048 + 1024 + 16 * lane;
          *(u32x4*)yp = w0; *(u32x4*)(yp + 8) = w1; }
    }
}

struct SchedDense {
    int G, c, nM, nN; const char* A; const char* B; unsigned lda, ldb; int bdiv; size_t bstride;
    DI bool next(int i, pg8::UnitD& u) const {
        const int L = i * G + c; if (L >= nM * nN) return false;
        u.rows = nullptr; u.nvalid = 0; u.lda = lda; u.ldb = ldb; u.type = 0; u.e = 0; u.x0 = 0;
        if (G == 256 && nM == 32 && nN == 8) { const int x = L >> 5, s = L & 31; u.pm = (x & 3) * 8 + (s & 7); u.pn = (x >> 2) * 4 + (s >> 3); }
        else { u.pn = L / nM; u.pm = L % nM; }
        u.A = A + (size_t)u.pm * 256 * lda; u.B = B + (size_t)u.pn * 256 * ldb + (size_t)(u.pm / bdiv) * bstride;
        return true;
    }
};
template <bool BASE_BF16>
struct EpiResid {
    static constexpr bool AFTER_DRAIN = false;
    const void* base; bf16_t* out; float* part; unsigned char* out8; float accscale;
    DI void operator()(const f32x4 (&acc)[2][2][4][2], const pg8::UnitD& u, int wr, int wc, int fr, int fq) const {
        { int ln_ = threadIdx.x; asm volatile("" : "+v"(ln_)); fr = ln_ & 15; fq = (ln_ >> 4) & 3; }
        const int row0 = u.pm * 256 + wr * 64 + fr, col0 = u.pn * 256 + wc * 32 + 8 * fq;
#pragma unroll
        for (int ai = 0; ai < 2; ++ai)
#pragma unroll
            for (int m = 0; m < 4; ++m) { const size_t row = (size_t)(row0 + ai * 128 + m * 16); float ss = 0.f;
#pragma unroll
                for (int bj = 0; bj < 2; ++bj) { const size_t idx = row * 2048 + col0 + bj * 128;
                    f32x4 b0, b1;
                    if constexpr (BASE_BF16) { const u32x4 r = *(const u32x4*)((const bf16_t*)base + idx); b0 = (f32x4){bflo(r.x), bfhi(r.x), bflo(r.y), bfhi(r.y)}; b1 = (f32x4){bflo(r.z), bfhi(r.z), bflo(r.w), bfhi(r.w)}; }
                    else { b0 = *(const f32x4*)((const float*)base + idx); b1 = *(const f32x4*)((const float*)base + idx + 4); }
                    const f32x4 v0 = acc[ai][bj][m][0] * accscale + b0, v1 = acc[ai][bj][m][1] * accscale + b1;
                    { u32x4 w; w.x = pk2(v0[0], v0[1]); w.y = pk2(v0[2], v0[3]); w.z = pk2(v1[0], v1[1]); w.w = pk2(v1[2], v1[3]); *(u32x4*)(out + idx) = w; }
                    if (out8) { u32x2 w; w.x = __builtin_amdgcn_cvt_pk_fp8_f32(v0[0] * 16.f, v0[1] * 16.f, 0u, false); w.x = __builtin_amdgcn_cvt_pk_fp8_f32(v0[2] * 16.f, v0[3] * 16.f, w.x, true);
                        w.y = __builtin_amdgcn_cvt_pk_fp8_f32(v1[0] * 16.f, v1[1] * 16.f, 0u, false); w.y = __builtin_amdgcn_cvt_pk_fp8_f32(v1[2] * 16.f, v1[3] * 16.f, w.y, true); *(u32x2*)(out8 + idx) = w; }
                    ss += (v0[0] * v0[0] + v0[1] * v0[1]) + (v0[2] * v0[2] + v0[3] * v0[3]) + (v1[0] * v1[0] + v1[1] * v1[1]) + (v1[2] * v1[2] + v1[3] * v1[3]); }
                if (part) { ss += __shfl_xor(ss, 16); ss += __shfl_xor(ss, 32); if (fq == 0) part[row * 32 + u.pn * 4 + wc] = ss; } }
    }
};

struct EpiQ {
    static constexpr bool AFTER_DRAIN = false;
    unsigned char* out8; float* part;
    DI void operator()(const f32x4 (&acc)[2][2][4][2], const pg8::UnitD& u, int wr, int wc, int fr, int fq) const {
        { int ln_ = threadIdx.x; asm volatile("" : "+v"(ln_)); fr = ln_ & 15; fq = (ln_ >> 4) & 3; }
        const int row0 = u.pm * 256 + wr * 64 + fr, col0 = u.pn * 256 + wc * 32 + 8 * fq;
#pragma unroll
        for (int ai = 0; ai < 2; ++ai)
#pragma unroll
            for (int m = 0; m < 4; ++m) { const size_t row = (size_t)(row0 + ai * 128 + m * 16); float ss = 0.f;
#pragma unroll
                for (int bj = 0; bj < 2; ++bj) { const size_t idx = row * 2048 + col0 + bj * 128; const f32x4 v0 = acc[ai][bj][m][0] * (1.f / 1024.f), v1 = acc[ai][bj][m][1] * (1.f / 1024.f);
                    u32x2 w; w.x = __builtin_amdgcn_cvt_pk_fp8_f32(v0[0] * 16.f, v0[1] * 16.f, 0u, false); w.x = __builtin_amdgcn_cvt_pk_fp8_f32(v0[2] * 16.f, v0[3] * 16.f, w.x, true);
                    w.y = __builtin_amdgcn_cvt_pk_fp8_f32(v1[0] * 16.f, v1[1] * 16.f, 0u, false); w.y = __builtin_amdgcn_cvt_pk_fp8_f32(v1[2] * 16.f, v1[3] * 16.f, w.y, true); *(u32x2*)(out8 + idx) = w;
                    ss += (v0[0] * v0[0] + v0[1] * v0[1]) + (v0[2] * v0[2] + v0[3] * v0[3]) + (v1[0] * v1[0] + v1[1] * v1[1]) + (v1[2] * v1[2] + v1[3] * v1[3]); }
                ss += __shfl_xor(ss, 16); ss += __shfl_xor(ss, 32); if (fq == 0) part[row * 32 + u.pn * 4 + wc] = ss; }
    }
};

struct SchedXS {
    int G, c; const unsigned char* ws;
    DI bool next(int i, pg8::UnitD& u) const {
        const int L = i * G + c; if (L >= 256) return false;
        u.rows = nullptr; u.nvalid = 0; u.e = 0;
        const int q = L & 127, bh = q >> 3, t8 = q & 7, b = bh >> 2, h = bh & 3;
        u.pm = b; u.pn = h; u.x0 = t8;
        if (L < 128) { u.type = 0; u.lda = 2048u; u.ldb = 512u;
            u.A = (const char*)(ws + WS_QF8) + (size_t)(b * 2048 + t8 * 256) * 2048 + h * 512; u.B = (const char*)(ws + WS_KN8) + (size_t)(bh * 256) * 512; }
        else { u.type = 1; u.lda = 2048u; u.ldb = 2048u;
            u.A = (const char*)(ws + WS_WO) + (size_t)(t8 * 256) * 2048 + h * 512; u.B = (const char*)(ws + WS_VF8) + (size_t)(b * 256) * 2048 + h * 512; }
        return true;
    }
};
struct EpiXS {
    static constexpr bool AFTER_DRAIN = false;
    unsigned char* P; unsigned char* VWT; const float* part1; const float* partq; LAS float* red;
    DI void operator()(const f32x4 (&acc)[2][2][4][2], const pg8::UnitD& u, int wr, int wc, int fr, int fq) const {
        { int ln_ = threadIdx.x; asm volatile("" : "+v"(ln_)); fr = ln_ & 15; fq = (ln_ >> 4) & 3; }
        const int b = u.pm, h = u.pn, t8 = u.x0;
        const int col0 = wc * 32 + 8 * fq;
        if (u.type == 1) {
            unsigned char* Vu = VWT + ((size_t)b * 2048 + t8 * 256) * 1024 + h * 256;
#pragma unroll
            for (int ai = 0; ai < 2; ++ai)
#pragma unroll
                for (int m = 0; m < 4; ++m) { const unsigned rl = (unsigned)(ai * 128 + wr * 64 + m * 16 + fr);
#pragma unroll
                    for (int bj = 0; bj < 2; ++bj) { const f32x4 v0 = acc[ai][bj][m][0] * (32.f / 1024.f), v1 = acc[ai][bj][m][1] * (32.f / 1024.f);
                        u32x2 w; w.x = __builtin_amdgcn_cvt_pk_fp8_f32(v0[0], v0[1], 0u, false); w.x = __builtin_amdgcn_cvt_pk_fp8_f32(v0[2], v0[3], w.x, true);
                        w.y = __builtin_amdgcn_cvt_pk_fp8_f32(v1[0], v1[1], 0u, false); w.y = __builtin_amdgcn_cvt_pk_fp8_f32(v1[2], v1[3], w.y, true);
                        *(u32x2*)(Vu + (rl * 1024u + (unsigned)(bj * 128 + col0))) = w; } }
            return;
        }
        const size_t row0 = (size_t)b * 2048 + t8 * 256;
        const char* p1u = (const char*)(part1 + row0 * 32); const char* pqu = (const char*)(partq + row0 * 32 + h * 8); unsigned char* Pu = P + row0 * 1024 + h * 256;
        float rsc[2][4];
#pragma unroll
        for (int ai = 0; ai < 2; ++ai)
#pragma unroll
            for (int m = 0; m < 4; ++m) { const unsigned rl = (unsigned)(ai * 128 + wr * 64 + m * 16 + fr);
                const f32x4 p0 = *(const f32x4*)(p1u + (rl * 32u + (unsigned)fq * 8u) * 4u), p1 = *(const f32x4*)(p1u + (rl * 32u + (unsigned)fq * 8u + 4u) * 4u);
                float s1 = (p0[0] + p0[1]) + (p0[2] + p0[3]) + (p1[0] + p1[1]) + (p1[2] + p1[3]);
                const f32x2 pq = *(const f32x2*)(pqu + (rl * 32u + (unsigned)fq * 2u) * 4u);
                float sq = pq[0] + pq[1];
                s1 = quad_sum_16_32(s1); sq = quad_sum_16_32(sq);
                rsc[ai][m] = __builtin_amdgcn_rsqf(sq * (1.f / 512.f) + EPS_ * (s1 * (1.f / 2048.f) + EPS_)) * (1.4426950408889634f / 2048.f);
                float ps = 0.f;
#pragma unroll
                for (int bj = 0; bj < 2; ++bj)
#pragma unroll
                    for (int n = 0; n < 2; ++n)
#pragma unroll
                        for (int e = 0; e < 4; ++e) ps += __builtin_amdgcn_exp2f(fminf(acc[ai][bj][m][n][e] * rsc[ai][m], 100.f));
                ps = quad_sum_16_32(ps);
                if (fq == 0) red[rl * 4 + wc] = ps;
                __builtin_amdgcn_sched_barrier(0); }
        __syncthreads();
        { int ln_ = threadIdx.x; asm volatile("" : "+v"(ln_)); fr = ln_ & 15; fq = (ln_ >> 4) & 3; }
#pragma unroll
        for (int ai = 0; ai < 2; ++ai)
#pragma unroll
            for (int m = 0; m < 4; ++m) { const unsigned rl = (unsigned)(ai * 128 + wr * 64 + m * 16 + fr);
                const f32x4 t = *(const LAS f32x4*)(red + rl * 4); const float inv = 256.f * __builtin_amdgcn_rcpf((t[0] + t[1]) + (t[2] + t[3])); float rs = rsc[ai][m]; asm volatile("" : "+v"(rs));
#pragma unroll
                for (int bj = 0; bj < 2; ++bj) { float x[8];
#pragma unroll
                    for (int n = 0; n < 2; ++n)
#pragma unroll
                        for (int e = 0; e < 4; ++e) x[n * 4 + e] = __builtin_amdgcn_exp2f(fminf(acc[ai][bj][m][n][e] * rs, 100.f)) * inv;
                    u32x2 w; w.x = __builtin_amdgcn_cvt_pk_fp8_f32(x[0], x[1], 0u, false); w.x = __builtin_amdgcn_cvt_pk_fp8_f32(x[2], x[3], w.x, true);
                    w.y = __builtin_amdgcn_cvt_pk_fp8_f32(x[4], x[5], 0u, false); w.y = __builtin_amdgcn_cvt_pk_fp8_f32(x[6], x[7], w.y, true);
                    *(u32x2*)(Pu + (rl * 1024u + (unsigned)(bj * 128 + wc * 32 + 8 * fq))) = w; } }
        __syncthreads();
    }
};

constexpr int HNP = 2052;
DI void p8_route(Frame& F, const ArgP& a) {
    LAS float* s_hn = (LAS float*)F.lds; LAS float* s_part = (LAS float*)(F.lds + 16 * HNP * 4); LAS float* s_log = s_part + 8 * 16 * 32; LAS int* s_slot = (LAS int*)(s_log + 16 * 32);
    LAS int* s_cnt = s_slot + 64; LAS int* s_base = s_cnt + 32;
    const bf16_t* h2 = (const bf16_t*)(F.ws + WS_H2); unsigned char* xg = (unsigned char*)(F.ws + WS_XG);
    float* gate_of = (float*)(F.ws + WS_GATEOF); int* tok_e = (int*)(F.ws + WS_TOKE);
    const float* rw = a.in(I_RW); const float* rb = a.in(I_RB); const float* g3 = a.in(I_GFFN);
    const int lane = F.lane, wave = F.wave, tid = F.tid;
    float bw0[64], bw1[64];
    { const int kq = lane >> 4, c16 = lane & 15; const float* bp = rw + (size_t)(256 * wave + kq) * 32 + c16;
#pragma unroll
      for (int j = 0; j < 64; ++j) { bw0[j] = bp[(size_t)(4 * j) * 32]; bw1[j] = bp[(size_t)(4 * j) * 32 + 16]; } }
    for (int task = F.vcu; task < NTOK / 16; task += F.G) {
        const int tb = task * 16;
#pragma unroll
        for (int q = 0; q < 2; ++q) { const int tl = 2 * wave + q; const size_t tok = (size_t)(tb + tl);
            const u32x2* xr = (const u32x2*)(h2 + tok * 2048) + lane;
            f32x4 v[8]; float s = 0.f;
#pragma unroll
            for (int j = 0; j < 8; ++j) { const u32x2 rw_ = xr[64 * j]; v[j] = (f32x4){bflo(rw_.x), bfhi(rw_.x), bflo(rw_.y), bfhi(rw_.y)}; s += (v[j].x * v[j].x + v[j].y * v[j].y) + (v[j].z * v[j].z + v[j].w * v[j].w); }
            const float rstd = 1.f / sqrtf(wave_sum(s) * (1.f / 2048.f) + EPS_);
#pragma unroll
            for (int j = 0; j < 8; ++j) { const f32x4 gg = ((const f32x4*)g3)[lane + 64 * j]; const f32x4 y = v[j] * rstd * gg;
                *(LAS f32x4*)(s_hn + tl * HNP + (lane + 64 * j) * 4) = y; } }
        __syncthreads();
        {
            f32x4 acc0 = {0.f, 0.f, 0.f, 0.f}, acc1 = {0.f, 0.f, 0.f, 0.f};
            const int kq = lane >> 4, c16 = lane & 15;
            const LAS float* ap = s_hn + c16 * HNP + 256 * wave;
#pragma unroll
            for (int j = 0; j < 64; ++j) { const f32x4 a4 = *(const LAS f32x4*)(ap + 4 * j);
                const float av = (kq == 0) ? a4.x : (kq == 1) ? a4.y : (kq == 2) ? a4.z : a4.w;
                acc0 = __builtin_amdgcn_mfma_f32_16x16x4f32(av, bw0[j], acc0, 0, 0, 0);
                acc1 = __builtin_amdgcn_mfma_f32_16x16x4f32(av, bw1[j], acc1, 0, 0, 0); }
            LAS float* pp = s_part + wave * 512 + c16;
#pragma unroll
            for (int r = 0; r < 4; ++r) { pp[(4 * kq + r) * 32] = acc0[r]; pp[(4 * kq + r) * 32 + 16] = acc1[r]; }
        }
        __syncthreads();
        {
            const int tt = tid >> 5, e = tid & 31; float lg = rb[e];
#pragma unroll
            for (int w = 0; w < 8; ++w) lg += s_part[w * 512 + tt * 32 + e];
            if (tid < 32) s_cnt[tid] = 0;
            float val[4]; int idx[4]; float cur = lg;
#pragma unroll
            for (int k = 0; k < 4; ++k) { float bv = cur; int bi = e;
#pragma unroll
                for (int o = 1; o < 32; o <<= 1) { const float ov = __shfl_xor(bv, o); const int oi = __shfl_xor(bi, o); if (ov > bv || (ov == bv && oi < bi)) { bv = ov; bi = oi; } }
                val[k] = bv; idx[k] = bi; if (e == bi) cur = -INFINITY; }
            __syncthreads();
            int myrank = 0, myexp = 0; float mygate = 0.f;
            if (e < 4) { const float sum = (__expf(val[0] - val[0]) + __expf(val[1] - val[0])) + (__expf(val[2] - val[0]) + __expf(val[3] - val[0]));
                const float mv = (e == 0) ? val[0] : (e == 1) ? val[1] : (e == 2) ? val[2] : val[3]; myexp = (e == 0) ? idx[0] : (e == 1) ? idx[1] : (e == 2) ? idx[2] : idx[3];
                mygate = __expf(mv - val[0]) / sum; myrank = __hip_atomic_fetch_add(&s_cnt[myexp], 1, __ATOMIC_RELAXED, __HIP_MEMORY_SCOPE_WORKGROUP); }
            __syncthreads();
            if (tid < 32) { const int c = s_cnt[tid]; s_base[tid] = c ? (int)__hip_atomic_fetch_add(F.ctl + CW_CNT + 64 * tid, (unsigned)c, __ATOMIC_RELAXED, __HIP_MEMORY_SCOPE_AGENT) : 0; }
            __syncthreads();
            if (e < 4) { const int slot = myexp * 8192 + s_base[myexp] + myrank; const int tok = tb + tt;
                gate_of[slot] = mygate; tok_e[tok * 4 + e] = slot; s_slot[tt * 4 + e] = slot; }
        }
        __syncthreads();
#pragma unroll
        for (int q = 0; q < 2; ++q) { const int tl = 2 * wave + q;
            unsigned o[8];
#pragma unroll
            for (int j = 0; j < 8; ++j) { const f32x4 y = *(const LAS f32x4*)(s_hn + tl * HNP + (lane + 64 * j) * 4);
                unsigned w = 0u; w = __builtin_amdgcn_cvt_pk_fp8_f32(y.x * 4.f, y.y * 4.f, w, false); w = __builtin_amdgcn_cvt_pk_fp8_f32(y.z * 4.f, y.w * 4.f, w, true); o[j] = w; }
#pragma unroll
            for (int k = 0; k < 4; ++k) { unsigned* o4 = (unsigned*)(xg + (size_t)s_slot[tl * 4 + k] * 2048) + lane;
#pragma unroll
                for (int j = 0; j < 8; ++j) o4[64 * j] = o[j]; } }
        __syncthreads();
    }
}

DI void moe_tables(Frame& F) {
    if (F.tid < 64) { const int e = F.tid & 31;
        const unsigned c = F.ctl[CW_CNT + 64 * e], mt = (c + 255u) >> 8;
        unsigned incl = mt;
#pragma unroll
        for (int o = 1; o < 32; o <<= 1) { const unsigned v = __shfl_up(incl, o, 64); if (e >= o) incl += v; }
        const unsigned base = incl - mt;
        if (F.tid < 32) { F.MISC[16 + e] = c; F.MISC[48 + e] = base; F.MISC[80 + e] = mt; if (e == 31) F.MISC[112] = incl;
            volatile LAS unsigned char* tab = (volatile LAS unsigned char*)(F.MISC + 128);
            for (unsigned t = 0; t < mt; ++t) tab[base + t] = (unsigned char)e; } }
    __syncthreads();
}
DI int ldsu(volatile LAS unsigned* p) { return __builtin_amdgcn_readfirstlane((int)*p); }
template <int NTN  >
struct SchedMoe {
    int G, c; const unsigned char* ws; volatile LAS unsigned* MISC; int total;
    DI bool next(int i, pg8::UnitD& u) const {
        const int L = i * G + c; if (L >= total) return false;
        const int e = __builtin_amdgcn_readfirstlane((int)((volatile LAS unsigned char*)(MISC + 128))[L / NTN]);
        const int tb = ldsu(MISC + 48 + e), mte = ldsu(MISC + 80 + e), cnt = ldsu(MISC + 16 + e);
        const int local = L - tb * NTN, nt = local / mte, mt = local % mte;
        u.type = 0; u.e = e; u.pn = nt; u.pm = tb + mt; u.x0 = mt; u.lda = 2048u; u.ldb = 128u;
        u.rows = nullptr; u.nvalid = cnt - mt * 256;
        if (NTN == 16) { u.A = (const char*)(ws + WS_XG) + ((size_t)e * 8192 + (size_t)mt * 256) * 2048;
            u.B = (const char*)(ws + WS_W1) + ((size_t)e * 4096 + (size_t)nt * 256) * 2048; }
        else { u.A = (const char*)(ws + WS_ACT) + ((size_t)e * 8192 + (size_t)mt * 256) * 2048;
            u.B = (const char*)(ws + WS_W2) + ((size_t)e * 2048 + (size_t)nt * 256) * 2048; }
        return true;
    }
};
struct EpiMoe1 {
    static constexpr bool AFTER_DRAIN = false;
    unsigned char* act; const float* b1;
    DI void operator()(const f32x4 (&acc)[2][2][4][2], const pg8::UnitD& u, int wr, int wc, int fr, int fq) const {
        { int ln_ = threadIdx.x; asm volatile("" : "+v"(ln_)); fr = ln_ & 15; fq = (ln_ >> 4) & 3; }
        const int j0 = u.pn * 128 + wc * 32 + 8 * fq;
        const float* bg = b1 + (size_t)u.e * 4096 + j0; const float* bu = bg + 2048;
        const f32x4 bg0 = *(const f32x4*)bg, bg1 = *(const f32x4*)(bg + 4), bu0 = *(const f32x4*)bu, bu1 = *(const f32x4*)(bu + 4);
#pragma unroll
        for (int ai = 0; ai < 2; ++ai)
#pragma unroll
            for (int m = 0; m < 4; ++m) { const size_t row = (size_t)u.e * 8192 + u.x0 * 256 + ai * 128 + wr * 64 + m * 16 + fr;
                float o[8];
#pragma unroll
                for (int n = 0; n < 2; ++n)
#pragma unroll
                    for (int e = 0; e < 4; ++e) { const float g = fminf(acc[ai][0][m][n][e] * (1.f / 256.f) + (n ? bg1[e] : bg0[e]), 7.f);
                        const float uu = fminf(fmaxf(acc[ai][1][m][n][e] * (1.f / 256.f) + (n ? bu1[e] : bu0[e]), -7.f), 7.f);
                        o[n * 4 + e] = g * __builtin_amdgcn_rcpf(1.f + __builtin_amdgcn_exp2f(g * (-1.702f * 1.4426950408889634f))) * (uu + 1.f) * 4.f; }
                u32x2 w; w.x = __builtin_amdgcn_cvt_pk_fp8_f32(o[0], o[1], 0u, false); w.x = __builtin_amdgcn_cvt_pk_fp8_f32(o[2], o[3], w.x, true);
                w.y = __builtin_amdgcn_cvt_pk_fp8_f32(o[4], o[5], 0u, false); w.y = __builtin_amdgcn_cvt_pk_fp8_f32(o[6], o[7], w.y, true);
                *(u32x2*)(act + row * 2048 + j0) = w;
                __builtin_amdgcn_sched_barrier(0); }
    }
};
struct EpiMoe2 {
    static constexpr bool AFTER_DRAIN = false;
    unsigned char* y; const float* b2; const float* gate_of;
    DI void operator()(const f32x4 (&acc)[2][2][4][2], const pg8::UnitD& u, int wr, int wc, int fr, int fq) const {
        { int ln_ = threadIdx.x; asm volatile("" : "+v"(ln_)); fr = ln_ & 15; fq = (ln_ >> 4) & 3; }
        const int col0 = u.pn * 256 + wc * 32 + 8 * fq;
        const float* bp = b2 + (size_t)u.e * 2048 + col0;
#pragma unroll
        for (int ai = 0; ai < 2; ++ai)
#pragma unroll
            for (int m = 0; m < 4; ++m) { const int rl = ai * 128 + wr * 64 + m * 16 + fr; const size_t row = (size_t)u.e * 8192 + u.x0 * 256 + rl;
                const float gt = (rl < u.nvalid) ? gate_of[u.e * 8192 + u.x0 * 256 + rl] * 32.f : 0.f;
#pragma unroll
                for (int bj = 0; bj < 2; ++bj) { const f32x4 v0 = (acc[ai][bj][m][0] * (1.f / 256.f) + *(const f32x4*)(bp + bj * 128)) * gt, v1 = (acc[ai][bj][m][1] * (1.f / 256.f) + *(const f32x4*)(bp + bj * 128 + 4)) * gt;
                    u32x2 w; w.x = __builtin_amdgcn_cvt_pk_fp8_f32(v0[0], v0[1], 0u, false); w.x = __builtin_amdgcn_cvt_pk_fp8_f32(v0[2], v0[3], w.x, true);
                    w.y = __builtin_amdgcn_cvt_pk_fp8_f32(v1[0], v1[1], 0u, false); w.y = __builtin_amdgcn_cvt_pk_fp8_f32(v1[2], v1[3], w.y, true);
                    *(u32x2*)(y + row * 2048 + col0 + bj * 128) = w; } }
    }
};

DI void p11_combine(Frame& F, const ArgP& a) {
    const int gw = F.vcu * NWAVES + F.wave, NGW = F.G * NWAVES, lane = F.lane;
    const bf16_t* h2 = (const bf16_t*)(F.ws + WS_H2); const unsigned char* y = (const unsigned char*)(F.ws + WS_Y);
    const int* tok_e = (const int*)(F.ws + WS_TOKE);
    for (int t = gw; t < NTOK; t += NGW) {
        size_t yrow[4];
#pragma unroll
        for (int k = 0; k < 4; ++k) yrow[k] = (size_t)tok_e[t * 4 + k] * 2048;
#pragma unroll
        for (int j = 0; j < 8; ++j) { const int c = (lane + 64 * j) * 4;
            const u32x2 hw = *(const u32x2*)(h2 + (size_t)t * 2048 + c); f32x4 v = {bflo(hw.x), bfhi(hw.x), bflo(hw.y), bfhi(hw.y)};
#pragma unroll
            for (int k = 0; k < 4; ++k) { const unsigned w = *(const unsigned*)(y + yrow[k] + c); const f32x2 lo = __builtin_amdgcn_cvt_pk_f32_fp8(w, false), hi = __builtin_amdgcn_cvt_pk_f32_fp8(w, true);
                v.x += lo.x * (1.f / 32.f); v.y += lo.y * (1.f / 32.f); v.z += hi.x * (1.f / 32.f); v.w += hi.y * (1.f / 32.f); }
            *(f32x4*)(a.out() + (size_t)t * 2048 + c) = v; }
    }
}

#ifndef MK_PER_PHASE
#define MK_PER_PHASE 0
#endif
#ifndef MK_LAST_PHASE
#define MK_LAST_PHASE 12
#endif
constexpr int N_PHASES = MK_LAST_PHASE;

__global__ void __launch_bounds__(NWAVES * 64, 2) mega_fwd(Args args_) {
    const ArgP args{};
    extern __shared__ __attribute__((aligned(16))) unsigned char lds_raw[];
    Frame F;
    F.lds = (LAS unsigned char*)lds_raw;
    F.MISC = (volatile LAS unsigned*)(F.lds + MISC_OFF);
    F.tid = threadIdx.x; F.lane = F.tid & 63; F.wave = __builtin_amdgcn_readfirstlane(F.tid >> 6);
    F.G = gridDim.x; { const int bx = blockIdx.x; F.vcu = (F.G % 8 == 0) ? (bx % 8) * (F.G / 8) + bx / 8 : bx; }
    F.ws = args_.ws; F.ctl = (unsigned*)(args_.ws + WS_CTL);
    for (int u = F.tid; u < 256; u += NWAVES * 64) F.MISC[u] = 0u;
    __syncthreads();
    XcdBarrier bar; bar.bar = F.ctl + CW_BAR; bar.x = 0; bar.st = nullptr;
    const int lo = args_.ph_lo, hi = args_.ph_hi;
    if (hi - lo > 1) bar = xcd_barrier_post(F.ctl + CW_BAR, F.MISC + 8);
#ifndef MK_PHASE_MASK
#define MK_PHASE_MASK 0xFFFF
#endif
#define IN(k) (((MK_PHASE_MASK >> (k)) & 1) && lo <= (k) && (k) < hi)
#define SEAM(k) do { if (IN(k) && IN((k) + 1)) xcd_barrier(bar); } while (0)
#define FRESH() do { int t_ = threadIdx.x; asm volatile("" : "+v"(t_)); F.tid = t_; F.lane = t_ & 63; F.wave = __builtin_amdgcn_readfirstlane(t_ >> 6); } while (0)
    unsigned char* ws = args_.ws;

    if (IN(0)) { FRESH(); p0_prologue(F, args); }
    SEAM(0);
    if (IN(1)) { FRESH();
        const bool conv_first = (F.vcu & 1) == 0;
        if (conv_first) { conv_share(F, args); __syncthreads(); }
        SchedP1 S{F.G, F.vcu, ws, 0, 32 * 23};
        EpiP1 E{(bf16_t*)(ws + WS_PROJ), (float*)(ws + WS_DT), (bf16_t*)(ws + WS_KVRAW), args.in(I_DAQG), args.in(I_DAKG), (unsigned char*)(ws + WS_VF8)};
        pg8::gemm_phase<EpiP1, SchedP1, false, true>(F.lds + RING_OFF, 32, S, E);
        if (!conv_first) { __syncthreads(); conv_share(F, args); }
    }
    SEAM(1);
    if (IN(2)) { FRESH();
        if ((F.vcu & 3) == 1) {
            SchedP1 S{(F.G + 3) >> 2, F.vcu >> 2, ws, 32 * 23, 32 * 23 + 64};
            EpiP1 E{(bf16_t*)(ws + WS_PROJ), (float*)(ws + WS_DT), (bf16_t*)(ws + WS_KVRAW), args.in(I_DAQG), args.in(I_DAKG), (unsigned char*)(ws + WS_VF8)};
            pg8::gemm_phase<EpiP1, SchedP1, false, true>(F.lds + RING_OFF, 32, S, E);
            __syncthreads();
        }
        if ((F.vcu & 3) == 0) { for (int u = F.vcu >> 2; u < 64; u += (F.G + 3) >> 2) ssd_unit(F, args, u >> 4, u & 15); }
        __syncthreads();
        attn_phase_da(F);
        __syncthreads();
        conv_queue(F, args, CW_QCONV, CV_NJ - CV_TAIL, CV_TAIL1);
    }
    SEAM(2);
    if (IN(3)) { FRESH(); kprep(F, args); p3_finalize(F, args); }
    SEAM(3);
    if (IN(4)) { FRESH();
        SchedDense S{F.G, F.vcu, 32, 8, (const char*)(ws + WS_YCAT), (const char*)(ws + WS_WOUT), 4096u, 4096u, 1 << 30, 0};
        EpiResid<false> E{args.in(I_X), (bf16_t*)(ws + WS_H1), (float*)(ws + WS_PART1), (unsigned char*)(ws + WS_H1F8), 1.f};
        pg8::gemm_phase<EpiResid<false>, SchedDense, false, true>(F.lds + RING_OFF, 32, S, E);
    }
    SEAM(4);
    if (IN(5)) { FRESH();
        SchedDense S{F.G, F.vcu, 32, 8, (const char*)(ws + WS_H1F8), (const char*)(ws + WS_WQ), 2048u, 2048u, 1 << 30, 0};
        EpiQ E{(unsigned char*)(ws + WS_QF8), (float*)(ws + WS_PARTQ)};
        pg8::gemm_phase<EpiQ, SchedDense, false, true, true>(F.lds + RING_OFF, 16, S, E);
    }
    SEAM(5);
    if (IN(6)) { FRESH();
        SchedXS S{F.G, F.vcu, ws};
        EpiXS E{(unsigned char*)(ws + WS_P8), (unsigned char*)(ws + WS_VWT8), (const float*)(ws + WS_PART1), (const float*)(ws + WS_PARTQ), (LAS float*)(F.lds + RING_BYTES)};
        pg8::gemm_phase<EpiXS, SchedXS, false, true, true>(F.lds + RING_OFF, 4, S, E);
    }
    SEAM(6);
    if (IN(7)) { FRESH();
        SchedDense S{F.G, F.vcu, 32, 8, (const char*)(ws + WS_P8), (const char*)(ws + WS_VWT8), 1024u, 1024u, 8, (size_t)2048 * 1024};
        EpiResid<true> E{(const void*)(ws + WS_H1), (bf16_t*)(ws + WS_H2), nullptr, nullptr, 1.f / 8192.f};
        pg8::gemm_phase<EpiResid<true>, SchedDense, false, true, true>(F.lds + RING_OFF, 8, S, E);
    }
    SEAM(7);
    if (IN(8)) { FRESH(); p8_route(F, args); }
    SEAM(8);
    if (IN(9)) { FRESH();
        moe_tables(F);
        SchedMoe<16> S{F.G, F.vcu, ws, F.MISC, ldsu(F.MISC + 112) * 16};
        EpiMoe1 E{(unsigned char*)(ws + WS_ACT), args.in(I_B1)};
        pg8::gemm_phase<EpiMoe1, SchedMoe<16>, false, true, true>(F.lds + RING_OFF, 16, S, E);
        __syncthreads();
        conv_queue(F, args, CW_QCONV2, CV_NJ - CV_TAIL2, CV_TAIL2);
    }
    SEAM(9);
    if (IN(10)) { FRESH();
        moe_tables(F);
        SchedMoe<8> S{F.G, F.vcu, ws, F.MISC, ldsu(F.MISC + 112) * 8};
        EpiMoe2 E{(unsigned char*)(ws + WS_Y), args.in(I_B2), (const float*)(ws + WS_GATEOF)};
        pg8::gemm_phase<EpiMoe2, SchedMoe<8>, false, true, true>(F.lds + RING_OFF, 16, S, E);
    }
    SEAM(10);
    if (IN(11)) { FRESH(); p11_combine(F, args); }
#undef IN
#undef SEAM
}

extern "C" void kernel_launch(void* const* d_in, const int* in_sizes, int n_in, void* d_out, int out_size, void* d_ws, size_t ws_size, hipStream_t stream) {
    static int grid = 0;
    if (grid == 0) {
        if (n_in != 32 || out_size != NTOK * 2048 || ws_size < WS_END) { fprintf(stderr, "kernel_launch: unexpected shapes (n_in %d out %d ws %zu); nothing launched\n", n_in, out_size, ws_size); grid = -1; return; }
        int dev = 0, cus = 0, per_cu = 0;
        if (hipGetDevice(&dev) != hipSuccess || hipDeviceGetAttribute(&cus, hipDeviceAttributeMultiprocessorCount, dev) != hipSuccess) { grid = -1; return; }
        if (hipFuncSetAttribute((const void*)mega_fwd, hipFuncAttributeMaxDynamicSharedMemorySize, LDS_BYTES) != hipSuccess) { fprintf(stderr, "kernel_launch: hipFuncSetAttribute failed\n"); grid = -1; return; }
        if (hipOccupancyMaxActiveBlocksPerMultiprocessor(&per_cu, (const void*)mega_fwd, NWAVES * 64, LDS_BYTES) != hipSuccess || per_cu < 1) { fprintf(stderr, "kernel_launch: occupancy query says %d\n", per_cu); }
        (void)hipGetLastError();
        if (cus < 256) { fprintf(stderr, "kernel_launch: needs 256 CUs, found %d; nothing launched\n", cus); grid = -1; return; }
        grid = 256;
    }
    if (grid < 0) return;
    if (hipMemsetAsync((char*)d_ws + WS_CTL, 0, CTL_ZERO_BYTES, stream) != hipSuccess) return;
    Args a{};
    for (int i = 0; i < 32; ++i) a.in[i] = (const float*)d_in[i];
    a.out = (float*)d_out; a.ws = (unsigned char*)d_ws;
#if MK_PER_PHASE
    for (int p = 0; p < N_PHASES; ++p) { a.ph_lo = p; a.ph_hi = p + 1; hipLaunchKernelGGL(mega_fwd, dim3(grid), dim3(NWAVES * 64), LDS_BYTES, stream, a); }
#else
    a.ph_lo = 0; a.ph_hi = N_PHASES;
    hipLaunchKernelGGL(mega_fwd, dim3(grid), dim3(NWAVES * 64), LDS_BYTES, stream, a);
#ifdef MK_PROBE_LO
    for (int p = MK_PROBE_LO; p < MK_PROBE_HI; ++p) { a.ph_lo = p; a.ph_hi = p + 1;
#ifdef MK_HOTPROBE
        a.probe = MK_HOTPROBE;
#endif
        if (p == 2) (void)hipMemsetAsync((char*)d_ws + WS_CTL + CW_QATT * 4, 0, 1024, stream);
        hipLaunchKernelGGL(mega_fwd, dim3(grid), dim3(NWAVES * 64), LDS_BYTES, stream, a); }
#endif
#endif
}
```

```cpp
#define MK_PER_PHASE 0
#define MK_LAST_PHASE 12
#include <hip/hip_runtime.h>
#include <hip/hip_bf16.h>
#include <cstdio>
#include <cstdint>
#include <cmath>

#define GAS __attribute__((address_space(1)))
#define LAS __attribute__((address_space(3)))
typedef unsigned short bf16_t;
typedef short bf16x8 __attribute__((ext_vector_type(8)));
typedef float f32x2 __attribute__((ext_vector_type(2)));
typedef float f32x4 __attribute__((ext_vector_type(4)));
typedef float f32x16 __attribute__((ext_vector_type(16)));
typedef unsigned u32x2 __attribute__((ext_vector_type(2)));
typedef unsigned u32x4 __attribute__((ext_vector_type(4)));
typedef __bf16 bf16x2_t __attribute__((ext_vector_type(2)));

#define DI __device__ __forceinline__
DI unsigned pk2(float lo, float hi) { f32x2 v = {lo, hi}; bf16x2_t b = __builtin_convertvector(v, bf16x2_t); return __builtin_bit_cast(unsigned, b); }
DI float bflo(unsigned u) { return __uint_as_float(u << 16); }
DI float bfhi(unsigned u) { return __uint_as_float(u & 0xffff0000u); }
DI float bf2f(bf16_t h) { return __uint_as_float(((unsigned)h) << 16); }
DI float wave_sum(float v) {
#pragma unroll
    for (int o = 1; o < 64; o <<= 1) v += __shfl_xor(v, o);
    return v;
}
DI float quad_sum_16_32(float v) {
    int l_ = threadIdx.x; asm volatile("" : "+v"(l_));
    const int a16 = ((l_ ^ 16) & 63) << 2, a32 = ((l_ ^ 32) & 63) << 2;
    v += __builtin_bit_cast(float, __builtin_amdgcn_ds_bpermute(a16, __builtin_bit_cast(int, v)));
    v += __builtin_bit_cast(float, __builtin_amdgcn_ds_bpermute(a32, __builtin_bit_cast(int, v)));
    return v;
}
DI float siluf(float x) { return x / (1.f + __expf(-x)); }

constexpr int DM_ = 2048, NB = 4, SEQ_ = 2048, NTOK = NB * SEQ_;
constexpr int PP = 5632;
constexpr int PC_XBC = 1024, PC_Q = 2560, PC_K = 3584, PC_V = 4608, PC_DT = 5632;
constexpr int WIN_ROWS = 5888;
constexpr int NEXP = 32, MEMLEN = 256;
constexpr float EPS_ = 1e-6f;
constexpr float LAM_INIT = 0.2f;

namespace pg8 {
constexpr int BM = 256, BK = 64, HALF = 128, HTB = HALF * BK * 2  , STAGE_BYTES = 8 * HTB;
DI int lds_byte(int r, int c) { const int st = (r >> 4) * 2 + (c >> 5), rr = r & 15, cc = c & 31, ob = rr * 64 + cc * 2; return st * 1024 + (ob ^ (((ob >> 9) & 1) << 5)); }
DI void stage_rc(int b, int& R, int& C) { const int st = b / 1024, sb = b % 1024, swz = sb ^ (((sb >> 9) & 1) << 5); R = (st >> 1) * 16 + swz / 64; C = (st & 1) * 32 + (swz % 64) / 2; }
DI int perm32(int rho) { const int n = rho >> 4, i = rho & 15; return 8 * (i >> 2) + 4 * n + (i & 3); }

struct UnitD {
    const char* A; const char* B;
    const int* rows;
    unsigned lda, ldb;
    int nvalid;
    int type, pm, pn, e, x0;
};
typedef int v8i_t __attribute__((ext_vector_type(8)));
DI v8i_t cat8(bf16x8 lo, bf16x8 hi) { typedef int v4i_t __attribute__((ext_vector_type(4))); const v4i_t a = __builtin_bit_cast(v4i_t, lo), b = __builtin_bit_cast(v4i_t, hi); return (v8i_t){a[0], a[1], a[2], a[3], b[0], b[1], b[2], b[3]}; }
DI void dense_voff(unsigned lda, unsigned ldb, int tid, unsigned (&vA)[2], unsigned (&vB)[2]) {
#pragma unroll
    for (int i = 0; i < 2; ++i) { int R, C; stage_rc(tid * 16 + i * 8192, R, C); const int Rb = (R & ~31) + perm32(R & 31);
        vA[i] = (unsigned)R * lda + (unsigned)C * 2u; vB[i] = (unsigned)Rb * ldb + (unsigned)C * 2u; }
}
DI void gather_voff(const UnitD& u, int tid, unsigned (&gA)[2][2]) {
#pragma unroll
    for (int i = 0; i < 2; ++i) { int R, C; stage_rc(tid * 16 + i * 8192, R, C);
#pragma unroll
        for (int h = 0; h < 2; ++h) { const int ra = h * 128 + R; const unsigned rowA = (ra < u.nvalid) ? (unsigned)u.rows[ra] : 0u; gA[h][i] = rowA * u.lda + (unsigned)C * 2u; } }
}

template <class Epi, class Sched, bool GATHER, bool ALIGN_EPI, bool FP8 = false>
DI void gemm_phase(LAS unsigned char* lds, int nt, const Sched& S, const Epi& E) {

    const int tid = threadIdx.x, wid = __builtin_amdgcn_readfirstlane(tid >> 6), lane = tid & 63, wr = wid >> 2, wc = wid & 3, fr = lane & 15, fq = lane >> 4;
#ifndef MK_HOTPROBE
#define PG8_NODMA false
#define PG8_NOMMA false
#define PG8_NOLD false
#define PG8_NOEPI false
#define PG8_NOLOOP false
#else
#define PG8_NODMA ((hot_ & 4) != 0)
#define PG8_NOMMA ((hot_ & 8) != 0)
#define PG8_NOLD ((hot_ & 16) != 0)
#define PG8_NOEPI ((hot_ & 32) != 0)
#define PG8_NOLOOP ((hot_ & 64) != 0)
#endif
#ifdef MK_HOTPROBE
    int hot_; { typedef const __attribute__((address_space(4))) char* kptr; kptr kp = (kptr)__builtin_amdgcn_kernarg_segment_ptr(); asm volatile("" : "+s"(kp)); hot_ = *(const int __attribute__((address_space(4)))*)(kp + 280); }
    const size_t kstep = (hot_ & 1) ? (size_t)0 : (size_t)(BK * 2);
#else
    const size_t kstep = (size_t)(BK * 2);
#endif
    const unsigned ldsb = (unsigned)__builtin_amdgcn_readfirstlane((int)((unsigned)(uintptr_t)lds + (unsigned)wid * 1024u));
    const int aoff = lds_byte(wr * 64 + fr, fq * 8), boff = lds_byte(wc * 32 + fr, fq * 8);
#define PG8_SA(b, h) (((b) * 2 + (h)) * HTB)
#define PG8_SB(b, h) ((4 + (b) * 2 + (h)) * HTB)
#define PG8_STAGE(bufoff, gbase, voff) do { if (PG8_NODMA) break; _Pragma("unroll") for (int _i = 0; _i < 2; ++_i) { unsigned keep_; \
        asm volatile("s_mov_b32 %0, m0\n\ts_mov_b32 m0, %3\n\ts_nop 0\n\tglobal_load_lds_dwordx4 %1, %2\n\ts_mov_b32 m0, %0" \
                     : "=&s"(keep_) : "v"((voff)[_i]), "s"((const char*)(gbase)), "s"(ldsb + (unsigned)((bufoff) + _i * 8192)) : "memory"); } } while (0)
#define PG8_STA(bufoff, gbase, h, HS, GA) do { if constexpr (GATHER) { PG8_STAGE(bufoff, gbase, GA[h]); } else { PG8_STAGE(bufoff, (gbase) + (h) * (HS), vA); } } while (0)
#define PG8_STB(bufoff, gbase, h, HS) PG8_STAGE(bufoff, (gbase) + (h) * (HS), vB)
typedef int v4i_t __attribute__((ext_vector_type(4)));
#define PG8_LDA(dst, b, h) do { if (PG8_NOLD) break; _Pragma("unroll") for (int m = 0; m < 4; ++m) { if constexpr (FP8) { \
            const v4i_t lo_ = *(const LAS v4i_t*)(lds + PG8_SA(b, h) + aoff + m * 2048), hi_ = *(const LAS v4i_t*)(lds + PG8_SA(b, h) + aoff + m * 2048 + 1024); \
            dst##8[m] = __builtin_shufflevector(lo_, hi_, 0, 1, 2, 3, 4, 5, 6, 7); } \
        else { _Pragma("unroll") for (int k = 0; k < 2; ++k) dst[m][k] = *(const LAS bf16x8*)(lds + PG8_SA(b, h) + aoff + m * 2048 + k * 1024); } } } while (0)
#define PG8_LDB(dst, b, h) do { if (PG8_NOLD) break; _Pragma("unroll") for (int n = 0; n < 2; ++n) { if constexpr (FP8) { \
            const v4i_t lo_ = *(const LAS v4i_t*)(lds + PG8_SB(b, h) + boff + n * 2048), hi_ = *(const LAS v4i_t*)(lds + PG8_SB(b, h) + boff + n * 2048 + 1024); \
            dst##8[n] = __builtin_shufflevector(lo_, hi_, 0, 1, 2, 3, 4, 5, 6, 7); } \
        else { _Pragma("unroll") for (int k = 0; k < 2; ++k) dst[n][k] = *(const LAS bf16x8*)(lds + PG8_SB(b, h) + boff + n * 2048 + k * 1024); } } } while (0)
#ifndef PG8_FP8_PRIO
#define PG8_FP8_PRIO 1
#endif
#define PG8_MMA(ai, bj, At, Bt) do { if (PG8_NOMMA) break; if (!FP8 || PG8_FP8_PRIO) __builtin_amdgcn_s_setprio(1); _Pragma("unroll") for (int m = 0; m < 4; ++m) _Pragma("unroll") for (int n = 0; n < 2; ++n) { \
        if constexpr (FP8) { acc[ai][bj][m][n] = __builtin_amdgcn_mfma_scale_f32_16x16x128_f8f6f4(Bt##8[n], At##8[m], acc[ai][bj][m][n], 0, 0, 0, 0x7f7f7f7f, 0, 0x7f7f7f7f); } \
        else { _Pragma("unroll") for (int k = 0; k < 2; ++k) acc[ai][bj][m][n] = __builtin_amdgcn_mfma_f32_16x16x32_bf16(Bt[n][k], At[m][k], acc[ai][bj][m][n], 0, 0, 0); } } \
        if (!FP8 || PG8_FP8_PRIO) __builtin_amdgcn_s_setprio(0); } while (0)
#define PG8_WAIT_V(n) asm volatile("s_waitcnt vmcnt(" #n ")" ::: "memory")
#define PG8_WAIT_L(n) asm volatile("s_waitcnt lgkmcnt(" #n ")" ::: "memory")
#define PG8_BAR __builtin_amdgcn_s_barrier()
#define PG8_SCHED __builtin_amdgcn_sched_barrier(0)
#define PG8_ITER(A1P, A2P, B2P, HA2, HB2, GA2) do { \
        const char* a3p_ = (A2P) + kstep; const char* b3p_ = (B2P) + kstepB; \
        PG8_LDB(B0, 0, 0); PG8_LDB(B1, 0, 1); PG8_SCHED; PG8_LDA(At, 0, 0); PG8_STA(PG8_SA(1, 1), (A1P), 1, hsA, gA); \
        PG8_WAIT_V(8); PG8_WAIT_L(0); PG8_BAR; PG8_MMA(0, 0, At, B0); PG8_MMA(0, 1, At, B1); PG8_BAR; PG8_SCHED; \
        PG8_LDA(At, 0, 1); PG8_STB(PG8_SB(0, 0), (B2P), 0, HB2); PG8_STB(PG8_SB(0, 1), (B2P), 1, HB2); PG8_STA(PG8_SA(0, 0), (A2P), 0, HA2, GA2); \
        PG8_WAIT_V(8); PG8_WAIT_L(0); PG8_BAR; PG8_MMA(1, 0, At, B0); PG8_MMA(1, 1, At, B1); PG8_BAR; PG8_SCHED; \
        PG8_LDB(B0, 1, 0); PG8_LDB(B1, 1, 1); PG8_SCHED; PG8_LDA(At, 1, 0); PG8_STA(PG8_SA(0, 1), (A2P), 1, HA2, GA2); \
        PG8_WAIT_V(8); PG8_WAIT_L(0); PG8_BAR; PG8_MMA(0, 0, At, B0); PG8_MMA(0, 1, At, B1); PG8_BAR; PG8_SCHED; \
        PG8_LDA(At, 1, 1); PG8_STB(PG8_SB(1, 0), b3p_, 0, HB2); PG8_STB(PG8_SB(1, 1), b3p_, 1, HB2); PG8_STA(PG8_SA(1, 0), a3p_, 0, HA2, GA2); \
        PG8_WAIT_V(8); PG8_WAIT_L(0); PG8_BAR; PG8_MMA(1, 0, At, B0); PG8_MMA(1, 1, At, B1); PG8_BAR; PG8_SCHED; \
    } while (0)
    UnitD cur, nxt; int ui = 0;
    if (!S.next(0, cur)) return;
    f32x4 acc[2][2][4][2];
#pragma unroll
    for (int a = 0; a < 2; ++a)
#pragma unroll
        for (int b = 0; b < 2; ++b)
#pragma unroll
            for (int m = 0; m < 4; ++m)
#pragma unroll
                for (int n = 0; n < 2; ++n) acc[a][b][m][n] = (f32x4){0.f, 0.f, 0.f, 0.f};
    bf16x8 At[4][2], B0[2][2], B1[2][2]; v8i_t At8[4], B08[2], B18[2];
    unsigned vA[2], vB[2], gA[2][2], ngA[2][2];
    dense_voff(cur.lda, cur.ldb, tid, vA, vB);
#ifdef MK_HOTPROBE
    const size_t kstepB = (hot_ & 2) ? (size_t)0 : ((cur.ldb == 128u) ? (size_t)32768 : (size_t)(BK * 2));
#else
    const size_t kstepB = (cur.ldb == 128u) ? (size_t)32768 : kstep;
#endif
    if constexpr (GATHER) gather_voff(cur, tid, gA);
    const char* cA = cur.A; const char* cB = cur.B;
    size_t hsA = GATHER ? 0 : (size_t)cur.lda * HALF, hsB = (size_t)cur.ldb * HALF;
    PG8_STB(PG8_SB(0, 0), cB, 0, hsB); PG8_STB(PG8_SB(0, 1), cB, 1, hsB); PG8_STA(PG8_SA(0, 0), cA, 0, hsA, gA); PG8_STA(PG8_SA(0, 1), cA, 1, hsA, gA);
    if (wr == 1) PG8_BAR;
    PG8_WAIT_V(2); PG8_BAR;
    PG8_STB(PG8_SB(1, 0), cB + kstepB, 0, hsB); PG8_STA(PG8_SA(1, 0), cA + kstep, 0, hsA, gA); PG8_STB(PG8_SB(1, 1), cB + kstepB, 1, hsB);
    PG8_WAIT_V(6); PG8_BAR;
    for (;;) {
        const bool has_next = S.next(ui + 1, nxt);
        const char* nA = cA; const char* nB = cB; size_t nhsA = hsA, nhsB = hsB;
        if (has_next) { nA = nxt.A; nB = nxt.B; nhsA = GATHER ? 0 : (size_t)nxt.lda * HALF; nhsB = (size_t)nxt.ldb * HALF; }
        if constexpr (GATHER) {
            if (has_next) gather_voff(nxt, tid, ngA);
            else {
#pragma unroll
                for (int h = 0; h < 2; ++h)
#pragma unroll
                    for (int i = 0; i < 2; ++i) ngA[h][i] = gA[h][i];
            }
        }
#pragma unroll 1
        for (int t = 0; t < (PG8_NOLOOP ? 0 : nt); t += 2) {
            const bool last = (t == nt - 2);
            const char* a2 = last ? nA : cA + (size_t)(t + 2) * kstep; const char* b2 = last ? nB : cB + (size_t)(t + 2) * kstepB;
            const size_t hA2 = last ? nhsA : hsA, hB2 = last ? nhsB : hsB;
            unsigned g2[2][2];
            if constexpr (GATHER) {
#pragma unroll
                for (int h = 0; h < 2; ++h)
#pragma unroll
                    for (int i = 0; i < 2; ++i) g2[h][i] = last ? ngA[h][i] : gA[h][i];
            }
            PG8_ITER(cA + (size_t)(t + 1) * kstep, a2, b2, hA2, hB2, g2);
        }
        if constexpr (ALIGN_EPI) { if (wr == 0) PG8_BAR; }
        if constexpr (!Epi::AFTER_DRAIN) { if (!PG8_NOEPI) E(acc, cur, wr, wc, fr, fq); }
        if (!has_next) break;
#pragma unroll
        for (int a = 0; a < 2; ++a)
#pragma unroll
            for (int b = 0; b < 2; ++b)
#pragma unroll
                for (int m = 0; m < 4; ++m)
#pragma unroll
                    for (int n = 0; n < 2; ++n) acc[a][b][m][n] = (f32x4){0.f, 0.f, 0.f, 0.f};
        cur = nxt; cA = nA; cB = nB; hsA = nhsA; hsB = nhsB; ++ui;
        if constexpr (GATHER) {
#pragma unroll
            for (int h = 0; h < 2; ++h)
#pragma unroll
                for (int i = 0; i < 2; ++i) gA[h][i] = ngA[h][i];
        }
        if constexpr (ALIGN_EPI) { if (wr == 1) PG8_BAR; }
    }
    PG8_WAIT_V(0);
    if constexpr (!ALIGN_EPI) { if (wr == 0) PG8_BAR; }
    PG8_BAR;
    if constexpr (Epi::AFTER_DRAIN) { E.fused(acc, cur, wr, wc, fr, fq, lds, wid, lane); }
#undef PG8_SA
#undef PG8_SB
#undef PG8_STAGE
#undef PG8_STA
#undef PG8_STB
#undef PG8_LDA
#undef PG8_LDB
#undef PG8_MMA
#undef PG8_WAIT_V
#undef PG8_WAIT_L
#undef PG8_BAR
#undef PG8_SCHED
#undef PG8_ITER
}
}
namespace attn_body {
using bf16=__hip_bfloat16;
using bf16x8=__attribute__((ext_vector_type(8)))short;
using s16x4=__attribute__((ext_vector_type(4)))short;
using f32x16=__attribute__((ext_vector_type(16)))float;
using u32x4=__attribute__((ext_vector_type(4)))unsigned;
constexpr int BATCH=4,SEQ=2048,D=64,DM=5632,OPITCH=1024;
constexpr int NW=8,QBLK=32,QB=QBLK*NW,KVBLK=64,NQB=SEQ/QB;
constexpr int ATTN_UNIT_ROWS=QB;
__device__ __forceinline__ int crow(int r,int hi){return (r&3)+8*(r>>2)+4*hi;}
#define SBAR() __builtin_amdgcn_sched_barrier(0)
__device__ __forceinline__ void cmask(f32x16&p0,f32x16&p1,int jb,int qrel,int hi){
  const float NEG=-INFINITY; int kb=64*jb+4*hi;
  #pragma unroll
  for(int r=0;r<16;++r){int kv=kb+(r&3)+8*(r>>2); if(kv>qrel)p0[r]=NEG; if(kv+32>qrel)p1[r]=NEG;}
}

constexpr int NSLOT=3, SLOTB=8192;
constexpr int LDS_K=0, LDS_V=NSLOT*SLOTB, LDS_WS=2*NSLOT*SLOTB, LDS_OST=LDS_WS+NW*64*4, LDS_BYTES=LDS_OST+NW*4096;
constexpr float C2=0.125f*1.4426950408889634f;
__device__ __forceinline__ void glds16(const void*gsrc,unsigned lds_dst){unsigned keep;
  asm volatile("s_mov_b32 %0, m0\n\ts_mov_b32 m0, %2\n\ts_nop 0\n\tglobal_load_lds_dwordx4 %1, off\n\ts_mov_b32 m0, %0":"=&s"(keep):"v"(gsrc),"s"(lds_dst):"memory");}
__device__ __forceinline__ float max3f(float a,float b,float c){float r;asm("v_max3_f32 %0, %1, %2, %3":"=v"(r):"v"(a),"v"(b),"v"(c));return r;}
__device__ __forceinline__ float max2f(float a,float b){float r;asm("v_max_f32_e32 %0, %1, %2":"=v"(r):"v"(a),"v"(b));return r;}
__device__ __forceinline__ float fadd_s(float a,float b){float r;asm("v_add_f32_e32 %0, %1, %2":"=v"(r):"v"(a),"v"(b));return r;}
__device__ __forceinline__ float fsub_s(float a,float b){float r;asm("v_sub_f32_e32 %0, %1, %2":"=v"(r):"v"(a),"v"(b));return r;}
typedef float f32x2_t __attribute__((ext_vector_type(2))); typedef __bf16 bf16x2_t __attribute__((ext_vector_type(2)));
__device__ __forceinline__ unsigned cvtpk_s(float lo,float hi){f32x2_t v={lo,hi};bf16x2_t b=__builtin_convertvector(v,bf16x2_t);return __builtin_bit_cast(unsigned,b);}
#define WAIT_BAR(N) asm volatile("s_waitcnt vmcnt(" #N ") lgkmcnt(0)\n\ts_barrier":::"memory")

__device__ __forceinline__ void qkt(f32x16&p0,f32x16&p1,const char*Kslot,const bf16x8*qr,const f32x16&negm,int r32,int hi){
  const char*kb=Kslot+hi*1024+r32*16;
  #pragma unroll
  for(int d0=0;d0<4;++d0){
    const bf16x8 b0=*reinterpret_cast<const bf16x8*>(kb+d0*2048);
    const bf16x8 b1=*reinterpret_cast<const bf16x8*>(kb+d0*2048+512);
    if(d0==0){p0=__builtin_amdgcn_mfma_f32_32x32x16_bf16(b0,qr[0],negm,0,0,0);p1=__builtin_amdgcn_mfma_f32_32x32x16_bf16(b1,qr[0],negm,0,0,0);}
    else{p0=__builtin_amdgcn_mfma_f32_32x32x16_bf16(b0,qr[d0],p0,0,0,0);p1=__builtin_amdgcn_mfma_f32_32x32x16_bf16(b1,qr[d0],p1,0,0,0);}}
}
typedef __attribute__((address_space(3))) const char* lds_cptr;
typedef short v4i16_t __attribute__((ext_vector_type(4)));
__device__ __forceinline__ void kload8(bf16x8*kf,lds_cptr kp){
  kf[0]=*(const __attribute__((address_space(3))) bf16x8*)(kp);      kf[1]=*(const __attribute__((address_space(3))) bf16x8*)(kp+512);
  kf[2]=*(const __attribute__((address_space(3))) bf16x8*)(kp+2048); kf[3]=*(const __attribute__((address_space(3))) bf16x8*)(kp+2560);
  kf[4]=*(const __attribute__((address_space(3))) bf16x8*)(kp+4096); kf[5]=*(const __attribute__((address_space(3))) bf16x8*)(kp+4608);
  kf[6]=*(const __attribute__((address_space(3))) bf16x8*)(kp+6144); kf[7]=*(const __attribute__((address_space(3))) bf16x8*)(kp+6656);
}
__device__ __forceinline__ void kload2(bf16x8*kf,lds_cptr kp,int j){ kf[2*j]=*(const __attribute__((address_space(3))) bf16x8*)(kp+j*2048); kf[2*j+1]=*(const __attribute__((address_space(3))) bf16x8*)(kp+j*2048+512); }
__device__ __forceinline__ s16x4 vtr(lds_cptr p){ return __builtin_bit_cast(s16x4,__builtin_amdgcn_ds_read_tr16_b64_v4i16((__attribute__((address_space(3))) v4i16_t*)p)); }
__device__ __forceinline__ float rowmax(const f32x16&p0,const f32x16&p1){
  float a=max3f(p0[0],p0[1],p1[0]),b=max3f(p0[2],p0[3],p1[1]);a=max3f(a,p1[2],p1[3]);
  #pragma unroll
  for(int r=4;r<16;r+=4){a=max3f(a,p0[r],p0[r+1]);b=max3f(b,p0[r+2],p0[r+3]);a=max3f(a,p1[r],p1[r+1]);b=max3f(b,p1[r+2],p1[r+3]);}
  const float m=max2f(a,b);
  auto rr=__builtin_amdgcn_permlane32_swap(__float_as_uint(m),__float_as_uint(m),false,false);
  return max2f(__uint_as_float(rr[0]),__uint_as_float(rr[1]));
}
__device__ __forceinline__ void pv(f32x16*o,int vb,bf16x8 pa0,bf16x8 pa1,bf16x8 pa2,bf16x8 pa3){
  #pragma unroll
  for(int d0=0;d0<2;++d0){s16x4 lo[4],hi[4];
    #pragma unroll
    for(int ks=0;ks<4;++ks){
      asm volatile("ds_read_b64_tr_b16 %0,%1 offset:%c2":"=&v"(lo[ks]):"v"(vb),"i"(d0*4096+ks*1024):"memory");
      asm volatile("ds_read_b64_tr_b16 %0,%1 offset:%c2":"=&v"(hi[ks]):"v"(vb),"i"(d0*4096+ks*1024+512):"memory");}
    asm volatile("s_waitcnt lgkmcnt(0)":::"memory");SBAR();
    #define PK(k) (bf16x8){lo[k][0],lo[k][1],lo[k][2],lo[k][3],hi[k][0],hi[k][1],hi[k][2],hi[k][3]}
    o[d0]=__builtin_amdgcn_mfma_f32_32x32x16_bf16(pa0,PK(0),o[d0],0,0,0);
    o[d0]=__builtin_amdgcn_mfma_f32_32x32x16_bf16(pa1,PK(1),o[d0],0,0,0);
    o[d0]=__builtin_amdgcn_mfma_f32_32x32x16_bf16(pa2,PK(2),o[d0],0,0,0);
    o[d0]=__builtin_amdgcn_mfma_f32_32x32x16_bf16(pa3,PK(3),o[d0],0,0,0);
    #undef PK
  }
}

#ifndef ATTN_STORE16
#define ATTN_STORE16(p,v) (*(u32x4*)(p)=(v))
#endif
template<int THRL> __device__ __forceinline__ void attn_unit(int b,int qcol,int vcol,int ocol,int qb,const bf16*Q,const bf16*__restrict__ K,const bf16*__restrict__ V,bf16*O,char*shm,unsigned*qctr,unsigned&ticket){
  const int tid=threadIdx.x,lane=tid&63,r32=lane&31,hi=lane>>5; const int wid=__builtin_amdgcn_readfirstlane(tid>>6);
  const long rowbase=(long)b*SEQ; const int q0=qb*QB;
  const bf16*Qw=Q+(rowbase+q0+wid*QBLK)*DM+qcol;
  const bf16*Kh=K+rowbase*DM+qcol,*Vh=V+rowbase*DM+vcol;
  const unsigned lds0=(unsigned)(uintptr_t)shm;
  float*wsf=(float*)(shm+LDS_WS)+wid*64;
  const bf16*ksrc=Kh+(long)lane*DM+wid*8;
  const bf16*vsrc=Vh+(long)(16*(wid&3)+(lane>>2))*DM+(wid>>2)*32+(lane&3)*8;
  const unsigned kdst=lds0+LDS_K+wid*1024, vdst=lds0+LDS_V+wid*1024;
  #define DMA_K(t,slot) glds16(ksrc+(long)(t)*KVBLK*DM,(unsigned)__builtin_amdgcn_readfirstlane(kdst+(slot)))
  #define DMA_V(t,slot) glds16(vsrc+(long)(t)*KVBLK*DM,(unsigned)__builtin_amdgcn_readfirstlane(vdst+(slot)))
  const int vb0=(int)(lds0+LDS_V)+((lane>>4)&1)*32+(lane&3)*8+(4*hi+((lane&15)>>2))*64;
  const char*Kbase=shm+LDS_K; bf16x8 kf[8];
  const lds_cptr shm3=(lds_cptr)shm; const lds_cptr kp0=shm3+LDS_K+hi*1024+r32*16; const lds_cptr vp0=shm3+LDS_V+((lane>>4)&1)*32+(lane&3)*8+(4*hi+((lane&15)>>2))*64;
  const int NT=(q0+QB)/KVBLK;
  DMA_K(0,0);DMA_V(0,0);DMA_K(1,SLOTB);
  bf16x8 qr[4];
  #pragma unroll
  for(int d0=0;d0<4;++d0)qr[d0]=*reinterpret_cast<const bf16x8*>(&Qw[(long)r32*DM+d0*16+hi*8]);
  float mhat=0.f,l_reg=0.f;f32x16 o[2];o[0]=f32x16{};o[1]=f32x16{};f32x16 negm=f32x16{};asm volatile("":"+v"(negm));
  const int qrel=wid*QBLK+r32;
  #define CMASK(P0,P1,t) do{int jb_=(t)-(NT-4); if(jb_>=0)cmask(P0,P1,jb_,qrel,hi);}while(0)
  bool resc=false;
  #define START(P0,P1) do{ const float rm=rowmax(P0,P1); resc=false; \
    { const float dl=rm; mhat=fadd_s(mhat,dl); \
      _Pragma("unroll") for(int r=0;r<16;++r){P0[r]=fsub_s(P0[r],dl);P1[r]=fsub_s(P1[r],dl);} \
      _Pragma("unroll") for(int r=0;r<16;++r)negm[r]=-mhat; asm volatile("":"+v"(negm)); } \
    _Pragma("unroll") for(int r=0;r<16;++r)P0[r]=__builtin_amdgcn_exp2f(P0[r]); }while(0)
  #define RESC() do{ if(resc){ asm volatile("s_waitcnt lgkmcnt(0)":::"memory"); \
      _Pragma("unroll") for(int d_=0;d_<2;++d_) _Pragma("unroll") for(int r=0;r<16;++r)o[d_][r]*=wsf[crow(r,hi)]; } }while(0)
  f32x16 pA0,pA1,pB0,pB1;
  int sl_prev=0,sl_cur=0,sl_next=SLOTB;
  #define ROT() do{sl_prev=sl_cur;sl_cur=sl_next;sl_next=(sl_next==(NSLOT-1)*SLOTB)?0:sl_next+SLOTB;}while(0)
  DMA_K(2,2*SLOTB);
  WAIT_BAR(3);
  qkt(pA0,pA1,Kbase,qr,negm,r32,hi);asm volatile("s_nop 15\n\ts_nop 7":"+v"(pA0),"+v"(pA1));CMASK(pA0,pA1,0);
  START(pA0,pA1);
  _Pragma("unroll") for(int r=0;r<16;++r)pA1[r]=__builtin_amdgcn_exp2f(pA1[r]);
  WAIT_BAR(0);
  DMA_K(3,0);DMA_V(1,SLOTB);
  ROT();
  kload8(kf,kp0+sl_cur);
  WAIT_BAR(2);
  s16x4 vlo[8],vhi[8]; u32x4 pw0,pw1,pw2,pw3;
  #define PKW(P,B) cvtpk_s(P[B],P[B+1])
  #define PAF(k) __builtin_bit_cast(bf16x8,pw##k)
  #define VFR(i) (bf16x8){vlo[i][0],vlo[i][1],vlo[i][2],vlo[i][3],vhi[i][0],vhi[i][1],vhi[i][2],vhi[i][3]}
  #define PIN(x) asm volatile("":"+v"(x))
  #define MX3(a,b,c) __builtin_fmaxf(__builtin_fmaxf((a),(b)),(c))
  #define GAPA(MF,A0,A1,A2,A3,W0,W1,PW) do{ MF; sacc+=A0; sacc+=A1; sacc+=A2; sacc+=A3; PIN(sacc); W0; W1; PIN(PW); SBAR(); }while(0)
  #define EX(v) __builtin_amdgcn_exp2f(v)
  #define GAPB(MF,X,B) do{ MF; X[B]=EX(X[B]); X[B+1]=EX(X[B+1]); X[B+2]=EX(X[B+2]); X[B+3]=EX(X[B+3]); PIN(X); SBAR(); }while(0)
  #define VRD(i) do{ vlo[i]=vtr(vp_+(((i)>>2)*4096+((i)&3)*1024)); vhi[i]=vtr(vp_+(((i)>>2)*4096+((i)&3)*1024+512)); }while(0)
  #define KRD(G,j) do{ if(G){ kload2(kf,kp0+sl_next,j); SBAR(); } }while(0)
  #define STEP(C0,C1,P0,P1,t,GK,GV,GL) do{ SBAR(); \
    const lds_cptr vp_=vp0+sl_prev; \
    VRD(0); SBAR(); float sacc=(P0[0]+P0[1]); \
    GAPA(C0=__builtin_amdgcn_mfma_f32_32x32x16_bf16(kf[0],qr[0],negm,0,0,0), P0[2],P0[3],P0[4],P0[5],     pw0[0]=PKW(P0,0), pw0[1]=PKW(P0,2), pw0); \
    VRD(4); SBAR(); GAPA(C1=__builtin_amdgcn_mfma_f32_32x32x16_bf16(kf[1],qr[0],negm,0,0,0), P0[6],P0[7],P0[8],P0[9],     pw0[2]=PKW(P0,4), pw0[3]=PKW(P0,6), pw0); \
    VRD(1); SBAR(); GAPA(C0=__builtin_amdgcn_mfma_f32_32x32x16_bf16(kf[2],qr[1],C0,0,0,0),   P0[10],P0[11],P0[12],P0[13], pw1[0]=PKW(P0,8), pw1[1]=PKW(P0,10), pw1); \
    VRD(5); SBAR(); GAPA(C1=__builtin_amdgcn_mfma_f32_32x32x16_bf16(kf[3],qr[1],C1,0,0,0),   P0[14],P0[15],P1[0],P1[1],   pw1[2]=PKW(P0,12),pw1[3]=PKW(P0,14), pw1); \
    VRD(2); SBAR(); GAPA(C0=__builtin_amdgcn_mfma_f32_32x32x16_bf16(kf[4],qr[2],C0,0,0,0),   P1[2],P1[3],P1[4],P1[5],     pw2[0]=PKW(P1,0), pw2[1]=PKW(P1,2), pw2); \
    VRD(6); SBAR(); GAPA(C1=__builtin_amdgcn_mfma_f32_32x32x16_bf16(kf[5],qr[2],C1,0,0,0),   P1[6],P1[7],P1[8],P1[9],     pw2[2]=PKW(P1,4), pw2[3]=PKW(P1,6), pw2); \
    VRD(3); SBAR(); GAPA(C0=__builtin_amdgcn_mfma_f32_32x32x16_bf16(kf[6],qr[3],C0,0,0,0),   P1[10],P1[11],P1[12],P1[13], pw3[0]=PKW(P1,8), pw3[1]=PKW(P1,10), pw3); \
    VRD(7); SBAR(); GAPA(C1=__builtin_amdgcn_mfma_f32_32x32x16_bf16(kf[7],qr[3],C1,0,0,0),   P1[14],P1[15],0.f,0.f,       pw3[2]=PKW(P1,12),pw3[3]=PKW(P1,14), pw3); \
    l_reg+=sacc; \
    if(GK){DMA_K((t)+3,sl_cur);} if(GV){DMA_V((t)+1,sl_next);} \
    CMASK(C0,C1,t); \
    { float a=MX3(C0[0],C0[1],C1[0]),b=MX3(C0[2],C0[3],C1[1]); a=MX3(a,C1[2],C1[3]); \
      _Pragma("unroll") for(int r=4;r<16;r+=4){a=MX3(a,C0[r],C0[r+1]);b=MX3(b,C0[r+2],C0[r+3]);a=MX3(a,C1[r],C1[r+1]);b=MX3(b,C1[r+2],C1[r+3]);} \
      float rm=__builtin_fmaxf(a,b); { auto rr=__builtin_amdgcn_permlane32_swap(__float_as_uint(rm),__float_as_uint(rm),false,false); rm=__builtin_fmaxf(__uint_as_float(rr[0]),__uint_as_float(rr[1])); } \
      resc=false; \
      if(__builtin_expect(__any(rm>(float)THRL),0)){ const float dl=__builtin_fmaxf(rm,0.f); mhat+=dl; \
        _Pragma("unroll") for(int r=0;r<16;++r){C0[r]-=dl;C1[r]-=dl;} \
        _Pragma("unroll") for(int r=0;r<16;++r)negm[r]=-mhat; asm volatile("":"+v"(negm)); \
        const float f=__builtin_amdgcn_exp2f(-dl); l_reg*=f; if(hi==0)wsf[r32]=f; resc=true; } } \
    SBAR(); \
    GAPB(o[0]=__builtin_amdgcn_mfma_f32_32x32x16_bf16(PAF(0),VFR(0),o[0],0,0,0), C0,0); \
    GAPB(o[1]=__builtin_amdgcn_mfma_f32_32x32x16_bf16(PAF(0),VFR(4),o[1],0,0,0), C0,4); \
    KRD(GL,0); GAPB(o[0]=__builtin_amdgcn_mfma_f32_32x32x16_bf16(PAF(1),VFR(1),o[0],0,0,0), C0,8); \
    KRD(GL,1); GAPB(o[1]=__builtin_amdgcn_mfma_f32_32x32x16_bf16(PAF(1),VFR(5),o[1],0,0,0), C0,12); \
    KRD(GL,2); GAPB(o[0]=__builtin_amdgcn_mfma_f32_32x32x16_bf16(PAF(2),VFR(2),o[0],0,0,0), C1,0); \
    KRD(GL,3); GAPB(o[1]=__builtin_amdgcn_mfma_f32_32x32x16_bf16(PAF(2),VFR(6),o[1],0,0,0), C1,4); \
    GAPB(o[0]=__builtin_amdgcn_mfma_f32_32x32x16_bf16(PAF(3),VFR(3),o[0],0,0,0), C1,8); \
    GAPB(o[1]=__builtin_amdgcn_mfma_f32_32x32x16_bf16(PAF(3),VFR(7),o[1],0,0,0), C1,12); \
    }while(0)
  int t=1;
  #undef CMASK
  #define CMASK(P0,P1,t) do{}while(0)
  for(;t+5<NT;t+=2){
    STEP(pB0,pB1,pA0,pA1,t,true,true,true);     WAIT_BAR(2); RESC(); ROT();
    STEP(pA0,pA1,pB0,pB1,t+1,true,true,true);   WAIT_BAR(2); RESC(); ROT();
  }
  #undef CMASK
  #define CMASK(P0,P1,t) do{int jb_=(t)-(NT-4); if(jb_>=0)cmask(P0,P1,jb_,qrel,hi);}while(0)
  #define ENDW(tt) do{ if((tt)+3<NT){WAIT_BAR(2);} else if((tt)+2<NT){WAIT_BAR(1);} else {WAIT_BAR(0);} }while(0)
  for(;t+1<NT;t+=2){
    STEP(pB0,pB1,pA0,pA1,t,(t+3<NT),(t+1<NT),(t+1<NT));       ENDW(t);   RESC(); ROT();
    STEP(pA0,pA1,pB0,pB1,t+1,(t+4<NT),(t+2<NT),(t+2<NT));     ENDW(t+1); RESC(); ROT();
  }
  STEP(pB0,pB1,pA0,pA1,NT-1,false,false,false); RESC();
  { float sacc=pB0[0]+pB0[1]; _Pragma("unroll") for(int r=2;r<16;++r)sacc+=pB0[r]; _Pragma("unroll") for(int r=0;r<16;++r)sacc+=pB1[r]; l_reg+=sacc;
    pw0=(u32x4){PKW(pB0,0),PKW(pB0,2),PKW(pB0,4),PKW(pB0,6)};pw1=(u32x4){PKW(pB0,8),PKW(pB0,10),PKW(pB0,12),PKW(pB0,14)};pw2=(u32x4){PKW(pB1,0),PKW(pB1,2),PKW(pB1,4),PKW(pB1,6)};pw3=(u32x4){PKW(pB1,8),PKW(pB1,10),PKW(pB1,12),PKW(pB1,14)};
    SBAR(); pv(o,vb0+sl_cur,PAF(0),PAF(1),PAF(2),PAF(3)); }
  #undef PKW
  #undef PAF
  #undef VFR
  #undef PIN
  #undef MX3
  #undef GAPA
  #undef GAPB
  #undef EX
  #undef VRD
  #undef KRD
  #undef STEP
  #undef ENDW
  if(threadIdx.x==0){unsigned z_=0u;asm volatile("":"+v"(z_));ticket=__hip_atomic_fetch_add(qctr+z_,1u,__ATOMIC_RELAXED,__HIP_MEMORY_SCOPE_AGENT);}
  {auto rr=__builtin_amdgcn_permlane32_swap(__float_as_uint(l_reg),__float_as_uint(l_reg),false,false);l_reg=__uint_as_float(rr[0])+__uint_as_float(rr[1]);}
  if(hi==0)wsf[32+r32]=l_reg;asm volatile("s_waitcnt lgkmcnt(0)":::"memory");
  float rli[16];
  #pragma unroll
  for(int r=0;r<16;++r)rli[r]=__builtin_amdgcn_rcpf(wsf[32+crow(r,hi)]);
  bf16*Ow=O+(rowbase+q0+wid*QBLK)*OPITCH+ocol;
  { bf16*stg=(bf16*)(shm+LDS_OST)+wid*2048;
    #pragma unroll
    for(int r=0;r<16;++r){const int orow=crow(r,hi);
      #pragma unroll
      for(int d0=0;d0<2;++d0)stg[orow*64+d0*32+r32]=__float2bfloat16(o[d0][r]*rli[r]);}
    asm volatile("s_waitcnt lgkmcnt(0)":::"memory");
    #pragma unroll
    for(int i=0;i<4;++i){const int row=i*8+(lane>>3),ch=lane&7; const u32x4 v=*(const u32x4*)(stg+row*64+ch*8); ATTN_STORE16(Ow+(long)row*OPITCH+ch*8,v);} }
  asm volatile("s_waitcnt lgkmcnt(0)\n\ts_barrier":::"memory");
  #undef DMA_K
  #undef DMA_V
  #undef CMASK
  #undef START
  #undef RESC
  #undef ROT
}
constexpr int ATTN_LDS_BYTES=LDS_BYTES;
#undef SBAR
#undef WAIT_BAR
}
constexpr size_t MiB = 1u << 20;
constexpr size_t WS_CTL = 0, CTL_ZERO_BYTES = 1 * MiB;
constexpr size_t WS_WIN = 2 * MiB, WS_WOUT = 26 * MiB, WS_WQ = 34 * MiB, WS_WKV = 42 * MiB, WS_WO = 58 * MiB, WS_W1 = 66 * MiB, WS_W2 = 578 * MiB;
constexpr size_t WS_HN = 834 * MiB, WS_MN = 866 * MiB, WS_PROJ = 870 * MiB, WS_DT = 958 * MiB, WS_KVRAW = 959 * MiB, WS_KN = 967 * MiB;
constexpr size_t WS_YCAT = 971 * MiB, WS_O0 = 1003 * MiB, WS_O1 = 1019 * MiB, WS_H1 = 1035 * MiB, WS_H1B = 1099 * MiB, WS_PART1 = 1131 * MiB, WS_PARTQ = 1132 * MiB;
constexpr size_t WS_QRAW = 1133 * MiB, WS_P = 1165 * MiB, WS_VWT = 1181 * MiB, WS_H2 = 1197 * MiB, WS_HN3 = 1261 * MiB;
constexpr size_t WS_TOKOF = 1293 * MiB, WS_GATEOF = 1294 * MiB, WS_TOKE = 1295 * MiB, WS_TOKR = 1296 * MiB, WS_YG = 1297 * MiB;
constexpr size_t WS_H1F8 = 3368 * MiB  , WS_QF8 = 3384 * MiB  , WS_KN8 = 3400 * MiB  , WS_VF8 = 3402 * MiB  ;
constexpr size_t WS_P8 = 3404 * MiB  , WS_VWT8 = 3412 * MiB  ;
constexpr size_t WS_XG = 1320 * MiB  , WS_ACT = 1832 * MiB  , WS_Y = 2344 * MiB  , WS_END = 3420 * MiB;
constexpr int CW_BAR = 4096;
constexpr int CW_QCONV2 = 12416;
constexpr int CW_QCONV = 12352;
constexpr int CW_QATT = 12288;
constexpr int CW_CNT = 8192;
static_assert((CW_CNT + 64 * 32) * 4 <= (int)CTL_ZERO_BYTES, "CTL words inside the memset region");

constexpr int RING_OFF = 0, RING_BYTES = 131072;
constexpr int LDS_BYTES = 163840;
constexpr int MISC_OFF = 163840 - 1024;
constexpr int NWAVES = 8;

#define XB_TMO      128
#define XB_XCNT(j)  (256  + 64 * (j))
#define XB_XSUB(j)  (1280 + 64 * (j))
#define XB_XGEN(j)  (2304 + 64 * (j))
#define XB_TOP      3328
#define XB_TOPGEN   3392
#define XCD_BAR_WORDS 3456
#define XB_SPIN_CAP (1u << 20)

__device__ __forceinline__ unsigned xb_ld(unsigned* p)              { return __hip_atomic_load(p, __ATOMIC_RELAXED, __HIP_MEMORY_SCOPE_AGENT); }
__device__ __forceinline__ unsigned xb_add(unsigned* p, unsigned v) { return __hip_atomic_fetch_add(p, v, __ATOMIC_RELAXED, __HIP_MEMORY_SCOPE_AGENT); }
__device__ __forceinline__ unsigned xb_xcc_id() { return (unsigned)__builtin_amdgcn_s_getreg((3 << 11) | 20) & 0xFu; }
#define XB_SPIN(cond, bar) do { unsigned _sp = 0; while (cond) { __builtin_amdgcn_s_sleep(1); \
    if ((++_sp & 255u) == 0u) { if (xb_ld(&(bar)[XB_TMO])) break; if (_sp > XB_SPIN_CAP) { atomicAdd(&(bar)[XB_TMO], 1u); break; } } } } while (0)

struct XcdBarrier {
    unsigned* bar; unsigned x;
    volatile LAS unsigned* st;
};
__device__ __forceinline__ XcdBarrier xcd_barrier_post(unsigned* bar, volatile LAS unsigned* st) {
    XcdBarrier b; b.bar = bar; b.x = xb_xcc_id(); b.st = st;
    if (threadIdx.x == 0) (void)xb_add(&bar[XB_XCNT(b.x)], 1u);
    return b;
}
__device__ __forceinline__ void xcd_barrier_complete(unsigned* bar, unsigned x, unsigned& nloc, unsigned& nx) {
    const unsigned G = gridDim.x * gridDim.y * gridDim.z;
    unsigned sum, cnt, mine, sp = 0u;
    for (;;) {
        sum = 0u; cnt = 0u; mine = 0u;
#pragma unroll
        for (unsigned j = 0; j < 16; ++j) { const unsigned c = xb_ld(&bar[XB_XCNT(j)]); sum += c; cnt += (c > 0u) ? 1u : 0u; mine = (j == x) ? c : mine; }
        if (sum == G) break;
        __builtin_amdgcn_s_sleep(1);
        if ((++sp & 255u) == 0u) { if (xb_ld(&bar[XB_TMO])) break; if (sp > XB_SPIN_CAP) { atomicAdd(&bar[XB_TMO], 1u); break; } }
    }
    nloc = mine > 0u ? mine : 1u; nx = cnt > 0u ? cnt : 1u;
}
__device__ __forceinline__ void xcd_barrier(const XcdBarrier& b) {
    asm volatile("s_waitcnt vmcnt(0)" ::: "memory");
    __syncthreads();
    if (threadIdx.x == 0) {
        unsigned* bar = b.bar;
        __builtin_amdgcn_s_waitcnt(0);
        unsigned nloc = b.st[0], nx = b.st[1];
        if (nloc == 0u) { xcd_barrier_complete(bar, b.x, nloc, nx); b.st[0] = nloc; b.st[1] = nx; }
        const unsigned old = xb_add(&bar[XB_XSUB(b.x)], 1u);
        const unsigned gen = old / nloc;
        if (old + 1u == (gen + 1u) * nloc) {
            __builtin_amdgcn_fence(__ATOMIC_RELEASE, "agent");
            asm volatile("s_waitcnt vmcnt(0)" ::: "memory");
            const unsigned og = xb_add(&bar[XB_TOP], 1u);
            const unsigned tg = og / nx;
            if (og + 1u == (tg + 1u) * nx) xb_add(&bar[XB_TOPGEN], 1u);
            else XB_SPIN(xb_ld(&bar[XB_TOPGEN]) == tg, bar);
            __builtin_amdgcn_fence(__ATOMIC_ACQUIRE, "agent");
            xb_add(&bar[XB_XGEN(b.x)], 1u);
            asm volatile("s_waitcnt vmcnt(0)" ::: "memory");
        } else {
            XB_SPIN(xb_ld(&bar[XB_XGEN(b.x)]) == gen, bar);
            __builtin_amdgcn_fence(__ATOMIC_ACQUIRE, "agent");
            asm volatile("s_waitcnt vmcnt(0)" ::: "memory");
        }
    }
    __syncthreads();
}

struct Args { const float* in[32]; float* out; unsigned char* ws; int ph_lo, ph_hi, probe, pad_; };
enum In { I_X = 0, I_MEM, I_GMIX, I_WIN, I_CONVW, I_CONVB, I_DTB, I_ALOG, I_DSKIP, I_SSDG, I_DAQG, I_DAKG, I_LQ1, I_LK1, I_LQ2, I_LK2, I_SUBG, I_WOUT, I_GXA, I_GMEM,
          I_WQ, I_WKV, I_XQG, I_XKG, I_WO, I_GFFN, I_RW, I_RB, I_W1, I_B1, I_W2, I_B2 };

struct ArgP {
    typedef const __attribute__((address_space(4))) char* kptr;
    DI const float* in(int i) const { kptr kp = (kptr)__builtin_amdgcn_kernarg_segment_ptr(); asm volatile("" : "+s"(kp)); return *(const float* const __attribute__((address_space(4)))*)(kp + 8 * i); }
    DI float* out() const { kptr kp = (kptr)__builtin_amdgcn_kernarg_segment_ptr(); asm volatile("" : "+s"(kp)); return *(float* const __attribute__((address_space(4)))*)(kp + 8 * 32); }
};
struct Frame {
    LAS unsigned char* lds;
    volatile LAS unsigned* MISC;
    unsigned* ctl;
    unsigned char* ws;
    int tid, lane, wave, vcu, G;
};

template <class DestRow>
DI void tr_item(const float* W, size_t ldw, int k0, int ncol0, int nvalid, const float* kscale, bf16_t* WT, int K, DestRow dr, LAS float* scr, int lane) {
    const int c = lane & 31;
#pragma unroll 8
    for (int i = 0; i < 32; ++i) { const int kk = 2 * i + (lane >> 5);
        float v = (c < nvalid) ? W[(size_t)(k0 + kk) * ldw + ncol0 + c] : 0.f;
        if (kscale) v *= kscale[k0 + kk];
        scr[kk * 33 + c] = v; }
    asm volatile("s_waitcnt lgkmcnt(0)" ::: "memory");
    const int c8 = lane & 7;
#pragma unroll
    for (int j = 0; j < 4; ++j) { const int n = (lane >> 3) + 8 * j; const LAS float* s = scr + (8 * c8) * 33 + n;
        u32x4 o; o.x = pk2(s[0 * 33], s[1 * 33]); o.y = pk2(s[2 * 33], s[3 * 33]); o.z = pk2(s[4 * 33], s[5 * 33]); o.w = pk2(s[6 * 33], s[7 * 33]);
        if (n < nvalid) *(u32x4*)(WT + (size_t)dr(ncol0 + n) * K + k0 + 8 * c8) = o; }
    asm volatile("s_waitcnt lgkmcnt(0)" ::: "memory");
}
template <class DestRow>
DI void tr_item_fp8(const float* W, size_t ldw, int k0, int ncol0, const float* kscale, unsigned char* WT, int K, DestRow dr, LAS float* scr, int lane) {
    const int c = lane & 31;
#pragma unroll 8
    for (int i = 0; i < 32; ++i) { const int kk = 2 * i + (lane >> 5); float v = W[(size_t)(k0 + kk) * ldw + ncol0 + c]; if (kscale) v *= kscale[k0 + kk]; scr[kk * 33 + c] = v; }
    asm volatile("s_waitcnt lgkmcnt(0)" ::: "memory");
    const int n = lane >> 1, hf = lane & 1; const LAS float* s = scr + (32 * hf) * 33 + n;
    unsigned w[8];
#pragma unroll
    for (int j = 0; j < 8; ++j) { unsigned x = 0u;
        x = __builtin_amdgcn_cvt_pk_fp8_f32(s[(4 * j) * 33] * 64.f, s[(4 * j + 1) * 33] * 64.f, x, false);
        x = __builtin_amdgcn_cvt_pk_fp8_f32(s[(4 * j + 2) * 33] * 64.f, s[(4 * j + 3) * 33] * 64.f, x, true); w[j] = x; }
    unsigned char* op = WT + (size_t)dr(ncol0 + n) * K + k0 + 32 * hf;
    *(u32x4*)op = (u32x4){w[0], w[1], w[2], w[3]}; *(u32x4*)(op + 16) = (u32x4){w[4], w[5], w[6], w[7]};
    asm volatile("s_waitcnt lgkmcnt(0)" ::: "memory");
}
DI int tileperm(int col) { const int o = col & 255; return (col & ~255) + 128 * ((o & 63) >> 5) + 32 * (o >> 6) + (o & 31); }
struct DrIdent { DI int operator()(int n) const { return n; } };
struct DrTile  { DI int operator()(int n) const { return tileperm(n); } };
struct DrWin   { DI int operator()(int n) const { const int pc = (n < 2560) ? n : (n < 2576 ? PC_DT + (n - 2560) : n - 16); return tileperm(pc); } };
struct DrW1    { DI int operator()(int n) const { const int half = n >> 11, j = n & 2047; return (j >> 7) * 256 + half * 128 + (j & 127); } };

template <bool FP8, class DestRow>
DI void cv_item(const float* W, size_t ldw, int k0, int ncol0, const float* kscale, float scale, void* WT, int kpitch, DestRow dr, LAS float* scr, int lane) {
    const int r = lane >> 3, c4 = (lane & 7) * 4;
    f32x4 v[16];
#pragma unroll
    for (int i = 0; i < 16; ++i) v[i] = *(const f32x4*)(W + (size_t)(k0 + 8 * i + r) * ldw + ncol0 + c4);
#pragma unroll
    for (int i = 0; i < 16; ++i) { f32x4 x = v[i] * scale; if (kscale) x = x * kscale[k0 + 8 * i + r]; *(LAS f32x4*)(scr + (8 * i + r) * 36 + c4) = x; }
    asm volatile("s_waitcnt lgkmcnt(0)" ::: "memory");
    const int n = lane & 31, hf = lane >> 5; const LAS float* s = scr + (64 * hf) * 36 + n;
    if constexpr (FP8) {
        unsigned w[16];
#pragma unroll
        for (int j = 0; j < 16; ++j) { unsigned x = 0u; x = __builtin_amdgcn_cvt_pk_fp8_f32(s[(4 * j) * 36], s[(4 * j + 1) * 36], x, false); x = __builtin_amdgcn_cvt_pk_fp8_f32(s[(4 * j + 2) * 36], s[(4 * j + 3) * 36], x, true); w[j] = x; }
        unsigned char* op = (unsigned char*)WT + (size_t)dr(ncol0 + n) * kpitch + k0 + 64 * hf;
#pragma unroll
        for (int j = 0; j < 4; ++j) *(u32x4*)(op + 16 * j) = (u32x4){w[4 * j], w[4 * j + 1], w[4 * j + 2], w[4 * j + 3]};
    } else {
        unsigned w[32];
#pragma unroll
        for (int j = 0; j < 32; ++j) w[j] = pk2(s[(2 * j) * 36], s[(2 * j + 1) * 36]);
        unsigned char* op = (unsigned char*)WT + (size_t)dr(ncol0 + n) * kpitch + (k0 + 64 * hf) * 2;
#pragma unroll
        for (int j = 0; j < 8; ++j) *(u32x4*)(op + 16 * j) = (u32x4){w[4 * j], w[4 * j + 1], w[4 * j + 2], w[4 * j + 3]};
    }
    asm volatile("s_waitcnt lgkmcnt(0)" ::: "memory");
}
DI void rms_row_to_bf16(const float* xrow, const float* g, bf16_t* orow, int lane) {
    const f32x4* xr = (const f32x4*)xrow + lane;
    f32x4 v[8]; float s = 0.f;
#pragma unroll
    for (int j = 0; j < 8; ++j) { v[j] = xr[64 * j]; s += (v[j].x * v[j].x + v[j].y * v[j].y) + (v[j].z * v[j].z + v[j].w * v[j].w); }
    const float rstd = 1.f / sqrtf(wave_sum(s) * (1.f / 2048.f) + EPS_);
    u32x2* o8 = (u32x2*)orow + lane;
#pragma unroll
    for (int j = 0; j < 8; ++j) { const f32x4 gg = ((const f32x4*)g)[lane + 64 * j];
        u32x2 o; o.x = pk2(v[j].x * rstd * gg.x, v[j].y * rstd * gg.y); o.y = pk2(v[j].z * rstd * gg.z, v[j].w * rstd * gg.w); o8[64 * j] = o; }
}

DI void p0_prologue(Frame& F, const ArgP& a) {
    LAS float* scr = (LAS float*)(F.lds + RING_OFF + F.wave * 16384);
    const int gw = F.vcu * NWAVES + F.wave, NGW = F.G * NWAVES;
    unsigned char* ws = F.ws;
    constexpr int I_A = 32 * 80, I_B = 32, I_C = 32 * 96, NITEMS = I_A + I_B + I_C;
    for (int it = gw; it < NITEMS; it += NGW) {
        int r = it;
        if (r < I_A) { tr_item(a.in(I_WIN), 5648, 64 * (r / 80), 32 * (r % 80), 32, nullptr, (bf16_t*)(ws + WS_WIN), 2048, DrWin(), scr, F.lane); continue; } r -= I_A;
        if (r < I_B) { tr_item(a.in(I_WIN), 5648, 64 * r, 2560, 16, nullptr, (bf16_t*)(ws + WS_WIN), 2048, DrWin(), scr, F.lane); continue; } r -= I_B;
        tr_item(a.in(I_WIN), 5648, 64 * (r / 96), 2576 + 32 * (r % 96), 32, nullptr, (bf16_t*)(ws + WS_WIN), 2048, DrWin(), scr, F.lane);
    }
    for (int m = gw; m < NTOK; m += NGW) rms_row_to_bf16(a.in(I_X) + (size_t)m * 2048, a.in(I_GMIX), (bf16_t*)(ws + WS_HN) + (size_t)m * 2048, F.lane);
    for (int m = gw; m < NB * MEMLEN; m += NGW) rms_row_to_bf16(a.in(I_MEM) + (size_t)m * 2048, a.in(I_GMEM), (bf16_t*)(ws + WS_MN) + (size_t)m * 2048, F.lane);
}
struct CvIt { const float* W; size_t ldw; const float* ks; unsigned char* WT; float scale; int k0, n0, kpitch, fp8, dr, tiled; };
DI CvIt cv_decode(int it, const ArgP& a, unsigned char* ws) {
    constexpr int J_WOUT = 16 * 64, J_WKV = 16 * 128, J_WQ = 16 * 64, J_WO = 16 * 64, J_W1 = 32 * 16 * 128;
    CvIt c; c.ks = nullptr; c.scale = 64.f; c.fp8 = 1; c.dr = 0; c.kpitch = 2048; c.ldw = 2048; c.tiled = 0;
    int r = it;
    if (r < J_WOUT) { c.W = a.in(I_WOUT); c.k0 = 128 * (r / 64); c.n0 = 32 * (r % 64); c.WT = ws + WS_WOUT; c.scale = 1.f; c.fp8 = 0; c.kpitch = 4096; return c; } r -= J_WOUT;
    if (r < J_WKV) { c.W = a.in(I_WKV); c.ldw = 4096; c.k0 = 128 * (r / 128); c.n0 = 32 * (r % 128); c.WT = ws + WS_WKV; c.scale = 1.f; c.fp8 = 0; c.kpitch = 4096; c.dr = 1; return c; } r -= J_WKV;
    if (r < J_WQ) { c.W = a.in(I_WQ); c.ks = a.in(I_GXA); c.k0 = 128 * (r / 64); c.n0 = 32 * (r % 64); c.WT = ws + WS_WQ; return c; } r -= J_WQ;
    if (r < J_WO) { c.W = a.in(I_WO); c.k0 = 128 * (r / 64); c.n0 = 32 * (r % 64); c.WT = ws + WS_WO; return c; } r -= J_WO;
    if (r < J_W1) { const int e = r / (16 * 128), q = r % (16 * 128); c.W = a.in(I_W1) + (size_t)e * 2048 * 4096; c.ldw = 4096; c.k0 = 128 * (q / 128); c.n0 = 32 * (q % 128); c.WT = ws + WS_W1 + (size_t)e * 4096 * 2048; c.dr = 2; c.tiled = 1; return c; } r -= J_W1;
    { const int e = r / (16 * 64), q = r % (16 * 64); c.W = a.in(I_W2) + (size_t)e * 2048 * 2048; c.k0 = 128 * (q / 64); c.n0 = 32 * (q % 64); c.WT = ws + WS_W2 + (size_t)e * 2048 * 2048; c.tiled = 1; }
    return c;
}
constexpr int CV_NJ = 16 * 64 * 3 + 16 * 128 + 32 * 16 * 128 + 32 * 16 * 64;
constexpr int CV_TAIL2 = 12288;
constexpr int CV_TAIL1 = 20480;
constexpr int CV_TAIL = CV_TAIL1 + CV_TAIL2;
DI void conv_share(Frame& F, const ArgP& a) {
    LAS float* scr = (LAS float*)(F.lds + F.wave * 16384);
    const unsigned sbase = (unsigned)__builtin_amdgcn_readfirstlane((int)((unsigned)(uintptr_t)F.lds + (unsigned)F.wave * 16384u));
    const int gw = F.vcu * NWAVES + F.wave, NGW = F.G * NWAVES, lane = F.lane;
    unsigned char* ws = F.ws;
    constexpr int NJ = CV_NJ - CV_TAIL;
    const int n = lane & 31, hf = lane >> 5;
    for (int it = gw; it < NJ; it += NGW) {
        const CvIt cur = cv_decode(it, a, ws);
        const char* gb = (const char*)(cur.W + (size_t)cur.k0 * cur.ldw + cur.n0);
        const unsigned vo0 = (unsigned)(((size_t)(lane >> 3) * cur.ldw + (size_t)(lane & 7) * 4) * 4), vstep = (unsigned)(8 * cur.ldw * 4);
#pragma unroll
        for (int p = 0; p < 16; ++p) { unsigned keep_;
            asm volatile("s_mov_b32 %0, m0\n\ts_mov_b32 m0, %3\n\ts_nop 0\n\tglobal_load_lds_dwordx4 %1, %2 nt\n\ts_mov_b32 m0, %0"
                         : "=&s"(keep_) : "v"(vo0 + (unsigned)p * vstep), "s"(gb), "s"(sbase + (unsigned)p * 1024u) : "memory"); }
        asm volatile("s_waitcnt vmcnt(0)" ::: "memory");
        const LAS float* s = scr + (64 * hf) * 32 + n;
        const int col = cur.n0 + n; const int drow = (cur.dr == 0) ? col : (cur.dr == 1 ? tileperm(col) : DrW1()(col));
        const float* ksp = cur.ks ? cur.ks + cur.k0 + 64 * hf : nullptr;
        if (cur.fp8) {
            unsigned w[16];
#pragma unroll
            for (int j = 0; j < 16; ++j) { float x0 = s[(4 * j) * 32] * cur.scale, x1 = s[(4 * j + 1) * 32] * cur.scale, x2 = s[(4 * j + 2) * 32] * cur.scale, x3 = s[(4 * j + 3) * 32] * cur.scale;
                if (ksp) { x0 *= ksp[4 * j]; x1 *= ksp[4 * j + 1]; x2 *= ksp[4 * j + 2]; x3 *= ksp[4 * j + 3]; }
                unsigned x = 0u; x = __builtin_amdgcn_cvt_pk_fp8_f32(x0, x1, x, false); x = __builtin_amdgcn_cvt_pk_fp8_f32(x2, x3, x, true); w[j] = x; }
            unsigned char* op = cur.tiled ? cur.WT + ((size_t)(((drow >> 8) * 16 + (cur.k0 >> 7)) * 256 + (drow & 255))) * 128 + 64 * hf : cur.WT + (size_t)drow * cur.kpitch + cur.k0 + 64 * hf;
#pragma unroll
            for (int j = 0; j < 4; ++j) *(u32x4*)(op + 16 * j) = (u32x4){w[4 * j], w[4 * j + 1], w[4 * j + 2], w[4 * j + 3]};
        } else {
            unsigned w[32];
#pragma unroll
            for (int j = 0; j < 32; ++j) w[j] = pk2(s[(2 * j) * 32] * cur.scale, s[(2 * j + 1) * 32] * cur.scale);
            unsigned char* op = cur.WT + (size_t)drow * cur.kpitch + (cur.k0 + 64 * hf) * 2;
#pragma unroll
            for (int j = 0; j < 8; ++j) *(u32x4*)(op + 16 * j) = (u32x4){w[4 * j], w[4 * j + 1], w[4 * j + 2], w[4 * j + 3]};
        }
        asm volatile("s_waitcnt lgkmcnt(0)" ::: "memory");
    }
}

DI void conv_queue(Frame& F, const ArgP& a, int qword, int first, int count) {
    LAS float* scr = (LAS float*)(F.lds + F.wave * 18432);
    unsigned char* ws = F.ws;
    const int lane = threadIdx.x & 63, r = lane >> 3, c4 = (lane & 7) * 4, n = lane & 31, hf = lane >> 5;
    for (;;) {
        if (threadIdx.x == 0) F.MISC[121] = __hip_atomic_fetch_add(F.ctl + qword, 8u, __ATOMIC_RELAXED, __HIP_MEMORY_SCOPE_AGENT);
        __syncthreads();
        const int base = __builtin_amdgcn_readfirstlane((int)F.MISC[121]);
        __syncthreads();
        if (base >= count) break;
        const int it = first + base + F.wave;
        if (base + F.wave < count) {
            const CvIt cur = cv_decode(it, a, ws);
            f32x4 v[16];
#pragma unroll
            for (int i = 0; i < 16; ++i) v[i] = __builtin_nontemporal_load((const f32x4*)(cur.W + (size_t)(cur.k0 + 8 * i + r) * cur.ldw + cur.n0 + c4));
#pragma unroll
            for (int i = 0; i < 16; ++i) *(LAS f32x4*)(scr + (8 * i + r) * 36 + c4) = v[i] * cur.scale;
            asm volatile("s_waitcnt lgkmcnt(0)" ::: "memory");
            const LAS float* s = scr + (64 * hf) * 36 + n;
            unsigned w[16];
#pragma unroll
            for (int j = 0; j < 16; ++j) { unsigned x = 0u; x = __builtin_amdgcn_cvt_pk_fp8_f32(s[(4 * j) * 36], s[(4 * j + 1) * 36], x, false); x = __builtin_amdgcn_cvt_pk_fp8_f32(s[(4 * j + 2) * 36], s[(4 * j + 3) * 36], x, true); w[j] = x; }
            const int drow = cur.n0 + n; unsigned char* op = cur.WT + ((size_t)(((drow >> 8) * 16 + (cur.k0 >> 7)) * 256 + (drow & 255))) * 128 + 64 * hf;
#pragma unroll
            for (int j = 0; j < 4; ++j) *(u32x4*)(op + 16 * j) = (u32x4){w[4 * j], w[4 * j + 1], w[4 * j + 2], w[4 * j + 3]};
            asm volatile("s_waitcnt lgkmcnt(0)" ::: "memory");
        }
    }
}
static_assert(CV_TAIL <= 32 * 16 * 64 && CV_TAIL1 % 8 == 0 && CV_TAIL2 % 8 == 0, "the tails are a suffix of the moe_w2 items");

struct SchedP1 {
    int G, c; const unsigned char* ws; int lo, hi;
    DI bool next(int i, pg8::UnitD& u) const {
        u.rows = nullptr; u.nvalid = 0; u.lda = 4096u; u.ldb = 4096u; u.e = 0; u.x0 = 0;
        if (lo == 0) {
            if (G == 256) { const int x = c >> 5, s = c & 31, bidx = i * 8 + x; if (bidx >= 24) return false;
                const int g = bidx >> 2, h = bidx & 3; u.pn = 4 * g + (s >> 3); u.pm = h * 8 + (s & 7); if (u.pn >= 23) return false; }
            else { const int L = i * G + c; if (L >= 32 * 23) return false; u.pn = L / 32; u.pm = L % 32; }
            u.type = 0; u.A = (const char*)(ws + WS_HN) + (size_t)u.pm * 256 * 4096; u.B = (const char*)(ws + WS_WIN) + (size_t)u.pn * 256 * 4096;
            return true;
        }
        const int L = lo + i * G + c; if (L >= hi) return false;
        { const int q = L - 32 * 23; u.type = 1; u.pn = q / 4; u.pm = q % 4; u.A = (const char*)(ws + WS_MN) + (size_t)u.pm * 256 * 4096; u.B = (const char*)(ws + WS_WKV) + (size_t)u.pn * 256 * 4096; }
        return true;
    }
};
struct EpiP1 {
    static constexpr bool AFTER_DRAIN = false;
    bf16_t* proj; float* dtb; bf16_t* kvraw; const float* gq; const float* gk; unsigned char* vf8;
    DI void operator()(const f32x4 (&acc)[2][2][4][2], const pg8::UnitD& u, int wr, int wc, int fr, int fq) const {
        { int ln_ = threadIdx.x; asm volatile("" : "+v"(ln_)); fr = ln_ & 15; fq = (ln_ >> 4) & 3; }
        const int row0 = u.pm * 256 + wr * 64 + fr;
        const int cn = u.pn * 256 + 64 * wc + 8 * fq;
        if (u.type == 1 && u.pn >= 8) {
#pragma unroll
            for (int ai = 0; ai < 2; ++ai)
#pragma unroll
                for (int m = 0; m < 4; ++m) { unsigned char* rp = vf8 + (size_t)(row0 + ai * 128 + m * 16) * 2048 + (cn - 2048);
#pragma unroll
                    for (int bj = 0; bj < 2; ++bj) { const f32x4 v0 = acc[ai][bj][m][0] * 16.f, v1 = acc[ai][bj][m][1] * 16.f;
                        u32x2 w; w.x = __builtin_amdgcn_cvt_pk_fp8_f32(v0[0], v0[1], 0u, false); w.x = __builtin_amdgcn_cvt_pk_fp8_f32(v0[2], v0[3], w.x, true);
                        w.y = __builtin_amdgcn_cvt_pk_fp8_f32(v1[0], v1[1], 0u, false); w.y = __builtin_amdgcn_cvt_pk_fp8_f32(v1[2], v1[3], w.y, true);
                        *(u32x2*)(rp + 32 * bj) = w; } }
            return;
        }
        if (u.type == 1) {
#pragma unroll
            for (int ai = 0; ai < 2; ++ai)
#pragma unroll
                for (int m = 0; m < 4; ++m) { bf16_t* rp = kvraw + (size_t)(row0 + ai * 128 + m * 16) * 4096 + cn;
#pragma unroll
                    for (int bj = 0; bj < 2; ++bj) { const f32x4 v0 = acc[ai][bj][m][0], v1 = acc[ai][bj][m][1];
                        u32x4 w; w.x = pk2(v0[0], v0[1]); w.y = pk2(v0[2], v0[3]); w.z = pk2(v1[0], v1[1]); w.w = pk2(v1[2], v1[3]); *(u32x4*)(rp + 32 * bj) = w; } }
            return;
        }
        if (u.pn == 22) {
            if (wc == 0 && fq < 2) {
#pragma unroll
                for (int ai = 0; ai < 2; ++ai)
#pragma unroll
                    for (int m = 0; m < 4; ++m) { float* rp = dtb + (size_t)(row0 + ai * 128 + m * 16) * 16 + 8 * fq;
                        *(f32x4*)(rp) = acc[ai][0][m][0]; *(f32x4*)(rp + 4) = acc[ai][0][m][1]; }
            }
            return;
        }
        const bool isq = (u.pn >= 10 && u.pn < 14), isk = (u.pn >= 14 && u.pn < 18);
        if (!(isq || isk)) {
#pragma unroll
            for (int ai = 0; ai < 2; ++ai)
#pragma unroll
                for (int m = 0; m < 4; ++m) { bf16_t* rp = proj + (size_t)(row0 + ai * 128 + m * 16) * PP + cn;
#pragma unroll
                    for (int bj = 0; bj < 2; ++bj) { const f32x4 v0 = acc[ai][bj][m][0], v1 = acc[ai][bj][m][1];
                        u32x4 w; w.x = pk2(v0[0], v0[1]); w.y = pk2(v0[2], v0[3]); w.z = pk2(v1[0], v1[1]); w.w = pk2(v1[2], v1[3]); *(u32x4*)(rp + 32 * bj) = w; } }
            return;
        }
        const float* g = (isq ? gq : gk) + 8 * fq; const float sc = isq ? (0.125f * 1.4426950408889634f) : 1.f;
#pragma unroll
        for (int ai = 0; ai < 2; ++ai)
#pragma unroll
            for (int m = 0; m < 4; ++m) { bf16_t* rp = proj + (size_t)(row0 + ai * 128 + m * 16) * PP + cn;
                float ss = 0.f;
#pragma unroll
                for (int bj = 0; bj < 2; ++bj)
#pragma unroll
                    for (int n = 0; n < 2; ++n) { const f32x4 v = acc[ai][bj][m][n]; ss += (v[0] * v[0] + v[1] * v[1]) + (v[2] * v[2] + v[3] * v[3]); }
                ss += __shfl_xor(ss, 16); ss += __shfl_xor(ss, 32);
                const float rs = sc / sqrtf(ss * (1.f / 64.f) + EPS_);
#pragma unroll
                for (int bj = 0; bj < 2; ++bj) { const f32x4 v0 = acc[ai][bj][m][0] * rs * *(const f32x4*)(g + 32 * bj), v1 = acc[ai][bj][m][1] * rs * *(const f32x4*)(g + 32 * bj + 4);
                    u32x4 w; w.x = pk2(v0[0], v0[1]); w.y = pk2(v0[2], v0[3]); w.z = pk2(v1[0], v1[1]); w.w = pk2(v1[2], v1[3]); *(u32x4*)(rp + 32 * bj) = w; } }
    }
};

DI void kprep(Frame& F, const ArgP& a) {
    const int gw = F.vcu * NWAVES + F.wave, NGW = F.G * NWAVES;
    const bf16_t* kv = (const bf16_t*)(F.ws + WS_KVRAW); unsigned char* kn = (unsigned char*)(F.ws + WS_KN8);
    for (int it = gw; it < NB * MEMLEN * 4; it += NGW) {
        const int row = it >> 2, h = it & 3, b = row >> 8, key = row & 255;
        const u32x4 raw = *(const u32x4*)(kv + (size_t)row * 4096 + h * 512 + F.lane * 8);
        float v[8]; v[0] = bflo(raw.x); v[1] = bfhi(raw.x); v[2] = bflo(raw.y); v[3] = bfhi(raw.y); v[4] = bflo(raw.z); v[5] = bfhi(raw.z); v[6] = bflo(raw.w); v[7] = bfhi(raw.w);
        float ss = 0.f;
#pragma unroll
        for (int j = 0; j < 8; ++j) ss += v[j] * v[j];
        const float rs = 1.f / sqrtf(wave_sum(ss) * (1.f / 512.f) + EPS_) * 0.04419417382415922f * 128.f;
        const float* gk = a.in(I_XKG) + F.lane * 8; const float* gq = a.in(I_XQG) + F.lane * 8;
        u32x2 o; o.x = __builtin_amdgcn_cvt_pk_fp8_f32(v[0] * rs * gk[0] * gq[0], v[1] * rs * gk[1] * gq[1], 0u, false); o.x = __builtin_amdgcn_cvt_pk_fp8_f32(v[2] * rs * gk[2] * gq[2], v[3] * rs * gk[3] * gq[3], o.x, true);
        o.y = __builtin_amdgcn_cvt_pk_fp8_f32(v[4] * rs * gk[4] * gq[4], v[5] * rs * gk[5] * gq[5], 0u, false); o.y = __builtin_amdgcn_cvt_pk_fp8_f32(v[6] * rs * gk[6] * gq[6], v[7] * rs * gk[7] * gq[7], o.y, true);
        *(u32x2*)(kn + ((size_t)((b * 4 + h) * 256 + key)) * 512 + F.lane * 8) = o;
    }
}

constexpr int SP = 272;
constexpr int S_C = 0, S_BM = 34816, S_BT = 69632, S_XDT = 104448, S_HB = 121856, S_F = 139264, S_W = 155648  , SSD_LDS = 162048;
static_assert(SSD_LDS <= MISC_OFF, "SSD LDS map");
#define MFMA32(a, b, c) __builtin_amdgcn_mfma_f32_32x32x16_bf16((a), (b), (c), 0, 0, 0)
DI int crow(int r, int hi) { return (r & 3) + 8 * (r >> 2) + 4 * hi; }
DI bf16x8 ldfrag(LAS const unsigned char* base, int row, int kel) { return *(const LAS bf16x8*)(base + row * SP + kel * 2); }
DI float fexp(float x) { return __builtin_amdgcn_exp2f(x * 1.4426950408889634f); }
DI float fsilu(float x) { return x * __builtin_amdgcn_rcpf(1.f + fexp(-x)); }

DI void ssd_unit(Frame& F, const ArgP& a, int b, int hd) {
    LAS unsigned char* lds = F.lds;
    int tid = F.tid, lane = F.lane, r32 = lane & 31, hh = lane >> 5; const int wid = F.wave;
    LAS float* sdt = (LAS float*)(lds + S_F); LAS float* sac = sdt + 2048;
    const bf16_t* proj = (const bf16_t*)(F.ws + WS_PROJ); const float* dtbuf = (const float*)(F.ws + WS_DT); bf16_t* yg = (bf16_t*)(F.ws + WS_YG);
    const int g = hd >> 3;
    const float aneg = -__expf(a.in(I_ALOG)[hd]), dtb = a.in(I_DTB)[hd], dsk = a.in(I_DSKIP)[hd];
#pragma unroll
    for (int q = 0; q < 2; ++q) { const int c = 2 * wid + q; const size_t t0 = (size_t)b * SEQ_ + c * 128;
        const float x0 = dtbuf[(t0 + 2 * lane) * 16 + hd] + dtb, x1 = dtbuf[(t0 + 2 * lane + 1) * 16 + hd] + dtb;
        const float d0 = x0 > 20.f ? x0 : log1pf(__expf(x0)), d1 = x1 > 20.f ? x1 : log1pf(__expf(x1));
        const float a0 = d0 * aneg, a1 = d1 * aneg;
        float s = a0 + a1;
#pragma unroll
        for (int o = 1; o < 64; o <<= 1) { const float t = __shfl_up(s, o); if (lane >= o) s += t; }
        sdt[c * 128 + 2 * lane] = d0; sdt[c * 128 + 2 * lane + 1] = d1; sac[c * 128 + 2 * lane] = s - a1; sac[c * 128 + 2 * lane + 1] = s; }
    int seg = tid >> 5, cg = tid & 31, l0 = seg * 8;
    int colbc = (cg < 16) ? (1024 + g * 128 + cg * 8) : (1280 + g * 128 + (cg - 16) * 8);
    const int colx = hd * 64 + wid * 8; int lx = 2 * lane;
    LAS float* swt = (LAS float*)(lds + S_W);
    { const float* convw = a.in(I_CONVW); const float* convb = a.in(I_CONVB);
      if (tid < 320) { const int ci = tid;
          const int xc = (ci < 64) ? (hd * 64 + ci) : (ci < 192 ? (1024 + g * 128 + (ci - 64)) : (1280 + g * 128 + (ci - 192)));
#pragma unroll
          for (int k = 0; k < 4; ++k) swt[k * 320 + ci] = convw[k * 1536 + xc];
          swt[4 * 320 + ci] = convb[xc]; } }
    int cibc = 64 + cg * 8; const int cix = wid * 8;
    const char* pub = (const char*)F.ws; const unsigned pxb = (unsigned)(WS_PROJ + ((size_t)b * SEQ_ * PP + PC_XBC) * 2), zoff = (unsigned)(WS_CTL + 524288);
    u32x4 inbc[11], inx[5];
#define SSD_PREFETCH(c_) do { \
        int sd_ = l0; asm volatile("" : "+v"(sd_)); \
        _Pragma("unroll") for (int j = 0; j < 11; ++j) { const int tt = (c_) * 128 + sd_ - 3 + j; inbc[j] = *(const u32x4*)(pub + ((tt >= 0) ? pxb + (unsigned)(tt * PP + colbc) * 2u : zoff)); } } while (0)
    SSD_PREFETCH(0);
    f32x16 hT; for (int i = 0; i < 16; ++i) hT[i] = 0.f;
    const int nb = wid & 3, pb = wid >> 2;
    __syncthreads();
    for (int c = 0; c < 16; ++c) {
        { int t_ = threadIdx.x; asm volatile("" : "+v"(t_)); tid = t_; lane = t_ & 63; r32 = lane & 31; hh = lane >> 5; seg = t_ >> 5; cg = t_ & 31; l0 = seg * 8; lx = 2 * lane;
          colbc = (cg < 16) ? (1024 + g * 128 + cg * 8) : (1280 + g * 128 + (cg - 16) * 8); cibc = 64 + cg * 8; }
        const size_t t0 = (size_t)b * SEQ_ + c * 128;
        const LAS float* cdt = sdt + c * 128; const LAS float* cac = sac + c * 128;
        const float aend = cac[127];
#pragma unroll
        for (int j = 0; j < 5; ++j) { int sd_ = lx; asm volatile("" : "+v"(sd_)); const int tt = c * 128 + sd_ - 3 + j; inx[j] = *(const u32x4*)(pub + ((tt >= 0) ? pxb + (unsigned)(tt * PP + colx) * 2u : zoff)); }
        {
            LAS unsigned char* hbp = lds + S_HB + (32 * pb + r32) * SP + (32 * nb + 4 * hh) * 2;
#pragma unroll
            for (int q4 = 0; q4 < 4; ++q4) { u32x2 w; w.x = pk2(hT[4 * q4], hT[4 * q4 + 1]); w.y = pk2(hT[4 * q4 + 2], hT[4 * q4 + 3]); *(LAS u32x2*)(hbp + 16 * q4) = w; }
        }
        {
            float wbc[5][8];
#pragma unroll
            for (int k = 0; k < 5; ++k) { const f32x4 w0 = *(const LAS f32x4*)(swt + k * 320 + cibc), w1 = *(const LAS f32x4*)(swt + k * 320 + cibc + 4);
#pragma unroll
                for (int i = 0; i < 4; ++i) { wbc[k][i] = w0[i]; wbc[k][4 + i] = w1[i]; } }
#pragma unroll
            for (int hf = 0; hf < 2; ++hf) {
                __builtin_amdgcn_sched_barrier(0);
                float o[4][8];
#pragma unroll
                for (int j = 0; j < 4; ++j)
#pragma unroll
                    for (int i = 0; i < 8; ++i) { float s = wbc[4][i];
#pragma unroll
                        for (int k = 0; k < 4; ++k) { const unsigned wd = inbc[4 * hf + j + k][i >> 1]; s += wbc[k][i] * ((i & 1) ? bfhi(wd) : bflo(wd)); }
                        o[j][i] = fsilu(s); }
                const int lh = l0 + 4 * hf;
                if (cg < 16) {
                    const int n0 = cg * 8; float ev[4];
#pragma unroll
                    for (int j = 0; j < 4; ++j) { ev[j] = fexp(aend - cac[lh + j]);
                        u32x4 w1; w1.x = pk2(o[j][0], o[j][1]); w1.y = pk2(o[j][2], o[j][3]); w1.z = pk2(o[j][4], o[j][5]); w1.w = pk2(o[j][6], o[j][7]);
                        *(LAS u32x4*)(lds + S_BM + (lh + j) * SP + n0 * 2) = w1; }
#pragma unroll
                    for (int i = 0; i < 8; ++i) { u32x2 w2; w2.x = pk2(o[0][i] * ev[0], o[1][i] * ev[1]); w2.y = pk2(o[2][i] * ev[2], o[3][i] * ev[3]);
                        *(LAS u32x2*)(lds + S_BT + (n0 + i) * SP + lh * 2) = w2; }
                } else {
                    const int n0 = (cg - 16) * 8;
#pragma unroll
                    for (int j = 0; j < 4; ++j) { u32x4 w1; w1.x = pk2(o[j][0], o[j][1]); w1.y = pk2(o[j][2], o[j][3]); w1.z = pk2(o[j][4], o[j][5]); w1.w = pk2(o[j][6], o[j][7]);
                        *(LAS u32x4*)(lds + S_C + (lh + j) * SP + n0 * 2) = w1; }
                }
            }
        }
        __builtin_amdgcn_sched_barrier(0);
        {
            const float d0 = cdt[lx], d1 = cdt[lx + 1];
            float wx[5][8];
#pragma unroll
            for (int k = 0; k < 5; ++k) { const f32x4 w0 = *(const LAS f32x4*)(swt + k * 320 + cix), w1 = *(const LAS f32x4*)(swt + k * 320 + cix + 4);
#pragma unroll
                for (int i = 0; i < 4; ++i) { wx[k][i] = w0[i]; wx[k][4 + i] = w1[i]; } }
#pragma unroll
            for (int i = 0; i < 8; ++i) { float s0 = wx[4][i], s1 = wx[4][i];
#pragma unroll
                for (int k = 0; k < 4; ++k) { const unsigned w0 = inx[k][i >> 1], w1 = inx[k + 1][i >> 1];
                    s0 += wx[k][i] * ((i & 1) ? bfhi(w0) : bflo(w0)); s1 += wx[k][i] * ((i & 1) ? bfhi(w1) : bflo(w1)); }
                *(LAS unsigned*)(lds + S_XDT + (wid * 8 + i) * SP + lx * 2) = pk2(fsilu(s0) * d0, fsilu(s1) * d1); }
        }
        if (c < 15) SSD_PREFETCH(c + 1);
        __syncthreads();
        const int lb = wid >> 1;
        f32x16 xt[2];
        {
            bf16x8 cf[8];
#pragma unroll
            for (int ks = 0; ks < 8; ++ks) cf[ks] = ldfrag(lds + S_C, 32 * lb + r32, 16 * ks + 8 * hh);
#pragma unroll
            for (int q = 0; q < 2; ++q) { const int sb = 2 * (wid & 1) + q;
                for (int i = 0; i < 16; ++i) xt[q][i] = 0.f;
                if (sb <= lb) {
                    bf16x8 bfr[8];
#pragma unroll
                    for (int ks = 0; ks < 8; ++ks) bfr[ks] = ldfrag(lds + S_BM, 32 * sb + r32, 16 * ks + 8 * hh);
                    __builtin_amdgcn_sched_barrier(0);
#pragma unroll
                    for (int ks = 0; ks < 8; ++ks) xt[q] = MFMA32(bfr[ks], cf[ks], xt[q]);
                }
            }
        }
        __syncthreads();
        {
            const int l = 32 * lb + r32; const float al = cac[l], ddl = dsk * __builtin_amdgcn_rcpf(cdt[l]);
            f32x4 cs[2][4];
#pragma unroll
            for (int q = 0; q < 2; ++q)
#pragma unroll
                for (int q4 = 0; q4 < 4; ++q4) cs[q][q4] = *(const LAS f32x4*)(cac + 32 * (2 * (wid & 1) + q) + 8 * q4 + 4 * hh);
#pragma unroll
            for (int q = 0; q < 2; ++q) { const int sb = 2 * (wid & 1) + q;
#pragma unroll
                for (int q4 = 0; q4 < 4; ++q4) { float mv[4];
#pragma unroll
                    for (int e = 0; e < 4; ++e) { const int s = 32 * sb + 8 * q4 + 4 * hh + e;
                        const float ev = fexp(fminf(al - cs[q][q4][e], 0.f));
                        float v = (s <= l) ? xt[q][4 * q4 + e] * ev : 0.f;
                        v += (s == l) ? ddl : 0.f;
                        mv[e] = v; }
                    u32x2 w; w.x = pk2(mv[0], mv[1]); w.y = pk2(mv[2], mv[3]);
                    *(LAS u32x2*)(lds + S_BM + l * SP + (32 * sb + 8 * q4 + 4 * hh) * 2) = w; }
            }
        }
        __syncthreads();
        {
            const int lb2 = wid & 3, pb2 = wid >> 2; const int l = 32 * lb2 + r32; const size_t tok = t0 + l;
            const int pc0 = hd * 64 + 32 * pb2 + 4 * hh;
            u32x2 zz[4];
#pragma unroll
            for (int q4 = 0; q4 < 4; ++q4) zz[q4] = *(const u32x2*)(proj + tok * PP + pc0 + 8 * q4);
            f32x16 y1, y2; for (int i = 0; i < 16; ++i) { y1[i] = 0.f; y2[i] = 0.f; }
            bf16x8 fa[8], fb[8];
#pragma unroll
            for (int ks = 0; ks < 8; ++ks) { fa[ks] = ldfrag(lds + S_XDT, 32 * pb2 + r32, 16 * ks + 8 * hh); fb[ks] = ldfrag(lds + S_BM, 32 * lb2 + r32, 16 * ks + 8 * hh); }
            __builtin_amdgcn_sched_barrier(0);
#pragma unroll
            for (int ks = 0; ks < 8; ++ks) { if (ks < 2 * (lb2 + 1)) y1 = MFMA32(fa[ks], fb[ks], y1); }
            const float cd = fexp(aend);
#pragma unroll
            for (int i = 0; i < 16; ++i) hT[i] *= cd;
#pragma unroll
            for (int ks = 0; ks < 8; ++ks) fb[ks] = ldfrag(lds + S_BT, 32 * nb + r32, 16 * ks + 8 * hh);
            __builtin_amdgcn_sched_barrier(0);
#pragma unroll
            for (int ks = 0; ks < 8; ++ks) hT = MFMA32(fb[ks], fa[ks], hT);
#pragma unroll
            for (int ks = 0; ks < 8; ++ks) { fa[ks] = ldfrag(lds + S_HB, 32 * pb2 + r32, 16 * ks + 8 * hh); fb[ks] = ldfrag(lds + S_C, 32 * lb2 + r32, 16 * ks + 8 * hh); }
            __builtin_amdgcn_sched_barrier(0);
#pragma unroll
            for (int ks = 0; ks < 8; ++ks) y2 = MFMA32(fa[ks], fb[ks], y2);
            const float el = fexp(cac[l]);
#pragma unroll
            for (int q4 = 0; q4 < 4; ++q4) { float yv[4];
#pragma unroll
                for (int e = 0; e < 4; ++e) { const float z = (e & 1) ? bfhi(e < 2 ? zz[q4].x : zz[q4].y) : bflo(e < 2 ? zz[q4].x : zz[q4].y);
                    yv[e] = (y1[4 * q4 + e] + el * y2[4 * q4 + e]) * fsilu(z); }
                u32x2 w; w.x = pk2(yv[0], yv[1]); w.y = pk2(yv[2], yv[3]);
                *(u32x2*)(yg + tok * 1024 + pc0 + 8 * q4) = w; }
        }
        __syncthreads();
    }
#undef SSD_PREFETCH
}

DI void attn_phase_da(Frame& F) {
    const attn_body::bf16* proj = (const attn_body::bf16*)(F.ws + WS_PROJ);
    if (threadIdx.x == 0) F.MISC[120] = __hip_atomic_fetch_add(F.ctl + CW_QATT, 1u, __ATOMIC_RELAXED, __HIP_MEMORY_SCOPE_AGENT);
    __syncthreads();
    int u = __builtin_amdgcn_readfirstlane((int)F.MISC[120]);
    while (u < 1024) {
        unsigned pend = 0u;
        const int qb = 7 - (u >> 7), combo = u & 127;
        const int half = combo & 1, j = (combo >> 1) & 1, h = (combo >> 2) & 7, b = combo >> 5;
        attn_body::bf16* O = (attn_body::bf16*)(F.ws + (j ? WS_O1 : WS_O0));
        attn_body::attn_unit<8>(b, PC_Q + (h * 2 + j) * 64, PC_V + h * 128 + half * 64, h * 128 + half * 64, qb, proj, proj + (PC_K - PC_Q), proj, O, (char*)F.lds, F.ctl + CW_QATT, pend);
        if (threadIdx.x == 0) F.MISC[120] = pend;
        __syncthreads();
        u = __builtin_amdgcn_readfirstlane((int)F.MISC[120]);
    }
}

DI void p3_finalize(Frame& F, const ArgP& a) {
    const int gw = F.vcu * NWAVES + F.wave, NGW = F.G * NWAVES, lane = F.lane;
    bf16_t* ycat = (bf16_t*)(F.ws + WS_YCAT); const bf16_t* yg = (const bf16_t*)(F.ws + WS_YG); const bf16_t* o0 = (const bf16_t*)(F.ws + WS_O0); const bf16_t* o1 = (const bf16_t*)(F.ws + WS_O1);
    float l1 = a.in(I_LQ1)[lane] * a.in(I_LK1)[lane], l2 = a.in(I_LQ2)[lane] * a.in(I_LK2)[lane];
    const float lam = __expf(wave_sum(l1)) - __expf(wave_sum(l2)) + LAM_INIT;
    for (int m = gw; m < NTOK; m += NGW) {
        { bf16_t* yp = ycat + (size_t)m * 2048 + 16 * lane; const bf16_t* gp = yg + (size_t)m * 1024 + 16 * lane;
          const u32x4 r0 = *(const u32x4*)gp, r1 = *(const u32x4*)(gp + 8);
          float v[16]; v[0] = bflo(r0.x); v[1] = bfhi(r0.x); v[2] = bflo(r0.y); v[3] = bfhi(r0.y); v[4] = bflo(r0.z); v[5] = bfhi(r0.z); v[6] = bflo(r0.w); v[7] = bfhi(r0.w);
          v[8] = bflo(r1.x); v[9] = bfhi(r1.x); v[10] = bflo(r1.y); v[11] = bfhi(r1.y); v[12] = bflo(r1.z); v[13] = bfhi(r1.z); v[14] = bflo(r1.w); v[15] = bfhi(r1.w);
          float ss = 0.f;
#pragma unroll
          for (int i = 0; i < 16; ++i) ss += v[i] * v[i];
#pragma unroll
          for (int o = 1; o < 32; o <<= 1) ss += __shfl_xor(ss, o);
          const float rs = 1.f / sqrtf(ss * (1.f / 512.f) + EPS_);
          const float* g = a.in(I_SSDG) + 16 * lane;
          u32x4 w0, w1;
          w0.x = pk2(v[0] * rs * g[0], v[1] * rs * g[1]); w0.y = pk2(v[2] * rs * g[2], v[3] * rs * g[3]); w0.z = pk2(v[4] * rs * g[4], v[5] * rs * g[5]); w0.w = pk2(v[6] * rs * g[6], v[7] * rs * g[7]);
          w1.x = pk2(v[8] * rs * g[8], v[9] * rs * g[9]); w1.y = pk2(v[10] * rs * g[10], v[11] * rs * g[11]); w1.z = pk2(v[12] * rs * g[12], v[13] * rs * g[13]); w1.w = pk2(v[14] * rs * g[14], v[15] * rs * g[15]);
          *(u32x4*)yp = w0; *(u32x4*)(yp + 8) = w1; }
        { const bf16_t* p0 = o0 + (size_t)m * 1024 + 16 * lane; const bf16_t* p1 = o1 + (size_t)m * 1024 + 16 * lane;
          const u32x4 a0 = *(const u32x4*)p0, a1 = *(const u32x4*)(p0 + 8), b0 = *(const u32x4*)p1, b1 = *(const u32x4*)(p1 + 8);
          float v[16];
          v[0] = bflo(a0.x) - lam * bflo(b0.x); v[1] = bfhi(a0.x) - lam * bfhi(b0.x); v[2] = bflo(a0.y) - lam * bflo(b0.y); v[3] = bfhi(a0.y) - lam * bfhi(b0.y);
          v[4] = bflo(a0.z) - lam * bflo(b0.z); v[5] = bfhi(a0.z) - lam * bfhi(b0.z); v[6] = bflo(a0.w) - lam * bflo(b0.w); v[7] = bfhi(a0.w) - lam * bfhi(b0.w);
          v[8] = bflo(a1.x) - lam * bflo(b1.x); v[9] = bfhi(a1.x) - lam * bfhi(b1.x); v[10] = bflo(a1.y) - lam * bflo(b1.y); v[11] = bfhi(a1.y) - lam * bfhi(b1.y);
          v[12] = bflo(a1.z) - lam * bflo(b1.z); v[13] = bfhi(a1.z) - lam * bfhi(b1.z); v[14] = bflo(a1.w) - lam * bflo(b1.w); v[15] = bfhi(a1.w) - lam * bfhi(b1.w);
          float ss = 0.f;
#pragma unroll
          for (int i = 0; i < 16; ++i) ss += v[i] * v[i];
          ss += __shfl_xor(ss, 1); ss += __shfl_xor(ss, 2); ss += __shfl_xor(ss, 4);
          const float rs = 1.f / sqrtf(ss * (1.f / 128.f) + EPS_) * (1.f - LAM_INIT);
          const float* g = a.in(I_SUBG) + 16 * (lane & 7);
          u32x4 w0, w1;
          w0.x = pk2(v[0] * rs * g[0], v[1] * rs * g[1]); w0.y = pk2(v[2] * rs * g[2], v[3] * rs * g[3]); w0.z = pk2(v[4] * rs * g[4], v[5] * rs * g[5]); w0.w = pk2(v[6] * rs * g[6], v[7] * rs * g[7]);
          w1.x = pk2(v[8] * rs * g[8], v[9] * rs * g[9]); w1.y = pk2(v[10] * rs * g[10], v[11] * rs * g[11]); w1.z = pk2(v[12] * rs * g[12], v[13] * rs * g[13]); w1.w = pk2(v[14] * rs * g[14], v[15] * rs * g[15]);
          bf16_t* yp = ycat + (size_t)m * 2048 + 1024 + 16 * lane;
          *(u32x4*)yp = w0; *(u32x4*)(yp + 8) = w1; }
    }
}

struct SchedDense {
    int G, c, nM, nN; const char* A; const char* B; unsigned lda, ldb; int bdiv; size_t bstride;
    DI bool next(int i, pg8::UnitD& u) const {
        const int L = i * G + c; if (L >= nM * nN) return false;
        u.rows = nullptr; u.nvalid = 0; u.lda = lda; u.ldb = ldb; u.type = 0; u.e = 0; u.x0 = 0;
        if (G == 256 && nM == 32 && nN == 8) { const int x = L >> 5, s = L & 31; u.pm = (x & 3) * 8 + (s & 7); u.pn = (x >> 2) * 4 + (s >> 3); }
        else { u.pn = L / nM; u.pm = L % nM; }
        u.A = A + (size_t)u.pm * 256 * lda; u.B = B + (size_t)u.pn * 256 * ldb + (size_t)(u.pm / bdiv) * bstride;
        return true;
    }
};
template <bool BASE_BF16>
struct EpiResid {
    static constexpr bool AFTER_DRAIN = false;
    const void* base; bf16_t* out; float* part; unsigned char* out8; float accscale;
    DI void operator()(const f32x4 (&acc)[2][2][4][2], const pg8::UnitD& u, int wr, int wc, int fr, int fq) const {
        { int ln_ = threadIdx.x; asm volatile("" : "+v"(ln_)); fr = ln_ & 15; fq = (ln_ >> 4) & 3; }
        const int row0 = u.pm * 256 + wr * 64 + fr, col0 = u.pn * 256 + wc * 32 + 8 * fq;
#pragma unroll
        for (int ai = 0; ai < 2; ++ai)
#pragma unroll
            for (int m = 0; m < 4; ++m) { const size_t row = (size_t)(row0 + ai * 128 + m * 16); float ss = 0.f;
#pragma unroll
                for (int bj = 0; bj < 2; ++bj) { const size_t idx = row * 2048 + col0 + bj * 128;
                    f32x4 b0, b1;
                    if constexpr (BASE_BF16) { const u32x4 r = *(const u32x4*)((const bf16_t*)base + idx); b0 = (f32x4){bflo(r.x), bfhi(r.x), bflo(r.y), bfhi(r.y)}; b1 = (f32x4){bflo(r.z), bfhi(r.z), bflo(r.w), bfhi(r.w)}; }
                    else { b0 = *(const f32x4*)((const float*)base + idx); b1 = *(const f32x4*)((const float*)base + idx + 4); }
                    const f32x4 v0 = acc[ai][bj][m][0] * accscale + b0, v1 = acc[ai][bj][m][1] * accscale + b1;
                    { u32x4 w; w.x = pk2(v0[0], v0[1]); w.y = pk2(v0[2], v0[3]); w.z = pk2(v1[0], v1[1]); w.w = pk2(v1[2], v1[3]); *(u32x4*)(out + idx) = w; }
                    if (out8) { u32x2 w; w.x = __builtin_amdgcn_cvt_pk_fp8_f32(v0[0] * 16.f, v0[1] * 16.f, 0u, false); w.x = __builtin_amdgcn_cvt_pk_fp8_f32(v0[2] * 16.f, v0[3] * 16.f, w.x, true);
                        w.y = __builtin_amdgcn_cvt_pk_fp8_f32(v1[0] * 16.f, v1[1] * 16.f, 0u, false); w.y = __builtin_amdgcn_cvt_pk_fp8_f32(v1[2] * 16.f, v1[3] * 16.f, w.y, true); *(u32x2*)(out8 + idx) = w; }
                    ss += (v0[0] * v0[0] + v0[1] * v0[1]) + (v0[2] * v0[2] + v0[3] * v0[3]) + (v1[0] * v1[0] + v1[1] * v1[1]) + (v1[2] * v1[2] + v1[3] * v1[3]); }
                if (part) { ss += __shfl_xor(ss, 16); ss += __shfl_xor(ss, 32); if (fq == 0) part[row * 32 + u.pn * 4 + wc] = ss; } }
    }
};

struct EpiQ {
    static constexpr bool AFTER_DRAIN = false;
    unsigned char* out8; float* part;
    DI void operator()(const f32x4 (&acc)[2][2][4][2], const pg8::UnitD& u, int wr, int wc, int fr, int fq) const {
        { int ln_ = threadIdx.x; asm volatile("" : "+v"(ln_)); fr = ln_ & 15; fq = (ln_ >> 4) & 3; }
        const int row0 = u.pm * 256 + wr * 64 + fr, col0 = u.pn * 256 + wc * 32 + 8 * fq;
#pragma unroll
        for (int ai = 0; ai < 2; ++ai)
#pragma unroll
            for (int m = 0; m < 4; ++m) { const size_t row = (size_t)(row0 + ai * 128 + m * 16); float ss = 0.f;
#pragma unroll
                for (int bj = 0; bj < 2; ++bj) { const size_t idx = row * 2048 + col0 + bj * 128; const f32x4 v0 = acc[ai][bj][m][0] * (1.f / 1024.f), v1 = acc[ai][bj][m][1] * (1.f / 1024.f);
                    u32x2 w; w.x = __builtin_amdgcn_cvt_pk_fp8_f32(v0[0] * 16.f, v0[1] * 16.f, 0u, false); w.x = __builtin_amdgcn_cvt_pk_fp8_f32(v0[2] * 16.f, v0[3] * 16.f, w.x, true);
                    w.y = __builtin_amdgcn_cvt_pk_fp8_f32(v1[0] * 16.f, v1[1] * 16.f, 0u, false); w.y = __builtin_amdgcn_cvt_pk_fp8_f32(v1[2] * 16.f, v1[3] * 16.f, w.y, true); *(u32x2*)(out8 + idx) = w;
                    ss += (v0[0] * v0[0] + v0[1] * v0[1]) + (v0[2] * v0[2] + v0[3] * v0[3]) + (v1[0] * v1[0] + v1[1] * v1[1]) + (v1[2] * v1[2] + v1[3] * v1[3]); }
                ss += __shfl_xor(ss, 16); ss += __shfl_xor(ss, 32); if (fq == 0) part[row * 32 + u.pn * 4 + wc] = ss; }
    }
};

struct SchedXS {
    int G, c; const unsigned char* ws;
    DI bool next(int i, pg8::UnitD& u) const {
        const int L = i * G + c; if (L >= 256) return false;
        u.rows = nullptr; u.nvalid = 0; u.e = 0;
        const int q = L & 127, bh = q >> 3, t8 = q & 7, b = bh >> 2, h = bh & 3;
        u.pm = b; u.pn = h; u.x0 = t8;
        if (L < 128) { u.type = 0; u.lda = 2048u; u.ldb = 512u;
            u.A = (const char*)(ws + WS_QF8) + (size_t)(b * 2048 + t8 * 256) * 2048 + h * 512; u.B = (const char*)(ws + WS_KN8) + (size_t)(bh * 256) * 512; }
        else { u.type = 1; u.lda = 2048u; u.ldb = 2048u;
            u.A = (const char*)(ws + WS_WO) + (size_t)(t8 * 256) * 2048 + h * 512; u.B = (const char*)(ws + WS_VF8) + (size_t)(b * 256) * 2048 + h * 512; }
        return true;
    }
};
struct EpiXS {
    static constexpr bool AFTER_DRAIN = false;
    unsigned char* P; unsigned char* VWT; const float* part1; const float* partq; LAS float* red;
    DI void operator()(const f32x4 (&acc)[2][2][4][2], const pg8::UnitD& u, int wr, int wc, int fr, int fq) const {
        { int ln_ = threadIdx.x; asm volatile("" : "+v"(ln_)); fr = ln_ & 15; fq = (ln_ >> 4) & 3; }
        const int b = u.pm, h = u.pn, t8 = u.x0;
        const int col0 = wc * 32 + 8 * fq;
        if (u.type == 1) {
            unsigned char* Vu = VWT + ((size_t)b * 2048 + t8 * 256) * 1024 + h * 256;
#pragma unroll
            for (int ai = 0; ai < 2; ++ai)
#pragma unroll
                for (int m = 0; m < 4; ++m) { const unsigned rl = (unsigned)(ai * 128 + wr * 64 + m * 16 + fr);
#pragma unroll
                    for (int bj = 0; bj < 2; ++bj) { const f32x4 v0 = acc[ai][bj][m][0] * (32.f / 1024.f), v1 = acc[ai][bj][m][1] * (32.f / 1024.f);
                        u32x2 w; w.x = __builtin_amdgcn_cvt_pk_fp8_f32(v0[0], v0[1], 0u, false); w.x = __builtin_amdgcn_cvt_pk_fp8_f32(v0[2], v0[3], w.x, true);
                        w.y = __builtin_amdgcn_cvt_pk_fp8_f32(v1[0], v1[1], 0u, false); w.y = __builtin_amdgcn_cvt_pk_fp8_f32(v1[2], v1[3], w.y, true);
                        *(u32x2*)(Vu + (rl * 1024u + (unsigned)(bj * 128 + col0))) = w; } }
            return;
        }
        const size_t row0 = (size_t)b * 2048 + t8 * 256;
        const char* p1u = (const char*)(part1 + row0 * 32); const char* pqu = (const char*)(partq + row0 * 32 + h * 8); unsigned char* Pu = P + row0 * 1024 + h * 256;
        float rsc[2][4];
#pragma unroll
        for (int ai = 0; ai < 2; ++ai)
#pragma unroll
            for (int m = 0; m < 4; ++m) { const unsigned rl = (unsigned)(ai * 128 + wr * 64 + m * 16 + fr);
                const f32x4 p0 = *(const f32x4*)(p1u + (rl * 32u + (unsigned)fq * 8u) * 4u), p1 = *(const f32x4*)(p1u + (rl * 32u + (unsigned)fq * 8u + 4u) * 4u);
                float s1 = (p0[0] + p0[1]) + (p0[2] + p0[3]) + (p1[0] + p1[1]) + (p1[2] + p1[3]);
                const f32x2 pq = *(const f32x2*)(pqu + (rl * 32u + (unsigned)fq * 2u) * 4u);
                float sq = pq[0] + pq[1];
                s1 = quad_sum_16_32(s1); sq = quad_sum_16_32(sq);
                rsc[ai][m] = __builtin_amdgcn_rsqf(sq * (1.f / 512.f) + EPS_ * (s1 * (1.f / 2048.f) + EPS_)) * (1.4426950408889634f / 2048.f);
                float ps = 0.f;
#pragma unroll
                for (int bj = 0; bj < 2; ++bj)
#pragma unroll
                    for (int n = 0; n < 2; ++n)
#pragma unroll
                        for (int e = 0; e < 4; ++e) ps += __builtin_amdgcn_exp2f(fminf(acc[ai][bj][m][n][e] * rsc[ai][m], 100.f));
                ps = quad_sum_16_32(ps);
                if (fq == 0) red[rl * 4 + wc] = ps;
                __builtin_amdgcn_sched_barrier(0); }
        __syncthreads();
        { int ln_ = threadIdx.x; asm volatile("" : "+v"(ln_)); fr = ln_ & 15; fq = (ln_ >> 4) & 3; }
#pragma unroll
        for (int ai = 0; ai < 2; ++ai)
#pragma unroll
            for (int m = 0; m < 4; ++m) { const unsigned rl = (unsigned)(ai * 128 + wr * 64 + m * 16 + fr);
                const f32x4 t = *(const LAS f32x4*)(red + rl * 4); const float inv = 256.f * __builtin_amdgcn_rcpf((t[0] + t[1]) + (t[2] + t[3])); float rs = rsc[ai][m]; asm volatile("" : "+v"(rs));
#pragma unroll
                for (int bj = 0; bj < 2; ++bj) { float x[8];
#pragma unroll
                    for (int n = 0; n < 2; ++n)
#pragma unroll
                        for (int e = 0; e < 4; ++e) x[n * 4 + e] = __builtin_amdgcn_exp2f(fminf(acc[ai][bj][m][n][e] * rs, 100.f)) * inv;
                    u32x2 w; w.x = __builtin_amdgcn_cvt_pk_fp8_f32(x[0], x[1], 0u, false); w.x = __builtin_amdgcn_cvt_pk_fp8_f32(x[2], x[3], w.x, true);
                    w.y = __builtin_amdgcn_cvt_pk_fp8_f32(x[4], x[5], 0u, false); w.y = __builtin_amdgcn_cvt_pk_fp8_f32(x[6], x[7], w.y, true);
                    *(u32x2*)(Pu + (rl * 1024u + (unsigned)(bj * 128 + wc * 32 + 8 * fq))) = w; } }
        __syncthreads();
    }
};

constexpr int HNP = 2052;
DI void p8_route(Frame& F, const ArgP& a) {
    LAS float* s_hn = (LAS float*)F.lds; LAS float* s_part = (LAS float*)(F.lds + 16 * HNP * 4); LAS float* s_log = s_part + 8 * 16 * 32; LAS int* s_slot = (LAS int*)(s_log + 16 * 32);
    LAS int* s_cnt = s_slot + 64; LAS int* s_base = s_cnt + 32;
    const bf16_t* h2 = (const bf16_t*)(F.ws + WS_H2); unsigned char* xg = (unsigned char*)(F.ws + WS_XG);
    float* gate_of = (float*)(F.ws + WS_GATEOF); int* tok_e = (int*)(F.ws + WS_TOKE);
    const float* rw = a.in(I_RW); const float* rb = a.in(I_RB); const float* g3 = a.in(I_GFFN);
    const int lane = F.lane, wave = F.wave, tid = F.tid;
    float bw0[64], bw1[64];
    { const int kq = lane >> 4, c16 = lane & 15; const float* bp = rw + (size_t)(256 * wave + kq) * 32 + c16;
#pragma unroll
      for (int j = 0; j < 64; ++j) { bw0[j] = bp[(size_t)(4 * j) * 32]; bw1[j] = bp[(size_t)(4 * j) * 32 + 16]; } }
    for (int task = F.vcu; task < NTOK / 16; task += F.G) {
        const int tb = task * 16;
#pragma unroll
        for (int q = 0; q < 2; ++q) { const int tl = 2 * wave + q; const size_t tok = (size_t)(tb + tl);
            const u32x2* xr = (const u32x2*)(h2 + tok * 2048) + lane;
            f32x4 v[8]; float s = 0.f;
#pragma unroll
            for (int j = 0; j < 8; ++j) { const u32x2 rw_ = xr[64 * j]; v[j] = (f32x4){bflo(rw_.x), bfhi(rw_.x), bflo(rw_.y), bfhi(rw_.y)}; s += (v[j].x * v[j].x + v[j].y * v[j].y) + (v[j].z * v[j].z + v[j].w * v[j].w); }
            const float rstd = 1.f / sqrtf(wave_sum(s) * (1.f / 2048.f) + EPS_);
#pragma unroll
            for (int j = 0; j < 8; ++j) { const f32x4 gg = ((const f32x4*)g3)[lane + 64 * j]; const f32x4 y = v[j] * rstd * gg;
                *(LAS f32x4*)(s_hn + tl * HNP + (lane + 64 * j) * 4) = y; } }
        __syncthreads();
        {
            f32x4 acc0 = {0.f, 0.f, 0.f, 0.f}, acc1 = {0.f, 0.f, 0.f, 0.f};
            const int kq = lane >> 4, c16 = lane & 15;
            const LAS float* ap = s_hn + c16 * HNP + 256 * wave;
#pragma unroll
            for (int j = 0; j < 64; ++j) { const f32x4 a4 = *(const LAS f32x4*)(ap + 4 * j);
                const float av = (kq == 0) ? a4.x : (kq == 1) ? a4.y : (kq == 2) ? a4.z : a4.w;
                acc0 = __builtin_amdgcn_mfma_f32_16x16x4f32(av, bw0[j], acc0, 0, 0, 0);
                acc1 = __builtin_amdgcn_mfma_f32_16x16x4f32(av, bw1[j], acc1, 0, 0, 0); }
            LAS float* pp = s_part + wave * 512 + c16;
#pragma unroll
            for (int r = 0; r < 4; ++r) { pp[(4 * kq + r) * 32] = acc0[r]; pp[(4 * kq + r) * 32 + 16] = acc1[r]; }
        }
        __syncthreads();
        {
            const int tt = tid >> 5, e = tid & 31; float lg = rb[e];
#pragma unroll
            for (int w = 0; w < 8; ++w) lg += s_part[w * 512 + tt * 32 + e];
            if (tid < 32) s_cnt[tid] = 0;
            float val[4]; int idx[4]; float cur = lg;
#pragma unroll
            for (int k = 0; k < 4; ++k) { float bv = cur; int bi = e;
#pragma unroll
                for (int o = 1; o < 32; o <<= 1) { const float ov = __shfl_xor(bv, o); const int oi = __shfl_xor(bi, o); if (ov > bv || (ov == bv && oi < bi)) { bv = ov; bi = oi; } }
                val[k] = bv; idx[k] = bi; if (e == bi) cur = -INFINITY; }
            __syncthreads();
            int myrank = 0, myexp = 0; float mygate = 0.f;
            if (e < 4) { const float sum = (__expf(val[0] - val[0]) + __expf(val[1] - val[0])) + (__expf(val[2] - val[0]) + __expf(val[3] - val[0]));
                const float mv = (e == 0) ? val[0] : (e == 1) ? val[1] : (e == 2) ? val[2] : val[3]; myexp = (e == 0) ? idx[0] : (e == 1) ? idx[1] : (e == 2) ? idx[2] : idx[3];
                mygate = __expf(mv - val[0]) / sum; myrank = __hip_atomic_fetch_add(&s_cnt[myexp], 1, __ATOMIC_RELAXED, __HIP_MEMORY_SCOPE_WORKGROUP); }
            __syncthreads();
            if (tid < 32) { const int c = s_cnt[tid]; s_base[tid] = c ? (int)__hip_atomic_fetch_add(F.ctl + CW_CNT + 64 * tid, (unsigned)c, __ATOMIC_RELAXED, __HIP_MEMORY_SCOPE_AGENT) : 0; }
            __syncthreads();
            if (e < 4) { const int slot = myexp * 8192 + s_base[myexp] + myrank; const int tok = tb + tt;
                gate_of[slot] = mygate; tok_e[tok * 4 + e] = slot; s_slot[tt * 4 + e] = slot; }
        }
        __syncthreads();
#pragma unroll
        for (int q = 0; q < 2; ++q) { const int tl = 2 * wave + q;
            unsigned o[8];
#pragma unroll
            for (int j = 0; j < 8; ++j) { const f32x4 y = *(const LAS f32x4*)(s_hn + tl * HNP + (lane + 64 * j) * 4);
                unsigned w = 0u; w = __builtin_amdgcn_cvt_pk_fp8_f32(y.x * 4.f, y.y * 4.f, w, false); w = __builtin_amdgcn_cvt_pk_fp8_f32(y.z * 4.f, y.w * 4.f, w, true); o[j] = w; }
#pragma unroll
            for (int k = 0; k < 4; ++k) { unsigned* o4 = (unsigned*)(xg + (size_t)s_slot[tl * 4 + k] * 2048) + lane;
#pragma unroll
                for (int j = 0; j < 8; ++j) o4[64 * j] = o[j]; } }
        __syncthreads();
    }
}

DI void moe_tables(Frame& F) {
    if (F.tid < 64) { const int e = F.tid & 31;
        const unsigned c = F.ctl[CW_CNT + 64 * e], mt = (c + 255u) >> 8;
        unsigned incl = mt;
#pragma unroll
        for (int o = 1; o < 32; o <<= 1) { const unsigned v = __shfl_up(incl, o, 64); if (e >= o) incl += v; }
        const unsigned base = incl - mt;
        if (F.tid < 32) { F.MISC[16 + e] = c; F.MISC[48 + e] = base; F.MISC[80 + e] = mt; if (e == 31) F.MISC[112] = incl;
            volatile LAS unsigned char* tab = (volatile LAS unsigned char*)(F.MISC + 128);
            for (unsigned t = 0; t < mt; ++t) tab[base + t] = (unsigned char)e; } }
    __syncthreads();
}
DI int ldsu(volatile LAS unsigned* p) { return __builtin_amdgcn_readfirstlane((int)*p); }
template <int NTN  >
struct SchedMoe {
    int G, c; const unsigned char* ws; volatile LAS unsigned* MISC; int total;
    DI bool next(int i, pg8::UnitD& u) const {
        const int L = i * G + c; if (L >= total) return false;
        const int e = __builtin_amdgcn_readfirstlane((int)((volatile LAS unsigned char*)(MISC + 128))[L / NTN]);
        const int tb = ldsu(MISC + 48 + e), mte = ldsu(MISC + 80 + e), cnt = ldsu(MISC + 16 + e);
        const int local = L - tb * NTN, nt = local / mte, mt = local % mte;
        u.type = 0; u.e = e; u.pn = nt; u.pm = tb + mt; u.x0 = mt; u.lda = 2048u; u.ldb = 128u;
        u.rows = nullptr; u.nvalid = cnt - mt * 256;
        if (NTN == 16) { u.A = (const char*)(ws + WS_XG) + ((size_t)e * 8192 + (size_t)mt * 256) * 2048;
            u.B = (const char*)(ws + WS_W1) + ((size_t)e * 4096 + (size_t)nt * 256) * 2048; }
        else { u.A = (const char*)(ws + WS_ACT) + ((size_t)e * 8192 + (size_t)mt * 256) * 2048;
            u.B = (const char*)(ws + WS_W2) + ((size_t)e * 2048 + (size_t)nt * 256) * 2048; }
        return true;
    }
};
struct EpiMoe1 {
    static constexpr bool AFTER_DRAIN = false;
    unsigned char* act; const float* b1;
    DI void operator()(const f32x4 (&acc)[2][2][4][2], const pg8::UnitD& u, int wr, int wc, int fr, int fq) const {
        { int ln_ = threadIdx.x; asm volatile("" : "+v"(ln_)); fr = ln_ & 15; fq = (ln_ >> 4) & 3; }
        const int j0 = u.pn * 128 + wc * 32 + 8 * fq;
        const float* bg = b1 + (size_t)u.e * 4096 + j0; const float* bu = bg + 2048;
        const f32x4 bg0 = *(const f32x4*)bg, bg1 = *(const f32x4*)(bg + 4), bu0 = *(const f32x4*)bu, bu1 = *(const f32x4*)(bu + 4);
#pragma unroll
        for (int ai = 0; ai < 2; ++ai)
#pragma unroll
            for (int m = 0; m < 4; ++m) { const size_t row = (size_t)u.e * 8192 + u.x0 * 256 + ai * 128 + wr * 64 + m * 16 + fr;
                float o[8];
#pragma unroll
                for (int n = 0; n < 2; ++n)
#pragma unroll
                    for (int e = 0; e < 4; ++e) { const float g = fminf(acc[ai][0][m][n][e] * (1.f / 256.f) + (n ? bg1[e] : bg0[e]), 7.f);
                        const float uu = fminf(fmaxf(acc[ai][1][m][n][e] * (1.f / 256.f) + (n ? bu1[e] : bu0[e]), -7.f), 7.f);
                        o[n * 4 + e] = g * __builtin_amdgcn_rcpf(1.f + __builtin_amdgcn_exp2f(g * (-1.702f * 1.4426950408889634f))) * (uu + 1.f) * 4.f; }
                u32x2 w; w.x = __builtin_amdgcn_cvt_pk_fp8_f32(o[0], o[1], 0u, false); w.x = __builtin_amdgcn_cvt_pk_fp8_f32(o[2], o[3], w.x, true);
                w.y = __builtin_amdgcn_cvt_pk_fp8_f32(o[4], o[5], 0u, false); w.y = __builtin_amdgcn_cvt_pk_fp8_f32(o[6], o[7], w.y, true);
                *(u32x2*)(act + row * 2048 + j0) = w;
                __builtin_amdgcn_sched_barrier(0); }
    }
};
struct EpiMoe2 {
    static constexpr bool AFTER_DRAIN = false;
    unsigned char* y; const float* b2; const float* gate_of;
    DI void operator()(const f32x4 (&acc)[2][2][4][2], const pg8::UnitD& u, int wr, int wc, int fr, int fq) const {
        { int ln_ = threadIdx.x; asm volatile("" : "+v"(ln_)); fr = ln_ & 15; fq = (ln_ >> 4) & 3; }
        const int col0 = u.pn * 256 + wc * 32 + 8 * fq;
        const float* bp = b2 + (size_t)u.e * 2048 + col0;
#pragma unroll
        for (int ai = 0; ai < 2; ++ai)
#pragma unroll
            for (int m = 0; m < 4; ++m) { const int rl = ai * 128 + wr * 64 + m * 16 + fr; const size_t row = (size_t)u.e * 8192 + u.x0 * 256 + rl;
                const float gt = (rl < u.nvalid) ? gate_of[u.e * 8192 + u.x0 * 256 + rl] * 32.f : 0.f;
#pragma unroll
                for (int bj = 0; bj < 2; ++bj) { const f32x4 v0 = (acc[ai][bj][m][0] * (1.f / 256.f) + *(const f32x4*)(bp + bj * 128)) * gt, v1 = (acc[ai][bj][m][1] * (1.f / 256.f) + *(const f32x4*)(bp + bj * 128 + 4)) * gt;
                    u32x2 w; w.x = __builtin_amdgcn_cvt_pk_fp8_f32(v0[0], v0[1], 0u, false); w.x = __builtin_amdgcn_cvt_pk_fp8_f32(v0[2], v0[3], w.x, true);
                    w.y = __builtin_amdgcn_cvt_pk_fp8_f32(v1[0], v1[1], 0u, false); w.y = __builtin_amdgcn_cvt_pk_fp8_f32(v1[2], v1[3], w.y, true);
                    *(u32x2*)(y + row * 2048 + col0 + bj * 128) = w; } }
    }
};

DI void p11_combine(Frame& F, const ArgP& a) {
    const int gw = F.vcu * NWAVES + F.wave, NGW = F.G * NWAVES, lane = F.lane;
    const bf16_t* h2 = (const bf16_t*)(F.ws + WS_H2); const unsigned char* y = (const unsigned char*)(F.ws + WS_Y);
    const int* tok_e = (const int*)(F.ws + WS_TOKE);
    for (int t = gw; t < NTOK; t += NGW) {
        size_t yrow[4];
#pragma unroll
        for (int k = 0; k < 4; ++k) yrow[k] = (size_t)tok_e[t * 4 + k] * 2048;
#pragma unroll
        for (int j = 0; j < 8; ++j) { const int c = (lane + 64 * j) * 4;
            const u32x2 hw = *(const u32x2*)(h2 + (size_t)t * 2048 + c); f32x4 v = {bflo(hw.x), bfhi(hw.x), bflo(hw.y), bfhi(hw.y)};
#pragma unroll
            for (int k = 0; k < 4; ++k) { const unsigned w = *(const unsigned*)(y + yrow[k] + c); const f32x2 lo = __builtin_amdgcn_cvt_pk_f32_fp8(w, false), hi = __builtin_amdgcn_cvt_pk_f32_fp8(w, true);
                v.x += lo.x * (1.f / 32.f); v.y += lo.y * (1.f / 32.f); v.z += hi.x * (1.f / 32.f); v.w += hi.y * (1.f / 32.f); }
            *(f32x4*)(a.out() + (size_t)t * 2048 + c) = v; }
    }
}

#ifndef MK_PER_PHASE
#define MK_PER_PHASE 0
#endif
#ifndef MK_LAST_PHASE
#define MK_LAST_PHASE 12
#endif
constexpr int N_PHASES = MK_LAST_PHASE;

__global__ void __launch_bounds__(NWAVES * 64, 2) mega_fwd(Args args_) {
    const ArgP args{};
    extern __shared__ __attribute__((aligned(16))) unsigned char lds_raw[];
    Frame F;
    F.lds = (LAS unsigned char*)lds_raw;
    F.MISC = (volatile LAS unsigned*)(F.lds + MISC_OFF);
    F.tid = threadIdx.x; F.lane = F.tid & 63; F.wave = __builtin_amdgcn_readfirstlane(F.tid >> 6);
    F.G = gridDim.x; { const int bx = blockIdx.x; F.vcu = (F.G % 8 == 0) ? (bx % 8) * (F.G / 8) + bx / 8 : bx; }
    F.ws = args_.ws; F.ctl = (unsigned*)(args_.ws + WS_CTL);
    for (int u = F.tid; u < 256; u += NWAVES * 64) F.MISC[u] = 0u;
    __syncthreads();
    XcdBarrier bar; bar.bar = F.ctl + CW_BAR; bar.x = 0; bar.st = nullptr;
    const int lo = args_.ph_lo, hi = args_.ph_hi;
    if (hi - lo > 1) bar = xcd_barrier_post(F.ctl + CW_BAR, F.MISC + 8);
#ifndef MK_PHASE_MASK
#define MK_PHASE_MASK 0xFFFF
#endif
#define IN(k) (((MK_PHASE_MASK >> (k)) & 1) && lo <= (k) && (k) < hi)
#define SEAM(k) do { if (IN(k) && IN((k) + 1)) xcd_barrier(bar); } while (0)
#define FRESH() do { int t_ = threadIdx.x; asm volatile("" : "+v"(t_)); F.tid = t_; F.lane = t_ & 63; F.wave = __builtin_amdgcn_readfirstlane(t_ >> 6); } while (0)
    unsigned char* ws = args_.ws;

    if (IN(0)) { FRESH(); p0_prologue(F, args); }
    SEAM(0);
    if (IN(1)) { FRESH();
        const bool conv_first = (F.vcu & 1) == 0;
        if (conv_first) { conv_share(F, args); __syncthreads(); }
        SchedP1 S{F.G, F.vcu, ws, 0, 32 * 23};
        EpiP1 E{(bf16_t*)(ws + WS_PROJ), (float*)(ws + WS_DT), (bf16_t*)(ws + WS_KVRAW), args.in(I_DAQG), args.in(I_DAKG), (unsigned char*)(ws + WS_VF8)};
        pg8::gemm_phase<EpiP1, SchedP1, false, true>(F.lds + RING_OFF, 32, S, E);
        if (!conv_first) { __syncthreads(); conv_share(F, args); }
    }
    SEAM(1);
    if (IN(2)) { FRESH();
        if ((F.vcu & 3) == 1) {
            SchedP1 S{(F.G + 3) >> 2, F.vcu >> 2, ws, 32 * 23, 32 * 23 + 64};
            EpiP1 E{(bf16_t*)(ws + WS_PROJ), (float*)(ws + WS_DT), (bf16_t*)(ws + WS_KVRAW), args.in(I_DAQG), args.in(I_DAKG), (unsigned char*)(ws + WS_VF8)};
            pg8::gemm_phase<EpiP1, SchedP1, false, true>(F.lds + RING_OFF, 32, S, E);
            __syncthreads();
        }
        if ((F.vcu & 3) == 0) { for (int u = F.vcu >> 2; u < 64; u += (F.G + 3) >> 2) ssd_unit(F, args, u >> 4, u & 15); }
        __syncthreads();
        attn_phase_da(F);
        __syncthreads();
        conv_queue(F, args, CW_QCONV, CV_NJ - CV_TAIL, CV_TAIL1);
    }
    SEAM(2);
    if (IN(3)) { FRESH(); kprep(F, args); p3_finalize(F, args); }
    SEAM(3);
    if (IN(4)) { FRESH();
        SchedDense S{F.G, F.vcu, 32, 8, (const char*)(ws + WS_YCAT), (const char*)(ws + WS_WOUT), 4096u, 4096u, 1 << 30, 0};
        EpiResid<false> E{args.in(I_X), (bf16_t*)(ws + WS_H1), (float*)(ws + WS_PART1), (unsigned char*)(ws + WS_H1F8), 1.f};
        pg8::gemm_phase<EpiResid<false>, SchedDense, false, true>(F.lds + RING_OFF, 32, S, E);
    }
    SEAM(4);
    if (IN(5)) { FRESH();
        SchedDense S{F.G, F.vcu, 32, 8, (const char*)(ws + WS_H1F8), (const char*)(ws + WS_WQ), 2048u, 2048u, 1 << 30, 0};
        EpiQ E{(unsigned char*)(ws + WS_QF8), (float*)(ws + WS_PARTQ)};
        pg8::gemm_phase<EpiQ, SchedDense, false, true, true>(F.lds + RING_OFF, 16, S, E);
    }
    SEAM(5);
    if (IN(6)) { FRESH();
        SchedXS S{F.G, F.vcu, ws};
        EpiXS E{(unsigned char*)(ws + WS_P8), (unsigned char*)(ws + WS_VWT8), (const float*)(ws + WS_PART1), (const float*)(ws + WS_PARTQ), (LAS float*)(F.lds + RING_BYTES)};
        pg8::gemm_phase<EpiXS, SchedXS, false, true, true>(F.lds + RING_OFF, 4, S, E);
    }
    SEAM(6);
    if (IN(7)) { FRESH();
        SchedDense S{F.G, F.vcu, 32, 8, (const char*)(ws + WS_P8), (const char*)(ws + WS_VWT8), 1024u, 1024u, 8, (size_t)2048 * 1024};
        EpiResid<true> E{(const void*)(ws + WS_H1), (bf16_t*)(ws + WS_H2), nullptr, nullptr, 1.f / 8192.f};
        pg8::gemm_phase<EpiResid<true>, SchedDense, false, true, true>(F.lds + RING_OFF, 8, S, E);
    }
    SEAM(7);
    if (IN(8)) { FRESH(); p8_route(F, args); }
    SEAM(8);
    if (IN(9)) { FRESH();
        moe_tables(F);
        SchedMoe<16> S{F.G, F.vcu, ws, F.MISC, ldsu(F.MISC + 112) * 16};
        EpiMoe1 E{(unsigned char*)(ws + WS_ACT), args.in(I_B1)};
        pg8::gemm_phase<EpiMoe1, SchedMoe<16>, false, true, true>(F.lds + RING_OFF, 16, S, E);
        __syncthreads();
        conv_queue(F, args, CW_QCONV2, CV_NJ - CV_TAIL2, CV_TAIL2);
    }
    SEAM(9);
    if (IN(10)) { FRESH();
        moe_tables(F);
        SchedMoe<8> S{F.G, F.vcu, ws, F.MISC, ldsu(F.MISC + 112) * 8};
        EpiMoe2 E{(unsigned char*)(ws + WS_Y), args.in(I_B2), (const float*)(ws + WS_GATEOF)};
        pg8::gemm_phase<EpiMoe2, SchedMoe<8>, false, true, true>(F.lds + RING_OFF, 16, S, E);
    }
    SEAM(10);
    if (IN(11)) { FRESH(); p11_combine(F, args); }
#undef IN
#undef SEAM
}

extern "C" void kernel_launch(void* const* d_in, const int* in_sizes, int n_in, void* d_out, int out_size, void* d_ws, size_t ws_size, hipStream_t stream) {
    static int grid = 0;
    if (grid == 0) {
        if (n_in != 32 || out_size != NTOK * 2048 || ws_size < WS_END) { fprintf(stderr, "kernel_launch: unexpected shapes (n_in %d out %d ws %zu); nothing launched\n", n_in, out_size, ws_size); grid = -1; return; }
        int dev = 0, cus = 0, per_cu = 0;
        if (hipGetDevice(&dev) != hipSuccess || hipDeviceGetAttribute(&cus, hipDeviceAttributeMultiprocessorCount, dev) != hipSuccess) { grid = -1; return; }
        if (hipFuncSetAttribute((const void*)mega_fwd, hipFuncAttributeMaxDynamicSharedMemorySize, LDS_BYTES) != hipSuccess) { fprintf(stderr, "kernel_launch: hipFuncSetAttribute failed\n"); grid = -1; return; }
        if (hipOccupancyMaxActiveBlocksPerMultiprocessor(&per_cu, (const void*)mega_fwd, NWAVES * 64, LDS_BYTES) != hipSuccess || per_cu < 1) { fprintf(stderr, "kernel_launch: occupancy query says %d\n", per_cu); }
        (void)hipGetLastError();
        if (cus < 256) { fprintf(stderr, "kernel_launch: needs 256 CUs, found %d; nothing launched\n", cus); grid = -1; return; }
        grid = 256;
    }
    if (grid < 0) return;
    if (hipMemsetAsync((char*)d_ws + WS_CTL, 0, CTL_ZERO_BYTES, stream) != hipSuccess) return;
    Args a{};
    for (int i = 0; i < 32; ++i) a.in[i] = (const float*)d_in[i];
    a.out = (float*)d_out; a.ws = (unsigned char*)d_ws;
#if MK_PER_PHASE
    for (int p = 0; p < N_PHASES; ++p) { a.ph_lo = p; a.ph_hi = p + 1; hipLaunchKernelGGL(mega_fwd, dim3(grid), dim3(NWAVES * 64), LDS_BYTES, stream, a); }
#else
    a.ph_lo = 0; a.ph_hi = N_PHASES;
    hipLaunchKernelGGL(mega_fwd, dim3(grid), dim3(NWAVES * 64), LDS_BYTES, stream, a);
#ifdef MK_PROBE_LO
    for (int p = MK_PROBE_LO; p < MK_PROBE_HI; ++p) { a.ph_lo = p; a.ph_hi = p + 1;
#ifdef MK_HOTPROBE
        a.probe = MK_HOTPROBE;
#endif
        if (p == 2) (void)hipMemsetAsync((char*)d_ws + WS_CTL + CW_QATT * 4, 0, 1024, stream);
        hipLaunchKernelGGL(mega_fwd, dim3(grid), dim3(NWAVES * 64), LDS_BYTES, stream, a); }
#endif
#endif
}
```

```cpp
#define MK_PER_PHASE 0
#define MK_LAST_PHASE 12
#include <hip/hip_runtime.h>
#include <hip/hip_bf16.h>
#include <cstdio>
#include <cstdint>
#include <cmath>

#define GAS __attribute__((address_space(1)))
#define LAS __attribute__((address_space(3)))
typedef unsigned short bf16_t;
typedef short bf16x8 __attribute__((ext_vector_type(8)));
typedef float f32x2 __attribute__((ext_vector_type(2)));
typedef float f32x4 __attribute__((ext_vector_type(4)));
typedef float f32x16 __attribute__((ext_vector_type(16)));
typedef unsigned u32x2 __attribute__((ext_vector_type(2)));
typedef unsigned u32x4 __attribute__((ext_vector_type(4)));
typedef __bf16 bf16x2_t __attribute__((ext_vector_type(2)));

#define DI __device__ __forceinline__
DI unsigned pk2(float lo, float hi) { f32x2 v = {lo, hi}; bf16x2_t b = __builtin_convertvector(v, bf16x2_t); return __builtin_bit_cast(unsigned, b); }
DI float bflo(unsigned u) { return __uint_as_float(u << 16); }
DI float bfhi(unsigned u) { return __uint_as_float(u & 0xffff0000u); }
DI float bf2f(bf16_t h) { return __uint_as_float(((unsigned)h) << 16); }
DI float wave_sum(float v) {
#pragma unroll
    for (int o = 1; o < 64; o <<= 1) v += __shfl_xor(v, o);
    return v;
}
DI float quad_sum_16_32(float v) {
    int l_ = threadIdx.x; asm volatile("" : "+v"(l_));
    const int a16 = ((l_ ^ 16) & 63) << 2, a32 = ((l_ ^ 32) & 63) << 2;
    v += __builtin_bit_cast(float, __builtin_amdgcn_ds_bpermute(a16, __builtin_bit_cast(int, v)));
    v += __builtin_bit_cast(float, __builtin_amdgcn_ds_bpermute(a32, __builtin_bit_cast(int, v)));
    return v;
}
DI float siluf(float x) { return x / (1.f + __expf(-x)); }

constexpr int DM_ = 2048, NB = 4, SEQ_ = 2048, NTOK = NB * SEQ_;
constexpr int PP = 5632;
constexpr int PC_XBC = 1024, PC_Q = 2560, PC_K = 3584, PC_V = 4608, PC_DT = 5632;
constexpr int WIN_ROWS = 5888;
constexpr int NEXP = 32, MEMLEN = 256;
constexpr float EPS_ = 1e-6f;
constexpr float LAM_INIT = 0.2f;

namespace pg8 {
constexpr int BM = 256, BK = 64, HALF = 128, HTB = HALF * BK * 2  , STAGE_BYTES = 8 * HTB;
DI int lds_byte(int r, int c) { const int st = (r >> 4) * 2 + (c >> 5), rr = r & 15, cc = c & 31, ob = rr * 64 + cc * 2; return st * 1024 + (ob ^ (((ob >> 9) & 1) << 5)); }
DI void stage_rc(int b, int& R, int& C) { const int st = b / 1024, sb = b % 1024, swz = sb ^ (((sb >> 9) & 1) << 5); R = (st >> 1) * 16 + swz / 64; C = (st & 1) * 32 + (swz % 64) / 2; }
DI int perm32(int rho) { const int n = rho >> 4, i = rho & 15; return 8 * (i >> 2) + 4 * n + (i & 3); }

struct UnitD {
    const char* A; const char* B;
    const int* rows;
    unsigned lda, ldb;
    int nvalid;
    int type, pm, pn, e, x0;
};
typedef int v8i_t __attribute__((ext_vector_type(8)));
DI v8i_t cat8(bf16x8 lo, bf16x8 hi) { typedef int v4i_t __attribute__((ext_vector_type(4))); const v4i_t a = __builtin_bit_cast(v4i_t, lo), b = __builtin_bit_cast(v4i_t, hi); return (v8i_t){a[0], a[1], a[2], a[3], b[0], b[1], b[2], b[3]}; }
DI void dense_voff(unsigned lda, unsigned ldb, int tid, unsigned (&vA)[2], unsigned (&vB)[2]) {
#pragma unroll
    for (int i = 0; i < 2; ++i) { int R, C; stage_rc(tid * 16 + i * 8192, R, C); const int Rb = (R & ~31) + perm32(R & 31);
        vA[i] = (unsigned)R * lda + (unsigned)C * 2u; vB[i] = (unsigned)Rb * ldb + (unsigned)C * 2u; }
}
DI void gather_voff(const UnitD& u, int tid, unsigned (&gA)[2][2]) {
#pragma unroll
    for (int i = 0; i < 2; ++i) { int R, C; stage_rc(tid * 16 + i * 8192, R, C);
#pragma unroll
        for (int h = 0; h < 2; ++h) { const int ra = h * 128 + R; const unsigned rowA = (ra < u.nvalid) ? (unsigned)u.rows[ra] : 0u; gA[h][i] = rowA * u.lda + (unsigned)C * 2u; } }
}

template <class Epi, class Sched, bool GATHER, bool ALIGN_EPI, bool FP8 = false>
DI void gemm_phase(LAS unsigned char* lds, int nt, const Sched& S, const Epi& E) {

    const int tid = threadIdx.x, wid = __builtin_amdgcn_readfirstlane(tid >> 6), lane = tid & 63, wr = wid >> 2, wc = wid & 3, fr = lane & 15, fq = lane >> 4;
#ifndef MK_HOTPROBE
#define PG8_NODMA false
#define PG8_NOMMA false
#define PG8_NOLD false
#define PG8_NOEPI false
#define PG8_NOLOOP false
#else
#define PG8_NODMA ((hot_ & 4) != 0)
#define PG8_NOMMA ((hot_ & 8) != 0)
#define PG8_NOLD ((hot_ & 16) != 0)
#define PG8_NOEPI ((hot_ & 32) != 0)
#define PG8_NOLOOP ((hot_ & 64) != 0)
#endif
#ifdef MK_HOTPROBE
    int hot_; { typedef const __attribute__((address_space(4))) char* kptr; kptr kp = (kptr)__builtin_amdgcn_kernarg_segment_ptr(); asm volatile("" : "+s"(kp)); hot_ = *(const int __attribute__((address_space(4)))*)(kp + 280); }
    const size_t kstep = (hot_ & 1) ? (size_t)0 : (size_t)(BK * 2);
#else
    const size_t kstep = (size_t)(BK * 2);
#endif
    const unsigned ldsb = (unsigned)__builtin_amdgcn_readfirstlane((int)((unsigned)(uintptr_t)lds + (unsigned)wid * 1024u));
    const int aoff = lds_byte(wr * 64 + fr, fq * 8), boff = lds_byte(wc * 32 + fr, fq * 8);
#define PG8_SA(b, h) (((b) * 2 + (h)) * HTB)
#define PG8_SB(b, h) ((4 + (b) * 2 + (h)) * HTB)
#define PG8_STAGE(bufoff, gbase, voff) do { if (PG8_NODMA) break; _Pragma("unroll") for (int _i = 0; _i < 2; ++_i) { unsigned keep_; \
        asm volatile("s_mov_b32 %0, m0\n\ts_mov_b32 m0, %3\n\ts_nop 0\n\tglobal_load_lds_dwordx4 %1, %2\n\ts_mov_b32 m0, %0" \
                     : "=&s"(keep_) : "v"((voff)[_i]), "s"((const char*)(gbase)), "s"(ldsb + (unsigned)((bufoff) + _i * 8192)) : "memory"); } } while (0)
#define PG8_STA(bufoff, gbase, h, HS, GA) do { if constexpr (GATHER) { PG8_STAGE(bufoff, gbase, GA[h]); } else { PG8_STAGE(bufoff, (gbase) + (h) * (HS), vA); } } while (0)
#define PG8_STB(bufoff, gbase, h, HS) PG8_STAGE(bufoff, (gbase) + (h) * (HS), vB)
typedef int v4i_t __attribute__((ext_vector_type(4)));
#define PG8_LDA(dst, b, h) do { if (PG8_NOLD) break; _Pragma("unroll") for (int m = 0; m < 4; ++m) { if constexpr (FP8) { \
            const v4i_t lo_ = *(const LAS v4i_t*)(lds + PG8_SA(b, h) + aoff + m * 2048), hi_ = *(const LAS v4i_t*)(lds + PG8_SA(b, h) + aoff + m * 2048 + 1024); \
            dst##8[m] = __builtin_shufflevector(lo_, hi_, 0, 1, 2, 3, 4, 5, 6, 7); } \
        else { _Pragma("unroll") for (int k = 0; k < 2; ++k) dst[m][k] = *(const LAS bf16x8*)(lds + PG8_SA(b, h) + aoff + m * 2048 + k * 1024); } } } while (0)
#define PG8_LDB(dst, b, h) do { if (PG8_NOLD) break; _Pragma("unroll") for (int n = 0; n < 2; ++n) { if constexpr (FP8) { \
            const v4i_t lo_ = *(const LAS v4i_t*)(lds + PG8_SB(b, h) + boff + n * 2048), hi_ = *(const LAS v4i_t*)(lds + PG8_SB(b, h) + boff + n * 2048 + 1024); \
            dst##8[n] = __builtin_shufflevector(lo_, hi_, 0, 1, 2, 3, 4, 5, 6, 7); } \
        else { _Pragma("unroll") for (int k = 0; k < 2; ++k) dst[n][k] = *(const LAS bf16x8*)(lds + PG8_SB(b, h) + boff + n * 2048 + k * 1024); } } } while (0)
#ifndef PG8_FP8_PRIO
#define PG8_FP8_PRIO 1
#endif
#define PG8_MMA(ai, bj, At, Bt) do { if (PG8_NOMMA) break; if (!FP8 || PG8_FP8_PRIO) __builtin_amdgcn_s_setprio(1); _Pragma("unroll") for (int m = 0; m < 4; ++m) _Pragma("unroll") for (int n = 0; n < 2; ++n) { \
        if constexpr (FP8) { acc[ai][bj][m][n] = __builtin_amdgcn_mfma_scale_f32_16x16x128_f8f6f4(Bt##8[n], At##8[m], acc[ai][bj][m][n], 0, 0, 0, 0x7f7f7f7f, 0, 0x7f7f7f7f); } \
        else { _Pragma("unroll") for (int k = 0; k < 2; ++k) acc[ai][bj][m][n] = __builtin_amdgcn_mfma_f32_16x16x32_bf16(Bt[n][k], At[m][k], acc[ai][bj][m][n], 0, 0, 0); } } \
        if (!FP8 || PG8_FP8_PRIO) __builtin_amdgcn_s_setprio(0); } while (0)
#define PG8_WAIT_V(n) asm volatile("s_waitcnt vmcnt(" #n ")" ::: "memory")
#define PG8_WAIT_L(n) asm volatile("s_waitcnt lgkmcnt(" #n ")" ::: "memory")
#define PG8_BAR __builtin_amdgcn_s_barrier()
#define PG8_SCHED __builtin_amdgcn_sched_barrier(0)
#define PG8_ITER(A1P, A2P, B2P, HA2, HB2, GA2) do { \
        const char* a3p_ = (A2P) + kstep; const char* b3p_ = (B2P) + kstepB; \
        PG8_LDB(B0, 0, 0); PG8_LDB(B1, 0, 1); PG8_SCHED; PG8_LDA(At, 0, 0); PG8_STA(PG8_SA(1, 1), (A1P), 1, hsA, gA); \
        PG8_WAIT_V(8); PG8_WAIT_L(0); PG8_BAR; PG8_MMA(0, 0, At, B0); PG8_MMA(0, 1, At, B1); PG8_BAR; PG8_SCHED; \
        PG8_LDA(At, 0, 1); PG8_STB(PG8_SB(0, 0), (B2P), 0, HB2); PG8_STB(PG8_SB(0, 1), (B2P), 1, HB2); PG8_STA(PG8_SA(0, 0), (A2P), 0, HA2, GA2); \
        PG8_WAIT_V(8); PG8_WAIT_L(0); PG8_BAR; PG8_MMA(1, 0, At, B0); PG8_MMA(1, 1, At, B1); PG8_BAR; PG8_SCHED; \
        PG8_LDB(B0, 1, 0); PG8_LDB(B1, 1, 1); PG8_SCHED; PG8_LDA(At, 1, 0); PG8_STA(PG8_SA(0, 1), (A2P), 1, HA2, GA2); \
        PG8_WAIT_V(8); PG8_WAIT_L(0); PG8_BAR; PG8_MMA(0, 0, At, B0); PG8_MMA(0, 1, At, B1); PG8_BAR; PG8_SCHED; \
        PG8_LDA(At, 1, 1); PG8_STB(PG8_SB(1, 0), b3p_, 0, HB2); PG8_STB(PG8_SB(1, 1), b3p_, 1, HB2); PG8_STA(PG8_SA(1, 0), a3p_, 0, HA2, GA2); \
        PG8_WAIT_V(8); PG8_WAIT_L(0); PG8_BAR; PG8_MMA(1, 0, At, B0); PG8_MMA(1, 1, At, B1); PG8_BAR; PG8_SCHED; \
    } while (0)
    UnitD cur, nxt; int ui = 0;
    if (!S.next(0, cur)) return;
    f32x4 acc[2][2][4][2];
#pragma unroll
    for (int a = 0; a < 2; ++a)
#pragma unroll
        for (int b = 0; b < 2; ++b)
#pragma unroll
            for (int m = 0; m < 4; ++m)
#pragma unroll
                for (int n = 0; n < 2; ++n) acc[a][b][m][n] = (f32x4){0.f, 0.f, 0.f, 0.f};
    bf16x8 At[4][2], B0[2][2], B1[2][2]; v8i_t At8[4], B08[2], B18[2];
    unsigned vA[2], vB[2], gA[2][2], ngA[2][2];
    dense_voff(cur.lda, cur.ldb, tid, vA, vB);
#ifdef MK_HOTPROBE
    const size_t kstepB = (hot_ & 2) ? (size_t)0 : ((cur.ldb == 128u) ? (size_t)32768 : (size_t)(BK * 2));
#else
    const size_t kstepB = (cur.ldb == 128u) ? (size_t)32768 : kstep;
#endif
    if constexpr (GATHER) gather_voff(cur, tid, gA);
    const char* cA = cur.A; const char* cB = cur.B;
    size_t hsA = GATHER ? 0 : (size_t)cur.lda * HALF, hsB = (size_t)cur.ldb * HALF;
    PG8_STB(PG8_SB(0, 0), cB, 0, hsB); PG8_STB(PG8_SB(0, 1), cB, 1, hsB); PG8_STA(PG8_SA(0, 0), cA, 0, hsA, gA); PG8_STA(PG8_SA(0, 1), cA, 1, hsA, gA);
    if (wr == 1) PG8_BAR;
    PG8_WAIT_V(2); PG8_BAR;
    PG8_STB(PG8_SB(1, 0), cB + kstepB, 0, hsB); PG8_STA(PG8_SA(1, 0), cA + kstep, 0, hsA, gA); PG8_STB(PG8_SB(1, 1), cB + kstepB, 1, hsB);
    PG8_WAIT_V(6); PG8_BAR;
    for (;;) {
        const bool has_next = S.next(ui + 1, nxt);
        const char* nA = cA; const char* nB = cB; size_t nhsA = hsA, nhsB = hsB;
        if (has_next) { nA = nxt.A; nB = nxt.B; nhsA = GATHER ? 0 : (size_t)nxt.lda * HALF; nhsB = (size_t)nxt.ldb * HALF; }
        if constexpr (GATHER) {
            if (has_next) gather_voff(nxt, tid, ngA);
            else {
#pragma unroll
                for (int h = 0; h < 2; ++h)
#pragma unroll
                    for (int i = 0; i < 2; ++i) ngA[h][i] = gA[h][i];
            }
        }
#pragma unroll 1
        for (int t = 0; t < (PG8_NOLOOP ? 0 : nt); t += 2) {
            const bool last = (t == nt - 2);
            const char* a2 = last ? nA : cA + (size_t)(t + 2) * kstep; const char* b2 = last ? nB : cB + (size_t)(t + 2) * kstepB;
            const size_t hA2 = last ? nhsA : hsA, hB2 = last ? nhsB : hsB;
            unsigned g2[2][2];
            if constexpr (GATHER) {
#pragma unroll
                for (int h = 0; h < 2; ++h)
#pragma unroll
                    for (int i = 0; i < 2; ++i) g2[h][i] = last ? ngA[h][i] : gA[h][i];
            }
            PG8_ITER(cA + (size_t)(t + 1) * kstep, a2, b2, hA2, hB2, g2);
        }
        if constexpr (ALIGN_EPI) { if (wr == 0) PG8_BAR; }
        if constexpr (!Epi::AFTER_DRAIN) { if (!PG8_NOEPI) E(acc, cur, wr, wc, fr, fq); }
        if (!has_next) break;
#pragma unroll
        for (int a = 0; a < 2; ++a)
#pragma unroll
            for (int b = 0; b < 2; ++b)
#pragma unroll
                for (int m = 0; m < 4; ++m)
#pragma unroll
                    for (int n = 0; n < 2; ++n) acc[a][b][m][n] = (f32x4){0.f, 0.f, 0.f, 0.f};
        cur = nxt; cA = nA; cB = nB; hsA = nhsA; hsB = nhsB; ++ui;
        if constexpr (GATHER) {
#pragma unroll
            for (int h = 0; h < 2; ++h)
#pragma unroll
                for (int i = 0; i < 2; ++i) gA[h][i] = ngA[h][i];
        }
        if constexpr (ALIGN_EPI) { if (wr == 1) PG8_BAR; }
    }
    PG8_WAIT_V(0);
    if constexpr (!ALIGN_EPI) { if (wr == 0) PG8_BAR; }
    PG8_BAR;
    if constexpr (Epi::AFTER_DRAIN) { E.fused(acc, cur, wr, wc, fr, fq, lds, wid, lane); }
#undef PG8_SA
#undef PG8_SB
#undef PG8_STAGE
#undef PG8_STA
#undef PG8_STB
#undef PG8_LDA
#undef PG8_LDB
#undef PG8_MMA
#undef PG8_WAIT_V
#undef PG8_WAIT_L
#undef PG8_BAR
#undef PG8_SCHED
#undef PG8_ITER
}

template <class Epi, class Sched, bool FP8>
DI void gemm_phase2(LAS unsigned char* lds, int nt, const Sched& S, const Epi& E) {
    const int tid = threadIdx.x, wid = __builtin_amdgcn_readfirstlane(tid >> 6), lane = tid & 63, wr = wid >> 2, wc = wid & 3, fr = lane & 15, fq = lane >> 4;
    const size_t kstep = (size_t)(BK * 2);
    const unsigned ldsb = (unsigned)__builtin_amdgcn_readfirstlane((int)((unsigned)(uintptr_t)lds + (unsigned)wid * 1024u));
    const int aoff = lds_byte(wr * 64 + fr, fq * 8), boff = lds_byte(wc * 32 + fr, fq * 8);
#define P2_SA(b, h) (((b) * 2 + (h)) * HTB)
#define P2_SB(b, h) ((4 + (b) * 2 + (h)) * HTB)
#define P2_STAGE(bufoff, gbase, voff) do { _Pragma("unroll") for (int _i = 0; _i < 2; ++_i) { unsigned keep_; \
        asm volatile("s_mov_b32 %0, m0\n\ts_mov_b32 m0, %3\n\ts_nop 0\n\tglobal_load_lds_dwordx4 %1, %2\n\ts_mov_b32 m0, %0" \
                     : "=&s"(keep_) : "v"((voff)[_i]), "s"((const char*)(gbase)), "s"(ldsb + (unsigned)((bufoff) + _i * 8192)) : "memory"); } } while (0)
#define P2_STA(bufoff, gbase, h, HS) P2_STAGE(bufoff, (gbase) + (h) * (HS), vA)
#define P2_STB(bufoff, gbase, h, HS) P2_STAGE(bufoff, (gbase) + (h) * (HS), vB)
typedef int v4i_t __attribute__((ext_vector_type(4)));
#define P2_LDA1(m, b, h) do { if constexpr (FP8) { \
            const v4i_t lo_ = *(const LAS v4i_t*)(lds + P2_SA(b, h) + aoff + (m) * 2048), hi_ = *(const LAS v4i_t*)(lds + P2_SA(b, h) + aoff + (m) * 2048 + 1024); \
            At8[m] = __builtin_shufflevector(lo_, hi_, 0, 1, 2, 3, 4, 5, 6, 7); } \
        else { _Pragma("unroll") for (int k = 0; k < 2; ++k) At[m][k] = *(const LAS bf16x8*)(lds + P2_SA(b, h) + aoff + (m) * 2048 + k * 1024); } } while (0)
#define P2_LDA(b, h) do { _Pragma("unroll") for (int m = 0; m < 4; ++m) P2_LDA1(m, b, h); } while (0)
#define P2_LDB(dst, b, h) do { _Pragma("unroll") for (int n = 0; n < 2; ++n) { if constexpr (FP8) { \
            const v4i_t lo_ = *(const LAS v4i_t*)(lds + P2_SB(b, h) + boff + n * 2048), hi_ = *(const LAS v4i_t*)(lds + P2_SB(b, h) + boff + n * 2048 + 1024); \
            dst##8[n] = __builtin_shufflevector(lo_, hi_, 0, 1, 2, 3, 4, 5, 6, 7); } \
        else { _Pragma("unroll") for (int k = 0; k < 2; ++k) dst[n][k] = *(const LAS bf16x8*)(lds + P2_SB(b, h) + boff + n * 2048 + k * 1024); } } } while (0)
#define P2_MMA4(ai, m) do { if constexpr (FP8) { _Pragma("unroll") for (int n = 0; n < 2; ++n) acc[ai][0][m][n] = __builtin_amdgcn_mfma_scale_f32_16x16x128_f8f6f4(B08[n], At8[m], acc[ai][0][m][n], 0, 0, 0, 0x7f7f7f7f, 0, 0x7f7f7f7f); \
            _Pragma("unroll") for (int n = 0; n < 2; ++n) acc[ai][1][m][n] = __builtin_amdgcn_mfma_scale_f32_16x16x128_f8f6f4(B18[n], At8[m], acc[ai][1][m][n], 0, 0, 0, 0x7f7f7f7f, 0, 0x7f7f7f7f); } \
        else { _Pragma("unroll") for (int k = 0; k < 2; ++k) { _Pragma("unroll") for (int n = 0; n < 2; ++n) acc[ai][0][m][n] = __builtin_amdgcn_mfma_f32_16x16x32_bf16(B0[n][k], At[m][k], acc[ai][0][m][n], 0, 0, 0); \
            _Pragma("unroll") for (int n = 0; n < 2; ++n) acc[ai][1][m][n] = __builtin_amdgcn_mfma_f32_16x16x32_bf16(B1[n][k], At[m][k], acc[ai][1][m][n], 0, 0, 0); } } } while (0)
#define P2_SCHED __builtin_amdgcn_sched_barrier(0)
#define P2_MMA32(b) do { __builtin_amdgcn_s_setprio(1); \
        P2_MMA4(0, 0); P2_SCHED; P2_LDA1(0, b, 1); P2_SCHED; P2_MMA4(0, 1); P2_SCHED; P2_LDA1(1, b, 1); P2_SCHED; \
        P2_MMA4(0, 2); P2_SCHED; P2_LDA1(2, b, 1); P2_SCHED; P2_MMA4(0, 3); P2_SCHED; P2_LDA1(3, b, 1); P2_SCHED; \
        P2_MMA4(1, 0); P2_SCHED; P2_MMA4(1, 1); P2_SCHED; P2_MMA4(1, 2); P2_SCHED; P2_MMA4(1, 3); P2_SCHED; \
        __builtin_amdgcn_s_setprio(0); } while (0)
#define P2_LD(b) do { P2_LDB(B0, b, 0); P2_LDB(B1, b, 1); P2_LDA(b, 0); } while (0)
#define P2_WAIT_V(n) asm volatile("s_waitcnt vmcnt(" #n ")" ::: "memory")
#define P2_WAIT_L(n) asm volatile("s_waitcnt lgkmcnt(" #n ")" ::: "memory")
#define P2_BAR __builtin_amdgcn_s_barrier()
    UnitD cur, nxt; int ui = 0;
    if (!S.next(0, cur)) return;
    f32x4 acc[2][2][4][2];
#pragma unroll
    for (int a = 0; a < 2; ++a)
#pragma unroll
        for (int b = 0; b < 2; ++b)
#pragma unroll
            for (int m = 0; m < 4; ++m)
#pragma unroll
                for (int n = 0; n < 2; ++n) acc[a][b][m][n] = (f32x4){0.f, 0.f, 0.f, 0.f};
    bf16x8 At[4][2], B0[2][2], B1[2][2]; v8i_t At8[4], B08[2], B18[2];
    unsigned vA[2], vB[2];
    dense_voff(cur.lda, cur.ldb, tid, vA, vB);
    const size_t kstepB = (cur.ldb == 128u) ? (size_t)32768 : kstep;
    const char* cA = cur.A; const char* cB = cur.B;
    size_t hsA = (size_t)cur.lda * HALF, hsB = (size_t)cur.ldb * HALF;
    P2_STB(P2_SB(0, 0), cB, 0, hsB); P2_STB(P2_SB(0, 1), cB, 1, hsB); P2_STA(P2_SA(0, 0), cA, 0, hsA); P2_STA(P2_SA(0, 1), cA, 1, hsA);
    P2_WAIT_V(0); P2_BAR;
    for (;;) {
        const bool has_next = S.next(ui + 1, nxt);
        const char* nA = cA; const char* nB = cB; size_t nhsA = hsA, nhsB = hsB;
        if (has_next) { nA = nxt.A; nB = nxt.B; nhsA = (size_t)nxt.lda * HALF; nhsB = (size_t)nxt.ldb * HALF; }
        if (wr == 0) {
#pragma unroll 1
            for (int t = 0; t < nt; t += 2) {
                const bool last = (t == nt - 2);
                const char* a1 = cA + (size_t)(t + 1) * kstep; const char* b1 = cB + (size_t)(t + 1) * kstepB;
                const char* a2 = last ? nA : cA + (size_t)(t + 2) * kstep; const char* b2 = last ? nB : cB + (size_t)(t + 2) * kstepB;
                const size_t hA2 = last ? nhsA : hsA, hB2 = last ? nhsB : hsB;
                P2_STB(P2_SB(1, 0), b1, 0, hsB); P2_STB(P2_SB(1, 1), b1, 1, hsB); P2_STA(P2_SA(1, 0), a1, 0, hsA);
                P2_LD(0); P2_WAIT_V(6); P2_WAIT_L(0); P2_BAR; P2_SCHED;
                P2_STA(P2_SA(1, 1), a1, 1, hsA);
                P2_MMA32(0); P2_WAIT_V(2); P2_BAR; P2_SCHED;
                P2_STB(P2_SB(0, 0), b2, 0, hB2); P2_STB(P2_SB(0, 1), b2, 1, hB2); P2_STA(P2_SA(0, 0), a2, 0, hA2);
                P2_LD(1); P2_WAIT_V(6); P2_WAIT_L(0); P2_BAR; P2_SCHED;
                P2_STA(P2_SA(0, 1), a2, 1, hA2);
                P2_MMA32(1); P2_WAIT_V(2); P2_BAR; P2_SCHED;
            }
            P2_BAR;
        } else {
#pragma unroll 1
            for (int t = 0; t < nt; t += 2) {
                const bool last = (t == nt - 2);
                const char* a1 = cA + (size_t)(t + 1) * kstep; const char* b1 = cB + (size_t)(t + 1) * kstepB;
                const char* a2 = last ? nA : cA + (size_t)(t + 2) * kstep; const char* b2 = last ? nB : cB + (size_t)(t + 2) * kstepB;
                const size_t hA2 = last ? nhsA : hsA, hB2 = last ? nhsB : hsB;
                P2_STB(P2_SB(1, 0), b1, 0, hsB); P2_STB(P2_SB(1, 1), b1, 1, hsB); P2_STA(P2_SA(1, 0), a1, 0, hsA);
                if (t != 0) { P2_MMA32(1); }
                P2_WAIT_V(6); P2_BAR; P2_SCHED;
                P2_STA(P2_SA(1, 1), a1, 1, hsA);
                P2_LD(0); P2_WAIT_V(2); P2_WAIT_L(0); P2_BAR; P2_SCHED;
                P2_STB(P2_SB(0, 0), b2, 0, hB2); P2_STB(P2_SB(0, 1), b2, 1, hB2); P2_STA(P2_SA(0, 0), a2, 0, hA2);
                P2_MMA32(0); P2_WAIT_V(6); P2_BAR; P2_SCHED;
                P2_STA(P2_SA(0, 1), a2, 1, hA2);
                P2_LD(1); P2_WAIT_V(2); P2_WAIT_L(0); P2_BAR; P2_SCHED;
            }
            P2_MMA32(1); P2_BAR; P2_SCHED;
        }
        E(acc, cur, wr, wc, fr, fq);
        if (!has_next) break;
#pragma unroll
        for (int a = 0; a < 2; ++a)
#pragma unroll
            for (int b = 0; b < 2; ++b)
#pragma unroll
                for (int m = 0; m < 4; ++m)
#pragma unroll
                    for (int n = 0; n < 2; ++n) acc[a][b][m][n] = (f32x4){0.f, 0.f, 0.f, 0.f};
        cur = nxt; cA = nA; cB = nB; hsA = nhsA; hsB = nhsB; ++ui;
    }
    P2_WAIT_V(0);
    P2_BAR;
#undef P2_SA
#undef P2_SB
#undef P2_STAGE
#undef P2_STA
#undef P2_STB
#undef P2_LDA1
#undef P2_LDA
#undef P2_LDB
#undef P2_MMA4
#undef P2_SCHED
#undef P2_MMA32
#undef P2_LD
#undef P2_WAIT_V
#undef P2_WAIT_L
#undef P2_BAR
}
template <class Epi, class Sched, bool FP8>
DI void gemm_phase3(LAS unsigned char* lds, int nt, const Sched& S, const Epi& E) {
    const int tid = threadIdx.x, wid = __builtin_amdgcn_readfirstlane(tid >> 6), lane = tid & 63, wr = wid >> 2, wc = wid & 3, fr = lane & 15, fq = lane >> 4;
    const size_t kstep = (size_t)(BK * 2);
    const unsigned ldsb = (unsigned)__builtin_amdgcn_readfirstlane((int)((unsigned)(uintptr_t)lds + (unsigned)wid * 1024u));
    const int aoff = lds_byte(wr * 64 + fr, fq * 8), boff = lds_byte(wc * 32 + fr, fq * 8);
#define P2_SA(b, h) (((b) * 2 + (h)) * HTB)
#define P2_SB(b, h) ((4 + (b) * 2 + (h)) * HTB)
#define P2_STAGE(bufoff, gbase, voff) do { _Pragma("unroll") for (int _i = 0; _i < 2; ++_i) { unsigned keep_; \
        asm volatile("s_mov_b32 %0, m0\n\ts_mov_b32 m0, %3\n\ts_nop 0\n\tglobal_load_lds_dwordx4 %1, %2\n\ts_mov_b32 m0, %0" \
                     : "=&s"(keep_) : "v"((voff)[_i]), "s"((const char*)(gbase)), "s"(ldsb + (unsigned)((bufoff) + _i * 8192)) : "memory"); } } while (0)
#define P2_STA(bufoff, gbase, h, HS) P2_STAGE(bufoff, (gbase) + (h) * (HS), vA)
#define P2_STB(bufoff, gbase, h, HS) P2_STAGE(bufoff, (gbase) + (h) * (HS), vB)
typedef int v4i_t __attribute__((ext_vector_type(4)));
#define P2_LDA1(D, m, b, h) do { if constexpr (FP8) { \
            const v4i_t lo_ = *(const LAS v4i_t*)(lds + P2_SA(b, h) + aoff + (m) * 2048), hi_ = *(const LAS v4i_t*)(lds + P2_SA(b, h) + aoff + (m) * 2048 + 1024); \
            D##8[m] = __builtin_shufflevector(lo_, hi_, 0, 1, 2, 3, 4, 5, 6, 7); } \
        else { _Pragma("unroll") for (int k = 0; k < 2; ++k) D[m][k] = *(const LAS bf16x8*)(lds + P2_SA(b, h) + aoff + (m) * 2048 + k * 1024); } } while (0)
#define P2_LDA(D, b, h) do { _Pragma("unroll") for (int m = 0; m < 4; ++m) P2_LDA1(D, m, b, h); } while (0)
#define P2_LDB(dst, b, h) do { _Pragma("unroll") for (int n = 0; n < 2; ++n) { if constexpr (FP8) { \
            const v4i_t lo_ = *(const LAS v4i_t*)(lds + P2_SB(b, h) + boff + n * 2048), hi_ = *(const LAS v4i_t*)(lds + P2_SB(b, h) + boff + n * 2048 + 1024); \
            dst##8[n] = __builtin_shufflevector(lo_, hi_, 0, 1, 2, 3, 4, 5, 6, 7); } \
        else { _Pragma("unroll") for (int k = 0; k < 2; ++k) dst[n][k] = *(const LAS bf16x8*)(lds + P2_SB(b, h) + boff + n * 2048 + k * 1024); } } } while (0)
#define P2_MMA4(ai, m, D) do { if constexpr (FP8) { _Pragma("unroll") for (int n = 0; n < 2; ++n) acc[ai][0][m][n] = __builtin_amdgcn_mfma_scale_f32_16x16x128_f8f6f4(B08[n], D##8[m], acc[ai][0][m][n], 0, 0, 0, 0x7f7f7f7f, 0, 0x7f7f7f7f); \
            _Pragma("unroll") for (int n = 0; n < 2; ++n) acc[ai][1][m][n] = __builtin_amdgcn_mfma_scale_f32_16x16x128_f8f6f4(B18[n], D##8[m], acc[ai][1][m][n], 0, 0, 0, 0x7f7f7f7f, 0, 0x7f7f7f7f); } \
        else { _Pragma("unroll") for (int k = 0; k < 2; ++k) { _Pragma("unroll") for (int n = 0; n < 2; ++n) acc[ai][0][m][n] = __builtin_amdgcn_mfma_f32_16x16x32_bf16(B0[n][k], D[m][k], acc[ai][0][m][n], 0, 0, 0); \
            _Pragma("unroll") for (int n = 0; n < 2; ++n) acc[ai][1][m][n] = __builtin_amdgcn_mfma_f32_16x16x32_bf16(B1[n][k], D[m][k], acc[ai][1][m][n], 0, 0, 0); } } } while (0)
#define P2_SCHED __builtin_amdgcn_sched_barrier(0)
#define P2_MMA32(b) do { __builtin_amdgcn_s_setprio(1); \
        P2_MMA4(0, 0, At); P2_MMA4(0, 1, At); P2_MMA4(0, 2, At); P2_MMA4(0, 3, At); P2_MMA4(1, 0, Au); P2_MMA4(1, 1, Au); P2_MMA4(1, 2, Au); P2_MMA4(1, 3, Au); \
        __builtin_amdgcn_s_setprio(0); } while (0)
#define P2_LD(b) do { P2_LDB(B0, b, 0); P2_LDB(B1, b, 1); P2_LDA(At, b, 0); P2_LDA(Au, b, 1); } while (0)
#define P2_WAIT_V(n) asm volatile("s_waitcnt vmcnt(" #n ")" ::: "memory")
#define P2_WAIT_L(n) asm volatile("s_waitcnt lgkmcnt(" #n ")" ::: "memory")
#define P2_BAR __builtin_amdgcn_s_barrier()
    UnitD cur, nxt; int ui = 0;
    if (!S.next(0, cur)) return;
    f32x4 acc[2][2][4][2];
#pragma unroll
    for (int a = 0; a < 2; ++a)
#pragma unroll
        for (int b = 0; b < 2; ++b)
#pragma unroll
            for (int m = 0; m < 4; ++m)
#pragma unroll
                for (int n = 0; n < 2; ++n) acc[a][b][m][n] = (f32x4){0.f, 0.f, 0.f, 0.f};
    bf16x8 At[4][2], Au[4][2], B0[2][2], B1[2][2]; v8i_t At8[4], Au8[4], B08[2], B18[2];
    unsigned vA[2], vB[2];
    dense_voff(cur.lda, cur.ldb, tid, vA, vB);
    const size_t kstepB = (cur.ldb == 128u) ? (size_t)32768 : kstep;
    const char* cA = cur.A; const char* cB = cur.B;
    size_t hsA = (size_t)cur.lda * HALF, hsB = (size_t)cur.ldb * HALF;
    P2_STB(P2_SB(0, 0), cB, 0, hsB); P2_STB(P2_SB(0, 1), cB, 1, hsB); P2_STA(P2_SA(0, 0), cA, 0, hsA); P2_STA(P2_SA(0, 1), cA, 1, hsA);
    P2_WAIT_V(0); P2_BAR;
    for (;;) {
        const bool has_next = S.next(ui + 1, nxt);
        const char* nA = cA; const char* nB = cB; size_t nhsA = hsA, nhsB = hsB;
        if (has_next) { nA = nxt.A; nB = nxt.B; nhsA = (size_t)nxt.lda * HALF; nhsB = (size_t)nxt.ldb * HALF; }
        if (wr == 0) {
#pragma unroll 1
            for (int t = 0; t < nt; t += 2) {
                const bool last = (t == nt - 2);
                const char* a1 = cA + (size_t)(t + 1) * kstep; const char* b1 = cB + (size_t)(t + 1) * kstepB;
                const char* a2 = last ? nA : cA + (size_t)(t + 2) * kstep; const char* b2 = last ? nB : cB + (size_t)(t + 2) * kstepB;
                const size_t hA2 = last ? nhsA : hsA, hB2 = last ? nhsB : hsB;
                P2_STB(P2_SB(1, 0), b1, 0, hsB); P2_STB(P2_SB(1, 1), b1, 1, hsB); P2_STA(P2_SA(1, 0), a1, 0, hsA); P2_STA(P2_SA(1, 1), a1, 1, hsA);
                P2_LD(0); P2_WAIT_L(0); P2_BAR; P2_SCHED;
                P2_MMA32(0); P2_WAIT_V(0); P2_BAR; P2_SCHED;
                P2_STB(P2_SB(0, 0), b2, 0, hB2); P2_STB(P2_SB(0, 1), b2, 1, hB2); P2_STA(P2_SA(0, 0), a2, 0, hA2); P2_STA(P2_SA(0, 1), a2, 1, hA2);
                P2_LD(1); P2_WAIT_L(0); P2_BAR; P2_SCHED;
                P2_MMA32(1); P2_WAIT_V(0); P2_BAR; P2_SCHED;
            }
            P2_BAR;
        } else {
#pragma unroll 1
            for (int t = 0; t < nt; t += 2) {
                const bool last = (t == nt - 2);
                const char* a1 = cA + (size_t)(t + 1) * kstep; const char* b1 = cB + (size_t)(t + 1) * kstepB;
                const char* a2 = last ? nA : cA + (size_t)(t + 2) * kstep; const char* b2 = last ? nB : cB + (size_t)(t + 2) * kstepB;
                const size_t hA2 = last ? nhsA : hsA, hB2 = last ? nhsB : hsB;
                P2_STB(P2_SB(1, 0), b1, 0, hsB); P2_STB(P2_SB(1, 1), b1, 1, hsB); P2_STA(P2_SA(1, 0), a1, 0, hsA); P2_STA(P2_SA(1, 1), a1, 1, hsA);
                if (t != 0) { P2_MMA32(1); }
                P2_BAR; P2_SCHED;
                P2_LD(0); P2_WAIT_V(0); P2_WAIT_L(0); P2_BAR; P2_SCHED;
                P2_STB(P2_SB(0, 0), b2, 0, hB2); P2_STB(P2_SB(0, 1), b2, 1, hB2); P2_STA(P2_SA(0, 0), a2, 0, hA2); P2_STA(P2_SA(0, 1), a2, 1, hA2);
                P2_MMA32(0); P2_BAR; P2_SCHED;
                P2_LD(1); P2_WAIT_V(0); P2_WAIT_L(0); P2_BAR; P2_SCHED;
            }
            P2_MMA32(1); P2_BAR; P2_SCHED;
        }
        E(acc, cur, wr, wc, fr, fq);
        if (!has_next) break;
#pragma unroll
        for (int a = 0; a < 2; ++a)
#pragma unroll
            for (int b = 0; b < 2; ++b)
#pragma unroll
                for (int m = 0; m < 4; ++m)
#pragma unroll
                    for (int n = 0; n < 2; ++n) acc[a][b][m][n] = (f32x4){0.f, 0.f, 0.f, 0.f};
        cur = nxt; cA = nA; cB = nB; hsA = nhsA; hsB = nhsB; ++ui;
    }
    P2_WAIT_V(0);
    P2_BAR;
#undef P2_SA
#undef P2_SB
#undef P2_STAGE
#undef P2_STA
#undef P2_STB
#undef P2_LDA1
#undef P2_LDA
#undef P2_LDB
#undef P2_MMA4
#undef P2_SCHED
#undef P2_MMA32
#undef P2_LD
#undef P2_WAIT_V
#undef P2_WAIT_L
#undef P2_BAR
}
}
namespace attn_body {
using bf16=__hip_bfloat16;
using bf16x8=__attribute__((ext_vector_type(8)))short;
using s16x4=__attribute__((ext_vector_type(4)))short;
using f32x16=__attribute__((ext_vector_type(16)))float;
using u32x4=__attribute__((ext_vector_type(4)))unsigned;
constexpr int BATCH=4,SEQ=2048,D=64,DM=5632,OPITCH=1024;
constexpr int NW=8,QBLK=32,QB=QBLK*NW,KVBLK=64,NQB=SEQ/QB;
constexpr int ATTN_UNIT_ROWS=QB;
__device__ __forceinline__ int crow(int r,int hi){return (r&3)+8*(r>>2)+4*hi;}
#define SBAR() __builtin_amdgcn_sched_barrier(0)
__device__ __forceinline__ void cmask(f32x16&p0,f32x16&p1,int jb,int qrel,int hi){
  const float NEG=-INFINITY; int kb=64*jb+4*hi;
  #pragma unroll
  for(int r=0;r<16;++r){int kv=kb+(r&3)+8*(r>>2); if(kv>qrel)p0[r]=NEG; if(kv+32>qrel)p1[r]=NEG;}
}

constexpr int NSLOT=3, SLOTB=8192;
constexpr int LDS_K=0, LDS_V=NSLOT*SLOTB, LDS_WS=2*NSLOT*SLOTB, LDS_OST=LDS_WS+NW*64*4, LDS_BYTES=LDS_OST+NW*4096;
constexpr float C2=0.125f*1.4426950408889634f;
__device__ __forceinline__ void glds16(const void*gsrc,unsigned lds_dst){unsigned keep;
  asm volatile("s_mov_b32 %0, m0\n\ts_mov_b32 m0, %2\n\ts_nop 0\n\tglobal_load_lds_dwordx4 %1, off\n\ts_mov_b32 m0, %0":"=&s"(keep):"v"(gsrc),"s"(lds_dst):"memory");}
__device__ __forceinline__ float max3f(float a,float b,float c){float r;asm("v_max3_f32 %0, %1, %2, %3":"=v"(r):"v"(a),"v"(b),"v"(c));return r;}
__device__ __forceinline__ float max2f(float a,float b){float r;asm("v_max_f32_e32 %0, %1, %2":"=v"(r):"v"(a),"v"(b));return r;}
__device__ __forceinline__ float fadd_s(float a,float b){float r;asm("v_add_f32_e32 %0, %1, %2":"=v"(r):"v"(a),"v"(b));return r;}
__device__ __forceinline__ float fsub_s(float a,float b){float r;asm("v_sub_f32_e32 %0, %1, %2":"=v"(r):"v"(a),"v"(b));return r;}
typedef float f32x2_t __attribute__((ext_vector_type(2))); typedef __bf16 bf16x2_t __attribute__((ext_vector_type(2)));
__device__ __forceinline__ unsigned cvtpk_s(float lo,float hi){f32x2_t v={lo,hi};bf16x2_t b=__builtin_convertvector(v,bf16x2_t);return __builtin_bit_cast(unsigned,b);}
#define WAIT_BAR(N) asm volatile("s_waitcnt vmcnt(" #N ") lgkmcnt(0)\n\ts_barrier":::"memory")

__device__ __forceinline__ void qkt(f32x16&p0,f32x16&p1,const char*Kslot,const bf16x8*qr,const f32x16&negm,int r32,int hi){
  const char*kb=Kslot+hi*1024+r32*16;
  #pragma unroll
  for(int d0=0;d0<4;++d0){
    const bf16x8 b0=*reinterpret_cast<const bf16x8*>(kb+d0*2048);
    const bf16x8 b1=*reinterpret_cast<const bf16x8*>(kb+d0*2048+512);
    if(d0==0){p0=__builtin_amdgcn_mfma_f32_32x32x16_bf16(b0,qr[0],negm,0,0,0);p1=__builtin_amdgcn_mfma_f32_32x32x16_bf16(b1,qr[0],negm,0,0,0);}
    else{p0=__builtin_amdgcn_mfma_f32_32x32x16_bf16(b0,qr[d0],p0,0,0,0);p1=__builtin_amdgcn_mfma_f32_32x32x16_bf16(b1,qr[d0],p1,0,0,0);}}
}
typedef __attribute__((address_space(3))) const char* lds_cptr;
typedef short v4i16_t __attribute__((ext_vector_type(4)));
__device__ __forceinline__ void kload8(bf16x8*kf,lds_cptr kp){
  kf[0]=*(const __attribute__((address_space(3))) bf16x8*)(kp);      kf[1]=*(const __attribute__((address_space(3))) bf16x8*)(kp+512);
  kf[2]=*(const __attribute__((address_space(3))) bf16x8*)(kp+2048); kf[3]=*(const __attribute__((address_space(3))) bf16x8*)(kp+2560);
  kf[4]=*(const __attribute__((address_space(3))) bf16x8*)(kp+4096); kf[5]=*(const __attribute__((address_space(3))) bf16x8*)(kp+4608);
  kf[6]=*(const __attribute__((address_space(3))) bf16x8*)(kp+6144); kf[7]=*(const __attribute__((address_space(3))) bf16x8*)(kp+6656);
}
__device__ __forceinline__ void kload2(bf16x8*kf,lds_cptr kp,int j){ kf[2*j]=*(const __attribute__((address_space(3))) bf16x8*)(kp+j*2048); kf[2*j+1]=*(const __attribute__((address_space(3))) bf16x8*)(kp+j*2048+512); }
__device__ __forceinline__ s16x4 vtr(lds_cptr p){ return __builtin_bit_cast(s16x4,__builtin_amdgcn_ds_read_tr16_b64_v4i16((__attribute__((address_space(3))) v4i16_t*)p)); }
__device__ __forceinline__ float rowmax(const f32x16&p0,const f32x16&p1){
  float a=max3f(p0[0],p0[1],p1[0]),b=max3f(p0[2],p0[3],p1[1]);a=max3f(a,p1[2],p1[3]);
  #pragma unroll
  for(int r=4;r<16;r+=4){a=max3f(a,p0[r],p0[r+1]);b=max3f(b,p0[r+2],p0[r+3]);a=max3f(a,p1[r],p1[r+1]);b=max3f(b,p1[r+2],p1[r+3]);}
  const float m=max2f(a,b);
  auto rr=__builtin_amdgcn_permlane32_swap(__float_as_uint(m),__float_as_uint(m),false,false);
  return max2f(__uint_as_float(rr[0]),__uint_as_float(rr[1]));
}
__device__ __forceinline__ void pv(f32x16*o,int vb,bf16x8 pa0,bf16x8 pa1,bf16x8 pa2,bf16x8 pa3){
  #pragma unroll
  for(int d0=0;d0<2;++d0){s16x4 lo[4],hi[4];
    #pragma unroll
    for(int ks=0;ks<4;++ks){
      asm volatile("ds_read_b64_tr_b16 %0,%1 offset:%c2":"=&v"(lo[ks]):"v"(vb),"i"(d0*4096+ks*1024):"memory");
      asm volatile("ds_read_b64_tr_b16 %0,%1 offset:%c2":"=&v"(hi[ks]):"v"(vb),"i"(d0*4096+ks*1024+512):"memory");}
    asm volatile("s_waitcnt lgkmcnt(0)":::"memory");SBAR();
    #define PK(k) (bf16x8){lo[k][0],lo[k][1],lo[k][2],lo[k][3],hi[k][0],hi[k][1],hi[k][2],hi[k][3]}
    o[d0]=__builtin_amdgcn_mfma_f32_32x32x16_bf16(pa0,PK(0),o[d0],0,0,0);
    o[d0]=__builtin_amdgcn_mfma_f32_32x32x16_bf16(pa1,PK(1),o[d0],0,0,0);
    o[d0]=__builtin_amdgcn_mfma_f32_32x32x16_bf16(pa2,PK(2),o[d0],0,0,0);
    o[d0]=__builtin_amdgcn_mfma_f32_32x32x16_bf16(pa3,PK(3),o[d0],0,0,0);
    #undef PK
  }
}

#ifndef ATTN_STORE16
#define ATTN_STORE16(p,v) (*(u32x4*)(p)=(v))
#endif
template<int THRL> __device__ __forceinline__ void attn_unit(int b,int qcol,int vcol,int ocol,int qb,const bf16*Q,const bf16*__restrict__ K,const bf16*__restrict__ V,bf16*O,char*shm,unsigned*qctr,unsigned&ticket){
  const int tid=threadIdx.x,lane=tid&63,r32=lane&31,hi=lane>>5; const int wid=__builtin_amdgcn_readfirstlane(tid>>6);
  const long rowbase=(long)b*SEQ; const int q0=qb*QB;
  const bf16*Qw=Q+(rowbase+q0+wid*QBLK)*DM+qcol;
  const bf16*Kh=K+rowbase*DM+qcol,*Vh=V+rowbase*DM+vcol;
  const unsigned lds0=(unsigned)(uintptr_t)shm;
  float*wsf=(float*)(shm+LDS_WS)+wid*64;
  const bf16*ksrc=Kh+(long)lane*DM+wid*8;
  const bf16*vsrc=Vh+(long)(16*(wid&3)+(lane>>2))*DM+(wid>>2)*32+(lane&3)*8;
  const unsigned kdst=lds0+LDS_K+wid*1024, vdst=lds0+LDS_V+wid*1024;
  #define DMA_K(t,slot) glds16(ksrc+(long)(t)*KVBLK*DM,(unsigned)__builtin_amdgcn_readfirstlane(kdst+(slot)))
  #define DMA_V(t,slot) glds16(vsrc+(long)(t)*KVBLK*DM,(unsigned)__builtin_amdgcn_readfirstlane(vdst+(slot)))
  const int vb0=(int)(lds0+LDS_V)+((lane>>4)&1)*32+(lane&3)*8+(4*hi+((lane&15)>>2))*64;
  const char*Kbase=shm+LDS_K; bf16x8 kf[8];
  const lds_cptr shm3=(lds_cptr)shm; const lds_cptr kp0=shm3+LDS_K+hi*1024+r32*16; const lds_cptr vp0=shm3+LDS_V+((lane>>4)&1)*32+(lane&3)*8+(4*hi+((lane&15)>>2))*64;
  const int NT=(q0+QB)/KVBLK;
  DMA_K(0,0);DMA_V(0,0);DMA_K(1,SLOTB);
  bf16x8 qr[4];
  #pragma unroll
  for(int d0=0;d0<4;++d0)qr[d0]=*reinterpret_cast<const bf16x8*>(&Qw[(long)r32*DM+d0*16+hi*8]);
  float mhat=0.f,l_reg=0.f;f32x16 o[2];o[0]=f32x16{};o[1]=f32x16{};f32x16 negm=f32x16{};asm volatile("":"+v"(negm));
  const int qrel=wid*QBLK+r32;
  #define CMASK(P0,P1,t) do{int jb_=(t)-(NT-4); if(jb_>=0)cmask(P0,P1,jb_,qrel,hi);}while(0)
  bool resc=false;
  #define START(P0,P1) do{ const float rm=rowmax(P0,P1); resc=false; \
    { const float dl=rm; mhat=fadd_s(mhat,dl); \
      _Pragma("unroll") for(int r=0;r<16;++r){P0[r]=fsub_s(P0[r],dl);P1[r]=fsub_s(P1[r],dl);} \
      _Pragma("unroll") for(int r=0;r<16;++r)negm[r]=-mhat; asm volatile("":"+v"(negm)); } \
    _Pragma("unroll") for(int r=0;r<16;++r)P0[r]=__builtin_amdgcn_exp2f(P0[r]); }while(0)
  #define RESC() do{ if(resc){ asm volatile("s_waitcnt lgkmcnt(0)":::"memory"); \
      _Pragma("unroll") for(int d_=0;d_<2;++d_) _Pragma("unroll") for(int r=0;r<16;++r)o[d_][r]*=wsf[crow(r,hi)]; } }while(0)
  f32x16 pA0,pA1,pB0,pB1;
  int sl_prev=0,sl_cur=0,sl_next=SLOTB;
  #define ROT() do{sl_prev=sl_cur;sl_cur=sl_next;sl_next=(sl_next==(NSLOT-1)*SLOTB)?0:sl_next+SLOTB;}while(0)
  DMA_K(2,2*SLOTB);
  WAIT_BAR(3);
  qkt(pA0,pA1,Kbase,qr,negm,r32,hi);asm volatile("s_nop 15\n\ts_nop 7":"+v"(pA0),"+v"(pA1));CMASK(pA0,pA1,0);
  START(pA0,pA1);
  _Pragma("unroll") for(int r=0;r<16;++r)pA1[r]=__builtin_amdgcn_exp2f(pA1[r]);
  WAIT_BAR(0);
  DMA_K(3,0);DMA_V(1,SLOTB);
  ROT();
  kload8(kf,kp0+sl_cur);
  WAIT_BAR(2);
  s16x4 vlo[8],vhi[8]; u32x4 pw0,pw1,pw2,pw3;
  #define PKW(P,B) cvtpk_s(P[B],P[B+1])
  #define PAF(k) __builtin_bit_cast(bf16x8,pw##k)
  #define VFR(i) (bf16x8){vlo[i][0],vlo[i][1],vlo[i][2],vlo[i][3],vhi[i][0],vhi[i][1],vhi[i][2],vhi[i][3]}
  #define PIN(x) asm volatile("":"+v"(x))
  #define MX3(a,b,c) __builtin_fmaxf(__builtin_fmaxf((a),(b)),(c))
  #define GAPA(MF,A0,A1,A2,A3,W0,W1,PW) do{ MF; sacc+=A0; sacc+=A1; sacc+=A2; sacc+=A3; PIN(sacc); W0; W1; PIN(PW); SBAR(); }while(0)
  #define EX(v) __builtin_amdgcn_exp2f(v)
  #define GAPB(MF,X,B) do{ MF; X[B]=EX(X[B]); X[B+1]=EX(X[B+1]); X[B+2]=EX(X[B+2]); X[B+3]=EX(X[B+3]); PIN(X); SBAR(); }while(0)
  #define VRD(i) do{ vlo[i]=vtr(vp_+(((i)>>2)*4096+((i)&3)*1024)); vhi[i]=vtr(vp_+(((i)>>2)*4096+((i)&3)*1024+512)); }while(0)
  #define KRD(G,j) do{ if(G){ kload2(kf,kp0+sl_next,j); SBAR(); } }while(0)
  #define STEP(C0,C1,P0,P1,t,GK,GV,GL) do{ SBAR(); \
    const lds_cptr vp_=vp0+sl_prev; \
    VRD(0); SBAR(); float sacc=(P0[0]+P0[1]); \
    GAPA(C0=__builtin_amdgcn_mfma_f32_32x32x16_bf16(kf[0],qr[0],negm,0,0,0), P0[2],P0[3],P0[4],P0[5],     pw0[0]=PKW(P0,0), pw0[1]=PKW(P0,2), pw0); \
    VRD(4); SBAR(); GAPA(C1=__builtin_amdgcn_mfma_f32_32x32x16_bf16(kf[1],qr[0],negm,0,0,0), P0[6],P0[7],P0[8],P0[9],     pw0[2]=PKW(P0,4), pw0[3]=PKW(P0,6), pw0); \
    VRD(1); SBAR(); GAPA(C0=__builtin_amdgcn_mfma_f32_32x32x16_bf16(kf[2],qr[1],C0,0,0,0),   P0[10],P0[11],P0[12],P0[13], pw1[0]=PKW(P0,8), pw1[1]=PKW(P0,10), pw1); \
    VRD(5); SBAR(); GAPA(C1=__builtin_amdgcn_mfma_f32_32x32x16_bf16(kf[3],qr[1],C1,0,0,0),   P0[14],P0[15],P1[0],P1[1],   pw1[2]=PKW(P0,12),pw1[3]=PKW(P0,14), pw1); \
    VRD(2); SBAR(); GAPA(C0=__builtin_amdgcn_mfma_f32_32x32x16_bf16(kf[4],qr[2],C0,0,0,0),   P1[2],P1[3],P1[4],P1[5],     pw2[0]=PKW(P1,0), pw2[1]=PKW(P1,2), pw2); \
    VRD(6); SBAR(); GAPA(C1=__builtin_amdgcn_mfma_f32_32x32x16_bf16(kf[5],qr[2],C1,0,0,0),   P1[6],P1[7],P1[8],P1[9],     pw2[2]=PKW(P1,4), pw2[3]=PKW(P1,6), pw2); \
    VRD(3); SBAR(); GAPA(C0=__builtin_amdgcn_mfma_f32_32x32x16_bf16(kf[6],qr[3],C0,0,0,0),   P1[10],P1[11],P1[12],P1[13], pw3[0]=PKW(P1,8), pw3[1]=PKW(P1,10), pw3); \
    VRD(7); SBAR(); GAPA(C1=__builtin_amdgcn_mfma_f32_32x32x16_bf16(kf[7],qr[3],C1,0,0,0),   P1[14],P1[15],0.f,0.f,       pw3[2]=PKW(P1,12),pw3[3]=PKW(P1,14), pw3); \
    l_reg+=sacc; \
    if(GK){DMA_K((t)+3,sl_cur);} if(GV){DMA_V((t)+1,sl_next);} \
    CMASK(C0,C1,t); \
    { float a=MX3(C0[0],C0[1],C1[0]),b=MX3(C0[2],C0[3],C1[1]); a=MX3(a,C1[2],C1[3]); \
      _Pragma("unroll") for(int r=4;r<16;r+=4){a=MX3(a,C0[r],C0[r+1]);b=MX3(b,C0[r+2],C0[r+3]);a=MX3(a,C1[r],C1[r+1]);b=MX3(b,C1[r+2],C1[r+3]);} \
      float rm=__builtin_fmaxf(a,b); { auto rr=__builtin_amdgcn_permlane32_swap(__float_as_uint(rm),__float_as_uint(rm),false,false); rm=__builtin_fmaxf(__uint_as_float(rr[0]),__uint_as_float(rr[1])); } \
      resc=false; \
      if(__builtin_expect(__any(rm>(float)THRL),0)){ const float dl=__builtin_fmaxf(rm,0.f); mhat+=dl; \
        _Pragma("unroll") for(int r=0;r<16;++r){C0[r]-=dl;C1[r]-=dl;} \
        _Pragma("unroll") for(int r=0;r<16;++r)negm[r]=-mhat; asm volatile("":"+v"(negm)); \
        const float f=__builtin_amdgcn_exp2f(-dl); l_reg*=f; if(hi==0)wsf[r32]=f; resc=true; } } \
    SBAR(); \
    GAPB(o[0]=__builtin_amdgcn_mfma_f32_32x32x16_bf16(PAF(0),VFR(0),o[0],0,0,0), C0,0); \
    GAPB(o[1]=__builtin_amdgcn_mfma_f32_32x32x16_bf16(PAF(0),VFR(4),o[1],0,0,0), C0,4); \
    KRD(GL,0); GAPB(o[0]=__builtin_amdgcn_mfma_f32_32x32x16_bf16(PAF(1),VFR(1),o[0],0,0,0), C0,8); \
    KRD(GL,1); GAPB(o[1]=__builtin_amdgcn_mfma_f32_32x32x16_bf16(PAF(1),VFR(5),o[1],0,0,0), C0,12); \
    KRD(GL,2); GAPB(o[0]=__builtin_amdgcn_mfma_f32_32x32x16_bf16(PAF(2),VFR(2),o[0],0,0,0), C1,0); \
    KRD(GL,3); GAPB(o[1]=__builtin_amdgcn_mfma_f32_32x32x16_bf16(PAF(2),VFR(6),o[1],0,0,0), C1,4); \
    GAPB(o[0]=__builtin_amdgcn_mfma_f32_32x32x16_bf16(PAF(3),VFR(3),o[0],0,0,0), C1,8); \
    GAPB(o[1]=__builtin_amdgcn_mfma_f32_32x32x16_bf16(PAF(3),VFR(7),o[1],0,0,0), C1,12); \
    }while(0)
  int t=1;
  #undef CMASK
  #define CMASK(P0,P1,t) do{}while(0)
  for(;t+5<NT;t+=2){
    STEP(pB0,pB1,pA0,pA1,t,true,true,true);     WAIT_BAR(2); RESC(); ROT();
    STEP(pA0,pA1,pB0,pB1,t+1,true,true,true);   WAIT_BAR(2); RESC(); ROT();
  }
  #undef CMASK
  #define CMASK(P0,P1,t) do{int jb_=(t)-(NT-4); if(jb_>=0)cmask(P0,P1,jb_,qrel,hi);}while(0)
  #define ENDW(tt) do{ if((tt)+3<NT){WAIT_BAR(2);} else if((tt)+2<NT){WAIT_BAR(1);} else {WAIT_BAR(0);} }while(0)
  for(;t+1<NT;t+=2){
    STEP(pB0,pB1,pA0,pA1,t,(t+3<NT),(t+1<NT),(t+1<NT));       ENDW(t);   RESC(); ROT();
    STEP(pA0,pA1,pB0,pB1,t+1,(t+4<NT),(t+2<NT),(t+2<NT));     ENDW(t+1); RESC(); ROT();
  }
  STEP(pB0,pB1,pA0,pA1,NT-1,false,false,false); RESC();
  { float sacc=pB0[0]+pB0[1]; _Pragma("unroll") for(int r=2;r<16;++r)sacc+=pB0[r]; _Pragma("unroll") for(int r=0;r<16;++r)sacc+=pB1[r]; l_reg+=sacc;
    pw0=(u32x4){PKW(pB0,0),PKW(pB0,2),PKW(pB0,4),PKW(pB0,6)};pw1=(u32x4){PKW(pB0,8),PKW(pB0,10),PKW(pB0,12),PKW(pB0,14)};pw2=(u32x4){PKW(pB1,0),PKW(pB1,2),PKW(pB1,4),PKW(pB1,6)};pw3=(u32x4){PKW(pB1,8),PKW(pB1,10),PKW(pB1,12),PKW(pB1,14)};
    SBAR(); pv(o,vb0+sl_cur,PAF(0),PAF(1),PAF(2),PAF(3)); }
  #undef PKW
  #undef PAF
  #undef VFR
  #undef PIN
  #undef MX3
  #undef GAPA
  #undef GAPB
  #undef EX
  #undef VRD
  #undef KRD
  #undef STEP
  #undef ENDW
  if(threadIdx.x==0){unsigned z_=0u;asm volatile("":"+v"(z_));ticket=__hip_atomic_fetch_add(qctr+z_,1u,__ATOMIC_RELAXED,__HIP_MEMORY_SCOPE_AGENT);}
  {auto rr=__builtin_amdgcn_permlane32_swap(__float_as_uint(l_reg),__float_as_uint(l_reg),false,false);l_reg=__uint_as_float(rr[0])+__uint_as_float(rr[1]);}
  if(hi==0)wsf[32+r32]=l_reg;asm volatile("s_waitcnt lgkmcnt(0)":::"memory");
  float rli[16];
  #pragma unroll
  for(int r=0;r<16;++r)rli[r]=__builtin_amdgcn_rcpf(wsf[32+crow(r,hi)]);
  bf16*Ow=O+(rowbase+q0+wid*QBLK)*OPITCH+ocol;
  { bf16*stg=(bf16*)(shm+LDS_OST)+wid*2048;
    #pragma unroll
    for(int r=0;r<16;++r){const int orow=crow(r,hi);
      #pragma unroll
      for(int d0=0;d0<2;++d0)stg[orow*64+d0*32+r32]=__float2bfloat16(o[d0][r]*rli[r]);}
    asm volatile("s_waitcnt lgkmcnt(0)":::"memory");
    #pragma unroll
    for(int i=0;i<4;++i){const int row=i*8+(lane>>3),ch=lane&7; const u32x4 v=*(const u32x4*)(stg+row*64+ch*8); ATTN_STORE16(Ow+(long)row*OPITCH+ch*8,v);} }
  asm volatile("s_waitcnt lgkmcnt(0)\n\ts_barrier":::"memory");
  #undef DMA_K
  #undef DMA_V
  #undef CMASK
  #undef START
  #undef RESC
  #undef ROT
}
constexpr int ATTN_LDS_BYTES=LDS_BYTES;
#undef SBAR
#undef WAIT_BAR
}
constexpr size_t MiB = 1u << 20;
constexpr size_t WS_CTL = 0, CTL_ZERO_BYTES = 1 * MiB;
constexpr size_t WS_WIN = 2 * MiB, WS_WOUT = 26 * MiB, WS_WQ = 34 * MiB, WS_WKV = 42 * MiB, WS_WO = 58 * MiB, WS_W1 = 66 * MiB, WS_W2 = 578 * MiB;
constexpr size_t WS_HN = 834 * MiB, WS_MN = 866 * MiB, WS_PROJ = 870 * MiB, WS_DT = 958 * MiB, WS_KVRAW = 959 * MiB, WS_KN = 967 * MiB;
constexpr size_t WS_YCAT = 971 * MiB, WS_O0 = 1003 * MiB, WS_O1 = 1019 * MiB, WS_H1 = 1035 * MiB, WS_H1B = 1099 * MiB, WS_PART1 = 1131 * MiB, WS_PARTQ = 1132 * MiB;
constexpr size_t WS_QRAW = 1133 * MiB, WS_P = 1165 * MiB, WS_VWT = 1181 * MiB, WS_H2 = 1197 * MiB, WS_HN3 = 1261 * MiB;
constexpr size_t WS_TOKOF = 1293 * MiB, WS_GATEOF = 1294 * MiB, WS_TOKE = 1295 * MiB, WS_TOKR = 1296 * MiB, WS_YG = 1297 * MiB;
constexpr size_t WS_H1F8 = 3368 * MiB  , WS_QF8 = 3384 * MiB  , WS_KN8 = 3400 * MiB  , WS_VF8 = 3402 * MiB  ;
constexpr size_t WS_P8 = 3404 * MiB  , WS_VWT8 = 3412 * MiB  ;
constexpr size_t WS_XG = 1320 * MiB  , WS_ACT = 1832 * MiB  , WS_Y = 2344 * MiB  , WS_END = 3420 * MiB;
constexpr int CW_BAR = 4096;
constexpr int CW_QCONV2 = 12416;
constexpr int CW_QCONV = 12352;
constexpr int CW_QATT = 12288;
constexpr int CW_CNT = 8192;
static_assert((CW_CNT + 64 * 32) * 4 <= (int)CTL_ZERO_BYTES, "CTL words inside the memset region");

constexpr int RING_OFF = 0, RING_BYTES = 131072;
constexpr int LDS_BYTES = 163840;
constexpr int MISC_OFF = 163840 - 1024;
constexpr int NWAVES = 8;

#define XB_TMO      128
#define XB_XCNT(j)  (256  + 64 * (j))
#define XB_XSUB(j)  (1280 + 64 * (j))
#define XB_XGEN(j)  (2304 + 64 * (j))
#define XB_TOP      3328
#define XB_TOPGEN   3392
#define XCD_BAR_WORDS 3456
#define XB_SPIN_CAP (1u << 20)

__device__ __forceinline__ unsigned xb_ld(unsigned* p)              { return __hip_atomic_load(p, __ATOMIC_RELAXED, __HIP_MEMORY_SCOPE_AGENT); }
__device__ __forceinline__ unsigned xb_add(unsigned* p, unsigned v) { return __hip_atomic_fetch_add(p, v, __ATOMIC_RELAXED, __HIP_MEMORY_SCOPE_AGENT); }
__device__ __forceinline__ unsigned xb_xcc_id() { return (unsigned)__builtin_amdgcn_s_getreg((3 << 11) | 20) & 0xFu; }
#define XB_SPIN(cond, bar) do { unsigned _sp = 0; while (cond) { __builtin_amdgcn_s_sleep(1); \
    if ((++_sp & 255u) == 0u) { if (xb_ld(&(bar)[XB_TMO])) break; if (_sp > XB_SPIN_CAP) { atomicAdd(&(bar)[XB_TMO], 1u); break; } } } } while (0)

struct XcdBarrier {
    unsigned* bar; unsigned x;
    volatile LAS unsigned* st;
};
__device__ __forceinline__ XcdBarrier xcd_barrier_post(unsigned* bar, volatile LAS unsigned* st) {
    XcdBarrier b; b.bar = bar; b.x = xb_xcc_id(); b.st = st;
    if (threadIdx.x == 0) (void)xb_add(&bar[XB_XCNT(b.x)], 1u);
    return b;
}
__device__ __forceinline__ void xcd_barrier_complete(unsigned* bar, unsigned x, unsigned& nloc, unsigned& nx) {
    const unsigned G = gridDim.x * gridDim.y * gridDim.z;
    unsigned sum, cnt, mine, sp = 0u;
    for (;;) {
        sum = 0u; cnt = 0u; mine = 0u;
#pragma unroll
        for (unsigned j = 0; j < 16; ++j) { const unsigned c = xb_ld(&bar[XB_XCNT(j)]); sum += c; cnt += (c > 0u) ? 1u : 0u; mine = (j == x) ? c : mine; }
        if (sum == G) break;
        __builtin_amdgcn_s_sleep(1);
        if ((++sp & 255u) == 0u) { if (xb_ld(&bar[XB_TMO])) break; if (sp > XB_SPIN_CAP) { atomicAdd(&bar[XB_TMO], 1u); break; } }
    }
    nloc = mine > 0u ? mine : 1u; nx = cnt > 0u ? cnt : 1u;
}
__device__ __forceinline__ void xcd_barrier(const XcdBarrier& b) {
    asm volatile("s_waitcnt vmcnt(0)" ::: "memory");
    __syncthreads();
    if (threadIdx.x == 0) {
        unsigned* bar = b.bar;
        __builtin_amdgcn_s_waitcnt(0);
        unsigned nloc = b.st[0], nx = b.st[1];
        if (nloc == 0u) { xcd_barrier_complete(bar, b.x, nloc, nx); b.st[0] = nloc; b.st[1] = nx; }
        const unsigned old = xb_add(&bar[XB_XSUB(b.x)], 1u);
        const unsigned gen = old / nloc;
        if (old + 1u == (gen + 1u) * nloc) {
            __builtin_amdgcn_fence(__ATOMIC_RELEASE, "agent");
            asm volatile("s_waitcnt vmcnt(0)" ::: "memory");
            const unsigned og = xb_add(&bar[XB_TOP], 1u);
            const unsigned tg = og / nx;
            if (og + 1u == (tg + 1u) * nx) xb_add(&bar[XB_TOPGEN], 1u);
            else XB_SPIN(xb_ld(&bar[XB_TOPGEN]) == tg, bar);
            __builtin_amdgcn_fence(__ATOMIC_ACQUIRE, "agent");
            xb_add(&bar[XB_XGEN(b.x)], 1u);
            asm volatile("s_waitcnt vmcnt(0)" ::: "memory");
        } else {
            XB_SPIN(xb_ld(&bar[XB_XGEN(b.x)]) == gen, bar);
            __builtin_amdgcn_fence(__ATOMIC_ACQUIRE, "agent");
            asm volatile("s_waitcnt vmcnt(0)" ::: "memory");
        }
    }
    __syncthreads();
}

struct Args { const float* in[32]; float* out; unsigned char* ws; int ph_lo, ph_hi, probe, pad_; };
enum In { I_X = 0, I_MEM, I_GMIX, I_WIN, I_CONVW, I_CONVB, I_DTB, I_ALOG, I_DSKIP, I_SSDG, I_DAQG, I_DAKG, I_LQ1, I_LK1, I_LQ2, I_LK2, I_SUBG, I_WOUT, I_GXA, I_GMEM,
          I_WQ, I_WKV, I_XQG, I_XKG, I_WO, I_GFFN, I_RW, I_RB, I_W1, I_B1, I_W2, I_B2 };

struct ArgP {
    typedef const __attribute__((address_space(4))) char* kptr;
    DI const float* in(int i) const { kptr kp = (kptr)__builtin_amdgcn_kernarg_segment_ptr(); asm volatile("" : "+s"(kp)); return *(const float* const __attribute__((address_space(4)))*)(kp + 8 * i); }
    DI float* out() const { kptr kp = (kptr)__builtin_amdgcn_kernarg_segment_ptr(); asm volatile("" : "+s"(kp)); return *(float* const __attribute__((address_space(4)))*)(kp + 8 * 32); }
};
struct Frame {
    LAS unsigned char* lds;
    volatile LAS unsigned* MISC;
    unsigned* ctl;
    unsigned char* ws;
    int tid, lane, wave, vcu, G;
};

template <class DestRow>
DI void tr_item(const float* W, size_t ldw, int k0, int ncol0, int nvalid, const float* kscale, bf16_t* WT, int K, DestRow dr, LAS float* scr, int lane) {
    const int c = lane & 31;
#pragma unroll 8
    for (int i = 0; i < 32; ++i) { const int kk = 2 * i + (lane >> 5);
        float v = (c < nvalid) ? W[(size_t)(k0 + kk) * ldw + ncol0 + c] : 0.f;
        if (kscale) v *= kscale[k0 + kk];
        scr[kk * 33 + c] = v; }
    asm volatile("s_waitcnt lgkmcnt(0)" ::: "memory");
    const int c8 = lane & 7;
#pragma unroll
    for (int j = 0; j < 4; ++j) { const int n = (lane >> 3) + 8 * j; const LAS float* s = scr + (8 * c8) * 33 + n;
        u32x4 o; o.x = pk2(s[0 * 33], s[1 * 33]); o.y = pk2(s[2 * 33], s[3 * 33]); o.z = pk2(s[4 * 33], s[5 * 33]); o.w = pk2(s[6 * 33], s[7 * 33]);
        if (n < nvalid) *(u32x4*)(WT + (size_t)dr(ncol0 + n) * K + k0 + 8 * c8) = o; }
    asm volatile("s_waitcnt lgkmcnt(0)" ::: "memory");
}
template <class DestRow>
DI void tr_item_fp8(const float* W, size_t ldw, int k0, int ncol0, const float* kscale, unsigned char* WT, int K, DestRow dr, LAS float* scr, int lane) {
    const int c = lane & 31;
#pragma unroll 8
    for (int i = 0; i < 32; ++i) { const int kk = 2 * i + (lane >> 5); float v = W[(size_t)(k0 + kk) * ldw + ncol0 + c]; if (kscale) v *= kscale[k0 + kk]; scr[kk * 33 + c] = v; }
    asm volatile("s_waitcnt lgkmcnt(0)" ::: "memory");
    const int n = lane >> 1, hf = lane & 1; const LAS float* s = scr + (32 * hf) * 33 + n;
    unsigned w[8];
#pragma unroll
    for (int j = 0; j < 8; ++j) { unsigned x = 0u;
        x = __builtin_amdgcn_cvt_pk_fp8_f32(s[(4 * j) * 33] * 64.f, s[(4 * j + 1) * 33] * 64.f, x, false);
        x = __builtin_amdgcn_cvt_pk_fp8_f32(s[(4 * j + 2) * 33] * 64.f, s[(4 * j + 3) * 33] * 64.f, x, true); w[j] = x; }
    unsigned char* op = WT + (size_t)dr(ncol0 + n) * K + k0 + 32 * hf;
    *(u32x4*)op = (u32x4){w[0], w[1], w[2], w[3]}; *(u32x4*)(op + 16) = (u32x4){w[4], w[5], w[6], w[7]};
    asm volatile("s_waitcnt lgkmcnt(0)" ::: "memory");
}
DI int tileperm(int col) { const int o = col & 255; return (col & ~255) + 128 * ((o & 63) >> 5) + 32 * (o >> 6) + (o & 31); }
struct DrIdent { DI int operator()(int n) const { return n; } };
struct DrTile  { DI int operator()(int n) const { return tileperm(n); } };
struct DrWin   { DI int operator()(int n) const { const int pc = (n < 2560) ? n : (n < 2576 ? PC_DT + (n - 2560) : n - 16); return tileperm(pc); } };
struct DrW1    { DI int operator()(int n) const { const int half = n >> 11, j = n & 2047; return (j >> 7) * 256 + half * 128 + (j & 127); } };

template <bool FP8, class DestRow>
DI void cv_item(const float* W, size_t ldw, int k0, int ncol0, const float* kscale, float scale, void* WT, int kpitch, DestRow dr, LAS float* scr, int lane) {
    const int r = lane >> 3, c4 = (lane & 7) * 4;
    f32x4 v[16];
#pragma unroll
    for (int i = 0; i < 16; ++i) v[i] = *(const f32x4*)(W + (size_t)(k0 + 8 * i + r) * ldw + ncol0 + c4);
#pragma unroll
    for (int i = 0; i < 16; ++i) { f32x4 x = v[i] * scale; if (kscale) x = x * kscale[k0 + 8 * i + r]; *(LAS f32x4*)(scr + (8 * i + r) * 36 + c4) = x; }
    asm volatile("s_waitcnt lgkmcnt(0)" ::: "memory");
    const int n = lane & 31, hf = lane >> 5; const LAS float* s = scr + (64 * hf) * 36 + n;
    if constexpr (FP8) {
        unsigned w[16];
#pragma unroll
        for (int j = 0; j < 16; ++j) { unsigned x = 0u; x = __builtin_amdgcn_cvt_pk_fp8_f32(s[(4 * j) * 36], s[(4 * j + 1) * 36], x, false); x = __builtin_amdgcn_cvt_pk_fp8_f32(s[(4 * j + 2) * 36], s[(4 * j + 3) * 36], x, true); w[j] = x; }
        unsigned char* op = (unsigned char*)WT + (size_t)dr(ncol0 + n) * kpitch + k0 + 64 * hf;
#pragma unroll
        for (int j = 0; j < 4; ++j) *(u32x4*)(op + 16 * j) = (u32x4){w[4 * j], w[4 * j + 1], w[4 * j + 2], w[4 * j + 3]};
    } else {
        unsigned w[32];
#pragma unroll
        for (int j = 0; j < 32; ++j) w[j] = pk2(s[(2 * j) * 36], s[(2 * j + 1) * 36]);
        unsigned char* op = (unsigned char*)WT + (size_t)dr(ncol0 + n) * kpitch + (k0 + 64 * hf) * 2;
#pragma unroll
        for (int j = 0; j < 8; ++j) *(u32x4*)(op + 16 * j) = (u32x4){w[4 * j], w[4 * j + 1], w[4 * j + 2], w[4 * j + 3]};
    }
    asm volatile("s_waitcnt lgkmcnt(0)" ::: "memory");
}
DI void rms_row_to_bf16(const float* xrow, const float* g, bf16_t* orow, int lane) {
    const f32x4* xr = (const f32x4*)xrow + lane;
    f32x4 v[8]; float s = 0.f;
#pragma unroll
    for (int j = 0; j < 8; ++j) { v[j] = xr[64 * j]; s += (v[j].x * v[j].x + v[j].y * v[j].y) + (v[j].z * v[j].z + v[j].w * v[j].w); }
    const float rstd = 1.f / sqrtf(wave_sum(s) * (1.f / 2048.f) + EPS_);
    u32x2* o8 = (u32x2*)orow + lane;
#pragma unroll
    for (int j = 0; j < 8; ++j) { const f32x4 gg = ((const f32x4*)g)[lane + 64 * j];
        u32x2 o; o.x = pk2(v[j].x * rstd * gg.x, v[j].y * rstd * gg.y); o.y = pk2(v[j].z * rstd * gg.z, v[j].w * rstd * gg.w); o8[64 * j] = o; }
}

DI void p0_prologue(Frame& F, const ArgP& a) {
    LAS float* scr = (LAS float*)(F.lds + RING_OFF + F.wave * 16384);
    const int gw = F.vcu * NWAVES + F.wave, NGW = F.G * NWAVES;
    unsigned char* ws = F.ws;
    constexpr int I_A = 32 * 80, I_B = 32, I_C = 32 * 96, NITEMS = I_A + I_B + I_C;
    for (int it = gw; it < NITEMS; it += NGW) {
        int r = it;
        if (r < I_A) { tr_item(a.in(I_WIN), 5648, 64 * (r / 80), 32 * (r % 80), 32, nullptr, (bf16_t*)(ws + WS_WIN), 2048, DrWin(), scr, F.lane); continue; } r -= I_A;
        if (r < I_B) { tr_item(a.in(I_WIN), 5648, 64 * r, 2560, 16, nullptr, (bf16_t*)(ws + WS_WIN), 2048, DrWin(), scr, F.lane); continue; } r -= I_B;
        tr_item(a.in(I_WIN), 5648, 64 * (r / 96), 2576 + 32 * (r % 96), 32, nullptr, (bf16_t*)(ws + WS_WIN), 2048, DrWin(), scr, F.lane);
    }
    for (int m = gw; m < NTOK; m += NGW) rms_row_to_bf16(a.in(I_X) + (size_t)m * 2048, a.in(I_GMIX), (bf16_t*)(ws + WS_HN) + (size_t)m * 2048, F.lane);
    for (int m = gw; m < NB * MEMLEN; m += NGW) rms_row_to_bf16(a.in(I_MEM) + (size_t)m * 2048, a.in(I_GMEM), (bf16_t*)(ws + WS_MN) + (size_t)m * 2048, F.lane);
}
struct CvIt { const float* W; size_t ldw; const float* ks; unsigned char* WT; float scale; int k0, n0, kpitch, fp8, dr, tiled; };
DI CvIt cv_decode(int it, const ArgP& a, unsigned char* ws) {
    constexpr int J_WOUT = 16 * 64, J_WKV = 16 * 128, J_WQ = 16 * 64, J_WO = 16 * 64, J_W1 = 32 * 16 * 128;
    CvIt c; c.ks = nullptr; c.scale = 64.f; c.fp8 = 1; c.dr = 0; c.kpitch = 2048; c.ldw = 2048; c.tiled = 0;
    int r = it;
    if (r < J_WOUT) { c.W = a.in(I_WOUT); c.k0 = 128 * (r / 64); c.n0 = 32 * (r % 64); c.WT = ws + WS_WOUT; c.scale = 1.f; c.fp8 = 0; c.kpitch = 4096; return c; } r -= J_WOUT;
    if (r < J_WKV) { c.W = a.in(I_WKV); c.ldw = 4096; c.k0 = 128 * (r / 128); c.n0 = 32 * (r % 128); c.WT = ws + WS_WKV; c.scale = 1.f; c.fp8 = 0; c.kpitch = 4096; c.dr = 1; return c; } r -= J_WKV;
    if (r < J_WQ) { c.W = a.in(I_WQ); c.ks = a.in(I_GXA); c.k0 = 128 * (r / 64); c.n0 = 32 * (r % 64); c.WT = ws + WS_WQ; return c; } r -= J_WQ;
    if (r < J_WO) { c.W = a.in(I_WO); c.k0 = 128 * (r / 64); c.n0 = 32 * (r % 64); c.WT = ws + WS_WO; return c; } r -= J_WO;
    if (r < J_W1) { const int e = r / (16 * 128), q = r % (16 * 128); c.W = a.in(I_W1) + (size_t)e * 2048 * 4096; c.ldw = 4096; c.k0 = 128 * (q / 128); c.n0 = 32 * (q % 128); c.WT = ws + WS_W1 + (size_t)e * 4096 * 2048; c.dr = 2; c.tiled = 1; return c; } r -= J_W1;
    { const int e = r / (16 * 64), q = r % (16 * 64); c.W = a.in(I_W2) + (size_t)e * 2048 * 2048; c.k0 = 128 * (q / 64); c.n0 = 32 * (q % 64); c.WT = ws + WS_W2 + (size_t)e * 2048 * 2048; c.tiled = 1; }
    return c;
}
constexpr int CV_NJ = 16 * 64 * 3 + 16 * 128 + 32 * 16 * 128 + 32 * 16 * 64;
constexpr int CV_TAIL2 = 12288;
constexpr int CV_TAIL1 = 20480;
constexpr int CV_TAIL = CV_TAIL1 + CV_TAIL2;
DI void conv_share(Frame& F, const ArgP& a) {
    LAS float* scr = (LAS float*)(F.lds + F.wave * 16384);
    const unsigned sbase = (unsigned)__builtin_amdgcn_readfirstlane((int)((unsigned)(uintptr_t)F.lds + (unsigned)F.wave * 16384u));
    const int gw = F.vcu * NWAVES + F.wave, NGW = F.G * NWAVES, lane = F.lane;
    unsigned char* ws = F.ws;
    constexpr int NJ = CV_NJ - CV_TAIL;
    const int n = lane & 31, hf = lane >> 5;
    for (int it = gw; it < NJ; it += NGW) {
        const CvIt cur = cv_decode(it, a, ws);
        const char* gb = (const char*)(cur.W + (size_t)cur.k0 * cur.ldw + cur.n0);
        const unsigned vo0 = (unsigned)(((size_t)(lane >> 3) * cur.ldw + (size_t)(lane & 7) * 4) * 4), vstep = (unsigned)(8 * cur.ldw * 4);
#pragma unroll
        for (int p = 0; p < 16; ++p) { unsigned keep_;
            asm volatile("s_mov_b32 %0, m0\n\ts_mov_b32 m0, %3\n\ts_nop 0\n\tglobal_load_lds_dwordx4 %1, %2 nt\n\ts_mov_b32 m0, %0"
                         : "=&s"(keep_) : "v"(vo0 + (unsigned)p * vstep), "s"(gb), "s"(sbase + (unsigned)p * 1024u) : "memory"); }
        asm volatile("s_waitcnt vmcnt(0)" ::: "memory");
        const LAS float* s = scr + (64 * hf) * 32 + n;
        const int col = cur.n0 + n; const int drow = (cur.dr == 0) ? col : (cur.dr == 1 ? tileperm(col) : DrW1()(col));
        const float* ksp = cur.ks ? cur.ks + cur.k0 + 64 * hf : nullptr;
        if (cur.fp8) {
            unsigned w[16];
#pragma unroll
            for (int j = 0; j < 16; ++j) { float x0 = s[(4 * j) * 32] * cur.scale, x1 = s[(4 * j + 1) * 32] * cur.scale, x2 = s[(4 * j + 2) * 32] * cur.scale, x3 = s[(4 * j + 3) * 32] * cur.scale;
                if (ksp) { x0 *= ksp[4 * j]; x1 *= ksp[4 * j + 1]; x2 *= ksp[4 * j + 2]; x3 *= ksp[4 * j + 3]; }
                unsigned x = 0u; x = __builtin_amdgcn_cvt_pk_fp8_f32(x0, x1, x, false); x = __builtin_amdgcn_cvt_pk_fp8_f32(x2, x3, x, true); w[j] = x; }
            unsigned char* op = cur.tiled ? cur.WT + ((size_t)(((drow >> 8) * 16 + (cur.k0 >> 7)) * 256 + (drow & 255))) * 128 + 64 * hf : cur.WT + (size_t)drow * cur.kpitch + cur.k0 + 64 * hf;
#pragma unroll
            for (int j = 0; j < 4; ++j) *(u32x4*)(op + 16 * j) = (u32x4){w[4 * j], w[4 * j + 1], w[4 * j + 2], w[4 * j + 3]};
        } else {
            unsigned w[32];
#pragma unroll
            for (int j = 0; j < 32; ++j) w[j] = pk2(s[(2 * j) * 32] * cur.scale, s[(2 * j + 1) * 32] * cur.scale);
            unsigned char* op = cur.WT + (size_t)drow * cur.kpitch + (cur.k0 + 64 * hf) * 2;
#pragma unroll
            for (int j = 0; j < 8; ++j) *(u32x4*)(op + 16 * j) = (u32x4){w[4 * j], w[4 * j + 1], w[4 * j + 2], w[4 * j + 3]};
        }
        asm volatile("s_waitcnt lgkmcnt(0)" ::: "memory");
    }
}

DI void conv_queue(Frame& F, const ArgP& a, int qword, int first, int count) {
    LAS float* scr = (LAS float*)(F.lds + F.wave * 18432);
    unsigned char* ws = F.ws;
    const int lane = threadIdx.x & 63, r = lane >> 3, c4 = (lane & 7) * 4, n = lane & 31, hf = lane >> 5;
    for (;;) {
        if (threadIdx.x == 0) F.MISC[121] = __hip_atomic_fetch_add(F.ctl + qword, 8u, __ATOMIC_RELAXED, __HIP_MEMORY_SCOPE_AGENT);
        __syncthreads();
        const int base = __builtin_amdgcn_readfirstlane((int)F.MISC[121]);
        __syncthreads();
        if (base >= count) break;
        const int it = first + base + F.wave;
        if (base + F.wave < count) {
            const CvIt cur = cv_decode(it, a, ws);
            f32x4 v[16];
#pragma unroll
            for (int i = 0; i < 16; ++i) v[i] = __builtin_nontemporal_load((const f32x4*)(cur.W + (size_t)(cur.k0 + 8 * i + r) * cur.ldw + cur.n0 + c4));
#pragma unroll
            for (int i = 0; i < 16; ++i) *(LAS f32x4*)(scr + (8 * i + r) * 36 + c4) = v[i] * cur.scale;
            asm volatile("s_waitcnt lgkmcnt(0)" ::: "memory");
            const LAS float* s = scr + (64 * hf) * 36 + n;
            unsigned w[16];
#pragma unroll
            for (int j = 0; j < 16; ++j) { unsigned x = 0u; x = __builtin_amdgcn_cvt_pk_fp8_f32(s[(4 * j) * 36], s[(4 * j + 1) * 36], x, false); x = __builtin_amdgcn_cvt_pk_fp8_f32(s[(4 * j + 2) * 36], s[(4 * j + 3) * 36], x, true); w[j] = x; }
            const int drow = cur.n0 + n; unsigned char* op = cur.WT + ((size_t)(((drow >> 8) * 16 + (cur.k0 >> 7)) * 256 + (drow & 255))) * 128 + 64 * hf;
#pragma unroll
            for (int j = 0; j < 4; ++j) *(u32x4*)(op + 16 * j) = (u32x4){w[4 * j], w[4 * j + 1], w[4 * j + 2], w[4 * j + 3]};
            asm volatile("s_waitcnt lgkmcnt(0)" ::: "memory");
        }
    }
}
static_assert(CV_TAIL <= 32 * 16 * 64 && CV_TAIL1 % 8 == 0 && CV_TAIL2 % 8 == 0, "the tails are a suffix of the moe_w2 items");

struct SchedP1 {
    int G, c; const unsigned char* ws; int lo, hi;
    DI bool next(int i, pg8::UnitD& u) const {
        u.rows = nullptr; u.nvalid = 0; u.lda = 4096u; u.ldb = 4096u; u.e = 0; u.x0 = 0;
        if (lo == 0) {
            if (G == 256) { const int x = c >> 5, s = c & 31, bidx = i * 8 + x; if (bidx >= 24) return false;
                const int g = bidx >> 2, h = bidx & 3; u.pn = 4 * g + (s >> 3); u.pm = h * 8 + (s & 7); if (u.pn >= 23) return false; }
            else { const int L = i * G + c; if (L >= 32 * 23) return false; u.pn = L / 32; u.pm = L % 32; }
            u.type = 0; u.A = (const char*)(ws + WS_HN) + (size_t)u.pm * 256 * 4096; u.B = (const char*)(ws + WS_WIN) + (size_t)u.pn * 256 * 4096;
            return true;
        }
        const int L = lo + i * G + c; if (L >= hi) return false;
        { const int q = L - 32 * 23; u.type = 1; u.pn = q / 4; u.pm = q % 4; u.A = (const char*)(ws + WS_MN) + (size_t)u.pm * 256 * 4096; u.B = (const char*)(ws + WS_WKV) + (size_t)u.pn * 256 * 4096; }
        return true;
    }
};
struct EpiP1 {
    static constexpr bool AFTER_DRAIN = false;
    bf16_t* proj; float* dtb; bf16_t* kvraw; const float* gq; const float* gk; unsigned char* vf8;
    DI void operator()(const f32x4 (&acc)[2][2][4][2], const pg8::UnitD& u, int wr, int wc, int fr, int fq) const {
        { int ln_ = threadIdx.x; asm volatile("" : "+v"(ln_)); fr = ln_ & 15; fq = (ln_ >> 4) & 3; }
        const int row0 = u.pm * 256 + wr * 64 + fr;
        const int cn = u.pn * 256 + 64 * wc + 8 * fq;
        if (u.type == 1 && u.pn >= 8) {
#pragma unroll
            for (int ai = 0; ai < 2; ++ai)
#pragma unroll
                for (int m = 0; m < 4; ++m) { unsigned char* rp = vf8 + (size_t)(row0 + ai * 128 + m * 16) * 2048 + (cn - 2048);
#pragma unroll
                    for (int bj = 0; bj < 2; ++bj) { const f32x4 v0 = acc[ai][bj][m][0] * 16.f, v1 = acc[ai][bj][m][1] * 16.f;
                        u32x2 w; w.x = __builtin_amdgcn_cvt_pk_fp8_f32(v0[0], v0[1], 0u, false); w.x = __builtin_amdgcn_cvt_pk_fp8_f32(v0[2], v0[3], w.x, true);
                        w.y = __builtin_amdgcn_cvt_pk_fp8_f32(v1[0], v1[1], 0u, false); w.y = __builtin_amdgcn_cvt_pk_fp8_f32(v1[2], v1[3], w.y, true);
                        *(u32x2*)(rp + 32 * bj) = w; } }
            return;
        }
        if (u.type == 1) {
#pragma unroll
            for (int ai = 0; ai < 2; ++ai)
#pragma unroll
                for (int m = 0; m < 4; ++m) { bf16_t* rp = kvraw + (size_t)(row0 + ai * 128 + m * 16) * 4096 + cn;
#pragma unroll
                    for (int bj = 0; bj < 2; ++bj) { const f32x4 v0 = acc[ai][bj][m][0], v1 = acc[ai][bj][m][1];
                        u32x4 w; w.x = pk2(v0[0], v0[1]); w.y = pk2(v0[2], v0[3]); w.z = pk2(v1[0], v1[1]); w.w = pk2(v1[2], v1[3]); *(u32x4*)(rp + 32 * bj) = w; } }
            return;
        }
        if (u.pn == 22) {
            if (wc == 0 && fq < 2) {
#pragma unroll
                for (int ai = 0; ai < 2; ++ai)
#pragma unroll
                    for (int m = 0; m < 4; ++m) { float* rp = dtb + (size_t)(row0 + ai * 128 + m * 16) * 16 + 8 * fq;
                        *(f32x4*)(rp) = acc[ai][0][m][0]; *(f32x4*)(rp + 4) = acc[ai][0][m][1]; }
            }
            return;
        }
        const bool isq = (u.pn >= 10 && u.pn < 14), isk = (u.pn >= 14 && u.pn < 18);
        if (!(isq || isk)) {
#pragma unroll
            for (int ai = 0; ai < 2; ++ai)
#pragma unroll
                for (int m = 0; m < 4; ++m) { bf16_t* rp = proj + (size_t)(row0 + ai * 128 + m * 16) * PP + cn;
#pragma unroll
                    for (int bj = 0; bj < 2; ++bj) { const f32x4 v0 = acc[ai][bj][m][0], v1 = acc[ai][bj][m][1];
                        u32x4 w; w.x = pk2(v0[0], v0[1]); w.y = pk2(v0[2], v0[3]); w.z = pk2(v1[0], v1[1]); w.w = pk2(v1[2], v1[3]); *(u32x4*)(rp + 32 * bj) = w; } }
            return;
        }
        const float* g = (isq ? gq : gk) + 8 * fq; const float sc = isq ? (0.125f * 1.4426950408889634f) : 1.f;
#pragma unroll
        for (int ai = 0; ai < 2; ++ai)
#pragma unroll
            for (int m = 0; m < 4; ++m) { bf16_t* rp = proj + (size_t)(row0 + ai * 128 + m * 16) * PP + cn;
                float ss = 0.f;
#pragma unroll
                for (int bj = 0; bj < 2; ++bj)
#pragma unroll
                    for (int n = 0; n < 2; ++n) { const f32x4 v = acc[ai][bj][m][n]; ss += (v[0] * v[0] + v[1] * v[1]) + (v[2] * v[2] + v[3] * v[3]); }
                ss += __shfl_xor(ss, 16); ss += __shfl_xor(ss, 32);
                const float rs = sc / sqrtf(ss * (1.f / 64.f) + EPS_);
#pragma unroll
                for (int bj = 0; bj < 2; ++bj) { const f32x4 v0 = acc[ai][bj][m][0] * rs * *(const f32x4*)(g + 32 * bj), v1 = acc[ai][bj][m][1] * rs * *(const f32x4*)(g + 32 * bj + 4);
                    u32x4 w; w.x = pk2(v0[0], v0[1]); w.y = pk2(v0[2], v0[3]); w.z = pk2(v1[0], v1[1]); w.w = pk2(v1[2], v1[3]); *(u32x4*)(rp + 32 * bj) = w; } }
    }
};

DI void kprep(Frame& F, const ArgP& a) {
    const int gw = F.vcu * NWAVES + F.wave, NGW = F.G * NWAVES;
    const bf16_t* kv = (const bf16_t*)(F.ws + WS_KVRAW); unsigned char* kn = (unsigned char*)(F.ws + WS_KN8);
    for (int it = gw; it < NB * MEMLEN * 4; it += NGW) {
        const int row = it >> 2, h = it & 3, b = row >> 8, key = row & 255;
        const u32x4 raw = *(const u32x4*)(kv + (size_t)row * 4096 + h * 512 + F.lane * 8);
        float v[8]; v[0] = bflo(raw.x); v[1] = bfhi(raw.x); v[2] = bflo(raw.y); v[3] = bfhi(raw.y); v[4] = bflo(raw.z); v[5] = bfhi(raw.z); v[6] = bflo(raw.w); v[7] = bfhi(raw.w);
        float ss = 0.f;
#pragma unroll
        for (int j = 0; j < 8; ++j) ss += v[j] * v[j];
        const float rs = 1.f / sqrtf(wave_sum(ss) * (1.f / 512.f) + EPS_) * 0.04419417382415922f * 128.f;
        const float* gk = a.in(I_XKG) + F.lane * 8; const float* gq = a.in(I_XQG) + F.lane * 8;
        u32x2 o; o.x = __builtin_amdgcn_cvt_pk_fp8_f32(v[0] * rs * gk[0] * gq[0], v[1] * rs * gk[1] * gq[1], 0u, false); o.x = __builtin_amdgcn_cvt_pk_fp8_f32(v[2] * rs * gk[2] * gq[2], v[3] * rs * gk[3] * gq[3], o.x, true);
        o.y = __builtin_amdgcn_cvt_pk_fp8_f32(v[4] * rs * gk[4] * gq[4], v[5] * rs * gk[5] * gq[5], 0u, false); o.y = __builtin_amdgcn_cvt_pk_fp8_f32(v[6] * rs * gk[6] * gq[6], v[7] * rs * gk[7] * gq[7], o.y, true);
        *(u32x2*)(kn + ((size_t)((b * 4 + h) * 256 + key)) * 512 + F.lane * 8) = o;
    }
}

constexpr int SP = 272;
constexpr int S_C = 0, S_BM = 34816, S_BT = 69632, S_XDT = 104448, S_HB = 121856, S_F = 139264, S_W = 155648  , SSD_LDS = 162048;
static_assert(SSD_LDS <= MISC_OFF, "SSD LDS map");
#define MFMA32(a, b, c) __builtin_amdgcn_mfma_f32_32x32x16_bf16((a), (b), (c), 0, 0, 0)
DI int crow(int r, int hi) { return (r & 3) + 8 * (r >> 2) + 4 * hi; }
DI bf16x8 ldfrag(LAS const unsigned char* base, int row, int kel) { return *(const LAS bf16x8*)(base + row * SP + kel * 2); }
DI float fexp(float x) { return __builtin_amdgcn_exp2f(x * 1.4426950408889634f); }
DI float fsilu(float x) { return x * __builtin_amdgcn_rcpf(1.f + fexp(-x)); }

DI void ssd_unit(Frame& F, const ArgP& a, int b, int hd) {
    LAS unsigned char* lds = F.lds;
    int tid = F.tid, lane = F.lane, r32 = lane & 31, hh = lane >> 5; const int wid = F.wave;
    LAS float* sdt = (LAS float*)(lds + S_F); LAS float* sac = sdt + 2048;
    const bf16_t* proj = (const bf16_t*)(F.ws + WS_PROJ); const float* dtbuf = (const float*)(F.ws + WS_DT); bf16_t* yg = (bf16_t*)(F.ws + WS_YG);
    const int g = hd >> 3;
    const float aneg = -__expf(a.in(I_ALOG)[hd]), dtb = a.in(I_DTB)[hd], dsk = a.in(I_DSKIP)[hd];
#pragma unroll
    for (int q = 0; q < 2; ++q) { const int c = 2 * wid + q; const size_t t0 = (size_t)b * SEQ_ + c * 128;
        const float x0 = dtbuf[(t0 + 2 * lane) * 16 + hd] + dtb, x1 = dtbuf[(t0 + 2 * lane + 1) * 16 + hd] + dtb;
        const float d0 = x0 > 20.f ? x0 : log1pf(__expf(x0)), d1 = x1 > 20.f ? x1 : log1pf(__expf(x1));
        const float a0 = d0 * aneg, a1 = d1 * aneg;
        float s = a0 + a1;
#pragma unroll
        for (int o = 1; o < 64; o <<= 1) { const float t = __shfl_up(s, o); if (lane >= o) s += t; }
        sdt[c * 128 + 2 * lane] = d0; sdt[c * 128 + 2 * lane + 1] = d1; sac[c * 128 + 2 * lane] = s - a1; sac[c * 128 + 2 * lane + 1] = s; }
    int seg = tid >> 5, cg = tid & 31, l0 = seg * 8;
    int colbc = (cg < 16) ? (1024 + g * 128 + cg * 8) : (1280 + g * 128 + (cg - 16) * 8);
    const int colx = hd * 64 + wid * 8; int lx = 2 * lane;
    LAS float* swt = (LAS float*)(lds + S_W);
    { const float* convw = a.in(I_CONVW); const float* convb = a.in(I_CONVB);
      if (tid < 320) { const int ci = tid;
          const int xc = (ci < 64) ? (hd * 64 + ci) : (ci < 192 ? (1024 + g * 128 + (ci - 64)) : (1280 + g * 128 + (ci - 192)));
#pragma unroll
          for (int k = 0; k < 4; ++k) swt[k * 320 + ci] = convw[k * 1536 + xc];
          swt[4 * 320 + ci] = convb[xc]; } }
    int cibc = 64 + cg * 8; const int cix = wid * 8;
    const char* pub = (const char*)F.ws; const unsigned pxb = (unsigned)(WS_PROJ + ((size_t)b * SEQ_ * PP + PC_XBC) * 2), zoff = (unsigned)(WS_CTL + 524288);
    u32x4 inbc[11], inx[5];
#define SSD_PREFETCH(c_) do { \
        int sd_ = l0; asm volatile("" : "+v"(sd_)); \
        _Pragma("unroll") for (int j = 0; j < 11; ++j) { const int tt = (c_) * 128 + sd_ - 3 + j; inbc[j] = *(const u32x4*)(pub + ((tt >= 0) ? pxb + (unsigned)(tt * PP + colbc) * 2u : zoff)); } } while (0)
    SSD_PREFETCH(0);
    f32x16 hT; for (int i = 0; i < 16; ++i) hT[i] = 0.f;
    const int nb = wid & 3, pb = wid >> 2;
    __syncthreads();
    for (int c = 0; c < 16; ++c) {
        { int t_ = threadIdx.x; asm volatile("" : "+v"(t_)); tid = t_; lane = t_ & 63; r32 = lane & 31; hh = lane >> 5; seg = t_ >> 5; cg = t_ & 31; l0 = seg * 8; lx = 2 * lane;
          colbc = (cg < 16) ? (1024 + g * 128 + cg * 8) : (1280 + g * 128 + (cg - 16) * 8); cibc = 64 + cg * 8; }
        const size_t t0 = (size_t)b * SEQ_ + c * 128;
        const LAS float* cdt = sdt + c * 128; const LAS float* cac = sac + c * 128;
        const float aend = cac[127];
#pragma unroll
        for (int j = 0; j < 5; ++j) { int sd_ = lx; asm volatile("" : "+v"(sd_)); const int tt = c * 128 + sd_ - 3 + j; inx[j] = *(const u32x4*)(pub + ((tt >= 0) ? pxb + (unsigned)(tt * PP + colx) * 2u : zoff)); }
        {
            LAS unsigned char* hbp = lds + S_HB + (32 * pb + r32) * SP + (32 * nb + 4 * hh) * 2;
#pragma unroll
            for (int q4 = 0; q4 < 4; ++q4) { u32x2 w; w.x = pk2(hT[4 * q4], hT[4 * q4 + 1]); w.y = pk2(hT[4 * q4 + 2], hT[4 * q4 + 3]); *(LAS u32x2*)(hbp + 16 * q4) = w; }
        }
        {
            float wbc[5][8];
#pragma unroll
            for (int k = 0; k < 5; ++k) { const f32x4 w0 = *(const LAS f32x4*)(swt + k * 320 + cibc), w1 = *(const LAS f32x4*)(swt + k * 320 + cibc + 4);
#pragma unroll
                for (int i = 0; i < 4; ++i) { wbc[k][i] = w0[i]; wbc[k][4 + i] = w1[i]; } }
#pragma unroll
            for (int hf = 0; hf < 2; ++hf) {
                __builtin_amdgcn_sched_barrier(0);
                float o[4][8];
#pragma unroll
                for (int j = 0; j < 4; ++j)
#pragma unroll
                    for (int i = 0; i < 8; ++i) { float s = wbc[4][i];
#pragma unroll
                        for (int k = 0; k < 4; ++k) { const unsigned wd = inbc[4 * hf + j + k][i >> 1]; s += wbc[k][i] * ((i & 1) ? bfhi(wd) : bflo(wd)); }
                        o[j][i] = fsilu(s); }
                const int lh = l0 + 4 * hf;
                if (cg < 16) {
                    const int n0 = cg * 8; float ev[4];
#pragma unroll
                    for (int j = 0; j < 4; ++j) { ev[j] = fexp(aend - cac[lh + j]);
                        u32x4 w1; w1.x = pk2(o[j][0], o[j][1]); w1.y = pk2(o[j][2], o[j][3]); w1.z = pk2(o[j][4], o[j][5]); w1.w = pk2(o[j][6], o[j][7]);
                        *(LAS u32x4*)(lds + S_BM + (lh + j) * SP + n0 * 2) = w1; }
#pragma unroll
                    for (int i = 0; i < 8; ++i) { u32x2 w2; w2.x = pk2(o[0][i] * ev[0], o[1][i] * ev[1]); w2.y = pk2(o[2][i] * ev[2], o[3][i] * ev[3]);
                        *(LAS u32x2*)(lds + S_BT + (n0 + i) * SP + lh * 2) = w2; }
                } else {
                    const int n0 = (cg - 16) * 8;
#pragma unroll
                    for (int j = 0; j < 4; ++j) { u32x4 w1; w1.x = pk2(o[j][0], o[j][1]); w1.y = pk2(o[j][2], o[j][3]); w1.z = pk2(o[j][4], o[j][5]); w1.w = pk2(o[j][6], o[j][7]);
                        *(LAS u32x4*)(lds + S_C + (lh + j) * SP + n0 * 2) = w1; }
                }
            }
        }
        __builtin_amdgcn_sched_barrier(0);
        {
            const float d0 = cdt[lx], d1 = cdt[lx + 1];
            float wx[5][8];
#pragma unroll
            for (int k = 0; k < 5; ++k) { const f32x4 w0 = *(const LAS f32x4*)(swt + k * 320 + cix), w1 = *(const LAS f32x4*)(swt + k * 320 + cix + 4);
#pragma unroll
                for (int i = 0; i < 4; ++i) { wx[k][i] = w0[i]; wx[k][4 + i] = w1[i]; } }
#pragma unroll
            for (int i = 0; i < 8; ++i) { float s0 = wx[4][i], s1 = wx[4][i];
#pragma unroll
                for (int k = 0; k < 4; ++k) { const unsigned w0 = inx[k][i >> 1], w1 = inx[k + 1][i >> 1];
                    s0 += wx[k][i] * ((i & 1) ? bfhi(w0) : bflo(w0)); s1 += wx[k][i] * ((i & 1) ? bfhi(w1) : bflo(w1)); }
                *(LAS unsigned*)(lds + S_XDT + (wid * 8 + i) * SP + lx * 2) = pk2(fsilu(s0) * d0, fsilu(s1) * d1); }
        }
        if (c < 15) SSD_PREFETCH(c + 1);
        __syncthreads();
        const int lb = wid >> 1;
        f32x16 xt[2];
        {
            bf16x8 cf[8];
#pragma unroll
            for (int ks = 0; ks < 8; ++ks) cf[ks] = ldfrag(lds + S_C, 32 * lb + r32, 16 * ks + 8 * hh);
#pragma unroll
            for (int q = 0; q < 2; ++q) { const int sb = 2 * (wid & 1) + q;
                for (int i = 0; i < 16; ++i) xt[q][i] = 0.f;
                if (sb <= lb) {
                    bf16x8 bfr[8];
#pragma unroll
                    for (int ks = 0; ks < 8; ++ks) bfr[ks] = ldfrag(lds + S_BM, 32 * sb + r32, 16 * ks + 8 * hh);
                    __builtin_amdgcn_sched_barrier(0);
#pragma unroll
                    for (int ks = 0; ks < 8; ++ks) xt[q] = MFMA32(bfr[ks], cf[ks], xt[q]);
                }
            }
        }
        __syncthreads();
        {
            const int l = 32 * lb + r32; const float al = cac[l], ddl = dsk * __builtin_amdgcn_rcpf(cdt[l]);
            f32x4 cs[2][4];
#pragma unroll
            for (int q = 0; q < 2; ++q)
#pragma unroll
                for (int q4 = 0; q4 < 4; ++q4) cs[q][q4] = *(const LAS f32x4*)(cac + 32 * (2 * (wid & 1) + q) + 8 * q4 + 4 * hh);
#pragma unroll
            for (int q = 0; q < 2; ++q) { const int sb = 2 * (wid & 1) + q;
#pragma unroll
                for (int q4 = 0; q4 < 4; ++q4) { float mv[4];
#pragma unroll
                    for (int e = 0; e < 4; ++e) { const int s = 32 * sb + 8 * q4 + 4 * hh + e;
                        const float ev = fexp(fminf(al - cs[q][q4][e], 0.f));
                        float v = (s <= l) ? xt[q][4 * q4 + e] * ev : 0.f;
                        v += (s == l) ? ddl : 0.f;
                        mv[e] = v; }
                    u32x2 w; w.x = pk2(mv[0], mv[1]); w.y = pk2(mv[2], mv[3]);
                    *(LAS u32x2*)(lds + S_BM + l * SP + (32 * sb + 8 * q4 + 4 * hh) * 2) = w; }
            }
        }
        __syncthreads();
        {
            const int lb2 = wid & 3, pb2 = wid >> 2; const int l = 32 * lb2 + r32; const size_t tok = t0 + l;
            const int pc0 = hd * 64 + 32 * pb2 + 4 * hh;
            u32x2 zz[4];
#pragma unroll
            for (int q4 = 0; q4 < 4; ++q4) zz[q4] = *(const u32x2*)(proj + tok * PP + pc0 + 8 * q4);
            f32x16 y1, y2; for (int i = 0; i < 16; ++i) { y1[i] = 0.f; y2[i] = 0.f; }
            bf16x8 fa[8], fb[8];
#pragma unroll
            for (int ks = 0; ks < 8; ++ks) { fa[ks] = ldfrag(lds + S_XDT, 32 * pb2 + r32, 16 * ks + 8 * hh); fb[ks] = ldfrag(lds + S_BM, 32 * lb2 + r32, 16 * ks + 8 * hh); }
            __builtin_amdgcn_sched_barrier(0);
#pragma unroll
            for (int ks = 0; ks < 8; ++ks) { if (ks < 2 * (lb2 + 1)) y1 = MFMA32(fa[ks], fb[ks], y1); }
            const float cd = fexp(aend);
#pragma unroll
            for (int i = 0; i < 16; ++i) hT[i] *= cd;
#pragma unroll
            for (int ks = 0; ks < 8; ++ks) fb[ks] = ldfrag(lds + S_BT, 32 * nb + r32, 16 * ks + 8 * hh);
            __builtin_amdgcn_sched_barrier(0);
#pragma unroll
            for (int ks = 0; ks < 8; ++ks) hT = MFMA32(fb[ks], fa[ks], hT);
#pragma unroll
            for (int ks = 0; ks < 8; ++ks) { fa[ks] = ldfrag(lds + S_HB, 32 * pb2 + r32, 16 * ks + 8 * hh); fb[ks] = ldfrag(lds + S_C, 32 * lb2 + r32, 16 * ks + 8 * hh); }
            __builtin_amdgcn_sched_barrier(0);
#pragma unroll
            for (int ks = 0; ks < 8; ++ks) y2 = MFMA32(fa[ks], fb[ks], y2);
            const float el = fexp(cac[l]);
#pragma unroll
            for (int q4 = 0; q4 < 4; ++q4) { float yv[4];
#pragma unroll
                for (int e = 0; e < 4; ++e) { const float z = (e & 1) ? bfhi(e < 2 ? zz[q4].x : zz[q4].y) : bflo(e < 2 ? zz[q4].x : zz[q4].y);
                    yv[e] = (y1[4 * q4 + e] + el * y2[4 * q4 + e]) * fsilu(z); }
                u32x2 w; w.x = pk2(yv[0], yv[1]); w.y = pk2(yv[2], yv[3]);
                *(u32x2*)(yg + tok * 1024 + pc0 + 8 * q4) = w; }
        }
        __syncthreads();
    }
#undef SSD_PREFETCH
}

DI void attn_phase_da(Frame& F) {
    const attn_body::bf16* proj = (const attn_body::bf16*)(F.ws + WS_PROJ);
    if (threadIdx.x == 0) F.MISC[120] = __hip_atomic_fetch_add(F.ctl + CW_QATT, 1u, __ATOMIC_RELAXED, __HIP_MEMORY_SCOPE_AGENT);
    __syncthreads();
    int u = __builtin_amdgcn_readfirstlane((int)F.MISC[120]);
    while (u < 1024) {
        unsigned pend = 0u;
        const int qb = 7 - (u >> 7), combo = u & 127;
        const int half = combo & 1, j = (combo >> 1) & 1, h = (combo >> 2) & 7, b = combo >> 5;
        attn_body::bf16* O = (attn_body::bf16*)(F.ws + (j ? WS_O1 : WS_O0));
        attn_body::attn_unit<8>(b, PC_Q + (h * 2 + j) * 64, PC_V + h * 128 + half * 64, h * 128 + half * 64, qb, proj, proj + (PC_K - PC_Q), proj, O, (char*)F.lds, F.ctl + CW_QATT, pend);
        if (threadIdx.x == 0) F.MISC[120] = pend;
        __syncthreads();
        u = __builtin_amdgcn_readfirstlane((int)F.MISC[120]);
    }
}

DI void p3_finalize(Frame& F, const ArgP& a) {
    const int gw = F.vcu * NWAVES + F.wave, NGW = F.G * NWAVES, lane = F.lane;
    bf16_t* ycat = (bf16_t*)(F.ws + WS_YCAT); const bf16_t* yg = (const bf16_t*)(F.ws + WS_YG); const bf16_t* o0 = (const bf16_t*)(F.ws + WS_O0); const bf16_t* o1 = (const bf16_t*)(F.ws + WS_O1);
    float l1 = a.in(I_LQ1)[lane] * a.in(I_LK1)[lane], l2 = a.in(I_LQ2)[lane] * a.in(I_LK2)[lane];
    const float lam = __expf(wave_sum(l1)) - __expf(wave_sum(l2)) + LAM_INIT;
    for (int m = gw; m < NTOK; m += NGW) {
        { bf16_t* yp = ycat + (size_t)m * 2048 + 16 * lane; const bf16_t* gp = yg + (size_t)m * 1024 + 16 * lane;
          const u32x4 r0 = *(const u32x4*)gp, r1 = *(const u32x4*)(gp + 8);
          float v[16]; v[0] = bflo(r0.x); v[1] = bfhi(r0.x); v[2] = bflo(r0.y); v[3] = bfhi(r0.y); v[4] = bflo(r0.z); v[5] = bfhi(r0.z); v[6] = bflo(r0.w); v[7] = bfhi(r0.w);
          v[8] = bflo(r1.x); v[9] = bfhi(r1.x); v[10] = bflo(r1.y); v[11] = bfhi(r1.y); v[12] = bflo(r1.z); v[13] = bfhi(r1.z); v[14] = bflo(r1.w); v[15] = bfhi(r1.w);
          float ss = 0.f;
#pragma unroll
          for (int i = 0; i < 16; ++i) ss += v[i] * v[i];
#pragma unroll
          for (int o = 1; o < 32; o <<= 1) ss += __shfl_xor(ss, o);
          const float rs = 1.f / sqrtf(ss * (1.f / 512.f) + EPS_);
          const float* g = a.in(I_SSDG) + 16 * lane;
          u32x4 w0, w1;
          w0.x = pk2(v[0] * rs * g[0], v[1] * rs * g[1]); w0.y = pk2(v[2] * rs * g[2], v[3] * rs * g[3]); w0.z = pk2(v[4] * rs * g[4], v[5] * rs * g[5]); w0.w = pk2(v[6] * rs * g[6], v[7] * rs * g[7]);
          w1.x = pk2(v[8] * rs * g[8], v[9] * rs * g[9]); w1.y = pk2(v[10] * rs * g[10], v[11] * rs * g[11]); w1.z = pk2(v[12] * rs * g[12], v[13] * rs * g[13]); w1.w = pk2(v[14] * rs * g[14], v[15] * rs * g[15]);
          *(u32x4*)yp = w0; *(u32x4*)(yp + 8) = w1; }
        { const bf16_t* p0 = o0 + (size_t)m * 1024 + 16 * lane; const bf16_t* p1 = o1 + (size_t)m * 1024 + 16 * lane;
          const u32x4 a0 = *(const u32x4*)p0, a1 = *(const u32x4*)(p0 + 8), b0 = *(const u32x4*)p1, b1 = *(const u32x4*)(p1 + 8);
          float v[16];
          v[0] = bflo(a0.x) - lam * bflo(b0.x); v[1] = bfhi(a0.x) - lam * bfhi(b0.x); v[2] = bflo(a0.y) - lam * bflo(b0.y); v[3] = bfhi(a0.y) - lam * bfhi(b0.y);
          v[4] = bflo(a0.z) - lam * bflo(b0.z); v[5] = bfhi(a0.z) - lam * bfhi(b0.z); v[6] = bflo(a0.w) - lam * bflo(b0.w); v[7] = bfhi(a0.w) - lam * bfhi(b0.w);
          v[8] = bflo(a1.x) - lam * bflo(b1.x); v[9] = bfhi(a1.x) - lam * bfhi(b1.x); v[10] = bflo(a1.y) - lam * bflo(b1.y); v[11] = bfhi(a1.y) - lam * bfhi(b1.y);
          v[12] = bflo(a1.z) - lam * bflo(b1.z); v[13] = bfhi(a1.z) - lam * bfhi(b1.z); v[14] = bflo(a1.w) - lam * bflo(b1.w); v[15] = bfhi(a1.w) - lam * bfhi(b1.w);
          float ss = 0.f;
#pragma unroll
          for (int i = 0; i < 16; ++i) ss += v[i] * v[i];
          ss += __shfl_xor(ss, 1); ss += __shfl_xor(ss, 2); ss += __shfl_xor(ss, 4);
          const float rs = 1.f / sqrtf(ss * (1.f / 128.f) + EPS_) * (1.f - LAM_INIT);
          const float* g = a.in(I_SUBG) + 16 * (lane & 7);
          u32x4 w0, w1;
          w0.x = pk2(v[0] * rs * g[0], v[1] * rs * g[1]); w0.y = pk2(v[2] * rs * g[2], v[3] * rs * g[3]); w0.z = pk2(v[4] * rs * g[4], v[5] * rs * g[5]); w0.w = pk2(v[6] * rs * g[6], v[7] * rs * g[7]);
          w1.x = pk2(v[8] * rs * g[8], v[9] * rs * g[9]); w1.y = pk2(v[10] * rs * g[10], v[11] * rs * g[11]); w1.z = pk2(v[12] * rs * g[12], v[13] * rs * g[13]); w1.w = pk2(v[14] * rs * g[14], v[15] * rs * g[15]);
          bf16_t* yp = ycat + (size_t)m * 2048 + 1024 + 16 * lane;
          *(u32x4*)yp = w0; *(u32x4*)(yp + 8) = w1; }
    }
}

struct SchedDense {
    int G, c, nM, nN; const char* A; const char* B; unsigned lda, ldb; int bdiv; size_t bstride;
    DI bool next(int i, pg8::UnitD& u) const {
        const int L = i * G + c; if (L >= nM * nN) return false;
        u.rows = nullptr; u.nvalid = 0; u.lda = lda; u.ldb = ldb; u.type = 0; u.e = 0; u.x0 = 0;
        if (G == 256 && nM == 32 && nN == 8) { const int x = L >> 5, s = L & 31; u.pm = (x & 3) * 8 + (s & 7); u.pn = (x >> 2) * 4 + (s >> 3); }
        else { u.pn = L / nM; u.pm = L % nM; }
        u.A = A + (size_t)u.pm * 256 * lda; u.B = B + (size_t)u.pn * 256 * ldb + (size_t)(u.pm / bdiv) * bstride;
        return true;
    }
};
template <bool BASE_BF16>
struct EpiResid {
    static constexpr bool AFTER_DRAIN = false;
    const void* base; bf16_t* out; float* part; unsigned char* out8; float accscale;
    DI void operator()(const f32x4 (&acc)[2][2][4][2], const pg8::UnitD& u, int wr, int wc, int fr, int fq) const {
        { int ln_ = threadIdx.x; asm volatile("" : "+v"(ln_)); fr = ln_ & 15; fq = (ln_ >> 4) & 3; }
        const int row0 = u.pm * 256 + wr * 64 + fr, col0 = u.pn * 256 + wc * 32 + 8 * fq;
#pragma unroll
        for (int ai = 0; ai < 2; ++ai) {
            u32x4 rb[4][2]; f32x4 rf[4][2][2];
#pragma unroll
            for (int m = 0; m < 4; ++m)
#pragma unroll
                for (int bj = 0; bj < 2; ++bj) { const size_t idx = (size_t)(row0 + ai * 128 + m * 16) * 2048 + col0 + bj * 128;
                    if constexpr (BASE_BF16) rb[m][bj] = *(const u32x4*)((const bf16_t*)base + idx);
                    else { rf[m][bj][0] = *(const f32x4*)((const float*)base + idx); rf[m][bj][1] = *(const f32x4*)((const float*)base + idx + 4); } }
#pragma unroll
            for (int m = 0; m < 4; ++m) { const size_t row = (size_t)(row0 + ai * 128 + m * 16); float ss = 0.f;
#pragma unroll
                for (int bj = 0; bj < 2; ++bj) { const size_t idx = row * 2048 + col0 + bj * 128;
                    f32x4 b0, b1;
                    if constexpr (BASE_BF16) { const u32x4 r = rb[m][bj]; b0 = (f32x4){bflo(r.x), bfhi(r.x), bflo(r.y), bfhi(r.y)}; b1 = (f32x4){bflo(r.z), bfhi(r.z), bflo(r.w), bfhi(r.w)}; }
                    else { b0 = rf[m][bj][0]; b1 = rf[m][bj][1]; }
                    const f32x4 v0 = acc[ai][bj][m][0] * accscale + b0, v1 = acc[ai][bj][m][1] * accscale + b1;
                    { u32x4 w; w.x = pk2(v0[0], v0[1]); w.y = pk2(v0[2], v0[3]); w.z = pk2(v1[0], v1[1]); w.w = pk2(v1[2], v1[3]); *(u32x4*)(out + idx) = w; }
                    if (out8) { u32x2 w; w.x = __builtin_amdgcn_cvt_pk_fp8_f32(v0[0] * 16.f, v0[1] * 16.f, 0u, false); w.x = __builtin_amdgcn_cvt_pk_fp8_f32(v0[2] * 16.f, v0[3] * 16.f, w.x, true);
                        w.y = __builtin_amdgcn_cvt_pk_fp8_f32(v1[0] * 16.f, v1[1] * 16.f, 0u, false); w.y = __builtin_amdgcn_cvt_pk_fp8_f32(v1[2] * 16.f, v1[3] * 16.f, w.y, true); *(u32x2*)(out8 + idx) = w; }
                    ss += (v0[0] * v0[0] + v0[1] * v0[1]) + (v0[2] * v0[2] + v0[3] * v0[3]) + (v1[0] * v1[0] + v1[1] * v1[1]) + (v1[2] * v1[2] + v1[3] * v1[3]); }
                if (part) { ss += __shfl_xor(ss, 16); ss += __shfl_xor(ss, 32); if (fq == 0) part[row * 32 + u.pn * 4 + wc] = ss; } }
        }
    }
};

struct EpiQ {
    static constexpr bool AFTER_DRAIN = false;
    unsigned char* out8; float* part;
    DI void operator()(const f32x4 (&acc)[2][2][4][2], const pg8::UnitD& u, int wr, int wc, int fr, int fq) const {
        { int ln_ = threadIdx.x; asm volatile("" : "+v"(ln_)); fr = ln_ & 15; fq = (ln_ >> 4) & 3; }
        const int row0 = u.pm * 256 + wr * 64 + fr, col0 = u.pn * 256 + wc * 32 + 8 * fq;
#pragma unroll
        for (int ai = 0; ai < 2; ++ai)
#pragma unroll
            for (int m = 0; m < 4; ++m) { const size_t row = (size_t)(row0 + ai * 128 + m * 16); float ss = 0.f;
#pragma unroll
                for (int bj = 0; bj < 2; ++bj) { const size_t idx = row * 2048 + col0 + bj * 128; const f32x4 v0 = acc[ai][bj][m][0] * (1.f / 1024.f), v1 = acc[ai][bj][m][1] * (1.f / 1024.f);
                    u32x2 w; w.x = __builtin_amdgcn_cvt_pk_fp8_f32(v0[0] * 16.f, v0[1] * 16.f, 0u, false); w.x = __builtin_amdgcn_cvt_pk_fp8_f32(v0[2] * 16.f, v0[3] * 16.f, w.x, true);
                    w.y = __builtin_amdgcn_cvt_pk_fp8_f32(v1[0] * 16.f, v1[1] * 16.f, 0u, false); w.y = __builtin_amdgcn_cvt_pk_fp8_f32(v1[2] * 16.f, v1[3] * 16.f, w.y, true); *(u32x2*)(out8 + idx) = w;
                    ss += (v0[0] * v0[0] + v0[1] * v0[1]) + (v0[2] * v0[2] + v0[3] * v0[3]) + (v1[0] * v1[0] + v1[1] * v1[1]) + (v1[2] * v1[2] + v1[3] * v1[3]); }
                ss += __shfl_xor(ss, 16); ss += __shfl_xor(ss, 32); if (fq == 0) part[row * 32 + u.pn * 4 + wc] = ss; }
    }
};

struct SchedXS {
    int G, c; const unsigned char* ws;
    DI bool next(int i, pg8::UnitD& u) const {
        const int L = i * G + c; if (L >= 256) return false;
        u.rows = nullptr; u.nvalid = 0; u.e = 0;
        const int q = L & 127, bh = q >> 3, t8 = q & 7, b = bh >> 2, h = bh & 3;
        u.pm = b; u.pn = h; u.x0 = t8;
        if (L < 128) { u.type = 0; u.lda = 2048u; u.ldb = 512u;
            u.A = (const char*)(ws + WS_QF8) + (size_t)(b * 2048 + t8 * 256) * 2048 + h * 512; u.B = (const char*)(ws + WS_KN8) + (size_t)(bh * 256) * 512; }
        else { u.type = 1; u.lda = 2048u; u.ldb = 2048u;
            u.A = (const char*)(ws + WS_WO) + (size_t)(t8 * 256) * 2048 + h * 512; u.B = (const char*)(ws + WS_VF8) + (size_t)(b * 256) * 2048 + h * 512; }
        return true;
    }
};
struct EpiXS {
    static constexpr bool AFTER_DRAIN = false;
    unsigned char* P; unsigned char* VWT; const float* part1; const float* partq; LAS float* red;
    DI void operator()(const f32x4 (&acc)[2][2][4][2], const pg8::UnitD& u, int wr, int wc, int fr, int fq) const {
        { int ln_ = threadIdx.x; asm volatile("" : "+v"(ln_)); fr = ln_ & 15; fq = (ln_ >> 4) & 3; }
        const int b = u.pm, h = u.pn, t8 = u.x0;
        const int col0 = wc * 32 + 8 * fq;
        if (u.type == 1) {
            unsigned char* Vu = VWT + ((size_t)b * 2048 + t8 * 256) * 1024 + h * 256;
#pragma unroll
            for (int ai = 0; ai < 2; ++ai)
#pragma unroll
                for (int m = 0; m < 4; ++m) { const unsigned rl = (unsigned)(ai * 128 + wr * 64 + m * 16 + fr);
#pragma unroll
                    for (int bj = 0; bj < 2; ++bj) { const f32x4 v0 = acc[ai][bj][m][0] * (32.f / 1024.f), v1 = acc[ai][bj][m][1] * (32.f / 1024.f);
                        u32x2 w; w.x = __builtin_amdgcn_cvt_pk_fp8_f32(v0[0], v0[1], 0u, false); w.x = __builtin_amdgcn_cvt_pk_fp8_f32(v0[2], v0[3], w.x, true);
                        w.y = __builtin_amdgcn_cvt_pk_fp8_f32(v1[0], v1[1], 0u, false); w.y = __builtin_amdgcn_cvt_pk_fp8_f32(v1[2], v1[3], w.y, true);
                        *(u32x2*)(Vu + (rl * 1024u + (unsigned)(bj * 128 + col0))) = w; } }
            return;
        }
        const size_t row0 = (size_t)b * 2048 + t8 * 256;
        const char* p1u = (const char*)(part1 + row0 * 32); const char* pqu = (const char*)(partq + row0 * 32 + h * 8); unsigned char* Pu = P + row0 * 1024 + h * 256;
        float rsc[2][4];
#pragma unroll
        for (int ai = 0; ai < 2; ++ai)
#pragma unroll
            for (int m = 0; m < 4; ++m) { const unsigned rl = (unsigned)(ai * 128 + wr * 64 + m * 16 + fr);
                const f32x4 p0 = *(const f32x4*)(p1u + (rl * 32u + (unsigned)fq * 8u) * 4u), p1 = *(const f32x4*)(p1u + (rl * 32u + (unsigned)fq * 8u + 4u) * 4u);
                float s1 = (p0[0] + p0[1]) + (p0[2] + p0[3]) + (p1[0] + p1[1]) + (p1[2] + p1[3]);
                const f32x2 pq = *(const f32x2*)(pqu + (rl * 32u + (unsigned)fq * 2u) * 4u);
                float sq = pq[0] + pq[1];
                s1 = quad_sum_16_32(s1); sq = quad_sum_16_32(sq);
                rsc[ai][m] = __builtin_amdgcn_rsqf(sq * (1.f / 512.f) + EPS_ * (s1 * (1.f / 2048.f) + EPS_)) * (1.4426950408889634f / 2048.f);
                float ps = 0.f;
#pragma unroll
                for (int bj = 0; bj < 2; ++bj)
#pragma unroll
                    for (int n = 0; n < 2; ++n)
#pragma unroll
                        for (int e = 0; e < 4; ++e) ps += __builtin_amdgcn_exp2f(fminf(acc[ai][bj][m][n][e] * rsc[ai][m], 100.f));
                ps = quad_sum_16_32(ps);
                if (fq == 0) red[rl * 4 + wc] = ps;
                __builtin_amdgcn_sched_barrier(0); }
        __syncthreads();
        { int ln_ = threadIdx.x; asm volatile("" : "+v"(ln_)); fr = ln_ & 15; fq = (ln_ >> 4) & 3; }
#pragma unroll
        for (int ai = 0; ai < 2; ++ai)
#pragma unroll
            for (int m = 0; m < 4; ++m) { const unsigned rl = (unsigned)(ai * 128 + wr * 64 + m * 16 + fr);
                const f32x4 t = *(const LAS f32x4*)(red + rl * 4); const float inv = 256.f * __builtin_amdgcn_rcpf((t[0] + t[1]) + (t[2] + t[3])); float rs = rsc[ai][m]; asm volatile("" : "+v"(rs));
#pragma unroll
                for (int bj = 0; bj < 2; ++bj) { float x[8];
#pragma unroll
                    for (int n = 0; n < 2; ++n)
#pragma unroll
                        for (int e = 0; e < 4; ++e) x[n * 4 + e] = __builtin_amdgcn_exp2f(fminf(acc[ai][bj][m][n][e] * rs, 100.f)) * inv;
                    u32x2 w; w.x = __builtin_amdgcn_cvt_pk_fp8_f32(x[0], x[1], 0u, false); w.x = __builtin_amdgcn_cvt_pk_fp8_f32(x[2], x[3], w.x, true);
                    w.y = __builtin_amdgcn_cvt_pk_fp8_f32(x[4], x[5], 0u, false); w.y = __builtin_amdgcn_cvt_pk_fp8_f32(x[6], x[7], w.y, true);
                    *(u32x2*)(Pu + (rl * 1024u + (unsigned)(bj * 128 + wc * 32 + 8 * fq))) = w; } }
        __syncthreads();
    }
};

constexpr int HNP = 2052;
DI void p8_route(Frame& F, const ArgP& a) {
    LAS float* s_hn = (LAS float*)F.lds; LAS float* s_part = (LAS float*)(F.lds + 16 * HNP * 4); LAS float* s_log = s_part + 8 * 16 * 32; LAS int* s_slot = (LAS int*)(s_log + 16 * 32);
    LAS int* s_cnt = s_slot + 64; LAS int* s_base = s_cnt + 32;
    const bf16_t* h2 = (const bf16_t*)(F.ws + WS_H2); unsigned char* xg = (unsigned char*)(F.ws + WS_XG);
    float* gate_of = (float*)(F.ws + WS_GATEOF); int* tok_e = (int*)(F.ws + WS_TOKE);
    const float* rw = a.in(I_RW); const float* rb = a.in(I_RB); const float* g3 = a.in(I_GFFN);
    const int lane = F.lane, wave = F.wave, tid = F.tid;
    float bw0[64], bw1[64];
    { const int kq = lane >> 4, c16 = lane & 15; const float* bp = rw + (size_t)(256 * wave + kq) * 32 + c16;
#pragma unroll
      for (int j = 0; j < 64; ++j) { bw0[j] = bp[(size_t)(4 * j) * 32]; bw1[j] = bp[(size_t)(4 * j) * 32 + 16]; } }
    for (int task = F.vcu; task < NTOK / 16; task += F.G) {
        const int tb = task * 16;
#pragma unroll
        for (int q = 0; q < 2; ++q) { const int tl = 2 * wave + q; const size_t tok = (size_t)(tb + tl);
            const u32x2* xr = (const u32x2*)(h2 + tok * 2048) + lane;
            f32x4 v[8]; float s = 0.f;
#pragma unroll
            for (int j = 0; j < 8; ++j) { const u32x2 rw_ = xr[64 * j]; v[j] = (f32x4){bflo(rw_.x), bfhi(rw_.x), bflo(rw_.y), bfhi(rw_.y)}; s += (v[j].x * v[j].x + v[j].y * v[j].y) + (v[j].z * v[j].z + v[j].w * v[j].w); }
            const float rstd = 1.f / sqrtf(wave_sum(s) * (1.f / 2048.f) + EPS_);
#pragma unroll
            for (int j = 0; j < 8; ++j) { const f32x4 gg = ((const f32x4*)g3)[lane + 64 * j]; const f32x4 y = v[j] * rstd * gg;
                *(LAS f32x4*)(s_hn + tl * HNP + (lane + 64 * j) * 4) = y; } }
        __syncthreads();
        {
            f32x4 acc0 = {0.f, 0.f, 0.f, 0.f}, acc1 = {0.f, 0.f, 0.f, 0.f};
            const int kq = lane >> 4, c16 = lane & 15;
            const LAS float* ap = s_hn + c16 * HNP + 256 * wave;
#pragma unroll
            for (int j = 0; j < 64; ++j) { const f32x4 a4 = *(const LAS f32x4*)(ap + 4 * j);
                const float av = (kq == 0) ? a4.x : (kq == 1) ? a4.y : (kq == 2) ? a4.z : a4.w;
                acc0 = __builtin_amdgcn_mfma_f32_16x16x4f32(av, bw0[j], acc0, 0, 0, 0);
                acc1 = __builtin_amdgcn_mfma_f32_16x16x4f32(av, bw1[j], acc1, 0, 0, 0); }
            LAS float* pp = s_part + wave * 512 + c16;
#pragma unroll
            for (int r = 0; r < 4; ++r) { pp[(4 * kq + r) * 32] = acc0[r]; pp[(4 * kq + r) * 32 + 16] = acc1[r]; }
        }
        __syncthreads();
        {
            const int tt = tid >> 5, e = tid & 31; float lg = rb[e];
#pragma unroll
            for (int w = 0; w < 8; ++w) lg += s_part[w * 512 + tt * 32 + e];
            if (tid < 32) s_cnt[tid] = 0;
            float val[4]; int idx[4]; float cur = lg;
#pragma unroll
            for (int k = 0; k < 4; ++k) { float bv = cur; int bi = e;
#pragma unroll
                for (int o = 1; o < 32; o <<= 1) { const float ov = __shfl_xor(bv, o); const int oi = __shfl_xor(bi, o); if (ov > bv || (ov == bv && oi < bi)) { bv = ov; bi = oi; } }
                val[k] = bv; idx[k] = bi; if (e == bi) cur = -INFINITY; }
            __syncthreads();
            int myrank = 0, myexp = 0; float mygate = 0.f;
            if (e < 4) { const float sum = (__expf(val[0] - val[0]) + __expf(val[1] - val[0])) + (__expf(val[2] - val[0]) + __expf(val[3] - val[0]));
                const float mv = (e == 0) ? val[0] : (e == 1) ? val[1] : (e == 2) ? val[2] : val[3]; myexp = (e == 0) ? idx[0] : (e == 1) ? idx[1] : (e == 2) ? idx[2] : idx[3];
                mygate = __expf(mv - val[0]) / sum; myrank = __hip_atomic_fetch_add(&s_cnt[myexp], 1, __ATOMIC_RELAXED, __HIP_MEMORY_SCOPE_WORKGROUP); }
            __syncthreads();
            if (tid < 32) { const int c = s_cnt[tid]; s_base[tid] = c ? (int)__hip_atomic_fetch_add(F.ctl + CW_CNT + 64 * tid, (unsigned)c, __ATOMIC_RELAXED, __HIP_MEMORY_SCOPE_AGENT) : 0; }
            __syncthreads();
            if (e < 4) { const int slot = myexp * 8192 + s_base[myexp] + myrank; const int tok = tb + tt;
                gate_of[slot] = mygate; tok_e[tok * 4 + e] = slot; s_slot[tt * 4 + e] = slot; }
        }
        __syncthreads();
#pragma unroll
        for (int q = 0; q < 2; ++q) { const int tl = 2 * wave + q;
            unsigned o[8];
#pragma unroll
            for (int j = 0; j < 8; ++j) { const f32x4 y = *(const LAS f32x4*)(s_hn + tl * HNP + (lane + 64 * j) * 4);
                unsigned w = 0u; w = __builtin_amdgcn_cvt_pk_fp8_f32(y.x * 4.f, y.y * 4.f, w, false); w = __builtin_amdgcn_cvt_pk_fp8_f32(y.z * 4.f, y.w * 4.f, w, true); o[j] = w; }
#pragma unroll
            for (int k = 0; k < 4; ++k) { unsigned* o4 = (unsigned*)(xg + (size_t)s_slot[tl * 4 + k] * 2048) + lane;
#pragma unroll
                for (int j = 0; j < 8; ++j) o4[64 * j] = o[j]; } }
        __syncthreads();
    }
}

DI void moe_tables(Frame& F) {
    if (F.tid < 64) { const int e = F.tid & 31;
        const unsigned c = F.ctl[CW_CNT + 64 * e], mt = (c + 255u) >> 8;
        unsigned incl = mt;
#pragma unroll
        for (int o = 1; o < 32; o <<= 1) { const unsigned v = __shfl_up(incl, o, 64); if (e >= o) incl += v; }
        const unsigned base = incl - mt;
        if (F.tid < 32) { F.MISC[16 + e] = c; F.MISC[48 + e] = base; F.MISC[80 + e] = mt; if (e == 31) F.MISC[112] = incl;
            volatile LAS unsigned char* tab = (volatile LAS unsigned char*)(F.MISC + 128);
            for (unsigned t = 0; t < mt; ++t) tab[base + t] = (unsigned char)e; } }
    __syncthreads();
}
DI int ldsu(volatile LAS unsigned* p) { return __builtin_amdgcn_readfirstlane((int)*p); }
template <int NTN  >
struct SchedMoe {
    int G, c; const unsigned char* ws; volatile LAS unsigned* MISC; int total;
    DI bool next(int i, pg8::UnitD& u) const {
        const int L = i * G + c; if (L >= total) return false;
        const int e = __builtin_amdgcn_readfirstlane((int)((volatile LAS unsigned char*)(MISC + 128))[L / NTN]);
        const int tb = ldsu(MISC + 48 + e), mte = ldsu(MISC + 80 + e), cnt = ldsu(MISC + 16 + e);
        const int local = L - tb * NTN, nt = local / mte, mt = local % mte;
        u.type = 0; u.e = e; u.pn = nt; u.pm = tb + mt; u.x0 = mt; u.lda = 2048u; u.ldb = 128u;
        u.rows = nullptr; u.nvalid = cnt - mt * 256;
        if (NTN == 16) { u.A = (const char*)(ws + WS_XG) + ((size_t)e * 8192 + (size_t)mt * 256) * 2048;
            u.B = (const char*)(ws + WS_W1) + ((size_t)e * 4096 + (size_t)nt * 256) * 2048; }
        else { u.A = (const char*)(ws + WS_ACT) + ((size_t)e * 8192 + (size_t)mt * 256) * 2048;
            u.B = (const char*)(ws + WS_W2) + ((size_t)e * 2048 + (size_t)nt * 256) * 2048; }
        return true;
    }
};
struct EpiMoe1 {
    static constexpr bool AFTER_DRAIN = false;
    unsigned char* act; const float* b1;
    DI void operator()(const f32x4 (&acc)[2][2][4][2], const pg8::UnitD& u, int wr, int wc, int fr, int fq) const {
        { int ln_ = threadIdx.x; asm volatile("" : "+v"(ln_)); fr = ln_ & 15; fq = (ln_ >> 4) & 3; }
        const int j0 = u.pn * 128 + wc * 32 + 8 * fq;
        const float* bg = b1 + (size_t)u.e * 4096 + j0; const float* bu = bg + 2048;
        const f32x4 bg0 = *(const f32x4*)bg, bg1 = *(const f32x4*)(bg + 4), bu0 = *(const f32x4*)bu, bu1 = *(const f32x4*)(bu + 4);
#pragma unroll
        for (int ai = 0; ai < 2; ++ai)
#pragma unroll
            for (int m = 0; m < 4; ++m) { const size_t row = (size_t)u.e * 8192 + u.x0 * 256 + ai * 128 + wr * 64 + m * 16 + fr;
                float o[8];
#pragma unroll
                for (int n = 0; n < 2; ++n)
#pragma unroll
                    for (int e = 0; e < 4; ++e) { const float g = fminf(acc[ai][0][m][n][e] * (1.f / 256.f) + (n ? bg1[e] : bg0[e]), 7.f);
                        const float uu = fminf(fmaxf(acc[ai][1][m][n][e] * (1.f / 256.f) + (n ? bu1[e] : bu0[e]), -7.f), 7.f);
                        o[n * 4 + e] = g * __builtin_amdgcn_rcpf(1.f + __builtin_amdgcn_exp2f(g * (-1.702f * 1.4426950408889634f))) * (uu + 1.f) * 4.f; }
                u32x2 w; w.x = __builtin_amdgcn_cvt_pk_fp8_f32(o[0], o[1], 0u, false); w.x = __builtin_amdgcn_cvt_pk_fp8_f32(o[2], o[3], w.x, true);
                w.y = __builtin_amdgcn_cvt_pk_fp8_f32(o[4], o[5], 0u, false); w.y = __builtin_amdgcn_cvt_pk_fp8_f32(o[6], o[7], w.y, true);
                *(u32x2*)(act + row * 2048 + j0) = w;
                __builtin_amdgcn_sched_barrier(0); }
    }
};
struct EpiMoe2 {
    static constexpr bool AFTER_DRAIN = false;
    unsigned char* y; const float* b2; const float* gate_of;
    DI void operator()(const f32x4 (&acc)[2][2][4][2], const pg8::UnitD& u, int wr, int wc, int fr, int fq) const {
        { int ln_ = threadIdx.x; asm volatile("" : "+v"(ln_)); fr = ln_ & 15; fq = (ln_ >> 4) & 3; }
        const int col0 = u.pn * 256 + wc * 32 + 8 * fq;
        const float* bp = b2 + (size_t)u.e * 2048 + col0;
        const f32x4 bb[2][2] = {{*(const f32x4*)(bp), *(const f32x4*)(bp + 4)}, {*(const f32x4*)(bp + 128), *(const f32x4*)(bp + 132)}};
        const float* gp = gate_of + (size_t)u.e * 8192 + u.x0 * 256 + wr * 64 + fr;
        float gts[2][4];
#pragma unroll
        for (int ai = 0; ai < 2; ++ai)
#pragma unroll
            for (int m = 0; m < 4; ++m) gts[ai][m] = gp[ai * 128 + m * 16];
#pragma unroll
        for (int ai = 0; ai < 2; ++ai)
#pragma unroll
            for (int m = 0; m < 4; ++m) { const int rl = ai * 128 + wr * 64 + m * 16 + fr; const size_t row = (size_t)u.e * 8192 + u.x0 * 256 + rl;
                const float gt = (rl < u.nvalid) ? gts[ai][m] * 32.f : 0.f;
#pragma unroll
                for (int bj = 0; bj < 2; ++bj) { const f32x4 v0 = (acc[ai][bj][m][0] * (1.f / 256.f) + bb[bj][0]) * gt, v1 = (acc[ai][bj][m][1] * (1.f / 256.f) + bb[bj][1]) * gt;
                    u32x2 w; w.x = __builtin_amdgcn_cvt_pk_fp8_f32(v0[0], v0[1], 0u, false); w.x = __builtin_amdgcn_cvt_pk_fp8_f32(v0[2], v0[3], w.x, true);
                    w.y = __builtin_amdgcn_cvt_pk_fp8_f32(v1[0], v1[1], 0u, false); w.y = __builtin_amdgcn_cvt_pk_fp8_f32(v1[2], v1[3], w.y, true);
                    *(u32x2*)(y + row * 2048 + col0 + bj * 128) = w; } }
    }
};

DI void p11_combine(Frame& F, const ArgP& a) {
    const int gw = F.vcu * NWAVES + F.wave, NGW = F.G * NWAVES, lane = F.lane;
    const bf16_t* h2 = (const bf16_t*)(F.ws + WS_H2); const unsigned char* y = (const unsigned char*)(F.ws + WS_Y);
    const int* tok_e = (const int*)(F.ws + WS_TOKE);
    for (int t = gw; t < NTOK; t += NGW) {
        size_t yrow[4];
#pragma unroll
        for (int k = 0; k < 4; ++k) yrow[k] = (size_t)tok_e[t * 4 + k] * 2048;
#pragma unroll
        for (int j = 0; j < 8; ++j) { const int c = (lane + 64 * j) * 4;
            const u32x2 hw = *(const u32x2*)(h2 + (size_t)t * 2048 + c); f32x4 v = {bflo(hw.x), bfhi(hw.x), bflo(hw.y), bfhi(hw.y)};
#pragma unroll
            for (int k = 0; k < 4; ++k) { const unsigned w = *(const unsigned*)(y + yrow[k] + c); const f32x2 lo = __builtin_amdgcn_cvt_pk_f32_fp8(w, false), hi = __builtin_amdgcn_cvt_pk_f32_fp8(w, true);
                v.x += lo.x * (1.f / 32.f); v.y += lo.y * (1.f / 32.f); v.z += hi.x * (1.f / 32.f); v.w += hi.y * (1.f / 32.f); }
            *(f32x4*)(a.out() + (size_t)t * 2048 + c) = v; }
    }
}

#ifndef MK_PER_PHASE
#define MK_PER_PHASE 0
#endif
#ifndef MK_LAST_PHASE
#define MK_LAST_PHASE 12
#endif
constexpr int N_PHASES = MK_LAST_PHASE;

__global__ void __launch_bounds__(NWAVES * 64, 2) mega_fwd(Args args_) {
    const ArgP args{};
    extern __shared__ __attribute__((aligned(16))) unsigned char lds_raw[];
    Frame F;
    F.lds = (LAS unsigned char*)lds_raw;
    F.MISC = (volatile LAS unsigned*)(F.lds + MISC_OFF);
    F.tid = threadIdx.x; F.lane = F.tid & 63; F.wave = __builtin_amdgcn_readfirstlane(F.tid >> 6);
    F.G = gridDim.x; { const int bx = blockIdx.x; F.vcu = (F.G % 8 == 0) ? (bx % 8) * (F.G / 8) + bx / 8 : bx; }
    F.ws = args_.ws; F.ctl = (unsigned*)(args_.ws + WS_CTL);
    for (int u = F.tid; u < 256; u += NWAVES * 64) F.MISC[u] = 0u;
    __syncthreads();
    XcdBarrier bar; bar.bar = F.ctl + CW_BAR; bar.x = 0; bar.st = nullptr;
    const int lo = args_.ph_lo, hi = args_.ph_hi;
    if (hi - lo > 1) bar = xcd_barrier_post(F.ctl + CW_BAR, F.MISC + 8);
#ifndef MK_PHASE_MASK
#define MK_PHASE_MASK 0xFFFF
#endif
#define IN(k) (((MK_PHASE_MASK >> (k)) & 1) && lo <= (k) && (k) < hi)
#define SEAM(k) do { if (IN(k) && IN((k) + 1)) xcd_barrier(bar); } while (0)
#define FRESH() do { int t_ = threadIdx.x; asm volatile("" : "+v"(t_)); F.tid = t_; F.lane = t_ & 63; F.wave = __builtin_amdgcn_readfirstlane(t_ >> 6); } while (0)
    unsigned char* ws = args_.ws;

    if (IN(0)) { FRESH(); p0_prologue(F, args); }
    SEAM(0);
    if (IN(1)) { FRESH();
        const bool conv_first = (F.vcu & 1) == 0;
        if (conv_first) { conv_share(F, args); __syncthreads(); }
        SchedP1 S{F.G, F.vcu, ws, 0, 32 * 23};
        EpiP1 E{(bf16_t*)(ws + WS_PROJ), (float*)(ws + WS_DT), (bf16_t*)(ws + WS_KVRAW), args.in(I_DAQG), args.in(I_DAKG), (unsigned char*)(ws + WS_VF8)};
        pg8::gemm_phase<EpiP1, SchedP1, false, true>(F.lds + RING_OFF, 32, S, E);
        if (!conv_first) { __syncthreads(); conv_share(F, args); }
    }
    SEAM(1);
    if (IN(2)) { FRESH();
        if ((F.vcu & 3) == 1) {
            SchedP1 S{(F.G + 3) >> 2, F.vcu >> 2, ws, 32 * 23, 32 * 23 + 64};
            EpiP1 E{(bf16_t*)(ws + WS_PROJ), (float*)(ws + WS_DT), (bf16_t*)(ws + WS_KVRAW), args.in(I_DAQG), args.in(I_DAKG), (unsigned char*)(ws + WS_VF8)};
            pg8::gemm_phase<EpiP1, SchedP1, false, true>(F.lds + RING_OFF, 32, S, E);
            __syncthreads();
        }
        if ((F.vcu & 3) == 0) { for (int u = F.vcu >> 2; u < 64; u += (F.G + 3) >> 2) ssd_unit(F, args, u >> 4, u & 15); }
        __syncthreads();
        attn_phase_da(F);
        __syncthreads();
        conv_queue(F, args, CW_QCONV, CV_NJ - CV_TAIL, CV_TAIL1);
    }
    SEAM(2);
    if (IN(3)) { FRESH(); kprep(F, args); p3_finalize(F, args); }
    SEAM(3);
    if (IN(4)) { FRESH();
        SchedDense S{F.G, F.vcu, 32, 8, (const char*)(ws + WS_YCAT), (const char*)(ws + WS_WOUT), 4096u, 4096u, 1 << 30, 0};
        EpiResid<false> E{args.in(I_X), (bf16_t*)(ws + WS_H1), (float*)(ws + WS_PART1), (unsigned char*)(ws + WS_H1F8), 1.f};
        pg8::gemm_phase<EpiResid<false>, SchedDense, false, true>(F.lds + RING_OFF, 32, S, E);
    }
    SEAM(4);
    if (IN(5)) { FRESH();
        SchedDense S{F.G, F.vcu, 32, 8, (const char*)(ws + WS_H1F8), (const char*)(ws + WS_WQ), 2048u, 2048u, 1 << 30, 0};
        EpiQ E{(unsigned char*)(ws + WS_QF8), (float*)(ws + WS_PARTQ)};
        pg8::gemm_phase<EpiQ, SchedDense, false, true, true>(F.lds + RING_OFF, 16, S, E);
    }
    SEAM(5);
    if (IN(6)) { FRESH();
        SchedXS S{F.G, F.vcu, ws};
        EpiXS E{(unsigned char*)(ws + WS_P8), (unsigned char*)(ws + WS_VWT8), (const float*)(ws + WS_PART1), (const float*)(ws + WS_PARTQ), (LAS float*)(F.lds + RING_BYTES)};
        pg8::gemm_phase<EpiXS, SchedXS, false, true, true>(F.lds + RING_OFF, 4, S, E);
    }
    SEAM(6);
    if (IN(7)) { FRESH();
        SchedDense S{F.G, F.vcu, 32, 8, (const char*)(ws + WS_P8), (const char*)(ws + WS_VWT8), 1024u, 1024u, 8, (size_t)2048 * 1024};
        EpiResid<true> E{(const void*)(ws + WS_H1), (bf16_t*)(ws + WS_H2), nullptr, nullptr, 1.f / 8192.f};
        pg8::gemm_phase<EpiResid<true>, SchedDense, false, true, true>(F.lds + RING_OFF, 8, S, E);
    }
    SEAM(7);
    if (IN(8)) { FRESH(); p8_route(F, args); }
    SEAM(8);
    if (IN(9)) { FRESH();
        moe_tables(F);
        SchedMoe<16> S{F.G, F.vcu, ws, F.MISC, ldsu(F.MISC + 112) * 16};
        EpiMoe1 E{(unsigned char*)(ws + WS_ACT), args.in(I_B1)};
        pg8::gemm_phase<EpiMoe1, SchedMoe<16>, false, true, true>(F.lds + RING_OFF, 16, S, E);
        __syncthreads();
        conv_queue(F, args, CW_QCONV2, CV_NJ - CV_TAIL2, CV_TAIL2);
    }
    SEAM(9);
    if (IN(10)) { FRESH();
        moe_tables(F);
        SchedMoe<8> S{F.G, F.vcu, ws, F.MISC, ldsu(F.MISC + 112) * 8};
        EpiMoe2 E{(unsigned char*)(ws + WS_Y), args.in(I_B2), (const float*)(ws + WS_GATEOF)};
        pg8::gemm_phase<EpiMoe2, SchedMoe<8>, false, true, true>(F.lds + RING_OFF, 16, S, E);
    }
    SEAM(10);
    if (IN(11)) { FRESH(); p11_combine(F, args); }
#undef IN
#undef SEAM
}

#ifdef MK_PROBE2
__global__ void __launch_bounds__(NWAVES * 64, 2) moe_probe(Args args_) {
    const ArgP args{};
    extern __shared__ __attribute__((aligned(16))) unsigned char lds_raw[];
    Frame F;
    F.lds = (LAS unsigned char*)lds_raw;
    F.MISC = (volatile LAS unsigned*)(F.lds + MISC_OFF);
    F.tid = threadIdx.x; F.lane = F.tid & 63; F.wave = __builtin_amdgcn_readfirstlane(F.tid >> 6);
    F.G = gridDim.x; { const int bx = blockIdx.x; F.vcu = (F.G % 8 == 0) ? (bx % 8) * (F.G / 8) + bx / 8 : bx; }
    F.ws = args_.ws; F.ctl = (unsigned*)(args_.ws + WS_CTL);
    for (int u = F.tid; u < 256; u += NWAVES * 64) F.MISC[u] = 0u;
    __syncthreads();
    unsigned char* ws = args_.ws;
    moe_tables(F);
    if (args_.ph_lo == 9) {
        SchedMoe<16> S{F.G, F.vcu, ws, F.MISC, ldsu(F.MISC + 112) * 16};
        EpiMoe1 E{(unsigned char*)(ws + WS_ACT), args.in(I_B1)};
#if MK_PROBE2 == 1
        pg8::gemm_phase<EpiMoe1, SchedMoe<16>, false, true, true>(F.lds + RING_OFF, 16, S, E);
#elif MK_PROBE2 == 2
        pg8::gemm_phase2<EpiMoe1, SchedMoe<16>, true>(F.lds + RING_OFF, 16, S, E);
#else
        pg8::gemm_phase3<EpiMoe1, SchedMoe<16>, true>(F.lds + RING_OFF, 16, S, E);
#endif
    } else {
        SchedMoe<8> S{F.G, F.vcu, ws, F.MISC, ldsu(F.MISC + 112) * 8};
        EpiMoe2 E{(unsigned char*)(ws + WS_Y), args.in(I_B2), (const float*)(ws + WS_GATEOF)};
#if MK_PROBE2 == 1
        pg8::gemm_phase<EpiMoe2, SchedMoe<8>, false, true, true>(F.lds + RING_OFF, 16, S, E);
#elif MK_PROBE2 == 2
        pg8::gemm_phase2<EpiMoe2, SchedMoe<8>, true>(F.lds + RING_OFF, 16, S, E);
#else
        pg8::gemm_phase3<EpiMoe2, SchedMoe<8>, true>(F.lds + RING_OFF, 16, S, E);
#endif
    }
}
#endif

extern "C" void kernel_launch(void* const* d_in, const int* in_sizes, int n_in, void* d_out, int out_size, void* d_ws, size_t ws_size, hipStream_t stream) {
    static int grid = 0;
    if (grid == 0) {
        if (n_in != 32 || out_size != NTOK * 2048 || ws_size < WS_END) { fprintf(stderr, "kernel_launch: unexpected shapes (n_in %d out %d ws %zu); nothing launched\n", n_in, out_size, ws_size); grid = -1; return; }
        int dev = 0, cus = 0, per_cu = 0;
        if (hipGetDevice(&dev) != hipSuccess || hipDeviceGetAttribute(&cus, hipDeviceAttributeMultiprocessorCount, dev) != hipSuccess) { grid = -1; return; }
        if (hipFuncSetAttribute((const void*)mega_fwd, hipFuncAttributeMaxDynamicSharedMemorySize, LDS_BYTES) != hipSuccess) { fprintf(stderr, "kernel_launch: hipFuncSetAttribute failed\n"); grid = -1; return; }
        if (hipOccupancyMaxActiveBlocksPerMultiprocessor(&per_cu, (const void*)mega_fwd, NWAVES * 64, LDS_BYTES) != hipSuccess || per_cu < 1) { fprintf(stderr, "kernel_launch: occupancy query says %d\n", per_cu); }
        (void)hipGetLastError();
        if (cus < 256) { fprintf(stderr, "kernel_launch: needs 256 CUs, found %d; nothing launched\n", cus); grid = -1; return; }
        grid = 256;
    }
    if (grid < 0) return;
    if (hipMemsetAsync((char*)d_ws + WS_CTL, 0, CTL_ZERO_BYTES, stream) != hipSuccess) return;
    Args a{};
    for (int i = 0; i < 32; ++i) a.in[i] = (const float*)d_in[i];
    a.out = (float*)d_out; a.ws = (unsigned char*)d_ws;
#if MK_PER_PHASE
    for (int p = 0; p < N_PHASES; ++p) { a.ph_lo = p; a.ph_hi = p + 1; hipLaunchKernelGGL(mega_fwd, dim3(grid), dim3(NWAVES * 64), LDS_BYTES, stream, a); }
#else
    a.ph_lo = 0; a.ph_hi = N_PHASES;
    hipLaunchKernelGGL(mega_fwd, dim3(grid), dim3(NWAVES * 64), LDS_BYTES, stream, a);
#ifdef MK_PROBE2
    (void)hipFuncSetAttribute((const void*)moe_probe, hipFuncAttributeMaxDynamicSharedMemorySize, LDS_BYTES);
#ifdef MK_HOTPROBE
    a.probe = MK_HOTPROBE;
#endif
    for (int p = 9; p < 11; ++p) { a.ph_lo = p; a.ph_hi = p + 1; hipLaunchKernelGGL(moe_probe, dim3(grid), dim3(NWAVES * 64), LDS_BYTES, stream, a); }
#endif
#ifdef MK_PROBE_LO
    for (int p = MK_PROBE_LO; p < MK_PROBE_HI; ++p) { a.ph_lo = p; a.ph_hi = p + 1;
#ifdef MK_HOTPROBE
        a.probe = MK_HOTPROBE;
#endif
        if (p == 2) (void)hipMemsetAsync((char*)d_ws + WS_CTL + CW_QATT * 4, 0, 1024, stream);
        hipLaunchKernelGGL(mega_fwd, dim3(grid), dim3(NWAVES * 64), LDS_BYTES, stream, a); }
#endif
#endif
}
```

```cpp
#define MK_PER_PHASE 0
#define MK_LAST_PHASE 12
#include <hip/hip_runtime.h>
#include <hip/hip_bf16.h>
#include <cstdio>
#include <cstdint>
#include <cmath>

#define GAS __attribute__((address_space(1)))
#define LAS __attribute__((address_space(3)))
typedef unsigned short bf16_t;
typedef short bf16x8 __attribute__((ext_vector_type(8)));
typedef float f32x2 __attribute__((ext_vector_type(2)));
typedef float f32x4 __attribute__((ext_vector_type(4)));
typedef float f32x16 __attribute__((ext_vector_type(16)));
typedef unsigned u32x2 __attribute__((ext_vector_type(2)));
typedef unsigned u32x4 __attribute__((ext_vector_type(4)));
typedef __bf16 bf16x2_t __attribute__((ext_vector_type(2)));

#define DI __device__ __forceinline__
DI unsigned pk2(float lo, float hi) { f32x2 v = {lo, hi}; bf16x2_t b = __builtin_convertvector(v, bf16x2_t); return __builtin_bit_cast(unsigned, b); }
DI float bflo(unsigned u) { return __uint_as_float(u << 16); }
DI float bfhi(unsigned u) { return __uint_as_float(u & 0xffff0000u); }
DI float bf2f(bf16_t h) { return __uint_as_float(((unsigned)h) << 16); }
DI float wave_sum(float v) {
#pragma unroll
    for (int o = 1; o < 64; o <<= 1) v += __shfl_xor(v, o);
    return v;
}
DI float quad_sum_16_32(float v) {
    int l_ = threadIdx.x; asm volatile("" : "+v"(l_));
    const int a16 = ((l_ ^ 16) & 63) << 2, a32 = ((l_ ^ 32) & 63) << 2;
    v += __builtin_bit_cast(float, __builtin_amdgcn_ds_bpermute(a16, __builtin_bit_cast(int, v)));
    v += __builtin_bit_cast(float, __builtin_amdgcn_ds_bpermute(a32, __builtin_bit_cast(int, v)));
    return v;
}
DI float siluf(float x) { return x / (1.f + __expf(-x)); }

constexpr int DM_ = 2048, NB = 4, SEQ_ = 2048, NTOK = NB * SEQ_;
constexpr int PP = 5632;
constexpr int PC_XBC = 1024, PC_Q = 2560, PC_K = 3584, PC_V = 4608, PC_DT = 5632;
constexpr int WIN_ROWS = 5888;
constexpr int NEXP = 32, MEMLEN = 256;
constexpr float EPS_ = 1e-6f;
constexpr float LAM_INIT = 0.2f;

namespace pg8 {
constexpr int BM = 256, BK = 64, HALF = 128, HTB = HALF * BK * 2  , STAGE_BYTES = 8 * HTB;
DI int lds_byte(int r, int c) { const int st = (r >> 4) * 2 + (c >> 5), rr = r & 15, cc = c & 31, ob = rr * 64 + cc * 2; return st * 1024 + (ob ^ (((ob >> 9) & 1) << 5)); }
DI void stage_rc(int b, int& R, int& C) { const int st = b / 1024, sb = b % 1024, swz = sb ^ (((sb >> 9) & 1) << 5); R = (st >> 1) * 16 + swz / 64; C = (st & 1) * 32 + (swz % 64) / 2; }
DI int perm32(int rho) { const int n = rho >> 4, i = rho & 15; return 8 * (i >> 2) + 4 * n + (i & 3); }

struct UnitD {
    const char* A; const char* B;
    const int* rows;
    unsigned lda, ldb;
    int nvalid;
    int type, pm, pn, e, x0;
};
typedef int v8i_t __attribute__((ext_vector_type(8)));
DI v8i_t cat8(bf16x8 lo, bf16x8 hi) { typedef int v4i_t __attribute__((ext_vector_type(4))); const v4i_t a = __builtin_bit_cast(v4i_t, lo), b = __builtin_bit_cast(v4i_t, hi); return (v8i_t){a[0], a[1], a[2], a[3], b[0], b[1], b[2], b[3]}; }
DI void dense_voff(unsigned lda, unsigned ldb, int tid, unsigned (&vA)[2], unsigned (&vB)[2]) {
#pragma unroll
    for (int i = 0; i < 2; ++i) { int R, C; stage_rc(tid * 16 + i * 8192, R, C); const int Rb = (R & ~31) + perm32(R & 31);
        vA[i] = (unsigned)R * lda + (unsigned)C * 2u; vB[i] = (unsigned)Rb * ldb + (unsigned)C * 2u; }
}
DI void gather_voff(const UnitD& u, int tid, unsigned (&gA)[2][2]) {
#pragma unroll
    for (int i = 0; i < 2; ++i) { int R, C; stage_rc(tid * 16 + i * 8192, R, C);
#pragma unroll
        for (int h = 0; h < 2; ++h) { const int ra = h * 128 + R; const unsigned rowA = (ra < u.nvalid) ? (unsigned)u.rows[ra] : 0u; gA[h][i] = rowA * u.lda + (unsigned)C * 2u; } }
}

template <class Epi, class Sched, bool GATHER, bool ALIGN_EPI, bool FP8 = false>
DI void gemm_phase(LAS unsigned char* lds, int nt, const Sched& S, const Epi& E) {

    const int tid = threadIdx.x, wid = __builtin_amdgcn_readfirstlane(tid >> 6), lane = tid & 63, wr = wid >> 2, wc = wid & 3, fr = lane & 15, fq = lane >> 4;
#ifndef MK_HOTPROBE
#define PG8_NODMA false
#define PG8_NOMMA false
#define PG8_NOLD false
#define PG8_NOEPI false
#define PG8_NOLOOP false
#else
#define PG8_NODMA ((hot_ & 4) != 0)
#define PG8_NOMMA ((hot_ & 8) != 0)
#define PG8_NOLD ((hot_ & 16) != 0)
#define PG8_NOEPI ((hot_ & 32) != 0)
#define PG8_NOLOOP ((hot_ & 64) != 0)
#endif
#ifdef MK_HOTPROBE
    int hot_; { typedef const __attribute__((address_space(4))) char* kptr; kptr kp = (kptr)__builtin_amdgcn_kernarg_segment_ptr(); asm volatile("" : "+s"(kp)); hot_ = *(const int __attribute__((address_space(4)))*)(kp + 280); }
    const size_t kstep = (hot_ & 1) ? (size_t)0 : (size_t)(BK * 2);
#else
    const size_t kstep = (size_t)(BK * 2);
#endif
    const unsigned ldsb = (unsigned)__builtin_amdgcn_readfirstlane((int)((unsigned)(uintptr_t)lds + (unsigned)wid * 1024u));
    const int aoff = lds_byte(wr * 64 + fr, fq * 8), boff = lds_byte(wc * 32 + fr, fq * 8);
#define PG8_SA(b, h) (((b) * 2 + (h)) * HTB)
#define PG8_SB(b, h) ((4 + (b) * 2 + (h)) * HTB)
#define PG8_STAGE(bufoff, gbase, voff) do { if (PG8_NODMA) break; _Pragma("unroll") for (int _i = 0; _i < 2; ++_i) { unsigned keep_; \
        asm volatile("s_mov_b32 %0, m0\n\ts_mov_b32 m0, %3\n\ts_nop 0\n\tglobal_load_lds_dwordx4 %1, %2\n\ts_mov_b32 m0, %0" \
                     : "=&s"(keep_) : "v"((voff)[_i]), "s"((const char*)(gbase)), "s"(ldsb + (unsigned)((bufoff) + _i * 8192)) : "memory"); } } while (0)
#define PG8_STA(bufoff, gbase, h, HS, GA) do { if constexpr (GATHER) { PG8_STAGE(bufoff, gbase, GA[h]); } else { PG8_STAGE(bufoff, (gbase) + (h) * (HS), vA); } } while (0)
#define PG8_STB(bufoff, gbase, h, HS) PG8_STAGE(bufoff, (gbase) + (h) * (HS), vB)
typedef int v4i_t __attribute__((ext_vector_type(4)));
#define PG8_LDA(dst, b, h) do { if (PG8_NOLD) break; _Pragma("unroll") for (int m = 0; m < 4; ++m) { if constexpr (FP8) { \
            const v4i_t lo_ = *(const LAS v4i_t*)(lds + PG8_SA(b, h) + aoff + m * 2048), hi_ = *(const LAS v4i_t*)(lds + PG8_SA(b, h) + aoff + m * 2048 + 1024); \
            dst##8[m] = __builtin_shufflevector(lo_, hi_, 0, 1, 2, 3, 4, 5, 6, 7); } \
        else { _Pragma("unroll") for (int k = 0; k < 2; ++k) dst[m][k] = *(const LAS bf16x8*)(lds + PG8_SA(b, h) + aoff + m * 2048 + k * 1024); } } } while (0)
#define PG8_LDB(dst, b, h) do { if (PG8_NOLD) break; _Pragma("unroll") for (int n = 0; n < 2; ++n) { if constexpr (FP8) { \
            const v4i_t lo_ = *(const LAS v4i_t*)(lds + PG8_SB(b, h) + boff + n * 2048), hi_ = *(const LAS v4i_t*)(lds + PG8_SB(b, h) + boff + n * 2048 + 1024); \
            dst##8[n] = __builtin_shufflevector(lo_, hi_, 0, 1, 2, 3, 4, 5, 6, 7); } \
        else { _Pragma("unroll") for (int k = 0; k < 2; ++k) dst[n][k] = *(const LAS bf16x8*)(lds + PG8_SB(b, h) + boff + n * 2048 + k * 1024); } } } while (0)
#ifndef PG8_FP8_PRIO
#define PG8_FP8_PRIO 1
#endif
#define PG8_MMA(ai, bj, At, Bt) do { if (PG8_NOMMA) break; if (!FP8 || PG8_FP8_PRIO) __builtin_amdgcn_s_setprio(1); _Pragma("unroll") for (int m = 0; m < 4; ++m) _Pragma("unroll") for (int n = 0; n < 2; ++n) { \
        if constexpr (FP8) { acc[ai][bj][m][n] = __builtin_amdgcn_mfma_scale_f32_16x16x128_f8f6f4(Bt##8[n], At##8[m], acc[ai][bj][m][n], 0, 0, 0, 0x7f7f7f7f, 0, 0x7f7f7f7f); } \
        else { _Pragma("unroll") for (int k = 0; k < 2; ++k) acc[ai][bj][m][n] = __builtin_amdgcn_mfma_f32_16x16x32_bf16(Bt[n][k], At[m][k], acc[ai][bj][m][n], 0, 0, 0); } } \
        if (!FP8 || PG8_FP8_PRIO) __builtin_amdgcn_s_setprio(0); } while (0)
#define PG8_WAIT_V(n) asm volatile("s_waitcnt vmcnt(" #n ")" ::: "memory")
#define PG8_WAIT_L(n) asm volatile("s_waitcnt lgkmcnt(" #n ")" ::: "memory")
#define PG8_BAR __builtin_amdgcn_s_barrier()
#define PG8_SCHED __builtin_amdgcn_sched_barrier(0)
#define PG8_ITER(A1P, A2P, B2P, HA2, HB2, GA2) do { \
        const char* a3p_ = (A2P) + kstep; const char* b3p_ = (B2P) + kstepB; \
        PG8_LDB(B0, 0, 0); PG8_LDB(B1, 0, 1); PG8_SCHED; PG8_LDA(At, 0, 0); PG8_STA(PG8_SA(1, 1), (A1P), 1, hsA, gA); \
        PG8_WAIT_V(8); PG8_WAIT_L(0); PG8_BAR; PG8_MMA(0, 0, At, B0); PG8_MMA(0, 1, At, B1); PG8_BAR; PG8_SCHED; \
        PG8_LDA(At, 0, 1); PG8_STB(PG8_SB(0, 0), (B2P), 0, HB2); PG8_STB(PG8_SB(0, 1), (B2P), 1, HB2); PG8_STA(PG8_SA(0, 0), (A2P), 0, HA2, GA2); \
        PG8_WAIT_V(8); PG8_WAIT_L(0); PG8_BAR; PG8_MMA(1, 0, At, B0); PG8_MMA(1, 1, At, B1); PG8_BAR; PG8_SCHED; \
        PG8_LDB(B0, 1, 0); PG8_LDB(B1, 1, 1); PG8_SCHED; PG8_LDA(At, 1, 0); PG8_STA(PG8_SA(0, 1), (A2P), 1, HA2, GA2); \
        PG8_WAIT_V(8); PG8_WAIT_L(0); PG8_BAR; PG8_MMA(0, 0, At, B0); PG8_MMA(0, 1, At, B1); PG8_BAR; PG8_SCHED; \
        PG8_LDA(At, 1, 1); PG8_STB(PG8_SB(1, 0), b3p_, 0, HB2); PG8_STB(PG8_SB(1, 1), b3p_, 1, HB2); PG8_STA(PG8_SA(1, 0), a3p_, 0, HA2, GA2); \
        PG8_WAIT_V(8); PG8_WAIT_L(0); PG8_BAR; PG8_MMA(1, 0, At, B0); PG8_MMA(1, 1, At, B1); PG8_BAR; PG8_SCHED; \
    } while (0)
    UnitD cur, nxt; int ui = 0;
    if (!S.next(0, cur)) return;
    f32x4 acc[2][2][4][2];
#pragma unroll
    for (int a = 0; a < 2; ++a)
#pragma unroll
        for (int b = 0; b < 2; ++b)
#pragma unroll
            for (int m = 0; m < 4; ++m)
#pragma unroll
                for (int n = 0; n < 2; ++n) acc[a][b][m][n] = (f32x4){0.f, 0.f, 0.f, 0.f};
    bf16x8 At[4][2], B0[2][2], B1[2][2]; v8i_t At8[4], B08[2], B18[2];
    unsigned vA[2], vB[2], gA[2][2], ngA[2][2];
    dense_voff(cur.lda, cur.ldb, tid, vA, vB);
#ifdef MK_HOTPROBE
    const size_t kstepB = (hot_ & 2) ? (size_t)0 : ((cur.ldb == 128u) ? (size_t)32768 : (size_t)(BK * 2));
#else
    const size_t kstepB = (cur.ldb == 128u) ? (size_t)32768 : kstep;
#endif
    if constexpr (GATHER) gather_voff(cur, tid, gA);
    const char* cA = cur.A; const char* cB = cur.B;
    size_t hsA = GATHER ? 0 : (size_t)cur.lda * HALF, hsB = (size_t)cur.ldb * HALF;
    PG8_STB(PG8_SB(0, 0), cB, 0, hsB); PG8_STB(PG8_SB(0, 1), cB, 1, hsB); PG8_STA(PG8_SA(0, 0), cA, 0, hsA, gA); PG8_STA(PG8_SA(0, 1), cA, 1, hsA, gA);
    if (wr == 1) PG8_BAR;
    PG8_WAIT_V(2); PG8_BAR;
    PG8_STB(PG8_SB(1, 0), cB + kstepB, 0, hsB); PG8_STA(PG8_SA(1, 0), cA + kstep, 0, hsA, gA); PG8_STB(PG8_SB(1, 1), cB + kstepB, 1, hsB);
    PG8_WAIT_V(6); PG8_BAR;
    for (;;) {
        const bool has_next = S.next(ui + 1, nxt);
        const char* nA = cA; const char* nB = cB; size_t nhsA = hsA, nhsB = hsB;
        if (has_next) { nA = nxt.A; nB = nxt.B; nhsA = GATHER ? 0 : (size_t)nxt.lda * HALF; nhsB = (size_t)nxt.ldb * HALF; }
        if constexpr (GATHER) {
            if (has_next) gather_voff(nxt, tid, ngA);
            else {
#pragma unroll
                for (int h = 0; h < 2; ++h)
#pragma unroll
                    for (int i = 0; i < 2; ++i) ngA[h][i] = gA[h][i];
            }
        }
#pragma unroll 1
        for (int t = 0; t < (PG8_NOLOOP ? 0 : nt); t += 2) {
            const bool last = (t == nt - 2);
            const char* a2 = last ? nA : cA + (size_t)(t + 2) * kstep; const char* b2 = last ? nB : cB + (size_t)(t + 2) * kstepB;
            const size_t hA2 = last ? nhsA : hsA, hB2 = last ? nhsB : hsB;
            unsigned g2[2][2];
            if constexpr (GATHER) {
#pragma unroll
                for (int h = 0; h < 2; ++h)
#pragma unroll
                    for (int i = 0; i < 2; ++i) g2[h][i] = last ? ngA[h][i] : gA[h][i];
            }
            PG8_ITER(cA + (size_t)(t + 1) * kstep, a2, b2, hA2, hB2, g2);
        }
        if constexpr (ALIGN_EPI) { if (wr == 0) PG8_BAR; }
        if constexpr (!Epi::AFTER_DRAIN) { if (!PG8_NOEPI) E(acc, cur, wr, wc, fr, fq); }
        if (!has_next) break;
#pragma unroll
        for (int a = 0; a < 2; ++a)
#pragma unroll
            for (int b = 0; b < 2; ++b)
#pragma unroll
                for (int m = 0; m < 4; ++m)
#pragma unroll
                    for (int n = 0; n < 2; ++n) acc[a][b][m][n] = (f32x4){0.f, 0.f, 0.f, 0.f};
        cur = nxt; cA = nA; cB = nB; hsA = nhsA; hsB = nhsB; ++ui;
        if constexpr (GATHER) {
#pragma unroll
            for (int h = 0; h < 2; ++h)
#pragma unroll
                for (int i = 0; i < 2; ++i) gA[h][i] = ngA[h][i];
        }
        if constexpr (ALIGN_EPI) { if (wr == 1) PG8_BAR; }
    }
    PG8_WAIT_V(0);
    if constexpr (!ALIGN_EPI) { if (wr == 0) PG8_BAR; }
    PG8_BAR;
    if constexpr (Epi::AFTER_DRAIN) { E.fused(acc, cur, wr, wc, fr, fq, lds, wid, lane); }
#undef PG8_SA
#undef PG8_SB
#undef PG8_STAGE
#undef PG8_STA
#undef PG8_STB
#undef PG8_LDA
#undef PG8_LDB
#undef PG8_MMA
#undef PG8_WAIT_V
#undef PG8_WAIT_L
#undef PG8_BAR
#undef PG8_SCHED
#undef PG8_ITER
}

template <class Epi, class Sched, bool FP8>
DI void gemm_phase2(LAS unsigned char* lds, int nt, const Sched& S, const Epi& E) {
    const int tid = threadIdx.x, wid = __builtin_amdgcn_readfirstlane(tid >> 6), lane = tid & 63, wr = wid >> 2, wc = wid & 3, fr = lane & 15, fq = lane >> 4;
    const size_t kstep = (size_t)(BK * 2);
    const unsigned ldsb = (unsigned)__builtin_amdgcn_readfirstlane((int)((unsigned)(uintptr_t)lds + (unsigned)wid * 1024u));
    const int aoff = lds_byte(wr * 64 + fr, fq * 8), boff = lds_byte(wc * 32 + fr, fq * 8);
#define P2_SA(b, h) (((b) * 2 + (h)) * HTB)
#define P2_SB(b, h) ((4 + (b) * 2 + (h)) * HTB)
#define P2_STAGE(bufoff, gbase, voff) do { _Pragma("unroll") for (int _i = 0; _i < 2; ++_i) { unsigned keep_; \
        asm volatile("s_mov_b32 %0, m0\n\ts_mov_b32 m0, %3\n\ts_nop 0\n\tglobal_load_lds_dwordx4 %1, %2\n\ts_mov_b32 m0, %0" \
                     : "=&s"(keep_) : "v"((voff)[_i]), "s"((const char*)(gbase)), "s"(ldsb + (unsigned)((bufoff) + _i * 8192)) : "memory"); } } while (0)
#define P2_STA(bufoff, gbase, h, HS) P2_STAGE(bufoff, (gbase) + (h) * (HS), vA)
#define P2_STB(bufoff, gbase, h, HS) P2_STAGE(bufoff, (gbase) + (h) * (HS), vB)
typedef int v4i_t __attribute__((ext_vector_type(4)));
#define P2_LDA1(m, b, h) do { if constexpr (FP8) { \
            const v4i_t lo_ = *(const LAS v4i_t*)(lds + P2_SA(b, h) + aoff + (m) * 2048), hi_ = *(const LAS v4i_t*)(lds + P2_SA(b, h) + aoff + (m) * 2048 + 1024); \
            At8[m] = __builtin_shufflevector(lo_, hi_, 0, 1, 2, 3, 4, 5, 6, 7); } \
        else { _Pragma("unroll") for (int k = 0; k < 2; ++k) At[m][k] = *(const LAS bf16x8*)(lds + P2_SA(b, h) + aoff + (m) * 2048 + k * 1024); } } while (0)
#define P2_LDA(b, h) do { _Pragma("unroll") for (int m = 0; m < 4; ++m) P2_LDA1(m, b, h); } while (0)
#define P2_LDB(dst, b, h) do { _Pragma("unroll") for (int n = 0; n < 2; ++n) { if constexpr (FP8) { \
            const v4i_t lo_ = *(const LAS v4i_t*)(lds + P2_SB(b, h) + boff + n * 2048), hi_ = *(const LAS v4i_t*)(lds + P2_SB(b, h) + boff + n * 2048 + 1024); \
            dst##8[n] = __builtin_shufflevector(lo_, hi_, 0, 1, 2, 3, 4, 5, 6, 7); } \
        else { _Pragma("unroll") for (int k = 0; k < 2; ++k) dst[n][k] = *(const LAS bf16x8*)(lds + P2_SB(b, h) + boff + n * 2048 + k * 1024); } } } while (0)
#define P2_MMA4(ai, m) do { if constexpr (FP8) { _Pragma("unroll") for (int n = 0; n < 2; ++n) acc[ai][0][m][n] = __builtin_amdgcn_mfma_scale_f32_16x16x128_f8f6f4(B08[n], At8[m], acc[ai][0][m][n], 0, 0, 0, 0x7f7f7f7f, 0, 0x7f7f7f7f); \
            _Pragma("unroll") for (int n = 0; n < 2; ++n) acc[ai][1][m][n] = __builtin_amdgcn_mfma_scale_f32_16x16x128_f8f6f4(B18[n], At8[m], acc[ai][1][m][n], 0, 0, 0, 0x7f7f7f7f, 0, 0x7f7f7f7f); } \
        else { _Pragma("unroll") for (int k = 0; k < 2; ++k) { _Pragma("unroll") for (int n = 0; n < 2; ++n) acc[ai][0][m][n] = __builtin_amdgcn_mfma_f32_16x16x32_bf16(B0[n][k], At[m][k], acc[ai][0][m][n], 0, 0, 0); \
            _Pragma("unroll") for (int n = 0; n < 2; ++n) acc[ai][1][m][n] = __builtin_amdgcn_mfma_f32_16x16x32_bf16(B1[n][k], At[m][k], acc[ai][1][m][n], 0, 0, 0); } } } while (0)
#define P2_SCHED __builtin_amdgcn_sched_barrier(0)
#define P2_MMA32(b) do { __builtin_amdgcn_s_setprio(1); \
        P2_MMA4(0, 0); P2_SCHED; P2_LDA1(0, b, 1); P2_SCHED; P2_MMA4(0, 1); P2_SCHED; P2_LDA1(1, b, 1); P2_SCHED; \
        P2_MMA4(0, 2); P2_SCHED; P2_LDA1(2, b, 1); P2_SCHED; P2_MMA4(0, 3); P2_SCHED; P2_LDA1(3, b, 1); P2_SCHED; \
        P2_MMA4(1, 0); P2_SCHED; P2_MMA4(1, 1); P2_SCHED; P2_MMA4(1, 2); P2_SCHED; P2_MMA4(1, 3); P2_SCHED; \
        __builtin_amdgcn_s_setprio(0); } while (0)
#define P2_LD(b) do { P2_LDB(B0, b, 0); P2_LDB(B1, b, 1); P2_LDA(b, 0); } while (0)
#define P2_WAIT_V(n) asm volatile("s_waitcnt vmcnt(" #n ")" ::: "memory")
#define P2_WAIT_L(n) asm volatile("s_waitcnt lgkmcnt(" #n ")" ::: "memory")
#define P2_BAR __builtin_amdgcn_s_barrier()
    UnitD cur, nxt; int ui = 0;
    if (!S.next(0, cur)) return;
    f32x4 acc[2][2][4][2];
#pragma unroll
    for (int a = 0; a < 2; ++a)
#pragma unroll
        for (int b = 0; b < 2; ++b)
#pragma unroll
            for (int m = 0; m < 4; ++m)
#pragma unroll
                for (int n = 0; n < 2; ++n) acc[a][b][m][n] = (f32x4){0.f, 0.f, 0.f, 0.f};
    bf16x8 At[4][2], B0[2][2], B1[2][2]; v8i_t At8[4], B08[2], B18[2];
    unsigned vA[2], vB[2];
    dense_voff(cur.lda, cur.ldb, tid, vA, vB);
    const size_t kstepB = (cur.ldb == 128u) ? (size_t)32768 : kstep;
    const char* cA = cur.A; const char* cB = cur.B;
    size_t hsA = (size_t)cur.lda * HALF, hsB = (size_t)cur.ldb * HALF;
    P2_STB(P2_SB(0, 0), cB, 0, hsB); P2_STB(P2_SB(0, 1), cB, 1, hsB); P2_STA(P2_SA(0, 0), cA, 0, hsA); P2_STA(P2_SA(0, 1), cA, 1, hsA);
    P2_WAIT_V(0); P2_BAR;
    for (;;) {
        const bool has_next = S.next(ui + 1, nxt);
        const char* nA = cA; const char* nB = cB; size_t nhsA = hsA, nhsB = hsB;
        if (has_next) { nA = nxt.A; nB = nxt.B; nhsA = (size_t)nxt.lda * HALF; nhsB = (size_t)nxt.ldb * HALF; }
        if (wr == 0) {
#pragma unroll 1
            for (int t = 0; t < nt; t += 2) {
                const bool last = (t == nt - 2);
                const char* a1 = cA + (size_t)(t + 1) * kstep; const char* b1 = cB + (size_t)(t + 1) * kstepB;
                const char* a2 = last ? nA : cA + (size_t)(t + 2) * kstep; const char* b2 = last ? nB : cB + (size_t)(t + 2) * kstepB;
                const size_t hA2 = last ? nhsA : hsA, hB2 = last ? nhsB : hsB;
                P2_STB(P2_SB(1, 0), b1, 0, hsB); P2_STB(P2_SB(1, 1), b1, 1, hsB); P2_STA(P2_SA(1, 0), a1, 0, hsA);
                P2_LD(0); P2_WAIT_V(6); P2_WAIT_L(0); P2_BAR; P2_SCHED;
                P2_STA(P2_SA(1, 1), a1, 1, hsA);
                P2_MMA32(0); P2_WAIT_V(2); P2_BAR; P2_SCHED;
                P2_STB(P2_SB(0, 0), b2, 0, hB2); P2_STB(P2_SB(0, 1), b2, 1, hB2); P2_STA(P2_SA(0, 0), a2, 0, hA2);
                P2_LD(1); P2_WAIT_V(6); P2_WAIT_L(0); P2_BAR; P2_SCHED;
                P2_STA(P2_SA(0, 1), a2, 1, hA2);
                P2_MMA32(1); P2_WAIT_V(2); P2_BAR; P2_SCHED;
            }
            P2_BAR;
        } else {
#pragma unroll 1
            for (int t = 0; t < nt; t += 2) {
                const bool last = (t == nt - 2);
                const char* a1 = cA + (size_t)(t + 1) * kstep; const char* b1 = cB + (size_t)(t + 1) * kstepB;
                const char* a2 = last ? nA : cA + (size_t)(t + 2) * kstep; const char* b2 = last ? nB : cB + (size_t)(t + 2) * kstepB;
                const size_t hA2 = last ? nhsA : hsA, hB2 = last ? nhsB : hsB;
                P2_STB(P2_SB(1, 0), b1, 0, hsB); P2_STB(P2_SB(1, 1), b1, 1, hsB); P2_STA(P2_SA(1, 0), a1, 0, hsA);
                if (t != 0) { P2_MMA32(1); }
                P2_WAIT_V(6); P2_BAR; P2_SCHED;
                P2_STA(P2_SA(1, 1), a1, 1, hsA);
                P2_LD(0); P2_WAIT_V(2); P2_WAIT_L(0); P2_BAR; P2_SCHED;
                P2_STB(P2_SB(0, 0), b2, 0, hB2); P2_STB(P2_SB(0, 1), b2, 1, hB2); P2_STA(P2_SA(0, 0), a2, 0, hA2);
                P2_MMA32(0); P2_WAIT_V(6); P2_BAR; P2_SCHED;
                P2_STA(P2_SA(0, 1), a2, 1, hA2);
                P2_LD(1); P2_WAIT_V(2); P2_WAIT_L(0); P2_BAR; P2_SCHED;
            }
            P2_MMA32(1); P2_BAR; P2_SCHED;
        }
        E(acc, cur, wr, wc, fr, fq);
        if (!has_next) break;
#pragma unroll
        for (int a = 0; a < 2; ++a)
#pragma unroll
            for (int b = 0; b < 2; ++b)
#pragma unroll
                for (int m = 0; m < 4; ++m)
#pragma unroll
                    for (int n = 0; n < 2; ++n) acc[a][b][m][n] = (f32x4){0.f, 0.f, 0.f, 0.f};
        cur = nxt; cA = nA; cB = nB; hsA = nhsA; hsB = nhsB; ++ui;
    }
    P2_WAIT_V(0);
    P2_BAR;
#undef P2_SA
#undef P2_SB
#undef P2_STAGE
#undef P2_STA
#undef P2_STB
#undef P2_LDA1
#undef P2_LDA
#undef P2_LDB
#undef P2_MMA4
#undef P2_SCHED
#undef P2_MMA32
#undef P2_LD
#undef P2_WAIT_V
#undef P2_WAIT_L
#undef P2_BAR
}
template <class Epi, class Sched, bool FP8>
DI void gemm_phase3(LAS unsigned char* lds, int nt, const Sched& S, const Epi& E) {
    const int tid = threadIdx.x, wid = __builtin_amdgcn_readfirstlane(tid >> 6), lane = tid & 63, wr = wid >> 2, wc = wid & 3, fr = lane & 15, fq = lane >> 4;
    const size_t kstep = (size_t)(BK * 2);
    const unsigned ldsb = (unsigned)__builtin_amdgcn_readfirstlane((int)((unsigned)(uintptr_t)lds + (unsigned)wid * 1024u));
    const int aoff = lds_byte(wr * 64 + fr, fq * 8), boff = lds_byte(wc * 32 + fr, fq * 8);
#define P2_SA(b, h) (((b) * 2 + (h)) * HTB)
#define P2_SB(b, h) ((4 + (b) * 2 + (h)) * HTB)
#define P2_STAGE(bufoff, gbase, voff) do { _Pragma("unroll") for (int _i = 0; _i < 2; ++_i) { unsigned keep_; \
        asm volatile("s_mov_b32 %0, m0\n\ts_mov_b32 m0, %3\n\ts_nop 0\n\tglobal_load_lds_dwordx4 %1, %2\n\ts_mov_b32 m0, %0" \
                     : "=&s"(keep_) : "v"((voff)[_i]), "s"((const char*)(gbase)), "s"(ldsb + (unsigned)((bufoff) + _i * 8192)) : "memory"); } } while (0)
#define P2_STA(bufoff, gbase, h, HS) P2_STAGE(bufoff, (gbase) + (h) * (HS), vA)
#define P2_STB(bufoff, gbase, h, HS) P2_STAGE(bufoff, (gbase) + (h) * (HS), vB)
typedef int v4i_t __attribute__((ext_vector_type(4)));
#define P2_LDA1(D, m, b, h) do { if constexpr (FP8) { \
            const v4i_t lo_ = *(const LAS v4i_t*)(lds + P2_SA(b, h) + aoff + (m) * 2048), hi_ = *(const LAS v4i_t*)(lds + P2_SA(b, h) + aoff + (m) * 2048 + 1024); \
            D##8[m] = __builtin_shufflevector(lo_, hi_, 0, 1, 2, 3, 4, 5, 6, 7); } \
        else { _Pragma("unroll") for (int k = 0; k < 2; ++k) D[m][k] = *(const LAS bf16x8*)(lds + P2_SA(b, h) + aoff + (m) * 2048 + k * 1024); } } while (0)
#define P2_LDA(D, b, h) do { _Pragma("unroll") for (int m = 0; m < 4; ++m) P2_LDA1(D, m, b, h); } while (0)
#define P2_LDB(dst, b, h) do { _Pragma("unroll") for (int n = 0; n < 2; ++n) { if constexpr (FP8) { \
            const v4i_t lo_ = *(const LAS v4i_t*)(lds + P2_SB(b, h) + boff + n * 2048), hi_ = *(const LAS v4i_t*)(lds + P2_SB(b, h) + boff + n * 2048 + 1024); \
            dst##8[n] = __builtin_shufflevector(lo_, hi_, 0, 1, 2, 3, 4, 5, 6, 7); } \
        else { _Pragma("unroll") for (int k = 0; k < 2; ++k) dst[n][k] = *(const LAS bf16x8*)(lds + P2_SB(b, h) + boff + n * 2048 + k * 1024); } } } while (0)
#define P2_MMA4(ai, m, D) do { if constexpr (FP8) { _Pragma("unroll") for (int n = 0; n < 2; ++n) acc[ai][0][m][n] = __builtin_amdgcn_mfma_scale_f32_16x16x128_f8f6f4(B08[n], D##8[m], acc[ai][0][m][n], 0, 0, 0, 0x7f7f7f7f, 0, 0x7f7f7f7f); \
            _Pragma("unroll") for (int n = 0; n < 2; ++n) acc[ai][1][m][n] = __builtin_amdgcn_mfma_scale_f32_16x16x128_f8f6f4(B18[n], D##8[m], acc[ai][1][m][n], 0, 0, 0, 0x7f7f7f7f, 0, 0x7f7f7f7f); } \
        else { _Pragma("unroll") for (int k = 0; k < 2; ++k) { _Pragma("unroll") for (int n = 0; n < 2; ++n) acc[ai][0][m][n] = __builtin_amdgcn_mfma_f32_16x16x32_bf16(B0[n][k], D[m][k], acc[ai][0][m][n], 0, 0, 0); \
            _Pragma("unroll") for (int n = 0; n < 2; ++n) acc[ai][1][m][n] = __builtin_amdgcn_mfma_f32_16x16x32_bf16(B1[n][k], D[m][k], acc[ai][1][m][n], 0, 0, 0); } } } while (0)
#define P2_SCHED __builtin_amdgcn_sched_barrier(0)
#define P2_MMA32(b) do { __builtin_amdgcn_s_setprio(1); \
        P2_MMA4(0, 0, At); P2_MMA4(0, 1, At); P2_MMA4(0, 2, At); P2_MMA4(0, 3, At); P2_MMA4(1, 0, Au); P2_MMA4(1, 1, Au); P2_MMA4(1, 2, Au); P2_MMA4(1, 3, Au); \
        __builtin_amdgcn_s_setprio(0); } while (0)
#define P2_LD(b) do { P2_LDB(B0, b, 0); P2_LDB(B1, b, 1); P2_LDA(At, b, 0); P2_LDA(Au, b, 1); } while (0)
#define P2_WAIT_V(n) asm volatile("s_waitcnt vmcnt(" #n ")" ::: "memory")
#define P2_WAIT_L(n) asm volatile("s_waitcnt lgkmcnt(" #n ")" ::: "memory")
#define P2_BAR __builtin_amdgcn_s_barrier()
    UnitD cur, nxt; int ui = 0;
    if (!S.next(0, cur)) return;
    f32x4 acc[2][2][4][2];
#pragma unroll
    for (int a = 0; a < 2; ++a)
#pragma unroll
        for (int b = 0; b < 2; ++b)
#pragma unroll
            for (int m = 0; m < 4; ++m)
#pragma unroll
                for (int n = 0; n < 2; ++n) acc[a][b][m][n] = (f32x4){0.f, 0.f, 0.f, 0.f};
    bf16x8 At[4][2], Au[4][2], B0[2][2], B1[2][2]; v8i_t At8[4], Au8[4], B08[2], B18[2];
    unsigned vA[2], vB[2];
    dense_voff(cur.lda, cur.ldb, tid, vA, vB);
    const size_t kstepB = (cur.ldb == 128u) ? (size_t)32768 : kstep;
    const char* cA = cur.A; const char* cB = cur.B;
    size_t hsA = (size_t)cur.lda * HALF, hsB = (size_t)cur.ldb * HALF;
    P2_STB(P2_SB(0, 0), cB, 0, hsB); P2_STB(P2_SB(0, 1), cB, 1, hsB); P2_STA(P2_SA(0, 0), cA, 0, hsA); P2_STA(P2_SA(0, 1), cA, 1, hsA);
    P2_WAIT_V(0); P2_BAR;
    for (;;) {
        const bool has_next = S.next(ui + 1, nxt);
        const char* nA = cA; const char* nB = cB; size_t nhsA = hsA, nhsB = hsB;
        if (has_next) { nA = nxt.A; nB = nxt.B; nhsA = (size_t)nxt.lda * HALF; nhsB = (size_t)nxt.ldb * HALF; }
        if (wr == 0) {
#pragma unroll 1
            for (int t = 0; t < nt; t += 2) {
                const bool last = (t == nt - 2);
                const char* a1 = cA + (size_t)(t + 1) * kstep; const char* b1 = cB + (size_t)(t + 1) * kstepB;
                const char* a2 = last ? nA : cA + (size_t)(t + 2) * kstep; const char* b2 = last ? nB : cB + (size_t)(t + 2) * kstepB;
                const size_t hA2 = last ? nhsA : hsA, hB2 = last ? nhsB : hsB;
                P2_STB(P2_SB(1, 0), b1, 0, hsB); P2_STB(P2_SB(1, 1), b1, 1, hsB); P2_STA(P2_SA(1, 0), a1, 0, hsA); P2_STA(P2_SA(1, 1), a1, 1, hsA);
                P2_LD(0); P2_WAIT_L(0); P2_BAR; P2_SCHED;
                P2_MMA32(0); P2_WAIT_V(0); P2_BAR; P2_SCHED;
                P2_STB(P2_SB(0, 0), b2, 0, hB2); P2_STB(P2_SB(0, 1), b2, 1, hB2); P2_STA(P2_SA(0, 0), a2, 0, hA2); P2_STA(P2_SA(0, 1), a2, 1, hA2);
                P2_LD(1); P2_WAIT_L(0); P2_BAR; P2_SCHED;
                P2_MMA32(1); P2_WAIT_V(0); P2_BAR; P2_SCHED;
            }
            P2_BAR;
        } else {
#pragma unroll 1
            for (int t = 0; t < nt; t += 2) {
                const bool last = (t == nt - 2);
                const char* a1 = cA + (size_t)(t + 1) * kstep; const char* b1 = cB + (size_t)(t + 1) * kstepB;
                const char* a2 = last ? nA : cA + (size_t)(t + 2) * kstep; const char* b2 = last ? nB : cB + (size_t)(t + 2) * kstepB;
                const size_t hA2 = last ? nhsA : hsA, hB2 = last ? nhsB : hsB;
                P2_STB(P2_SB(1, 0), b1, 0, hsB); P2_STB(P2_SB(1, 1), b1, 1, hsB); P2_STA(P2_SA(1, 0), a1, 0, hsA); P2_STA(P2_SA(1, 1), a1, 1, hsA);
                if (t != 0) { P2_MMA32(1); }
                P2_BAR; P2_SCHED;
                P2_LD(0); P2_WAIT_V(0); P2_WAIT_L(0); P2_BAR; P2_SCHED;
                P2_STB(P2_SB(0, 0), b2, 0, hB2); P2_STB(P2_SB(0, 1), b2, 1, hB2); P2_STA(P2_SA(0, 0), a2, 0, hA2); P2_STA(P2_SA(0, 1), a2, 1, hA2);
                P2_MMA32(0); P2_BAR; P2_SCHED;
                P2_LD(1); P2_WAIT_V(0); P2_WAIT_L(0); P2_BAR; P2_SCHED;
            }
            P2_MMA32(1); P2_BAR; P2_SCHED;
        }
        E(acc, cur, wr, wc, fr, fq);
        if (!has_next) break;
#pragma unroll
        for (int a = 0; a < 2; ++a)
#pragma unroll
            for (int b = 0; b < 2; ++b)
#pragma unroll
                for (int m = 0; m < 4; ++m)
#pragma unroll
                    for (int n = 0; n < 2; ++n) acc[a][b][m][n] = (f32x4){0.f, 0.f, 0.f, 0.f};
        cur = nxt; cA = nA; cB = nB; hsA = nhsA; hsB = nhsB; ++ui;
    }
    P2_WAIT_V(0);
    P2_BAR;
#undef P2_SA
#undef P2_SB
#undef P2_STAGE
#undef P2_STA
#undef P2_STB
#undef P2_LDA1
#undef P2_LDA
#undef P2_LDB
#undef P2_MMA4
#undef P2_SCHED
#undef P2_MMA32
#undef P2_LD
#undef P2_WAIT_V
#undef P2_WAIT_L
#undef P2_BAR
}
}
namespace attn_body {
using bf16=__hip_bfloat16;
using bf16x8=__attribute__((ext_vector_type(8)))short;
using s16x4=__attribute__((ext_vector_type(4)))short;
using f32x16=__attribute__((ext_vector_type(16)))float;
using u32x4=__attribute__((ext_vector_type(4)))unsigned;
constexpr int BATCH=4,SEQ=2048,D=64,DM=5632,OPITCH=1024;
constexpr int NW=8,QBLK=32,QB=QBLK*NW,KVBLK=64,NQB=SEQ/QB;
constexpr int ATTN_UNIT_ROWS=QB;
__device__ __forceinline__ int crow(int r,int hi){return (r&3)+8*(r>>2)+4*hi;}
#define SBAR() __builtin_amdgcn_sched_barrier(0)
__device__ __forceinline__ void cmask(f32x16&p0,f32x16&p1,int jb,int qrel,int hi){
  const float NEG=-INFINITY; int kb=64*jb+4*hi;
  #pragma unroll
  for(int r=0;r<16;++r){int kv=kb+(r&3)+8*(r>>2); if(kv>qrel)p0[r]=NEG; if(kv+32>qrel)p1[r]=NEG;}
}

constexpr int NSLOT=3, SLOTB=8192;
constexpr int LDS_K=0, LDS_V=NSLOT*SLOTB, LDS_WS=2*NSLOT*SLOTB, LDS_OST=LDS_WS+NW*64*4, LDS_BYTES=LDS_OST+NW*4096;
constexpr float C2=0.125f*1.4426950408889634f;
__device__ __forceinline__ void glds16(const void*gsrc,unsigned lds_dst){unsigned keep;
  asm volatile("s_mov_b32 %0, m0\n\ts_mov_b32 m0, %2\n\ts_nop 0\n\tglobal_load_lds_dwordx4 %1, off\n\ts_mov_b32 m0, %0":"=&s"(keep):"v"(gsrc),"s"(lds_dst):"memory");}
__device__ __forceinline__ float max3f(float a,float b,float c){float r;asm("v_max3_f32 %0, %1, %2, %3":"=v"(r):"v"(a),"v"(b),"v"(c));return r;}
__device__ __forceinline__ float max2f(float a,float b){float r;asm("v_max_f32_e32 %0, %1, %2":"=v"(r):"v"(a),"v"(b));return r;}
__device__ __forceinline__ float fadd_s(float a,float b){float r;asm("v_add_f32_e32 %0, %1, %2":"=v"(r):"v"(a),"v"(b));return r;}
__device__ __forceinline__ float fsub_s(float a,float b){float r;asm("v_sub_f32_e32 %0, %1, %2":"=v"(r):"v"(a),"v"(b));return r;}
typedef float f32x2_t __attribute__((ext_vector_type(2))); typedef __bf16 bf16x2_t __attribute__((ext_vector_type(2)));
__device__ __forceinline__ unsigned cvtpk_s(float lo,float hi){f32x2_t v={lo,hi};bf16x2_t b=__builtin_convertvector(v,bf16x2_t);return __builtin_bit_cast(unsigned,b);}
#define WAIT_BAR(N) asm volatile("s_waitcnt vmcnt(" #N ") lgkmcnt(0)\n\ts_barrier":::"memory")

__device__ __forceinline__ void qkt(f32x16&p0,f32x16&p1,const char*Kslot,const bf16x8*qr,const f32x16&negm,int r32,int hi){
  const char*kb=Kslot+hi*1024+r32*16;
  #pragma unroll
  for(int d0=0;d0<4;++d0){
    const bf16x8 b0=*reinterpret_cast<const bf16x8*>(kb+d0*2048);
    const bf16x8 b1=*reinterpret_cast<const bf16x8*>(kb+d0*2048+512);
    if(d0==0){p0=__builtin_amdgcn_mfma_f32_32x32x16_bf16(b0,qr[0],negm,0,0,0);p1=__builtin_amdgcn_mfma_f32_32x32x16_bf16(b1,qr[0],negm,0,0,0);}
    else{p0=__builtin_amdgcn_mfma_f32_32x32x16_bf16(b0,qr[d0],p0,0,0,0);p1=__builtin_amdgcn_mfma_f32_32x32x16_bf16(b1,qr[d0],p1,0,0,0);}}
}
typedef __attribute__((address_space(3))) const char* lds_cptr;
typedef short v4i16_t __attribute__((ext_vector_type(4)));
__device__ __forceinline__ void kload8(bf16x8*kf,lds_cptr kp){
  kf[0]=*(const __attribute__((address_space(3))) bf16x8*)(kp);      kf[1]=*(const __attribute__((address_space(3))) bf16x8*)(kp+512);
  kf[2]=*(const __attribute__((address_space(3))) bf16x8*)(kp+2048); kf[3]=*(const __attribute__((address_space(3))) bf16x8*)(kp+2560);
  kf[4]=*(const __attribute__((address_space(3))) bf16x8*)(kp+4096); kf[5]=*(const __attribute__((address_space(3))) bf16x8*)(kp+4608);
  kf[6]=*(const __attribute__((address_space(3))) bf16x8*)(kp+6144); kf[7]=*(const __attribute__((address_space(3))) bf16x8*)(kp+6656);
}
__device__ __forceinline__ void kload2(bf16x8*kf,lds_cptr kp,int j){ kf[2*j]=*(const __attribute__((address_space(3))) bf16x8*)(kp+j*2048); kf[2*j+1]=*(const __attribute__((address_space(3))) bf16x8*)(kp+j*2048+512); }
__device__ __forceinline__ s16x4 vtr(lds_cptr p){ return __builtin_bit_cast(s16x4,__builtin_amdgcn_ds_read_tr16_b64_v4i16((__attribute__((address_space(3))) v4i16_t*)p)); }
__device__ __forceinline__ float rowmax(const f32x16&p0,const f32x16&p1){
  float a=max3f(p0[0],p0[1],p1[0]),b=max3f(p0[2],p0[3],p1[1]);a=max3f(a,p1[2],p1[3]);
  #pragma unroll
  for(int r=4;r<16;r+=4){a=max3f(a,p0[r],p0[r+1]);b=max3f(b,p0[r+2],p0[r+3]);a=max3f(a,p1[r],p1[r+1]);b=max3f(b,p1[r+2],p1[r+3]);}
  const float m=max2f(a,b);
  auto rr=__builtin_amdgcn_permlane32_swap(__float_as_uint(m),__float_as_uint(m),false,false);
  return max2f(__uint_as_float(rr[0]),__uint_as_float(rr[1]));
}
__device__ __forceinline__ void pv(f32x16*o,int vb,bf16x8 pa0,bf16x8 pa1,bf16x8 pa2,bf16x8 pa3){
  #pragma unroll
  for(int d0=0;d0<2;++d0){s16x4 lo[4],hi[4];
    #pragma unroll
    for(int ks=0;ks<4;++ks){
      asm volatile("ds_read_b64_tr_b16 %0,%1 offset:%c2":"=&v"(lo[ks]):"v"(vb),"i"(d0*4096+ks*1024):"memory");
      asm volatile("ds_read_b64_tr_b16 %0,%1 offset:%c2":"=&v"(hi[ks]):"v"(vb),"i"(d0*4096+ks*1024+512):"memory");}
    asm volatile("s_waitcnt lgkmcnt(0)":::"memory");SBAR();
    #define PK(k) (bf16x8){lo[k][0],lo[k][1],lo[k][2],lo[k][3],hi[k][0],hi[k][1],hi[k][2],hi[k][3]}
    o[d0]=__builtin_amdgcn_mfma_f32_32x32x16_bf16(pa0,PK(0),o[d0],0,0,0);
    o[d0]=__builtin_amdgcn_mfma_f32_32x32x16_bf16(pa1,PK(1),o[d0],0,0,0);
    o[d0]=__builtin_amdgcn_mfma_f32_32x32x16_bf16(pa2,PK(2),o[d0],0,0,0);
    o[d0]=__builtin_amdgcn_mfma_f32_32x32x16_bf16(pa3,PK(3),o[d0],0,0,0);
    #undef PK
  }
}

#ifndef ATTN_STORE16
#define ATTN_STORE16(p,v) (*(u32x4*)(p)=(v))
#endif
template<int THRL> __device__ __forceinline__ void attn_unit(int b,int qcol,int vcol,int ocol,int qb,const bf16*Q,const bf16*__restrict__ K,const bf16*__restrict__ V,bf16*O,char*shm,unsigned*qctr,unsigned&ticket){
  const int tid=threadIdx.x,lane=tid&63,r32=lane&31,hi=lane>>5; const int wid=__builtin_amdgcn_readfirstlane(tid>>6);
  const long rowbase=(long)b*SEQ; const int q0=qb*QB;
  const bf16*Qw=Q+(rowbase+q0+wid*QBLK)*DM+qcol;
  const bf16*Kh=K+rowbase*DM+qcol,*Vh=V+rowbase*DM+vcol;
  const unsigned lds0=(unsigned)(uintptr_t)shm;
  float*wsf=(float*)(shm+LDS_WS)+wid*64;
  const bf16*ksrc=Kh+(long)lane*DM+wid*8;
  const bf16*vsrc=Vh+(long)(16*(wid&3)+(lane>>2))*DM+(wid>>2)*32+(lane&3)*8;
  const unsigned kdst=lds0+LDS_K+wid*1024, vdst=lds0+LDS_V+wid*1024;
  #define DMA_K(t,slot) glds16(ksrc+(long)(t)*KVBLK*DM,(unsigned)__builtin_amdgcn_readfirstlane(kdst+(slot)))
  #define DMA_V(t,slot) glds16(vsrc+(long)(t)*KVBLK*DM,(unsigned)__builtin_amdgcn_readfirstlane(vdst+(slot)))
  const int vb0=(int)(lds0+LDS_V)+((lane>>4)&1)*32+(lane&3)*8+(4*hi+((lane&15)>>2))*64;
  const char*Kbase=shm+LDS_K; bf16x8 kf[8];
  const lds_cptr shm3=(lds_cptr)shm; const lds_cptr kp0=shm3+LDS_K+hi*1024+r32*16; const lds_cptr vp0=shm3+LDS_V+((lane>>4)&1)*32+(lane&3)*8+(4*hi+((lane&15)>>2))*64;
  const int NT=(q0+QB)/KVBLK;
  DMA_K(0,0);DMA_V(0,0);DMA_K(1,SLOTB);
  bf16x8 qr[4];
  #pragma unroll
  for(int d0=0;d0<4;++d0)qr[d0]=*reinterpret_cast<const bf16x8*>(&Qw[(long)r32*DM+d0*16+hi*8]);
  float mhat=0.f,l_reg=0.f;f32x16 o[2];o[0]=f32x16{};o[1]=f32x16{};f32x16 negm=f32x16{};asm volatile("":"+v"(negm));
  const int qrel=wid*QBLK+r32;
  #define CMASK(P0,P1,t) do{int jb_=(t)-(NT-4); if(jb_>=0)cmask(P0,P1,jb_,qrel,hi);}while(0)
  bool resc=false;
  #define START(P0,P1) do{ const float rm=rowmax(P0,P1); resc=false; \
    { const float dl=rm; mhat=fadd_s(mhat,dl); \
      _Pragma("unroll") for(int r=0;r<16;++r){P0[r]=fsub_s(P0[r],dl);P1[r]=fsub_s(P1[r],dl);} \
      _Pragma("unroll") for(int r=0;r<16;++r)negm[r]=-mhat; asm volatile("":"+v"(negm)); } \
    _Pragma("unroll") for(int r=0;r<16;++r)P0[r]=__builtin_amdgcn_exp2f(P0[r]); }while(0)
  #define RESC() do{ if(resc){ asm volatile("s_waitcnt lgkmcnt(0)":::"memory"); \
      _Pragma("unroll") for(int d_=0;d_<2;++d_) _Pragma("unroll") for(int r=0;r<16;++r)o[d_][r]*=wsf[crow(r,hi)]; } }while(0)
  f32x16 pA0,pA1,pB0,pB1;
  int sl_prev=0,sl_cur=0,sl_next=SLOTB;
  #define ROT() do{sl_prev=sl_cur;sl_cur=sl_next;sl_next=(sl_next==(NSLOT-1)*SLOTB)?0:sl_next+SLOTB;}while(0)
  DMA_K(2,2*SLOTB);
  WAIT_BAR(3);
  qkt(pA0,pA1,Kbase,qr,negm,r32,hi);asm volatile("s_nop 15\n\ts_nop 7":"+v"(pA0),"+v"(pA1));CMASK(pA0,pA1,0);
  START(pA0,pA1);
  _Pragma("unroll") for(int r=0;r<16;++r)pA1[r]=__builtin_amdgcn_exp2f(pA1[r]);
  WAIT_BAR(0);
  DMA_K(3,0);DMA_V(1,SLOTB);
  ROT();
  kload8(kf,kp0+sl_cur);
  WAIT_BAR(2);
  s16x4 vlo[8],vhi[8]; u32x4 pw0,pw1,pw2,pw3;
  #define PKW(P,B) cvtpk_s(P[B],P[B+1])
  #define PAF(k) __builtin_bit_cast(bf16x8,pw##k)
  #define VFR(i) (bf16x8){vlo[i][0],vlo[i][1],vlo[i][2],vlo[i][3],vhi[i][0],vhi[i][1],vhi[i][2],vhi[i][3]}
  #define PIN(x) asm volatile("":"+v"(x))
  #define MX3(a,b,c) __builtin_fmaxf(__builtin_fmaxf((a),(b)),(c))
  #define GAPA(MF,A0,A1,A2,A3,W0,W1,PW) do{ MF; sacc+=A0; sacc+=A1; sacc+=A2; sacc+=A3; PIN(sacc); W0; W1; PIN(PW); SBAR(); }while(0)
  #define EX(v) __builtin_amdgcn_exp2f(v)
  #define GAPB(MF,X,B) do{ MF; X[B]=EX(X[B]); X[B+1]=EX(X[B+1]); X[B+2]=EX(X[B+2]); X[B+3]=EX(X[B+3]); PIN(X); SBAR(); }while(0)
  #define VRD(i) do{ vlo[i]=vtr(vp_+(((i)>>2)*4096+((i)&3)*1024)); vhi[i]=vtr(vp_+(((i)>>2)*4096+((i)&3)*1024+512)); }while(0)
  #define KRD(G,j) do{ if(G){ kload2(kf,kp0+sl_next,j); SBAR(); } }while(0)
  #define STEP(C0,C1,P0,P1,t,GK,GV,GL) do{ SBAR(); \
    const lds_cptr vp_=vp0+sl_prev; \
    VRD(0); SBAR(); float sacc=(P0[0]+P0[1]); \
    GAPA(C0=__builtin_amdgcn_mfma_f32_32x32x16_bf16(kf[0],qr[0],negm,0,0,0), P0[2],P0[3],P0[4],P0[5],     pw0[0]=PKW(P0,0), pw0[1]=PKW(P0,2), pw0); \
    VRD(4); SBAR(); GAPA(C1=__builtin_amdgcn_mfma_f32_32x32x16_bf16(kf[1],qr[0],negm,0,0,0), P0[6],P0[7],P0[8],P0[9],     pw0[2]=PKW(P0,4), pw0[3]=PKW(P0,6), pw0); \
    VRD(1); SBAR(); GAPA(C0=__builtin_amdgcn_mfma_f32_32x32x16_bf16(kf[2],qr[1],C0,0,0,0),   P0[10],P0[11],P0[12],P0[13], pw1[0]=PKW(P0,8), pw1[1]=PKW(P0,10), pw1); \
    VRD(5); SBAR(); GAPA(C1=__builtin_amdgcn_mfma_f32_32x32x16_bf16(kf[3],qr[1],C1,0,0,0),   P0[14],P0[15],P1[0],P1[1],   pw1[2]=PKW(P0,12),pw1[3]=PKW(P0,14), pw1); \
    VRD(2); SBAR(); GAPA(C0=__builtin_amdgcn_mfma_f32_32x32x16_bf16(kf[4],qr[2],C0,0,0,0),   P1[2],P1[3],P1[4],P1[5],     pw2[0]=PKW(P1,0), pw2[1]=PKW(P1,2), pw2); \
    VRD(6); SBAR(); GAPA(C1=__builtin_amdgcn_mfma_f32_32x32x16_bf16(kf[5],qr[2],C1,0,0,0),   P1[6],P1[7],P1[8],P1[9],     pw2[2]=PKW(P1,4), pw2[3]=PKW(P1,6), pw2); \
    VRD(3); SBAR(); GAPA(C0=__builtin_amdgcn_mfma_f32_32x32x16_bf16(kf[6],qr[3],C0,0,0,0),   P1[10],P1[11],P1[12],P1[13], pw3[0]=PKW(P1,8), pw3[1]=PKW(P1,10), pw3); \
    VRD(7); SBAR(); GAPA(C1=__builtin_amdgcn_mfma_f32_32x32x16_bf16(kf[7],qr[3],C1,0,0,0),   P1[14],P1[15],0.f,0.f,       pw3[2]=PKW(P1,12),pw3[3]=PKW(P1,14), pw3); \
    l_reg+=sacc; \
    if(GK){DMA_K((t)+3,sl_cur);} if(GV){DMA_V((t)+1,sl_next);} \
    CMASK(C0,C1,t); \
    { float a=MX3(C0[0],C0[1],C1[0]),b=MX3(C0[2],C0[3],C1[1]); a=MX3(a,C1[2],C1[3]); \
      _Pragma("unroll") for(int r=4;r<16;r+=4){a=MX3(a,C0[r],C0[r+1]);b=MX3(b,C0[r+2],C0[r+3]);a=MX3(a,C1[r],C1[r+1]);b=MX3(b,C1[r+2],C1[r+3]);} \
      float rm=__builtin_fmaxf(a,b); { auto rr=__builtin_amdgcn_permlane32_swap(__float_as_uint(rm),__float_as_uint(rm),false,false); rm=__builtin_fmaxf(__uint_as_float(rr[0]),__uint_as_float(rr[1])); } \
      resc=false; \
      if(__builtin_expect(__any(rm>(float)THRL),0)){ const float dl=__builtin_fmaxf(rm,0.f); mhat+=dl; \
        _Pragma("unroll") for(int r=0;r<16;++r){C0[r]-=dl;C1[r]-=dl;} \
        _Pragma("unroll") for(int r=0;r<16;++r)negm[r]=-mhat; asm volatile("":"+v"(negm)); \
        const float f=__builtin_amdgcn_exp2f(-dl); l_reg*=f; if(hi==0)wsf[r32]=f; resc=true; } } \
    SBAR(); \
    GAPB(o[0]=__builtin_amdgcn_mfma_f32_32x32x16_bf16(PAF(0),VFR(0),o[0],0,0,0), C0,0); \
    GAPB(o[1]=__builtin_amdgcn_mfma_f32_32x32x16_bf16(PAF(0),VFR(4),o[1],0,0,0), C0,4); \
    KRD(GL,0); GAPB(o[0]=__builtin_amdgcn_mfma_f32_32x32x16_bf16(PAF(1),VFR(1),o[0],0,0,0), C0,8); \
    KRD(GL,1); GAPB(o[1]=__builtin_amdgcn_mfma_f32_32x32x16_bf16(PAF(1),VFR(5),o[1],0,0,0), C0,12); \
    KRD(GL,2); GAPB(o[0]=__builtin_amdgcn_mfma_f32_32x32x16_bf16(PAF(2),VFR(2),o[0],0,0,0), C1,0); \
    KRD(GL,3); GAPB(o[1]=__builtin_amdgcn_mfma_f32_32x32x16_bf16(PAF(2),VFR(6),o[1],0,0,0), C1,4); \
    GAPB(o[0]=__builtin_amdgcn_mfma_f32_32x32x16_bf16(PAF(3),VFR(3),o[0],0,0,0), C1,8); \
    GAPB(o[1]=__builtin_amdgcn_mfma_f32_32x32x16_bf16(PAF(3),VFR(7),o[1],0,0,0), C1,12); \
    }while(0)
  int t=1;
  #undef CMASK
  #define CMASK(P0,P1,t) do{}while(0)
  for(;t+5<NT;t+=2){
    STEP(pB0,pB1,pA0,pA1,t,true,true,true);     WAIT_BAR(2); RESC(); ROT();
    STEP(pA0,pA1,pB0,pB1,t+1,true,true,true);   WAIT_BAR(2); RESC(); ROT();
  }
  #undef CMASK
  #define CMASK(P0,P1,t) do{int jb_=(t)-(NT-4); if(jb_>=0)cmask(P0,P1,jb_,qrel,hi);}while(0)
  #define ENDW(tt) do{ if((tt)+3<NT){WAIT_BAR(2);} else if((tt)+2<NT){WAIT_BAR(1);} else {WAIT_BAR(0);} }while(0)
  for(;t+1<NT;t+=2){
    STEP(pB0,pB1,pA0,pA1,t,(t+3<NT),(t+1<NT),(t+1<NT));       ENDW(t);   RESC(); ROT();
    STEP(pA0,pA1,pB0,pB1,t+1,(t+4<NT),(t+2<NT),(t+2<NT));     ENDW(t+1); RESC(); ROT();
  }
  STEP(pB0,pB1,pA0,pA1,NT-1,false,false,false); RESC();
  { float sacc=pB0[0]+pB0[1]; _Pragma("unroll") for(int r=2;r<16;++r)sacc+=pB0[r]; _Pragma("unroll") for(int r=0;r<16;++r)sacc+=pB1[r]; l_reg+=sacc;
    pw0=(u32x4){PKW(pB0,0),PKW(pB0,2),PKW(pB0,4),PKW(pB0,6)};pw1=(u32x4){PKW(pB0,8),PKW(pB0,10),PKW(pB0,12),PKW(pB0,14)};pw2=(u32x4){PKW(pB1,0),PKW(pB1,2),PKW(pB1,4),PKW(pB1,6)};pw3=(u32x4){PKW(pB1,8),PKW(pB1,10),PKW(pB1,12),PKW(pB1,14)};
    SBAR(); pv(o,vb0+sl_cur,PAF(0),PAF(1),PAF(2),PAF(3)); }
  #undef PKW
  #undef PAF
  #undef VFR
  #undef PIN
  #undef MX3
  #undef GAPA
  #undef GAPB
  #undef EX
  #undef VRD
  #undef KRD
  #undef STEP
  #undef ENDW
  if(threadIdx.x==0){unsigned z_=0u;asm volatile("":"+v"(z_));ticket=__hip_atomic_fetch_add(qctr+z_,1u,__ATOMIC_RELAXED,__HIP_MEMORY_SCOPE_AGENT);}
  {auto rr=__builtin_amdgcn_permlane32_swap(__float_as_uint(l_reg),__float_as_uint(l_reg),false,false);l_reg=__uint_as_float(rr[0])+__uint_as_float(rr[1]);}
  if(hi==0)wsf[32+r32]=l_reg;asm volatile("s_waitcnt lgkmcnt(0)":::"memory");
  float rli[16];
  #pragma unroll
  for(int r=0;r<16;++r)rli[r]=__builtin_amdgcn_rcpf(wsf[32+crow(r,hi)]);
  bf16*Ow=O+(rowbase+q0+wid*QBLK)*OPITCH+ocol;
  { bf16*stg=(bf16*)(shm+LDS_OST)+wid*2048;
    #pragma unroll
    for(int r=0;r<16;++r){const int orow=crow(r,hi);
      #pragma unroll
      for(int d0=0;d0<2;++d0)stg[orow*64+d0*32+r32]=__float2bfloat16(o[d0][r]*rli[r]);}
    asm volatile("s_waitcnt lgkmcnt(0)":::"memory");
    #pragma unroll
    for(int i=0;i<4;++i){const int row=i*8+(lane>>3),ch=lane&7; const u32x4 v=*(const u32x4*)(stg+row*64+ch*8); ATTN_STORE16(Ow+(long)row*OPITCH+ch*8,v);} }
  asm volatile("s_waitcnt lgkmcnt(0)\n\ts_barrier":::"memory");
  #undef DMA_K
  #undef DMA_V
  #undef CMASK
  #undef START
  #undef RESC
  #undef ROT
}
constexpr int ATTN_LDS_BYTES=LDS_BYTES;
#undef SBAR
#undef WAIT_BAR
}
constexpr size_t MiB = 1u << 20;
constexpr size_t WS_CTL = 0, CTL_ZERO_BYTES = 1 * MiB;
constexpr size_t WS_WIN = 2 * MiB, WS_WOUT = 26 * MiB, WS_WQ = 34 * MiB, WS_WKV = 42 * MiB, WS_WO = 58 * MiB, WS_W1 = 66 * MiB, WS_W2 = 578 * MiB;
constexpr size_t WS_HN = 834 * MiB, WS_MN = 866 * MiB, WS_PROJ = 870 * MiB, WS_DT = 958 * MiB, WS_KVRAW = 959 * MiB, WS_KN = 967 * MiB;
constexpr size_t WS_YCAT = 971 * MiB, WS_O0 = 1003 * MiB, WS_O1 = 1019 * MiB, WS_H1 = 1035 * MiB, WS_H1B = 1099 * MiB, WS_PART1 = 1131 * MiB, WS_PARTQ = 1132 * MiB;
constexpr size_t WS_QRAW = 1133 * MiB, WS_P = 1165 * MiB, WS_VWT = 1181 * MiB, WS_H2 = 1197 * MiB, WS_HN3 = 1261 * MiB;
constexpr size_t WS_TOKOF = 1293 * MiB, WS_GATEOF = 1294 * MiB, WS_TOKE = 1295 * MiB, WS_TOKR = 1296 * MiB, WS_YG = 1297 * MiB;
constexpr size_t WS_H1F8 = 3368 * MiB  , WS_QF8 = 3384 * MiB  , WS_KN8 = 3400 * MiB  , WS_VF8 = 3402 * MiB  ;
constexpr size_t WS_P8 = 3404 * MiB  , WS_VWT8 = 3412 * MiB  ;
constexpr size_t WS_XG = 1320 * MiB  , WS_ACT = 1832 * MiB  , WS_Y = 2344 * MiB  , WS_END = 3420 * MiB;
constexpr int CW_BAR = 4096;
constexpr int CW_QCONV2 = 12416;
constexpr int CW_QCONV = 12352;
constexpr int CW_QATT = 12288;
constexpr int CW_CNT = 8192;
static_assert((CW_CNT + 64 * 32) * 4 <= (int)CTL_ZERO_BYTES, "CTL words inside the memset region");

constexpr int RING_OFF = 0, RING_BYTES = 131072;
constexpr int LDS_BYTES = 163840;
constexpr int MISC_OFF = 163840 - 1024;
constexpr int NWAVES = 8;

#define XB_TMO      128
#define XB_XCNT(j)  (256  + 64 * (j))
#define XB_XSUB(j)  (1280 + 64 * (j))
#define XB_XGEN(j)  (2304 + 64 * (j))
#define XB_TOP      3328
#define XB_TOPGEN   3392
#define XCD_BAR_WORDS 3456
#define XB_SPIN_CAP (1u << 20)

__device__ __forceinline__ unsigned xb_ld(unsigned* p)              { return __hip_atomic_load(p, __ATOMIC_RELAXED, __HIP_MEMORY_SCOPE_AGENT); }
__device__ __forceinline__ unsigned xb_add(unsigned* p, unsigned v) { return __hip_atomic_fetch_add(p, v, __ATOMIC_RELAXED, __HIP_MEMORY_SCOPE_AGENT); }
__device__ __forceinline__ unsigned xb_xcc_id() { return (unsigned)__builtin_amdgcn_s_getreg((3 << 11) | 20) & 0xFu; }
#define XB_SPIN(cond, bar) do { unsigned _sp = 0; while (cond) { __builtin_amdgcn_s_sleep(1); \
    if ((++_sp & 255u) == 0u) { if (xb_ld(&(bar)[XB_TMO])) break; if (_sp > XB_SPIN_CAP) { atomicAdd(&(bar)[XB_TMO], 1u); break; } } } } while (0)

struct XcdBarrier {
    unsigned* bar; unsigned x;
    volatile LAS unsigned* st;
};
__device__ __forceinline__ XcdBarrier xcd_barrier_post(unsigned* bar, volatile LAS unsigned* st) {
    XcdBarrier b; b.bar = bar; b.x = xb_xcc_id(); b.st = st;
    if (threadIdx.x == 0) (void)xb_add(&bar[XB_XCNT(b.x)], 1u);
    return b;
}
__device__ __forceinline__ void xcd_barrier_complete(unsigned* bar, unsigned x, unsigned& nloc, unsigned& nx) {
    const unsigned G = gridDim.x * gridDim.y * gridDim.z;
    unsigned sum, cnt, mine, sp = 0u;
    for (;;) {
        sum = 0u; cnt = 0u; mine = 0u;
#pragma unroll
        for (unsigned j = 0; j < 16; ++j) { const unsigned c = xb_ld(&bar[XB_XCNT(j)]); sum += c; cnt += (c > 0u) ? 1u : 0u; mine = (j == x) ? c : mine; }
        if (sum == G) break;
        __builtin_amdgcn_s_sleep(1);
        if ((++sp & 255u) == 0u) { if (xb_ld(&bar[XB_TMO])) break; if (sp > XB_SPIN_CAP) { atomicAdd(&bar[XB_TMO], 1u); break; } }
    }
    nloc = mine > 0u ? mine : 1u; nx = cnt > 0u ? cnt : 1u;
}
__device__ __forceinline__ void xcd_barrier(const XcdBarrier& b) {
    asm volatile("s_waitcnt vmcnt(0)" ::: "memory");
    __syncthreads();
    if (threadIdx.x == 0) {
        unsigned* bar = b.bar;
        __builtin_amdgcn_s_waitcnt(0);
        unsigned nloc = b.st[0], nx = b.st[1];
        if (nloc == 0u) { xcd_barrier_complete(bar, b.x, nloc, nx); b.st[0] = nloc; b.st[1] = nx; }
        const unsigned old = xb_add(&bar[XB_XSUB(b.x)], 1u);
        const unsigned gen = old / nloc;
        if (old + 1u == (gen + 1u) * nloc) {
            __builtin_amdgcn_fence(__ATOMIC_RELEASE, "agent");
            asm volatile("s_waitcnt vmcnt(0)" ::: "memory");
            const unsigned og = xb_add(&bar[XB_TOP], 1u);
            const unsigned tg = og / nx;
            if (og + 1u == (tg + 1u) * nx) xb_add(&bar[XB_TOPGEN], 1u);
            else XB_SPIN(xb_ld(&bar[XB_TOPGEN]) == tg, bar);
            __builtin_amdgcn_fence(__ATOMIC_ACQUIRE, "agent");
            xb_add(&bar[XB_XGEN(b.x)], 1u);
            asm volatile("s_waitcnt vmcnt(0)" ::: "memory");
        } else {
            XB_SPIN(xb_ld(&bar[XB_XGEN(b.x)]) == gen, bar);
            __builtin_amdgcn_fence(__ATOMIC_ACQUIRE, "agent");
            asm volatile("s_waitcnt vmcnt(0)" ::: "memory");
        }
    }
    __syncthreads();
}

struct Args { const float* in[32]; float* out; unsigned char* ws; int ph_lo, ph_hi, probe, pad_; };
enum In { I_X = 0, I_MEM, I_GMIX, I_WIN, I_CONVW, I_CONVB, I_DTB, I_ALOG, I_DSKIP, I_SSDG, I_DAQG, I_DAKG, I_LQ1, I_LK1, I_LQ2, I_LK2, I_SUBG, I_WOUT, I_GXA, I_GMEM,
          I_WQ, I_WKV, I_XQG, I_XKG, I_WO, I_GFFN, I_RW, I_RB, I_W1, I_B1, I_W2, I_B2 };

struct ArgP {
    typedef const __attribute__((address_space(4))) char* kptr;
    DI const float* in(int i) const { kptr kp = (kptr)__builtin_amdgcn_kernarg_segment_ptr(); asm volatile("" : "+s"(kp)); return *(const float* const __attribute__((address_space(4)))*)(kp + 8 * i); }
    DI float* out() const { kptr kp = (kptr)__builtin_amdgcn_kernarg_segment_ptr(); asm volatile("" : "+s"(kp)); return *(float* const __attribute__((address_space(4)))*)(kp + 8 * 32); }
};
struct Frame {
    LAS unsigned char* lds;
    volatile LAS unsigned* MISC;
    unsigned* ctl;
    unsigned char* ws;
    int tid, lane, wave, vcu, G;
};

template <class DestRow>
DI void tr_item(const float* W, size_t ldw, int k0, int ncol0, int nvalid, const float* kscale, bf16_t* WT, int K, DestRow dr, LAS float* scr, int lane) {
    const int c = lane & 31;
#pragma unroll 8
    for (int i = 0; i < 32; ++i) { const int kk = 2 * i + (lane >> 5);
        float v = (c < nvalid) ? W[(size_t)(k0 + kk) * ldw + ncol0 + c] : 0.f;
        if (kscale) v *= kscale[k0 + kk];
        scr[kk * 33 + c] = v; }
    asm volatile("s_waitcnt lgkmcnt(0)" ::: "memory");
    const int c8 = lane & 7;
#pragma unroll
    for (int j = 0; j < 4; ++j) { const int n = (lane >> 3) + 8 * j; const LAS float* s = scr + (8 * c8) * 33 + n;
        u32x4 o; o.x = pk2(s[0 * 33], s[1 * 33]); o.y = pk2(s[2 * 33], s[3 * 33]); o.z = pk2(s[4 * 33], s[5 * 33]); o.w = pk2(s[6 * 33], s[7 * 33]);
        if (n < nvalid) *(u32x4*)(WT + (size_t)dr(ncol0 + n) * K + k0 + 8 * c8) = o; }
    asm volatile("s_waitcnt lgkmcnt(0)" ::: "memory");
}
template <class DestRow>
DI void tr_item_fp8(const float* W, size_t ldw, int k0, int ncol0, const float* kscale, unsigned char* WT, int K, DestRow dr, LAS float* scr, int lane) {
    const int c = lane & 31;
#pragma unroll 8
    for (int i = 0; i < 32; ++i) { const int kk = 2 * i + (lane >> 5); float v = W[(size_t)(k0 + kk) * ldw + ncol0 + c]; if (kscale) v *= kscale[k0 + kk]; scr[kk * 33 + c] = v; }
    asm volatile("s_waitcnt lgkmcnt(0)" ::: "memory");
    const int n = lane >> 1, hf = lane & 1; const LAS float* s = scr + (32 * hf) * 33 + n;
    unsigned w[8];
#pragma unroll
    for (int j = 0; j < 8; ++j) { unsigned x = 0u;
        x = __builtin_amdgcn_cvt_pk_fp8_f32(s[(4 * j) * 33] * 64.f, s[(4 * j + 1) * 33] * 64.f, x, false);
        x = __builtin_amdgcn_cvt_pk_fp8_f32(s[(4 * j + 2) * 33] * 64.f, s[(4 * j + 3) * 33] * 64.f, x, true); w[j] = x; }
    unsigned char* op = WT + (size_t)dr(ncol0 + n) * K + k0 + 32 * hf;
    *(u32x4*)op = (u32x4){w[0], w[1], w[2], w[3]}; *(u32x4*)(op + 16) = (u32x4){w[4], w[5], w[6], w[7]};
    asm volatile("s_waitcnt lgkmcnt(0)" ::: "memory");
}
DI int tileperm(int col) { const int o = col & 255; return (col & ~255) + 128 * ((o & 63) >> 5) + 32 * (o >> 6) + (o & 31); }
struct DrIdent { DI int operator()(int n) const { return n; } };
struct DrTile  { DI int operator()(int n) const { return tileperm(n); } };
struct DrWin   { DI int operator()(int n) const { const int pc = (n < 2560) ? n : (n < 2576 ? PC_DT + (n - 2560) : n - 16); return tileperm(pc); } };
struct DrW1    { DI int operator()(int n) const { const int half = n >> 11, j = n & 2047; return (j >> 7) * 256 + half * 128 + (j & 127); } };

template <bool FP8, class DestRow>
DI void cv_item(const float* W, size_t ldw, int k0, int ncol0, const float* kscale, float scale, void* WT, int kpitch, DestRow dr, LAS float* scr, int lane) {
    const int r = lane >> 3, c4 = (lane & 7) * 4;
    f32x4 v[16];
#pragma unroll
    for (int i = 0; i < 16; ++i) v[i] = *(const f32x4*)(W + (size_t)(k0 + 8 * i + r) * ldw + ncol0 + c4);
#pragma unroll
    for (int i = 0; i < 16; ++i) { f32x4 x = v[i] * scale; if (kscale) x = x * kscale[k0 + 8 * i + r]; *(LAS f32x4*)(scr + (8 * i + r) * 36 + c4) = x; }
    asm volatile("s_waitcnt lgkmcnt(0)" ::: "memory");
    const int n = lane & 31, hf = lane >> 5; const LAS float* s = scr + (64 * hf) * 36 + n;
    if constexpr (FP8) {
        unsigned w[16];
#pragma unroll
        for (int j = 0; j < 16; ++j) { unsigned x = 0u; x = __builtin_amdgcn_cvt_pk_fp8_f32(s[(4 * j) * 36], s[(4 * j + 1) * 36], x, false); x = __builtin_amdgcn_cvt_pk_fp8_f32(s[(4 * j + 2) * 36], s[(4 * j + 3) * 36], x, true); w[j] = x; }
        unsigned char* op = (unsigned char*)WT + (size_t)dr(ncol0 + n) * kpitch + k0 + 64 * hf;
#pragma unroll
        for (int j = 0; j < 4; ++j) *(u32x4*)(op + 16 * j) = (u32x4){w[4 * j], w[4 * j + 1], w[4 * j + 2], w[4 * j + 3]};
    } else {
        unsigned w[32];
#pragma unroll
        for (int j = 0; j < 32; ++j) w[j] = pk2(s[(2 * j) * 36], s[(2 * j + 1) * 36]);
        unsigned char* op = (unsigned char*)WT + (size_t)dr(ncol0 + n) * kpitch + (k0 + 64 * hf) * 2;
#pragma unroll
        for (int j = 0; j < 8; ++j) *(u32x4*)(op + 16 * j) = (u32x4){w[4 * j], w[4 * j + 1], w[4 * j + 2], w[4 * j + 3]};
    }
    asm volatile("s_waitcnt lgkmcnt(0)" ::: "memory");
}
DI void rms_row_to_bf16(const float* xrow, const float* g, bf16_t* orow, int lane) {
    const f32x4* xr = (const f32x4*)xrow + lane;
    f32x4 v[8]; float s = 0.f;
#pragma unroll
    for (int j = 0; j < 8; ++j) { v[j] = xr[64 * j]; s += (v[j].x * v[j].x + v[j].y * v[j].y) + (v[j].z * v[j].z + v[j].w * v[j].w); }
    const float rstd = 1.f / sqrtf(wave_sum(s) * (1.f / 2048.f) + EPS_);
    u32x2* o8 = (u32x2*)orow + lane;
#pragma unroll
    for (int j = 0; j < 8; ++j) { const f32x4 gg = ((const f32x4*)g)[lane + 64 * j];
        u32x2 o; o.x = pk2(v[j].x * rstd * gg.x, v[j].y * rstd * gg.y); o.y = pk2(v[j].z * rstd * gg.z, v[j].w * rstd * gg.w); o8[64 * j] = o; }
}

DI void p0_prologue(Frame& F, const ArgP& a) {
    LAS float* scr = (LAS float*)(F.lds + RING_OFF + F.wave * 16384);
    const int gw = F.vcu * NWAVES + F.wave, NGW = F.G * NWAVES;
    unsigned char* ws = F.ws;
    constexpr int I_A = 32 * 80, I_B = 32, I_C = 32 * 96, NITEMS = I_A + I_B + I_C;
    for (int it = gw; it < NITEMS; it += NGW) {
        int r = it;
        if (r < I_A) { tr_item(a.in(I_WIN), 5648, 64 * (r / 80), 32 * (r % 80), 32, nullptr, (bf16_t*)(ws + WS_WIN), 2048, DrWin(), scr, F.lane); continue; } r -= I_A;
        if (r < I_B) { tr_item(a.in(I_WIN), 5648, 64 * r, 2560, 16, nullptr, (bf16_t*)(ws + WS_WIN), 2048, DrWin(), scr, F.lane); continue; } r -= I_B;
        tr_item(a.in(I_WIN), 5648, 64 * (r / 96), 2576 + 32 * (r % 96), 32, nullptr, (bf16_t*)(ws + WS_WIN), 2048, DrWin(), scr, F.lane);
    }
    for (int m = gw; m < NTOK; m += NGW) rms_row_to_bf16(a.in(I_X) + (size_t)m * 2048, a.in(I_GMIX), (bf16_t*)(ws + WS_HN) + (size_t)m * 2048, F.lane);
    for (int m = gw; m < NB * MEMLEN; m += NGW) rms_row_to_bf16(a.in(I_MEM) + (size_t)m * 2048, a.in(I_GMEM), (bf16_t*)(ws + WS_MN) + (size_t)m * 2048, F.lane);
}
struct CvIt { const float* W; size_t ldw; const float* ks; unsigned char* WT; float scale; int k0, n0, kpitch, fp8, dr, tiled; };
DI CvIt cv_decode(int it, const ArgP& a, unsigned char* ws) {
    constexpr int J_WOUT = 16 * 64, J_WKV = 16 * 128, J_WQ = 16 * 64, J_WO = 16 * 64, J_W1 = 32 * 16 * 128;
    CvIt c; c.ks = nullptr; c.scale = 64.f; c.fp8 = 1; c.dr = 0; c.kpitch = 2048; c.ldw = 2048; c.tiled = 0;
    int r = it;
    if (r < J_WOUT) { c.W = a.in(I_WOUT); c.k0 = 128 * (r / 64); c.n0 = 32 * (r % 64); c.WT = ws + WS_WOUT; c.scale = 1.f; c.fp8 = 0; c.kpitch = 4096; return c; } r -= J_WOUT;
    if (r < J_WKV) { c.W = a.in(I_WKV); c.ldw = 4096; c.k0 = 128 * (r / 128); c.n0 = 32 * (r % 128); c.WT = ws + WS_WKV; c.scale = 1.f; c.fp8 = 0; c.kpitch = 4096; c.dr = 1; return c; } r -= J_WKV;
    if (r < J_WQ) { c.W = a.in(I_WQ); c.ks = a.in(I_GXA); c.k0 = 128 * (r / 64); c.n0 = 32 * (r % 64); c.WT = ws + WS_WQ; return c; } r -= J_WQ;
    if (r < J_WO) { c.W = a.in(I_WO); c.k0 = 128 * (r / 64); c.n0 = 32 * (r % 64); c.WT = ws + WS_WO; return c; } r -= J_WO;
    if (r < J_W1) { const int e = r / (16 * 128), q = r % (16 * 128); c.W = a.in(I_W1) + (size_t)e * 2048 * 4096; c.ldw = 4096; c.k0 = 128 * (q / 128); c.n0 = 32 * (q % 128); c.WT = ws + WS_W1 + (size_t)e * 4096 * 2048; c.dr = 2; c.tiled = 1; return c; } r -= J_W1;
    { const int e = r / (16 * 64), q = r % (16 * 64); c.W = a.in(I_W2) + (size_t)e * 2048 * 2048; c.k0 = 128 * (q / 64); c.n0 = 32 * (q % 64); c.WT = ws + WS_W2 + (size_t)e * 2048 * 2048; c.tiled = 1; }
    return c;
}
constexpr int CV_NJ = 16 * 64 * 3 + 16 * 128 + 32 * 16 * 128 + 32 * 16 * 64;
constexpr int CV_TAIL2 = 12288;
constexpr int CV_TAIL1 = 20480;
constexpr int CV_TAIL = CV_TAIL1 + CV_TAIL2;
DI void conv_share(Frame& F, const ArgP& a) {
    LAS float* scr = (LAS float*)(F.lds + F.wave * 16384);
    const unsigned sbase = (unsigned)__builtin_amdgcn_readfirstlane((int)((unsigned)(uintptr_t)F.lds + (unsigned)F.wave * 16384u));
    const int gw = F.vcu * NWAVES + F.wave, NGW = F.G * NWAVES, lane = F.lane;
    unsigned char* ws = F.ws;
    constexpr int NJ = CV_NJ - CV_TAIL;
    const int n = lane & 31, hf = lane >> 5;
    for (int it = gw; it < NJ; it += NGW) {
        const CvIt cur = cv_decode(it, a, ws);
        const char* gb = (const char*)(cur.W + (size_t)cur.k0 * cur.ldw + cur.n0);
        const unsigned vo0 = (unsigned)(((size_t)(lane >> 3) * cur.ldw + (size_t)(lane & 7) * 4) * 4), vstep = (unsigned)(8 * cur.ldw * 4);
#pragma unroll
        for (int p = 0; p < 16; ++p) { unsigned keep_;
            asm volatile("s_mov_b32 %0, m0\n\ts_mov_b32 m0, %3\n\ts_nop 0\n\tglobal_load_lds_dwordx4 %1, %2 nt\n\ts_mov_b32 m0, %0"
                         : "=&s"(keep_) : "v"(vo0 + (unsigned)p * vstep), "s"(gb), "s"(sbase + (unsigned)p * 1024u) : "memory"); }
        asm volatile("s_waitcnt vmcnt(0)" ::: "memory");
        const LAS float* s = scr + (64 * hf) * 32 + n;
        const int col = cur.n0 + n; const int drow = (cur.dr == 0) ? col : (cur.dr == 1 ? tileperm(col) : DrW1()(col));
        const float* ksp = cur.ks ? cur.ks + cur.k0 + 64 * hf : nullptr;
        if (cur.fp8) {
            unsigned w[16];
#pragma unroll
            for (int j = 0; j < 16; ++j) { float x0 = s[(4 * j) * 32] * cur.scale, x1 = s[(4 * j + 1) * 32] * cur.scale, x2 = s[(4 * j + 2) * 32] * cur.scale, x3 = s[(4 * j + 3) * 32] * cur.scale;
                if (ksp) { x0 *= ksp[4 * j]; x1 *= ksp[4 * j + 1]; x2 *= ksp[4 * j + 2]; x3 *= ksp[4 * j + 3]; }
                unsigned x = 0u; x = __builtin_amdgcn_cvt_pk_fp8_f32(x0, x1, x, false); x = __builtin_amdgcn_cvt_pk_fp8_f32(x2, x3, x, true); w[j] = x; }
            unsigned char* op = cur.tiled ? cur.WT + ((size_t)(((drow >> 8) * 16 + (cur.k0 >> 7)) * 256 + (drow & 255))) * 128 + 64 * hf : cur.WT + (size_t)drow * cur.kpitch + cur.k0 + 64 * hf;
#pragma unroll
            for (int j = 0; j < 4; ++j) *(u32x4*)(op + 16 * j) = (u32x4){w[4 * j], w[4 * j + 1], w[4 * j + 2], w[4 * j + 3]};
        } else {
            unsigned w[32];
#pragma unroll
            for (int j = 0; j < 32; ++j) w[j] = pk2(s[(2 * j) * 32] * cur.scale, s[(2 * j + 1) * 32] * cur.scale);
            unsigned char* op = cur.WT + (size_t)drow * cur.kpitch + (cur.k0 + 64 * hf) * 2;
#pragma unroll
            for (int j = 0; j < 8; ++j) *(u32x4*)(op + 16 * j) = (u32x4){w[4 * j], w[4 * j + 1], w[4 * j + 2], w[4 * j + 3]};
        }
        asm volatile("s_waitcnt lgkmcnt(0)" ::: "memory");
    }
}

DI void conv_queue(Frame& F, const ArgP& a, int qword, int first, int count) {
    LAS float* scr = (LAS float*)(F.lds + F.wave * 18432);
    unsigned char* ws = F.ws;
    const int lane = threadIdx.x & 63, r = lane >> 3, c4 = (lane & 7) * 4, n = lane & 31, hf = lane >> 5;
    for (;;) {
        if (threadIdx.x == 0) F.MISC[121] = __hip_atomic_fetch_add(F.ctl + qword, 8u, __ATOMIC_RELAXED, __HIP_MEMORY_SCOPE_AGENT);
        __syncthreads();
        const int base = __builtin_amdgcn_readfirstlane((int)F.MISC[121]);
        __syncthreads();
        if (base >= count) break;
        const int it = first + base + F.wave;
        if (base + F.wave < count) {
            const CvIt cur = cv_decode(it, a, ws);
            f32x4 v[16];
#pragma unroll
            for (int i = 0; i < 16; ++i) v[i] = __builtin_nontemporal_load((const f32x4*)(cur.W + (size_t)(cur.k0 + 8 * i + r) * cur.ldw + cur.n0 + c4));
#pragma unroll
            for (int i = 0; i < 16; ++i) *(LAS f32x4*)(scr + (8 * i + r) * 36 + c4) = v[i] * cur.scale;
            asm volatile("s_waitcnt lgkmcnt(0)" ::: "memory");
            const LAS float* s = scr + (64 * hf) * 36 + n;
            unsigned w[16];
#pragma unroll
            for (int j = 0; j < 16; ++j) { unsigned x = 0u; x = __builtin_amdgcn_cvt_pk_fp8_f32(s[(4 * j) * 36], s[(4 * j + 1) * 36], x, false); x = __builtin_amdgcn_cvt_pk_fp8_f32(s[(4 * j + 2) * 36], s[(4 * j + 3) * 36], x, true); w[j] = x; }
            const int drow = cur.n0 + n; unsigned char* op = cur.WT + ((size_t)(((drow >> 8) * 16 + (cur.k0 >> 7)) * 256 + (drow & 255))) * 128 + 64 * hf;
#pragma unroll
            for (int j = 0; j < 4; ++j) *(u32x4*)(op + 16 * j) = (u32x4){w[4 * j], w[4 * j + 1], w[4 * j + 2], w[4 * j + 3]};
            asm volatile("s_waitcnt lgkmcnt(0)" ::: "memory");
        }
    }
}
static_assert(CV_TAIL <= 32 * 16 * 64 && CV_TAIL1 % 8 == 0 && CV_TAIL2 % 8 == 0, "the tails are a suffix of the moe_w2 items");

struct SchedP1 {
    int G, c; const unsigned char* ws; int lo, hi;
    DI bool next(int i, pg8::UnitD& u) const {
        u.rows = nullptr; u.nvalid = 0; u.lda = 4096u; u.ldb = 4096u; u.e = 0; u.x0 = 0;
        if (lo == 0) {
            if (G == 256) { const int x = c >> 5, s = c & 31, bidx = i * 8 + x; if (bidx >= 24) return false;
                const int g = bidx >> 2, h = bidx & 3; u.pn = 4 * g + (s >> 3); u.pm = h * 8 + (s & 7); if (u.pn >= 23) return false; }
            else { const int L = i * G + c; if (L >= 32 * 23) return false; u.pn = L / 32; u.pm = L % 32; }
            u.type = 0; u.A = (const char*)(ws + WS_HN) + (size_t)u.pm * 256 * 4096; u.B = (const char*)(ws + WS_WIN) + (size_t)u.pn * 256 * 4096;
            return true;
        }
        const int L = lo + i * G + c; if (L >= hi) return false;
        { const int q = L - 32 * 23; u.type = 1; u.pn = q / 4; u.pm = q % 4; u.A = (const char*)(ws + WS_MN) + (size_t)u.pm * 256 * 4096; u.B = (const char*)(ws + WS_WKV) + (size_t)u.pn * 256 * 4096; }
        return true;
    }
};
struct EpiP1 {
    static constexpr bool AFTER_DRAIN = false;
    bf16_t* proj; float* dtb; bf16_t* kvraw; const float* gq; const float* gk; unsigned char* vf8;
    DI void operator()(const f32x4 (&acc)[2][2][4][2], const pg8::UnitD& u, int wr, int wc, int fr, int fq) const {
        { int ln_ = threadIdx.x; asm volatile("" : "+v"(ln_)); fr = ln_ & 15; fq = (ln_ >> 4) & 3; }
        const int row0 = u.pm * 256 + wr * 64 + fr;
        const int cn = u.pn * 256 + 64 * wc + 8 * fq;
        if (u.type == 1 && u.pn >= 8) {
#pragma unroll
            for (int ai = 0; ai < 2; ++ai)
#pragma unroll
                for (int m = 0; m < 4; ++m) { unsigned char* rp = vf8 + (size_t)(row0 + ai * 128 + m * 16) * 2048 + (cn - 2048);
#pragma unroll
                    for (int bj = 0; bj < 2; ++bj) { const f32x4 v0 = acc[ai][bj][m][0] * 16.f, v1 = acc[ai][bj][m][1] * 16.f;
                        u32x2 w; w.x = __builtin_amdgcn_cvt_pk_fp8_f32(v0[0], v0[1], 0u, false); w.x = __builtin_amdgcn_cvt_pk_fp8_f32(v0[2], v0[3], w.x, true);
                        w.y = __builtin_amdgcn_cvt_pk_fp8_f32(v1[0], v1[1], 0u, false); w.y = __builtin_amdgcn_cvt_pk_fp8_f32(v1[2], v1[3], w.y, true);
                        *(u32x2*)(rp + 32 * bj) = w; } }
            return;
        }
        if (u.type == 1) {
#pragma unroll
            for (int ai = 0; ai < 2; ++ai)
#pragma unroll
                for (int m = 0; m < 4; ++m) { bf16_t* rp = kvraw + (size_t)(row0 + ai * 128 + m * 16) * 4096 + cn;
#pragma unroll
                    for (int bj = 0; bj < 2; ++bj) { const f32x4 v0 = acc[ai][bj][m][0], v1 = acc[ai][bj][m][1];
                        u32x4 w; w.x = pk2(v0[0], v0[1]); w.y = pk2(v0[2], v0[3]); w.z = pk2(v1[0], v1[1]); w.w = pk2(v1[2], v1[3]); *(u32x4*)(rp + 32 * bj) = w; } }
            return;
        }
        if (u.pn == 22) {
            if (wc == 0 && fq < 2) {
#pragma unroll
                for (int ai = 0; ai < 2; ++ai)
#pragma unroll
                    for (int m = 0; m < 4; ++m) { float* rp = dtb + (size_t)(row0 + ai * 128 + m * 16) * 16 + 8 * fq;
                        *(f32x4*)(rp) = acc[ai][0][m][0]; *(f32x4*)(rp + 4) = acc[ai][0][m][1]; }
            }
            return;
        }
        const bool isq = (u.pn >= 10 && u.pn < 14), isk = (u.pn >= 14 && u.pn < 18);
        if (!(isq || isk)) {
#pragma unroll
            for (int ai = 0; ai < 2; ++ai)
#pragma unroll
                for (int m = 0; m < 4; ++m) { bf16_t* rp = proj + (size_t)(row0 + ai * 128 + m * 16) * PP + cn;
#pragma unroll
                    for (int bj = 0; bj < 2; ++bj) { const f32x4 v0 = acc[ai][bj][m][0], v1 = acc[ai][bj][m][1];
                        u32x4 w; w.x = pk2(v0[0], v0[1]); w.y = pk2(v0[2], v0[3]); w.z = pk2(v1[0], v1[1]); w.w = pk2(v1[2], v1[3]); *(u32x4*)(rp + 32 * bj) = w; } }
            return;
        }
        const float* g = (isq ? gq : gk) + 8 * fq; const float sc = isq ? (0.125f * 1.4426950408889634f) : 1.f;
#pragma unroll
        for (int ai = 0; ai < 2; ++ai)
#pragma unroll
            for (int m = 0; m < 4; ++m) { bf16_t* rp = proj + (size_t)(row0 + ai * 128 + m * 16) * PP + cn;
                float ss = 0.f;
#pragma unroll
                for (int bj = 0; bj < 2; ++bj)
#pragma unroll
                    for (int n = 0; n < 2; ++n) { const f32x4 v = acc[ai][bj][m][n]; ss += (v[0] * v[0] + v[1] * v[1]) + (v[2] * v[2] + v[3] * v[3]); }
                ss += __shfl_xor(ss, 16); ss += __shfl_xor(ss, 32);
                const float rs = sc / sqrtf(ss * (1.f / 64.f) + EPS_);
#pragma unroll
                for (int bj = 0; bj < 2; ++bj) { const f32x4 v0 = acc[ai][bj][m][0] * rs * *(const f32x4*)(g + 32 * bj), v1 = acc[ai][bj][m][1] * rs * *(const f32x4*)(g + 32 * bj + 4);
                    u32x4 w; w.x = pk2(v0[0], v0[1]); w.y = pk2(v0[2], v0[3]); w.z = pk2(v1[0], v1[1]); w.w = pk2(v1[2], v1[3]); *(u32x4*)(rp + 32 * bj) = w; } }
    }
};

DI void kprep(Frame& F, const ArgP& a) {
    const int gw = F.vcu * NWAVES + F.wave, NGW = F.G * NWAVES;
    const bf16_t* kv = (const bf16_t*)(F.ws + WS_KVRAW); unsigned char* kn = (unsigned char*)(F.ws + WS_KN8);
    for (int it = gw; it < NB * MEMLEN * 4; it += NGW) {
        const int row = it >> 2, h = it & 3, b = row >> 8, key = row & 255;
        const u32x4 raw = *(const u32x4*)(kv + (size_t)row * 4096 + h * 512 + F.lane * 8);
        float v[8]; v[0] = bflo(raw.x); v[1] = bfhi(raw.x); v[2] = bflo(raw.y); v[3] = bfhi(raw.y); v[4] = bflo(raw.z); v[5] = bfhi(raw.z); v[6] = bflo(raw.w); v[7] = bfhi(raw.w);
        float ss = 0.f;
#pragma unroll
        for (int j = 0; j < 8; ++j) ss += v[j] * v[j];
        const float rs = 1.f / sqrtf(wave_sum(ss) * (1.f / 512.f) + EPS_) * 0.04419417382415922f * 128.f;
        const float* gk = a.in(I_XKG) + F.lane * 8; const float* gq = a.in(I_XQG) + F.lane * 8;
        u32x2 o; o.x = __builtin_amdgcn_cvt_pk_fp8_f32(v[0] * rs * gk[0] * gq[0], v[1] * rs * gk[1] * gq[1], 0u, false); o.x = __builtin_amdgcn_cvt_pk_fp8_f32(v[2] * rs * gk[2] * gq[2], v[3] * rs * gk[3] * gq[3], o.x, true);
        o.y = __builtin_amdgcn_cvt_pk_fp8_f32(v[4] * rs * gk[4] * gq[4], v[5] * rs * gk[5] * gq[5], 0u, false); o.y = __builtin_amdgcn_cvt_pk_fp8_f32(v[6] * rs * gk[6] * gq[6], v[7] * rs * gk[7] * gq[7], o.y, true);
        *(u32x2*)(kn + ((size_t)((b * 4 + h) * 256 + key)) * 512 + F.lane * 8) = o;
    }
}

constexpr int SP = 272;
constexpr int S_C = 0, S_BM = 34816, S_BT = 69632, S_XDT = 104448, S_HB = 121856, S_F = 139264, S_W = 155648  , SSD_LDS = 162048;
static_assert(SSD_LDS <= MISC_OFF, "SSD LDS map");
#define MFMA32(a, b, c) __builtin_amdgcn_mfma_f32_32x32x16_bf16((a), (b), (c), 0, 0, 0)
DI int crow(int r, int hi) { return (r & 3) + 8 * (r >> 2) + 4 * hi; }
DI bf16x8 ldfrag(LAS const unsigned char* base, int row, int kel) { return *(const LAS bf16x8*)(base + row * SP + kel * 2); }
DI float fexp(float x) { return __builtin_amdgcn_exp2f(x * 1.4426950408889634f); }
DI float fsilu(float x) { return x * __builtin_amdgcn_rcpf(1.f + fexp(-x)); }

DI void ssd_unit(Frame& F, const ArgP& a, int b, int hd) {
    LAS unsigned char* lds = F.lds;
    int tid = F.tid, lane = F.lane, r32 = lane & 31, hh = lane >> 5; const int wid = F.wave;
    LAS float* sdt = (LAS float*)(lds + S_F); LAS float* sac = sdt + 2048;
    const bf16_t* proj = (const bf16_t*)(F.ws + WS_PROJ); const float* dtbuf = (const float*)(F.ws + WS_DT); bf16_t* yg = (bf16_t*)(F.ws + WS_YG);
    const int g = hd >> 3;
    const float aneg = -__expf(a.in(I_ALOG)[hd]), dtb = a.in(I_DTB)[hd], dsk = a.in(I_DSKIP)[hd];
#pragma unroll
    for (int q = 0; q < 2; ++q) { const int c = 2 * wid + q; const size_t t0 = (size_t)b * SEQ_ + c * 128;
        const float x0 = dtbuf[(t0 + 2 * lane) * 16 + hd] + dtb, x1 = dtbuf[(t0 + 2 * lane + 1) * 16 + hd] + dtb;
        const float d0 = x0 > 20.f ? x0 : log1pf(__expf(x0)), d1 = x1 > 20.f ? x1 : log1pf(__expf(x1));
        const float a0 = d0 * aneg, a1 = d1 * aneg;
        float s = a0 + a1;
#pragma unroll
        for (int o = 1; o < 64; o <<= 1) { const float t = __shfl_up(s, o); if (lane >= o) s += t; }
        sdt[c * 128 + 2 * lane] = d0; sdt[c * 128 + 2 * lane + 1] = d1; sac[c * 128 + 2 * lane] = s - a1; sac[c * 128 + 2 * lane + 1] = s; }
    int seg = tid >> 5, cg = tid & 31, l0 = seg * 8;
    int colbc = (cg < 16) ? (1024 + g * 128 + cg * 8) : (1280 + g * 128 + (cg - 16) * 8);
    const int colx = hd * 64 + wid * 8; int lx = 2 * lane;
    LAS float* swt = (LAS float*)(lds + S_W);
    { const float* convw = a.in(I_CONVW); const float* convb = a.in(I_CONVB);
      if (tid < 320) { const int ci = tid;
          const int xc = (ci < 64) ? (hd * 64 + ci) : (ci < 192 ? (1024 + g * 128 + (ci - 64)) : (1280 + g * 128 + (ci - 192)));
#pragma unroll
          for (int k = 0; k < 4; ++k) swt[k * 320 + ci] = convw[k * 1536 + xc];
          swt[4 * 320 + ci] = convb[xc]; } }
    int cibc = 64 + cg * 8; const int cix = wid * 8;
    const char* pub = (const char*)F.ws; const unsigned pxb = (unsigned)(WS_PROJ + ((size_t)b * SEQ_ * PP + PC_XBC) * 2), zoff = (unsigned)(WS_CTL + 524288);
    u32x4 inbc[11], inx[5];
#define SSD_PREFETCH(c_) do { \
        int sd_ = l0; asm volatile("" : "+v"(sd_)); \
        _Pragma("unroll") for (int j = 0; j < 11; ++j) { const int tt = (c_) * 128 + sd_ - 3 + j; inbc[j] = *(const u32x4*)(pub + ((tt >= 0) ? pxb + (unsigned)(tt * PP + colbc) * 2u : zoff)); } } while (0)
    SSD_PREFETCH(0);
    f32x16 hT; for (int i = 0; i < 16; ++i) hT[i] = 0.f;
    const int nb = wid & 3, pb = wid >> 2;
    __syncthreads();
    for (int c = 0; c < 16; ++c) {
        { int t_ = threadIdx.x; asm volatile("" : "+v"(t_)); tid = t_; lane = t_ & 63; r32 = lane & 31; hh = lane >> 5; seg = t_ >> 5; cg = t_ & 31; l0 = seg * 8; lx = 2 * lane;
          colbc = (cg < 16) ? (1024 + g * 128 + cg * 8) : (1280 + g * 128 + (cg - 16) * 8); cibc = 64 + cg * 8; }
        const size_t t0 = (size_t)b * SEQ_ + c * 128;
        const LAS float* cdt = sdt + c * 128; const LAS float* cac = sac + c * 128;
        const float aend = cac[127];
#pragma unroll
        for (int j = 0; j < 5; ++j) { int sd_ = lx; asm volatile("" : "+v"(sd_)); const int tt = c * 128 + sd_ - 3 + j; inx[j] = *(const u32x4*)(pub + ((tt >= 0) ? pxb + (unsigned)(tt * PP + colx) * 2u : zoff)); }
        {
            LAS unsigned char* hbp = lds + S_HB + (32 * pb + r32) * SP + (32 * nb + 4 * hh) * 2;
#pragma unroll
            for (int q4 = 0; q4 < 4; ++q4) { u32x2 w; w.x = pk2(hT[4 * q4], hT[4 * q4 + 1]); w.y = pk2(hT[4 * q4 + 2], hT[4 * q4 + 3]); *(LAS u32x2*)(hbp + 16 * q4) = w; }
        }
        {
            float wbc[5][8];
#pragma unroll
            for (int k = 0; k < 5; ++k) { const f32x4 w0 = *(const LAS f32x4*)(swt + k * 320 + cibc), w1 = *(const LAS f32x4*)(swt + k * 320 + cibc + 4);
#pragma unroll
                for (int i = 0; i < 4; ++i) { wbc[k][i] = w0[i]; wbc[k][4 + i] = w1[i]; } }
#pragma unroll
            for (int hf = 0; hf < 2; ++hf) {
                __builtin_amdgcn_sched_barrier(0);
                float o[4][8];
#pragma unroll
                for (int j = 0; j < 4; ++j)
#pragma unroll
                    for (int i = 0; i < 8; ++i) { float s = wbc[4][i];
#pragma unroll
                        for (int k = 0; k < 4; ++k) { const unsigned wd = inbc[4 * hf + j + k][i >> 1]; s += wbc[k][i] * ((i & 1) ? bfhi(wd) : bflo(wd)); }
                        o[j][i] = fsilu(s); }
                const int lh = l0 + 4 * hf;
                if (cg < 16) {
                    const int n0 = cg * 8; float ev[4];
#pragma unroll
                    for (int j = 0; j < 4; ++j) { ev[j] = fexp(aend - cac[lh + j]);
                        u32x4 w1; w1.x = pk2(o[j][0], o[j][1]); w1.y = pk2(o[j][2], o[j][3]); w1.z = pk2(o[j][4], o[j][5]); w1.w = pk2(o[j][6], o[j][7]);
                        *(LAS u32x4*)(lds + S_BM + (lh + j) * SP + n0 * 2) = w1; }
#pragma unroll
                    for (int i = 0; i < 8; ++i) { u32x2 w2; w2.x = pk2(o[0][i] * ev[0], o[1][i] * ev[1]); w2.y = pk2(o[2][i] * ev[2], o[3][i] * ev[3]);
                        *(LAS u32x2*)(lds + S_BT + (n0 + i) * SP + lh * 2) = w2; }
                } else {
                    const int n0 = (cg - 16) * 8;
#pragma unroll
                    for (int j = 0; j < 4; ++j) { u32x4 w1; w1.x = pk2(o[j][0], o[j][1]); w1.y = pk2(o[j][2], o[j][3]); w1.z = pk2(o[j][4], o[j][5]); w1.w = pk2(o[j][6], o[j][7]);
                        *(LAS u32x4*)(lds + S_C + (lh + j) * SP + n0 * 2) = w1; }
                }
            }
        }
        __builtin_amdgcn_sched_barrier(0);
        {
            const float d0 = cdt[lx], d1 = cdt[lx + 1];
            float wx[5][8];
#pragma unroll
            for (int k = 0; k < 5; ++k) { const f32x4 w0 = *(const LAS f32x4*)(swt + k * 320 + cix), w1 = *(const LAS f32x4*)(swt + k * 320 + cix + 4);
#pragma unroll
                for (int i = 0; i < 4; ++i) { wx[k][i] = w0[i]; wx[k][4 + i] = w1[i]; } }
#pragma unroll
            for (int i = 0; i < 8; ++i) { float s0 = wx[4][i], s1 = wx[4][i];
#pragma unroll
                for (int k = 0; k < 4; ++k) { const unsigned w0 = inx[k][i >> 1], w1 = inx[k + 1][i >> 1];
                    s0 += wx[k][i] * ((i & 1) ? bfhi(w0) : bflo(w0)); s1 += wx[k][i] * ((i & 1) ? bfhi(w1) : bflo(w1)); }
                *(LAS unsigned*)(lds + S_XDT + (wid * 8 + i) * SP + lx * 2) = pk2(fsilu(s0) * d0, fsilu(s1) * d1); }
        }
        if (c < 15) SSD_PREFETCH(c + 1);
        __syncthreads();
        const int lb = wid >> 1;
        f32x16 xt[2];
        {
            bf16x8 cf[8];
#pragma unroll
            for (int ks = 0; ks < 8; ++ks) cf[ks] = ldfrag(lds + S_C, 32 * lb + r32, 16 * ks + 8 * hh);
#pragma unroll
            for (int q = 0; q < 2; ++q) { const int sb = 2 * (wid & 1) + q;
                for (int i = 0; i < 16; ++i) xt[q][i] = 0.f;
                if (sb <= lb) {
                    bf16x8 bfr[8];
#pragma unroll
                    for (int ks = 0; ks < 8; ++ks) bfr[ks] = ldfrag(lds + S_BM, 32 * sb + r32, 16 * ks + 8 * hh);
                    __builtin_amdgcn_sched_barrier(0);
#pragma unroll
                    for (int ks = 0; ks < 8; ++ks) xt[q] = MFMA32(bfr[ks], cf[ks], xt[q]);
                }
            }
        }
        __syncthreads();
        {
            const int l = 32 * lb + r32; const float al = cac[l], ddl = dsk * __builtin_amdgcn_rcpf(cdt[l]);
            f32x4 cs[2][4];
#pragma unroll
            for (int q = 0; q < 2; ++q)
#pragma unroll
                for (int q4 = 0; q4 < 4; ++q4) cs[q][q4] = *(const LAS f32x4*)(cac + 32 * (2 * (wid & 1) + q) + 8 * q4 + 4 * hh);
#pragma unroll
            for (int q = 0; q < 2; ++q) { const int sb = 2 * (wid & 1) + q;
#pragma unroll
                for (int q4 = 0; q4 < 4; ++q4) { float mv[4];
#pragma unroll
                    for (int e = 0; e < 4; ++e) { const int s = 32 * sb + 8 * q4 + 4 * hh + e;
                        const float ev = fexp(fminf(al - cs[q][q4][e], 0.f));
                        float v = (s <= l) ? xt[q][4 * q4 + e] * ev : 0.f;
                        v += (s == l) ? ddl : 0.f;
                        mv[e] = v; }
                    u32x2 w; w.x = pk2(mv[0], mv[1]); w.y = pk2(mv[2], mv[3]);
                    *(LAS u32x2*)(lds + S_BM + l * SP + (32 * sb + 8 * q4 + 4 * hh) * 2) = w; }
            }
        }
        __syncthreads();
        {
            const int lb2 = wid & 3, pb2 = wid >> 2; const int l = 32 * lb2 + r32; const size_t tok = t0 + l;
            const int pc0 = hd * 64 + 32 * pb2 + 4 * hh;
            u32x2 zz[4];
#pragma unroll
            for (int q4 = 0; q4 < 4; ++q4) zz[q4] = *(const u32x2*)(proj + tok * PP + pc0 + 8 * q4);
            f32x16 y1, y2; for (int i = 0; i < 16; ++i) { y1[i] = 0.f; y2[i] = 0.f; }
            bf16x8 fa[8], fb[8];
#pragma unroll
            for (int ks = 0; ks < 8; ++ks) { fa[ks] = ldfrag(lds + S_XDT, 32 * pb2 + r32, 16 * ks + 8 * hh); fb[ks] = ldfrag(lds + S_BM, 32 * lb2 + r32, 16 * ks + 8 * hh); }
            __builtin_amdgcn_sched_barrier(0);
#pragma unroll
            for (int ks = 0; ks < 8; ++ks) { if (ks < 2 * (lb2 + 1)) y1 = MFMA32(fa[ks], fb[ks], y1); }
            const float cd = fexp(aend);
#pragma unroll
            for (int i = 0; i < 16; ++i) hT[i] *= cd;
#pragma unroll
            for (int ks = 0; ks < 8; ++ks) fb[ks] = ldfrag(lds + S_BT, 32 * nb + r32, 16 * ks + 8 * hh);
            __builtin_amdgcn_sched_barrier(0);
#pragma unroll
            for (int ks = 0; ks < 8; ++ks) hT = MFMA32(fb[ks], fa[ks], hT);
#pragma unroll
            for (int ks = 0; ks < 8; ++ks) { fa[ks] = ldfrag(lds + S_HB, 32 * pb2 + r32, 16 * ks + 8 * hh); fb[ks] = ldfrag(lds + S_C, 32 * lb2 + r32, 16 * ks + 8 * hh); }
            __builtin_amdgcn_sched_barrier(0);
#pragma unroll
            for (int ks = 0; ks < 8; ++ks) y2 = MFMA32(fa[ks], fb[ks], y2);
            const float el = fexp(cac[l]);
#pragma unroll
            for (int q4 = 0; q4 < 4; ++q4) { float yv[4];
#pragma unroll
                for (int e = 0; e < 4; ++e) { const float z = (e & 1) ? bfhi(e < 2 ? zz[q4].x : zz[q4].y) : bflo(e < 2 ? zz[q4].x : zz[q4].y);
                    yv[e] = (y1[4 * q4 + e] + el * y2[4 * q4 + e]) * fsilu(z); }
                u32x2 w; w.x = pk2(yv[0], yv[1]); w.y = pk2(yv[2], yv[3]);
                *(u32x2*)(yg + tok * 1024 + pc0 + 8 * q4) = w; }
        }
        __syncthreads();
    }
#undef SSD_PREFETCH
}

DI void attn_phase_da(Frame& F) {
    const attn_body::bf16* proj = (const attn_body::bf16*)(F.ws + WS_PROJ);
    if (threadIdx.x == 0) F.MISC[120] = __hip_atomic_fetch_add(F.ctl + CW_QATT, 1u, __ATOMIC_RELAXED, __HIP_MEMORY_SCOPE_AGENT);
    __syncthreads();
    int u = __builtin_amdgcn_readfirstlane((int)F.MISC[120]);
    while (u < 1024) {
        unsigned pend = 0u;
        const int qb = 7 - (u >> 7), combo = u & 127;
        const int half = combo & 1, j = (combo >> 1) & 1, h = (combo >> 2) & 7, b = combo >> 5;
        attn_body::bf16* O = (attn_body::bf16*)(F.ws + (j ? WS_O1 : WS_O0));
        attn_body::attn_unit<8>(b, PC_Q + (h * 2 + j) * 64, PC_V + h * 128 + half * 64, h * 128 + half * 64, qb, proj, proj + (PC_K - PC_Q), proj, O, (char*)F.lds, F.ctl + CW_QATT, pend);
        if (threadIdx.x == 0) F.MISC[120] = pend;
        __syncthreads();
        u = __builtin_amdgcn_readfirstlane((int)F.MISC[120]);
    }
}

DI void p3_finalize(Frame& F, const ArgP& a) {
    const int gw = F.vcu * NWAVES + F.wave, NGW = F.G * NWAVES, lane = F.lane;
    bf16_t* ycat = (bf16_t*)(F.ws + WS_YCAT); const bf16_t* yg = (const bf16_t*)(F.ws + WS_YG); const bf16_t* o0 = (const bf16_t*)(F.ws + WS_O0); const bf16_t* o1 = (const bf16_t*)(F.ws + WS_O1);
    float l1 = a.in(I_LQ1)[lane] * a.in(I_LK1)[lane], l2 = a.in(I_LQ2)[lane] * a.in(I_LK2)[lane];
    const float lam = __expf(wave_sum(l1)) - __expf(wave_sum(l2)) + LAM_INIT;
    for (int m = gw; m < NTOK; m += NGW) {
        { bf16_t* yp = ycat + (size_t)m * 2048 + 16 * lane; const bf16_t* gp = yg + (size_t)m * 1024 + 16 * lane;
          const u32x4 r0 = *(const u32x4*)gp, r1 = *(const u32x4*)(gp + 8);
          float v[16]; v[0] = bflo(r0.x); v[1] = bfhi(r0.x); v[2] = bflo(r0.y); v[3] = bfhi(r0.y); v[4] = bflo(r0.z); v[5] = bfhi(r0.z); v[6] = bflo(r0.w); v[7] = bfhi(r0.w);
          v[8] = bflo(r1.x); v[9] = bfhi(r1.x); v[10] = bflo(r1.y); v[11] = bfhi(r1.y); v[12] = bflo(r1.z); v[13] = bfhi(r1.z); v[14] = bflo(r1.w); v[15] = bfhi(r1.w);
          float ss = 0.f;
#pragma unroll
          for (int i = 0; i < 16; ++i) ss += v[i] * v[i];
#pragma unroll
          for (int o = 1; o < 32; o <<= 1) ss += __shfl_xor(ss, o);
          const float rs = 1.f / sqrtf(ss * (1.f / 512.f) + EPS_);
          const float* g = a.in(I_SSDG) + 16 * lane;
          u32x4 w0, w1;
          w0.x = pk2(v[0] * rs * g[0], v[1] * rs * g[1]); w0.y = pk2(v[2] * rs * g[2], v[3] * rs * g[3]); w0.z = pk2(v[4] * rs * g[4], v[5] * rs * g[5]); w0.w = pk2(v[6] * rs * g[6], v[7] * rs * g[7]);
          w1.x = pk2(v[8] * rs * g[8], v[9] * rs * g[9]); w1.y = pk2(v[10] * rs * g[10], v[11] * rs * g[11]); w1.z = pk2(v[12] * rs * g[12], v[13] * rs * g[13]); w1.w = pk2(v[14] * rs * g[14], v[15] * rs * g[15]);
          *(u32x4*)yp = w0; *(u32x4*)(yp + 8) = w1; }
        { const bf16_t* p0 = o0 + (size_t)m * 1024 + 16 * lane; const bf16_t* p1 = o1 + (size_t)m * 1024 + 16 * lane;
          const u32x4 a0 = *(const u32x4*)p0, a1 = *(const u32x4*)(p0 + 8), b0 = *(const u32x4*)p1, b1 = *(const u32x4*)(p1 + 8);
          float v[16];
          v[0] = bflo(a0.x) - lam * bflo(b0.x); v[1] = bfhi(a0.x) - lam * bfhi(b0.x); v[2] = bflo(a0.y) - lam * bflo(b0.y); v[3] = bfhi(a0.y) - lam * bfhi(b0.y);
          v[4] = bflo(a0.z) - lam * bflo(b0.z); v[5] = bfhi(a0.z) - lam * bfhi(b0.z); v[6] = bflo(a0.w) - lam * bflo(b0.w); v[7] = bfhi(a0.w) - lam * bfhi(b0.w);
          v[8] = bflo(a1.x) - lam * bflo(b1.x); v[9] = bfhi(a1.x) - lam * bfhi(b1.x); v[10] = bflo(a1.y) - lam * bflo(b1.y); v[11] = bfhi(a1.y) - lam * bfhi(b1.y);
          v[12] = bflo(a1.z) - lam * bflo(b1.z); v[13] = bfhi(a1.z) - lam * bfhi(b1.z); v[14] = bflo(a1.w) - lam * bflo(b1.w); v[15] = bfhi(a1.w) - lam * bfhi(b1.w);
          float ss = 0.f;
#pragma unroll
          for (int i = 0; i < 16; ++i) ss += v[i] * v[i];
          ss += __shfl_xor(ss, 1); ss += __shfl_xor(ss, 2); ss += __shfl_xor(ss, 4);
          const float rs = 1.f / sqrtf(ss * (1.f / 128.f) + EPS_) * (1.f - LAM_INIT);
          const float* g = a.in(I_SUBG) + 16 * (lane & 7);
          u32x4 w0, w1;
          w0.x = pk2(v[0] * rs * g[0], v[1] * rs * g[1]); w0.y = pk2(v[2] * rs * g[2], v[3] * rs * g[3]); w0.z = pk2(v[4] * rs * g[4], v[5] * rs * g[5]); w0.w = pk2(v[6] * rs * g[6], v[7] * rs * g[7]);
          w1.x = pk2(v[8] * rs * g[8], v[9] * rs * g[9]); w1.y = pk2(v[10] * rs * g[10], v[11] * rs * g[11]); w1.z = pk2(v[12] * rs * g[12], v[13] * rs * g[13]); w1.w = pk2(v[14] * rs * g[14], v[15] * rs * g[15]);
          bf16_t* yp = ycat + (size_t)m * 2048 + 1024 + 16 * lane;
          *(u32x4*)yp = w0; *(u32x4*)(yp + 8) = w1; }
    }
}

struct SchedDense {
    int G, c, nM, nN; const char* A; const char* B; unsigned lda, ldb; int bdiv; size_t bstride;
    DI bool next(int i, pg8::UnitD& u) const {
        const int L = i * G + c; if (L >= nM * nN) return false;
        u.rows = nullptr; u.nvalid = 0; u.lda = lda; u.ldb = ldb; u.type = 0; u.e = 0; u.x0 = 0;
        if (G == 256 && nM == 32 && nN == 8) { const int x = L >> 5, s = L & 31; u.pm = (x & 3) * 8 + (s & 7); u.pn = (x >> 2) * 4 + (s >> 3); }
        else { u.pn = L / nM; u.pm = L % nM; }
        u.A = A + (size_t)u.pm * 256 * lda; u.B = B + (size_t)u.pn * 256 * ldb + (size_t)(u.pm / bdiv) * bstride;
        return true;
    }
};
template <bool BASE_BF16>
struct EpiResid {
    static constexpr bool AFTER_DRAIN = false;
    const void* base; bf16_t* out; float* part; unsigned char* out8; float accscale;
    DI void operator()(const f32x4 (&acc)[2][2][4][2], const pg8::UnitD& u, int wr, int wc, int fr, int fq) const {
        { int ln_ = threadIdx.x; asm volatile("" : "+v"(ln_)); fr = ln_ & 15; fq = (ln_ >> 4) & 3; }
        const int row0 = u.pm * 256 + wr * 64 + fr, col0 = u.pn * 256 + wc * 32 + 8 * fq;
#pragma unroll
        for (int ai = 0; ai < 2; ++ai) {
            u32x4 rb[4][2]; f32x4 rf[4][2][2];
#pragma unroll
            for (int m = 0; m < 4; ++m)
#pragma unroll
                for (int bj = 0; bj < 2; ++bj) { const size_t idx = (size_t)(row0 + ai * 128 + m * 16) * 2048 + col0 + bj * 128;
                    if constexpr (BASE_BF16) rb[m][bj] = *(const u32x4*)((const bf16_t*)base + idx);
                    else { rf[m][bj][0] = *(const f32x4*)((const float*)base + idx); rf[m][bj][1] = *(const f32x4*)((const float*)base + idx + 4); } }
#pragma unroll
            for (int m = 0; m < 4; ++m) { const size_t row = (size_t)(row0 + ai * 128 + m * 16); float ss = 0.f;
#pragma unroll
                for (int bj = 0; bj < 2; ++bj) { const size_t idx = row * 2048 + col0 + bj * 128;
                    f32x4 b0, b1;
                    if constexpr (BASE_BF16) { const u32x4 r = rb[m][bj]; b0 = (f32x4){bflo(r.x), bfhi(r.x), bflo(r.y), bfhi(r.y)}; b1 = (f32x4){bflo(r.z), bfhi(r.z), bflo(r.w), bfhi(r.w)}; }
                    else { b0 = rf[m][bj][0]; b1 = rf[m][bj][1]; }
                    const f32x4 v0 = acc[ai][bj][m][0] * accscale + b0, v1 = acc[ai][bj][m][1] * accscale + b1;
                    { u32x4 w; w.x = pk2(v0[0], v0[1]); w.y = pk2(v0[2], v0[3]); w.z = pk2(v1[0], v1[1]); w.w = pk2(v1[2], v1[3]); *(u32x4*)(out + idx) = w; }
                    if (out8) { u32x2 w; w.x = __builtin_amdgcn_cvt_pk_fp8_f32(v0[0] * 16.f, v0[1] * 16.f, 0u, false); w.x = __builtin_amdgcn_cvt_pk_fp8_f32(v0[2] * 16.f, v0[3] * 16.f, w.x, true);
                        w.y = __builtin_amdgcn_cvt_pk_fp8_f32(v1[0] * 16.f, v1[1] * 16.f, 0u, false); w.y = __builtin_amdgcn_cvt_pk_fp8_f32(v1[2] * 16.f, v1[3] * 16.f, w.y, true); *(u32x2*)(out8 + idx) = w; }
                    ss += (v0[0] * v0[0] + v0[1] * v0[1]) + (v0[2] * v0[2] + v0[3] * v0[3]) + (v1[0] * v1[0] + v1[1] * v1[1]) + (v1[2] * v1[2] + v1[3] * v1[3]); }
                if (part) { ss += __shfl_xor(ss, 16); ss += __shfl_xor(ss, 32); if (fq == 0) part[row * 32 + u.pn * 4 + wc] = ss; } }
        }
    }
};

struct EpiQ {
    static constexpr bool AFTER_DRAIN = false;
    unsigned char* out8; float* part;
    DI void operator()(const f32x4 (&acc)[2][2][4][2], const pg8::UnitD& u, int wr, int wc, int fr, int fq) const {
        { int ln_ = threadIdx.x; asm volatile("" : "+v"(ln_)); fr = ln_ & 15; fq = (ln_ >> 4) & 3; }
        const int row0 = u.pm * 256 + wr * 64 + fr, col0 = u.pn * 256 + wc * 32 + 8 * fq;
#pragma unroll
        for (int ai = 0; ai < 2; ++ai)
#pragma unroll
            for (int m = 0; m < 4; ++m) { const size_t row = (size_t)(row0 + ai * 128 + m * 16); float ss = 0.f;
#pragma unroll
                for (int bj = 0; bj < 2; ++bj) { const size_t idx = row * 2048 + col0 + bj * 128; const f32x4 v0 = acc[ai][bj][m][0] * (1.f / 1024.f), v1 = acc[ai][bj][m][1] * (1.f / 1024.f);
                    u32x2 w; w.x = __builtin_amdgcn_cvt_pk_fp8_f32(v0[0] * 16.f, v0[1] * 16.f, 0u, false); w.x = __builtin_amdgcn_cvt_pk_fp8_f32(v0[2] * 16.f, v0[3] * 16.f, w.x, true);
                    w.y = __builtin_amdgcn_cvt_pk_fp8_f32(v1[0] * 16.f, v1[1] * 16.f, 0u, false); w.y = __builtin_amdgcn_cvt_pk_fp8_f32(v1[2] * 16.f, v1[3] * 16.f, w.y, true); *(u32x2*)(out8 + idx) = w;
                    ss += (v0[0] * v0[0] + v0[1] * v0[1]) + (v0[2] * v0[2] + v0[3] * v0[3]) + (v1[0] * v1[0] + v1[1] * v1[1]) + (v1[2] * v1[2] + v1[3] * v1[3]); }
                ss += __shfl_xor(ss, 16); ss += __shfl_xor(ss, 32); if (fq == 0) part[row * 32 + u.pn * 4 + wc] = ss; }
    }
};

struct SchedXS {
    int G, c; const unsigned char* ws;
    DI bool next(int i, pg8::UnitD& u) const {
        const int L = i * G + c; if (L >= 256) return false;
        u.rows = nullptr; u.nvalid = 0; u.e = 0;
        const int q = L & 127, bh = q >> 3, t8 = q & 7, b = bh >> 2, h = bh & 3;
        u.pm = b; u.pn = h; u.x0 = t8;
        if (L < 128) { u.type = 0; u.lda = 2048u; u.ldb = 512u;
            u.A = (const char*)(ws + WS_QF8) + (size_t)(b * 2048 + t8 * 256) * 2048 + h * 512; u.B = (const char*)(ws + WS_KN8) + (size_t)(bh * 256) * 512; }
        else { u.type = 1; u.lda = 2048u; u.ldb = 2048u;
            u.A = (const char*)(ws + WS_WO) + (size_t)(t8 * 256) * 2048 + h * 512; u.B = (const char*)(ws + WS_VF8) + (size_t)(b * 256) * 2048 + h * 512; }
        return true;
    }
};
struct EpiXS {
    static constexpr bool AFTER_DRAIN = false;
    unsigned char* P; unsigned char* VWT; const float* part1; const float* partq; LAS float* red;
    DI void operator()(const f32x4 (&acc)[2][2][4][2], const pg8::UnitD& u, int wr, int wc, int fr, int fq) const {
        { int ln_ = threadIdx.x; asm volatile("" : "+v"(ln_)); fr = ln_ & 15; fq = (ln_ >> 4) & 3; }
        const int b = u.pm, h = u.pn, t8 = u.x0;
        const int col0 = wc * 32 + 8 * fq;
        if (u.type == 1) {
            unsigned char* Vu = VWT + ((size_t)b * 2048 + t8 * 256) * 1024 + h * 256;
#pragma unroll
            for (int ai = 0; ai < 2; ++ai)
#pragma unroll
                for (int m = 0; m < 4; ++m) { const unsigned rl = (unsigned)(ai * 128 + wr * 64 + m * 16 + fr);
#pragma unroll
                    for (int bj = 0; bj < 2; ++bj) { const f32x4 v0 = acc[ai][bj][m][0] * (32.f / 1024.f), v1 = acc[ai][bj][m][1] * (32.f / 1024.f);
                        u32x2 w; w.x = __builtin_amdgcn_cvt_pk_fp8_f32(v0[0], v0[1], 0u, false); w.x = __builtin_amdgcn_cvt_pk_fp8_f32(v0[2], v0[3], w.x, true);
                        w.y = __builtin_amdgcn_cvt_pk_fp8_f32(v1[0], v1[1], 0u, false); w.y = __builtin_amdgcn_cvt_pk_fp8_f32(v1[2], v1[3], w.y, true);
                        *(u32x2*)(Vu + (rl * 1024u + (unsigned)(bj * 128 + col0))) = w; } }
            return;
        }
        const size_t row0 = (size_t)b * 2048 + t8 * 256;
        const char* p1u = (const char*)(part1 + row0 * 32); const char* pqu = (const char*)(partq + row0 * 32 + h * 8); unsigned char* Pu = P + row0 * 1024 + h * 256;
        float rsc[2][4];
#pragma unroll
        for (int ai = 0; ai < 2; ++ai)
#pragma unroll
            for (int m = 0; m < 4; ++m) { const unsigned rl = (unsigned)(ai * 128 + wr * 64 + m * 16 + fr);
                const f32x4 p0 = *(const f32x4*)(p1u + (rl * 32u + (unsigned)fq * 8u) * 4u), p1 = *(const f32x4*)(p1u + (rl * 32u + (unsigned)fq * 8u + 4u) * 4u);
                float s1 = (p0[0] + p0[1]) + (p0[2] + p0[3]) + (p1[0] + p1[1]) + (p1[2] + p1[3]);
                const f32x2 pq = *(const f32x2*)(pqu + (rl * 32u + (unsigned)fq * 2u) * 4u);
                float sq = pq[0] + pq[1];
                s1 = quad_sum_16_32(s1); sq = quad_sum_16_32(sq);
                rsc[ai][m] = __builtin_amdgcn_rsqf(sq * (1.f / 512.f) + EPS_ * (s1 * (1.f / 2048.f) + EPS_)) * (1.4426950408889634f / 2048.f);
                float ps = 0.f;
#pragma unroll
                for (int bj = 0; bj < 2; ++bj)
#pragma unroll
                    for (int n = 0; n < 2; ++n)
#pragma unroll
                        for (int e = 0; e < 4; ++e) ps += __builtin_amdgcn_exp2f(fminf(acc[ai][bj][m][n][e] * rsc[ai][m], 100.f));
                ps = quad_sum_16_32(ps);
                if (fq == 0) red[rl * 4 + wc] = ps;
                __builtin_amdgcn_sched_barrier(0); }
        __syncthreads();
        { int ln_ = threadIdx.x; asm volatile("" : "+v"(ln_)); fr = ln_ & 15; fq = (ln_ >> 4) & 3; }
#pragma unroll
        for (int ai = 0; ai < 2; ++ai)
#pragma unroll
            for (int m = 0; m < 4; ++m) { const unsigned rl = (unsigned)(ai * 128 + wr * 64 + m * 16 + fr);
                const f32x4 t = *(const LAS f32x4*)(red + rl * 4); const float inv = 256.f * __builtin_amdgcn_rcpf((t[0] + t[1]) + (t[2] + t[3])); float rs = rsc[ai][m]; asm volatile("" : "+v"(rs));
#pragma unroll
                for (int bj = 0; bj < 2; ++bj) { float x[8];
#pragma unroll
                    for (int n = 0; n < 2; ++n)
#pragma unroll
                        for (int e = 0; e < 4; ++e) x[n * 4 + e] = __builtin_amdgcn_exp2f(fminf(acc[ai][bj][m][n][e] * rs, 100.f)) * inv;
                    u32x2 w; w.x = __builtin_amdgcn_cvt_pk_fp8_f32(x[0], x[1], 0u, false); w.x = __builtin_amdgcn_cvt_pk_fp8_f32(x[2], x[3], w.x, true);
                    w.y = __builtin_amdgcn_cvt_pk_fp8_f32(x[4], x[5], 0u, false); w.y = __builtin_amdgcn_cvt_pk_fp8_f32(x[6], x[7], w.y, true);
                    *(u32x2*)(Pu + (rl * 1024u + (unsigned)(bj * 128 + wc * 32 + 8 * fq))) = w; } }
        __syncthreads();
    }
};

constexpr int HNP = 2052;
DI void p8_route(Frame& F, const ArgP& a) {
    LAS float* s_hn = (LAS float*)F.lds; LAS float* s_part = (LAS float*)(F.lds + 16 * HNP * 4); LAS float* s_log = s_part + 8 * 16 * 32; LAS int* s_slot = (LAS int*)(s_log + 16 * 32);
    LAS int* s_cnt = s_slot + 64; LAS int* s_base = s_cnt + 32;
    const bf16_t* h2 = (const bf16_t*)(F.ws + WS_H2); unsigned char* xg = (unsigned char*)(F.ws + WS_XG);
    float* gate_of = (float*)(F.ws + WS_GATEOF); int* tok_e = (int*)(F.ws + WS_TOKE);
    const float* rw = a.in(I_RW); const float* rb = a.in(I_RB); const float* g3 = a.in(I_GFFN);
    const int lane = F.lane, wave = F.wave, tid = F.tid;
    float bw0[64], bw1[64];
    { const int kq = lane >> 4, c16 = lane & 15; const float* bp = rw + (size_t)(256 * wave + kq) * 32 + c16;
#pragma unroll
      for (int j = 0; j < 64; ++j) { bw0[j] = bp[(size_t)(4 * j) * 32]; bw1[j] = bp[(size_t)(4 * j) * 32 + 16]; } }
    for (int task = F.vcu; task < NTOK / 16; task += F.G) {
        const int tb = task * 16;
#pragma unroll
        for (int q = 0; q < 2; ++q) { const int tl = 2 * wave + q; const size_t tok = (size_t)(tb + tl);
            const u32x2* xr = (const u32x2*)(h2 + tok * 2048) + lane;
            f32x4 v[8]; float s = 0.f;
#pragma unroll
            for (int j = 0; j < 8; ++j) { const u32x2 rw_ = xr[64 * j]; v[j] = (f32x4){bflo(rw_.x), bfhi(rw_.x), bflo(rw_.y), bfhi(rw_.y)}; s += (v[j].x * v[j].x + v[j].y * v[j].y) + (v[j].z * v[j].z + v[j].w * v[j].w); }
            const float rstd = 1.f / sqrtf(wave_sum(s) * (1.f / 2048.f) + EPS_);
#pragma unroll
            for (int j = 0; j < 8; ++j) { const f32x4 gg = ((const f32x4*)g3)[lane + 64 * j]; const f32x4 y = v[j] * rstd * gg;
                *(LAS f32x4*)(s_hn + tl * HNP + (lane + 64 * j) * 4) = y; } }
        __syncthreads();
        {
            f32x4 acc0 = {0.f, 0.f, 0.f, 0.f}, acc1 = {0.f, 0.f, 0.f, 0.f};
            const int kq = lane >> 4, c16 = lane & 15;
            const LAS float* ap = s_hn + c16 * HNP + 256 * wave;
#pragma unroll
            for (int j = 0; j < 64; ++j) { const f32x4 a4 = *(const LAS f32x4*)(ap + 4 * j);
                const float av = (kq == 0) ? a4.x : (kq == 1) ? a4.y : (kq == 2) ? a4.z : a4.w;
                acc0 = __builtin_amdgcn_mfma_f32_16x16x4f32(av, bw0[j], acc0, 0, 0, 0);
                acc1 = __builtin_amdgcn_mfma_f32_16x16x4f32(av, bw1[j], acc1, 0, 0, 0); }
            LAS float* pp = s_part + wave * 512 + c16;
#pragma unroll
            for (int r = 0; r < 4; ++r) { pp[(4 * kq + r) * 32] = acc0[r]; pp[(4 * kq + r) * 32 + 16] = acc1[r]; }
        }
        __syncthreads();
        {
            const int tt = tid >> 5, e = tid & 31; float lg = rb[e];
#pragma unroll
            for (int w = 0; w < 8; ++w) lg += s_part[w * 512 + tt * 32 + e];
            if (tid < 32) s_cnt[tid] = 0;
            float val[4]; int idx[4]; float cur = lg;
#pragma unroll
            for (int k = 0; k < 4; ++k) { float bv = cur; int bi = e;
#pragma unroll
                for (int o = 1; o < 32; o <<= 1) { const float ov = __shfl_xor(bv, o); const int oi = __shfl_xor(bi, o); if (ov > bv || (ov == bv && oi < bi)) { bv = ov; bi = oi; } }
                val[k] = bv; idx[k] = bi; if (e == bi) cur = -INFINITY; }
            __syncthreads();
            int myrank = 0, myexp = 0; float mygate = 0.f;
            if (e < 4) { const float sum = (__expf(val[0] - val[0]) + __expf(val[1] - val[0])) + (__expf(val[2] - val[0]) + __expf(val[3] - val[0]));
                const float mv = (e == 0) ? val[0] : (e == 1) ? val[1] : (e == 2) ? val[2] : val[3]; myexp = (e == 0) ? idx[0] : (e == 1) ? idx[1] : (e == 2) ? idx[2] : idx[3];
                mygate = __expf(mv - val[0]) / sum; myrank = __hip_atomic_fetch_add(&s_cnt[myexp], 1, __ATOMIC_RELAXED, __HIP_MEMORY_SCOPE_WORKGROUP); }
            __syncthreads();
            if (tid < 32) { const int c = s_cnt[tid]; s_base[tid] = c ? (int)__hip_atomic_fetch_add(F.ctl + CW_CNT + 64 * tid, (unsigned)c, __ATOMIC_RELAXED, __HIP_MEMORY_SCOPE_AGENT) : 0; }
            __syncthreads();
            if (e < 4) { const int slot = myexp * 8192 + s_base[myexp] + myrank; const int tok = tb + tt;
                gate_of[slot] = mygate; tok_e[tok * 4 + e] = slot; s_slot[tt * 4 + e] = slot; }
        }
        __syncthreads();
#pragma unroll
        for (int q = 0; q < 2; ++q) { const int tl = 2 * wave + q;
            unsigned o[8];
#pragma unroll
            for (int j = 0; j < 8; ++j) { const f32x4 y = *(const LAS f32x4*)(s_hn + tl * HNP + (lane + 64 * j) * 4);
                unsigned w = 0u; w = __builtin_amdgcn_cvt_pk_fp8_f32(y.x * 4.f, y.y * 4.f, w, false); w = __builtin_amdgcn_cvt_pk_fp8_f32(y.z * 4.f, y.w * 4.f, w, true); o[j] = w; }
#pragma unroll
            for (int k = 0; k < 4; ++k) { unsigned* o4 = (unsigned*)(xg + (size_t)s_slot[tl * 4 + k] * 2048) + lane;
#pragma unroll
                for (int j = 0; j < 8; ++j) o4[64 * j] = o[j]; } }
        __syncthreads();
    }
}

DI void moe_tables(Frame& F) {
    if (F.tid < 64) { const int e = F.tid & 31;
        const unsigned c = F.ctl[CW_CNT + 64 * e], mt = (c + 255u) >> 8;
        unsigned incl = mt;
#pragma unroll
        for (int o = 1; o < 32; o <<= 1) { const unsigned v = __shfl_up(incl, o, 64); if (e >= o) incl += v; }
        const unsigned base = incl - mt;
        if (F.tid < 32) { F.MISC[16 + e] = c; F.MISC[48 + e] = base; F.MISC[80 + e] = mt; if (e == 31) F.MISC[112] = incl;
            volatile LAS unsigned char* tab = (volatile LAS unsigned char*)(F.MISC + 128);
            for (unsigned t = 0; t < mt; ++t) tab[base + t] = (unsigned char)e; } }
    __syncthreads();
}
DI int ldsu(volatile LAS unsigned* p) { return __builtin_amdgcn_readfirstlane((int)*p); }
template <int NTN  >
struct SchedMoe {
    int G, c; const unsigned char* ws; volatile LAS unsigned* MISC; int total;
    DI bool next(int i, pg8::UnitD& u) const {
        const int L = i * G + c; if (L >= total) return false;
        const int e = __builtin_amdgcn_readfirstlane((int)((volatile LAS unsigned char*)(MISC + 128))[L / NTN]);
        const int tb = ldsu(MISC + 48 + e), mte = ldsu(MISC + 80 + e), cnt = ldsu(MISC + 16 + e);
        const int local = L - tb * NTN, nt = local / mte, mt = local % mte;
        u.type = 0; u.e = e; u.pn = nt; u.pm = tb + mt; u.x0 = mt; u.lda = 2048u; u.ldb = 128u;
        u.rows = nullptr; u.nvalid = cnt - mt * 256;
        if (NTN == 16) { u.A = (const char*)(ws + WS_XG) + ((size_t)e * 8192 + (size_t)mt * 256) * 2048;
            u.B = (const char*)(ws + WS_W1) + ((size_t)e * 4096 + (size_t)nt * 256) * 2048; }
        else { u.A = (const char*)(ws + WS_ACT) + ((size_t)e * 8192 + (size_t)mt * 256) * 2048;
            u.B = (const char*)(ws + WS_W2) + ((size_t)e * 2048 + (size_t)nt * 256) * 2048; }
        return true;
    }
};
struct EpiMoe1 {
    static constexpr bool AFTER_DRAIN = false;
    unsigned char* act; const float* b1;
    DI void operator()(const f32x4 (&acc)[2][2][4][2], const pg8::UnitD& u, int wr, int wc, int fr, int fq) const {
        { int ln_ = threadIdx.x; asm volatile("" : "+v"(ln_)); fr = ln_ & 15; fq = (ln_ >> 4) & 3; }
        const int j0 = u.pn * 128 + wc * 32 + 8 * fq;
        const float* bg = b1 + (size_t)u.e * 4096 + j0; const float* bu = bg + 2048;
        const f32x4 bg0 = *(const f32x4*)bg, bg1 = *(const f32x4*)(bg + 4), bu0 = *(const f32x4*)bu, bu1 = *(const f32x4*)(bu + 4);
#pragma unroll
        for (int ai = 0; ai < 2; ++ai)
#pragma unroll
            for (int m = 0; m < 4; ++m) { const size_t row = (size_t)u.e * 8192 + u.x0 * 256 + ai * 128 + wr * 64 + m * 16 + fr;
                float o[8];
#pragma unroll
                for (int n = 0; n < 2; ++n) {
                    f32x4 g = acc[ai][0][m][n] * (1.f / 256.f) + (n ? bg1 : bg0);
                    g = __builtin_elementwise_min(g, (f32x4){7.f, 7.f, 7.f, 7.f});
                    f32x4 uu = acc[ai][1][m][n] * (1.f / 256.f) + (n ? bu1 : bu0);
                    uu = __builtin_elementwise_min(__builtin_elementwise_max(uu, (f32x4){-7.f, -7.f, -7.f, -7.f}), (f32x4){7.f, 7.f, 7.f, 7.f});
                    f32x4 t = g * (-1.702f * 1.4426950408889634f);
                    t = (f32x4){__builtin_amdgcn_exp2f(t[0]), __builtin_amdgcn_exp2f(t[1]), __builtin_amdgcn_exp2f(t[2]), __builtin_amdgcn_exp2f(t[3])} + 1.f;
                    const f32x4 r = {__builtin_amdgcn_rcpf(t[0]), __builtin_amdgcn_rcpf(t[1]), __builtin_amdgcn_rcpf(t[2]), __builtin_amdgcn_rcpf(t[3])};
                    const f32x4 ov = g * r * (uu * 4.f + 4.f);
#pragma unroll
                    for (int e = 0; e < 4; ++e) o[n * 4 + e] = ov[e]; }
                u32x2 w; w.x = __builtin_amdgcn_cvt_pk_fp8_f32(o[0], o[1], 0u, false); w.x = __builtin_amdgcn_cvt_pk_fp8_f32(o[2], o[3], w.x, true);
                w.y = __builtin_amdgcn_cvt_pk_fp8_f32(o[4], o[5], 0u, false); w.y = __builtin_amdgcn_cvt_pk_fp8_f32(o[6], o[7], w.y, true);
                *(u32x2*)(act + row * 2048 + j0) = w;
                __builtin_amdgcn_sched_barrier(0); }
    }
};
struct EpiMoe2 {
    static constexpr bool AFTER_DRAIN = false;
    unsigned char* y; const float* b2; const float* gate_of;
    DI void operator()(const f32x4 (&acc)[2][2][4][2], const pg8::UnitD& u, int wr, int wc, int fr, int fq) const {
        { int ln_ = threadIdx.x; asm volatile("" : "+v"(ln_)); fr = ln_ & 15; fq = (ln_ >> 4) & 3; }
        const int col0 = u.pn * 256 + wc * 32 + 8 * fq;
        const float* bp = b2 + (size_t)u.e * 2048 + col0;
        const f32x4 bb[2][2] = {{*(const f32x4*)(bp), *(const f32x4*)(bp + 4)}, {*(const f32x4*)(bp + 128), *(const f32x4*)(bp + 132)}};
        const float* gp = gate_of + (size_t)u.e * 8192 + u.x0 * 256 + wr * 64 + fr;
        float gts[2][4];
#pragma unroll
        for (int ai = 0; ai < 2; ++ai)
#pragma unroll
            for (int m = 0; m < 4; ++m) gts[ai][m] = gp[ai * 128 + m * 16];
#pragma unroll
        for (int ai = 0; ai < 2; ++ai)
#pragma unroll
            for (int m = 0; m < 4; ++m) { const int rl = ai * 128 + wr * 64 + m * 16 + fr; const size_t row = (size_t)u.e * 8192 + u.x0 * 256 + rl;
                const float gt = (rl < u.nvalid) ? gts[ai][m] * 32.f : 0.f;
#pragma unroll
                for (int bj = 0; bj < 2; ++bj) { const f32x4 v0 = (acc[ai][bj][m][0] * (1.f / 256.f) + bb[bj][0]) * gt, v1 = (acc[ai][bj][m][1] * (1.f / 256.f) + bb[bj][1]) * gt;
                    u32x2 w; w.x = __builtin_amdgcn_cvt_pk_fp8_f32(v0[0], v0[1], 0u, false); w.x = __builtin_amdgcn_cvt_pk_fp8_f32(v0[2], v0[3], w.x, true);
                    w.y = __builtin_amdgcn_cvt_pk_fp8_f32(v1[0], v1[1], 0u, false); w.y = __builtin_amdgcn_cvt_pk_fp8_f32(v1[2], v1[3], w.y, true);
                    *(u32x2*)(y + row * 2048 + col0 + bj * 128) = w; } }
    }
};

DI void p11_combine(Frame& F, const ArgP& a) {
    const int gw = F.vcu * NWAVES + F.wave, NGW = F.G * NWAVES, lane = F.lane;
    const bf16_t* h2 = (const bf16_t*)(F.ws + WS_H2); const unsigned char* y = (const unsigned char*)(F.ws + WS_Y);
    const int* tok_e = (const int*)(F.ws + WS_TOKE);
    for (int t = gw; t < NTOK; t += NGW) {
        size_t yrow[4];
#pragma unroll
        for (int k = 0; k < 4; ++k) yrow[k] = (size_t)tok_e[t * 4 + k] * 2048;
#pragma unroll
        for (int j = 0; j < 8; ++j) { const int c = (lane + 64 * j) * 4;
            const u32x2 hw = *(const u32x2*)(h2 + (size_t)t * 2048 + c); f32x4 v = {bflo(hw.x), bfhi(hw.x), bflo(hw.y), bfhi(hw.y)};
#pragma unroll
            for (int k = 0; k < 4; ++k) { const unsigned w = *(const unsigned*)(y + yrow[k] + c); const f32x2 lo = __builtin_amdgcn_cvt_pk_f32_fp8(w, false), hi = __builtin_amdgcn_cvt_pk_f32_fp8(w, true);
                v.x += lo.x * (1.f / 32.f); v.y += lo.y * (1.f / 32.f); v.z += hi.x * (1.f / 32.f); v.w += hi.y * (1.f / 32.f); }
            *(f32x4*)(a.out() + (size_t)t * 2048 + c) = v; }
    }
}

#ifndef MK_PER_PHASE
#define MK_PER_PHASE 0
#endif
#ifndef MK_LAST_PHASE
#define MK_LAST_PHASE 12
#endif
constexpr int N_PHASES = MK_LAST_PHASE;

__global__ void __launch_bounds__(NWAVES * 64, 2) mega_fwd(Args args_) {
    const ArgP args{};
    extern __shared__ __attribute__((aligned(16))) unsigned char lds_raw[];
    Frame F;
    F.lds = (LAS unsigned char*)lds_raw;
    F.MISC = (volatile LAS unsigned*)(F.lds + MISC_OFF);
    F.tid = threadIdx.x; F.lane = F.tid & 63; F.wave = __builtin_amdgcn_readfirstlane(F.tid >> 6);
    F.G = gridDim.x; { const int bx = blockIdx.x; F.vcu = (F.G % 8 == 0) ? (bx % 8) * (F.G / 8) + bx / 8 : bx; }
    F.ws = args_.ws; F.ctl = (unsigned*)(args_.ws + WS_CTL);
    for (int u = F.tid; u < 256; u += NWAVES * 64) F.MISC[u] = 0u;
    __syncthreads();
    XcdBarrier bar; bar.bar = F.ctl + CW_BAR; bar.x = 0; bar.st = nullptr;
    const int lo = args_.ph_lo, hi = args_.ph_hi;
    if (hi - lo > 1) bar = xcd_barrier_post(F.ctl + CW_BAR, F.MISC + 8);
#ifndef MK_PHASE_MASK
#define MK_PHASE_MASK 0xFFFF
#endif
#define IN(k) (((MK_PHASE_MASK >> (k)) & 1) && lo <= (k) && (k) < hi)
#define SEAM(k) do { if (IN(k) && IN((k) + 1)) xcd_barrier(bar); } while (0)
#define FRESH() do { int t_ = threadIdx.x; asm volatile("" : "+v"(t_)); F.tid = t_; F.lane = t_ & 63; F.wave = __builtin_amdgcn_readfirstlane(t_ >> 6); } while (0)
    unsigned char* ws = args_.ws;

    if (IN(0)) { FRESH(); p0_prologue(F, args); }
    SEAM(0);
    if (IN(1)) { FRESH();
        const bool conv_first = (F.vcu & 1) == 0;
        if (conv_first) { conv_share(F, args); __syncthreads(); }
        SchedP1 S{F.G, F.vcu, ws, 0, 32 * 23};
        EpiP1 E{(bf16_t*)(ws + WS_PROJ), (float*)(ws + WS_DT), (bf16_t*)(ws + WS_KVRAW), args.in(I_DAQG), args.in(I_DAKG), (unsigned char*)(ws + WS_VF8)};
        pg8::gemm_phase<EpiP1, SchedP1, false, true>(F.lds + RING_OFF, 32, S, E);
        if (!conv_first) { __syncthreads(); conv_share(F, args); }
    }
    SEAM(1);
    if (IN(2)) { FRESH();
        if ((F.vcu & 3) == 1) {
            SchedP1 S{(F.G + 3) >> 2, F.vcu >> 2, ws, 32 * 23, 32 * 23 + 64};
            EpiP1 E{(bf16_t*)(ws + WS_PROJ), (float*)(ws + WS_DT), (bf16_t*)(ws + WS_KVRAW), args.in(I_DAQG), args.in(I_DAKG), (unsigned char*)(ws + WS_VF8)};
            pg8::gemm_phase<EpiP1, SchedP1, false, true>(F.lds + RING_OFF, 32, S, E);
            __syncthreads();
        }
        if ((F.vcu & 3) == 0) { for (int u = F.vcu >> 2; u < 64; u += (F.G + 3) >> 2) ssd_unit(F, args, u >> 4, u & 15); }
        __syncthreads();
        attn_phase_da(F);
        __syncthreads();
        conv_queue(F, args, CW_QCONV, CV_NJ - CV_TAIL, CV_TAIL1);
    }
    SEAM(2);
    if (IN(3)) { FRESH(); kprep(F, args); p3_finalize(F, args); }
    SEAM(3);
    if (IN(4)) { FRESH();
        SchedDense S{F.G, F.vcu, 32, 8, (const char*)(ws + WS_YCAT), (const char*)(ws + WS_WOUT), 4096u, 4096u, 1 << 30, 0};
        EpiResid<false> E{args.in(I_X), (bf16_t*)(ws + WS_H1), (float*)(ws + WS_PART1), (unsigned char*)(ws + WS_H1F8), 1.f};
        pg8::gemm_phase<EpiResid<false>, SchedDense, false, true>(F.lds + RING_OFF, 32, S, E);
    }
    SEAM(4);
    if (IN(5)) { FRESH();
        SchedDense S{F.G, F.vcu, 32, 8, (const char*)(ws + WS_H1F8), (const char*)(ws + WS_WQ), 2048u, 2048u, 1 << 30, 0};
        EpiQ E{(unsigned char*)(ws + WS_QF8), (float*)(ws + WS_PARTQ)};
        pg8::gemm_phase<EpiQ, SchedDense, false, true, true>(F.lds + RING_OFF, 16, S, E);
    }
    SEAM(5);
    if (IN(6)) { FRESH();
        SchedXS S{F.G, F.vcu, ws};
        EpiXS E{(unsigned char*)(ws + WS_P8), (unsigned char*)(ws + WS_VWT8), (const float*)(ws + WS_PART1), (const float*)(ws + WS_PARTQ), (LAS float*)(F.lds + RING_BYTES)};
        pg8::gemm_phase<EpiXS, SchedXS, false, true, true>(F.lds + RING_OFF, 4, S, E);
    }
    SEAM(6);
    if (IN(7)) { FRESH();
        SchedDense S{F.G, F.vcu, 32, 8, (const char*)(ws + WS_P8), (const char*)(ws + WS_VWT8), 1024u, 1024u, 8, (size_t)2048 * 1024};
        EpiResid<true> E{(const void*)(ws + WS_H1), (bf16_t*)(ws + WS_H2), nullptr, nullptr, 1.f / 8192.f};
        pg8::gemm_phase<EpiResid<true>, SchedDense, false, true, true>(F.lds + RING_OFF, 8, S, E);
    }
    SEAM(7);
    if (IN(8)) { FRESH(); p8_route(F, args); }
    SEAM(8);
    if (IN(9)) { FRESH();
        moe_tables(F);
        SchedMoe<16> S{F.G, F.vcu, ws, F.MISC, ldsu(F.MISC + 112) * 16};
        EpiMoe1 E{(unsigned char*)(ws + WS_ACT), args.in(I_B1)};
        pg8::gemm_phase<EpiMoe1, SchedMoe<16>, false, true, true>(F.lds + RING_OFF, 16, S, E);
        __syncthreads();
        conv_queue(F, args, CW_QCONV2, CV_NJ - CV_TAIL2, CV_TAIL2);
    }
    SEAM(9);
    if (IN(10)) { FRESH();
        moe_tables(F);
        SchedMoe<8> S{F.G, F.vcu, ws, F.MISC, ldsu(F.MISC + 112) * 8};
        EpiMoe2 E{(unsigned char*)(ws + WS_Y), args.in(I_B2), (const float*)(ws + WS_GATEOF)};
        pg8::gemm_phase<EpiMoe2, SchedMoe<8>, false, true, true>(F.lds + RING_OFF, 16, S, E);
    }
    SEAM(10);
    if (IN(11)) { FRESH(); p11_combine(F, args); }
#undef IN
#undef SEAM
}

#ifdef MK_PROBE2
__global__ void __launch_bounds__(NWAVES * 64, 2) moe_probe(Args args_) {
    const ArgP args{};
    extern __shared__ __attribute__((aligned(16))) unsigned char lds_raw[];
    Frame F;
    F.lds = (LAS unsigned char*)lds_raw;
    F.MISC = (volatile LAS unsigned*)(F.lds + MISC_OFF);
    F.tid = threadIdx.x; F.lane = F.tid & 63; F.wave = __builtin_amdgcn_readfirstlane(F.tid >> 6);
    F.G = gridDim.x; { const int bx = blockIdx.x; F.vcu = (F.G % 8 == 0) ? (bx % 8) * (F.G / 8) + bx / 8 : bx; }
    F.ws = args_.ws; F.ctl = (unsigned*)(args_.ws + WS_CTL);
    for (int u = F.tid; u < 256; u += NWAVES * 64) F.MISC[u] = 0u;
    __syncthreads();
    unsigned char* ws = args_.ws;
    moe_tables(F);
    if (args_.ph_lo == 9) {
        SchedMoe<16> S{F.G, F.vcu, ws, F.MISC, ldsu(F.MISC + 112) * 16};
        EpiMoe1 E{(unsigned char*)(ws + WS_ACT), args.in(I_B1)};
#if MK_PROBE2 == 1
        pg8::gemm_phase<EpiMoe1, SchedMoe<16>, false, true, true>(F.lds + RING_OFF, 16, S, E);
#elif MK_PROBE2 == 2
        pg8::gemm_phase2<EpiMoe1, SchedMoe<16>, true>(F.lds + RING_OFF, 16, S, E);
#else
        pg8::gemm_phase3<EpiMoe1, SchedMoe<16>, true>(F.lds + RING_OFF, 16, S, E);
#endif
    } else {
        SchedMoe<8> S{F.G, F.vcu, ws, F.MISC, ldsu(F.MISC + 112) * 8};
        EpiMoe2 E{(unsigned char*)(ws + WS_Y), args.in(I_B2), (const float*)(ws + WS_GATEOF)};
#if MK_PROBE2 == 1
        pg8::gemm_phase<EpiMoe2, SchedMoe<8>, false, true, true>(F.lds + RING_OFF, 16, S, E);
#elif MK_PROBE2 == 2
        pg8::gemm_phase2<EpiMoe2, SchedMoe<8>, true>(F.lds + RING_OFF, 16, S, E);
#else
        pg8::gemm_phase3<EpiMoe2, SchedMoe<8>, true>(F.lds + RING_OFF, 16, S, E);
#endif
    }
}
#endif

extern "C" void kernel_launch(void* const* d_in, const int* in_sizes, int n_in, void* d_out, int out_size, void* d_ws, size_t ws_size, hipStream_t stream) {
    static int grid = 0;
    if (grid == 0) {
        if (n_in != 32 || out_size != NTOK * 2048 || ws_size < WS_END) { fprintf(stderr, "kernel_launch: unexpected shapes (n_in %d out %d ws %zu); nothing launched\n", n_in, out_size, ws_size); grid = -1; return; }
        int dev = 0, cus = 0, per_cu = 0;
        if (hipGetDevice(&dev) != hipSuccess || hipDeviceGetAttribute(&cus, hipDeviceAttributeMultiprocessorCount, dev) != hipSuccess) { grid = -1; return; }
        if (hipFuncSetAttribute((const void*)mega_fwd, hipFuncAttributeMaxDynamicSharedMemorySize, LDS_BYTES) != hipSuccess) { fprintf(stderr, "kernel_launch: hipFuncSetAttribute failed\n"); grid = -1; return; }
        if (hipOccupancyMaxActiveBlocksPerMultiprocessor(&per_cu, (const void*)mega_fwd, NWAVES * 64, LDS_BYTES) != hipSuccess || per_cu < 1) { fprintf(stderr, "kernel_launch: occupancy query says %d\n", per_cu); }
        (void)hipGetLastError();
        if (cus < 256) { fprintf(stderr, "kernel_launch: needs 256 CUs, found %d; nothing launched\n", cus); grid = -1; return; }
        grid = 256;
    }
    if (grid < 0) return;
    if (hipMemsetAsync((char*)d_ws + WS_CTL, 0, CTL_ZERO_BYTES, stream) != hipSuccess) return;
    Args a{};
    for (int i = 0; i < 32; ++i) a.in[i] = (const float*)d_in[i];
    a.out = (float*)d_out; a.ws = (unsigned char*)d_ws;
#if MK_PER_PHASE
    for (int p = 0; p < N_PHASES; ++p) { a.ph_lo = p; a.ph_hi = p + 1; hipLaunchKernelGGL(mega_fwd, dim3(grid), dim3(NWAVES * 64), LDS_BYTES, stream, a); }
#else
    a.ph_lo = 0; a.ph_hi = N_PHASES;
    hipLaunchKernelGGL(mega_fwd, dim3(grid), dim3(NWAVES * 64), LDS_BYTES, stream, a);
#ifdef MK_PROBE2
    (void)hipFuncSetAttribute((const void*)moe_probe, hipFuncAttributeMaxDynamicSharedMemorySize, LDS_BYTES);
#ifdef MK_HOTPROBE
    a.probe = MK_HOTPROBE;
#endif
    for (int p = 9; p < 11; ++p) { a.ph_lo = p; a.ph_hi = p + 1; hipLaunchKernelGGL(moe_probe, dim3(grid), dim3(NWAVES * 64), LDS_BYTES, stream, a); }
#endif
#ifdef MK_PROBE_LO
    for (int p = MK_PROBE_LO; p < MK_PROBE_HI; ++p) { a.ph_lo = p; a.ph_hi = p + 1;
#ifdef MK_HOTPROBE
        a.probe = MK_HOTPROBE;
#endif
        if (p == 2) (void)hipMemsetAsync((char*)d_ws + WS_CTL + CW_QATT * 4, 0, 1024, stream);
        hipLaunchKernelGGL(mega_fwd, dim3(grid), dim3(NWAVES * 64), LDS_BYTES, stream, a); }
#endif
#endif
}
```

```cpp
#define MK_PER_PHASE 0
#define MK_LAST_PHASE 12
#include <hip/hip_runtime.h>
#include <hip/hip_bf16.h>
#include <cstdio>
#include <cstdint>
#include <cmath>

#define GAS __attribute__((address_space(1)))
#define LAS __attribute__((address_space(3)))
typedef unsigned short bf16_t;
typedef short bf16x8 __attribute__((ext_vector_type(8)));
typedef float f32x2 __attribute__((ext_vector_type(2)));
typedef float f32x4 __attribute__((ext_vector_type(4)));
typedef float f32x16 __attribute__((ext_vector_type(16)));
typedef unsigned u32x2 __attribute__((ext_vector_type(2)));
typedef unsigned u32x4 __attribute__((ext_vector_type(4)));
typedef __bf16 bf16x2_t __attribute__((ext_vector_type(2)));

#define DI __device__ __forceinline__
DI int lane_id() { int l_; asm volatile("v_mbcnt_lo_u32_b32 %0, -1, 0\n\tv_mbcnt_hi_u32_b32 %0, -1, %0" : "=v"(l_)); return l_; }
DI unsigned pk2(float lo, float hi) { f32x2 v = {lo, hi}; bf16x2_t b = __builtin_convertvector(v, bf16x2_t); return __builtin_bit_cast(unsigned, b); }
DI float bflo(unsigned u) { return __uint_as_float(u << 16); }
DI float bfhi(unsigned u) { return __uint_as_float(u & 0xffff0000u); }
DI float bf2f(bf16_t h) { return __uint_as_float(((unsigned)h) << 16); }
DI float wave_sum(float v) {
#pragma unroll
    for (int o = 1; o < 64; o <<= 1) v += __shfl_xor(v, o);
    return v;
}
DI float quad_sum_16_32(float v) {
    int l_ = lane_id(); asm volatile("" : "+v"(l_));
    const int a16 = ((l_ ^ 16) & 63) << 2, a32 = ((l_ ^ 32) & 63) << 2;
    v += __builtin_bit_cast(float, __builtin_amdgcn_ds_bpermute(a16, __builtin_bit_cast(int, v)));
    v += __builtin_bit_cast(float, __builtin_amdgcn_ds_bpermute(a32, __builtin_bit_cast(int, v)));
    return v;
}
DI float siluf(float x) { return x / (1.f + __expf(-x)); }

constexpr int DM_ = 2048, NB = 4, SEQ_ = 2048, NTOK = NB * SEQ_;
constexpr int PP = 5632;
constexpr int PC_XBC = 1024, PC_Q = 2560, PC_K = 3584, PC_V = 4608, PC_DT = 5632;
constexpr int WIN_ROWS = 5888;
constexpr int NEXP = 32, MEMLEN = 256;
constexpr float EPS_ = 1e-6f;
constexpr float LAM_INIT = 0.2f;

namespace pg8 {
constexpr int BM = 256, BK = 64, HALF = 128, HTB = HALF * BK * 2  , STAGE_BYTES = 8 * HTB;
DI int lds_byte(int r, int c) { const int st = (r >> 4) * 2 + (c >> 5), rr = r & 15, cc = c & 31, ob = rr * 64 + cc * 2; return st * 1024 + (ob ^ (((ob >> 9) & 1) << 5)); }
DI void stage_rc(int b, int& R, int& C) { const int st = b / 1024, sb = b % 1024, swz = sb ^ (((sb >> 9) & 1) << 5); R = (st >> 1) * 16 + swz / 64; C = (st & 1) * 32 + (swz % 64) / 2; }
DI int perm32(int rho) { const int n = rho >> 4, i = rho & 15; return 8 * (i >> 2) + 4 * n + (i & 3); }

struct UnitD {
    const char* A; const char* B;
    const int* rows;
    unsigned lda, ldb;
    int nvalid;
    int type, pm, pn, e, x0;
};
typedef int v8i_t __attribute__((ext_vector_type(8)));
DI v8i_t cat8(bf16x8 lo, bf16x8 hi) { typedef int v4i_t __attribute__((ext_vector_type(4))); const v4i_t a = __builtin_bit_cast(v4i_t, lo), b = __builtin_bit_cast(v4i_t, hi); return (v8i_t){a[0], a[1], a[2], a[3], b[0], b[1], b[2], b[3]}; }
DI void dense_voff(unsigned lda, unsigned ldb, int tid, unsigned (&vA)[2], unsigned (&vB)[2]) {
#pragma unroll
    for (int i = 0; i < 2; ++i) { int R, C; stage_rc(tid * 16 + i * 8192, R, C); const int Rb = (R & ~31) + perm32(R & 31);
        vA[i] = (unsigned)R * lda + (unsigned)C * 2u; vB[i] = (unsigned)Rb * ldb + (unsigned)C * 2u; }
}
DI void gather_voff(const UnitD& u, int tid, unsigned (&gA)[2][2]) {
#pragma unroll
    for (int i = 0; i < 2; ++i) { int R, C; stage_rc(tid * 16 + i * 8192, R, C);
#pragma unroll
        for (int h = 0; h < 2; ++h) { const int ra = h * 128 + R; const unsigned rowA = (ra < u.nvalid) ? (unsigned)u.rows[ra] : 0u; gA[h][i] = rowA * u.lda + (unsigned)C * 2u; } }
}

template <class Epi, class Sched, bool GATHER, bool ALIGN_EPI, bool FP8 = false>
DI void gemm_phase(int wv, LAS unsigned char* lds, int nt, const Sched& S, const Epi& E) {

    int lane_ = lane_id(); asm volatile("" : "+v"(lane_)); const int wid = wv, lane = lane_, tid = wid * 64 + lane, wr = wid >> 2, wc = wid & 3, fr = lane & 15, fq = lane >> 4;
#ifndef MK_HOTPROBE
#define PG8_NODMA false
#define PG8_NOMMA false
#define PG8_NOLD false
#define PG8_NOEPI false
#define PG8_NOLOOP false
#else
#define PG8_NODMA ((hot_ & 4) != 0)
#define PG8_NOMMA ((hot_ & 8) != 0)
#define PG8_NOLD ((hot_ & 16) != 0)
#define PG8_NOEPI ((hot_ & 32) != 0)
#define PG8_NOLOOP ((hot_ & 64) != 0)
#endif
#ifdef MK_HOTPROBE
    int hot_; { typedef const __attribute__((address_space(4))) char* kptr; kptr kp = (kptr)__builtin_amdgcn_kernarg_segment_ptr(); asm volatile("" : "+s"(kp)); hot_ = *(const int __attribute__((address_space(4)))*)(kp + 280); }
    const size_t kstep = (hot_ & 1) ? (size_t)0 : (size_t)(BK * 2);
#else
    const size_t kstep = (size_t)(BK * 2);
#endif
    const unsigned ldsb = (unsigned)__builtin_amdgcn_readfirstlane((int)((unsigned)(uintptr_t)lds + (unsigned)wid * 1024u));
    const int aoff = lds_byte(wr * 64 + fr, fq * 8), boff = lds_byte(wc * 32 + fr, fq * 8);
#define PG8_SA(b, h) (((b) * 2 + (h)) * HTB)
#define PG8_SB(b, h) ((4 + (b) * 2 + (h)) * HTB)
#define PG8_STAGE(bufoff, gbase, voff) do { if (PG8_NODMA) break; _Pragma("unroll") for (int _i = 0; _i < 2; ++_i) { unsigned keep_; \
        asm volatile("s_mov_b32 %0, m0\n\ts_mov_b32 m0, %3\n\ts_nop 0\n\tglobal_load_lds_dwordx4 %1, %2\n\ts_mov_b32 m0, %0" \
                     : "=&s"(keep_) : "v"((voff)[_i]), "s"((const char*)(gbase)), "s"(ldsb + (unsigned)((bufoff) + _i * 8192)) : "memory"); } } while (0)
#define PG8_STA(bufoff, gbase, h, HS, GA) do { if constexpr (GATHER) { PG8_STAGE(bufoff, gbase, GA[h]); } else { PG8_STAGE(bufoff, (gbase) + (h) * (HS), vA); } } while (0)
#define PG8_STB(bufoff, gbase, h, HS) PG8_STAGE(bufoff, (gbase) + (h) * (HS), vB)
typedef int v4i_t __attribute__((ext_vector_type(4)));
#define PG8_LDA(dst, b, h) do { if (PG8_NOLD) break; _Pragma("unroll") for (int m = 0; m < 4; ++m) { if constexpr (FP8) { \
            const v4i_t lo_ = *(const LAS v4i_t*)(lds + PG8_SA(b, h) + aoff + m * 2048), hi_ = *(const LAS v4i_t*)(lds + PG8_SA(b, h) + aoff + m * 2048 + 1024); \
            dst##8[m] = __builtin_shufflevector(lo_, hi_, 0, 1, 2, 3, 4, 5, 6, 7); } \
        else { _Pragma("unroll") for (int k = 0; k < 2; ++k) dst[m][k] = *(const LAS bf16x8*)(lds + PG8_SA(b, h) + aoff + m * 2048 + k * 1024); } } } while (0)
#define PG8_LDB(dst, b, h) do { if (PG8_NOLD) break; _Pragma("unroll") for (int n = 0; n < 2; ++n) { if constexpr (FP8) { \
            const v4i_t lo_ = *(const LAS v4i_t*)(lds + PG8_SB(b, h) + boff + n * 2048), hi_ = *(const LAS v4i_t*)(lds + PG8_SB(b, h) + boff + n * 2048 + 1024); \
            dst##8[n] = __builtin_shufflevector(lo_, hi_, 0, 1, 2, 3, 4, 5, 6, 7); } \
        else { _Pragma("unroll") for (int k = 0; k < 2; ++k) dst[n][k] = *(const LAS bf16x8*)(lds + PG8_SB(b, h) + boff + n * 2048 + k * 1024); } } } while (0)
#ifndef PG8_FP8_PRIO
#define PG8_FP8_PRIO 1
#endif
#define PG8_MMA(ai, bj, At, Bt) do { if (PG8_NOMMA) break; if (!FP8 || PG8_FP8_PRIO) __builtin_amdgcn_s_setprio(1); _Pragma("unroll") for (int m = 0; m < 4; ++m) _Pragma("unroll") for (int n = 0; n < 2; ++n) { \
        if constexpr (FP8) { acc[ai][bj][m][n] = __builtin_amdgcn_mfma_scale_f32_16x16x128_f8f6f4(Bt##8[n], At##8[m], acc[ai][bj][m][n], 0, 0, 0, 0x7f7f7f7f, 0, 0x7f7f7f7f); } \
        else { _Pragma("unroll") for (int k = 0; k < 2; ++k) acc[ai][bj][m][n] = __builtin_amdgcn_mfma_f32_16x16x32_bf16(Bt[n][k], At[m][k], acc[ai][bj][m][n], 0, 0, 0); } } \
        if (!FP8 || PG8_FP8_PRIO) __builtin_amdgcn_s_setprio(0); } while (0)
#define PG8_WAIT_V(n) asm volatile("s_waitcnt vmcnt(" #n ")" ::: "memory")
#define PG8_WAIT_L(n) asm volatile("s_waitcnt lgkmcnt(" #n ")" ::: "memory")
#define PG8_BAR __builtin_amdgcn_s_barrier()
#define PG8_SCHED __builtin_amdgcn_sched_barrier(0)
#define PG8_ITER(A1P, A2P, B2P, HA2, HB2, GA2) do { \
        const char* a3p_ = (A2P) + kstep; const char* b3p_ = (B2P) + kstepB; \
        PG8_LDB(B0, 0, 0); PG8_LDB(B1, 0, 1); PG8_SCHED; PG8_LDA(At, 0, 0); PG8_STA(PG8_SA(1, 1), (A1P), 1, hsA, gA); \
        PG8_WAIT_V(8); PG8_WAIT_L(0); PG8_BAR; PG8_MMA(0, 0, At, B0); PG8_MMA(0, 1, At, B1); PG8_BAR; PG8_SCHED; \
        PG8_LDA(At, 0, 1); PG8_STB(PG8_SB(0, 0), (B2P), 0, HB2); PG8_STB(PG8_SB(0, 1), (B2P), 1, HB2); PG8_STA(PG8_SA(0, 0), (A2P), 0, HA2, GA2); \
        PG8_WAIT_V(8); PG8_WAIT_L(0); PG8_BAR; PG8_MMA(1, 0, At, B0); PG8_MMA(1, 1, At, B1); PG8_BAR; PG8_SCHED; \
        PG8_LDB(B0, 1, 0); PG8_LDB(B1, 1, 1); PG8_SCHED; PG8_LDA(At, 1, 0); PG8_STA(PG8_SA(0, 1), (A2P), 1, HA2, GA2); \
        PG8_WAIT_V(8); PG8_WAIT_L(0); PG8_BAR; PG8_MMA(0, 0, At, B0); PG8_MMA(0, 1, At, B1); PG8_BAR; PG8_SCHED; \
        PG8_LDA(At, 1, 1); PG8_STB(PG8_SB(1, 0), b3p_, 0, HB2); PG8_STB(PG8_SB(1, 1), b3p_, 1, HB2); PG8_STA(PG8_SA(1, 0), a3p_, 0, HA2, GA2); \
        PG8_WAIT_V(8); PG8_WAIT_L(0); PG8_BAR; PG8_MMA(1, 0, At, B0); PG8_MMA(1, 1, At, B1); PG8_BAR; PG8_SCHED; \
    } while (0)
    UnitD cur, nxt; int ui = 0;
    if (!S.next(0, cur)) return;
    f32x4 acc[2][2][4][2];
#pragma unroll
    for (int a = 0; a < 2; ++a)
#pragma unroll
        for (int b = 0; b < 2; ++b)
#pragma unroll
            for (int m = 0; m < 4; ++m)
#pragma unroll
                for (int n = 0; n < 2; ++n) acc[a][b][m][n] = (f32x4){0.f, 0.f, 0.f, 0.f};
    bf16x8 At[4][2], B0[2][2], B1[2][2]; v8i_t At8[4], B08[2], B18[2];
    unsigned vA[2], vB[2], gA[2][2], ngA[2][2];
    dense_voff(cur.lda, cur.ldb, tid, vA, vB);
#ifdef MK_HOTPROBE
    const size_t kstepB = (hot_ & 2) ? (size_t)0 : ((cur.ldb == 128u) ? (size_t)32768 : (size_t)(BK * 2));
#else
    const size_t kstepB = (cur.ldb == 128u) ? (size_t)32768 : kstep;
#endif
    if constexpr (GATHER) gather_voff(cur, tid, gA);
    const char* cA = cur.A; const char* cB = cur.B;
    size_t hsA = GATHER ? 0 : (size_t)cur.lda * HALF, hsB = (size_t)cur.ldb * HALF;
    PG8_STB(PG8_SB(0, 0), cB, 0, hsB); PG8_STB(PG8_SB(0, 1), cB, 1, hsB); PG8_STA(PG8_SA(0, 0), cA, 0, hsA, gA); PG8_STA(PG8_SA(0, 1), cA, 1, hsA, gA);
    if (wr == 1) PG8_BAR;
    PG8_WAIT_V(2); PG8_BAR;
    PG8_STB(PG8_SB(1, 0), cB + kstepB, 0, hsB); PG8_STA(PG8_SA(1, 0), cA + kstep, 0, hsA, gA); PG8_STB(PG8_SB(1, 1), cB + kstepB, 1, hsB);
    PG8_WAIT_V(6); PG8_BAR;
    for (;;) {
        const bool has_next = S.next(ui + 1, nxt);
        const char* nA = cA; const char* nB = cB; size_t nhsA = hsA, nhsB = hsB;
        if (has_next) { nA = nxt.A; nB = nxt.B; nhsA = GATHER ? 0 : (size_t)nxt.lda * HALF; nhsB = (size_t)nxt.ldb * HALF; }
        if constexpr (GATHER) {
            if (has_next) gather_voff(nxt, tid, ngA);
            else {
#pragma unroll
                for (int h = 0; h < 2; ++h)
#pragma unroll
                    for (int i = 0; i < 2; ++i) ngA[h][i] = gA[h][i];
            }
        }
#pragma unroll 1
        for (int t = 0; t < (PG8_NOLOOP ? 0 : nt); t += 2) {
            const bool last = (t == nt - 2);
            const char* a2 = last ? nA : cA + (size_t)(t + 2) * kstep; const char* b2 = last ? nB : cB + (size_t)(t + 2) * kstepB;
            const size_t hA2 = last ? nhsA : hsA, hB2 = last ? nhsB : hsB;
            unsigned g2[2][2];
            if constexpr (GATHER) {
#pragma unroll
                for (int h = 0; h < 2; ++h)
#pragma unroll
                    for (int i = 0; i < 2; ++i) g2[h][i] = last ? ngA[h][i] : gA[h][i];
            }
            PG8_ITER(cA + (size_t)(t + 1) * kstep, a2, b2, hA2, hB2, g2);
        }
        if constexpr (ALIGN_EPI) { if (wr == 0) PG8_BAR; }
        if constexpr (!Epi::AFTER_DRAIN) { if (!PG8_NOEPI) E(acc, cur, wr, wc, fr, fq); }
        if (!has_next) break;
#pragma unroll
        for (int a = 0; a < 2; ++a)
#pragma unroll
            for (int b = 0; b < 2; ++b)
#pragma unroll
                for (int m = 0; m < 4; ++m)
#pragma unroll
                    for (int n = 0; n < 2; ++n) acc[a][b][m][n] = (f32x4){0.f, 0.f, 0.f, 0.f};
        cur = nxt; cA = nA; cB = nB; hsA = nhsA; hsB = nhsB; ++ui;
        if constexpr (GATHER) {
#pragma unroll
            for (int h = 0; h < 2; ++h)
#pragma unroll
                for (int i = 0; i < 2; ++i) gA[h][i] = ngA[h][i];
        }
        if constexpr (ALIGN_EPI) { if (wr == 1) PG8_BAR; }
    }
    PG8_WAIT_V(0);
    if constexpr (!ALIGN_EPI) { if (wr == 0) PG8_BAR; }
    PG8_BAR;
    if constexpr (Epi::AFTER_DRAIN) { E.fused(acc, cur, wr, wc, fr, fq, lds, wid, lane); }
#undef PG8_SA
#undef PG8_SB
#undef PG8_STAGE
#undef PG8_STA
#undef PG8_STB
#undef PG8_LDA
#undef PG8_LDB
#undef PG8_MMA
#undef PG8_WAIT_V
#undef PG8_WAIT_L
#undef PG8_BAR
#undef PG8_SCHED
#undef PG8_ITER
}

}
namespace attn_body {
using bf16=__hip_bfloat16;
using bf16x8=__attribute__((ext_vector_type(8)))short;
using s16x4=__attribute__((ext_vector_type(4)))short;
using f32x16=__attribute__((ext_vector_type(16)))float;
using u32x4=__attribute__((ext_vector_type(4)))unsigned;
constexpr int BATCH=4,SEQ=2048,D=64,DM=5632,OPITCH=1024;
constexpr int NW=8,QBLK=32,QB=QBLK*NW,KVBLK=64,NQB=SEQ/QB;
constexpr int ATTN_UNIT_ROWS=QB;
__device__ __forceinline__ int crow(int r,int hi){return (r&3)+8*(r>>2)+4*hi;}
#define SBAR() __builtin_amdgcn_sched_barrier(0)
__device__ __forceinline__ void cmask(f32x16&p0,f32x16&p1,int jb,int qrel,int hi){
  const float NEG=-INFINITY; int kb=64*jb+4*hi;
  #pragma unroll
  for(int r=0;r<16;++r){int kv=kb+(r&3)+8*(r>>2); if(kv>qrel)p0[r]=NEG; if(kv+32>qrel)p1[r]=NEG;}
}

constexpr int NSLOT=3, SLOTB=8192;
constexpr int LDS_K=0, LDS_V=NSLOT*SLOTB, LDS_WS=2*NSLOT*SLOTB, LDS_OST=LDS_WS+NW*64*4, LDS_BYTES=LDS_OST+NW*4096;
constexpr float C2=0.125f*1.4426950408889634f;
__device__ __forceinline__ void glds16(const void*gsrc,unsigned lds_dst){unsigned keep;
  asm volatile("s_mov_b32 %0, m0\n\ts_mov_b32 m0, %2\n\ts_nop 0\n\tglobal_load_lds_dwordx4 %1, off\n\ts_mov_b32 m0, %0":"=&s"(keep):"v"(gsrc),"s"(lds_dst):"memory");}
__device__ __forceinline__ float max3f(float a,float b,float c){float r;asm("v_max3_f32 %0, %1, %2, %3":"=v"(r):"v"(a),"v"(b),"v"(c));return r;}
__device__ __forceinline__ float max2f(float a,float b){float r;asm("v_max_f32_e32 %0, %1, %2":"=v"(r):"v"(a),"v"(b));return r;}
__device__ __forceinline__ float fadd_s(float a,float b){float r;asm("v_add_f32_e32 %0, %1, %2":"=v"(r):"v"(a),"v"(b));return r;}
__device__ __forceinline__ float fsub_s(float a,float b){float r;asm("v_sub_f32_e32 %0, %1, %2":"=v"(r):"v"(a),"v"(b));return r;}
typedef float f32x2_t __attribute__((ext_vector_type(2))); typedef __bf16 bf16x2_t __attribute__((ext_vector_type(2)));
__device__ __forceinline__ unsigned cvtpk_s(float lo,float hi){f32x2_t v={lo,hi};bf16x2_t b=__builtin_convertvector(v,bf16x2_t);return __builtin_bit_cast(unsigned,b);}
#define WAIT_BAR(N) asm volatile("s_waitcnt vmcnt(" #N ") lgkmcnt(0)\n\ts_barrier":::"memory")

__device__ __forceinline__ void qkt(f32x16&p0,f32x16&p1,const char*Kslot,const bf16x8*qr,const f32x16&negm,int r32,int hi){
  const char*kb=Kslot+hi*1024+r32*16;
  #pragma unroll
  for(int d0=0;d0<4;++d0){
    const bf16x8 b0=*reinterpret_cast<const bf16x8*>(kb+d0*2048);
    const bf16x8 b1=*reinterpret_cast<const bf16x8*>(kb+d0*2048+512);
    if(d0==0){p0=__builtin_amdgcn_mfma_f32_32x32x16_bf16(b0,qr[0],negm,0,0,0);p1=__builtin_amdgcn_mfma_f32_32x32x16_bf16(b1,qr[0],negm,0,0,0);}
    else{p0=__builtin_amdgcn_mfma_f32_32x32x16_bf16(b0,qr[d0],p0,0,0,0);p1=__builtin_amdgcn_mfma_f32_32x32x16_bf16(b1,qr[d0],p1,0,0,0);}}
}
typedef __attribute__((address_space(3))) const char* lds_cptr;
typedef short v4i16_t __attribute__((ext_vector_type(4)));
__device__ __forceinline__ void kload8(bf16x8*kf,lds_cptr kp){
  kf[0]=*(const __attribute__((address_space(3))) bf16x8*)(kp);      kf[1]=*(const __attribute__((address_space(3))) bf16x8*)(kp+512);
  kf[2]=*(const __attribute__((address_space(3))) bf16x8*)(kp+2048); kf[3]=*(const __attribute__((address_space(3))) bf16x8*)(kp+2560);
  kf[4]=*(const __attribute__((address_space(3))) bf16x8*)(kp+4096); kf[5]=*(const __attribute__((address_space(3))) bf16x8*)(kp+4608);
  kf[6]=*(const __attribute__((address_space(3))) bf16x8*)(kp+6144); kf[7]=*(const __attribute__((address_space(3))) bf16x8*)(kp+6656);
}
__device__ __forceinline__ void kload2(bf16x8*kf,lds_cptr kp,int j){ kf[2*j]=*(const __attribute__((address_space(3))) bf16x8*)(kp+j*2048); kf[2*j+1]=*(const __attribute__((address_space(3))) bf16x8*)(kp+j*2048+512); }
__device__ __forceinline__ s16x4 vtr(lds_cptr p){ return __builtin_bit_cast(s16x4,__builtin_amdgcn_ds_read_tr16_b64_v4i16((__attribute__((address_space(3))) v4i16_t*)p)); }
__device__ __forceinline__ float rowmax(const f32x16&p0,const f32x16&p1){
  float a=max3f(p0[0],p0[1],p1[0]),b=max3f(p0[2],p0[3],p1[1]);a=max3f(a,p1[2],p1[3]);
  #pragma unroll
  for(int r=4;r<16;r+=4){a=max3f(a,p0[r],p0[r+1]);b=max3f(b,p0[r+2],p0[r+3]);a=max3f(a,p1[r],p1[r+1]);b=max3f(b,p1[r+2],p1[r+3]);}
  const float m=max2f(a,b);
  auto rr=__builtin_amdgcn_permlane32_swap(__float_as_uint(m),__float_as_uint(m),false,false);
  return max2f(__uint_as_float(rr[0]),__uint_as_float(rr[1]));
}
__device__ __forceinline__ void pv(f32x16*o,int vb,bf16x8 pa0,bf16x8 pa1,bf16x8 pa2,bf16x8 pa3){
  #pragma unroll
  for(int d0=0;d0<2;++d0){s16x4 lo[4],hi[4];
    #pragma unroll
    for(int ks=0;ks<4;++ks){
      asm volatile("ds_read_b64_tr_b16 %0,%1 offset:%c2":"=&v"(lo[ks]):"v"(vb),"i"(d0*4096+ks*1024):"memory");
      asm volatile("ds_read_b64_tr_b16 %0,%1 offset:%c2":"=&v"(hi[ks]):"v"(vb),"i"(d0*4096+ks*1024+512):"memory");}
    asm volatile("s_waitcnt lgkmcnt(0)":::"memory");SBAR();
    #define PK(k) (bf16x8){lo[k][0],lo[k][1],lo[k][2],lo[k][3],hi[k][0],hi[k][1],hi[k][2],hi[k][3]}
    o[d0]=__builtin_amdgcn_mfma_f32_32x32x16_bf16(pa0,PK(0),o[d0],0,0,0);
    o[d0]=__builtin_amdgcn_mfma_f32_32x32x16_bf16(pa1,PK(1),o[d0],0,0,0);
    o[d0]=__builtin_amdgcn_mfma_f32_32x32x16_bf16(pa2,PK(2),o[d0],0,0,0);
    o[d0]=__builtin_amdgcn_mfma_f32_32x32x16_bf16(pa3,PK(3),o[d0],0,0,0);
    #undef PK
  }
}

#ifndef ATTN_STORE16
#define ATTN_STORE16(p,v) (*(u32x4*)(p)=(v))
#endif
template<int THRL> __device__ __forceinline__ void attn_unit(int b,int qcol,int vcol,int ocol,int qb,const bf16*Q,const bf16*__restrict__ K,const bf16*__restrict__ V,bf16*O,char*shm,unsigned*qctr,unsigned&ticket,int wv){
  int lane_=lane_id();asm volatile("":"+v"(lane_)); const int wid=wv,lane=lane_,tid=wid*64+lane,r32=lane&31,hi=lane>>5;
  const long rowbase=(long)b*SEQ; const int q0=qb*QB;
  const bf16*Qw=Q+(rowbase+q0+wid*QBLK)*DM+qcol;
  const bf16*Kh=K+rowbase*DM+qcol,*Vh=V+rowbase*DM+vcol;
  const unsigned lds0=(unsigned)(uintptr_t)shm;
  float*wsf=(float*)(shm+LDS_WS)+wid*64;
  const bf16*ksrc=Kh+(long)lane*DM+wid*8;
  const bf16*vsrc=Vh+(long)(16*(wid&3)+(lane>>2))*DM+(wid>>2)*32+(lane&3)*8;
  const unsigned kdst=lds0+LDS_K+wid*1024, vdst=lds0+LDS_V+wid*1024;
  #define DMA_K(t,slot) glds16(ksrc+(long)(t)*KVBLK*DM,(unsigned)__builtin_amdgcn_readfirstlane(kdst+(slot)))
  #define DMA_V(t,slot) glds16(vsrc+(long)(t)*KVBLK*DM,(unsigned)__builtin_amdgcn_readfirstlane(vdst+(slot)))
  const int vb0=(int)(lds0+LDS_V)+((lane>>4)&1)*32+(lane&3)*8+(4*hi+((lane&15)>>2))*64;
  const char*Kbase=shm+LDS_K; bf16x8 kf[8];
  const lds_cptr shm3=(lds_cptr)shm; const lds_cptr kp0=shm3+LDS_K+hi*1024+r32*16; const lds_cptr vp0=shm3+LDS_V+((lane>>4)&1)*32+(lane&3)*8+(4*hi+((lane&15)>>2))*64;
  const int NT=(q0+QB)/KVBLK;
  DMA_K(0,0);DMA_V(0,0);DMA_K(1,SLOTB);
  bf16x8 qr[4];
  #pragma unroll
  for(int d0=0;d0<4;++d0)qr[d0]=*reinterpret_cast<const bf16x8*>(&Qw[(long)r32*DM+d0*16+hi*8]);
  float mhat=0.f,l_reg=0.f;f32x16 o[2];o[0]=f32x16{};o[1]=f32x16{};f32x16 negm=f32x16{};asm volatile("":"+v"(negm));
  const int qrel=wid*QBLK+r32;
  #define CMASK(P0,P1,t) do{int jb_=(t)-(NT-4); if(jb_>=0)cmask(P0,P1,jb_,qrel,hi);}while(0)
  bool resc=false;
  #define START(P0,P1) do{ const float rm=rowmax(P0,P1); resc=false; \
    { const float dl=rm; mhat=fadd_s(mhat,dl); \
      _Pragma("unroll") for(int r=0;r<16;++r){P0[r]=fsub_s(P0[r],dl);P1[r]=fsub_s(P1[r],dl);} \
      _Pragma("unroll") for(int r=0;r<16;++r)negm[r]=-mhat; asm volatile("":"+v"(negm)); } \
    _Pragma("unroll") for(int r=0;r<16;++r)P0[r]=__builtin_amdgcn_exp2f(P0[r]); }while(0)
  #define RESC() do{ if(resc){ asm volatile("s_waitcnt lgkmcnt(0)":::"memory"); \
      _Pragma("unroll") for(int d_=0;d_<2;++d_) _Pragma("unroll") for(int r=0;r<16;++r)o[d_][r]*=wsf[crow(r,hi)]; } }while(0)
  f32x16 pA0,pA1,pB0,pB1;
  int sl_prev=0,sl_cur=0,sl_next=SLOTB;
  #define ROT() do{sl_prev=sl_cur;sl_cur=sl_next;sl_next=(sl_next==(NSLOT-1)*SLOTB)?0:sl_next+SLOTB;}while(0)
  DMA_K(2,2*SLOTB);
  WAIT_BAR(3);
  qkt(pA0,pA1,Kbase,qr,negm,r32,hi);asm volatile("s_nop 15\n\ts_nop 7":"+v"(pA0),"+v"(pA1));CMASK(pA0,pA1,0);
  START(pA0,pA1);
  _Pragma("unroll") for(int r=0;r<16;++r)pA1[r]=__builtin_amdgcn_exp2f(pA1[r]);
  WAIT_BAR(0);
  DMA_K(3,0);DMA_V(1,SLOTB);
  ROT();
  kload8(kf,kp0+sl_cur);
  WAIT_BAR(2);
  s16x4 vlo[8],vhi[8]; u32x4 pw0,pw1,pw2,pw3;
  #define PKW(P,B) cvtpk_s(P[B],P[B+1])
  #define PAF(k) __builtin_bit_cast(bf16x8,pw##k)
  #define VFR(i) (bf16x8){vlo[i][0],vlo[i][1],vlo[i][2],vlo[i][3],vhi[i][0],vhi[i][1],vhi[i][2],vhi[i][3]}
  #define PIN(x) asm volatile("":"+v"(x))
  #define MX3(a,b,c) __builtin_fmaxf(__builtin_fmaxf((a),(b)),(c))
  #define GAPA(MF,A0,A1,A2,A3,W0,W1,PW) do{ MF; sacc+=A0; sacc+=A1; sacc+=A2; sacc+=A3; PIN(sacc); W0; W1; PIN(PW); SBAR(); }while(0)
  #define EX(v) __builtin_amdgcn_exp2f(v)
  #define GAPB(MF,X,B) do{ MF; X[B]=EX(X[B]); X[B+1]=EX(X[B+1]); X[B+2]=EX(X[B+2]); X[B+3]=EX(X[B+3]); PIN(X); SBAR(); }while(0)
  #define VRD(i) do{ vlo[i]=vtr(vp_+(((i)>>2)*4096+((i)&3)*1024)); vhi[i]=vtr(vp_+(((i)>>2)*4096+((i)&3)*1024+512)); }while(0)
  #define KRD(G,j) do{ if(G){ kload2(kf,kp0+sl_next,j); SBAR(); } }while(0)
  #define STEP(C0,C1,P0,P1,t,GK,GV,GL) do{ SBAR(); \
    const lds_cptr vp_=vp0+sl_prev; \
    VRD(0); SBAR(); float sacc=(P0[0]+P0[1]); \
    GAPA(C0=__builtin_amdgcn_mfma_f32_32x32x16_bf16(kf[0],qr[0],negm,0,0,0), P0[2],P0[3],P0[4],P0[5],     pw0[0]=PKW(P0,0), pw0[1]=PKW(P0,2), pw0); \
    VRD(4); SBAR(); GAPA(C1=__builtin_amdgcn_mfma_f32_32x32x16_bf16(kf[1],qr[0],negm,0,0,0), P0[6],P0[7],P0[8],P0[9],     pw0[2]=PKW(P0,4), pw0[3]=PKW(P0,6), pw0); \
    VRD(1); SBAR(); GAPA(C0=__builtin_amdgcn_mfma_f32_32x32x16_bf16(kf[2],qr[1],C0,0,0,0),   P0[10],P0[11],P0[12],P0[13], pw1[0]=PKW(P0,8), pw1[1]=PKW(P0,10), pw1); \
    VRD(5); SBAR(); GAPA(C1=__builtin_amdgcn_mfma_f32_32x32x16_bf16(kf[3],qr[1],C1,0,0,0),   P0[14],P0[15],P1[0],P1[1],   pw1[2]=PKW(P0,12),pw1[3]=PKW(P0,14), pw1); \
    VRD(2); SBAR(); GAPA(C0=__builtin_amdgcn_mfma_f32_32x32x16_bf16(kf[4],qr[2],C0,0,0,0),   P1[2],P1[3],P1[4],P1[5],     pw2[0]=PKW(P1,0), pw2[1]=PKW(P1,2), pw2); \
    VRD(6); SBAR(); GAPA(C1=__builtin_amdgcn_mfma_f32_32x32x16_bf16(kf[5],qr[2],C1,0,0,0),   P1[6],P1[7],P1[8],P1[9],     pw2[2]=PKW(P1,4), pw2[3]=PKW(P1,6), pw2); \
    VRD(3); SBAR(); GAPA(C0=__builtin_amdgcn_mfma_f32_32x32x16_bf16(kf[6],qr[3],C0,0,0,0),   P1[10],P1[11],P1[12],P1[13], pw3[0]=PKW(P1,8), pw3[1]=PKW(P1,10), pw3); \
    VRD(7); SBAR(); GAPA(C1=__builtin_amdgcn_mfma_f32_32x32x16_bf16(kf[7],qr[3],C1,0,0,0),   P1[14],P1[15],0.f,0.f,       pw3[2]=PKW(P1,12),pw3[3]=PKW(P1,14), pw3); \
    l_reg+=sacc; \
    if(GK){DMA_K((t)+3,sl_cur);} if(GV){DMA_V((t)+1,sl_next);} \
    CMASK(C0,C1,t); \
    { float a=MX3(C0[0],C0[1],C1[0]),b=MX3(C0[2],C0[3],C1[1]); a=MX3(a,C1[2],C1[3]); \
      _Pragma("unroll") for(int r=4;r<16;r+=4){a=MX3(a,C0[r],C0[r+1]);b=MX3(b,C0[r+2],C0[r+3]);a=MX3(a,C1[r],C1[r+1]);b=MX3(b,C1[r+2],C1[r+3]);} \
      float rm=__builtin_fmaxf(a,b); { auto rr=__builtin_amdgcn_permlane32_swap(__float_as_uint(rm),__float_as_uint(rm),false,false); rm=__builtin_fmaxf(__uint_as_float(rr[0]),__uint_as_float(rr[1])); } \
      resc=false; \
      if(__builtin_expect(__any(rm>(float)THRL),0)){ const float dl=__builtin_fmaxf(rm,0.f); mhat+=dl; \
        _Pragma("unroll") for(int r=0;r<16;++r){C0[r]-=dl;C1[r]-=dl;} \
        _Pragma("unroll") for(int r=0;r<16;++r)negm[r]=-mhat; asm volatile("":"+v"(negm)); \
        const float f=__builtin_amdgcn_exp2f(-dl); l_reg*=f; if(hi==0)wsf[r32]=f; resc=true; } } \
    SBAR(); \
    GAPB(o[0]=__builtin_amdgcn_mfma_f32_32x32x16_bf16(PAF(0),VFR(0),o[0],0,0,0), C0,0); \
    GAPB(o[1]=__builtin_amdgcn_mfma_f32_32x32x16_bf16(PAF(0),VFR(4),o[1],0,0,0), C0,4); \
    KRD(GL,0); GAPB(o[0]=__builtin_amdgcn_mfma_f32_32x32x16_bf16(PAF(1),VFR(1),o[0],0,0,0), C0,8); \
    KRD(GL,1); GAPB(o[1]=__builtin_amdgcn_mfma_f32_32x32x16_bf16(PAF(1),VFR(5),o[1],0,0,0), C0,12); \
    KRD(GL,2); GAPB(o[0]=__builtin_amdgcn_mfma_f32_32x32x16_bf16(PAF(2),VFR(2),o[0],0,0,0), C1,0); \
    KRD(GL,3); GAPB(o[1]=__builtin_amdgcn_mfma_f32_32x32x16_bf16(PAF(2),VFR(6),o[1],0,0,0), C1,4); \
    GAPB(o[0]=__builtin_amdgcn_mfma_f32_32x32x16_bf16(PAF(3),VFR(3),o[0],0,0,0), C1,8); \
    GAPB(o[1]=__builtin_amdgcn_mfma_f32_32x32x16_bf16(PAF(3),VFR(7),o[1],0,0,0), C1,12); \
    }while(0)
  int t=1;
  #undef CMASK
  #define CMASK(P0,P1,t) do{}while(0)
  for(;t+5<NT;t+=2){
    STEP(pB0,pB1,pA0,pA1,t,true,true,true);     WAIT_BAR(2); RESC(); ROT();
    STEP(pA0,pA1,pB0,pB1,t+1,true,true,true);   WAIT_BAR(2); RESC(); ROT();
  }
  #undef CMASK
  #define CMASK(P0,P1,t) do{int jb_=(t)-(NT-4); if(jb_>=0)cmask(P0,P1,jb_,qrel,hi);}while(0)
  #define ENDW(tt) do{ if((tt)+3<NT){WAIT_BAR(2);} else if((tt)+2<NT){WAIT_BAR(1);} else {WAIT_BAR(0);} }while(0)
  for(;t+1<NT;t+=2){
    STEP(pB0,pB1,pA0,pA1,t,(t+3<NT),(t+1<NT),(t+1<NT));       ENDW(t);   RESC(); ROT();
    STEP(pA0,pA1,pB0,pB1,t+1,(t+4<NT),(t+2<NT),(t+2<NT));     ENDW(t+1); RESC(); ROT();
  }
  STEP(pB0,pB1,pA0,pA1,NT-1,false,false,false); RESC();
  { float sacc=pB0[0]+pB0[1]; _Pragma("unroll") for(int r=2;r<16;++r)sacc+=pB0[r]; _Pragma("unroll") for(int r=0;r<16;++r)sacc+=pB1[r]; l_reg+=sacc;
    pw0=(u32x4){PKW(pB0,0),PKW(pB0,2),PKW(pB0,4),PKW(pB0,6)};pw1=(u32x4){PKW(pB0,8),PKW(pB0,10),PKW(pB0,12),PKW(pB0,14)};pw2=(u32x4){PKW(pB1,0),PKW(pB1,2),PKW(pB1,4),PKW(pB1,6)};pw3=(u32x4){PKW(pB1,8),PKW(pB1,10),PKW(pB1,12),PKW(pB1,14)};
    SBAR(); pv(o,vb0+sl_cur,PAF(0),PAF(1),PAF(2),PAF(3)); }
  #undef PKW
  #undef PAF
  #undef VFR
  #undef PIN
  #undef MX3
  #undef GAPA
  #undef GAPB
  #undef EX
  #undef VRD
  #undef KRD
  #undef STEP
  #undef ENDW
  if(wid==0&&lane_id()==0){unsigned z_=0u;asm volatile("":"+v"(z_));ticket=__hip_atomic_fetch_add(qctr+z_,1u,__ATOMIC_RELAXED,__HIP_MEMORY_SCOPE_AGENT);}
  {auto rr=__builtin_amdgcn_permlane32_swap(__float_as_uint(l_reg),__float_as_uint(l_reg),false,false);l_reg=__uint_as_float(rr[0])+__uint_as_float(rr[1]);}
  if(hi==0)wsf[32+r32]=l_reg;asm volatile("s_waitcnt lgkmcnt(0)":::"memory");
  float rli[16];
  #pragma unroll
  for(int r=0;r<16;++r)rli[r]=__builtin_amdgcn_rcpf(wsf[32+crow(r,hi)]);
  bf16*Ow=O+(rowbase+q0+wid*QBLK)*OPITCH+ocol;
  { bf16*stg=(bf16*)(shm+LDS_OST)+wid*2048;
    #pragma unroll
    for(int r=0;r<16;++r){const int orow=crow(r,hi);
      #pragma unroll
      for(int d0=0;d0<2;++d0)stg[orow*64+d0*32+r32]=__float2bfloat16(o[d0][r]*rli[r]);}
    asm volatile("s_waitcnt lgkmcnt(0)":::"memory");
    #pragma unroll
    for(int i=0;i<4;++i){const int row=i*8+(lane>>3),ch=lane&7; const u32x4 v=*(const u32x4*)(stg+row*64+ch*8); ATTN_STORE16(Ow+(long)row*OPITCH+ch*8,v);} }
  asm volatile("s_waitcnt lgkmcnt(0)\n\ts_barrier":::"memory");
  #undef DMA_K
  #undef DMA_V
  #undef CMASK
  #undef START
  #undef RESC
  #undef ROT
}
constexpr int ATTN_LDS_BYTES=LDS_BYTES;
#undef SBAR
#undef WAIT_BAR
}
constexpr size_t MiB = 1u << 20;
constexpr size_t WS_CTL = 0, CTL_ZERO_BYTES = 1 * MiB;
constexpr size_t WS_WIN = 2 * MiB, WS_WOUT = 26 * MiB, WS_WQ = 34 * MiB, WS_WKV = 42 * MiB, WS_WO = 58 * MiB, WS_W1 = 66 * MiB, WS_W2 = 578 * MiB;
constexpr size_t WS_HN = 834 * MiB, WS_MN = 866 * MiB, WS_PROJ = 870 * MiB, WS_DT = 958 * MiB, WS_KVRAW = 959 * MiB, WS_KN = 967 * MiB;
constexpr size_t WS_YCAT = 971 * MiB, WS_O0 = 1003 * MiB, WS_O1 = 1019 * MiB, WS_H1 = 1035 * MiB, WS_H1B = 1099 * MiB, WS_PART1 = 1131 * MiB, WS_PARTQ = 1132 * MiB;
constexpr size_t WS_QRAW = 1133 * MiB, WS_P = 1165 * MiB, WS_VWT = 1181 * MiB, WS_H2 = 1197 * MiB, WS_HN3 = 1261 * MiB;
constexpr size_t WS_TOKOF = 1293 * MiB, WS_GATEOF = 1294 * MiB, WS_TOKE = 1295 * MiB, WS_TOKR = 1296 * MiB, WS_YG = 1297 * MiB;
constexpr size_t WS_H1F8 = 3368 * MiB  , WS_QF8 = 3384 * MiB  , WS_KN8 = 3400 * MiB  , WS_VF8 = 3402 * MiB  ;
constexpr size_t WS_P8 = 3404 * MiB  , WS_VWT8 = 3412 * MiB  ;
constexpr size_t WS_XG = 1320 * MiB  , WS_ACT = 1832 * MiB  , WS_Y = 2344 * MiB  , WS_END = 3420 * MiB;
constexpr int CW_BAR = 4096;
constexpr int CW_QCONV2 = 12416;
constexpr int CW_QCONV = 12352;
constexpr int CW_QATT = 12288;
constexpr int CW_CNT = 8192;
static_assert((CW_CNT + 64 * 32) * 4 <= (int)CTL_ZERO_BYTES, "CTL words inside the memset region");

constexpr int RING_OFF = 0, RING_BYTES = 131072;
constexpr int LDS_BYTES = 163840;
constexpr int MISC_OFF = 163840 - 1024;
constexpr int NWAVES = 8;

DI int wave_now(volatile LAS unsigned* misc) { const unsigned hs = (unsigned)__builtin_amdgcn_s_getreg((5 << 11) | 4) & 63u; return __builtin_amdgcn_readfirstlane((int)misc[192 + hs]); }
#define XB_TMO      128
#define XB_XCNT(j)  (256  + 64 * (j))
#define XB_XSUB(j)  (1280 + 64 * (j))
#define XB_XGEN(j)  (2304 + 64 * (j))
#define XB_TOP      3328
#define XB_TOPGEN   3392
#define XCD_BAR_WORDS 3456
#define XB_SPIN_CAP (1u << 20)

__device__ __forceinline__ unsigned xb_ld(unsigned* p)              { return __hip_atomic_load(p, __ATOMIC_RELAXED, __HIP_MEMORY_SCOPE_AGENT); }
__device__ __forceinline__ unsigned xb_add(unsigned* p, unsigned v) { return __hip_atomic_fetch_add(p, v, __ATOMIC_RELAXED, __HIP_MEMORY_SCOPE_AGENT); }
__device__ __forceinline__ unsigned xb_xcc_id() { return (unsigned)__builtin_amdgcn_s_getreg((3 << 11) | 20) & 0xFu; }
#define XB_SPIN(cond, bar) do { unsigned _sp = 0; while (cond) { __builtin_amdgcn_s_sleep(1); \
    if ((++_sp & 255u) == 0u) { if (xb_ld(&(bar)[XB_TMO])) break; if (_sp > XB_SPIN_CAP) { atomicAdd(&(bar)[XB_TMO], 1u); break; } } } } while (0)

struct XcdBarrier {
    unsigned* bar; unsigned x;
    volatile LAS unsigned* st;
};
__device__ __forceinline__ XcdBarrier xcd_barrier_post(unsigned* bar, volatile LAS unsigned* st) {
    XcdBarrier b; b.bar = bar; b.x = xb_xcc_id(); b.st = st;
    if (wave_now(st - 8) == 0 && lane_id() == 0) (void)xb_add(&bar[XB_XCNT(b.x)], 1u);
    return b;
}
__device__ __forceinline__ void xcd_barrier_complete(unsigned* bar, unsigned x, unsigned& nloc, unsigned& nx) {
    const unsigned G = gridDim.x * gridDim.y * gridDim.z;
    unsigned sum, cnt, mine, sp = 0u;
    for (;;) {
        sum = 0u; cnt = 0u; mine = 0u;
#pragma unroll
        for (unsigned j = 0; j < 16; ++j) { const unsigned c = xb_ld(&bar[XB_XCNT(j)]); sum += c; cnt += (c > 0u) ? 1u : 0u; mine = (j == x) ? c : mine; }
        if (sum == G) break;
        __builtin_amdgcn_s_sleep(1);
        if ((++sp & 255u) == 0u) { if (xb_ld(&bar[XB_TMO])) break; if (sp > XB_SPIN_CAP) { atomicAdd(&bar[XB_TMO], 1u); break; } }
    }
    nloc = mine > 0u ? mine : 1u; nx = cnt > 0u ? cnt : 1u;
}
__device__ __forceinline__ void xcd_barrier(const XcdBarrier& b) {
    asm volatile("s_waitcnt vmcnt(0)" ::: "memory");
    __syncthreads();
    if (wave_now(b.st - 8) == 0 && lane_id() == 0) {
        unsigned* bar = b.bar;
        __builtin_amdgcn_s_waitcnt(0);
        unsigned nloc = b.st[0], nx = b.st[1];
        if (nloc == 0u) { xcd_barrier_complete(bar, b.x, nloc, nx); b.st[0] = nloc; b.st[1] = nx; }
        const unsigned old = xb_add(&bar[XB_XSUB(b.x)], 1u);
        const unsigned gen = old / nloc;
        if (old + 1u == (gen + 1u) * nloc) {
            __builtin_amdgcn_fence(__ATOMIC_RELEASE, "agent");
            asm volatile("s_waitcnt vmcnt(0)" ::: "memory");
            const unsigned og = xb_add(&bar[XB_TOP], 1u);
            const unsigned tg = og / nx;
            if (og + 1u == (tg + 1u) * nx) xb_add(&bar[XB_TOPGEN], 1u);
            else XB_SPIN(xb_ld(&bar[XB_TOPGEN]) == tg, bar);
            __builtin_amdgcn_fence(__ATOMIC_ACQUIRE, "agent");
            xb_add(&bar[XB_XGEN(b.x)], 1u);
            asm volatile("s_waitcnt vmcnt(0)" ::: "memory");
        } else {
            XB_SPIN(xb_ld(&bar[XB_XGEN(b.x)]) == gen, bar);
            __builtin_amdgcn_fence(__ATOMIC_ACQUIRE, "agent");
            asm volatile("s_waitcnt vmcnt(0)" ::: "memory");
        }
    }
    __syncthreads();
}

struct Args { const float* in[32]; float* out; unsigned char* ws; int ph_lo, ph_hi, probe, pad_; };
enum In { I_X = 0, I_MEM, I_GMIX, I_WIN, I_CONVW, I_CONVB, I_DTB, I_ALOG, I_DSKIP, I_SSDG, I_DAQG, I_DAKG, I_LQ1, I_LK1, I_LQ2, I_LK2, I_SUBG, I_WOUT, I_GXA, I_GMEM,
          I_WQ, I_WKV, I_XQG, I_XKG, I_WO, I_GFFN, I_RW, I_RB, I_W1, I_B1, I_W2, I_B2 };

struct ArgP {
    typedef const __attribute__((address_space(4))) char* kptr;
    DI const float* in(int i) const { kptr kp = (kptr)__builtin_amdgcn_kernarg_segment_ptr(); asm volatile("" : "+s"(kp)); return *(const float* const __attribute__((address_space(4)))*)(kp + 8 * i); }
    DI float* out() const { kptr kp = (kptr)__builtin_amdgcn_kernarg_segment_ptr(); asm volatile("" : "+s"(kp)); return *(float* const __attribute__((address_space(4)))*)(kp + 8 * 32); }
};
struct Frame {
    LAS unsigned char* lds;
    volatile LAS unsigned* MISC;
    unsigned* ctl;
    unsigned char* ws;
    int tid, lane, wave, vcu, G;
};

template <class DestRow>
DI void tr_item(const float* W, size_t ldw, int k0, int ncol0, int nvalid, const float* kscale, bf16_t* WT, int K, DestRow dr, LAS float* scr, int lane) {
    const int c = lane & 31;
#pragma unroll 8
    for (int i = 0; i < 32; ++i) { const int kk = 2 * i + (lane >> 5);
        float v = (c < nvalid) ? W[(size_t)(k0 + kk) * ldw + ncol0 + c] : 0.f;
        if (kscale) v *= kscale[k0 + kk];
        scr[kk * 33 + c] = v; }
    asm volatile("s_waitcnt lgkmcnt(0)" ::: "memory");
    const int c8 = lane & 7;
#pragma unroll
    for (int j = 0; j < 4; ++j) { const int n = (lane >> 3) + 8 * j; const LAS float* s = scr + (8 * c8) * 33 + n;
        u32x4 o; o.x = pk2(s[0 * 33], s[1 * 33]); o.y = pk2(s[2 * 33], s[3 * 33]); o.z = pk2(s[4 * 33], s[5 * 33]); o.w = pk2(s[6 * 33], s[7 * 33]);
        if (n < nvalid) *(u32x4*)(WT + (size_t)dr(ncol0 + n) * K + k0 + 8 * c8) = o; }
    asm volatile("s_waitcnt lgkmcnt(0)" ::: "memory");
}
template <class DestRow>
DI void tr_item_fp8(const float* W, size_t ldw, int k0, int ncol0, const float* kscale, unsigned char* WT, int K, DestRow dr, LAS float* scr, int lane) {
    const int c = lane & 31;
#pragma unroll 8
    for (int i = 0; i < 32; ++i) { const int kk = 2 * i + (lane >> 5); float v = W[(size_t)(k0 + kk) * ldw + ncol0 + c]; if (kscale) v *= kscale[k0 + kk]; scr[kk * 33 + c] = v; }
    asm volatile("s_waitcnt lgkmcnt(0)" ::: "memory");
    const int n = lane >> 1, hf = lane & 1; const LAS float* s = scr + (32 * hf) * 33 + n;
    unsigned w[8];
#pragma unroll
    for (int j = 0; j < 8; ++j) { unsigned x = 0u;
        x = __builtin_amdgcn_cvt_pk_fp8_f32(s[(4 * j) * 33] * 64.f, s[(4 * j + 1) * 33] * 64.f, x, false);
        x = __builtin_amdgcn_cvt_pk_fp8_f32(s[(4 * j + 2) * 33] * 64.f, s[(4 * j + 3) * 33] * 64.f, x, true); w[j] = x; }
    unsigned char* op = WT + (size_t)dr(ncol0 + n) * K + k0 + 32 * hf;
    *(u32x4*)op = (u32x4){w[0], w[1], w[2], w[3]}; *(u32x4*)(op + 16) = (u32x4){w[4], w[5], w[6], w[7]};
    asm volatile("s_waitcnt lgkmcnt(0)" ::: "memory");
}
DI int tileperm(int col) { const int o = col & 255; return (col & ~255) + 128 * ((o & 63) >> 5) + 32 * (o >> 6) + (o & 31); }
struct DrIdent { DI int operator()(int n) const { return n; } };
struct DrTile  { DI int operator()(int n) const { return tileperm(n); } };
struct DrWin   { DI int operator()(int n) const { const int pc = (n < 2560) ? n : (n < 2576 ? PC_DT + (n - 2560) : n - 16); return tileperm(pc); } };
struct DrW1    { DI int operator()(int n) const { const int half = n >> 11, j = n & 2047; return (j >> 7) * 256 + half * 128 + (j & 127); } };

template <bool FP8, class DestRow>
DI void cv_item(const float* W, size_t ldw, int k0, int ncol0, const float* kscale, float scale, void* WT, int kpitch, DestRow dr, LAS float* scr, int lane) {
    const int r = lane >> 3, c4 = (lane & 7) * 4;
    f32x4 v[16];
#pragma unroll
    for (int i = 0; i < 16; ++i) v[i] = *(const f32x4*)(W + (size_t)(k0 + 8 * i + r) * ldw + ncol0 + c4);
#pragma unroll
    for (int i = 0; i < 16; ++i) { f32x4 x = v[i] * scale; if (kscale) x = x * kscale[k0 + 8 * i + r]; *(LAS f32x4*)(scr + (8 * i + r) * 36 + c4) = x; }
    asm volatile("s_waitcnt lgkmcnt(0)" ::: "memory");
    const int n = lane & 31, hf = lane >> 5; const LAS float* s = scr + (64 * hf) * 36 + n;
    if constexpr (FP8) {
        unsigned w[16];
#pragma unroll
        for (int j = 0; j < 16; ++j) { unsigned x = 0u; x = __builtin_amdgcn_cvt_pk_fp8_f32(s[(4 * j) * 36], s[(4 * j + 1) * 36], x, false); x = __builtin_amdgcn_cvt_pk_fp8_f32(s[(4 * j + 2) * 36], s[(4 * j + 3) * 36], x, true); w[j] = x; }
        unsigned char* op = (unsigned char*)WT + (size_t)dr(ncol0 + n) * kpitch + k0 + 64 * hf;
#pragma unroll
        for (int j = 0; j < 4; ++j) *(u32x4*)(op + 16 * j) = (u32x4){w[4 * j], w[4 * j + 1], w[4 * j + 2], w[4 * j + 3]};
    } else {
        unsigned w[32];
#pragma unroll
        for (int j = 0; j < 32; ++j) w[j] = pk2(s[(2 * j) * 36], s[(2 * j + 1) * 36]);
        unsigned char* op = (unsigned char*)WT + (size_t)dr(ncol0 + n) * kpitch + (k0 + 64 * hf) * 2;
#pragma unroll
        for (int j = 0; j < 8; ++j) *(u32x4*)(op + 16 * j) = (u32x4){w[4 * j], w[4 * j + 1], w[4 * j + 2], w[4 * j + 3]};
    }
    asm volatile("s_waitcnt lgkmcnt(0)" ::: "memory");
}
DI void rms_row_to_bf16(const float* xrow, const float* g, bf16_t* orow, int lane) {
    const f32x4* xr = (const f32x4*)xrow + lane;
    f32x4 v[8]; float s = 0.f;
#pragma unroll
    for (int j = 0; j < 8; ++j) { v[j] = xr[64 * j]; s += (v[j].x * v[j].x + v[j].y * v[j].y) + (v[j].z * v[j].z + v[j].w * v[j].w); }
    const float rstd = 1.f / sqrtf(wave_sum(s) * (1.f / 2048.f) + EPS_);
    u32x2* o8 = (u32x2*)orow + lane;
#pragma unroll
    for (int j = 0; j < 8; ++j) { const f32x4 gg = ((const f32x4*)g)[lane + 64 * j];
        u32x2 o; o.x = pk2(v[j].x * rstd * gg.x, v[j].y * rstd * gg.y); o.y = pk2(v[j].z * rstd * gg.z, v[j].w * rstd * gg.w); o8[64 * j] = o; }
}

DI void p0_prologue(Frame& F, const ArgP& a) {
    LAS float* scr = (LAS float*)(F.lds + RING_OFF + F.wave * 16384);
    const int gw = F.vcu * NWAVES + F.wave, NGW = F.G * NWAVES;
    unsigned char* ws = F.ws;
    constexpr int I_A = 32 * 80, I_B = 32, I_C = 32 * 96, NITEMS = I_A + I_B + I_C;
    for (int it = gw; it < NITEMS; it += NGW) {
        int r = it;
        if (r < I_A) { tr_item(a.in(I_WIN), 5648, 64 * (r / 80), 32 * (r % 80), 32, nullptr, (bf16_t*)(ws + WS_WIN), 2048, DrWin(), scr, F.lane); continue; } r -= I_A;
        if (r < I_B) { tr_item(a.in(I_WIN), 5648, 64 * r, 2560, 16, nullptr, (bf16_t*)(ws + WS_WIN), 2048, DrWin(), scr, F.lane); continue; } r -= I_B;
        tr_item(a.in(I_WIN), 5648, 64 * (r / 96), 2576 + 32 * (r % 96), 32, nullptr, (bf16_t*)(ws + WS_WIN), 2048, DrWin(), scr, F.lane);
    }
    for (int m = gw; m < NTOK; m += NGW) rms_row_to_bf16(a.in(I_X) + (size_t)m * 2048, a.in(I_GMIX), (bf16_t*)(ws + WS_HN) + (size_t)m * 2048, F.lane);
    for (int m = gw; m < NB * MEMLEN; m += NGW) rms_row_to_bf16(a.in(I_MEM) + (size_t)m * 2048, a.in(I_GMEM), (bf16_t*)(ws + WS_MN) + (size_t)m * 2048, F.lane);
}
struct CvIt { const float* W; size_t ldw; const float* ks; unsigned char* WT; float scale; int k0, n0, kpitch, fp8, dr, tiled; };
DI CvIt cv_decode(int it, const ArgP& a, unsigned char* ws) {
    constexpr int J_WOUT = 16 * 64, J_WKV = 16 * 128, J_WQ = 16 * 64, J_WO = 16 * 64, J_W1 = 32 * 16 * 128;
    CvIt c; c.ks = nullptr; c.scale = 64.f; c.fp8 = 1; c.dr = 0; c.kpitch = 2048; c.ldw = 2048; c.tiled = 0;
    int r = it;
    if (r < J_WOUT) { c.W = a.in(I_WOUT); c.k0 = 128 * (r / 64); c.n0 = 32 * (r % 64); c.WT = ws + WS_WOUT; c.scale = 1.f; c.fp8 = 0; c.kpitch = 4096; return c; } r -= J_WOUT;
    if (r < J_WKV) { c.W = a.in(I_WKV); c.ldw = 4096; c.k0 = 128 * (r / 128); c.n0 = 32 * (r % 128); c.WT = ws + WS_WKV; c.scale = 1.f; c.fp8 = 0; c.kpitch = 4096; c.dr = 1; return c; } r -= J_WKV;
    if (r < J_WQ) { c.W = a.in(I_WQ); c.ks = a.in(I_GXA); c.k0 = 128 * (r / 64); c.n0 = 32 * (r % 64); c.WT = ws + WS_WQ; return c; } r -= J_WQ;
    if (r < J_WO) { c.W = a.in(I_WO); c.k0 = 128 * (r / 64); c.n0 = 32 * (r % 64); c.WT = ws + WS_WO; return c; } r -= J_WO;
    if (r < J_W1) { const int e = r / (16 * 128), q = r % (16 * 128); c.W = a.in(I_W1) + (size_t)e * 2048 * 4096; c.ldw = 4096; c.k0 = 128 * (q / 128); c.n0 = 32 * (q % 128); c.WT = ws + WS_W1 + (size_t)e * 4096 * 2048; c.dr = 2; c.tiled = 1; return c; } r -= J_W1;
    { const int e = r / (16 * 64), q = r % (16 * 64); c.W = a.in(I_W2) + (size_t)e * 2048 * 2048; c.k0 = 128 * (q / 64); c.n0 = 32 * (q % 64); c.WT = ws + WS_W2 + (size_t)e * 2048 * 2048; c.tiled = 1; }
    return c;
}
constexpr int CV_NJ = 16 * 64 * 3 + 16 * 128 + 32 * 16 * 128 + 32 * 16 * 64;
constexpr int CV_TAIL2 = 12288;
constexpr int CV_TAIL1 = 20480;
constexpr int CV_TAIL = CV_TAIL1 + CV_TAIL2;
DI void conv_share(Frame& F, const ArgP& a) {
    LAS float* scr = (LAS float*)(F.lds + F.wave * 16384);
    const unsigned sbase = (unsigned)__builtin_amdgcn_readfirstlane((int)((unsigned)(uintptr_t)F.lds + (unsigned)F.wave * 16384u));
    const int gw = F.vcu * NWAVES + F.wave, NGW = F.G * NWAVES, lane = F.lane;
    unsigned char* ws = F.ws;
    constexpr int NJ = CV_NJ - CV_TAIL;
    const int n = lane & 31, hf = lane >> 5;
    for (int it = gw; it < NJ; it += NGW) {
        const CvIt cur = cv_decode(it, a, ws);
        const char* gb = (const char*)(cur.W + (size_t)cur.k0 * cur.ldw + cur.n0);
        const unsigned vo0 = (unsigned)(((size_t)(lane >> 3) * cur.ldw + (size_t)(lane & 7) * 4) * 4), vstep = (unsigned)(8 * cur.ldw * 4);
#pragma unroll
        for (int p = 0; p < 16; ++p) { unsigned keep_;
            asm volatile("s_mov_b32 %0, m0\n\ts_mov_b32 m0, %3\n\ts_nop 0\n\tglobal_load_lds_dwordx4 %1, %2 nt\n\ts_mov_b32 m0, %0"
                         : "=&s"(keep_) : "v"(vo0 + (unsigned)p * vstep), "s"(gb), "s"(sbase + (unsigned)p * 1024u) : "memory"); }
        asm volatile("s_waitcnt vmcnt(0)" ::: "memory");
        const LAS float* s = scr + (64 * hf) * 32 + n;
        const int col = cur.n0 + n; const int drow = (cur.dr == 0) ? col : (cur.dr == 1 ? tileperm(col) : DrW1()(col));
        const float* ksp = cur.ks ? cur.ks + cur.k0 + 64 * hf : nullptr;
        if (cur.fp8) {
            unsigned w[16];
#pragma unroll
            for (int j = 0; j < 16; ++j) { float x0 = s[(4 * j) * 32] * cur.scale, x1 = s[(4 * j + 1) * 32] * cur.scale, x2 = s[(4 * j + 2) * 32] * cur.scale, x3 = s[(4 * j + 3) * 32] * cur.scale;
                if (ksp) { x0 *= ksp[4 * j]; x1 *= ksp[4 * j + 1]; x2 *= ksp[4 * j + 2]; x3 *= ksp[4 * j + 3]; }
                unsigned x = 0u; x = __builtin_amdgcn_cvt_pk_fp8_f32(x0, x1, x, false); x = __builtin_amdgcn_cvt_pk_fp8_f32(x2, x3, x, true); w[j] = x; }
            unsigned char* op = cur.tiled ? cur.WT + ((size_t)(((drow >> 8) * 16 + (cur.k0 >> 7)) * 256 + (drow & 255))) * 128 + 64 * hf : cur.WT + (size_t)drow * cur.kpitch + cur.k0 + 64 * hf;
#pragma unroll
            for (int j = 0; j < 4; ++j) *(u32x4*)(op + 16 * j) = (u32x4){w[4 * j], w[4 * j + 1], w[4 * j + 2], w[4 * j + 3]};
        } else {
            unsigned w[32];
#pragma unroll
            for (int j = 0; j < 32; ++j) w[j] = pk2(s[(2 * j) * 32] * cur.scale, s[(2 * j + 1) * 32] * cur.scale);
            unsigned char* op = cur.WT + (size_t)drow * cur.kpitch + (cur.k0 + 64 * hf) * 2;
#pragma unroll
            for (int j = 0; j < 8; ++j) *(u32x4*)(op + 16 * j) = (u32x4){w[4 * j], w[4 * j + 1], w[4 * j + 2], w[4 * j + 3]};
        }
        asm volatile("s_waitcnt lgkmcnt(0)" ::: "memory");
    }
}

DI void conv_queue(Frame& F, const ArgP& a, int qword, int first, int count) {
    LAS float* scr = (LAS float*)(F.lds + F.wave * 18432);
    unsigned char* ws = F.ws;
    const int lane = lane_id(), r = lane >> 3, c4 = (lane & 7) * 4, n = lane & 31, hf = lane >> 5;
    for (;;) {
        if (F.wave == 0 && lane == 0) F.MISC[121] = __hip_atomic_fetch_add(F.ctl + qword, 8u, __ATOMIC_RELAXED, __HIP_MEMORY_SCOPE_AGENT);
        __syncthreads();
        const int base = __builtin_amdgcn_readfirstlane((int)F.MISC[121]);
        __syncthreads();
        if (base >= count) break;
        const int it = first + base + F.wave;
        if (base + F.wave < count) {
            const CvIt cur = cv_decode(it, a, ws);
            f32x4 v[16];
#pragma unroll
            for (int i = 0; i < 16; ++i) v[i] = __builtin_nontemporal_load((const f32x4*)(cur.W + (size_t)(cur.k0 + 8 * i + r) * cur.ldw + cur.n0 + c4));
#pragma unroll
            for (int i = 0; i < 16; ++i) *(LAS f32x4*)(scr + (8 * i + r) * 36 + c4) = v[i] * cur.scale;
            asm volatile("s_waitcnt lgkmcnt(0)" ::: "memory");
            const LAS float* s = scr + (64 * hf) * 36 + n;
            unsigned w[16];
#pragma unroll
            for (int j = 0; j < 16; ++j) { unsigned x = 0u; x = __builtin_amdgcn_cvt_pk_fp8_f32(s[(4 * j) * 36], s[(4 * j + 1) * 36], x, false); x = __builtin_amdgcn_cvt_pk_fp8_f32(s[(4 * j + 2) * 36], s[(4 * j + 3) * 36], x, true); w[j] = x; }
            const int drow = cur.n0 + n; unsigned char* op = cur.WT + ((size_t)(((drow >> 8) * 16 + (cur.k0 >> 7)) * 256 + (drow & 255))) * 128 + 64 * hf;
#pragma unroll
            for (int j = 0; j < 4; ++j) *(u32x4*)(op + 16 * j) = (u32x4){w[4 * j], w[4 * j + 1], w[4 * j + 2], w[4 * j + 3]};
            asm volatile("s_waitcnt lgkmcnt(0)" ::: "memory");
        }
    }
}
static_assert(CV_TAIL <= 32 * 16 * 64 && CV_TAIL1 % 8 == 0 && CV_TAIL2 % 8 == 0, "the tails are a suffix of the moe_w2 items");

struct SchedP1 {
    int G, c; const unsigned char* ws; int lo, hi;
    DI bool next(int i, pg8::UnitD& u) const {
        u.rows = nullptr; u.nvalid = 0; u.lda = 4096u; u.ldb = 4096u; u.e = 0; u.x0 = 0;
        if (lo == 0) {
            if (G == 256) { const int x = c >> 5, s = c & 31, bidx = i * 8 + x; if (bidx >= 24) return false;
                const int g = bidx >> 2, h = bidx & 3; u.pn = 4 * g + (s >> 3); u.pm = h * 8 + (s & 7); if (u.pn >= 23) return false; }
            else { const int L = i * G + c; if (L >= 32 * 23) return false; u.pn = L / 32; u.pm = L % 32; }
            u.type = 0; u.A = (const char*)(ws + WS_HN) + (size_t)u.pm * 256 * 4096; u.B = (const char*)(ws + WS_WIN) + (size_t)u.pn * 256 * 4096;
            return true;
        }
        const int L = lo + i * G + c; if (L >= hi) return false;
        { const int q = L - 32 * 23; u.type = 1; u.pn = q / 4; u.pm = q % 4; u.A = (const char*)(ws + WS_MN) + (size_t)u.pm * 256 * 4096; u.B = (const char*)(ws + WS_WKV) + (size_t)u.pn * 256 * 4096; }
        return true;
    }
};
struct EpiP1 {
    static constexpr bool AFTER_DRAIN = false;
    bf16_t* proj; float* dtb; bf16_t* kvraw; const float* gq; const float* gk; unsigned char* vf8;
    DI void operator()(const f32x4 (&acc)[2][2][4][2], const pg8::UnitD& u, int wr, int wc, int fr, int fq) const {
        { int ln_ = lane_id(); asm volatile("" : "+v"(ln_)); fr = ln_ & 15; fq = (ln_ >> 4) & 3; }
        const int row0 = u.pm * 256 + wr * 64 + fr;
        const int cn = u.pn * 256 + 64 * wc + 8 * fq;
        if (u.type == 1 && u.pn >= 8) {
#pragma unroll
            for (int ai = 0; ai < 2; ++ai)
#pragma unroll
                for (int m = 0; m < 4; ++m) { unsigned char* rp = vf8 + (size_t)(row0 + ai * 128 + m * 16) * 2048 + (cn - 2048);
#pragma unroll
                    for (int bj = 0; bj < 2; ++bj) { const f32x4 v0 = acc[ai][bj][m][0] * 16.f, v1 = acc[ai][bj][m][1] * 16.f;
                        u32x2 w; w.x = __builtin_amdgcn_cvt_pk_fp8_f32(v0[0], v0[1], 0u, false); w.x = __builtin_amdgcn_cvt_pk_fp8_f32(v0[2], v0[3], w.x, true);
                        w.y = __builtin_amdgcn_cvt_pk_fp8_f32(v1[0], v1[1], 0u, false); w.y = __builtin_amdgcn_cvt_pk_fp8_f32(v1[2], v1[3], w.y, true);
                        *(u32x2*)(rp + 32 * bj) = w; } }
            return;
        }
        if (u.type == 1) {
#pragma unroll
            for (int ai = 0; ai < 2; ++ai)
#pragma unroll
                for (int m = 0; m < 4; ++m) { bf16_t* rp = kvraw + (size_t)(row0 + ai * 128 + m * 16) * 4096 + cn;
#pragma unroll
                    for (int bj = 0; bj < 2; ++bj) { const f32x4 v0 = acc[ai][bj][m][0], v1 = acc[ai][bj][m][1];
                        u32x4 w; w.x = pk2(v0[0], v0[1]); w.y = pk2(v0[2], v0[3]); w.z = pk2(v1[0], v1[1]); w.w = pk2(v1[2], v1[3]); *(u32x4*)(rp + 32 * bj) = w; } }
            return;
        }
        if (u.pn == 22) {
            if (wc == 0 && fq < 2) {
#pragma unroll
                for (int ai = 0; ai < 2; ++ai)
#pragma unroll
                    for (int m = 0; m < 4; ++m) { float* rp = dtb + (size_t)(row0 + ai * 128 + m * 16) * 16 + 8 * fq;
                        *(f32x4*)(rp) = acc[ai][0][m][0]; *(f32x4*)(rp + 4) = acc[ai][0][m][1]; }
            }
            return;
        }
        const bool isq = (u.pn >= 10 && u.pn < 14), isk = (u.pn >= 14 && u.pn < 18);
        if (!(isq || isk)) {
#pragma unroll
            for (int ai = 0; ai < 2; ++ai)
#pragma unroll
                for (int m = 0; m < 4; ++m) { bf16_t* rp = proj + (size_t)(row0 + ai * 128 + m * 16) * PP + cn;
#pragma unroll
                    for (int bj = 0; bj < 2; ++bj) { const f32x4 v0 = acc[ai][bj][m][0], v1 = acc[ai][bj][m][1];
                        u32x4 w; w.x = pk2(v0[0], v0[1]); w.y = pk2(v0[2], v0[3]); w.z = pk2(v1[0], v1[1]); w.w = pk2(v1[2], v1[3]); *(u32x4*)(rp + 32 * bj) = w; } }
            return;
        }
        const float* g = (isq ? gq : gk) + 8 * fq; const float sc = isq ? (0.125f * 1.4426950408889634f) : 1.f;
#pragma unroll
        for (int ai = 0; ai < 2; ++ai)
#pragma unroll
            for (int m = 0; m < 4; ++m) { bf16_t* rp = proj + (size_t)(row0 + ai * 128 + m * 16) * PP + cn;
                float ss = 0.f;
#pragma unroll
                for (int bj = 0; bj < 2; ++bj)
#pragma unroll
                    for (int n = 0; n < 2; ++n) { const f32x4 v = acc[ai][bj][m][n]; ss += (v[0] * v[0] + v[1] * v[1]) + (v[2] * v[2] + v[3] * v[3]); }
                ss += __shfl_xor(ss, 16); ss += __shfl_xor(ss, 32);
                const float rs = sc / sqrtf(ss * (1.f / 64.f) + EPS_);
#pragma unroll
                for (int bj = 0; bj < 2; ++bj) { const f32x4 v0 = acc[ai][bj][m][0] * rs * *(const f32x4*)(g + 32 * bj), v1 = acc[ai][bj][m][1] * rs * *(const f32x4*)(g + 32 * bj + 4);
                    u32x4 w; w.x = pk2(v0[0], v0[1]); w.y = pk2(v0[2], v0[3]); w.z = pk2(v1[0], v1[1]); w.w = pk2(v1[2], v1[3]); *(u32x4*)(rp + 32 * bj) = w; } }
    }
};

DI void kprep(Frame& F, const ArgP& a) {
    const int gw = F.vcu * NWAVES + F.wave, NGW = F.G * NWAVES;
    const bf16_t* kv = (const bf16_t*)(F.ws + WS_KVRAW); unsigned char* kn = (unsigned char*)(F.ws + WS_KN8);
    for (int it = gw; it < NB * MEMLEN * 4; it += NGW) {
        const int row = it >> 2, h = it & 3, b = row >> 8, key = row & 255;
        const u32x4 raw = *(const u32x4*)(kv + (size_t)row * 4096 + h * 512 + F.lane * 8);
        float v[8]; v[0] = bflo(raw.x); v[1] = bfhi(raw.x); v[2] = bflo(raw.y); v[3] = bfhi(raw.y); v[4] = bflo(raw.z); v[5] = bfhi(raw.z); v[6] = bflo(raw.w); v[7] = bfhi(raw.w);
        float ss = 0.f;
#pragma unroll
        for (int j = 0; j < 8; ++j) ss += v[j] * v[j];
        const float rs = 1.f / sqrtf(wave_sum(ss) * (1.f / 512.f) + EPS_) * 0.04419417382415922f * 128.f;
        const float* gk = a.in(I_XKG) + F.lane * 8; const float* gq = a.in(I_XQG) + F.lane * 8;
        u32x2 o; o.x = __builtin_amdgcn_cvt_pk_fp8_f32(v[0] * rs * gk[0] * gq[0], v[1] * rs * gk[1] * gq[1], 0u, false); o.x = __builtin_amdgcn_cvt_pk_fp8_f32(v[2] * rs * gk[2] * gq[2], v[3] * rs * gk[3] * gq[3], o.x, true);
        o.y = __builtin_amdgcn_cvt_pk_fp8_f32(v[4] * rs * gk[4] * gq[4], v[5] * rs * gk[5] * gq[5], 0u, false); o.y = __builtin_amdgcn_cvt_pk_fp8_f32(v[6] * rs * gk[6] * gq[6], v[7] * rs * gk[7] * gq[7], o.y, true);
        *(u32x2*)(kn + ((size_t)((b * 4 + h) * 256 + key)) * 512 + F.lane * 8) = o;
    }
}

constexpr int SP = 272;
constexpr int S_C = 0, S_BM = 34816, S_BT = 69632, S_XDT = 104448, S_HB = 121856, S_F = 139264, S_W = 155648  , SSD_LDS = 162048;
static_assert(SSD_LDS <= MISC_OFF, "SSD LDS map");
#define MFMA32(a, b, c) __builtin_amdgcn_mfma_f32_32x32x16_bf16((a), (b), (c), 0, 0, 0)
DI int crow(int r, int hi) { return (r & 3) + 8 * (r >> 2) + 4 * hi; }
DI bf16x8 ldfrag(LAS const unsigned char* base, int row, int kel) { return *(const LAS bf16x8*)(base + row * SP + kel * 2); }
DI float fexp(float x) { return __builtin_amdgcn_exp2f(x * 1.4426950408889634f); }
DI float fsilu(float x) { return x * __builtin_amdgcn_rcpf(1.f + fexp(-x)); }

DI void ssd_unit(Frame& F, const ArgP& a, int b, int hd) {
    LAS unsigned char* lds = F.lds;
    int tid = F.tid, lane = F.lane, r32 = lane & 31, hh = lane >> 5; const int wid = F.wave;
    LAS float* sdt = (LAS float*)(lds + S_F); LAS float* sac = sdt + 2048;
    const bf16_t* proj = (const bf16_t*)(F.ws + WS_PROJ); const float* dtbuf = (const float*)(F.ws + WS_DT); bf16_t* yg = (bf16_t*)(F.ws + WS_YG);
    const int g = hd >> 3;
    const float aneg = -__expf(a.in(I_ALOG)[hd]), dtb = a.in(I_DTB)[hd], dsk = a.in(I_DSKIP)[hd];
#pragma unroll
    for (int q = 0; q < 2; ++q) { const int c = 2 * wid + q; const size_t t0 = (size_t)b * SEQ_ + c * 128;
        const float x0 = dtbuf[(t0 + 2 * lane) * 16 + hd] + dtb, x1 = dtbuf[(t0 + 2 * lane + 1) * 16 + hd] + dtb;
        const float d0 = x0 > 20.f ? x0 : log1pf(__expf(x0)), d1 = x1 > 20.f ? x1 : log1pf(__expf(x1));
        const float a0 = d0 * aneg, a1 = d1 * aneg;
        float s = a0 + a1;
#pragma unroll
        for (int o = 1; o < 64; o <<= 1) { const float t = __shfl_up(s, o); if (lane >= o) s += t; }
        sdt[c * 128 + 2 * lane] = d0; sdt[c * 128 + 2 * lane + 1] = d1; sac[c * 128 + 2 * lane] = s - a1; sac[c * 128 + 2 * lane + 1] = s; }
    int seg = tid >> 5, cg = tid & 31, l0 = seg * 8;
    int colbc = (cg < 16) ? (1024 + g * 128 + cg * 8) : (1280 + g * 128 + (cg - 16) * 8);
    const int colx = hd * 64 + wid * 8; int lx = 2 * lane;
    LAS float* swt = (LAS float*)(lds + S_W);
    { const float* convw = a.in(I_CONVW); const float* convb = a.in(I_CONVB);
      if (tid < 320) { const int ci = tid;
          const int xc = (ci < 64) ? (hd * 64 + ci) : (ci < 192 ? (1024 + g * 128 + (ci - 64)) : (1280 + g * 128 + (ci - 192)));
#pragma unroll
          for (int k = 0; k < 4; ++k) swt[k * 320 + ci] = convw[k * 1536 + xc];
          swt[4 * 320 + ci] = convb[xc]; } }
    int cibc = 64 + cg * 8; const int cix = wid * 8;
    const char* pub = (const char*)F.ws; const unsigned pxb = (unsigned)(WS_PROJ + ((size_t)b * SEQ_ * PP + PC_XBC) * 2), zoff = (unsigned)(WS_CTL + 524288);
    u32x4 inbc[11], inx[5];
#define SSD_PREFETCH(c_) do { \
        int sd_ = l0; asm volatile("" : "+v"(sd_)); \
        _Pragma("unroll") for (int j = 0; j < 11; ++j) { const int tt = (c_) * 128 + sd_ - 3 + j; inbc[j] = *(const u32x4*)(pub + ((tt >= 0) ? pxb + (unsigned)(tt * PP + colbc) * 2u : zoff)); } } while (0)
    SSD_PREFETCH(0);
    f32x16 hT; for (int i = 0; i < 16; ++i) hT[i] = 0.f;
    const int nb = wid & 3, pb = wid >> 2;
    __syncthreads();
    for (int c = 0; c < 16; ++c) {
        { int t_ = lane_id(); asm volatile("" : "+v"(t_)); t_ += F.wave * 64; tid = t_; lane = t_ & 63; r32 = lane & 31; hh = lane >> 5; seg = t_ >> 5; cg = t_ & 31; l0 = seg * 8; lx = 2 * lane;
          colbc = (cg < 16) ? (1024 + g * 128 + cg * 8) : (1280 + g * 128 + (cg - 16) * 8); cibc = 64 + cg * 8; }
        const size_t t0 = (size_t)b * SEQ_ + c * 128;
        const LAS float* cdt = sdt + c * 128; const LAS float* cac = sac + c * 128;
        const float aend = cac[127];
#pragma unroll
        for (int j = 0; j < 5; ++j) { int sd_ = lx; asm volatile("" : "+v"(sd_)); const int tt = c * 128 + sd_ - 3 + j; inx[j] = *(const u32x4*)(pub + ((tt >= 0) ? pxb + (unsigned)(tt * PP + colx) * 2u : zoff)); }
        {
            LAS unsigned char* hbp = lds + S_HB + (32 * pb + r32) * SP + (32 * nb + 4 * hh) * 2;
#pragma unroll
            for (int q4 = 0; q4 < 4; ++q4) { u32x2 w; w.x = pk2(hT[4 * q4], hT[4 * q4 + 1]); w.y = pk2(hT[4 * q4 + 2], hT[4 * q4 + 3]); *(LAS u32x2*)(hbp + 16 * q4) = w; }
        }
        {
            float wbc[5][8];
#pragma unroll
            for (int k = 0; k < 5; ++k) { const f32x4 w0 = *(const LAS f32x4*)(swt + k * 320 + cibc), w1 = *(const LAS f32x4*)(swt + k * 320 + cibc + 4);
#pragma unroll
                for (int i = 0; i < 4; ++i) { wbc[k][i] = w0[i]; wbc[k][4 + i] = w1[i]; } }
#pragma unroll
            for (int hf = 0; hf < 2; ++hf) {
                __builtin_amdgcn_sched_barrier(0);
                float o[4][8];
#pragma unroll
                for (int j = 0; j < 4; ++j)
#pragma unroll
                    for (int i = 0; i < 8; ++i) { float s = wbc[4][i];
#pragma unroll
                        for (int k = 0; k < 4; ++k) { const unsigned wd = inbc[4 * hf + j + k][i >> 1]; s += wbc[k][i] * ((i & 1) ? bfhi(wd) : bflo(wd)); }
                        o[j][i] = fsilu(s); }
                const int lh = l0 + 4 * hf;
                if (cg < 16) {
                    const int n0 = cg * 8; float ev[4];
#pragma unroll
                    for (int j = 0; j < 4; ++j) { ev[j] = fexp(aend - cac[lh + j]);
                        u32x4 w1; w1.x = pk2(o[j][0], o[j][1]); w1.y = pk2(o[j][2], o[j][3]); w1.z = pk2(o[j][4], o[j][5]); w1.w = pk2(o[j][6], o[j][7]);
                        *(LAS u32x4*)(lds + S_BM + (lh + j) * SP + n0 * 2) = w1; }
#pragma unroll
                    for (int i = 0; i < 8; ++i) { u32x2 w2; w2.x = pk2(o[0][i] * ev[0], o[1][i] * ev[1]); w2.y = pk2(o[2][i] * ev[2], o[3][i] * ev[3]);
                        *(LAS u32x2*)(lds + S_BT + (n0 + i) * SP + lh * 2) = w2; }
                } else {
                    const int n0 = (cg - 16) * 8;
#pragma unroll
                    for (int j = 0; j < 4; ++j) { u32x4 w1; w1.x = pk2(o[j][0], o[j][1]); w1.y = pk2(o[j][2], o[j][3]); w1.z = pk2(o[j][4], o[j][5]); w1.w = pk2(o[j][6], o[j][7]);
                        *(LAS u32x4*)(lds + S_C + (lh + j) * SP + n0 * 2) = w1; }
                }
            }
        }
        __builtin_amdgcn_sched_barrier(0);
        {
            const float d0 = cdt[lx], d1 = cdt[lx + 1];
            float wx[5][8];
#pragma unroll
            for (int k = 0; k < 5; ++k) { const f32x4 w0 = *(const LAS f32x4*)(swt + k * 320 + cix), w1 = *(const LAS f32x4*)(swt + k * 320 + cix + 4);
#pragma unroll
                for (int i = 0; i < 4; ++i) { wx[k][i] = w0[i]; wx[k][4 + i] = w1[i]; } }
#pragma unroll
            for (int i = 0; i < 8; ++i) { float s0 = wx[4][i], s1 = wx[4][i];
#pragma unroll
                for (int k = 0; k < 4; ++k) { const unsigned w0 = inx[k][i >> 1], w1 = inx[k + 1][i >> 1];
                    s0 += wx[k][i] * ((i & 1) ? bfhi(w0) : bflo(w0)); s1 += wx[k][i] * ((i & 1) ? bfhi(w1) : bflo(w1)); }
                *(LAS unsigned*)(lds + S_XDT + (wid * 8 + i) * SP + lx * 2) = pk2(fsilu(s0) * d0, fsilu(s1) * d1); }
        }
        if (c < 15) SSD_PREFETCH(c + 1);
        __syncthreads();
        const int lb = wid >> 1;
        f32x16 xt[2];
        {
            bf16x8 cf[8];
#pragma unroll
            for (int ks = 0; ks < 8; ++ks) cf[ks] = ldfrag(lds + S_C, 32 * lb + r32, 16 * ks + 8 * hh);
#pragma unroll
            for (int q = 0; q < 2; ++q) { const int sb = 2 * (wid & 1) + q;
                for (int i = 0; i < 16; ++i) xt[q][i] = 0.f;
                if (sb <= lb) {
                    bf16x8 bfr[8];
#pragma unroll
                    for (int ks = 0; ks < 8; ++ks) bfr[ks] = ldfrag(lds + S_BM, 32 * sb + r32, 16 * ks + 8 * hh);
                    __builtin_amdgcn_sched_barrier(0);
#pragma unroll
                    for (int ks = 0; ks < 8; ++ks) xt[q] = MFMA32(bfr[ks], cf[ks], xt[q]);
                }
            }
        }
        __syncthreads();
        {
            const int l = 32 * lb + r32; const float al = cac[l], ddl = dsk * __builtin_amdgcn_rcpf(cdt[l]);
            f32x4 cs[2][4];
#pragma unroll
            for (int q = 0; q < 2; ++q)
#pragma unroll
                for (int q4 = 0; q4 < 4; ++q4) cs[q][q4] = *(const LAS f32x4*)(cac + 32 * (2 * (wid & 1) + q) + 8 * q4 + 4 * hh);
#pragma unroll
            for (int q = 0; q < 2; ++q) { const int sb = 2 * (wid & 1) + q;
#pragma unroll
                for (int q4 = 0; q4 < 4; ++q4) { float mv[4];
#pragma unroll
                    for (int e = 0; e < 4; ++e) { const int s = 32 * sb + 8 * q4 + 4 * hh + e;
                        const float ev = fexp(fminf(al - cs[q][q4][e], 0.f));
                        float v = (s <= l) ? xt[q][4 * q4 + e] * ev : 0.f;
                        v += (s == l) ? ddl : 0.f;
                        mv[e] = v; }
                    u32x2 w; w.x = pk2(mv[0], mv[1]); w.y = pk2(mv[2], mv[3]);
                    *(LAS u32x2*)(lds + S_BM + l * SP + (32 * sb + 8 * q4 + 4 * hh) * 2) = w; }
            }
        }
        __syncthreads();
        {
            const int lb2 = wid & 3, pb2 = wid >> 2; const int l = 32 * lb2 + r32; const size_t tok = t0 + l;
            const int pc0 = hd * 64 + 32 * pb2 + 4 * hh;
            u32x2 zz[4];
#pragma unroll
            for (int q4 = 0; q4 < 4; ++q4) zz[q4] = *(const u32x2*)(proj + tok * PP + pc0 + 8 * q4);
            f32x16 y1, y2; for (int i = 0; i < 16; ++i) { y1[i] = 0.f; y2[i] = 0.f; }
            bf16x8 fa[8], fb[8];
#pragma unroll
            for (int ks = 0; ks < 8; ++ks) { fa[ks] = ldfrag(lds + S_XDT, 32 * pb2 + r32, 16 * ks + 8 * hh); fb[ks] = ldfrag(lds + S_BM, 32 * lb2 + r32, 16 * ks + 8 * hh); }
            __builtin_amdgcn_sched_barrier(0);
#pragma unroll
            for (int ks = 0; ks < 8; ++ks) { if (ks < 2 * (lb2 + 1)) y1 = MFMA32(fa[ks], fb[ks], y1); }
            const float cd = fexp(aend);
#pragma unroll
            for (int i = 0; i < 16; ++i) hT[i] *= cd;
#pragma unroll
            for (int ks = 0; ks < 8; ++ks) fb[ks] = ldfrag(lds + S_BT, 32 * nb + r32, 16 * ks + 8 * hh);
            __builtin_amdgcn_sched_barrier(0);
#pragma unroll
            for (int ks = 0; ks < 8; ++ks) hT = MFMA32(fb[ks], fa[ks], hT);
#pragma unroll
            for (int ks = 0; ks < 8; ++ks) { fa[ks] = ldfrag(lds + S_HB, 32 * pb2 + r32, 16 * ks + 8 * hh); fb[ks] = ldfrag(lds + S_C, 32 * lb2 + r32, 16 * ks + 8 * hh); }
            __builtin_amdgcn_sched_barrier(0);
#pragma unroll
            for (int ks = 0; ks < 8; ++ks) y2 = MFMA32(fa[ks], fb[ks], y2);
            const float el = fexp(cac[l]);
#pragma unroll
            for (int q4 = 0; q4 < 4; ++q4) { float yv[4];
#pragma unroll
                for (int e = 0; e < 4; ++e) { const float z = (e & 1) ? bfhi(e < 2 ? zz[q4].x : zz[q4].y) : bflo(e < 2 ? zz[q4].x : zz[q4].y);
                    yv[e] = (y1[4 * q4 + e] + el * y2[4 * q4 + e]) * fsilu(z); }
                u32x2 w; w.x = pk2(yv[0], yv[1]); w.y = pk2(yv[2], yv[3]);
                *(u32x2*)(yg + tok * 1024 + pc0 + 8 * q4) = w; }
        }
        __syncthreads();
    }
#undef SSD_PREFETCH
}

DI void attn_phase_da(Frame& F) {
    const attn_body::bf16* proj = (const attn_body::bf16*)(F.ws + WS_PROJ);
    if (F.wave == 0 && lane_id() == 0) F.MISC[120] = __hip_atomic_fetch_add(F.ctl + CW_QATT, 1u, __ATOMIC_RELAXED, __HIP_MEMORY_SCOPE_AGENT);
    __syncthreads();
    int u = __builtin_amdgcn_readfirstlane((int)F.MISC[120]);
    while (u < 1024) {
        unsigned pend = 0u;
        const int qb = 7 - (u >> 7), combo = u & 127;
        const int half = combo & 1, j = (combo >> 1) & 1, h = (combo >> 2) & 7, b = combo >> 5;
        attn_body::bf16* O = (attn_body::bf16*)(F.ws + (j ? WS_O1 : WS_O0));
        attn_body::attn_unit<8>(b, PC_Q + (h * 2 + j) * 64, PC_V + h * 128 + half * 64, h * 128 + half * 64, qb, proj, proj + (PC_K - PC_Q), proj, O, (char*)F.lds, F.ctl + CW_QATT, pend, F.wave);
        if (F.wave == 0 && lane_id() == 0) F.MISC[120] = pend;
        __syncthreads();
        u = __builtin_amdgcn_readfirstlane((int)F.MISC[120]);
    }
}

DI void p3_finalize(Frame& F, const ArgP& a) {
    const int gw = F.vcu * NWAVES + F.wave, NGW = F.G * NWAVES, lane = F.lane;
    bf16_t* ycat = (bf16_t*)(F.ws + WS_YCAT); const bf16_t* yg = (const bf16_t*)(F.ws + WS_YG); const bf16_t* o0 = (const bf16_t*)(F.ws + WS_O0); const bf16_t* o1 = (const bf16_t*)(F.ws + WS_O1);
    float l1 = a.in(I_LQ1)[lane] * a.in(I_LK1)[lane], l2 = a.in(I_LQ2)[lane] * a.in(I_LK2)[lane];
    const float lam = __expf(wave_sum(l1)) - __expf(wave_sum(l2)) + LAM_INIT;
    for (int m = gw; m < NTOK; m += NGW) {
        { bf16_t* yp = ycat + (size_t)m * 2048 + 16 * lane; const bf16_t* gp = yg + (size_t)m * 1024 + 16 * lane;
          const u32x4 r0 = *(const u32x4*)gp, r1 = *(const u32x4*)(gp + 8);
          float v[16]; v[0] = bflo(r0.x); v[1] = bfhi(r0.x); v[2] = bflo(r0.y); v[3] = bfhi(r0.y); v[4] = bflo(r0.z); v[5] = bfhi(r0.z); v[6] = bflo(r0.w); v[7] = bfhi(r0.w);
          v[8] = bflo(r1.x); v[9] = bfhi(r1.x); v[10] = bflo(r1.y); v[11] = bfhi(r1.y); v[12] = bflo(r1.z); v[13] = bfhi(r1.z); v[14] = bflo(r1.w); v[15] = bfhi(r1.w);
          float ss = 0.f;
#pragma unroll
          for (int i = 0; i < 16; ++i) ss += v[i] * v[i];
#pragma unroll
          for (int o = 1; o < 32; o <<= 1) ss += __shfl_xor(ss, o);
          const float rs = 1.f / sqrtf(ss * (1.f / 512.f) + EPS_);
          const float* g = a.in(I_SSDG) + 16 * lane;
          u32x4 w0, w1;
          w0.x = pk2(v[0] * rs * g[0], v[1] * rs * g[1]); w0.y = pk2(v[2] * rs * g[2], v[3] * rs * g[3]); w0.z = pk2(v[4] * rs * g[4], v[5] * rs * g[5]); w0.w = pk2(v[6] * rs * g[6], v[7] * rs * g[7]);
          w1.x = pk2(v[8] * rs * g[8], v[9] * rs * g[9]); w1.y = pk2(v[10] * rs * g[10], v[11] * rs * g[11]); w1.z = pk2(v[12] * rs * g[12], v[13] * rs * g[13]); w1.w = pk2(v[14] * rs * g[14], v[15] * rs * g[15]);
          *(u32x4*)yp = w0; *(u32x4*)(yp + 8) = w1; }
        { const bf16_t* p0 = o0 + (size_t)m * 1024 + 16 * lane; const bf16_t* p1 = o1 + (size_t)m * 1024 + 16 * lane;
          const u32x4 a0 = *(const u32x4*)p0, a1 = *(const u32x4*)(p0 + 8), b0 = *(const u32x4*)p1, b1 = *(const u32x4*)(p1 + 8);
          float v[16];
          v[0] = bflo(a0.x) - lam * bflo(b0.x); v[1] = bfhi(a0.x) - lam * bfhi(b0.x); v[2] = bflo(a0.y) - lam * bflo(b0.y); v[3] = bfhi(a0.y) - lam * bfhi(b0.y);
          v[4] = bflo(a0.z) - lam * bflo(b0.z); v[5] = bfhi(a0.z) - lam * bfhi(b0.z); v[6] = bflo(a0.w) - lam * bflo(b0.w); v[7] = bfhi(a0.w) - lam * bfhi(b0.w);
          v[8] = bflo(a1.x) - lam * bflo(b1.x); v[9] = bfhi(a1.x) - lam * bfhi(b1.x); v[10] = bflo(a1.y) - lam * bflo(b1.y); v[11] = bfhi(a1.y) - lam * bfhi(b1.y);
          v[12] = bflo(a1.z) - lam * bflo(b1.z); v[13] = bfhi(a1.z) - lam * bfhi(b1.z); v[14] = bflo(a1.w) - lam * bflo(b1.w); v[15] = bfhi(a1.w) - lam * bfhi(b1.w);
          float ss = 0.f;
#pragma unroll
          for (int i = 0; i < 16; ++i) ss += v[i] * v[i];
          ss += __shfl_xor(ss, 1); ss += __shfl_xor(ss, 2); ss += __shfl_xor(ss, 4);
          const float rs = 1.f / sqrtf(ss * (1.f / 128.f) + EPS_) * (1.f - LAM_INIT);
          const float* g = a.in(I_SUBG) + 16 * (lane & 7);
          u32x4 w0, w1;
          w0.x = pk2(v[0] * rs * g[0], v[1] * rs * g[1]); w0.y = pk2(v[2] * rs * g[2], v[3] * rs * g[3]); w0.z = pk2(v[4] * rs * g[4], v[5] * rs * g[5]); w0.w = pk2(v[6] * rs * g[6], v[7] * rs * g[7]);
          w1.x = pk2(v[8] * rs * g[8], v[9] * rs * g[9]); w1.y = pk2(v[10] * rs * g[10], v[11] * rs * g[11]); w1.z = pk2(v[12] * rs * g[12], v[13] * rs * g[13]); w1.w = pk2(v[14] * rs * g[14], v[15] * rs * g[15]);
          bf16_t* yp = ycat + (size_t)m * 2048 + 1024 + 16 * lane;
          *(u32x4*)yp = w0; *(u32x4*)(yp + 8) = w1; }
    }
}

struct SchedDense {
    int G, c, nM, nN; const char* A; const char* B; unsigned lda, ldb; int bdiv; size_t bstride;
    DI bool next(int i, pg8::UnitD& u) const {
        const int L = i * G + c; if (L >= nM * nN) return false;
        u.rows = nullptr; u.nvalid = 0; u.lda = lda; u.ldb = ldb; u.type = 0; u.e = 0; u.x0 = 0;
        if (G == 256 && nM == 32 && nN == 8) { const int x = L >> 5, s = L & 31; u.pm = (x & 3) * 8 + (s & 7); u.pn = (x >> 2) * 4 + (s >> 3); }
        else { u.pn = L / nM; u.pm = L % nM; }
        u.A = A + (size_t)u.pm * 256 * lda; u.B = B + (size_t)u.pn * 256 * ldb + (size_t)(u.pm / bdiv) * bstride;
        return true;
    }
};
template <bool BASE_BF16>
struct EpiResid {
    static constexpr bool AFTER_DRAIN = false;
    const void* base; bf16_t* out; float* part; unsigned char* out8; float accscale;
    DI void operator()(const f32x4 (&acc)[2][2][4][2], const pg8::UnitD& u, int wr, int wc, int fr, int fq) const {
        { int ln_ = lane_id(); asm volatile("" : "+v"(ln_)); fr = ln_ & 15; fq = (ln_ >> 4) & 3; }
        const int row0 = u.pm * 256 + wr * 64 + fr, col0 = u.pn * 256 + wc * 32 + 8 * fq;
#pragma unroll
        for (int ai = 0; ai < 2; ++ai) {
            u32x4 rb[4][2]; f32x4 rf[4][2][2];
#pragma unroll
            for (int m = 0; m < 4; ++m)
#pragma unroll
                for (int bj = 0; bj < 2; ++bj) { const size_t idx = (size_t)(row0 + ai * 128 + m * 16) * 2048 + col0 + bj * 128;
                    if constexpr (BASE_BF16) rb[m][bj] = *(const u32x4*)((const bf16_t*)base + idx);
                    else { rf[m][bj][0] = *(const f32x4*)((const float*)base + idx); rf[m][bj][1] = *(const f32x4*)((const float*)base + idx + 4); } }
#pragma unroll
            for (int m = 0; m < 4; ++m) { const size_t row = (size_t)(row0 + ai * 128 + m * 16); float ss = 0.f;
#pragma unroll
                for (int bj = 0; bj < 2; ++bj) { const size_t idx = row * 2048 + col0 + bj * 128;
                    f32x4 b0, b1;
                    if constexpr (BASE_BF16) { const u32x4 r = rb[m][bj]; b0 = (f32x4){bflo(r.x), bfhi(r.x), bflo(r.y), bfhi(r.y)}; b1 = (f32x4){bflo(r.z), bfhi(r.z), bflo(r.w), bfhi(r.w)}; }
                    else { b0 = rf[m][bj][0]; b1 = rf[m][bj][1]; }
                    const f32x4 v0 = acc[ai][bj][m][0] * accscale + b0, v1 = acc[ai][bj][m][1] * accscale + b1;
                    { u32x4 w; w.x = pk2(v0[0], v0[1]); w.y = pk2(v0[2], v0[3]); w.z = pk2(v1[0], v1[1]); w.w = pk2(v1[2], v1[3]); *(u32x4*)(out + idx) = w; }
                    if (out8) { u32x2 w; w.x = __builtin_amdgcn_cvt_pk_fp8_f32(v0[0] * 16.f, v0[1] * 16.f, 0u, false); w.x = __builtin_amdgcn_cvt_pk_fp8_f32(v0[2] * 16.f, v0[3] * 16.f, w.x, true);
                        w.y = __builtin_amdgcn_cvt_pk_fp8_f32(v1[0] * 16.f, v1[1] * 16.f, 0u, false); w.y = __builtin_amdgcn_cvt_pk_fp8_f32(v1[2] * 16.f, v1[3] * 16.f, w.y, true); *(u32x2*)(out8 + idx) = w; }
                    ss += (v0[0] * v0[0] + v0[1] * v0[1]) + (v0[2] * v0[2] + v0[3] * v0[3]) + (v1[0] * v1[0] + v1[1] * v1[1]) + (v1[2] * v1[2] + v1[3] * v1[3]); }
                if (part) { ss += __shfl_xor(ss, 16); ss += __shfl_xor(ss, 32); if (fq == 0) part[row * 32 + u.pn * 4 + wc] = ss; } }
        }
    }
};

struct EpiQ {
    static constexpr bool AFTER_DRAIN = false;
    unsigned char* out8; float* part;
    DI void operator()(const f32x4 (&acc)[2][2][4][2], const pg8::UnitD& u, int wr, int wc, int fr, int fq) const {
        { int ln_ = lane_id(); asm volatile("" : "+v"(ln_)); fr = ln_ & 15; fq = (ln_ >> 4) & 3; }
        const int row0 = u.pm * 256 + wr * 64 + fr, col0 = u.pn * 256 + wc * 32 + 8 * fq;
#pragma unroll
        for (int ai = 0; ai < 2; ++ai)
#pragma unroll
            for (int m = 0; m < 4; ++m) { const size_t row = (size_t)(row0 + ai * 128 + m * 16); float ss = 0.f;
#pragma unroll
                for (int bj = 0; bj < 2; ++bj) { const size_t idx = row * 2048 + col0 + bj * 128; const f32x4 v0 = acc[ai][bj][m][0] * (1.f / 1024.f), v1 = acc[ai][bj][m][1] * (1.f / 1024.f);
                    u32x2 w; w.x = __builtin_amdgcn_cvt_pk_fp8_f32(v0[0] * 16.f, v0[1] * 16.f, 0u, false); w.x = __builtin_amdgcn_cvt_pk_fp8_f32(v0[2] * 16.f, v0[3] * 16.f, w.x, true);
                    w.y = __builtin_amdgcn_cvt_pk_fp8_f32(v1[0] * 16.f, v1[1] * 16.f, 0u, false); w.y = __builtin_amdgcn_cvt_pk_fp8_f32(v1[2] * 16.f, v1[3] * 16.f, w.y, true); *(u32x2*)(out8 + idx) = w;
                    ss += (v0[0] * v0[0] + v0[1] * v0[1]) + (v0[2] * v0[2] + v0[3] * v0[3]) + (v1[0] * v1[0] + v1[1] * v1[1]) + (v1[2] * v1[2] + v1[3] * v1[3]); }
                ss += __shfl_xor(ss, 16); ss += __shfl_xor(ss, 32); if (fq == 0) part[row * 32 + u.pn * 4 + wc] = ss; }
    }
};

struct SchedXS {
    int G, c; const unsigned char* ws;
    DI bool next(int i, pg8::UnitD& u) const {
        const int L = i * G + c; if (L >= 256) return false;
        u.rows = nullptr; u.nvalid = 0; u.e = 0;
        const int q = L & 127, bh = q >> 3, t8 = q & 7, b = bh >> 2, h = bh & 3;
        u.pm = b; u.pn = h; u.x0 = t8;
        if (L < 128) { u.type = 0; u.lda = 2048u; u.ldb = 512u;
            u.A = (const char*)(ws + WS_QF8) + (size_t)(b * 2048 + t8 * 256) * 2048 + h * 512; u.B = (const char*)(ws + WS_KN8) + (size_t)(bh * 256) * 512; }
        else { u.type = 1; u.lda = 2048u; u.ldb = 2048u;
            u.A = (const char*)(ws + WS_WO) + (size_t)(t8 * 256) * 2048 + h * 512; u.B = (const char*)(ws + WS_VF8) + (size_t)(b * 256) * 2048 + h * 512; }
        return true;
    }
};
struct EpiXS {
    static constexpr bool AFTER_DRAIN = false;
    unsigned char* P; unsigned char* VWT; const float* part1; const float* partq; LAS float* red;
    DI void operator()(const f32x4 (&acc)[2][2][4][2], const pg8::UnitD& u, int wr, int wc, int fr, int fq) const {
        { int ln_ = lane_id(); asm volatile("" : "+v"(ln_)); fr = ln_ & 15; fq = (ln_ >> 4) & 3; }
        const int b = u.pm, h = u.pn, t8 = u.x0;
        const int col0 = wc * 32 + 8 * fq;
        if (u.type == 1) {
            unsigned char* Vu = VWT + ((size_t)b * 2048 + t8 * 256) * 1024 + h * 256;
#pragma unroll
            for (int ai = 0; ai < 2; ++ai)
#pragma unroll
                for (int m = 0; m < 4; ++m) { const unsigned rl = (unsigned)(ai * 128 + wr * 64 + m * 16 + fr);
#pragma unroll
                    for (int bj = 0; bj < 2; ++bj) { const f32x4 v0 = acc[ai][bj][m][0] * (32.f / 1024.f), v1 = acc[ai][bj][m][1] * (32.f / 1024.f);
                        u32x2 w; w.x = __builtin_amdgcn_cvt_pk_fp8_f32(v0[0], v0[1], 0u, false); w.x = __builtin_amdgcn_cvt_pk_fp8_f32(v0[2], v0[3], w.x, true);
                        w.y = __builtin_amdgcn_cvt_pk_fp8_f32(v1[0], v1[1], 0u, false); w.y = __builtin_amdgcn_cvt_pk_fp8_f32(v1[2], v1[3], w.y, true);
                        *(u32x2*)(Vu + (rl * 1024u + (unsigned)(bj * 128 + col0))) = w; } }
            return;
        }
        const size_t row0 = (size_t)b * 2048 + t8 * 256;
        const char* p1u = (const char*)(part1 + row0 * 32); const char* pqu = (const char*)(partq + row0 * 32 + h * 8); unsigned char* Pu = P + row0 * 1024 + h * 256;
        float rsc[2][4];
#pragma unroll
        for (int ai = 0; ai < 2; ++ai)
#pragma unroll
            for (int m = 0; m < 4; ++m) { const unsigned rl = (unsigned)(ai * 128 + wr * 64 + m * 16 + fr);
                const f32x4 p0 = *(const f32x4*)(p1u + (rl * 32u + (unsigned)fq * 8u) * 4u), p1 = *(const f32x4*)(p1u + (rl * 32u + (unsigned)fq * 8u + 4u) * 4u);
                float s1 = (p0[0] + p0[1]) + (p0[2] + p0[3]) + (p1[0] + p1[1]) + (p1[2] + p1[3]);
                const f32x2 pq = *(const f32x2*)(pqu + (rl * 32u + (unsigned)fq * 2u) * 4u);
                float sq = pq[0] + pq[1];
                s1 = quad_sum_16_32(s1); sq = quad_sum_16_32(sq);
                rsc[ai][m] = __builtin_amdgcn_rsqf(sq * (1.f / 512.f) + EPS_ * (s1 * (1.f / 2048.f) + EPS_)) * (1.4426950408889634f / 2048.f);
                float ps = 0.f;
#pragma unroll
                for (int bj = 0; bj < 2; ++bj)
#pragma unroll
                    for (int n = 0; n < 2; ++n)
#pragma unroll
                        for (int e = 0; e < 4; ++e) ps += __builtin_amdgcn_exp2f(fminf(acc[ai][bj][m][n][e] * rsc[ai][m], 100.f));
                ps = quad_sum_16_32(ps);
                if (fq == 0) red[rl * 4 + wc] = ps;
                __builtin_amdgcn_sched_barrier(0); }
        __syncthreads();
        { int ln_ = lane_id(); asm volatile("" : "+v"(ln_)); fr = ln_ & 15; fq = (ln_ >> 4) & 3; }
#pragma unroll
        for (int ai = 0; ai < 2; ++ai)
#pragma unroll
            for (int m = 0; m < 4; ++m) { const unsigned rl = (unsigned)(ai * 128 + wr * 64 + m * 16 + fr);
                const f32x4 t = *(const LAS f32x4*)(red + rl * 4); const float inv = 256.f * __builtin_amdgcn_rcpf((t[0] + t[1]) + (t[2] + t[3])); float rs = rsc[ai][m]; asm volatile("" : "+v"(rs));
#pragma unroll
                for (int bj = 0; bj < 2; ++bj) { float x[8];
#pragma unroll
                    for (int n = 0; n < 2; ++n)
#pragma unroll
                        for (int e = 0; e < 4; ++e) x[n * 4 + e] = __builtin_amdgcn_exp2f(fminf(acc[ai][bj][m][n][e] * rs, 100.f)) * inv;
                    u32x2 w; w.x = __builtin_amdgcn_cvt_pk_fp8_f32(x[0], x[1], 0u, false); w.x = __builtin_amdgcn_cvt_pk_fp8_f32(x[2], x[3], w.x, true);
                    w.y = __builtin_amdgcn_cvt_pk_fp8_f32(x[4], x[5], 0u, false); w.y = __builtin_amdgcn_cvt_pk_fp8_f32(x[6], x[7], w.y, true);
                    *(u32x2*)(Pu + (rl * 1024u + (unsigned)(bj * 128 + wc * 32 + 8 * fq))) = w; } }
        __syncthreads();
    }
};

constexpr int HNP = 2052;
DI void p8_route(Frame& F, const ArgP& a) {
    LAS float* s_hn = (LAS float*)F.lds; LAS float* s_part = (LAS float*)(F.lds + 16 * HNP * 4); LAS float* s_log = s_part + 8 * 16 * 32; LAS int* s_slot = (LAS int*)(s_log + 16 * 32);
    LAS int* s_cnt = s_slot + 64; LAS int* s_base = s_cnt + 32;
    const bf16_t* h2 = (const bf16_t*)(F.ws + WS_H2); unsigned char* xg = (unsigned char*)(F.ws + WS_XG);
    float* gate_of = (float*)(F.ws + WS_GATEOF); int* tok_e = (int*)(F.ws + WS_TOKE);
    const float* rw = a.in(I_RW); const float* rb = a.in(I_RB); const float* g3 = a.in(I_GFFN);
    const int lane = F.lane, wave = F.wave, tid = F.tid;
    float bw0[64], bw1[64];
    { const int kq = lane >> 4, c16 = lane & 15; const float* bp = rw + (size_t)(256 * wave + kq) * 32 + c16;
#pragma unroll
      for (int j = 0; j < 64; ++j) { bw0[j] = bp[(size_t)(4 * j) * 32]; bw1[j] = bp[(size_t)(4 * j) * 32 + 16]; } }
    for (int task = F.vcu; task < NTOK / 16; task += F.G) {
        const int tb = task * 16;
#pragma unroll
        for (int q = 0; q < 2; ++q) { const int tl = 2 * wave + q; const size_t tok = (size_t)(tb + tl);
            const u32x2* xr = (const u32x2*)(h2 + tok * 2048) + lane;
            f32x4 v[8]; float s = 0.f;
#pragma unroll
            for (int j = 0; j < 8; ++j) { const u32x2 rw_ = xr[64 * j]; v[j] = (f32x4){bflo(rw_.x), bfhi(rw_.x), bflo(rw_.y), bfhi(rw_.y)}; s += (v[j].x * v[j].x + v[j].y * v[j].y) + (v[j].z * v[j].z + v[j].w * v[j].w); }
            const float rstd = 1.f / sqrtf(wave_sum(s) * (1.f / 2048.f) + EPS_);
#pragma unroll
            for (int j = 0; j < 8; ++j) { const f32x4 gg = ((const f32x4*)g3)[lane + 64 * j]; const f32x4 y = v[j] * rstd * gg;
                *(LAS f32x4*)(s_hn + tl * HNP + (lane + 64 * j) * 4) = y; } }
        __syncthreads();
        {
            f32x4 acc0 = {0.f, 0.f, 0.f, 0.f}, acc1 = {0.f, 0.f, 0.f, 0.f};
            const int kq = lane >> 4, c16 = lane & 15;
            const LAS float* ap = s_hn + c16 * HNP + 256 * wave;
#pragma unroll
            for (int j = 0; j < 64; ++j) { const f32x4 a4 = *(const LAS f32x4*)(ap + 4 * j);
                const float av = (kq == 0) ? a4.x : (kq == 1) ? a4.y : (kq == 2) ? a4.z : a4.w;
                acc0 = __builtin_amdgcn_mfma_f32_16x16x4f32(av, bw0[j], acc0, 0, 0, 0);
                acc1 = __builtin_amdgcn_mfma_f32_16x16x4f32(av, bw1[j], acc1, 0, 0, 0); }
            LAS float* pp = s_part + wave * 512 + c16;
#pragma unroll
            for (int r = 0; r < 4; ++r) { pp[(4 * kq + r) * 32] = acc0[r]; pp[(4 * kq + r) * 32 + 16] = acc1[r]; }
        }
        __syncthreads();
        {
            const int tt = tid >> 5, e = tid & 31; float lg = rb[e];
#pragma unroll
            for (int w = 0; w < 8; ++w) lg += s_part[w * 512 + tt * 32 + e];
            if (tid < 32) s_cnt[tid] = 0;
            float val[4]; int idx[4]; float cur = lg;
#pragma unroll
            for (int k = 0; k < 4; ++k) { float bv = cur; int bi = e;
#pragma unroll
                for (int o = 1; o < 32; o <<= 1) { const float ov = __shfl_xor(bv, o); const int oi = __shfl_xor(bi, o); if (ov > bv || (ov == bv && oi < bi)) { bv = ov; bi = oi; } }
                val[k] = bv; idx[k] = bi; if (e == bi) cur = -INFINITY; }
            __syncthreads();
            int myrank = 0, myexp = 0; float mygate = 0.f;
            if (e < 4) { const float sum = (__expf(val[0] - val[0]) + __expf(val[1] - val[0])) + (__expf(val[2] - val[0]) + __expf(val[3] - val[0]));
                const float mv = (e == 0) ? val[0] : (e == 1) ? val[1] : (e == 2) ? val[2] : val[3]; myexp = (e == 0) ? idx[0] : (e == 1) ? idx[1] : (e == 2) ? idx[2] : idx[3];
                mygate = __expf(mv - val[0]) / sum; myrank = __hip_atomic_fetch_add(&s_cnt[myexp], 1, __ATOMIC_RELAXED, __HIP_MEMORY_SCOPE_WORKGROUP); }
            __syncthreads();
            if (tid < 32) { const int c = s_cnt[tid]; s_base[tid] = c ? (int)__hip_atomic_fetch_add(F.ctl + CW_CNT + 64 * tid, (unsigned)c, __ATOMIC_RELAXED, __HIP_MEMORY_SCOPE_AGENT) : 0; }
            __syncthreads();
            if (e < 4) { const int slot = myexp * 8192 + s_base[myexp] + myrank; const int tok = tb + tt;
                gate_of[slot] = mygate; tok_e[tok * 4 + e] = slot; s_slot[tt * 4 + e] = slot; }
        }
        __syncthreads();
#pragma unroll
        for (int q = 0; q < 2; ++q) { const int tl = 2 * wave + q;
            unsigned o[8];
#pragma unroll
            for (int j = 0; j < 8; ++j) { const f32x4 y = *(const LAS f32x4*)(s_hn + tl * HNP + (lane + 64 * j) * 4);
                unsigned w = 0u; w = __builtin_amdgcn_cvt_pk_fp8_f32(y.x * 4.f, y.y * 4.f, w, false); w = __builtin_amdgcn_cvt_pk_fp8_f32(y.z * 4.f, y.w * 4.f, w, true); o[j] = w; }
#pragma unroll
            for (int k = 0; k < 4; ++k) { unsigned* o4 = (unsigned*)(xg + (size_t)s_slot[tl * 4 + k] * 2048) + lane;
#pragma unroll
                for (int j = 0; j < 8; ++j) o4[64 * j] = o[j]; } }
        __syncthreads();
    }
}

DI void moe_tables(Frame& F) {
    if (F.tid < 64) { const int e = F.tid & 31;
        const unsigned c = F.ctl[CW_CNT + 64 * e], mt = (c + 255u) >> 8;
        unsigned incl = mt;
#pragma unroll
        for (int o = 1; o < 32; o <<= 1) { const unsigned v = __shfl_up(incl, o, 64); if (e >= o) incl += v; }
        const unsigned base = incl - mt;
        if (F.tid < 32) { F.MISC[16 + e] = c; F.MISC[48 + e] = base; F.MISC[80 + e] = mt; if (e == 31) F.MISC[112] = incl;
            volatile LAS unsigned char* tab = (volatile LAS unsigned char*)(F.MISC + 128);
            for (unsigned t = 0; t < mt; ++t) tab[base + t] = (unsigned char)e; } }
    __syncthreads();
}
DI int ldsu(volatile LAS unsigned* p) { return __builtin_amdgcn_readfirstlane((int)*p); }
template <int NTN  >
struct SchedMoe {
    int G, c; const unsigned char* ws; volatile LAS unsigned* MISC; int total;
    DI bool next(int i, pg8::UnitD& u) const {
        const int L = i * G + c; if (L >= total) return false;
        const int e = __builtin_amdgcn_readfirstlane((int)((volatile LAS unsigned char*)(MISC + 128))[L / NTN]);
        const int tb = ldsu(MISC + 48 + e), mte = ldsu(MISC + 80 + e), cnt = ldsu(MISC + 16 + e);
        const int local = L - tb * NTN, nt = local / mte, mt = local % mte;
        u.type = 0; u.e = e; u.pn = nt; u.pm = tb + mt; u.x0 = mt; u.lda = 2048u; u.ldb = 128u;
        u.rows = nullptr; u.nvalid = cnt - mt * 256;
        if (NTN == 16) { u.A = (const char*)(ws + WS_XG) + ((size_t)e * 8192 + (size_t)mt * 256) * 2048;
            u.B = (const char*)(ws + WS_W1) + ((size_t)e * 4096 + (size_t)nt * 256) * 2048; }
        else { u.A = (const char*)(ws + WS_ACT) + ((size_t)e * 8192 + (size_t)mt * 256) * 2048;
            u.B = (const char*)(ws + WS_W2) + ((size_t)e * 2048 + (size_t)nt * 256) * 2048; }
        return true;
    }
};
struct EpiMoe1 {
    static constexpr bool AFTER_DRAIN = false;
    unsigned char* act; const float* b1;
    DI void operator()(const f32x4 (&acc)[2][2][4][2], const pg8::UnitD& u, int wr, int wc, int fr, int fq) const {
        { int ln_ = lane_id(); asm volatile("" : "+v"(ln_)); fr = ln_ & 15; fq = (ln_ >> 4) & 3; }
        const int j0 = u.pn * 128 + wc * 32 + 8 * fq;
        const float* bg = b1 + (size_t)u.e * 4096 + j0; const float* bu = bg + 2048;
        const f32x4 bg0 = *(const f32x4*)bg, bg1 = *(const f32x4*)(bg + 4), bu0 = *(const f32x4*)bu, bu1 = *(const f32x4*)(bu + 4);
#pragma unroll
        for (int ai = 0; ai < 2; ++ai)
#pragma unroll
            for (int m = 0; m < 4; ++m) { const size_t row = (size_t)u.e * 8192 + u.x0 * 256 + ai * 128 + wr * 64 + m * 16 + fr;
                float o[8];
#pragma unroll
                for (int n = 0; n < 2; ++n) {
                    f32x4 g = acc[ai][0][m][n] * (1.f / 256.f) + (n ? bg1 : bg0);
                    g = __builtin_elementwise_min(g, (f32x4){7.f, 7.f, 7.f, 7.f});
                    f32x4 uu = acc[ai][1][m][n] * (1.f / 256.f) + (n ? bu1 : bu0);
                    uu = __builtin_elementwise_min(__builtin_elementwise_max(uu, (f32x4){-7.f, -7.f, -7.f, -7.f}), (f32x4){7.f, 7.f, 7.f, 7.f});
                    f32x4 t = g * (-1.702f * 1.4426950408889634f);
                    t = (f32x4){__builtin_amdgcn_exp2f(t[0]), __builtin_amdgcn_exp2f(t[1]), __builtin_amdgcn_exp2f(t[2]), __builtin_amdgcn_exp2f(t[3])} + 1.f;
                    const f32x4 r = {__builtin_amdgcn_rcpf(t[0]), __builtin_amdgcn_rcpf(t[1]), __builtin_amdgcn_rcpf(t[2]), __builtin_amdgcn_rcpf(t[3])};
                    const f32x4 ov = g * r * (uu * 4.f + 4.f);
#pragma unroll
                    for (int e = 0; e < 4; ++e) o[n * 4 + e] = ov[e]; }
                u32x2 w; w.x = __builtin_amdgcn_cvt_pk_fp8_f32(o[0], o[1], 0u, false); w.x = __builtin_amdgcn_cvt_pk_fp8_f32(o[2], o[3], w.x, true);
                w.y = __builtin_amdgcn_cvt_pk_fp8_f32(o[4], o[5], 0u, false); w.y = __builtin_amdgcn_cvt_pk_fp8_f32(o[6], o[7], w.y, true);
                *(u32x2*)(act + row * 2048 + j0) = w;
                __builtin_amdgcn_sched_barrier(0); }
    }
};
struct EpiMoe2 {
    static constexpr bool AFTER_DRAIN = false;
    unsigned char* y; const float* b2; const float* gate_of;
    DI void operator()(const f32x4 (&acc)[2][2][4][2], const pg8::UnitD& u, int wr, int wc, int fr, int fq) const {
        { int ln_ = lane_id(); asm volatile("" : "+v"(ln_)); fr = ln_ & 15; fq = (ln_ >> 4) & 3; }
        const int col0 = u.pn * 256 + wc * 32 + 8 * fq;
        const float* bp = b2 + (size_t)u.e * 2048 + col0;
        const f32x4 bb[2][2] = {{*(const f32x4*)(bp), *(const f32x4*)(bp + 4)}, {*(const f32x4*)(bp + 128), *(const f32x4*)(bp + 132)}};
        const float* gp = gate_of + (size_t)u.e * 8192 + u.x0 * 256 + wr * 64 + fr;
        float gts[2][4];
#pragma unroll
        for (int ai = 0; ai < 2; ++ai)
#pragma unroll
            for (int m = 0; m < 4; ++m) gts[ai][m] = gp[ai * 128 + m * 16];
#pragma unroll
        for (int ai = 0; ai < 2; ++ai)
#pragma unroll
            for (int m = 0; m < 4; ++m) { const int rl = ai * 128 + wr * 64 + m * 16 + fr; const size_t row = (size_t)u.e * 8192 + u.x0 * 256 + rl;
                const float gt = (rl < u.nvalid) ? gts[ai][m] * 32.f : 0.f;
#pragma unroll
                for (int bj = 0; bj < 2; ++bj) { const f32x4 v0 = (acc[ai][bj][m][0] * (1.f / 256.f) + bb[bj][0]) * gt, v1 = (acc[ai][bj][m][1] * (1.f / 256.f) + bb[bj][1]) * gt;
                    u32x2 w; w.x = __builtin_amdgcn_cvt_pk_fp8_f32(v0[0], v0[1], 0u, false); w.x = __builtin_amdgcn_cvt_pk_fp8_f32(v0[2], v0[3], w.x, true);
                    w.y = __builtin_amdgcn_cvt_pk_fp8_f32(v1[0], v1[1], 0u, false); w.y = __builtin_amdgcn_cvt_pk_fp8_f32(v1[2], v1[3], w.y, true);
                    *(u32x2*)(y + row * 2048 + col0 + bj * 128) = w; } }
    }
};

DI void p11_combine(Frame& F, const ArgP& a) {
    const int gw = F.vcu * NWAVES + F.wave, NGW = F.G * NWAVES, lane = F.lane;
    const bf16_t* h2 = (const bf16_t*)(F.ws + WS_H2); const unsigned char* y = (const unsigned char*)(F.ws + WS_Y);
    const int* tok_e = (const int*)(F.ws + WS_TOKE);
    for (int t = gw; t < NTOK; t += NGW) {
        size_t yrow[4];
#pragma unroll
        for (int k = 0; k < 4; ++k) yrow[k] = (size_t)tok_e[t * 4 + k] * 2048;
#pragma unroll
        for (int j = 0; j < 8; ++j) { const int c = (lane + 64 * j) * 4;
            const u32x2 hw = *(const u32x2*)(h2 + (size_t)t * 2048 + c); f32x4 v = {bflo(hw.x), bfhi(hw.x), bflo(hw.y), bfhi(hw.y)};
#pragma unroll
            for (int k = 0; k < 4; ++k) { const unsigned w = *(const unsigned*)(y + yrow[k] + c); const f32x2 lo = __builtin_amdgcn_cvt_pk_f32_fp8(w, false), hi = __builtin_amdgcn_cvt_pk_f32_fp8(w, true);
                v.x += lo.x * (1.f / 32.f); v.y += lo.y * (1.f / 32.f); v.z += hi.x * (1.f / 32.f); v.w += hi.y * (1.f / 32.f); }
            *(f32x4*)(a.out() + (size_t)t * 2048 + c) = v; }
    }
}

#ifndef MK_PER_PHASE
#define MK_PER_PHASE 0
#endif
#ifndef MK_LAST_PHASE
#define MK_LAST_PHASE 12
#endif
constexpr int N_PHASES = MK_LAST_PHASE;

__global__ void __launch_bounds__(NWAVES * 64, 2) mega_fwd(Args args_) {
    const ArgP args{};
    extern __shared__ __attribute__((aligned(16))) unsigned char lds_raw[];
    Frame F;
    F.lds = (LAS unsigned char*)lds_raw;
    F.MISC = (volatile LAS unsigned*)(F.lds + MISC_OFF);
    F.wave = __builtin_amdgcn_readfirstlane((int)(threadIdx.x >> 6)); F.lane = lane_id(); F.tid = F.wave * 64 + F.lane;
    F.G = gridDim.x; { const int bx = blockIdx.x; F.vcu = (F.G % 8 == 0) ? (bx % 8) * (F.G / 8) + bx / 8 : bx; }
    F.ws = args_.ws; F.ctl = (unsigned*)(args_.ws + WS_CTL);
    for (int u = F.tid; u < 256; u += NWAVES * 64) F.MISC[u] = 0u;
    __syncthreads();
    if (F.lane == 0) F.MISC[192 + ((unsigned)__builtin_amdgcn_s_getreg((5 << 11) | 4) & 63u)] = (unsigned)F.wave;
    __syncthreads();
    XcdBarrier bar; bar.bar = F.ctl + CW_BAR; bar.x = 0; bar.st = nullptr;
    const int lo = args_.ph_lo, hi = args_.ph_hi;
    if (hi - lo > 1) bar = xcd_barrier_post(F.ctl + CW_BAR, F.MISC + 8);
#ifndef MK_PHASE_MASK
#define MK_PHASE_MASK 0xFFFF
#endif
#define IN(k) (((MK_PHASE_MASK >> (k)) & 1) && lo <= (k) && (k) < hi)
#define SEAM(k) do { if (IN(k) && IN((k) + 1)) xcd_barrier(bar); } while (0)
#define FRESH() do { int l_ = lane_id(); asm volatile("" : "+v"(l_)); F.lane = l_; F.wave = wave_now(F.MISC); F.tid = F.wave * 64 + l_; } while (0)
    unsigned char* ws = args_.ws;

    if (IN(0)) { FRESH(); p0_prologue(F, args); }
    SEAM(0);
    if (IN(1)) { FRESH();
        const bool conv_first = (F.vcu & 1) == 0;
        if (conv_first) { conv_share(F, args); __syncthreads(); }
        SchedP1 S{F.G, F.vcu, ws, 0, 32 * 23};
        EpiP1 E{(bf16_t*)(ws + WS_PROJ), (float*)(ws + WS_DT), (bf16_t*)(ws + WS_KVRAW), args.in(I_DAQG), args.in(I_DAKG), (unsigned char*)(ws + WS_VF8)};
        pg8::gemm_phase<EpiP1, SchedP1, false, true>(F.wave, F.lds + RING_OFF, 32, S, E);
        if (!conv_first) { __syncthreads(); conv_share(F, args); }
    }
    SEAM(1);
    if (IN(2)) { FRESH();
        if ((F.vcu & 3) == 1) {
            SchedP1 S{(F.G + 3) >> 2, F.vcu >> 2, ws, 32 * 23, 32 * 23 + 64};
            EpiP1 E{(bf16_t*)(ws + WS_PROJ), (float*)(ws + WS_DT), (bf16_t*)(ws + WS_KVRAW), args.in(I_DAQG), args.in(I_DAKG), (unsigned char*)(ws + WS_VF8)};
            pg8::gemm_phase<EpiP1, SchedP1, false, true>(F.wave, F.lds + RING_OFF, 32, S, E);
            __syncthreads();
        }
        if ((F.vcu & 3) == 0) { for (int u = F.vcu >> 2; u < 64; u += (F.G + 3) >> 2) ssd_unit(F, args, u >> 4, u & 15); }
        __syncthreads();
        attn_phase_da(F);
        __syncthreads();
        conv_queue(F, args, CW_QCONV, CV_NJ - CV_TAIL, CV_TAIL1);
    }
    SEAM(2);
    if (IN(3)) { FRESH(); kprep(F, args); p3_finalize(F, args); }
    SEAM(3);
    if (IN(4)) { FRESH();
        SchedDense S{F.G, F.vcu, 32, 8, (const char*)(ws + WS_YCAT), (const char*)(ws + WS_WOUT), 4096u, 4096u, 1 << 30, 0};
        EpiResid<false> E{args.in(I_X), (bf16_t*)(ws + WS_H1), (float*)(ws + WS_PART1), (unsigned char*)(ws + WS_H1F8), 1.f};
        pg8::gemm_phase<EpiResid<false>, SchedDense, false, true>(F.wave, F.lds + RING_OFF, 32, S, E);
    }
    SEAM(4);
    if (IN(5)) { FRESH();
        SchedDense S{F.G, F.vcu, 32, 8, (const char*)(ws + WS_H1F8), (const char*)(ws + WS_WQ), 2048u, 2048u, 1 << 30, 0};
        EpiQ E{(unsigned char*)(ws + WS_QF8), (float*)(ws + WS_PARTQ)};
        pg8::gemm_phase<EpiQ, SchedDense, false, true, true>(F.wave, F.lds + RING_OFF, 16, S, E);
    }
    SEAM(5);
    if (IN(6)) { FRESH();
        SchedXS S{F.G, F.vcu, ws};
        EpiXS E{(unsigned char*)(ws + WS_P8), (unsigned char*)(ws + WS_VWT8), (const float*)(ws + WS_PART1), (const float*)(ws + WS_PARTQ), (LAS float*)(F.lds + RING_BYTES)};
        pg8::gemm_phase<EpiXS, SchedXS, false, true, true>(F.wave, F.lds + RING_OFF, 4, S, E);
    }
    SEAM(6);
    if (IN(7)) { FRESH();
        SchedDense S{F.G, F.vcu, 32, 8, (const char*)(ws + WS_P8), (const char*)(ws + WS_VWT8), 1024u, 1024u, 8, (size_t)2048 * 1024};
        EpiResid<true> E{(const void*)(ws + WS_H1), (bf16_t*)(ws + WS_H2), nullptr, nullptr, 1.f / 8192.f};
        pg8::gemm_phase<EpiResid<true>, SchedDense, false, true, true>(F.wave, F.lds + RING_OFF, 8, S, E);
    }
    SEAM(7);
    if (IN(8)) { FRESH(); p8_route(F, args); }
    SEAM(8);
    if (IN(9)) { FRESH();
        moe_tables(F);
        SchedMoe<16> S{F.G, F.vcu, ws, F.MISC, ldsu(F.MISC + 112) * 16};
        EpiMoe1 E{(unsigned char*)(ws + WS_ACT), args.in(I_B1)};
        pg8::gemm_phase<EpiMoe1, SchedMoe<16>, false, true, true>(F.wave, F.lds + RING_OFF, 16, S, E);
        __syncthreads();
        conv_queue(F, args, CW_QCONV2, CV_NJ - CV_TAIL2, CV_TAIL2);
    }
    SEAM(9);
    if (IN(10)) { FRESH();
        moe_tables(F);
        SchedMoe<8> S{F.G, F.vcu, ws, F.MISC, ldsu(F.MISC + 112) * 8};
        EpiMoe2 E{(unsigned char*)(ws + WS_Y), args.in(I_B2), (const float*)(ws + WS_GATEOF)};
        pg8::gemm_phase<EpiMoe2, SchedMoe<8>, false, true, true>(F.wave, F.lds + RING_OFF, 16, S, E);
    }
    SEAM(10);
    if (IN(11)) { FRESH(); p11_combine(F, args); }
#undef IN
#undef SEAM
}

extern "C" void kernel_launch(void* const* d_in, const int* in_sizes, int n_in, void* d_out, int out_size, void* d_ws, size_t ws_size, hipStream_t stream) {
    static int grid = 0;
    if (grid == 0) {
        if (n_in != 32 || out_size != NTOK * 2048 || ws_size < WS_END) { fprintf(stderr, "kernel_launch: unexpected shapes (n_in %d out %d ws %zu); nothing launched\n", n_in, out_size, ws_size); grid = -1; return; }
        int dev = 0, cus = 0, per_cu = 0;
        if (hipGetDevice(&dev) != hipSuccess || hipDeviceGetAttribute(&cus, hipDeviceAttributeMultiprocessorCount, dev) != hipSuccess) { grid = -1; return; }
        if (hipFuncSetAttribute((const void*)mega_fwd, hipFuncAttributeMaxDynamicSharedMemorySize, LDS_BYTES) != hipSuccess) { fprintf(stderr, "kernel_launch: hipFuncSetAttribute failed\n"); grid = -1; return; }
        if (hipOccupancyMaxActiveBlocksPerMultiprocessor(&per_cu, (const void*)mega_fwd, NWAVES * 64, LDS_BYTES) != hipSuccess || per_cu < 1) { fprintf(stderr, "kernel_launch: occupancy query says %d\n", per_cu); }
        (void)hipGetLastError();
        if (cus < 256) { fprintf(stderr, "kernel_launch: needs 256 CUs, found %d; nothing launched\n", cus); grid = -1; return; }
        grid = 256;
    }
    if (grid < 0) return;
    if (hipMemsetAsync((char*)d_ws + WS_CTL, 0, CTL_ZERO_BYTES, stream) != hipSuccess) return;
    Args a{};
    for (int i = 0; i < 32; ++i) a.in[i] = (const float*)d_in[i];
    a.out = (float*)d_out; a.ws = (unsigned char*)d_ws;
#if MK_PER_PHASE
    for (int p = 0; p < N_PHASES; ++p) { a.ph_lo = p; a.ph_hi = p + 1; hipLaunchKernelGGL(mega_fwd, dim3(grid), dim3(NWAVES * 64), LDS_BYTES, stream, a); }
#else
    a.ph_lo = 0; a.ph_hi = N_PHASES;
    hipLaunchKernelGGL(mega_fwd, dim3(grid), dim3(NWAVES * 64), LDS_BYTES, stream, a);
#ifdef MK_PROBE_LO
    for (int p = MK_PROBE_LO; p < MK_PROBE_HI; ++p) { a.ph_lo = p; a.ph_hi = p + 1;
#ifdef MK_HOTPROBE
        a.probe = MK_HOTPROBE;
#endif
        if (p == 2) (void)hipMemsetAsync((char*)d_ws + WS_CTL + CW_QATT * 4, 0, 1024, stream);
        hipLaunchKernelGGL(mega_fwd, dim3(grid), dim3(NWAVES * 64), LDS_BYTES, stream, a); }
#endif
#endif
}
```

```cpp
#define MK_PER_PHASE 0
#define MK_LAST_PHASE 12
#define MK_WOUT_FP8 1
#include <hip/hip_runtime.h>
#include <hip/hip_bf16.h>
#include <cstdio>
#include <cstdint>
#include <cmath>

#define GAS __attribute__((address_space(1)))
#define LAS __attribute__((address_space(3)))
typedef unsigned short bf16_t;
typedef short bf16x8 __attribute__((ext_vector_type(8)));
typedef float f32x2 __attribute__((ext_vector_type(2)));
typedef float f32x4 __attribute__((ext_vector_type(4)));
typedef float f32x16 __attribute__((ext_vector_type(16)));
typedef unsigned u32x2 __attribute__((ext_vector_type(2)));
typedef unsigned u32x4 __attribute__((ext_vector_type(4)));
typedef __bf16 bf16x2_t __attribute__((ext_vector_type(2)));

#define DI __device__ __forceinline__
DI int lane_id() { int l_; asm volatile("v_mbcnt_lo_u32_b32 %0, -1, 0\n\tv_mbcnt_hi_u32_b32 %0, -1, %0" : "=v"(l_)); return l_; }
DI unsigned pk2(float lo, float hi) { f32x2 v = {lo, hi}; bf16x2_t b = __builtin_convertvector(v, bf16x2_t); return __builtin_bit_cast(unsigned, b); }
DI float bflo(unsigned u) { return __uint_as_float(u << 16); }
DI float bfhi(unsigned u) { return __uint_as_float(u & 0xffff0000u); }
DI float bf2f(bf16_t h) { return __uint_as_float(((unsigned)h) << 16); }
DI float wave_sum(float v) {
#pragma unroll
    for (int o = 1; o < 64; o <<= 1) v += __shfl_xor(v, o);
    return v;
}
DI float quad_sum_16_32(float v) {
    int l_ = lane_id(); asm volatile("" : "+v"(l_));
    const int a16 = ((l_ ^ 16) & 63) << 2, a32 = ((l_ ^ 32) & 63) << 2;
    v += __builtin_bit_cast(float, __builtin_amdgcn_ds_bpermute(a16, __builtin_bit_cast(int, v)));
    v += __builtin_bit_cast(float, __builtin_amdgcn_ds_bpermute(a32, __builtin_bit_cast(int, v)));
    return v;
}
DI float siluf(float x) { return x / (1.f + __expf(-x)); }

constexpr int DM_ = 2048, NB = 4, SEQ_ = 2048, NTOK = NB * SEQ_;
constexpr int PP = 5632;
constexpr int PC_XBC = 1024, PC_Q = 2560, PC_K = 3584, PC_V = 4608, PC_DT = 5632;
constexpr int WIN_ROWS = 5888;
constexpr int NEXP = 32, MEMLEN = 256;
constexpr float EPS_ = 1e-6f;
constexpr float LAM_INIT = 0.2f;

namespace pg8 {
constexpr int BM = 256, BK = 64, HALF = 128, HTB = HALF * BK * 2  , STAGE_BYTES = 8 * HTB;
DI int lds_byte(int r, int c) { const int st = (r >> 4) * 2 + (c >> 5), rr = r & 15, cc = c & 31, ob = rr * 64 + cc * 2; return st * 1024 + (ob ^ (((ob >> 9) & 1) << 5)); }
DI void stage_rc(int b, int& R, int& C) { const int st = b / 1024, sb = b % 1024, swz = sb ^ (((sb >> 9) & 1) << 5); R = (st >> 1) * 16 + swz / 64; C = (st & 1) * 32 + (swz % 64) / 2; }
DI int perm32(int rho) { const int n = rho >> 4, i = rho & 15; return 8 * (i >> 2) + 4 * n + (i & 3); }

struct UnitD {
    const char* A; const char* B;
    const int* rows;
    unsigned lda, ldb;
    int nvalid;
    int type, pm, pn, e, x0;
};
typedef int v8i_t __attribute__((ext_vector_type(8)));
DI v8i_t cat8(bf16x8 lo, bf16x8 hi) { typedef int v4i_t __attribute__((ext_vector_type(4))); const v4i_t a = __builtin_bit_cast(v4i_t, lo), b = __builtin_bit_cast(v4i_t, hi); return (v8i_t){a[0], a[1], a[2], a[3], b[0], b[1], b[2], b[3]}; }
DI void dense_voff(unsigned lda, unsigned ldb, int tid, unsigned (&vA)[2], unsigned (&vB)[2]) {
#pragma unroll
    for (int i = 0; i < 2; ++i) { int R, C; stage_rc(tid * 16 + i * 8192, R, C); const int Rb = (R & ~31) + perm32(R & 31);
        vA[i] = (unsigned)R * lda + (unsigned)C * 2u; vB[i] = (unsigned)Rb * ldb + (unsigned)C * 2u; }
}
DI void gather_voff(const UnitD& u, int tid, unsigned (&gA)[2][2]) {
#pragma unroll
    for (int i = 0; i < 2; ++i) { int R, C; stage_rc(tid * 16 + i * 8192, R, C);
#pragma unroll
        for (int h = 0; h < 2; ++h) { const int ra = h * 128 + R; const unsigned rowA = (ra < u.nvalid) ? (unsigned)u.rows[ra] : 0u; gA[h][i] = rowA * u.lda + (unsigned)C * 2u; } }
}

template <class Epi, class Sched, bool GATHER, bool ALIGN_EPI, bool FP8 = false>
DI void gemm_phase(int wv, LAS unsigned char* lds, int nt, const Sched& S, const Epi& E) {

    int lane_ = lane_id(); asm volatile("" : "+v"(lane_)); const int wid = wv, lane = lane_, tid = wid * 64 + lane, wr = wid >> 2, wc = wid & 3, fr = lane & 15, fq = lane >> 4;
#ifndef MK_HOTPROBE
#define PG8_NODMA false
#define PG8_NOMMA false
#define PG8_NOLD false
#define PG8_NOEPI false
#define PG8_NOLOOP false
#else
#define PG8_NODMA ((hot_ & 4) != 0)
#define PG8_NOMMA ((hot_ & 8) != 0)
#define PG8_NOLD ((hot_ & 16) != 0)
#define PG8_NOEPI ((hot_ & 32) != 0)
#define PG8_NOLOOP ((hot_ & 64) != 0)
#endif
#ifdef MK_HOTPROBE
    int hot_; { typedef const __attribute__((address_space(4))) char* kptr; kptr kp = (kptr)__builtin_amdgcn_kernarg_segment_ptr(); asm volatile("" : "+s"(kp)); hot_ = *(const int __attribute__((address_space(4)))*)(kp + 280); }
    const size_t kstep = (hot_ & 1) ? (size_t)0 : (size_t)(BK * 2);
#else
    const size_t kstep = (size_t)(BK * 2);
#endif
    const unsigned ldsb = (unsigned)__builtin_amdgcn_readfirstlane((int)((unsigned)(uintptr_t)lds + (unsigned)wid * 1024u));
    const int aoff = lds_byte(wr * 64 + fr, fq * 8), boff = lds_byte(wc * 32 + fr, fq * 8);
#define PG8_SA(b, h) (((b) * 2 + (h)) * HTB)
#define PG8_SB(b, h) ((4 + (b) * 2 + (h)) * HTB)
#define PG8_STAGE(bufoff, gbase, voff) do { if (PG8_NODMA) break; _Pragma("unroll") for (int _i = 0; _i < 2; ++_i) { unsigned keep_; \
        asm volatile("s_mov_b32 %0, m0\n\ts_mov_b32 m0, %3\n\ts_nop 0\n\tglobal_load_lds_dwordx4 %1, %2\n\ts_mov_b32 m0, %0" \
                     : "=&s"(keep_) : "v"((voff)[_i]), "s"((const char*)(gbase)), "s"(ldsb + (unsigned)((bufoff) + _i * 8192)) : "memory"); } } while (0)
#define PG8_STA(bufoff, gbase, h, HS, GA) do { if constexpr (GATHER) { PG8_STAGE(bufoff, gbase, GA[h]); } else { PG8_STAGE(bufoff, (gbase) + (h) * (HS), vA); } } while (0)
#define PG8_STB(bufoff, gbase, h, HS) PG8_STAGE(bufoff, (gbase) + (h) * (HS), vB)
typedef int v4i_t __attribute__((ext_vector_type(4)));
#define PG8_LDA(dst, b, h) do { if (PG8_NOLD) break; _Pragma("unroll") for (int m = 0; m < 4; ++m) { if constexpr (FP8) { \
            const v4i_t lo_ = *(const LAS v4i_t*)(lds + PG8_SA(b, h) + aoff + m * 2048), hi_ = *(const LAS v4i_t*)(lds + PG8_SA(b, h) + aoff + m * 2048 + 1024); \
            dst##8[m] = __builtin_shufflevector(lo_, hi_, 0, 1, 2, 3, 4, 5, 6, 7); } \
        else { _Pragma("unroll") for (int k = 0; k < 2; ++k) dst[m][k] = *(const LAS bf16x8*)(lds + PG8_SA(b, h) + aoff + m * 2048 + k * 1024); } } } while (0)
#define PG8_LDB(dst, b, h) do { if (PG8_NOLD) break; _Pragma("unroll") for (int n = 0; n < 2; ++n) { if constexpr (FP8) { \
            const v4i_t lo_ = *(const LAS v4i_t*)(lds + PG8_SB(b, h) + boff + n * 2048), hi_ = *(const LAS v4i_t*)(lds + PG8_SB(b, h) + boff + n * 2048 + 1024); \
            dst##8[n] = __builtin_shufflevector(lo_, hi_, 0, 1, 2, 3, 4, 5, 6, 7); } \
        else { _Pragma("unroll") for (int k = 0; k < 2; ++k) dst[n][k] = *(const LAS bf16x8*)(lds + PG8_SB(b, h) + boff + n * 2048 + k * 1024); } } } while (0)
#ifndef PG8_FP8_PRIO
#define PG8_FP8_PRIO 1
#endif
#define PG8_MMA(ai, bj, At, Bt) do { if (PG8_NOMMA) break; if (!FP8 || PG8_FP8_PRIO) __builtin_amdgcn_s_setprio(1); _Pragma("unroll") for (int m = 0; m < 4; ++m) _Pragma("unroll") for (int n = 0; n < 2; ++n) { \
        if constexpr (FP8) { acc[ai][bj][m][n] = __builtin_amdgcn_mfma_scale_f32_16x16x128_f8f6f4(Bt##8[n], At##8[m], acc[ai][bj][m][n], 0, 0, 0, 0x7f7f7f7f, 0, 0x7f7f7f7f); } \
        else { _Pragma("unroll") for (int k = 0; k < 2; ++k) acc[ai][bj][m][n] = __builtin_amdgcn_mfma_f32_16x16x32_bf16(Bt[n][k], At[m][k], acc[ai][bj][m][n], 0, 0, 0); } } \
        if (!FP8 || PG8_FP8_PRIO) __builtin_amdgcn_s_setprio(0); } while (0)
#define PG8_WAIT_V(n) asm volatile("s_waitcnt vmcnt(" #n ")" ::: "memory")
#define PG8_WAIT_L(n) asm volatile("s_waitcnt lgkmcnt(" #n ")" ::: "memory")
#define PG8_BAR __builtin_amdgcn_s_barrier()
#define PG8_SCHED __builtin_amdgcn_sched_barrier(0)
#define PG8_ITER(A1P, A2P, B2P, HA2, HB2, GA2) do { \
        const char* a3p_ = (A2P) + kstep; const char* b3p_ = (B2P) + kstepB; \
        PG8_LDB(B0, 0, 0); PG8_LDB(B1, 0, 1); PG8_SCHED; PG8_LDA(At, 0, 0); PG8_STA(PG8_SA(1, 1), (A1P), 1, hsA, gA); \
        PG8_WAIT_V(8); PG8_WAIT_L(0); PG8_BAR; PG8_MMA(0, 0, At, B0); PG8_MMA(0, 1, At, B1); PG8_BAR; PG8_SCHED; \
        PG8_LDA(At, 0, 1); PG8_STB(PG8_SB(0, 0), (B2P), 0, HB2); PG8_STB(PG8_SB(0, 1), (B2P), 1, HB2); PG8_STA(PG8_SA(0, 0), (A2P), 0, HA2, GA2); \
        PG8_WAIT_V(8); PG8_WAIT_L(0); PG8_BAR; PG8_MMA(1, 0, At, B0); PG8_MMA(1, 1, At, B1); PG8_BAR; PG8_SCHED; \
        PG8_LDB(B0, 1, 0); PG8_LDB(B1, 1, 1); PG8_SCHED; PG8_LDA(At, 1, 0); PG8_STA(PG8_SA(0, 1), (A2P), 1, HA2, GA2); \
        PG8_WAIT_V(8); PG8_WAIT_L(0); PG8_BAR; PG8_MMA(0, 0, At, B0); PG8_MMA(0, 1, At, B1); PG8_BAR; PG8_SCHED; \
        PG8_LDA(At, 1, 1); PG8_STB(PG8_SB(1, 0), b3p_, 0, HB2); PG8_STB(PG8_SB(1, 1), b3p_, 1, HB2); PG8_STA(PG8_SA(1, 0), a3p_, 0, HA2, GA2); \
        PG8_WAIT_V(8); PG8_WAIT_L(0); PG8_BAR; PG8_MMA(1, 0, At, B0); PG8_MMA(1, 1, At, B1); PG8_BAR; PG8_SCHED; \
    } while (0)
    UnitD cur, nxt; int ui = 0;
    if (!S.next(0, cur)) return;
    f32x4 acc[2][2][4][2];
#pragma unroll
    for (int a = 0; a < 2; ++a)
#pragma unroll
        for (int b = 0; b < 2; ++b)
#pragma unroll
            for (int m = 0; m < 4; ++m)
#pragma unroll
                for (int n = 0; n < 2; ++n) acc[a][b][m][n] = (f32x4){0.f, 0.f, 0.f, 0.f};
    bf16x8 At[4][2], B0[2][2], B1[2][2]; v8i_t At8[4], B08[2], B18[2];
    unsigned vA[2], vB[2], gA[2][2], ngA[2][2];
    dense_voff(cur.lda, cur.ldb, tid, vA, vB);
#ifdef MK_HOTPROBE
    const size_t kstepB = (hot_ & 2) ? (size_t)0 : ((cur.ldb == 128u) ? (size_t)32768 : (size_t)(BK * 2));
#else
    const size_t kstepB = (cur.ldb == 128u) ? (size_t)32768 : kstep;
#endif
    if constexpr (GATHER) gather_voff(cur, tid, gA);
    const char* cA = cur.A; const char* cB = cur.B;
    size_t hsA = GATHER ? 0 : (size_t)cur.lda * HALF, hsB = (size_t)cur.ldb * HALF;
    PG8_STB(PG8_SB(0, 0), cB, 0, hsB); PG8_STB(PG8_SB(0, 1), cB, 1, hsB); PG8_STA(PG8_SA(0, 0), cA, 0, hsA, gA); PG8_STA(PG8_SA(0, 1), cA, 1, hsA, gA);
    if (wr == 1) PG8_BAR;
    PG8_WAIT_V(2); PG8_BAR;
    PG8_STB(PG8_SB(1, 0), cB + kstepB, 0, hsB); PG8_STA(PG8_SA(1, 0), cA + kstep, 0, hsA, gA); PG8_STB(PG8_SB(1, 1), cB + kstepB, 1, hsB);
    PG8_WAIT_V(6); PG8_BAR;
    for (;;) {
        const bool has_next = S.next(ui + 1, nxt);
        const char* nA = cA; const char* nB = cB; size_t nhsA = hsA, nhsB = hsB;
        if (has_next) { nA = nxt.A; nB = nxt.B; nhsA = GATHER ? 0 : (size_t)nxt.lda * HALF; nhsB = (size_t)nxt.ldb * HALF; }
        if constexpr (GATHER) {
            if (has_next) gather_voff(nxt, tid, ngA);
            else {
#pragma unroll
                for (int h = 0; h < 2; ++h)
#pragma unroll
                    for (int i = 0; i < 2; ++i) ngA[h][i] = gA[h][i];
            }
        }
#pragma unroll 1
        for (int t = 0; t < (PG8_NOLOOP ? 0 : nt); t += 2) {
            const bool last = (t == nt - 2);
            const char* a2 = last ? nA : cA + (size_t)(t + 2) * kstep; const char* b2 = last ? nB : cB + (size_t)(t + 2) * kstepB;
            const size_t hA2 = last ? nhsA : hsA, hB2 = last ? nhsB : hsB;
            unsigned g2[2][2];
            if constexpr (GATHER) {
#pragma unroll
                for (int h = 0; h < 2; ++h)
#pragma unroll
                    for (int i = 0; i < 2; ++i) g2[h][i] = last ? ngA[h][i] : gA[h][i];
            }
            PG8_ITER(cA + (size_t)(t + 1) * kstep, a2, b2, hA2, hB2, g2);
        }
        if constexpr (ALIGN_EPI) { if (wr == 0) PG8_BAR; }
        if constexpr (!Epi::AFTER_DRAIN) { if (!PG8_NOEPI) E(acc, cur, wr, wc, fr, fq); }
        if (!has_next) break;
#pragma unroll
        for (int a = 0; a < 2; ++a)
#pragma unroll
            for (int b = 0; b < 2; ++b)
#pragma unroll
                for (int m = 0; m < 4; ++m)
#pragma unroll
                    for (int n = 0; n < 2; ++n) acc[a][b][m][n] = (f32x4){0.f, 0.f, 0.f, 0.f};
        cur = nxt; cA = nA; cB = nB; hsA = nhsA; hsB = nhsB; ++ui;
        if constexpr (GATHER) {
#pragma unroll
            for (int h = 0; h < 2; ++h)
#pragma unroll
                for (int i = 0; i < 2; ++i) gA[h][i] = ngA[h][i];
        }
        if constexpr (ALIGN_EPI) { if (wr == 1) PG8_BAR; }
    }
    PG8_WAIT_V(0);
    if constexpr (!ALIGN_EPI) { if (wr == 0) PG8_BAR; }
    PG8_BAR;
    if constexpr (Epi::AFTER_DRAIN) { E.fused(acc, cur, wr, wc, fr, fq, lds, wid, lane); }
#undef PG8_SA
#undef PG8_SB
#undef PG8_STAGE
#undef PG8_STA
#undef PG8_STB
#undef PG8_LDA
#undef PG8_LDB
#undef PG8_MMA
#undef PG8_WAIT_V
#undef PG8_WAIT_L
#undef PG8_BAR
#undef PG8_SCHED
#undef PG8_ITER
}

}
namespace attn_body {
using bf16=__hip_bfloat16;
using bf16x8=__attribute__((ext_vector_type(8)))short;
using s16x4=__attribute__((ext_vector_type(4)))short;
using f32x16=__attribute__((ext_vector_type(16)))float;
using u32x4=__attribute__((ext_vector_type(4)))unsigned;
constexpr int BATCH=4,SEQ=2048,D=64,DM=5632,OPITCH=1024;
constexpr int NW=8,QBLK=32,QB=QBLK*NW,KVBLK=64,NQB=SEQ/QB;
constexpr int ATTN_UNIT_ROWS=QB;
__device__ __forceinline__ int crow(int r,int hi){return (r&3)+8*(r>>2)+4*hi;}
#define SBAR() __builtin_amdgcn_sched_barrier(0)
__device__ __forceinline__ void cmask(f32x16&p0,f32x16&p1,int jb,int qrel,int hi){
  const float NEG=-INFINITY; int kb=64*jb+4*hi;
  #pragma unroll
  for(int r=0;r<16;++r){int kv=kb+(r&3)+8*(r>>2); if(kv>qrel)p0[r]=NEG; if(kv+32>qrel)p1[r]=NEG;}
}

constexpr int NSLOT=3, SLOTB=8192;
constexpr int LDS_K=0, LDS_V=NSLOT*SLOTB, LDS_WS=2*NSLOT*SLOTB, LDS_OST=LDS_WS+NW*64*4, LDS_BYTES=LDS_OST+NW*4096;
constexpr float C2=0.125f*1.4426950408889634f;
__device__ __forceinline__ void glds16(const void*gsrc,unsigned lds_dst){unsigned keep;
  asm volatile("s_mov_b32 %0, m0\n\ts_mov_b32 m0, %2\n\ts_nop 0\n\tglobal_load_lds_dwordx4 %1, off\n\ts_mov_b32 m0, %0":"=&s"(keep):"v"(gsrc),"s"(lds_dst):"memory");}
__device__ __forceinline__ float max3f(float a,float b,float c){float r;asm("v_max3_f32 %0, %1, %2, %3":"=v"(r):"v"(a),"v"(b),"v"(c));return r;}
__device__ __forceinline__ float max2f(float a,float b){float r;asm("v_max_f32_e32 %0, %1, %2":"=v"(r):"v"(a),"v"(b));return r;}
__device__ __forceinline__ float fadd_s(float a,float b){float r;asm("v_add_f32_e32 %0, %1, %2":"=v"(r):"v"(a),"v"(b));return r;}
__device__ __forceinline__ float fsub_s(float a,float b){float r;asm("v_sub_f32_e32 %0, %1, %2":"=v"(r):"v"(a),"v"(b));return r;}
typedef float f32x2_t __attribute__((ext_vector_type(2))); typedef __bf16 bf16x2_t __attribute__((ext_vector_type(2)));
__device__ __forceinline__ unsigned cvtpk_s(float lo,float hi){f32x2_t v={lo,hi};bf16x2_t b=__builtin_convertvector(v,bf16x2_t);return __builtin_bit_cast(unsigned,b);}
#define WAIT_BAR(N) asm volatile("s_waitcnt vmcnt(" #N ") lgkmcnt(0)\n\ts_barrier":::"memory")

__device__ __forceinline__ void qkt(f32x16&p0,f32x16&p1,const char*Kslot,const bf16x8*qr,const f32x16&negm,int r32,int hi){
  const char*kb=Kslot+hi*1024+r32*16;
  #pragma unroll
  for(int d0=0;d0<4;++d0){
    const bf16x8 b0=*reinterpret_cast<const bf16x8*>(kb+d0*2048);
    const bf16x8 b1=*reinterpret_cast<const bf16x8*>(kb+d0*2048+512);
    if(d0==0){p0=__builtin_amdgcn_mfma_f32_32x32x16_bf16(b0,qr[0],negm,0,0,0);p1=__builtin_amdgcn_mfma_f32_32x32x16_bf16(b1,qr[0],negm,0,0,0);}
    else{p0=__builtin_amdgcn_mfma_f32_32x32x16_bf16(b0,qr[d0],p0,0,0,0);p1=__builtin_amdgcn_mfma_f32_32x32x16_bf16(b1,qr[d0],p1,0,0,0);}}
}
typedef __attribute__((address_space(3))) const char* lds_cptr;
typedef short v4i16_t __attribute__((ext_vector_type(4)));
__device__ __forceinline__ void kload8(bf16x8*kf,lds_cptr kp){
  kf[0]=*(const __attribute__((address_space(3))) bf16x8*)(kp);      kf[1]=*(const __attribute__((address_space(3))) bf16x8*)(kp+512);
  kf[2]=*(const __attribute__((address_space(3))) bf16x8*)(kp+2048); kf[3]=*(const __attribute__((address_space(3))) bf16x8*)(kp+2560);
  kf[4]=*(const __attribute__((address_space(3))) bf16x8*)(kp+4096); kf[5]=*(const __attribute__((address_space(3))) bf16x8*)(kp+4608);
  kf[6]=*(const __attribute__((address_space(3))) bf16x8*)(kp+6144); kf[7]=*(const __attribute__((address_space(3))) bf16x8*)(kp+6656);
}
__device__ __forceinline__ void kload2(bf16x8*kf,lds_cptr kp,int j){ kf[2*j]=*(const __attribute__((address_space(3))) bf16x8*)(kp+j*2048); kf[2*j+1]=*(const __attribute__((address_space(3))) bf16x8*)(kp+j*2048+512); }
__device__ __forceinline__ s16x4 vtr(lds_cptr p){ return __builtin_bit_cast(s16x4,__builtin_amdgcn_ds_read_tr16_b64_v4i16((__attribute__((address_space(3))) v4i16_t*)p)); }
__device__ __forceinline__ float rowmax(const f32x16&p0,const f32x16&p1){
  float a=max3f(p0[0],p0[1],p1[0]),b=max3f(p0[2],p0[3],p1[1]);a=max3f(a,p1[2],p1[3]);
  #pragma unroll
  for(int r=4;r<16;r+=4){a=max3f(a,p0[r],p0[r+1]);b=max3f(b,p0[r+2],p0[r+3]);a=max3f(a,p1[r],p1[r+1]);b=max3f(b,p1[r+2],p1[r+3]);}
  const float m=max2f(a,b);
  auto rr=__builtin_amdgcn_permlane32_swap(__float_as_uint(m),__float_as_uint(m),false,false);
  return max2f(__uint_as_float(rr[0]),__uint_as_float(rr[1]));
}
__device__ __forceinline__ void pv(f32x16*o,int vb,bf16x8 pa0,bf16x8 pa1,bf16x8 pa2,bf16x8 pa3){
  #pragma unroll
  for(int d0=0;d0<2;++d0){s16x4 lo[4],hi[4];
    #pragma unroll
    for(int ks=0;ks<4;++ks){
      asm volatile("ds_read_b64_tr_b16 %0,%1 offset:%c2":"=&v"(lo[ks]):"v"(vb),"i"(d0*4096+ks*1024):"memory");
      asm volatile("ds_read_b64_tr_b16 %0,%1 offset:%c2":"=&v"(hi[ks]):"v"(vb),"i"(d0*4096+ks*1024+512):"memory");}
    asm volatile("s_waitcnt lgkmcnt(0)":::"memory");SBAR();
    #define PK(k) (bf16x8){lo[k][0],lo[k][1],lo[k][2],lo[k][3],hi[k][0],hi[k][1],hi[k][2],hi[k][3]}
    o[d0]=__builtin_amdgcn_mfma_f32_32x32x16_bf16(pa0,PK(0),o[d0],0,0,0);
    o[d0]=__builtin_amdgcn_mfma_f32_32x32x16_bf16(pa1,PK(1),o[d0],0,0,0);
    o[d0]=__builtin_amdgcn_mfma_f32_32x32x16_bf16(pa2,PK(2),o[d0],0,0,0);
    o[d0]=__builtin_amdgcn_mfma_f32_32x32x16_bf16(pa3,PK(3),o[d0],0,0,0);
    #undef PK
  }
}

#ifndef ATTN_STORE16
#define ATTN_STORE16(p,v) (*(u32x4*)(p)=(v))
#endif
template<int THRL> __device__ __forceinline__ void attn_unit(int b,int qcol,int vcol,int ocol,int qb,const bf16*Q,const bf16*__restrict__ K,const bf16*__restrict__ V,bf16*O,char*shm,unsigned*qctr,unsigned&ticket,int wv){
  int lane_=lane_id();asm volatile("":"+v"(lane_)); const int wid=wv,lane=lane_,tid=wid*64+lane,r32=lane&31,hi=lane>>5;
  const long rowbase=(long)b*SEQ; const int q0=qb*QB;
  const bf16*Qw=Q+(rowbase+q0+wid*QBLK)*DM+qcol;
  const bf16*Kh=K+rowbase*DM+qcol,*Vh=V+rowbase*DM+vcol;
  const unsigned lds0=(unsigned)(uintptr_t)shm;
  float*wsf=(float*)(shm+LDS_WS)+wid*64;
  const bf16*ksrc=Kh+(long)lane*DM+wid*8;
  const bf16*vsrc=Vh+(long)(16*(wid&3)+(lane>>2))*DM+(wid>>2)*32+(lane&3)*8;
  const unsigned kdst=lds0+LDS_K+wid*1024, vdst=lds0+LDS_V+wid*1024;
  #define DMA_K(t,slot) glds16(ksrc+(long)(t)*KVBLK*DM,(unsigned)__builtin_amdgcn_readfirstlane(kdst+(slot)))
  #define DMA_V(t,slot) glds16(vsrc+(long)(t)*KVBLK*DM,(unsigned)__builtin_amdgcn_readfirstlane(vdst+(slot)))
  const int vb0=(int)(lds0+LDS_V)+((lane>>4)&1)*32+(lane&3)*8+(4*hi+((lane&15)>>2))*64;
  const char*Kbase=shm+LDS_K; bf16x8 kf[8];
  const lds_cptr shm3=(lds_cptr)shm; const lds_cptr kp0=shm3+LDS_K+hi*1024+r32*16; const lds_cptr vp0=shm3+LDS_V+((lane>>4)&1)*32+(lane&3)*8+(4*hi+((lane&15)>>2))*64;
  const int NT=(q0+QB)/KVBLK;
  DMA_K(0,0);DMA_V(0,0);DMA_K(1,SLOTB);
  bf16x8 qr[4];
  #pragma unroll
  for(int d0=0;d0<4;++d0)qr[d0]=*reinterpret_cast<const bf16x8*>(&Qw[(long)r32*DM+d0*16+hi*8]);
  float mhat=0.f,l_reg=0.f;f32x16 o[2];o[0]=f32x16{};o[1]=f32x16{};f32x16 negm=f32x16{};asm volatile("":"+v"(negm));
  const int qrel=wid*QBLK+r32;
  #define CMASK(P0,P1,t) do{int jb_=(t)-(NT-4); if(jb_>=0)cmask(P0,P1,jb_,qrel,hi);}while(0)
  bool resc=false;
  #define START(P0,P1) do{ const float rm=rowmax(P0,P1); resc=false; \
    { const float dl=rm; mhat=fadd_s(mhat,dl); \
      _Pragma("unroll") for(int r=0;r<16;++r){P0[r]=fsub_s(P0[r],dl);P1[r]=fsub_s(P1[r],dl);} \
      _Pragma("unroll") for(int r=0;r<16;++r)negm[r]=-mhat; asm volatile("":"+v"(negm)); } \
    _Pragma("unroll") for(int r=0;r<16;++r)P0[r]=__builtin_amdgcn_exp2f(P0[r]); }while(0)
  #define RESC() do{ if(resc){ asm volatile("s_waitcnt lgkmcnt(0)":::"memory"); \
      _Pragma("unroll") for(int d_=0;d_<2;++d_) _Pragma("unroll") for(int r=0;r<16;++r)o[d_][r]*=wsf[crow(r,hi)]; } }while(0)
  f32x16 pA0,pA1,pB0,pB1;
  int sl_prev=0,sl_cur=0,sl_next=SLOTB;
  #define ROT() do{sl_prev=sl_cur;sl_cur=sl_next;sl_next=(sl_next==(NSLOT-1)*SLOTB)?0:sl_next+SLOTB;}while(0)
  DMA_K(2,2*SLOTB);
  WAIT_BAR(3);
  qkt(pA0,pA1,Kbase,qr,negm,r32,hi);asm volatile("s_nop 15\n\ts_nop 7":"+v"(pA0),"+v"(pA1));CMASK(pA0,pA1,0);
  START(pA0,pA1);
  _Pragma("unroll") for(int r=0;r<16;++r)pA1[r]=__builtin_amdgcn_exp2f(pA1[r]);
  WAIT_BAR(0);
  DMA_K(3,0);DMA_V(1,SLOTB);
  ROT();
  kload8(kf,kp0+sl_cur);
  WAIT_BAR(2);
  s16x4 vlo[8],vhi[8]; u32x4 pw0,pw1,pw2,pw3;
  #define PKW(P,B) cvtpk_s(P[B],P[B+1])
  #define PAF(k) __builtin_bit_cast(bf16x8,pw##k)
  #define VFR(i) (bf16x8){vlo[i][0],vlo[i][1],vlo[i][2],vlo[i][3],vhi[i][0],vhi[i][1],vhi[i][2],vhi[i][3]}
  #define PIN(x) asm volatile("":"+v"(x))
  #define MX3(a,b,c) __builtin_fmaxf(__builtin_fmaxf((a),(b)),(c))
  #define GAPA(MF,A0,A1,A2,A3,W0,W1,PW) do{ MF; sacc+=A0; sacc+=A1; sacc+=A2; sacc+=A3; PIN(sacc); W0; W1; PIN(PW); SBAR(); }while(0)
  #define EX(v) __builtin_amdgcn_exp2f(v)
  #define GAPB(MF,X,B) do{ MF; X[B]=EX(X[B]); X[B+1]=EX(X[B+1]); X[B+2]=EX(X[B+2]); X[B+3]=EX(X[B+3]); PIN(X); SBAR(); }while(0)
  #define VRD(i) do{ vlo[i]=vtr(vp_+(((i)>>2)*4096+((i)&3)*1024)); vhi[i]=vtr(vp_+(((i)>>2)*4096+((i)&3)*1024+512)); }while(0)
  #define KRD(G,j) do{ if(G){ kload2(kf,kp0+sl_next,j); SBAR(); } }while(0)
  #define STEP(C0,C1,P0,P1,t,GK,GV,GL) do{ SBAR(); \
    const lds_cptr vp_=vp0+sl_prev; \
    VRD(0); SBAR(); float sacc=(P0[0]+P0[1]); \
    GAPA(C0=__builtin_amdgcn_mfma_f32_32x32x16_bf16(kf[0],qr[0],negm,0,0,0), P0[2],P0[3],P0[4],P0[5],     pw0[0]=PKW(P0,0), pw0[1]=PKW(P0,2), pw0); \
    VRD(4); SBAR(); GAPA(C1=__builtin_amdgcn_mfma_f32_32x32x16_bf16(kf[1],qr[0],negm,0,0,0), P0[6],P0[7],P0[8],P0[9],     pw0[2]=PKW(P0,4), pw0[3]=PKW(P0,6), pw0); \
    VRD(1); SBAR(); GAPA(C0=__builtin_amdgcn_mfma_f32_32x32x16_bf16(kf[2],qr[1],C0,0,0,0),   P0[10],P0[11],P0[12],P0[13], pw1[0]=PKW(P0,8), pw1[1]=PKW(P0,10), pw1); \
    VRD(5); SBAR(); GAPA(C1=__builtin_amdgcn_mfma_f32_32x32x16_bf16(kf[3],qr[1],C1,0,0,0),   P0[14],P0[15],P1[0],P1[1],   pw1[2]=PKW(P0,12),pw1[3]=PKW(P0,14), pw1); \
    VRD(2); SBAR(); GAPA(C0=__builtin_amdgcn_mfma_f32_32x32x16_bf16(kf[4],qr[2],C0,0,0,0),   P1[2],P1[3],P1[4],P1[5],     pw2[0]=PKW(P1,0), pw2[1]=PKW(P1,2), pw2); \
    VRD(6); SBAR(); GAPA(C1=__builtin_amdgcn_mfma_f32_32x32x16_bf16(kf[5],qr[2],C1,0,0,0),   P1[6],P1[7],P1[8],P1[9],     pw2[2]=PKW(P1,4), pw2[3]=PKW(P1,6), pw2); \
    VRD(3); SBAR(); GAPA(C0=__builtin_amdgcn_mfma_f32_32x32x16_bf16(kf[6],qr[3],C0,0,0,0),   P1[10],P1[11],P1[12],P1[13], pw3[0]=PKW(P1,8), pw3[1]=PKW(P1,10), pw3); \
    VRD(7); SBAR(); GAPA(C1=__builtin_amdgcn_mfma_f32_32x32x16_bf16(kf[7],qr[3],C1,0,0,0),   P1[14],P1[15],0.f,0.f,       pw3[2]=PKW(P1,12),pw3[3]=PKW(P1,14), pw3); \
    l_reg+=sacc; \
    if(GK){DMA_K((t)+3,sl_cur);} if(GV){DMA_V((t)+1,sl_next);} \
    CMASK(C0,C1,t); \
    { float a=MX3(C0[0],C0[1],C1[0]),b=MX3(C0[2],C0[3],C1[1]); a=MX3(a,C1[2],C1[3]); \
      _Pragma("unroll") for(int r=4;r<16;r+=4){a=MX3(a,C0[r],C0[r+1]);b=MX3(b,C0[r+2],C0[r+3]);a=MX3(a,C1[r],C1[r+1]);b=MX3(b,C1[r+2],C1[r+3]);} \
      float rm=__builtin_fmaxf(a,b); { auto rr=__builtin_amdgcn_permlane32_swap(__float_as_uint(rm),__float_as_uint(rm),false,false); rm=__builtin_fmaxf(__uint_as_float(rr[0]),__uint_as_float(rr[1])); } \
      resc=false; \
      if(__builtin_expect(__any(rm>(float)THRL),0)){ const float dl=__builtin_fmaxf(rm,0.f); mhat+=dl; \
        _Pragma("unroll") for(int r=0;r<16;++r){C0[r]-=dl;C1[r]-=dl;} \
        _Pragma("unroll") for(int r=0;r<16;++r)negm[r]=-mhat; asm volatile("":"+v"(negm)); \
        const float f=__builtin_amdgcn_exp2f(-dl); l_reg*=f; if(hi==0)wsf[r32]=f; resc=true; } } \
    SBAR(); \
    GAPB(o[0]=__builtin_amdgcn_mfma_f32_32x32x16_bf16(PAF(0),VFR(0),o[0],0,0,0), C0,0); \
    GAPB(o[1]=__builtin_amdgcn_mfma_f32_32x32x16_bf16(PAF(0),VFR(4),o[1],0,0,0), C0,4); \
    KRD(GL,0); GAPB(o[0]=__builtin_amdgcn_mfma_f32_32x32x16_bf16(PAF(1),VFR(1),o[0],0,0,0), C0,8); \
    KRD(GL,1); GAPB(o[1]=__builtin_amdgcn_mfma_f32_32x32x16_bf16(PAF(1),VFR(5),o[1],0,0,0), C0,12); \
    KRD(GL,2); GAPB(o[0]=__builtin_amdgcn_mfma_f32_32x32x16_bf16(PAF(2),VFR(2),o[0],0,0,0), C1,0); \
    KRD(GL,3); GAPB(o[1]=__builtin_amdgcn_mfma_f32_32x32x16_bf16(PAF(2),VFR(6),o[1],0,0,0), C1,4); \
    GAPB(o[0]=__builtin_amdgcn_mfma_f32_32x32x16_bf16(PAF(3),VFR(3),o[0],0,0,0), C1,8); \
    GAPB(o[1]=__builtin_amdgcn_mfma_f32_32x32x16_bf16(PAF(3),VFR(7),o[1],0,0,0), C1,12); \
    }while(0)
  int t=1;
  #undef CMASK
  #define CMASK(P0,P1,t) do{}while(0)
  for(;t+5<NT;t+=2){
    STEP(pB0,pB1,pA0,pA1,t,true,true,true);     WAIT_BAR(2); RESC(); ROT();
    STEP(pA0,pA1,pB0,pB1,t+1,true,true,true);   WAIT_BAR(2); RESC(); ROT();
  }
  #undef CMASK
  #define CMASK(P0,P1,t) do{int jb_=(t)-(NT-4); if(jb_>=0)cmask(P0,P1,jb_,qrel,hi);}while(0)
  #define ENDW(tt) do{ if((tt)+3<NT){WAIT_BAR(2);} else if((tt)+2<NT){WAIT_BAR(1);} else {WAIT_BAR(0);} }while(0)
  for(;t+1<NT;t+=2){
    STEP(pB0,pB1,pA0,pA1,t,(t+3<NT),(t+1<NT),(t+1<NT));       ENDW(t);   RESC(); ROT();
    STEP(pA0,pA1,pB0,pB1,t+1,(t+4<NT),(t+2<NT),(t+2<NT));     ENDW(t+1); RESC(); ROT();
  }
  STEP(pB0,pB1,pA0,pA1,NT-1,false,false,false); RESC();
  { float sacc=pB0[0]+pB0[1]; _Pragma("unroll") for(int r=2;r<16;++r)sacc+=pB0[r]; _Pragma("unroll") for(int r=0;r<16;++r)sacc+=pB1[r]; l_reg+=sacc;
    pw0=(u32x4){PKW(pB0,0),PKW(pB0,2),PKW(pB0,4),PKW(pB0,6)};pw1=(u32x4){PKW(pB0,8),PKW(pB0,10),PKW(pB0,12),PKW(pB0,14)};pw2=(u32x4){PKW(pB1,0),PKW(pB1,2),PKW(pB1,4),PKW(pB1,6)};pw3=(u32x4){PKW(pB1,8),PKW(pB1,10),PKW(pB1,12),PKW(pB1,14)};
    SBAR(); pv(o,vb0+sl_cur,PAF(0),PAF(1),PAF(2),PAF(3)); }
  #undef PKW
  #undef PAF
  #undef VFR
  #undef PIN
  #undef MX3
  #undef GAPA
  #undef GAPB
  #undef EX
  #undef VRD
  #undef KRD
  #undef STEP
  #undef ENDW
  if(wid==0&&lane_id()==0){unsigned z_=0u;asm volatile("":"+v"(z_));ticket=__hip_atomic_fetch_add(qctr+z_,1u,__ATOMIC_RELAXED,__HIP_MEMORY_SCOPE_AGENT);}
  {auto rr=__builtin_amdgcn_permlane32_swap(__float_as_uint(l_reg),__float_as_uint(l_reg),false,false);l_reg=__uint_as_float(rr[0])+__uint_as_float(rr[1]);}
  if(hi==0)wsf[32+r32]=l_reg;asm volatile("s_waitcnt lgkmcnt(0)":::"memory");
  float rli[16];
  #pragma unroll
  for(int r=0;r<16;++r)rli[r]=__builtin_amdgcn_rcpf(wsf[32+crow(r,hi)]);
  bf16*Ow=O+(rowbase+q0+wid*QBLK)*OPITCH+ocol;
  { bf16*stg=(bf16*)(shm+LDS_OST)+wid*2048;
    #pragma unroll
    for(int r=0;r<16;++r){const int orow=crow(r,hi);
      #pragma unroll
      for(int d0=0;d0<2;++d0)stg[orow*64+d0*32+r32]=__float2bfloat16(o[d0][r]*rli[r]);}
    asm volatile("s_waitcnt lgkmcnt(0)":::"memory");
    #pragma unroll
    for(int i=0;i<4;++i){const int row=i*8+(lane>>3),ch=lane&7; const u32x4 v=*(const u32x4*)(stg+row*64+ch*8); ATTN_STORE16(Ow+(long)row*OPITCH+ch*8,v);} }
  asm volatile("s_waitcnt lgkmcnt(0)\n\ts_barrier":::"memory");
  #undef DMA_K
  #undef DMA_V
  #undef CMASK
  #undef START
  #undef RESC
  #undef ROT
}
constexpr int ATTN_LDS_BYTES=LDS_BYTES;
#undef SBAR
#undef WAIT_BAR
}
constexpr size_t MiB = 1u << 20;
constexpr size_t WS_CTL = 0, CTL_ZERO_BYTES = 1 * MiB;
constexpr size_t WS_WIN = 2 * MiB, WS_WOUT = 26 * MiB, WS_WQ = 34 * MiB, WS_WKV = 42 * MiB, WS_WO = 58 * MiB, WS_W1 = 66 * MiB, WS_W2 = 578 * MiB;
constexpr size_t WS_HN = 834 * MiB, WS_MN = 866 * MiB, WS_PROJ = 870 * MiB, WS_DT = 958 * MiB, WS_KVRAW = 959 * MiB, WS_KN = 967 * MiB;
constexpr size_t WS_YCAT = 971 * MiB, WS_O0 = 1003 * MiB, WS_O1 = 1019 * MiB, WS_H1 = 1035 * MiB, WS_H1B = 1099 * MiB, WS_PART1 = 1131 * MiB, WS_PARTQ = 1132 * MiB;
constexpr size_t WS_QRAW = 1133 * MiB, WS_P = 1165 * MiB, WS_VWT = 1181 * MiB, WS_H2 = 1197 * MiB, WS_HN3 = 1261 * MiB;
constexpr size_t WS_TOKOF = 1293 * MiB, WS_GATEOF = 1294 * MiB, WS_TOKE = 1295 * MiB, WS_TOKR = 1296 * MiB, WS_YG = 1297 * MiB;
constexpr size_t WS_H1F8 = 3368 * MiB  , WS_QF8 = 3384 * MiB  , WS_KN8 = 3400 * MiB  , WS_VF8 = 3402 * MiB  ;
constexpr size_t WS_P8 = 3404 * MiB  , WS_VWT8 = 3412 * MiB  ;
constexpr size_t WS_XG = 1320 * MiB  , WS_ACT = 1832 * MiB  , WS_Y = 2344 * MiB  , WS_END = 3420 * MiB;
constexpr int CW_BAR = 4096;
constexpr int CW_QCONV2 = 12416;
constexpr int CW_QCONV = 12352;
constexpr int CW_QATT = 12288;
constexpr int CW_CNT = 8192;
static_assert((CW_CNT + 64 * 32) * 4 <= (int)CTL_ZERO_BYTES, "CTL words inside the memset region");

constexpr int RING_OFF = 0, RING_BYTES = 131072;
constexpr int LDS_BYTES = 163840;
constexpr int MISC_OFF = 163840 - 1024;
constexpr int NWAVES = 8;

DI int wave_now(volatile LAS unsigned* misc) { const unsigned hs = (unsigned)__builtin_amdgcn_s_getreg((5 << 11) | 4) & 63u; return __builtin_amdgcn_readfirstlane((int)misc[192 + hs]); }
#define XB_TMO      128
#define XB_XCNT(j)  (256  + 64 * (j))
#define XB_XSUB(j)  (1280 + 64 * (j))
#define XB_XGEN(j)  (2304 + 64 * (j))
#define XB_TOP      3328
#define XB_TOPGEN   3392
#define XCD_BAR_WORDS 3456
#define XB_SPIN_CAP (1u << 20)

__device__ __forceinline__ unsigned xb_ld(unsigned* p)              { return __hip_atomic_load(p, __ATOMIC_RELAXED, __HIP_MEMORY_SCOPE_AGENT); }
__device__ __forceinline__ unsigned xb_add(unsigned* p, unsigned v) { return __hip_atomic_fetch_add(p, v, __ATOMIC_RELAXED, __HIP_MEMORY_SCOPE_AGENT); }
__device__ __forceinline__ unsigned xb_xcc_id() { return (unsigned)__builtin_amdgcn_s_getreg((3 << 11) | 20) & 0xFu; }
#define XB_SPIN(cond, bar) do { unsigned _sp = 0; while (cond) { __builtin_amdgcn_s_sleep(1); \
    if ((++_sp & 255u) == 0u) { if (xb_ld(&(bar)[XB_TMO])) break; if (_sp > XB_SPIN_CAP) { atomicAdd(&(bar)[XB_TMO], 1u); break; } } } } while (0)

struct XcdBarrier {
    unsigned* bar; unsigned x;
    volatile LAS unsigned* st;
};
__device__ __forceinline__ XcdBarrier xcd_barrier_post(unsigned* bar, volatile LAS unsigned* st) {
    XcdBarrier b; b.bar = bar; b.x = xb_xcc_id(); b.st = st;
    if (wave_now(st - 8) == 0 && lane_id() == 0) (void)xb_add(&bar[XB_XCNT(b.x)], 1u);
    return b;
}
__device__ __forceinline__ void xcd_barrier_complete(unsigned* bar, unsigned x, unsigned& nloc, unsigned& nx) {
    const unsigned G = gridDim.x * gridDim.y * gridDim.z;
    unsigned sum, cnt, mine, sp = 0u;
    for (;;) {
        sum = 0u; cnt = 0u; mine = 0u;
#pragma unroll
        for (unsigned j = 0; j < 16; ++j) { const unsigned c = xb_ld(&bar[XB_XCNT(j)]); sum += c; cnt += (c > 0u) ? 1u : 0u; mine = (j == x) ? c : mine; }
        if (sum == G) break;
        __builtin_amdgcn_s_sleep(1);
        if ((++sp & 255u) == 0u) { if (xb_ld(&bar[XB_TMO])) break; if (sp > XB_SPIN_CAP) { atomicAdd(&bar[XB_TMO], 1u); break; } }
    }
    nloc = mine > 0u ? mine : 1u; nx = cnt > 0u ? cnt : 1u;
}
__device__ __forceinline__ void xcd_barrier(const XcdBarrier& b) {
    asm volatile("s_waitcnt vmcnt(0)" ::: "memory");
    __syncthreads();
    if (wave_now(b.st - 8) == 0 && lane_id() == 0) {
        unsigned* bar = b.bar;
        __builtin_amdgcn_s_waitcnt(0);
        unsigned nloc = b.st[0], nx = b.st[1];
        if (nloc == 0u) { xcd_barrier_complete(bar, b.x, nloc, nx); b.st[0] = nloc; b.st[1] = nx; }
        const unsigned old = xb_add(&bar[XB_XSUB(b.x)], 1u);
        const unsigned gen = old / nloc;
        if (old + 1u == (gen + 1u) * nloc) {
            __builtin_amdgcn_fence(__ATOMIC_RELEASE, "agent");
            asm volatile("s_waitcnt vmcnt(0)" ::: "memory");
            const unsigned og = xb_add(&bar[XB_TOP], 1u);
            const unsigned tg = og / nx;
            if (og + 1u == (tg + 1u) * nx) xb_add(&bar[XB_TOPGEN], 1u);
            else XB_SPIN(xb_ld(&bar[XB_TOPGEN]) == tg, bar);
            __builtin_amdgcn_fence(__ATOMIC_ACQUIRE, "agent");
            xb_add(&bar[XB_XGEN(b.x)], 1u);
            asm volatile("s_waitcnt vmcnt(0)" ::: "memory");
        } else {
            XB_SPIN(xb_ld(&bar[XB_XGEN(b.x)]) == gen, bar);
            __builtin_amdgcn_fence(__ATOMIC_ACQUIRE, "agent");
            asm volatile("s_waitcnt vmcnt(0)" ::: "memory");
        }
    }
    __syncthreads();
}

struct Args { const float* in[32]; float* out; unsigned char* ws; int ph_lo, ph_hi, probe, pad_; };
enum In { I_X = 0, I_MEM, I_GMIX, I_WIN, I_CONVW, I_CONVB, I_DTB, I_ALOG, I_DSKIP, I_SSDG, I_DAQG, I_DAKG, I_LQ1, I_LK1, I_LQ2, I_LK2, I_SUBG, I_WOUT, I_GXA, I_GMEM,
          I_WQ, I_WKV, I_XQG, I_XKG, I_WO, I_GFFN, I_RW, I_RB, I_W1, I_B1, I_W2, I_B2 };

struct ArgP {
    typedef const __attribute__((address_space(4))) char* kptr;
    DI const float* in(int i) const { kptr kp = (kptr)__builtin_amdgcn_kernarg_segment_ptr(); asm volatile("" : "+s"(kp)); return *(const float* const __attribute__((address_space(4)))*)(kp + 8 * i); }
    DI float* out() const { kptr kp = (kptr)__builtin_amdgcn_kernarg_segment_ptr(); asm volatile("" : "+s"(kp)); return *(float* const __attribute__((address_space(4)))*)(kp + 8 * 32); }
};
struct Frame {
    LAS unsigned char* lds;
    volatile LAS unsigned* MISC;
    unsigned* ctl;
    unsigned char* ws;
    int tid, lane, wave, vcu, G;
};

template <class DestRow>
DI void tr_item(const float* W, size_t ldw, int k0, int ncol0, int nvalid, const float* kscale, bf16_t* WT, int K, DestRow dr, LAS float* scr, int lane) {
    const int c = lane & 31;
#pragma unroll 8
    for (int i = 0; i < 32; ++i) { const int kk = 2 * i + (lane >> 5);
        float v = (c < nvalid) ? W[(size_t)(k0 + kk) * ldw + ncol0 + c] : 0.f;
        if (kscale) v *= kscale[k0 + kk];
        scr[kk * 33 + c] = v; }
    asm volatile("s_waitcnt lgkmcnt(0)" ::: "memory");
    const int c8 = lane & 7;
#pragma unroll
    for (int j = 0; j < 4; ++j) { const int n = (lane >> 3) + 8 * j; const LAS float* s = scr + (8 * c8) * 33 + n;
        u32x4 o; o.x = pk2(s[0 * 33], s[1 * 33]); o.y = pk2(s[2 * 33], s[3 * 33]); o.z = pk2(s[4 * 33], s[5 * 33]); o.w = pk2(s[6 * 33], s[7 * 33]);
        if (n < nvalid) *(u32x4*)(WT + (size_t)dr(ncol0 + n) * K + k0 + 8 * c8) = o; }
    asm volatile("s_waitcnt lgkmcnt(0)" ::: "memory");
}
template <class DestRow>
DI void tr_item_fp8(const float* W, size_t ldw, int k0, int ncol0, const float* kscale, unsigned char* WT, int K, DestRow dr, LAS float* scr, int lane) {
    const int c = lane & 31;
#pragma unroll 8
    for (int i = 0; i < 32; ++i) { const int kk = 2 * i + (lane >> 5); float v = W[(size_t)(k0 + kk) * ldw + ncol0 + c]; if (kscale) v *= kscale[k0 + kk]; scr[kk * 33 + c] = v; }
    asm volatile("s_waitcnt lgkmcnt(0)" ::: "memory");
    const int n = lane >> 1, hf = lane & 1; const LAS float* s = scr + (32 * hf) * 33 + n;
    unsigned w[8];
#pragma unroll
    for (int j = 0; j < 8; ++j) { unsigned x = 0u;
        x = __builtin_amdgcn_cvt_pk_fp8_f32(s[(4 * j) * 33] * 64.f, s[(4 * j + 1) * 33] * 64.f, x, false);
        x = __builtin_amdgcn_cvt_pk_fp8_f32(s[(4 * j + 2) * 33] * 64.f, s[(4 * j + 3) * 33] * 64.f, x, true); w[j] = x; }
    unsigned char* op = WT + (size_t)dr(ncol0 + n) * K + k0 + 32 * hf;
    *(u32x4*)op = (u32x4){w[0], w[1], w[2], w[3]}; *(u32x4*)(op + 16) = (u32x4){w[4], w[5], w[6], w[7]};
    asm volatile("s_waitcnt lgkmcnt(0)" ::: "memory");
}
DI int tileperm(int col) { const int o = col & 255; return (col & ~255) + 128 * ((o & 63) >> 5) + 32 * (o >> 6) + (o & 31); }
struct DrIdent { DI int operator()(int n) const { return n; } };
struct DrTile  { DI int operator()(int n) const { return tileperm(n); } };
struct DrWin   { DI int operator()(int n) const { const int pc = (n < 2560) ? n : (n < 2576 ? PC_DT + (n - 2560) : n - 16); return tileperm(pc); } };
struct DrW1    { DI int operator()(int n) const { const int half = n >> 11, j = n & 2047; return (j >> 7) * 256 + half * 128 + (j & 127); } };

template <bool FP8, class DestRow>
DI void cv_item(const float* W, size_t ldw, int k0, int ncol0, const float* kscale, float scale, void* WT, int kpitch, DestRow dr, LAS float* scr, int lane) {
    const int r = lane >> 3, c4 = (lane & 7) * 4;
    f32x4 v[16];
#pragma unroll
    for (int i = 0; i < 16; ++i) v[i] = *(const f32x4*)(W + (size_t)(k0 + 8 * i + r) * ldw + ncol0 + c4);
#pragma unroll
    for (int i = 0; i < 16; ++i) { f32x4 x = v[i] * scale; if (kscale) x = x * kscale[k0 + 8 * i + r]; *(LAS f32x4*)(scr + (8 * i + r) * 36 + c4) = x; }
    asm volatile("s_waitcnt lgkmcnt(0)" ::: "memory");
    const int n = lane & 31, hf = lane >> 5; const LAS float* s = scr + (64 * hf) * 36 + n;
    if constexpr (FP8) {
        unsigned w[16];
#pragma unroll
        for (int j = 0; j < 16; ++j) { unsigned x = 0u; x = __builtin_amdgcn_cvt_pk_fp8_f32(s[(4 * j) * 36], s[(4 * j + 1) * 36], x, false); x = __builtin_amdgcn_cvt_pk_fp8_f32(s[(4 * j + 2) * 36], s[(4 * j + 3) * 36], x, true); w[j] = x; }
        unsigned char* op = (unsigned char*)WT + (size_t)dr(ncol0 + n) * kpitch + k0 + 64 * hf;
#pragma unroll
        for (int j = 0; j < 4; ++j) *(u32x4*)(op + 16 * j) = (u32x4){w[4 * j], w[4 * j + 1], w[4 * j + 2], w[4 * j + 3]};
    } else {
        unsigned w[32];
#pragma unroll
        for (int j = 0; j < 32; ++j) w[j] = pk2(s[(2 * j) * 36], s[(2 * j + 1) * 36]);
        unsigned char* op = (unsigned char*)WT + (size_t)dr(ncol0 + n) * kpitch + (k0 + 64 * hf) * 2;
#pragma unroll
        for (int j = 0; j < 8; ++j) *(u32x4*)(op + 16 * j) = (u32x4){w[4 * j], w[4 * j + 1], w[4 * j + 2], w[4 * j + 3]};
    }
    asm volatile("s_waitcnt lgkmcnt(0)" ::: "memory");
}
DI void rms_row_to_bf16(const float* xrow, const float* g, bf16_t* orow, int lane) {
    const f32x4* xr = (const f32x4*)xrow + lane;
    f32x4 v[8]; float s = 0.f;
#pragma unroll
    for (int j = 0; j < 8; ++j) { v[j] = xr[64 * j]; s += (v[j].x * v[j].x + v[j].y * v[j].y) + (v[j].z * v[j].z + v[j].w * v[j].w); }
    const float rstd = 1.f / sqrtf(wave_sum(s) * (1.f / 2048.f) + EPS_);
    u32x2* o8 = (u32x2*)orow + lane;
#pragma unroll
    for (int j = 0; j < 8; ++j) { const f32x4 gg = ((const f32x4*)g)[lane + 64 * j];
        u32x2 o; o.x = pk2(v[j].x * rstd * gg.x, v[j].y * rstd * gg.y); o.y = pk2(v[j].z * rstd * gg.z, v[j].w * rstd * gg.w); o8[64 * j] = o; }
}

DI void p0_prologue(Frame& F, const ArgP& a) {
    LAS float* scr = (LAS float*)(F.lds + RING_OFF + F.wave * 16384);
    const int gw = F.vcu * NWAVES + F.wave, NGW = F.G * NWAVES;
    unsigned char* ws = F.ws;
    constexpr int I_A = 32 * 80, I_B = 32, I_C = 32 * 96, NITEMS = I_A + I_B + I_C;
    for (int it = gw; it < NITEMS; it += NGW) {
        int r = it;
        if (r < I_A) { tr_item(a.in(I_WIN), 5648, 64 * (r / 80), 32 * (r % 80), 32, nullptr, (bf16_t*)(ws + WS_WIN), 2048, DrWin(), scr, F.lane); continue; } r -= I_A;
        if (r < I_B) { tr_item(a.in(I_WIN), 5648, 64 * r, 2560, 16, nullptr, (bf16_t*)(ws + WS_WIN), 2048, DrWin(), scr, F.lane); continue; } r -= I_B;
        tr_item(a.in(I_WIN), 5648, 64 * (r / 96), 2576 + 32 * (r % 96), 32, nullptr, (bf16_t*)(ws + WS_WIN), 2048, DrWin(), scr, F.lane);
    }
    for (int m = gw; m < NTOK; m += NGW) rms_row_to_bf16(a.in(I_X) + (size_t)m * 2048, a.in(I_GMIX), (bf16_t*)(ws + WS_HN) + (size_t)m * 2048, F.lane);
    for (int m = gw; m < NB * MEMLEN; m += NGW) rms_row_to_bf16(a.in(I_MEM) + (size_t)m * 2048, a.in(I_GMEM), (bf16_t*)(ws + WS_MN) + (size_t)m * 2048, F.lane);
}
struct CvIt { const float* W; size_t ldw; const float* ks; unsigned char* WT; float scale; int k0, n0, kpitch, fp8, dr, tiled; };
DI CvIt cv_decode(int it, const ArgP& a, unsigned char* ws) {
    constexpr int J_WOUT = 16 * 64, J_WKV = 16 * 128, J_WQ = 16 * 64, J_WO = 16 * 64, J_W1 = 32 * 16 * 128;
    CvIt c; c.ks = nullptr; c.scale = 64.f; c.fp8 = 1; c.dr = 0; c.kpitch = 2048; c.ldw = 2048; c.tiled = 0;
    int r = it;
    if (r < J_WOUT) { c.W = a.in(I_WOUT); c.k0 = 128 * (r / 64); c.n0 = 32 * (r % 64); c.WT = ws + WS_WOUT;
#ifndef MK_WOUT_FP8
        c.scale = 1.f; c.fp8 = 0; c.kpitch = 4096;
#endif
        return c; } r -= J_WOUT;
    if (r < J_WKV) { c.W = a.in(I_WKV); c.ldw = 4096; c.k0 = 128 * (r / 128); c.n0 = 32 * (r % 128); c.WT = ws + WS_WKV; c.scale = 1.f; c.fp8 = 0; c.kpitch = 4096; c.dr = 1; return c; } r -= J_WKV;
    if (r < J_WQ) { c.W = a.in(I_WQ); c.ks = a.in(I_GXA); c.k0 = 128 * (r / 64); c.n0 = 32 * (r % 64); c.WT = ws + WS_WQ; return c; } r -= J_WQ;
    if (r < J_WO) { c.W = a.in(I_WO); c.k0 = 128 * (r / 64); c.n0 = 32 * (r % 64); c.WT = ws + WS_WO; return c; } r -= J_WO;
    if (r < J_W1) { const int e = r / (16 * 128), q = r % (16 * 128); c.W = a.in(I_W1) + (size_t)e * 2048 * 4096; c.ldw = 4096; c.k0 = 128 * (q / 128); c.n0 = 32 * (q % 128); c.WT = ws + WS_W1 + (size_t)e * 4096 * 2048; c.dr = 2; c.tiled = 1; return c; } r -= J_W1;
    { const int e = r / (16 * 64), q = r % (16 * 64); c.W = a.in(I_W2) + (size_t)e * 2048 * 2048; c.k0 = 128 * (q / 64); c.n0 = 32 * (q % 64); c.WT = ws + WS_W2 + (size_t)e * 2048 * 2048; c.tiled = 1; }
    return c;
}
constexpr int CV_NJ = 16 * 64 * 3 + 16 * 128 + 32 * 16 * 128 + 32 * 16 * 64;
constexpr int CV_TAIL2 = 12288;
constexpr int CV_TAIL1 = 20480;
constexpr int CV_TAIL = CV_TAIL1 + CV_TAIL2;
DI void conv_share(Frame& F, const ArgP& a) {
    LAS float* scr = (LAS float*)(F.lds + F.wave * 16384);
    const unsigned sbase = (unsigned)__builtin_amdgcn_readfirstlane((int)((unsigned)(uintptr_t)F.lds + (unsigned)F.wave * 16384u));
    const int gw = F.vcu * NWAVES + F.wave, NGW = F.G * NWAVES, lane = F.lane;
    unsigned char* ws = F.ws;
    constexpr int NJ = CV_NJ - CV_TAIL;
    const int n = lane & 31, hf = lane >> 5;
    for (int it = gw; it < NJ; it += NGW) {
        const CvIt cur = cv_decode(it, a, ws);
        const char* gb = (const char*)(cur.W + (size_t)cur.k0 * cur.ldw + cur.n0);
        const unsigned vo0 = (unsigned)(((size_t)(lane >> 3) * cur.ldw + (size_t)(lane & 7) * 4) * 4), vstep = (unsigned)(8 * cur.ldw * 4);
#pragma unroll
        for (int p = 0; p < 16; ++p) { unsigned keep_;
            asm volatile("s_mov_b32 %0, m0\n\ts_mov_b32 m0, %3\n\ts_nop 0\n\tglobal_load_lds_dwordx4 %1, %2 nt\n\ts_mov_b32 m0, %0"
                         : "=&s"(keep_) : "v"(vo0 + (unsigned)p * vstep), "s"(gb), "s"(sbase + (unsigned)p * 1024u) : "memory"); }
        asm volatile("s_waitcnt vmcnt(0)" ::: "memory");
        const LAS float* s = scr + (64 * hf) * 32 + n;
        const int col = cur.n0 + n; const int drow = (cur.dr == 0) ? col : (cur.dr == 1 ? tileperm(col) : DrW1()(col));
        const float* ksp = cur.ks ? cur.ks + cur.k0 + 64 * hf : nullptr;
        if (cur.fp8) {
            unsigned w[16];
#pragma unroll
            for (int j = 0; j < 16; ++j) { float x0 = s[(4 * j) * 32] * cur.scale, x1 = s[(4 * j + 1) * 32] * cur.scale, x2 = s[(4 * j + 2) * 32] * cur.scale, x3 = s[(4 * j + 3) * 32] * cur.scale;
                if (ksp) { x0 *= ksp[4 * j]; x1 *= ksp[4 * j + 1]; x2 *= ksp[4 * j + 2]; x3 *= ksp[4 * j + 3]; }
                unsigned x = 0u; x = __builtin_amdgcn_cvt_pk_fp8_f32(x0, x1, x, false); x = __builtin_amdgcn_cvt_pk_fp8_f32(x2, x3, x, true); w[j] = x; }
            unsigned char* op = cur.tiled ? cur.WT + ((size_t)(((drow >> 8) * 16 + (cur.k0 >> 7)) * 256 + (drow & 255))) * 128 + 64 * hf : cur.WT + (size_t)drow * cur.kpitch + cur.k0 + 64 * hf;
#pragma unroll
            for (int j = 0; j < 4; ++j) *(u32x4*)(op + 16 * j) = (u32x4){w[4 * j], w[4 * j + 1], w[4 * j + 2], w[4 * j + 3]};
        } else {
            unsigned w[32];
#pragma unroll
            for (int j = 0; j < 32; ++j) w[j] = pk2(s[(2 * j) * 32] * cur.scale, s[(2 * j + 1) * 32] * cur.scale);
            unsigned char* op = cur.WT + (size_t)drow * cur.kpitch + (cur.k0 + 64 * hf) * 2;
#pragma unroll
            for (int j = 0; j < 8; ++j) *(u32x4*)(op + 16 * j) = (u32x4){w[4 * j], w[4 * j + 1], w[4 * j + 2], w[4 * j + 3]};
        }
        asm volatile("s_waitcnt lgkmcnt(0)" ::: "memory");
    }
}

DI void conv_queue(Frame& F, const ArgP& a, int qword, int first, int count) {
    LAS float* scr = (LAS float*)(F.lds + F.wave * 18432);
    unsigned char* ws = F.ws;
    const int lane = lane_id(), r = lane >> 3, c4 = (lane & 7) * 4, n = lane & 31, hf = lane >> 5;
    for (;;) {
        if (F.wave == 0 && lane == 0) F.MISC[121] = __hip_atomic_fetch_add(F.ctl + qword, 8u, __ATOMIC_RELAXED, __HIP_MEMORY_SCOPE_AGENT);
        __syncthreads();
        const int base = __builtin_amdgcn_readfirstlane((int)F.MISC[121]);
        __syncthreads();
        if (base >= count) break;
        const int it = first + base + F.wave;
        if (base + F.wave < count) {
            const CvIt cur = cv_decode(it, a, ws);
            f32x4 v[16];
#pragma unroll
            for (int i = 0; i < 16; ++i) v[i] = __builtin_nontemporal_load((const f32x4*)(cur.W + (size_t)(cur.k0 + 8 * i + r) * cur.ldw + cur.n0 + c4));
#pragma unroll
            for (int i = 0; i < 16; ++i) *(LAS f32x4*)(scr + (8 * i + r) * 36 + c4) = v[i] * cur.scale;
            asm volatile("s_waitcnt lgkmcnt(0)" ::: "memory");
            const LAS float* s = scr + (64 * hf) * 36 + n;
            unsigned w[16];
#pragma unroll
            for (int j = 0; j < 16; ++j) { unsigned x = 0u; x = __builtin_amdgcn_cvt_pk_fp8_f32(s[(4 * j) * 36], s[(4 * j + 1) * 36], x, false); x = __builtin_amdgcn_cvt_pk_fp8_f32(s[(4 * j + 2) * 36], s[(4 * j + 3) * 36], x, true); w[j] = x; }
            const int drow = cur.n0 + n; unsigned char* op = cur.WT + ((size_t)(((drow >> 8) * 16 + (cur.k0 >> 7)) * 256 + (drow & 255))) * 128 + 64 * hf;
#pragma unroll
            for (int j = 0; j < 4; ++j) *(u32x4*)(op + 16 * j) = (u32x4){w[4 * j], w[4 * j + 1], w[4 * j + 2], w[4 * j + 3]};
            asm volatile("s_waitcnt lgkmcnt(0)" ::: "memory");
        }
    }
}
static_assert(CV_TAIL <= 32 * 16 * 64 && CV_TAIL1 % 8 == 0 && CV_TAIL2 % 8 == 0, "the tails are a suffix of the moe_w2 items");

struct SchedP1 {
    int G, c; const unsigned char* ws; int lo, hi;
    DI bool next(int i, pg8::UnitD& u) const {
        u.rows = nullptr; u.nvalid = 0; u.lda = 4096u; u.ldb = 4096u; u.e = 0; u.x0 = 0;
        if (lo == 0) {
            if (G == 256) { const int x = c >> 5, s = c & 31, bidx = i * 8 + x; if (bidx >= 24) return false;
                const int g = bidx >> 2, h = bidx & 3; u.pn = 4 * g + (s >> 3); u.pm = h * 8 + (s & 7); if (u.pn >= 23) return false; }
            else { const int L = i * G + c; if (L >= 32 * 23) return false; u.pn = L / 32; u.pm = L % 32; }
            u.type = 0; u.A = (const char*)(ws + WS_HN) + (size_t)u.pm * 256 * 4096; u.B = (const char*)(ws + WS_WIN) + (size_t)u.pn * 256 * 4096;
            return true;
        }
        const int L = lo + i * G + c; if (L >= hi) return false;
        { const int q = L - 32 * 23; u.type = 1; u.pn = q / 4; u.pm = q % 4; u.A = (const char*)(ws + WS_MN) + (size_t)u.pm * 256 * 4096; u.B = (const char*)(ws + WS_WKV) + (size_t)u.pn * 256 * 4096; }
        return true;
    }
};
struct EpiP1 {
    static constexpr bool AFTER_DRAIN = false;
    bf16_t* proj; float* dtb; bf16_t* kvraw; const float* gq; const float* gk; unsigned char* vf8;
    DI void operator()(const f32x4 (&acc)[2][2][4][2], const pg8::UnitD& u, int wr, int wc, int fr, int fq) const {
        { int ln_ = lane_id(); asm volatile("" : "+v"(ln_)); fr = ln_ & 15; fq = (ln_ >> 4) & 3; }
        const int row0 = u.pm * 256 + wr * 64 + fr;
        const int cn = u.pn * 256 + 64 * wc + 8 * fq;
        if (u.type == 1 && u.pn >= 8) {
#pragma unroll
            for (int ai = 0; ai < 2; ++ai)
#pragma unroll
                for (int m = 0; m < 4; ++m) { unsigned char* rp = vf8 + (size_t)(row0 + ai * 128 + m * 16) * 2048 + (cn - 2048);
#pragma unroll
                    for (int bj = 0; bj < 2; ++bj) { const f32x4 v0 = acc[ai][bj][m][0] * 16.f, v1 = acc[ai][bj][m][1] * 16.f;
                        u32x2 w; w.x = __builtin_amdgcn_cvt_pk_fp8_f32(v0[0], v0[1], 0u, false); w.x = __builtin_amdgcn_cvt_pk_fp8_f32(v0[2], v0[3], w.x, true);
                        w.y = __builtin_amdgcn_cvt_pk_fp8_f32(v1[0], v1[1], 0u, false); w.y = __builtin_amdgcn_cvt_pk_fp8_f32(v1[2], v1[3], w.y, true);
                        *(u32x2*)(rp + 32 * bj) = w; } }
            return;
        }
        if (u.type == 1) {
#pragma unroll
            for (int ai = 0; ai < 2; ++ai)
#pragma unroll
                for (int m = 0; m < 4; ++m) { bf16_t* rp = kvraw + (size_t)(row0 + ai * 128 + m * 16) * 4096 + cn;
#pragma unroll
                    for (int bj = 0; bj < 2; ++bj) { const f32x4 v0 = acc[ai][bj][m][0], v1 = acc[ai][bj][m][1];
                        u32x4 w; w.x = pk2(v0[0], v0[1]); w.y = pk2(v0[2], v0[3]); w.z = pk2(v1[0], v1[1]); w.w = pk2(v1[2], v1[3]); *(u32x4*)(rp + 32 * bj) = w; } }
            return;
        }
        if (u.pn == 22) {
            if (wc == 0 && fq < 2) {
#pragma unroll
                for (int ai = 0; ai < 2; ++ai)
#pragma unroll
                    for (int m = 0; m < 4; ++m) { float* rp = dtb + (size_t)(row0 + ai * 128 + m * 16) * 16 + 8 * fq;
                        *(f32x4*)(rp) = acc[ai][0][m][0]; *(f32x4*)(rp + 4) = acc[ai][0][m][1]; }
            }
            return;
        }
        const bool isq = (u.pn >= 10 && u.pn < 14), isk = (u.pn >= 14 && u.pn < 18);
        if (!(isq || isk)) {
#pragma unroll
            for (int ai = 0; ai < 2; ++ai)
#pragma unroll
                for (int m = 0; m < 4; ++m) { bf16_t* rp = proj + (size_t)(row0 + ai * 128 + m * 16) * PP + cn;
#pragma unroll
                    for (int bj = 0; bj < 2; ++bj) { const f32x4 v0 = acc[ai][bj][m][0], v1 = acc[ai][bj][m][1];
                        u32x4 w; w.x = pk2(v0[0], v0[1]); w.y = pk2(v0[2], v0[3]); w.z = pk2(v1[0], v1[1]); w.w = pk2(v1[2], v1[3]); *(u32x4*)(rp + 32 * bj) = w; } }
            return;
        }
        const float* g = (isq ? gq : gk) + 8 * fq; const float sc = isq ? (0.125f * 1.4426950408889634f) : 1.f;
#pragma unroll
        for (int ai = 0; ai < 2; ++ai)
#pragma unroll
            for (int m = 0; m < 4; ++m) { bf16_t* rp = proj + (size_t)(row0 + ai * 128 + m * 16) * PP + cn;
                float ss = 0.f;
#pragma unroll
                for (int bj = 0; bj < 2; ++bj)
#pragma unroll
                    for (int n = 0; n < 2; ++n) { const f32x4 v = acc[ai][bj][m][n]; ss += (v[0] * v[0] + v[1] * v[1]) + (v[2] * v[2] + v[3] * v[3]); }
                ss += __shfl_xor(ss, 16); ss += __shfl_xor(ss, 32);
                const float rs = sc / sqrtf(ss * (1.f / 64.f) + EPS_);
#pragma unroll
                for (int bj = 0; bj < 2; ++bj) { const f32x4 v0 = acc[ai][bj][m][0] * rs * *(const f32x4*)(g + 32 * bj), v1 = acc[ai][bj][m][1] * rs * *(const f32x4*)(g + 32 * bj + 4);
                    u32x4 w; w.x = pk2(v0[0], v0[1]); w.y = pk2(v0[2], v0[3]); w.z = pk2(v1[0], v1[1]); w.w = pk2(v1[2], v1[3]); *(u32x4*)(rp + 32 * bj) = w; } }
    }
};

DI void kprep(Frame& F, const ArgP& a) {
    const int gw = F.vcu * NWAVES + F.wave, NGW = F.G * NWAVES;
    const bf16_t* kv = (const bf16_t*)(F.ws + WS_KVRAW); unsigned char* kn = (unsigned char*)(F.ws + WS_KN8);
    for (int it = gw; it < NB * MEMLEN * 4; it += NGW) {
        const int row = it >> 2, h = it & 3, b = row >> 8, key = row & 255;
        const u32x4 raw = *(const u32x4*)(kv + (size_t)row * 4096 + h * 512 + F.lane * 8);
        float v[8]; v[0] = bflo(raw.x); v[1] = bfhi(raw.x); v[2] = bflo(raw.y); v[3] = bfhi(raw.y); v[4] = bflo(raw.z); v[5] = bfhi(raw.z); v[6] = bflo(raw.w); v[7] = bfhi(raw.w);
        float ss = 0.f;
#pragma unroll
        for (int j = 0; j < 8; ++j) ss += v[j] * v[j];
        const float rs = 1.f / sqrtf(wave_sum(ss) * (1.f / 512.f) + EPS_) * 0.04419417382415922f * 128.f;
        const float* gk = a.in(I_XKG) + F.lane * 8; const float* gq = a.in(I_XQG) + F.lane * 8;
        u32x2 o; o.x = __builtin_amdgcn_cvt_pk_fp8_f32(v[0] * rs * gk[0] * gq[0], v[1] * rs * gk[1] * gq[1], 0u, false); o.x = __builtin_amdgcn_cvt_pk_fp8_f32(v[2] * rs * gk[2] * gq[2], v[3] * rs * gk[3] * gq[3], o.x, true);
        o.y = __builtin_amdgcn_cvt_pk_fp8_f32(v[4] * rs * gk[4] * gq[4], v[5] * rs * gk[5] * gq[5], 0u, false); o.y = __builtin_amdgcn_cvt_pk_fp8_f32(v[6] * rs * gk[6] * gq[6], v[7] * rs * gk[7] * gq[7], o.y, true);
        *(u32x2*)(kn + ((size_t)((b * 4 + h) * 256 + key)) * 512 + F.lane * 8) = o;
    }
}

constexpr int SP = 272;
constexpr int S_C = 0, S_BM = 34816, S_BT = 69632, S_XDT = 104448, S_HB = 121856, S_F = 139264, S_W = 155648  , SSD_LDS = 162048;
static_assert(SSD_LDS <= MISC_OFF, "SSD LDS map");
#define MFMA32(a, b, c) __builtin_amdgcn_mfma_f32_32x32x16_bf16((a), (b), (c), 0, 0, 0)
DI int crow(int r, int hi) { return (r & 3) + 8 * (r >> 2) + 4 * hi; }
DI bf16x8 ldfrag(LAS const unsigned char* base, int row, int kel) { return *(const LAS bf16x8*)(base + row * SP + kel * 2); }
DI float fexp(float x) { return __builtin_amdgcn_exp2f(x * 1.4426950408889634f); }
DI float fsilu(float x) { return x * __builtin_amdgcn_rcpf(1.f + fexp(-x)); }

DI void ssd_unit(Frame& F, const ArgP& a, int b, int hd) {
    LAS unsigned char* lds = F.lds;
    int tid = F.tid, lane = F.lane, r32 = lane & 31, hh = lane >> 5; const int wid = F.wave;
    LAS float* sdt = (LAS float*)(lds + S_F); LAS float* sac = sdt + 2048;
    const bf16_t* proj = (const bf16_t*)(F.ws + WS_PROJ); const float* dtbuf = (const float*)(F.ws + WS_DT); bf16_t* yg = (bf16_t*)(F.ws + WS_YG);
    const int g = hd >> 3;
    const float aneg = -__expf(a.in(I_ALOG)[hd]), dtb = a.in(I_DTB)[hd], dsk = a.in(I_DSKIP)[hd];
#pragma unroll
    for (int q = 0; q < 2; ++q) { const int c = 2 * wid + q; const size_t t0 = (size_t)b * SEQ_ + c * 128;
        const float x0 = dtbuf[(t0 + 2 * lane) * 16 + hd] + dtb, x1 = dtbuf[(t0 + 2 * lane + 1) * 16 + hd] + dtb;
        const float d0 = x0 > 20.f ? x0 : log1pf(__expf(x0)), d1 = x1 > 20.f ? x1 : log1pf(__expf(x1));
        const float a0 = d0 * aneg, a1 = d1 * aneg;
        float s = a0 + a1;
#pragma unroll
        for (int o = 1; o < 64; o <<= 1) { const float t = __shfl_up(s, o); if (lane >= o) s += t; }
        sdt[c * 128 + 2 * lane] = d0; sdt[c * 128 + 2 * lane + 1] = d1; sac[c * 128 + 2 * lane] = s - a1; sac[c * 128 + 2 * lane + 1] = s; }
    int seg = tid >> 5, cg = tid & 31, l0 = seg * 8;
    int colbc = (cg < 16) ? (1024 + g * 128 + cg * 8) : (1280 + g * 128 + (cg - 16) * 8);
    const int colx = hd * 64 + wid * 8; int lx = 2 * lane;
    LAS float* swt = (LAS float*)(lds + S_W);
    { const float* convw = a.in(I_CONVW); const float* convb = a.in(I_CONVB);
      if (tid < 320) { const int ci = tid;
          const int xc = (ci < 64) ? (hd * 64 + ci) : (ci < 192 ? (1024 + g * 128 + (ci - 64)) : (1280 + g * 128 + (ci - 192)));
#pragma unroll
          for (int k = 0; k < 4; ++k) swt[k * 320 + ci] = convw[k * 1536 + xc];
          swt[4 * 320 + ci] = convb[xc]; } }
    int cibc = 64 + cg * 8; const int cix = wid * 8;
    const char* pub = (const char*)F.ws; const unsigned pxb = (unsigned)(WS_PROJ + ((size_t)b * SEQ_ * PP + PC_XBC) * 2), zoff = (unsigned)(WS_CTL + 524288);
    u32x4 inbc[11], inx[5];
#define SSD_PREFETCH(c_) do { \
        int sd_ = l0; asm volatile("" : "+v"(sd_)); \
        _Pragma("unroll") for (int j = 0; j < 11; ++j) { const int tt = (c_) * 128 + sd_ - 3 + j; inbc[j] = *(const u32x4*)(pub + ((tt >= 0) ? pxb + (unsigned)(tt * PP + colbc) * 2u : zoff)); } } while (0)
    SSD_PREFETCH(0);
    f32x16 hT; for (int i = 0; i < 16; ++i) hT[i] = 0.f;
    const int nb = wid & 3, pb = wid >> 2;
    __syncthreads();
    for (int c = 0; c < 16; ++c) {
        { int t_ = lane_id(); asm volatile("" : "+v"(t_)); t_ += F.wave * 64; tid = t_; lane = t_ & 63; r32 = lane & 31; hh = lane >> 5; seg = t_ >> 5; cg = t_ & 31; l0 = seg * 8; lx = 2 * lane;
          colbc = (cg < 16) ? (1024 + g * 128 + cg * 8) : (1280 + g * 128 + (cg - 16) * 8); cibc = 64 + cg * 8; }
        const size_t t0 = (size_t)b * SEQ_ + c * 128;
        const LAS float* cdt = sdt + c * 128; const LAS float* cac = sac + c * 128;
        const float aend = cac[127];
#pragma unroll
        for (int j = 0; j < 5; ++j) { int sd_ = lx; asm volatile("" : "+v"(sd_)); const int tt = c * 128 + sd_ - 3 + j; inx[j] = *(const u32x4*)(pub + ((tt >= 0) ? pxb + (unsigned)(tt * PP + colx) * 2u : zoff)); }
        {
            LAS unsigned char* hbp = lds + S_HB + (32 * pb + r32) * SP + (32 * nb + 4 * hh) * 2;
#pragma unroll
            for (int q4 = 0; q4 < 4; ++q4) { u32x2 w; w.x = pk2(hT[4 * q4], hT[4 * q4 + 1]); w.y = pk2(hT[4 * q4 + 2], hT[4 * q4 + 3]); *(LAS u32x2*)(hbp + 16 * q4) = w; }
        }
        {
            float wbc[5][8];
#pragma unroll
            for (int k = 0; k < 5; ++k) { const f32x4 w0 = *(const LAS f32x4*)(swt + k * 320 + cibc), w1 = *(const LAS f32x4*)(swt + k * 320 + cibc + 4);
#pragma unroll
                for (int i = 0; i < 4; ++i) { wbc[k][i] = w0[i]; wbc[k][4 + i] = w1[i]; } }
#pragma unroll
            for (int hf = 0; hf < 2; ++hf) {
                __builtin_amdgcn_sched_barrier(0);
                float o[4][8];
#pragma unroll
                for (int j = 0; j < 4; ++j)
#pragma unroll
                    for (int i = 0; i < 8; ++i) { float s = wbc[4][i];
#pragma unroll
                        for (int k = 0; k < 4; ++k) { const unsigned wd = inbc[4 * hf + j + k][i >> 1]; s += wbc[k][i] * ((i & 1) ? bfhi(wd) : bflo(wd)); }
                        o[j][i] = fsilu(s); }
                const int lh = l0 + 4 * hf;
                if (cg < 16) {
                    const int n0 = cg * 8; float ev[4];
#pragma unroll
                    for (int j = 0; j < 4; ++j) { ev[j] = fexp(aend - cac[lh + j]);
                        u32x4 w1; w1.x = pk2(o[j][0], o[j][1]); w1.y = pk2(o[j][2], o[j][3]); w1.z = pk2(o[j][4], o[j][5]); w1.w = pk2(o[j][6], o[j][7]);
                        *(LAS u32x4*)(lds + S_BM + (lh + j) * SP + n0 * 2) = w1; }
#pragma unroll
                    for (int i = 0; i < 8; ++i) { u32x2 w2; w2.x = pk2(o[0][i] * ev[0], o[1][i] * ev[1]); w2.y = pk2(o[2][i] * ev[2], o[3][i] * ev[3]);
                        *(LAS u32x2*)(lds + S_BT + (n0 + i) * SP + lh * 2) = w2; }
                } else {
                    const int n0 = (cg - 16) * 8;
#pragma unroll
                    for (int j = 0; j < 4; ++j) { u32x4 w1; w1.x = pk2(o[j][0], o[j][1]); w1.y = pk2(o[j][2], o[j][3]); w1.z = pk2(o[j][4], o[j][5]); w1.w = pk2(o[j][6], o[j][7]);
                        *(LAS u32x4*)(lds + S_C + (lh + j) * SP + n0 * 2) = w1; }
                }
            }
        }
        __builtin_amdgcn_sched_barrier(0);
        {
            const float d0 = cdt[lx], d1 = cdt[lx + 1];
            float wx[5][8];
#pragma unroll
            for (int k = 0; k < 5; ++k) { const f32x4 w0 = *(const LAS f32x4*)(swt + k * 320 + cix), w1 = *(const LAS f32x4*)(swt + k * 320 + cix + 4);
#pragma unroll
                for (int i = 0; i < 4; ++i) { wx[k][i] = w0[i]; wx[k][4 + i] = w1[i]; } }
#pragma unroll
            for (int i = 0; i < 8; ++i) { float s0 = wx[4][i], s1 = wx[4][i];
#pragma unroll
                for (int k = 0; k < 4; ++k) { const unsigned w0 = inx[k][i >> 1], w1 = inx[k + 1][i >> 1];
                    s0 += wx[k][i] * ((i & 1) ? bfhi(w0) : bflo(w0)); s1 += wx[k][i] * ((i & 1) ? bfhi(w1) : bflo(w1)); }
                *(LAS unsigned*)(lds + S_XDT + (wid * 8 + i) * SP + lx * 2) = pk2(fsilu(s0) * d0, fsilu(s1) * d1); }
        }
        if (c < 15) SSD_PREFETCH(c + 1);
        __syncthreads();
        const int lb = wid >> 1;
        f32x16 xt[2];
        {
            bf16x8 cf[8];
#pragma unroll
            for (int ks = 0; ks < 8; ++ks) cf[ks] = ldfrag(lds + S_C, 32 * lb + r32, 16 * ks + 8 * hh);
#pragma unroll
            for (int q = 0; q < 2; ++q) { const int sb = 2 * (wid & 1) + q;
                for (int i = 0; i < 16; ++i) xt[q][i] = 0.f;
                if (sb <= lb) {
                    bf16x8 bfr[8];
#pragma unroll
                    for (int ks = 0; ks < 8; ++ks) bfr[ks] = ldfrag(lds + S_BM, 32 * sb + r32, 16 * ks + 8 * hh);
                    __builtin_amdgcn_sched_barrier(0);
#pragma unroll
                    for (int ks = 0; ks < 8; ++ks) xt[q] = MFMA32(bfr[ks], cf[ks], xt[q]);
                }
            }
        }
        __syncthreads();
        {
            const int l = 32 * lb + r32; const float al = cac[l], ddl = dsk * __builtin_amdgcn_rcpf(cdt[l]);
            f32x4 cs[2][4];
#pragma unroll
            for (int q = 0; q < 2; ++q)
#pragma unroll
                for (int q4 = 0; q4 < 4; ++q4) cs[q][q4] = *(const LAS f32x4*)(cac + 32 * (2 * (wid & 1) + q) + 8 * q4 + 4 * hh);
#pragma unroll
            for (int q = 0; q < 2; ++q) { const int sb = 2 * (wid & 1) + q;
#pragma unroll
                for (int q4 = 0; q4 < 4; ++q4) { float mv[4];
#pragma unroll
                    for (int e = 0; e < 4; ++e) { const int s = 32 * sb + 8 * q4 + 4 * hh + e;
                        const float ev = fexp(fminf(al - cs[q][q4][e], 0.f));
                        float v = (s <= l) ? xt[q][4 * q4 + e] * ev : 0.f;
                        v += (s == l) ? ddl : 0.f;
                        mv[e] = v; }
                    u32x2 w; w.x = pk2(mv[0], mv[1]); w.y = pk2(mv[2], mv[3]);
                    *(LAS u32x2*)(lds + S_BM + l * SP + (32 * sb + 8 * q4 + 4 * hh) * 2) = w; }
            }
        }
        __syncthreads();
        {
            const int lb2 = wid & 3, pb2 = wid >> 2; const int l = 32 * lb2 + r32; const size_t tok = t0 + l;
            const int pc0 = hd * 64 + 32 * pb2 + 4 * hh;
            u32x2 zz[4];
#pragma unroll
            for (int q4 = 0; q4 < 4; ++q4) zz[q4] = *(const u32x2*)(proj + tok * PP + pc0 + 8 * q4);
            f32x16 y1, y2; for (int i = 0; i < 16; ++i) { y1[i] = 0.f; y2[i] = 0.f; }
            bf16x8 fa[8], fb[8];
#pragma unroll
            for (int ks = 0; ks < 8; ++ks) { fa[ks] = ldfrag(lds + S_XDT, 32 * pb2 + r32, 16 * ks + 8 * hh); fb[ks] = ldfrag(lds + S_BM, 32 * lb2 + r32, 16 * ks + 8 * hh); }
            __builtin_amdgcn_sched_barrier(0);
#pragma unroll
            for (int ks = 0; ks < 8; ++ks) { if (ks < 2 * (lb2 + 1)) y1 = MFMA32(fa[ks], fb[ks], y1); }
            const float cd = fexp(aend);
#pragma unroll
            for (int i = 0; i < 16; ++i) hT[i] *= cd;
#pragma unroll
            for (int ks = 0; ks < 8; ++ks) fb[ks] = ldfrag(lds + S_BT, 32 * nb + r32, 16 * ks + 8 * hh);
            __builtin_amdgcn_sched_barrier(0);
#pragma unroll
            for (int ks = 0; ks < 8; ++ks) hT = MFMA32(fb[ks], fa[ks], hT);
#pragma unroll
            for (int ks = 0; ks < 8; ++ks) { fa[ks] = ldfrag(lds + S_HB, 32 * pb2 + r32, 16 * ks + 8 * hh); fb[ks] = ldfrag(lds + S_C, 32 * lb2 + r32, 16 * ks + 8 * hh); }
            __builtin_amdgcn_sched_barrier(0);
#pragma unroll
            for (int ks = 0; ks < 8; ++ks) y2 = MFMA32(fa[ks], fb[ks], y2);
            const float el = fexp(cac[l]);
#pragma unroll
            for (int q4 = 0; q4 < 4; ++q4) { float yv[4];
#pragma unroll
                for (int e = 0; e < 4; ++e) { const float z = (e & 1) ? bfhi(e < 2 ? zz[q4].x : zz[q4].y) : bflo(e < 2 ? zz[q4].x : zz[q4].y);
                    yv[e] = (y1[4 * q4 + e] + el * y2[4 * q4 + e]) * fsilu(z); }
                u32x2 w; w.x = pk2(yv[0], yv[1]); w.y = pk2(yv[2], yv[3]);
                *(u32x2*)(yg + tok * 1024 + pc0 + 8 * q4) = w; }
        }
        __syncthreads();
    }
#undef SSD_PREFETCH
}

DI void attn_phase_da(Frame& F) {
    const attn_body::bf16* proj = (const attn_body::bf16*)(F.ws + WS_PROJ);
    if (F.wave == 0 && lane_id() == 0) F.MISC[120] = __hip_atomic_fetch_add(F.ctl + CW_QATT, 1u, __ATOMIC_RELAXED, __HIP_MEMORY_SCOPE_AGENT);
    __syncthreads();
    int u = __builtin_amdgcn_readfirstlane((int)F.MISC[120]);
    while (u < 1024) {
        unsigned pend = 0u;
        const int qb = 7 - (u >> 7), combo = u & 127;
        const int half = combo & 1, j = (combo >> 1) & 1, h = (combo >> 2) & 7, b = combo >> 5;
        attn_body::bf16* O = (attn_body::bf16*)(F.ws + (j ? WS_O1 : WS_O0));
        attn_body::attn_unit<8>(b, PC_Q + (h * 2 + j) * 64, PC_V + h * 128 + half * 64, h * 128 + half * 64, qb, proj, proj + (PC_K - PC_Q), proj, O, (char*)F.lds, F.ctl + CW_QATT, pend, F.wave);
        if (F.wave == 0 && lane_id() == 0) F.MISC[120] = pend;
        __syncthreads();
        u = __builtin_amdgcn_readfirstlane((int)F.MISC[120]);
    }
}

DI void p3_finalize(Frame& F, const ArgP& a) {
    const int gw = F.vcu * NWAVES + F.wave, NGW = F.G * NWAVES, lane = F.lane;
    bf16_t* ycat = (bf16_t*)(F.ws + WS_YCAT); const bf16_t* yg = (const bf16_t*)(F.ws + WS_YG); const bf16_t* o0 = (const bf16_t*)(F.ws + WS_O0); const bf16_t* o1 = (const bf16_t*)(F.ws + WS_O1);
    float l1 = a.in(I_LQ1)[lane] * a.in(I_LK1)[lane], l2 = a.in(I_LQ2)[lane] * a.in(I_LK2)[lane];
    const float lam = __expf(wave_sum(l1)) - __expf(wave_sum(l2)) + LAM_INIT;
    for (int m = gw; m < NTOK; m += NGW) {
        { bf16_t* yp = ycat + (size_t)m * 2048 + 16 * lane; const bf16_t* gp = yg + (size_t)m * 1024 + 16 * lane;
          const u32x4 r0 = *(const u32x4*)gp, r1 = *(const u32x4*)(gp + 8);
          float v[16]; v[0] = bflo(r0.x); v[1] = bfhi(r0.x); v[2] = bflo(r0.y); v[3] = bfhi(r0.y); v[4] = bflo(r0.z); v[5] = bfhi(r0.z); v[6] = bflo(r0.w); v[7] = bfhi(r0.w);
          v[8] = bflo(r1.x); v[9] = bfhi(r1.x); v[10] = bflo(r1.y); v[11] = bfhi(r1.y); v[12] = bflo(r1.z); v[13] = bfhi(r1.z); v[14] = bflo(r1.w); v[15] = bfhi(r1.w);
          float ss = 0.f;
#pragma unroll
          for (int i = 0; i < 16; ++i) ss += v[i] * v[i];
#pragma unroll
          for (int o = 1; o < 32; o <<= 1) ss += __shfl_xor(ss, o);
          const float rs = 1.f / sqrtf(ss * (1.f / 512.f) + EPS_);
          const float* g = a.in(I_SSDG) + 16 * lane;
          u32x4 w0, w1;
          w0.x = pk2(v[0] * rs * g[0], v[1] * rs * g[1]); w0.y = pk2(v[2] * rs * g[2], v[3] * rs * g[3]); w0.z = pk2(v[4] * rs * g[4], v[5] * rs * g[5]); w0.w = pk2(v[6] * rs * g[6], v[7] * rs * g[7]);
          w1.x = pk2(v[8] * rs * g[8], v[9] * rs * g[9]); w1.y = pk2(v[10] * rs * g[10], v[11] * rs * g[11]); w1.z = pk2(v[12] * rs * g[12], v[13] * rs * g[13]); w1.w = pk2(v[14] * rs * g[14], v[15] * rs * g[15]);
#ifdef MK_WOUT_FP8
          { const float sc = rs * 16.f; u32x4 q;
            q.x = __builtin_amdgcn_cvt_pk_fp8_f32(v[0] * sc * g[0], v[1] * sc * g[1], 0u, false); q.x = __builtin_amdgcn_cvt_pk_fp8_f32(v[2] * sc * g[2], v[3] * sc * g[3], q.x, true);
            q.y = __builtin_amdgcn_cvt_pk_fp8_f32(v[4] * sc * g[4], v[5] * sc * g[5], 0u, false); q.y = __builtin_amdgcn_cvt_pk_fp8_f32(v[6] * sc * g[6], v[7] * sc * g[7], q.y, true);
            q.z = __builtin_amdgcn_cvt_pk_fp8_f32(v[8] * sc * g[8], v[9] * sc * g[9], 0u, false); q.z = __builtin_amdgcn_cvt_pk_fp8_f32(v[10] * sc * g[10], v[11] * sc * g[11], q.z, true);
            q.w = __builtin_amdgcn_cvt_pk_fp8_f32(v[12] * sc * g[12], v[13] * sc * g[13], 0u, false); q.w = __builtin_amdgcn_cvt_pk_fp8_f32(v[14] * sc * g[14], v[15] * sc * g[15], q.w, true);
            *(u32x4*)((unsigned char*)ycat + (size_t)m * 2048 + 16 * lane) = q; } }
#else
          *(u32x4*)yp = w0; *(u32x4*)(yp + 8) = w1; }
#endif
        { const bf16_t* p0 = o0 + (size_t)m * 1024 + 16 * lane; const bf16_t* p1 = o1 + (size_t)m * 1024 + 16 * lane;
          const u32x4 a0 = *(const u32x4*)p0, a1 = *(const u32x4*)(p0 + 8), b0 = *(const u32x4*)p1, b1 = *(const u32x4*)(p1 + 8);
          float v[16];
          v[0] = bflo(a0.x) - lam * bflo(b0.x); v[1] = bfhi(a0.x) - lam * bfhi(b0.x); v[2] = bflo(a0.y) - lam * bflo(b0.y); v[3] = bfhi(a0.y) - lam * bfhi(b0.y);
          v[4] = bflo(a0.z) - lam * bflo(b0.z); v[5] = bfhi(a0.z) - lam * bfhi(b0.z); v[6] = bflo(a0.w) - lam * bflo(b0.w); v[7] = bfhi(a0.w) - lam * bfhi(b0.w);
          v[8] = bflo(a1.x) - lam * bflo(b1.x); v[9] = bfhi(a1.x) - lam * bfhi(b1.x); v[10] = bflo(a1.y) - lam * bflo(b1.y); v[11] = bfhi(a1.y) - lam * bfhi(b1.y);
          v[12] = bflo(a1.z) - lam * bflo(b1.z); v[13] = bfhi(a1.z) - lam * bfhi(b1.z); v[14] = bflo(a1.w) - lam * bflo(b1.w); v[15] = bfhi(a1.w) - lam * bfhi(b1.w);
          float ss = 0.f;
#pragma unroll
          for (int i = 0; i < 16; ++i) ss += v[i] * v[i];
          ss += __shfl_xor(ss, 1); ss += __shfl_xor(ss, 2); ss += __shfl_xor(ss, 4);
          const float rs = 1.f / sqrtf(ss * (1.f / 128.f) + EPS_) * (1.f - LAM_INIT);
          const float* g = a.in(I_SUBG) + 16 * (lane & 7);
          u32x4 w0, w1;
          w0.x = pk2(v[0] * rs * g[0], v[1] * rs * g[1]); w0.y = pk2(v[2] * rs * g[2], v[3] * rs * g[3]); w0.z = pk2(v[4] * rs * g[4], v[5] * rs * g[5]); w0.w = pk2(v[6] * rs * g[6], v[7] * rs * g[7]);
          w1.x = pk2(v[8] * rs * g[8], v[9] * rs * g[9]); w1.y = pk2(v[10] * rs * g[10], v[11] * rs * g[11]); w1.z = pk2(v[12] * rs * g[12], v[13] * rs * g[13]); w1.w = pk2(v[14] * rs * g[14], v[15] * rs * g[15]);
#ifdef MK_WOUT_FP8
          { const float sc = rs * 16.f; u32x4 q;
            q.x = __builtin_amdgcn_cvt_pk_fp8_f32(v[0] * sc * g[0], v[1] * sc * g[1], 0u, false); q.x = __builtin_amdgcn_cvt_pk_fp8_f32(v[2] * sc * g[2], v[3] * sc * g[3], q.x, true);
            q.y = __builtin_amdgcn_cvt_pk_fp8_f32(v[4] * sc * g[4], v[5] * sc * g[5], 0u, false); q.y = __builtin_amdgcn_cvt_pk_fp8_f32(v[6] * sc * g[6], v[7] * sc * g[7], q.y, true);
            q.z = __builtin_amdgcn_cvt_pk_fp8_f32(v[8] * sc * g[8], v[9] * sc * g[9], 0u, false); q.z = __builtin_amdgcn_cvt_pk_fp8_f32(v[10] * sc * g[10], v[11] * sc * g[11], q.z, true);
            q.w = __builtin_amdgcn_cvt_pk_fp8_f32(v[12] * sc * g[12], v[13] * sc * g[13], 0u, false); q.w = __builtin_amdgcn_cvt_pk_fp8_f32(v[14] * sc * g[14], v[15] * sc * g[15], q.w, true);
            *(u32x4*)((unsigned char*)ycat + (size_t)m * 2048 + 1024 + 16 * lane) = q; }
#else
          bf16_t* yp = ycat + (size_t)m * 2048 + 1024 + 16 * lane;
          *(u32x4*)yp = w0; *(u32x4*)(yp + 8) = w1;
#endif
          }
    }
}

struct SchedDense {
    int G, c, nM, nN; const char* A; const char* B; unsigned lda, ldb; int bdiv; size_t bstride;
    DI bool next(int i, pg8::UnitD& u) const {
        const int L = i * G + c; if (L >= nM * nN) return false;
        u.rows = nullptr; u.nvalid = 0; u.lda = lda; u.ldb = ldb; u.type = 0; u.e = 0; u.x0 = 0;
        if (G == 256 && nM == 32 && nN == 8) { const int x = L >> 5, s = L & 31; u.pm = (x & 3) * 8 + (s & 7); u.pn = (x >> 2) * 4 + (s >> 3); }
        else { u.pn = L / nM; u.pm = L % nM; }
        u.A = A + (size_t)u.pm * 256 * lda; u.B = B + (size_t)u.pn * 256 * ldb + (size_t)(u.pm / bdiv) * bstride;
        return true;
    }
};
template <bool BASE_BF16>
struct EpiResid {
    static constexpr bool AFTER_DRAIN = false;
    const void* base; bf16_t* out; float* part; unsigned char* out8; float accscale;
    DI void operator()(const f32x4 (&acc)[2][2][4][2], const pg8::UnitD& u, int wr, int wc, int fr, int fq) const {
        { int ln_ = lane_id(); asm volatile("" : "+v"(ln_)); fr = ln_ & 15; fq = (ln_ >> 4) & 3; }
        const int row0 = u.pm * 256 + wr * 64 + fr, col0 = u.pn * 256 + wc * 32 + 8 * fq;
#pragma unroll
        for (int ai = 0; ai < 2; ++ai) {
            u32x4 rb[4][2]; f32x4 rf[4][2][2];
#pragma unroll
            for (int m = 0; m < 4; ++m)
#pragma unroll
                for (int bj = 0; bj < 2; ++bj) { const size_t idx = (size_t)(row0 + ai * 128 + m * 16) * 2048 + col0 + bj * 128;
                    if constexpr (BASE_BF16) rb[m][bj] = *(const u32x4*)((const bf16_t*)base + idx);
                    else { rf[m][bj][0] = *(const f32x4*)((const float*)base + idx); rf[m][bj][1] = *(const f32x4*)((const float*)base + idx + 4); } }
#pragma unroll
            for (int m = 0; m < 4; ++m) { const size_t row = (size_t)(row0 + ai * 128 + m * 16); float ss = 0.f;
#pragma unroll
                for (int bj = 0; bj < 2; ++bj) { const size_t idx = row * 2048 + col0 + bj * 128;
                    f32x4 b0, b1;
                    if constexpr (BASE_BF16) { const u32x4 r = rb[m][bj]; b0 = (f32x4){bflo(r.x), bfhi(r.x), bflo(r.y), bfhi(r.y)}; b1 = (f32x4){bflo(r.z), bfhi(r.z), bflo(r.w), bfhi(r.w)}; }
                    else { b0 = rf[m][bj][0]; b1 = rf[m][bj][1]; }
                    const f32x4 v0 = acc[ai][bj][m][0] * accscale + b0, v1 = acc[ai][bj][m][1] * accscale + b1;
                    { u32x4 w; w.x = pk2(v0[0], v0[1]); w.y = pk2(v0[2], v0[3]); w.z = pk2(v1[0], v1[1]); w.w = pk2(v1[2], v1[3]); *(u32x4*)(out + idx) = w; }
                    if (out8) { u32x2 w; w.x = __builtin_amdgcn_cvt_pk_fp8_f32(v0[0] * 16.f, v0[1] * 16.f, 0u, false); w.x = __builtin_amdgcn_cvt_pk_fp8_f32(v0[2] * 16.f, v0[3] * 16.f, w.x, true);
                        w.y = __builtin_amdgcn_cvt_pk_fp8_f32(v1[0] * 16.f, v1[1] * 16.f, 0u, false); w.y = __builtin_amdgcn_cvt_pk_fp8_f32(v1[2] * 16.f, v1[3] * 16.f, w.y, true); *(u32x2*)(out8 + idx) = w; }
                    ss += (v0[0] * v0[0] + v0[1] * v0[1]) + (v0[2] * v0[2] + v0[3] * v0[3]) + (v1[0] * v1[0] + v1[1] * v1[1]) + (v1[2] * v1[2] + v1[3] * v1[3]); }
                if (part) { ss += __shfl_xor(ss, 16); ss += __shfl_xor(ss, 32); if (fq == 0) part[row * 32 + u.pn * 4 + wc] = ss; } }
        }
    }
};

struct EpiQ {
    static constexpr bool AFTER_DRAIN = false;
    unsigned char* out8; float* part;
    DI void operator()(const f32x4 (&acc)[2][2][4][2], const pg8::UnitD& u, int wr, int wc, int fr, int fq) const {
        { int ln_ = lane_id(); asm volatile("" : "+v"(ln_)); fr = ln_ & 15; fq = (ln_ >> 4) & 3; }
        const int row0 = u.pm * 256 + wr * 64 + fr, col0 = u.pn * 256 + wc * 32 + 8 * fq;
#pragma unroll
        for (int ai = 0; ai < 2; ++ai)
#pragma unroll
            for (int m = 0; m < 4; ++m) { const size_t row = (size_t)(row0 + ai * 128 + m * 16); float ss = 0.f;
#pragma unroll
                for (int bj = 0; bj < 2; ++bj) { const size_t idx = row * 2048 + col0 + bj * 128; const f32x4 v0 = acc[ai][bj][m][0] * (1.f / 1024.f), v1 = acc[ai][bj][m][1] * (1.f / 1024.f);
                    u32x2 w; w.x = __builtin_amdgcn_cvt_pk_fp8_f32(v0[0] * 16.f, v0[1] * 16.f, 0u, false); w.x = __builtin_amdgcn_cvt_pk_fp8_f32(v0[2] * 16.f, v0[3] * 16.f, w.x, true);
                    w.y = __builtin_amdgcn_cvt_pk_fp8_f32(v1[0] * 16.f, v1[1] * 16.f, 0u, false); w.y = __builtin_amdgcn_cvt_pk_fp8_f32(v1[2] * 16.f, v1[3] * 16.f, w.y, true); *(u32x2*)(out8 + idx) = w;
                    ss += (v0[0] * v0[0] + v0[1] * v0[1]) + (v0[2] * v0[2] + v0[3] * v0[3]) + (v1[0] * v1[0] + v1[1] * v1[1]) + (v1[2] * v1[2] + v1[3] * v1[3]); }
                ss += __shfl_xor(ss, 16); ss += __shfl_xor(ss, 32); if (fq == 0) part[row * 32 + u.pn * 4 + wc] = ss; }
    }
};

struct SchedXS {
    int G, c; const unsigned char* ws;
    DI bool next(int i, pg8::UnitD& u) const {
        const int L = i * G + c; if (L >= 256) return false;
        u.rows = nullptr; u.nvalid = 0; u.e = 0;
        const int q = L & 127, bh = q >> 3, t8 = q & 7, b = bh >> 2, h = bh & 3;
        u.pm = b; u.pn = h; u.x0 = t8;
        if (L < 128) { u.type = 0; u.lda = 2048u; u.ldb = 512u;
            u.A = (const char*)(ws + WS_QF8) + (size_t)(b * 2048 + t8 * 256) * 2048 + h * 512; u.B = (const char*)(ws + WS_KN8) + (size_t)(bh * 256) * 512; }
        else { u.type = 1; u.lda = 2048u; u.ldb = 2048u;
            u.A = (const char*)(ws + WS_WO) + (size_t)(t8 * 256) * 2048 + h * 512; u.B = (const char*)(ws + WS_VF8) + (size_t)(b * 256) * 2048 + h * 512; }
        return true;
    }
};
struct EpiXS {
    static constexpr bool AFTER_DRAIN = false;
    unsigned char* P; unsigned char* VWT; const float* part1; const float* partq; LAS float* red;
    DI void operator()(const f32x4 (&acc)[2][2][4][2], const pg8::UnitD& u, int wr, int wc, int fr, int fq) const {
        { int ln_ = lane_id(); asm volatile("" : "+v"(ln_)); fr = ln_ & 15; fq = (ln_ >> 4) & 3; }
        const int b = u.pm, h = u.pn, t8 = u.x0;
        const int col0 = wc * 32 + 8 * fq;
        if (u.type == 1) {
            unsigned char* Vu = VWT + ((size_t)b * 2048 + t8 * 256) * 1024 + h * 256;
#pragma unroll
            for (int ai = 0; ai < 2; ++ai)
#pragma unroll
                for (int m = 0; m < 4; ++m) { const unsigned rl = (unsigned)(ai * 128 + wr * 64 + m * 16 + fr);
#pragma unroll
                    for (int bj = 0; bj < 2; ++bj) { const f32x4 v0 = acc[ai][bj][m][0] * (32.f / 1024.f), v1 = acc[ai][bj][m][1] * (32.f / 1024.f);
                        u32x2 w; w.x = __builtin_amdgcn_cvt_pk_fp8_f32(v0[0], v0[1], 0u, false); w.x = __builtin_amdgcn_cvt_pk_fp8_f32(v0[2], v0[3], w.x, true);
                        w.y = __builtin_amdgcn_cvt_pk_fp8_f32(v1[0], v1[1], 0u, false); w.y = __builtin_amdgcn_cvt_pk_fp8_f32(v1[2], v1[3], w.y, true);
                        *(u32x2*)(Vu + (rl * 1024u + (unsigned)(bj * 128 + col0))) = w; } }
            return;
        }
        const size_t row0 = (size_t)b * 2048 + t8 * 256;
        const char* p1u = (const char*)(part1 + row0 * 32); const char* pqu = (const char*)(partq + row0 * 32 + h * 8); unsigned char* Pu = P + row0 * 1024 + h * 256;
        float rsc[2][4];
#pragma unroll
        for (int ai = 0; ai < 2; ++ai)
#pragma unroll
            for (int m = 0; m < 4; ++m) { const unsigned rl = (unsigned)(ai * 128 + wr * 64 + m * 16 + fr);
                const f32x4 p0 = *(const f32x4*)(p1u + (rl * 32u + (unsigned)fq * 8u) * 4u), p1 = *(const f32x4*)(p1u + (rl * 32u + (unsigned)fq * 8u + 4u) * 4u);
                float s1 = (p0[0] + p0[1]) + (p0[2] + p0[3]) + (p1[0] + p1[1]) + (p1[2] + p1[3]);
                const f32x2 pq = *(const f32x2*)(pqu + (rl * 32u + (unsigned)fq * 2u) * 4u);
                float sq = pq[0] + pq[1];
                s1 = quad_sum_16_32(s1); sq = quad_sum_16_32(sq);
                rsc[ai][m] = __builtin_amdgcn_rsqf(sq * (1.f / 512.f) + EPS_ * (s1 * (1.f / 2048.f) + EPS_)) * (1.4426950408889634f / 2048.f);
                float ps = 0.f;
#pragma unroll
                for (int bj = 0; bj < 2; ++bj)
#pragma unroll
                    for (int n = 0; n < 2; ++n)
#pragma unroll
                        for (int e = 0; e < 4; ++e) ps += __builtin_amdgcn_exp2f(fminf(acc[ai][bj][m][n][e] * rsc[ai][m], 100.f));
                ps = quad_sum_16_32(ps);
                if (fq == 0) red[rl * 4 + wc] = ps;
                __builtin_amdgcn_sched_barrier(0); }
        __syncthreads();
        { int ln_ = lane_id(); asm volatile("" : "+v"(ln_)); fr = ln_ & 15; fq = (ln_ >> 4) & 3; }
#pragma unroll
        for (int ai = 0; ai < 2; ++ai)
#pragma unroll
            for (int m = 0; m < 4; ++m) { const unsigned rl = (unsigned)(ai * 128 + wr * 64 + m * 16 + fr);
                const f32x4 t = *(const LAS f32x4*)(red + rl * 4); const float inv = 256.f * __builtin_amdgcn_rcpf((t[0] + t[1]) + (t[2] + t[3])); float rs = rsc[ai][m]; asm volatile("" : "+v"(rs));
#pragma unroll
                for (int bj = 0; bj < 2; ++bj) { float x[8];
#pragma unroll
                    for (int n = 0; n < 2; ++n)
#pragma unroll
                        for (int e = 0; e < 4; ++e) x[n * 4 + e] = __builtin_amdgcn_exp2f(fminf(acc[ai][bj][m][n][e] * rs, 100.f)) * inv;
                    u32x2 w; w.x = __builtin_amdgcn_cvt_pk_fp8_f32(x[0], x[1], 0u, false); w.x = __builtin_amdgcn_cvt_pk_fp8_f32(x[2], x[3], w.x, true);
                    w.y = __builtin_amdgcn_cvt_pk_fp8_f32(x[4], x[5], 0u, false); w.y = __builtin_amdgcn_cvt_pk_fp8_f32(x[6], x[7], w.y, true);
                    *(u32x2*)(Pu + (rl * 1024u + (unsigned)(bj * 128 + wc * 32 + 8 * fq))) = w; } }
        __syncthreads();
    }
};

constexpr int HNP = 2052;
DI void p8_route(Frame& F, const ArgP& a) {
    LAS float* s_hn = (LAS float*)F.lds; LAS float* s_part = (LAS float*)(F.lds + 16 * HNP * 4); LAS float* s_log = s_part + 8 * 16 * 32; LAS int* s_slot = (LAS int*)(s_log + 16 * 32);
    LAS int* s_cnt = s_slot + 64; LAS int* s_base = s_cnt + 32;
    const bf16_t* h2 = (const bf16_t*)(F.ws + WS_H2); unsigned char* xg = (unsigned char*)(F.ws + WS_XG);
    float* gate_of = (float*)(F.ws + WS_GATEOF); int* tok_e = (int*)(F.ws + WS_TOKE);
    const float* rw = a.in(I_RW); const float* rb = a.in(I_RB); const float* g3 = a.in(I_GFFN);
    const int lane = F.lane, wave = F.wave, tid = F.tid;
    float bw0[64], bw1[64];
    { const int kq = lane >> 4, c16 = lane & 15; const float* bp = rw + (size_t)(256 * wave + kq) * 32 + c16;
#pragma unroll
      for (int j = 0; j < 64; ++j) { bw0[j] = bp[(size_t)(4 * j) * 32]; bw1[j] = bp[(size_t)(4 * j) * 32 + 16]; } }
    for (int task = F.vcu; task < NTOK / 16; task += F.G) {
        const int tb = task * 16;
#pragma unroll
        for (int q = 0; q < 2; ++q) { const int tl = 2 * wave + q; const size_t tok = (size_t)(tb + tl);
            const u32x2* xr = (const u32x2*)(h2 + tok * 2048) + lane;
            f32x4 v[8]; float s = 0.f;
#pragma unroll
            for (int j = 0; j < 8; ++j) { const u32x2 rw_ = xr[64 * j]; v[j] = (f32x4){bflo(rw_.x), bfhi(rw_.x), bflo(rw_.y), bfhi(rw_.y)}; s += (v[j].x * v[j].x + v[j].y * v[j].y) + (v[j].z * v[j].z + v[j].w * v[j].w); }
            const float rstd = 1.f / sqrtf(wave_sum(s) * (1.f / 2048.f) + EPS_);
#pragma unroll
            for (int j = 0; j < 8; ++j) { const f32x4 gg = ((const f32x4*)g3)[lane + 64 * j]; const f32x4 y = v[j] * rstd * gg;
                *(LAS f32x4*)(s_hn + tl * HNP + (lane + 64 * j) * 4) = y; } }
        __syncthreads();
        {
            f32x4 acc0 = {0.f, 0.f, 0.f, 0.f}, acc1 = {0.f, 0.f, 0.f, 0.f};
            const int kq = lane >> 4, c16 = lane & 15;
            const LAS float* ap = s_hn + c16 * HNP + 256 * wave;
#pragma unroll
            for (int j = 0; j < 64; ++j) { const f32x4 a4 = *(const LAS f32x4*)(ap + 4 * j);
                const float av = (kq == 0) ? a4.x : (kq == 1) ? a4.y : (kq == 2) ? a4.z : a4.w;
                acc0 = __builtin_amdgcn_mfma_f32_16x16x4f32(av, bw0[j], acc0, 0, 0, 0);
                acc1 = __builtin_amdgcn_mfma_f32_16x16x4f32(av, bw1[j], acc1, 0, 0, 0); }
            LAS float* pp = s_part + wave * 512 + c16;
#pragma unroll
            for (int r = 0; r < 4; ++r) { pp[(4 * kq + r) * 32] = acc0[r]; pp[(4 * kq + r) * 32 + 16] = acc1[r]; }
        }
        __syncthreads();
        {
            const int tt = tid >> 5, e = tid & 31; float lg = rb[e];
#pragma unroll
            for (int w = 0; w < 8; ++w) lg += s_part[w * 512 + tt * 32 + e];
            if (tid < 32) s_cnt[tid] = 0;
            float val[4]; int idx[4]; float cur = lg;
#pragma unroll
            for (int k = 0; k < 4; ++k) { float bv = cur; int bi = e;
#pragma unroll
                for (int o = 1; o < 32; o <<= 1) { const float ov = __shfl_xor(bv, o); const int oi = __shfl_xor(bi, o); if (ov > bv || (ov == bv && oi < bi)) { bv = ov; bi = oi; } }
                val[k] = bv; idx[k] = bi; if (e == bi) cur = -INFINITY; }
            __syncthreads();
            int myrank = 0, myexp = 0; float mygate = 0.f;
            if (e < 4) { const float sum = (__expf(val[0] - val[0]) + __expf(val[1] - val[0])) + (__expf(val[2] - val[0]) + __expf(val[3] - val[0]));
                const float mv = (e == 0) ? val[0] : (e == 1) ? val[1] : (e == 2) ? val[2] : val[3]; myexp = (e == 0) ? idx[0] : (e == 1) ? idx[1] : (e == 2) ? idx[2] : idx[3];
                mygate = __expf(mv - val[0]) / sum; myrank = __hip_atomic_fetch_add(&s_cnt[myexp], 1, __ATOMIC_RELAXED, __HIP_MEMORY_SCOPE_WORKGROUP); }
            __syncthreads();
            if (tid < 32) { const int c = s_cnt[tid]; s_base[tid] = c ? (int)__hip_atomic_fetch_add(F.ctl + CW_CNT + 64 * tid, (unsigned)c, __ATOMIC_RELAXED, __HIP_MEMORY_SCOPE_AGENT) : 0; }
            __syncthreads();
            if (e < 4) { const int slot = myexp * 8192 + s_base[myexp] + myrank; const int tok = tb + tt;
                gate_of[slot] = mygate; tok_e[tok * 4 + e] = slot; s_slot[tt * 4 + e] = slot; }
        }
        __syncthreads();
#pragma unroll
        for (int q = 0; q < 2; ++q) { const int tl = 2 * wave + q;
            unsigned o[8];
#pragma unroll
            for (int j = 0; j < 8; ++j) { const f32x4 y = *(const LAS f32x4*)(s_hn + tl * HNP + (lane + 64 * j) * 4);
                unsigned w = 0u; w = __builtin_amdgcn_cvt_pk_fp8_f32(y.x * 4.f, y.y * 4.f, w, false); w = __builtin_amdgcn_cvt_pk_fp8_f32(y.z * 4.f, y.w * 4.f, w, true); o[j] = w; }
#pragma unroll
            for (int k = 0; k < 4; ++k) { unsigned* o4 = (unsigned*)(xg + (size_t)s_slot[tl * 4 + k] * 2048) + lane;
#pragma unroll
                for (int j = 0; j < 8; ++j) o4[64 * j] = o[j]; } }
        __syncthreads();
    }
}

DI void moe_tables(Frame& F) {
    if (F.tid < 64) { const int e = F.tid & 31;
        const unsigned c = F.ctl[CW_CNT + 64 * e], mt = (c + 255u) >> 8;
        unsigned incl = mt;
#pragma unroll
        for (int o = 1; o < 32; o <<= 1) { const unsigned v = __shfl_up(incl, o, 64); if (e >= o) incl += v; }
        const unsigned base = incl - mt;
        if (F.tid < 32) { F.MISC[16 + e] = c; F.MISC[48 + e] = base; F.MISC[80 + e] = mt; if (e == 31) F.MISC[112] = incl;
            volatile LAS unsigned char* tab = (volatile LAS unsigned char*)(F.MISC + 128);
            for (unsigned t = 0; t < mt; ++t) tab[base + t] = (unsigned char)e; } }
    __syncthreads();
}
DI int ldsu(volatile LAS unsigned* p) { return __builtin_amdgcn_readfirstlane((int)*p); }
template <int NTN  >
struct SchedMoe {
    int G, c; const unsigned char* ws; volatile LAS unsigned* MISC; int total;
    DI bool next(int i, pg8::UnitD& u) const {
        const int L = i * G + c; if (L >= total) return false;
        const int e = __builtin_amdgcn_readfirstlane((int)((volatile LAS unsigned char*)(MISC + 128))[L / NTN]);
        const int tb = ldsu(MISC + 48 + e), mte = ldsu(MISC + 80 + e), cnt = ldsu(MISC + 16 + e);
        const int local = L - tb * NTN, nt = local / mte, mt = local % mte;
        u.type = 0; u.e = e; u.pn = nt; u.pm = tb + mt; u.x0 = mt; u.lda = 2048u; u.ldb = 128u;
        u.rows = nullptr; u.nvalid = cnt - mt * 256;
        if (NTN == 16) { u.A = (const char*)(ws + WS_XG) + ((size_t)e * 8192 + (size_t)mt * 256) * 2048;
            u.B = (const char*)(ws + WS_W1) + ((size_t)e * 4096 + (size_t)nt * 256) * 2048; }
        else { u.A = (const char*)(ws + WS_ACT) + ((size_t)e * 8192 + (size_t)mt * 256) * 2048;
            u.B = (const char*)(ws + WS_W2) + ((size_t)e * 2048 + (size_t)nt * 256) * 2048; }
        return true;
    }
};
struct EpiMoe1 {
    static constexpr bool AFTER_DRAIN = false;
    unsigned char* act; const float* b1;
    DI void operator()(const f32x4 (&acc)[2][2][4][2], const pg8::UnitD& u, int wr, int wc, int fr, int fq) const {
        { int ln_ = lane_id(); asm volatile("" : "+v"(ln_)); fr = ln_ & 15; fq = (ln_ >> 4) & 3; }
        const int j0 = u.pn * 128 + wc * 32 + 8 * fq;
        const float* bg = b1 + (size_t)u.e * 4096 + j0; const float* bu = bg + 2048;
        const f32x4 bg0 = *(const f32x4*)bg, bg1 = *(const f32x4*)(bg + 4), bu0 = *(const f32x4*)bu, bu1 = *(const f32x4*)(bu + 4);
#pragma unroll
        for (int ai = 0; ai < 2; ++ai)
#pragma unroll
            for (int m = 0; m < 4; ++m) { const size_t row = (size_t)u.e * 8192 + u.x0 * 256 + ai * 128 + wr * 64 + m * 16 + fr;
                float o[8];
#pragma unroll
                for (int n = 0; n < 2; ++n) {
                    f32x4 g = acc[ai][0][m][n] * (1.f / 256.f) + (n ? bg1 : bg0);
                    g = __builtin_elementwise_min(g, (f32x4){7.f, 7.f, 7.f, 7.f});
                    f32x4 uu = acc[ai][1][m][n] * (1.f / 256.f) + (n ? bu1 : bu0);
                    uu = __builtin_elementwise_min(__builtin_elementwise_max(uu, (f32x4){-7.f, -7.f, -7.f, -7.f}), (f32x4){7.f, 7.f, 7.f, 7.f});
                    f32x4 t = g * (-1.702f * 1.4426950408889634f);
                    t = (f32x4){__builtin_amdgcn_exp2f(t[0]), __builtin_amdgcn_exp2f(t[1]), __builtin_amdgcn_exp2f(t[2]), __builtin_amdgcn_exp2f(t[3])} + 1.f;
                    const f32x4 r = {__builtin_amdgcn_rcpf(t[0]), __builtin_amdgcn_rcpf(t[1]), __builtin_amdgcn_rcpf(t[2]), __builtin_amdgcn_rcpf(t[3])};
                    const f32x4 ov = g * r * (uu * 4.f + 4.f);
#pragma unroll
                    for (int e = 0; e < 4; ++e) o[n * 4 + e] = ov[e]; }
                u32x2 w; w.x = __builtin_amdgcn_cvt_pk_fp8_f32(o[0], o[1], 0u, false); w.x = __builtin_amdgcn_cvt_pk_fp8_f32(o[2], o[3], w.x, true);
                w.y = __builtin_amdgcn_cvt_pk_fp8_f32(o[4], o[5], 0u, false); w.y = __builtin_amdgcn_cvt_pk_fp8_f32(o[6], o[7], w.y, true);
                *(u32x2*)(act + row * 2048 + j0) = w;
                __builtin_amdgcn_sched_barrier(0); }
    }
};
struct EpiMoe2 {
    static constexpr bool AFTER_DRAIN = false;
    unsigned char* y; const float* b2; const float* gate_of;
    DI void operator()(const f32x4 (&acc)[2][2][4][2], const pg8::UnitD& u, int wr, int wc, int fr, int fq) const {
        { int ln_ = lane_id(); asm volatile("" : "+v"(ln_)); fr = ln_ & 15; fq = (ln_ >> 4) & 3; }
        const int col0 = u.pn * 256 + wc * 32 + 8 * fq;
        const float* bp = b2 + (size_t)u.e * 2048 + col0;
        const f32x4 bb[2][2] = {{*(const f32x4*)(bp), *(const f32x4*)(bp + 4)}, {*(const f32x4*)(bp + 128), *(const f32x4*)(bp + 132)}};
        const float* gp = gate_of + (size_t)u.e * 8192 + u.x0 * 256 + wr * 64 + fr;
        float gts[2][4];
#pragma unroll
        for (int ai = 0; ai < 2; ++ai)
#pragma unroll
            for (int m = 0; m < 4; ++m) gts[ai][m] = gp[ai * 128 + m * 16];
#pragma unroll
        for (int ai = 0; ai < 2; ++ai)
#pragma unroll
            for (int m = 0; m < 4; ++m) { const int rl = ai * 128 + wr * 64 + m * 16 + fr; const size_t row = (size_t)u.e * 8192 + u.x0 * 256 + rl;
                const float gt = (rl < u.nvalid) ? gts[ai][m] * 32.f : 0.f;
#pragma unroll
                for (int bj = 0; bj < 2; ++bj) { const f32x4 v0 = (acc[ai][bj][m][0] * (1.f / 256.f) + bb[bj][0]) * gt, v1 = (acc[ai][bj][m][1] * (1.f / 256.f) + bb[bj][1]) * gt;
                    u32x2 w; w.x = __builtin_amdgcn_cvt_pk_fp8_f32(v0[0], v0[1], 0u, false); w.x = __builtin_amdgcn_cvt_pk_fp8_f32(v0[2], v0[3], w.x, true);
                    w.y = __builtin_amdgcn_cvt_pk_fp8_f32(v1[0], v1[1], 0u, false); w.y = __builtin_amdgcn_cvt_pk_fp8_f32(v1[2], v1[3], w.y, true);
                    *(u32x2*)(y + row * 2048 + col0 + bj * 128) = w; } }
    }
};

DI void p11_combine(Frame& F, const ArgP& a) {
    const int gw = F.vcu * NWAVES + F.wave, NGW = F.G * NWAVES, lane = F.lane;
    const bf16_t* h2 = (const bf16_t*)(F.ws + WS_H2); const unsigned char* y = (const unsigned char*)(F.ws + WS_Y);
    const int* tok_e = (const int*)(F.ws + WS_TOKE);
    for (int t = gw; t < NTOK; t += NGW) {
        size_t yrow[4];
#pragma unroll
        for (int k = 0; k < 4; ++k) yrow[k] = (size_t)tok_e[t * 4 + k] * 2048;
#pragma unroll
        for (int j = 0; j < 8; ++j) { const int c = (lane + 64 * j) * 4;
            const u32x2 hw = *(const u32x2*)(h2 + (size_t)t * 2048 + c); f32x4 v = {bflo(hw.x), bfhi(hw.x), bflo(hw.y), bfhi(hw.y)};
#pragma unroll
            for (int k = 0; k < 4; ++k) { const unsigned w = *(const unsigned*)(y + yrow[k] + c); const f32x2 lo = __builtin_amdgcn_cvt_pk_f32_fp8(w, false), hi = __builtin_amdgcn_cvt_pk_f32_fp8(w, true);
                v.x += lo.x * (1.f / 32.f); v.y += lo.y * (1.f / 32.f); v.z += hi.x * (1.f / 32.f); v.w += hi.y * (1.f / 32.f); }
            *(f32x4*)(a.out() + (size_t)t * 2048 + c) = v; }
    }
}

#ifndef MK_PER_PHASE
#define MK_PER_PHASE 0
#endif
#ifndef MK_LAST_PHASE
#define MK_LAST_PHASE 12
#endif
constexpr int N_PHASES = MK_LAST_PHASE;

__global__ void __launch_bounds__(NWAVES * 64, 2) mega_fwd(Args args_) {
    const ArgP args{};
    extern __shared__ __attribute__((aligned(16))) unsigned char lds_raw[];
    Frame F;
    F.lds = (LAS unsigned char*)lds_raw;
    F.MISC = (volatile LAS unsigned*)(F.lds + MISC_OFF);
    F.wave = __builtin_amdgcn_readfirstlane((int)(threadIdx.x >> 6)); F.lane = lane_id(); F.tid = F.wave * 64 + F.lane;
    F.G = gridDim.x; { const int bx = blockIdx.x; F.vcu = (F.G % 8 == 0) ? (bx % 8) * (F.G / 8) + bx / 8 : bx; }
    F.ws = args_.ws; F.ctl = (unsigned*)(args_.ws + WS_CTL);
    for (int u = F.tid; u < 256; u += NWAVES * 64) F.MISC[u] = 0u;
    __syncthreads();
    if (F.lane == 0) F.MISC[192 + ((unsigned)__builtin_amdgcn_s_getreg((5 << 11) | 4) & 63u)] = (unsigned)F.wave;
    __syncthreads();
    XcdBarrier bar; bar.bar = F.ctl + CW_BAR; bar.x = 0; bar.st = nullptr;
    const int lo = args_.ph_lo, hi = args_.ph_hi;
    if (hi - lo > 1) bar = xcd_barrier_post(F.ctl + CW_BAR, F.MISC + 8);
#ifndef MK_PHASE_MASK
#define MK_PHASE_MASK 0xFFFF
#endif
#define IN(k) (((MK_PHASE_MASK >> (k)) & 1) && lo <= (k) && (k) < hi)
#define SEAM(k) do { if (IN(k) && IN((k) + 1)) xcd_barrier(bar); } while (0)
#define FRESH() do { int l_ = lane_id(); asm volatile("" : "+v"(l_)); F.lane = l_; F.wave = wave_now(F.MISC); F.tid = F.wave * 64 + l_; } while (0)
    unsigned char* ws = args_.ws;

    if (IN(0)) { FRESH(); p0_prologue(F, args); }
    SEAM(0);
    if (IN(1)) { FRESH();
        const bool conv_first = (F.vcu & 1) == 0;
        if (conv_first) { conv_share(F, args); __syncthreads(); }
        SchedP1 S{F.G, F.vcu, ws, 0, 32 * 23};
        EpiP1 E{(bf16_t*)(ws + WS_PROJ), (float*)(ws + WS_DT), (bf16_t*)(ws + WS_KVRAW), args.in(I_DAQG), args.in(I_DAKG), (unsigned char*)(ws + WS_VF8)};
        pg8::gemm_phase<EpiP1, SchedP1, false, true>(F.wave, F.lds + RING_OFF, 32, S, E);
        if (!conv_first) { __syncthreads(); conv_share(F, args); }
    }
    SEAM(1);
    if (IN(2)) { FRESH();
        if ((F.vcu & 3) == 1) {
            SchedP1 S{(F.G + 3) >> 2, F.vcu >> 2, ws, 32 * 23, 32 * 23 + 64};
            EpiP1 E{(bf16_t*)(ws + WS_PROJ), (float*)(ws + WS_DT), (bf16_t*)(ws + WS_KVRAW), args.in(I_DAQG), args.in(I_DAKG), (unsigned char*)(ws + WS_VF8)};
            pg8::gemm_phase<EpiP1, SchedP1, false, true>(F.wave, F.lds + RING_OFF, 32, S, E);
            __syncthreads();
        }
        if ((F.vcu & 3) == 0) { for (int u = F.vcu >> 2; u < 64; u += (F.G + 3) >> 2) ssd_unit(F, args, u >> 4, u & 15); }
        __syncthreads();
        attn_phase_da(F);
        __syncthreads();
        conv_queue(F, args, CW_QCONV, CV_NJ - CV_TAIL, CV_TAIL1);
    }
    SEAM(2);
    if (IN(3)) { FRESH(); kprep(F, args); p3_finalize(F, args); }
    SEAM(3);
    if (IN(4)) { FRESH();
#ifdef MK_WOUT_FP8
        SchedDense S{F.G, F.vcu, 32, 8, (const char*)(ws + WS_YCAT), (const char*)(ws + WS_WOUT), 2048u, 2048u, 1 << 30, 0};
        EpiResid<false> E{args.in(I_X), (bf16_t*)(ws + WS_H1), (float*)(ws + WS_PART1), (unsigned char*)(ws + WS_H1F8), 1.f / 1024.f};
        pg8::gemm_phase<EpiResid<false>, SchedDense, false, true, true>(F.wave, F.lds + RING_OFF, 16, S, E);
#else
        SchedDense S{F.G, F.vcu, 32, 8, (const char*)(ws + WS_YCAT), (const char*)(ws + WS_WOUT), 4096u, 4096u, 1 << 30, 0};
        EpiResid<false> E{args.in(I_X), (bf16_t*)(ws + WS_H1), (float*)(ws + WS_PART1), (unsigned char*)(ws + WS_H1F8), 1.f};
        pg8::gemm_phase<EpiResid<false>, SchedDense, false, true>(F.wave, F.lds + RING_OFF, 32, S, E);
#endif
    }
    SEAM(4);
    if (IN(5)) { FRESH();
        SchedDense S{F.G, F.vcu, 32, 8, (const char*)(ws + WS_H1F8), (const char*)(ws + WS_WQ), 2048u, 2048u, 1 << 30, 0};
        EpiQ E{(unsigned char*)(ws + WS_QF8), (float*)(ws + WS_PARTQ)};
        pg8::gemm_phase<EpiQ, SchedDense, false, true, true>(F.wave, F.lds + RING_OFF, 16, S, E);
    }
    SEAM(5);
    if (IN(6)) { FRESH();
        SchedXS S{F.G, F.vcu, ws};
        EpiXS E{(unsigned char*)(ws + WS_P8), (unsigned char*)(ws + WS_VWT8), (const float*)(ws + WS_PART1), (const float*)(ws + WS_PARTQ), (LAS float*)(F.lds + RING_BYTES)};
        pg8::gemm_phase<EpiXS, SchedXS, false, true, true>(F.wave, F.lds + RING_OFF, 4, S, E);
    }
    SEAM(6);
    if (IN(7)) { FRESH();
        SchedDense S{F.G, F.vcu, 32, 8, (const char*)(ws + WS_P8), (const char*)(ws + WS_VWT8), 1024u, 1024u, 8, (size_t)2048 * 1024};
        EpiResid<true> E{(const void*)(ws + WS_H1), (bf16_t*)(ws + WS_H2), nullptr, nullptr, 1.f / 8192.f};
        pg8::gemm_phase<EpiResid<true>, SchedDense, false, true, true>(F.wave, F.lds + RING_OFF, 8, S, E);
    }
    SEAM(7);
    if (IN(8)) { FRESH(); p8_route(F, args); }
    SEAM(8);
    if (IN(9)) { FRESH();
        moe_tables(F);
        SchedMoe<16> S{F.G, F.vcu, ws, F.MISC, ldsu(F.MISC + 112) * 16};
        EpiMoe1 E{(unsigned char*)(ws + WS_ACT), args.in(I_B1)};
        pg8::gemm_phase<EpiMoe1, SchedMoe<16>, false, true, true>(F.wave, F.lds + RING_OFF, 16, S, E);
        __syncthreads();
        conv_queue(F, args, CW_QCONV2, CV_NJ - CV_TAIL2, CV_TAIL2);
    }
    SEAM(9);
    if (IN(10)) { FRESH();
        moe_tables(F);
        SchedMoe<8> S{F.G, F.vcu, ws, F.MISC, ldsu(F.MISC + 112) * 8};
        EpiMoe2 E{(unsigned char*)(ws + WS_Y), args.in(I_B2), (const float*)(ws + WS_GATEOF)};
        pg8::gemm_phase<EpiMoe2, SchedMoe<8>, false, true, true>(F.wave, F.lds + RING_OFF, 16, S, E);
    }
    SEAM(10);
    if (IN(11)) { FRESH(); p11_combine(F, args); }
#undef IN
#undef SEAM
}

extern "C" void kernel_launch(void* const* d_in, const int* in_sizes, int n_in, void* d_out, int out_size, void* d_ws, size_t ws_size, hipStream_t stream) {
    static int grid = 0;
    if (grid == 0) {
        if (n_in != 32 || out_size != NTOK * 2048 || ws_size < WS_END) { fprintf(stderr, "kernel_launch: unexpected shapes (n_in %d out %d ws %zu); nothing launched\n", n_in, out_size, ws_size); grid = -1; return; }
        int dev = 0, cus = 0, per_cu = 0;
        if (hipGetDevice(&dev) != hipSuccess || hipDeviceGetAttribute(&cus, hipDeviceAttributeMultiprocessorCount, dev) != hipSuccess) { grid = -1; return; }
        if (hipFuncSetAttribute((const void*)mega_fwd, hipFuncAttributeMaxDynamicSharedMemorySize, LDS_BYTES) != hipSuccess) { fprintf(stderr, "kernel_launch: hipFuncSetAttribute failed\n"); grid = -1; return; }
        if (hipOccupancyMaxActiveBlocksPerMultiprocessor(&per_cu, (const void*)mega_fwd, NWAVES * 64, LDS_BYTES) != hipSuccess || per_cu < 1) { fprintf(stderr, "kernel_launch: occupancy query says %d\n", per_cu); }
        (void)hipGetLastError();
        if (cus < 256) { fprintf(stderr, "kernel_launch: needs 256 CUs, found %d; nothing launched\n", cus); grid = -1; return; }
        grid = 256;
    }
    if (grid < 0) return;
    if (hipMemsetAsync((char*)d_ws + WS_CTL, 0, CTL_ZERO_BYTES, stream) != hipSuccess) return;
    Args a{};
    for (int i = 0; i < 32; ++i) a.in[i] = (const float*)d_in[i];
    a.out = (float*)d_out; a.ws = (unsigned char*)d_ws;
#if MK_PER_PHASE
    for (int p = 0; p < N_PHASES; ++p) { a.ph_lo = p; a.ph_hi = p + 1; hipLaunchKernelGGL(mega_fwd, dim3(grid), dim3(NWAVES * 64), LDS_BYTES, stream, a); }
#else
    a.ph_lo = 0; a.ph_hi = N_PHASES;
    hipLaunchKernelGGL(mega_fwd, dim3(grid), dim3(NWAVES * 64), LDS_BYTES, stream, a);
#ifdef MK_PROBE_LO
    for (int p = MK_PROBE_LO; p < MK_PROBE_HI; ++p) { a.ph_lo = p; a.ph_hi = p + 1;
#ifdef MK_HOTPROBE
        a.probe = MK_HOTPROBE;
#endif
        if (p == 2) (void)hipMemsetAsync((char*)d_ws + WS_CTL + CW_QATT * 4, 0, 1024, stream);
        hipLaunchKernelGGL(mega_fwd, dim3(grid), dim3(NWAVES * 64), LDS_BYTES, stream, a); }
#endif
#endif
}
```
